# Optimizing an MI355X kernel written in HIP

```python
import math
import jax, jax.numpy as jnp
from jax import lax
import numpy as np

D_MODEL = 1024
BATCH = 8
SEQ = 2048
DEPTH = 2

MIX_WIDTH = D_MODEL
SSM_WIDTH = MIX_WIDTH // 2
POOL_WIDTH = MIX_WIDTH - SSM_WIDTH
SSM_GROUP = 16
SSM_GROUPS = SSM_WIDTH // SSM_GROUP
SSM_STATE = 64
POOL_WINDOWS = (2, 4, 8, 16)
POOL_GROUPS = 4
POOL_GROUP_WIDTH = POOL_WIDTH // POOL_GROUPS
PEER_HEADS = 8
PEER_N_KEYS = 128
PEER_N_EXPERTS = PEER_N_KEYS * PEER_N_KEYS
PEER_KEY_DIM = 256
PEER_HALF = PEER_KEY_DIM // 2
PEER_TOPK = 16
PEER_CHUNK = 128
RMS_EPS = 1e-6
DT_MIN = 1e-3
DT_MAX = 1e-1

kernel_name = 'hybrid_s5_pool_peer'


def rmsnorm(x, g):
    xf = x.astype(jnp.float32)
    y = xf * lax.rsqrt(jnp.mean(xf * xf, axis=-1, keepdims=True) + RMS_EPS)
    return (y * g.astype(jnp.float32)).astype(x.dtype)


def _complex_affine_combine(left, right):
    a1r, a1i, b1r, b1i = left
    a2r, a2i, b2r, b2i = right
    ar = a1r * a2r - a1i * a2i
    ai = a1r * a2i + a1i * a2r
    br = a2r * b1r - a2i * b1i + b2r
    bi = a2r * b1i + a2i * b1r + b2i
    return ar, ai, br, bi


def s5_mixer(u, a_re, a_im, log_dt, b_re, b_im, c_re, c_im, d_skip, w_glu, b_glu):
    bsz, seq, _ = u.shape
    f32 = jnp.float32
    uf = u.astype(f32).reshape(bsz, seq, SSM_GROUPS, SSM_GROUP)
    lam_re = a_re.astype(f32)
    lam_im = a_im.astype(f32)
    dt = jnp.exp(log_dt.astype(f32))[:, None]
    decay = jnp.exp(lam_re * dt)
    abar_re = decay * jnp.cos(lam_im * dt)
    abar_im = decay * jnp.sin(lam_im * dt)
    inv_den = 1.0 / (lam_re * lam_re + lam_im * lam_im)
    num_re = abar_re - 1.0
    zoh_re = (num_re * lam_re + abar_im * lam_im) * inv_den
    zoh_im = (abar_im * lam_re - num_re * lam_im) * inv_den
    bu_re = jnp.einsum('blgh,gph->blgp', uf, b_re.astype(f32))
    bu_im = jnp.einsum('blgh,gph->blgp', uf, b_im.astype(f32))
    in_re = zoh_re * bu_re - zoh_im * bu_im
    in_im = zoh_re * bu_im + zoh_im * bu_re
    a_seq_re = jnp.broadcast_to(abar_re, in_re.shape)
    a_seq_im = jnp.broadcast_to(abar_im, in_re.shape)
    _, _, s_re, s_im = lax.associative_scan(
        _complex_affine_combine, (a_seq_re, a_seq_im, in_re, in_im), axis=1)
    y = (jnp.einsum('blgp,ghp->blgh', s_re, c_re.astype(f32))
         - jnp.einsum('blgp,ghp->blgh', s_im, c_im.astype(f32))
         + d_skip.astype(f32) * uf)
    y = jax.nn.gelu(y.reshape(bsz, seq, SSM_WIDTH), approximate=False)
    y = y * jax.nn.sigmoid(y @ w_glu.astype(f32) + b_glu.astype(f32))
    return y.astype(u.dtype)


def pool_mixer(u, w_pool, pool_scale):
    bsz, seq, _ = u.shape
    f32 = jnp.float32
    uf = u.astype(f32).reshape(bsz, seq, POOL_GROUPS, POOL_GROUP_WIDTH)
    cs = jnp.cumsum(uf, axis=1)
    pos = jnp.arange(1, seq + 1, dtype=f32)
    outs = []
    for gi, win in enumerate(POOL_WINDOWS):
        csg = cs[:, :, gi]
        lagged = jnp.pad(csg, ((0, 0), (win, 0), (0, 0)))[:, :seq]
        count = jnp.minimum(pos, float(win))[:, None]
        outs.append((csg - lagged) / count - uf[:, :, gi])
    pooled = jnp.stack(outs, axis=2)
    mixed = jnp.einsum('blgc,gcd->blgd', pooled, w_pool.astype(f32))
    y = mixed.reshape(bsz, seq, POOL_WIDTH) * pool_scale.astype(f32)
    return y.astype(u.dtype)


def peer_ffn(h, w_q, k1, k2, u_tab, v_tab):
    bsz, seq, dm = h.shape
    q = jnp.einsum('bld,dk->blk', h, w_q).reshape(bsz, seq, PEER_HEADS, 2, PEER_HALF)
    s1 = jnp.einsum('blhk,nk->blhn', q[..., 0, :], k1).astype(jnp.float32)
    s2 = jnp.einsum('blhk,nk->blhn', q[..., 1, :], k2).astype(jnp.float32)
    v1, i1 = lax.top_k(s1, PEER_TOPK)
    v2, i2 = lax.top_k(s2, PEER_TOPK)
    cand_score = (v1[..., :, None] + v2[..., None, :]).reshape(bsz, seq, PEER_HEADS, PEER_TOPK * PEER_TOPK)
    cand_idx = (i1[..., :, None] * PEER_N_KEYS + i2[..., None, :]).reshape(bsz, seq, PEER_HEADS, PEER_TOPK * PEER_TOPK)
    best, sel = lax.top_k(cand_score, PEER_TOPK)
    experts = jnp.take_along_axis(cand_idx, sel, axis=-1)
    gates = jax.nn.softmax(best, axis=-1).astype(h.dtype)
    n_chunks = (bsz * seq) // PEER_CHUNK
    hc = h.reshape(n_chunks, PEER_CHUNK, dm)
    ec = experts.reshape(n_chunks, PEER_CHUNK, PEER_HEADS, PEER_TOPK)
    gc = gates.reshape(n_chunks, PEER_CHUNK, PEER_HEADS, PEER_TOPK)

    def chunk(args):
        xc, ei, gi = args
        u_sel = jnp.take(u_tab, ei, axis=0)
        act = jax.nn.gelu(jnp.einsum('cd,chkd->chk', xc, u_sel), approximate=False) * gi
        v_sel = jnp.take(v_tab, ei, axis=0)
        return jnp.einsum('chk,chkd->cd', act, v_sel)

    out = lax.map(chunk, (hc, ec, gc))
    return out.reshape(bsz, seq, dm)


def setup_inputs(seed: int = 0) -> dict:
    key = jax.random.key(seed)
    ks = jax.random.split(key, 26)
    f32 = jnp.float32

    def nrm(k, shape, scale):
        return jax.random.normal(k, shape, f32) * scale

    def gain(k, shape):
        return 1.0 + 0.05 * jax.random.normal(k, shape, f32)

    nl, g, p, hh = DEPTH, SSM_GROUPS, SSM_STATE, SSM_GROUP
    x = jax.random.normal(ks[0], (BATCH, SEQ, D_MODEL), f32)
    norm_mix = gain(ks[1], (nl, D_MODEL))
    w_in = nrm(ks[2], (nl, D_MODEL, MIX_WIDTH), D_MODEL ** -0.5)
    a_re = -0.5 + 0.01 * jax.random.normal(ks[3], (nl, g, p), f32)
    a_im = math.pi * jnp.arange(p, dtype=f32) + 0.01 * jax.random.normal(ks[4], (nl, g, p), f32)
    log_dt = jax.random.uniform(ks[5], (nl, g), f32, math.log(DT_MIN), math.log(DT_MAX))
    b_re = nrm(ks[6], (nl, g, p, hh), (2 * hh) ** -0.5)
    b_im = nrm(ks[7], (nl, g, p, hh), (2 * hh) ** -0.5)
    c_re = nrm(ks[8], (nl, g, hh, p), (2 * p) ** -0.5)
    c_im = nrm(ks[9], (nl, g, hh, p), (2 * p) ** -0.5)
    d_skip = nrm(ks[10], (nl, g, hh), 1.0)
    w_glu = nrm(ks[11], (nl, SSM_WIDTH, SSM_WIDTH), SSM_WIDTH ** -0.5)
    b_glu = nrm(ks[12], (nl, SSM_WIDTH), 0.02)
    w_pool = nrm(ks[13], (nl, POOL_GROUPS, POOL_GROUP_WIDTH, POOL_GROUP_WIDTH), POOL_GROUP_WIDTH ** -0.5)
    pool_scale = gain(ks[14], (nl, POOL_WIDTH))
    g_out_ssm = gain(ks[15], (nl, SSM_WIDTH))
    g_out_pool = gain(ks[16], (nl, POOL_WIDTH))
    w_out = nrm(ks[17], (nl, MIX_WIDTH, D_MODEL), MIX_WIDTH ** -0.5)
    norm_ffn = gain(ks[18], (nl, D_MODEL))
    w_q = nrm(ks[19], (nl, D_MODEL, PEER_HEADS * PEER_KEY_DIM), D_MODEL ** -0.5)
    k1 = nrm(ks[20], (nl, PEER_N_KEYS, PEER_HALF), PEER_HALF ** -0.5)
    k2 = nrm(ks[21], (nl, PEER_N_KEYS, PEER_HALF), PEER_HALF ** -0.5)
    u_experts = nrm(ks[22], (nl, PEER_N_EXPERTS, D_MODEL), D_MODEL ** -0.5)
    v_experts = nrm(ks[23], (nl, PEER_N_EXPERTS, D_MODEL), PEER_HEADS ** -0.5)
    norm_final = gain(ks[24], (D_MODEL,))
    return {'x': x, 'norm_mix': norm_mix, 'w_in': w_in, 'a_re': a_re, 'a_im': a_im,
            'log_dt': log_dt, 'b_re': b_re, 'b_im': b_im, 'c_re': c_re, 'c_im': c_im,
            'd_skip': d_skip, 'w_glu': w_glu, 'b_glu': b_glu, 'w_pool': w_pool,
            'pool_scale': pool_scale, 'g_out_ssm': g_out_ssm, 'g_out_pool': g_out_pool,
            'w_out': w_out, 'norm_ffn': norm_ffn, 'w_q': w_q, 'k1': k1, 'k2': k2,
            'u_experts': u_experts, 'v_experts': v_experts, 'norm_final': norm_final}


def reference(x, norm_mix, w_in, a_re, a_im, log_dt, b_re, b_im, c_re, c_im, d_skip,
              w_glu, b_glu, w_pool, pool_scale, g_out_ssm, g_out_pool, w_out, norm_ffn,
              w_q, k1, k2, u_experts, v_experts, norm_final):
    for i in range(DEPTH):
        hn = rmsnorm(x, norm_mix[i])
        proj = jnp.einsum('bld,dm->blm', hn, w_in[i])
        u_ssm = proj[..., :SSM_WIDTH]
        u_pool = proj[..., SSM_WIDTH:]
        y_ssm = s5_mixer(u_ssm, a_re[i], a_im[i], log_dt[i], b_re[i], b_im[i],
                         c_re[i], c_im[i], d_skip[i], w_glu[i], b_glu[i])
        y_pool = pool_mixer(u_pool, w_pool[i], pool_scale[i])
        mixed = jnp.concatenate([rmsnorm(y_ssm, g_out_ssm[i]), rmsnorm(y_pool, g_out_pool[i])], axis=-1)
        x = x + jnp.einsum('blm,md->bld', mixed, w_out[i])
        x = x + peer_ffn(rmsnorm(x, norm_ffn[i]), w_q[i], k1[i], k2[i], u_experts[i], v_experts[i])
    return rmsnorm(x, norm_final)
```

```cpp
#include <hip/hip_runtime.h>
#include <math.h>
#include <stdint.h>

#define NTOK 16384
#define SEQ 2048
#define DM 1024
#define SSMW 512
#define NEXP 16384

__device__ __forceinline__ float gelu_exact(float x) { return 0.5f * x * (1.f + erff(x * 0.70710678118654752f)); }

__device__ __forceinline__ float wave_sum(float v) {
#pragma unroll
    for (int o = 32; o > 0; o >>= 1) v += __shfl_xor(v, o);
    return v;
}

__global__ void __launch_bounds__(256) rmsnorm_rows(const float* __restrict__ x, int ldx, const float* __restrict__ g,
                                                    float* __restrict__ y, int ldy, int W) {
    const int row = blockIdx.x * 4 + (threadIdx.x >> 6), lane = threadIdx.x & 63;
    const float* xr = x + (size_t)row * ldx;
    float ss = 0.f;
    for (int c = lane * 4; c < W; c += 256) { float4 v = *(const float4*)(xr + c); ss += v.x * v.x + v.y * v.y + v.z * v.z + v.w * v.w; }
    ss = wave_sum(ss);
    const float r = rsqrtf(ss / (float)W + 1e-6f);
    float* yr = y + (size_t)row * ldy;
    for (int c = lane * 4; c < W; c += 256) {
        float4 v = *(const float4*)(xr + c); float4 gg = *(const float4*)(g + c);
        float4 o; o.x = v.x * r * gg.x; o.y = v.y * r * gg.y; o.z = v.z * r * gg.z; o.w = v.w * r * gg.w;
        *(float4*)(yr + c) = o;
    }
}

template <int ACC>
__global__ void __launch_bounds__(256) gemm_naive(const float* __restrict__ A, int lda, const float* __restrict__ B, int ldb,
                                                  float* __restrict__ C, int ldc, int K, const float* __restrict__ bias) {
    __shared__ float As[16][68];
    __shared__ float Bs[16][68];
    const int tid = threadIdx.x, tx = tid & 15, ty = tid >> 4;
    const int m0 = blockIdx.y * 64, n0 = blockIdx.x * 64;
    float acc[4][4];
#pragma unroll
    for (int i = 0; i < 4; ++i)
#pragma unroll
        for (int j = 0; j < 4; ++j) acc[i][j] = 0.f;
    const int ar = tid >> 2, ak = (tid & 3) * 4;
    const int bk = tid >> 4, bn = (tid & 15) * 4;
    for (int k0 = 0; k0 < K; k0 += 16) {
        float4 av = *(const float4*)(A + (size_t)(m0 + ar) * lda + k0 + ak);
        float4 bv = *(const float4*)(B + (size_t)(k0 + bk) * ldb + n0 + bn);
        __syncthreads();
        As[ak + 0][ar] = av.x; As[ak + 1][ar] = av.y; As[ak + 2][ar] = av.z; As[ak + 3][ar] = av.w;
        *(float4*)&Bs[bk][bn] = bv;
        __syncthreads();
#pragma unroll
        for (int kk = 0; kk < 16; ++kk) {
            float4 a = *(const float4*)&As[kk][ty * 4];
            float4 b = *(const float4*)&Bs[kk][tx * 4];
            const float aa[4] = {a.x, a.y, a.z, a.w}, bb[4] = {b.x, b.y, b.z, b.w};
#pragma unroll
            for (int i = 0; i < 4; ++i)
#pragma unroll
                for (int j = 0; j < 4; ++j) acc[i][j] = fmaf(aa[i], bb[j], acc[i][j]);
        }
    }
#pragma unroll
    for (int i = 0; i < 4; ++i) {
        float* cp = C + (size_t)(m0 + ty * 4 + i) * ldc + n0 + tx * 4;
        float4 o = make_float4(acc[i][0], acc[i][1], acc[i][2], acc[i][3]);
        if (bias) { float4 bb = *(const float4*)(bias + n0 + tx * 4); o.x += bb.x; o.y += bb.y; o.z += bb.z; o.w += bb.w; }
        if (ACC) { float4 c = *(const float4*)cp; o.x += c.x; o.y += c.y; o.z += c.z; o.w += c.w; }
        *(float4*)cp = o;
    }
}

__global__ void __launch_bounds__(64) s5_naive(const float* __restrict__ proj, const float* __restrict__ a_re, const float* __restrict__ a_im,
                                               const float* __restrict__ log_dt, const float* __restrict__ b_re, const float* __restrict__ b_im,
                                               const float* __restrict__ c_re, const float* __restrict__ c_im, const float* __restrict__ d_skip,
                                               float* __restrict__ ypre) {
    __shared__ float su[64][17];
    __shared__ float ss[64][129];
    const int b = blockIdx.x >> 5, g = blockIdx.x & 31, p = threadIdx.x;
    const float lre = a_re[g * 64 + p], lim = a_im[g * 64 + p], dt = expf(log_dt[g]);
    const float decay = expf(lre * dt);
    const float are = decay * cosf(lim * dt), aim = decay * sinf(lim * dt);
    const float inv = 1.f / (lre * lre + lim * lim), nre = are - 1.f;
    const float zre = (nre * lre + aim * lim) * inv, zim = (aim * lre - nre * lim) * inv;
    float bzr[16], bzi[16];
#pragma unroll
    for (int h = 0; h < 16; ++h) {
        const float br = b_re[(g * 64 + p) * 16 + h], bi = b_im[(g * 64 + p) * 16 + h];
        bzr[h] = zre * br - zim * bi; bzi[h] = zre * bi + zim * br;
    }
    float sr = 0.f, si = 0.f;
#pragma unroll 1
    for (int c = 0; c < SEQ / 64; ++c) {
        __syncthreads();
        {
            const float* src = proj + (size_t)(b * SEQ + c * 64 + p) * DM + g * 16;
#pragma unroll
            for (int h = 0; h < 16; h += 4) { float4 v = *(const float4*)(src + h); su[p][h] = v.x; su[p][h + 1] = v.y; su[p][h + 2] = v.z; su[p][h + 3] = v.w; }
        }
        __syncthreads();
#pragma unroll 1
        for (int j = 0; j < 64; ++j) {
            float ir = 0.f, ii = 0.f;
#pragma unroll
            for (int h = 0; h < 16; ++h) { const float u = su[j][h]; ir = fmaf(bzr[h], u, ir); ii = fmaf(bzi[h], u, ii); }
            const float nr = are * sr - aim * si + ir, ni = are * si + aim * sr + ii;
            sr = nr; si = ni;
            ss[j][p] = sr; ss[j][64 + p] = si;
        }
        __syncthreads();
        float* dst = ypre + (size_t)(b * SEQ + c * 64 + p) * SSMW + g * 16;
#pragma unroll 1
        for (int h = 0; h < 16; ++h) {
            float y = d_skip[g * 16 + h] * su[p][h];
            const float* cr = c_re + (g * 16 + h) * 64; const float* ci = c_im + (g * 16 + h) * 64;
#pragma unroll 4
            for (int q = 0; q < 64; ++q) y += ss[p][q] * cr[q] - ss[p][64 + q] * ci[q];
            dst[h] = y;
        }
    }
}

__global__ void gelu_inplace(float* y, size_t n) {
    size_t i = (size_t)blockIdx.x * blockDim.x + threadIdx.x;
    if (i < n) y[i] = gelu_exact(y[i]);
}
__global__ void glu_gate(float* y, const float* z, size_t n) {
    size_t i = (size_t)blockIdx.x * blockDim.x + threadIdx.x;
    if (i < n) y[i] = y[i] / (1.f + expf(-z[i]));
}
__global__ void pool_naive(const float* __restrict__ proj, float* __restrict__ pooled) {
    size_t i = (size_t)blockIdx.x * blockDim.x + threadIdx.x;
    if (i >= (size_t)NTOK * 512) return;
    const int c = (int)(i & 511); const int tok = (int)(i >> 9);
    const int t = tok & (SEQ - 1);
    const int gi = c >> 7; const int win = 2 << gi;
    const int cnt = (t + 1 < win) ? (t + 1) : win;
    float s = 0.f;
    for (int k = 0; k < cnt; ++k) s += proj[(size_t)(tok - k) * DM + 512 + c];
    pooled[i] = s / (float)cnt - proj[(size_t)tok * DM + 512 + c];
}
__global__ void scale_cols(float* y, const float* sc, size_t n) {
    size_t i = (size_t)blockIdx.x * blockDim.x + threadIdx.x;
    if (i < n) y[i] *= sc[i & 511];
}

__device__ __forceinline__ unsigned long long mk_key(float v, unsigned idx) {
    unsigned u = __float_as_uint(v);
    u ^= (u >> 31) ? 0xFFFFFFFFu : 0x80000000u;
    return ((unsigned long long)u << 32) | (unsigned long long)(0xFFFFFFFFu - idx);
}
__device__ __forceinline__ unsigned long long wave_max_u64(unsigned long long k) {
#pragma unroll
    for (int o = 32; o > 0; o >>= 1) { unsigned long long t = __shfl_xor(k, o); k = (t > k) ? t : k; }
    return k;
}
__global__ void __launch_bounds__(512) peer_route_naive(const float* __restrict__ Q, const float* __restrict__ k1, const float* __restrict__ k2,
                                                        int* __restrict__ experts, float* __restrict__ gates) {
    __shared__ float sq[8][256];
    __shared__ float sv[8][2][16];
    __shared__ int si[8][2][16];
    const int tok = blockIdx.x, w = threadIdx.x >> 6, lane = threadIdx.x & 63;
    const float* qr = Q + (size_t)tok * 2048 + w * 256;
    for (int i = lane; i < 256; i += 64) sq[w][i] = qr[i];
    __syncthreads();
    for (int half = 0; half < 2; ++half) {
        const float* kt = half ? k2 : k1;
        float s[2];
#pragma unroll
        for (int r = 0; r < 2; ++r) {
            const float* kr = kt + (size_t)(lane + 64 * r) * 128;
            float a = 0.f;
            for (int k = 0; k < 128; ++k) a = fmaf(sq[w][half * 128 + k], kr[k], a);
            s[r] = a;
        }
        bool used0 = false, used1 = false;
        for (int it = 0; it < 16; ++it) {
            unsigned long long key0 = used0 ? 0ull : mk_key(s[0], lane);
            unsigned long long key1 = used1 ? 0ull : mk_key(s[1], lane + 64);
            unsigned long long key = key0 > key1 ? key0 : key1;
            key = wave_max_u64(key);
            const unsigned idx = 0xFFFFFFFFu - (unsigned)(key & 0xFFFFFFFFull);
            if (idx == (unsigned)lane) { used0 = true; sv[w][half][it] = s[0]; si[w][half][it] = lane; }
            if (idx == (unsigned)(lane + 64)) { used1 = true; sv[w][half][it] = s[1]; si[w][half][it] = lane + 64; }
        }
    }
    __syncthreads();
    float cs[4]; bool used[4];
#pragma unroll
    for (int j = 0; j < 4; ++j) { const int c = lane + 64 * j; cs[j] = sv[w][0][c >> 4] + sv[w][1][c & 15]; used[j] = false; }
    float mybest = 0.f; int mye = 0;
    for (int it = 0; it < 16; ++it) {
        unsigned long long key = 0ull;
#pragma unroll
        for (int j = 0; j < 4; ++j) { unsigned long long kj = used[j] ? 0ull : mk_key(cs[j], lane + 64 * j); key = kj > key ? kj : key; }
        key = wave_max_u64(key);
        const unsigned idx = 0xFFFFFFFFu - (unsigned)(key & 0xFFFFFFFFull);
        float val = 0.f;
#pragma unroll
        for (int j = 0; j < 4; ++j) if (idx == (unsigned)(lane + 64 * j)) { used[j] = true; val = cs[j]; }
        val = __shfl(val, idx & 63);
        if (lane == it) { mybest = val; mye = si[w][0][idx >> 4] * 128 + si[w][1][idx & 15]; }
    }
    const float mx = __shfl(mybest, 0);
    float e = (lane < 16) ? expf(mybest - mx) : 0.f;
    const float sum = wave_sum(e);
    if (lane < 16) {
        experts[((size_t)tok * 8 + w) * 16 + lane] = mye;
        gates[((size_t)tok * 8 + w) * 16 + lane] = e / sum;
    }
}

__global__ void __launch_bounds__(512) peer_apply_naive(const float* __restrict__ H, const int* __restrict__ experts, const float* __restrict__ gates,
                                                        const float* __restrict__ ut, const float* __restrict__ vt, float* __restrict__ X) {
    __shared__ float part[8][1024];
    const int tok = blockIdx.x, w = threadIdx.x >> 6, lane = threadIdx.x & 63;
    const float* hr = H + (size_t)tok * DM;
    float4 h[4], acc[4];
#pragma unroll
    for (int j = 0; j < 4; ++j) { h[j] = *(const float4*)(hr + j * 256 + lane * 4); acc[j] = make_float4(0.f, 0.f, 0.f, 0.f); }
    for (int k = 0; k < 16; ++k) {
        const int e = experts[((size_t)tok * 8 + w) * 16 + k];
        const float gt = gates[((size_t)tok * 8 + w) * 16 + k];
        const float* ur = ut + (size_t)e * DM; const float* vr = vt + (size_t)e * DM;
        float d = 0.f;
#pragma unroll
        for (int j = 0; j < 4; ++j) { float4 u = *(const float4*)(ur + j * 256 + lane * 4); d += u.x * h[j].x + u.y * h[j].y + u.z * h[j].z + u.w * h[j].w; }
        d = wave_sum(d);
        const float a = gelu_exact(d) * gt;
#pragma unroll
        for (int j = 0; j < 4; ++j) { float4 v = *(const float4*)(vr + j * 256 + lane * 4); acc[j].x += a * v.x; acc[j].y += a * v.y; acc[j].z += a * v.z; acc[j].w += a * v.w; }
    }
#pragma unroll
    for (int j = 0; j < 4; ++j) *(float4*)&part[w][j * 256 + lane * 4] = acc[j];
    __syncthreads();
    for (int c = threadIdx.x; c < 1024; c += 512) {
        float s = 0.f;
#pragma unroll
        for (int ww = 0; ww < 8; ++ww) s += part[ww][c];
        X[(size_t)tok * DM + c] += s;
    }
}

static void gemm(hipStream_t st, bool acc, const float* A, int lda, const float* B, int ldb, float* C, int ldc, int M, int N, int K, const float* bias) {
    dim3 grid(N / 64, M / 64);
    if (acc) gemm_naive<1><<<grid, 256, 0, st>>>(A, lda, B, ldb, C, ldc, K, bias);
    else gemm_naive<0><<<grid, 256, 0, st>>>(A, lda, B, ldb, C, ldc, K, bias);
}

extern "C" void kernel_launch(void* const* d_in, const int* in_sizes, int n_in, void* d_out, int out_size, void* d_ws, size_t ws_size,
                              hipStream_t stream) {
    const float* x = (const float*)d_in[0];
    const float* norm_mix = (const float*)d_in[1];
    const float* w_in = (const float*)d_in[2];
    const float* a_re = (const float*)d_in[3];
    const float* a_im = (const float*)d_in[4];
    const float* log_dt = (const float*)d_in[5];
    const float* b_re = (const float*)d_in[6];
    const float* b_im = (const float*)d_in[7];
    const float* c_re = (const float*)d_in[8];
    const float* c_im = (const float*)d_in[9];
    const float* d_skip = (const float*)d_in[10];
    const float* w_glu = (const float*)d_in[11];
    const float* b_glu = (const float*)d_in[12];
    const float* w_pool = (const float*)d_in[13];
    const float* pool_scale = (const float*)d_in[14];
    const float* g_out_ssm = (const float*)d_in[15];
    const float* g_out_pool = (const float*)d_in[16];
    const float* w_out = (const float*)d_in[17];
    const float* norm_ffn = (const float*)d_in[18];
    const float* w_q = (const float*)d_in[19];
    const float* k1 = (const float*)d_in[20];
    const float* k2 = (const float*)d_in[21];
    const float* u_exp = (const float*)d_in[22];
    const float* v_exp = (const float*)d_in[23];
    const float* norm_final = (const float*)d_in[24];

    float* ws = (float*)d_ws;
    float* X = ws;
    float* HN = X + (size_t)NTOK * DM;
    float* PROJ = HN + (size_t)NTOK * DM;
    float* Y = PROJ + (size_t)NTOK * DM;
    float* Z = Y + (size_t)NTOK * 512;
    float* MIX = Z + (size_t)NTOK * 512;
    float* Q = MIX + (size_t)NTOK * DM;
    float* GT = Q + (size_t)NTOK * 2048;
    int* EX = (int*)(GT + (size_t)NTOK * 128);

    hipMemcpyAsync(X, x, (size_t)NTOK * DM * 4, hipMemcpyDeviceToDevice, stream);
    const size_t nh = (size_t)NTOK * 512;
    for (int l = 0; l < 2; ++l) {
        rmsnorm_rows<<<NTOK / 4, 256, 0, stream>>>(X, DM, norm_mix + l * DM, HN, DM, DM);
        gemm(stream, false, HN, DM, w_in + (size_t)l * DM * DM, DM, PROJ, DM, NTOK, DM, DM, nullptr);
        s5_naive<<<256, 64, 0, stream>>>(PROJ, a_re + l * 2048, a_im + l * 2048, log_dt + l * 32, b_re + l * 32768, b_im + l * 32768,
                                         c_re + l * 32768, c_im + l * 32768, d_skip + l * 512, Y);
        gelu_inplace<<<(unsigned)(nh / 256), 256, 0, stream>>>(Y, nh);
        gemm(stream, false, Y, 512, w_glu + (size_t)l * 512 * 512, 512, Z, 512, NTOK, 512, 512, b_glu + l * 512);
        glu_gate<<<(unsigned)(nh / 256), 256, 0, stream>>>(Y, Z, nh);
        rmsnorm_rows<<<NTOK / 4, 256, 0, stream>>>(Y, 512, g_out_ssm + l * 512, MIX, DM, 512);
        pool_naive<<<(unsigned)(nh / 256), 256, 0, stream>>>(PROJ, Y);
        for (int gi = 0; gi < 4; ++gi)
            gemm(stream, false, Y + gi * 128, 512, w_pool + (size_t)(l * 4 + gi) * 128 * 128, 128, Z + gi * 128, 512, NTOK, 128, 128, nullptr);
        scale_cols<<<(unsigned)(nh / 256), 256, 0, stream>>>(Z, pool_scale + l * 512, nh);
        rmsnorm_rows<<<NTOK / 4, 256, 0, stream>>>(Z, 512, g_out_pool + l * 512, MIX + 512, DM, 512);
        gemm(stream, true, MIX, DM, w_out + (size_t)l * DM * DM, DM, X, DM, NTOK, DM, DM, nullptr);
        rmsnorm_rows<<<NTOK / 4, 256, 0, stream>>>(X, DM, norm_ffn + l * DM, HN, DM, DM);
        gemm(stream, false, HN, DM, w_q + (size_t)l * DM * 2048, 2048, Q, 2048, NTOK, 2048, DM, nullptr);
        peer_route_naive<<<NTOK, 512, 0, stream>>>(Q, k1 + (size_t)l * 128 * 128, k2 + (size_t)l * 128 * 128, EX, GT);
        peer_apply_naive<<<NTOK, 512, 0, stream>>>(HN, EX, GT, u_exp + (size_t)l * NEXP * DM, v_exp + (size_t)l * NEXP * DM, X);
    }
    rmsnorm_rows<<<NTOK / 4, 256, 0, stream>>>(X, DM, norm_final, (float*)d_out, DM, DM);
}
```

```cpp
#include <hip/hip_runtime.h>
#include <math.h>
#include <stdint.h>

#define NTOK 16384
#define SEQ 2048
#define DM 1024
#define SSMW 512
#define NEXP 16384

__device__ __forceinline__ float gelu_exact(float x) { return 0.5f * x * (1.f + erff(x * 0.70710678118654752f)); }

__device__ __forceinline__ float wave_sum(float v) {
#pragma unroll
    for (int o = 32; o > 0; o >>= 1) v += __shfl_xor(v, o);
    return v;
}

#define DI __device__ __forceinline__
typedef __attribute__((ext_vector_type(8))) short bf16x8;
typedef __attribute__((ext_vector_type(16))) float f32x16;
typedef __attribute__((ext_vector_type(2))) __bf16 bf2_t;
typedef __attribute__((ext_vector_type(2))) float f2_t;
typedef unsigned short bf16_t;
typedef __attribute__((ext_vector_type(4))) unsigned u32x4;
typedef __attribute__((ext_vector_type(4))) float f32x4;
typedef const __attribute__((address_space(1))) bf16x8* gwp_t;
#define MFMA32(a, b, c) __builtin_amdgcn_mfma_f32_32x32x16_bf16((a), (b), (c), 0, 0, 0)

DI unsigned pack_bf2(float a, float b) { f2_t v = {a, b}; return __builtin_bit_cast(unsigned, __builtin_convertvector(v, bf2_t)); }
DI float bf_lo(unsigned u) { return __uint_as_float(u << 16); }
DI float bf_hi(unsigned u) { return __uint_as_float(u & 0xffff0000u); }
DI int crow(int reg, int h) { return (reg & 3) + 8 * (reg >> 2) + 4 * h; }

#define SA_STRIDE 272
#define SA_BYTES (64 * SA_STRIDE)
#define NTHR 512

DI void conv_wfrag(const float* __restrict__ src, int ldk, int ldn, const float* __restrict__ ga, const float* __restrict__ gb, int split,
                   int K, int N, int NTG, bf16x8* __restrict__ dst, size_t gtid, size_t gstride) {
    const int KS = K / 16;
    const size_t total = (size_t)(N / 32) * KS * 64;
    for (size_t item = gtid; item < total; item += gstride) {
        const int lane = (int)(item & 63); const size_t f = item >> 6;
        const int nti = (int)(f % NTG); const size_t f2 = f / NTG;
        const int ks = (int)(f2 % KS), nt = (int)(f2 / KS) * NTG + nti;
        const int r = lane & 31, h = lane >> 5;
        const int n = nt * 32 + r, k0 = ks * 16 + 8 * h;
        float v[8];
#pragma unroll
        for (int j = 0; j < 8; ++j) {
            const int k = k0 + j;
            const float g = (k < split) ? ga[k] : gb[k - split];
            v[j] = src[(size_t)k * ldk + (size_t)n * ldn] * g;
        }
        uint4 o; o.x = pack_bf2(v[0], v[1]); o.y = pack_bf2(v[2], v[3]); o.z = pack_bf2(v[4], v[5]); o.w = pack_bf2(v[6], v[7]);
        *(uint4*)(dst + item) = o;
    }
}

DI void conv_rows_bf16(const float* __restrict__ src, const float* __restrict__ gain, bf16_t* __restrict__ dst, size_t nelem, size_t gtid, size_t gstride) {
    for (size_t i = gtid * 8; i < nelem; i += gstride * 8) {
        float4 a = *(const float4*)(src + i), b = *(const float4*)(src + i + 4);
        if (gain) {
            const int c = (int)(i & 1023);
            float4 g0 = *(const float4*)(gain + c), g1 = *(const float4*)(gain + c + 4);
            a.x *= g0.x; a.y *= g0.y; a.z *= g0.z; a.w *= g0.w; b.x *= g1.x; b.y *= g1.y; b.z *= g1.z; b.w *= g1.w;
        }
        uint4 o; o.x = pack_bf2(a.x, a.y); o.y = pack_bf2(a.z, a.w); o.z = pack_bf2(b.x, b.y); o.w = pack_bf2(b.z, b.w);
        *(uint4*)(dst + i) = o;
    }
}

struct ALoadF32 {
    const float* base; f32x4 v0, v1, v2, v3; float ss;
    DI void init(const float* rowbase) { base = rowbase + (threadIdx.x & 7) * 16; ss = 0.f; }
    DI void issue(int c) { const f32x4* p = (const f32x4*)(base + c * 128); v0 = p[0]; v1 = p[1]; v2 = p[2]; v3 = p[3]; }
    DI void commit(char* buf) {
        u32x4 o0, o1;
        ss += v0.x * v0.x + v0.y * v0.y + v0.z * v0.z + v0.w * v0.w + v1.x * v1.x + v1.y * v1.y + v1.z * v1.z + v1.w * v1.w
            + v2.x * v2.x + v2.y * v2.y + v2.z * v2.z + v2.w * v2.w + v3.x * v3.x + v3.y * v3.y + v3.z * v3.z + v3.w * v3.w;
        o0.x = pack_bf2(v0.x, v0.y); o0.y = pack_bf2(v0.z, v0.w); o0.z = pack_bf2(v1.x, v1.y); o0.w = pack_bf2(v1.z, v1.w);
        o1.x = pack_bf2(v2.x, v2.y); o1.y = pack_bf2(v2.z, v2.w); o1.z = pack_bf2(v3.x, v3.y); o1.w = pack_bf2(v3.z, v3.w);
        char* d = buf + (threadIdx.x >> 3) * SA_STRIDE + (threadIdx.x & 7) * 32;
        *(u32x4*)d = o0; *(u32x4*)(d + 16) = o1;
    }
};
struct ALoadBF16 {
    const bf16_t* base; u32x4 v0, v1;
    DI void init(const bf16_t* rowbase) { base = rowbase + (threadIdx.x & 7) * 16; }
    DI void issue(int c) { const u32x4* p = (const u32x4*)(base + c * 128); v0 = p[0]; v1 = p[1]; }
    DI void commit(char* buf) {
        char* d = buf + (threadIdx.x >> 3) * SA_STRIDE + (threadIdx.x & 7) * 32;
        *(u32x4*)d = v0; *(u32x4*)(d + 16) = v1;
    }
};

template <int NT, int PF, class AL>
DI void gemm64(f32x16 (&acc)[NT][2], AL& al, const int nchunks, const bf16x8* __restrict__ wf_, char* sA) {
    gwp_t wf = (gwp_t)wf_;
    const int lane = threadIdx.x & 63, r = lane & 31, h = lane >> 5;
    bf16x8 bq[PF][NT];
    al.issue(0);
#pragma unroll
    for (int p = 0; p < PF; ++p)
#pragma unroll
        for (int nt = 0; nt < NT; ++nt) bq[p][nt] = wf[(p * NT + nt) * 64];
    gwp_t wpf = wf + PF * NT * 64;
    al.commit(sA);
    const int kend = nchunks * 8 - PF;
    int kg = 0;
#pragma unroll 1
    for (int c = 0; c < nchunks; ++c) {
        if (c + 1 < nchunks) al.issue(c + 1);
        __syncthreads();
        const char* buf = sA + (c & 1) * SA_BYTES + r * SA_STRIDE + h * 16;
#pragma unroll
        for (int ks = 0; ks < 8; ++ks) {
            const bf16x8 a0 = *(const bf16x8*)(buf + ks * 32);
            const bf16x8 a1 = *(const bf16x8*)(buf + 32 * SA_STRIDE + ks * 32);
#pragma unroll
            for (int nt = 0; nt < NT; ++nt) {
                acc[nt][0] = MFMA32(bq[ks % PF][nt], a0, acc[nt][0]);
                acc[nt][1] = MFMA32(bq[ks % PF][nt], a1, acc[nt][1]);
            }
            if (kg < kend) {
#pragma unroll
                for (int nt = 0; nt < NT; ++nt) bq[ks % PF][nt] = wpf[nt * 64];
            }
            wpf += NT * 64; ++kg;
            asm volatile("" : "+v"(wpf));
        }
        if (c + 1 < nchunks) al.commit(sA + ((c + 1) & 1) * SA_BYTES);
    }
    __syncthreads();
}

template <int NT>
DI void zero_acc(f32x16 (&acc)[NT][2]) {
#pragma unroll
    for (int nt = 0; nt < NT; ++nt)
#pragma unroll
        for (int mt = 0; mt < 2; ++mt)
#pragma unroll
            for (int i = 0; i < 16; ++i) acc[nt][mt][i] = 0.f;
}

DI void phaseA_tile(const float* __restrict__ X, const bf16x8* __restrict__ wfin, bf16_t* __restrict__ U, int tile, char* smem) {
    char* sA = smem; float* srstd = (float*)(smem + 2 * SA_BYTES);
    const int tid = threadIdx.x, w = tid >> 6, lane = tid & 63, r = lane & 31, h = lane >> 5;
    const int tok0 = tile * 64;
    ALoadF32 al; al.init(X + (size_t)(tok0 + (tid >> 3)) * DM);
    f32x16 acc[4][2]; zero_acc<4>(acc);
    gemm64<4, 2>(acc, al, 8, wfin + (size_t)w * (64 * 4 * 64) + lane, sA);
    float ss = al.ss;
    ss += __shfl_xor(ss, 1); ss += __shfl_xor(ss, 2); ss += __shfl_xor(ss, 4);
    if ((tid & 7) == 0) srstd[tid >> 3] = rsqrtf(ss * (1.f / 1024.f) + 1e-6f);
    __syncthreads();
#pragma unroll
    for (int mt = 0; mt < 2; ++mt) {
        const float rs = srstd[mt * 32 + r];
        bf16_t* orow = U + (size_t)(tok0 + mt * 32 + r) * DM + w * 128;
#pragma unroll
        for (int nt = 0; nt < 4; ++nt)
#pragma unroll
            for (int q = 0; q < 4; ++q) {
                uint2 o; o.x = pack_bf2(acc[nt][mt][4 * q] * rs, acc[nt][mt][4 * q + 1] * rs);
                o.y = pack_bf2(acc[nt][mt][4 * q + 2] * rs, acc[nt][mt][4 * q + 3] * rs);
                *(uint2*)(orow + nt * 32 + 8 * q + 4 * h) = o;
            }
    }
    __syncthreads();
}

__global__ void __launch_bounds__(NTHR) k_prep_weights(const float* norm_mix, const float* w_in, const float* w_glu, const float* w_pool,
                                                       const float* g_out_ssm, const float* g_out_pool, const float* w_out, const float* norm_ffn,
                                                       const float* w_q, const float* k1, const float* k2,
                                                       bf16x8* wfin, bf16x8* wfglu, bf16x8* wfpool, bf16x8* wfout, bf16x8* wfq, bf16x8* wfk1, bf16x8* wfk2, const float* ones) {
    const size_t gtid = (size_t)blockIdx.x * blockDim.x + threadIdx.x, gs = (size_t)gridDim.x * blockDim.x;
    for (int l = 0; l < 2; ++l) {
        conv_wfrag(w_in + (size_t)l * DM * DM, DM, 1, norm_mix + l * DM, ones, DM, DM, DM, 4, wfin + (size_t)l * (DM * DM / 8), gtid, gs);
        conv_wfrag(w_glu + (size_t)l * 512 * 512, 512, 1, ones, ones, 512, 512, 512, 2, wfglu + (size_t)l * (512 * 512 / 8), gtid, gs);
        for (int gi = 0; gi < 4; ++gi)
            conv_wfrag(w_pool + (size_t)(l * 4 + gi) * 128 * 128, 128, 1, ones, ones, 128, 128, 128, 2, wfpool + (size_t)(l * 4 + gi) * (128 * 128 / 8), gtid, gs);
        conv_wfrag(w_out + (size_t)l * DM * DM, DM, 1, g_out_ssm + l * 512, g_out_pool + l * 512, 512, DM, DM, 4, wfout + (size_t)l * (DM * DM / 8), gtid, gs);
        conv_wfrag(w_q + (size_t)l * DM * 2048, 2048, 1, norm_ffn + l * DM, ones, DM, DM, 2048, 4, wfq + (size_t)l * (DM * 2048 / 8), gtid, gs);
        conv_wfrag(k1 + (size_t)l * 128 * 128, 1, 128, ones, ones, 128, 128, 128, 4, wfk1 + (size_t)l * (128 * 128 / 8), gtid, gs);
        conv_wfrag(k2 + (size_t)l * 128 * 128, 1, 128, ones, ones, 128, 128, 128, 4, wfk2 + (size_t)l * (128 * 128 / 8), gtid, gs);
    }
}

__global__ void k_fill_ones(float* p, int n) { int i = blockIdx.x * blockDim.x + threadIdx.x; if (i < n) p[i] = 1.f; }

__global__ void __launch_bounds__(NTHR) k_phaseA(const float* X, const bf16x8* wfin, bf16_t* U) {
    __shared__ __attribute__((aligned(16))) char smem[2 * SA_BYTES + 256];
    for (int tile = blockIdx.x; tile < NTOK / 64; tile += gridDim.x) phaseA_tile(X, wfin, U, tile, smem);
}
#define KT_BLK 528
#define KT_BYTES (65 * KT_BLK)
#define WST_FRAGS (4 * 64 * 64)
#define CCAR_FRAGS (32 * 8 * 64)
#define SU_CH 2064

DI void prep_s5_item(int lg, const float* __restrict__ a_re, const float* __restrict__ a_im, const float* __restrict__ log_dt,
                     const float* __restrict__ b_re, const float* __restrict__ b_im, const float* __restrict__ c_re, const float* __restrict__ c_im,
                     const float* __restrict__ d_skip, char* __restrict__ KT, bf16x8* __restrict__ WST, bf16x8* __restrict__ CCAR,
                     float* __restrict__ ABT, char* smem) {
    float* powr = (float*)smem;
    float* powi = powr + 65 * 64;
    float* bzr = powi + 65 * 64;
    float* bzi = bzr + 1024;
    float* cr = bzi + 1024;
    float* ci = cr + 1024;
    const int tid = threadIdx.x;
    const float* are_p = a_re + lg * 64; const float* aim_p = a_im + lg * 64;
    const float dt = expf(log_dt[lg]);
    for (int it = tid; it < 65 * 64; it += NTHR) {
        const int tau = it >> 6, p = it & 63;
        const float lre = are_p[p], lim = aim_p[p];
        const float mag = expf((float)tau * lre * dt);
        double rev = (double)lim * (double)dt * (double)tau * 0.15915494309189535;
        rev -= floor(rev);
        const float ang = (float)rev * 6.283185307179586f;
        powr[it] = mag * cosf(ang); powi[it] = mag * sinf(ang);
    }
    for (int it = tid; it < 1024; it += NTHR) {
        cr[it] = c_re[lg * 1024 + it]; ci[it] = c_im[lg * 1024 + it];
    }
    __syncthreads();
    for (int it = tid; it < 1024; it += NTHR) {
        const int p = it >> 4;
        const float lre = are_p[p], lim = aim_p[p];
        const float ar = powr[64 + p], ai = powi[64 + p];
        const float inv = 1.f / (lre * lre + lim * lim), nre = ar - 1.f;
        const float zre = (nre * lre + ai * lim) * inv, zim = (ai * lre - nre * lim) * inv;
        const float br = b_re[lg * 1024 + it], bi = b_im[lg * 1024 + it];
        bzr[it] = zre * br - zim * bi; bzi[it] = zre * bi + zim * br;
    }
    __syncthreads();
    if (tid < 64) { ABT[lg * 128 + 2 * tid] = powr[64 * 64 + tid]; ABT[lg * 128 + 2 * tid + 1] = powi[64 * 64 + tid]; }
    char* kt = KT + (size_t)lg * KT_BYTES;
    for (int it = tid; it < KT_BLK / 4; it += NTHR) ((unsigned*)kt)[it] = 0u;
    for (int it = tid; it < 64 * 128; it += NTHR) {
        const int tau = it >> 7, ho = (it >> 3) & 15, hi = (it & 7) * 2;
        float s0 = 0.f, s1 = 0.f;
        for (int p = 0; p < 64; ++p) {
            const float c_r = cr[ho * 64 + p], c_i = ci[ho * 64 + p], pr = powr[tau * 64 + p], pi = powi[tau * 64 + p];
            const float cpr = c_r * pr - c_i * pi, cpi = c_r * pi + c_i * pr;
            s0 += cpr * bzr[p * 16 + hi] - cpi * bzi[p * 16 + hi];
            s1 += cpr * bzr[p * 16 + hi + 1] - cpi * bzi[p * 16 + hi + 1];
        }
        if (tau == 0) { if (ho == hi) s0 += d_skip[lg * 16 + ho]; if (ho == hi + 1) s1 += d_skip[lg * 16 + ho]; }
        *(unsigned*)(kt + (tau + 1) * KT_BLK + ho * 32 + hi * 2) = pack_bf2(s0, s1);
    }
    for (int it = tid; it < 65 * 4; it += NTHR) ((unsigned*)(kt + (it >> 2) * KT_BLK + 512))[it & 3] = 0u;
    bf16x8* wst = WST + (size_t)lg * WST_FRAGS;
    for (int it = tid; it < WST_FRAGS; it += NTHR) {
        const int lane = it & 63, j = (it >> 6) & 63, nt = it >> 12;
        const int r = lane & 31, h = lane >> 5, n = nt * 32 + r, p = n & 63, im = n >> 6;
        const float pr = powr[(63 - j) * 64 + p], pi = powi[(63 - j) * 64 + p];
        float v[8];
#pragma unroll
        for (int jj = 0; jj < 8; ++jj) {
            const float zr = bzr[p * 16 + 8 * h + jj], zi = bzi[p * 16 + 8 * h + jj];
            v[jj] = im ? (pr * zi + pi * zr) : (pr * zr - pi * zi);
        }
        uint4 o; o.x = pack_bf2(v[0], v[1]); o.y = pack_bf2(v[2], v[3]); o.z = pack_bf2(v[4], v[5]); o.w = pack_bf2(v[6], v[7]);
        *(uint4*)(wst + it) = o;
    }
    bf16x8* cc = CCAR + (size_t)lg * CCAR_FRAGS;
    for (int it = tid; it < CCAR_FRAGS; it += NTHR) {
        const int lane = it & 63, ks = (it >> 6) & 7, mt = it >> 9;
        const int r = lane & 31, h = lane >> 5, m = mt * 32 + r, i = m >> 4, ho = m & 15;
        float v[8];
#pragma unroll
        for (int jj = 0; jj < 8; ++jj) {
            const int k = ks * 16 + 8 * h + jj, p = k & 63, im = k >> 6;
            const float c_r = cr[ho * 64 + p], c_i = ci[ho * 64 + p], pr = powr[(i + 1) * 64 + p], pi = powi[(i + 1) * 64 + p];
            v[jj] = im ? -(c_r * pi + c_i * pr) : (c_r * pr - c_i * pi);
        }
        uint4 o; o.x = pack_bf2(v[0], v[1]); o.y = pack_bf2(v[2], v[3]); o.z = pack_bf2(v[4], v[5]); o.w = pack_bf2(v[6], v[7]);
        *(uint4*)(cc + it) = o;
    }
    __syncthreads();
}

#define PB_SU 0
#define PB_SKT (32 * SU_CH)
#define PB_SL (PB_SKT + KT_BYTES)
#define PB_SPART (PB_SL + 32 * 132 * 4)
#define PB_SSP (PB_SPART + 4 * 4096)
#define PB_BYTES (PB_SSP + 32 * 272)

DI void phaseB_tile(const bf16_t* __restrict__ U, const char* __restrict__ KT, const bf16x8* __restrict__ WST, const bf16x8* __restrict__ CCAR,
                    const float* __restrict__ ABT, bf16_t* __restrict__ YPRE, int tile, char* smem) {
    const int g = tile & 31, b = tile >> 5;
    const int tid = threadIdx.x, w = tid >> 6, lane = tid & 63, r = lane & 31, h = lane >> 5;
    char* sU = smem + PB_SU; char* sKT = smem + PB_SKT; float* sL = (float*)(smem + PB_SL); float* sPart = (float*)(smem + PB_SPART);
    char* sSp = smem + PB_SSP;
#pragma unroll
    for (int it = 0; it < 4; ++it) {
        const int tok = tid + NTHR * it;
        const uint4* src = (const uint4*)(U + (size_t)(b * SEQ + tok) * DM + g * 16);
        const uint4 v0 = src[0], v1 = src[1];
        char* d = sU + (tok >> 6) * SU_CH + (tok & 63) * 32;
        *(uint4*)d = v0; *(uint4*)(d + 16) = v1;
    }
    {
        const uint4* src = (const uint4*)(KT + (size_t)g * KT_BYTES);
        for (int it = tid; it < KT_BYTES / 16; it += NTHR) ((uint4*)sKT)[it] = src[it];
    }
    __syncthreads();
    {
        const int nt = w & 3, kh = w >> 2;
        f32x16 acc;
#pragma unroll
        for (int i = 0; i < 16; ++i) acc[i] = 0.f;
        const bf16x8* wp = WST + (size_t)g * WST_FRAGS + (size_t)(nt * 64 + kh * 32) * 64 + lane;
        const char* up = sU + r * SU_CH + h * 16 + kh * 32 * 32;
#pragma unroll 4
        for (int j = 0; j < 32; ++j) {
            const bf16x8 a = wp[j * 64];
            const bf16x8 bb = *(const bf16x8*)(up + j * 32);
            acc = MFMA32(a, bb, acc);
        }
        if (kh == 1) {
#pragma unroll
            for (int i = 0; i < 16; ++i) sPart[(nt * 16 + i) * 64 + lane] = acc[i];
        }
        __syncthreads();
        if (kh == 0) {
#pragma unroll
            for (int i = 0; i < 16; ++i) sL[r * 132 + nt * 32 + crow(i, h)] = acc[i] + sPart[(nt * 16 + i) * 64 + lane];
        }
        __syncthreads();
    }
    if (tid < 64) {
        const int p = tid;
        const float ar = ABT[g * 128 + 2 * p], ai = ABT[g * 128 + 2 * p + 1];
        float sr = 0.f, si = 0.f;
        for (int c = 0; c < 32; ++c) {
            *(bf16_t*)(sSp + c * 272 + p * 2) = (bf16_t)(pack_bf2(sr, 0.f) & 0xffffu);
            *(bf16_t*)(sSp + c * 272 + (64 + p) * 2) = (bf16_t)(pack_bf2(si, 0.f) & 0xffffu);
            const float lr = sL[c * 132 + p], li = sL[c * 132 + 64 + p];
            const float nr = ar * sr - ai * si + lr, ni = ar * si + ai * sr + li;
            sr = nr; si = ni;
        }
    }
    f32x16 acc4[4];
#pragma unroll
    for (int q = 0; q < 4; ++q)
#pragma unroll
        for (int i = 0; i < 16; ++i) acc4[q][i] = 0.f;
    const int mts0 = w, mts1 = 15 - w, mts2 = 16 + w, mts3 = 31 - w;
    {
        const char* up = sU + r * SU_CH + h * 16;
        const char* kp = sKT + (r & 15) * 32 + h * 16 + ((r >> 4) + 1) * KT_BLK;
        for (int j = 0; j < 64; ++j) {
            const bf16x8 bb = *(const bf16x8*)(up + j * 32);
#define TOEP_STEP(q, mt) if (2 * (mt) + 1 >= j) { const bf16x8 a = *(const bf16x8*)(kp + (2 * (mt) - j) * KT_BLK); acc4[q] = MFMA32(a, bb, acc4[q]); }
            TOEP_STEP(0, mts0) TOEP_STEP(1, mts1) TOEP_STEP(2, mts2) TOEP_STEP(3, mts3)
#undef TOEP_STEP
        }
    }
    __syncthreads();
    {
        const bf16x8* cp = CCAR + (size_t)g * CCAR_FRAGS + lane;
        const char* sp = sSp + r * 272 + h * 16;
#pragma unroll
        for (int ks = 0; ks < 8; ++ks) {
            const bf16x8 bb = *(const bf16x8*)(sp + ks * 32);
            acc4[0] = MFMA32(cp[(mts0 * 8 + ks) * 64], bb, acc4[0]);
            acc4[1] = MFMA32(cp[(mts1 * 8 + ks) * 64], bb, acc4[1]);
            acc4[2] = MFMA32(cp[(mts2 * 8 + ks) * 64], bb, acc4[2]);
            acc4[3] = MFMA32(cp[(mts3 * 8 + ks) * 64], bb, acc4[3]);
        }
    }
    {
        bf16_t* ybase = YPRE + (size_t)(b * SEQ + r * 64) * 512 + g * 16;
#define PB_STORE(q, mt) _Pragma("unroll") for (int rq = 0; rq < 4; ++rq) { const int c0 = 8 * rq + 4 * h; const int i = 2 * (mt) + (c0 >> 4); \
            uint2 o; o.x = pack_bf2(acc4[q][4 * rq], acc4[q][4 * rq + 1]); o.y = pack_bf2(acc4[q][4 * rq + 2], acc4[q][4 * rq + 3]); \
            *(uint2*)(ybase + (size_t)i * 512 + (c0 & 15)) = o; }
        PB_STORE(0, mts0) PB_STORE(1, mts1) PB_STORE(2, mts2) PB_STORE(3, mts3)
#undef PB_STORE
    }
    __syncthreads();
}

__global__ void __launch_bounds__(NTHR) k_prep_s5(const float* a_re, const float* a_im, const float* log_dt, const float* b_re, const float* b_im,
                                                  const float* c_re, const float* c_im, const float* d_skip, char* KT, bf16x8* WST, bf16x8* CCAR, float* ABT) {
    __shared__ __attribute__((aligned(16))) char smem[(2 * 65 * 64 + 4 * 1024) * 4];
    for (int lg = blockIdx.x; lg < 64; lg += gridDim.x) prep_s5_item(lg, a_re, a_im, log_dt, b_re, b_im, c_re, c_im, d_skip, KT, WST, CCAR, ABT, smem);
}
__global__ void __launch_bounds__(NTHR) k_phaseB(const bf16_t* U, const char* KT, const bf16x8* WST, const bf16x8* CCAR, const float* ABT, bf16_t* YPRE) {
    __shared__ __attribute__((aligned(16))) char smem[PB_BYTES];
    for (int tile = blockIdx.x; tile < 256; tile += gridDim.x) phaseB_tile(U, KT, WST, CCAR, ABT, YPRE, tile, smem);
}
struct ALoadGelu {
    const bf16_t* base; bf16_t* gout; u32x4 v0, v1; int cc;
    DI void init(const bf16_t* rowbase, bf16_t* growbase) { base = rowbase + (threadIdx.x & 7) * 16; gout = growbase + (threadIdx.x & 7) * 16; }
    DI void issue(int c) { const u32x4* p = (const u32x4*)(base + c * 128); v0 = p[0]; v1 = p[1]; cc = c; }
    DI unsigned g2(unsigned u) { return pack_bf2(gelu_exact(bf_lo(u)), gelu_exact(bf_hi(u))); }
    DI void commit(char* buf) {
        u32x4 o0, o1;
        o0.x = g2(v0.x); o0.y = g2(v0.y); o0.z = g2(v0.z); o0.w = g2(v0.w);
        o1.x = g2(v1.x); o1.y = g2(v1.y); o1.z = g2(v1.z); o1.w = g2(v1.w);
        char* d = buf + (threadIdx.x >> 3) * SA_STRIDE + (threadIdx.x & 7) * 32;
        *(u32x4*)d = o0; *(u32x4*)(d + 16) = o1;
        u32x4* gp = (u32x4*)(gout + cc * 128); gp[0] = o0; gp[1] = o1;
    }
};

DI void tok_reduce(float p0, float p1, float* sred, float& t0, float& t1) {
    const int w = threadIdx.x >> 6, lane = threadIdx.x & 63, r = lane & 31, h = lane >> 5;
    __syncthreads();
    sred[(w * 2 + h) * 64 + r] = p0; sred[(w * 2 + h) * 64 + 32 + r] = p1;
    __syncthreads();
    float a = 0.f, b = 0.f;
#pragma unroll
    for (int k = 0; k < 16; ++k) { a += sred[k * 64 + r]; b += sred[k * 64 + 32 + r]; }
    t0 = a; t1 = b;
}

#define PC_SRED (4 * SA_BYTES)
#define PC_BYTES (PC_SRED + 4096 + 256)

struct PCArgs {
    const bf16_t* U; const bf16_t* YPRE; bf16_t* G1; bf16_t* A2; const float* Xin; float* Xout; bf16_t* Hb; float* RSTD;
    const bf16x8* wfglu; const float* b_glu; const bf16x8* wfpool; const float* pool_scale; const bf16x8* wfout;
};

DI void phaseC1_tile(const PCArgs& a, int tile, char* smem) {
    char* sA = smem; float* sred = (float*)(smem + PC_SRED);
    {
        int tok0 = tile * 64; asm volatile("" : "+s"(tok0));
        int tid = threadIdx.x; asm volatile("" : "+v"(tid));
        const int w = __builtin_amdgcn_readfirstlane(tid >> 6), lane = tid & 63, r = lane & 31, h = lane >> 5;
        ALoadGelu al; al.init(a.YPRE + (size_t)(tok0 + (tid >> 3)) * 512, a.G1 + (size_t)(tok0 + (tid >> 3)) * 512);
        f32x16 acc[2][2]; zero_acc<2>(acc);
        gemm64<2, 4>(acc, al, 4, a.wfglu + (size_t)w * (32 * 2 * 64) + lane, sA);
        float ss0 = 0.f, ss1 = 0.f;
#pragma unroll
        for (int mt = 0; mt < 2; ++mt) {
            const bf16_t* yrow = a.G1 + (size_t)(tok0 + mt * 32 + r) * 512 + w * 64;
#pragma unroll
            for (int nt = 0; nt < 2; ++nt)
#pragma unroll
                for (int q = 0; q < 4; ++q) {
                    asm volatile("" ::: "memory");
                    const int n = nt * 32 + 8 * q + 4 * h;
                    const uint2 yp = *(const uint2*)(yrow + n);
                    const float4 bg = *(const float4*)(a.b_glu + w * 64 + n);
                    const float y0 = bf_lo(yp.x), y1 = bf_hi(yp.x), y2 = bf_lo(yp.y), y3 = bf_hi(yp.y);
                    const float o0 = y0 / (1.f + __expf(-(acc[nt][mt][4 * q] + bg.x)));
                    const float o1 = y1 / (1.f + __expf(-(acc[nt][mt][4 * q + 1] + bg.y)));
                    const float o2 = y2 / (1.f + __expf(-(acc[nt][mt][4 * q + 2] + bg.z)));
                    const float o3 = y3 / (1.f + __expf(-(acc[nt][mt][4 * q + 3] + bg.w)));
                    acc[nt][mt][4 * q] = o0; acc[nt][mt][4 * q + 1] = o1; acc[nt][mt][4 * q + 2] = o2; acc[nt][mt][4 * q + 3] = o3;
                    const float s = o0 * o0 + o1 * o1 + o2 * o2 + o3 * o3;
                    if (mt == 0) ss0 += s; else ss1 += s;
                }
        }
        float t0, t1; tok_reduce(ss0, ss1, sred, t0, t1);
        const float rs0 = rsqrtf(t0 * (1.f / 512.f) + 1e-6f), rs1 = rsqrtf(t1 * (1.f / 512.f) + 1e-6f);
#pragma unroll
        for (int mt = 0; mt < 2; ++mt) {
            const float rs = mt ? rs1 : rs0;
            bf16_t* orow = a.A2 + (size_t)(tok0 + mt * 32 + r) * DM + w * 64;
#pragma unroll
            for (int nt = 0; nt < 2; ++nt)
#pragma unroll
                for (int q = 0; q < 4; ++q) {
                    uint2 o; o.x = pack_bf2(acc[nt][mt][4 * q] * rs, acc[nt][mt][4 * q + 1] * rs);
                    o.y = pack_bf2(acc[nt][mt][4 * q + 2] * rs, acc[nt][mt][4 * q + 3] * rs);
                    *(uint2*)(orow + nt * 32 + 8 * q + 4 * h) = o;
                }
        }
    }
    {
        int tok0 = tile * 64; asm volatile("" : "+s"(tok0));
        int tid = threadIdx.x; asm volatile("" : "+v"(tid));
        const int w = __builtin_amdgcn_readfirstlane(tid >> 6), lane = tid & 63, r = lane & 31, h = lane >> 5;
        const int row = tid >> 3, seg = tid & 7;
        const int tok = tok0 + row, t = tok & (SEQ - 1);
#pragma unroll
        for (int gi = 0; gi < 4; ++gi) {
            const int win = 2 << gi;
            const int cnt = (t + 1 < win) ? (t + 1) : win;
            const bf16_t* up = a.U + (size_t)tok * DM + 512 + gi * 128 + seg * 16;
            float s[16];
            const uint4 c0 = *(const uint4*)up, c1 = *(const uint4*)(up + 8);
            const unsigned cu[8] = {c0.x, c0.y, c0.z, c0.w, c1.x, c1.y, c1.z, c1.w};
#pragma unroll
            for (int i = 0; i < 8; ++i) { s[2 * i] = bf_lo(cu[i]); s[2 * i + 1] = bf_hi(cu[i]); }
            for (int k = 1; k < cnt; ++k) {
                const uint4 d0 = *(const uint4*)(up - (size_t)k * DM), d1 = *(const uint4*)(up - (size_t)k * DM + 8);
                const unsigned du[8] = {d0.x, d0.y, d0.z, d0.w, d1.x, d1.y, d1.z, d1.w};
#pragma unroll
                for (int i = 0; i < 8; ++i) { s[2 * i] += bf_lo(du[i]); s[2 * i + 1] += bf_hi(du[i]); }
            }
            const float inv = 1.f / (float)cnt;
            unsigned o[8];
#pragma unroll
            for (int i = 0; i < 8; ++i) o[i] = pack_bf2(s[2 * i] * inv - bf_lo(cu[i]), s[2 * i + 1] * inv - bf_hi(cu[i]));
            char* d = sA + gi * SA_BYTES + row * SA_STRIDE + seg * 32;
            *(uint4*)d = make_uint4(o[0], o[1], o[2], o[3]); *(uint4*)(d + 16) = make_uint4(o[4], o[5], o[6], o[7]);
        }
        __syncthreads();
        const int gi = w >> 1;
        f32x16 acc[2][2]; zero_acc<2>(acc);
        const bf16x8* wp = a.wfpool + (size_t)gi * (128 * 128 / 8) + (size_t)(w & 1) * (8 * 2 * 64) + lane;
        const char* buf = sA + gi * SA_BYTES + r * SA_STRIDE + h * 16;
#pragma unroll
        for (int ks = 0; ks < 8; ++ks) {
            const bf16x8 a0 = *(const bf16x8*)(buf + ks * 32);
            const bf16x8 a1 = *(const bf16x8*)(buf + 32 * SA_STRIDE + ks * 32);
#pragma unroll
            for (int nt = 0; nt < 2; ++nt) {
                const bf16x8 wv = wp[(ks * 2 + nt) * 64];
                acc[nt][0] = MFMA32(wv, a0, acc[nt][0]);
                acc[nt][1] = MFMA32(wv, a1, acc[nt][1]);
            }
        }
        float ss0 = 0.f, ss1 = 0.f;
#pragma unroll
        for (int mt = 0; mt < 2; ++mt)
#pragma unroll
            for (int nt = 0; nt < 2; ++nt)
#pragma unroll
                for (int q = 0; q < 4; ++q) {
                    asm volatile("" ::: "memory");
                    const int n = w * 64 + nt * 32 + 8 * q + 4 * h;
                    const float4 sc = *(const float4*)(a.pool_scale + n);
                    const float o0 = acc[nt][mt][4 * q] * sc.x, o1 = acc[nt][mt][4 * q + 1] * sc.y, o2 = acc[nt][mt][4 * q + 2] * sc.z, o3 = acc[nt][mt][4 * q + 3] * sc.w;
                    acc[nt][mt][4 * q] = o0; acc[nt][mt][4 * q + 1] = o1; acc[nt][mt][4 * q + 2] = o2; acc[nt][mt][4 * q + 3] = o3;
                    const float s = o0 * o0 + o1 * o1 + o2 * o2 + o3 * o3;
                    if (mt == 0) ss0 += s; else ss1 += s;
                }
        float t0, t1; tok_reduce(ss0, ss1, sred, t0, t1);
        const float rs0 = rsqrtf(t0 * (1.f / 512.f) + 1e-6f), rs1 = rsqrtf(t1 * (1.f / 512.f) + 1e-6f);
#pragma unroll
        for (int mt = 0; mt < 2; ++mt) {
            const float rs = mt ? rs1 : rs0;
            bf16_t* orow = a.A2 + (size_t)(tok0 + mt * 32 + r) * DM + 512 + w * 64;
#pragma unroll
            for (int nt = 0; nt < 2; ++nt)
#pragma unroll
                for (int q = 0; q < 4; ++q) {
                    uint2 o; o.x = pack_bf2(acc[nt][mt][4 * q] * rs, acc[nt][mt][4 * q + 1] * rs);
                    o.y = pack_bf2(acc[nt][mt][4 * q + 2] * rs, acc[nt][mt][4 * q + 3] * rs);
                    *(uint2*)(orow + nt * 32 + 8 * q + 4 * h) = o;
                }
        }
        __syncthreads();
    }
    {
        int tok0 = tile * 64; asm volatile("" : "+s"(tok0));
        int tid = threadIdx.x; asm volatile("" : "+v"(tid));
        const int w = __builtin_amdgcn_readfirstlane(tid >> 6), lane = tid & 63, r = lane & 31, h = lane >> 5;
        ALoadBF16 al; al.init(a.A2 + (size_t)(tok0 + (tid >> 3)) * DM);
        f32x16 acc[4][2]; zero_acc<4>(acc);
        gemm64<4, 2>(acc, al, 8, a.wfout + (size_t)w * (64 * 4 * 64) + lane, sA);
        float ss0 = 0.f, ss1 = 0.f;
#pragma unroll
        for (int mt = 0; mt < 2; ++mt) {
            const size_t ro = (size_t)(tok0 + mt * 32 + r) * DM + w * 128;
#pragma unroll
            for (int nt = 0; nt < 4; ++nt)
#pragma unroll
                for (int q = 0; q < 4; ++q) {
                    asm volatile("" ::: "memory");
                    const int n = nt * 32 + 8 * q + 4 * h;
                    const float4 xi = *(const float4*)(a.Xin + ro + n);
                    float4 xo; xo.x = xi.x + acc[nt][mt][4 * q]; xo.y = xi.y + acc[nt][mt][4 * q + 1]; xo.z = xi.z + acc[nt][mt][4 * q + 2]; xo.w = xi.w + acc[nt][mt][4 * q + 3];
                    *(float4*)(a.Xout + ro + n) = xo;
                    uint2 o; o.x = pack_bf2(xo.x, xo.y); o.y = pack_bf2(xo.z, xo.w);
                    *(uint2*)(a.Hb + ro + n) = o;
                    const float s = xo.x * xo.x + xo.y * xo.y + xo.z * xo.z + xo.w * xo.w;
                    if (mt == 0) ss0 += s; else ss1 += s;
                }
        }
        float t0, t1; tok_reduce(ss0, ss1, sred, t0, t1);
        if (w == 0) { a.RSTD[tok0 + r + 32 * h] = rsqrtf((h ? t1 : t0) * (1.f / 1024.f) + 1e-6f); }
        __syncthreads();
    }
}

__global__ void __launch_bounds__(NTHR) k_phaseC1(PCArgs a) {
    __shared__ __attribute__((aligned(16))) char smem[PC_BYTES];
    for (int tile = blockIdx.x; tile < NTOK / 64; tile += gridDim.x) phaseC1_tile(a, tile, smem);
}
DI unsigned f2ord(float f) { const unsigned u = __float_as_uint(f); return u ^ ((u >> 31) ? 0xFFFFFFFFu : 0x80000000u); }
DI float ord2f(unsigned o) { return __uint_as_float((o & 0x80000000u) ? (o ^ 0x80000000u) : ~o); }
DI unsigned umax_(unsigned a, unsigned b) { return a > b ? a : b; }
DI unsigned umin_(unsigned a, unsigned b) { return a < b ? a : b; }

struct PRArgs {
    const bf16_t* Hb; const float* RSTD; bf16_t* Qb; const bf16x8* wfq; const bf16x8* wfk1; const bf16x8* wfk2; int* EX; float* GT;
};

DI void topk_insert16(unsigned (&L)[16], const f32x16& s, int nbase, int h) {
#pragma unroll
    for (int i = 0; i < 16; ++i) {
        unsigned x = (f2ord(s[i]) & 0xFFFFFF80u) | (unsigned)(127 - (nbase + crow(i, h)));
#pragma unroll
        for (int k = 0; k < 16; ++k) { const unsigned hi = umax_(L[k], x); x = umin_(L[k], x); L[k] = hi; }
    }
}

DI void phaseC2_tile(const PRArgs& a, int tile, char* smem) {
    char* sA = smem;
#pragma unroll 1
    for (int ps = 0; ps < 2; ++ps) {
        int tok0 = tile * 64; asm volatile("" : "+s"(tok0));
        int tid = threadIdx.x; asm volatile("" : "+v"(tid));
        const int w = __builtin_amdgcn_readfirstlane(tid >> 6), lane = tid & 63, r = lane & 31, h = lane >> 5;
        ALoadBF16 al; al.init(a.Hb + (size_t)(tok0 + (tid >> 3)) * DM);
        f32x16 acc[4][2]; zero_acc<4>(acc);
        const int ng = ps * 8 + w;
        gemm64<4, 2>(acc, al, 8, a.wfq + (size_t)ng * (64 * 4 * 64) + lane, sA);
#pragma unroll
        for (int mt = 0; mt < 2; ++mt) {
            const float rs = a.RSTD[tok0 + mt * 32 + r];
            bf16_t* orow = a.Qb + (size_t)(tok0 + mt * 32 + r) * 2048 + ng * 128;
#pragma unroll
            for (int nt = 0; nt < 4; ++nt)
#pragma unroll
                for (int q = 0; q < 4; ++q) {
                    uint2 o; o.x = pack_bf2(acc[nt][mt][4 * q] * rs, acc[nt][mt][4 * q + 1] * rs);
                    o.y = pack_bf2(acc[nt][mt][4 * q + 2] * rs, acc[nt][mt][4 * q + 3] * rs);
                    *(uint2*)(orow + nt * 32 + 8 * q + 4 * h) = o;
                }
        }
    }
    __syncthreads();
    {
        int tok0 = tile * 64; asm volatile("" : "+s"(tok0));
        int tid = threadIdx.x; asm volatile("" : "+v"(tid));
        const int w = __builtin_amdgcn_readfirstlane(tid >> 6), lane = tid & 63, r = lane & 31, h = lane >> 5;
        unsigned T0[16], T1[16];
#pragma unroll 1
        for (int half = 0; half < 2; ++half) {
            gwp_t wk = (gwp_t)(half ? a.wfk2 : a.wfk1) + lane;
#pragma unroll 1
            for (int mt = 0; mt < 2; ++mt) {
                f32x16 sc[4];
#pragma unroll
                for (int nt = 0; nt < 4; ++nt)
#pragma unroll
                    for (int i = 0; i < 16; ++i) sc[nt][i] = 0.f;
                const bf16_t* qrow = a.Qb + (size_t)(tok0 + mt * 32 + r) * 2048 + w * 256 + half * 128 + 8 * h;
#pragma unroll
                for (int ks = 0; ks < 8; ++ks) {
                    const bf16x8 qv = *(const bf16x8*)(qrow + ks * 16);
#pragma unroll
                    for (int nt = 0; nt < 4; ++nt) sc[nt] = MFMA32(wk[(ks * 4 + nt) * 64], qv, sc[nt]);
                }
                unsigned L[16];
#pragma unroll
                for (int k = 0; k < 16; ++k) L[k] = 0u;
#pragma unroll
                for (int nt = 0; nt < 4; ++nt) topk_insert16(L, sc[nt], nt * 32, h);
                unsigned P[16];
#pragma unroll
                for (int k = 0; k < 16; ++k) P[k] = (unsigned)__shfl_xor((int)L[k], 32);
#pragma unroll
                for (int k = 0; k < 16; ++k) L[k] = umax_(L[k], P[15 - k]);
#pragma unroll
                for (int d = 8; d > 0; d >>= 1)
#pragma unroll
                    for (int k = 0; k < 16; ++k)
                        if ((k & d) == 0) { const unsigned hi = umax_(L[k], L[k + d]), lo = umin_(L[k], L[k + d]); L[k] = hi; L[k + d] = lo; }
                if (h == mt) {
                    if (half == 0) {
#pragma unroll
                        for (int k = 0; k < 16; ++k) T0[k] = L[k];
                    } else {
#pragma unroll
                        for (int k = 0; k < 16; ++k) T1[k] = L[k];
                    }
                }
            }
        }
        float v1[16], v2[16];
#pragma unroll
        for (int k = 0; k < 16; ++k) { v1[k] = ord2f(T0[k] & 0xFFFFFF80u); v2[k] = ord2f(T1[k] & 0xFFFFFF80u); }
        unsigned C[16];
#pragma unroll
        for (int b = 0; b < 16; ++b) C[b] = (f2ord(v1[0] + v2[b]) & 0xFFFFFF00u) | (unsigned)(255 - b);
#pragma unroll
        for (int aa = 1; aa < 16; ++aa)
#pragma unroll
            for (int b = 0; b < 16; ++b)
                if ((aa + 1) * (b + 1) <= 16) {
                    unsigned x = (f2ord(v1[aa] + v2[b]) & 0xFFFFFF00u) | (unsigned)(255 - (aa * 16 + b));
#pragma unroll
                    for (int k = (aa + 1) * (b + 1) - 1; k < 16; ++k) { const unsigned hi = umax_(C[k], x); x = umin_(C[k], x); C[k] = hi; }
                }
        unsigned* sI = (unsigned*)(smem) + (w * 64 + lane) * 9;
#pragma unroll
        for (int q = 0; q < 4; ++q) {
            unsigned p1 = 0u, p2 = 0u;
#pragma unroll
            for (int j = 0; j < 4; ++j) { p1 |= (127u - (T0[4 * q + j] & 0x7Fu)) << (8 * j); p2 |= (127u - (T1[4 * q + j] & 0x7Fu)) << (8 * j); }
            sI[q] = p1; sI[4 + q] = p2;
        }
        const unsigned char* sB = (const unsigned char*)sI;
        const float mx = ord2f(C[0] & 0xFFFFFF00u);
        float e[16]; float sum = 0.f; int ex[16];
#pragma unroll
        for (int k = 0; k < 16; ++k) {
            e[k] = __expf(ord2f(C[k] & 0xFFFFFF00u) - mx); sum += e[k];
            const unsigned ci = 255u - (C[k] & 0xFFu);
            ex[k] = (int)sB[ci >> 4] * 128 + (int)sB[16 + (ci & 15u)];
        }
        const float inv = 1.f / sum;
        const size_t ob = ((size_t)(tok0 + h * 32 + r) * 8 + w) * 16;
#pragma unroll
        for (int q = 0; q < 4; ++q) {
            *(int4*)(a.EX + ob + 4 * q) = make_int4(ex[4 * q], ex[4 * q + 1], ex[4 * q + 2], ex[4 * q + 3]);
            *(float4*)(a.GT + ob + 4 * q) = make_float4(e[4 * q] * inv, e[4 * q + 1] * inv, e[4 * q + 2] * inv, e[4 * q + 3] * inv);
        }
    }
    __syncthreads();
}

__global__ void __launch_bounds__(NTHR) k_phaseC2(PRArgs a) {
    __shared__ __attribute__((aligned(16))) char smem[2 * SA_BYTES];
    for (int tile = blockIdx.x; tile < NTOK / 64; tile += gridDim.x) phaseC2_tile(a, tile, smem);
}
typedef __attribute__((ext_vector_type(2))) short s16x2;
DI float dot2bf(unsigned a, unsigned b, float c) {
    return __builtin_amdgcn_fdot2_f32_bf16(__builtin_bit_cast(bf2_t, a), __builtin_bit_cast(bf2_t, b), c, false);
}
typedef const __attribute__((address_space(1))) u32x4* grow_t;

struct PGArgs {
    const bf16_t* Hb; const float* RSTD; const int* EX; const float* GT; const bf16_t* Ub; const bf16_t* Vb;
    const float* Xin; float* Xout; const float* gfinal; int final_norm;
};

struct RowQuad { u32x4 a0, a1, b0, b1, c0, c1, d0, d1; };
DI void quad_load(RowQuad& q, const bf16_t* tab, int e0, int e1, int e2, int e3, int lane) {
    grow_t p0 = (grow_t)(tab + (size_t)e0 * DM) + lane; grow_t p1 = (grow_t)(tab + (size_t)e1 * DM) + lane;
    grow_t p2 = (grow_t)(tab + (size_t)e2 * DM) + lane; grow_t p3 = (grow_t)(tab + (size_t)e3 * DM) + lane;
    q.a0 = p0[0]; q.a1 = p0[64]; q.b0 = p1[0]; q.b1 = p1[64]; q.c0 = p2[0]; q.c1 = p2[64]; q.d0 = p3[0]; q.d1 = p3[64];
}
DI float row_dot(const u32x4& r0, const u32x4& r1, const u32x4& h0, const u32x4& h1) {
    float s = 0.f;
    s = dot2bf(r0.x, h0.x, s); s = dot2bf(r0.y, h0.y, s); s = dot2bf(r0.z, h0.z, s); s = dot2bf(r0.w, h0.w, s);
    s = dot2bf(r1.x, h1.x, s); s = dot2bf(r1.y, h1.y, s); s = dot2bf(r1.z, h1.z, s); s = dot2bf(r1.w, h1.w, s);
    return s;
}
DI void row_axpy(float (&acc)[16], const u32x4& r0, const u32x4& r1, float s) {
    acc[0] = fmaf(s, bf_lo(r0.x), acc[0]); acc[1] = fmaf(s, bf_hi(r0.x), acc[1]); acc[2] = fmaf(s, bf_lo(r0.y), acc[2]); acc[3] = fmaf(s, bf_hi(r0.y), acc[3]);
    acc[4] = fmaf(s, bf_lo(r0.z), acc[4]); acc[5] = fmaf(s, bf_hi(r0.z), acc[5]); acc[6] = fmaf(s, bf_lo(r0.w), acc[6]); acc[7] = fmaf(s, bf_hi(r0.w), acc[7]);
    acc[8] = fmaf(s, bf_lo(r1.x), acc[8]); acc[9] = fmaf(s, bf_hi(r1.x), acc[9]); acc[10] = fmaf(s, bf_lo(r1.y), acc[10]); acc[11] = fmaf(s, bf_hi(r1.y), acc[11]);
    acc[12] = fmaf(s, bf_lo(r1.z), acc[12]); acc[13] = fmaf(s, bf_hi(r1.z), acc[13]); acc[14] = fmaf(s, bf_lo(r1.w), acc[14]); acc[15] = fmaf(s, bf_hi(r1.w), acc[15]);
}
#define RL(v, l) __builtin_amdgcn_readlane((v), (l))
#define RLF(v, l) __uint_as_float((unsigned)__builtin_amdgcn_readlane((int)__float_as_uint(v), (l)))

DI float reduce16(float (&p)[16], int lane) {
    const bool b5 = lane & 32, b4 = lane & 16, b3 = lane & 8, b2 = lane & 4;
    float q8[8], q4[4], q2[2];
#pragma unroll
    for (int k = 0; k < 8; ++k) { const float keep = b5 ? p[k + 8] : p[k], send = b5 ? p[k] : p[k + 8]; q8[k] = keep + __shfl_xor(send, 32); }
#pragma unroll
    for (int k = 0; k < 4; ++k) { const float keep = b4 ? q8[k + 4] : q8[k], send = b4 ? q8[k] : q8[k + 4]; q4[k] = keep + __shfl_xor(send, 16); }
#pragma unroll
    for (int k = 0; k < 2; ++k) { const float keep = b3 ? q4[k + 2] : q4[k], send = b3 ? q4[k] : q4[k + 2]; q2[k] = keep + __shfl_xor(send, 8); }
    float t;
    { const float keep = b2 ? q2[1] : q2[0], send = b2 ? q2[0] : q2[1]; t = keep + __shfl_xor(send, 4); }
    t += __shfl_xor(t, 1); t += __shfl_xor(t, 2);
    return t;
}

DI void phaseC3_tile(const PGArgs& a, int tile) {
    int tid = threadIdx.x; asm volatile("" : "+v"(tid));
    const int w = __builtin_amdgcn_readfirstlane(tid >> 6), lane = tid & 63;
    const int el = (lane >> 2) & 15;
#pragma unroll 1
    for (int ti = 0; ti < 8; ++ti) {
        const int tok = tile * 64 + w * 8 + ti;
        const u32x4* hp = (const u32x4*)(a.Hb + (size_t)tok * DM) + lane;
        const u32x4 h0 = hp[0], h1 = hp[64];
        const float rs = a.RSTD[tok];
        float acc[16];
#pragma unroll
        for (int i = 0; i < 16; ++i) acc[i] = 0.f;
#pragma unroll 1
        for (int hd = 0; hd < 8; ++hd) {
            const int exv = a.EX[((size_t)tok * 8 + hd) * 16 + (lane & 15)];
            const float gt = a.GT[((size_t)tok * 8 + hd) * 16 + el];
            RowQuad qa, qb;
            float p[16];
            quad_load(qa, a.Ub, RL(exv, 0), RL(exv, 1), RL(exv, 2), RL(exv, 3), lane);
            quad_load(qb, a.Ub, RL(exv, 4), RL(exv, 5), RL(exv, 6), RL(exv, 7), lane);
            p[0] = row_dot(qa.a0, qa.a1, h0, h1); p[1] = row_dot(qa.b0, qa.b1, h0, h1); p[2] = row_dot(qa.c0, qa.c1, h0, h1); p[3] = row_dot(qa.d0, qa.d1, h0, h1);
            quad_load(qa, a.Ub, RL(exv, 8), RL(exv, 9), RL(exv, 10), RL(exv, 11), lane);
            p[4] = row_dot(qb.a0, qb.a1, h0, h1); p[5] = row_dot(qb.b0, qb.b1, h0, h1); p[6] = row_dot(qb.c0, qb.c1, h0, h1); p[7] = row_dot(qb.d0, qb.d1, h0, h1);
            quad_load(qb, a.Ub, RL(exv, 12), RL(exv, 13), RL(exv, 14), RL(exv, 15), lane);
            p[8] = row_dot(qa.a0, qa.a1, h0, h1); p[9] = row_dot(qa.b0, qa.b1, h0, h1); p[10] = row_dot(qa.c0, qa.c1, h0, h1); p[11] = row_dot(qa.d0, qa.d1, h0, h1);
            quad_load(qa, a.Vb, RL(exv, 0), RL(exv, 1), RL(exv, 2), RL(exv, 3), lane);
            p[12] = row_dot(qb.a0, qb.a1, h0, h1); p[13] = row_dot(qb.b0, qb.b1, h0, h1); p[14] = row_dot(qb.c0, qb.c1, h0, h1); p[15] = row_dot(qb.d0, qb.d1, h0, h1);
            quad_load(qb, a.Vb, RL(exv, 4), RL(exv, 5), RL(exv, 6), RL(exv, 7), lane);
            const float act = gelu_exact(reduce16(p, lane) * rs) * gt;
            row_axpy(acc, qa.a0, qa.a1, RLF(act, 0)); row_axpy(acc, qa.b0, qa.b1, RLF(act, 4)); row_axpy(acc, qa.c0, qa.c1, RLF(act, 8)); row_axpy(acc, qa.d0, qa.d1, RLF(act, 12));
            quad_load(qa, a.Vb, RL(exv, 8), RL(exv, 9), RL(exv, 10), RL(exv, 11), lane);
            row_axpy(acc, qb.a0, qb.a1, RLF(act, 16)); row_axpy(acc, qb.b0, qb.b1, RLF(act, 20)); row_axpy(acc, qb.c0, qb.c1, RLF(act, 24)); row_axpy(acc, qb.d0, qb.d1, RLF(act, 28));
            quad_load(qb, a.Vb, RL(exv, 12), RL(exv, 13), RL(exv, 14), RL(exv, 15), lane);
            row_axpy(acc, qa.a0, qa.a1, RLF(act, 32)); row_axpy(acc, qa.b0, qa.b1, RLF(act, 36)); row_axpy(acc, qa.c0, qa.c1, RLF(act, 40)); row_axpy(acc, qa.d0, qa.d1, RLF(act, 44));
            row_axpy(acc, qb.a0, qb.a1, RLF(act, 48)); row_axpy(acc, qb.b0, qb.b1, RLF(act, 52)); row_axpy(acc, qb.c0, qb.c1, RLF(act, 56)); row_axpy(acc, qb.d0, qb.d1, RLF(act, 60));
        }
        const float* xi = a.Xin + (size_t)tok * DM + lane * 8;
        float* xo = a.Xout + (size_t)tok * DM + lane * 8;
        float4 x0 = *(const float4*)xi, x1 = *(const float4*)(xi + 4), x2 = *(const float4*)(xi + 512), x3 = *(const float4*)(xi + 516);
        x0.x += acc[0]; x0.y += acc[1]; x0.z += acc[2]; x0.w += acc[3]; x1.x += acc[4]; x1.y += acc[5]; x1.z += acc[6]; x1.w += acc[7];
        x2.x += acc[8]; x2.y += acc[9]; x2.z += acc[10]; x2.w += acc[11]; x3.x += acc[12]; x3.y += acc[13]; x3.z += acc[14]; x3.w += acc[15];
        if (a.final_norm) {
            float ss = x0.x * x0.x + x0.y * x0.y + x0.z * x0.z + x0.w * x0.w + x1.x * x1.x + x1.y * x1.y + x1.z * x1.z + x1.w * x1.w
                     + x2.x * x2.x + x2.y * x2.y + x2.z * x2.z + x2.w * x2.w + x3.x * x3.x + x3.y * x3.y + x3.z * x3.z + x3.w * x3.w;
            ss = wave_sum(ss);
            const float rf = rsqrtf(ss * (1.f / 1024.f) + 1e-6f);
            const float* gf = a.gfinal + lane * 8;
            const float4 g0 = *(const float4*)gf, g1 = *(const float4*)(gf + 4), g2 = *(const float4*)(gf + 512), g3 = *(const float4*)(gf + 516);
            x0.x *= rf * g0.x; x0.y *= rf * g0.y; x0.z *= rf * g0.z; x0.w *= rf * g0.w; x1.x *= rf * g1.x; x1.y *= rf * g1.y; x1.z *= rf * g1.z; x1.w *= rf * g1.w;
            x2.x *= rf * g2.x; x2.y *= rf * g2.y; x2.z *= rf * g2.z; x2.w *= rf * g2.w; x3.x *= rf * g3.x; x3.y *= rf * g3.y; x3.z *= rf * g3.z; x3.w *= rf * g3.w;
        }
        *(float4*)xo = x0; *(float4*)(xo + 4) = x1; *(float4*)(xo + 512) = x2; *(float4*)(xo + 516) = x3;
    }
}

__global__ void __launch_bounds__(NTHR) k_phaseC3(PGArgs a) {
    for (int tile = blockIdx.x; tile < NTOK / 64; tile += gridDim.x) phaseC3_tile(a, tile);
}
__global__ void __launch_bounds__(NTHR) k_prep_experts(const float* u_exp, const float* v_exp, const float* norm_ffn, bf16_t* Ub, bf16_t* Vb) {
    const size_t gtid = (size_t)blockIdx.x * blockDim.x + threadIdx.x, gs = (size_t)gridDim.x * blockDim.x;
    for (int l = 0; l < 2; ++l) {
        conv_rows_bf16(u_exp + (size_t)l * NEXP * DM, norm_ffn + l * DM, Ub + (size_t)l * NEXP * DM, (size_t)NEXP * DM, gtid, gs);
        conv_rows_bf16(v_exp + (size_t)l * NEXP * DM, nullptr, Vb + (size_t)l * NEXP * DM, (size_t)NEXP * DM, gtid, gs);
    }
}

extern "C" void kernel_launch(void* const* d_in, const int* in_sizes, int n_in, void* d_out, int out_size, void* d_ws, size_t ws_size,
                              hipStream_t stream) {
    const float* x = (const float*)d_in[0];
    const float* norm_mix = (const float*)d_in[1];
    const float* w_in = (const float*)d_in[2];
    const float* a_re = (const float*)d_in[3];
    const float* a_im = (const float*)d_in[4];
    const float* log_dt = (const float*)d_in[5];
    const float* b_re = (const float*)d_in[6];
    const float* b_im = (const float*)d_in[7];
    const float* c_re = (const float*)d_in[8];
    const float* c_im = (const float*)d_in[9];
    const float* d_skip = (const float*)d_in[10];
    const float* w_glu = (const float*)d_in[11];
    const float* b_glu = (const float*)d_in[12];
    const float* w_pool = (const float*)d_in[13];
    const float* pool_scale = (const float*)d_in[14];
    const float* g_out_ssm = (const float*)d_in[15];
    const float* g_out_pool = (const float*)d_in[16];
    const float* w_out = (const float*)d_in[17];
    const float* norm_ffn = (const float*)d_in[18];
    const float* w_q = (const float*)d_in[19];
    const float* k1 = (const float*)d_in[20];
    const float* k2 = (const float*)d_in[21];
    const float* u_exp = (const float*)d_in[22];
    const float* v_exp = (const float*)d_in[23];
    const float* norm_final = (const float*)d_in[24];

    char* wsb = (char*)d_ws;
    size_t off = 0;
    auto take = [&](size_t bytes) { char* p = wsb + off; off += (bytes + 255) & ~(size_t)255; return p; };
    float* X = (float*)d_out;
    bf16_t* U = (bf16_t*)take((size_t)NTOK * DM * 2);
    bf16_t* YPRE = (bf16_t*)take((size_t)NTOK * 512 * 2);
    bf16_t* G1 = (bf16_t*)take((size_t)NTOK * 512 * 2);
    bf16_t* A2 = (bf16_t*)take((size_t)NTOK * DM * 2);
    bf16_t* Hb = (bf16_t*)take((size_t)NTOK * DM * 2);
    bf16_t* Qb = (bf16_t*)take((size_t)NTOK * 2048 * 2);
    int* EX = (int*)take((size_t)NTOK * 128 * 4);
    float* GT = (float*)take((size_t)NTOK * 128 * 4);
    float* RSTD = (float*)take(NTOK * 4);
    bf16x8* wfin = (bf16x8*)take((size_t)2 * DM * DM * 2);
    bf16x8* wfglu = (bf16x8*)take((size_t)2 * 512 * 512 * 2);
    bf16x8* wfpool = (bf16x8*)take((size_t)2 * 4 * 128 * 128 * 2);
    bf16x8* wfout = (bf16x8*)take((size_t)2 * DM * DM * 2);
    bf16x8* wfq = (bf16x8*)take((size_t)2 * DM * 2048 * 2);
    bf16x8* wfk1 = (bf16x8*)take((size_t)2 * 128 * 128 * 2);
    bf16x8* wfk2 = (bf16x8*)take((size_t)2 * 128 * 128 * 2);
    float* ones = (float*)take(2048 * 4);
    char* KT = take((size_t)64 * KT_BYTES);
    bf16x8* WST = (bf16x8*)take((size_t)64 * WST_FRAGS * 16);
    bf16x8* CCAR = (bf16x8*)take((size_t)64 * CCAR_FRAGS * 16);
    float* ABT = (float*)take(64 * 128 * 4);
    bf16_t* Ub = (bf16_t*)take((size_t)2 * NEXP * DM * 2);
    bf16_t* Vb = (bf16_t*)take((size_t)2 * NEXP * DM * 2);

    k_fill_ones<<<8, 256, 0, stream>>>(ones, 2048);
    k_prep_weights<<<256, NTHR, 0, stream>>>(norm_mix, w_in, w_glu, w_pool, g_out_ssm, g_out_pool, w_out, norm_ffn, w_q, k1, k2,
                                             wfin, wfglu, wfpool, wfout, wfq, wfk1, wfk2, ones);
    k_prep_s5<<<64, NTHR, 0, stream>>>(a_re, a_im, log_dt, b_re, b_im, c_re, c_im, d_skip, KT, WST, CCAR, ABT);
    k_prep_experts<<<1024, NTHR, 0, stream>>>(u_exp, v_exp, norm_ffn, Ub, Vb);
    for (int l = 0; l < 2; ++l) {
        k_phaseA<<<256, NTHR, 0, stream>>>(l == 0 ? x : X, wfin + (size_t)l * (DM * DM / 8), U);
        k_phaseB<<<256, NTHR, 0, stream>>>(U, KT + (size_t)l * 32 * KT_BYTES, WST + (size_t)l * 32 * WST_FRAGS, CCAR + (size_t)l * 32 * CCAR_FRAGS, ABT + l * 32 * 128, YPRE);
        {
            PCArgs pa{};
            pa.U = U; pa.YPRE = YPRE; pa.G1 = G1; pa.A2 = A2; pa.Xin = (l == 0 ? x : X); pa.Xout = X; pa.Hb = Hb; pa.RSTD = RSTD;
            pa.wfglu = wfglu + (size_t)l * (512 * 512 / 8); pa.b_glu = b_glu + l * 512; pa.wfpool = wfpool + (size_t)l * 4 * (128 * 128 / 8);
            pa.pool_scale = pool_scale + l * 512; pa.wfout = wfout + (size_t)l * (DM * DM / 8);
            k_phaseC1<<<256, NTHR, 0, stream>>>(pa);
        }
        {
            PRArgs pr{};
            pr.Hb = Hb; pr.RSTD = RSTD; pr.Qb = Qb; pr.wfq = wfq + (size_t)l * (DM * 2048 / 8); pr.wfk1 = wfk1 + (size_t)l * (128 * 128 / 8);
            pr.wfk2 = wfk2 + (size_t)l * (128 * 128 / 8); pr.EX = EX; pr.GT = GT;
            k_phaseC2<<<256, NTHR, 0, stream>>>(pr);
        }
        {
            PGArgs pg{};
            pg.Hb = Hb; pg.RSTD = RSTD; pg.EX = EX; pg.GT = GT; pg.Ub = Ub + (size_t)l * NEXP * DM; pg.Vb = Vb + (size_t)l * NEXP * DM;
            pg.Xin = X; pg.Xout = X; pg.gfinal = norm_final; pg.final_norm = (l == 1);
            k_phaseC3<<<256, NTHR, 0, stream>>>(pg);
        }
    }
}
```

```cpp
#include <hip/hip_runtime.h>
#include <hip/hip_cooperative_groups.h>
#include <cstdio>
#include <cstring>
namespace cg = cooperative_groups;
#include <math.h>
#include <stdint.h>

#define NTOK 16384
#define SEQ 2048
#define DM 1024
#define SSMW 512
#define NEXP 16384

__device__ __forceinline__ float gelu_exact(float x) { return 0.5f * x * (1.f + erff(x * 0.70710678118654752f)); }

__device__ __forceinline__ float wave_sum(float v) {
#pragma unroll
    for (int o = 32; o > 0; o >>= 1) v += __shfl_xor(v, o);
    return v;
}

#define DI __device__ __forceinline__
typedef __attribute__((ext_vector_type(8))) short bf16x8;
typedef __attribute__((ext_vector_type(16))) float f32x16;
typedef __attribute__((ext_vector_type(2))) __bf16 bf2_t;
typedef __attribute__((ext_vector_type(2))) float f2_t;
typedef unsigned short bf16_t;
typedef __attribute__((ext_vector_type(4))) unsigned u32x4;
typedef __attribute__((ext_vector_type(4))) float f32x4;
typedef const __attribute__((address_space(1))) bf16x8* gwp_t;
#define MFMA32(a, b, c) __builtin_amdgcn_mfma_f32_32x32x16_bf16((a), (b), (c), 0, 0, 0)

DI unsigned pack_bf2(float a, float b) { f2_t v = {a, b}; return __builtin_bit_cast(unsigned, __builtin_convertvector(v, bf2_t)); }
DI float bf_lo(unsigned u) { return __uint_as_float(u << 16); }
DI float bf_hi(unsigned u) { return __uint_as_float(u & 0xffff0000u); }
DI int crow(int reg, int h) { return (reg & 3) + 8 * (reg >> 2) + 4 * h; }

#define SA_STRIDE 272
#define SA_BYTES (64 * SA_STRIDE)
#define NTHR 512

template <bool GAIN>
DI void conv_wfrag(const float* __restrict__ src, int ldk, int ldn, const float* __restrict__ ga, const float* __restrict__ gb, int split,
                   int K, int N, int NTG, bf16x8* __restrict__ dst, size_t gtid, size_t gstride) {
    const int KS = K / 16;
    const size_t total = (size_t)(N / 32) * KS * 64;
    for (size_t item = gtid; item < total; item += gstride) {
        const int lane = (int)(item & 63); const size_t f = item >> 6;
        const int nti = (int)(f % NTG); const size_t f2 = f / NTG;
        const int ks = (int)(f2 % KS), nt = (int)(f2 / KS) * NTG + nti;
        const int r = lane & 31, h = lane >> 5;
        const int n = nt * 32 + r, k0 = ks * 16 + 8 * h;
        float v[8];
#pragma unroll
        for (int j = 0; j < 8; ++j) {
            const int k = k0 + j;
            float g = 1.f;
            if (GAIN) g = (k < split) ? ga[k] : gb[k - split];
            v[j] = src[(size_t)k * ldk + (size_t)n * ldn] * g;
        }
        uint4 o; o.x = pack_bf2(v[0], v[1]); o.y = pack_bf2(v[2], v[3]); o.z = pack_bf2(v[4], v[5]); o.w = pack_bf2(v[6], v[7]);
        *(uint4*)(dst + item) = o;
    }
}

DI void conv_rows_bf16(const float* __restrict__ src, const float* __restrict__ gain, bf16_t* __restrict__ dst, size_t nelem, size_t gtid, size_t gstride) {
    for (size_t i = gtid * 8; i < nelem; i += gstride * 8) {
        float4 a = *(const float4*)(src + i), b = *(const float4*)(src + i + 4);
        if (gain) {
            const int c = (int)(i & 1023);
            float4 g0 = *(const float4*)(gain + c), g1 = *(const float4*)(gain + c + 4);
            a.x *= g0.x; a.y *= g0.y; a.z *= g0.z; a.w *= g0.w; b.x *= g1.x; b.y *= g1.y; b.z *= g1.z; b.w *= g1.w;
        }
        uint4 o; o.x = pack_bf2(a.x, a.y); o.y = pack_bf2(a.z, a.w); o.z = pack_bf2(b.x, b.y); o.w = pack_bf2(b.z, b.w);
        *(uint4*)(dst + i) = o;
    }
}

struct ALoadF32 {
    const float* base; f32x4 v0, v1, v2, v3; float ss; int dofs;
    DI void init(const float* rowbase, int tid) { base = rowbase + (tid & 7) * 16; ss = 0.f; dofs = (tid >> 3) * SA_STRIDE + (tid & 7) * 32; }
    DI void issue(int c) { const f32x4* p = (const f32x4*)(base + c * 128); v0 = p[0]; v1 = p[1]; v2 = p[2]; v3 = p[3]; }
    DI void commit(char* buf) {
        u32x4 o0, o1;
        ss += v0.x * v0.x + v0.y * v0.y + v0.z * v0.z + v0.w * v0.w + v1.x * v1.x + v1.y * v1.y + v1.z * v1.z + v1.w * v1.w
            + v2.x * v2.x + v2.y * v2.y + v2.z * v2.z + v2.w * v2.w + v3.x * v3.x + v3.y * v3.y + v3.z * v3.z + v3.w * v3.w;
        o0.x = pack_bf2(v0.x, v0.y); o0.y = pack_bf2(v0.z, v0.w); o0.z = pack_bf2(v1.x, v1.y); o0.w = pack_bf2(v1.z, v1.w);
        o1.x = pack_bf2(v2.x, v2.y); o1.y = pack_bf2(v2.z, v2.w); o1.z = pack_bf2(v3.x, v3.y); o1.w = pack_bf2(v3.z, v3.w);
        char* d = buf + dofs;
        *(u32x4*)d = o0; *(u32x4*)(d + 16) = o1;
    }
};
struct ALoadBF16 {
    const bf16_t* base; u32x4 v0, v1; int dofs;
    DI void init(const bf16_t* rowbase, int tid) { base = rowbase + (tid & 7) * 16; dofs = (tid >> 3) * SA_STRIDE + (tid & 7) * 32; }
    DI void issue(int c) { const u32x4* p = (const u32x4*)(base + c * 128); v0 = p[0]; v1 = p[1]; }
    DI void commit(char* buf) {
        char* d = buf + dofs;
        *(u32x4*)d = v0; *(u32x4*)(d + 16) = v1;
    }
};

template <int NT, int PF, class AL>
DI void gemm64(f32x16 (&acc)[NT][2], AL& al, const int nchunks, const bf16x8* __restrict__ wf_, char* sA, const int lane) {
    gwp_t wf = (gwp_t)wf_;
    const int r = lane & 31, h = lane >> 5;
    bf16x8 bq[PF][NT];
    al.issue(0);
#pragma unroll
    for (int p = 0; p < PF; ++p)
#pragma unroll
        for (int nt = 0; nt < NT; ++nt) bq[p][nt] = wf[(p * NT + nt) * 64];
    gwp_t wpf = wf + PF * NT * 64;
    al.commit(sA);
    const int kend = nchunks * 8 - PF;
    int kg = 0;
#pragma unroll 1
    for (int c = 0; c < nchunks; ++c) {
        if (c + 1 < nchunks) al.issue(c + 1);
        __syncthreads();
        const char* buf = sA + (c & 1) * SA_BYTES + r * SA_STRIDE + h * 16;
#pragma unroll
        for (int ks = 0; ks < 8; ++ks) {
            const bf16x8 a0 = *(const bf16x8*)(buf + ks * 32);
            const bf16x8 a1 = *(const bf16x8*)(buf + 32 * SA_STRIDE + ks * 32);
#pragma unroll
            for (int nt = 0; nt < NT; ++nt) {
                acc[nt][0] = MFMA32(bq[ks % PF][nt], a0, acc[nt][0]);
                acc[nt][1] = MFMA32(bq[ks % PF][nt], a1, acc[nt][1]);
            }
            if (kg < kend) {
#pragma unroll
                for (int nt = 0; nt < NT; ++nt) bq[ks % PF][nt] = wpf[nt * 64];
            }
            wpf += NT * 64; ++kg;
            asm volatile("" : "+v"(wpf));
        }
        if (c + 1 < nchunks) al.commit(sA + ((c + 1) & 1) * SA_BYTES);
    }
    __syncthreads();
}

template <int NT>
DI void zero_acc(f32x16 (&acc)[NT][2]) {
#pragma unroll
    for (int nt = 0; nt < NT; ++nt)
#pragma unroll
        for (int mt = 0; mt < 2; ++mt)
#pragma unroll
            for (int i = 0; i < 16; ++i) acc[nt][mt][i] = 0.f;
}

DI void phaseA_tile(const float* __restrict__ X, const bf16x8* __restrict__ wfin, bf16_t* __restrict__ U, int tile, char* smem) {
    char* sA = smem; float* srstd = (float*)(smem + 2 * SA_BYTES);
    int tok0 = tile * 64; asm volatile("" : "+s"(tok0));
    int tid = threadIdx.x; asm volatile("" : "+v"(tid));
    const int w = __builtin_amdgcn_readfirstlane(tid >> 6), lane = tid & 63, r = lane & 31, h = lane >> 5;
    ALoadF32 al; al.init(X + (size_t)(tok0 + (tid >> 3)) * DM, tid);
    f32x16 acc[4][2]; zero_acc<4>(acc);
    gemm64<4, 2>(acc, al, 8, wfin + (size_t)w * (64 * 4 * 64) + lane, sA, lane);
    float ss = al.ss;
    ss += __shfl_xor(ss, 1); ss += __shfl_xor(ss, 2); ss += __shfl_xor(ss, 4);
    if ((tid & 7) == 0) srstd[tid >> 3] = rsqrtf(ss * (1.f / 1024.f) + 1e-6f);
    __syncthreads();
#pragma unroll
    for (int mt = 0; mt < 2; ++mt) {
        const float rs = srstd[mt * 32 + r];
        bf16_t* orow = U + (size_t)(tok0 + mt * 32 + r) * DM + w * 128;
#pragma unroll
        for (int nt = 0; nt < 4; ++nt)
#pragma unroll
            for (int q = 0; q < 4; ++q) {
                uint2 o; o.x = pack_bf2(acc[nt][mt][4 * q] * rs, acc[nt][mt][4 * q + 1] * rs);
                o.y = pack_bf2(acc[nt][mt][4 * q + 2] * rs, acc[nt][mt][4 * q + 3] * rs);
                *(uint2*)(orow + nt * 32 + 8 * q + 4 * h) = o;
            }
    }
    __syncthreads();
}

struct PrepW {
    const float* norm_mix; const float* w_in; const float* w_glu; const float* w_pool; const float* g_out_ssm; const float* g_out_pool;
    const float* w_out; const float* norm_ffn; const float* w_q; const float* k1; const float* k2;
    bf16x8* wfin; bf16x8* wfglu; bf16x8* wfpool; bf16x8* wfout; bf16x8* wfq; bf16x8* wfk1; bf16x8* wfk2;
};
DI void prep_weights(const PrepW& p, size_t gtid, size_t gs) {
#pragma unroll 1
    for (int l = 0; l < 2; ++l) {
        conv_wfrag<true>(p.w_in + (size_t)l * DM * DM, DM, 1, p.norm_mix + l * DM, p.norm_mix + l * DM, DM, DM, DM, 4, p.wfin + (size_t)l * (DM * DM / 8), gtid, gs);
        conv_wfrag<false>(p.w_glu + (size_t)l * 512 * 512, 512, 1, p.norm_mix, p.norm_mix, 512, 512, 512, 2, p.wfglu + (size_t)l * (512 * 512 / 8), gtid, gs);
#pragma unroll 1
        for (int gi = 0; gi < 4; ++gi)
            conv_wfrag<false>(p.w_pool + (size_t)(l * 4 + gi) * 128 * 128, 128, 1, p.norm_mix, p.norm_mix, 128, 128, 128, 2, p.wfpool + (size_t)(l * 4 + gi) * (128 * 128 / 8), gtid, gs);
        conv_wfrag<true>(p.w_out + (size_t)l * DM * DM, DM, 1, p.g_out_ssm + l * 512, p.g_out_pool + l * 512, 512, DM, DM, 4, p.wfout + (size_t)l * (DM * DM / 8), gtid, gs);
        conv_wfrag<true>(p.w_q + (size_t)l * DM * 2048, 2048, 1, p.norm_ffn + l * DM, p.norm_ffn + l * DM, DM, DM, 2048, 4, p.wfq + (size_t)l * (DM * 2048 / 8), gtid, gs);
        conv_wfrag<false>(p.k1 + (size_t)l * 128 * 128, 1, 128, p.norm_mix, p.norm_mix, 128, 128, 128, 4, p.wfk1 + (size_t)l * (128 * 128 / 8), gtid, gs);
        conv_wfrag<false>(p.k2 + (size_t)l * 128 * 128, 1, 128, p.norm_mix, p.norm_mix, 128, 128, 128, 4, p.wfk2 + (size_t)l * (128 * 128 / 8), gtid, gs);
    }
}
#define KT_BLK 528
#define KT_BYTES (65 * KT_BLK)
#define WST_FRAGS (4 * 64 * 64)
#define CCAR_FRAGS (32 * 8 * 64)
#define SU_CH 2064

DI void prep_s5_item(int lg, const float* __restrict__ a_re, const float* __restrict__ a_im, const float* __restrict__ log_dt,
                     const float* __restrict__ b_re, const float* __restrict__ b_im, const float* __restrict__ c_re, const float* __restrict__ c_im,
                     const float* __restrict__ d_skip, char* __restrict__ KT, bf16x8* __restrict__ WST, bf16x8* __restrict__ CCAR,
                     float* __restrict__ ABT, char* smem) {
    float* powr = (float*)smem;
    float* powi = powr + 65 * 64;
    float* bzr = powi + 65 * 64;
    float* bzi = bzr + 1024;
    float* cr = bzi + 1024;
    float* ci = cr + 1024;
    int tid = threadIdx.x; asm volatile("" : "+v"(tid));
    const float* are_p = a_re + lg * 64; const float* aim_p = a_im + lg * 64;
    const float dt = expf(log_dt[lg]);
    for (int it = tid; it < 65 * 64; it += NTHR) {
        const int tau = it >> 6, p = it & 63;
        const float lre = are_p[p], lim = aim_p[p];
        const float mag = expf((float)tau * lre * dt);
        double rev = (double)lim * (double)dt * (double)tau * 0.15915494309189535;
        rev -= floor(rev);
        const float ang = (float)rev * 6.283185307179586f;
        powr[it] = mag * cosf(ang); powi[it] = mag * sinf(ang);
    }
    for (int it = tid; it < 1024; it += NTHR) {
        cr[it] = c_re[lg * 1024 + it]; ci[it] = c_im[lg * 1024 + it];
    }
    __syncthreads();
    for (int it = tid; it < 1024; it += NTHR) {
        const int p = it >> 4;
        const float lre = are_p[p], lim = aim_p[p];
        const float ar = powr[64 + p], ai = powi[64 + p];
        const float inv = 1.f / (lre * lre + lim * lim), nre = ar - 1.f;
        const float zre = (nre * lre + ai * lim) * inv, zim = (ai * lre - nre * lim) * inv;
        const float br = b_re[lg * 1024 + it], bi = b_im[lg * 1024 + it];
        bzr[it] = zre * br - zim * bi; bzi[it] = zre * bi + zim * br;
    }
    __syncthreads();
    if (tid < 64) { ABT[lg * 128 + 2 * tid] = powr[64 * 64 + tid]; ABT[lg * 128 + 2 * tid + 1] = powi[64 * 64 + tid]; }
    char* kt = KT + (size_t)lg * KT_BYTES;
    for (int it = tid; it < KT_BLK / 4; it += NTHR) ((unsigned*)kt)[it] = 0u;
    for (int it = tid; it < 64 * 128; it += NTHR) {
        const int tau = it >> 7, ho = (it >> 3) & 15, hi = (it & 7) * 2;
        float s0 = 0.f, s1 = 0.f;
        for (int p = 0; p < 64; ++p) {
            const float c_r = cr[ho * 64 + p], c_i = ci[ho * 64 + p], pr = powr[tau * 64 + p], pi = powi[tau * 64 + p];
            const float cpr = c_r * pr - c_i * pi, cpi = c_r * pi + c_i * pr;
            s0 += cpr * bzr[p * 16 + hi] - cpi * bzi[p * 16 + hi];
            s1 += cpr * bzr[p * 16 + hi + 1] - cpi * bzi[p * 16 + hi + 1];
        }
        if (tau == 0) { if (ho == hi) s0 += d_skip[lg * 16 + ho]; if (ho == hi + 1) s1 += d_skip[lg * 16 + ho]; }
        *(unsigned*)(kt + (tau + 1) * KT_BLK + ho * 32 + hi * 2) = pack_bf2(s0, s1);
    }
    for (int it = tid; it < 65 * 4; it += NTHR) ((unsigned*)(kt + (it >> 2) * KT_BLK + 512))[it & 3] = 0u;
    bf16x8* wst = WST + (size_t)lg * WST_FRAGS;
    for (int it = tid; it < WST_FRAGS; it += NTHR) {
        const int lane = it & 63, j = (it >> 6) & 63, nt = it >> 12;
        const int r = lane & 31, h = lane >> 5, n = nt * 32 + r, p = n & 63, im = n >> 6;
        const float pr = powr[(63 - j) * 64 + p], pi = powi[(63 - j) * 64 + p];
        float v[8];
#pragma unroll
        for (int jj = 0; jj < 8; ++jj) {
            const float zr = bzr[p * 16 + 8 * h + jj], zi = bzi[p * 16 + 8 * h + jj];
            v[jj] = im ? (pr * zi + pi * zr) : (pr * zr - pi * zi);
        }
        uint4 o; o.x = pack_bf2(v[0], v[1]); o.y = pack_bf2(v[2], v[3]); o.z = pack_bf2(v[4], v[5]); o.w = pack_bf2(v[6], v[7]);
        *(uint4*)(wst + it) = o;
    }
    bf16x8* cc = CCAR + (size_t)lg * CCAR_FRAGS;
    for (int it = tid; it < CCAR_FRAGS; it += NTHR) {
        const int lane = it & 63, ks = (it >> 6) & 7, mt = it >> 9;
        const int r = lane & 31, h = lane >> 5, m = mt * 32 + r, i = m >> 4, ho = m & 15;
        float v[8];
#pragma unroll
        for (int jj = 0; jj < 8; ++jj) {
            const int k = ks * 16 + 8 * h + jj, p = k & 63, im = k >> 6;
            const float c_r = cr[ho * 64 + p], c_i = ci[ho * 64 + p], pr = powr[(i + 1) * 64 + p], pi = powi[(i + 1) * 64 + p];
            v[jj] = im ? -(c_r * pi + c_i * pr) : (c_r * pr - c_i * pi);
        }
        uint4 o; o.x = pack_bf2(v[0], v[1]); o.y = pack_bf2(v[2], v[3]); o.z = pack_bf2(v[4], v[5]); o.w = pack_bf2(v[6], v[7]);
        *(uint4*)(cc + it) = o;
    }
    __syncthreads();
}

#define PB_SU 0
#define PB_SKT (32 * SU_CH)
#define PB_SL (PB_SKT + KT_BYTES)
#define PB_SPART (PB_SL + 32 * 132 * 4)
#define PB_SSP (PB_SPART + 4 * 4096)
#define PB_BYTES (PB_SSP + 32 * 272)

DI void phaseB_tile(const bf16_t* __restrict__ U, const char* __restrict__ KT, const bf16x8* __restrict__ WST, const bf16x8* __restrict__ CCAR,
                    const float* __restrict__ ABT, bf16_t* __restrict__ YPRE, int tile, char* smem) {
    const int g = tile & 31, b = tile >> 5;
    int tid = threadIdx.x; asm volatile("" : "+v"(tid));
    const int w = __builtin_amdgcn_readfirstlane(tid >> 6), lane = tid & 63, r = lane & 31, h = lane >> 5;
    char* sU = smem + PB_SU; char* sKT = smem + PB_SKT; float* sL = (float*)(smem + PB_SL); float* sPart = (float*)(smem + PB_SPART);
    char* sSp = smem + PB_SSP;
#pragma unroll
    for (int it = 0; it < 4; ++it) {
        const int tok = tid + NTHR * it;
        const uint4* src = (const uint4*)(U + (size_t)(b * SEQ + tok) * DM + g * 16);
        const uint4 v0 = src[0], v1 = src[1];
        char* d = sU + (tok >> 6) * SU_CH + (tok & 63) * 32;
        *(uint4*)d = v0; *(uint4*)(d + 16) = v1;
    }
    {
        const uint4* src = (const uint4*)(KT + (size_t)g * KT_BYTES);
        for (int it = tid; it < KT_BYTES / 16; it += NTHR) ((uint4*)sKT)[it] = src[it];
    }
    __syncthreads();
    {
        const int nt = w & 3, kh = w >> 2;
        f32x16 acc;
#pragma unroll
        for (int i = 0; i < 16; ++i) acc[i] = 0.f;
        const bf16x8* wp = WST + (size_t)g * WST_FRAGS + (size_t)(nt * 64 + kh * 32) * 64 + lane;
        const char* up = sU + r * SU_CH + h * 16 + kh * 32 * 32;
#pragma unroll 4
        for (int j = 0; j < 32; ++j) {
            const bf16x8 a = wp[j * 64];
            const bf16x8 bb = *(const bf16x8*)(up + j * 32);
            acc = MFMA32(a, bb, acc);
        }
        if (kh == 1) {
#pragma unroll
            for (int i = 0; i < 16; ++i) sPart[(nt * 16 + i) * 64 + lane] = acc[i];
        }
        __syncthreads();
        if (kh == 0) {
#pragma unroll
            for (int i = 0; i < 16; ++i) sL[r * 132 + nt * 32 + crow(i, h)] = acc[i] + sPart[(nt * 16 + i) * 64 + lane];
        }
        __syncthreads();
    }
    if (tid < 64) {
        const int p = tid;
        const float ar = ABT[g * 128 + 2 * p], ai = ABT[g * 128 + 2 * p + 1];
        float sr = 0.f, si = 0.f;
        for (int c = 0; c < 32; ++c) {
            *(bf16_t*)(sSp + c * 272 + p * 2) = (bf16_t)(pack_bf2(sr, 0.f) & 0xffffu);
            *(bf16_t*)(sSp + c * 272 + (64 + p) * 2) = (bf16_t)(pack_bf2(si, 0.f) & 0xffffu);
            const float lr = sL[c * 132 + p], li = sL[c * 132 + 64 + p];
            const float nr = ar * sr - ai * si + lr, ni = ar * si + ai * sr + li;
            sr = nr; si = ni;
        }
    }
    f32x16 acc4[4];
#pragma unroll
    for (int q = 0; q < 4; ++q)
#pragma unroll
        for (int i = 0; i < 16; ++i) acc4[q][i] = 0.f;
    const int mts0 = w, mts1 = 15 - w, mts2 = 16 + w, mts3 = 31 - w;
    {
        const char* up = sU + r * SU_CH + h * 16;
        const char* kp = sKT + (r & 15) * 32 + h * 16 + ((r >> 4) + 1) * KT_BLK;
        for (int j = 0; j < 64; ++j) {
            const bf16x8 bb = *(const bf16x8*)(up + j * 32);
#define TOEP_STEP(q, mt) if (2 * (mt) + 1 >= j) { const bf16x8 a = *(const bf16x8*)(kp + (2 * (mt) - j) * KT_BLK); acc4[q] = MFMA32(a, bb, acc4[q]); }
            TOEP_STEP(0, mts0) TOEP_STEP(1, mts1) TOEP_STEP(2, mts2) TOEP_STEP(3, mts3)
#undef TOEP_STEP
        }
    }
    __syncthreads();
    {
        const bf16x8* cp = CCAR + (size_t)g * CCAR_FRAGS + lane;
        const char* sp = sSp + r * 272 + h * 16;
#pragma unroll
        for (int ks = 0; ks < 8; ++ks) {
            const bf16x8 bb = *(const bf16x8*)(sp + ks * 32);
            acc4[0] = MFMA32(cp[(mts0 * 8 + ks) * 64], bb, acc4[0]);
            acc4[1] = MFMA32(cp[(mts1 * 8 + ks) * 64], bb, acc4[1]);
            acc4[2] = MFMA32(cp[(mts2 * 8 + ks) * 64], bb, acc4[2]);
            acc4[3] = MFMA32(cp[(mts3 * 8 + ks) * 64], bb, acc4[3]);
        }
    }
    {
        bf16_t* ybase = YPRE + (size_t)(b * SEQ + r * 64) * 512 + g * 16;
#define PB_STORE(q, mt) _Pragma("unroll") for (int rq = 0; rq < 4; ++rq) { const int c0 = 8 * rq + 4 * h; const int i = 2 * (mt) + (c0 >> 4); \
            uint2 o; o.x = pack_bf2(acc4[q][4 * rq], acc4[q][4 * rq + 1]); o.y = pack_bf2(acc4[q][4 * rq + 2], acc4[q][4 * rq + 3]); \
            *(uint2*)(ybase + (size_t)i * 512 + (c0 & 15)) = o; }
        PB_STORE(0, mts0) PB_STORE(1, mts1) PB_STORE(2, mts2) PB_STORE(3, mts3)
#undef PB_STORE
    }
    __syncthreads();
}

struct ALoadGelu {
    const bf16_t* base; bf16_t* gout; u32x4 v0, v1; int cc; int dofs;
    DI void init(const bf16_t* rowbase, bf16_t* growbase, int tid) { base = rowbase + (tid & 7) * 16; gout = growbase + (tid & 7) * 16; dofs = (tid >> 3) * SA_STRIDE + (tid & 7) * 32; }
    DI void issue(int c) { const u32x4* p = (const u32x4*)(base + c * 128); v0 = p[0]; v1 = p[1]; cc = c; }
    DI unsigned g2(unsigned u) { return pack_bf2(gelu_exact(bf_lo(u)), gelu_exact(bf_hi(u))); }
    DI void commit(char* buf) {
        u32x4 o0, o1;
        o0.x = g2(v0.x); o0.y = g2(v0.y); o0.z = g2(v0.z); o0.w = g2(v0.w);
        o1.x = g2(v1.x); o1.y = g2(v1.y); o1.z = g2(v1.z); o1.w = g2(v1.w);
        char* d = buf + dofs;
        *(u32x4*)d = o0; *(u32x4*)(d + 16) = o1;
        u32x4* gp = (u32x4*)(gout + cc * 128); gp[0] = o0; gp[1] = o1;
    }
};

DI void tok_reduce(float p0, float p1, float* sred, float& t0, float& t1, int tid) {
    const int w = tid >> 6, lane = tid & 63, r = lane & 31, h = lane >> 5;
    __syncthreads();
    sred[(w * 2 + h) * 64 + r] = p0; sred[(w * 2 + h) * 64 + 32 + r] = p1;
    __syncthreads();
    float a = 0.f, b = 0.f;
#pragma unroll
    for (int k = 0; k < 16; ++k) { a += sred[k * 64 + r]; b += sred[k * 64 + 32 + r]; }
    t0 = a; t1 = b;
}

#define PC_SRED (4 * SA_BYTES)
#define PC_BYTES (PC_SRED + 4096 + 256)

struct PCArgs {
    const bf16_t* U; const bf16_t* YPRE; bf16_t* G1; bf16_t* A2; const float* Xin; float* Xout; bf16_t* Hb; float* RSTD;
    const bf16x8* wfglu; const float* b_glu; const bf16x8* wfpool; const float* pool_scale; const bf16x8* wfout;
};

DI void phaseC1_tile(const PCArgs& a, int tile, char* smem) {
    char* sA = smem; float* sred = (float*)(smem + PC_SRED);
    {
        int tok0 = tile * 64; asm volatile("" : "+s"(tok0));
        int tid = threadIdx.x; asm volatile("" : "+v"(tid));
        const int w = __builtin_amdgcn_readfirstlane(tid >> 6), lane = tid & 63, r = lane & 31, h = lane >> 5;
        ALoadGelu al; al.init(a.YPRE + (size_t)(tok0 + (tid >> 3)) * 512, a.G1 + (size_t)(tok0 + (tid >> 3)) * 512, tid);
        f32x16 acc[2][2]; zero_acc<2>(acc);
        gemm64<2, 4>(acc, al, 4, a.wfglu + (size_t)w * (32 * 2 * 64) + lane, sA, lane);
        float ss0 = 0.f, ss1 = 0.f;
#pragma unroll
        for (int mt = 0; mt < 2; ++mt) {
            const bf16_t* yrow = a.G1 + (size_t)(tok0 + mt * 32 + r) * 512 + w * 64;
#pragma unroll
            for (int nt = 0; nt < 2; ++nt)
#pragma unroll
                for (int q = 0; q < 4; ++q) {
                    asm volatile("" ::: "memory");
                    const int n = nt * 32 + 8 * q + 4 * h;
                    const uint2 yp = *(const uint2*)(yrow + n);
                    const float4 bg = *(const float4*)(a.b_glu + w * 64 + n);
                    const float y0 = bf_lo(yp.x), y1 = bf_hi(yp.x), y2 = bf_lo(yp.y), y3 = bf_hi(yp.y);
                    const float o0 = y0 / (1.f + __expf(-(acc[nt][mt][4 * q] + bg.x)));
                    const float o1 = y1 / (1.f + __expf(-(acc[nt][mt][4 * q + 1] + bg.y)));
                    const float o2 = y2 / (1.f + __expf(-(acc[nt][mt][4 * q + 2] + bg.z)));
                    const float o3 = y3 / (1.f + __expf(-(acc[nt][mt][4 * q + 3] + bg.w)));
                    acc[nt][mt][4 * q] = o0; acc[nt][mt][4 * q + 1] = o1; acc[nt][mt][4 * q + 2] = o2; acc[nt][mt][4 * q + 3] = o3;
                    const float s = o0 * o0 + o1 * o1 + o2 * o2 + o3 * o3;
                    if (mt == 0) ss0 += s; else ss1 += s;
                }
        }
        float t0, t1; tok_reduce(ss0, ss1, sred, t0, t1, tid);
        const float rs0 = rsqrtf(t0 * (1.f / 512.f) + 1e-6f), rs1 = rsqrtf(t1 * (1.f / 512.f) + 1e-6f);
#pragma unroll
        for (int mt = 0; mt < 2; ++mt) {
            const float rs = mt ? rs1 : rs0;
            bf16_t* orow = a.A2 + (size_t)(tok0 + mt * 32 + r) * DM + w * 64;
#pragma unroll
            for (int nt = 0; nt < 2; ++nt)
#pragma unroll
                for (int q = 0; q < 4; ++q) {
                    uint2 o; o.x = pack_bf2(acc[nt][mt][4 * q] * rs, acc[nt][mt][4 * q + 1] * rs);
                    o.y = pack_bf2(acc[nt][mt][4 * q + 2] * rs, acc[nt][mt][4 * q + 3] * rs);
                    *(uint2*)(orow + nt * 32 + 8 * q + 4 * h) = o;
                }
        }
    }
    {
        int tok0 = tile * 64; asm volatile("" : "+s"(tok0));
        int tid = threadIdx.x; asm volatile("" : "+v"(tid));
        const int w = __builtin_amdgcn_readfirstlane(tid >> 6), lane = tid & 63, r = lane & 31, h = lane >> 5;
        const int row = tid >> 3, seg = tid & 7;
        const int tok = tok0 + row, t = tok & (SEQ - 1);
#pragma unroll
        for (int gi = 0; gi < 4; ++gi) {
            const int win = 2 << gi;
            const int cnt = (t + 1 < win) ? (t + 1) : win;
            const bf16_t* up = a.U + (size_t)tok * DM + 512 + gi * 128 + seg * 16;
            float s[16];
            const uint4 c0 = *(const uint4*)up, c1 = *(const uint4*)(up + 8);
            const unsigned cu[8] = {c0.x, c0.y, c0.z, c0.w, c1.x, c1.y, c1.z, c1.w};
#pragma unroll
            for (int i = 0; i < 8; ++i) { s[2 * i] = bf_lo(cu[i]); s[2 * i + 1] = bf_hi(cu[i]); }
            for (int k = 1; k < cnt; ++k) {
                const uint4 d0 = *(const uint4*)(up - (size_t)k * DM), d1 = *(const uint4*)(up - (size_t)k * DM + 8);
                const unsigned du[8] = {d0.x, d0.y, d0.z, d0.w, d1.x, d1.y, d1.z, d1.w};
#pragma unroll
                for (int i = 0; i < 8; ++i) { s[2 * i] += bf_lo(du[i]); s[2 * i + 1] += bf_hi(du[i]); }
            }
            const float inv = 1.f / (float)cnt;
            unsigned o[8];
#pragma unroll
            for (int i = 0; i < 8; ++i) o[i] = pack_bf2(s[2 * i] * inv - bf_lo(cu[i]), s[2 * i + 1] * inv - bf_hi(cu[i]));
            char* d = sA + gi * SA_BYTES + row * SA_STRIDE + seg * 32;
            *(uint4*)d = make_uint4(o[0], o[1], o[2], o[3]); *(uint4*)(d + 16) = make_uint4(o[4], o[5], o[6], o[7]);
        }
        __syncthreads();
        const int gi = w >> 1;
        f32x16 acc[2][2]; zero_acc<2>(acc);
        const bf16x8* wp = a.wfpool + (size_t)gi * (128 * 128 / 8) + (size_t)(w & 1) * (8 * 2 * 64) + lane;
        const char* buf = sA + gi * SA_BYTES + r * SA_STRIDE + h * 16;
#pragma unroll
        for (int ks = 0; ks < 8; ++ks) {
            const bf16x8 a0 = *(const bf16x8*)(buf + ks * 32);
            const bf16x8 a1 = *(const bf16x8*)(buf + 32 * SA_STRIDE + ks * 32);
#pragma unroll
            for (int nt = 0; nt < 2; ++nt) {
                const bf16x8 wv = wp[(ks * 2 + nt) * 64];
                acc[nt][0] = MFMA32(wv, a0, acc[nt][0]);
                acc[nt][1] = MFMA32(wv, a1, acc[nt][1]);
            }
        }
        float ss0 = 0.f, ss1 = 0.f;
#pragma unroll
        for (int mt = 0; mt < 2; ++mt)
#pragma unroll
            for (int nt = 0; nt < 2; ++nt)
#pragma unroll
                for (int q = 0; q < 4; ++q) {
                    asm volatile("" ::: "memory");
                    const int n = w * 64 + nt * 32 + 8 * q + 4 * h;
                    const float4 sc = *(const float4*)(a.pool_scale + n);
                    const float o0 = acc[nt][mt][4 * q] * sc.x, o1 = acc[nt][mt][4 * q + 1] * sc.y, o2 = acc[nt][mt][4 * q + 2] * sc.z, o3 = acc[nt][mt][4 * q + 3] * sc.w;
                    acc[nt][mt][4 * q] = o0; acc[nt][mt][4 * q + 1] = o1; acc[nt][mt][4 * q + 2] = o2; acc[nt][mt][4 * q + 3] = o3;
                    const float s = o0 * o0 + o1 * o1 + o2 * o2 + o3 * o3;
                    if (mt == 0) ss0 += s; else ss1 += s;
                }
        float t0, t1; tok_reduce(ss0, ss1, sred, t0, t1, tid);
        const float rs0 = rsqrtf(t0 * (1.f / 512.f) + 1e-6f), rs1 = rsqrtf(t1 * (1.f / 512.f) + 1e-6f);
#pragma unroll
        for (int mt = 0; mt < 2; ++mt) {
            const float rs = mt ? rs1 : rs0;
            bf16_t* orow = a.A2 + (size_t)(tok0 + mt * 32 + r) * DM + 512 + w * 64;
#pragma unroll
            for (int nt = 0; nt < 2; ++nt)
#pragma unroll
                for (int q = 0; q < 4; ++q) {
                    uint2 o; o.x = pack_bf2(acc[nt][mt][4 * q] * rs, acc[nt][mt][4 * q + 1] * rs);
                    o.y = pack_bf2(acc[nt][mt][4 * q + 2] * rs, acc[nt][mt][4 * q + 3] * rs);
                    *(uint2*)(orow + nt * 32 + 8 * q + 4 * h) = o;
                }
        }
        __syncthreads();
    }
    {
        int tok0 = tile * 64; asm volatile("" : "+s"(tok0));
        int tid = threadIdx.x; asm volatile("" : "+v"(tid));
        const int w = __builtin_amdgcn_readfirstlane(tid >> 6), lane = tid & 63, r = lane & 31, h = lane >> 5;
        ALoadBF16 al; al.init(a.A2 + (size_t)(tok0 + (tid >> 3)) * DM, tid);
        f32x16 acc[4][2]; zero_acc<4>(acc);
        gemm64<4, 2>(acc, al, 8, a.wfout + (size_t)w * (64 * 4 * 64) + lane, sA, lane);
        float ss0 = 0.f, ss1 = 0.f;
#pragma unroll
        for (int mt = 0; mt < 2; ++mt) {
            const size_t ro = (size_t)(tok0 + mt * 32 + r) * DM + w * 128;
#pragma unroll
            for (int nt = 0; nt < 4; ++nt)
#pragma unroll
                for (int q = 0; q < 4; ++q) {
                    asm volatile("" ::: "memory");
                    const int n = nt * 32 + 8 * q + 4 * h;
                    const float4 xi = *(const float4*)(a.Xin + ro + n);
                    float4 xo; xo.x = xi.x + acc[nt][mt][4 * q]; xo.y = xi.y + acc[nt][mt][4 * q + 1]; xo.z = xi.z + acc[nt][mt][4 * q + 2]; xo.w = xi.w + acc[nt][mt][4 * q + 3];
                    *(float4*)(a.Xout + ro + n) = xo;
                    uint2 o; o.x = pack_bf2(xo.x, xo.y); o.y = pack_bf2(xo.z, xo.w);
                    *(uint2*)(a.Hb + ro + n) = o;
                    const float s = xo.x * xo.x + xo.y * xo.y + xo.z * xo.z + xo.w * xo.w;
                    if (mt == 0) ss0 += s; else ss1 += s;
                }
        }
        float t0, t1; tok_reduce(ss0, ss1, sred, t0, t1, tid);
        if (w == 0) { a.RSTD[tok0 + r + 32 * h] = rsqrtf((h ? t1 : t0) * (1.f / 1024.f) + 1e-6f); }
        __syncthreads();
    }
}

DI unsigned f2ord(float f) { const unsigned u = __float_as_uint(f); return u ^ ((u >> 31) ? 0xFFFFFFFFu : 0x80000000u); }
DI float ord2f(unsigned o) { return __uint_as_float((o & 0x80000000u) ? (o ^ 0x80000000u) : ~o); }
DI unsigned umax_(unsigned a, unsigned b) { return a > b ? a : b; }
DI unsigned umin_(unsigned a, unsigned b) { return a < b ? a : b; }

struct PRArgs {
    const bf16_t* Hb; const float* RSTD; bf16_t* Qb; const bf16x8* wfq; const bf16x8* wfk1; const bf16x8* wfk2; int* EX; float* GT;
};

DI void topk_insert16(unsigned (&L)[16], const f32x16& s, int nbase, int h) {
#pragma unroll
    for (int i = 0; i < 16; ++i) {
        unsigned x = (f2ord(s[i]) & 0xFFFFFF80u) | (unsigned)(127 - (nbase + crow(i, h)));
#pragma unroll
        for (int k = 0; k < 16; ++k) { const unsigned hi = umax_(L[k], x); x = umin_(L[k], x); L[k] = hi; }
    }
}

DI void phaseC2_tile(const PRArgs& a, int tile, char* smem) {
    char* sA = smem;
#pragma unroll 1
    for (int ps = 0; ps < 2; ++ps) {
        int tok0 = tile * 64; asm volatile("" : "+s"(tok0));
        int tid = threadIdx.x; asm volatile("" : "+v"(tid));
        const int w = __builtin_amdgcn_readfirstlane(tid >> 6), lane = tid & 63, r = lane & 31, h = lane >> 5;
        ALoadBF16 al; al.init(a.Hb + (size_t)(tok0 + (tid >> 3)) * DM, tid);
        f32x16 acc[4][2]; zero_acc<4>(acc);
        const int ng = ps * 8 + w;
        gemm64<4, 2>(acc, al, 8, a.wfq + (size_t)ng * (64 * 4 * 64) + lane, sA, lane);
#pragma unroll
        for (int mt = 0; mt < 2; ++mt) {
            const float rs = a.RSTD[tok0 + mt * 32 + r];
            bf16_t* orow = a.Qb + (size_t)(tok0 + mt * 32 + r) * 2048 + ng * 128;
#pragma unroll
            for (int nt = 0; nt < 4; ++nt)
#pragma unroll
                for (int q = 0; q < 4; ++q) {
                    uint2 o; o.x = pack_bf2(acc[nt][mt][4 * q] * rs, acc[nt][mt][4 * q + 1] * rs);
                    o.y = pack_bf2(acc[nt][mt][4 * q + 2] * rs, acc[nt][mt][4 * q + 3] * rs);
                    *(uint2*)(orow + nt * 32 + 8 * q + 4 * h) = o;
                }
        }
    }
    __syncthreads();
    {
        int tok0 = tile * 64; asm volatile("" : "+s"(tok0));
        int tid = threadIdx.x; asm volatile("" : "+v"(tid));
        const int w = __builtin_amdgcn_readfirstlane(tid >> 6), lane = tid & 63, r = lane & 31, h = lane >> 5;
        unsigned T0[16], T1[16];
#pragma unroll 1
        for (int half = 0; half < 2; ++half) {
            gwp_t wk = (gwp_t)(half ? a.wfk2 : a.wfk1) + lane;
#pragma unroll 1
            for (int mt = 0; mt < 2; ++mt) {
                f32x16 sc[4];
#pragma unroll
                for (int nt = 0; nt < 4; ++nt)
#pragma unroll
                    for (int i = 0; i < 16; ++i) sc[nt][i] = 0.f;
                const bf16_t* qrow = a.Qb + (size_t)(tok0 + mt * 32 + r) * 2048 + w * 256 + half * 128 + 8 * h;
#pragma unroll
                for (int ks = 0; ks < 8; ++ks) {
                    const bf16x8 qv = *(const bf16x8*)(qrow + ks * 16);
#pragma unroll
                    for (int nt = 0; nt < 4; ++nt) sc[nt] = MFMA32(wk[(ks * 4 + nt) * 64], qv, sc[nt]);
                }
                unsigned L[16];
#pragma unroll
                for (int k = 0; k < 16; ++k) L[k] = 0u;
#pragma unroll
                for (int nt = 0; nt < 4; ++nt) topk_insert16(L, sc[nt], nt * 32, h);
                unsigned P[16];
#pragma unroll
                for (int k = 0; k < 16; ++k) P[k] = (unsigned)__shfl_xor((int)L[k], 32);
#pragma unroll
                for (int k = 0; k < 16; ++k) L[k] = umax_(L[k], P[15 - k]);
#pragma unroll
                for (int d = 8; d > 0; d >>= 1)
#pragma unroll
                    for (int k = 0; k < 16; ++k)
                        if ((k & d) == 0) { const unsigned hi = umax_(L[k], L[k + d]), lo = umin_(L[k], L[k + d]); L[k] = hi; L[k + d] = lo; }
                if (h == mt) {
                    if (half == 0) {
#pragma unroll
                        for (int k = 0; k < 16; ++k) T0[k] = L[k];
                    } else {
#pragma unroll
                        for (int k = 0; k < 16; ++k) T1[k] = L[k];
                    }
                }
            }
        }
        float v1[16], v2[16];
#pragma unroll
        for (int k = 0; k < 16; ++k) { v1[k] = ord2f(T0[k] & 0xFFFFFF80u); v2[k] = ord2f(T1[k] & 0xFFFFFF80u); }
        unsigned C[16];
#pragma unroll
        for (int b = 0; b < 16; ++b) C[b] = (f2ord(v1[0] + v2[b]) & 0xFFFFFF00u) | (unsigned)(255 - b);
#pragma unroll
        for (int aa = 1; aa < 16; ++aa)
#pragma unroll
            for (int b = 0; b < 16; ++b)
                if ((aa + 1) * (b + 1) <= 16) {
                    unsigned x = (f2ord(v1[aa] + v2[b]) & 0xFFFFFF00u) | (unsigned)(255 - (aa * 16 + b));
#pragma unroll
                    for (int k = (aa + 1) * (b + 1) - 1; k < 16; ++k) { const unsigned hi = umax_(C[k], x); x = umin_(C[k], x); C[k] = hi; }
                }
        unsigned* sI = (unsigned*)(smem) + (w * 64 + lane) * 9;
#pragma unroll
        for (int q = 0; q < 4; ++q) {
            unsigned p1 = 0u, p2 = 0u;
#pragma unroll
            for (int j = 0; j < 4; ++j) { p1 |= (127u - (T0[4 * q + j] & 0x7Fu)) << (8 * j); p2 |= (127u - (T1[4 * q + j] & 0x7Fu)) << (8 * j); }
            sI[q] = p1; sI[4 + q] = p2;
        }
        const unsigned char* sB = (const unsigned char*)sI;
        const float mx = ord2f(C[0] & 0xFFFFFF00u);
        float e[16]; float sum = 0.f; int ex[16];
#pragma unroll
        for (int k = 0; k < 16; ++k) {
            e[k] = __expf(ord2f(C[k] & 0xFFFFFF00u) - mx); sum += e[k];
            const unsigned ci = 255u - (C[k] & 0xFFu);
            ex[k] = (int)sB[ci >> 4] * 128 + (int)sB[16 + (ci & 15u)];
        }
        const float inv = 1.f / sum;
        const size_t ob = ((size_t)(tok0 + h * 32 + r) * 8 + w) * 16;
#pragma unroll
        for (int q = 0; q < 4; ++q) {
            *(int4*)(a.EX + ob + 4 * q) = make_int4(ex[4 * q], ex[4 * q + 1], ex[4 * q + 2], ex[4 * q + 3]);
            *(float4*)(a.GT + ob + 4 * q) = make_float4(e[4 * q] * inv, e[4 * q + 1] * inv, e[4 * q + 2] * inv, e[4 * q + 3] * inv);
        }
    }
    __syncthreads();
}

typedef __attribute__((ext_vector_type(2))) short s16x2;
DI float dot2bf(unsigned a, unsigned b, float c) {
    return __builtin_amdgcn_fdot2_f32_bf16(__builtin_bit_cast(bf2_t, a), __builtin_bit_cast(bf2_t, b), c, false);
}
typedef const __attribute__((address_space(1))) u32x4* grow_t;

struct PGArgs {
    const bf16_t* Hb; const float* RSTD; const int* EX; const float* GT; const bf16_t* Ub; const bf16_t* Vb;
    const float* Xin; float* Xout; const float* gfinal; int final_norm;
};

struct RowQuad { u32x4 a0, a1, b0, b1, c0, c1, d0, d1; };
DI void quad_load(RowQuad& q, const bf16_t* tab, int e0, int e1, int e2, int e3, int lane) {
    grow_t p0 = (grow_t)(tab + (size_t)e0 * DM) + lane; grow_t p1 = (grow_t)(tab + (size_t)e1 * DM) + lane;
    grow_t p2 = (grow_t)(tab + (size_t)e2 * DM) + lane; grow_t p3 = (grow_t)(tab + (size_t)e3 * DM) + lane;
    q.a0 = p0[0]; q.a1 = p0[64]; q.b0 = p1[0]; q.b1 = p1[64]; q.c0 = p2[0]; q.c1 = p2[64]; q.d0 = p3[0]; q.d1 = p3[64];
}
DI float row_dot(const u32x4& r0, const u32x4& r1, const u32x4& h0, const u32x4& h1) {
    float s = 0.f;
    s = dot2bf(r0.x, h0.x, s); s = dot2bf(r0.y, h0.y, s); s = dot2bf(r0.z, h0.z, s); s = dot2bf(r0.w, h0.w, s);
    s = dot2bf(r1.x, h1.x, s); s = dot2bf(r1.y, h1.y, s); s = dot2bf(r1.z, h1.z, s); s = dot2bf(r1.w, h1.w, s);
    return s;
}
DI void row_axpy(float (&acc)[16], const u32x4& r0, const u32x4& r1, float s) {
    acc[0] = fmaf(s, bf_lo(r0.x), acc[0]); acc[1] = fmaf(s, bf_hi(r0.x), acc[1]); acc[2] = fmaf(s, bf_lo(r0.y), acc[2]); acc[3] = fmaf(s, bf_hi(r0.y), acc[3]);
    acc[4] = fmaf(s, bf_lo(r0.z), acc[4]); acc[5] = fmaf(s, bf_hi(r0.z), acc[5]); acc[6] = fmaf(s, bf_lo(r0.w), acc[6]); acc[7] = fmaf(s, bf_hi(r0.w), acc[7]);
    acc[8] = fmaf(s, bf_lo(r1.x), acc[8]); acc[9] = fmaf(s, bf_hi(r1.x), acc[9]); acc[10] = fmaf(s, bf_lo(r1.y), acc[10]); acc[11] = fmaf(s, bf_hi(r1.y), acc[11]);
    acc[12] = fmaf(s, bf_lo(r1.z), acc[12]); acc[13] = fmaf(s, bf_hi(r1.z), acc[13]); acc[14] = fmaf(s, bf_lo(r1.w), acc[14]); acc[15] = fmaf(s, bf_hi(r1.w), acc[15]);
}
#define RL(v, l) __builtin_amdgcn_readlane((v), (l))
#define RLF(v, l) __uint_as_float((unsigned)__builtin_amdgcn_readlane((int)__float_as_uint(v), (l)))

DI float reduce16(float (&p)[16], int lane) {
    const bool b5 = lane & 32, b4 = lane & 16, b3 = lane & 8, b2 = lane & 4;
    float q8[8], q4[4], q2[2];
#pragma unroll
    for (int k = 0; k < 8; ++k) { const float keep = b5 ? p[k + 8] : p[k], send = b5 ? p[k] : p[k + 8]; q8[k] = keep + __shfl_xor(send, 32); }
#pragma unroll
    for (int k = 0; k < 4; ++k) { const float keep = b4 ? q8[k + 4] : q8[k], send = b4 ? q8[k] : q8[k + 4]; q4[k] = keep + __shfl_xor(send, 16); }
#pragma unroll
    for (int k = 0; k < 2; ++k) { const float keep = b3 ? q4[k + 2] : q4[k], send = b3 ? q4[k] : q4[k + 2]; q2[k] = keep + __shfl_xor(send, 8); }
    float t;
    { const float keep = b2 ? q2[1] : q2[0], send = b2 ? q2[0] : q2[1]; t = keep + __shfl_xor(send, 4); }
    t += __shfl_xor(t, 1); t += __shfl_xor(t, 2);
    return t;
}

DI void phaseC3_tile(const PGArgs& a, int tile) {
    int tid = threadIdx.x; asm volatile("" : "+v"(tid));
    const int w = __builtin_amdgcn_readfirstlane(tid >> 6), lane = tid & 63;
    const int el = (lane >> 2) & 15;
#pragma unroll 1
    for (int ti = 0; ti < 8; ++ti) {
        const int tok = tile * 64 + w * 8 + ti;
        const u32x4* hp = (const u32x4*)(a.Hb + (size_t)tok * DM) + lane;
        const u32x4 h0 = hp[0], h1 = hp[64];
        const float rs = a.RSTD[tok];
        float acc[16];
#pragma unroll
        for (int i = 0; i < 16; ++i) acc[i] = 0.f;
#pragma unroll 1
        for (int hd = 0; hd < 8; ++hd) {
            const int exv = a.EX[((size_t)tok * 8 + hd) * 16 + (lane & 15)];
            const float gt = a.GT[((size_t)tok * 8 + hd) * 16 + el];
            RowQuad qa, qb;
            float p[16];
            quad_load(qa, a.Ub, RL(exv, 0), RL(exv, 1), RL(exv, 2), RL(exv, 3), lane);
            quad_load(qb, a.Ub, RL(exv, 4), RL(exv, 5), RL(exv, 6), RL(exv, 7), lane);
            p[0] = row_dot(qa.a0, qa.a1, h0, h1); p[1] = row_dot(qa.b0, qa.b1, h0, h1); p[2] = row_dot(qa.c0, qa.c1, h0, h1); p[3] = row_dot(qa.d0, qa.d1, h0, h1);
            quad_load(qa, a.Ub, RL(exv, 8), RL(exv, 9), RL(exv, 10), RL(exv, 11), lane);
            p[4] = row_dot(qb.a0, qb.a1, h0, h1); p[5] = row_dot(qb.b0, qb.b1, h0, h1); p[6] = row_dot(qb.c0, qb.c1, h0, h1); p[7] = row_dot(qb.d0, qb.d1, h0, h1);
            quad_load(qb, a.Ub, RL(exv, 12), RL(exv, 13), RL(exv, 14), RL(exv, 15), lane);
            p[8] = row_dot(qa.a0, qa.a1, h0, h1); p[9] = row_dot(qa.b0, qa.b1, h0, h1); p[10] = row_dot(qa.c0, qa.c1, h0, h1); p[11] = row_dot(qa.d0, qa.d1, h0, h1);
            quad_load(qa, a.Vb, RL(exv, 0), RL(exv, 1), RL(exv, 2), RL(exv, 3), lane);
            p[12] = row_dot(qb.a0, qb.a1, h0, h1); p[13] = row_dot(qb.b0, qb.b1, h0, h1); p[14] = row_dot(qb.c0, qb.c1, h0, h1); p[15] = row_dot(qb.d0, qb.d1, h0, h1);
            quad_load(qb, a.Vb, RL(exv, 4), RL(exv, 5), RL(exv, 6), RL(exv, 7), lane);
            const float act = gelu_exact(reduce16(p, lane) * rs) * gt;
            row_axpy(acc, qa.a0, qa.a1, RLF(act, 0)); row_axpy(acc, qa.b0, qa.b1, RLF(act, 4)); row_axpy(acc, qa.c0, qa.c1, RLF(act, 8)); row_axpy(acc, qa.d0, qa.d1, RLF(act, 12));
            quad_load(qa, a.Vb, RL(exv, 8), RL(exv, 9), RL(exv, 10), RL(exv, 11), lane);
            row_axpy(acc, qb.a0, qb.a1, RLF(act, 16)); row_axpy(acc, qb.b0, qb.b1, RLF(act, 20)); row_axpy(acc, qb.c0, qb.c1, RLF(act, 24)); row_axpy(acc, qb.d0, qb.d1, RLF(act, 28));
            quad_load(qb, a.Vb, RL(exv, 12), RL(exv, 13), RL(exv, 14), RL(exv, 15), lane);
            row_axpy(acc, qa.a0, qa.a1, RLF(act, 32)); row_axpy(acc, qa.b0, qa.b1, RLF(act, 36)); row_axpy(acc, qa.c0, qa.c1, RLF(act, 40)); row_axpy(acc, qa.d0, qa.d1, RLF(act, 44));
            row_axpy(acc, qb.a0, qb.a1, RLF(act, 48)); row_axpy(acc, qb.b0, qb.b1, RLF(act, 52)); row_axpy(acc, qb.c0, qb.c1, RLF(act, 56)); row_axpy(acc, qb.d0, qb.d1, RLF(act, 60));
        }
        const float* xi = a.Xin + (size_t)tok * DM + lane * 8;
        float* xo = a.Xout + (size_t)tok * DM + lane * 8;
        float4 x0 = *(const float4*)xi, x1 = *(const float4*)(xi + 4), x2 = *(const float4*)(xi + 512), x3 = *(const float4*)(xi + 516);
        x0.x += acc[0]; x0.y += acc[1]; x0.z += acc[2]; x0.w += acc[3]; x1.x += acc[4]; x1.y += acc[5]; x1.z += acc[6]; x1.w += acc[7];
        x2.x += acc[8]; x2.y += acc[9]; x2.z += acc[10]; x2.w += acc[11]; x3.x += acc[12]; x3.y += acc[13]; x3.z += acc[14]; x3.w += acc[15];
        if (a.final_norm) {
            float ss = x0.x * x0.x + x0.y * x0.y + x0.z * x0.z + x0.w * x0.w + x1.x * x1.x + x1.y * x1.y + x1.z * x1.z + x1.w * x1.w
                     + x2.x * x2.x + x2.y * x2.y + x2.z * x2.z + x2.w * x2.w + x3.x * x3.x + x3.y * x3.y + x3.z * x3.z + x3.w * x3.w;
            ss = wave_sum(ss);
            const float rf = rsqrtf(ss * (1.f / 1024.f) + 1e-6f);
            const float* gf = a.gfinal + lane * 8;
            const float4 g0 = *(const float4*)gf, g1 = *(const float4*)(gf + 4), g2 = *(const float4*)(gf + 512), g3 = *(const float4*)(gf + 516);
            x0.x *= rf * g0.x; x0.y *= rf * g0.y; x0.z *= rf * g0.z; x0.w *= rf * g0.w; x1.x *= rf * g1.x; x1.y *= rf * g1.y; x1.z *= rf * g1.z; x1.w *= rf * g1.w;
            x2.x *= rf * g2.x; x2.y *= rf * g2.y; x2.z *= rf * g2.z; x2.w *= rf * g2.w; x3.x *= rf * g3.x; x3.y *= rf * g3.y; x3.z *= rf * g3.z; x3.w *= rf * g3.w;
        }
        *(float4*)xo = x0; *(float4*)(xo + 4) = x1; *(float4*)(xo + 512) = x2; *(float4*)(xo + 516) = x3;
    }
}

struct MegaArgs {
    const float* x; const float* a_re; const float* a_im; const float* log_dt; const float* b_re; const float* b_im; const float* c_re;
    const float* c_im; const float* d_skip; const float* b_glu; const float* pool_scale; const float* u_exp; const float* v_exp;
    const float* norm_final;
    PrepW pw;
    float* X; bf16_t* U; bf16_t* YPRE; bf16_t* G1; bf16_t* A2; bf16_t* Hb; bf16_t* Qb; int* EX; float* GT; float* RSTD;
    char* KT; bf16x8* WST; bf16x8* CCAR; float* ABT; bf16_t* Ub; bf16_t* Vb;
};

__global__ void __launch_bounds__(NTHR) mega_kernel(MegaArgs a) {
    __shared__ __attribute__((aligned(16))) char smem[PB_BYTES];
    cg::grid_group grid = cg::this_grid();
    const int nblk = gridDim.x;
    {
        const size_t gtid = (size_t)blockIdx.x * NTHR + threadIdx.x, gs = (size_t)nblk * NTHR;
        for (int lg = blockIdx.x; lg < 64; lg += nblk)
            prep_s5_item(lg, a.a_re, a.a_im, a.log_dt, a.b_re, a.b_im, a.c_re, a.c_im, a.d_skip, a.KT, a.WST, a.CCAR, a.ABT, smem);
        prep_weights(a.pw, gtid, gs);
#pragma unroll 1
        for (int l = 0; l < 2; ++l) {
            conv_rows_bf16(a.u_exp + (size_t)l * NEXP * DM, a.pw.norm_ffn + l * DM, a.Ub + (size_t)l * NEXP * DM, (size_t)NEXP * DM, gtid, gs);
            conv_rows_bf16(a.v_exp + (size_t)l * NEXP * DM, nullptr, a.Vb + (size_t)l * NEXP * DM, (size_t)NEXP * DM, gtid, gs);
        }
    }
    grid.sync();
#pragma unroll 1
    for (int l = 0; l < 2; ++l) {
        const float* xin = (l == 0) ? a.x : a.X;
        if (l == 0) {
            for (int tile = blockIdx.x; tile < NTOK / 64; tile += nblk) phaseA_tile(xin, a.pw.wfin, a.U, tile, smem);
        }
        grid.sync();
        bf16_t* Ul = a.U + (size_t)l * NTOK * DM;
        for (int tile = blockIdx.x; tile < 256; tile += nblk)
            phaseB_tile(Ul, a.KT + (size_t)l * 32 * KT_BYTES, a.WST + (size_t)l * 32 * WST_FRAGS, a.CCAR + (size_t)l * 32 * CCAR_FRAGS, a.ABT + l * 32 * 128, a.YPRE, tile, smem);
        grid.sync();
        PCArgs pa; pa.U = Ul; pa.YPRE = a.YPRE; pa.G1 = a.G1; pa.A2 = a.A2; pa.Xin = xin; pa.Xout = a.X; pa.Hb = a.Hb; pa.RSTD = a.RSTD;
        pa.wfglu = a.pw.wfglu + (size_t)l * (512 * 512 / 8); pa.b_glu = a.b_glu + l * 512; pa.wfpool = a.pw.wfpool + (size_t)l * 4 * (128 * 128 / 8);
        pa.pool_scale = a.pool_scale + l * 512; pa.wfout = a.pw.wfout + (size_t)l * (DM * DM / 8);
        PRArgs pr; pr.Hb = a.Hb; pr.RSTD = a.RSTD; pr.Qb = a.Qb; pr.wfq = a.pw.wfq + (size_t)l * (DM * 2048 / 8); pr.wfk1 = a.pw.wfk1 + (size_t)l * (128 * 128 / 8);
        pr.wfk2 = a.pw.wfk2 + (size_t)l * (128 * 128 / 8); pr.EX = a.EX; pr.GT = a.GT;
        PGArgs pg; pg.Hb = a.Hb; pg.RSTD = a.RSTD; pg.EX = a.EX; pg.GT = a.GT; pg.Ub = a.Ub + (size_t)l * NEXP * DM; pg.Vb = a.Vb + (size_t)l * NEXP * DM;
        pg.Xin = a.X; pg.Xout = a.X; pg.gfinal = a.norm_final; pg.final_norm = (l == 1);
        for (int tile = blockIdx.x; tile < NTOK / 64; tile += nblk) {
            phaseC1_tile(pa, tile, smem);
            phaseC2_tile(pr, tile, smem);
            phaseC3_tile(pg, tile);
            if (l == 0) {
                __syncthreads();
                phaseA_tile(a.X, a.pw.wfin + (size_t)(DM * DM / 8), a.U + (size_t)NTOK * DM, tile, smem);
            }
        }
    }
}

extern "C" void kernel_launch(void* const* d_in, const int* in_sizes, int n_in, void* d_out, int out_size, void* d_ws, size_t ws_size,
                              hipStream_t stream) {
    char* wsb = (char*)d_ws;
    size_t off = 0;
    auto take = [&](size_t bytes) { char* p = wsb + off; off += (bytes + 255) & ~(size_t)255; return p; };
    MegaArgs a;
    memset(&a, 0, sizeof(a));
    a.x = (const float*)d_in[0];
    a.pw.norm_mix = (const float*)d_in[1]; a.pw.w_in = (const float*)d_in[2];
    a.a_re = (const float*)d_in[3]; a.a_im = (const float*)d_in[4]; a.log_dt = (const float*)d_in[5];
    a.b_re = (const float*)d_in[6]; a.b_im = (const float*)d_in[7]; a.c_re = (const float*)d_in[8]; a.c_im = (const float*)d_in[9];
    a.d_skip = (const float*)d_in[10]; a.pw.w_glu = (const float*)d_in[11]; a.b_glu = (const float*)d_in[12];
    a.pw.w_pool = (const float*)d_in[13]; a.pool_scale = (const float*)d_in[14]; a.pw.g_out_ssm = (const float*)d_in[15];
    a.pw.g_out_pool = (const float*)d_in[16]; a.pw.w_out = (const float*)d_in[17]; a.pw.norm_ffn = (const float*)d_in[18];
    a.pw.w_q = (const float*)d_in[19]; a.pw.k1 = (const float*)d_in[20]; a.pw.k2 = (const float*)d_in[21];
    a.u_exp = (const float*)d_in[22]; a.v_exp = (const float*)d_in[23]; a.norm_final = (const float*)d_in[24];
    a.X = (float*)d_out;
    a.U = (bf16_t*)take((size_t)2 * NTOK * DM * 2);
    a.YPRE = (bf16_t*)take((size_t)NTOK * 512 * 2);
    a.G1 = (bf16_t*)take((size_t)NTOK * 512 * 2);
    a.A2 = (bf16_t*)take((size_t)NTOK * DM * 2);
    a.Hb = (bf16_t*)take((size_t)NTOK * DM * 2);
    a.Qb = (bf16_t*)take((size_t)NTOK * 2048 * 2);
    a.EX = (int*)take((size_t)NTOK * 128 * 4);
    a.GT = (float*)take((size_t)NTOK * 128 * 4);
    a.RSTD = (float*)take(NTOK * 4);
    a.pw.wfin = (bf16x8*)take((size_t)2 * DM * DM * 2);
    a.pw.wfglu = (bf16x8*)take((size_t)2 * 512 * 512 * 2);
    a.pw.wfpool = (bf16x8*)take((size_t)2 * 4 * 128 * 128 * 2);
    a.pw.wfout = (bf16x8*)take((size_t)2 * DM * DM * 2);
    a.pw.wfq = (bf16x8*)take((size_t)2 * DM * 2048 * 2);
    a.pw.wfk1 = (bf16x8*)take((size_t)2 * 128 * 128 * 2);
    a.pw.wfk2 = (bf16x8*)take((size_t)2 * 128 * 128 * 2);
    a.KT = take((size_t)64 * KT_BYTES);
    a.WST = (bf16x8*)take((size_t)64 * WST_FRAGS * 16);
    a.CCAR = (bf16x8*)take((size_t)64 * CCAR_FRAGS * 16);
    a.ABT = (float*)take(64 * 128 * 4);
    a.Ub = (bf16_t*)take((size_t)2 * NEXP * DM * 2);
    a.Vb = (bf16_t*)take((size_t)2 * NEXP * DM * 2);

    static int grid_blocks = 0;
    if (!grid_blocks) {
        int dev = 0, cus = 0, per_cu = 0;
        hipGetDevice(&dev);
        hipDeviceGetAttribute(&cus, hipDeviceAttributeMultiprocessorCount, dev);
        hipOccupancyMaxActiveBlocksPerMultiprocessor(&per_cu, mega_kernel, NTHR, 0);
        if (per_cu > 1) per_cu = 1;
        grid_blocks = cus * per_cu;
        if (grid_blocks > 256) grid_blocks = 256;
    }
    void* args[] = {&a};
    hipError_t e = hipLaunchCooperativeKernel((void*)mega_kernel, dim3(grid_blocks), dim3(NTHR), args, 0, stream);
    if (e != hipSuccess) fprintf(stderr, "cooperative launch failed: %s (grid %d)\n", hipGetErrorString(e), grid_blocks);
}
```

```cpp
#include <hip/hip_runtime.h>
#include <hip/hip_cooperative_groups.h>
#include <cstdio>
#include <cstring>
namespace cg = cooperative_groups;
#include <math.h>
#include <stdint.h>

#define NTOK 16384
#define SEQ 2048
#define DM 1024
#define SSMW 512
#define NEXP 16384

__device__ __forceinline__ float gelu_exact(float x) { return 0.5f * x * (1.f + erff(x * 0.70710678118654752f)); }

template <int M> __device__ __forceinline__ int shx_i(int v, int lane) {
    if constexpr (M == 1) return __builtin_amdgcn_mov_dpp(v, 0xB1, 0xF, 0xF, true);
    else if constexpr (M == 2) return __builtin_amdgcn_mov_dpp(v, 0x4E, 0xF, 0xF, true);
    else if constexpr (M < 32) return __builtin_amdgcn_ds_swizzle(v, (M << 10) | 0x1F);
    else return __builtin_amdgcn_ds_bpermute((lane ^ 32) << 2, v);
}
template <int M> __device__ __forceinline__ float shx(float v, int lane) { return __int_as_float(shx_i<M>(__float_as_int(v), lane)); }
__device__ __forceinline__ float wave_sum(float v, int lane) {
    v += shx<1>(v, lane); v += shx<2>(v, lane); v += shx<4>(v, lane); v += shx<8>(v, lane); v += shx<16>(v, lane); v += shx<32>(v, lane);
    return v;
}

#define DI __device__ __forceinline__
typedef __attribute__((ext_vector_type(8))) short bf16x8;
typedef __attribute__((ext_vector_type(16))) float f32x16;
typedef __attribute__((ext_vector_type(2))) __bf16 bf2_t;
typedef __attribute__((ext_vector_type(2))) float f2_t;
typedef unsigned short bf16_t;
typedef __attribute__((ext_vector_type(4))) unsigned u32x4;
typedef __attribute__((ext_vector_type(4))) float f32x4;
typedef const __attribute__((address_space(1))) bf16x8* gwp_t;
#define MFMA32(a, b, c) __builtin_amdgcn_mfma_f32_32x32x16_bf16((a), (b), (c), 0, 0, 0)

DI unsigned pack_bf2(float a, float b) { f2_t v = {a, b}; return __builtin_bit_cast(unsigned, __builtin_convertvector(v, bf2_t)); }
DI float bf_lo(unsigned u) { return __uint_as_float(u << 16); }
DI float bf_hi(unsigned u) { return __uint_as_float(u & 0xffff0000u); }
DI int crow(int reg, int h) { return (reg & 3) + 8 * (reg >> 2) + 4 * h; }

#define SA_STRIDE 272
#define SA_BYTES (64 * SA_STRIDE)
#define NTHR 512

template <bool GAIN>
DI void conv_wfrag(const float* __restrict__ src, int ldk, int ldn, const float* __restrict__ ga, const float* __restrict__ gb, int split,
                   int K, int N, int NTG, bf16x8* __restrict__ dst, size_t gtid, size_t gstride) {
    const int KS = K / 16;
    const size_t total = (size_t)(N / 32) * KS * 64;
    for (size_t item = gtid; item < total; item += gstride) {
        const int lane = (int)(item & 63); const size_t f = item >> 6;
        const int nti = (int)(f % NTG); const size_t f2 = f / NTG;
        const int ks = (int)(f2 % KS), nt = (int)(f2 / KS) * NTG + nti;
        const int r = lane & 31, h = lane >> 5;
        const int n = nt * 32 + r, k0 = ks * 16 + 8 * h;
        float v[8];
#pragma unroll
        for (int j = 0; j < 8; ++j) {
            const int k = k0 + j;
            float g = 1.f;
            if (GAIN) g = (k < split) ? ga[k] : gb[k - split];
            v[j] = src[(size_t)k * ldk + (size_t)n * ldn] * g;
        }
        uint4 o; o.x = pack_bf2(v[0], v[1]); o.y = pack_bf2(v[2], v[3]); o.z = pack_bf2(v[4], v[5]); o.w = pack_bf2(v[6], v[7]);
        *(uint4*)(dst + item) = o;
    }
}

DI void conv_rows_bf16(const float* __restrict__ src, const float* __restrict__ gain, bf16_t* __restrict__ dst, size_t nelem, size_t gtid, size_t gstride) {
    for (size_t i = gtid * 8; i < nelem; i += gstride * 8) {
        float4 a = *(const float4*)(src + i), b = *(const float4*)(src + i + 4);
        if (gain) {
            const int c = (int)(i & 1023);
            float4 g0 = *(const float4*)(gain + c), g1 = *(const float4*)(gain + c + 4);
            a.x *= g0.x; a.y *= g0.y; a.z *= g0.z; a.w *= g0.w; b.x *= g1.x; b.y *= g1.y; b.z *= g1.z; b.w *= g1.w;
        }
        uint4 o; o.x = pack_bf2(a.x, a.y); o.y = pack_bf2(a.z, a.w); o.z = pack_bf2(b.x, b.y); o.w = pack_bf2(b.z, b.w);
        *(uint4*)(dst + i) = o;
    }
}

struct ALoadF32 {
    const float* base; f32x4 v0, v1, v2, v3; float ss; int dofs;
    DI void init(const float* rowbase, int tid) { base = rowbase + (tid & 7) * 16; ss = 0.f; dofs = (tid >> 3) * SA_STRIDE + (tid & 7) * 32; }
    DI void issue(int c) { const f32x4* p = (const f32x4*)(base + c * 128); v0 = p[0]; v1 = p[1]; v2 = p[2]; v3 = p[3]; }
    DI void commit(char* buf) {
        u32x4 o0, o1;
        ss += v0.x * v0.x + v0.y * v0.y + v0.z * v0.z + v0.w * v0.w + v1.x * v1.x + v1.y * v1.y + v1.z * v1.z + v1.w * v1.w
            + v2.x * v2.x + v2.y * v2.y + v2.z * v2.z + v2.w * v2.w + v3.x * v3.x + v3.y * v3.y + v3.z * v3.z + v3.w * v3.w;
        o0.x = pack_bf2(v0.x, v0.y); o0.y = pack_bf2(v0.z, v0.w); o0.z = pack_bf2(v1.x, v1.y); o0.w = pack_bf2(v1.z, v1.w);
        o1.x = pack_bf2(v2.x, v2.y); o1.y = pack_bf2(v2.z, v2.w); o1.z = pack_bf2(v3.x, v3.y); o1.w = pack_bf2(v3.z, v3.w);
        char* d = buf + dofs;
        *(u32x4*)d = o0; *(u32x4*)(d + 16) = o1;
    }
};
struct ALoadBF16 {
    const bf16_t* base; u32x4 v0, v1; int dofs;
    DI void init(const bf16_t* rowbase, int tid) { base = rowbase + (tid & 7) * 16; dofs = (tid >> 3) * SA_STRIDE + (tid & 7) * 32; }
    DI void issue(int c) { const u32x4* p = (const u32x4*)(base + c * 128); v0 = p[0]; v1 = p[1]; }
    DI void commit(char* buf) {
        char* d = buf + dofs;
        *(u32x4*)d = v0; *(u32x4*)(d + 16) = v1;
    }
};

template <int NT, int PF, class AL>
DI void gemm64(f32x16 (&acc)[NT][2], AL& al, const int nchunks, const bf16x8* __restrict__ wf_, char* sA, const int lane) {
    gwp_t wf = (gwp_t)wf_;
    const int r = lane & 31, h = lane >> 5;
    bf16x8 bq[PF][NT];
    al.issue(0);
#pragma unroll
    for (int p = 0; p < PF; ++p)
#pragma unroll
        for (int nt = 0; nt < NT; ++nt) bq[p][nt] = wf[(p * NT + nt) * 64];
    gwp_t wpf = wf + PF * NT * 64;
    al.commit(sA);
    const int kend = nchunks * 8 - PF;
    int kg = 0;
#pragma unroll 1
    for (int c = 0; c < nchunks; ++c) {
        if (c + 1 < nchunks) al.issue(c + 1);
        __syncthreads();
        const char* buf = sA + (c & 1) * SA_BYTES + r * SA_STRIDE + h * 16;
#pragma unroll
        for (int ks = 0; ks < 8; ++ks) {
            const bf16x8 a0 = *(const bf16x8*)(buf + ks * 32);
            const bf16x8 a1 = *(const bf16x8*)(buf + 32 * SA_STRIDE + ks * 32);
#pragma unroll
            for (int nt = 0; nt < NT; ++nt) {
                acc[nt][0] = MFMA32(bq[ks % PF][nt], a0, acc[nt][0]);
                acc[nt][1] = MFMA32(bq[ks % PF][nt], a1, acc[nt][1]);
            }
            if (kg < kend) {
#pragma unroll
                for (int nt = 0; nt < NT; ++nt) bq[ks % PF][nt] = wpf[nt * 64];
            }
            wpf += NT * 64; ++kg;
            asm volatile("" : "+v"(wpf));
        }
        if (c + 1 < nchunks) al.commit(sA + ((c + 1) & 1) * SA_BYTES);
    }
    __syncthreads();
}

template <int NT>
DI void zero_acc(f32x16 (&acc)[NT][2]) {
#pragma unroll
    for (int nt = 0; nt < NT; ++nt)
#pragma unroll
        for (int mt = 0; mt < 2; ++mt)
#pragma unroll
            for (int i = 0; i < 16; ++i) acc[nt][mt][i] = 0.f;
}

DI void phaseA_tile(const float* __restrict__ X, const bf16x8* __restrict__ wfin, bf16_t* __restrict__ U, int tile, char* smem) {
    char* sA = smem; float* srstd = (float*)(smem + 2 * SA_BYTES);
    int tok0 = tile * 64; asm volatile("" : "+s"(tok0));
    int tid = threadIdx.x; asm volatile("" : "+v"(tid));
    const int w = __builtin_amdgcn_readfirstlane(tid >> 6), lane = tid & 63, r = lane & 31, h = lane >> 5;
    ALoadF32 al; al.init(X + (size_t)(tok0 + (tid >> 3)) * DM, tid);
    f32x16 acc[4][2]; zero_acc<4>(acc);
    gemm64<4, 2>(acc, al, 8, wfin + (size_t)w * (64 * 4 * 64) + lane, sA, lane);
    float ss = al.ss;
    ss += shx<1>(ss, lane); ss += shx<2>(ss, lane); ss += shx<4>(ss, lane);
    if ((tid & 7) == 0) srstd[tid >> 3] = rsqrtf(ss * (1.f / 1024.f) + 1e-6f);
    __syncthreads();
#pragma unroll
    for (int mt = 0; mt < 2; ++mt) {
        const float rs = srstd[mt * 32 + r];
        bf16_t* orow = U + (size_t)(tok0 + mt * 32 + r) * DM + w * 128;
#pragma unroll
        for (int nt = 0; nt < 4; ++nt)
#pragma unroll
            for (int q = 0; q < 4; ++q) {
                uint2 o; o.x = pack_bf2(acc[nt][mt][4 * q] * rs, acc[nt][mt][4 * q + 1] * rs);
                o.y = pack_bf2(acc[nt][mt][4 * q + 2] * rs, acc[nt][mt][4 * q + 3] * rs);
                *(uint2*)(orow + nt * 32 + 8 * q + 4 * h) = o;
            }
    }
    __syncthreads();
}

struct PrepW {
    const float* norm_mix; const float* w_in; const float* w_glu; const float* w_pool; const float* g_out_ssm; const float* g_out_pool;
    const float* w_out; const float* norm_ffn; const float* w_q; const float* k1; const float* k2;
    bf16x8* wfin; bf16x8* wfglu; bf16x8* wfpool; bf16x8* wfout; bf16x8* wfq; bf16x8* wfk1; bf16x8* wfk2;
};
DI void prep_weights(const PrepW& p, size_t gtid, size_t gs) {
#pragma unroll 1
    for (int l = 0; l < 2; ++l) {
        conv_wfrag<true>(p.w_in + (size_t)l * DM * DM, DM, 1, p.norm_mix + l * DM, p.norm_mix + l * DM, DM, DM, DM, 4, p.wfin + (size_t)l * (DM * DM / 8), gtid, gs);
        conv_wfrag<false>(p.w_glu + (size_t)l * 512 * 512, 512, 1, p.norm_mix, p.norm_mix, 512, 512, 512, 2, p.wfglu + (size_t)l * (512 * 512 / 8), gtid, gs);
#pragma unroll 1
        for (int gi = 0; gi < 4; ++gi)
            conv_wfrag<false>(p.w_pool + (size_t)(l * 4 + gi) * 128 * 128, 128, 1, p.norm_mix, p.norm_mix, 128, 128, 128, 2, p.wfpool + (size_t)(l * 4 + gi) * (128 * 128 / 8), gtid, gs);
        conv_wfrag<true>(p.w_out + (size_t)l * DM * DM, DM, 1, p.g_out_ssm + l * 512, p.g_out_pool + l * 512, 512, DM, DM, 4, p.wfout + (size_t)l * (DM * DM / 8), gtid, gs);
        conv_wfrag<true>(p.w_q + (size_t)l * DM * 2048, 2048, 1, p.norm_ffn + l * DM, p.norm_ffn + l * DM, DM, DM, 2048, 4, p.wfq + (size_t)l * (DM * 2048 / 8), gtid, gs);
        conv_wfrag<false>(p.k1 + (size_t)l * 128 * 128, 1, 128, p.norm_mix, p.norm_mix, 128, 128, 128, 4, p.wfk1 + (size_t)l * (128 * 128 / 8), gtid, gs);
        conv_wfrag<false>(p.k2 + (size_t)l * 128 * 128, 1, 128, p.norm_mix, p.norm_mix, 128, 128, 128, 4, p.wfk2 + (size_t)l * (128 * 128 / 8), gtid, gs);
    }
}
#define KT_BLK 528
#define KT_BYTES (65 * KT_BLK)
#define WST_FRAGS (4 * 64 * 64)
#define CCAR_FRAGS (32 * 8 * 64)
#define SU_CH 2064

DI void prep_s5_item(int lg, const float* __restrict__ a_re, const float* __restrict__ a_im, const float* __restrict__ log_dt,
                     const float* __restrict__ b_re, const float* __restrict__ b_im, const float* __restrict__ c_re, const float* __restrict__ c_im,
                     const float* __restrict__ d_skip, char* __restrict__ KT, bf16x8* __restrict__ WST, bf16x8* __restrict__ CCAR,
                     float* __restrict__ ABT, char* smem) {
    float* powr = (float*)smem;
    float* powi = powr + 65 * 64;
    float* bzr = powi + 65 * 64;
    float* bzi = bzr + 1024;
    float* cr = bzi + 1024;
    float* ci = cr + 1024;
    int tid = threadIdx.x; asm volatile("" : "+v"(tid));
    const float* are_p = a_re + lg * 64; const float* aim_p = a_im + lg * 64;
    const float dt = expf(log_dt[lg]);
    for (int it = tid; it < 65 * 64; it += NTHR) {
        const int tau = it >> 6, p = it & 63;
        const float lre = are_p[p], lim = aim_p[p];
        const float mag = expf((float)tau * lre * dt);
        double rev = (double)lim * (double)dt * (double)tau * 0.15915494309189535;
        rev -= floor(rev);
        const float ang = (float)rev * 6.283185307179586f;
        powr[it] = mag * cosf(ang); powi[it] = mag * sinf(ang);
    }
    for (int it = tid; it < 1024; it += NTHR) {
        cr[it] = c_re[lg * 1024 + it]; ci[it] = c_im[lg * 1024 + it];
    }
    __syncthreads();
    for (int it = tid; it < 1024; it += NTHR) {
        const int p = it >> 4;
        const float lre = are_p[p], lim = aim_p[p];
        const float ar = powr[64 + p], ai = powi[64 + p];
        const float inv = 1.f / (lre * lre + lim * lim), nre = ar - 1.f;
        const float zre = (nre * lre + ai * lim) * inv, zim = (ai * lre - nre * lim) * inv;
        const float br = b_re[lg * 1024 + it], bi = b_im[lg * 1024 + it];
        bzr[it] = zre * br - zim * bi; bzi[it] = zre * bi + zim * br;
    }
    __syncthreads();
    if (tid < 64) { ABT[lg * 128 + 2 * tid] = powr[64 * 64 + tid]; ABT[lg * 128 + 2 * tid + 1] = powi[64 * 64 + tid]; }
    char* kt = KT + (size_t)lg * KT_BYTES;
    for (int it = tid; it < KT_BLK / 4; it += NTHR) ((unsigned*)kt)[it] = 0u;
    for (int it = tid; it < 64 * 128; it += NTHR) {
        const int tau = it >> 7, ho = (it >> 3) & 15, hi = (it & 7) * 2;
        float s0 = 0.f, s1 = 0.f;
        for (int p = 0; p < 64; ++p) {
            const float c_r = cr[ho * 64 + p], c_i = ci[ho * 64 + p], pr = powr[tau * 64 + p], pi = powi[tau * 64 + p];
            const float cpr = c_r * pr - c_i * pi, cpi = c_r * pi + c_i * pr;
            s0 += cpr * bzr[p * 16 + hi] - cpi * bzi[p * 16 + hi];
            s1 += cpr * bzr[p * 16 + hi + 1] - cpi * bzi[p * 16 + hi + 1];
        }
        if (tau == 0) { if (ho == hi) s0 += d_skip[lg * 16 + ho]; if (ho == hi + 1) s1 += d_skip[lg * 16 + ho]; }
        *(unsigned*)(kt + (tau + 1) * KT_BLK + ho * 32 + hi * 2) = pack_bf2(s0, s1);
    }
    for (int it = tid; it < 65 * 4; it += NTHR) ((unsigned*)(kt + (it >> 2) * KT_BLK + 512))[it & 3] = 0u;
    bf16x8* wst = WST + (size_t)lg * WST_FRAGS;
    for (int it = tid; it < WST_FRAGS; it += NTHR) {
        const int lane = it & 63, j = (it >> 6) & 63, nt = it >> 12;
        const int r = lane & 31, h = lane >> 5, n = nt * 32 + r, p = n & 63, im = n >> 6;
        const float pr = powr[(63 - j) * 64 + p], pi = powi[(63 - j) * 64 + p];
        float v[8];
#pragma unroll
        for (int jj = 0; jj < 8; ++jj) {
            const float zr = bzr[p * 16 + 8 * h + jj], zi = bzi[p * 16 + 8 * h + jj];
            v[jj] = im ? (pr * zi + pi * zr) : (pr * zr - pi * zi);
        }
        uint4 o; o.x = pack_bf2(v[0], v[1]); o.y = pack_bf2(v[2], v[3]); o.z = pack_bf2(v[4], v[5]); o.w = pack_bf2(v[6], v[7]);
        *(uint4*)(wst + it) = o;
    }
    bf16x8* cc = CCAR + (size_t)lg * CCAR_FRAGS;
    for (int it = tid; it < CCAR_FRAGS; it += NTHR) {
        const int lane = it & 63, ks = (it >> 6) & 7, mt = it >> 9;
        const int r = lane & 31, h = lane >> 5, m = mt * 32 + r, i = m >> 4, ho = m & 15;
        float v[8];
#pragma unroll
        for (int jj = 0; jj < 8; ++jj) {
            const int k = ks * 16 + 8 * h + jj, p = k & 63, im = k >> 6;
            const float c_r = cr[ho * 64 + p], c_i = ci[ho * 64 + p], pr = powr[(i + 1) * 64 + p], pi = powi[(i + 1) * 64 + p];
            v[jj] = im ? -(c_r * pi + c_i * pr) : (c_r * pr - c_i * pi);
        }
        uint4 o; o.x = pack_bf2(v[0], v[1]); o.y = pack_bf2(v[2], v[3]); o.z = pack_bf2(v[4], v[5]); o.w = pack_bf2(v[6], v[7]);
        *(uint4*)(cc + it) = o;
    }
    __syncthreads();
}

#define PB_SU 0
#define PB_SKT (32 * SU_CH)
#define PB_SL (PB_SKT + KT_BYTES)
#define PB_SPART (PB_SL + 32 * 132 * 4)
#define PB_SSP (PB_SPART + 4 * 4096)
#define PB_BYTES (PB_SSP + 32 * 272)

DI void phaseB_tile(const bf16_t* __restrict__ U, const char* __restrict__ KT, const bf16x8* __restrict__ WST, const bf16x8* __restrict__ CCAR,
                    const float* __restrict__ ABT, bf16_t* __restrict__ YPRE, int tile, char* smem) {
    const int g = tile & 31, b = tile >> 5;
    int tid = threadIdx.x; asm volatile("" : "+v"(tid));
    const int w = __builtin_amdgcn_readfirstlane(tid >> 6), lane = tid & 63, r = lane & 31, h = lane >> 5;
    char* sU = smem + PB_SU; char* sKT = smem + PB_SKT; float* sL = (float*)(smem + PB_SL); float* sPart = (float*)(smem + PB_SPART);
    char* sSp = smem + PB_SSP;
#pragma unroll
    for (int it = 0; it < 4; ++it) {
        const int tok = tid + NTHR * it;
        const uint4* src = (const uint4*)(U + (size_t)(b * SEQ + tok) * DM + g * 16);
        const uint4 v0 = src[0], v1 = src[1];
        char* d = sU + (tok >> 6) * SU_CH + (tok & 63) * 32;
        *(uint4*)d = v0; *(uint4*)(d + 16) = v1;
    }
    {
        const uint4* src = (const uint4*)(KT + (size_t)g * KT_BYTES);
        for (int it = tid; it < KT_BYTES / 16; it += NTHR) ((uint4*)sKT)[it] = src[it];
    }
    __syncthreads();
    {
        const int nt = w & 3, kh = w >> 2;
        f32x16 acc;
#pragma unroll
        for (int i = 0; i < 16; ++i) acc[i] = 0.f;
        const bf16x8* wp = WST + (size_t)g * WST_FRAGS + (size_t)(nt * 64 + kh * 32) * 64 + lane;
        const char* up = sU + r * SU_CH + h * 16 + kh * 32 * 32;
#pragma unroll 4
        for (int j = 0; j < 32; ++j) {
            const bf16x8 a = wp[j * 64];
            const bf16x8 bb = *(const bf16x8*)(up + j * 32);
            acc = MFMA32(a, bb, acc);
        }
        if (kh == 1) {
#pragma unroll
            for (int i = 0; i < 16; ++i) sPart[(nt * 16 + i) * 64 + lane] = acc[i];
        }
        __syncthreads();
        if (kh == 0) {
#pragma unroll
            for (int i = 0; i < 16; ++i) sL[r * 132 + nt * 32 + crow(i, h)] = acc[i] + sPart[(nt * 16 + i) * 64 + lane];
        }
        __syncthreads();
    }
    if (tid < 64) {
        const int p = tid;
        const float ar = ABT[g * 128 + 2 * p], ai = ABT[g * 128 + 2 * p + 1];
        float sr = 0.f, si = 0.f;
        for (int c = 0; c < 32; ++c) {
            *(bf16_t*)(sSp + c * 272 + p * 2) = (bf16_t)(pack_bf2(sr, 0.f) & 0xffffu);
            *(bf16_t*)(sSp + c * 272 + (64 + p) * 2) = (bf16_t)(pack_bf2(si, 0.f) & 0xffffu);
            const float lr = sL[c * 132 + p], li = sL[c * 132 + 64 + p];
            const float nr = ar * sr - ai * si + lr, ni = ar * si + ai * sr + li;
            sr = nr; si = ni;
        }
    }
    f32x16 acc4[4];
#pragma unroll
    for (int q = 0; q < 4; ++q)
#pragma unroll
        for (int i = 0; i < 16; ++i) acc4[q][i] = 0.f;
    const int mts0 = w, mts1 = 15 - w, mts2 = 16 + w, mts3 = 31 - w;
    {
        const char* up = sU + r * SU_CH + h * 16;
        const char* kp = sKT + (r & 15) * 32 + h * 16 + ((r >> 4) + 1) * KT_BLK;
        for (int j = 0; j < 64; ++j) {
            const bf16x8 bb = *(const bf16x8*)(up + j * 32);
#define TOEP_STEP(q, mt) if (2 * (mt) + 1 >= j) { const bf16x8 a = *(const bf16x8*)(kp + (2 * (mt) - j) * KT_BLK); acc4[q] = MFMA32(a, bb, acc4[q]); }
            TOEP_STEP(0, mts0) TOEP_STEP(1, mts1) TOEP_STEP(2, mts2) TOEP_STEP(3, mts3)
#undef TOEP_STEP
        }
    }
    __syncthreads();
    {
        const bf16x8* cp = CCAR + (size_t)g * CCAR_FRAGS + lane;
        const char* sp = sSp + r * 272 + h * 16;
#pragma unroll
        for (int ks = 0; ks < 8; ++ks) {
            const bf16x8 bb = *(const bf16x8*)(sp + ks * 32);
            acc4[0] = MFMA32(cp[(mts0 * 8 + ks) * 64], bb, acc4[0]);
            acc4[1] = MFMA32(cp[(mts1 * 8 + ks) * 64], bb, acc4[1]);
            acc4[2] = MFMA32(cp[(mts2 * 8 + ks) * 64], bb, acc4[2]);
            acc4[3] = MFMA32(cp[(mts3 * 8 + ks) * 64], bb, acc4[3]);
        }
    }
    {
        bf16_t* ybase = YPRE + (size_t)(b * SEQ + r * 64) * 512 + g * 16;
#define PB_STORE(q, mt) _Pragma("unroll") for (int rq = 0; rq < 4; ++rq) { const int c0 = 8 * rq + 4 * h; const int i = 2 * (mt) + (c0 >> 4); \
            uint2 o; o.x = pack_bf2(acc4[q][4 * rq], acc4[q][4 * rq + 1]); o.y = pack_bf2(acc4[q][4 * rq + 2], acc4[q][4 * rq + 3]); \
            *(uint2*)(ybase + (size_t)i * 512 + (c0 & 15)) = o; }
        PB_STORE(0, mts0) PB_STORE(1, mts1) PB_STORE(2, mts2) PB_STORE(3, mts3)
#undef PB_STORE
    }
    __syncthreads();
}

struct ALoadGelu {
    const bf16_t* base; bf16_t* gout; u32x4 v0, v1; int cc; int dofs;
    DI void init(const bf16_t* rowbase, bf16_t* growbase, int tid) { base = rowbase + (tid & 7) * 16; gout = growbase + (tid & 7) * 16; dofs = (tid >> 3) * SA_STRIDE + (tid & 7) * 32; }
    DI void issue(int c) { const u32x4* p = (const u32x4*)(base + c * 128); v0 = p[0]; v1 = p[1]; cc = c; }
    DI unsigned g2(unsigned u) { return pack_bf2(gelu_exact(bf_lo(u)), gelu_exact(bf_hi(u))); }
    DI void commit(char* buf) {
        u32x4 o0, o1;
        o0.x = g2(v0.x); o0.y = g2(v0.y); o0.z = g2(v0.z); o0.w = g2(v0.w);
        o1.x = g2(v1.x); o1.y = g2(v1.y); o1.z = g2(v1.z); o1.w = g2(v1.w);
        char* d = buf + dofs;
        *(u32x4*)d = o0; *(u32x4*)(d + 16) = o1;
        u32x4* gp = (u32x4*)(gout + cc * 128); gp[0] = o0; gp[1] = o1;
    }
};

DI void tok_reduce(float p0, float p1, float* sred, float& t0, float& t1, int tid) {
    const int w = tid >> 6, lane = tid & 63, r = lane & 31, h = lane >> 5;
    __syncthreads();
    sred[(w * 2 + h) * 64 + r] = p0; sred[(w * 2 + h) * 64 + 32 + r] = p1;
    __syncthreads();
    float a = 0.f, b = 0.f;
#pragma unroll
    for (int k = 0; k < 16; ++k) { a += sred[k * 64 + r]; b += sred[k * 64 + 32 + r]; }
    t0 = a; t1 = b;
}

#define PC_SRED (4 * SA_BYTES)
#define PC_BYTES (PC_SRED + 4096 + 256)

struct PCArgs {
    const bf16_t* U; const bf16_t* YPRE; bf16_t* G1; bf16_t* A2; const float* Xin; float* Xout; bf16_t* Hb; float* RSTD;
    const bf16x8* wfglu; const float* b_glu; const bf16x8* wfpool; const float* pool_scale; const bf16x8* wfout;
};

DI void phaseC1_tile(const PCArgs& a, int tile, char* smem) {
    char* sA = smem; float* sred = (float*)(smem + PC_SRED);
    {
        int tok0 = tile * 64; asm volatile("" : "+s"(tok0));
        int tid = threadIdx.x; asm volatile("" : "+v"(tid));
        const int w = __builtin_amdgcn_readfirstlane(tid >> 6), lane = tid & 63, r = lane & 31, h = lane >> 5;
        ALoadGelu al; al.init(a.YPRE + (size_t)(tok0 + (tid >> 3)) * 512, a.G1 + (size_t)(tok0 + (tid >> 3)) * 512, tid);
        f32x16 acc[2][2]; zero_acc<2>(acc);
        gemm64<2, 4>(acc, al, 4, a.wfglu + (size_t)w * (32 * 2 * 64) + lane, sA, lane);
        float ss0 = 0.f, ss1 = 0.f;
#pragma unroll
        for (int mt = 0; mt < 2; ++mt) {
            const bf16_t* yrow = a.G1 + (size_t)(tok0 + mt * 32 + r) * 512 + w * 64;
#pragma unroll
            for (int nt = 0; nt < 2; ++nt)
#pragma unroll
                for (int q = 0; q < 4; ++q) {
                    asm volatile("" ::: "memory");
                    const int n = nt * 32 + 8 * q + 4 * h;
                    const uint2 yp = *(const uint2*)(yrow + n);
                    const float4 bg = *(const float4*)(a.b_glu + w * 64 + n);
                    const float y0 = bf_lo(yp.x), y1 = bf_hi(yp.x), y2 = bf_lo(yp.y), y3 = bf_hi(yp.y);
                    const float o0 = y0 / (1.f + __expf(-(acc[nt][mt][4 * q] + bg.x)));
                    const float o1 = y1 / (1.f + __expf(-(acc[nt][mt][4 * q + 1] + bg.y)));
                    const float o2 = y2 / (1.f + __expf(-(acc[nt][mt][4 * q + 2] + bg.z)));
                    const float o3 = y3 / (1.f + __expf(-(acc[nt][mt][4 * q + 3] + bg.w)));
                    acc[nt][mt][4 * q] = o0; acc[nt][mt][4 * q + 1] = o1; acc[nt][mt][4 * q + 2] = o2; acc[nt][mt][4 * q + 3] = o3;
                    const float s = o0 * o0 + o1 * o1 + o2 * o2 + o3 * o3;
                    if (mt == 0) ss0 += s; else ss1 += s;
                }
        }
        float t0, t1; tok_reduce(ss0, ss1, sred, t0, t1, tid);
        const float rs0 = rsqrtf(t0 * (1.f / 512.f) + 1e-6f), rs1 = rsqrtf(t1 * (1.f / 512.f) + 1e-6f);
#pragma unroll
        for (int mt = 0; mt < 2; ++mt) {
            const float rs = mt ? rs1 : rs0;
            bf16_t* orow = a.A2 + (size_t)(tok0 + mt * 32 + r) * DM + w * 64;
#pragma unroll
            for (int nt = 0; nt < 2; ++nt)
#pragma unroll
                for (int q = 0; q < 4; ++q) {
                    uint2 o; o.x = pack_bf2(acc[nt][mt][4 * q] * rs, acc[nt][mt][4 * q + 1] * rs);
                    o.y = pack_bf2(acc[nt][mt][4 * q + 2] * rs, acc[nt][mt][4 * q + 3] * rs);
                    *(uint2*)(orow + nt * 32 + 8 * q + 4 * h) = o;
                }
        }
    }
    {
        int tok0 = tile * 64; asm volatile("" : "+s"(tok0));
        int tid = threadIdx.x; asm volatile("" : "+v"(tid));
        const int w = __builtin_amdgcn_readfirstlane(tid >> 6), lane = tid & 63, r = lane & 31, h = lane >> 5;
        const int row = tid >> 3, seg = tid & 7;
        const int tok = tok0 + row, t = tok & (SEQ - 1);
#pragma unroll
        for (int gi = 0; gi < 4; ++gi) {
            const int win = 2 << gi;
            const int cnt = (t + 1 < win) ? (t + 1) : win;
            const bf16_t* up = a.U + (size_t)tok * DM + 512 + gi * 128 + seg * 16;
            float s[16];
            const uint4 c0 = *(const uint4*)up, c1 = *(const uint4*)(up + 8);
            const unsigned cu[8] = {c0.x, c0.y, c0.z, c0.w, c1.x, c1.y, c1.z, c1.w};
#pragma unroll
            for (int i = 0; i < 8; ++i) { s[2 * i] = bf_lo(cu[i]); s[2 * i + 1] = bf_hi(cu[i]); }
            for (int k = 1; k < cnt; ++k) {
                const uint4 d0 = *(const uint4*)(up - (size_t)k * DM), d1 = *(const uint4*)(up - (size_t)k * DM + 8);
                const unsigned du[8] = {d0.x, d0.y, d0.z, d0.w, d1.x, d1.y, d1.z, d1.w};
#pragma unroll
                for (int i = 0; i < 8; ++i) { s[2 * i] += bf_lo(du[i]); s[2 * i + 1] += bf_hi(du[i]); }
            }
            const float inv = 1.f / (float)cnt;
            unsigned o[8];
#pragma unroll
            for (int i = 0; i < 8; ++i) o[i] = pack_bf2(s[2 * i] * inv - bf_lo(cu[i]), s[2 * i + 1] * inv - bf_hi(cu[i]));
            char* d = sA + gi * SA_BYTES + row * SA_STRIDE + seg * 32;
            *(uint4*)d = make_uint4(o[0], o[1], o[2], o[3]); *(uint4*)(d + 16) = make_uint4(o[4], o[5], o[6], o[7]);
        }
        __syncthreads();
        const int gi = w >> 1;
        f32x16 acc[2][2]; zero_acc<2>(acc);
        const bf16x8* wp = a.wfpool + (size_t)gi * (128 * 128 / 8) + (size_t)(w & 1) * (8 * 2 * 64) + lane;
        const char* buf = sA + gi * SA_BYTES + r * SA_STRIDE + h * 16;
#pragma unroll
        for (int ks = 0; ks < 8; ++ks) {
            const bf16x8 a0 = *(const bf16x8*)(buf + ks * 32);
            const bf16x8 a1 = *(const bf16x8*)(buf + 32 * SA_STRIDE + ks * 32);
#pragma unroll
            for (int nt = 0; nt < 2; ++nt) {
                const bf16x8 wv = wp[(ks * 2 + nt) * 64];
                acc[nt][0] = MFMA32(wv, a0, acc[nt][0]);
                acc[nt][1] = MFMA32(wv, a1, acc[nt][1]);
            }
        }
        float ss0 = 0.f, ss1 = 0.f;
#pragma unroll
        for (int mt = 0; mt < 2; ++mt)
#pragma unroll
            for (int nt = 0; nt < 2; ++nt)
#pragma unroll
                for (int q = 0; q < 4; ++q) {
                    asm volatile("" ::: "memory");
                    const int n = w * 64 + nt * 32 + 8 * q + 4 * h;
                    const float4 sc = *(const float4*)(a.pool_scale + n);
                    const float o0 = acc[nt][mt][4 * q] * sc.x, o1 = acc[nt][mt][4 * q + 1] * sc.y, o2 = acc[nt][mt][4 * q + 2] * sc.z, o3 = acc[nt][mt][4 * q + 3] * sc.w;
                    acc[nt][mt][4 * q] = o0; acc[nt][mt][4 * q + 1] = o1; acc[nt][mt][4 * q + 2] = o2; acc[nt][mt][4 * q + 3] = o3;
                    const float s = o0 * o0 + o1 * o1 + o2 * o2 + o3 * o3;
                    if (mt == 0) ss0 += s; else ss1 += s;
                }
        float t0, t1; tok_reduce(ss0, ss1, sred, t0, t1, tid);
        const float rs0 = rsqrtf(t0 * (1.f / 512.f) + 1e-6f), rs1 = rsqrtf(t1 * (1.f / 512.f) + 1e-6f);
#pragma unroll
        for (int mt = 0; mt < 2; ++mt) {
            const float rs = mt ? rs1 : rs0;
            bf16_t* orow = a.A2 + (size_t)(tok0 + mt * 32 + r) * DM + 512 + w * 64;
#pragma unroll
            for (int nt = 0; nt < 2; ++nt)
#pragma unroll
                for (int q = 0; q < 4; ++q) {
                    uint2 o; o.x = pack_bf2(acc[nt][mt][4 * q] * rs, acc[nt][mt][4 * q + 1] * rs);
                    o.y = pack_bf2(acc[nt][mt][4 * q + 2] * rs, acc[nt][mt][4 * q + 3] * rs);
                    *(uint2*)(orow + nt * 32 + 8 * q + 4 * h) = o;
                }
        }
        __syncthreads();
    }
    {
        int tok0 = tile * 64; asm volatile("" : "+s"(tok0));
        int tid = threadIdx.x; asm volatile("" : "+v"(tid));
        const int w = __builtin_amdgcn_readfirstlane(tid >> 6), lane = tid & 63, r = lane & 31, h = lane >> 5;
        ALoadBF16 al; al.init(a.A2 + (size_t)(tok0 + (tid >> 3)) * DM, tid);
        f32x16 acc[4][2]; zero_acc<4>(acc);
        gemm64<4, 2>(acc, al, 8, a.wfout + (size_t)w * (64 * 4 * 64) + lane, sA, lane);
        float ss0 = 0.f, ss1 = 0.f;
#pragma unroll
        for (int mt = 0; mt < 2; ++mt) {
            const size_t ro = (size_t)(tok0 + mt * 32 + r) * DM + w * 128;
#pragma unroll
            for (int nt = 0; nt < 4; ++nt)
#pragma unroll
                for (int q = 0; q < 4; ++q) {
                    asm volatile("" ::: "memory");
                    const int n = nt * 32 + 8 * q + 4 * h;
                    const float4 xi = *(const float4*)(a.Xin + ro + n);
                    float4 xo; xo.x = xi.x + acc[nt][mt][4 * q]; xo.y = xi.y + acc[nt][mt][4 * q + 1]; xo.z = xi.z + acc[nt][mt][4 * q + 2]; xo.w = xi.w + acc[nt][mt][4 * q + 3];
                    *(float4*)(a.Xout + ro + n) = xo;
                    uint2 o; o.x = pack_bf2(xo.x, xo.y); o.y = pack_bf2(xo.z, xo.w);
                    *(uint2*)(a.Hb + ro + n) = o;
                    const float s = xo.x * xo.x + xo.y * xo.y + xo.z * xo.z + xo.w * xo.w;
                    if (mt == 0) ss0 += s; else ss1 += s;
                }
        }
        float t0, t1; tok_reduce(ss0, ss1, sred, t0, t1, tid);
        if (w == 0) { a.RSTD[tok0 + r + 32 * h] = rsqrtf((h ? t1 : t0) * (1.f / 1024.f) + 1e-6f); }
        __syncthreads();
    }
}

DI unsigned f2ord(float f) { const unsigned u = __float_as_uint(f); return u ^ ((u >> 31) ? 0xFFFFFFFFu : 0x80000000u); }
DI float ord2f(unsigned o) { return __uint_as_float((o & 0x80000000u) ? (o ^ 0x80000000u) : ~o); }
DI unsigned umax_(unsigned a, unsigned b) { return a > b ? a : b; }
DI unsigned umin_(unsigned a, unsigned b) { return a < b ? a : b; }

struct PRArgs {
    const bf16_t* Hb; const float* RSTD; bf16_t* Qb; const bf16x8* wfq; const bf16x8* wfk1; const bf16x8* wfk2; int* EX; float* GT;
};

DI void topk_insert16(unsigned (&L)[16], const f32x16& s, int nbase, int h) {
#pragma unroll
    for (int i = 0; i < 16; ++i) {
        unsigned x = (f2ord(s[i]) & 0xFFFFFF80u) | (unsigned)(127 - (nbase + crow(i, h)));
#pragma unroll
        for (int k = 0; k < 16; ++k) { const unsigned hi = umax_(L[k], x); x = umin_(L[k], x); L[k] = hi; }
    }
}

DI void phaseC2_tile(const PRArgs& a, int tile, char* smem) {
    char* sA = smem;
#pragma unroll 1
    for (int ps = 0; ps < 2; ++ps) {
        int tok0 = tile * 64; asm volatile("" : "+s"(tok0));
        int tid = threadIdx.x; asm volatile("" : "+v"(tid));
        const int w = __builtin_amdgcn_readfirstlane(tid >> 6), lane = tid & 63, r = lane & 31, h = lane >> 5;
        ALoadBF16 al; al.init(a.Hb + (size_t)(tok0 + (tid >> 3)) * DM, tid);
        f32x16 acc[4][2]; zero_acc<4>(acc);
        const int ng = ps * 8 + w;
        gemm64<4, 2>(acc, al, 8, a.wfq + (size_t)ng * (64 * 4 * 64) + lane, sA, lane);
#pragma unroll
        for (int mt = 0; mt < 2; ++mt) {
            const float rs = a.RSTD[tok0 + mt * 32 + r];
            bf16_t* orow = a.Qb + (size_t)(tok0 + mt * 32 + r) * 2048 + ng * 128;
#pragma unroll
            for (int nt = 0; nt < 4; ++nt)
#pragma unroll
                for (int q = 0; q < 4; ++q) {
                    uint2 o; o.x = pack_bf2(acc[nt][mt][4 * q] * rs, acc[nt][mt][4 * q + 1] * rs);
                    o.y = pack_bf2(acc[nt][mt][4 * q + 2] * rs, acc[nt][mt][4 * q + 3] * rs);
                    *(uint2*)(orow + nt * 32 + 8 * q + 4 * h) = o;
                }
        }
    }
    __syncthreads();
    {
        int tok0 = tile * 64; asm volatile("" : "+s"(tok0));
        int tid = threadIdx.x; asm volatile("" : "+v"(tid));
        const int w = __builtin_amdgcn_readfirstlane(tid >> 6), lane = tid & 63, r = lane & 31, h = lane >> 5;
        unsigned T0[16], T1[16];
#pragma unroll 1
        for (int half = 0; half < 2; ++half) {
            gwp_t wk = (gwp_t)(half ? a.wfk2 : a.wfk1) + lane;
#pragma unroll 1
            for (int mt = 0; mt < 2; ++mt) {
                f32x16 sc[4];
#pragma unroll
                for (int nt = 0; nt < 4; ++nt)
#pragma unroll
                    for (int i = 0; i < 16; ++i) sc[nt][i] = 0.f;
                const bf16_t* qrow = a.Qb + (size_t)(tok0 + mt * 32 + r) * 2048 + w * 256 + half * 128 + 8 * h;
#pragma unroll
                for (int ks = 0; ks < 8; ++ks) {
                    const bf16x8 qv = *(const bf16x8*)(qrow + ks * 16);
#pragma unroll
                    for (int nt = 0; nt < 4; ++nt) sc[nt] = MFMA32(wk[(ks * 4 + nt) * 64], qv, sc[nt]);
                }
                unsigned L[16];
#pragma unroll
                for (int k = 0; k < 16; ++k) L[k] = 0u;
#pragma unroll
                for (int nt = 0; nt < 4; ++nt) topk_insert16(L, sc[nt], nt * 32, h);
                unsigned P[16];
#pragma unroll
                for (int k = 0; k < 16; ++k) P[k] = (unsigned)shx_i<32>((int)L[k], lane);
#pragma unroll
                for (int k = 0; k < 16; ++k) L[k] = umax_(L[k], P[15 - k]);
#pragma unroll
                for (int d = 8; d > 0; d >>= 1)
#pragma unroll
                    for (int k = 0; k < 16; ++k)
                        if ((k & d) == 0) { const unsigned hi = umax_(L[k], L[k + d]), lo = umin_(L[k], L[k + d]); L[k] = hi; L[k + d] = lo; }
                if (h == mt) {
                    if (half == 0) {
#pragma unroll
                        for (int k = 0; k < 16; ++k) T0[k] = L[k];
                    } else {
#pragma unroll
                        for (int k = 0; k < 16; ++k) T1[k] = L[k];
                    }
                }
            }
        }
        float v1[16], v2[16];
#pragma unroll
        for (int k = 0; k < 16; ++k) { v1[k] = ord2f(T0[k] & 0xFFFFFF80u); v2[k] = ord2f(T1[k] & 0xFFFFFF80u); }
        unsigned C[16];
#pragma unroll
        for (int b = 0; b < 16; ++b) C[b] = (f2ord(v1[0] + v2[b]) & 0xFFFFFF00u) | (unsigned)(255 - b);
#pragma unroll
        for (int aa = 1; aa < 16; ++aa)
#pragma unroll
            for (int b = 0; b < 16; ++b)
                if ((aa + 1) * (b + 1) <= 16) {
                    unsigned x = (f2ord(v1[aa] + v2[b]) & 0xFFFFFF00u) | (unsigned)(255 - (aa * 16 + b));
#pragma unroll
                    for (int k = (aa + 1) * (b + 1) - 1; k < 16; ++k) { const unsigned hi = umax_(C[k], x); x = umin_(C[k], x); C[k] = hi; }
                }
        unsigned* sI = (unsigned*)(smem) + (w * 64 + lane) * 9;
#pragma unroll
        for (int q = 0; q < 4; ++q) {
            unsigned p1 = 0u, p2 = 0u;
#pragma unroll
            for (int j = 0; j < 4; ++j) { p1 |= (127u - (T0[4 * q + j] & 0x7Fu)) << (8 * j); p2 |= (127u - (T1[4 * q + j] & 0x7Fu)) << (8 * j); }
            sI[q] = p1; sI[4 + q] = p2;
        }
        const unsigned char* sB = (const unsigned char*)sI;
        const float mx = ord2f(C[0] & 0xFFFFFF00u);
        float e[16]; float sum = 0.f; int ex[16];
#pragma unroll
        for (int k = 0; k < 16; ++k) {
            e[k] = __expf(ord2f(C[k] & 0xFFFFFF00u) - mx); sum += e[k];
            const unsigned ci = 255u - (C[k] & 0xFFu);
            ex[k] = (int)sB[ci >> 4] * 128 + (int)sB[16 + (ci & 15u)];
        }
        const float inv = 1.f / sum;
        const size_t ob = ((size_t)(tok0 + h * 32 + r) * 8 + w) * 16;
#pragma unroll
        for (int q = 0; q < 4; ++q) {
            *(int4*)(a.EX + ob + 4 * q) = make_int4(ex[4 * q], ex[4 * q + 1], ex[4 * q + 2], ex[4 * q + 3]);
            *(float4*)(a.GT + ob + 4 * q) = make_float4(e[4 * q] * inv, e[4 * q + 1] * inv, e[4 * q + 2] * inv, e[4 * q + 3] * inv);
        }
    }
    __syncthreads();
}

typedef const __attribute__((address_space(1))) u32x4* grow_t;
typedef unsigned char fp8_t;

struct PGArgs {
    const bf16_t* Hb; const float* RSTD; const int* EX; const float* GT; const fp8_t* U8; const fp8_t* V8; const float* SU; const float* SV;
    const float* Xin; float* Xout; const float* gfinal; int final_norm;
};

DI void conv_rows_fp8(const float* __restrict__ src, const float* __restrict__ gain, fp8_t* __restrict__ dst, float* __restrict__ scales,
                      int nrows, int gwave, int nwaves, int lane) {
    for (int row = gwave; row < nrows; row += nwaves) {
        const float4* p = (const float4*)(src + (size_t)row * DM + lane * 16);
        float4 v0 = p[0], v1 = p[1], v2 = p[2], v3 = p[3];
        if (gain) {
            const float4* g = (const float4*)(gain + lane * 16);
            const float4 g0 = g[0], g1 = g[1], g2 = g[2], g3 = g[3];
            v0.x *= g0.x; v0.y *= g0.y; v0.z *= g0.z; v0.w *= g0.w; v1.x *= g1.x; v1.y *= g1.y; v1.z *= g1.z; v1.w *= g1.w;
            v2.x *= g2.x; v2.y *= g2.y; v2.z *= g2.z; v2.w *= g2.w; v3.x *= g3.x; v3.y *= g3.y; v3.z *= g3.z; v3.w *= g3.w;
        }
        float m = fmaxf(fmaxf(fmaxf(fabsf(v0.x), fabsf(v0.y)), fmaxf(fabsf(v0.z), fabsf(v0.w))), fmaxf(fmaxf(fabsf(v1.x), fabsf(v1.y)), fmaxf(fabsf(v1.z), fabsf(v1.w))));
        m = fmaxf(m, fmaxf(fmaxf(fmaxf(fabsf(v2.x), fabsf(v2.y)), fmaxf(fabsf(v2.z), fabsf(v2.w))), fmaxf(fmaxf(fabsf(v3.x), fabsf(v3.y)), fmaxf(fabsf(v3.z), fabsf(v3.w)))));
#pragma unroll
        for (int o = 0; o < 1; ++o) { m = fmaxf(m, shx<1>(m, lane)); m = fmaxf(m, shx<2>(m, lane)); m = fmaxf(m, shx<4>(m, lane)); m = fmaxf(m, shx<8>(m, lane)); m = fmaxf(m, shx<16>(m, lane)); m = fmaxf(m, shx<32>(m, lane)); }
        const float sc = (m > 0.f) ? m * (1.f / 448.f) : 1.f;
        const float inv = 1.f / sc;
        u32x4 o;
        unsigned t;
        t = 0u; t = __builtin_amdgcn_cvt_pk_fp8_f32(v0.x * inv, v0.y * inv, t, false); t = __builtin_amdgcn_cvt_pk_fp8_f32(v0.z * inv, v0.w * inv, t, true); o.x = t;
        t = 0u; t = __builtin_amdgcn_cvt_pk_fp8_f32(v1.x * inv, v1.y * inv, t, false); t = __builtin_amdgcn_cvt_pk_fp8_f32(v1.z * inv, v1.w * inv, t, true); o.y = t;
        t = 0u; t = __builtin_amdgcn_cvt_pk_fp8_f32(v2.x * inv, v2.y * inv, t, false); t = __builtin_amdgcn_cvt_pk_fp8_f32(v2.z * inv, v2.w * inv, t, true); o.z = t;
        t = 0u; t = __builtin_amdgcn_cvt_pk_fp8_f32(v3.x * inv, v3.y * inv, t, false); t = __builtin_amdgcn_cvt_pk_fp8_f32(v3.z * inv, v3.w * inv, t, true); o.w = t;
        *(u32x4*)(dst + (size_t)row * DM + lane * 16) = o;
        if (lane == 0) scales[row] = sc;
    }
}

struct RowOct { u32x4 r0, r1, r2, r3, r4, r5, r6, r7; };
DI void oct_load(RowOct& q, const fp8_t* tab, int e0, int e1, int e2, int e3, int e4, int e5, int e6, int e7, int lane) {
    q.r0 = ((grow_t)(tab + (size_t)e0 * DM))[lane]; q.r1 = ((grow_t)(tab + (size_t)e1 * DM))[lane];
    q.r2 = ((grow_t)(tab + (size_t)e2 * DM))[lane]; q.r3 = ((grow_t)(tab + (size_t)e3 * DM))[lane];
    q.r4 = ((grow_t)(tab + (size_t)e4 * DM))[lane]; q.r5 = ((grow_t)(tab + (size_t)e5 * DM))[lane];
    q.r6 = ((grow_t)(tab + (size_t)e6 * DM))[lane]; q.r7 = ((grow_t)(tab + (size_t)e7 * DM))[lane];
}
DI float dot4w(unsigned w, float h0, float h1, float h2, float h3, float s) {
    const f2_t lo = __builtin_amdgcn_cvt_pk_f32_fp8(w, false), hi = __builtin_amdgcn_cvt_pk_f32_fp8(w, true);
    s = fmaf(lo.x, h0, s); s = fmaf(lo.y, h1, s); s = fmaf(hi.x, h2, s); s = fmaf(hi.y, h3, s);
    return s;
}
DI float row_dot8(const u32x4& r, const float (&h)[16]) {
    float s = 0.f;
    s = dot4w(r.x, h[0], h[1], h[2], h[3], s); s = dot4w(r.y, h[4], h[5], h[6], h[7], s);
    s = dot4w(r.z, h[8], h[9], h[10], h[11], s); s = dot4w(r.w, h[12], h[13], h[14], h[15], s);
    return s;
}
DI void axpy4w(unsigned w, float c, float& a0, float& a1, float& a2, float& a3) {
    const f2_t lo = __builtin_amdgcn_cvt_pk_f32_fp8(w, false), hi = __builtin_amdgcn_cvt_pk_f32_fp8(w, true);
    a0 = fmaf(c, lo.x, a0); a1 = fmaf(c, lo.y, a1); a2 = fmaf(c, hi.x, a2); a3 = fmaf(c, hi.y, a3);
}
DI void row_axpy8(float (&acc)[16], const u32x4& r, float c) {
    axpy4w(r.x, c, acc[0], acc[1], acc[2], acc[3]); axpy4w(r.y, c, acc[4], acc[5], acc[6], acc[7]);
    axpy4w(r.z, c, acc[8], acc[9], acc[10], acc[11]); axpy4w(r.w, c, acc[12], acc[13], acc[14], acc[15]);
}
#define RL(v, l) __builtin_amdgcn_readlane((v), (l))
#define RLF(v, l) __uint_as_float((unsigned)__builtin_amdgcn_readlane((int)__float_as_uint(v), (l)))

DI float reduce16(float (&p)[16], int lane) {
    const bool b5 = lane & 32, b4 = lane & 16, b3 = lane & 8, b2 = lane & 4;
    float q8[8], q4[4], q2[2];
#pragma unroll
    for (int k = 0; k < 8; ++k) { const float keep = b5 ? p[k + 8] : p[k], send = b5 ? p[k] : p[k + 8]; q8[k] = keep + shx<32>(send, lane); }
#pragma unroll
    for (int k = 0; k < 4; ++k) { const float keep = b4 ? q8[k + 4] : q8[k], send = b4 ? q8[k] : q8[k + 4]; q4[k] = keep + shx<16>(send, lane); }
#pragma unroll
    for (int k = 0; k < 2; ++k) { const float keep = b3 ? q4[k + 2] : q4[k], send = b3 ? q4[k] : q4[k + 2]; q2[k] = keep + shx<8>(send, lane); }
    float t;
    { const float keep = b2 ? q2[1] : q2[0], send = b2 ? q2[0] : q2[1]; t = keep + shx<4>(send, lane); }
    t += shx<1>(t, lane); t += shx<2>(t, lane);
    return t;
}

DI void phaseC3_tile(const PGArgs& a, int tile) {
    int tid = threadIdx.x; asm volatile("" : "+v"(tid));
    const int w = __builtin_amdgcn_readfirstlane(tid >> 6), lane = tid & 63;
    const int el = (lane >> 2) & 15;
#pragma unroll 1
    for (int ti = 0; ti < 8; ++ti) {
        const int tok = tile * 64 + w * 8 + ti;
        float h[16];
        {
            const u32x4* hp = (const u32x4*)(a.Hb + (size_t)tok * DM + lane * 16);
            const u32x4 h0 = hp[0], h1 = hp[1];
            h[0] = bf_lo(h0.x); h[1] = bf_hi(h0.x); h[2] = bf_lo(h0.y); h[3] = bf_hi(h0.y); h[4] = bf_lo(h0.z); h[5] = bf_hi(h0.z); h[6] = bf_lo(h0.w); h[7] = bf_hi(h0.w);
            h[8] = bf_lo(h1.x); h[9] = bf_hi(h1.x); h[10] = bf_lo(h1.y); h[11] = bf_hi(h1.y); h[12] = bf_lo(h1.z); h[13] = bf_hi(h1.z); h[14] = bf_lo(h1.w); h[15] = bf_hi(h1.w);
        }
        const float rs = a.RSTD[tok];
        float acc[16];
#pragma unroll
        for (int i = 0; i < 16; ++i) acc[i] = 0.f;
#pragma unroll 1
        for (int hd = 0; hd < 8; ++hd) {
            const size_t eb = ((size_t)tok * 8 + hd) * 16;
            const int exv = a.EX[eb + (lane & 15)];
            const int exl = a.EX[eb + el];
            const float coef = a.GT[eb + el] * a.SV[exl];
            const float su = a.SU[exl] * rs;
            RowOct qa, qb;
            float p[16];
            oct_load(qa, a.U8, RL(exv, 0), RL(exv, 1), RL(exv, 2), RL(exv, 3), RL(exv, 4), RL(exv, 5), RL(exv, 6), RL(exv, 7), lane);
            oct_load(qb, a.U8, RL(exv, 8), RL(exv, 9), RL(exv, 10), RL(exv, 11), RL(exv, 12), RL(exv, 13), RL(exv, 14), RL(exv, 15), lane);
            p[0] = row_dot8(qa.r0, h); p[1] = row_dot8(qa.r1, h); p[2] = row_dot8(qa.r2, h); p[3] = row_dot8(qa.r3, h);
            p[4] = row_dot8(qa.r4, h); p[5] = row_dot8(qa.r5, h); p[6] = row_dot8(qa.r6, h); p[7] = row_dot8(qa.r7, h);
            oct_load(qa, a.V8, RL(exv, 0), RL(exv, 1), RL(exv, 2), RL(exv, 3), RL(exv, 4), RL(exv, 5), RL(exv, 6), RL(exv, 7), lane);
            p[8] = row_dot8(qb.r0, h); p[9] = row_dot8(qb.r1, h); p[10] = row_dot8(qb.r2, h); p[11] = row_dot8(qb.r3, h);
            p[12] = row_dot8(qb.r4, h); p[13] = row_dot8(qb.r5, h); p[14] = row_dot8(qb.r6, h); p[15] = row_dot8(qb.r7, h);
            oct_load(qb, a.V8, RL(exv, 8), RL(exv, 9), RL(exv, 10), RL(exv, 11), RL(exv, 12), RL(exv, 13), RL(exv, 14), RL(exv, 15), lane);
            const float act = gelu_exact(reduce16(p, lane) * su) * coef;
            row_axpy8(acc, qa.r0, RLF(act, 0)); row_axpy8(acc, qa.r1, RLF(act, 4)); row_axpy8(acc, qa.r2, RLF(act, 8)); row_axpy8(acc, qa.r3, RLF(act, 12));
            row_axpy8(acc, qa.r4, RLF(act, 16)); row_axpy8(acc, qa.r5, RLF(act, 20)); row_axpy8(acc, qa.r6, RLF(act, 24)); row_axpy8(acc, qa.r7, RLF(act, 28));
            row_axpy8(acc, qb.r0, RLF(act, 32)); row_axpy8(acc, qb.r1, RLF(act, 36)); row_axpy8(acc, qb.r2, RLF(act, 40)); row_axpy8(acc, qb.r3, RLF(act, 44));
            row_axpy8(acc, qb.r4, RLF(act, 48)); row_axpy8(acc, qb.r5, RLF(act, 52)); row_axpy8(acc, qb.r6, RLF(act, 56)); row_axpy8(acc, qb.r7, RLF(act, 60));
        }
        const float* xi = a.Xin + (size_t)tok * DM + lane * 16;
        float* xo = a.Xout + (size_t)tok * DM + lane * 16;
        float4 x0 = *(const float4*)xi, x1 = *(const float4*)(xi + 4), x2 = *(const float4*)(xi + 8), x3 = *(const float4*)(xi + 12);
        x0.x += acc[0]; x0.y += acc[1]; x0.z += acc[2]; x0.w += acc[3]; x1.x += acc[4]; x1.y += acc[5]; x1.z += acc[6]; x1.w += acc[7];
        x2.x += acc[8]; x2.y += acc[9]; x2.z += acc[10]; x2.w += acc[11]; x3.x += acc[12]; x3.y += acc[13]; x3.z += acc[14]; x3.w += acc[15];
        if (a.final_norm) {
            float ss = x0.x * x0.x + x0.y * x0.y + x0.z * x0.z + x0.w * x0.w + x1.x * x1.x + x1.y * x1.y + x1.z * x1.z + x1.w * x1.w
                     + x2.x * x2.x + x2.y * x2.y + x2.z * x2.z + x2.w * x2.w + x3.x * x3.x + x3.y * x3.y + x3.z * x3.z + x3.w * x3.w;
            ss = wave_sum(ss, lane);
            const float rf = rsqrtf(ss * (1.f / 1024.f) + 1e-6f);
            const float* gf = a.gfinal + lane * 16;
            const float4 g0 = *(const float4*)gf, g1 = *(const float4*)(gf + 4), g2 = *(const float4*)(gf + 8), g3 = *(const float4*)(gf + 12);
            x0.x *= rf * g0.x; x0.y *= rf * g0.y; x0.z *= rf * g0.z; x0.w *= rf * g0.w; x1.x *= rf * g1.x; x1.y *= rf * g1.y; x1.z *= rf * g1.z; x1.w *= rf * g1.w;
            x2.x *= rf * g2.x; x2.y *= rf * g2.y; x2.z *= rf * g2.z; x2.w *= rf * g2.w; x3.x *= rf * g3.x; x3.y *= rf * g3.y; x3.z *= rf * g3.z; x3.w *= rf * g3.w;
        }
        *(float4*)xo = x0; *(float4*)(xo + 4) = x1; *(float4*)(xo + 8) = x2; *(float4*)(xo + 12) = x3;
    }
}
struct MegaArgs {
    const float* x; const float* a_re; const float* a_im; const float* log_dt; const float* b_re; const float* b_im; const float* c_re;
    const float* c_im; const float* d_skip; const float* b_glu; const float* pool_scale; const float* u_exp; const float* v_exp;
    const float* norm_final;
    PrepW pw;
    float* X; bf16_t* U; bf16_t* YPRE; bf16_t* G1; bf16_t* A2; bf16_t* Hb; bf16_t* Qb; int* EX; float* GT; float* RSTD;
    char* KT; bf16x8* WST; bf16x8* CCAR; float* ABT; fp8_t* U8; fp8_t* V8; float* SU; float* SV;
};

#ifndef REP_P0
#define REP_P0 1
#endif
#ifndef REP_PA
#define REP_PA 1
#endif
#ifndef REP_PB
#define REP_PB 1
#endif
#ifndef REP_C1
#define REP_C1 1
#endif
#ifndef REP_C2
#define REP_C2 1
#endif
#ifndef REP_C3
#define REP_C3 1
#endif
__global__ void __launch_bounds__(NTHR) mega_kernel(MegaArgs a) {
    __shared__ __attribute__((aligned(16))) char smem[PB_BYTES];
    cg::grid_group grid = cg::this_grid();
    const int nblk = gridDim.x;
    for (int rep = 0; rep < REP_P0; ++rep) {
        const size_t gtid = (size_t)blockIdx.x * NTHR + threadIdx.x, gs = (size_t)nblk * NTHR;
        for (int lg = blockIdx.x; lg < 64; lg += nblk)
            prep_s5_item(lg, a.a_re, a.a_im, a.log_dt, a.b_re, a.b_im, a.c_re, a.c_im, a.d_skip, a.KT, a.WST, a.CCAR, a.ABT, smem);
        prep_weights(a.pw, gtid, gs);
        {
            int tid = threadIdx.x; asm volatile("" : "+v"(tid));
            const int gwave = blockIdx.x * 8 + (tid >> 6), nwaves = nblk * 8, lane = tid & 63;
#pragma unroll 1
            for (int l = 0; l < 2; ++l) {
                conv_rows_fp8(a.u_exp + (size_t)l * NEXP * DM, a.pw.norm_ffn + l * DM, a.U8 + (size_t)l * NEXP * DM, a.SU + l * NEXP, NEXP, gwave, nwaves, lane);
                conv_rows_fp8(a.v_exp + (size_t)l * NEXP * DM, nullptr, a.V8 + (size_t)l * NEXP * DM, a.SV + l * NEXP, NEXP, gwave, nwaves, lane);
            }
        }
    }
    grid.sync();
#pragma unroll 1
    for (int l = 0; l < 2; ++l) {
        const float* xin = (l == 0) ? a.x : a.X;
        if (l == 0) {
            for (int rep = 0; rep < REP_PA; ++rep)
            for (int tile = blockIdx.x; tile < NTOK / 64; tile += nblk) phaseA_tile(xin, a.pw.wfin, a.U, tile, smem);
        }
        grid.sync();
        bf16_t* Ul = a.U + (size_t)l * NTOK * DM;
        for (int rep = 0; rep < REP_PB; ++rep)
        for (int tile = blockIdx.x; tile < 256; tile += nblk)
            phaseB_tile(Ul, a.KT + (size_t)l * 32 * KT_BYTES, a.WST + (size_t)l * 32 * WST_FRAGS, a.CCAR + (size_t)l * 32 * CCAR_FRAGS, a.ABT + l * 32 * 128, a.YPRE, tile, smem);
        grid.sync();
        PCArgs pa; pa.U = Ul; pa.YPRE = a.YPRE; pa.G1 = a.G1; pa.A2 = a.A2; pa.Xin = xin; pa.Xout = a.X; pa.Hb = a.Hb; pa.RSTD = a.RSTD;
        pa.wfglu = a.pw.wfglu + (size_t)l * (512 * 512 / 8); pa.b_glu = a.b_glu + l * 512; pa.wfpool = a.pw.wfpool + (size_t)l * 4 * (128 * 128 / 8);
        pa.pool_scale = a.pool_scale + l * 512; pa.wfout = a.pw.wfout + (size_t)l * (DM * DM / 8);
        PRArgs pr; pr.Hb = a.Hb; pr.RSTD = a.RSTD; pr.Qb = a.Qb; pr.wfq = a.pw.wfq + (size_t)l * (DM * 2048 / 8); pr.wfk1 = a.pw.wfk1 + (size_t)l * (128 * 128 / 8);
        pr.wfk2 = a.pw.wfk2 + (size_t)l * (128 * 128 / 8); pr.EX = a.EX; pr.GT = a.GT;
        PGArgs pg; pg.Hb = a.Hb; pg.RSTD = a.RSTD; pg.EX = a.EX; pg.GT = a.GT; pg.U8 = a.U8 + (size_t)l * NEXP * DM; pg.V8 = a.V8 + (size_t)l * NEXP * DM; pg.SU = a.SU + l * NEXP; pg.SV = a.SV + l * NEXP;
        pg.Xin = a.X; pg.Xout = a.X; pg.gfinal = a.norm_final; pg.final_norm = (l == 1);
        for (int tile = blockIdx.x; tile < NTOK / 64; tile += nblk) {
            for (int rep = 1; rep < REP_C1; ++rep) { PCArgs pa2 = pa; pa2.Xout = (float*)a.Qb; phaseC1_tile(pa2, tile, smem); }
            phaseC1_tile(pa, tile, smem);
            for (int rep = 0; rep < REP_C2; ++rep) phaseC2_tile(pr, tile, smem);
            for (int rep = 1; rep < REP_C3; ++rep) { PGArgs pg2 = pg; pg2.Xout = (float*)a.Qb; __syncthreads(); phaseC3_tile(pg2, tile); }
            phaseC3_tile(pg, tile);
            if (l == 0) {
                __syncthreads();
                for (int rep = 0; rep < REP_PA; ++rep)
                phaseA_tile(a.X, a.pw.wfin + (size_t)(DM * DM / 8), a.U + (size_t)NTOK * DM, tile, smem);
            }
        }
    }
}

extern "C" void kernel_launch(void* const* d_in, const int* in_sizes, int n_in, void* d_out, int out_size, void* d_ws, size_t ws_size,
                              hipStream_t stream) {
    char* wsb = (char*)d_ws;
    size_t off = 0;
    auto take = [&](size_t bytes) { char* p = wsb + off; off += (bytes + 255) & ~(size_t)255; return p; };
    MegaArgs a;
    memset(&a, 0, sizeof(a));
    a.x = (const float*)d_in[0];
    a.pw.norm_mix = (const float*)d_in[1]; a.pw.w_in = (const float*)d_in[2];
    a.a_re = (const float*)d_in[3]; a.a_im = (const float*)d_in[4]; a.log_dt = (const float*)d_in[5];
    a.b_re = (const float*)d_in[6]; a.b_im = (const float*)d_in[7]; a.c_re = (const float*)d_in[8]; a.c_im = (const float*)d_in[9];
    a.d_skip = (const float*)d_in[10]; a.pw.w_glu = (const float*)d_in[11]; a.b_glu = (const float*)d_in[12];
    a.pw.w_pool = (const float*)d_in[13]; a.pool_scale = (const float*)d_in[14]; a.pw.g_out_ssm = (const float*)d_in[15];
    a.pw.g_out_pool = (const float*)d_in[16]; a.pw.w_out = (const float*)d_in[17]; a.pw.norm_ffn = (const float*)d_in[18];
    a.pw.w_q = (const float*)d_in[19]; a.pw.k1 = (const float*)d_in[20]; a.pw.k2 = (const float*)d_in[21];
    a.u_exp = (const float*)d_in[22]; a.v_exp = (const float*)d_in[23]; a.norm_final = (const float*)d_in[24];
    a.X = (float*)d_out;
    a.U = (bf16_t*)take((size_t)2 * NTOK * DM * 2);
    a.YPRE = (bf16_t*)take((size_t)NTOK * 512 * 2);
    a.G1 = (bf16_t*)take((size_t)NTOK * 512 * 2);
    a.A2 = (bf16_t*)take((size_t)NTOK * DM * 2);
    a.Hb = (bf16_t*)take((size_t)NTOK * DM * 2);
    a.Qb = (bf16_t*)take((size_t)NTOK * 2048 * 2);
    a.EX = (int*)take((size_t)NTOK * 128 * 4);
    a.GT = (float*)take((size_t)NTOK * 128 * 4);
    a.RSTD = (float*)take(NTOK * 4);
    a.pw.wfin = (bf16x8*)take((size_t)2 * DM * DM * 2);
    a.pw.wfglu = (bf16x8*)take((size_t)2 * 512 * 512 * 2);
    a.pw.wfpool = (bf16x8*)take((size_t)2 * 4 * 128 * 128 * 2);
    a.pw.wfout = (bf16x8*)take((size_t)2 * DM * DM * 2);
    a.pw.wfq = (bf16x8*)take((size_t)2 * DM * 2048 * 2);
    a.pw.wfk1 = (bf16x8*)take((size_t)2 * 128 * 128 * 2);
    a.pw.wfk2 = (bf16x8*)take((size_t)2 * 128 * 128 * 2);
    a.KT = take((size_t)64 * KT_BYTES);
    a.WST = (bf16x8*)take((size_t)64 * WST_FRAGS * 16);
    a.CCAR = (bf16x8*)take((size_t)64 * CCAR_FRAGS * 16);
    a.ABT = (float*)take(64 * 128 * 4);
    a.U8 = (fp8_t*)take((size_t)2 * NEXP * DM);
    a.V8 = (fp8_t*)take((size_t)2 * NEXP * DM);
    a.SU = (float*)take((size_t)2 * NEXP * 4);
    a.SV = (float*)take((size_t)2 * NEXP * 4);

    static int grid_blocks = 0;
    if (!grid_blocks) {
        int dev = 0, cus = 0, per_cu = 0;
        hipGetDevice(&dev);
        hipDeviceGetAttribute(&cus, hipDeviceAttributeMultiprocessorCount, dev);
        hipOccupancyMaxActiveBlocksPerMultiprocessor(&per_cu, mega_kernel, NTHR, 0);
        if (per_cu > 1) per_cu = 1;
        grid_blocks = cus * per_cu;
        if (grid_blocks > 256) grid_blocks = 256;
    }
    void* args[] = {&a};
    hipError_t e = hipLaunchCooperativeKernel((void*)mega_kernel, dim3(grid_blocks), dim3(NTHR), args, 0, stream);
    if (e != hipSuccess) fprintf(stderr, "cooperative launch failed: %s (grid %d)\n", hipGetErrorString(e), grid_blocks);
}
```

```cpp
#include <hip/hip_runtime.h>
#include <hip/hip_cooperative_groups.h>
#include <cstdio>
#include <cstring>
namespace cg = cooperative_groups;
#include <math.h>
#include <stdint.h>

#define NTOK 16384
#define SEQ 2048
#define DM 1024
#define SSMW 512
#define NEXP 16384

__device__ __forceinline__ float gelu_exact(float x) { return 0.5f * x * (1.f + erff(x * 0.70710678118654752f)); }

template <int M> __device__ __forceinline__ int shx_i(int v, int lane) {
    if constexpr (M == 1) return __builtin_amdgcn_mov_dpp(v, 0xB1, 0xF, 0xF, true);
    else if constexpr (M == 2) return __builtin_amdgcn_mov_dpp(v, 0x4E, 0xF, 0xF, true);
    else if constexpr (M < 32) return __builtin_amdgcn_ds_swizzle(v, (M << 10) | 0x1F);
    else return __builtin_amdgcn_ds_bpermute((lane ^ 32) << 2, v);
}
template <int M> __device__ __forceinline__ float shx(float v, int lane) { return __int_as_float(shx_i<M>(__float_as_int(v), lane)); }
__device__ __forceinline__ float wave_sum(float v, int lane) {
    v += shx<1>(v, lane); v += shx<2>(v, lane); v += shx<4>(v, lane); v += shx<8>(v, lane); v += shx<16>(v, lane); v += shx<32>(v, lane);
    return v;
}

__device__ __forceinline__ int get_tid(int wid) {
    int t = wid * 64 + (int)__builtin_amdgcn_mbcnt_hi(~0u, __builtin_amdgcn_mbcnt_lo(~0u, 0u));
    asm volatile("" : "+v"(t));
    return t;
}

#define DI __device__ __forceinline__
typedef __attribute__((ext_vector_type(8))) short bf16x8;
typedef __attribute__((ext_vector_type(16))) float f32x16;
typedef __attribute__((ext_vector_type(2))) __bf16 bf2_t;
typedef __attribute__((ext_vector_type(2))) float f2_t;
typedef unsigned short bf16_t;
typedef __attribute__((ext_vector_type(4))) unsigned u32x4;
typedef __attribute__((ext_vector_type(4))) float f32x4;
typedef const __attribute__((address_space(1))) bf16x8* gwp_t;
#define MFMA32(a, b, c) __builtin_amdgcn_mfma_f32_32x32x16_bf16((a), (b), (c), 0, 0, 0)

DI unsigned pack_bf2(float a, float b) { f2_t v = {a, b}; return __builtin_bit_cast(unsigned, __builtin_convertvector(v, bf2_t)); }
DI float bf_lo(unsigned u) { return __uint_as_float(u << 16); }
DI float bf_hi(unsigned u) { return __uint_as_float(u & 0xffff0000u); }
DI int crow(int reg, int h) { return (reg & 3) + 8 * (reg >> 2) + 4 * h; }

#define SA_STRIDE 272
#define SA_BYTES (64 * SA_STRIDE)
#define NTHR 512

template <bool GAIN>
DI void conv_wfrag(const float* __restrict__ src, int ldk, int ldn, const float* __restrict__ ga, const float* __restrict__ gb, int split,
                   int K, int N, int NTG, bf16x8* __restrict__ dst, size_t gtid, size_t gstride) {
    const int KS = K / 16;
    const size_t total = (size_t)(N / 32) * KS * 64;
    for (size_t item = gtid; item < total; item += gstride) {
        const int lane = (int)(item & 63); const size_t f = item >> 6;
        const int nti = (int)(f % NTG); const size_t f2 = f / NTG;
        const int ks = (int)(f2 % KS), nt = (int)(f2 / KS) * NTG + nti;
        const int r = lane & 31, h = lane >> 5;
        const int n = nt * 32 + r, k0 = ks * 16 + 8 * h;
        float v[8];
#pragma unroll
        for (int j = 0; j < 8; ++j) {
            const int k = k0 + j;
            float g = 1.f;
            if (GAIN) g = (k < split) ? ga[k] : gb[k - split];
            v[j] = src[(size_t)k * ldk + (size_t)n * ldn] * g;
        }
        uint4 o; o.x = pack_bf2(v[0], v[1]); o.y = pack_bf2(v[2], v[3]); o.z = pack_bf2(v[4], v[5]); o.w = pack_bf2(v[6], v[7]);
        *(uint4*)(dst + item) = o;
    }
}

DI void conv_rows_bf16(const float* __restrict__ src, const float* __restrict__ gain, bf16_t* __restrict__ dst, size_t nelem, size_t gtid, size_t gstride) {
    for (size_t i = gtid * 8; i < nelem; i += gstride * 8) {
        float4 a = *(const float4*)(src + i), b = *(const float4*)(src + i + 4);
        if (gain) {
            const int c = (int)(i & 1023);
            float4 g0 = *(const float4*)(gain + c), g1 = *(const float4*)(gain + c + 4);
            a.x *= g0.x; a.y *= g0.y; a.z *= g0.z; a.w *= g0.w; b.x *= g1.x; b.y *= g1.y; b.z *= g1.z; b.w *= g1.w;
        }
        uint4 o; o.x = pack_bf2(a.x, a.y); o.y = pack_bf2(a.z, a.w); o.z = pack_bf2(b.x, b.y); o.w = pack_bf2(b.z, b.w);
        *(uint4*)(dst + i) = o;
    }
}

struct ALoadF32 {
    const float* base; f32x4 v0, v1, v2, v3; float ss; int dofs;
    DI void init(const float* rowbase, int tid) { base = rowbase + (tid & 7) * 16; ss = 0.f; dofs = (tid >> 3) * SA_STRIDE + (tid & 7) * 32; }
    DI void issue(int c) { const f32x4* p = (const f32x4*)(base + c * 128); v0 = p[0]; v1 = p[1]; v2 = p[2]; v3 = p[3]; }
    DI void commit(char* buf) {
        u32x4 o0, o1;
        ss += v0.x * v0.x + v0.y * v0.y + v0.z * v0.z + v0.w * v0.w + v1.x * v1.x + v1.y * v1.y + v1.z * v1.z + v1.w * v1.w
            + v2.x * v2.x + v2.y * v2.y + v2.z * v2.z + v2.w * v2.w + v3.x * v3.x + v3.y * v3.y + v3.z * v3.z + v3.w * v3.w;
        o0.x = pack_bf2(v0.x, v0.y); o0.y = pack_bf2(v0.z, v0.w); o0.z = pack_bf2(v1.x, v1.y); o0.w = pack_bf2(v1.z, v1.w);
        o1.x = pack_bf2(v2.x, v2.y); o1.y = pack_bf2(v2.z, v2.w); o1.z = pack_bf2(v3.x, v3.y); o1.w = pack_bf2(v3.z, v3.w);
        char* d = buf + dofs;
        *(u32x4*)d = o0; *(u32x4*)(d + 16) = o1;
    }
};
struct ALoadBF16 {
    const bf16_t* base; u32x4 v0, v1; int dofs;
    DI void init(const bf16_t* rowbase, int tid) { base = rowbase + (tid & 7) * 16; dofs = (tid >> 3) * SA_STRIDE + (tid & 7) * 32; }
    DI void issue(int c) { const u32x4* p = (const u32x4*)(base + c * 128); v0 = p[0]; v1 = p[1]; }
    DI void commit(char* buf) {
        char* d = buf + dofs;
        *(u32x4*)d = v0; *(u32x4*)(d + 16) = v1;
    }
};

template <int NT, int PF, class AL>
DI void gemm64(f32x16 (&acc)[NT][2], AL& al, const int nchunks, const bf16x8* __restrict__ wf_, char* sA, const int lane) {
    gwp_t wf = (gwp_t)wf_;
    const int r = lane & 31, h = lane >> 5;
    bf16x8 bq[PF][NT];
    al.issue(0);
#pragma unroll
    for (int p = 0; p < PF; ++p)
#pragma unroll
        for (int nt = 0; nt < NT; ++nt) bq[p][nt] = wf[(p * NT + nt) * 64];
    gwp_t wpf = wf + PF * NT * 64;
    al.commit(sA);
    const int kend = nchunks * 8 - PF;
    int kg = 0;
#pragma unroll 1
    for (int c = 0; c < nchunks; ++c) {
        if (c + 1 < nchunks) al.issue(c + 1);
        __syncthreads();
        const char* buf = sA + (c & 1) * SA_BYTES + r * SA_STRIDE + h * 16;
#pragma unroll
        for (int ks = 0; ks < 8; ++ks) {
            const bf16x8 a0 = *(const bf16x8*)(buf + ks * 32);
            const bf16x8 a1 = *(const bf16x8*)(buf + 32 * SA_STRIDE + ks * 32);
#pragma unroll
            for (int nt = 0; nt < NT; ++nt) {
                acc[nt][0] = MFMA32(bq[ks % PF][nt], a0, acc[nt][0]);
                acc[nt][1] = MFMA32(bq[ks % PF][nt], a1, acc[nt][1]);
            }
            if (kg < kend) {
#pragma unroll
                for (int nt = 0; nt < NT; ++nt) bq[ks % PF][nt] = wpf[nt * 64];
            }
            wpf += NT * 64; ++kg;
            asm volatile("" : "+v"(wpf));
        }
        if (c + 1 < nchunks) al.commit(sA + ((c + 1) & 1) * SA_BYTES);
    }
    __syncthreads();
}

template <int NT>
DI void zero_acc(f32x16 (&acc)[NT][2]) {
#pragma unroll
    for (int nt = 0; nt < NT; ++nt)
#pragma unroll
        for (int mt = 0; mt < 2; ++mt)
#pragma unroll
            for (int i = 0; i < 16; ++i) acc[nt][mt][i] = 0.f;
}

DI void phaseA_tile(const float* __restrict__ X, const bf16x8* __restrict__ wfin, bf16_t* __restrict__ U, int tile, char* smem, int wid) {
    char* sA = smem; float* srstd = (float*)(smem + 2 * SA_BYTES);
    int tok0 = tile * 64; asm volatile("" : "+s"(tok0));
    int tid = get_tid(wid);
    const int w = __builtin_amdgcn_readfirstlane(tid >> 6), lane = tid & 63, r = lane & 31, h = lane >> 5;
    ALoadF32 al; al.init(X + (size_t)(tok0 + (tid >> 3)) * DM, tid);
    f32x16 acc[4][2]; zero_acc<4>(acc);
    gemm64<4, 2>(acc, al, 8, wfin + (size_t)w * (64 * 4 * 64) + lane, sA, lane);
    float ss = al.ss;
    ss += shx<1>(ss, lane); ss += shx<2>(ss, lane); ss += shx<4>(ss, lane);
    if ((tid & 7) == 0) srstd[tid >> 3] = rsqrtf(ss * (1.f / 1024.f) + 1e-6f);
    __syncthreads();
#pragma unroll
    for (int mt = 0; mt < 2; ++mt) {
        const float rs = srstd[mt * 32 + r];
        bf16_t* orow = U + (size_t)(tok0 + mt * 32 + r) * DM + w * 128;
#pragma unroll
        for (int nt = 0; nt < 4; ++nt)
#pragma unroll
            for (int q = 0; q < 4; ++q) {
                uint2 o; o.x = pack_bf2(acc[nt][mt][4 * q] * rs, acc[nt][mt][4 * q + 1] * rs);
                o.y = pack_bf2(acc[nt][mt][4 * q + 2] * rs, acc[nt][mt][4 * q + 3] * rs);
                *(uint2*)(orow + nt * 32 + 8 * q + 4 * h) = o;
            }
    }
    __syncthreads();
}

struct PrepW {
    const float* norm_mix; const float* w_in; const float* w_glu; const float* w_pool; const float* g_out_ssm; const float* g_out_pool;
    const float* w_out; const float* norm_ffn; const float* w_q; const float* k1; const float* k2;
    bf16x8* wfin; bf16x8* wfglu; bf16x8* wfpool; bf16x8* wfout; bf16x8* wfq; bf16x8* wfk1; bf16x8* wfk2;
};
DI void prep_weights(const PrepW& p, size_t gtid, size_t gs) {
#pragma unroll 1
    for (int l = 0; l < 2; ++l) {
        conv_wfrag<true>(p.w_in + (size_t)l * DM * DM, DM, 1, p.norm_mix + l * DM, p.norm_mix + l * DM, DM, DM, DM, 4, p.wfin + (size_t)l * (DM * DM / 8), gtid, gs);
        conv_wfrag<false>(p.w_glu + (size_t)l * 512 * 512, 512, 1, p.norm_mix, p.norm_mix, 512, 512, 512, 2, p.wfglu + (size_t)l * (512 * 512 / 8), gtid, gs);
#pragma unroll 1
        for (int gi = 0; gi < 4; ++gi)
            conv_wfrag<false>(p.w_pool + (size_t)(l * 4 + gi) * 128 * 128, 128, 1, p.norm_mix, p.norm_mix, 128, 128, 128, 2, p.wfpool + (size_t)(l * 4 + gi) * (128 * 128 / 8), gtid, gs);
        conv_wfrag<true>(p.w_out + (size_t)l * DM * DM, DM, 1, p.g_out_ssm + l * 512, p.g_out_pool + l * 512, 512, DM, DM, 4, p.wfout + (size_t)l * (DM * DM / 8), gtid, gs);
        conv_wfrag<true>(p.w_q + (size_t)l * DM * 2048, 2048, 1, p.norm_ffn + l * DM, p.norm_ffn + l * DM, DM, DM, 2048, 4, p.wfq + (size_t)l * (DM * 2048 / 8), gtid, gs);
        conv_wfrag<false>(p.k1 + (size_t)l * 128 * 128, 1, 128, p.norm_mix, p.norm_mix, 128, 128, 128, 4, p.wfk1 + (size_t)l * (128 * 128 / 8), gtid, gs);
        conv_wfrag<false>(p.k2 + (size_t)l * 128 * 128, 1, 128, p.norm_mix, p.norm_mix, 128, 128, 128, 4, p.wfk2 + (size_t)l * (128 * 128 / 8), gtid, gs);
    }
}
#define KT_BLK 528
#define KT_BYTES (65 * KT_BLK)
#define WST_FRAGS (4 * 64 * 64)
#define CCAR_FRAGS (32 * 8 * 64)
#define SU_CH 2064

DI void prep_s5_item(int lg, const float* __restrict__ a_re, const float* __restrict__ a_im, const float* __restrict__ log_dt,
                     const float* __restrict__ b_re, const float* __restrict__ b_im, const float* __restrict__ c_re, const float* __restrict__ c_im,
                     const float* __restrict__ d_skip, char* __restrict__ KT, bf16x8* __restrict__ WST, bf16x8* __restrict__ CCAR,
                     float* __restrict__ ABT, char* smem, int wid) {
    float* powr = (float*)smem;
    float* powi = powr + 65 * 64;
    float* bzr = powi + 65 * 64;
    float* bzi = bzr + 1024;
    float* cr = bzi + 1024;
    float* ci = cr + 1024;
    int tid = get_tid(wid);
    const float* are_p = a_re + lg * 64; const float* aim_p = a_im + lg * 64;
    const float dt = expf(log_dt[lg]);
    for (int it = tid; it < 65 * 64; it += NTHR) {
        const int tau = it >> 6, p = it & 63;
        const float lre = are_p[p], lim = aim_p[p];
        const float mag = expf((float)tau * lre * dt);
        double rev = (double)lim * (double)dt * (double)tau * 0.15915494309189535;
        rev -= floor(rev);
        const float ang = (float)rev * 6.283185307179586f;
        powr[it] = mag * cosf(ang); powi[it] = mag * sinf(ang);
    }
    for (int it = tid; it < 1024; it += NTHR) {
        cr[it] = c_re[lg * 1024 + it]; ci[it] = c_im[lg * 1024 + it];
    }
    __syncthreads();
    for (int it = tid; it < 1024; it += NTHR) {
        const int p = it >> 4;
        const float lre = are_p[p], lim = aim_p[p];
        const float ar = powr[64 + p], ai = powi[64 + p];
        const float inv = 1.f / (lre * lre + lim * lim), nre = ar - 1.f;
        const float zre = (nre * lre + ai * lim) * inv, zim = (ai * lre - nre * lim) * inv;
        const float br = b_re[lg * 1024 + it], bi = b_im[lg * 1024 + it];
        bzr[it] = zre * br - zim * bi; bzi[it] = zre * bi + zim * br;
    }
    __syncthreads();
    if (tid < 64) { ABT[lg * 128 + 2 * tid] = powr[64 * 64 + tid]; ABT[lg * 128 + 2 * tid + 1] = powi[64 * 64 + tid]; }
    char* kt = KT + (size_t)lg * KT_BYTES;
    for (int it = tid; it < KT_BLK / 4; it += NTHR) ((unsigned*)kt)[it] = 0u;
    for (int it = tid; it < 64 * 128; it += NTHR) {
        const int tau = it >> 7, ho = (it >> 3) & 15, hi = (it & 7) * 2;
        float s0 = 0.f, s1 = 0.f;
        for (int p = 0; p < 64; ++p) {
            const float c_r = cr[ho * 64 + p], c_i = ci[ho * 64 + p], pr = powr[tau * 64 + p], pi = powi[tau * 64 + p];
            const float cpr = c_r * pr - c_i * pi, cpi = c_r * pi + c_i * pr;
            s0 += cpr * bzr[p * 16 + hi] - cpi * bzi[p * 16 + hi];
            s1 += cpr * bzr[p * 16 + hi + 1] - cpi * bzi[p * 16 + hi + 1];
        }
        if (tau == 0) { if (ho == hi) s0 += d_skip[lg * 16 + ho]; if (ho == hi + 1) s1 += d_skip[lg * 16 + ho]; }
        *(unsigned*)(kt + (tau + 1) * KT_BLK + ho * 32 + hi * 2) = pack_bf2(s0, s1);
    }
    for (int it = tid; it < 65 * 4; it += NTHR) ((unsigned*)(kt + (it >> 2) * KT_BLK + 512))[it & 3] = 0u;
    bf16x8* wst = WST + (size_t)lg * WST_FRAGS;
    for (int it = tid; it < WST_FRAGS; it += NTHR) {
        const int lane = it & 63, j = (it >> 6) & 63, nt = it >> 12;
        const int r = lane & 31, h = lane >> 5, n = nt * 32 + r, p = n & 63, im = n >> 6;
        const float pr = powr[(63 - j) * 64 + p], pi = powi[(63 - j) * 64 + p];
        float v[8];
#pragma unroll
        for (int jj = 0; jj < 8; ++jj) {
            const float zr = bzr[p * 16 + 8 * h + jj], zi = bzi[p * 16 + 8 * h + jj];
            v[jj] = im ? (pr * zi + pi * zr) : (pr * zr - pi * zi);
        }
        uint4 o; o.x = pack_bf2(v[0], v[1]); o.y = pack_bf2(v[2], v[3]); o.z = pack_bf2(v[4], v[5]); o.w = pack_bf2(v[6], v[7]);
        *(uint4*)(wst + it) = o;
    }
    bf16x8* cc = CCAR + (size_t)lg * CCAR_FRAGS;
    for (int it = tid; it < CCAR_FRAGS; it += NTHR) {
        const int lane = it & 63, ks = (it >> 6) & 7, mt = it >> 9;
        const int r = lane & 31, h = lane >> 5, m = mt * 32 + r, i = m >> 4, ho = m & 15;
        float v[8];
#pragma unroll
        for (int jj = 0; jj < 8; ++jj) {
            const int k = ks * 16 + 8 * h + jj, p = k & 63, im = k >> 6;
            const float c_r = cr[ho * 64 + p], c_i = ci[ho * 64 + p], pr = powr[(i + 1) * 64 + p], pi = powi[(i + 1) * 64 + p];
            v[jj] = im ? -(c_r * pi + c_i * pr) : (c_r * pr - c_i * pi);
        }
        uint4 o; o.x = pack_bf2(v[0], v[1]); o.y = pack_bf2(v[2], v[3]); o.z = pack_bf2(v[4], v[5]); o.w = pack_bf2(v[6], v[7]);
        *(uint4*)(cc + it) = o;
    }
    __syncthreads();
}

#define PB_SU 0
#define PB_SKT (32 * SU_CH)
#define PB_SL (PB_SKT + KT_BYTES)
#define PB_SPART (PB_SL + 32 * 132 * 4)
#define PB_SSP (PB_SPART + 4 * 4096)
#define PB_BYTES (PB_SSP + 32 * 272)

DI void phaseB_tile(const bf16_t* __restrict__ U, const char* __restrict__ KT, const bf16x8* __restrict__ WST, const bf16x8* __restrict__ CCAR,
                    const float* __restrict__ ABT, bf16_t* __restrict__ YPRE, int tile, char* smem, int wid) {
    const int g = tile & 31, b = tile >> 5;
    int tid = get_tid(wid);
    const int w = __builtin_amdgcn_readfirstlane(tid >> 6), lane = tid & 63, r = lane & 31, h = lane >> 5;
    char* sU = smem + PB_SU; char* sKT = smem + PB_SKT; float* sL = (float*)(smem + PB_SL); float* sPart = (float*)(smem + PB_SPART);
    char* sSp = smem + PB_SSP;
#pragma unroll
    for (int it = 0; it < 4; ++it) {
        const int tok = tid + NTHR * it;
        const uint4* src = (const uint4*)(U + (size_t)(b * SEQ + tok) * DM + g * 16);
        const uint4 v0 = src[0], v1 = src[1];
        char* d = sU + (tok >> 6) * SU_CH + (tok & 63) * 32;
        *(uint4*)d = v0; *(uint4*)(d + 16) = v1;
    }
    {
        const uint4* src = (const uint4*)(KT + (size_t)g * KT_BYTES);
        for (int it = tid; it < KT_BYTES / 16; it += NTHR) ((uint4*)sKT)[it] = src[it];
    }
    __syncthreads();
    {
        const int nt = w & 3, kh = w >> 2;
        f32x16 acc;
#pragma unroll
        for (int i = 0; i < 16; ++i) acc[i] = 0.f;
        const bf16x8* wp = WST + (size_t)g * WST_FRAGS + (size_t)(nt * 64 + kh * 32) * 64 + lane;
        const char* up = sU + r * SU_CH + h * 16 + kh * 32 * 32;
#pragma unroll 4
        for (int j = 0; j < 32; ++j) {
            const bf16x8 a = wp[j * 64];
            const bf16x8 bb = *(const bf16x8*)(up + j * 32);
            acc = MFMA32(a, bb, acc);
        }
        if (kh == 1) {
#pragma unroll
            for (int i = 0; i < 16; ++i) sPart[(nt * 16 + i) * 64 + lane] = acc[i];
        }
        __syncthreads();
        if (kh == 0) {
#pragma unroll
            for (int i = 0; i < 16; ++i) sL[r * 132 + nt * 32 + crow(i, h)] = acc[i] + sPart[(nt * 16 + i) * 64 + lane];
        }
        __syncthreads();
    }
    if (tid < 64) {
        const int p = tid;
        const float ar = ABT[g * 128 + 2 * p], ai = ABT[g * 128 + 2 * p + 1];
        float sr = 0.f, si = 0.f;
        for (int c = 0; c < 32; ++c) {
            *(bf16_t*)(sSp + c * 272 + p * 2) = (bf16_t)(pack_bf2(sr, 0.f) & 0xffffu);
            *(bf16_t*)(sSp + c * 272 + (64 + p) * 2) = (bf16_t)(pack_bf2(si, 0.f) & 0xffffu);
            const float lr = sL[c * 132 + p], li = sL[c * 132 + 64 + p];
            const float nr = ar * sr - ai * si + lr, ni = ar * si + ai * sr + li;
            sr = nr; si = ni;
        }
    }
    f32x16 acc4[4];
#pragma unroll
    for (int q = 0; q < 4; ++q)
#pragma unroll
        for (int i = 0; i < 16; ++i) acc4[q][i] = 0.f;
    const int mts0 = w, mts1 = 15 - w, mts2 = 16 + w, mts3 = 31 - w;
    {
        const char* up = sU + r * SU_CH + h * 16;
        const char* kp = sKT + (r & 15) * 32 + h * 16 + ((r >> 4) + 1) * KT_BLK;
        for (int j = 0; j < 64; ++j) {
            const bf16x8 bb = *(const bf16x8*)(up + j * 32);
#define TOEP_STEP(q, mt) if (2 * (mt) + 1 >= j) { const bf16x8 a = *(const bf16x8*)(kp + (2 * (mt) - j) * KT_BLK); acc4[q] = MFMA32(a, bb, acc4[q]); }
            TOEP_STEP(0, mts0) TOEP_STEP(1, mts1) TOEP_STEP(2, mts2) TOEP_STEP(3, mts3)
#undef TOEP_STEP
        }
    }
    __syncthreads();
    {
        const bf16x8* cp = CCAR + (size_t)g * CCAR_FRAGS + lane;
        const char* sp = sSp + r * 272 + h * 16;
#pragma unroll
        for (int ks = 0; ks < 8; ++ks) {
            const bf16x8 bb = *(const bf16x8*)(sp + ks * 32);
            acc4[0] = MFMA32(cp[(mts0 * 8 + ks) * 64], bb, acc4[0]);
            acc4[1] = MFMA32(cp[(mts1 * 8 + ks) * 64], bb, acc4[1]);
            acc4[2] = MFMA32(cp[(mts2 * 8 + ks) * 64], bb, acc4[2]);
            acc4[3] = MFMA32(cp[(mts3 * 8 + ks) * 64], bb, acc4[3]);
        }
    }
    {
        bf16_t* ybase = YPRE + (size_t)(b * SEQ + r * 64) * 512 + g * 16;
#define PB_STORE(q, mt) _Pragma("unroll") for (int rq = 0; rq < 4; ++rq) { const int c0 = 8 * rq + 4 * h; const int i = 2 * (mt) + (c0 >> 4); \
            uint2 o; o.x = pack_bf2(acc4[q][4 * rq], acc4[q][4 * rq + 1]); o.y = pack_bf2(acc4[q][4 * rq + 2], acc4[q][4 * rq + 3]); \
            *(uint2*)(ybase + (size_t)i * 512 + (c0 & 15)) = o; }
        PB_STORE(0, mts0) PB_STORE(1, mts1) PB_STORE(2, mts2) PB_STORE(3, mts3)
#undef PB_STORE
    }
    __syncthreads();
}

struct ALoadGelu {
    const bf16_t* base; bf16_t* gout; u32x4 v0, v1; int cc; int dofs;
    DI void init(const bf16_t* rowbase, bf16_t* growbase, int tid) { base = rowbase + (tid & 7) * 16; gout = growbase + (tid & 7) * 16; dofs = (tid >> 3) * SA_STRIDE + (tid & 7) * 32; }
    DI void issue(int c) { const u32x4* p = (const u32x4*)(base + c * 128); v0 = p[0]; v1 = p[1]; cc = c; }
    DI unsigned g2(unsigned u) { return pack_bf2(gelu_exact(bf_lo(u)), gelu_exact(bf_hi(u))); }
    DI void commit(char* buf) {
        u32x4 o0, o1;
        o0.x = g2(v0.x); o0.y = g2(v0.y); o0.z = g2(v0.z); o0.w = g2(v0.w);
        o1.x = g2(v1.x); o1.y = g2(v1.y); o1.z = g2(v1.z); o1.w = g2(v1.w);
        char* d = buf + dofs;
        *(u32x4*)d = o0; *(u32x4*)(d + 16) = o1;
        u32x4* gp = (u32x4*)(gout + cc * 128); gp[0] = o0; gp[1] = o1;
    }
};

DI void tok_reduce(float p0, float p1, float* sred, float& t0, float& t1, int tid) {
    const int w = tid >> 6, lane = tid & 63, r = lane & 31, h = lane >> 5;
    __syncthreads();
    sred[(w * 2 + h) * 64 + r] = p0; sred[(w * 2 + h) * 64 + 32 + r] = p1;
    __syncthreads();
    float a = 0.f, b = 0.f;
#pragma unroll
    for (int k = 0; k < 16; ++k) { a += sred[k * 64 + r]; b += sred[k * 64 + 32 + r]; }
    t0 = a; t1 = b;
}

#define PC_SRED (4 * SA_BYTES)
#define PC_BYTES (PC_SRED + 4096 + 256)

struct PCArgs {
    const bf16_t* U; const bf16_t* YPRE; bf16_t* G1; bf16_t* A2; const float* Xin; float* Xout; bf16_t* Hb; float* RSTD;
    const bf16x8* wfglu; const float* b_glu; const bf16x8* wfpool; const float* pool_scale; const bf16x8* wfout;
};

DI void phaseC1_tile(const PCArgs& a, int tile, char* smem, int wid) {
    char* sA = smem; float* sred = (float*)(smem + PC_SRED);
    {
        int tok0 = tile * 64; asm volatile("" : "+s"(tok0));
        int tid = get_tid(wid);
        const int w = __builtin_amdgcn_readfirstlane(tid >> 6), lane = tid & 63, r = lane & 31, h = lane >> 5;
        ALoadGelu al; al.init(a.YPRE + (size_t)(tok0 + (tid >> 3)) * 512, a.G1 + (size_t)(tok0 + (tid >> 3)) * 512, tid);
        f32x16 acc[2][2]; zero_acc<2>(acc);
        gemm64<2, 4>(acc, al, 4, a.wfglu + (size_t)w * (32 * 2 * 64) + lane, sA, lane);
        float ss0 = 0.f, ss1 = 0.f;
#pragma unroll
        for (int mt = 0; mt < 2; ++mt) {
            const bf16_t* yrow = a.G1 + (size_t)(tok0 + mt * 32 + r) * 512 + w * 64;
#pragma unroll
            for (int nt = 0; nt < 2; ++nt)
#pragma unroll
                for (int q = 0; q < 4; ++q) {
                    asm volatile("" ::: "memory");
                    const int n = nt * 32 + 8 * q + 4 * h;
                    const uint2 yp = *(const uint2*)(yrow + n);
                    const float4 bg = *(const float4*)(a.b_glu + w * 64 + n);
                    const float y0 = bf_lo(yp.x), y1 = bf_hi(yp.x), y2 = bf_lo(yp.y), y3 = bf_hi(yp.y);
                    const float o0 = y0 / (1.f + __expf(-(acc[nt][mt][4 * q] + bg.x)));
                    const float o1 = y1 / (1.f + __expf(-(acc[nt][mt][4 * q + 1] + bg.y)));
                    const float o2 = y2 / (1.f + __expf(-(acc[nt][mt][4 * q + 2] + bg.z)));
                    const float o3 = y3 / (1.f + __expf(-(acc[nt][mt][4 * q + 3] + bg.w)));
                    acc[nt][mt][4 * q] = o0; acc[nt][mt][4 * q + 1] = o1; acc[nt][mt][4 * q + 2] = o2; acc[nt][mt][4 * q + 3] = o3;
                    const float s = o0 * o0 + o1 * o1 + o2 * o2 + o3 * o3;
                    if (mt == 0) ss0 += s; else ss1 += s;
                }
        }
        float t0, t1; tok_reduce(ss0, ss1, sred, t0, t1, tid);
        const float rs0 = rsqrtf(t0 * (1.f / 512.f) + 1e-6f), rs1 = rsqrtf(t1 * (1.f / 512.f) + 1e-6f);
#pragma unroll
        for (int mt = 0; mt < 2; ++mt) {
            const float rs = mt ? rs1 : rs0;
            bf16_t* orow = a.A2 + (size_t)(tok0 + mt * 32 + r) * DM + w * 64;
#pragma unroll
            for (int nt = 0; nt < 2; ++nt)
#pragma unroll
                for (int q = 0; q < 4; ++q) {
                    uint2 o; o.x = pack_bf2(acc[nt][mt][4 * q] * rs, acc[nt][mt][4 * q + 1] * rs);
                    o.y = pack_bf2(acc[nt][mt][4 * q + 2] * rs, acc[nt][mt][4 * q + 3] * rs);
                    *(uint2*)(orow + nt * 32 + 8 * q + 4 * h) = o;
                }
        }
    }
    {
        int tok0 = tile * 64; asm volatile("" : "+s"(tok0));
        int tid = get_tid(wid);
        const int w = __builtin_amdgcn_readfirstlane(tid >> 6), lane = tid & 63, r = lane & 31, h = lane >> 5;
        const int row = tid >> 3, seg = tid & 7;
        const int tok = tok0 + row, t = tok & (SEQ - 1);
#pragma unroll
        for (int gi = 0; gi < 4; ++gi) {
            const int win = 2 << gi;
            const int cnt = (t + 1 < win) ? (t + 1) : win;
            const bf16_t* up = a.U + (size_t)tok * DM + 512 + gi * 128 + seg * 16;
            float s[16];
            const uint4 c0 = *(const uint4*)up, c1 = *(const uint4*)(up + 8);
            const unsigned cu[8] = {c0.x, c0.y, c0.z, c0.w, c1.x, c1.y, c1.z, c1.w};
#pragma unroll
            for (int i = 0; i < 8; ++i) { s[2 * i] = bf_lo(cu[i]); s[2 * i + 1] = bf_hi(cu[i]); }
            for (int k = 1; k < cnt; ++k) {
                const uint4 d0 = *(const uint4*)(up - (size_t)k * DM), d1 = *(const uint4*)(up - (size_t)k * DM + 8);
                const unsigned du[8] = {d0.x, d0.y, d0.z, d0.w, d1.x, d1.y, d1.z, d1.w};
#pragma unroll
                for (int i = 0; i < 8; ++i) { s[2 * i] += bf_lo(du[i]); s[2 * i + 1] += bf_hi(du[i]); }
            }
            const float inv = 1.f / (float)cnt;
            unsigned o[8];
#pragma unroll
            for (int i = 0; i < 8; ++i) o[i] = pack_bf2(s[2 * i] * inv - bf_lo(cu[i]), s[2 * i + 1] * inv - bf_hi(cu[i]));
            char* d = sA + gi * SA_BYTES + row * SA_STRIDE + seg * 32;
            *(uint4*)d = make_uint4(o[0], o[1], o[2], o[3]); *(uint4*)(d + 16) = make_uint4(o[4], o[5], o[6], o[7]);
        }
        __syncthreads();
        const int gi = w >> 1;
        f32x16 acc[2][2]; zero_acc<2>(acc);
        const bf16x8* wp = a.wfpool + (size_t)gi * (128 * 128 / 8) + (size_t)(w & 1) * (8 * 2 * 64) + lane;
        const char* buf = sA + gi * SA_BYTES + r * SA_STRIDE + h * 16;
#pragma unroll
        for (int ks = 0; ks < 8; ++ks) {
            const bf16x8 a0 = *(const bf16x8*)(buf + ks * 32);
            const bf16x8 a1 = *(const bf16x8*)(buf + 32 * SA_STRIDE + ks * 32);
#pragma unroll
            for (int nt = 0; nt < 2; ++nt) {
                const bf16x8 wv = wp[(ks * 2 + nt) * 64];
                acc[nt][0] = MFMA32(wv, a0, acc[nt][0]);
                acc[nt][1] = MFMA32(wv, a1, acc[nt][1]);
            }
        }
        float ss0 = 0.f, ss1 = 0.f;
#pragma unroll
        for (int mt = 0; mt < 2; ++mt)
#pragma unroll
            for (int nt = 0; nt < 2; ++nt)
#pragma unroll
                for (int q = 0; q < 4; ++q) {
                    asm volatile("" ::: "memory");
                    const int n = w * 64 + nt * 32 + 8 * q + 4 * h;
                    const float4 sc = *(const float4*)(a.pool_scale + n);
                    const float o0 = acc[nt][mt][4 * q] * sc.x, o1 = acc[nt][mt][4 * q + 1] * sc.y, o2 = acc[nt][mt][4 * q + 2] * sc.z, o3 = acc[nt][mt][4 * q + 3] * sc.w;
                    acc[nt][mt][4 * q] = o0; acc[nt][mt][4 * q + 1] = o1; acc[nt][mt][4 * q + 2] = o2; acc[nt][mt][4 * q + 3] = o3;
                    const float s = o0 * o0 + o1 * o1 + o2 * o2 + o3 * o3;
                    if (mt == 0) ss0 += s; else ss1 += s;
                }
        float t0, t1; tok_reduce(ss0, ss1, sred, t0, t1, tid);
        const float rs0 = rsqrtf(t0 * (1.f / 512.f) + 1e-6f), rs1 = rsqrtf(t1 * (1.f / 512.f) + 1e-6f);
#pragma unroll
        for (int mt = 0; mt < 2; ++mt) {
            const float rs = mt ? rs1 : rs0;
            bf16_t* orow = a.A2 + (size_t)(tok0 + mt * 32 + r) * DM + 512 + w * 64;
#pragma unroll
            for (int nt = 0; nt < 2; ++nt)
#pragma unroll
                for (int q = 0; q < 4; ++q) {
                    uint2 o; o.x = pack_bf2(acc[nt][mt][4 * q] * rs, acc[nt][mt][4 * q + 1] * rs);
                    o.y = pack_bf2(acc[nt][mt][4 * q + 2] * rs, acc[nt][mt][4 * q + 3] * rs);
                    *(uint2*)(orow + nt * 32 + 8 * q + 4 * h) = o;
                }
        }
        __syncthreads();
    }
    {
        int tok0 = tile * 64; asm volatile("" : "+s"(tok0));
        int tid = get_tid(wid);
        const int w = __builtin_amdgcn_readfirstlane(tid >> 6), lane = tid & 63, r = lane & 31, h = lane >> 5;
        ALoadBF16 al; al.init(a.A2 + (size_t)(tok0 + (tid >> 3)) * DM, tid);
        f32x16 acc[4][2]; zero_acc<4>(acc);
        gemm64<4, 2>(acc, al, 8, a.wfout + (size_t)w * (64 * 4 * 64) + lane, sA, lane);
        float ss0 = 0.f, ss1 = 0.f;
#pragma unroll
        for (int mt = 0; mt < 2; ++mt) {
            const size_t ro = (size_t)(tok0 + mt * 32 + r) * DM + w * 128;
#pragma unroll
            for (int nt = 0; nt < 4; ++nt)
#pragma unroll
                for (int q = 0; q < 4; ++q) {
                    asm volatile("" ::: "memory");
                    const int n = nt * 32 + 8 * q + 4 * h;
                    const float4 xi = *(const float4*)(a.Xin + ro + n);
                    float4 xo; xo.x = xi.x + acc[nt][mt][4 * q]; xo.y = xi.y + acc[nt][mt][4 * q + 1]; xo.z = xi.z + acc[nt][mt][4 * q + 2]; xo.w = xi.w + acc[nt][mt][4 * q + 3];
                    *(float4*)(a.Xout + ro + n) = xo;
                    uint2 o; o.x = pack_bf2(xo.x, xo.y); o.y = pack_bf2(xo.z, xo.w);
                    *(uint2*)(a.Hb + ro + n) = o;
                    const float s = xo.x * xo.x + xo.y * xo.y + xo.z * xo.z + xo.w * xo.w;
                    if (mt == 0) ss0 += s; else ss1 += s;
                }
        }
        float t0, t1; tok_reduce(ss0, ss1, sred, t0, t1, tid);
        if (w == 0) { a.RSTD[tok0 + r + 32 * h] = rsqrtf((h ? t1 : t0) * (1.f / 1024.f) + 1e-6f); }
        __syncthreads();
    }
}

DI unsigned f2ord(float f) { const unsigned u = __float_as_uint(f); return u ^ ((u >> 31) ? 0xFFFFFFFFu : 0x80000000u); }
DI float ord2f(unsigned o) { return __uint_as_float((o & 0x80000000u) ? (o ^ 0x80000000u) : ~o); }
DI unsigned umax_(unsigned a, unsigned b) { return a > b ? a : b; }
DI unsigned umin_(unsigned a, unsigned b) { return a < b ? a : b; }

struct PRArgs {
    const bf16_t* Hb; const float* RSTD; bf16_t* Qb; const bf16x8* wfq; const bf16x8* wfk1; const bf16x8* wfk2; int* EX; float* GT;
};

DI void topk_insert16(unsigned (&L)[16], const f32x16& s, int nbase, int h) {
#pragma unroll
    for (int i = 0; i < 16; ++i) {
        unsigned x = (f2ord(s[i]) & 0xFFFFFF80u) | (unsigned)(127 - (nbase + crow(i, h)));
#pragma unroll
        for (int k = 0; k < 16; ++k) { const unsigned hi = umax_(L[k], x); x = umin_(L[k], x); L[k] = hi; }
    }
}

DI void phaseC2_tile(const PRArgs& a, int tile, char* smem, int wid) {
    char* sA = smem;
#pragma unroll 1
    for (int ps = 0; ps < 2; ++ps) {
        int tok0 = tile * 64; asm volatile("" : "+s"(tok0));
        int tid = get_tid(wid);
        const int w = __builtin_amdgcn_readfirstlane(tid >> 6), lane = tid & 63, r = lane & 31, h = lane >> 5;
        ALoadBF16 al; al.init(a.Hb + (size_t)(tok0 + (tid >> 3)) * DM, tid);
        f32x16 acc[4][2]; zero_acc<4>(acc);
        const int ng = ps * 8 + w;
        gemm64<4, 2>(acc, al, 8, a.wfq + (size_t)ng * (64 * 4 * 64) + lane, sA, lane);
#pragma unroll
        for (int mt = 0; mt < 2; ++mt) {
            const float rs = a.RSTD[tok0 + mt * 32 + r];
            bf16_t* orow = a.Qb + (size_t)(tok0 + mt * 32 + r) * 2048 + ng * 128;
#pragma unroll
            for (int nt = 0; nt < 4; ++nt)
#pragma unroll
                for (int q = 0; q < 4; ++q) {
                    uint2 o; o.x = pack_bf2(acc[nt][mt][4 * q] * rs, acc[nt][mt][4 * q + 1] * rs);
                    o.y = pack_bf2(acc[nt][mt][4 * q + 2] * rs, acc[nt][mt][4 * q + 3] * rs);
                    *(uint2*)(orow + nt * 32 + 8 * q + 4 * h) = o;
                }
        }
    }
    __syncthreads();
    {
        int tok0 = tile * 64; asm volatile("" : "+s"(tok0));
        int tid = get_tid(wid);
        const int w = __builtin_amdgcn_readfirstlane(tid >> 6), lane = tid & 63, r = lane & 31, h = lane >> 5;
        unsigned T0[16], T1[16];
#pragma unroll 1
        for (int half = 0; half < 2; ++half) {
            gwp_t wk = (gwp_t)(half ? a.wfk2 : a.wfk1) + lane;
#pragma unroll 1
            for (int mt = 0; mt < 2; ++mt) {
                f32x16 sc[4];
#pragma unroll
                for (int nt = 0; nt < 4; ++nt)
#pragma unroll
                    for (int i = 0; i < 16; ++i) sc[nt][i] = 0.f;
                const bf16_t* qrow = a.Qb + (size_t)(tok0 + mt * 32 + r) * 2048 + w * 256 + half * 128 + 8 * h;
#pragma unroll
                for (int ks = 0; ks < 8; ++ks) {
                    const bf16x8 qv = *(const bf16x8*)(qrow + ks * 16);
#pragma unroll
                    for (int nt = 0; nt < 4; ++nt) sc[nt] = MFMA32(wk[(ks * 4 + nt) * 64], qv, sc[nt]);
                }
                unsigned L[16];
#pragma unroll
                for (int k = 0; k < 16; ++k) L[k] = 0u;
#pragma unroll
                for (int nt = 0; nt < 4; ++nt) topk_insert16(L, sc[nt], nt * 32, h);
                unsigned P[16];
#pragma unroll
                for (int k = 0; k < 16; ++k) P[k] = (unsigned)shx_i<32>((int)L[k], lane);
#pragma unroll
                for (int k = 0; k < 16; ++k) L[k] = umax_(L[k], P[15 - k]);
#pragma unroll
                for (int d = 8; d > 0; d >>= 1)
#pragma unroll
                    for (int k = 0; k < 16; ++k)
                        if ((k & d) == 0) { const unsigned hi = umax_(L[k], L[k + d]), lo = umin_(L[k], L[k + d]); L[k] = hi; L[k + d] = lo; }
                if (h == mt) {
                    if (half == 0) {
#pragma unroll
                        for (int k = 0; k < 16; ++k) T0[k] = L[k];
                    } else {
#pragma unroll
                        for (int k = 0; k < 16; ++k) T1[k] = L[k];
                    }
                }
            }
        }
        float v1[16], v2[16];
#pragma unroll
        for (int k = 0; k < 16; ++k) { v1[k] = ord2f(T0[k] & 0xFFFFFF80u); v2[k] = ord2f(T1[k] & 0xFFFFFF80u); }
        unsigned C[16];
#pragma unroll
        for (int b = 0; b < 16; ++b) C[b] = (f2ord(v1[0] + v2[b]) & 0xFFFFFF00u) | (unsigned)(255 - b);
#pragma unroll
        for (int aa = 1; aa < 16; ++aa)
#pragma unroll
            for (int b = 0; b < 16; ++b)
                if ((aa + 1) * (b + 1) <= 16) {
                    unsigned x = (f2ord(v1[aa] + v2[b]) & 0xFFFFFF00u) | (unsigned)(255 - (aa * 16 + b));
#pragma unroll
                    for (int k = (aa + 1) * (b + 1) - 1; k < 16; ++k) { const unsigned hi = umax_(C[k], x); x = umin_(C[k], x); C[k] = hi; }
                }
        unsigned* sI = (unsigned*)(smem) + (w * 64 + lane) * 9;
#pragma unroll
        for (int q = 0; q < 4; ++q) {
            unsigned p1 = 0u, p2 = 0u;
#pragma unroll
            for (int j = 0; j < 4; ++j) { p1 |= (127u - (T0[4 * q + j] & 0x7Fu)) << (8 * j); p2 |= (127u - (T1[4 * q + j] & 0x7Fu)) << (8 * j); }
            sI[q] = p1; sI[4 + q] = p2;
        }
        const unsigned char* sB = (const unsigned char*)sI;
        const float mx = ord2f(C[0] & 0xFFFFFF00u);
        float e[16]; float sum = 0.f; int ex[16];
#pragma unroll
        for (int k = 0; k < 16; ++k) {
            e[k] = __expf(ord2f(C[k] & 0xFFFFFF00u) - mx); sum += e[k];
            const unsigned ci = 255u - (C[k] & 0xFFu);
            ex[k] = (int)sB[ci >> 4] * 128 + (int)sB[16 + (ci & 15u)];
        }
        const float inv = 1.f / sum;
        const size_t ob = ((size_t)(tok0 + h * 32 + r) * 8 + w) * 16;
#pragma unroll
        for (int q = 0; q < 4; ++q) {
            *(int4*)(a.EX + ob + 4 * q) = make_int4(ex[4 * q], ex[4 * q + 1], ex[4 * q + 2], ex[4 * q + 3]);
            *(float4*)(a.GT + ob + 4 * q) = make_float4(e[4 * q] * inv, e[4 * q + 1] * inv, e[4 * q + 2] * inv, e[4 * q + 3] * inv);
        }
    }
    __syncthreads();
}

typedef const __attribute__((address_space(1))) u32x4* grow_t;
typedef unsigned char fp8_t;

struct PGArgs {
    const bf16_t* Hb; const float* RSTD; const int* EX; const float* GT; const fp8_t* U8; const fp8_t* V8; const float* SU; const float* SV;
    const float* Xin; float* Xout; const float* gfinal; int final_norm;
};

DI void conv_rows_fp8(const float* __restrict__ src, const float* __restrict__ gain, fp8_t* __restrict__ dst, float* __restrict__ scales,
                      int nrows, int gwave, int nwaves, int lane) {
    for (int row = gwave; row < nrows; row += nwaves) {
        const float4* p = (const float4*)(src + (size_t)row * DM + lane * 16);
        float4 v0 = p[0], v1 = p[1], v2 = p[2], v3 = p[3];
        if (gain) {
            const float4* g = (const float4*)(gain + lane * 16);
            const float4 g0 = g[0], g1 = g[1], g2 = g[2], g3 = g[3];
            v0.x *= g0.x; v0.y *= g0.y; v0.z *= g0.z; v0.w *= g0.w; v1.x *= g1.x; v1.y *= g1.y; v1.z *= g1.z; v1.w *= g1.w;
            v2.x *= g2.x; v2.y *= g2.y; v2.z *= g2.z; v2.w *= g2.w; v3.x *= g3.x; v3.y *= g3.y; v3.z *= g3.z; v3.w *= g3.w;
        }
        float m = fmaxf(fmaxf(fmaxf(fabsf(v0.x), fabsf(v0.y)), fmaxf(fabsf(v0.z), fabsf(v0.w))), fmaxf(fmaxf(fabsf(v1.x), fabsf(v1.y)), fmaxf(fabsf(v1.z), fabsf(v1.w))));
        m = fmaxf(m, fmaxf(fmaxf(fmaxf(fabsf(v2.x), fabsf(v2.y)), fmaxf(fabsf(v2.z), fabsf(v2.w))), fmaxf(fmaxf(fabsf(v3.x), fabsf(v3.y)), fmaxf(fabsf(v3.z), fabsf(v3.w)))));
#pragma unroll
        for (int o = 0; o < 1; ++o) { m = fmaxf(m, shx<1>(m, lane)); m = fmaxf(m, shx<2>(m, lane)); m = fmaxf(m, shx<4>(m, lane)); m = fmaxf(m, shx<8>(m, lane)); m = fmaxf(m, shx<16>(m, lane)); m = fmaxf(m, shx<32>(m, lane)); }
        const float sc = (m > 0.f) ? m * (1.f / 448.f) : 1.f;
        const float inv = 1.f / sc;
        u32x4 o;
        unsigned t;
        t = 0u; t = __builtin_amdgcn_cvt_pk_fp8_f32(v0.x * inv, v0.y * inv, t, false); t = __builtin_amdgcn_cvt_pk_fp8_f32(v0.z * inv, v0.w * inv, t, true); o.x = t;
        t = 0u; t = __builtin_amdgcn_cvt_pk_fp8_f32(v1.x * inv, v1.y * inv, t, false); t = __builtin_amdgcn_cvt_pk_fp8_f32(v1.z * inv, v1.w * inv, t, true); o.y = t;
        t = 0u; t = __builtin_amdgcn_cvt_pk_fp8_f32(v2.x * inv, v2.y * inv, t, false); t = __builtin_amdgcn_cvt_pk_fp8_f32(v2.z * inv, v2.w * inv, t, true); o.z = t;
        t = 0u; t = __builtin_amdgcn_cvt_pk_fp8_f32(v3.x * inv, v3.y * inv, t, false); t = __builtin_amdgcn_cvt_pk_fp8_f32(v3.z * inv, v3.w * inv, t, true); o.w = t;
        *(u32x4*)(dst + ((size_t)(lane >> 3) * nrows + row) * 128 + (lane & 7) * 16) = o;
        if (lane == 0) scales[row] = sc;
    }
}

struct RowOct { u32x4 r0, r1, r2, r3, r4, r5, r6, r7; };
DI void oct_load(RowOct& q, const fp8_t* tab, int e0, int e1, int e2, int e3, int e4, int e5, int e6, int e7, int lane) {
    q.r0 = ((grow_t)(tab + (size_t)e0 * DM))[lane]; q.r1 = ((grow_t)(tab + (size_t)e1 * DM))[lane];
    q.r2 = ((grow_t)(tab + (size_t)e2 * DM))[lane]; q.r3 = ((grow_t)(tab + (size_t)e3 * DM))[lane];
    q.r4 = ((grow_t)(tab + (size_t)e4 * DM))[lane]; q.r5 = ((grow_t)(tab + (size_t)e5 * DM))[lane];
    q.r6 = ((grow_t)(tab + (size_t)e6 * DM))[lane]; q.r7 = ((grow_t)(tab + (size_t)e7 * DM))[lane];
}
DI float dot4w(unsigned w, float h0, float h1, float h2, float h3, float s) {
    const f2_t lo = __builtin_amdgcn_cvt_pk_f32_fp8(w, false), hi = __builtin_amdgcn_cvt_pk_f32_fp8(w, true);
    s = fmaf(lo.x, h0, s); s = fmaf(lo.y, h1, s); s = fmaf(hi.x, h2, s); s = fmaf(hi.y, h3, s);
    return s;
}
DI float row_dot8(const u32x4& r, const float (&h)[16]) {
    float s = 0.f;
    s = dot4w(r.x, h[0], h[1], h[2], h[3], s); s = dot4w(r.y, h[4], h[5], h[6], h[7], s);
    s = dot4w(r.z, h[8], h[9], h[10], h[11], s); s = dot4w(r.w, h[12], h[13], h[14], h[15], s);
    return s;
}
DI void axpy4w(unsigned w, float c, float& a0, float& a1, float& a2, float& a3) {
    const f2_t lo = __builtin_amdgcn_cvt_pk_f32_fp8(w, false), hi = __builtin_amdgcn_cvt_pk_f32_fp8(w, true);
    a0 = fmaf(c, lo.x, a0); a1 = fmaf(c, lo.y, a1); a2 = fmaf(c, hi.x, a2); a3 = fmaf(c, hi.y, a3);
}
DI void row_axpy8(float (&acc)[16], const u32x4& r, float c) {
    axpy4w(r.x, c, acc[0], acc[1], acc[2], acc[3]); axpy4w(r.y, c, acc[4], acc[5], acc[6], acc[7]);
    axpy4w(r.z, c, acc[8], acc[9], acc[10], acc[11]); axpy4w(r.w, c, acc[12], acc[13], acc[14], acc[15]);
}
#define RL(v, l) __builtin_amdgcn_readlane((v), (l))
#define RLF(v, l) __uint_as_float((unsigned)__builtin_amdgcn_readlane((int)__float_as_uint(v), (l)))

DI float reduce16(float (&p)[16], int lane) {
    const bool b5 = lane & 32, b4 = lane & 16, b3 = lane & 8, b2 = lane & 4;
    float q8[8], q4[4], q2[2];
#pragma unroll
    for (int k = 0; k < 8; ++k) { const float keep = b5 ? p[k + 8] : p[k], send = b5 ? p[k] : p[k + 8]; q8[k] = keep + shx<32>(send, lane); }
#pragma unroll
    for (int k = 0; k < 4; ++k) { const float keep = b4 ? q8[k + 4] : q8[k], send = b4 ? q8[k] : q8[k + 4]; q4[k] = keep + shx<16>(send, lane); }
#pragma unroll
    for (int k = 0; k < 2; ++k) { const float keep = b3 ? q4[k + 2] : q4[k], send = b3 ? q4[k] : q4[k + 2]; q2[k] = keep + shx<8>(send, lane); }
    float t;
    { const float keep = b2 ? q2[1] : q2[0], send = b2 ? q2[0] : q2[1]; t = keep + shx<4>(send, lane); }
    t += shx<1>(t, lane); t += shx<2>(t, lane);
    return t;
}

DI void phaseC3_tile(const PGArgs& a, int tile, int wid) {
    int tid = get_tid(wid);
    const int w = __builtin_amdgcn_readfirstlane(tid >> 6), lane = tid & 63;
    const int el = (lane >> 2) & 15;
#pragma unroll 1
    for (int ti = 0; ti < 8; ++ti) {
        const int tok = tile * 64 + w * 8 + ti;
        float h[16];
        {
            const u32x4* hp = (const u32x4*)(a.Hb + (size_t)tok * DM + lane * 16);
            const u32x4 h0 = hp[0], h1 = hp[1];
            h[0] = bf_lo(h0.x); h[1] = bf_hi(h0.x); h[2] = bf_lo(h0.y); h[3] = bf_hi(h0.y); h[4] = bf_lo(h0.z); h[5] = bf_hi(h0.z); h[6] = bf_lo(h0.w); h[7] = bf_hi(h0.w);
            h[8] = bf_lo(h1.x); h[9] = bf_hi(h1.x); h[10] = bf_lo(h1.y); h[11] = bf_hi(h1.y); h[12] = bf_lo(h1.z); h[13] = bf_hi(h1.z); h[14] = bf_lo(h1.w); h[15] = bf_hi(h1.w);
        }
        const float rs = a.RSTD[tok];
        float acc[16];
#pragma unroll
        for (int i = 0; i < 16; ++i) acc[i] = 0.f;
#pragma unroll 1
        for (int hd = 0; hd < 8; ++hd) {
            const size_t eb = ((size_t)tok * 8 + hd) * 16;
            const int exv = a.EX[eb + (lane & 15)];
            const int exl = a.EX[eb + el];
            const float coef = a.GT[eb + el] * a.SV[exl];
            const float su = a.SU[exl] * rs;
            RowOct qa, qb;
            float p[16];
            oct_load(qa, a.U8, RL(exv, 0), RL(exv, 1), RL(exv, 2), RL(exv, 3), RL(exv, 4), RL(exv, 5), RL(exv, 6), RL(exv, 7), lane);
            oct_load(qb, a.U8, RL(exv, 8), RL(exv, 9), RL(exv, 10), RL(exv, 11), RL(exv, 12), RL(exv, 13), RL(exv, 14), RL(exv, 15), lane);
            p[0] = row_dot8(qa.r0, h); p[1] = row_dot8(qa.r1, h); p[2] = row_dot8(qa.r2, h); p[3] = row_dot8(qa.r3, h);
            p[4] = row_dot8(qa.r4, h); p[5] = row_dot8(qa.r5, h); p[6] = row_dot8(qa.r6, h); p[7] = row_dot8(qa.r7, h);
            oct_load(qa, a.V8, RL(exv, 0), RL(exv, 1), RL(exv, 2), RL(exv, 3), RL(exv, 4), RL(exv, 5), RL(exv, 6), RL(exv, 7), lane);
            p[8] = row_dot8(qb.r0, h); p[9] = row_dot8(qb.r1, h); p[10] = row_dot8(qb.r2, h); p[11] = row_dot8(qb.r3, h);
            p[12] = row_dot8(qb.r4, h); p[13] = row_dot8(qb.r5, h); p[14] = row_dot8(qb.r6, h); p[15] = row_dot8(qb.r7, h);
            oct_load(qb, a.V8, RL(exv, 8), RL(exv, 9), RL(exv, 10), RL(exv, 11), RL(exv, 12), RL(exv, 13), RL(exv, 14), RL(exv, 15), lane);
            const float act = gelu_exact(reduce16(p, lane) * su) * coef;
            row_axpy8(acc, qa.r0, RLF(act, 0)); row_axpy8(acc, qa.r1, RLF(act, 4)); row_axpy8(acc, qa.r2, RLF(act, 8)); row_axpy8(acc, qa.r3, RLF(act, 12));
            row_axpy8(acc, qa.r4, RLF(act, 16)); row_axpy8(acc, qa.r5, RLF(act, 20)); row_axpy8(acc, qa.r6, RLF(act, 24)); row_axpy8(acc, qa.r7, RLF(act, 28));
            row_axpy8(acc, qb.r0, RLF(act, 32)); row_axpy8(acc, qb.r1, RLF(act, 36)); row_axpy8(acc, qb.r2, RLF(act, 40)); row_axpy8(acc, qb.r3, RLF(act, 44));
            row_axpy8(acc, qb.r4, RLF(act, 48)); row_axpy8(acc, qb.r5, RLF(act, 52)); row_axpy8(acc, qb.r6, RLF(act, 56)); row_axpy8(acc, qb.r7, RLF(act, 60));
        }
        const float* xi = a.Xin + (size_t)tok * DM + lane * 16;
        float* xo = a.Xout + (size_t)tok * DM + lane * 16;
        float4 x0 = *(const float4*)xi, x1 = *(const float4*)(xi + 4), x2 = *(const float4*)(xi + 8), x3 = *(const float4*)(xi + 12);
        x0.x += acc[0]; x0.y += acc[1]; x0.z += acc[2]; x0.w += acc[3]; x1.x += acc[4]; x1.y += acc[5]; x1.z += acc[6]; x1.w += acc[7];
        x2.x += acc[8]; x2.y += acc[9]; x2.z += acc[10]; x2.w += acc[11]; x3.x += acc[12]; x3.y += acc[13]; x3.z += acc[14]; x3.w += acc[15];
        if (a.final_norm) {
            float ss = x0.x * x0.x + x0.y * x0.y + x0.z * x0.z + x0.w * x0.w + x1.x * x1.x + x1.y * x1.y + x1.z * x1.z + x1.w * x1.w
                     + x2.x * x2.x + x2.y * x2.y + x2.z * x2.z + x2.w * x2.w + x3.x * x3.x + x3.y * x3.y + x3.z * x3.z + x3.w * x3.w;
            ss = wave_sum(ss, lane);
            const float rf = rsqrtf(ss * (1.f / 1024.f) + 1e-6f);
            const float* gf = a.gfinal + lane * 16;
            const float4 g0 = *(const float4*)gf, g1 = *(const float4*)(gf + 4), g2 = *(const float4*)(gf + 8), g3 = *(const float4*)(gf + 12);
            x0.x *= rf * g0.x; x0.y *= rf * g0.y; x0.z *= rf * g0.z; x0.w *= rf * g0.w; x1.x *= rf * g1.x; x1.y *= rf * g1.y; x1.z *= rf * g1.z; x1.w *= rf * g1.w;
            x2.x *= rf * g2.x; x2.y *= rf * g2.y; x2.z *= rf * g2.z; x2.w *= rf * g2.w; x3.x *= rf * g3.x; x3.y *= rf * g3.y; x3.z *= rf * g3.z; x3.w *= rf * g3.w;
        }
        *(float4*)xo = x0; *(float4*)(xo + 4) = x1; *(float4*)(xo + 8) = x2; *(float4*)(xo + 12) = x3;
    }
}
#define XB_TMO      128
#define XB_XCNT(j)  (256  + 64 * (j))
#define XB_XSUB(j)  (1280 + 64 * (j))
#define XB_XGEN(j)  (2304 + 64 * (j))
#define XB_TOP      3328
#define XB_TOPGEN   3392
#define XB_QUEUE(j) (3456 + 64 * (j))
#define XCD_BAR_WORDS (3456 + 64 * 64)
#define XB_SPIN_CAP (1u << 20)
#define LAS __attribute__((address_space(3)))

DI unsigned xb_ld(unsigned* p)              { return __hip_atomic_load(p, __ATOMIC_RELAXED, __HIP_MEMORY_SCOPE_AGENT); }
DI unsigned xb_add(unsigned* p, unsigned v) { return __hip_atomic_fetch_add(p, v, __ATOMIC_RELAXED, __HIP_MEMORY_SCOPE_AGENT); }
DI unsigned xb_xcc_id() { return (unsigned)__builtin_amdgcn_s_getreg((3 << 11) | 20) & 0xFu; }
#define XB_SPIN(cond, bar) do { unsigned _sp = 0; while (cond) { __builtin_amdgcn_s_sleep(1); \
    if ((++_sp & 255u) == 0u) { if (xb_ld(&(bar)[XB_TMO])) break; if (_sp > XB_SPIN_CAP) { atomicAdd(&(bar)[XB_TMO], 1u); break; } } } } while (0)

struct XcdBarrier { unsigned* bar; unsigned x; volatile LAS unsigned* st; };

DI XcdBarrier xcd_barrier_post(unsigned* bar, volatile LAS unsigned* st, int tid) {
    XcdBarrier b; b.bar = bar; b.x = xb_xcc_id(); b.st = st;
    if (tid == 0) st[2] = xb_add(&bar[XB_XCNT(b.x)], 1u);
    return b;
}
DI void xcd_barrier_complete(unsigned* bar, unsigned x, unsigned& nloc, unsigned& nx) {
    const unsigned G = gridDim.x * gridDim.y * gridDim.z;
    unsigned sum, cnt, mine, sp = 0u;
    for (;;) {
        sum = 0u; cnt = 0u; mine = 0u;
#pragma unroll
        for (unsigned j = 0; j < 16; ++j) { const unsigned c = xb_ld(&bar[XB_XCNT(j)]); sum += c; cnt += (c > 0u) ? 1u : 0u; mine = (j == x) ? c : mine; }
        if (sum == G) break;
        __builtin_amdgcn_s_sleep(1);
        if ((++sp & 255u) == 0u) { if (xb_ld(&bar[XB_TMO])) break; if (sp > XB_SPIN_CAP) { atomicAdd(&bar[XB_TMO], 1u); break; } }
    }
    nloc = mine > 0u ? mine : 1u; nx = cnt > 0u ? cnt : 1u;
}
DI void xcd_barrier(const XcdBarrier& b, int wid) {
    asm volatile("s_waitcnt vmcnt(0)" ::: "memory");
    __syncthreads();
    if (get_tid(wid) == 0) {
        unsigned* bar = b.bar;
        __builtin_amdgcn_s_waitcnt(0);
        unsigned nloc = b.st[0], nx = b.st[1];
        if (nloc == 0u) { xcd_barrier_complete(bar, b.x, nloc, nx); b.st[0] = nloc; b.st[1] = nx; }
        const unsigned old = xb_add(&bar[XB_XSUB(b.x)], 1u);
        const unsigned gen = old / nloc;
        if (old + 1u == (gen + 1u) * nloc) {
            __builtin_amdgcn_fence(__ATOMIC_RELEASE, "agent");
            asm volatile("s_waitcnt vmcnt(0)" ::: "memory");
            const unsigned og = xb_add(&bar[XB_TOP], 1u);
            const unsigned tg = og / nx;
            if (og + 1u == (tg + 1u) * nx) xb_add(&bar[XB_TOPGEN], 1u);
            else XB_SPIN(xb_ld(&bar[XB_TOPGEN]) == tg, bar);
            __builtin_amdgcn_fence(__ATOMIC_ACQUIRE, "agent");
            xb_add(&bar[XB_XGEN(b.x)], 1u);
            asm volatile("s_waitcnt vmcnt(0)" ::: "memory");
        } else {
            XB_SPIN(xb_ld(&bar[XB_XGEN(b.x)]) == gen, bar);
            __builtin_amdgcn_fence(__ATOMIC_ACQUIRE, "agent");
            asm volatile("s_waitcnt vmcnt(0)" ::: "memory");
        }
    }
    __syncthreads();
}
struct PSArgs {
    const bf16_t* Hb; const float* RSTD; const int* EX; const float* GT; const fp8_t* U8; const fp8_t* V8; const float* SU; const float* SV;
    float* PD; float* COEF; const float* Xin; float* Xout;
};

DI void dot4p(unsigned w, const f2_t& h01, const f2_t& h23, f2_t& s2) {
    const f2_t lo = __builtin_amdgcn_cvt_pk_f32_fp8(w, false), hi = __builtin_amdgcn_cvt_pk_f32_fp8(w, true);
    s2 = __builtin_elementwise_fma(lo, h01, s2); s2 = __builtin_elementwise_fma(hi, h23, s2);
}
DI float row_dot8p(const u32x4& r, const f2_t (&h)[8]) {
    f2_t s2 = {0.f, 0.f};
    dot4p(r.x, h[0], h[1], s2); dot4p(r.y, h[2], h[3], s2); dot4p(r.z, h[4], h[5], s2); dot4p(r.w, h[6], h[7], s2);
    return s2.x + s2.y;
}
DI void axpy4p(unsigned w, const f2_t& c2, f2_t& a01, f2_t& a23) {
    const f2_t lo = __builtin_amdgcn_cvt_pk_f32_fp8(w, false), hi = __builtin_amdgcn_cvt_pk_f32_fp8(w, true);
    a01 = __builtin_elementwise_fma(c2, lo, a01); a23 = __builtin_elementwise_fma(c2, hi, a23);
}
DI void row_axpy8p(f2_t (&acc)[8], const u32x4& r, float c) {
    const f2_t c2 = {c, c};
    axpy4p(r.x, c2, acc[0], acc[1]); axpy4p(r.y, c2, acc[2], acc[3]); axpy4p(r.z, c2, acc[4], acc[5]); axpy4p(r.w, c2, acc[6], acc[7]);
}

DI int run_token(int n, int k, int nloc, int wid) { return (k + (n >> 3) * nloc) * 64 + wid * 8 + (n & 7); }

struct Ids16 { u32x4 a, b, c, d; };
DI void ids_load(Ids16& q, const int* EX, int tok, int rg) { const u32x4* p = (const u32x4*)(EX + (size_t)tok * 128 + rg * 16); q.a = p[0]; q.b = p[1]; q.c = p[2]; q.d = p[3]; }
DI void rows_lo(u32x4 (&r)[8], const Ids16& q, const fp8_t* tab, unsigned loff) {
    r[0] = *(grow_t)(tab + (q.a.x * 128u + loff)); r[1] = *(grow_t)(tab + (q.a.y * 128u + loff)); r[2] = *(grow_t)(tab + (q.a.z * 128u + loff)); r[3] = *(grow_t)(tab + (q.a.w * 128u + loff));
    r[4] = *(grow_t)(tab + (q.b.x * 128u + loff)); r[5] = *(grow_t)(tab + (q.b.y * 128u + loff)); r[6] = *(grow_t)(tab + (q.b.z * 128u + loff)); r[7] = *(grow_t)(tab + (q.b.w * 128u + loff));
}
DI void rows_hi(u32x4 (&r)[8], const Ids16& q, const fp8_t* tab, unsigned loff) {
    r[0] = *(grow_t)(tab + (q.c.x * 128u + loff)); r[1] = *(grow_t)(tab + (q.c.y * 128u + loff)); r[2] = *(grow_t)(tab + (q.c.z * 128u + loff)); r[3] = *(grow_t)(tab + (q.c.w * 128u + loff));
    r[4] = *(grow_t)(tab + (q.d.x * 128u + loff)); r[5] = *(grow_t)(tab + (q.d.y * 128u + loff)); r[6] = *(grow_t)(tab + (q.d.z * 128u + loff)); r[7] = *(grow_t)(tab + (q.d.w * 128u + loff));
}
DI void unpack_h(f2_t (&h)[8], const u32x4& h0, const u32x4& h1) {
    h[0] = (f2_t){bf_lo(h0.x), bf_hi(h0.x)}; h[1] = (f2_t){bf_lo(h0.y), bf_hi(h0.y)}; h[2] = (f2_t){bf_lo(h0.z), bf_hi(h0.z)}; h[3] = (f2_t){bf_lo(h0.w), bf_hi(h0.w)};
    h[4] = (f2_t){bf_lo(h1.x), bf_hi(h1.x)}; h[5] = (f2_t){bf_lo(h1.y), bf_hi(h1.y)}; h[6] = (f2_t){bf_lo(h1.z), bf_hi(h1.z)}; h[7] = (f2_t){bf_lo(h1.w), bf_hi(h1.w)};
}
DI void dots8(float* p, const u32x4 (&r)[8], const f2_t (&h)[8]) {
#pragma unroll
    for (int i = 0; i < 8; ++i) { p[i] = row_dot8p(r[i], h); if ((i & 1) == 1) __builtin_amdgcn_sched_barrier(0); }
}
DI void peerU_finish(const PSArgs& a, float (&p)[16], int tok, int s, int lane) {
    const int rg = lane >> 3, pc = lane & 7;
    const bool b2 = pc & 4, b1 = pc & 2, b0 = pc & 1;
    float q8[8], q4[4], q2[2];
#pragma unroll
    for (int k = 0; k < 8; ++k) { const float keep = b2 ? p[k + 8] : p[k], send = b2 ? p[k] : p[k + 8]; q8[k] = keep + shx<4>(send, lane); }
#pragma unroll
    for (int k = 0; k < 4; ++k) { const float keep = b1 ? q8[k + 4] : q8[k], send = b1 ? q8[k] : q8[k + 4]; q4[k] = keep + shx<2>(send, lane); }
#pragma unroll
    for (int k = 0; k < 2; ++k) { const float keep = b0 ? q4[k + 2] : q4[k], send = b0 ? q4[k] : q4[k + 2]; q2[k] = keep + shx<1>(send, lane); }
    *(float2*)(a.PD + ((size_t)s * NTOK + tok) * 128 + rg * 16 + 2 * pc) = make_float2(q2[0], q2[1]);
}

DI void peerU_run(const PSArgs& a, int s, int k, int nloc, int wid) {
    const int tid = get_tid(wid);
    const int lane = tid & 63, rg = lane >> 3, pc = lane & 7;
    const unsigned loff = (unsigned)(s * (NEXP * 128) + pc * 16);
    const int hoff = s * 128 + pc * 16;
    const int N = 8 * ((NTOK / 64 - k + nloc - 1) / nloc);
    Ids16 idE, idO;
    u32x4 rA[8], rB[8], hE0, hE1, hO0, hO1;
#define LOAD_H(d0, d1, tokv) { const u32x4* hp_ = (const u32x4*)(a.Hb + (size_t)(tokv) * DM + hoff); d0 = hp_[0]; d1 = hp_[1]; }
    ids_load(idE, a.EX, run_token(0, k, nloc, wid), rg);
    ids_load(idO, a.EX, run_token(1, k, nloc, wid), rg);
    rows_lo(rA, idE, a.U8, loff); LOAD_H(hE0, hE1, run_token(0, k, nloc, wid)); rows_hi(rB, idE, a.U8, loff);
#pragma unroll 1
    for (int n = 0; n < N; n += 2) {
        const int t0 = run_token(n, k, nloc, wid), t1 = run_token(n + 1, k, nloc, wid);
        const int t2 = run_token((n + 2 < N) ? n + 2 : N - 1, k, nloc, wid), t3 = run_token((n + 3 < N) ? n + 3 : N - 1, k, nloc, wid);
        {
            f2_t h[8]; float p[16];
            unpack_h(h, hE0, hE1);
            dots8(p, rA, h);
            rows_lo(rA, idO, a.U8, loff); LOAD_H(hO0, hO1, t1);
            dots8(p + 8, rB, h);
            rows_hi(rB, idO, a.U8, loff);
            ids_load(idE, a.EX, t2, rg);
            peerU_finish(a, p, t0, s, lane);
        }
        {
            f2_t h[8]; float p[16];
            unpack_h(h, hO0, hO1);
            dots8(p, rA, h);
            rows_lo(rA, idE, a.U8, loff); LOAD_H(hE0, hE1, t2);
            dots8(p + 8, rB, h);
            rows_hi(rB, idE, a.U8, loff);
            ids_load(idO, a.EX, t3, rg);
            peerU_finish(a, p, t1, s, lane);
        }
    }
#undef LOAD_H
}

DI void peerR_tile(const PSArgs& a, int tile, int wid) {
    const int tid = get_tid(wid);
    const int lane = tid & 63;
#pragma unroll 1
    for (int ti = 0; ti < 8; ++ti) {
        const int tok = tile * 64 + wid * 8 + ti;
        float d0 = 0.f, d1 = 0.f;
#pragma unroll
        for (int x = 0; x < 8; ++x) { const float2 v = *(const float2*)(a.PD + ((size_t)x * NTOK + tok) * 128 + 2 * lane); d0 += v.x; d1 += v.y; }
        const int2 ex = *(const int2*)(a.EX + (size_t)tok * 128 + 2 * lane);
        const float2 gt = *(const float2*)(a.GT + (size_t)tok * 128 + 2 * lane);
        const float rs = a.RSTD[tok];
        float2 o;
        o.x = gelu_exact(d0 * a.SU[ex.x] * rs) * gt.x * a.SV[ex.x];
        o.y = gelu_exact(d1 * a.SU[ex.y] * rs) * gt.y * a.SV[ex.y];
        *(float2*)(a.COEF + (size_t)tok * 128 + 2 * lane) = o;
    }
}

struct Cf16 { f32x4 a, b, c, d; };
DI void cf_load(Cf16& q, const float* COEF, int tok, int rg) { const f32x4* p = (const f32x4*)(COEF + (size_t)tok * 128 + rg * 16); q.a = p[0]; q.b = p[1]; q.c = p[2]; q.d = p[3]; }
DI void axpy8(f2_t (&acc)[8], const u32x4 (&r)[8], const f32x4& c0, const f32x4& c1) {
    row_axpy8p(acc, r[0], c0.x); row_axpy8p(acc, r[1], c0.y); __builtin_amdgcn_sched_barrier(0);
    row_axpy8p(acc, r[2], c0.z); row_axpy8p(acc, r[3], c0.w); __builtin_amdgcn_sched_barrier(0);
    row_axpy8p(acc, r[4], c1.x); row_axpy8p(acc, r[5], c1.y); __builtin_amdgcn_sched_barrier(0);
    row_axpy8p(acc, r[6], c1.z); row_axpy8p(acc, r[7], c1.w); __builtin_amdgcn_sched_barrier(0);
}
DI void peerV_finish(const PSArgs& a, f2_t (&acc)[8], float2 xv, int tok, int s, int lane) {
    const int rg = lane >> 3, pc = lane & 7;
    const bool r2 = rg & 4, r1 = rg & 2, r0 = rg & 1;
    f2_t q4[4], q2[2], q1;
#pragma unroll
    for (int k = 0; k < 4; ++k) {
        const f2_t keep = r2 ? acc[k + 4] : acc[k], send = r2 ? acc[k] : acc[k + 4];
        q4[k] = (f2_t){keep.x + shx<32>(send.x, lane), keep.y + shx<32>(send.y, lane)};
    }
#pragma unroll
    for (int k = 0; k < 2; ++k) {
        const f2_t keep = r1 ? q4[k + 2] : q4[k], send = r1 ? q4[k] : q4[k + 2];
        q2[k] = (f2_t){keep.x + shx<16>(send.x, lane), keep.y + shx<16>(send.y, lane)};
    }
    {
        const f2_t keep = r0 ? q2[1] : q2[0], send = r0 ? q2[0] : q2[1];
        q1 = (f2_t){keep.x + shx<8>(send.x, lane), keep.y + shx<8>(send.y, lane)};
    }
    xv.x += q1.x; xv.y += q1.y;
    *(float2*)(a.Xout + (size_t)tok * DM + s * 128 + 16 * pc + 2 * rg) = xv;
}

DI void peerV_run(const PSArgs& a, int s, int k, int nloc, int wid) {
    const int tid = get_tid(wid);
    const int lane = tid & 63, rg = lane >> 3, pc = lane & 7;
    const unsigned loff = (unsigned)(s * (NEXP * 128) + pc * 16);
    const int N = 8 * ((NTOK / 64 - k + nloc - 1) / nloc);
    Ids16 idE, idO; Cf16 cfE, cfO; float2 xE, xO;
    u32x4 rA[8], rB[8];
#define LOAD_X(x_, tokv) { x_ = *(const float2*)(a.Xin + (size_t)(tokv) * DM + s * 128 + 16 * pc + 2 * rg); }
    ids_load(idE, a.EX, run_token(0, k, nloc, wid), rg);
    ids_load(idO, a.EX, run_token(1, k, nloc, wid), rg);
    rows_lo(rA, idE, a.V8, loff); cf_load(cfE, a.COEF, run_token(0, k, nloc, wid), rg); rows_hi(rB, idE, a.V8, loff); LOAD_X(xE, run_token(0, k, nloc, wid));
#pragma unroll 1
    for (int n = 0; n < N; n += 2) {
        const int t0 = run_token(n, k, nloc, wid), t1 = run_token(n + 1, k, nloc, wid);
        const int t2 = run_token((n + 2 < N) ? n + 2 : N - 1, k, nloc, wid), t3 = run_token((n + 3 < N) ? n + 3 : N - 1, k, nloc, wid);
        {
            f2_t acc[8];
#pragma unroll
            for (int i = 0; i < 8; ++i) acc[i] = (f2_t){0.f, 0.f};
            axpy8(acc, rA, cfE.a, cfE.b);
            rows_lo(rA, idO, a.V8, loff); cf_load(cfO, a.COEF, t1, rg);
            axpy8(acc, rB, cfE.c, cfE.d);
            rows_hi(rB, idO, a.V8, loff); LOAD_X(xO, t1);
            ids_load(idE, a.EX, t2, rg);
            peerV_finish(a, acc, xE, t0, s, lane);
        }
        {
            f2_t acc[8];
#pragma unroll
            for (int i = 0; i < 8; ++i) acc[i] = (f2_t){0.f, 0.f};
            axpy8(acc, rA, cfO.a, cfO.b);
            rows_lo(rA, idE, a.V8, loff); cf_load(cfE, a.COEF, t2, rg);
            axpy8(acc, rB, cfO.c, cfO.d);
            rows_hi(rB, idE, a.V8, loff); LOAD_X(xE, t2);
            ids_load(idO, a.EX, t3, rg);
            peerV_finish(a, acc, xO, t1, s, lane);
        }
    }
#undef LOAD_X
}

DI void final_norm_tile(float* X, const float* __restrict__ g, int tile, int wid) {
    const int tid = get_tid(wid);
    const int lane = tid & 63;
    const float* gf = g + lane * 16;
    const float4 g0 = *(const float4*)gf, g1 = *(const float4*)(gf + 4), g2 = *(const float4*)(gf + 8), g3 = *(const float4*)(gf + 12);
#pragma unroll 1
    for (int ti = 0; ti < 8; ++ti) {
        float* xp = X + (size_t)(tile * 64 + wid * 8 + ti) * DM + lane * 16;
        float4 x0 = *(const float4*)xp, x1 = *(const float4*)(xp + 4), x2 = *(const float4*)(xp + 8), x3 = *(const float4*)(xp + 12);
        float ss = x0.x * x0.x + x0.y * x0.y + x0.z * x0.z + x0.w * x0.w + x1.x * x1.x + x1.y * x1.y + x1.z * x1.z + x1.w * x1.w
                 + x2.x * x2.x + x2.y * x2.y + x2.z * x2.z + x2.w * x2.w + x3.x * x3.x + x3.y * x3.y + x3.z * x3.z + x3.w * x3.w;
        ss = wave_sum(ss, lane);
        const float rf = rsqrtf(ss * (1.f / 1024.f) + 1e-6f);
        x0.x *= rf * g0.x; x0.y *= rf * g0.y; x0.z *= rf * g0.z; x0.w *= rf * g0.w; x1.x *= rf * g1.x; x1.y *= rf * g1.y; x1.z *= rf * g1.z; x1.w *= rf * g1.w;
        x2.x *= rf * g2.x; x2.y *= rf * g2.y; x2.z *= rf * g2.z; x2.w *= rf * g2.w; x3.x *= rf * g3.x; x3.y *= rf * g3.y; x3.z *= rf * g3.z; x3.w *= rf * g3.w;
        *(float4*)xp = x0; *(float4*)(xp + 4) = x1; *(float4*)(xp + 8) = x2; *(float4*)(xp + 12) = x3;
    }
}
struct MegaArgs {
    const float* x; const float* a_re; const float* a_im; const float* log_dt; const float* b_re; const float* b_im; const float* c_re;
    const float* c_im; const float* d_skip; const float* b_glu; const float* pool_scale; const float* u_exp; const float* v_exp;
    const float* norm_final;
    PrepW pw;
    float* X; bf16_t* U; bf16_t* YPRE; bf16_t* G1; bf16_t* A2; bf16_t* Hb; bf16_t* Qb; int* EX; float* GT; float* RSTD;
    char* KT; bf16x8* WST; bf16x8* CCAR; float* ABT; fp8_t* U8; fp8_t* V8; float* SU; float* SV; float* PD; float* COEF;
    unsigned* bar;
};

#ifndef REP_P0
#define REP_P0 1
#endif
#ifndef REP_PA
#define REP_PA 1
#endif
#ifndef REP_PB
#define REP_PB 1
#endif
#ifndef REP_C1
#define REP_C1 1
#endif
#ifndef REP_C2
#define REP_C2 1
#endif
#ifndef REP_C3
#define REP_C3 1
#endif
__global__ void __launch_bounds__(NTHR) mega_kernel(MegaArgs a) {
    __shared__ __attribute__((aligned(16))) char smem[PB_BYTES];
    __shared__ uint4 xb_words;
    cg::grid_group grid = cg::this_grid();
    const int nblk = gridDim.x;
    const int wid = __builtin_amdgcn_readfirstlane(threadIdx.x >> 6);
    if (get_tid(wid) == 0) xb_words = make_uint4(0u, 0u, 0u, 0u);
    __syncthreads();
    const XcdBarrier xb = xcd_barrier_post(a.bar, (volatile LAS unsigned*)&xb_words, get_tid(wid));
    for (int rep = 0; rep < REP_P0; ++rep) {
        const size_t gtid = (size_t)blockIdx.x * NTHR + get_tid(wid), gs = (size_t)nblk * NTHR;
        for (int lg = blockIdx.x; lg < 64; lg += nblk)
            prep_s5_item(lg, a.a_re, a.a_im, a.log_dt, a.b_re, a.b_im, a.c_re, a.c_im, a.d_skip, a.KT, a.WST, a.CCAR, a.ABT, smem, wid);
        prep_weights(a.pw, gtid, gs);
        {
            int tid = get_tid(wid);
            const int gwave = blockIdx.x * 8 + (tid >> 6), nwaves = nblk * 8, lane = tid & 63;
#pragma unroll 1
            for (int l = 0; l < 2; ++l) {
                conv_rows_fp8(a.u_exp + (size_t)l * NEXP * DM, a.pw.norm_ffn + l * DM, a.U8 + (size_t)l * NEXP * DM, a.SU + l * NEXP, NEXP, gwave, nwaves, lane);
                conv_rows_fp8(a.v_exp + (size_t)l * NEXP * DM, nullptr, a.V8 + (size_t)l * NEXP * DM, a.SV + l * NEXP, NEXP, gwave, nwaves, lane);
            }
        }
    }
    grid.sync();
    __shared__ int sched[4];
    if (get_tid(wid) == 0) {
        int nx = 0, myj = 0, nloc = 1;
        for (unsigned j = 0; j < 16; ++j) {
            const unsigned cj = xb_ld(&a.bar[XB_XCNT(j)]);
            if (j == xb.x) { myj = nx; nloc = (int)cj; }
            nx += (cj > 0u) ? 1 : 0;
        }
        sched[0] = (int)xb.st[2]; sched[1] = nloc > 0 ? nloc : 1; sched[2] = myj; sched[3] = nx > 0 ? nx : 1;
    }
    __syncthreads();
    const int s_rank = sched[0], s_nloc = sched[1], s_myj = sched[2], s_nx = sched[3];
#pragma unroll 1
    for (int l = 0; l < 2; ++l) {
        const float* xin = (l == 0) ? a.x : a.X;
        if (l == 0) {
            for (int rep = 0; rep < REP_PA; ++rep)
            for (int tile = blockIdx.x; tile < NTOK / 64; tile += nblk) phaseA_tile(xin, a.pw.wfin, a.U, tile, smem, wid);
        }
        xcd_barrier(xb, wid);
        bf16_t* Ul = a.U + (size_t)l * NTOK * DM;
        for (int rep = 0; rep < REP_PB; ++rep)
        for (int tile = blockIdx.x; tile < 256; tile += nblk)
            phaseB_tile(Ul, a.KT + (size_t)l * 32 * KT_BYTES, a.WST + (size_t)l * 32 * WST_FRAGS, a.CCAR + (size_t)l * 32 * CCAR_FRAGS, a.ABT + l * 32 * 128, a.YPRE, tile, smem, wid);
        xcd_barrier(xb, wid);
        PCArgs pa; pa.U = Ul; pa.YPRE = a.YPRE; pa.G1 = a.G1; pa.A2 = a.A2; pa.Xin = xin; pa.Xout = a.X; pa.Hb = a.Hb; pa.RSTD = a.RSTD;
        pa.wfglu = a.pw.wfglu + (size_t)l * (512 * 512 / 8); pa.b_glu = a.b_glu + l * 512; pa.wfpool = a.pw.wfpool + (size_t)l * 4 * (128 * 128 / 8);
        pa.pool_scale = a.pool_scale + l * 512; pa.wfout = a.pw.wfout + (size_t)l * (DM * DM / 8);
        PRArgs pr; pr.Hb = a.Hb; pr.RSTD = a.RSTD; pr.Qb = a.Qb; pr.wfq = a.pw.wfq + (size_t)l * (DM * 2048 / 8); pr.wfk1 = a.pw.wfk1 + (size_t)l * (128 * 128 / 8);
        pr.wfk2 = a.pw.wfk2 + (size_t)l * (128 * 128 / 8); pr.EX = a.EX; pr.GT = a.GT;
        for (int tile = blockIdx.x; tile < NTOK / 64; tile += nblk) {
            phaseC1_tile(pa, tile, smem, wid);
            phaseC2_tile(pr, tile, smem, wid);
        }
        xcd_barrier(xb, wid);
        PSArgs ps; ps.Hb = a.Hb; ps.RSTD = a.RSTD; ps.EX = a.EX; ps.GT = a.GT; ps.U8 = a.U8 + (size_t)l * NEXP * DM; ps.V8 = a.V8 + (size_t)l * NEXP * DM;
        ps.SU = a.SU + l * NEXP; ps.SV = a.SV + l * NEXP; ps.PD = a.PD; ps.COEF = a.COEF; ps.Xin = a.X; ps.Xout = a.X;
        for (int s = s_myj; s < 8; s += s_nx) peerU_run(ps, s, s_rank, s_nloc, wid);
        xcd_barrier(xb, wid);
        for (int tile = blockIdx.x; tile < NTOK / 64; tile += nblk) peerR_tile(ps, tile, wid);
        xcd_barrier(xb, wid);
        for (int s = s_myj; s < 8; s += s_nx) peerV_run(ps, s, s_rank, s_nloc, wid);
        xcd_barrier(xb, wid);
        if (l == 0) {
            for (int tile = blockIdx.x; tile < NTOK / 64; tile += nblk) phaseA_tile(a.X, a.pw.wfin + (size_t)(DM * DM / 8), a.U + (size_t)NTOK * DM, tile, smem, wid);
        } else {
            for (int tile = blockIdx.x; tile < NTOK / 64; tile += nblk) final_norm_tile(a.X, a.norm_final, tile, wid);
        }
    }
}

extern "C" void kernel_launch(void* const* d_in, const int* in_sizes, int n_in, void* d_out, int out_size, void* d_ws, size_t ws_size,
                              hipStream_t stream) {
    char* wsb = (char*)d_ws;
    size_t off = 0;
    auto take = [&](size_t bytes) { char* p = wsb + off; off += (bytes + 255) & ~(size_t)255; return p; };
    MegaArgs a;
    memset(&a, 0, sizeof(a));
    a.x = (const float*)d_in[0];
    a.pw.norm_mix = (const float*)d_in[1]; a.pw.w_in = (const float*)d_in[2];
    a.a_re = (const float*)d_in[3]; a.a_im = (const float*)d_in[4]; a.log_dt = (const float*)d_in[5];
    a.b_re = (const float*)d_in[6]; a.b_im = (const float*)d_in[7]; a.c_re = (const float*)d_in[8]; a.c_im = (const float*)d_in[9];
    a.d_skip = (const float*)d_in[10]; a.pw.w_glu = (const float*)d_in[11]; a.b_glu = (const float*)d_in[12];
    a.pw.w_pool = (const float*)d_in[13]; a.pool_scale = (const float*)d_in[14]; a.pw.g_out_ssm = (const float*)d_in[15];
    a.pw.g_out_pool = (const float*)d_in[16]; a.pw.w_out = (const float*)d_in[17]; a.pw.norm_ffn = (const float*)d_in[18];
    a.pw.w_q = (const float*)d_in[19]; a.pw.k1 = (const float*)d_in[20]; a.pw.k2 = (const float*)d_in[21];
    a.u_exp = (const float*)d_in[22]; a.v_exp = (const float*)d_in[23]; a.norm_final = (const float*)d_in[24];
    a.X = (float*)d_out;
    a.U = (bf16_t*)take((size_t)2 * NTOK * DM * 2);
    a.YPRE = (bf16_t*)take((size_t)NTOK * 512 * 2);
    a.G1 = (bf16_t*)take((size_t)NTOK * 512 * 2);
    a.A2 = (bf16_t*)take((size_t)NTOK * DM * 2);
    a.Hb = (bf16_t*)take((size_t)NTOK * DM * 2);
    a.Qb = (bf16_t*)take((size_t)NTOK * 2048 * 2);
    a.EX = (int*)take((size_t)NTOK * 128 * 4);
    a.GT = (float*)take((size_t)NTOK * 128 * 4);
    a.RSTD = (float*)take(NTOK * 4);
    a.pw.wfin = (bf16x8*)take((size_t)2 * DM * DM * 2);
    a.pw.wfglu = (bf16x8*)take((size_t)2 * 512 * 512 * 2);
    a.pw.wfpool = (bf16x8*)take((size_t)2 * 4 * 128 * 128 * 2);
    a.pw.wfout = (bf16x8*)take((size_t)2 * DM * DM * 2);
    a.pw.wfq = (bf16x8*)take((size_t)2 * DM * 2048 * 2);
    a.pw.wfk1 = (bf16x8*)take((size_t)2 * 128 * 128 * 2);
    a.pw.wfk2 = (bf16x8*)take((size_t)2 * 128 * 128 * 2);
    a.KT = take((size_t)64 * KT_BYTES);
    a.WST = (bf16x8*)take((size_t)64 * WST_FRAGS * 16);
    a.CCAR = (bf16x8*)take((size_t)64 * CCAR_FRAGS * 16);
    a.ABT = (float*)take(64 * 128 * 4);
    a.U8 = (fp8_t*)take((size_t)2 * NEXP * DM);
    a.V8 = (fp8_t*)take((size_t)2 * NEXP * DM);
    a.SU = (float*)take((size_t)2 * NEXP * 4);
    a.SV = (float*)take((size_t)2 * NEXP * 4);
    a.PD = (float*)take((size_t)8 * NTOK * 128 * 4);
    a.COEF = (float*)take((size_t)NTOK * 128 * 4);
    a.bar = (unsigned*)take((size_t)XCD_BAR_WORDS * 4);
    hipMemsetAsync(a.bar, 0, (size_t)XCD_BAR_WORDS * 4, stream);

    static int grid_blocks = 0;
    if (!grid_blocks) {
        int dev = 0, cus = 0, per_cu = 0;
        hipGetDevice(&dev);
        hipDeviceGetAttribute(&cus, hipDeviceAttributeMultiprocessorCount, dev);
        hipOccupancyMaxActiveBlocksPerMultiprocessor(&per_cu, mega_kernel, NTHR, 0);
        if (per_cu > 1) per_cu = 1;
        grid_blocks = cus * per_cu;
        if (grid_blocks > 256) grid_blocks = 256;
    }
    void* args[] = {&a};
    hipError_t e = hipLaunchCooperativeKernel((void*)mega_kernel, dim3(grid_blocks), dim3(NTHR), args, 0, stream);
    if (e != hipSuccess) fprintf(stderr, "cooperative launch failed: %s (grid %d)\n", hipGetErrorString(e), grid_blocks);
}
```

```cpp
#include <hip/hip_runtime.h>
#include <hip/hip_cooperative_groups.h>
#include <cstdio>
#include <cstring>
namespace cg = cooperative_groups;
#include <math.h>
#include <stdint.h>

#define NTOK 16384
#define SEQ 2048
#define DM 1024
#define SSMW 512
#define NEXP 16384

__device__ __forceinline__ float gelu_exact(float x) { return 0.5f * x * (1.f + erff(x * 0.70710678118654752f)); }

template <int M> __device__ __forceinline__ int shx_i(int v, int lane) {
    if constexpr (M == 1) return __builtin_amdgcn_mov_dpp(v, 0xB1, 0xF, 0xF, true);
    else if constexpr (M == 2) return __builtin_amdgcn_mov_dpp(v, 0x4E, 0xF, 0xF, true);
    else if constexpr (M < 32) return __builtin_amdgcn_ds_swizzle(v, (M << 10) | 0x1F);
    else return __builtin_amdgcn_ds_bpermute((lane ^ 32) << 2, v);
}
template <int M> __device__ __forceinline__ float shx(float v, int lane) { return __int_as_float(shx_i<M>(__float_as_int(v), lane)); }
__device__ __forceinline__ float wave_sum(float v, int lane) {
    v += shx<1>(v, lane); v += shx<2>(v, lane); v += shx<4>(v, lane); v += shx<8>(v, lane); v += shx<16>(v, lane); v += shx<32>(v, lane);
    return v;
}

__device__ __forceinline__ int get_tid(int wid) {
    int t = wid * 64 + (int)__builtin_amdgcn_mbcnt_hi(~0u, __builtin_amdgcn_mbcnt_lo(~0u, 0u));
    asm volatile("" : "+v"(t));
    return t;
}

#define DI __device__ __forceinline__
typedef __attribute__((ext_vector_type(8))) short bf16x8;
typedef __attribute__((ext_vector_type(16))) float f32x16;
typedef __attribute__((ext_vector_type(2))) __bf16 bf2_t;
typedef __attribute__((ext_vector_type(2))) float f2_t;
typedef unsigned short bf16_t;
typedef __attribute__((ext_vector_type(4))) unsigned u32x4;
typedef __attribute__((ext_vector_type(4))) float f32x4;
typedef const __attribute__((address_space(1))) bf16x8* gwp_t;
#define MFMA32(a, b, c) __builtin_amdgcn_mfma_f32_32x32x16_bf16((a), (b), (c), 0, 0, 0)

DI unsigned pack_bf2(float a, float b) { f2_t v = {a, b}; return __builtin_bit_cast(unsigned, __builtin_convertvector(v, bf2_t)); }
DI float bf_lo(unsigned u) { return __uint_as_float(u << 16); }
DI float bf_hi(unsigned u) { return __uint_as_float(u & 0xffff0000u); }
DI int crow(int reg, int h) { return (reg & 3) + 8 * (reg >> 2) + 4 * h; }

#define SA_STRIDE 272
#define SA_BYTES (64 * SA_STRIDE)
#define NTHR 512

template <bool GAIN>
DI void conv_wfrag(const float* __restrict__ src, int ldk, int ldn, const float* __restrict__ ga, const float* __restrict__ gb, int split,
                   int K, int N, int NTG, bf16x8* __restrict__ dst, size_t gtid, size_t gstride) {
    const int KS = K / 16;
    const size_t total = (size_t)(N / 32) * KS * 64;
    for (size_t item = gtid; item < total; item += gstride) {
        const int lane = (int)(item & 63); const size_t f = item >> 6;
        const int nti = (int)(f % NTG); const size_t f2 = f / NTG;
        const int ks = (int)(f2 % KS), nt = (int)(f2 / KS) * NTG + nti;
        const int r = lane & 31, h = lane >> 5;
        const int n = nt * 32 + r, k0 = ks * 16 + 8 * h;
        float v[8];
#pragma unroll
        for (int j = 0; j < 8; ++j) {
            const int k = k0 + j;
            float g = 1.f;
            if (GAIN) g = (k < split) ? ga[k] : gb[k - split];
            v[j] = src[(size_t)k * ldk + (size_t)n * ldn] * g;
        }
        uint4 o; o.x = pack_bf2(v[0], v[1]); o.y = pack_bf2(v[2], v[3]); o.z = pack_bf2(v[4], v[5]); o.w = pack_bf2(v[6], v[7]);
        *(uint4*)(dst + item) = o;
    }
}

DI void conv_rows_bf16(const float* __restrict__ src, const float* __restrict__ gain, bf16_t* __restrict__ dst, size_t nelem, size_t gtid, size_t gstride) {
    for (size_t i = gtid * 8; i < nelem; i += gstride * 8) {
        float4 a = *(const float4*)(src + i), b = *(const float4*)(src + i + 4);
        if (gain) {
            const int c = (int)(i & 1023);
            float4 g0 = *(const float4*)(gain + c), g1 = *(const float4*)(gain + c + 4);
            a.x *= g0.x; a.y *= g0.y; a.z *= g0.z; a.w *= g0.w; b.x *= g1.x; b.y *= g1.y; b.z *= g1.z; b.w *= g1.w;
        }
        uint4 o; o.x = pack_bf2(a.x, a.y); o.y = pack_bf2(a.z, a.w); o.z = pack_bf2(b.x, b.y); o.w = pack_bf2(b.z, b.w);
        *(uint4*)(dst + i) = o;
    }
}

struct ALoadF32 {
    const float* base; f32x4 v0, v1, v2, v3; float ss; int dofs;
    DI void init(const float* rowbase, int tid) { base = rowbase + (tid & 7) * 16; ss = 0.f; dofs = (tid >> 3) * SA_STRIDE + (tid & 7) * 32; }
    DI void issue(int c) { const f32x4* p = (const f32x4*)(base + c * 128); v0 = p[0]; v1 = p[1]; v2 = p[2]; v3 = p[3]; }
    DI void commit(char* buf) {
        u32x4 o0, o1;
        ss += v0.x * v0.x + v0.y * v0.y + v0.z * v0.z + v0.w * v0.w + v1.x * v1.x + v1.y * v1.y + v1.z * v1.z + v1.w * v1.w
            + v2.x * v2.x + v2.y * v2.y + v2.z * v2.z + v2.w * v2.w + v3.x * v3.x + v3.y * v3.y + v3.z * v3.z + v3.w * v3.w;
        o0.x = pack_bf2(v0.x, v0.y); o0.y = pack_bf2(v0.z, v0.w); o0.z = pack_bf2(v1.x, v1.y); o0.w = pack_bf2(v1.z, v1.w);
        o1.x = pack_bf2(v2.x, v2.y); o1.y = pack_bf2(v2.z, v2.w); o1.z = pack_bf2(v3.x, v3.y); o1.w = pack_bf2(v3.z, v3.w);
        char* d = buf + dofs;
        *(u32x4*)d = o0; *(u32x4*)(d + 16) = o1;
    }
};
struct ALoadBF16 {
    const bf16_t* base; u32x4 v0, v1; int dofs;
    DI void init(const bf16_t* rowbase, int tid) { base = rowbase + (tid & 7) * 16; dofs = (tid >> 3) * SA_STRIDE + (tid & 7) * 32; }
    DI void issue(int c) { const u32x4* p = (const u32x4*)(base + c * 128); v0 = p[0]; v1 = p[1]; }
    DI void commit(char* buf) {
        char* d = buf + dofs;
        *(u32x4*)d = v0; *(u32x4*)(d + 16) = v1;
    }
};

template <int NT, int PF, class AL>
DI void gemm64(f32x16 (&acc)[NT][2], AL& al, const int nchunks, const bf16x8* __restrict__ wf_, char* sA, const int lane) {
    gwp_t wf = (gwp_t)wf_;
    const int r = lane & 31, h = lane >> 5;
    bf16x8 bq[PF][NT];
    al.issue(0);
#pragma unroll
    for (int p = 0; p < PF; ++p)
#pragma unroll
        for (int nt = 0; nt < NT; ++nt) bq[p][nt] = wf[(p * NT + nt) * 64];
    gwp_t wpf = wf + PF * NT * 64;
    al.commit(sA);
    const int kend = nchunks * 8 - PF;
    int kg = 0;
#pragma unroll 1
    for (int c = 0; c < nchunks; ++c) {
        if (c + 1 < nchunks) al.issue(c + 1);
        __syncthreads();
        const char* buf = sA + (c & 1) * SA_BYTES + r * SA_STRIDE + h * 16;
#pragma unroll
        for (int ks = 0; ks < 8; ++ks) {
            const bf16x8 a0 = *(const bf16x8*)(buf + ks * 32);
            const bf16x8 a1 = *(const bf16x8*)(buf + 32 * SA_STRIDE + ks * 32);
#pragma unroll
            for (int nt = 0; nt < NT; ++nt) {
                acc[nt][0] = MFMA32(bq[ks % PF][nt], a0, acc[nt][0]);
                acc[nt][1] = MFMA32(bq[ks % PF][nt], a1, acc[nt][1]);
            }
            if (kg < kend) {
#pragma unroll
                for (int nt = 0; nt < NT; ++nt) bq[ks % PF][nt] = wpf[nt * 64];
            }
            wpf += NT * 64; ++kg;
            asm volatile("" : "+v"(wpf));
        }
        if (c + 1 < nchunks) al.commit(sA + ((c + 1) & 1) * SA_BYTES);
    }
    __syncthreads();
}

template <int NT>
DI void zero_acc(f32x16 (&acc)[NT][2]) {
#pragma unroll
    for (int nt = 0; nt < NT; ++nt)
#pragma unroll
        for (int mt = 0; mt < 2; ++mt)
#pragma unroll
            for (int i = 0; i < 16; ++i) acc[nt][mt][i] = 0.f;
}


DI void tile_transpose(const f32x16& t, float* wscr, int lane, f32x4 (&out)[4]) {
    const int r = lane & 31, h = lane >> 5;
#pragma unroll
    for (int q = 0; q < 4; ++q) { f32x4 v = {t[4 * q], t[4 * q + 1], t[4 * q + 2], t[4 * q + 3]}; *(f32x4*)(wscr + r * 36 + 8 * q + 4 * h) = v; }
#pragma unroll
    for (int j = 0; j < 4; ++j) out[j] = *(const f32x4*)(wscr + ((lane >> 3) + 8 * j) * 36 + (lane & 7) * 4);
}
#define WSCR_BYTES (32 * 36 * 4)

DI void phaseA_tile(const float* __restrict__ X, const bf16x8* __restrict__ wfin, bf16_t* __restrict__ U, int tile, char* smem, int wid) {
    char* sA = smem; float* srstd = (float*)(smem + 8 * WSCR_BYTES);
    int tok0 = tile * 64; asm volatile("" : "+s"(tok0));
    int tid = get_tid(wid);
    const int w = __builtin_amdgcn_readfirstlane(tid >> 6), lane = tid & 63, r = lane & 31, h = lane >> 5;
    ALoadF32 al; al.init(X + (size_t)(tok0 + (tid >> 3)) * DM, tid);
    f32x16 acc[4][2]; zero_acc<4>(acc);
    gemm64<4, 2>(acc, al, 8, wfin + (size_t)w * (64 * 4 * 64) + lane, sA, lane);
    float ss = al.ss;
    ss += shx<1>(ss, lane); ss += shx<2>(ss, lane); ss += shx<4>(ss, lane);
    if ((tid & 7) == 0) srstd[tid >> 3] = rsqrtf(ss * (1.f / 1024.f) + 1e-6f);
    __syncthreads();
    {
        float* wscr = (float*)(smem + w * WSCR_BYTES);
        const int tl = lane >> 3, cl = (lane & 7) * 4;
#pragma unroll
        for (int mt = 0; mt < 2; ++mt) {
            float rs[4];
#pragma unroll
            for (int j = 0; j < 4; ++j) rs[j] = srstd[mt * 32 + tl + 8 * j];
#pragma unroll
            for (int nt = 0; nt < 4; ++nt) {
                f32x4 o[4]; tile_transpose(acc[nt][mt], wscr, lane, o);
#pragma unroll
                for (int j = 0; j < 4; ++j) {
                    uint2 p; p.x = pack_bf2(o[j].x * rs[j], o[j].y * rs[j]); p.y = pack_bf2(o[j].z * rs[j], o[j].w * rs[j]);
                    *(uint2*)(U + (size_t)(tok0 + mt * 32 + tl + 8 * j) * DM + w * 128 + nt * 32 + cl) = p;
                }
            }
        }
    }
    __syncthreads();
}

struct PrepW {
    const float* norm_mix; const float* w_in; const float* w_glu; const float* w_pool; const float* g_out_ssm; const float* g_out_pool;
    const float* w_out; const float* norm_ffn; const float* w_q; const float* k1; const float* k2;
    bf16x8* wfin; bf16x8* wfglu; bf16x8* wfpool; bf16x8* wfout; bf16x8* wfq; bf16x8* wfk1; bf16x8* wfk2;
};
DI void prep_weights(const PrepW& p, size_t gtid, size_t gs) {
#pragma unroll 1
    for (int l = 0; l < 2; ++l) {
        conv_wfrag<true>(p.w_in + (size_t)l * DM * DM, DM, 1, p.norm_mix + l * DM, p.norm_mix + l * DM, DM, DM, DM, 4, p.wfin + (size_t)l * (DM * DM / 8), gtid, gs);
        conv_wfrag<false>(p.w_glu + (size_t)l * 512 * 512, 512, 1, p.norm_mix, p.norm_mix, 512, 512, 512, 2, p.wfglu + (size_t)l * (512 * 512 / 8), gtid, gs);
#pragma unroll 1
        for (int gi = 0; gi < 4; ++gi)
            conv_wfrag<false>(p.w_pool + (size_t)(l * 4 + gi) * 128 * 128, 128, 1, p.norm_mix, p.norm_mix, 128, 128, 128, 2, p.wfpool + (size_t)(l * 4 + gi) * (128 * 128 / 8), gtid, gs);
        conv_wfrag<true>(p.w_out + (size_t)l * DM * DM, DM, 1, p.g_out_ssm + l * 512, p.g_out_pool + l * 512, 512, DM, DM, 4, p.wfout + (size_t)l * (DM * DM / 8), gtid, gs);
        conv_wfrag<true>(p.w_q + (size_t)l * DM * 2048, 2048, 1, p.norm_ffn + l * DM, p.norm_ffn + l * DM, DM, DM, 2048, 4, p.wfq + (size_t)l * (DM * 2048 / 8), gtid, gs);
        conv_wfrag<false>(p.k1 + (size_t)l * 128 * 128, 1, 128, p.norm_mix, p.norm_mix, 128, 128, 128, 4, p.wfk1 + (size_t)l * (128 * 128 / 8), gtid, gs);
        conv_wfrag<false>(p.k2 + (size_t)l * 128 * 128, 1, 128, p.norm_mix, p.norm_mix, 128, 128, 128, 4, p.wfk2 + (size_t)l * (128 * 128 / 8), gtid, gs);
    }
}
#define KT_BLK 528
#define KT_BYTES (65 * KT_BLK)
#define WST_FRAGS (4 * 64 * 64)
#define CCAR_FRAGS (32 * 8 * 64)
#define SU_CH 2064

DI void prep_s5_item(int lg, int part, const float* __restrict__ a_re, const float* __restrict__ a_im, const float* __restrict__ log_dt,
                     const float* __restrict__ b_re, const float* __restrict__ b_im, const float* __restrict__ c_re, const float* __restrict__ c_im,
                     const float* __restrict__ d_skip, char* __restrict__ KT, bf16x8* __restrict__ WST, bf16x8* __restrict__ CCAR,
                     float* __restrict__ ABT, char* smem, int wid) {
    float* powr = (float*)smem;
    float* powi = powr + 65 * 64;
    float* bzr = powi + 65 * 64;
    float* bzi = bzr + 1024;
    float* cr = bzi + 1024;
    float* ci = cr + 1024;
    int tid = get_tid(wid);
    const float* are_p = a_re + lg * 64; const float* aim_p = a_im + lg * 64;
    const float dt = expf(log_dt[lg]);
    for (int it = tid; it < 65 * 64; it += NTHR) {
        const int tau = it >> 6, p = it & 63;
        const float lre = are_p[p], lim = aim_p[p];
        const float mag = expf((float)tau * lre * dt);
        double rev = (double)lim * (double)dt * (double)tau * 0.15915494309189535;
        rev -= floor(rev);
        const float ang = (float)rev * 6.283185307179586f;
        powr[it] = mag * cosf(ang); powi[it] = mag * sinf(ang);
    }
    for (int it = tid; it < 1024; it += NTHR) {
        cr[it] = c_re[lg * 1024 + it]; ci[it] = c_im[lg * 1024 + it];
    }
    __syncthreads();
    for (int it = tid; it < 1024; it += NTHR) {
        const int p = it >> 4;
        const float lre = are_p[p], lim = aim_p[p];
        const float ar = powr[64 + p], ai = powi[64 + p];
        const float inv = 1.f / (lre * lre + lim * lim), nre = ar - 1.f;
        const float zre = (nre * lre + ai * lim) * inv, zim = (ai * lre - nre * lim) * inv;
        const float br = b_re[lg * 1024 + it], bi = b_im[lg * 1024 + it];
        bzr[it] = zre * br - zim * bi; bzi[it] = zre * bi + zim * br;
    }
    __syncthreads();
    if (part == 0 && tid < 64) { ABT[lg * 128 + 2 * tid] = powr[64 * 64 + tid]; ABT[lg * 128 + 2 * tid + 1] = powi[64 * 64 + tid]; }
    char* kt = KT + (size_t)lg * KT_BYTES;
    if (part == 0) for (int it = tid; it < KT_BLK / 4; it += NTHR) ((unsigned*)kt)[it] = 0u;
    for (int it = part * (16 * 128) + tid; it < (part + 1) * (16 * 128); it += NTHR) {
        const int tau = it >> 7, ho = (it >> 3) & 15, hi = (it & 7) * 2;
        float s0 = 0.f, s1 = 0.f;
        for (int p = 0; p < 64; ++p) {
            const float c_r = cr[ho * 64 + p], c_i = ci[ho * 64 + p], pr = powr[tau * 64 + p], pi = powi[tau * 64 + p];
            const float cpr = c_r * pr - c_i * pi, cpi = c_r * pi + c_i * pr;
            s0 += cpr * bzr[p * 16 + hi] - cpi * bzi[p * 16 + hi];
            s1 += cpr * bzr[p * 16 + hi + 1] - cpi * bzi[p * 16 + hi + 1];
        }
        if (tau == 0) { if (ho == hi) s0 += d_skip[lg * 16 + ho]; if (ho == hi + 1) s1 += d_skip[lg * 16 + ho]; }
        *(unsigned*)(kt + (tau + 1) * KT_BLK + ho * 32 + hi * 2) = pack_bf2(s0, s1);
    }
    if (part == 0) for (int it = tid; it < 65 * 4; it += NTHR) ((unsigned*)(kt + (it >> 2) * KT_BLK + 512))[it & 3] = 0u;
    bf16x8* wst = WST + (size_t)lg * WST_FRAGS;
    for (int it = part * (WST_FRAGS / 4) + tid; it < (part + 1) * (WST_FRAGS / 4); it += NTHR) {
        const int lane = it & 63, j = (it >> 6) & 63, nt = it >> 12;
        const int r = lane & 31, h = lane >> 5, n = nt * 32 + r, p = n & 63, im = n >> 6;
        const float pr = powr[(63 - j) * 64 + p], pi = powi[(63 - j) * 64 + p];
        float v[8];
#pragma unroll
        for (int jj = 0; jj < 8; ++jj) {
            const float zr = bzr[p * 16 + 8 * h + jj], zi = bzi[p * 16 + 8 * h + jj];
            v[jj] = im ? (pr * zi + pi * zr) : (pr * zr - pi * zi);
        }
        uint4 o; o.x = pack_bf2(v[0], v[1]); o.y = pack_bf2(v[2], v[3]); o.z = pack_bf2(v[4], v[5]); o.w = pack_bf2(v[6], v[7]);
        *(uint4*)(wst + it) = o;
    }
    bf16x8* cc = CCAR + (size_t)lg * CCAR_FRAGS;
    for (int it = part * (CCAR_FRAGS / 4) + tid; it < (part + 1) * (CCAR_FRAGS / 4); it += NTHR) {
        const int lane = it & 63, ks = (it >> 6) & 7, mt = it >> 9;
        const int r = lane & 31, h = lane >> 5, m = mt * 32 + r, i = m >> 4, ho = m & 15;
        float v[8];
#pragma unroll
        for (int jj = 0; jj < 8; ++jj) {
            const int k = ks * 16 + 8 * h + jj, p = k & 63, im = k >> 6;
            const float c_r = cr[ho * 64 + p], c_i = ci[ho * 64 + p], pr = powr[(i + 1) * 64 + p], pi = powi[(i + 1) * 64 + p];
            v[jj] = im ? -(c_r * pi + c_i * pr) : (c_r * pr - c_i * pi);
        }
        uint4 o; o.x = pack_bf2(v[0], v[1]); o.y = pack_bf2(v[2], v[3]); o.z = pack_bf2(v[4], v[5]); o.w = pack_bf2(v[6], v[7]);
        *(uint4*)(cc + it) = o;
    }
    __syncthreads();
}

#define PB_SU 0
#define PB_SKT (32 * SU_CH)
#define PB_SL (PB_SKT + KT_BYTES)
#define PB_SPART (PB_SL + 32 * 132 * 4)
#define PB_SSP (PB_SPART + 4 * 4096)
#define PB_BYTES (PB_SSP + 32 * 272)

DI void phaseB_tile(const bf16_t* __restrict__ U, const char* __restrict__ KT, const bf16x8* __restrict__ WST, const bf16x8* __restrict__ CCAR,
                    const float* __restrict__ ABT, bf16_t* __restrict__ YPRE, int tile, char* smem, int wid) {
    const int g = tile & 31, b = tile >> 5;
    int tid = get_tid(wid);
    const int w = __builtin_amdgcn_readfirstlane(tid >> 6), lane = tid & 63, r = lane & 31, h = lane >> 5;
    char* sU = smem + PB_SU; char* sKT = smem + PB_SKT; float* sL = (float*)(smem + PB_SL); float* sPart = (float*)(smem + PB_SPART);
    char* sSp = smem + PB_SSP;
#pragma unroll
    for (int it = 0; it < 4; ++it) {
        const int tok = tid + NTHR * it;
        const uint4* src = (const uint4*)(U + (size_t)(b * SEQ + tok) * DM + g * 16);
        const uint4 v0 = src[0], v1 = src[1];
        char* d = sU + (tok >> 6) * SU_CH + (tok & 63) * 32;
        *(uint4*)d = v0; *(uint4*)(d + 16) = v1;
    }
    {
        const uint4* src = (const uint4*)(KT + (size_t)g * KT_BYTES);
        for (int it = tid; it < KT_BYTES / 16; it += NTHR) ((uint4*)sKT)[it] = src[it];
    }
    __syncthreads();
    {
        const int nt = w & 3, kh = w >> 2;
        f32x16 acc;
#pragma unroll
        for (int i = 0; i < 16; ++i) acc[i] = 0.f;
        const bf16x8* wp = WST + (size_t)g * WST_FRAGS + (size_t)(nt * 64 + kh * 32) * 64 + lane;
        const char* up = sU + r * SU_CH + h * 16 + kh * 32 * 32;
#pragma unroll 4
        for (int j = 0; j < 32; ++j) {
            const bf16x8 a = wp[j * 64];
            const bf16x8 bb = *(const bf16x8*)(up + j * 32);
            acc = MFMA32(a, bb, acc);
        }
        if (kh == 1) {
#pragma unroll
            for (int i = 0; i < 16; ++i) sPart[(nt * 16 + i) * 64 + lane] = acc[i];
        }
        __syncthreads();
        if (kh == 0) {
#pragma unroll
            for (int i = 0; i < 16; ++i) sL[r * 132 + nt * 32 + crow(i, h)] = acc[i] + sPart[(nt * 16 + i) * 64 + lane];
        }
        __syncthreads();
    }
    if (tid < 64) {
        const int p = tid;
        const float ar = ABT[g * 128 + 2 * p], ai = ABT[g * 128 + 2 * p + 1];
        float sr = 0.f, si = 0.f;
        for (int c = 0; c < 32; ++c) {
            *(bf16_t*)(sSp + c * 272 + p * 2) = (bf16_t)(pack_bf2(sr, 0.f) & 0xffffu);
            *(bf16_t*)(sSp + c * 272 + (64 + p) * 2) = (bf16_t)(pack_bf2(si, 0.f) & 0xffffu);
            const float lr = sL[c * 132 + p], li = sL[c * 132 + 64 + p];
            const float nr = ar * sr - ai * si + lr, ni = ar * si + ai * sr + li;
            sr = nr; si = ni;
        }
    }
    f32x16 acc4[4];
#pragma unroll
    for (int q = 0; q < 4; ++q)
#pragma unroll
        for (int i = 0; i < 16; ++i) acc4[q][i] = 0.f;
    const int mts0 = w, mts1 = 15 - w, mts2 = 16 + w, mts3 = 31 - w;
    {
        const char* up = sU + r * SU_CH + h * 16;
        const char* kp = sKT + (r & 15) * 32 + h * 16 + ((r >> 4) + 1) * KT_BLK;
        for (int j = 0; j < 64; ++j) {
            const bf16x8 bb = *(const bf16x8*)(up + j * 32);
#define TOEP_STEP(q, mt) if (2 * (mt) + 1 >= j) { const bf16x8 a = *(const bf16x8*)(kp + (2 * (mt) - j) * KT_BLK); acc4[q] = MFMA32(a, bb, acc4[q]); }
            TOEP_STEP(0, mts0) TOEP_STEP(1, mts1) TOEP_STEP(2, mts2) TOEP_STEP(3, mts3)
#undef TOEP_STEP
        }
    }
    __syncthreads();
    {
        const bf16x8* cp = CCAR + (size_t)g * CCAR_FRAGS + lane;
        const char* sp = sSp + r * 272 + h * 16;
#pragma unroll
        for (int ks = 0; ks < 8; ++ks) {
            const bf16x8 bb = *(const bf16x8*)(sp + ks * 32);
            acc4[0] = MFMA32(cp[(mts0 * 8 + ks) * 64], bb, acc4[0]);
            acc4[1] = MFMA32(cp[(mts1 * 8 + ks) * 64], bb, acc4[1]);
            acc4[2] = MFMA32(cp[(mts2 * 8 + ks) * 64], bb, acc4[2]);
            acc4[3] = MFMA32(cp[(mts3 * 8 + ks) * 64], bb, acc4[3]);
        }
    }
    {
        bf16_t* ybase = YPRE + (size_t)(b * SEQ + r * 64) * 512 + g * 16;
#define PB_STORE(q, mt) _Pragma("unroll") for (int rq = 0; rq < 4; ++rq) { const int c0 = 8 * rq + 4 * h; const int i = 2 * (mt) + (c0 >> 4); \
            uint2 o; o.x = pack_bf2(acc4[q][4 * rq], acc4[q][4 * rq + 1]); o.y = pack_bf2(acc4[q][4 * rq + 2], acc4[q][4 * rq + 3]); \
            *(uint2*)(ybase + (size_t)i * 512 + (c0 & 15)) = o; }
        PB_STORE(0, mts0) PB_STORE(1, mts1) PB_STORE(2, mts2) PB_STORE(3, mts3)
#undef PB_STORE
    }
    __syncthreads();
}

#ifndef REP_GLU
#define REP_GLU 1
#endif
#ifndef REP_POOL
#define REP_POOL 1
#endif
#ifndef REP_OUT
#define REP_OUT 1
#endif
#ifndef REP_Q
#define REP_Q 1
#endif
#ifndef REP_SC
#define REP_SC 1
#endif
struct ALoadGelu {
    const bf16_t* base; bf16_t* gout; u32x4 v0, v1; int cc; int dofs;
    DI void init(const bf16_t* rowbase, bf16_t* growbase, int tid) { base = rowbase + (tid & 7) * 16; gout = growbase + (tid & 7) * 16; dofs = (tid >> 3) * SA_STRIDE + (tid & 7) * 32; }
    DI void issue(int c) { const u32x4* p = (const u32x4*)(base + c * 128); v0 = p[0]; v1 = p[1]; cc = c; }
    DI unsigned g2(unsigned u) { return pack_bf2(gelu_exact(bf_lo(u)), gelu_exact(bf_hi(u))); }
    DI void commit(char* buf) {
        u32x4 o0, o1;
        o0.x = g2(v0.x); o0.y = g2(v0.y); o0.z = g2(v0.z); o0.w = g2(v0.w);
        o1.x = g2(v1.x); o1.y = g2(v1.y); o1.z = g2(v1.z); o1.w = g2(v1.w);
        char* d = buf + dofs;
        *(u32x4*)d = o0; *(u32x4*)(d + 16) = o1;
        u32x4* gp = (u32x4*)(gout + cc * 128); gp[0] = o0; gp[1] = o1;
    }
};

DI void tok_reduce(float p0, float p1, float* sred, float& t0, float& t1, int tid) {
    const int w = tid >> 6, lane = tid & 63, r = lane & 31, h = lane >> 5;
    __syncthreads();
    sred[(w * 2 + h) * 64 + r] = p0; sred[(w * 2 + h) * 64 + 32 + r] = p1;
    __syncthreads();
    float a = 0.f, b = 0.f;
#pragma unroll
    for (int k = 0; k < 16; ++k) { a += sred[k * 64 + r]; b += sred[k * 64 + 32 + r]; }
    t0 = a; t1 = b;
}

#define PC_SRED (4 * SA_BYTES)
#define PC_BYTES (PC_SRED + 4096 + 256)

struct PCArgs {
    const bf16_t* U; const bf16_t* YPRE; bf16_t* G1; bf16_t* A2; const float* Xin; float* Xout; float* Xdummy; bf16_t* Hb; float* RSTD;
    const bf16x8* wfglu; const float* b_glu; const bf16x8* wfpool; const float* pool_scale; const bf16x8* wfout;
};

DI void phaseC1_tile(const PCArgs& a, int tile, char* smem, int wid) {
    char* sA = smem; float* sred = (float*)(smem + PC_SRED);
    for (int rep_ = 0; rep_ < REP_GLU; ++rep_) {
        int tok0 = tile * 64; asm volatile("" : "+s"(tok0));
        int tid = get_tid(wid);
        const int w = __builtin_amdgcn_readfirstlane(tid >> 6), lane = tid & 63, r = lane & 31, h = lane >> 5;
        ALoadGelu al; al.init(a.YPRE + (size_t)(tok0 + (tid >> 3)) * 512, a.G1 + (size_t)(tok0 + (tid >> 3)) * 512, tid);
        f32x16 acc[2][2]; zero_acc<2>(acc);
        gemm64<2, 4>(acc, al, 4, a.wfglu + (size_t)w * (32 * 2 * 64) + lane, sA, lane);
        float ss0 = 0.f, ss1 = 0.f;
        {
            uint2 yp[2][2][4]; float4 bg[2][4];
#pragma unroll
            for (int nt = 0; nt < 2; ++nt)
#pragma unroll
                for (int q = 0; q < 4; ++q) bg[nt][q] = *(const float4*)(a.b_glu + w * 64 + nt * 32 + 8 * q + 4 * h);
#pragma unroll
            for (int mt = 0; mt < 2; ++mt)
#pragma unroll
                for (int nt = 0; nt < 2; ++nt)
#pragma unroll
                    for (int q = 0; q < 4; ++q)
                        yp[mt][nt][q] = *(const uint2*)(a.G1 + (size_t)(tok0 + mt * 32 + r) * 512 + w * 64 + nt * 32 + 8 * q + 4 * h);
#pragma unroll
            for (int mt = 0; mt < 2; ++mt)
#pragma unroll
                for (int nt = 0; nt < 2; ++nt)
#pragma unroll
                    for (int q = 0; q < 4; ++q) {
                        const float y0 = bf_lo(yp[mt][nt][q].x), y1 = bf_hi(yp[mt][nt][q].x), y2 = bf_lo(yp[mt][nt][q].y), y3 = bf_hi(yp[mt][nt][q].y);
                        const float o0 = y0 / (1.f + __expf(-(acc[nt][mt][4 * q] + bg[nt][q].x)));
                        const float o1 = y1 / (1.f + __expf(-(acc[nt][mt][4 * q + 1] + bg[nt][q].y)));
                        const float o2 = y2 / (1.f + __expf(-(acc[nt][mt][4 * q + 2] + bg[nt][q].z)));
                        const float o3 = y3 / (1.f + __expf(-(acc[nt][mt][4 * q + 3] + bg[nt][q].w)));
                        acc[nt][mt][4 * q] = o0; acc[nt][mt][4 * q + 1] = o1; acc[nt][mt][4 * q + 2] = o2; acc[nt][mt][4 * q + 3] = o3;
                        const float s = o0 * o0 + o1 * o1 + o2 * o2 + o3 * o3;
                        if (mt == 0) ss0 += s; else ss1 += s;
                    }
        }
        float t0, t1; tok_reduce(ss0, ss1, sred, t0, t1, tid);
        const float rs0 = rsqrtf(t0 * (1.f / 512.f) + 1e-6f), rs1 = rsqrtf(t1 * (1.f / 512.f) + 1e-6f);
#pragma unroll
        for (int mt = 0; mt < 2; ++mt) {
            const float rs = mt ? rs1 : rs0;
            bf16_t* orow = a.A2 + (size_t)(tok0 + mt * 32 + r) * DM + w * 64;
#pragma unroll
            for (int nt = 0; nt < 2; ++nt)
#pragma unroll
                for (int q = 0; q < 4; ++q) {
                    uint2 o; o.x = pack_bf2(acc[nt][mt][4 * q] * rs, acc[nt][mt][4 * q + 1] * rs);
                    o.y = pack_bf2(acc[nt][mt][4 * q + 2] * rs, acc[nt][mt][4 * q + 3] * rs);
                    *(uint2*)(orow + nt * 32 + 8 * q + 4 * h) = o;
                }
        }
    }
    for (int rep_ = 0; rep_ < REP_POOL; ++rep_) {
        int tok0 = tile * 64; asm volatile("" : "+s"(tok0));
        int tid = get_tid(wid);
        const int w = __builtin_amdgcn_readfirstlane(tid >> 6), lane = tid & 63, r = lane & 31, h = lane >> 5;
        const int row = tid >> 3, seg = tid & 7;
        const int tok = tok0 + row, t = tok & (SEQ - 1);
#pragma unroll
        for (int gi = 0; gi < 4; ++gi) {
            const int win = 2 << gi;
            const int cnt = (t + 1 < win) ? (t + 1) : win;
            const bf16_t* up = a.U + (size_t)tok * DM + 512 + gi * 128 + seg * 16;
            float s[16];
            const uint4 c0 = *(const uint4*)up, c1 = *(const uint4*)(up + 8);
            const unsigned cu[8] = {c0.x, c0.y, c0.z, c0.w, c1.x, c1.y, c1.z, c1.w};
#pragma unroll
            for (int i = 0; i < 8; ++i) { s[2 * i] = bf_lo(cu[i]); s[2 * i + 1] = bf_hi(cu[i]); }
            for (int k = 1; k < cnt; ++k) {
                const uint4 d0 = *(const uint4*)(up - (size_t)k * DM), d1 = *(const uint4*)(up - (size_t)k * DM + 8);
                const unsigned du[8] = {d0.x, d0.y, d0.z, d0.w, d1.x, d1.y, d1.z, d1.w};
#pragma unroll
                for (int i = 0; i < 8; ++i) { s[2 * i] += bf_lo(du[i]); s[2 * i + 1] += bf_hi(du[i]); }
            }
            const float inv = 1.f / (float)cnt;
            unsigned o[8];
#pragma unroll
            for (int i = 0; i < 8; ++i) o[i] = pack_bf2(s[2 * i] * inv - bf_lo(cu[i]), s[2 * i + 1] * inv - bf_hi(cu[i]));
            char* d = sA + gi * SA_BYTES + row * SA_STRIDE + seg * 32;
            *(uint4*)d = make_uint4(o[0], o[1], o[2], o[3]); *(uint4*)(d + 16) = make_uint4(o[4], o[5], o[6], o[7]);
        }
        __syncthreads();
        const int gi = w >> 1;
        f32x16 acc[2][2]; zero_acc<2>(acc);
        const bf16x8* wp = a.wfpool + (size_t)gi * (128 * 128 / 8) + (size_t)(w & 1) * (8 * 2 * 64) + lane;
        const char* buf = sA + gi * SA_BYTES + r * SA_STRIDE + h * 16;
#pragma unroll
        for (int ks = 0; ks < 8; ++ks) {
            const bf16x8 a0 = *(const bf16x8*)(buf + ks * 32);
            const bf16x8 a1 = *(const bf16x8*)(buf + 32 * SA_STRIDE + ks * 32);
#pragma unroll
            for (int nt = 0; nt < 2; ++nt) {
                const bf16x8 wv = wp[(ks * 2 + nt) * 64];
                acc[nt][0] = MFMA32(wv, a0, acc[nt][0]);
                acc[nt][1] = MFMA32(wv, a1, acc[nt][1]);
            }
        }
        float ss0 = 0.f, ss1 = 0.f;
        float4 psc[2][4];
#pragma unroll
        for (int nt = 0; nt < 2; ++nt)
#pragma unroll
            for (int q = 0; q < 4; ++q) psc[nt][q] = *(const float4*)(a.pool_scale + w * 64 + nt * 32 + 8 * q + 4 * h);
#pragma unroll
        for (int mt = 0; mt < 2; ++mt)
#pragma unroll
            for (int nt = 0; nt < 2; ++nt)
#pragma unroll
                for (int q = 0; q < 4; ++q) {
                    const float4 sc = psc[nt][q];
                    const float o0 = acc[nt][mt][4 * q] * sc.x, o1 = acc[nt][mt][4 * q + 1] * sc.y, o2 = acc[nt][mt][4 * q + 2] * sc.z, o3 = acc[nt][mt][4 * q + 3] * sc.w;
                    acc[nt][mt][4 * q] = o0; acc[nt][mt][4 * q + 1] = o1; acc[nt][mt][4 * q + 2] = o2; acc[nt][mt][4 * q + 3] = o3;
                    const float s = o0 * o0 + o1 * o1 + o2 * o2 + o3 * o3;
                    if (mt == 0) ss0 += s; else ss1 += s;
                }
        float t0, t1; tok_reduce(ss0, ss1, sred, t0, t1, tid);
        const float rs0 = rsqrtf(t0 * (1.f / 512.f) + 1e-6f), rs1 = rsqrtf(t1 * (1.f / 512.f) + 1e-6f);
#pragma unroll
        for (int mt = 0; mt < 2; ++mt) {
            const float rs = mt ? rs1 : rs0;
            bf16_t* orow = a.A2 + (size_t)(tok0 + mt * 32 + r) * DM + 512 + w * 64;
#pragma unroll
            for (int nt = 0; nt < 2; ++nt)
#pragma unroll
                for (int q = 0; q < 4; ++q) {
                    uint2 o; o.x = pack_bf2(acc[nt][mt][4 * q] * rs, acc[nt][mt][4 * q + 1] * rs);
                    o.y = pack_bf2(acc[nt][mt][4 * q + 2] * rs, acc[nt][mt][4 * q + 3] * rs);
                    *(uint2*)(orow + nt * 32 + 8 * q + 4 * h) = o;
                }
        }
        __syncthreads();
    }
    for (int rep_ = 0; rep_ < REP_OUT; ++rep_) {
        float* xout_ = (rep_ + 1 < REP_OUT) ? a.Xdummy : a.Xout;
        int tok0 = tile * 64; asm volatile("" : "+s"(tok0));
        int tid = get_tid(wid);
        const int w = __builtin_amdgcn_readfirstlane(tid >> 6), lane = tid & 63, r = lane & 31, h = lane >> 5;
        ALoadBF16 al; al.init(a.A2 + (size_t)(tok0 + (tid >> 3)) * DM, tid);
        f32x16 acc[4][2]; zero_acc<4>(acc);
        gemm64<4, 2>(acc, al, 8, a.wfout + (size_t)w * (64 * 4 * 64) + lane, sA, lane);
        {
            float* wscr = (float*)(smem + w * WSCR_BYTES);
            const int tl = lane >> 3, cl = (lane & 7) * 4;
            float ssj[2][4];
#pragma unroll
            for (int mt = 0; mt < 2; ++mt)
#pragma unroll
                for (int j = 0; j < 4; ++j) ssj[mt][j] = 0.f;
            float4 xc[4], xn[4];
            const size_t rbase = (size_t)(tok0 + tl) * DM + w * 128 + cl;
#pragma unroll
            for (int j = 0; j < 4; ++j) xc[j] = *(const float4*)(a.Xin + rbase + (size_t)(8 * j) * DM);
#pragma unroll
            for (int g = 0; g < 8; ++g) {
                const int mt = g >> 2, nt = g & 3;
                if (g < 7) {
                    const size_t rn = rbase + (size_t)((g + 1) >> 2) * 32 * DM + ((g + 1) & 3) * 32;
#pragma unroll
                    for (int j = 0; j < 4; ++j) xn[j] = *(const float4*)(a.Xin + rn + (size_t)(8 * j) * DM);
                }
                f32x4 o[4]; tile_transpose(acc[nt][mt], wscr, lane, o);
                const size_t ro = rbase + (size_t)mt * 32 * DM + nt * 32;
#pragma unroll
                for (int j = 0; j < 4; ++j) {
                    float4 xo; xo.x = xc[j].x + o[j].x; xo.y = xc[j].y + o[j].y; xo.z = xc[j].z + o[j].z; xo.w = xc[j].w + o[j].w;
                    *(float4*)(xout_ + ro + (size_t)(8 * j) * DM) = xo;
                    uint2 p; p.x = pack_bf2(xo.x, xo.y); p.y = pack_bf2(xo.z, xo.w);
                    *(uint2*)(a.Hb + ro + (size_t)(8 * j) * DM) = p;
                    ssj[mt][j] += xo.x * xo.x + xo.y * xo.y + xo.z * xo.z + xo.w * xo.w;
                }
                asm volatile("" ::: "memory");
#pragma unroll
                for (int j = 0; j < 4; ++j) xc[j] = xn[j];
            }
#pragma unroll
            for (int mt = 0; mt < 2; ++mt)
#pragma unroll
                for (int j = 0; j < 4; ++j) {
                    float v = ssj[mt][j];
                    v += shx<1>(v, lane); v += shx<2>(v, lane); v += shx<4>(v, lane);
                    if ((lane & 7) == 0) sred[w * 64 + mt * 32 + tl + 8 * j] = v;
                }
            __syncthreads();
            if (tid < 64) {
                float tot = 0.f;
#pragma unroll
                for (int k = 0; k < 8; ++k) tot += sred[k * 64 + tid];
                a.RSTD[tok0 + tid] = rsqrtf(tot * (1.f / 1024.f) + 1e-6f);
            }
        }
        __syncthreads();
    }
}

DI unsigned f2ord(float f) { const unsigned u = __float_as_uint(f); return u ^ ((u >> 31) ? 0xFFFFFFFFu : 0x80000000u); }
DI float ord2f(unsigned o) { return __uint_as_float((o & 0x80000000u) ? (o ^ 0x80000000u) : ~o); }
DI unsigned umax_(unsigned a, unsigned b) { return a > b ? a : b; }
DI unsigned umin_(unsigned a, unsigned b) { return a < b ? a : b; }

struct PRArgs {
    const bf16_t* Hb; const float* RSTD; bf16_t* Qb; const bf16x8* wfq; const bf16x8* wfk1; const bf16x8* wfk2; int* EX; float* GT;
};

DI void topk_insert16(unsigned (&L)[16], const f32x16& s, int nbase, int h) {
#pragma unroll
    for (int i = 0; i < 16; ++i) {
        unsigned x = (f2ord(s[i]) & 0xFFFFFF80u) | (unsigned)(127 - (nbase + crow(i, h)));
#pragma unroll
        for (int k = 0; k < 16; ++k) { const unsigned hi = umax_(L[k], x); x = umin_(L[k], x); L[k] = hi; }
    }
}

DI void phaseC2_tile(const PRArgs& a, int tile, char* smem, int wid) {
    char* sA = smem;
    for (int rep_ = 0; rep_ < REP_Q; ++rep_)
#pragma unroll 1
    for (int ps = 0; ps < 2; ++ps) {
        int tok0 = tile * 64; asm volatile("" : "+s"(tok0));
        int tid = get_tid(wid);
        const int w = __builtin_amdgcn_readfirstlane(tid >> 6), lane = tid & 63, r = lane & 31, h = lane >> 5;
        ALoadBF16 al; al.init(a.Hb + (size_t)(tok0 + (tid >> 3)) * DM, tid);
        f32x16 acc[4][2]; zero_acc<4>(acc);
        const int ng = ps * 8 + w;
        gemm64<4, 2>(acc, al, 8, a.wfq + (size_t)ng * (64 * 4 * 64) + lane, sA, lane);
        {
            float* wscr = (float*)(smem + w * WSCR_BYTES);
            const int tl = lane >> 3, cl = (lane & 7) * 4;
#pragma unroll
            for (int mt = 0; mt < 2; ++mt) {
                float rs[4];
#pragma unroll
                for (int j = 0; j < 4; ++j) rs[j] = a.RSTD[tok0 + mt * 32 + tl + 8 * j];
#pragma unroll
                for (int nt = 0; nt < 4; ++nt) {
                    f32x4 o[4]; tile_transpose(acc[nt][mt], wscr, lane, o);
#pragma unroll
                    for (int j = 0; j < 4; ++j) {
                        uint2 p; p.x = pack_bf2(o[j].x * rs[j], o[j].y * rs[j]); p.y = pack_bf2(o[j].z * rs[j], o[j].w * rs[j]);
                        *(uint2*)(a.Qb + (size_t)(tok0 + mt * 32 + tl + 8 * j) * 2048 + ng * 128 + nt * 32 + cl) = p;
                    }
                }
            }
        }
        __syncthreads();
    }
    __syncthreads();
    for (int rep_ = 0; rep_ < REP_SC; ++rep_) {
        int tok0 = tile * 64; asm volatile("" : "+s"(tok0));
        int tid = get_tid(wid);
        const int w = __builtin_amdgcn_readfirstlane(tid >> 6), lane = tid & 63, r = lane & 31, h = lane >> 5;
        unsigned T0[16], T1[16];
#pragma unroll 1
        for (int half = 0; half < 2; ++half) {
            gwp_t wk = (gwp_t)(half ? a.wfk2 : a.wfk1) + lane;
#pragma unroll 1
            for (int mt = 0; mt < 2; ++mt) {
                f32x16 sc[4];
#pragma unroll
                for (int nt = 0; nt < 4; ++nt)
#pragma unroll
                    for (int i = 0; i < 16; ++i) sc[nt][i] = 0.f;
                const bf16_t* qrow = a.Qb + (size_t)(tok0 + mt * 32 + r) * 2048 + w * 256 + half * 128 + 8 * h;
#pragma unroll
                for (int ks = 0; ks < 8; ++ks) {
                    const bf16x8 qv = *(const bf16x8*)(qrow + ks * 16);
#pragma unroll
                    for (int nt = 0; nt < 4; ++nt) sc[nt] = MFMA32(wk[(ks * 4 + nt) * 64], qv, sc[nt]);
                }
                unsigned L[16];
#pragma unroll
                for (int k = 0; k < 16; ++k) L[k] = 0u;
#pragma unroll
                for (int nt = 0; nt < 4; ++nt) topk_insert16(L, sc[nt], nt * 32, h);
                unsigned P[16];
#pragma unroll
                for (int k = 0; k < 16; ++k) P[k] = (unsigned)shx_i<32>((int)L[k], lane);
#pragma unroll
                for (int k = 0; k < 16; ++k) L[k] = umax_(L[k], P[15 - k]);
#pragma unroll
                for (int d = 8; d > 0; d >>= 1)
#pragma unroll
                    for (int k = 0; k < 16; ++k)
                        if ((k & d) == 0) { const unsigned hi = umax_(L[k], L[k + d]), lo = umin_(L[k], L[k + d]); L[k] = hi; L[k + d] = lo; }
                if (h == mt) {
                    if (half == 0) {
#pragma unroll
                        for (int k = 0; k < 16; ++k) T0[k] = L[k];
                    } else {
#pragma unroll
                        for (int k = 0; k < 16; ++k) T1[k] = L[k];
                    }
                }
            }
        }
        float v1[16], v2[16];
#pragma unroll
        for (int k = 0; k < 16; ++k) { v1[k] = ord2f(T0[k] & 0xFFFFFF80u); v2[k] = ord2f(T1[k] & 0xFFFFFF80u); }
        unsigned C[16];
#pragma unroll
        for (int b = 0; b < 16; ++b) C[b] = (f2ord(v1[0] + v2[b]) & 0xFFFFFF00u) | (unsigned)(255 - b);
#pragma unroll
        for (int aa = 1; aa < 16; ++aa)
#pragma unroll
            for (int b = 0; b < 16; ++b)
                if ((aa + 1) * (b + 1) <= 16) {
                    unsigned x = (f2ord(v1[aa] + v2[b]) & 0xFFFFFF00u) | (unsigned)(255 - (aa * 16 + b));
#pragma unroll
                    for (int k = (aa + 1) * (b + 1) - 1; k < 16; ++k) { const unsigned hi = umax_(C[k], x); x = umin_(C[k], x); C[k] = hi; }
                }
        unsigned* sI = (unsigned*)(smem) + (w * 64 + lane) * 9;
#pragma unroll
        for (int q = 0; q < 4; ++q) {
            unsigned p1 = 0u, p2 = 0u;
#pragma unroll
            for (int j = 0; j < 4; ++j) { p1 |= (127u - (T0[4 * q + j] & 0x7Fu)) << (8 * j); p2 |= (127u - (T1[4 * q + j] & 0x7Fu)) << (8 * j); }
            sI[q] = p1; sI[4 + q] = p2;
        }
        const unsigned char* sB = (const unsigned char*)sI;
        const float mx = ord2f(C[0] & 0xFFFFFF00u);
        float e[16]; float sum = 0.f; int ex[16];
#pragma unroll
        for (int k = 0; k < 16; ++k) {
            e[k] = __expf(ord2f(C[k] & 0xFFFFFF00u) - mx); sum += e[k];
            const unsigned ci = 255u - (C[k] & 0xFFu);
            ex[k] = (int)sB[ci >> 4] * 128 + (int)sB[16 + (ci & 15u)];
        }
        const float inv = 1.f / sum;
        const size_t ob = ((size_t)(tok0 + h * 32 + r) * 8 + w) * 16;
#pragma unroll
        for (int q = 0; q < 4; ++q) {
            *(int4*)(a.EX + ob + 4 * q) = make_int4(ex[4 * q], ex[4 * q + 1], ex[4 * q + 2], ex[4 * q + 3]);
            *(float4*)(a.GT + ob + 4 * q) = make_float4(e[4 * q] * inv, e[4 * q + 1] * inv, e[4 * q + 2] * inv, e[4 * q + 3] * inv);
        }
    }
    __syncthreads();
}

typedef const __attribute__((address_space(1))) u32x4* grow_t;
typedef unsigned char fp8_t;

struct PGArgs {
    const bf16_t* Hb; const float* RSTD; const int* EX; const float* GT; const fp8_t* U8; const fp8_t* V8; const float* SU; const float* SV;
    const float* Xin; float* Xout; const float* gfinal; int final_norm;
};

DI void conv_rows_fp8(const float* __restrict__ src, const float* __restrict__ gain, fp8_t* __restrict__ dst, float* __restrict__ scales,
                      int nrows, int gwave, int nwaves, int lane) {
    for (int row = gwave; row < nrows; row += nwaves) {
        const float4* p = (const float4*)(src + (size_t)row * DM + lane * 16);
        float4 v0 = p[0], v1 = p[1], v2 = p[2], v3 = p[3];
        if (gain) {
            const float4* g = (const float4*)(gain + lane * 16);
            const float4 g0 = g[0], g1 = g[1], g2 = g[2], g3 = g[3];
            v0.x *= g0.x; v0.y *= g0.y; v0.z *= g0.z; v0.w *= g0.w; v1.x *= g1.x; v1.y *= g1.y; v1.z *= g1.z; v1.w *= g1.w;
            v2.x *= g2.x; v2.y *= g2.y; v2.z *= g2.z; v2.w *= g2.w; v3.x *= g3.x; v3.y *= g3.y; v3.z *= g3.z; v3.w *= g3.w;
        }
        float m = fmaxf(fmaxf(fmaxf(fabsf(v0.x), fabsf(v0.y)), fmaxf(fabsf(v0.z), fabsf(v0.w))), fmaxf(fmaxf(fabsf(v1.x), fabsf(v1.y)), fmaxf(fabsf(v1.z), fabsf(v1.w))));
        m = fmaxf(m, fmaxf(fmaxf(fmaxf(fabsf(v2.x), fabsf(v2.y)), fmaxf(fabsf(v2.z), fabsf(v2.w))), fmaxf(fmaxf(fabsf(v3.x), fabsf(v3.y)), fmaxf(fabsf(v3.z), fabsf(v3.w)))));
#pragma unroll
        for (int o = 0; o < 1; ++o) { m = fmaxf(m, shx<1>(m, lane)); m = fmaxf(m, shx<2>(m, lane)); m = fmaxf(m, shx<4>(m, lane)); m = fmaxf(m, shx<8>(m, lane)); m = fmaxf(m, shx<16>(m, lane)); m = fmaxf(m, shx<32>(m, lane)); }
        const float sc = (m > 0.f) ? m * (1.f / 448.f) : 1.f;
        const float inv = 1.f / sc;
        u32x4 o;
        unsigned t;
        t = 0u; t = __builtin_amdgcn_cvt_pk_fp8_f32(v0.x * inv, v0.y * inv, t, false); t = __builtin_amdgcn_cvt_pk_fp8_f32(v0.z * inv, v0.w * inv, t, true); o.x = t;
        t = 0u; t = __builtin_amdgcn_cvt_pk_fp8_f32(v1.x * inv, v1.y * inv, t, false); t = __builtin_amdgcn_cvt_pk_fp8_f32(v1.z * inv, v1.w * inv, t, true); o.y = t;
        t = 0u; t = __builtin_amdgcn_cvt_pk_fp8_f32(v2.x * inv, v2.y * inv, t, false); t = __builtin_amdgcn_cvt_pk_fp8_f32(v2.z * inv, v2.w * inv, t, true); o.z = t;
        t = 0u; t = __builtin_amdgcn_cvt_pk_fp8_f32(v3.x * inv, v3.y * inv, t, false); t = __builtin_amdgcn_cvt_pk_fp8_f32(v3.z * inv, v3.w * inv, t, true); o.w = t;
        *(u32x4*)(dst + ((size_t)(lane >> 3) * nrows + row) * 128 + (lane & 7) * 16) = o;
        if (lane == 0) scales[row] = sc;
    }
}

struct RowOct { u32x4 r0, r1, r2, r3, r4, r5, r6, r7; };
DI void oct_load(RowOct& q, const fp8_t* tab, int e0, int e1, int e2, int e3, int e4, int e5, int e6, int e7, int lane) {
    q.r0 = ((grow_t)(tab + (size_t)e0 * DM))[lane]; q.r1 = ((grow_t)(tab + (size_t)e1 * DM))[lane];
    q.r2 = ((grow_t)(tab + (size_t)e2 * DM))[lane]; q.r3 = ((grow_t)(tab + (size_t)e3 * DM))[lane];
    q.r4 = ((grow_t)(tab + (size_t)e4 * DM))[lane]; q.r5 = ((grow_t)(tab + (size_t)e5 * DM))[lane];
    q.r6 = ((grow_t)(tab + (size_t)e6 * DM))[lane]; q.r7 = ((grow_t)(tab + (size_t)e7 * DM))[lane];
}
DI float dot4w(unsigned w, float h0, float h1, float h2, float h3, float s) {
    const f2_t lo = __builtin_amdgcn_cvt_pk_f32_fp8(w, false), hi = __builtin_amdgcn_cvt_pk_f32_fp8(w, true);
    s = fmaf(lo.x, h0, s); s = fmaf(lo.y, h1, s); s = fmaf(hi.x, h2, s); s = fmaf(hi.y, h3, s);
    return s;
}
DI float row_dot8(const u32x4& r, const float (&h)[16]) {
    float s = 0.f;
    s = dot4w(r.x, h[0], h[1], h[2], h[3], s); s = dot4w(r.y, h[4], h[5], h[6], h[7], s);
    s = dot4w(r.z, h[8], h[9], h[10], h[11], s); s = dot4w(r.w, h[12], h[13], h[14], h[15], s);
    return s;
}
DI void axpy4w(unsigned w, float c, float& a0, float& a1, float& a2, float& a3) {
    const f2_t lo = __builtin_amdgcn_cvt_pk_f32_fp8(w, false), hi = __builtin_amdgcn_cvt_pk_f32_fp8(w, true);
    a0 = fmaf(c, lo.x, a0); a1 = fmaf(c, lo.y, a1); a2 = fmaf(c, hi.x, a2); a3 = fmaf(c, hi.y, a3);
}
DI void row_axpy8(float (&acc)[16], const u32x4& r, float c) {
    axpy4w(r.x, c, acc[0], acc[1], acc[2], acc[3]); axpy4w(r.y, c, acc[4], acc[5], acc[6], acc[7]);
    axpy4w(r.z, c, acc[8], acc[9], acc[10], acc[11]); axpy4w(r.w, c, acc[12], acc[13], acc[14], acc[15]);
}
#define RL(v, l) __builtin_amdgcn_readlane((v), (l))
#define RLF(v, l) __uint_as_float((unsigned)__builtin_amdgcn_readlane((int)__float_as_uint(v), (l)))

DI float reduce16(float (&p)[16], int lane) {
    const bool b5 = lane & 32, b4 = lane & 16, b3 = lane & 8, b2 = lane & 4;
    float q8[8], q4[4], q2[2];
#pragma unroll
    for (int k = 0; k < 8; ++k) { const float keep = b5 ? p[k + 8] : p[k], send = b5 ? p[k] : p[k + 8]; q8[k] = keep + shx<32>(send, lane); }
#pragma unroll
    for (int k = 0; k < 4; ++k) { const float keep = b4 ? q8[k + 4] : q8[k], send = b4 ? q8[k] : q8[k + 4]; q4[k] = keep + shx<16>(send, lane); }
#pragma unroll
    for (int k = 0; k < 2; ++k) { const float keep = b3 ? q4[k + 2] : q4[k], send = b3 ? q4[k] : q4[k + 2]; q2[k] = keep + shx<8>(send, lane); }
    float t;
    { const float keep = b2 ? q2[1] : q2[0], send = b2 ? q2[0] : q2[1]; t = keep + shx<4>(send, lane); }
    t += shx<1>(t, lane); t += shx<2>(t, lane);
    return t;
}

DI void phaseC3_tile(const PGArgs& a, int tile, int wid) {
    int tid = get_tid(wid);
    const int w = __builtin_amdgcn_readfirstlane(tid >> 6), lane = tid & 63;
    const int el = (lane >> 2) & 15;
#pragma unroll 1
    for (int ti = 0; ti < 8; ++ti) {
        const int tok = tile * 64 + w * 8 + ti;
        float h[16];
        {
            const u32x4* hp = (const u32x4*)(a.Hb + (size_t)tok * DM + lane * 16);
            const u32x4 h0 = hp[0], h1 = hp[1];
            h[0] = bf_lo(h0.x); h[1] = bf_hi(h0.x); h[2] = bf_lo(h0.y); h[3] = bf_hi(h0.y); h[4] = bf_lo(h0.z); h[5] = bf_hi(h0.z); h[6] = bf_lo(h0.w); h[7] = bf_hi(h0.w);
            h[8] = bf_lo(h1.x); h[9] = bf_hi(h1.x); h[10] = bf_lo(h1.y); h[11] = bf_hi(h1.y); h[12] = bf_lo(h1.z); h[13] = bf_hi(h1.z); h[14] = bf_lo(h1.w); h[15] = bf_hi(h1.w);
        }
        const float rs = a.RSTD[tok];
        float acc[16];
#pragma unroll
        for (int i = 0; i < 16; ++i) acc[i] = 0.f;
#pragma unroll 1
        for (int hd = 0; hd < 8; ++hd) {
            const size_t eb = ((size_t)tok * 8 + hd) * 16;
            const int exv = a.EX[eb + (lane & 15)];
            const int exl = a.EX[eb + el];
            const float coef = a.GT[eb + el] * a.SV[exl];
            const float su = a.SU[exl] * rs;
            RowOct qa, qb;
            float p[16];
            oct_load(qa, a.U8, RL(exv, 0), RL(exv, 1), RL(exv, 2), RL(exv, 3), RL(exv, 4), RL(exv, 5), RL(exv, 6), RL(exv, 7), lane);
            oct_load(qb, a.U8, RL(exv, 8), RL(exv, 9), RL(exv, 10), RL(exv, 11), RL(exv, 12), RL(exv, 13), RL(exv, 14), RL(exv, 15), lane);
            p[0] = row_dot8(qa.r0, h); p[1] = row_dot8(qa.r1, h); p[2] = row_dot8(qa.r2, h); p[3] = row_dot8(qa.r3, h);
            p[4] = row_dot8(qa.r4, h); p[5] = row_dot8(qa.r5, h); p[6] = row_dot8(qa.r6, h); p[7] = row_dot8(qa.r7, h);
            oct_load(qa, a.V8, RL(exv, 0), RL(exv, 1), RL(exv, 2), RL(exv, 3), RL(exv, 4), RL(exv, 5), RL(exv, 6), RL(exv, 7), lane);
            p[8] = row_dot8(qb.r0, h); p[9] = row_dot8(qb.r1, h); p[10] = row_dot8(qb.r2, h); p[11] = row_dot8(qb.r3, h);
            p[12] = row_dot8(qb.r4, h); p[13] = row_dot8(qb.r5, h); p[14] = row_dot8(qb.r6, h); p[15] = row_dot8(qb.r7, h);
            oct_load(qb, a.V8, RL(exv, 8), RL(exv, 9), RL(exv, 10), RL(exv, 11), RL(exv, 12), RL(exv, 13), RL(exv, 14), RL(exv, 15), lane);
            const float act = gelu_exact(reduce16(p, lane) * su) * coef;
            row_axpy8(acc, qa.r0, RLF(act, 0)); row_axpy8(acc, qa.r1, RLF(act, 4)); row_axpy8(acc, qa.r2, RLF(act, 8)); row_axpy8(acc, qa.r3, RLF(act, 12));
            row_axpy8(acc, qa.r4, RLF(act, 16)); row_axpy8(acc, qa.r5, RLF(act, 20)); row_axpy8(acc, qa.r6, RLF(act, 24)); row_axpy8(acc, qa.r7, RLF(act, 28));
            row_axpy8(acc, qb.r0, RLF(act, 32)); row_axpy8(acc, qb.r1, RLF(act, 36)); row_axpy8(acc, qb.r2, RLF(act, 40)); row_axpy8(acc, qb.r3, RLF(act, 44));
            row_axpy8(acc, qb.r4, RLF(act, 48)); row_axpy8(acc, qb.r5, RLF(act, 52)); row_axpy8(acc, qb.r6, RLF(act, 56)); row_axpy8(acc, qb.r7, RLF(act, 60));
        }
        const float* xi = a.Xin + (size_t)tok * DM + lane * 16;
        float* xo = a.Xout + (size_t)tok * DM + lane * 16;
        float4 x0 = *(const float4*)xi, x1 = *(const float4*)(xi + 4), x2 = *(const float4*)(xi + 8), x3 = *(const float4*)(xi + 12);
        x0.x += acc[0]; x0.y += acc[1]; x0.z += acc[2]; x0.w += acc[3]; x1.x += acc[4]; x1.y += acc[5]; x1.z += acc[6]; x1.w += acc[7];
        x2.x += acc[8]; x2.y += acc[9]; x2.z += acc[10]; x2.w += acc[11]; x3.x += acc[12]; x3.y += acc[13]; x3.z += acc[14]; x3.w += acc[15];
        if (a.final_norm) {
            float ss = x0.x * x0.x + x0.y * x0.y + x0.z * x0.z + x0.w * x0.w + x1.x * x1.x + x1.y * x1.y + x1.z * x1.z + x1.w * x1.w
                     + x2.x * x2.x + x2.y * x2.y + x2.z * x2.z + x2.w * x2.w + x3.x * x3.x + x3.y * x3.y + x3.z * x3.z + x3.w * x3.w;
            ss = wave_sum(ss, lane);
            const float rf = rsqrtf(ss * (1.f / 1024.f) + 1e-6f);
            const float* gf = a.gfinal + lane * 16;
            const float4 g0 = *(const float4*)gf, g1 = *(const float4*)(gf + 4), g2 = *(const float4*)(gf + 8), g3 = *(const float4*)(gf + 12);
            x0.x *= rf * g0.x; x0.y *= rf * g0.y; x0.z *= rf * g0.z; x0.w *= rf * g0.w; x1.x *= rf * g1.x; x1.y *= rf * g1.y; x1.z *= rf * g1.z; x1.w *= rf * g1.w;
            x2.x *= rf * g2.x; x2.y *= rf * g2.y; x2.z *= rf * g2.z; x2.w *= rf * g2.w; x3.x *= rf * g3.x; x3.y *= rf * g3.y; x3.z *= rf * g3.z; x3.w *= rf * g3.w;
        }
        *(float4*)xo = x0; *(float4*)(xo + 4) = x1; *(float4*)(xo + 8) = x2; *(float4*)(xo + 12) = x3;
    }
}
#define XB_TMO      128
#define XB_XCNT(j)  (256  + 64 * (j))
#define XB_XSUB(j)  (1280 + 64 * (j))
#define XB_XGEN(j)  (2304 + 64 * (j))
#define XB_TOP      3328
#define XB_TOPGEN   3392
#define XB_QUEUE(j) (3456 + 64 * (j))
#define XCD_BAR_WORDS (3456 + 64 * 64)
#define XB_SPIN_CAP (1u << 20)
#define LAS __attribute__((address_space(3)))

DI unsigned xb_ld(unsigned* p)              { return __hip_atomic_load(p, __ATOMIC_RELAXED, __HIP_MEMORY_SCOPE_AGENT); }
DI unsigned xb_add(unsigned* p, unsigned v) { return __hip_atomic_fetch_add(p, v, __ATOMIC_RELAXED, __HIP_MEMORY_SCOPE_AGENT); }
DI unsigned xb_xcc_id() { return (unsigned)__builtin_amdgcn_s_getreg((3 << 11) | 20) & 0xFu; }
#define XB_SPIN(cond, bar) do { unsigned _sp = 0; while (cond) { __builtin_amdgcn_s_sleep(1); \
    if ((++_sp & 255u) == 0u) { if (xb_ld(&(bar)[XB_TMO])) break; if (_sp > XB_SPIN_CAP) { atomicAdd(&(bar)[XB_TMO], 1u); break; } } } } while (0)

struct XcdBarrier { unsigned* bar; unsigned x; volatile LAS unsigned* st; };

DI XcdBarrier xcd_barrier_post(unsigned* bar, volatile LAS unsigned* st, int tid) {
    XcdBarrier b; b.bar = bar; b.x = xb_xcc_id(); b.st = st;
    if (tid == 0) st[2] = xb_add(&bar[XB_XCNT(b.x)], 1u);
    return b;
}
DI void xcd_barrier_complete(unsigned* bar, unsigned x, unsigned& nloc, unsigned& nx) {
    const unsigned G = gridDim.x * gridDim.y * gridDim.z;
    unsigned sum, cnt, mine, sp = 0u;
    for (;;) {
        sum = 0u; cnt = 0u; mine = 0u;
#pragma unroll
        for (unsigned j = 0; j < 16; ++j) { const unsigned c = xb_ld(&bar[XB_XCNT(j)]); sum += c; cnt += (c > 0u) ? 1u : 0u; mine = (j == x) ? c : mine; }
        if (sum == G) break;
        __builtin_amdgcn_s_sleep(1);
        if ((++sp & 255u) == 0u) { if (xb_ld(&bar[XB_TMO])) break; if (sp > XB_SPIN_CAP) { atomicAdd(&bar[XB_TMO], 1u); break; } }
    }
    nloc = mine > 0u ? mine : 1u; nx = cnt > 0u ? cnt : 1u;
}
DI void xcd_barrier(const XcdBarrier& b, int wid) {
    asm volatile("s_waitcnt vmcnt(0)" ::: "memory");
    __syncthreads();
    if (get_tid(wid) == 0) {
        unsigned* bar = b.bar;
        __builtin_amdgcn_s_waitcnt(0);
        unsigned nloc = b.st[0], nx = b.st[1];
        if (nloc == 0u) { xcd_barrier_complete(bar, b.x, nloc, nx); b.st[0] = nloc; b.st[1] = nx; }
        const unsigned old = xb_add(&bar[XB_XSUB(b.x)], 1u);
        const unsigned gen = old / nloc;
        if (old + 1u == (gen + 1u) * nloc) {
            __builtin_amdgcn_fence(__ATOMIC_RELEASE, "agent");
            asm volatile("s_waitcnt vmcnt(0)" ::: "memory");
            const unsigned og = xb_add(&bar[XB_TOP], 1u);
            const unsigned tg = og / nx;
            if (og + 1u == (tg + 1u) * nx) xb_add(&bar[XB_TOPGEN], 1u);
            else XB_SPIN(xb_ld(&bar[XB_TOPGEN]) == tg, bar);
            __builtin_amdgcn_fence(__ATOMIC_ACQUIRE, "agent");
            xb_add(&bar[XB_XGEN(b.x)], 1u);
            asm volatile("s_waitcnt vmcnt(0)" ::: "memory");
        } else {
            XB_SPIN(xb_ld(&bar[XB_XGEN(b.x)]) == gen, bar);
            __builtin_amdgcn_fence(__ATOMIC_ACQUIRE, "agent");
            asm volatile("s_waitcnt vmcnt(0)" ::: "memory");
        }
    }
    __syncthreads();
}
struct PSArgs {
    const bf16_t* Hb; const float* RSTD; const int* EX; const float* GT; const fp8_t* U8; const fp8_t* V8; const float* SU; const float* SV;
    float* PD; float* COEF; const float* Xin; float* Xout;
};

DI void dot4p(unsigned w, const f2_t& h01, const f2_t& h23, f2_t& s2) {
    const f2_t lo = __builtin_amdgcn_cvt_pk_f32_fp8(w, false), hi = __builtin_amdgcn_cvt_pk_f32_fp8(w, true);
    s2 = __builtin_elementwise_fma(lo, h01, s2); s2 = __builtin_elementwise_fma(hi, h23, s2);
}
DI float row_dot8p(const u32x4& r, const f2_t (&h)[8]) {
    f2_t s2 = {0.f, 0.f};
    dot4p(r.x, h[0], h[1], s2); dot4p(r.y, h[2], h[3], s2); dot4p(r.z, h[4], h[5], s2); dot4p(r.w, h[6], h[7], s2);
    return s2.x + s2.y;
}
DI void axpy4p(unsigned w, const f2_t& c2, f2_t& a01, f2_t& a23) {
    const f2_t lo = __builtin_amdgcn_cvt_pk_f32_fp8(w, false), hi = __builtin_amdgcn_cvt_pk_f32_fp8(w, true);
    a01 = __builtin_elementwise_fma(c2, lo, a01); a23 = __builtin_elementwise_fma(c2, hi, a23);
}
DI void row_axpy8p(f2_t (&acc)[8], const u32x4& r, float c) {
    const f2_t c2 = {c, c};
    axpy4p(r.x, c2, acc[0], acc[1]); axpy4p(r.y, c2, acc[2], acc[3]); axpy4p(r.z, c2, acc[4], acc[5]); axpy4p(r.w, c2, acc[6], acc[7]);
}

DI int run_token(int n, int k, int nloc, int wid) { return (k + (n >> 3) * nloc) * 64 + wid * 8 + (n & 7); }

struct Ids16 { u32x4 a, b, c, d; };
DI void ids_load(Ids16& q, const int* EX, int tok, int rg) { const u32x4* p = (const u32x4*)(EX + (size_t)tok * 128 + rg * 16); q.a = p[0]; q.b = p[1]; q.c = p[2]; q.d = p[3]; }
DI void rows_lo(u32x4 (&r)[8], const Ids16& q, const fp8_t* tab, unsigned loff) {
    r[0] = *(grow_t)(tab + (q.a.x * 128u + loff)); r[1] = *(grow_t)(tab + (q.a.y * 128u + loff)); r[2] = *(grow_t)(tab + (q.a.z * 128u + loff)); r[3] = *(grow_t)(tab + (q.a.w * 128u + loff));
    r[4] = *(grow_t)(tab + (q.b.x * 128u + loff)); r[5] = *(grow_t)(tab + (q.b.y * 128u + loff)); r[6] = *(grow_t)(tab + (q.b.z * 128u + loff)); r[7] = *(grow_t)(tab + (q.b.w * 128u + loff));
}
DI void rows_hi(u32x4 (&r)[8], const Ids16& q, const fp8_t* tab, unsigned loff) {
    r[0] = *(grow_t)(tab + (q.c.x * 128u + loff)); r[1] = *(grow_t)(tab + (q.c.y * 128u + loff)); r[2] = *(grow_t)(tab + (q.c.z * 128u + loff)); r[3] = *(grow_t)(tab + (q.c.w * 128u + loff));
    r[4] = *(grow_t)(tab + (q.d.x * 128u + loff)); r[5] = *(grow_t)(tab + (q.d.y * 128u + loff)); r[6] = *(grow_t)(tab + (q.d.z * 128u + loff)); r[7] = *(grow_t)(tab + (q.d.w * 128u + loff));
}
DI void unpack_h(f2_t (&h)[8], const u32x4& h0, const u32x4& h1) {
    h[0] = (f2_t){bf_lo(h0.x), bf_hi(h0.x)}; h[1] = (f2_t){bf_lo(h0.y), bf_hi(h0.y)}; h[2] = (f2_t){bf_lo(h0.z), bf_hi(h0.z)}; h[3] = (f2_t){bf_lo(h0.w), bf_hi(h0.w)};
    h[4] = (f2_t){bf_lo(h1.x), bf_hi(h1.x)}; h[5] = (f2_t){bf_lo(h1.y), bf_hi(h1.y)}; h[6] = (f2_t){bf_lo(h1.z), bf_hi(h1.z)}; h[7] = (f2_t){bf_lo(h1.w), bf_hi(h1.w)};
}
DI void dots8(float* p, const u32x4 (&r)[8], const f2_t (&h)[8]) {
#pragma unroll
    for (int i = 0; i < 8; ++i) { p[i] = row_dot8p(r[i], h); if ((i & 1) == 1) __builtin_amdgcn_sched_barrier(0); }
}
DI void peerU_finish(const PSArgs& a, float (&p)[16], int tok, int s, int lane) {
    const int rg = lane >> 3, pc = lane & 7;
    const bool b2 = pc & 4, b1 = pc & 2, b0 = pc & 1;
    float q8[8], q4[4], q2[2];
#pragma unroll
    for (int k = 0; k < 8; ++k) { const float keep = b2 ? p[k + 8] : p[k], send = b2 ? p[k] : p[k + 8]; q8[k] = keep + shx<4>(send, lane); }
#pragma unroll
    for (int k = 0; k < 4; ++k) { const float keep = b1 ? q8[k + 4] : q8[k], send = b1 ? q8[k] : q8[k + 4]; q4[k] = keep + shx<2>(send, lane); }
#pragma unroll
    for (int k = 0; k < 2; ++k) { const float keep = b0 ? q4[k + 2] : q4[k], send = b0 ? q4[k] : q4[k + 2]; q2[k] = keep + shx<1>(send, lane); }
    *(float2*)(a.PD + ((size_t)s * NTOK + tok) * 128 + rg * 16 + 2 * pc) = make_float2(q2[0], q2[1]);
}

DI void peerU_run(const PSArgs& a, int s, int k, int nloc, int wid) {
    const int tid = get_tid(wid);
    const int lane = tid & 63, rg = lane >> 3, pc = lane & 7;
    const unsigned loff = (unsigned)(s * (NEXP * 128) + pc * 16);
    const int hoff = s * 128 + pc * 16;
    const int N = 8 * ((NTOK / 64 - k + nloc - 1) / nloc);
    Ids16 idE, idO;
    u32x4 rA[8], rB[8], hE0, hE1, hO0, hO1;
#define LOAD_H(d0, d1, tokv) { const u32x4* hp_ = (const u32x4*)(a.Hb + (size_t)(tokv) * DM + hoff); d0 = hp_[0]; d1 = hp_[1]; }
    ids_load(idE, a.EX, run_token(0, k, nloc, wid), rg);
    ids_load(idO, a.EX, run_token(1, k, nloc, wid), rg);
    rows_lo(rA, idE, a.U8, loff); LOAD_H(hE0, hE1, run_token(0, k, nloc, wid)); rows_hi(rB, idE, a.U8, loff);
#pragma unroll 1
    for (int n = 0; n < N; n += 2) {
        const int t0 = run_token(n, k, nloc, wid), t1 = run_token(n + 1, k, nloc, wid);
        const int t2 = run_token((n + 2 < N) ? n + 2 : N - 1, k, nloc, wid), t3 = run_token((n + 3 < N) ? n + 3 : N - 1, k, nloc, wid);
        {
            f2_t h[8]; float p[16];
            unpack_h(h, hE0, hE1);
            dots8(p, rA, h);
            rows_lo(rA, idO, a.U8, loff); LOAD_H(hO0, hO1, t1);
            dots8(p + 8, rB, h);
            rows_hi(rB, idO, a.U8, loff);
            ids_load(idE, a.EX, t2, rg);
            peerU_finish(a, p, t0, s, lane);
        }
        {
            f2_t h[8]; float p[16];
            unpack_h(h, hO0, hO1);
            dots8(p, rA, h);
            rows_lo(rA, idE, a.U8, loff); LOAD_H(hE0, hE1, t2);
            dots8(p + 8, rB, h);
            rows_hi(rB, idE, a.U8, loff);
            ids_load(idO, a.EX, t3, rg);
            peerU_finish(a, p, t1, s, lane);
        }
    }
#undef LOAD_H
}

DI void peerR_tile(const PSArgs& a, int tile, int wid) {
    const int tid = get_tid(wid);
    const int lane = tid & 63;
#pragma unroll 1
    for (int ti = 0; ti < 8; ++ti) {
        const int tok = tile * 64 + wid * 8 + ti;
        float d0 = 0.f, d1 = 0.f;
#pragma unroll
        for (int x = 0; x < 8; ++x) { const float2 v = *(const float2*)(a.PD + ((size_t)x * NTOK + tok) * 128 + 2 * lane); d0 += v.x; d1 += v.y; }
        const int2 ex = *(const int2*)(a.EX + (size_t)tok * 128 + 2 * lane);
        const float2 gt = *(const float2*)(a.GT + (size_t)tok * 128 + 2 * lane);
        const float rs = a.RSTD[tok];
        float2 o;
        o.x = gelu_exact(d0 * a.SU[ex.x] * rs) * gt.x * a.SV[ex.x];
        o.y = gelu_exact(d1 * a.SU[ex.y] * rs) * gt.y * a.SV[ex.y];
        *(float2*)(a.COEF + (size_t)tok * 128 + 2 * lane) = o;
    }
}

struct Cf16 { f32x4 a, b, c, d; };
DI void cf_load(Cf16& q, const float* COEF, int tok, int rg) { const f32x4* p = (const f32x4*)(COEF + (size_t)tok * 128 + rg * 16); q.a = p[0]; q.b = p[1]; q.c = p[2]; q.d = p[3]; }
DI void axpy8(f2_t (&acc)[8], const u32x4 (&r)[8], const f32x4& c0, const f32x4& c1) {
    row_axpy8p(acc, r[0], c0.x); row_axpy8p(acc, r[1], c0.y); __builtin_amdgcn_sched_barrier(0);
    row_axpy8p(acc, r[2], c0.z); row_axpy8p(acc, r[3], c0.w); __builtin_amdgcn_sched_barrier(0);
    row_axpy8p(acc, r[4], c1.x); row_axpy8p(acc, r[5], c1.y); __builtin_amdgcn_sched_barrier(0);
    row_axpy8p(acc, r[6], c1.z); row_axpy8p(acc, r[7], c1.w); __builtin_amdgcn_sched_barrier(0);
}
DI void peerV_finish(const PSArgs& a, f2_t (&acc)[8], float2 xv, int tok, int s, int lane) {
    const int rg = lane >> 3, pc = lane & 7;
    const bool r2 = rg & 4, r1 = rg & 2, r0 = rg & 1;
    f2_t q4[4], q2[2], q1;
#pragma unroll
    for (int k = 0; k < 4; ++k) {
        const f2_t keep = r2 ? acc[k + 4] : acc[k], send = r2 ? acc[k] : acc[k + 4];
        q4[k] = (f2_t){keep.x + shx<32>(send.x, lane), keep.y + shx<32>(send.y, lane)};
    }
#pragma unroll
    for (int k = 0; k < 2; ++k) {
        const f2_t keep = r1 ? q4[k + 2] : q4[k], send = r1 ? q4[k] : q4[k + 2];
        q2[k] = (f2_t){keep.x + shx<16>(send.x, lane), keep.y + shx<16>(send.y, lane)};
    }
    {
        const f2_t keep = r0 ? q2[1] : q2[0], send = r0 ? q2[0] : q2[1];
        q1 = (f2_t){keep.x + shx<8>(send.x, lane), keep.y + shx<8>(send.y, lane)};
    }
    xv.x += q1.x; xv.y += q1.y;
    *(float2*)(a.Xout + (size_t)tok * DM + s * 128 + 16 * pc + 2 * rg) = xv;
}

DI void peerV_run(const PSArgs& a, int s, int k, int nloc, int wid) {
    const int tid = get_tid(wid);
    const int lane = tid & 63, rg = lane >> 3, pc = lane & 7;
    const unsigned loff = (unsigned)(s * (NEXP * 128) + pc * 16);
    const int N = 8 * ((NTOK / 64 - k + nloc - 1) / nloc);
    Ids16 idE, idO; Cf16 cfE, cfO; float2 xE, xO;
    u32x4 rA[8], rB[8];
#define LOAD_X(x_, tokv) { x_ = *(const float2*)(a.Xin + (size_t)(tokv) * DM + s * 128 + 16 * pc + 2 * rg); }
    ids_load(idE, a.EX, run_token(0, k, nloc, wid), rg);
    ids_load(idO, a.EX, run_token(1, k, nloc, wid), rg);
    rows_lo(rA, idE, a.V8, loff); cf_load(cfE, a.COEF, run_token(0, k, nloc, wid), rg); rows_hi(rB, idE, a.V8, loff); LOAD_X(xE, run_token(0, k, nloc, wid));
#pragma unroll 1
    for (int n = 0; n < N; n += 2) {
        const int t0 = run_token(n, k, nloc, wid), t1 = run_token(n + 1, k, nloc, wid);
        const int t2 = run_token((n + 2 < N) ? n + 2 : N - 1, k, nloc, wid), t3 = run_token((n + 3 < N) ? n + 3 : N - 1, k, nloc, wid);
        {
            f2_t acc[8];
#pragma unroll
            for (int i = 0; i < 8; ++i) acc[i] = (f2_t){0.f, 0.f};
            axpy8(acc, rA, cfE.a, cfE.b);
            rows_lo(rA, idO, a.V8, loff); cf_load(cfO, a.COEF, t1, rg);
            axpy8(acc, rB, cfE.c, cfE.d);
            rows_hi(rB, idO, a.V8, loff); LOAD_X(xO, t1);
            ids_load(idE, a.EX, t2, rg);
            peerV_finish(a, acc, xE, t0, s, lane);
        }
        {
            f2_t acc[8];
#pragma unroll
            for (int i = 0; i < 8; ++i) acc[i] = (f2_t){0.f, 0.f};
            axpy8(acc, rA, cfO.a, cfO.b);
            rows_lo(rA, idE, a.V8, loff); cf_load(cfE, a.COEF, t2, rg);
            axpy8(acc, rB, cfO.c, cfO.d);
            rows_hi(rB, idE, a.V8, loff); LOAD_X(xE, t2);
            ids_load(idO, a.EX, t3, rg);
            peerV_finish(a, acc, xO, t1, s, lane);
        }
    }
#undef LOAD_X
}

DI void final_norm_tile(float* X, const float* __restrict__ g, int tile, int wid) {
    const int tid = get_tid(wid);
    const int lane = tid & 63;
    const float* gf = g + lane * 16;
    const float4 g0 = *(const float4*)gf, g1 = *(const float4*)(gf + 4), g2 = *(const float4*)(gf + 8), g3 = *(const float4*)(gf + 12);
#pragma unroll 1
    for (int ti = 0; ti < 8; ++ti) {
        float* xp = X + (size_t)(tile * 64 + wid * 8 + ti) * DM + lane * 16;
        float4 x0 = *(const float4*)xp, x1 = *(const float4*)(xp + 4), x2 = *(const float4*)(xp + 8), x3 = *(const float4*)(xp + 12);
        float ss = x0.x * x0.x + x0.y * x0.y + x0.z * x0.z + x0.w * x0.w + x1.x * x1.x + x1.y * x1.y + x1.z * x1.z + x1.w * x1.w
                 + x2.x * x2.x + x2.y * x2.y + x2.z * x2.z + x2.w * x2.w + x3.x * x3.x + x3.y * x3.y + x3.z * x3.z + x3.w * x3.w;
        ss = wave_sum(ss, lane);
        const float rf = rsqrtf(ss * (1.f / 1024.f) + 1e-6f);
        x0.x *= rf * g0.x; x0.y *= rf * g0.y; x0.z *= rf * g0.z; x0.w *= rf * g0.w; x1.x *= rf * g1.x; x1.y *= rf * g1.y; x1.z *= rf * g1.z; x1.w *= rf * g1.w;
        x2.x *= rf * g2.x; x2.y *= rf * g2.y; x2.z *= rf * g2.z; x2.w *= rf * g2.w; x3.x *= rf * g3.x; x3.y *= rf * g3.y; x3.z *= rf * g3.z; x3.w *= rf * g3.w;
        *(float4*)xp = x0; *(float4*)(xp + 4) = x1; *(float4*)(xp + 8) = x2; *(float4*)(xp + 12) = x3;
    }
}
struct MegaArgs {
    const float* x; const float* a_re; const float* a_im; const float* log_dt; const float* b_re; const float* b_im; const float* c_re;
    const float* c_im; const float* d_skip; const float* b_glu; const float* pool_scale; const float* u_exp; const float* v_exp;
    const float* norm_final;
    PrepW pw;
    float* X; bf16_t* U; bf16_t* YPRE; bf16_t* G1; bf16_t* A2; bf16_t* Hb; bf16_t* Qb; int* EX; float* GT; float* RSTD;
    char* KT; bf16x8* WST; bf16x8* CCAR; float* ABT; fp8_t* U8; fp8_t* V8; float* SU; float* SV; float* PD; float* COEF;
    unsigned* bar;
};

#ifndef REP_P0
#define REP_P0 1
#endif
#ifndef REP_PA
#define REP_PA 1
#endif
#ifndef REP_PB
#define REP_PB 1
#endif
#ifndef REP_C1
#define REP_C1 1
#endif
#ifndef REP_C2
#define REP_C2 1
#endif
#ifndef REP_U
#define REP_U 1
#endif
#ifndef REP_R
#define REP_R 1
#endif
#ifndef REP_V
#define REP_V 1
#endif
__global__ void __launch_bounds__(NTHR) mega_kernel(MegaArgs a) {
    __shared__ __attribute__((aligned(16))) char smem[PB_BYTES];
    __shared__ uint4 xb_words;
    cg::grid_group grid = cg::this_grid();
    const int nblk = gridDim.x;
    const int wid = __builtin_amdgcn_readfirstlane(threadIdx.x >> 6);
    if (get_tid(wid) == 0) xb_words = make_uint4(0u, 0u, 0u, 0u);
    __syncthreads();
    const XcdBarrier xb = xcd_barrier_post(a.bar, (volatile LAS unsigned*)&xb_words, get_tid(wid));
    for (int rep = 0; rep < REP_P0; ++rep) {
        const size_t gtid = (size_t)blockIdx.x * NTHR + get_tid(wid), gs = (size_t)nblk * NTHR;
        for (int it = blockIdx.x; it < 256; it += nblk)
            prep_s5_item(it >> 2, it & 3, a.a_re, a.a_im, a.log_dt, a.b_re, a.b_im, a.c_re, a.c_im, a.d_skip, a.KT, a.WST, a.CCAR, a.ABT, smem, wid);
        prep_weights(a.pw, gtid, gs);
        {
            int tid = get_tid(wid);
            const int gwave = blockIdx.x * 8 + (tid >> 6), nwaves = nblk * 8, lane = tid & 63;
#pragma unroll 1
            for (int l = 0; l < 2; ++l) {
                conv_rows_fp8(a.u_exp + (size_t)l * NEXP * DM, a.pw.norm_ffn + l * DM, a.U8 + (size_t)l * NEXP * DM, a.SU + l * NEXP, NEXP, gwave, nwaves, lane);
                conv_rows_fp8(a.v_exp + (size_t)l * NEXP * DM, nullptr, a.V8 + (size_t)l * NEXP * DM, a.SV + l * NEXP, NEXP, gwave, nwaves, lane);
            }
        }
    }
    grid.sync();
    __shared__ int sched[4];
    if (get_tid(wid) == 0) {
        int nx = 0, myj = 0, nloc = 1;
        for (unsigned j = 0; j < 16; ++j) {
            const unsigned cj = xb_ld(&a.bar[XB_XCNT(j)]);
            if (j == xb.x) { myj = nx; nloc = (int)cj; }
            nx += (cj > 0u) ? 1 : 0;
        }
        sched[0] = (int)xb.st[2]; sched[1] = nloc > 0 ? nloc : 1; sched[2] = myj; sched[3] = nx > 0 ? nx : 1;
    }
    __syncthreads();
    const int s_rank = sched[0], s_nloc = sched[1], s_myj = sched[2], s_nx = sched[3];
#pragma unroll 1
    for (int l = 0; l < 2; ++l) {
        const float* xin = (l == 0) ? a.x : a.X;
        if (l == 0) {
            for (int rep = 0; rep < REP_PA; ++rep)
            for (int tile = blockIdx.x; tile < NTOK / 64; tile += nblk) phaseA_tile(xin, a.pw.wfin, a.U, tile, smem, wid);
        }
        xcd_barrier(xb, wid);
        bf16_t* Ul = a.U + (size_t)l * NTOK * DM;
        for (int rep = 0; rep < REP_PB; ++rep)
        for (int tile = blockIdx.x; tile < 256; tile += nblk)
            phaseB_tile(Ul, a.KT + (size_t)l * 32 * KT_BYTES, a.WST + (size_t)l * 32 * WST_FRAGS, a.CCAR + (size_t)l * 32 * CCAR_FRAGS, a.ABT + l * 32 * 128, a.YPRE, tile, smem, wid);
        xcd_barrier(xb, wid);
        PCArgs pa; pa.U = Ul; pa.YPRE = a.YPRE; pa.G1 = a.G1; pa.A2 = a.A2; pa.Xin = xin; pa.Xout = a.X; pa.Xdummy = (float*)a.Qb; pa.Hb = a.Hb; pa.RSTD = a.RSTD;
        pa.wfglu = a.pw.wfglu + (size_t)l * (512 * 512 / 8); pa.b_glu = a.b_glu + l * 512; pa.wfpool = a.pw.wfpool + (size_t)l * 4 * (128 * 128 / 8);
        pa.pool_scale = a.pool_scale + l * 512; pa.wfout = a.pw.wfout + (size_t)l * (DM * DM / 8);
        PRArgs pr; pr.Hb = a.Hb; pr.RSTD = a.RSTD; pr.Qb = a.Qb; pr.wfq = a.pw.wfq + (size_t)l * (DM * 2048 / 8); pr.wfk1 = a.pw.wfk1 + (size_t)l * (128 * 128 / 8);
        pr.wfk2 = a.pw.wfk2 + (size_t)l * (128 * 128 / 8); pr.EX = a.EX; pr.GT = a.GT;
        for (int tile = blockIdx.x; tile < NTOK / 64; tile += nblk) {
            for (int rep = 1; rep < REP_C1; ++rep) { PCArgs pa2 = pa; pa2.Xout = (float*)a.Qb; phaseC1_tile(pa2, tile, smem, wid); }
            phaseC1_tile(pa, tile, smem, wid);
            for (int rep = 0; rep < REP_C2; ++rep) phaseC2_tile(pr, tile, smem, wid);
        }
        xcd_barrier(xb, wid);
        PSArgs ps; ps.Hb = a.Hb; ps.RSTD = a.RSTD; ps.EX = a.EX; ps.GT = a.GT; ps.U8 = a.U8 + (size_t)l * NEXP * DM; ps.V8 = a.V8 + (size_t)l * NEXP * DM;
        ps.SU = a.SU + l * NEXP; ps.SV = a.SV + l * NEXP; ps.PD = a.PD; ps.COEF = a.COEF; ps.Xin = a.X; ps.Xout = a.X;
        for (int rep = 0; rep < REP_U; ++rep)
        for (int s = s_myj; s < 8; s += s_nx) peerU_run(ps, s, s_rank, s_nloc, wid);
        xcd_barrier(xb, wid);
        for (int rep = 0; rep < REP_R; ++rep)
        for (int tile = blockIdx.x; tile < NTOK / 64; tile += nblk) peerR_tile(ps, tile, wid);
        xcd_barrier(xb, wid);
        for (int rep = 1; rep < REP_V; ++rep) { PSArgs ps2 = ps; ps2.Xout = (float*)a.Qb; for (int s = s_myj; s < 8; s += s_nx) peerV_run(ps2, s, s_rank, s_nloc, wid); }
        for (int s = s_myj; s < 8; s += s_nx) peerV_run(ps, s, s_rank, s_nloc, wid);
        xcd_barrier(xb, wid);
        if (l == 0) {
            for (int rep = 0; rep < REP_PA; ++rep)
            for (int tile = blockIdx.x; tile < NTOK / 64; tile += nblk) phaseA_tile(a.X, a.pw.wfin + (size_t)(DM * DM / 8), a.U + (size_t)NTOK * DM, tile, smem, wid);
        } else {
            for (int tile = blockIdx.x; tile < NTOK / 64; tile += nblk) final_norm_tile(a.X, a.norm_final, tile, wid);
        }
    }
}

extern "C" void kernel_launch(void* const* d_in, const int* in_sizes, int n_in, void* d_out, int out_size, void* d_ws, size_t ws_size,
                              hipStream_t stream) {
    char* wsb = (char*)d_ws;
    size_t off = 0;
    auto take = [&](size_t bytes) { char* p = wsb + off; off += (bytes + 255) & ~(size_t)255; return p; };
    MegaArgs a;
    memset(&a, 0, sizeof(a));
    a.x = (const float*)d_in[0];
    a.pw.norm_mix = (const float*)d_in[1]; a.pw.w_in = (const float*)d_in[2];
    a.a_re = (const float*)d_in[3]; a.a_im = (const float*)d_in[4]; a.log_dt = (const float*)d_in[5];
    a.b_re = (const float*)d_in[6]; a.b_im = (const float*)d_in[7]; a.c_re = (const float*)d_in[8]; a.c_im = (const float*)d_in[9];
    a.d_skip = (const float*)d_in[10]; a.pw.w_glu = (const float*)d_in[11]; a.b_glu = (const float*)d_in[12];
    a.pw.w_pool = (const float*)d_in[13]; a.pool_scale = (const float*)d_in[14]; a.pw.g_out_ssm = (const float*)d_in[15];
    a.pw.g_out_pool = (const float*)d_in[16]; a.pw.w_out = (const float*)d_in[17]; a.pw.norm_ffn = (const float*)d_in[18];
    a.pw.w_q = (const float*)d_in[19]; a.pw.k1 = (const float*)d_in[20]; a.pw.k2 = (const float*)d_in[21];
    a.u_exp = (const float*)d_in[22]; a.v_exp = (const float*)d_in[23]; a.norm_final = (const float*)d_in[24];
    a.X = (float*)d_out;
    a.U = (bf16_t*)take((size_t)2 * NTOK * DM * 2);
    a.YPRE = (bf16_t*)take((size_t)NTOK * 512 * 2);
    a.G1 = (bf16_t*)take((size_t)NTOK * 512 * 2);
    a.A2 = (bf16_t*)take((size_t)NTOK * DM * 2);
    a.Hb = (bf16_t*)take((size_t)NTOK * DM * 2);
    a.Qb = (bf16_t*)take((size_t)NTOK * 2048 * 2);
    a.EX = (int*)take((size_t)NTOK * 128 * 4);
    a.GT = (float*)take((size_t)NTOK * 128 * 4);
    a.RSTD = (float*)take(NTOK * 4);
    a.pw.wfin = (bf16x8*)take((size_t)2 * DM * DM * 2);
    a.pw.wfglu = (bf16x8*)take((size_t)2 * 512 * 512 * 2);
    a.pw.wfpool = (bf16x8*)take((size_t)2 * 4 * 128 * 128 * 2);
    a.pw.wfout = (bf16x8*)take((size_t)2 * DM * DM * 2);
    a.pw.wfq = (bf16x8*)take((size_t)2 * DM * 2048 * 2);
    a.pw.wfk1 = (bf16x8*)take((size_t)2 * 128 * 128 * 2);
    a.pw.wfk2 = (bf16x8*)take((size_t)2 * 128 * 128 * 2);
    a.KT = take((size_t)64 * KT_BYTES);
    a.WST = (bf16x8*)take((size_t)64 * WST_FRAGS * 16);
    a.CCAR = (bf16x8*)take((size_t)64 * CCAR_FRAGS * 16);
    a.ABT = (float*)take(64 * 128 * 4);
    a.U8 = (fp8_t*)take((size_t)2 * NEXP * DM);
    a.V8 = (fp8_t*)take((size_t)2 * NEXP * DM);
    a.SU = (float*)take((size_t)2 * NEXP * 4);
    a.SV = (float*)take((size_t)2 * NEXP * 4);
    a.PD = (float*)take((size_t)8 * NTOK * 128 * 4);
    a.COEF = (float*)take((size_t)NTOK * 128 * 4);
    a.bar = (unsigned*)take((size_t)XCD_BAR_WORDS * 4);
    hipMemsetAsync(a.bar, 0, (size_t)XCD_BAR_WORDS * 4, stream);

    static int grid_blocks = 0;
    if (!grid_blocks) {
        int dev = 0, cus = 0, per_cu = 0;
        hipGetDevice(&dev);
        hipDeviceGetAttribute(&cus, hipDeviceAttributeMultiprocessorCount, dev);
        hipOccupancyMaxActiveBlocksPerMultiprocessor(&per_cu, mega_kernel, NTHR, 0);
        if (per_cu > 1) per_cu = 1;
        grid_blocks = cus * per_cu;
        if (grid_blocks > 256) grid_blocks = 256;
    }
    void* args[] = {&a};
    hipError_t e = hipLaunchCooperativeKernel((void*)mega_kernel, dim3(grid_blocks), dim3(NTHR), args, 0, stream);
    if (e != hipSuccess) fprintf(stderr, "cooperative launch failed: %s (grid %d)\n", hipGetErrorString(e), grid_blocks);
}
```

```cpp
#include <hip/hip_runtime.h>
#include <hip/hip_cooperative_groups.h>
#include <cstdio>
#include <cstring>
namespace cg = cooperative_groups;
#include <math.h>
#include <stdint.h>

#define NTOK 16384
#define SEQ 2048
#define DM 1024
#define SSMW 512
#define NEXP 16384

__device__ __forceinline__ float gelu_exact(float x) { return 0.5f * x * (1.f + erff(x * 0.70710678118654752f)); }

template <int M> __device__ __forceinline__ int shx_i(int v, int lane) {
    if constexpr (M == 1) return __builtin_amdgcn_mov_dpp(v, 0xB1, 0xF, 0xF, true);
    else if constexpr (M == 2) return __builtin_amdgcn_mov_dpp(v, 0x4E, 0xF, 0xF, true);
    else if constexpr (M < 32) return __builtin_amdgcn_ds_swizzle(v, (M << 10) | 0x1F);
    else return __builtin_amdgcn_ds_bpermute((lane ^ 32) << 2, v);
}
template <int M> __device__ __forceinline__ float shx(float v, int lane) { return __int_as_float(shx_i<M>(__float_as_int(v), lane)); }
__device__ __forceinline__ float wave_sum(float v, int lane) {
    v += shx<1>(v, lane); v += shx<2>(v, lane); v += shx<4>(v, lane); v += shx<8>(v, lane); v += shx<16>(v, lane); v += shx<32>(v, lane);
    return v;
}

__device__ __forceinline__ int get_tid(int wid) {
    int t = wid * 64 + (int)__builtin_amdgcn_mbcnt_hi(~0u, __builtin_amdgcn_mbcnt_lo(~0u, 0u));
    asm volatile("" : "+v"(t));
    return t;
}

#define DI __device__ __forceinline__
typedef __attribute__((ext_vector_type(8))) short bf16x8;
typedef __attribute__((ext_vector_type(16))) float f32x16;
typedef __attribute__((ext_vector_type(2))) __bf16 bf2_t;
typedef __attribute__((ext_vector_type(2))) float f2_t;
typedef unsigned short bf16_t;
typedef __attribute__((ext_vector_type(4))) unsigned u32x4;
typedef __attribute__((ext_vector_type(4))) float f32x4;
typedef const __attribute__((address_space(1))) bf16x8* gwp_t;
#define MFMA32(a, b, c) __builtin_amdgcn_mfma_f32_32x32x16_bf16((a), (b), (c), 0, 0, 0)

DI unsigned pack_bf2(float a, float b) { f2_t v = {a, b}; return __builtin_bit_cast(unsigned, __builtin_convertvector(v, bf2_t)); }
DI float bf_lo(unsigned u) { return __uint_as_float(u << 16); }
DI float bf_hi(unsigned u) { return __uint_as_float(u & 0xffff0000u); }
DI int crow(int reg, int h) { return (reg & 3) + 8 * (reg >> 2) + 4 * h; }

#define SA_STRIDE 272
#define SA_BYTES (64 * SA_STRIDE)
#define NTHR 512

template <bool GAIN>
DI void conv_wfrag(const float* __restrict__ src, int ldk, int ldn, const float* __restrict__ ga, const float* __restrict__ gb, int split,
                   int K, int N, int NTG, bf16x8* __restrict__ dst, size_t gtid, size_t gstride) {
    const int KS = K / 16;
    const size_t total = (size_t)(N / 32) * KS * 64;
    for (size_t item = gtid; item < total; item += gstride) {
        const int lane = (int)(item & 63); const size_t f = item >> 6;
        const int nti = (int)(f % NTG); const size_t f2 = f / NTG;
        const int ks = (int)(f2 % KS), nt = (int)(f2 / KS) * NTG + nti;
        const int r = lane & 31, h = lane >> 5;
        const int n = nt * 32 + r, k0 = ks * 16 + 8 * h;
        float v[8];
#pragma unroll
        for (int j = 0; j < 8; ++j) {
            const int k = k0 + j;
            float g = 1.f;
            if (GAIN) g = (k < split) ? ga[k] : gb[k - split];
            v[j] = src[(size_t)k * ldk + (size_t)n * ldn] * g;
        }
        uint4 o; o.x = pack_bf2(v[0], v[1]); o.y = pack_bf2(v[2], v[3]); o.z = pack_bf2(v[4], v[5]); o.w = pack_bf2(v[6], v[7]);
        *(uint4*)(dst + item) = o;
    }
}

DI void conv_rows_bf16(const float* __restrict__ src, const float* __restrict__ gain, bf16_t* __restrict__ dst, size_t nelem, size_t gtid, size_t gstride) {
    for (size_t i = gtid * 8; i < nelem; i += gstride * 8) {
        float4 a = *(const float4*)(src + i), b = *(const float4*)(src + i + 4);
        if (gain) {
            const int c = (int)(i & 1023);
            float4 g0 = *(const float4*)(gain + c), g1 = *(const float4*)(gain + c + 4);
            a.x *= g0.x; a.y *= g0.y; a.z *= g0.z; a.w *= g0.w; b.x *= g1.x; b.y *= g1.y; b.z *= g1.z; b.w *= g1.w;
        }
        uint4 o; o.x = pack_bf2(a.x, a.y); o.y = pack_bf2(a.z, a.w); o.z = pack_bf2(b.x, b.y); o.w = pack_bf2(b.z, b.w);
        *(uint4*)(dst + i) = o;
    }
}

struct ALoadF32 {
    const float* base; f32x4 v0, v1, v2, v3; float ss; int dofs;
    DI void init(const float* rowbase, int tid) { base = rowbase + (tid & 7) * 16; ss = 0.f; dofs = (tid >> 3) * SA_STRIDE + (tid & 7) * 32; }
    DI void issue(int c) { const f32x4* p = (const f32x4*)(base + c * 128); v0 = p[0]; v1 = p[1]; v2 = p[2]; v3 = p[3]; }
    DI void commit(char* buf) {
        u32x4 o0, o1;
        ss += v0.x * v0.x + v0.y * v0.y + v0.z * v0.z + v0.w * v0.w + v1.x * v1.x + v1.y * v1.y + v1.z * v1.z + v1.w * v1.w
            + v2.x * v2.x + v2.y * v2.y + v2.z * v2.z + v2.w * v2.w + v3.x * v3.x + v3.y * v3.y + v3.z * v3.z + v3.w * v3.w;
        o0.x = pack_bf2(v0.x, v0.y); o0.y = pack_bf2(v0.z, v0.w); o0.z = pack_bf2(v1.x, v1.y); o0.w = pack_bf2(v1.z, v1.w);
        o1.x = pack_bf2(v2.x, v2.y); o1.y = pack_bf2(v2.z, v2.w); o1.z = pack_bf2(v3.x, v3.y); o1.w = pack_bf2(v3.z, v3.w);
        char* d = buf + dofs;
        *(u32x4*)d = o0; *(u32x4*)(d + 16) = o1;
    }
};
struct ALoadBF16 {
    const bf16_t* base; u32x4 v0, v1; int dofs;
    DI void init(const bf16_t* rowbase, int tid) { base = rowbase + (tid & 7) * 16; dofs = (tid >> 3) * SA_STRIDE + (tid & 7) * 32; }
    DI void issue(int c) { const u32x4* p = (const u32x4*)(base + c * 128); v0 = p[0]; v1 = p[1]; }
    DI void commit(char* buf) {
        char* d = buf + dofs;
        *(u32x4*)d = v0; *(u32x4*)(d + 16) = v1;
    }
};

template <int NT, int PF, class AL>
DI void gemm64(f32x16 (&acc)[NT][2], AL& al, const int nchunks, const bf16x8* __restrict__ wf_, char* sA, const int lane) {
    gwp_t wf = (gwp_t)wf_;
    const int r = lane & 31, h = lane >> 5;
    bf16x8 bq[PF][NT];
    al.issue(0);
#pragma unroll
    for (int p = 0; p < PF; ++p)
#pragma unroll
        for (int nt = 0; nt < NT; ++nt) bq[p][nt] = wf[(p * NT + nt) * 64];
    gwp_t wpf = wf + PF * NT * 64;
    al.commit(sA);
    const int kend = nchunks * 8 - PF;
    int kg = 0;
#pragma unroll 1
    for (int c = 0; c < nchunks; ++c) {
        if (c + 1 < nchunks) al.issue(c + 1);
        __syncthreads();
        const char* buf = sA + (c & 1) * SA_BYTES + r * SA_STRIDE + h * 16;
#pragma unroll
        for (int ks = 0; ks < 8; ++ks) {
            const bf16x8 a0 = *(const bf16x8*)(buf + ks * 32);
            const bf16x8 a1 = *(const bf16x8*)(buf + 32 * SA_STRIDE + ks * 32);
#pragma unroll
            for (int nt = 0; nt < NT; ++nt) {
                acc[nt][0] = MFMA32(bq[ks % PF][nt], a0, acc[nt][0]);
                acc[nt][1] = MFMA32(bq[ks % PF][nt], a1, acc[nt][1]);
            }
            if (kg < kend) {
#pragma unroll
                for (int nt = 0; nt < NT; ++nt) bq[ks % PF][nt] = wpf[nt * 64];
            }
            wpf += NT * 64; ++kg;
            asm volatile("" : "+v"(wpf));
        }
        if (c + 1 < nchunks) al.commit(sA + ((c + 1) & 1) * SA_BYTES);
    }
    __syncthreads();
}

template <int NT>
DI void zero_acc(f32x16 (&acc)[NT][2]) {
#pragma unroll
    for (int nt = 0; nt < NT; ++nt)
#pragma unroll
        for (int mt = 0; mt < 2; ++mt)
#pragma unroll
            for (int i = 0; i < 16; ++i) acc[nt][mt][i] = 0.f;
}


DI void tile_transpose(const f32x16& t, float* wscr, int lane, f32x4 (&out)[4]) {
    const int r = lane & 31, h = lane >> 5;
#pragma unroll
    for (int q = 0; q < 4; ++q) { f32x4 v = {t[4 * q], t[4 * q + 1], t[4 * q + 2], t[4 * q + 3]}; *(f32x4*)(wscr + r * 36 + 8 * q + 4 * h) = v; }
#pragma unroll
    for (int j = 0; j < 4; ++j) out[j] = *(const f32x4*)(wscr + ((lane >> 3) + 8 * j) * 36 + (lane & 7) * 4);
}
#define WSCR_BYTES (32 * 36 * 4)

DI void phaseA_tile(const float* __restrict__ X, const bf16x8* __restrict__ wfin, bf16_t* __restrict__ U, int tile, char* smem, int wid) {
    char* sA = smem; float* srstd = (float*)(smem + 8 * WSCR_BYTES);
    int tok0 = tile * 64; asm volatile("" : "+s"(tok0));
    int tid = get_tid(wid);
    const int w = __builtin_amdgcn_readfirstlane(tid >> 6), lane = tid & 63, r = lane & 31, h = lane >> 5;
    ALoadF32 al; al.init(X + (size_t)(tok0 + (tid >> 3)) * DM, tid);
    f32x16 acc[4][2]; zero_acc<4>(acc);
    gemm64<4, 2>(acc, al, 8, wfin + (size_t)w * (64 * 4 * 64) + lane, sA, lane);
    float ss = al.ss;
    ss += shx<1>(ss, lane); ss += shx<2>(ss, lane); ss += shx<4>(ss, lane);
    if ((tid & 7) == 0) srstd[tid >> 3] = rsqrtf(ss * (1.f / 1024.f) + 1e-6f);
    __syncthreads();
    {
        float* wscr = (float*)(smem + w * WSCR_BYTES);
        const int tl = lane >> 3, cl = (lane & 7) * 4;
#pragma unroll
        for (int mt = 0; mt < 2; ++mt) {
            float rs[4];
#pragma unroll
            for (int j = 0; j < 4; ++j) rs[j] = srstd[mt * 32 + tl + 8 * j];
#pragma unroll
            for (int nt = 0; nt < 4; ++nt) {
                f32x4 o[4]; tile_transpose(acc[nt][mt], wscr, lane, o);
#pragma unroll
                for (int j = 0; j < 4; ++j) {
                    uint2 p; p.x = pack_bf2(o[j].x * rs[j], o[j].y * rs[j]); p.y = pack_bf2(o[j].z * rs[j], o[j].w * rs[j]);
                    *(uint2*)(U + (size_t)(tok0 + mt * 32 + tl + 8 * j) * DM + w * 128 + nt * 32 + cl) = p;
                }
            }
        }
    }
    __syncthreads();
}

struct PrepW {
    const float* norm_mix; const float* w_in; const float* w_glu; const float* w_pool; const float* g_out_ssm; const float* g_out_pool;
    const float* w_out; const float* norm_ffn; const float* w_q; const float* k1; const float* k2;
    bf16x8* wfin; bf16x8* wfglu; bf16x8* wfpool; bf16x8* wfout; bf16x8* wfq; bf16x8* wfk1; bf16x8* wfk2;
};
DI void prep_weights(const PrepW& p, size_t gtid, size_t gs) {
#pragma unroll 1
    for (int l = 0; l < 2; ++l) {
        conv_wfrag<true>(p.w_in + (size_t)l * DM * DM, DM, 1, p.norm_mix + l * DM, p.norm_mix + l * DM, DM, DM, DM, 4, p.wfin + (size_t)l * (DM * DM / 8), gtid, gs);
        conv_wfrag<false>(p.w_glu + (size_t)l * 512 * 512, 512, 1, p.norm_mix, p.norm_mix, 512, 512, 512, 2, p.wfglu + (size_t)l * (512 * 512 / 8), gtid, gs);
#pragma unroll 1
        for (int gi = 0; gi < 4; ++gi)
            conv_wfrag<false>(p.w_pool + (size_t)(l * 4 + gi) * 128 * 128, 128, 1, p.norm_mix, p.norm_mix, 128, 128, 128, 2, p.wfpool + (size_t)(l * 4 + gi) * (128 * 128 / 8), gtid, gs);
        conv_wfrag<true>(p.w_out + (size_t)l * DM * DM, DM, 1, p.g_out_ssm + l * 512, p.g_out_pool + l * 512, 512, DM, DM, 4, p.wfout + (size_t)l * (DM * DM / 8), gtid, gs);
        conv_wfrag<true>(p.w_q + (size_t)l * DM * 2048, 2048, 1, p.norm_ffn + l * DM, p.norm_ffn + l * DM, DM, DM, 2048, 4, p.wfq + (size_t)l * (DM * 2048 / 8), gtid, gs);
    }
}
#define KT_BLK 528
#define KT_BYTES (65 * KT_BLK)
#define WST_FRAGS (4 * 64 * 64)
#define CCAR_FRAGS (32 * 8 * 64)
#define SU_CH 2064

DI void prep_s5_item(int lg, int part, const float* __restrict__ a_re, const float* __restrict__ a_im, const float* __restrict__ log_dt,
                     const float* __restrict__ b_re, const float* __restrict__ b_im, const float* __restrict__ c_re, const float* __restrict__ c_im,
                     const float* __restrict__ d_skip, char* __restrict__ KT, bf16x8* __restrict__ WST, bf16x8* __restrict__ CCAR,
                     float* __restrict__ ABT, char* smem, int wid) {
    float* powr = (float*)smem;
    float* powi = powr + 65 * 64;
    float* bzr = powi + 65 * 64;
    float* bzi = bzr + 1024;
    float* cr = bzi + 1024;
    float* ci = cr + 1024;
    int tid = get_tid(wid);
    const float* are_p = a_re + lg * 64; const float* aim_p = a_im + lg * 64;
    const float dt = expf(log_dt[lg]);
    for (int it = tid; it < 65 * 64; it += NTHR) {
        const int tau = it >> 6, p = it & 63;
        const float lre = are_p[p], lim = aim_p[p];
        const float mag = expf((float)tau * lre * dt);
        double rev = (double)lim * (double)dt * (double)tau * 0.15915494309189535;
        rev -= floor(rev);
        const float ang = (float)rev * 6.283185307179586f;
        powr[it] = mag * cosf(ang); powi[it] = mag * sinf(ang);
    }
    for (int it = tid; it < 1024; it += NTHR) {
        cr[it] = c_re[lg * 1024 + it]; ci[it] = c_im[lg * 1024 + it];
    }
    __syncthreads();
    for (int it = tid; it < 1024; it += NTHR) {
        const int p = it >> 4;
        const float lre = are_p[p], lim = aim_p[p];
        const float ar = powr[64 + p], ai = powi[64 + p];
        const float inv = 1.f / (lre * lre + lim * lim), nre = ar - 1.f;
        const float zre = (nre * lre + ai * lim) * inv, zim = (ai * lre - nre * lim) * inv;
        const float br = b_re[lg * 1024 + it], bi = b_im[lg * 1024 + it];
        bzr[it] = zre * br - zim * bi; bzi[it] = zre * bi + zim * br;
    }
    __syncthreads();
    if (part == 0 && tid < 64) { ABT[lg * 128 + 2 * tid] = powr[64 * 64 + tid]; ABT[lg * 128 + 2 * tid + 1] = powi[64 * 64 + tid]; }
    char* kt = KT + (size_t)lg * KT_BYTES;
    if (part == 0) for (int it = tid; it < KT_BLK / 4; it += NTHR) ((unsigned*)kt)[it] = 0u;
    for (int it = part * (16 * 128) + tid; it < (part + 1) * (16 * 128); it += NTHR) {
        const int tau = it >> 7, ho = (it >> 3) & 15, hi = (it & 7) * 2;
        float s0 = 0.f, s1 = 0.f;
        for (int p = 0; p < 64; ++p) {
            const float c_r = cr[ho * 64 + p], c_i = ci[ho * 64 + p], pr = powr[tau * 64 + p], pi = powi[tau * 64 + p];
            const float cpr = c_r * pr - c_i * pi, cpi = c_r * pi + c_i * pr;
            s0 += cpr * bzr[p * 16 + hi] - cpi * bzi[p * 16 + hi];
            s1 += cpr * bzr[p * 16 + hi + 1] - cpi * bzi[p * 16 + hi + 1];
        }
        if (tau == 0) { if (ho == hi) s0 += d_skip[lg * 16 + ho]; if (ho == hi + 1) s1 += d_skip[lg * 16 + ho]; }
        *(unsigned*)(kt + (tau + 1) * KT_BLK + ho * 32 + hi * 2) = pack_bf2(s0, s1);
    }
    if (part == 0) for (int it = tid; it < 65 * 4; it += NTHR) ((unsigned*)(kt + (it >> 2) * KT_BLK + 512))[it & 3] = 0u;
    bf16x8* wst = WST + (size_t)lg * WST_FRAGS;
    for (int it = part * (WST_FRAGS / 4) + tid; it < (part + 1) * (WST_FRAGS / 4); it += NTHR) {
        const int lane = it & 63, j = (it >> 6) & 63, nt = it >> 12;
        const int r = lane & 31, h = lane >> 5, n = nt * 32 + r, p = n & 63, im = n >> 6;
        const float pr = powr[(63 - j) * 64 + p], pi = powi[(63 - j) * 64 + p];
        float v[8];
#pragma unroll
        for (int jj = 0; jj < 8; ++jj) {
            const float zr = bzr[p * 16 + 8 * h + jj], zi = bzi[p * 16 + 8 * h + jj];
            v[jj] = im ? (pr * zi + pi * zr) : (pr * zr - pi * zi);
        }
        uint4 o; o.x = pack_bf2(v[0], v[1]); o.y = pack_bf2(v[2], v[3]); o.z = pack_bf2(v[4], v[5]); o.w = pack_bf2(v[6], v[7]);
        *(uint4*)(wst + it) = o;
    }
    bf16x8* cc = CCAR + (size_t)lg * CCAR_FRAGS;
    for (int it = part * (CCAR_FRAGS / 4) + tid; it < (part + 1) * (CCAR_FRAGS / 4); it += NTHR) {
        const int lane = it & 63, ks = (it >> 6) & 7, mt = it >> 9;
        const int r = lane & 31, h = lane >> 5, m = mt * 32 + r, i = m >> 4, ho = m & 15;
        float v[8];
#pragma unroll
        for (int jj = 0; jj < 8; ++jj) {
            const int k = ks * 16 + 8 * h + jj, p = k & 63, im = k >> 6;
            const float c_r = cr[ho * 64 + p], c_i = ci[ho * 64 + p], pr = powr[(i + 1) * 64 + p], pi = powi[(i + 1) * 64 + p];
            v[jj] = im ? -(c_r * pi + c_i * pr) : (c_r * pr - c_i * pi);
        }
        uint4 o; o.x = pack_bf2(v[0], v[1]); o.y = pack_bf2(v[2], v[3]); o.z = pack_bf2(v[4], v[5]); o.w = pack_bf2(v[6], v[7]);
        *(uint4*)(cc + it) = o;
    }
    __syncthreads();
}

#define PB_SU 0
#define PB_SKT (32 * SU_CH)
#define PB_SL (PB_SKT + KT_BYTES)
#define PB_SPART (PB_SL + 32 * 132 * 4)
#define PB_SSP (PB_SPART + 4 * 4096)
#define PB_BYTES (PB_SSP + 32 * 272)

DI void phaseB_tile(const bf16_t* __restrict__ U, const char* __restrict__ KT, const bf16x8* __restrict__ WST, const bf16x8* __restrict__ CCAR,
                    const float* __restrict__ ABT, bf16_t* __restrict__ YPRE, int tile, char* smem, int wid) {
    const int g = tile & 31, b = tile >> 5;
    int tid = get_tid(wid);
    const int w = __builtin_amdgcn_readfirstlane(tid >> 6), lane = tid & 63, r = lane & 31, h = lane >> 5;
    char* sU = smem + PB_SU; char* sKT = smem + PB_SKT; float* sL = (float*)(smem + PB_SL); float* sPart = (float*)(smem + PB_SPART);
    char* sSp = smem + PB_SSP;
#pragma unroll
    for (int it = 0; it < 4; ++it) {
        const int tok = tid + NTHR * it;
        const uint4* src = (const uint4*)(U + (size_t)(b * SEQ + tok) * DM + g * 16);
        const uint4 v0 = src[0], v1 = src[1];
        char* d = sU + (tok >> 6) * SU_CH + (tok & 63) * 32;
        *(uint4*)d = v0; *(uint4*)(d + 16) = v1;
    }
    {
        const uint4* src = (const uint4*)(KT + (size_t)g * KT_BYTES);
        for (int it = tid; it < KT_BYTES / 16; it += NTHR) ((uint4*)sKT)[it] = src[it];
    }
    __syncthreads();
    {
        const int nt = w & 3, kh = w >> 2;
        f32x16 acc;
#pragma unroll
        for (int i = 0; i < 16; ++i) acc[i] = 0.f;
        const bf16x8* wp = WST + (size_t)g * WST_FRAGS + (size_t)(nt * 64 + kh * 32) * 64 + lane;
        const char* up = sU + r * SU_CH + h * 16 + kh * 32 * 32;
#pragma unroll 16
        for (int j = 0; j < 32; ++j) {
            const bf16x8 a = wp[j * 64];
            const bf16x8 bb = *(const bf16x8*)(up + j * 32);
            acc = MFMA32(a, bb, acc);
        }
        if (kh == 1) {
#pragma unroll
            for (int i = 0; i < 16; ++i) sPart[(nt * 16 + i) * 64 + lane] = acc[i];
        }
        __syncthreads();
        if (kh == 0) {
#pragma unroll
            for (int i = 0; i < 16; ++i) sL[r * 132 + nt * 32 + crow(i, h)] = acc[i] + sPart[(nt * 16 + i) * 64 + lane];
        }
        __syncthreads();
    }
    if (tid < 64) {
        const int p = tid;
        const float ar = ABT[g * 128 + 2 * p], ai = ABT[g * 128 + 2 * p + 1];
        float sr = 0.f, si = 0.f;
        for (int c = 0; c < 32; ++c) {
            *(bf16_t*)(sSp + c * 272 + p * 2) = (bf16_t)(pack_bf2(sr, 0.f) & 0xffffu);
            *(bf16_t*)(sSp + c * 272 + (64 + p) * 2) = (bf16_t)(pack_bf2(si, 0.f) & 0xffffu);
            const float lr = sL[c * 132 + p], li = sL[c * 132 + 64 + p];
            const float nr = ar * sr - ai * si + lr, ni = ar * si + ai * sr + li;
            sr = nr; si = ni;
        }
    }
    f32x16 acc4[4];
#pragma unroll
    for (int q = 0; q < 4; ++q)
#pragma unroll
        for (int i = 0; i < 16; ++i) acc4[q][i] = 0.f;
    const int mts0 = w, mts1 = 15 - w, mts2 = 16 + w, mts3 = 31 - w;
    {
        const char* up = sU + r * SU_CH + h * 16;
        const char* kp = sKT + (r & 15) * 32 + h * 16 + ((r >> 4) + 1) * KT_BLK;
        for (int j = 0; j < 64; ++j) {
            const bf16x8 bb = *(const bf16x8*)(up + j * 32);
#define TOEP_STEP(q, mt) if (2 * (mt) + 1 >= j) { const bf16x8 a = *(const bf16x8*)(kp + (2 * (mt) - j) * KT_BLK); acc4[q] = MFMA32(a, bb, acc4[q]); }
            TOEP_STEP(0, mts0) TOEP_STEP(1, mts1) TOEP_STEP(2, mts2) TOEP_STEP(3, mts3)
#undef TOEP_STEP
        }
    }
    __syncthreads();
    {
        const bf16x8* cp = CCAR + (size_t)g * CCAR_FRAGS + lane;
        const char* sp = sSp + r * 272 + h * 16;
#pragma unroll
        for (int ks = 0; ks < 8; ++ks) {
            const bf16x8 bb = *(const bf16x8*)(sp + ks * 32);
            acc4[0] = MFMA32(cp[(mts0 * 8 + ks) * 64], bb, acc4[0]);
            acc4[1] = MFMA32(cp[(mts1 * 8 + ks) * 64], bb, acc4[1]);
            acc4[2] = MFMA32(cp[(mts2 * 8 + ks) * 64], bb, acc4[2]);
            acc4[3] = MFMA32(cp[(mts3 * 8 + ks) * 64], bb, acc4[3]);
        }
    }
    {
        bf16_t* ybase = YPRE + (size_t)(b * SEQ + r * 64) * 512 + g * 16;
#define PB_STORE(q, mt) _Pragma("unroll") for (int rq = 0; rq < 4; ++rq) { const int c0 = 8 * rq + 4 * h; const int i = 2 * (mt) + (c0 >> 4); \
            uint2 o; o.x = pack_bf2(acc4[q][4 * rq], acc4[q][4 * rq + 1]); o.y = pack_bf2(acc4[q][4 * rq + 2], acc4[q][4 * rq + 3]); \
            *(uint2*)(ybase + (size_t)i * 512 + (c0 & 15)) = o; }
        PB_STORE(0, mts0) PB_STORE(1, mts1) PB_STORE(2, mts2) PB_STORE(3, mts3)
#undef PB_STORE
    }
    __syncthreads();
}

#ifndef REP_GLU
#define REP_GLU 1
#endif
#ifndef REP_POOL
#define REP_POOL 1
#endif
#ifndef REP_OUT
#define REP_OUT 1
#endif
#ifndef REP_Q
#define REP_Q 1
#endif
#ifndef REP_SC
#define REP_SC 1
#endif
struct ALoadGelu {
    const bf16_t* base; bf16_t* gout; u32x4 v0, v1; int cc; int dofs;
    DI void init(const bf16_t* rowbase, bf16_t* growbase, int tid) { base = rowbase + (tid & 7) * 16; gout = growbase + (tid & 7) * 16; dofs = (tid >> 3) * SA_STRIDE + (tid & 7) * 32; }
    DI void issue(int c) { const u32x4* p = (const u32x4*)(base + c * 128); v0 = p[0]; v1 = p[1]; cc = c; }
    DI unsigned g2(unsigned u) { return pack_bf2(gelu_exact(bf_lo(u)), gelu_exact(bf_hi(u))); }
    DI void commit(char* buf) {
        u32x4 o0, o1;
        o0.x = g2(v0.x); o0.y = g2(v0.y); o0.z = g2(v0.z); o0.w = g2(v0.w);
        o1.x = g2(v1.x); o1.y = g2(v1.y); o1.z = g2(v1.z); o1.w = g2(v1.w);
        char* d = buf + dofs;
        *(u32x4*)d = o0; *(u32x4*)(d + 16) = o1;
        u32x4* gp = (u32x4*)(gout + cc * 128); gp[0] = o0; gp[1] = o1;
    }
};

DI void tok_reduce(float p0, float p1, float* sred, float& t0, float& t1, int tid) {
    const int w = tid >> 6, lane = tid & 63, r = lane & 31, h = lane >> 5;
    __syncthreads();
    sred[(w * 2 + h) * 64 + r] = p0; sred[(w * 2 + h) * 64 + 32 + r] = p1;
    __syncthreads();
    float a = 0.f, b = 0.f;
#pragma unroll
    for (int k = 0; k < 16; ++k) { a += sred[k * 64 + r]; b += sred[k * 64 + 32 + r]; }
    t0 = a; t1 = b;
}

#define PC_SRED (4 * SA_BYTES)
#define PC_BYTES (PC_SRED + 4096 + 256)

struct PCArgs {
    const bf16_t* U; const bf16_t* YPRE; bf16_t* G1; bf16_t* A2; const float* Xin; float* Xout; float* Xdummy; bf16_t* Hb; float* RSTD;
    const bf16x8* wfglu; const float* b_glu; const bf16x8* wfpool; const float* pool_scale; const bf16x8* wfout;
};

DI void phaseC1_tile(const PCArgs& a, int tile, char* smem, int wid) {
    char* sA = smem; float* sred = (float*)(smem + PC_SRED);
    for (int rep_ = 0; rep_ < REP_GLU; ++rep_) {
        int tok0 = tile * 64; asm volatile("" : "+s"(tok0));
        int tid = get_tid(wid);
        const int w = __builtin_amdgcn_readfirstlane(tid >> 6), lane = tid & 63, r = lane & 31, h = lane >> 5;
        ALoadGelu al; al.init(a.YPRE + (size_t)(tok0 + (tid >> 3)) * 512, a.G1 + (size_t)(tok0 + (tid >> 3)) * 512, tid);
        f32x16 acc[2][2]; zero_acc<2>(acc);
        gemm64<2, 4>(acc, al, 4, a.wfglu + (size_t)w * (32 * 2 * 64) + lane, sA, lane);
        float ss0 = 0.f, ss1 = 0.f;
        {
            uint2 yp[2][2][4]; float4 bg[2][4];
#pragma unroll
            for (int nt = 0; nt < 2; ++nt)
#pragma unroll
                for (int q = 0; q < 4; ++q) bg[nt][q] = *(const float4*)(a.b_glu + w * 64 + nt * 32 + 8 * q + 4 * h);
#pragma unroll
            for (int mt = 0; mt < 2; ++mt)
#pragma unroll
                for (int nt = 0; nt < 2; ++nt)
#pragma unroll
                    for (int q = 0; q < 4; ++q)
                        yp[mt][nt][q] = *(const uint2*)(a.G1 + (size_t)(tok0 + mt * 32 + r) * 512 + w * 64 + nt * 32 + 8 * q + 4 * h);
#pragma unroll
            for (int mt = 0; mt < 2; ++mt)
#pragma unroll
                for (int nt = 0; nt < 2; ++nt)
#pragma unroll
                    for (int q = 0; q < 4; ++q) {
                        const float y0 = bf_lo(yp[mt][nt][q].x), y1 = bf_hi(yp[mt][nt][q].x), y2 = bf_lo(yp[mt][nt][q].y), y3 = bf_hi(yp[mt][nt][q].y);
                        const float o0 = y0 / (1.f + __expf(-(acc[nt][mt][4 * q] + bg[nt][q].x)));
                        const float o1 = y1 / (1.f + __expf(-(acc[nt][mt][4 * q + 1] + bg[nt][q].y)));
                        const float o2 = y2 / (1.f + __expf(-(acc[nt][mt][4 * q + 2] + bg[nt][q].z)));
                        const float o3 = y3 / (1.f + __expf(-(acc[nt][mt][4 * q + 3] + bg[nt][q].w)));
                        acc[nt][mt][4 * q] = o0; acc[nt][mt][4 * q + 1] = o1; acc[nt][mt][4 * q + 2] = o2; acc[nt][mt][4 * q + 3] = o3;
                        const float s = o0 * o0 + o1 * o1 + o2 * o2 + o3 * o3;
                        if (mt == 0) ss0 += s; else ss1 += s;
                    }
        }
        float t0, t1; tok_reduce(ss0, ss1, sred, t0, t1, tid);
        const float rs0 = rsqrtf(t0 * (1.f / 512.f) + 1e-6f), rs1 = rsqrtf(t1 * (1.f / 512.f) + 1e-6f);
#pragma unroll
        for (int mt = 0; mt < 2; ++mt) {
            const float rs = mt ? rs1 : rs0;
            bf16_t* orow = a.A2 + (size_t)(tok0 + mt * 32 + r) * DM + w * 64;
#pragma unroll
            for (int nt = 0; nt < 2; ++nt)
#pragma unroll
                for (int q = 0; q < 4; ++q) {
                    uint2 o; o.x = pack_bf2(acc[nt][mt][4 * q] * rs, acc[nt][mt][4 * q + 1] * rs);
                    o.y = pack_bf2(acc[nt][mt][4 * q + 2] * rs, acc[nt][mt][4 * q + 3] * rs);
                    *(uint2*)(orow + nt * 32 + 8 * q + 4 * h) = o;
                }
        }
    }
    for (int rep_ = 0; rep_ < REP_POOL; ++rep_) {
        int tok0 = tile * 64; asm volatile("" : "+s"(tok0));
        int tid = get_tid(wid);
        const int w = __builtin_amdgcn_readfirstlane(tid >> 6), lane = tid & 63, r = lane & 31, h = lane >> 5;
        const int row = tid >> 3, seg = tid & 7;
        const int tok = tok0 + row, t = tok & (SEQ - 1);
#pragma unroll
        for (int gi = 0; gi < 4; ++gi) {
            const int win = 2 << gi;
            const int cnt = (t + 1 < win) ? (t + 1) : win;
            const bf16_t* up = a.U + (size_t)tok * DM + 512 + gi * 128 + seg * 16;
            float s[16];
            const uint4 c0 = *(const uint4*)up, c1 = *(const uint4*)(up + 8);
            const unsigned cu[8] = {c0.x, c0.y, c0.z, c0.w, c1.x, c1.y, c1.z, c1.w};
#pragma unroll
            for (int i = 0; i < 8; ++i) { s[2 * i] = bf_lo(cu[i]); s[2 * i + 1] = bf_hi(cu[i]); }
#pragma unroll
            for (int k0 = 1; k0 < win; k0 += 5) {
                uint4 d0[5], d1[5];
#pragma unroll
                for (int u = 0; u < 5; ++u)
                    if (k0 + u < win) {
                        const bf16_t* p = (k0 + u <= t) ? up - (size_t)(k0 + u) * DM : up;
                        d0[u] = *(const uint4*)p; d1[u] = *(const uint4*)(p + 8);
                    }
#pragma unroll
                for (int u = 0; u < 5; ++u)
                    if (k0 + u < win) {
                        const float m = (k0 + u <= t) ? 1.f : 0.f;
                        const unsigned du[8] = {d0[u].x, d0[u].y, d0[u].z, d0[u].w, d1[u].x, d1[u].y, d1[u].z, d1[u].w};
#pragma unroll
                        for (int i = 0; i < 8; ++i) { s[2 * i] = fmaf(m, bf_lo(du[i]), s[2 * i]); s[2 * i + 1] = fmaf(m, bf_hi(du[i]), s[2 * i + 1]); }
                    }
            }
            const float inv = 1.f / (float)cnt;
            unsigned o[8];
#pragma unroll
            for (int i = 0; i < 8; ++i) o[i] = pack_bf2(s[2 * i] * inv - bf_lo(cu[i]), s[2 * i + 1] * inv - bf_hi(cu[i]));
            char* d = sA + gi * SA_BYTES + row * SA_STRIDE + seg * 32;
            *(uint4*)d = make_uint4(o[0], o[1], o[2], o[3]); *(uint4*)(d + 16) = make_uint4(o[4], o[5], o[6], o[7]);
        }
        __syncthreads();
        const int gi = w >> 1;
        f32x16 acc[2][2]; zero_acc<2>(acc);
        const bf16x8* wp = a.wfpool + (size_t)gi * (128 * 128 / 8) + (size_t)(w & 1) * (8 * 2 * 64) + lane;
        const char* buf = sA + gi * SA_BYTES + r * SA_STRIDE + h * 16;
#pragma unroll
        for (int ks = 0; ks < 8; ++ks) {
            const bf16x8 a0 = *(const bf16x8*)(buf + ks * 32);
            const bf16x8 a1 = *(const bf16x8*)(buf + 32 * SA_STRIDE + ks * 32);
#pragma unroll
            for (int nt = 0; nt < 2; ++nt) {
                const bf16x8 wv = wp[(ks * 2 + nt) * 64];
                acc[nt][0] = MFMA32(wv, a0, acc[nt][0]);
                acc[nt][1] = MFMA32(wv, a1, acc[nt][1]);
            }
        }
        float ss0 = 0.f, ss1 = 0.f;
        float4 psc[2][4];
#pragma unroll
        for (int nt = 0; nt < 2; ++nt)
#pragma unroll
            for (int q = 0; q < 4; ++q) psc[nt][q] = *(const float4*)(a.pool_scale + w * 64 + nt * 32 + 8 * q + 4 * h);
#pragma unroll
        for (int mt = 0; mt < 2; ++mt)
#pragma unroll
            for (int nt = 0; nt < 2; ++nt)
#pragma unroll
                for (int q = 0; q < 4; ++q) {
                    const float4 sc = psc[nt][q];
                    const float o0 = acc[nt][mt][4 * q] * sc.x, o1 = acc[nt][mt][4 * q + 1] * sc.y, o2 = acc[nt][mt][4 * q + 2] * sc.z, o3 = acc[nt][mt][4 * q + 3] * sc.w;
                    acc[nt][mt][4 * q] = o0; acc[nt][mt][4 * q + 1] = o1; acc[nt][mt][4 * q + 2] = o2; acc[nt][mt][4 * q + 3] = o3;
                    const float s = o0 * o0 + o1 * o1 + o2 * o2 + o3 * o3;
                    if (mt == 0) ss0 += s; else ss1 += s;
                }
        float t0, t1; tok_reduce(ss0, ss1, sred, t0, t1, tid);
        const float rs0 = rsqrtf(t0 * (1.f / 512.f) + 1e-6f), rs1 = rsqrtf(t1 * (1.f / 512.f) + 1e-6f);
#pragma unroll
        for (int mt = 0; mt < 2; ++mt) {
            const float rs = mt ? rs1 : rs0;
            bf16_t* orow = a.A2 + (size_t)(tok0 + mt * 32 + r) * DM + 512 + w * 64;
#pragma unroll
            for (int nt = 0; nt < 2; ++nt)
#pragma unroll
                for (int q = 0; q < 4; ++q) {
                    uint2 o; o.x = pack_bf2(acc[nt][mt][4 * q] * rs, acc[nt][mt][4 * q + 1] * rs);
                    o.y = pack_bf2(acc[nt][mt][4 * q + 2] * rs, acc[nt][mt][4 * q + 3] * rs);
                    *(uint2*)(orow + nt * 32 + 8 * q + 4 * h) = o;
                }
        }
        __syncthreads();
    }
    for (int rep_ = 0; rep_ < REP_OUT; ++rep_) {
        float* xout_ = (rep_ + 1 < REP_OUT) ? a.Xdummy : a.Xout;
        int tok0 = tile * 64; asm volatile("" : "+s"(tok0));
        int tid = get_tid(wid);
        const int w = __builtin_amdgcn_readfirstlane(tid >> 6), lane = tid & 63, r = lane & 31, h = lane >> 5;
        ALoadBF16 al; al.init(a.A2 + (size_t)(tok0 + (tid >> 3)) * DM, tid);
        f32x16 acc[4][2]; zero_acc<4>(acc);
        gemm64<4, 2>(acc, al, 8, a.wfout + (size_t)w * (64 * 4 * 64) + lane, sA, lane);
        {
            float* wscr = (float*)(smem + w * WSCR_BYTES);
            const int tl = lane >> 3, cl = (lane & 7) * 4;
            float ssj[2][4];
#pragma unroll
            for (int mt = 0; mt < 2; ++mt)
#pragma unroll
                for (int j = 0; j < 4; ++j) ssj[mt][j] = 0.f;
            float4 xc[4], xn[4];
            const size_t rbase = (size_t)(tok0 + tl) * DM + w * 128 + cl;
#pragma unroll
            for (int j = 0; j < 4; ++j) xc[j] = *(const float4*)(a.Xin + rbase + (size_t)(8 * j) * DM);
#pragma unroll
            for (int g = 0; g < 8; ++g) {
                const int mt = g >> 2, nt = g & 3;
                if (g < 7) {
                    const size_t rn = rbase + (size_t)((g + 1) >> 2) * 32 * DM + ((g + 1) & 3) * 32;
#pragma unroll
                    for (int j = 0; j < 4; ++j) xn[j] = *(const float4*)(a.Xin + rn + (size_t)(8 * j) * DM);
                }
                f32x4 o[4]; tile_transpose(acc[nt][mt], wscr, lane, o);
                const size_t ro = rbase + (size_t)mt * 32 * DM + nt * 32;
#pragma unroll
                for (int j = 0; j < 4; ++j) {
                    float4 xo; xo.x = xc[j].x + o[j].x; xo.y = xc[j].y + o[j].y; xo.z = xc[j].z + o[j].z; xo.w = xc[j].w + o[j].w;
                    *(float4*)(xout_ + ro + (size_t)(8 * j) * DM) = xo;
                    uint2 p; p.x = pack_bf2(xo.x, xo.y); p.y = pack_bf2(xo.z, xo.w);
                    *(uint2*)(a.Hb + ro + (size_t)(8 * j) * DM) = p;
                    ssj[mt][j] += xo.x * xo.x + xo.y * xo.y + xo.z * xo.z + xo.w * xo.w;
                }
                asm volatile("" ::: "memory");
#pragma unroll
                for (int j = 0; j < 4; ++j) xc[j] = xn[j];
            }
#pragma unroll
            for (int mt = 0; mt < 2; ++mt)
#pragma unroll
                for (int j = 0; j < 4; ++j) {
                    float v = ssj[mt][j];
                    v += shx<1>(v, lane); v += shx<2>(v, lane); v += shx<4>(v, lane);
                    if ((lane & 7) == 0) sred[w * 64 + mt * 32 + tl + 8 * j] = v;
                }
            __syncthreads();
            if (tid < 64) {
                float tot = 0.f;
#pragma unroll
                for (int k = 0; k < 8; ++k) tot += sred[k * 64 + tid];
                a.RSTD[tok0 + tid] = rsqrtf(tot * (1.f / 1024.f) + 1e-6f);
            }
        }
        __syncthreads();
    }
}

DI unsigned f2ord(float f) { const unsigned u = __float_as_uint(f); return u ^ ((u >> 31) ? 0xFFFFFFFFu : 0x80000000u); }
DI float ord2f(unsigned o) { return __uint_as_float((o & 0x80000000u) ? (o ^ 0x80000000u) : ~o); }
DI unsigned umax_(unsigned a, unsigned b) { return a > b ? a : b; }
DI unsigned umin_(unsigned a, unsigned b) { return a < b ? a : b; }

struct PRArgs {
    const bf16_t* Hb; const float* RSTD; const bf16x8* wfq; const bf16x8* kf1; const bf16x8* kf2; unsigned short* EX; float* GT;
};

DI void conv_kfrag(const float* __restrict__ K, bf16x8* __restrict__ dst, size_t gtid, size_t gstride) {
    for (size_t item = gtid; item < 8 * 4 * 64; item += gstride) {
        const int lane = (int)(item & 63), kt = (int)((item >> 6) & 3), ks = (int)(item >> 8);
        const int r = lane & 31, h = lane >> 5;
        float v[8];
#pragma unroll
        for (int j = 0; j < 8; ++j) v[j] = K[(size_t)(kt * 32 + r) * 128 + (ks >> 1) * 32 + 16 * (ks & 1) + 8 * (j >> 2) + 4 * h + (j & 3)];
        uint4 o; o.x = pack_bf2(v[0], v[1]); o.y = pack_bf2(v[2], v[3]); o.z = pack_bf2(v[4], v[5]); o.w = pack_bf2(v[6], v[7]);
        *(uint4*)(dst + item) = o;
    }
}

DI void bitonic_sort16(unsigned (&a)[16]) {
#pragma unroll
    for (int k = 2; k <= 16; k <<= 1)
#pragma unroll
        for (int j = k >> 1; j > 0; j >>= 1)
#pragma unroll
            for (int i = 0; i < 16; ++i) {
                const int l = i ^ j;
                if (l > i) {
                    const unsigned hi = umax_(a[i], a[l]), lo = umin_(a[i], a[l]);
                    if ((i & k) == 0) { a[i] = hi; a[l] = lo; } else { a[i] = lo; a[l] = hi; }
                }
            }
}
DI void bitonic_top16(unsigned (&a)[16], const unsigned (&b)[16]) {
#pragma unroll
    for (int i = 0; i < 16; ++i) a[i] = umax_(a[i], b[15 - i]);
#pragma unroll
    for (int j = 8; j > 0; j >>= 1)
#pragma unroll
        for (int i = 0; i < 16; ++i) {
            const int l = i ^ j;
            if (l > i) { const unsigned hi = umax_(a[i], a[l]), lo = umin_(a[i], a[l]); a[i] = hi; a[l] = lo; }
        }
}
DI void make_keys(unsigned (&x)[16], const f32x16& s, float rs, int nbase, int h) {
#pragma unroll
    for (int i = 0; i < 16; ++i) x[i] = (f2ord(s[i] * rs) & 0xFFFFFF80u) | (unsigned)(127 - (nbase + crow(i, h)));
}

#define PR_LIST_STRIDE 80
#define PR_SLIST (2 * SA_BYTES)
#define PR_SIDX (PR_SLIST + 8 * 32 * PR_LIST_STRIDE)

DI void phaseC2_tile(const PRArgs& a, int tile, char* smem, int wid) {
    char* sA = smem;
#pragma unroll 1
    for (int ps = 0; ps < 2; ++ps) {
        int tok0 = tile * 64; asm volatile("" : "+s"(tok0));
        int tid = get_tid(wid);
        const int w = __builtin_amdgcn_readfirstlane(tid >> 6), lane = tid & 63, r = lane & 31, h = lane >> 5;
        const int ng = ps * 8 + w, hd = ng >> 1, hf = ng & 1;
        bf16x8 qb[2][8];
        {
            ALoadBF16 al; al.init(a.Hb + (size_t)(tok0 + (tid >> 3)) * DM, tid);
            f32x16 acc[4][2]; zero_acc<4>(acc);
            gemm64<4, 2>(acc, al, 8, a.wfq + (size_t)ng * (64 * 4 * 64) + lane, sA, lane);
#pragma unroll
            for (int mt = 0; mt < 2; ++mt)
#pragma unroll
                for (int nt = 0; nt < 4; ++nt)
#pragma unroll
                    for (int s = 0; s < 2; ++s) {
                        u32x4 p;
                        p.x = pack_bf2(acc[nt][mt][8 * s], acc[nt][mt][8 * s + 1]); p.y = pack_bf2(acc[nt][mt][8 * s + 2], acc[nt][mt][8 * s + 3]);
                        p.z = pack_bf2(acc[nt][mt][8 * s + 4], acc[nt][mt][8 * s + 5]); p.w = pack_bf2(acc[nt][mt][8 * s + 6], acc[nt][mt][8 * s + 7]);
                        qb[mt][nt * 2 + s] = __builtin_bit_cast(bf16x8, p);
                    }
        }
        gwp_t kf = (gwp_t)(hf ? a.kf2 : a.kf1) + lane;
        unsigned Town[16];
#pragma unroll
        for (int mt = 0; mt < 2; ++mt) {
            f32x16 sc[4];
#pragma unroll
            for (int kt = 0; kt < 4; ++kt)
#pragma unroll
                for (int i = 0; i < 16; ++i) sc[kt][i] = 0.f;
#pragma unroll
            for (int ks = 0; ks < 8; ++ks) {
#pragma unroll
                for (int kt = 0; kt < 4; ++kt) sc[kt] = MFMA32(kf[(ks * 4 + kt) * 64], qb[mt][ks], sc[kt]);
                if (ks & 1) asm volatile("" ::: "memory");
            }
            const float rs = a.RSTD[tok0 + mt * 32 + r];
            unsigned L[16], S[16];
            make_keys(L, sc[0], rs, 0, h); bitonic_sort16(L);
#pragma unroll
            for (int kt = 1; kt < 4; ++kt) { make_keys(S, sc[kt], rs, kt * 32, h); bitonic_sort16(S); bitonic_top16(L, S); }
#pragma unroll
            for (int k = 0; k < 16; ++k) S[k] = (unsigned)shx_i<32>((int)L[k], lane);
            bitonic_top16(L, S);
            if (mt == hf) {
#pragma unroll
                for (int k = 0; k < 16; ++k) Town[k] = L[k];
            } else {
                char* dst = smem + PR_SLIST + (w * 32 + r) * PR_LIST_STRIDE + h * 32;
                u32x4 v0, v1;
                if (h == 0) { v0 = (u32x4){L[0], L[1], L[2], L[3]}; v1 = (u32x4){L[4], L[5], L[6], L[7]}; }
                else { v0 = (u32x4){L[8], L[9], L[10], L[11]}; v1 = (u32x4){L[12], L[13], L[14], L[15]}; }
                *(u32x4*)dst = v0; *(u32x4*)(dst + 16) = v1;
            }
        }
        __syncthreads();
        unsigned T0[16], T1[16];
        {
            const char* src = smem + PR_SLIST + ((w ^ 1) * 32 + r) * PR_LIST_STRIDE;
            const u32x4 p0 = *(const u32x4*)src, p1 = *(const u32x4*)(src + 16), p2 = *(const u32x4*)(src + 32), p3 = *(const u32x4*)(src + 48);
            const unsigned Tp[16] = {p0.x, p0.y, p0.z, p0.w, p1.x, p1.y, p1.z, p1.w, p2.x, p2.y, p2.z, p2.w, p3.x, p3.y, p3.z, p3.w};
#pragma unroll
            for (int k = 0; k < 16; ++k) { T0[k] = hf ? Tp[k] : Town[k]; T1[k] = hf ? Town[k] : Tp[k]; }
        }
        float v1[16], v2[16];
#pragma unroll
        for (int k = 0; k < 16; ++k) { v1[k] = ord2f(T0[k] & 0xFFFFFF80u); v2[k] = ord2f(T1[k] & 0xFFFFFF80u); }
        unsigned C[16];
#pragma unroll
        for (int b = 0; b < 16; ++b) C[b] = (f2ord(v1[0] + v2[b]) & 0xFFFFFF00u) | (unsigned)(255 - b);
#pragma unroll
        for (int aa = 1; aa < 16; ++aa)
#pragma unroll
            for (int b = 0; b < 16; ++b)
                if ((aa + 1) * (b + 1) <= 16) {
                    unsigned x = (f2ord(v1[aa] + v2[b]) & 0xFFFFFF00u) | (unsigned)(255 - (aa * 16 + b));
#pragma unroll
                    for (int k = (aa + 1) * (b + 1) - 1; k < 16; ++k) { const unsigned hi = umax_(C[k], x); x = umin_(C[k], x); C[k] = hi; }
                }
        unsigned* sI = (unsigned*)(smem + PR_SIDX) + (w * 64 + lane) * 9;
#pragma unroll
        for (int q = 0; q < 4; ++q) {
            unsigned p1 = 0u, p2 = 0u;
#pragma unroll
            for (int j = 0; j < 4; ++j) { p1 |= (127u - (T0[4 * q + j] & 0x7Fu)) << (8 * j); p2 |= (127u - (T1[4 * q + j] & 0x7Fu)) << (8 * j); }
            sI[q] = p1; sI[4 + q] = p2;
        }
        const unsigned char* sB = (const unsigned char*)sI;
        const float mx = ord2f(C[0] & 0xFFFFFF00u);
        float e[16]; float sum = 0.f; int ex[16];
#pragma unroll
        for (int k = 0; k < 16; ++k) {
            e[k] = __expf(ord2f(C[k] & 0xFFFFFF00u) - mx); sum += e[k];
            const unsigned ci = 255u - (C[k] & 0xFFu);
            ex[k] = (int)sB[ci >> 4] * 128 + (int)sB[16 + (ci & 15u)];
        }
        const float inv = 1.f / sum;
        const size_t ob = ((size_t)(tok0 + hf * 32 + r) * 8 + hd) * 16;
        if (h == 0) {
#pragma unroll
            for (int q = 0; q < 2; ++q) *(uint4*)(a.EX + ob + 8 * q) = make_uint4((unsigned)ex[8 * q] | ((unsigned)ex[8 * q + 1] << 16), (unsigned)ex[8 * q + 2] | ((unsigned)ex[8 * q + 3] << 16),
                                                                       (unsigned)ex[8 * q + 4] | ((unsigned)ex[8 * q + 5] << 16), (unsigned)ex[8 * q + 6] | ((unsigned)ex[8 * q + 7] << 16));
        } else {
#pragma unroll
            for (int q = 0; q < 4; ++q) *(float4*)(a.GT + ob + 4 * q) = make_float4(e[4 * q] * inv, e[4 * q + 1] * inv, e[4 * q + 2] * inv, e[4 * q + 3] * inv);
        }
        __syncthreads();
    }
}
typedef const __attribute__((address_space(1))) u32x4* grow_t;
typedef unsigned char fp8_t;

struct PGArgs {
    const bf16_t* Hb; const float* RSTD; const int* EX; const float* GT; const fp8_t* U8; const fp8_t* V8; const float* SU; const float* SV;
    const float* Xin; float* Xout; const float* gfinal; int final_norm;
};

DI void conv_row_fp8_one(float4 v0, float4 v1, float4 v2, float4 v3, const float* __restrict__ gain, fp8_t* __restrict__ dst, float* __restrict__ scales,
                         int nrows, int row, int lane) {
    if (gain) {
        const float4* g = (const float4*)(gain + lane * 16);
        const float4 g0 = g[0], g1 = g[1], g2 = g[2], g3 = g[3];
        v0.x *= g0.x; v0.y *= g0.y; v0.z *= g0.z; v0.w *= g0.w; v1.x *= g1.x; v1.y *= g1.y; v1.z *= g1.z; v1.w *= g1.w;
        v2.x *= g2.x; v2.y *= g2.y; v2.z *= g2.z; v2.w *= g2.w; v3.x *= g3.x; v3.y *= g3.y; v3.z *= g3.z; v3.w *= g3.w;
    }
    float m = fmaxf(fmaxf(fmaxf(fabsf(v0.x), fabsf(v0.y)), fmaxf(fabsf(v0.z), fabsf(v0.w))), fmaxf(fmaxf(fabsf(v1.x), fabsf(v1.y)), fmaxf(fabsf(v1.z), fabsf(v1.w))));
    m = fmaxf(m, fmaxf(fmaxf(fmaxf(fabsf(v2.x), fabsf(v2.y)), fmaxf(fabsf(v2.z), fabsf(v2.w))), fmaxf(fmaxf(fabsf(v3.x), fabsf(v3.y)), fmaxf(fabsf(v3.z), fabsf(v3.w)))));
    m = fmaxf(m, shx<1>(m, lane)); m = fmaxf(m, shx<2>(m, lane)); m = fmaxf(m, shx<4>(m, lane)); m = fmaxf(m, shx<8>(m, lane)); m = fmaxf(m, shx<16>(m, lane)); m = fmaxf(m, shx<32>(m, lane));
    const float sc = (m > 0.f) ? m * (1.f / 448.f) : 1.f;
    const float inv = 1.f / sc;
    u32x4 o;
    unsigned t;
    t = 0u; t = __builtin_amdgcn_cvt_pk_fp8_f32(v0.x * inv, v0.y * inv, t, false); t = __builtin_amdgcn_cvt_pk_fp8_f32(v0.z * inv, v0.w * inv, t, true); o.x = t;
    t = 0u; t = __builtin_amdgcn_cvt_pk_fp8_f32(v1.x * inv, v1.y * inv, t, false); t = __builtin_amdgcn_cvt_pk_fp8_f32(v1.z * inv, v1.w * inv, t, true); o.y = t;
    t = 0u; t = __builtin_amdgcn_cvt_pk_fp8_f32(v2.x * inv, v2.y * inv, t, false); t = __builtin_amdgcn_cvt_pk_fp8_f32(v2.z * inv, v2.w * inv, t, true); o.z = t;
    t = 0u; t = __builtin_amdgcn_cvt_pk_fp8_f32(v3.x * inv, v3.y * inv, t, false); t = __builtin_amdgcn_cvt_pk_fp8_f32(v3.z * inv, v3.w * inv, t, true); o.w = t;
    *(u32x4*)(dst + ((size_t)(lane >> 3) * nrows + row) * 128 + (lane & 7) * 16) = o;
    if (lane == 0) scales[row] = sc;
}
DI void conv_rows_fp8(const float* __restrict__ src, const float* __restrict__ gain, fp8_t* __restrict__ dst, float* __restrict__ scales,
                      int nrows, int gwave, int nwaves, int lane) {
#pragma unroll 1
    for (int row = gwave; row < nrows; row += 4 * nwaves) {
        const int r1 = min(row + nwaves, nrows - 1), r2 = min(row + 2 * nwaves, nrows - 1), r3 = min(row + 3 * nwaves, nrows - 1);
        const float4* p0 = (const float4*)(src + (size_t)row * DM + lane * 16);
        const float4* p1 = (const float4*)(src + (size_t)r1 * DM + lane * 16);
        const float4* p2 = (const float4*)(src + (size_t)r2 * DM + lane * 16);
        const float4* p3 = (const float4*)(src + (size_t)r3 * DM + lane * 16);
        const float4 a0 = p0[0], a1 = p0[1], a2 = p0[2], a3 = p0[3];
        const float4 b0 = p1[0], b1 = p1[1], b2 = p1[2], b3 = p1[3];
        const float4 c0 = p2[0], c1 = p2[1], c2 = p2[2], c3 = p2[3];
        const float4 d0 = p3[0], d1 = p3[1], d2 = p3[2], d3 = p3[3];
        conv_row_fp8_one(a0, a1, a2, a3, gain, dst, scales, nrows, row, lane);
        conv_row_fp8_one(b0, b1, b2, b3, gain, dst, scales, nrows, r1, lane);
        conv_row_fp8_one(c0, c1, c2, c3, gain, dst, scales, nrows, r2, lane);
        conv_row_fp8_one(d0, d1, d2, d3, gain, dst, scales, nrows, r3, lane);
    }
}

struct RowOct { u32x4 r0, r1, r2, r3, r4, r5, r6, r7; };
DI void oct_load(RowOct& q, const fp8_t* tab, int e0, int e1, int e2, int e3, int e4, int e5, int e6, int e7, int lane) {
    q.r0 = ((grow_t)(tab + (size_t)e0 * DM))[lane]; q.r1 = ((grow_t)(tab + (size_t)e1 * DM))[lane];
    q.r2 = ((grow_t)(tab + (size_t)e2 * DM))[lane]; q.r3 = ((grow_t)(tab + (size_t)e3 * DM))[lane];
    q.r4 = ((grow_t)(tab + (size_t)e4 * DM))[lane]; q.r5 = ((grow_t)(tab + (size_t)e5 * DM))[lane];
    q.r6 = ((grow_t)(tab + (size_t)e6 * DM))[lane]; q.r7 = ((grow_t)(tab + (size_t)e7 * DM))[lane];
}
DI float dot4w(unsigned w, float h0, float h1, float h2, float h3, float s) {
    const f2_t lo = __builtin_amdgcn_cvt_pk_f32_fp8(w, false), hi = __builtin_amdgcn_cvt_pk_f32_fp8(w, true);
    s = fmaf(lo.x, h0, s); s = fmaf(lo.y, h1, s); s = fmaf(hi.x, h2, s); s = fmaf(hi.y, h3, s);
    return s;
}
DI float row_dot8(const u32x4& r, const float (&h)[16]) {
    float s = 0.f;
    s = dot4w(r.x, h[0], h[1], h[2], h[3], s); s = dot4w(r.y, h[4], h[5], h[6], h[7], s);
    s = dot4w(r.z, h[8], h[9], h[10], h[11], s); s = dot4w(r.w, h[12], h[13], h[14], h[15], s);
    return s;
}
DI void axpy4w(unsigned w, float c, float& a0, float& a1, float& a2, float& a3) {
    const f2_t lo = __builtin_amdgcn_cvt_pk_f32_fp8(w, false), hi = __builtin_amdgcn_cvt_pk_f32_fp8(w, true);
    a0 = fmaf(c, lo.x, a0); a1 = fmaf(c, lo.y, a1); a2 = fmaf(c, hi.x, a2); a3 = fmaf(c, hi.y, a3);
}
DI void row_axpy8(float (&acc)[16], const u32x4& r, float c) {
    axpy4w(r.x, c, acc[0], acc[1], acc[2], acc[3]); axpy4w(r.y, c, acc[4], acc[5], acc[6], acc[7]);
    axpy4w(r.z, c, acc[8], acc[9], acc[10], acc[11]); axpy4w(r.w, c, acc[12], acc[13], acc[14], acc[15]);
}
#define RL(v, l) __builtin_amdgcn_readlane((v), (l))
#define RLF(v, l) __uint_as_float((unsigned)__builtin_amdgcn_readlane((int)__float_as_uint(v), (l)))

DI float reduce16(float (&p)[16], int lane) {
    const bool b5 = lane & 32, b4 = lane & 16, b3 = lane & 8, b2 = lane & 4;
    float q8[8], q4[4], q2[2];
#pragma unroll
    for (int k = 0; k < 8; ++k) { const float keep = b5 ? p[k + 8] : p[k], send = b5 ? p[k] : p[k + 8]; q8[k] = keep + shx<32>(send, lane); }
#pragma unroll
    for (int k = 0; k < 4; ++k) { const float keep = b4 ? q8[k + 4] : q8[k], send = b4 ? q8[k] : q8[k + 4]; q4[k] = keep + shx<16>(send, lane); }
#pragma unroll
    for (int k = 0; k < 2; ++k) { const float keep = b3 ? q4[k + 2] : q4[k], send = b3 ? q4[k] : q4[k + 2]; q2[k] = keep + shx<8>(send, lane); }
    float t;
    { const float keep = b2 ? q2[1] : q2[0], send = b2 ? q2[0] : q2[1]; t = keep + shx<4>(send, lane); }
    t += shx<1>(t, lane); t += shx<2>(t, lane);
    return t;
}

DI void phaseC3_tile(const PGArgs& a, int tile, int wid) {
    int tid = get_tid(wid);
    const int w = __builtin_amdgcn_readfirstlane(tid >> 6), lane = tid & 63;
    const int el = (lane >> 2) & 15;
#pragma unroll 1
    for (int ti = 0; ti < 8; ++ti) {
        const int tok = tile * 64 + w * 8 + ti;
        float h[16];
        {
            const u32x4* hp = (const u32x4*)(a.Hb + (size_t)tok * DM + lane * 16);
            const u32x4 h0 = hp[0], h1 = hp[1];
            h[0] = bf_lo(h0.x); h[1] = bf_hi(h0.x); h[2] = bf_lo(h0.y); h[3] = bf_hi(h0.y); h[4] = bf_lo(h0.z); h[5] = bf_hi(h0.z); h[6] = bf_lo(h0.w); h[7] = bf_hi(h0.w);
            h[8] = bf_lo(h1.x); h[9] = bf_hi(h1.x); h[10] = bf_lo(h1.y); h[11] = bf_hi(h1.y); h[12] = bf_lo(h1.z); h[13] = bf_hi(h1.z); h[14] = bf_lo(h1.w); h[15] = bf_hi(h1.w);
        }
        const float rs = a.RSTD[tok];
        float acc[16];
#pragma unroll
        for (int i = 0; i < 16; ++i) acc[i] = 0.f;
#pragma unroll 1
        for (int hd = 0; hd < 8; ++hd) {
            const size_t eb = ((size_t)tok * 8 + hd) * 16;
            const int exv = a.EX[eb + (lane & 15)];
            const int exl = a.EX[eb + el];
            const float coef = a.GT[eb + el] * a.SV[exl];
            const float su = a.SU[exl] * rs;
            RowOct qa, qb;
            float p[16];
            oct_load(qa, a.U8, RL(exv, 0), RL(exv, 1), RL(exv, 2), RL(exv, 3), RL(exv, 4), RL(exv, 5), RL(exv, 6), RL(exv, 7), lane);
            oct_load(qb, a.U8, RL(exv, 8), RL(exv, 9), RL(exv, 10), RL(exv, 11), RL(exv, 12), RL(exv, 13), RL(exv, 14), RL(exv, 15), lane);
            p[0] = row_dot8(qa.r0, h); p[1] = row_dot8(qa.r1, h); p[2] = row_dot8(qa.r2, h); p[3] = row_dot8(qa.r3, h);
            p[4] = row_dot8(qa.r4, h); p[5] = row_dot8(qa.r5, h); p[6] = row_dot8(qa.r6, h); p[7] = row_dot8(qa.r7, h);
            oct_load(qa, a.V8, RL(exv, 0), RL(exv, 1), RL(exv, 2), RL(exv, 3), RL(exv, 4), RL(exv, 5), RL(exv, 6), RL(exv, 7), lane);
            p[8] = row_dot8(qb.r0, h); p[9] = row_dot8(qb.r1, h); p[10] = row_dot8(qb.r2, h); p[11] = row_dot8(qb.r3, h);
            p[12] = row_dot8(qb.r4, h); p[13] = row_dot8(qb.r5, h); p[14] = row_dot8(qb.r6, h); p[15] = row_dot8(qb.r7, h);
            oct_load(qb, a.V8, RL(exv, 8), RL(exv, 9), RL(exv, 10), RL(exv, 11), RL(exv, 12), RL(exv, 13), RL(exv, 14), RL(exv, 15), lane);
            const float act = gelu_exact(reduce16(p, lane) * su) * coef;
            row_axpy8(acc, qa.r0, RLF(act, 0)); row_axpy8(acc, qa.r1, RLF(act, 4)); row_axpy8(acc, qa.r2, RLF(act, 8)); row_axpy8(acc, qa.r3, RLF(act, 12));
            row_axpy8(acc, qa.r4, RLF(act, 16)); row_axpy8(acc, qa.r5, RLF(act, 20)); row_axpy8(acc, qa.r6, RLF(act, 24)); row_axpy8(acc, qa.r7, RLF(act, 28));
            row_axpy8(acc, qb.r0, RLF(act, 32)); row_axpy8(acc, qb.r1, RLF(act, 36)); row_axpy8(acc, qb.r2, RLF(act, 40)); row_axpy8(acc, qb.r3, RLF(act, 44));
            row_axpy8(acc, qb.r4, RLF(act, 48)); row_axpy8(acc, qb.r5, RLF(act, 52)); row_axpy8(acc, qb.r6, RLF(act, 56)); row_axpy8(acc, qb.r7, RLF(act, 60));
        }
        const float* xi = a.Xin + (size_t)tok * DM + lane * 16;
        float* xo = a.Xout + (size_t)tok * DM + lane * 16;
        float4 x0 = *(const float4*)xi, x1 = *(const float4*)(xi + 4), x2 = *(const float4*)(xi + 8), x3 = *(const float4*)(xi + 12);
        x0.x += acc[0]; x0.y += acc[1]; x0.z += acc[2]; x0.w += acc[3]; x1.x += acc[4]; x1.y += acc[5]; x1.z += acc[6]; x1.w += acc[7];
        x2.x += acc[8]; x2.y += acc[9]; x2.z += acc[10]; x2.w += acc[11]; x3.x += acc[12]; x3.y += acc[13]; x3.z += acc[14]; x3.w += acc[15];
        if (a.final_norm) {
            float ss = x0.x * x0.x + x0.y * x0.y + x0.z * x0.z + x0.w * x0.w + x1.x * x1.x + x1.y * x1.y + x1.z * x1.z + x1.w * x1.w
                     + x2.x * x2.x + x2.y * x2.y + x2.z * x2.z + x2.w * x2.w + x3.x * x3.x + x3.y * x3.y + x3.z * x3.z + x3.w * x3.w;
            ss = wave_sum(ss, lane);
            const float rf = rsqrtf(ss * (1.f / 1024.f) + 1e-6f);
            const float* gf = a.gfinal + lane * 16;
            const float4 g0 = *(const float4*)gf, g1 = *(const float4*)(gf + 4), g2 = *(const float4*)(gf + 8), g3 = *(const float4*)(gf + 12);
            x0.x *= rf * g0.x; x0.y *= rf * g0.y; x0.z *= rf * g0.z; x0.w *= rf * g0.w; x1.x *= rf * g1.x; x1.y *= rf * g1.y; x1.z *= rf * g1.z; x1.w *= rf * g1.w;
            x2.x *= rf * g2.x; x2.y *= rf * g2.y; x2.z *= rf * g2.z; x2.w *= rf * g2.w; x3.x *= rf * g3.x; x3.y *= rf * g3.y; x3.z *= rf * g3.z; x3.w *= rf * g3.w;
        }
        *(float4*)xo = x0; *(float4*)(xo + 4) = x1; *(float4*)(xo + 8) = x2; *(float4*)(xo + 12) = x3;
    }
}
#define XB_TMO      128
#define XB_XCNT(j)  (256  + 64 * (j))
#define XB_XSUB(j)  (1280 + 64 * (j))
#define XB_XGEN(j)  (2304 + 64 * (j))
#define XB_TOP      3328
#define XB_TOPGEN   3392
#define XB_QUEUE(j) (3456 + 64 * (j))
#define XCD_BAR_WORDS (3456 + 64 * 64)
#define XB_SPIN_CAP (1u << 20)
#define LAS __attribute__((address_space(3)))

DI unsigned xb_ld(unsigned* p)              { return __hip_atomic_load(p, __ATOMIC_RELAXED, __HIP_MEMORY_SCOPE_AGENT); }
DI unsigned xb_add(unsigned* p, unsigned v) { return __hip_atomic_fetch_add(p, v, __ATOMIC_RELAXED, __HIP_MEMORY_SCOPE_AGENT); }
DI unsigned xb_xcc_id() { return (unsigned)__builtin_amdgcn_s_getreg((3 << 11) | 20) & 0xFu; }
#define XB_SPIN(cond, bar) do { unsigned _sp = 0; while (cond) { __builtin_amdgcn_s_sleep(1); \
    if ((++_sp & 255u) == 0u) { if (xb_ld(&(bar)[XB_TMO])) break; if (_sp > XB_SPIN_CAP) { atomicAdd(&(bar)[XB_TMO], 1u); break; } } } } while (0)

struct XcdBarrier { unsigned* bar; unsigned x; volatile LAS unsigned* st; };

DI XcdBarrier xcd_barrier_post(unsigned* bar, volatile LAS unsigned* st, int tid) {
    XcdBarrier b; b.bar = bar; b.x = xb_xcc_id(); b.st = st;
    if (tid == 0) st[2] = xb_add(&bar[XB_XCNT(b.x)], 1u);
    return b;
}
DI void xcd_barrier_complete(unsigned* bar, unsigned x, unsigned& nloc, unsigned& nx) {
    const unsigned G = gridDim.x * gridDim.y * gridDim.z;
    unsigned sum, cnt, mine, sp = 0u;
    for (;;) {
        sum = 0u; cnt = 0u; mine = 0u;
#pragma unroll
        for (unsigned j = 0; j < 16; ++j) { const unsigned c = xb_ld(&bar[XB_XCNT(j)]); sum += c; cnt += (c > 0u) ? 1u : 0u; mine = (j == x) ? c : mine; }
        if (sum == G) break;
        __builtin_amdgcn_s_sleep(1);
        if ((++sp & 255u) == 0u) { if (xb_ld(&bar[XB_TMO])) break; if (sp > XB_SPIN_CAP) { atomicAdd(&bar[XB_TMO], 1u); break; } }
    }
    nloc = mine > 0u ? mine : 1u; nx = cnt > 0u ? cnt : 1u;
}
DI void xcd_barrier(const XcdBarrier& b, int wid) {
    asm volatile("s_waitcnt vmcnt(0)" ::: "memory");
    __syncthreads();
    if (get_tid(wid) == 0) {
        unsigned* bar = b.bar;
        __builtin_amdgcn_s_waitcnt(0);
        unsigned nloc = b.st[0], nx = b.st[1];
        if (nloc == 0u) { xcd_barrier_complete(bar, b.x, nloc, nx); b.st[0] = nloc; b.st[1] = nx; }
        const unsigned old = xb_add(&bar[XB_XSUB(b.x)], 1u);
        const unsigned gen = old / nloc;
        if (old + 1u == (gen + 1u) * nloc) {
            __builtin_amdgcn_fence(__ATOMIC_RELEASE, "agent");
            asm volatile("s_waitcnt vmcnt(0)" ::: "memory");
            const unsigned og = xb_add(&bar[XB_TOP], 1u);
            const unsigned tg = og / nx;
            if (og + 1u == (tg + 1u) * nx) xb_add(&bar[XB_TOPGEN], 1u);
            else XB_SPIN(xb_ld(&bar[XB_TOPGEN]) == tg, bar);
            __builtin_amdgcn_fence(__ATOMIC_ACQUIRE, "agent");
            xb_add(&bar[XB_XGEN(b.x)], 1u);
            asm volatile("s_waitcnt vmcnt(0)" ::: "memory");
        } else {
            XB_SPIN(xb_ld(&bar[XB_XGEN(b.x)]) == gen, bar);
            __builtin_amdgcn_fence(__ATOMIC_ACQUIRE, "agent");
            asm volatile("s_waitcnt vmcnt(0)" ::: "memory");
        }
    }
    __syncthreads();
}
struct PSArgs {
    const bf16_t* Hb; const float* RSTD; const unsigned short* EX; const float* GT; const fp8_t* U8; const fp8_t* V8; const float* SU; const float* SV;
    float* PD; bf16_t* COEF; const float* Xin; float* Xout;
};

DI void dot4p(unsigned w, const f2_t& h01, const f2_t& h23, f2_t& s2) {
    const f2_t lo = __builtin_amdgcn_cvt_pk_f32_fp8(w, false), hi = __builtin_amdgcn_cvt_pk_f32_fp8(w, true);
    s2 = __builtin_elementwise_fma(lo, h01, s2); s2 = __builtin_elementwise_fma(hi, h23, s2);
}
DI float row_dot8p(const u32x4& r, const f2_t (&h)[8]) {
    f2_t s2 = {0.f, 0.f};
    dot4p(r.x, h[0], h[1], s2); dot4p(r.y, h[2], h[3], s2); dot4p(r.z, h[4], h[5], s2); dot4p(r.w, h[6], h[7], s2);
    return s2.x + s2.y;
}
DI void axpy4p(unsigned w, const f2_t& c2, f2_t& a01, f2_t& a23) {
    const f2_t lo = __builtin_amdgcn_cvt_pk_f32_fp8(w, false), hi = __builtin_amdgcn_cvt_pk_f32_fp8(w, true);
    a01 = __builtin_elementwise_fma(c2, lo, a01); a23 = __builtin_elementwise_fma(c2, hi, a23);
}
DI void row_axpy8p(f2_t (&acc)[8], const u32x4& r, float c) {
    const f2_t c2 = {c, c};
    axpy4p(r.x, c2, acc[0], acc[1]); axpy4p(r.y, c2, acc[2], acc[3]); axpy4p(r.z, c2, acc[4], acc[5]); axpy4p(r.w, c2, acc[6], acc[7]);
}

DI int run_token(int n, int k, int nloc, int wid) { return (k + (n >> 3) * nloc) * 64 + wid * 8 + (n & 7); }

struct Ids16 { u32x4 a, b; };
DI void ids_load(Ids16& q, const unsigned short* EX, int tok, int rg) { const u32x4* p = (const u32x4*)(EX + (size_t)tok * 128 + rg * 16); q.a = p[0]; q.b = p[1]; }
#define ID_LO(w) (((w) & 0xFFFFu) * 128u + loff)
#define ID_HI(w) (((w) >> 16) * 128u + loff)
DI void rows_lo(u32x4 (&r)[8], const Ids16& q, const fp8_t* tab, unsigned loff) {
    r[0] = *(grow_t)(tab + ID_LO(q.a.x)); r[1] = *(grow_t)(tab + ID_HI(q.a.x)); r[2] = *(grow_t)(tab + ID_LO(q.a.y)); r[3] = *(grow_t)(tab + ID_HI(q.a.y));
    r[4] = *(grow_t)(tab + ID_LO(q.a.z)); r[5] = *(grow_t)(tab + ID_HI(q.a.z)); r[6] = *(grow_t)(tab + ID_LO(q.a.w)); r[7] = *(grow_t)(tab + ID_HI(q.a.w));
}
DI void rows_hi(u32x4 (&r)[8], const Ids16& q, const fp8_t* tab, unsigned loff) {
    r[0] = *(grow_t)(tab + ID_LO(q.b.x)); r[1] = *(grow_t)(tab + ID_HI(q.b.x)); r[2] = *(grow_t)(tab + ID_LO(q.b.y)); r[3] = *(grow_t)(tab + ID_HI(q.b.y));
    r[4] = *(grow_t)(tab + ID_LO(q.b.z)); r[5] = *(grow_t)(tab + ID_HI(q.b.z)); r[6] = *(grow_t)(tab + ID_LO(q.b.w)); r[7] = *(grow_t)(tab + ID_HI(q.b.w));
}
DI void unpack_h(f2_t (&h)[8], const u32x4& h0, const u32x4& h1) {
    h[0] = (f2_t){bf_lo(h0.x), bf_hi(h0.x)}; h[1] = (f2_t){bf_lo(h0.y), bf_hi(h0.y)}; h[2] = (f2_t){bf_lo(h0.z), bf_hi(h0.z)}; h[3] = (f2_t){bf_lo(h0.w), bf_hi(h0.w)};
    h[4] = (f2_t){bf_lo(h1.x), bf_hi(h1.x)}; h[5] = (f2_t){bf_lo(h1.y), bf_hi(h1.y)}; h[6] = (f2_t){bf_lo(h1.z), bf_hi(h1.z)}; h[7] = (f2_t){bf_lo(h1.w), bf_hi(h1.w)};
}
DI void dots8(float* p, const u32x4 (&r)[8], const f2_t (&h)[8]) {
#pragma unroll
    for (int i = 0; i < 8; ++i) { p[i] = row_dot8p(r[i], h); if ((i & 1) == 1) __builtin_amdgcn_sched_barrier(0); }
}
DI void peerU_finish(const PSArgs& a, float (&p)[16], int tok, int s, int lane) {
    const int rg = lane >> 3, pc = lane & 7;
    const bool b2 = pc & 4, b1 = pc & 2, b0 = pc & 1;
    float q8[8], q4[4], q2[2];
#pragma unroll
    for (int k = 0; k < 8; ++k) { const float keep = b2 ? p[k + 8] : p[k], send = b2 ? p[k] : p[k + 8]; q8[k] = keep + shx<4>(send, lane); }
#pragma unroll
    for (int k = 0; k < 4; ++k) { const float keep = b1 ? q8[k + 4] : q8[k], send = b1 ? q8[k] : q8[k + 4]; q4[k] = keep + shx<2>(send, lane); }
#pragma unroll
    for (int k = 0; k < 2; ++k) { const float keep = b0 ? q4[k + 2] : q4[k], send = b0 ? q4[k] : q4[k + 2]; q2[k] = keep + shx<1>(send, lane); }
    *(float2*)(a.PD + ((size_t)s * NTOK + tok) * 128 + rg * 16 + 2 * pc) = make_float2(q2[0], q2[1]);
}

DI void peerU_run(const PSArgs& a, int s, int k, int nloc, int wid) {
    const int tid = get_tid(wid);
    const int lane = tid & 63, rg = lane >> 3, pc = lane & 7;
    const unsigned loff = (unsigned)(s * (NEXP * 128) + pc * 16);
    const int hoff = s * 128 + pc * 16;
    const int N = 8 * ((NTOK / 64 - k + nloc - 1) / nloc);
    Ids16 idE, idO;
    u32x4 rA[8], rB[8], hE0, hE1, hO0, hO1;
#define LOAD_H(d0, d1, tokv) { const u32x4* hp_ = (const u32x4*)(a.Hb + (size_t)(tokv) * DM + hoff); d0 = hp_[0]; d1 = hp_[1]; }
    ids_load(idE, a.EX, run_token(0, k, nloc, wid), rg);
    ids_load(idO, a.EX, run_token(1, k, nloc, wid), rg);
    rows_lo(rA, idE, a.U8, loff); LOAD_H(hE0, hE1, run_token(0, k, nloc, wid)); rows_hi(rB, idE, a.U8, loff);
#pragma unroll 1
    for (int n = 0; n < N; n += 2) {
        const int t0 = run_token(n, k, nloc, wid), t1 = run_token(n + 1, k, nloc, wid);
        const int t2 = run_token((n + 2 < N) ? n + 2 : N - 1, k, nloc, wid), t3 = run_token((n + 3 < N) ? n + 3 : N - 1, k, nloc, wid);
        {
            f2_t h[8]; float p[16];
            unpack_h(h, hE0, hE1);
            dots8(p, rA, h);
            rows_lo(rA, idO, a.U8, loff); LOAD_H(hO0, hO1, t1);
            dots8(p + 8, rB, h);
            rows_hi(rB, idO, a.U8, loff);
            ids_load(idE, a.EX, t2, rg);
            peerU_finish(a, p, t0, s, lane);
        }
        {
            f2_t h[8]; float p[16];
            unpack_h(h, hO0, hO1);
            dots8(p, rA, h);
            rows_lo(rA, idE, a.U8, loff); LOAD_H(hE0, hE1, t2);
            dots8(p + 8, rB, h);
            rows_hi(rB, idE, a.U8, loff);
            ids_load(idO, a.EX, t3, rg);
            peerU_finish(a, p, t1, s, lane);
        }
    }
#undef LOAD_H
}

DI void peerR_tile(const PSArgs& a, int tile, int wid) {
    const int tid = get_tid(wid);
    const int lane = tid & 63;
#pragma unroll 1
    for (int ti = 0; ti < 8; ++ti) {
        const int tok = tile * 64 + wid * 8 + ti;
        float d0 = 0.f, d1 = 0.f;
#pragma unroll
        for (int x = 0; x < 8; ++x) { const float2 v = *(const float2*)(a.PD + ((size_t)x * NTOK + tok) * 128 + 2 * lane); d0 += v.x; d1 += v.y; }
        const unsigned exw = *(const unsigned*)(a.EX + (size_t)tok * 128 + 2 * lane);
        const int2 ex = make_int2((int)(exw & 0xFFFFu), (int)(exw >> 16));
        const float2 gt = *(const float2*)(a.GT + (size_t)tok * 128 + 2 * lane);
        const float rs = a.RSTD[tok];
        float2 o;
        o.x = gelu_exact(d0 * a.SU[ex.x] * rs) * gt.x * a.SV[ex.x];
        o.y = gelu_exact(d1 * a.SU[ex.y] * rs) * gt.y * a.SV[ex.y];
        *(unsigned*)(a.COEF + (size_t)tok * 128 + 2 * lane) = pack_bf2(o.x, o.y);
    }
}

struct Cf16 { u32x4 a, b; };
DI void cf_load(Cf16& q, const bf16_t* COEF, int tok, int rg) { const u32x4* p = (const u32x4*)(COEF + (size_t)tok * 128 + rg * 16); q.a = p[0]; q.b = p[1]; }
DI void axpy8(f2_t (&acc)[8], const u32x4 (&r)[8], const u32x4& c) {
    row_axpy8p(acc, r[0], bf_lo(c.x)); row_axpy8p(acc, r[1], bf_hi(c.x)); __builtin_amdgcn_sched_barrier(0);
    row_axpy8p(acc, r[2], bf_lo(c.y)); row_axpy8p(acc, r[3], bf_hi(c.y)); __builtin_amdgcn_sched_barrier(0);
    row_axpy8p(acc, r[4], bf_lo(c.z)); row_axpy8p(acc, r[5], bf_hi(c.z)); __builtin_amdgcn_sched_barrier(0);
    row_axpy8p(acc, r[6], bf_lo(c.w)); row_axpy8p(acc, r[7], bf_hi(c.w)); __builtin_amdgcn_sched_barrier(0);
}
DI void peerV_finish(const PSArgs& a, f2_t (&acc)[8], float2 xv, int tok, int s, int lane) {
    const int rg = lane >> 3, pc = lane & 7;
    const bool r2 = rg & 4, r1 = rg & 2, r0 = rg & 1;
    f2_t q4[4], q2[2], q1;
#pragma unroll
    for (int k = 0; k < 4; ++k) {
        const f2_t keep = r2 ? acc[k + 4] : acc[k], send = r2 ? acc[k] : acc[k + 4];
        q4[k] = (f2_t){keep.x + shx<32>(send.x, lane), keep.y + shx<32>(send.y, lane)};
    }
#pragma unroll
    for (int k = 0; k < 2; ++k) {
        const f2_t keep = r1 ? q4[k + 2] : q4[k], send = r1 ? q4[k] : q4[k + 2];
        q2[k] = (f2_t){keep.x + shx<16>(send.x, lane), keep.y + shx<16>(send.y, lane)};
    }
    {
        const f2_t keep = r0 ? q2[1] : q2[0], send = r0 ? q2[0] : q2[1];
        q1 = (f2_t){keep.x + shx<8>(send.x, lane), keep.y + shx<8>(send.y, lane)};
    }
    xv.x += q1.x; xv.y += q1.y;
    *(float2*)(a.Xout + (size_t)tok * DM + s * 128 + 16 * pc + 2 * rg) = xv;
}

DI void peerV_run(const PSArgs& a, int s, int k, int nloc, int wid) {
    const int tid = get_tid(wid);
    const int lane = tid & 63, rg = lane >> 3, pc = lane & 7;
    const unsigned loff = (unsigned)(s * (NEXP * 128) + pc * 16);
    const int N = 8 * ((NTOK / 64 - k + nloc - 1) / nloc);
    Ids16 idE, idO; Cf16 cfE, cfO; float2 xE, xO;
    u32x4 rA[8], rB[8];
#define LOAD_X(x_, tokv) { x_ = *(const float2*)(a.Xin + (size_t)(tokv) * DM + s * 128 + 16 * pc + 2 * rg); }
    ids_load(idE, a.EX, run_token(0, k, nloc, wid), rg);
    ids_load(idO, a.EX, run_token(1, k, nloc, wid), rg);
    rows_lo(rA, idE, a.V8, loff); cf_load(cfE, a.COEF, run_token(0, k, nloc, wid), rg); rows_hi(rB, idE, a.V8, loff); LOAD_X(xE, run_token(0, k, nloc, wid));
#pragma unroll 1
    for (int n = 0; n < N; n += 2) {
        const int t0 = run_token(n, k, nloc, wid), t1 = run_token(n + 1, k, nloc, wid);
        const int t2 = run_token((n + 2 < N) ? n + 2 : N - 1, k, nloc, wid), t3 = run_token((n + 3 < N) ? n + 3 : N - 1, k, nloc, wid);
        {
            f2_t acc[8];
#pragma unroll
            for (int i = 0; i < 8; ++i) acc[i] = (f2_t){0.f, 0.f};
            axpy8(acc, rA, cfE.a);
            rows_lo(rA, idO, a.V8, loff); cf_load(cfO, a.COEF, t1, rg);
            axpy8(acc, rB, cfE.b);
            rows_hi(rB, idO, a.V8, loff); LOAD_X(xO, t1);
            ids_load(idE, a.EX, t2, rg);
            peerV_finish(a, acc, xE, t0, s, lane);
        }
        {
            f2_t acc[8];
#pragma unroll
            for (int i = 0; i < 8; ++i) acc[i] = (f2_t){0.f, 0.f};
            axpy8(acc, rA, cfO.a);
            rows_lo(rA, idE, a.V8, loff); cf_load(cfE, a.COEF, t2, rg);
            axpy8(acc, rB, cfO.b);
            rows_hi(rB, idE, a.V8, loff); LOAD_X(xE, t2);
            ids_load(idO, a.EX, t3, rg);
            peerV_finish(a, acc, xO, t1, s, lane);
        }
    }
#undef LOAD_X
}

DI void final_norm_tile(float* X, const float* __restrict__ g, int tile, int wid) {
    const int tid = get_tid(wid);
    const int lane = tid & 63;
    const float* gf = g + lane * 16;
    const float4 g0 = *(const float4*)gf, g1 = *(const float4*)(gf + 4), g2 = *(const float4*)(gf + 8), g3 = *(const float4*)(gf + 12);
#pragma unroll 1
    for (int ti = 0; ti < 8; ++ti) {
        float* xp = X + (size_t)(tile * 64 + wid * 8 + ti) * DM + lane * 16;
        float4 x0 = *(const float4*)xp, x1 = *(const float4*)(xp + 4), x2 = *(const float4*)(xp + 8), x3 = *(const float4*)(xp + 12);
        float ss = x0.x * x0.x + x0.y * x0.y + x0.z * x0.z + x0.w * x0.w + x1.x * x1.x + x1.y * x1.y + x1.z * x1.z + x1.w * x1.w
                 + x2.x * x2.x + x2.y * x2.y + x2.z * x2.z + x2.w * x2.w + x3.x * x3.x + x3.y * x3.y + x3.z * x3.z + x3.w * x3.w;
        ss = wave_sum(ss, lane);
        const float rf = rsqrtf(ss * (1.f / 1024.f) + 1e-6f);
        x0.x *= rf * g0.x; x0.y *= rf * g0.y; x0.z *= rf * g0.z; x0.w *= rf * g0.w; x1.x *= rf * g1.x; x1.y *= rf * g1.y; x1.z *= rf * g1.z; x1.w *= rf * g1.w;
        x2.x *= rf * g2.x; x2.y *= rf * g2.y; x2.z *= rf * g2.z; x2.w *= rf * g2.w; x3.x *= rf * g3.x; x3.y *= rf * g3.y; x3.z *= rf * g3.z; x3.w *= rf * g3.w;
        *(float4*)xp = x0; *(float4*)(xp + 4) = x1; *(float4*)(xp + 8) = x2; *(float4*)(xp + 12) = x3;
    }
}
struct MegaArgs {
    const float* x; const float* a_re; const float* a_im; const float* log_dt; const float* b_re; const float* b_im; const float* c_re;
    const float* c_im; const float* d_skip; const float* b_glu; const float* pool_scale; const float* u_exp; const float* v_exp;
    const float* norm_final;
    PrepW pw;
    float* X; bf16_t* U; bf16_t* YPRE; bf16_t* G1; bf16_t* A2; bf16_t* Hb; bf16_t* Qb; unsigned short* EX; float* GT; float* RSTD;
    char* KT; bf16x8* WST; bf16x8* CCAR; float* ABT; fp8_t* U8; fp8_t* V8; float* SU; float* SV; float* PD; bf16_t* COEF;
    unsigned* bar;
    int coop_probe; int pad_;
};

#ifndef REP_P0
#define REP_P0 1
#endif
#ifndef REP_PA
#define REP_PA 1
#endif
#ifndef REP_PB
#define REP_PB 1
#endif
#ifndef REP_C1
#define REP_C1 1
#endif
#ifndef REP_C2
#define REP_C2 1
#endif
#ifndef REP_U
#define REP_U 1
#endif
#ifndef REP_R
#define REP_R 1
#endif
#ifndef REP_V
#define REP_V 1
#endif
#ifndef REP_BAR
#define REP_BAR 1
#endif
#define XBAR() do { for (int rb_ = 0; rb_ < REP_BAR; ++rb_) xcd_barrier(xb, wid); } while (0)
__global__ void __launch_bounds__(NTHR) mega_kernel(MegaArgs a) {
    __shared__ __attribute__((aligned(16))) char smem[PB_BYTES];
    __shared__ uint4 xb_words;
    cg::grid_group grid = cg::this_grid();
    const int nblk = gridDim.x;
    const int wid = __builtin_amdgcn_readfirstlane(threadIdx.x >> 6);
    if (get_tid(wid) == 0) xb_words = make_uint4(0u, 0u, 0u, 0u);
    __syncthreads();
    const XcdBarrier xb = xcd_barrier_post(a.bar, (volatile LAS unsigned*)&xb_words, get_tid(wid));
    for (int rep = 0; rep < REP_P0; ++rep) {
        const size_t gtid = (size_t)blockIdx.x * NTHR + get_tid(wid), gs = (size_t)nblk * NTHR;
        for (int it = blockIdx.x; it < 256; it += nblk)
            prep_s5_item(it >> 2, it & 3, a.a_re, a.a_im, a.log_dt, a.b_re, a.b_im, a.c_re, a.c_im, a.d_skip, a.KT, a.WST, a.CCAR, a.ABT, smem, wid);
        prep_weights(a.pw, gtid, gs);
        for (int l = 0; l < 2; ++l) {
            conv_kfrag(a.pw.k1 + (size_t)l * 128 * 128, a.pw.wfk1 + (size_t)l * (128 * 128 / 8), gtid, gs);
            conv_kfrag(a.pw.k2 + (size_t)l * 128 * 128, a.pw.wfk2 + (size_t)l * (128 * 128 / 8), gtid, gs);
        }
        {
            int tid = get_tid(wid);
            const int gwave = blockIdx.x * 8 + (tid >> 6), nwaves = nblk * 8, lane = tid & 63;
#pragma unroll 1
            for (int l = 0; l < 2; ++l) {
                conv_rows_fp8(a.u_exp + (size_t)l * NEXP * DM, a.pw.norm_ffn + l * DM, a.U8 + (size_t)l * NEXP * DM, a.SU + l * NEXP, NEXP, gwave, nwaves, lane);
                conv_rows_fp8(a.v_exp + (size_t)l * NEXP * DM, nullptr, a.V8 + (size_t)l * NEXP * DM, a.SV + l * NEXP, NEXP, gwave, nwaves, lane);
            }
        }
    }
    XBAR();
    if (a.coop_probe) grid.sync();
    __shared__ int sched[4];
    if (get_tid(wid) == 0) {
        int nx = 0, myj = 0, nloc = 1;
        for (unsigned j = 0; j < 16; ++j) {
            const unsigned cj = xb_ld(&a.bar[XB_XCNT(j)]);
            if (j == xb.x) { myj = nx; nloc = (int)cj; }
            nx += (cj > 0u) ? 1 : 0;
        }
        sched[0] = (int)xb.st[2]; sched[1] = nloc > 0 ? nloc : 1; sched[2] = myj; sched[3] = nx > 0 ? nx : 1;
    }
    __syncthreads();
    const int s_rank = sched[0], s_nloc = sched[1], s_myj = sched[2], s_nx = sched[3];
#pragma unroll 1
    for (int l = 0; l < 2; ++l) {
        const float* xin = (l == 0) ? a.x : a.X;
        if (l == 0) {
            for (int rep = 0; rep < REP_PA; ++rep)
            for (int tile = blockIdx.x; tile < NTOK / 64; tile += nblk) phaseA_tile(xin, a.pw.wfin, a.U, tile, smem, wid);
        }
        XBAR();
        bf16_t* Ul = a.U + (size_t)l * NTOK * DM;
        for (int rep = 0; rep < REP_PB; ++rep)
        for (int tile = blockIdx.x; tile < 256; tile += nblk)
            phaseB_tile(Ul, a.KT + (size_t)l * 32 * KT_BYTES, a.WST + (size_t)l * 32 * WST_FRAGS, a.CCAR + (size_t)l * 32 * CCAR_FRAGS, a.ABT + l * 32 * 128, a.YPRE, tile, smem, wid);
        XBAR();
        PCArgs pa; pa.U = Ul; pa.YPRE = a.YPRE; pa.G1 = a.G1; pa.A2 = a.A2; pa.Xin = xin; pa.Xout = a.X; pa.Xdummy = (float*)a.Qb; pa.Hb = a.Hb; pa.RSTD = a.RSTD;
        pa.wfglu = a.pw.wfglu + (size_t)l * (512 * 512 / 8); pa.b_glu = a.b_glu + l * 512; pa.wfpool = a.pw.wfpool + (size_t)l * 4 * (128 * 128 / 8);
        pa.pool_scale = a.pool_scale + l * 512; pa.wfout = a.pw.wfout + (size_t)l * (DM * DM / 8);
        PRArgs pr; pr.Hb = a.Hb; pr.RSTD = a.RSTD; pr.wfq = a.pw.wfq + (size_t)l * (DM * 2048 / 8); pr.kf1 = a.pw.wfk1 + (size_t)l * (128 * 128 / 8);
        pr.kf2 = a.pw.wfk2 + (size_t)l * (128 * 128 / 8); pr.EX = a.EX; pr.GT = a.GT;
        for (int tile = blockIdx.x; tile < NTOK / 64; tile += nblk) {
            for (int rep = 1; rep < REP_C1; ++rep) { PCArgs pa2 = pa; pa2.Xout = (float*)a.Qb; phaseC1_tile(pa2, tile, smem, wid); }
            phaseC1_tile(pa, tile, smem, wid);
            for (int rep = 0; rep < REP_C2; ++rep) phaseC2_tile(pr, tile, smem, wid);
        }
        XBAR();
        PSArgs ps; ps.Hb = a.Hb; ps.RSTD = a.RSTD; ps.EX = a.EX; ps.GT = a.GT; ps.U8 = a.U8 + (size_t)l * NEXP * DM; ps.V8 = a.V8 + (size_t)l * NEXP * DM;
        ps.SU = a.SU + l * NEXP; ps.SV = a.SV + l * NEXP; ps.PD = a.PD; ps.COEF = a.COEF; ps.Xin = a.X; ps.Xout = a.X;
        for (int rep = 0; rep < REP_U; ++rep)
        for (int s = s_myj; s < 8; s += s_nx) peerU_run(ps, s, s_rank, s_nloc, wid);
        XBAR();
        for (int rep = 0; rep < REP_R; ++rep)
        for (int tile = blockIdx.x; tile < NTOK / 64; tile += nblk) peerR_tile(ps, tile, wid);
        XBAR();
        for (int rep = 1; rep < REP_V; ++rep) { PSArgs ps2 = ps; ps2.Xout = (float*)a.Qb; for (int s = s_myj; s < 8; s += s_nx) peerV_run(ps2, s, s_rank, s_nloc, wid); }
        for (int s = s_myj; s < 8; s += s_nx) peerV_run(ps, s, s_rank, s_nloc, wid);
        XBAR();
        if (l == 0) {
            for (int rep = 0; rep < REP_PA; ++rep)
            for (int tile = blockIdx.x; tile < NTOK / 64; tile += nblk) phaseA_tile(a.X, a.pw.wfin + (size_t)(DM * DM / 8), a.U + (size_t)NTOK * DM, tile, smem, wid);
        } else {
            for (int tile = blockIdx.x; tile < NTOK / 64; tile += nblk) final_norm_tile(a.X, a.norm_final, tile, wid);
        }
    }
}

extern "C" void kernel_launch(void* const* d_in, const int* in_sizes, int n_in, void* d_out, int out_size, void* d_ws, size_t ws_size,
                              hipStream_t stream) {
    char* wsb = (char*)d_ws;
    size_t off = 0;
    auto take = [&](size_t bytes) { char* p = wsb + off; off += (bytes + 255) & ~(size_t)255; return p; };
    MegaArgs a;
    memset(&a, 0, sizeof(a));
    a.x = (const float*)d_in[0];
    a.pw.norm_mix = (const float*)d_in[1]; a.pw.w_in = (const float*)d_in[2];
    a.a_re = (const float*)d_in[3]; a.a_im = (const float*)d_in[4]; a.log_dt = (const float*)d_in[5];
    a.b_re = (const float*)d_in[6]; a.b_im = (const float*)d_in[7]; a.c_re = (const float*)d_in[8]; a.c_im = (const float*)d_in[9];
    a.d_skip = (const float*)d_in[10]; a.pw.w_glu = (const float*)d_in[11]; a.b_glu = (const float*)d_in[12];
    a.pw.w_pool = (const float*)d_in[13]; a.pool_scale = (const float*)d_in[14]; a.pw.g_out_ssm = (const float*)d_in[15];
    a.pw.g_out_pool = (const float*)d_in[16]; a.pw.w_out = (const float*)d_in[17]; a.pw.norm_ffn = (const float*)d_in[18];
    a.pw.w_q = (const float*)d_in[19]; a.pw.k1 = (const float*)d_in[20]; a.pw.k2 = (const float*)d_in[21];
    a.u_exp = (const float*)d_in[22]; a.v_exp = (const float*)d_in[23]; a.norm_final = (const float*)d_in[24];
    a.X = (float*)d_out;
    a.U = (bf16_t*)take((size_t)2 * NTOK * DM * 2);
    a.YPRE = (bf16_t*)take((size_t)NTOK * 512 * 2);
    a.G1 = (bf16_t*)take((size_t)NTOK * 512 * 2);
    a.A2 = (bf16_t*)take((size_t)NTOK * DM * 2);
    a.Hb = (bf16_t*)take((size_t)NTOK * DM * 2);
    a.Qb = (bf16_t*)take((size_t)NTOK * 2048 * 2);
    a.EX = (unsigned short*)take((size_t)NTOK * 128 * 2);
    a.GT = (float*)take((size_t)NTOK * 128 * 4);
    a.RSTD = (float*)take(NTOK * 4);
    a.pw.wfin = (bf16x8*)take((size_t)2 * DM * DM * 2);
    a.pw.wfglu = (bf16x8*)take((size_t)2 * 512 * 512 * 2);
    a.pw.wfpool = (bf16x8*)take((size_t)2 * 4 * 128 * 128 * 2);
    a.pw.wfout = (bf16x8*)take((size_t)2 * DM * DM * 2);
    a.pw.wfq = (bf16x8*)take((size_t)2 * DM * 2048 * 2);
    a.pw.wfk1 = (bf16x8*)take((size_t)2 * 128 * 128 * 2);
    a.pw.wfk2 = (bf16x8*)take((size_t)2 * 128 * 128 * 2);
    a.KT = take((size_t)64 * KT_BYTES);
    a.WST = (bf16x8*)take((size_t)64 * WST_FRAGS * 16);
    a.CCAR = (bf16x8*)take((size_t)64 * CCAR_FRAGS * 16);
    a.ABT = (float*)take(64 * 128 * 4);
    a.U8 = (fp8_t*)take((size_t)2 * NEXP * DM);
    a.V8 = (fp8_t*)take((size_t)2 * NEXP * DM);
    a.SU = (float*)take((size_t)2 * NEXP * 4);
    a.SV = (float*)take((size_t)2 * NEXP * 4);
    a.PD = (float*)take((size_t)8 * NTOK * 128 * 4);
    a.COEF = (bf16_t*)take((size_t)NTOK * 128 * 2);
    a.bar = (unsigned*)take((size_t)XCD_BAR_WORDS * 4);
    hipMemsetAsync(a.bar, 0, (size_t)XCD_BAR_WORDS * 4, stream);

    static int grid_blocks = 0;
    if (!grid_blocks) {
        int dev = 0, cus = 0, per_cu = 0;
        hipGetDevice(&dev);
        hipDeviceGetAttribute(&cus, hipDeviceAttributeMultiprocessorCount, dev);
        hipOccupancyMaxActiveBlocksPerMultiprocessor(&per_cu, mega_kernel, NTHR, 0);
        if (per_cu > 1) per_cu = 1;
        grid_blocks = cus * per_cu;
        if (grid_blocks > 256) grid_blocks = 256;
    }
    void* args[] = {&a};
    hipError_t e = hipLaunchCooperativeKernel((void*)mega_kernel, dim3(grid_blocks), dim3(NTHR), args, 0, stream);
    if (e != hipSuccess) fprintf(stderr, "cooperative launch failed: %s (grid %d)\n", hipGetErrorString(e), grid_blocks);
}
```

```cpp
#include <hip/hip_runtime.h>
#include <hip/hip_cooperative_groups.h>
#include <cstdio>
#include <cstring>
namespace cg = cooperative_groups;
#include <math.h>
#include <stdint.h>

#define NTOK 16384
#define SEQ 2048
#define DM 1024
#define SSMW 512
#define NEXP 16384

__device__ __forceinline__ float gelu_exact(float x) { return 0.5f * x * (1.f + erff(x * 0.70710678118654752f)); }

template <int M> __device__ __forceinline__ int shx_i(int v, int lane) {
    if constexpr (M == 1) return __builtin_amdgcn_mov_dpp(v, 0xB1, 0xF, 0xF, true);
    else if constexpr (M == 2) return __builtin_amdgcn_mov_dpp(v, 0x4E, 0xF, 0xF, true);
    else if constexpr (M < 32) return __builtin_amdgcn_ds_swizzle(v, (M << 10) | 0x1F);
    else return __builtin_amdgcn_ds_bpermute((lane ^ 32) << 2, v);
}
template <int M> __device__ __forceinline__ float shx(float v, int lane) { return __int_as_float(shx_i<M>(__float_as_int(v), lane)); }
__device__ __forceinline__ float wave_sum(float v, int lane) {
    v += shx<1>(v, lane); v += shx<2>(v, lane); v += shx<4>(v, lane); v += shx<8>(v, lane); v += shx<16>(v, lane); v += shx<32>(v, lane);
    return v;
}

__device__ __forceinline__ int get_tid(int wid) {
    int t = wid * 64 + (int)__builtin_amdgcn_mbcnt_hi(~0u, __builtin_amdgcn_mbcnt_lo(~0u, 0u));
    asm volatile("" : "+v"(t));
    return t;
}

#define DI __device__ __forceinline__
typedef __attribute__((ext_vector_type(8))) short bf16x8;
typedef __attribute__((ext_vector_type(16))) float f32x16;
typedef __attribute__((ext_vector_type(2))) __bf16 bf2_t;
typedef __attribute__((ext_vector_type(2))) float f2_t;
typedef unsigned short bf16_t;
typedef __attribute__((ext_vector_type(4))) unsigned u32x4;
typedef __attribute__((ext_vector_type(4))) float f32x4;
typedef const __attribute__((address_space(1))) bf16x8* gwp_t;
#define MFMA32(a, b, c) __builtin_amdgcn_mfma_f32_32x32x16_bf16((a), (b), (c), 0, 0, 0)

DI unsigned pack_bf2(float a, float b) { f2_t v = {a, b}; return __builtin_bit_cast(unsigned, __builtin_convertvector(v, bf2_t)); }
DI float bf_lo(unsigned u) { return __uint_as_float(u << 16); }
DI float bf_hi(unsigned u) { return __uint_as_float(u & 0xffff0000u); }
DI int crow(int reg, int h) { return (reg & 3) + 8 * (reg >> 2) + 4 * h; }

#define SA_STRIDE 272
#define SA_BYTES (64 * SA_STRIDE)
#define NTHR 512

template <bool GAIN>
DI void conv_wfrag(const float* __restrict__ src, int ldk, int ldn, const float* __restrict__ ga, const float* __restrict__ gb, int split,
                   int K, int N, int NTG, bf16x8* __restrict__ dst, size_t gtid, size_t gstride) {
    const int KS = K / 16;
    const size_t total = (size_t)(N / 32) * KS * 64;
    for (size_t item = gtid; item < total; item += gstride) {
        const int lane = (int)(item & 63); const size_t f = item >> 6;
        const int nti = (int)(f % NTG); const size_t f2 = f / NTG;
        const int ks = (int)(f2 % KS), nt = (int)(f2 / KS) * NTG + nti;
        const int r = lane & 31, h = lane >> 5;
        const int n = nt * 32 + r, k0 = ks * 16 + 8 * h;
        float v[8];
#pragma unroll
        for (int j = 0; j < 8; ++j) {
            const int k = k0 + j;
            float g = 1.f;
            if (GAIN) g = (k < split) ? ga[k] : gb[k - split];
            v[j] = src[(size_t)k * ldk + (size_t)n * ldn] * g;
        }
        uint4 o; o.x = pack_bf2(v[0], v[1]); o.y = pack_bf2(v[2], v[3]); o.z = pack_bf2(v[4], v[5]); o.w = pack_bf2(v[6], v[7]);
        *(uint4*)(dst + item) = o;
    }
}

DI void conv_rows_bf16(const float* __restrict__ src, const float* __restrict__ gain, bf16_t* __restrict__ dst, size_t nelem, size_t gtid, size_t gstride) {
    for (size_t i = gtid * 8; i < nelem; i += gstride * 8) {
        float4 a = *(const float4*)(src + i), b = *(const float4*)(src + i + 4);
        if (gain) {
            const int c = (int)(i & 1023);
            float4 g0 = *(const float4*)(gain + c), g1 = *(const float4*)(gain + c + 4);
            a.x *= g0.x; a.y *= g0.y; a.z *= g0.z; a.w *= g0.w; b.x *= g1.x; b.y *= g1.y; b.z *= g1.z; b.w *= g1.w;
        }
        uint4 o; o.x = pack_bf2(a.x, a.y); o.y = pack_bf2(a.z, a.w); o.z = pack_bf2(b.x, b.y); o.w = pack_bf2(b.z, b.w);
        *(uint4*)(dst + i) = o;
    }
}

struct ALoadF32 {
    const float* base; f32x4 v0, v1, v2, v3; float ss; int dofs;
    DI void init(const float* rowbase, int tid) { base = rowbase + (tid & 7) * 16; ss = 0.f; dofs = (tid >> 3) * SA_STRIDE + (tid & 7) * 32; }
    DI void issue(int c) { const f32x4* p = (const f32x4*)(base + c * 128); v0 = p[0]; v1 = p[1]; v2 = p[2]; v3 = p[3]; }
    DI void commit(char* buf) {
        u32x4 o0, o1;
        ss += v0.x * v0.x + v0.y * v0.y + v0.z * v0.z + v0.w * v0.w + v1.x * v1.x + v1.y * v1.y + v1.z * v1.z + v1.w * v1.w
            + v2.x * v2.x + v2.y * v2.y + v2.z * v2.z + v2.w * v2.w + v3.x * v3.x + v3.y * v3.y + v3.z * v3.z + v3.w * v3.w;
        o0.x = pack_bf2(v0.x, v0.y); o0.y = pack_bf2(v0.z, v0.w); o0.z = pack_bf2(v1.x, v1.y); o0.w = pack_bf2(v1.z, v1.w);
        o1.x = pack_bf2(v2.x, v2.y); o1.y = pack_bf2(v2.z, v2.w); o1.z = pack_bf2(v3.x, v3.y); o1.w = pack_bf2(v3.z, v3.w);
        char* d = buf + dofs;
        *(u32x4*)d = o0; *(u32x4*)(d + 16) = o1;
    }
};
struct ALoadBF16 {
    const bf16_t* base; u32x4 v0, v1; int dofs;
    DI void init(const bf16_t* rowbase, int tid) { base = rowbase + (tid & 7) * 16; dofs = (tid >> 3) * SA_STRIDE + (tid & 7) * 32; }
    DI void issue(int c) { const u32x4* p = (const u32x4*)(base + c * 128); v0 = p[0]; v1 = p[1]; }
    DI void commit(char* buf) {
        char* d = buf + dofs;
        *(u32x4*)d = v0; *(u32x4*)(d + 16) = v1;
    }
};

template <int NT, int PF, class AL>
DI void gemm64(f32x16 (&acc)[NT][2], AL& al, const int nchunks, const bf16x8* __restrict__ wf_, char* sA, const int lane) {
    gwp_t wf = (gwp_t)wf_;
    const int r = lane & 31, h = lane >> 5;
    bf16x8 bq[PF][NT];
    al.issue(0);
#pragma unroll
    for (int p = 0; p < PF; ++p)
#pragma unroll
        for (int nt = 0; nt < NT; ++nt) bq[p][nt] = wf[(p * NT + nt) * 64];
    gwp_t wpf = wf + PF * NT * 64;
    al.commit(sA);
    const int kend = nchunks * 8 - PF;
    int kg = 0;
#pragma unroll 1
    for (int c = 0; c < nchunks; ++c) {
        if (c + 1 < nchunks) al.issue(c + 1);
        __syncthreads();
        const char* buf = sA + (c & 1) * SA_BYTES + r * SA_STRIDE + h * 16;
#pragma unroll
        for (int ks = 0; ks < 8; ++ks) {
            const bf16x8 a0 = *(const bf16x8*)(buf + ks * 32);
            const bf16x8 a1 = *(const bf16x8*)(buf + 32 * SA_STRIDE + ks * 32);
#pragma unroll
            for (int nt = 0; nt < NT; ++nt) {
                acc[nt][0] = MFMA32(bq[ks % PF][nt], a0, acc[nt][0]);
                acc[nt][1] = MFMA32(bq[ks % PF][nt], a1, acc[nt][1]);
            }
            if (kg < kend) {
#pragma unroll
                for (int nt = 0; nt < NT; ++nt) bq[ks % PF][nt] = wpf[nt * 64];
            }
            wpf += NT * 64; ++kg;
            asm volatile("" : "+v"(wpf));
        }
        if (c + 1 < nchunks) al.commit(sA + ((c + 1) & 1) * SA_BYTES);
    }
    __syncthreads();
}

template <int NT>
DI void zero_acc(f32x16 (&acc)[NT][2]) {
#pragma unroll
    for (int nt = 0; nt < NT; ++nt)
#pragma unroll
        for (int mt = 0; mt < 2; ++mt)
#pragma unroll
            for (int i = 0; i < 16; ++i) acc[nt][mt][i] = 0.f;
}


DI void tile_transpose(const f32x16& t, float* wscr, int lane, f32x4 (&out)[4]) {
    const int r = lane & 31, h = lane >> 5;
#pragma unroll
    for (int q = 0; q < 4; ++q) { f32x4 v = {t[4 * q], t[4 * q + 1], t[4 * q + 2], t[4 * q + 3]}; *(f32x4*)(wscr + r * 36 + 8 * q + 4 * h) = v; }
#pragma unroll
    for (int j = 0; j < 4; ++j) out[j] = *(const f32x4*)(wscr + ((lane >> 3) + 8 * j) * 36 + (lane & 7) * 4);
}
#define WSCR_BYTES (32 * 36 * 4)

DI void phaseA_tile(const float* __restrict__ X, const bf16x8* __restrict__ wfin, bf16_t* __restrict__ U, int tile, char* smem, int wid) {
    char* sA = smem; float* srstd = (float*)(smem + 8 * WSCR_BYTES);
    int tok0 = tile * 64; asm volatile("" : "+s"(tok0));
    int tid = get_tid(wid);
    const int w = __builtin_amdgcn_readfirstlane(tid >> 6), lane = tid & 63, r = lane & 31, h = lane >> 5;
    ALoadF32 al; al.init(X + (size_t)(tok0 + (tid >> 3)) * DM, tid);
    f32x16 acc[4][2]; zero_acc<4>(acc);
    gemm64<4, 2>(acc, al, 8, wfin + (size_t)w * (64 * 4 * 64) + lane, sA, lane);
    float ss = al.ss;
    ss += shx<1>(ss, lane); ss += shx<2>(ss, lane); ss += shx<4>(ss, lane);
    if ((tid & 7) == 0) srstd[tid >> 3] = rsqrtf(ss * (1.f / 1024.f) + 1e-6f);
    __syncthreads();
    {
        float* wscr = (float*)(smem + w * WSCR_BYTES);
        const int tl = lane >> 3, cl = (lane & 7) * 4;
#pragma unroll
        for (int mt = 0; mt < 2; ++mt) {
            float rs[4];
#pragma unroll
            for (int j = 0; j < 4; ++j) rs[j] = srstd[mt * 32 + tl + 8 * j];
#pragma unroll
            for (int nt = 0; nt < 4; ++nt) {
                f32x4 o[4]; tile_transpose(acc[nt][mt], wscr, lane, o);
#pragma unroll
                for (int j = 0; j < 4; ++j) {
                    uint2 p; p.x = pack_bf2(o[j].x * rs[j], o[j].y * rs[j]); p.y = pack_bf2(o[j].z * rs[j], o[j].w * rs[j]);
                    *(uint2*)(U + (size_t)(tok0 + mt * 32 + tl + 8 * j) * DM + w * 128 + nt * 32 + cl) = p;
                }
            }
        }
    }
    __syncthreads();
}

struct PrepW {
    const float* norm_mix; const float* w_in; const float* w_glu; const float* w_pool; const float* g_out_ssm; const float* g_out_pool;
    const float* w_out; const float* norm_ffn; const float* w_q; const float* k1; const float* k2;
    bf16x8* wfin; bf16x8* wfglu; bf16x8* wfpool; bf16x8* wfout; bf16x8* wfq; bf16x8* wfk1; bf16x8* wfk2;
};
DI void prep_weights(const PrepW& p, size_t gtid, size_t gs) {
#pragma unroll 1
    for (int l = 0; l < 2; ++l) {
        conv_wfrag<true>(p.w_in + (size_t)l * DM * DM, DM, 1, p.norm_mix + l * DM, p.norm_mix + l * DM, DM, DM, DM, 4, p.wfin + (size_t)l * (DM * DM / 8), gtid, gs);
        conv_wfrag<false>(p.w_glu + (size_t)l * 512 * 512, 512, 1, p.norm_mix, p.norm_mix, 512, 512, 512, 2, p.wfglu + (size_t)l * (512 * 512 / 8), gtid, gs);
#pragma unroll 1
        for (int gi = 0; gi < 4; ++gi)
            conv_wfrag<false>(p.w_pool + (size_t)(l * 4 + gi) * 128 * 128, 128, 1, p.norm_mix, p.norm_mix, 128, 128, 128, 2, p.wfpool + (size_t)(l * 4 + gi) * (128 * 128 / 8), gtid, gs);
        conv_wfrag<true>(p.w_out + (size_t)l * DM * DM, DM, 1, p.g_out_ssm + l * 512, p.g_out_pool + l * 512, 512, DM, DM, 4, p.wfout + (size_t)l * (DM * DM / 8), gtid, gs);
        conv_wfrag<true>(p.w_q + (size_t)l * DM * 2048, 2048, 1, p.norm_ffn + l * DM, p.norm_ffn + l * DM, DM, DM, 2048, 4, p.wfq + (size_t)l * (DM * 2048 / 8), gtid, gs);
    }
}
#define KT_BLK 528
#define KT_BYTES (65 * KT_BLK)
#define WST_FRAGS (4 * 64 * 64)
#define CCAR_FRAGS (32 * 8 * 64)
#define SU_CH 2064

DI void prep_s5_item(int lg, int part, const float* __restrict__ a_re, const float* __restrict__ a_im, const float* __restrict__ log_dt,
                     const float* __restrict__ b_re, const float* __restrict__ b_im, const float* __restrict__ c_re, const float* __restrict__ c_im,
                     const float* __restrict__ d_skip, char* __restrict__ KT, bf16x8* __restrict__ WST, bf16x8* __restrict__ CCAR,
                     float* __restrict__ ABT, char* smem, int wid) {
    float* powr = (float*)smem;
    float* powi = powr + 65 * 64;
    float* bzr = powi + 65 * 64;
    float* bzi = bzr + 1024;
    float* cr = bzi + 1024;
    float* ci = cr + 1024;
    int tid = get_tid(wid);
    const float* are_p = a_re + lg * 64; const float* aim_p = a_im + lg * 64;
    const float dt = expf(log_dt[lg]);
    for (int it = tid; it < 65 * 64; it += NTHR) {
        const int tau = it >> 6, p = it & 63;
        const float lre = are_p[p], lim = aim_p[p];
        const float mag = expf((float)tau * lre * dt);
        double rev = (double)lim * (double)dt * (double)tau * 0.15915494309189535;
        rev -= floor(rev);
        const float ang = (float)rev * 6.283185307179586f;
        powr[it] = mag * cosf(ang); powi[it] = mag * sinf(ang);
    }
    for (int it = tid; it < 1024; it += NTHR) {
        cr[it] = c_re[lg * 1024 + it]; ci[it] = c_im[lg * 1024 + it];
    }
    __syncthreads();
    for (int it = tid; it < 1024; it += NTHR) {
        const int p = it >> 4;
        const float lre = are_p[p], lim = aim_p[p];
        const float ar = powr[64 + p], ai = powi[64 + p];
        const float inv = 1.f / (lre * lre + lim * lim), nre = ar - 1.f;
        const float zre = (nre * lre + ai * lim) * inv, zim = (ai * lre - nre * lim) * inv;
        const float br = b_re[lg * 1024 + it], bi = b_im[lg * 1024 + it];
        bzr[it] = zre * br - zim * bi; bzi[it] = zre * bi + zim * br;
    }
    __syncthreads();
    if (part == 0 && tid < 64) { ABT[lg * 128 + 2 * tid] = powr[64 * 64 + tid]; ABT[lg * 128 + 2 * tid + 1] = powi[64 * 64 + tid]; }
    char* kt = KT + (size_t)lg * KT_BYTES;
    if (part == 0) for (int it = tid; it < KT_BLK / 4; it += NTHR) ((unsigned*)kt)[it] = 0u;
    for (int it = part * (16 * 128) + tid; it < (part + 1) * (16 * 128); it += NTHR) {
        const int tau = it >> 7, ho = (it >> 3) & 15, hi = (it & 7) * 2;
        float s0 = 0.f, s1 = 0.f;
        for (int p = 0; p < 64; ++p) {
            const float c_r = cr[ho * 64 + p], c_i = ci[ho * 64 + p], pr = powr[tau * 64 + p], pi = powi[tau * 64 + p];
            const float cpr = c_r * pr - c_i * pi, cpi = c_r * pi + c_i * pr;
            s0 += cpr * bzr[p * 16 + hi] - cpi * bzi[p * 16 + hi];
            s1 += cpr * bzr[p * 16 + hi + 1] - cpi * bzi[p * 16 + hi + 1];
        }
        if (tau == 0) { if (ho == hi) s0 += d_skip[lg * 16 + ho]; if (ho == hi + 1) s1 += d_skip[lg * 16 + ho]; }
        *(unsigned*)(kt + (tau + 1) * KT_BLK + ho * 32 + hi * 2) = pack_bf2(s0, s1);
    }
    if (part == 0) for (int it = tid; it < 65 * 4; it += NTHR) ((unsigned*)(kt + (it >> 2) * KT_BLK + 512))[it & 3] = 0u;
    bf16x8* wst = WST + (size_t)lg * WST_FRAGS;
    for (int it = part * (WST_FRAGS / 4) + tid; it < (part + 1) * (WST_FRAGS / 4); it += NTHR) {
        const int lane = it & 63, j = (it >> 6) & 63, nt = it >> 12;
        const int r = lane & 31, h = lane >> 5, n = nt * 32 + r, p = n & 63, im = n >> 6;
        const float pr = powr[(63 - j) * 64 + p], pi = powi[(63 - j) * 64 + p];
        float v[8];
#pragma unroll
        for (int jj = 0; jj < 8; ++jj) {
            const float zr = bzr[p * 16 + 8 * h + jj], zi = bzi[p * 16 + 8 * h + jj];
            v[jj] = im ? (pr * zi + pi * zr) : (pr * zr - pi * zi);
        }
        uint4 o; o.x = pack_bf2(v[0], v[1]); o.y = pack_bf2(v[2], v[3]); o.z = pack_bf2(v[4], v[5]); o.w = pack_bf2(v[6], v[7]);
        *(uint4*)(wst + it) = o;
    }
    bf16x8* cc = CCAR + (size_t)lg * CCAR_FRAGS;
    for (int it = part * (CCAR_FRAGS / 4) + tid; it < (part + 1) * (CCAR_FRAGS / 4); it += NTHR) {
        const int lane = it & 63, ks = (it >> 6) & 7, mt = it >> 9;
        const int r = lane & 31, h = lane >> 5, m = mt * 32 + r, i = m >> 4, ho = m & 15;
        float v[8];
#pragma unroll
        for (int jj = 0; jj < 8; ++jj) {
            const int k = ks * 16 + 8 * h + jj, p = k & 63, im = k >> 6;
            const float c_r = cr[ho * 64 + p], c_i = ci[ho * 64 + p], pr = powr[(i + 1) * 64 + p], pi = powi[(i + 1) * 64 + p];
            v[jj] = im ? -(c_r * pi + c_i * pr) : (c_r * pr - c_i * pi);
        }
        uint4 o; o.x = pack_bf2(v[0], v[1]); o.y = pack_bf2(v[2], v[3]); o.z = pack_bf2(v[4], v[5]); o.w = pack_bf2(v[6], v[7]);
        *(uint4*)(cc + it) = o;
    }
    __syncthreads();
}

#define PB_SU 0
#define PB_SKT (32 * SU_CH)
#define PB_SL (PB_SKT + KT_BYTES)
#define PB_SPART (PB_SL + 32 * 132 * 4)
#define PB_SSP (PB_SPART + 4 * 4096)
#define PB_BYTES (PB_SSP + 32 * 272)

DI void phaseB_tile(const bf16_t* __restrict__ U, const char* __restrict__ KT, const bf16x8* __restrict__ WST, const bf16x8* __restrict__ CCAR,
                    const float* __restrict__ ABT, bf16_t* __restrict__ YPRE, int tile, char* smem, int wid) {
    const int g = tile & 31, b = tile >> 5;
    int tid = get_tid(wid);
    const int w = __builtin_amdgcn_readfirstlane(tid >> 6), lane = tid & 63, r = lane & 31, h = lane >> 5;
    char* sU = smem + PB_SU; char* sKT = smem + PB_SKT; float* sL = (float*)(smem + PB_SL); float* sPart = (float*)(smem + PB_SPART);
    char* sSp = smem + PB_SSP;
#pragma unroll
    for (int it = 0; it < 4; ++it) {
        const int tok = tid + NTHR * it;
        const uint4* src = (const uint4*)(U + (size_t)(b * SEQ + tok) * DM + g * 16);
        const uint4 v0 = src[0], v1 = src[1];
        char* d = sU + (tok >> 6) * SU_CH + (tok & 63) * 32;
        *(uint4*)d = v0; *(uint4*)(d + 16) = v1;
    }
    {
        const uint4* src = (const uint4*)(KT + (size_t)g * KT_BYTES);
        for (int it = tid; it < KT_BYTES / 16; it += NTHR) ((uint4*)sKT)[it] = src[it];
    }
    __syncthreads();
    {
        const int nt = w & 3, kh = w >> 2;
        f32x16 acc;
#pragma unroll
        for (int i = 0; i < 16; ++i) acc[i] = 0.f;
        const bf16x8* wp = WST + (size_t)g * WST_FRAGS + (size_t)(nt * 64 + kh * 32) * 64 + lane;
        const char* up = sU + r * SU_CH + h * 16 + kh * 32 * 32;
#pragma unroll 16
        for (int j = 0; j < 32; ++j) {
            const bf16x8 a = wp[j * 64];
            const bf16x8 bb = *(const bf16x8*)(up + j * 32);
            acc = MFMA32(a, bb, acc);
        }
        if (kh == 1) {
#pragma unroll
            for (int i = 0; i < 16; ++i) sPart[(nt * 16 + i) * 64 + lane] = acc[i];
        }
        __syncthreads();
        if (kh == 0) {
#pragma unroll
            for (int i = 0; i < 16; ++i) sL[r * 132 + nt * 32 + crow(i, h)] = acc[i] + sPart[(nt * 16 + i) * 64 + lane];
        }
        __syncthreads();
    }
    if (tid < 64) {
        const int p = tid;
        const float ar = ABT[g * 128 + 2 * p], ai = ABT[g * 128 + 2 * p + 1];
        float sr = 0.f, si = 0.f;
        for (int c = 0; c < 32; ++c) {
            *(bf16_t*)(sSp + c * 272 + p * 2) = (bf16_t)(pack_bf2(sr, 0.f) & 0xffffu);
            *(bf16_t*)(sSp + c * 272 + (64 + p) * 2) = (bf16_t)(pack_bf2(si, 0.f) & 0xffffu);
            const float lr = sL[c * 132 + p], li = sL[c * 132 + 64 + p];
            const float nr = ar * sr - ai * si + lr, ni = ar * si + ai * sr + li;
            sr = nr; si = ni;
        }
    }
    f32x16 acc4[4];
#pragma unroll
    for (int q = 0; q < 4; ++q)
#pragma unroll
        for (int i = 0; i < 16; ++i) acc4[q][i] = 0.f;
    const int mts0 = w, mts1 = 15 - w, mts2 = 16 + w, mts3 = 31 - w;
    {
        const char* up = sU + r * SU_CH + h * 16;
        const char* kp = sKT + (r & 15) * 32 + h * 16 + ((r >> 4) + 1) * KT_BLK;
        for (int j = 0; j < 64; ++j) {
            const bf16x8 bb = *(const bf16x8*)(up + j * 32);
#define TOEP_STEP(q, mt) if (2 * (mt) + 1 >= j) { const bf16x8 a = *(const bf16x8*)(kp + (2 * (mt) - j) * KT_BLK); acc4[q] = MFMA32(a, bb, acc4[q]); }
            TOEP_STEP(0, mts0) TOEP_STEP(1, mts1) TOEP_STEP(2, mts2) TOEP_STEP(3, mts3)
#undef TOEP_STEP
        }
    }
    __syncthreads();
    {
        const bf16x8* cp = CCAR + (size_t)g * CCAR_FRAGS + lane;
        const char* sp = sSp + r * 272 + h * 16;
#pragma unroll
        for (int ks = 0; ks < 8; ++ks) {
            const bf16x8 bb = *(const bf16x8*)(sp + ks * 32);
            acc4[0] = MFMA32(cp[(mts0 * 8 + ks) * 64], bb, acc4[0]);
            acc4[1] = MFMA32(cp[(mts1 * 8 + ks) * 64], bb, acc4[1]);
            acc4[2] = MFMA32(cp[(mts2 * 8 + ks) * 64], bb, acc4[2]);
            acc4[3] = MFMA32(cp[(mts3 * 8 + ks) * 64], bb, acc4[3]);
        }
    }
    {
        bf16_t* ybase = YPRE + (size_t)(b * SEQ + r * 64) * 512 + g * 16;
#define PB_STORE(q, mt) _Pragma("unroll") for (int rq = 0; rq < 4; ++rq) { const int c0 = 8 * rq + 4 * h; const int i = 2 * (mt) + (c0 >> 4); \
            uint2 o; o.x = pack_bf2(acc4[q][4 * rq], acc4[q][4 * rq + 1]); o.y = pack_bf2(acc4[q][4 * rq + 2], acc4[q][4 * rq + 3]); \
            *(uint2*)(ybase + (size_t)i * 512 + (c0 & 15)) = o; }
        PB_STORE(0, mts0) PB_STORE(1, mts1) PB_STORE(2, mts2) PB_STORE(3, mts3)
#undef PB_STORE
    }
    __syncthreads();
}

#ifndef REP_GLU
#define REP_GLU 1
#endif
#ifndef REP_POOL
#define REP_POOL 1
#endif
#ifndef REP_OUT
#define REP_OUT 1
#endif
#ifndef REP_Q
#define REP_Q 1
#endif
#ifndef REP_SC
#define REP_SC 1
#endif
struct ALoadGelu {
    const bf16_t* base; bf16_t* gout; u32x4 v0, v1; int cc; int dofs;
    DI void init(const bf16_t* rowbase, bf16_t* growbase, int tid) { base = rowbase + (tid & 7) * 16; gout = growbase + (tid & 7) * 16; dofs = (tid >> 3) * SA_STRIDE + (tid & 7) * 32; }
    DI void issue(int c) { const u32x4* p = (const u32x4*)(base + c * 128); v0 = p[0]; v1 = p[1]; cc = c; }
    DI unsigned g2(unsigned u) { return pack_bf2(gelu_exact(bf_lo(u)), gelu_exact(bf_hi(u))); }
    DI void commit(char* buf) {
        u32x4 o0, o1;
        o0.x = g2(v0.x); o0.y = g2(v0.y); o0.z = g2(v0.z); o0.w = g2(v0.w);
        o1.x = g2(v1.x); o1.y = g2(v1.y); o1.z = g2(v1.z); o1.w = g2(v1.w);
        char* d = buf + dofs;
        *(u32x4*)d = o0; *(u32x4*)(d + 16) = o1;
        u32x4* gp = (u32x4*)(gout + cc * 128); gp[0] = o0; gp[1] = o1;
    }
};

DI void tok_reduce(float p0, float p1, float* sred, float& t0, float& t1, int tid) {
    const int w = tid >> 6, lane = tid & 63, r = lane & 31, h = lane >> 5;
    __syncthreads();
    sred[(w * 2 + h) * 64 + r] = p0; sred[(w * 2 + h) * 64 + 32 + r] = p1;
    __syncthreads();
    float a = 0.f, b = 0.f;
#pragma unroll
    for (int k = 0; k < 16; ++k) { a += sred[k * 64 + r]; b += sred[k * 64 + 32 + r]; }
    t0 = a; t1 = b;
}

#define PC_SRED (4 * SA_BYTES)
#define PC_BYTES (PC_SRED + 4096 + 256)

struct PCArgs {
    const bf16_t* U; const bf16_t* YPRE; bf16_t* G1; bf16_t* A2; const float* Xin; float* Xout; float* Xdummy; bf16_t* Hb; float* RSTD;
    const bf16x8* wfglu; const float* b_glu; const bf16x8* wfpool; const float* pool_scale; const bf16x8* wfout;
};

DI void phaseC1_tile(const PCArgs& a, int tile, char* smem, int wid) {
    char* sA = smem; float* sred = (float*)(smem + PC_SRED);
    for (int rep_ = 0; rep_ < REP_GLU; ++rep_) {
        int tok0 = tile * 64; asm volatile("" : "+s"(tok0));
        int tid = get_tid(wid);
        const int w = __builtin_amdgcn_readfirstlane(tid >> 6), lane = tid & 63, r = lane & 31, h = lane >> 5;
        ALoadGelu al; al.init(a.YPRE + (size_t)(tok0 + (tid >> 3)) * 512, a.G1 + (size_t)(tok0 + (tid >> 3)) * 512, tid);
        f32x16 acc[2][2]; zero_acc<2>(acc);
        gemm64<2, 4>(acc, al, 4, a.wfglu + (size_t)w * (32 * 2 * 64) + lane, sA, lane);
        float ss0 = 0.f, ss1 = 0.f;
        {
            uint2 yp[2][2][4]; float4 bg[2][4];
#pragma unroll
            for (int nt = 0; nt < 2; ++nt)
#pragma unroll
                for (int q = 0; q < 4; ++q) bg[nt][q] = *(const float4*)(a.b_glu + w * 64 + nt * 32 + 8 * q + 4 * h);
#pragma unroll
            for (int mt = 0; mt < 2; ++mt)
#pragma unroll
                for (int nt = 0; nt < 2; ++nt)
#pragma unroll
                    for (int q = 0; q < 4; ++q)
                        yp[mt][nt][q] = *(const uint2*)(a.G1 + (size_t)(tok0 + mt * 32 + r) * 512 + w * 64 + nt * 32 + 8 * q + 4 * h);
#pragma unroll
            for (int mt = 0; mt < 2; ++mt)
#pragma unroll
                for (int nt = 0; nt < 2; ++nt)
#pragma unroll
                    for (int q = 0; q < 4; ++q) {
                        const float y0 = bf_lo(yp[mt][nt][q].x), y1 = bf_hi(yp[mt][nt][q].x), y2 = bf_lo(yp[mt][nt][q].y), y3 = bf_hi(yp[mt][nt][q].y);
                        const float o0 = y0 / (1.f + __expf(-(acc[nt][mt][4 * q] + bg[nt][q].x)));
                        const float o1 = y1 / (1.f + __expf(-(acc[nt][mt][4 * q + 1] + bg[nt][q].y)));
                        const float o2 = y2 / (1.f + __expf(-(acc[nt][mt][4 * q + 2] + bg[nt][q].z)));
                        const float o3 = y3 / (1.f + __expf(-(acc[nt][mt][4 * q + 3] + bg[nt][q].w)));
                        acc[nt][mt][4 * q] = o0; acc[nt][mt][4 * q + 1] = o1; acc[nt][mt][4 * q + 2] = o2; acc[nt][mt][4 * q + 3] = o3;
                        const float s = o0 * o0 + o1 * o1 + o2 * o2 + o3 * o3;
                        if (mt == 0) ss0 += s; else ss1 += s;
                    }
        }
        float t0, t1; tok_reduce(ss0, ss1, sred, t0, t1, tid);
        const float rs0 = rsqrtf(t0 * (1.f / 512.f) + 1e-6f), rs1 = rsqrtf(t1 * (1.f / 512.f) + 1e-6f);
#pragma unroll
        for (int mt = 0; mt < 2; ++mt) {
            const float rs = mt ? rs1 : rs0;
            bf16_t* orow = a.A2 + (size_t)(tok0 + mt * 32 + r) * DM + w * 64;
#pragma unroll
            for (int nt = 0; nt < 2; ++nt)
#pragma unroll
                for (int q = 0; q < 4; ++q) {
                    uint2 o; o.x = pack_bf2(acc[nt][mt][4 * q] * rs, acc[nt][mt][4 * q + 1] * rs);
                    o.y = pack_bf2(acc[nt][mt][4 * q + 2] * rs, acc[nt][mt][4 * q + 3] * rs);
                    *(uint2*)(orow + nt * 32 + 8 * q + 4 * h) = o;
                }
        }
    }
    for (int rep_ = 0; rep_ < REP_POOL; ++rep_) {
        int tok0 = tile * 64; asm volatile("" : "+s"(tok0));
        int tid = get_tid(wid);
        const int w = __builtin_amdgcn_readfirstlane(tid >> 6), lane = tid & 63, r = lane & 31, h = lane >> 5;
        const int row = tid >> 3, seg = tid & 7;
        const int tok = tok0 + row, t = tok & (SEQ - 1);
#pragma unroll
        for (int gi = 0; gi < 4; ++gi) {
            const int win = 2 << gi;
            const int cnt = (t + 1 < win) ? (t + 1) : win;
            const bf16_t* up = a.U + (size_t)tok * DM + 512 + gi * 128 + seg * 16;
            float s[16];
            const uint4 c0 = *(const uint4*)up, c1 = *(const uint4*)(up + 8);
            const unsigned cu[8] = {c0.x, c0.y, c0.z, c0.w, c1.x, c1.y, c1.z, c1.w};
#pragma unroll
            for (int i = 0; i < 8; ++i) { s[2 * i] = bf_lo(cu[i]); s[2 * i + 1] = bf_hi(cu[i]); }
#pragma unroll
            for (int k0 = 1; k0 < win; k0 += 5) {
                uint4 d0[5], d1[5];
#pragma unroll
                for (int u = 0; u < 5; ++u)
                    if (k0 + u < win) {
                        const bf16_t* p = (k0 + u <= t) ? up - (size_t)(k0 + u) * DM : up;
                        d0[u] = *(const uint4*)p; d1[u] = *(const uint4*)(p + 8);
                    }
#pragma unroll
                for (int u = 0; u < 5; ++u)
                    if (k0 + u < win) {
                        const float m = (k0 + u <= t) ? 1.f : 0.f;
                        const unsigned du[8] = {d0[u].x, d0[u].y, d0[u].z, d0[u].w, d1[u].x, d1[u].y, d1[u].z, d1[u].w};
#pragma unroll
                        for (int i = 0; i < 8; ++i) { s[2 * i] = fmaf(m, bf_lo(du[i]), s[2 * i]); s[2 * i + 1] = fmaf(m, bf_hi(du[i]), s[2 * i + 1]); }
                    }
            }
            const float inv = 1.f / (float)cnt;
            unsigned o[8];
#pragma unroll
            for (int i = 0; i < 8; ++i) o[i] = pack_bf2(s[2 * i] * inv - bf_lo(cu[i]), s[2 * i + 1] * inv - bf_hi(cu[i]));
            char* d = sA + gi * SA_BYTES + row * SA_STRIDE + seg * 32;
            *(uint4*)d = make_uint4(o[0], o[1], o[2], o[3]); *(uint4*)(d + 16) = make_uint4(o[4], o[5], o[6], o[7]);
        }
        __syncthreads();
        const int gi = w >> 1;
        f32x16 acc[2][2]; zero_acc<2>(acc);
        const bf16x8* wp = a.wfpool + (size_t)gi * (128 * 128 / 8) + (size_t)(w & 1) * (8 * 2 * 64) + lane;
        const char* buf = sA + gi * SA_BYTES + r * SA_STRIDE + h * 16;
#pragma unroll
        for (int ks = 0; ks < 8; ++ks) {
            const bf16x8 a0 = *(const bf16x8*)(buf + ks * 32);
            const bf16x8 a1 = *(const bf16x8*)(buf + 32 * SA_STRIDE + ks * 32);
#pragma unroll
            for (int nt = 0; nt < 2; ++nt) {
                const bf16x8 wv = wp[(ks * 2 + nt) * 64];
                acc[nt][0] = MFMA32(wv, a0, acc[nt][0]);
                acc[nt][1] = MFMA32(wv, a1, acc[nt][1]);
            }
        }
        float ss0 = 0.f, ss1 = 0.f;
        float4 psc[2][4];
#pragma unroll
        for (int nt = 0; nt < 2; ++nt)
#pragma unroll
            for (int q = 0; q < 4; ++q) psc[nt][q] = *(const float4*)(a.pool_scale + w * 64 + nt * 32 + 8 * q + 4 * h);
#pragma unroll
        for (int mt = 0; mt < 2; ++mt)
#pragma unroll
            for (int nt = 0; nt < 2; ++nt)
#pragma unroll
                for (int q = 0; q < 4; ++q) {
                    const float4 sc = psc[nt][q];
                    const float o0 = acc[nt][mt][4 * q] * sc.x, o1 = acc[nt][mt][4 * q + 1] * sc.y, o2 = acc[nt][mt][4 * q + 2] * sc.z, o3 = acc[nt][mt][4 * q + 3] * sc.w;
                    acc[nt][mt][4 * q] = o0; acc[nt][mt][4 * q + 1] = o1; acc[nt][mt][4 * q + 2] = o2; acc[nt][mt][4 * q + 3] = o3;
                    const float s = o0 * o0 + o1 * o1 + o2 * o2 + o3 * o3;
                    if (mt == 0) ss0 += s; else ss1 += s;
                }
        float t0, t1; tok_reduce(ss0, ss1, sred, t0, t1, tid);
        const float rs0 = rsqrtf(t0 * (1.f / 512.f) + 1e-6f), rs1 = rsqrtf(t1 * (1.f / 512.f) + 1e-6f);
#pragma unroll
        for (int mt = 0; mt < 2; ++mt) {
            const float rs = mt ? rs1 : rs0;
            bf16_t* orow = a.A2 + (size_t)(tok0 + mt * 32 + r) * DM + 512 + w * 64;
#pragma unroll
            for (int nt = 0; nt < 2; ++nt)
#pragma unroll
                for (int q = 0; q < 4; ++q) {
                    uint2 o; o.x = pack_bf2(acc[nt][mt][4 * q] * rs, acc[nt][mt][4 * q + 1] * rs);
                    o.y = pack_bf2(acc[nt][mt][4 * q + 2] * rs, acc[nt][mt][4 * q + 3] * rs);
                    *(uint2*)(orow + nt * 32 + 8 * q + 4 * h) = o;
                }
        }
        __syncthreads();
    }
    for (int rep_ = 0; rep_ < REP_OUT; ++rep_) {
        float* xout_ = (rep_ + 1 < REP_OUT) ? a.Xdummy : a.Xout;
        int tok0 = tile * 64; asm volatile("" : "+s"(tok0));
        int tid = get_tid(wid);
        const int w = __builtin_amdgcn_readfirstlane(tid >> 6), lane = tid & 63, r = lane & 31, h = lane >> 5;
        ALoadBF16 al; al.init(a.A2 + (size_t)(tok0 + (tid >> 3)) * DM, tid);
        f32x16 acc[4][2]; zero_acc<4>(acc);
        gemm64<4, 2>(acc, al, 8, a.wfout + (size_t)w * (64 * 4 * 64) + lane, sA, lane);
        {
            float* wscr = (float*)(smem + w * WSCR_BYTES);
            const int tl = lane >> 3, cl = (lane & 7) * 4;
            float ssj[2][4];
#pragma unroll
            for (int mt = 0; mt < 2; ++mt)
#pragma unroll
                for (int j = 0; j < 4; ++j) ssj[mt][j] = 0.f;
            float4 xc[4], xn[4];
            const size_t rbase = (size_t)(tok0 + tl) * DM + w * 128 + cl;
#pragma unroll
            for (int j = 0; j < 4; ++j) xc[j] = *(const float4*)(a.Xin + rbase + (size_t)(8 * j) * DM);
#pragma unroll
            for (int g = 0; g < 8; ++g) {
                const int mt = g >> 2, nt = g & 3;
                if (g < 7) {
                    const size_t rn = rbase + (size_t)((g + 1) >> 2) * 32 * DM + ((g + 1) & 3) * 32;
#pragma unroll
                    for (int j = 0; j < 4; ++j) xn[j] = *(const float4*)(a.Xin + rn + (size_t)(8 * j) * DM);
                }
                f32x4 o[4]; tile_transpose(acc[nt][mt], wscr, lane, o);
                const size_t ro = rbase + (size_t)mt * 32 * DM + nt * 32;
#pragma unroll
                for (int j = 0; j < 4; ++j) {
                    float4 xo; xo.x = xc[j].x + o[j].x; xo.y = xc[j].y + o[j].y; xo.z = xc[j].z + o[j].z; xo.w = xc[j].w + o[j].w;
                    *(float4*)(xout_ + ro + (size_t)(8 * j) * DM) = xo;
                    uint2 p; p.x = pack_bf2(xo.x, xo.y); p.y = pack_bf2(xo.z, xo.w);
                    *(uint2*)(a.Hb + ro + (size_t)(8 * j) * DM) = p;
                    ssj[mt][j] += xo.x * xo.x + xo.y * xo.y + xo.z * xo.z + xo.w * xo.w;
                }
                asm volatile("" ::: "memory");
#pragma unroll
                for (int j = 0; j < 4; ++j) xc[j] = xn[j];
            }
#pragma unroll
            for (int mt = 0; mt < 2; ++mt)
#pragma unroll
                for (int j = 0; j < 4; ++j) {
                    float v = ssj[mt][j];
                    v += shx<1>(v, lane); v += shx<2>(v, lane); v += shx<4>(v, lane);
                    if ((lane & 7) == 0) sred[w * 64 + mt * 32 + tl + 8 * j] = v;
                }
            __syncthreads();
            if (tid < 64) {
                float tot = 0.f;
#pragma unroll
                for (int k = 0; k < 8; ++k) tot += sred[k * 64 + tid];
                a.RSTD[tok0 + tid] = rsqrtf(tot * (1.f / 1024.f) + 1e-6f);
            }
        }
        __syncthreads();
    }
}

DI unsigned f2ord(float f) { const unsigned u = __float_as_uint(f); return u ^ ((u >> 31) ? 0xFFFFFFFFu : 0x80000000u); }
DI float ord2f(unsigned o) { return __uint_as_float((o & 0x80000000u) ? (o ^ 0x80000000u) : ~o); }
DI unsigned umax_(unsigned a, unsigned b) { return a > b ? a : b; }
DI unsigned umin_(unsigned a, unsigned b) { return a < b ? a : b; }

struct PRArgs {
    const bf16_t* Hb; const float* RSTD; const bf16x8* wfq; const bf16x8* kf1; const bf16x8* kf2; unsigned short* EX; float* GT;
};

DI void conv_kfrag(const float* __restrict__ K, bf16x8* __restrict__ dst, size_t gtid, size_t gstride) {
    for (size_t item = gtid; item < 8 * 4 * 64; item += gstride) {
        const int lane = (int)(item & 63), kt = (int)((item >> 6) & 3), ks = (int)(item >> 8);
        const int r = lane & 31, h = lane >> 5;
        float v[8];
#pragma unroll
        for (int j = 0; j < 8; ++j) v[j] = K[(size_t)(kt * 32 + r) * 128 + (ks >> 1) * 32 + 16 * (ks & 1) + 8 * (j >> 2) + 4 * h + (j & 3)];
        uint4 o; o.x = pack_bf2(v[0], v[1]); o.y = pack_bf2(v[2], v[3]); o.z = pack_bf2(v[4], v[5]); o.w = pack_bf2(v[6], v[7]);
        *(uint4*)(dst + item) = o;
    }
}

DI void bitonic_sort16(unsigned (&a)[16]) {
#pragma unroll
    for (int k = 2; k <= 16; k <<= 1)
#pragma unroll
        for (int j = k >> 1; j > 0; j >>= 1)
#pragma unroll
            for (int i = 0; i < 16; ++i) {
                const int l = i ^ j;
                if (l > i) {
                    const unsigned hi = umax_(a[i], a[l]), lo = umin_(a[i], a[l]);
                    if ((i & k) == 0) { a[i] = hi; a[l] = lo; } else { a[i] = lo; a[l] = hi; }
                }
            }
}
DI void bitonic_top16(unsigned (&a)[16], const unsigned (&b)[16]) {
#pragma unroll
    for (int i = 0; i < 16; ++i) a[i] = umax_(a[i], b[15 - i]);
#pragma unroll
    for (int j = 8; j > 0; j >>= 1)
#pragma unroll
        for (int i = 0; i < 16; ++i) {
            const int l = i ^ j;
            if (l > i) { const unsigned hi = umax_(a[i], a[l]), lo = umin_(a[i], a[l]); a[i] = hi; a[l] = lo; }
        }
}
DI void make_keys(unsigned (&x)[16], const f32x16& s, float rs, int nbase, int h) {
#pragma unroll
    for (int i = 0; i < 16; ++i) x[i] = (f2ord(s[i] * rs) & 0xFFFFFF80u) | (unsigned)(127 - (nbase + crow(i, h)));
}

#define PR_LIST_STRIDE 80
#define PR_SLIST (2 * SA_BYTES)
#define PR_SIDX (PR_SLIST + 8 * 32 * PR_LIST_STRIDE)

DI void phaseC2_tile(const PRArgs& a, int tile, char* smem, int wid) {
    char* sA = smem;
#pragma unroll 1
    for (int ps = 0; ps < 2; ++ps) {
        int tok0 = tile * 64; asm volatile("" : "+s"(tok0));
        int tid = get_tid(wid);
        const int w = __builtin_amdgcn_readfirstlane(tid >> 6), lane = tid & 63, r = lane & 31, h = lane >> 5;
        const int ng = ps * 8 + w, hd = ng >> 1, hf = ng & 1;
        bf16x8 qb[2][8];
        {
            ALoadBF16 al; al.init(a.Hb + (size_t)(tok0 + (tid >> 3)) * DM, tid);
            f32x16 acc[4][2]; zero_acc<4>(acc);
            gemm64<4, 2>(acc, al, 8, a.wfq + (size_t)ng * (64 * 4 * 64) + lane, sA, lane);
#pragma unroll
            for (int mt = 0; mt < 2; ++mt)
#pragma unroll
                for (int nt = 0; nt < 4; ++nt)
#pragma unroll
                    for (int s = 0; s < 2; ++s) {
                        u32x4 p;
                        p.x = pack_bf2(acc[nt][mt][8 * s], acc[nt][mt][8 * s + 1]); p.y = pack_bf2(acc[nt][mt][8 * s + 2], acc[nt][mt][8 * s + 3]);
                        p.z = pack_bf2(acc[nt][mt][8 * s + 4], acc[nt][mt][8 * s + 5]); p.w = pack_bf2(acc[nt][mt][8 * s + 6], acc[nt][mt][8 * s + 7]);
                        qb[mt][nt * 2 + s] = __builtin_bit_cast(bf16x8, p);
                    }
        }
        gwp_t kf = (gwp_t)(hf ? a.kf2 : a.kf1) + lane;
        unsigned Town[16];
#pragma unroll
        for (int mt = 0; mt < 2; ++mt) {
            f32x16 sc[4];
#pragma unroll
            for (int kt = 0; kt < 4; ++kt)
#pragma unroll
                for (int i = 0; i < 16; ++i) sc[kt][i] = 0.f;
#pragma unroll
            for (int ks = 0; ks < 8; ++ks) {
#pragma unroll
                for (int kt = 0; kt < 4; ++kt) sc[kt] = MFMA32(kf[(ks * 4 + kt) * 64], qb[mt][ks], sc[kt]);
                if (ks & 1) asm volatile("" ::: "memory");
            }
            const float rs = a.RSTD[tok0 + mt * 32 + r];
            unsigned L[16], S[16];
            make_keys(L, sc[0], rs, 0, h); bitonic_sort16(L);
#pragma unroll
            for (int kt = 1; kt < 4; ++kt) { make_keys(S, sc[kt], rs, kt * 32, h); bitonic_sort16(S); bitonic_top16(L, S); }
#pragma unroll
            for (int k = 0; k < 16; ++k) S[k] = (unsigned)shx_i<32>((int)L[k], lane);
            bitonic_top16(L, S);
            if (mt == hf) {
#pragma unroll
                for (int k = 0; k < 16; ++k) Town[k] = L[k];
            } else {
                char* dst = smem + PR_SLIST + (w * 32 + r) * PR_LIST_STRIDE + h * 32;
                u32x4 v0, v1;
                if (h == 0) { v0 = (u32x4){L[0], L[1], L[2], L[3]}; v1 = (u32x4){L[4], L[5], L[6], L[7]}; }
                else { v0 = (u32x4){L[8], L[9], L[10], L[11]}; v1 = (u32x4){L[12], L[13], L[14], L[15]}; }
                *(u32x4*)dst = v0; *(u32x4*)(dst + 16) = v1;
            }
        }
        __syncthreads();
        unsigned T0[16], T1[16];
        {
            const char* src = smem + PR_SLIST + ((w ^ 1) * 32 + r) * PR_LIST_STRIDE;
            const u32x4 p0 = *(const u32x4*)src, p1 = *(const u32x4*)(src + 16), p2 = *(const u32x4*)(src + 32), p3 = *(const u32x4*)(src + 48);
            const unsigned Tp[16] = {p0.x, p0.y, p0.z, p0.w, p1.x, p1.y, p1.z, p1.w, p2.x, p2.y, p2.z, p2.w, p3.x, p3.y, p3.z, p3.w};
#pragma unroll
            for (int k = 0; k < 16; ++k) { T0[k] = hf ? Tp[k] : Town[k]; T1[k] = hf ? Town[k] : Tp[k]; }
        }
        float v1[16], v2[16];
#pragma unroll
        for (int k = 0; k < 16; ++k) { v1[k] = ord2f(T0[k] & 0xFFFFFF80u); v2[k] = ord2f(T1[k] & 0xFFFFFF80u); }
        unsigned C[16];
#pragma unroll
        for (int b = 0; b < 16; ++b) C[b] = (f2ord(v1[0] + v2[b]) & 0xFFFFFF00u) | (unsigned)(255 - b);
#pragma unroll
        for (int aa = 1; aa < 16; ++aa)
#pragma unroll
            for (int b = 0; b < 16; ++b)
                if ((aa + 1) * (b + 1) <= 16) {
                    unsigned x = (f2ord(v1[aa] + v2[b]) & 0xFFFFFF00u) | (unsigned)(255 - (aa * 16 + b));
#pragma unroll
                    for (int k = (aa + 1) * (b + 1) - 1; k < 16; ++k) { const unsigned hi = umax_(C[k], x); x = umin_(C[k], x); C[k] = hi; }
                }
        unsigned* sI = (unsigned*)(smem + PR_SIDX) + (w * 64 + lane) * 9;
#pragma unroll
        for (int q = 0; q < 4; ++q) {
            unsigned p1 = 0u, p2 = 0u;
#pragma unroll
            for (int j = 0; j < 4; ++j) { p1 |= (127u - (T0[4 * q + j] & 0x7Fu)) << (8 * j); p2 |= (127u - (T1[4 * q + j] & 0x7Fu)) << (8 * j); }
            sI[q] = p1; sI[4 + q] = p2;
        }
        const unsigned char* sB = (const unsigned char*)sI;
        const float mx = ord2f(C[0] & 0xFFFFFF00u);
        float e[16]; float sum = 0.f; int ex[16];
#pragma unroll
        for (int k = 0; k < 16; ++k) {
            e[k] = __expf(ord2f(C[k] & 0xFFFFFF00u) - mx); sum += e[k];
            const unsigned ci = 255u - (C[k] & 0xFFu);
            ex[k] = (int)sB[ci >> 4] * 128 + (int)sB[16 + (ci & 15u)];
        }
        const float inv = 1.f / sum;
        const size_t ob = ((size_t)(tok0 + hf * 32 + r) * 8 + hd) * 16;
        if (h == 0) {
#pragma unroll
            for (int q = 0; q < 2; ++q) *(uint4*)(a.EX + ob + 8 * q) = make_uint4((unsigned)ex[8 * q] | ((unsigned)ex[8 * q + 1] << 16), (unsigned)ex[8 * q + 2] | ((unsigned)ex[8 * q + 3] << 16),
                                                                       (unsigned)ex[8 * q + 4] | ((unsigned)ex[8 * q + 5] << 16), (unsigned)ex[8 * q + 6] | ((unsigned)ex[8 * q + 7] << 16));
        } else {
#pragma unroll
            for (int q = 0; q < 4; ++q) *(float4*)(a.GT + ob + 4 * q) = make_float4(e[4 * q] * inv, e[4 * q + 1] * inv, e[4 * q + 2] * inv, e[4 * q + 3] * inv);
        }
        __syncthreads();
    }
}
typedef const __attribute__((address_space(1))) u32x4* grow_t;
typedef unsigned char fp8_t;

struct PGArgs {
    const bf16_t* Hb; const float* RSTD; const int* EX; const float* GT; const fp8_t* U8; const fp8_t* V8; const float* SU; const float* SV;
    const float* Xin; float* Xout; const float* gfinal; int final_norm;
};

#ifndef EMU_FP4
#define EMU_FP4 0
#endif
DI float q_e2m1(float x, float inv, float sc) {
    const float a = fabsf(x) * inv;
    float q = (a < 0.25f) ? 0.f : (a < 0.75f) ? 0.5f : (a < 1.25f) ? 1.f : (a < 1.75f) ? 1.5f : (a < 2.5f) ? 2.f : (a < 3.5f) ? 3.f : (a < 5.f) ? 4.f : 6.f;
    return copysignf(q * sc, x);
}
DI void emu_fp4_block(float4& v0, float4& v1, float4& v2, float4& v3) {
    float m = fmaxf(fmaxf(fmaxf(fabsf(v0.x), fabsf(v0.y)), fmaxf(fabsf(v0.z), fabsf(v0.w))), fmaxf(fmaxf(fabsf(v1.x), fabsf(v1.y)), fmaxf(fabsf(v1.z), fabsf(v1.w))));
    m = fmaxf(m, fmaxf(fmaxf(fmaxf(fabsf(v2.x), fabsf(v2.y)), fmaxf(fabsf(v2.z), fabsf(v2.w))), fmaxf(fmaxf(fabsf(v3.x), fabsf(v3.y)), fmaxf(fabsf(v3.z), fabsf(v3.w)))));
    const float sc = (m > 0.f) ? m * (1.f / 6.f) : 1.f, inv = 1.f / sc;
    v0.x = q_e2m1(v0.x, inv, sc); v0.y = q_e2m1(v0.y, inv, sc); v0.z = q_e2m1(v0.z, inv, sc); v0.w = q_e2m1(v0.w, inv, sc);
    v1.x = q_e2m1(v1.x, inv, sc); v1.y = q_e2m1(v1.y, inv, sc); v1.z = q_e2m1(v1.z, inv, sc); v1.w = q_e2m1(v1.w, inv, sc);
    v2.x = q_e2m1(v2.x, inv, sc); v2.y = q_e2m1(v2.y, inv, sc); v2.z = q_e2m1(v2.z, inv, sc); v2.w = q_e2m1(v2.w, inv, sc);
    v3.x = q_e2m1(v3.x, inv, sc); v3.y = q_e2m1(v3.y, inv, sc); v3.z = q_e2m1(v3.z, inv, sc); v3.w = q_e2m1(v3.w, inv, sc);
}
DI void conv_row_fp8_one(float4 v0, float4 v1, float4 v2, float4 v3, const float* __restrict__ gain, fp8_t* __restrict__ dst, float* __restrict__ scales,
                         int nrows, int row, int lane) {
    if (gain) {
        const float4* g = (const float4*)(gain + lane * 16);
        const float4 g0 = g[0], g1 = g[1], g2 = g[2], g3 = g[3];
        v0.x *= g0.x; v0.y *= g0.y; v0.z *= g0.z; v0.w *= g0.w; v1.x *= g1.x; v1.y *= g1.y; v1.z *= g1.z; v1.w *= g1.w;
        v2.x *= g2.x; v2.y *= g2.y; v2.z *= g2.z; v2.w *= g2.w; v3.x *= g3.x; v3.y *= g3.y; v3.z *= g3.z; v3.w *= g3.w;
    }
    if (gain ? (EMU_FP4 & 1) : (EMU_FP4 & 2)) emu_fp4_block(v0, v1, v2, v3);
    float m = fmaxf(fmaxf(fmaxf(fabsf(v0.x), fabsf(v0.y)), fmaxf(fabsf(v0.z), fabsf(v0.w))), fmaxf(fmaxf(fabsf(v1.x), fabsf(v1.y)), fmaxf(fabsf(v1.z), fabsf(v1.w))));
    m = fmaxf(m, fmaxf(fmaxf(fmaxf(fabsf(v2.x), fabsf(v2.y)), fmaxf(fabsf(v2.z), fabsf(v2.w))), fmaxf(fmaxf(fabsf(v3.x), fabsf(v3.y)), fmaxf(fabsf(v3.z), fabsf(v3.w)))));
    m = fmaxf(m, shx<1>(m, lane)); m = fmaxf(m, shx<2>(m, lane)); m = fmaxf(m, shx<4>(m, lane)); m = fmaxf(m, shx<8>(m, lane)); m = fmaxf(m, shx<16>(m, lane)); m = fmaxf(m, shx<32>(m, lane));
    const float sc = (m > 0.f) ? m * (1.f / 448.f) : 1.f;
    const float inv = 1.f / sc;
    u32x4 o;
    unsigned t;
    t = 0u; t = __builtin_amdgcn_cvt_pk_fp8_f32(v0.x * inv, v0.y * inv, t, false); t = __builtin_amdgcn_cvt_pk_fp8_f32(v0.z * inv, v0.w * inv, t, true); o.x = t;
    t = 0u; t = __builtin_amdgcn_cvt_pk_fp8_f32(v1.x * inv, v1.y * inv, t, false); t = __builtin_amdgcn_cvt_pk_fp8_f32(v1.z * inv, v1.w * inv, t, true); o.y = t;
    t = 0u; t = __builtin_amdgcn_cvt_pk_fp8_f32(v2.x * inv, v2.y * inv, t, false); t = __builtin_amdgcn_cvt_pk_fp8_f32(v2.z * inv, v2.w * inv, t, true); o.z = t;
    t = 0u; t = __builtin_amdgcn_cvt_pk_fp8_f32(v3.x * inv, v3.y * inv, t, false); t = __builtin_amdgcn_cvt_pk_fp8_f32(v3.z * inv, v3.w * inv, t, true); o.w = t;
    *(u32x4*)(dst + ((size_t)(lane >> 3) * nrows + row) * 128 + (lane & 7) * 16) = o;
    if (lane == 0) scales[row] = sc;
}
DI void conv_rows_fp8(const float* __restrict__ src, const float* __restrict__ gain, fp8_t* __restrict__ dst, float* __restrict__ scales,
                      int nrows, int gwave, int nwaves, int lane) {
#pragma unroll 1
    for (int row = gwave; row < nrows; row += 4 * nwaves) {
        const int r1 = min(row + nwaves, nrows - 1), r2 = min(row + 2 * nwaves, nrows - 1), r3 = min(row + 3 * nwaves, nrows - 1);
        const float4* p0 = (const float4*)(src + (size_t)row * DM + lane * 16);
        const float4* p1 = (const float4*)(src + (size_t)r1 * DM + lane * 16);
        const float4* p2 = (const float4*)(src + (size_t)r2 * DM + lane * 16);
        const float4* p3 = (const float4*)(src + (size_t)r3 * DM + lane * 16);
        const float4 a0 = p0[0], a1 = p0[1], a2 = p0[2], a3 = p0[3];
        const float4 b0 = p1[0], b1 = p1[1], b2 = p1[2], b3 = p1[3];
        const float4 c0 = p2[0], c1 = p2[1], c2 = p2[2], c3 = p2[3];
        const float4 d0 = p3[0], d1 = p3[1], d2 = p3[2], d3 = p3[3];
        conv_row_fp8_one(a0, a1, a2, a3, gain, dst, scales, nrows, row, lane);
        conv_row_fp8_one(b0, b1, b2, b3, gain, dst, scales, nrows, r1, lane);
        conv_row_fp8_one(c0, c1, c2, c3, gain, dst, scales, nrows, r2, lane);
        conv_row_fp8_one(d0, d1, d2, d3, gain, dst, scales, nrows, r3, lane);
    }
}

struct RowOct { u32x4 r0, r1, r2, r3, r4, r5, r6, r7; };
DI void oct_load(RowOct& q, const fp8_t* tab, int e0, int e1, int e2, int e3, int e4, int e5, int e6, int e7, int lane) {
    q.r0 = ((grow_t)(tab + (size_t)e0 * DM))[lane]; q.r1 = ((grow_t)(tab + (size_t)e1 * DM))[lane];
    q.r2 = ((grow_t)(tab + (size_t)e2 * DM))[lane]; q.r3 = ((grow_t)(tab + (size_t)e3 * DM))[lane];
    q.r4 = ((grow_t)(tab + (size_t)e4 * DM))[lane]; q.r5 = ((grow_t)(tab + (size_t)e5 * DM))[lane];
    q.r6 = ((grow_t)(tab + (size_t)e6 * DM))[lane]; q.r7 = ((grow_t)(tab + (size_t)e7 * DM))[lane];
}
DI float dot4w(unsigned w, float h0, float h1, float h2, float h3, float s) {
    const f2_t lo = __builtin_amdgcn_cvt_pk_f32_fp8(w, false), hi = __builtin_amdgcn_cvt_pk_f32_fp8(w, true);
    s = fmaf(lo.x, h0, s); s = fmaf(lo.y, h1, s); s = fmaf(hi.x, h2, s); s = fmaf(hi.y, h3, s);
    return s;
}
DI float row_dot8(const u32x4& r, const float (&h)[16]) {
    float s = 0.f;
    s = dot4w(r.x, h[0], h[1], h[2], h[3], s); s = dot4w(r.y, h[4], h[5], h[6], h[7], s);
    s = dot4w(r.z, h[8], h[9], h[10], h[11], s); s = dot4w(r.w, h[12], h[13], h[14], h[15], s);
    return s;
}
DI void axpy4w(unsigned w, float c, float& a0, float& a1, float& a2, float& a3) {
    const f2_t lo = __builtin_amdgcn_cvt_pk_f32_fp8(w, false), hi = __builtin_amdgcn_cvt_pk_f32_fp8(w, true);
    a0 = fmaf(c, lo.x, a0); a1 = fmaf(c, lo.y, a1); a2 = fmaf(c, hi.x, a2); a3 = fmaf(c, hi.y, a3);
}
DI void row_axpy8(float (&acc)[16], const u32x4& r, float c) {
    axpy4w(r.x, c, acc[0], acc[1], acc[2], acc[3]); axpy4w(r.y, c, acc[4], acc[5], acc[6], acc[7]);
    axpy4w(r.z, c, acc[8], acc[9], acc[10], acc[11]); axpy4w(r.w, c, acc[12], acc[13], acc[14], acc[15]);
}
#define RL(v, l) __builtin_amdgcn_readlane((v), (l))
#define RLF(v, l) __uint_as_float((unsigned)__builtin_amdgcn_readlane((int)__float_as_uint(v), (l)))

DI float reduce16(float (&p)[16], int lane) {
    const bool b5 = lane & 32, b4 = lane & 16, b3 = lane & 8, b2 = lane & 4;
    float q8[8], q4[4], q2[2];
#pragma unroll
    for (int k = 0; k < 8; ++k) { const float keep = b5 ? p[k + 8] : p[k], send = b5 ? p[k] : p[k + 8]; q8[k] = keep + shx<32>(send, lane); }
#pragma unroll
    for (int k = 0; k < 4; ++k) { const float keep = b4 ? q8[k + 4] : q8[k], send = b4 ? q8[k] : q8[k + 4]; q4[k] = keep + shx<16>(send, lane); }
#pragma unroll
    for (int k = 0; k < 2; ++k) { const float keep = b3 ? q4[k + 2] : q4[k], send = b3 ? q4[k] : q4[k + 2]; q2[k] = keep + shx<8>(send, lane); }
    float t;
    { const float keep = b2 ? q2[1] : q2[0], send = b2 ? q2[0] : q2[1]; t = keep + shx<4>(send, lane); }
    t += shx<1>(t, lane); t += shx<2>(t, lane);
    return t;
}

DI void phaseC3_tile(const PGArgs& a, int tile, int wid) {
    int tid = get_tid(wid);
    const int w = __builtin_amdgcn_readfirstlane(tid >> 6), lane = tid & 63;
    const int el = (lane >> 2) & 15;
#pragma unroll 1
    for (int ti = 0; ti < 8; ++ti) {
        const int tok = tile * 64 + w * 8 + ti;
        float h[16];
        {
            const u32x4* hp = (const u32x4*)(a.Hb + (size_t)tok * DM + lane * 16);
            const u32x4 h0 = hp[0], h1 = hp[1];
            h[0] = bf_lo(h0.x); h[1] = bf_hi(h0.x); h[2] = bf_lo(h0.y); h[3] = bf_hi(h0.y); h[4] = bf_lo(h0.z); h[5] = bf_hi(h0.z); h[6] = bf_lo(h0.w); h[7] = bf_hi(h0.w);
            h[8] = bf_lo(h1.x); h[9] = bf_hi(h1.x); h[10] = bf_lo(h1.y); h[11] = bf_hi(h1.y); h[12] = bf_lo(h1.z); h[13] = bf_hi(h1.z); h[14] = bf_lo(h1.w); h[15] = bf_hi(h1.w);
        }
        const float rs = a.RSTD[tok];
        float acc[16];
#pragma unroll
        for (int i = 0; i < 16; ++i) acc[i] = 0.f;
#pragma unroll 1
        for (int hd = 0; hd < 8; ++hd) {
            const size_t eb = ((size_t)tok * 8 + hd) * 16;
            const int exv = a.EX[eb + (lane & 15)];
            const int exl = a.EX[eb + el];
            const float coef = a.GT[eb + el] * a.SV[exl];
            const float su = a.SU[exl] * rs;
            RowOct qa, qb;
            float p[16];
            oct_load(qa, a.U8, RL(exv, 0), RL(exv, 1), RL(exv, 2), RL(exv, 3), RL(exv, 4), RL(exv, 5), RL(exv, 6), RL(exv, 7), lane);
            oct_load(qb, a.U8, RL(exv, 8), RL(exv, 9), RL(exv, 10), RL(exv, 11), RL(exv, 12), RL(exv, 13), RL(exv, 14), RL(exv, 15), lane);
            p[0] = row_dot8(qa.r0, h); p[1] = row_dot8(qa.r1, h); p[2] = row_dot8(qa.r2, h); p[3] = row_dot8(qa.r3, h);
            p[4] = row_dot8(qa.r4, h); p[5] = row_dot8(qa.r5, h); p[6] = row_dot8(qa.r6, h); p[7] = row_dot8(qa.r7, h);
            oct_load(qa, a.V8, RL(exv, 0), RL(exv, 1), RL(exv, 2), RL(exv, 3), RL(exv, 4), RL(exv, 5), RL(exv, 6), RL(exv, 7), lane);
            p[8] = row_dot8(qb.r0, h); p[9] = row_dot8(qb.r1, h); p[10] = row_dot8(qb.r2, h); p[11] = row_dot8(qb.r3, h);
            p[12] = row_dot8(qb.r4, h); p[13] = row_dot8(qb.r5, h); p[14] = row_dot8(qb.r6, h); p[15] = row_dot8(qb.r7, h);
            oct_load(qb, a.V8, RL(exv, 8), RL(exv, 9), RL(exv, 10), RL(exv, 11), RL(exv, 12), RL(exv, 13), RL(exv, 14), RL(exv, 15), lane);
            const float act = gelu_exact(reduce16(p, lane) * su) * coef;
            row_axpy8(acc, qa.r0, RLF(act, 0)); row_axpy8(acc, qa.r1, RLF(act, 4)); row_axpy8(acc, qa.r2, RLF(act, 8)); row_axpy8(acc, qa.r3, RLF(act, 12));
            row_axpy8(acc, qa.r4, RLF(act, 16)); row_axpy8(acc, qa.r5, RLF(act, 20)); row_axpy8(acc, qa.r6, RLF(act, 24)); row_axpy8(acc, qa.r7, RLF(act, 28));
            row_axpy8(acc, qb.r0, RLF(act, 32)); row_axpy8(acc, qb.r1, RLF(act, 36)); row_axpy8(acc, qb.r2, RLF(act, 40)); row_axpy8(acc, qb.r3, RLF(act, 44));
            row_axpy8(acc, qb.r4, RLF(act, 48)); row_axpy8(acc, qb.r5, RLF(act, 52)); row_axpy8(acc, qb.r6, RLF(act, 56)); row_axpy8(acc, qb.r7, RLF(act, 60));
        }
        const float* xi = a.Xin + (size_t)tok * DM + lane * 16;
        float* xo = a.Xout + (size_t)tok * DM + lane * 16;
        float4 x0 = *(const float4*)xi, x1 = *(const float4*)(xi + 4), x2 = *(const float4*)(xi + 8), x3 = *(const float4*)(xi + 12);
        x0.x += acc[0]; x0.y += acc[1]; x0.z += acc[2]; x0.w += acc[3]; x1.x += acc[4]; x1.y += acc[5]; x1.z += acc[6]; x1.w += acc[7];
        x2.x += acc[8]; x2.y += acc[9]; x2.z += acc[10]; x2.w += acc[11]; x3.x += acc[12]; x3.y += acc[13]; x3.z += acc[14]; x3.w += acc[15];
        if (a.final_norm) {
            float ss = x0.x * x0.x + x0.y * x0.y + x0.z * x0.z + x0.w * x0.w + x1.x * x1.x + x1.y * x1.y + x1.z * x1.z + x1.w * x1.w
                     + x2.x * x2.x + x2.y * x2.y + x2.z * x2.z + x2.w * x2.w + x3.x * x3.x + x3.y * x3.y + x3.z * x3.z + x3.w * x3.w;
            ss = wave_sum(ss, lane);
            const float rf = rsqrtf(ss * (1.f / 1024.f) + 1e-6f);
            const float* gf = a.gfinal + lane * 16;
            const float4 g0 = *(const float4*)gf, g1 = *(const float4*)(gf + 4), g2 = *(const float4*)(gf + 8), g3 = *(const float4*)(gf + 12);
            x0.x *= rf * g0.x; x0.y *= rf * g0.y; x0.z *= rf * g0.z; x0.w *= rf * g0.w; x1.x *= rf * g1.x; x1.y *= rf * g1.y; x1.z *= rf * g1.z; x1.w *= rf * g1.w;
            x2.x *= rf * g2.x; x2.y *= rf * g2.y; x2.z *= rf * g2.z; x2.w *= rf * g2.w; x3.x *= rf * g3.x; x3.y *= rf * g3.y; x3.z *= rf * g3.z; x3.w *= rf * g3.w;
        }
        *(float4*)xo = x0; *(float4*)(xo + 4) = x1; *(float4*)(xo + 8) = x2; *(float4*)(xo + 12) = x3;
    }
}
#define XB_TMO      128
#define XB_XCNT(j)  (256  + 64 * (j))
#define XB_XSUB(j)  (1280 + 64 * (j))
#define XB_XGEN(j)  (2304 + 64 * (j))
#define XB_TOP      3328
#define XB_TOPGEN   3392
#define XB_QUEUE(j) (3456 + 64 * (j))
#define XCD_BAR_WORDS (3456 + 64 * 64)
#define XB_SPIN_CAP (1u << 20)
#define LAS __attribute__((address_space(3)))

DI unsigned xb_ld(unsigned* p)              { return __hip_atomic_load(p, __ATOMIC_RELAXED, __HIP_MEMORY_SCOPE_AGENT); }
DI unsigned xb_add(unsigned* p, unsigned v) { return __hip_atomic_fetch_add(p, v, __ATOMIC_RELAXED, __HIP_MEMORY_SCOPE_AGENT); }
DI unsigned xb_xcc_id() { return (unsigned)__builtin_amdgcn_s_getreg((3 << 11) | 20) & 0xFu; }
#define XB_SPIN(cond, bar) do { unsigned _sp = 0; while (cond) { __builtin_amdgcn_s_sleep(1); \
    if ((++_sp & 255u) == 0u) { if (xb_ld(&(bar)[XB_TMO])) break; if (_sp > XB_SPIN_CAP) { atomicAdd(&(bar)[XB_TMO], 1u); break; } } } } while (0)

struct XcdBarrier { unsigned* bar; unsigned x; volatile LAS unsigned* st; };

DI XcdBarrier xcd_barrier_post(unsigned* bar, volatile LAS unsigned* st, int tid) {
    XcdBarrier b; b.bar = bar; b.x = xb_xcc_id(); b.st = st;
    if (tid == 0) st[2] = xb_add(&bar[XB_XCNT(b.x)], 1u);
    return b;
}
DI void xcd_barrier_complete(unsigned* bar, unsigned x, unsigned& nloc, unsigned& nx) {
    const unsigned G = gridDim.x * gridDim.y * gridDim.z;
    unsigned sum, cnt, mine, sp = 0u;
    for (;;) {
        sum = 0u; cnt = 0u; mine = 0u;
#pragma unroll
        for (unsigned j = 0; j < 16; ++j) { const unsigned c = xb_ld(&bar[XB_XCNT(j)]); sum += c; cnt += (c > 0u) ? 1u : 0u; mine = (j == x) ? c : mine; }
        if (sum == G) break;
        __builtin_amdgcn_s_sleep(1);
        if ((++sp & 255u) == 0u) { if (xb_ld(&bar[XB_TMO])) break; if (sp > XB_SPIN_CAP) { atomicAdd(&bar[XB_TMO], 1u); break; } }
    }
    nloc = mine > 0u ? mine : 1u; nx = cnt > 0u ? cnt : 1u;
}
DI void xcd_barrier(const XcdBarrier& b, int wid) {
    asm volatile("s_waitcnt vmcnt(0)" ::: "memory");
    __syncthreads();
    if (get_tid(wid) == 0) {
        unsigned* bar = b.bar;
        __builtin_amdgcn_s_waitcnt(0);
        unsigned nloc = b.st[0], nx = b.st[1];
        if (nloc == 0u) { xcd_barrier_complete(bar, b.x, nloc, nx); b.st[0] = nloc; b.st[1] = nx; }
        const unsigned old = xb_add(&bar[XB_XSUB(b.x)], 1u);
        const unsigned gen = old / nloc;
        if (old + 1u == (gen + 1u) * nloc) {
            __builtin_amdgcn_fence(__ATOMIC_RELEASE, "agent");
            asm volatile("s_waitcnt vmcnt(0)" ::: "memory");
            const unsigned og = xb_add(&bar[XB_TOP], 1u);
            const unsigned tg = og / nx;
            if (og + 1u == (tg + 1u) * nx) xb_add(&bar[XB_TOPGEN], 1u);
            else XB_SPIN(xb_ld(&bar[XB_TOPGEN]) == tg, bar);
            __builtin_amdgcn_fence(__ATOMIC_ACQUIRE, "agent");
            xb_add(&bar[XB_XGEN(b.x)], 1u);
            asm volatile("s_waitcnt vmcnt(0)" ::: "memory");
        } else {
            XB_SPIN(xb_ld(&bar[XB_XGEN(b.x)]) == gen, bar);
            __builtin_amdgcn_fence(__ATOMIC_ACQUIRE, "agent");
            asm volatile("s_waitcnt vmcnt(0)" ::: "memory");
        }
    }
    __syncthreads();
}
struct PSArgs {
    const bf16_t* Hb; const float* RSTD; const unsigned short* EX; const float* GT; const fp8_t* U8; const fp8_t* V8; const float* SU; const float* SV;
    float* PD; bf16_t* COEF; const float* Xin; float* Xout;
};

DI void dot4p(unsigned w, const f2_t& h01, const f2_t& h23, f2_t& s2) {
    const f2_t lo = __builtin_amdgcn_cvt_pk_f32_fp8(w, false), hi = __builtin_amdgcn_cvt_pk_f32_fp8(w, true);
    s2 = __builtin_elementwise_fma(lo, h01, s2); s2 = __builtin_elementwise_fma(hi, h23, s2);
}
DI float row_dot8p(const u32x4& r, const f2_t (&h)[8]) {
    f2_t s2 = {0.f, 0.f};
    dot4p(r.x, h[0], h[1], s2); dot4p(r.y, h[2], h[3], s2); dot4p(r.z, h[4], h[5], s2); dot4p(r.w, h[6], h[7], s2);
    return s2.x + s2.y;
}
DI void axpy4p(unsigned w, const f2_t& c2, f2_t& a01, f2_t& a23) {
    const f2_t lo = __builtin_amdgcn_cvt_pk_f32_fp8(w, false), hi = __builtin_amdgcn_cvt_pk_f32_fp8(w, true);
    a01 = __builtin_elementwise_fma(c2, lo, a01); a23 = __builtin_elementwise_fma(c2, hi, a23);
}
DI void row_axpy8p(f2_t (&acc)[8], const u32x4& r, float c) {
    const f2_t c2 = {c, c};
    axpy4p(r.x, c2, acc[0], acc[1]); axpy4p(r.y, c2, acc[2], acc[3]); axpy4p(r.z, c2, acc[4], acc[5]); axpy4p(r.w, c2, acc[6], acc[7]);
}

DI int run_token(int n, int k, int nloc, int wid) { return (k + (n >> 3) * nloc) * 64 + wid * 8 + (n & 7); }

struct Ids16 { u32x4 a, b; };
DI void ids_load(Ids16& q, const unsigned short* EX, int tok, int rg) { const u32x4* p = (const u32x4*)(EX + (size_t)tok * 128 + rg * 16); q.a = p[0]; q.b = p[1]; }
#define ID_LO(w) (((w) & 0xFFFFu) * 128u + loff)
#define ID_HI(w) (((w) >> 16) * 128u + loff)
DI void rows_lo(u32x4 (&r)[8], const Ids16& q, const fp8_t* tab, unsigned loff) {
    r[0] = *(grow_t)(tab + ID_LO(q.a.x)); r[1] = *(grow_t)(tab + ID_HI(q.a.x)); r[2] = *(grow_t)(tab + ID_LO(q.a.y)); r[3] = *(grow_t)(tab + ID_HI(q.a.y));
    r[4] = *(grow_t)(tab + ID_LO(q.a.z)); r[5] = *(grow_t)(tab + ID_HI(q.a.z)); r[6] = *(grow_t)(tab + ID_LO(q.a.w)); r[7] = *(grow_t)(tab + ID_HI(q.a.w));
}
DI void rows_hi(u32x4 (&r)[8], const Ids16& q, const fp8_t* tab, unsigned loff) {
    r[0] = *(grow_t)(tab + ID_LO(q.b.x)); r[1] = *(grow_t)(tab + ID_HI(q.b.x)); r[2] = *(grow_t)(tab + ID_LO(q.b.y)); r[3] = *(grow_t)(tab + ID_HI(q.b.y));
    r[4] = *(grow_t)(tab + ID_LO(q.b.z)); r[5] = *(grow_t)(tab + ID_HI(q.b.z)); r[6] = *(grow_t)(tab + ID_LO(q.b.w)); r[7] = *(grow_t)(tab + ID_HI(q.b.w));
}
DI void unpack_h(f2_t (&h)[8], const u32x4& h0, const u32x4& h1) {
    h[0] = (f2_t){bf_lo(h0.x), bf_hi(h0.x)}; h[1] = (f2_t){bf_lo(h0.y), bf_hi(h0.y)}; h[2] = (f2_t){bf_lo(h0.z), bf_hi(h0.z)}; h[3] = (f2_t){bf_lo(h0.w), bf_hi(h0.w)};
    h[4] = (f2_t){bf_lo(h1.x), bf_hi(h1.x)}; h[5] = (f2_t){bf_lo(h1.y), bf_hi(h1.y)}; h[6] = (f2_t){bf_lo(h1.z), bf_hi(h1.z)}; h[7] = (f2_t){bf_lo(h1.w), bf_hi(h1.w)};
}
DI void dots8(float* p, const u32x4 (&r)[8], const f2_t (&h)[8]) {
#pragma unroll
    for (int i = 0; i < 8; ++i) { p[i] = row_dot8p(r[i], h); if ((i & 1) == 1) __builtin_amdgcn_sched_barrier(0); }
}
DI void peerU_finish(const PSArgs& a, float (&p)[16], int tok, int s, int lane) {
    const int rg = lane >> 3, pc = lane & 7;
    const bool b2 = pc & 4, b1 = pc & 2, b0 = pc & 1;
    float q8[8], q4[4], q2[2];
#pragma unroll
    for (int k = 0; k < 8; ++k) { const float keep = b2 ? p[k + 8] : p[k], send = b2 ? p[k] : p[k + 8]; q8[k] = keep + shx<4>(send, lane); }
#pragma unroll
    for (int k = 0; k < 4; ++k) { const float keep = b1 ? q8[k + 4] : q8[k], send = b1 ? q8[k] : q8[k + 4]; q4[k] = keep + shx<2>(send, lane); }
#pragma unroll
    for (int k = 0; k < 2; ++k) { const float keep = b0 ? q4[k + 2] : q4[k], send = b0 ? q4[k] : q4[k + 2]; q2[k] = keep + shx<1>(send, lane); }
    *(float2*)(a.PD + ((size_t)s * NTOK + tok) * 128 + rg * 16 + 2 * pc) = make_float2(q2[0], q2[1]);
}

DI void peerU_run(const PSArgs& a, int s, int k, int nloc, int wid) {
    const int tid = get_tid(wid);
    const int lane = tid & 63, rg = lane >> 3, pc = lane & 7;
    const unsigned loff = (unsigned)(s * (NEXP * 128) + pc * 16);
    const int hoff = s * 128 + pc * 16;
    const int N = 8 * ((NTOK / 64 - k + nloc - 1) / nloc);
    Ids16 idE, idO;
    u32x4 rA[8], rB[8], hE0, hE1, hO0, hO1;
#define LOAD_H(d0, d1, tokv) { const u32x4* hp_ = (const u32x4*)(a.Hb + (size_t)(tokv) * DM + hoff); d0 = hp_[0]; d1 = hp_[1]; }
    ids_load(idE, a.EX, run_token(0, k, nloc, wid), rg);
    ids_load(idO, a.EX, run_token(1, k, nloc, wid), rg);
    rows_lo(rA, idE, a.U8, loff); LOAD_H(hE0, hE1, run_token(0, k, nloc, wid)); rows_hi(rB, idE, a.U8, loff);
#pragma unroll 1
    for (int n = 0; n < N; n += 2) {
        const int t0 = run_token(n, k, nloc, wid), t1 = run_token(n + 1, k, nloc, wid);
        const int t2 = run_token((n + 2 < N) ? n + 2 : N - 1, k, nloc, wid), t3 = run_token((n + 3 < N) ? n + 3 : N - 1, k, nloc, wid);
        {
            f2_t h[8]; float p[16];
            unpack_h(h, hE0, hE1);
            dots8(p, rA, h);
            rows_lo(rA, idO, a.U8, loff); LOAD_H(hO0, hO1, t1);
            dots8(p + 8, rB, h);
            rows_hi(rB, idO, a.U8, loff);
            ids_load(idE, a.EX, t2, rg);
            peerU_finish(a, p, t0, s, lane);
        }
        {
            f2_t h[8]; float p[16];
            unpack_h(h, hO0, hO1);
            dots8(p, rA, h);
            rows_lo(rA, idE, a.U8, loff); LOAD_H(hE0, hE1, t2);
            dots8(p + 8, rB, h);
            rows_hi(rB, idE, a.U8, loff);
            ids_load(idO, a.EX, t3, rg);
            peerU_finish(a, p, t1, s, lane);
        }
    }
#undef LOAD_H
}

DI void peerR_tile(const PSArgs& a, int tile, int wid) {
    const int tid = get_tid(wid);
    const int lane = tid & 63;
#pragma unroll 1
    for (int ti = 0; ti < 8; ++ti) {
        const int tok = tile * 64 + wid * 8 + ti;
        float d0 = 0.f, d1 = 0.f;
#pragma unroll
        for (int x = 0; x < 8; ++x) { const float2 v = *(const float2*)(a.PD + ((size_t)x * NTOK + tok) * 128 + 2 * lane); d0 += v.x; d1 += v.y; }
        const unsigned exw = *(const unsigned*)(a.EX + (size_t)tok * 128 + 2 * lane);
        const int2 ex = make_int2((int)(exw & 0xFFFFu), (int)(exw >> 16));
        const float2 gt = *(const float2*)(a.GT + (size_t)tok * 128 + 2 * lane);
        const float rs = a.RSTD[tok];
        float2 o;
        o.x = gelu_exact(d0 * a.SU[ex.x] * rs) * gt.x * a.SV[ex.x];
        o.y = gelu_exact(d1 * a.SU[ex.y] * rs) * gt.y * a.SV[ex.y];
        *(unsigned*)(a.COEF + (size_t)tok * 128 + 2 * lane) = pack_bf2(o.x, o.y);
    }
}

struct Cf16 { u32x4 a, b; };
DI void cf_load(Cf16& q, const bf16_t* COEF, int tok, int rg) { const u32x4* p = (const u32x4*)(COEF + (size_t)tok * 128 + rg * 16); q.a = p[0]; q.b = p[1]; }
DI void axpy8(f2_t (&acc)[8], const u32x4 (&r)[8], const u32x4& c) {
    row_axpy8p(acc, r[0], bf_lo(c.x)); row_axpy8p(acc, r[1], bf_hi(c.x)); __builtin_amdgcn_sched_barrier(0);
    row_axpy8p(acc, r[2], bf_lo(c.y)); row_axpy8p(acc, r[3], bf_hi(c.y)); __builtin_amdgcn_sched_barrier(0);
    row_axpy8p(acc, r[4], bf_lo(c.z)); row_axpy8p(acc, r[5], bf_hi(c.z)); __builtin_amdgcn_sched_barrier(0);
    row_axpy8p(acc, r[6], bf_lo(c.w)); row_axpy8p(acc, r[7], bf_hi(c.w)); __builtin_amdgcn_sched_barrier(0);
}
DI void peerV_finish(const PSArgs& a, f2_t (&acc)[8], float2 xv, int tok, int s, int lane) {
    const int rg = lane >> 3, pc = lane & 7;
    const bool r2 = rg & 4, r1 = rg & 2, r0 = rg & 1;
    f2_t q4[4], q2[2], q1;
#pragma unroll
    for (int k = 0; k < 4; ++k) {
        const f2_t keep = r2 ? acc[k + 4] : acc[k], send = r2 ? acc[k] : acc[k + 4];
        q4[k] = (f2_t){keep.x + shx<32>(send.x, lane), keep.y + shx<32>(send.y, lane)};
    }
#pragma unroll
    for (int k = 0; k < 2; ++k) {
        const f2_t keep = r1 ? q4[k + 2] : q4[k], send = r1 ? q4[k] : q4[k + 2];
        q2[k] = (f2_t){keep.x + shx<16>(send.x, lane), keep.y + shx<16>(send.y, lane)};
    }
    {
        const f2_t keep = r0 ? q2[1] : q2[0], send = r0 ? q2[0] : q2[1];
        q1 = (f2_t){keep.x + shx<8>(send.x, lane), keep.y + shx<8>(send.y, lane)};
    }
    xv.x += q1.x; xv.y += q1.y;
    *(float2*)(a.Xout + (size_t)tok * DM + s * 128 + 16 * pc + 2 * rg) = xv;
}

DI void peerV_run(const PSArgs& a, int s, int k, int nloc, int wid) {
    const int tid = get_tid(wid);
    const int lane = tid & 63, rg = lane >> 3, pc = lane & 7;
    const unsigned loff = (unsigned)(s * (NEXP * 128) + pc * 16);
    const int N = 8 * ((NTOK / 64 - k + nloc - 1) / nloc);
    Ids16 idE, idO; Cf16 cfE, cfO; float2 xE, xO;
    u32x4 rA[8], rB[8];
#define LOAD_X(x_, tokv) { x_ = *(const float2*)(a.Xin + (size_t)(tokv) * DM + s * 128 + 16 * pc + 2 * rg); }
    ids_load(idE, a.EX, run_token(0, k, nloc, wid), rg);
    ids_load(idO, a.EX, run_token(1, k, nloc, wid), rg);
    rows_lo(rA, idE, a.V8, loff); cf_load(cfE, a.COEF, run_token(0, k, nloc, wid), rg); rows_hi(rB, idE, a.V8, loff); LOAD_X(xE, run_token(0, k, nloc, wid));
#pragma unroll 1
    for (int n = 0; n < N; n += 2) {
        const int t0 = run_token(n, k, nloc, wid), t1 = run_token(n + 1, k, nloc, wid);
        const int t2 = run_token((n + 2 < N) ? n + 2 : N - 1, k, nloc, wid), t3 = run_token((n + 3 < N) ? n + 3 : N - 1, k, nloc, wid);
        {
            f2_t acc[8];
#pragma unroll
            for (int i = 0; i < 8; ++i) acc[i] = (f2_t){0.f, 0.f};
            axpy8(acc, rA, cfE.a);
            rows_lo(rA, idO, a.V8, loff); cf_load(cfO, a.COEF, t1, rg);
            axpy8(acc, rB, cfE.b);
            rows_hi(rB, idO, a.V8, loff); LOAD_X(xO, t1);
            ids_load(idE, a.EX, t2, rg);
            peerV_finish(a, acc, xE, t0, s, lane);
        }
        {
            f2_t acc[8];
#pragma unroll
            for (int i = 0; i < 8; ++i) acc[i] = (f2_t){0.f, 0.f};
            axpy8(acc, rA, cfO.a);
            rows_lo(rA, idE, a.V8, loff); cf_load(cfE, a.COEF, t2, rg);
            axpy8(acc, rB, cfO.b);
            rows_hi(rB, idE, a.V8, loff); LOAD_X(xE, t2);
            ids_load(idO, a.EX, t3, rg);
            peerV_finish(a, acc, xO, t1, s, lane);
        }
    }
#undef LOAD_X
}

DI void final_norm_tile(float* X, const float* __restrict__ g, int tile, int wid) {
    const int tid = get_tid(wid);
    const int lane = tid & 63;
    const float* gf = g + lane * 16;
    const float4 g0 = *(const float4*)gf, g1 = *(const float4*)(gf + 4), g2 = *(const float4*)(gf + 8), g3 = *(const float4*)(gf + 12);
#pragma unroll 1
    for (int ti = 0; ti < 8; ++ti) {
        float* xp = X + (size_t)(tile * 64 + wid * 8 + ti) * DM + lane * 16;
        float4 x0 = *(const float4*)xp, x1 = *(const float4*)(xp + 4), x2 = *(const float4*)(xp + 8), x3 = *(const float4*)(xp + 12);
        float ss = x0.x * x0.x + x0.y * x0.y + x0.z * x0.z + x0.w * x0.w + x1.x * x1.x + x1.y * x1.y + x1.z * x1.z + x1.w * x1.w
                 + x2.x * x2.x + x2.y * x2.y + x2.z * x2.z + x2.w * x2.w + x3.x * x3.x + x3.y * x3.y + x3.z * x3.z + x3.w * x3.w;
        ss = wave_sum(ss, lane);
        const float rf = rsqrtf(ss * (1.f / 1024.f) + 1e-6f);
        x0.x *= rf * g0.x; x0.y *= rf * g0.y; x0.z *= rf * g0.z; x0.w *= rf * g0.w; x1.x *= rf * g1.x; x1.y *= rf * g1.y; x1.z *= rf * g1.z; x1.w *= rf * g1.w;
        x2.x *= rf * g2.x; x2.y *= rf * g2.y; x2.z *= rf * g2.z; x2.w *= rf * g2.w; x3.x *= rf * g3.x; x3.y *= rf * g3.y; x3.z *= rf * g3.z; x3.w *= rf * g3.w;
        *(float4*)xp = x0; *(float4*)(xp + 4) = x1; *(float4*)(xp + 8) = x2; *(float4*)(xp + 12) = x3;
    }
}

typedef unsigned char fp4x2_t;
DI void conv_row_fp4_one(float4 v0, float4 v1, float4 v2, float4 v3, fp4x2_t* __restrict__ dst, float* __restrict__ scales, int nrows, int row, int lane) {
    float m = fmaxf(fmaxf(fmaxf(fabsf(v0.x), fabsf(v0.y)), fmaxf(fabsf(v0.z), fabsf(v0.w))), fmaxf(fmaxf(fabsf(v1.x), fabsf(v1.y)), fmaxf(fabsf(v1.z), fabsf(v1.w))));
    m = fmaxf(m, fmaxf(fmaxf(fmaxf(fabsf(v2.x), fabsf(v2.y)), fmaxf(fabsf(v2.z), fabsf(v2.w))), fmaxf(fmaxf(fabsf(v3.x), fabsf(v3.y)), fmaxf(fabsf(v3.z), fabsf(v3.w)))));
    m = fmaxf(m, shx<1>(m, lane)); m = fmaxf(m, shx<2>(m, lane)); m = fmaxf(m, shx<4>(m, lane)); m = fmaxf(m, shx<8>(m, lane)); m = fmaxf(m, shx<16>(m, lane)); m = fmaxf(m, shx<32>(m, lane));
    const float sc = (m > 0.f) ? m * (1.f / 6.f) : 1.f;
    const float inv = 1.f / sc;
    unsigned d0 = 0u, d1 = 0u;
    d0 = __builtin_amdgcn_cvt_scalef32_pk_fp4_f32(d0, v0.x * inv, v0.y * inv, 1.0f, 0); d0 = __builtin_amdgcn_cvt_scalef32_pk_fp4_f32(d0, v0.z * inv, v0.w * inv, 1.0f, 1);
    d0 = __builtin_amdgcn_cvt_scalef32_pk_fp4_f32(d0, v1.x * inv, v1.y * inv, 1.0f, 2); d0 = __builtin_amdgcn_cvt_scalef32_pk_fp4_f32(d0, v1.z * inv, v1.w * inv, 1.0f, 3);
    d1 = __builtin_amdgcn_cvt_scalef32_pk_fp4_f32(d1, v2.x * inv, v2.y * inv, 1.0f, 0); d1 = __builtin_amdgcn_cvt_scalef32_pk_fp4_f32(d1, v2.z * inv, v2.w * inv, 1.0f, 1);
    d1 = __builtin_amdgcn_cvt_scalef32_pk_fp4_f32(d1, v3.x * inv, v3.y * inv, 1.0f, 2); d1 = __builtin_amdgcn_cvt_scalef32_pk_fp4_f32(d1, v3.z * inv, v3.w * inv, 1.0f, 3);
    *(uint2*)(dst + ((size_t)(lane >> 4) * nrows + row) * 128 + (lane & 15) * 8) = make_uint2(d0, d1);
    if (lane == 0) scales[row] = sc;
}
DI void conv_rows_fp4(const float* __restrict__ src, fp4x2_t* __restrict__ dst, float* __restrict__ scales, int nrows, int gwave, int nwaves, int lane) {
#pragma unroll 1
    for (int row = gwave; row < nrows; row += 2 * nwaves) {
        const int r1 = min(row + nwaves, nrows - 1);
        const float4* p0 = (const float4*)(src + (size_t)row * DM + lane * 16);
        const float4* p1 = (const float4*)(src + (size_t)r1 * DM + lane * 16);
        const float4 a0 = p0[0], a1 = p0[1], a2 = p0[2], a3 = p0[3];
        const float4 b0 = p1[0], b1 = p1[1], b2 = p1[2], b3 = p1[3];
        conv_row_fp4_one(a0, a1, a2, a3, dst, scales, nrows, row, lane);
        conv_row_fp4_one(b0, b1, b2, b3, dst, scales, nrows, r1, lane);
    }
}

DI void axpy8w4(f2_t (&acc)[16], unsigned w, int base, const f2_t& c2) {
    acc[base + 0] = __builtin_elementwise_fma(c2, __builtin_amdgcn_cvt_scalef32_pk_f32_fp4(w, 1.0f, 0), acc[base + 0]);
    acc[base + 1] = __builtin_elementwise_fma(c2, __builtin_amdgcn_cvt_scalef32_pk_f32_fp4(w, 1.0f, 1), acc[base + 1]);
    acc[base + 2] = __builtin_elementwise_fma(c2, __builtin_amdgcn_cvt_scalef32_pk_f32_fp4(w, 1.0f, 2), acc[base + 2]);
    acc[base + 3] = __builtin_elementwise_fma(c2, __builtin_amdgcn_cvt_scalef32_pk_f32_fp4(w, 1.0f, 3), acc[base + 3]);
}
DI void row_axpy32(f2_t (&acc)[16], const u32x4& r, float c) {
    const f2_t c2 = {c, c};
    axpy8w4(acc, r.x, 0, c2); axpy8w4(acc, r.y, 4, c2); axpy8w4(acc, r.z, 8, c2); axpy8w4(acc, r.w, 12, c2);
}
DI void axpy8_4(f2_t (&acc)[16], const u32x4 (&r)[8], const u32x4& c) {
    row_axpy32(acc, r[0], bf_lo(c.x)); __builtin_amdgcn_sched_barrier(0); row_axpy32(acc, r[1], bf_hi(c.x)); __builtin_amdgcn_sched_barrier(0);
    row_axpy32(acc, r[2], bf_lo(c.y)); __builtin_amdgcn_sched_barrier(0); row_axpy32(acc, r[3], bf_hi(c.y)); __builtin_amdgcn_sched_barrier(0);
    row_axpy32(acc, r[4], bf_lo(c.z)); __builtin_amdgcn_sched_barrier(0); row_axpy32(acc, r[5], bf_hi(c.z)); __builtin_amdgcn_sched_barrier(0);
    row_axpy32(acc, r[6], bf_lo(c.w)); __builtin_amdgcn_sched_barrier(0); row_axpy32(acc, r[7], bf_hi(c.w)); __builtin_amdgcn_sched_barrier(0);
}
DI void peerV4_finish(const PSArgs& a, f2_t (&acc)[16], float4 xv, int tok, int s4, int lane) {
    const int rg = lane >> 3, pc = lane & 7;
    const bool r2 = rg & 4, r1 = rg & 2, r0 = rg & 1;
    f2_t q8[8], q4[4], q2[2];
#pragma unroll
    for (int k = 0; k < 8; ++k) {
        const f2_t keep = r2 ? acc[k + 8] : acc[k], send = r2 ? acc[k] : acc[k + 8];
        q8[k] = (f2_t){keep.x + shx<32>(send.x, lane), keep.y + shx<32>(send.y, lane)};
    }
#pragma unroll
    for (int k = 0; k < 4; ++k) {
        const f2_t keep = r1 ? q8[k + 4] : q8[k], send = r1 ? q8[k] : q8[k + 4];
        q4[k] = (f2_t){keep.x + shx<16>(send.x, lane), keep.y + shx<16>(send.y, lane)};
    }
#pragma unroll
    for (int k = 0; k < 2; ++k) {
        const f2_t keep = r0 ? q4[k + 2] : q4[k], send = r0 ? q4[k] : q4[k + 2];
        q2[k] = (f2_t){keep.x + shx<8>(send.x, lane), keep.y + shx<8>(send.y, lane)};
    }
    xv.x += q2[0].x; xv.y += q2[0].y; xv.z += q2[1].x; xv.w += q2[1].y;
    *(float4*)(a.Xout + (size_t)tok * DM + s4 * 256 + 32 * pc + 4 * rg) = xv;
}
DI int run_token2(int n, int k, int nloc, int wid, int th) { return (2 * (k + (n >> 3) * nloc) + th) * 64 + wid * 8 + (n & 7); }

DI void peerV4_run(const PSArgs& a, const fp4x2_t* V4, int s4, int th, int k, int nloc, int wid) {
    const int tid = get_tid(wid);
    const int lane = tid & 63, rg = lane >> 3, pc = lane & 7;
    const unsigned loff = (unsigned)(s4 * (NEXP * 128) + pc * 16);
    const int N = 8 * ((NTOK / 128 - k + nloc - 1) / nloc);
    if (N <= 0) return;
    Ids16 idE, idO; Cf16 cfE, cfO; float4 xE, xO;
    u32x4 rA[8], rB[8];
    const fp8_t* tab = (const fp8_t*)V4;
#define LOAD_X4(x_, tokv) { x_ = *(const float4*)(a.Xin + (size_t)(tokv) * DM + s4 * 256 + 32 * pc + 4 * rg); }
    ids_load(idE, a.EX, run_token2(0, k, nloc, wid, th), rg);
    ids_load(idO, a.EX, run_token2(1, k, nloc, wid, th), rg);
    rows_lo(rA, idE, tab, loff); cf_load(cfE, a.COEF, run_token2(0, k, nloc, wid, th), rg); rows_hi(rB, idE, tab, loff); LOAD_X4(xE, run_token2(0, k, nloc, wid, th));
#pragma unroll 1
    for (int n = 0; n < N; n += 2) {
        const int t0 = run_token2(n, k, nloc, wid, th), t1 = run_token2(n + 1, k, nloc, wid, th);
        const int t2 = run_token2((n + 2 < N) ? n + 2 : N - 1, k, nloc, wid, th), t3 = run_token2((n + 3 < N) ? n + 3 : N - 1, k, nloc, wid, th);
        {
            f2_t acc[16];
#pragma unroll
            for (int i = 0; i < 16; ++i) acc[i] = (f2_t){0.f, 0.f};
            axpy8_4(acc, rA, cfE.a);
            rows_lo(rA, idO, tab, loff); cf_load(cfO, a.COEF, t1, rg);
            axpy8_4(acc, rB, cfE.b);
            rows_hi(rB, idO, tab, loff); LOAD_X4(xO, t1);
            ids_load(idE, a.EX, t2, rg);
            peerV4_finish(a, acc, xE, t0, s4, lane);
        }
        {
            f2_t acc[16];
#pragma unroll
            for (int i = 0; i < 16; ++i) acc[i] = (f2_t){0.f, 0.f};
            axpy8_4(acc, rA, cfO.a);
            rows_lo(rA, idE, tab, loff); cf_load(cfE, a.COEF, t2, rg);
            axpy8_4(acc, rB, cfO.b);
            rows_hi(rB, idE, tab, loff); LOAD_X4(xE, t2);
            ids_load(idO, a.EX, t3, rg);
            peerV4_finish(a, acc, xO, t1, s4, lane);
        }
    }
#undef LOAD_X4
}
struct MegaArgs {
    const float* x; const float* a_re; const float* a_im; const float* log_dt; const float* b_re; const float* b_im; const float* c_re;
    const float* c_im; const float* d_skip; const float* b_glu; const float* pool_scale; const float* u_exp; const float* v_exp;
    const float* norm_final;
    PrepW pw;
    float* X; bf16_t* U; bf16_t* YPRE; bf16_t* G1; bf16_t* A2; bf16_t* Hb; bf16_t* Qb; unsigned short* EX; float* GT; float* RSTD;
    char* KT; bf16x8* WST; bf16x8* CCAR; float* ABT; fp8_t* U8; fp4x2_t* V4; float* SU; float* SV; float* PD; bf16_t* COEF;
    unsigned* bar;
    int coop_probe; int pad_;
};

#ifndef REP_P0
#define REP_P0 1
#endif
#ifndef REP_PA
#define REP_PA 1
#endif
#ifndef REP_PB
#define REP_PB 1
#endif
#ifndef REP_C1
#define REP_C1 1
#endif
#ifndef REP_C2
#define REP_C2 1
#endif
#ifndef REP_U
#define REP_U 1
#endif
#ifndef REP_R
#define REP_R 1
#endif
#ifndef REP_V
#define REP_V 1
#endif
#ifndef REP_BAR
#define REP_BAR 1
#endif
#define XBAR() do { for (int rb_ = 0; rb_ < REP_BAR; ++rb_) xcd_barrier(xb, wid); } while (0)
__global__ void __launch_bounds__(NTHR) mega_kernel(MegaArgs a) {
    __shared__ __attribute__((aligned(16))) char smem[PB_BYTES];
    __shared__ uint4 xb_words;
    cg::grid_group grid = cg::this_grid();
    const int nblk = gridDim.x;
    const int wid = __builtin_amdgcn_readfirstlane(threadIdx.x >> 6);
    if (get_tid(wid) == 0) xb_words = make_uint4(0u, 0u, 0u, 0u);
    __syncthreads();
    const XcdBarrier xb = xcd_barrier_post(a.bar, (volatile LAS unsigned*)&xb_words, get_tid(wid));
    for (int rep = 0; rep < REP_P0; ++rep) {
        const size_t gtid = (size_t)blockIdx.x * NTHR + get_tid(wid), gs = (size_t)nblk * NTHR;
        for (int it = blockIdx.x; it < 256; it += nblk)
            prep_s5_item(it >> 2, it & 3, a.a_re, a.a_im, a.log_dt, a.b_re, a.b_im, a.c_re, a.c_im, a.d_skip, a.KT, a.WST, a.CCAR, a.ABT, smem, wid);
        prep_weights(a.pw, gtid, gs);
        for (int l = 0; l < 2; ++l) {
            conv_kfrag(a.pw.k1 + (size_t)l * 128 * 128, a.pw.wfk1 + (size_t)l * (128 * 128 / 8), gtid, gs);
            conv_kfrag(a.pw.k2 + (size_t)l * 128 * 128, a.pw.wfk2 + (size_t)l * (128 * 128 / 8), gtid, gs);
        }
        {
            int tid = get_tid(wid);
            const int gwave = blockIdx.x * 8 + (tid >> 6), nwaves = nblk * 8, lane = tid & 63;
#pragma unroll 1
            for (int l = 0; l < 2; ++l) {
                conv_rows_fp8(a.u_exp + (size_t)l * NEXP * DM, a.pw.norm_ffn + l * DM, a.U8 + (size_t)l * NEXP * DM, a.SU + l * NEXP, NEXP, gwave, nwaves, lane);
                conv_rows_fp4(a.v_exp + (size_t)l * NEXP * DM, a.V4 + (size_t)l * NEXP * (DM / 2), a.SV + l * NEXP, NEXP, gwave, nwaves, lane);
            }
        }
    }
    XBAR();
    if (a.coop_probe) grid.sync();
    __shared__ int sched[4];
    if (get_tid(wid) == 0) {
        int nx = 0, myj = 0, nloc = 1;
        for (unsigned j = 0; j < 16; ++j) {
            const unsigned cj = xb_ld(&a.bar[XB_XCNT(j)]);
            if (j == xb.x) { myj = nx; nloc = (int)cj; }
            nx += (cj > 0u) ? 1 : 0;
        }
        sched[0] = (int)xb.st[2]; sched[1] = nloc > 0 ? nloc : 1; sched[2] = myj; sched[3] = nx > 0 ? nx : 1;
    }
    __syncthreads();
    const int s_rank = sched[0], s_nloc = sched[1], s_myj = sched[2], s_nx = sched[3];
#pragma unroll 1
    for (int l = 0; l < 2; ++l) {
        const float* xin = (l == 0) ? a.x : a.X;
        if (l == 0) {
            for (int rep = 0; rep < REP_PA; ++rep)
            for (int tile = blockIdx.x; tile < NTOK / 64; tile += nblk) phaseA_tile(xin, a.pw.wfin, a.U, tile, smem, wid);
        }
        XBAR();
        bf16_t* Ul = a.U + (size_t)l * NTOK * DM;
        for (int rep = 0; rep < REP_PB; ++rep)
        for (int tile = blockIdx.x; tile < 256; tile += nblk)
            phaseB_tile(Ul, a.KT + (size_t)l * 32 * KT_BYTES, a.WST + (size_t)l * 32 * WST_FRAGS, a.CCAR + (size_t)l * 32 * CCAR_FRAGS, a.ABT + l * 32 * 128, a.YPRE, tile, smem, wid);
        XBAR();
        PCArgs pa; pa.U = Ul; pa.YPRE = a.YPRE; pa.G1 = a.G1; pa.A2 = a.A2; pa.Xin = xin; pa.Xout = a.X; pa.Xdummy = (float*)a.Qb; pa.Hb = a.Hb; pa.RSTD = a.RSTD;
        pa.wfglu = a.pw.wfglu + (size_t)l * (512 * 512 / 8); pa.b_glu = a.b_glu + l * 512; pa.wfpool = a.pw.wfpool + (size_t)l * 4 * (128 * 128 / 8);
        pa.pool_scale = a.pool_scale + l * 512; pa.wfout = a.pw.wfout + (size_t)l * (DM * DM / 8);
        PRArgs pr; pr.Hb = a.Hb; pr.RSTD = a.RSTD; pr.wfq = a.pw.wfq + (size_t)l * (DM * 2048 / 8); pr.kf1 = a.pw.wfk1 + (size_t)l * (128 * 128 / 8);
        pr.kf2 = a.pw.wfk2 + (size_t)l * (128 * 128 / 8); pr.EX = a.EX; pr.GT = a.GT;
        for (int tile = blockIdx.x; tile < NTOK / 64; tile += nblk) {
            for (int rep = 1; rep < REP_C1; ++rep) { PCArgs pa2 = pa; pa2.Xout = (float*)a.Qb; phaseC1_tile(pa2, tile, smem, wid); }
            phaseC1_tile(pa, tile, smem, wid);
            for (int rep = 0; rep < REP_C2; ++rep) phaseC2_tile(pr, tile, smem, wid);
        }
        XBAR();
        PSArgs ps; ps.Hb = a.Hb; ps.RSTD = a.RSTD; ps.EX = a.EX; ps.GT = a.GT; ps.U8 = a.U8 + (size_t)l * NEXP * DM; ps.V8 = nullptr;
        ps.SU = a.SU + l * NEXP; ps.SV = a.SV + l * NEXP; ps.PD = a.PD; ps.COEF = a.COEF; ps.Xin = a.X; ps.Xout = a.X;
        for (int rep = 0; rep < REP_U; ++rep)
        for (int s = s_myj; s < 8; s += s_nx) peerU_run(ps, s, s_rank, s_nloc, wid);
        XBAR();
        for (int rep = 0; rep < REP_R; ++rep)
        for (int tile = blockIdx.x; tile < NTOK / 64; tile += nblk) peerR_tile(ps, tile, wid);
        XBAR();
        for (int rep = 1; rep < REP_V; ++rep) { PSArgs ps2 = ps; ps2.Xout = (float*)a.Qb; for (int v = s_myj; v < 8; v += s_nx) peerV4_run(ps2, a.V4 + (size_t)l * NEXP * (DM / 2), v & 3, v >> 2, s_rank, s_nloc, wid); }
        for (int v = s_myj; v < 8; v += s_nx) peerV4_run(ps, a.V4 + (size_t)l * NEXP * (DM / 2), v & 3, v >> 2, s_rank, s_nloc, wid);
        XBAR();
        if (l == 0) {
            for (int rep = 0; rep < REP_PA; ++rep)
            for (int tile = blockIdx.x; tile < NTOK / 64; tile += nblk) phaseA_tile(a.X, a.pw.wfin + (size_t)(DM * DM / 8), a.U + (size_t)NTOK * DM, tile, smem, wid);
        } else {
            for (int tile = blockIdx.x; tile < NTOK / 64; tile += nblk) final_norm_tile(a.X, a.norm_final, tile, wid);
        }
    }
}

extern "C" void kernel_launch(void* const* d_in, const int* in_sizes, int n_in, void* d_out, int out_size, void* d_ws, size_t ws_size,
                              hipStream_t stream) {
    char* wsb = (char*)d_ws;
    size_t off = 0;
    auto take = [&](size_t bytes) { char* p = wsb + off; off += (bytes + 255) & ~(size_t)255; return p; };
    MegaArgs a;
    memset(&a, 0, sizeof(a));
    a.x = (const float*)d_in[0];
    a.pw.norm_mix = (const float*)d_in[1]; a.pw.w_in = (const float*)d_in[2];
    a.a_re = (const float*)d_in[3]; a.a_im = (const float*)d_in[4]; a.log_dt = (const float*)d_in[5];
    a.b_re = (const float*)d_in[6]; a.b_im = (const float*)d_in[7]; a.c_re = (const float*)d_in[8]; a.c_im = (const float*)d_in[9];
    a.d_skip = (const float*)d_in[10]; a.pw.w_glu = (const float*)d_in[11]; a.b_glu = (const float*)d_in[12];
    a.pw.w_pool = (const float*)d_in[13]; a.pool_scale = (const float*)d_in[14]; a.pw.g_out_ssm = (const float*)d_in[15];
    a.pw.g_out_pool = (const float*)d_in[16]; a.pw.w_out = (const float*)d_in[17]; a.pw.norm_ffn = (const float*)d_in[18];
    a.pw.w_q = (const float*)d_in[19]; a.pw.k1 = (const float*)d_in[20]; a.pw.k2 = (const float*)d_in[21];
    a.u_exp = (const float*)d_in[22]; a.v_exp = (const float*)d_in[23]; a.norm_final = (const float*)d_in[24];
    a.X = (float*)d_out;
    a.U = (bf16_t*)take((size_t)2 * NTOK * DM * 2);
    a.YPRE = (bf16_t*)take((size_t)NTOK * 512 * 2);
    a.G1 = (bf16_t*)take((size_t)NTOK * 512 * 2);
    a.A2 = (bf16_t*)take((size_t)NTOK * DM * 2);
    a.Hb = (bf16_t*)take((size_t)NTOK * DM * 2);
    a.Qb = (bf16_t*)take((size_t)NTOK * 2048 * 2);
    a.EX = (unsigned short*)take((size_t)NTOK * 128 * 2);
    a.GT = (float*)take((size_t)NTOK * 128 * 4);
    a.RSTD = (float*)take(NTOK * 4);
    a.pw.wfin = (bf16x8*)take((size_t)2 * DM * DM * 2);
    a.pw.wfglu = (bf16x8*)take((size_t)2 * 512 * 512 * 2);
    a.pw.wfpool = (bf16x8*)take((size_t)2 * 4 * 128 * 128 * 2);
    a.pw.wfout = (bf16x8*)take((size_t)2 * DM * DM * 2);
    a.pw.wfq = (bf16x8*)take((size_t)2 * DM * 2048 * 2);
    a.pw.wfk1 = (bf16x8*)take((size_t)2 * 128 * 128 * 2);
    a.pw.wfk2 = (bf16x8*)take((size_t)2 * 128 * 128 * 2);
    a.KT = take((size_t)64 * KT_BYTES);
    a.WST = (bf16x8*)take((size_t)64 * WST_FRAGS * 16);
    a.CCAR = (bf16x8*)take((size_t)64 * CCAR_FRAGS * 16);
    a.ABT = (float*)take(64 * 128 * 4);
    a.U8 = (fp8_t*)take((size_t)2 * NEXP * DM);
    a.V4 = (fp4x2_t*)take((size_t)2 * NEXP * (DM / 2));
    a.SU = (float*)take((size_t)2 * NEXP * 4);
    a.SV = (float*)take((size_t)2 * NEXP * 4);
    a.PD = (float*)take((size_t)8 * NTOK * 128 * 4);
    a.COEF = (bf16_t*)take((size_t)NTOK * 128 * 2);
    a.bar = (unsigned*)take((size_t)XCD_BAR_WORDS * 4);
    hipMemsetAsync(a.bar, 0, (size_t)XCD_BAR_WORDS * 4, stream);

    static int grid_blocks = 0;
    if (!grid_blocks) {
        int dev = 0, cus = 0, per_cu = 0;
        hipGetDevice(&dev);
        hipDeviceGetAttribute(&cus, hipDeviceAttributeMultiprocessorCount, dev);
        hipOccupancyMaxActiveBlocksPerMultiprocessor(&per_cu, mega_kernel, NTHR, 0);
        if (per_cu > 1) per_cu = 1;
        grid_blocks = cus * per_cu;
        if (grid_blocks > 256) grid_blocks = 256;
    }
    void* args[] = {&a};
    hipError_t e = hipLaunchCooperativeKernel((void*)mega_kernel, dim3(grid_blocks), dim3(NTHR), args, 0, stream);
    if (e != hipSuccess) fprintf(stderr, "cooperative launch failed: %s (grid %d)\n", hipGetErrorString(e), grid_blocks);
}
```

```cpp
#include <hip/hip_runtime.h>
#include <hip/hip_cooperative_groups.h>
#include <cstdio>
#include <cstring>
namespace cg = cooperative_groups;
#include <math.h>
#include <stdint.h>

#define NTOK 16384
#define SEQ 2048
#define DM 1024
#define SSMW 512
#define NEXP 16384

__device__ __forceinline__ float gelu_exact(float x) { return 0.5f * x * (1.f + erff(x * 0.70710678118654752f)); }

template <int M> __device__ __forceinline__ int shx_i(int v, int lane) {
    if constexpr (M == 1) return __builtin_amdgcn_mov_dpp(v, 0xB1, 0xF, 0xF, true);
    else if constexpr (M == 2) return __builtin_amdgcn_mov_dpp(v, 0x4E, 0xF, 0xF, true);
    else if constexpr (M < 32) return __builtin_amdgcn_ds_swizzle(v, (M << 10) | 0x1F);
    else return __builtin_amdgcn_ds_bpermute((lane ^ 32) << 2, v);
}
template <int M> __device__ __forceinline__ float shx(float v, int lane) { return __int_as_float(shx_i<M>(__float_as_int(v), lane)); }
__device__ __forceinline__ float wave_sum(float v, int lane) {
    v += shx<1>(v, lane); v += shx<2>(v, lane); v += shx<4>(v, lane); v += shx<8>(v, lane); v += shx<16>(v, lane); v += shx<32>(v, lane);
    return v;
}

__device__ __forceinline__ int get_tid(int wid) {
    int t = wid * 64 + (int)__builtin_amdgcn_mbcnt_hi(~0u, __builtin_amdgcn_mbcnt_lo(~0u, 0u));
    asm volatile("" : "+v"(t));
    return t;
}

#define DI __device__ __forceinline__
typedef __attribute__((ext_vector_type(8))) short bf16x8;
typedef __attribute__((ext_vector_type(16))) float f32x16;
typedef __attribute__((ext_vector_type(2))) __bf16 bf2_t;
typedef __attribute__((ext_vector_type(2))) float f2_t;
typedef unsigned short bf16_t;
typedef __attribute__((ext_vector_type(4))) unsigned u32x4;
typedef __attribute__((ext_vector_type(4))) float f32x4;
typedef const __attribute__((address_space(1))) bf16x8* gwp_t;
#define MFMA32(a, b, c) __builtin_amdgcn_mfma_f32_32x32x16_bf16((a), (b), (c), 0, 0, 0)

DI unsigned pack_bf2(float a, float b) { f2_t v = {a, b}; return __builtin_bit_cast(unsigned, __builtin_convertvector(v, bf2_t)); }
DI float bf_lo(unsigned u) { return __uint_as_float(u << 16); }
DI float bf_hi(unsigned u) { return __uint_as_float(u & 0xffff0000u); }
DI int crow(int reg, int h) { return (reg & 3) + 8 * (reg >> 2) + 4 * h; }

#define SA_STRIDE 272
#define SA_BYTES (64 * SA_STRIDE)
#define NTHR 512

template <bool GAIN>
DI void conv_wfrag(const float* __restrict__ src, int ldk, int ldn, const float* __restrict__ ga, const float* __restrict__ gb, int split,
                   int K, int N, int NTG, bf16x8* __restrict__ dst, size_t gtid, size_t gstride) {
    const int KS = K / 16;
    const size_t total = (size_t)(N / 32) * KS * 64;
    for (size_t item = gtid; item < total; item += gstride) {
        const int lane = (int)(item & 63); const size_t f = item >> 6;
        const int nti = (int)(f % NTG); const size_t f2 = f / NTG;
        const int ks = (int)(f2 % KS), nt = (int)(f2 / KS) * NTG + nti;
        const int r = lane & 31, h = lane >> 5;
        const int n = nt * 32 + r, k0 = ks * 16 + 8 * h;
        float v[8];
#pragma unroll
        for (int j = 0; j < 8; ++j) {
            const int k = k0 + j;
            float g = 1.f;
            if (GAIN) g = (k < split) ? ga[k] : gb[k - split];
            v[j] = src[(size_t)k * ldk + (size_t)n * ldn] * g;
        }
        uint4 o; o.x = pack_bf2(v[0], v[1]); o.y = pack_bf2(v[2], v[3]); o.z = pack_bf2(v[4], v[5]); o.w = pack_bf2(v[6], v[7]);
        *(uint4*)(dst + item) = o;
    }
}

DI void conv_rows_bf16(const float* __restrict__ src, const float* __restrict__ gain, bf16_t* __restrict__ dst, size_t nelem, size_t gtid, size_t gstride) {
    for (size_t i = gtid * 8; i < nelem; i += gstride * 8) {
        float4 a = *(const float4*)(src + i), b = *(const float4*)(src + i + 4);
        if (gain) {
            const int c = (int)(i & 1023);
            float4 g0 = *(const float4*)(gain + c), g1 = *(const float4*)(gain + c + 4);
            a.x *= g0.x; a.y *= g0.y; a.z *= g0.z; a.w *= g0.w; b.x *= g1.x; b.y *= g1.y; b.z *= g1.z; b.w *= g1.w;
        }
        uint4 o; o.x = pack_bf2(a.x, a.y); o.y = pack_bf2(a.z, a.w); o.z = pack_bf2(b.x, b.y); o.w = pack_bf2(b.z, b.w);
        *(uint4*)(dst + i) = o;
    }
}

struct ALoadF32 {
    const float* base; f32x4 v0, v1, v2, v3; float ss; int dofs;
    DI void init(const float* rowbase, int tid) { base = rowbase + (tid & 7) * 16; ss = 0.f; dofs = (tid >> 3) * SA_STRIDE + (tid & 7) * 32; }
    DI void issue(int c) { const f32x4* p = (const f32x4*)(base + c * 128); v0 = p[0]; v1 = p[1]; v2 = p[2]; v3 = p[3]; }
    DI void commit(char* buf) {
        u32x4 o0, o1;
        ss += v0.x * v0.x + v0.y * v0.y + v0.z * v0.z + v0.w * v0.w + v1.x * v1.x + v1.y * v1.y + v1.z * v1.z + v1.w * v1.w
            + v2.x * v2.x + v2.y * v2.y + v2.z * v2.z + v2.w * v2.w + v3.x * v3.x + v3.y * v3.y + v3.z * v3.z + v3.w * v3.w;
        o0.x = pack_bf2(v0.x, v0.y); o0.y = pack_bf2(v0.z, v0.w); o0.z = pack_bf2(v1.x, v1.y); o0.w = pack_bf2(v1.z, v1.w);
        o1.x = pack_bf2(v2.x, v2.y); o1.y = pack_bf2(v2.z, v2.w); o1.z = pack_bf2(v3.x, v3.y); o1.w = pack_bf2(v3.z, v3.w);
        char* d = buf + dofs;
        *(u32x4*)d = o0; *(u32x4*)(d + 16) = o1;
    }
};
struct ALoadBF16 {
    const bf16_t* base; u32x4 v0, v1; int dofs;
    DI void init(const bf16_t* rowbase, int tid) { base = rowbase + (tid & 7) * 16; dofs = (tid >> 3) * SA_STRIDE + (tid & 7) * 32; }
    DI void issue(int c) { const u32x4* p = (const u32x4*)(base + c * 128); v0 = p[0]; v1 = p[1]; }
    DI void commit(char* buf) {
        char* d = buf + dofs;
        *(u32x4*)d = v0; *(u32x4*)(d + 16) = v1;
    }
};

template <int NT, int PF, class AL>
DI void gemm64(f32x16 (&acc)[NT][2], AL& al, const int nchunks, const bf16x8* __restrict__ wf_, char* sA, const int lane) {
    gwp_t wf = (gwp_t)wf_;
    const int r = lane & 31, h = lane >> 5;
    bf16x8 bq[PF][NT];
    al.issue(0);
#pragma unroll
    for (int p = 0; p < PF; ++p)
#pragma unroll
        for (int nt = 0; nt < NT; ++nt) bq[p][nt] = wf[(p * NT + nt) * 64];
    gwp_t wpf = wf + PF * NT * 64;
    al.commit(sA);
    const int kend = nchunks * 8 - PF;
    int kg = 0;
#pragma unroll 1
    for (int c = 0; c < nchunks; ++c) {
        if (c + 1 < nchunks) al.issue(c + 1);
        __syncthreads();
        const char* buf = sA + (c & 1) * SA_BYTES + r * SA_STRIDE + h * 16;
#pragma unroll
        for (int ks = 0; ks < 8; ++ks) {
            const bf16x8 a0 = *(const bf16x8*)(buf + ks * 32);
            const bf16x8 a1 = *(const bf16x8*)(buf + 32 * SA_STRIDE + ks * 32);
#pragma unroll
            for (int nt = 0; nt < NT; ++nt) {
                acc[nt][0] = MFMA32(bq[ks % PF][nt], a0, acc[nt][0]);
                acc[nt][1] = MFMA32(bq[ks % PF][nt], a1, acc[nt][1]);
            }
            if (kg < kend) {
#pragma unroll
                for (int nt = 0; nt < NT; ++nt) bq[ks % PF][nt] = wpf[nt * 64];
            }
            wpf += NT * 64; ++kg;
            asm volatile("" : "+v"(wpf));
        }
        if (c + 1 < nchunks) al.commit(sA + ((c + 1) & 1) * SA_BYTES);
    }
    __syncthreads();
}

template <int NT>
DI void zero_acc(f32x16 (&acc)[NT][2]) {
#pragma unroll
    for (int nt = 0; nt < NT; ++nt)
#pragma unroll
        for (int mt = 0; mt < 2; ++mt)
#pragma unroll
            for (int i = 0; i < 16; ++i) acc[nt][mt][i] = 0.f;
}


DI void tile_transpose(const f32x16& t, float* wscr, int lane, f32x4 (&out)[4]) {
    const int r = lane & 31, h = lane >> 5;
#pragma unroll
    for (int q = 0; q < 4; ++q) { f32x4 v = {t[4 * q], t[4 * q + 1], t[4 * q + 2], t[4 * q + 3]}; *(f32x4*)(wscr + r * 36 + 8 * q + 4 * h) = v; }
#pragma unroll
    for (int j = 0; j < 4; ++j) out[j] = *(const f32x4*)(wscr + ((lane >> 3) + 8 * j) * 36 + (lane & 7) * 4);
}
#define WSCR_BYTES (32 * 36 * 4)

DI void phaseA_tile(const float* __restrict__ X, const bf16x8* __restrict__ wfin, bf16_t* __restrict__ U, int tile, char* smem, int wid) {
    char* sA = smem; float* srstd = (float*)(smem + 8 * WSCR_BYTES);
    int tok0 = tile * 64; asm volatile("" : "+s"(tok0));
    int tid = get_tid(wid);
    const int w = __builtin_amdgcn_readfirstlane(tid >> 6), lane = tid & 63, r = lane & 31, h = lane >> 5;
    ALoadF32 al; al.init(X + (size_t)(tok0 + (tid >> 3)) * DM, tid);
    f32x16 acc[4][2]; zero_acc<4>(acc);
    gemm64<4, 2>(acc, al, 8, wfin + (size_t)w * (64 * 4 * 64) + lane, sA, lane);
    float ss = al.ss;
    ss += shx<1>(ss, lane); ss += shx<2>(ss, lane); ss += shx<4>(ss, lane);
    if ((tid & 7) == 0) srstd[tid >> 3] = rsqrtf(ss * (1.f / 1024.f) + 1e-6f);
    __syncthreads();
    {
        float* wscr = (float*)(smem + w * WSCR_BYTES);
        const int tl = lane >> 3, cl = (lane & 7) * 4;
#pragma unroll
        for (int mt = 0; mt < 2; ++mt) {
            float rs[4];
#pragma unroll
            for (int j = 0; j < 4; ++j) rs[j] = srstd[mt * 32 + tl + 8 * j];
#pragma unroll
            for (int nt = 0; nt < 4; ++nt) {
                f32x4 o[4]; tile_transpose(acc[nt][mt], wscr, lane, o);
#pragma unroll
                for (int j = 0; j < 4; ++j) {
                    uint2 p; p.x = pack_bf2(o[j].x * rs[j], o[j].y * rs[j]); p.y = pack_bf2(o[j].z * rs[j], o[j].w * rs[j]);
                    *(uint2*)(U + (size_t)(tok0 + mt * 32 + tl + 8 * j) * DM + w * 128 + nt * 32 + cl) = p;
                }
            }
        }
    }
    __syncthreads();
}

struct PrepW {
    const float* norm_mix; const float* w_in; const float* w_glu; const float* w_pool; const float* g_out_ssm; const float* g_out_pool;
    const float* w_out; const float* norm_ffn; const float* w_q; const float* k1; const float* k2;
    bf16x8* wfin; bf16x8* wfglu; bf16x8* wfpool; bf16x8* wfout; bf16x8* wfq; bf16x8* wfk1; bf16x8* wfk2;
};
DI void prep_weights(const PrepW& p, size_t gtid, size_t gs) {
#pragma unroll 1
    for (int l = 0; l < 2; ++l) {
        conv_wfrag<true>(p.w_in + (size_t)l * DM * DM, DM, 1, p.norm_mix + l * DM, p.norm_mix + l * DM, DM, DM, DM, 4, p.wfin + (size_t)l * (DM * DM / 8), gtid, gs);
        conv_wfrag<false>(p.w_glu + (size_t)l * 512 * 512, 512, 1, p.norm_mix, p.norm_mix, 512, 512, 512, 2, p.wfglu + (size_t)l * (512 * 512 / 8), gtid, gs);
#pragma unroll 1
        for (int gi = 0; gi < 4; ++gi)
            conv_wfrag<false>(p.w_pool + (size_t)(l * 4 + gi) * 128 * 128, 128, 1, p.norm_mix, p.norm_mix, 128, 128, 128, 2, p.wfpool + (size_t)(l * 4 + gi) * (128 * 128 / 8), gtid, gs);
        conv_wfrag<true>(p.w_out + (size_t)l * DM * DM, DM, 1, p.g_out_ssm + l * 512, p.g_out_pool + l * 512, 512, DM, DM, 4, p.wfout + (size_t)l * (DM * DM / 8), gtid, gs);
        conv_wfrag<true>(p.w_q + (size_t)l * DM * 2048, 2048, 1, p.norm_ffn + l * DM, p.norm_ffn + l * DM, DM, DM, 2048, 4, p.wfq + (size_t)l * (DM * 2048 / 8), gtid, gs);
    }
}
#define KT_BLK 528
#define KT_BYTES (65 * KT_BLK)
#define WST_FRAGS (4 * 64 * 64)
#define CCAR_FRAGS (32 * 8 * 64)
#define SU_CH 2064

DI void prep_s5_item(int lg, int part, const float* __restrict__ a_re, const float* __restrict__ a_im, const float* __restrict__ log_dt,
                     const float* __restrict__ b_re, const float* __restrict__ b_im, const float* __restrict__ c_re, const float* __restrict__ c_im,
                     const float* __restrict__ d_skip, char* __restrict__ KT, bf16x8* __restrict__ WST, bf16x8* __restrict__ CCAR,
                     float* __restrict__ ABT, char* smem, int wid) {
    float* powr = (float*)smem;
    float* powi = powr + 65 * 64;
    float* bzr = powi + 65 * 64;
    float* bzi = bzr + 1024;
    float* cr = bzi + 1024;
    float* ci = cr + 1024;
    int tid = get_tid(wid);
    const float* are_p = a_re + lg * 64; const float* aim_p = a_im + lg * 64;
    const float dt = expf(log_dt[lg]);
    for (int it = tid; it < 65 * 64; it += NTHR) {
        const int tau = it >> 6, p = it & 63;
        const float lre = are_p[p], lim = aim_p[p];
        const float mag = expf((float)tau * lre * dt);
        double rev = (double)lim * (double)dt * (double)tau * 0.15915494309189535;
        rev -= floor(rev);
        const float ang = (float)rev * 6.283185307179586f;
        powr[it] = mag * cosf(ang); powi[it] = mag * sinf(ang);
    }
    for (int it = tid; it < 1024; it += NTHR) {
        cr[it] = c_re[lg * 1024 + it]; ci[it] = c_im[lg * 1024 + it];
    }
    __syncthreads();
    for (int it = tid; it < 1024; it += NTHR) {
        const int p = it >> 4;
        const float lre = are_p[p], lim = aim_p[p];
        const float ar = powr[64 + p], ai = powi[64 + p];
        const float inv = 1.f / (lre * lre + lim * lim), nre = ar - 1.f;
        const float zre = (nre * lre + ai * lim) * inv, zim = (ai * lre - nre * lim) * inv;
        const float br = b_re[lg * 1024 + it], bi = b_im[lg * 1024 + it];
        bzr[it] = zre * br - zim * bi; bzi[it] = zre * bi + zim * br;
    }
    __syncthreads();
    if (part == 0 && tid < 64) { ABT[lg * 128 + 2 * tid] = powr[64 * 64 + tid]; ABT[lg * 128 + 2 * tid + 1] = powi[64 * 64 + tid]; }
    char* kt = KT + (size_t)lg * KT_BYTES;
    if (part == 0) for (int it = tid; it < KT_BLK / 4; it += NTHR) ((unsigned*)kt)[it] = 0u;
    for (int it = part * (16 * 128) + tid; it < (part + 1) * (16 * 128); it += NTHR) {
        const int tau = it >> 7, ho = (it >> 3) & 15, hi = (it & 7) * 2;
        float s0 = 0.f, s1 = 0.f;
        for (int p = 0; p < 64; ++p) {
            const float c_r = cr[ho * 64 + p], c_i = ci[ho * 64 + p], pr = powr[tau * 64 + p], pi = powi[tau * 64 + p];
            const float cpr = c_r * pr - c_i * pi, cpi = c_r * pi + c_i * pr;
            s0 += cpr * bzr[p * 16 + hi] - cpi * bzi[p * 16 + hi];
            s1 += cpr * bzr[p * 16 + hi + 1] - cpi * bzi[p * 16 + hi + 1];
        }
        if (tau == 0) { if (ho == hi) s0 += d_skip[lg * 16 + ho]; if (ho == hi + 1) s1 += d_skip[lg * 16 + ho]; }
        *(unsigned*)(kt + (tau + 1) * KT_BLK + ho * 32 + hi * 2) = pack_bf2(s0, s1);
    }
    if (part == 0) for (int it = tid; it < 65 * 4; it += NTHR) ((unsigned*)(kt + (it >> 2) * KT_BLK + 512))[it & 3] = 0u;
    bf16x8* wst = WST + (size_t)lg * WST_FRAGS;
    for (int it = part * (WST_FRAGS / 4) + tid; it < (part + 1) * (WST_FRAGS / 4); it += NTHR) {
        const int lane = it & 63, j = (it >> 6) & 63, nt = it >> 12;
        const int r = lane & 31, h = lane >> 5, n = nt * 32 + r, p = n & 63, im = n >> 6;
        const float pr = powr[(63 - j) * 64 + p], pi = powi[(63 - j) * 64 + p];
        float v[8];
#pragma unroll
        for (int jj = 0; jj < 8; ++jj) {
            const float zr = bzr[p * 16 + 8 * h + jj], zi = bzi[p * 16 + 8 * h + jj];
            v[jj] = im ? (pr * zi + pi * zr) : (pr * zr - pi * zi);
        }
        uint4 o; o.x = pack_bf2(v[0], v[1]); o.y = pack_bf2(v[2], v[3]); o.z = pack_bf2(v[4], v[5]); o.w = pack_bf2(v[6], v[7]);
        *(uint4*)(wst + it) = o;
    }
    bf16x8* cc = CCAR + (size_t)lg * CCAR_FRAGS;
    for (int it = part * (CCAR_FRAGS / 4) + tid; it < (part + 1) * (CCAR_FRAGS / 4); it += NTHR) {
        const int lane = it & 63, ks = (it >> 6) & 7, mt = it >> 9;
        const int r = lane & 31, h = lane >> 5, m = mt * 32 + r, i = m >> 4, ho = m & 15;
        float v[8];
#pragma unroll
        for (int jj = 0; jj < 8; ++jj) {
            const int k = ks * 16 + 8 * h + jj, p = k & 63, im = k >> 6;
            const float c_r = cr[ho * 64 + p], c_i = ci[ho * 64 + p], pr = powr[(i + 1) * 64 + p], pi = powi[(i + 1) * 64 + p];
            v[jj] = im ? -(c_r * pi + c_i * pr) : (c_r * pr - c_i * pi);
        }
        uint4 o; o.x = pack_bf2(v[0], v[1]); o.y = pack_bf2(v[2], v[3]); o.z = pack_bf2(v[4], v[5]); o.w = pack_bf2(v[6], v[7]);
        *(uint4*)(cc + it) = o;
    }
    __syncthreads();
}

#define PB_SU 0
#define PB_SKT (32 * SU_CH)
#define PB_SL (PB_SKT + KT_BYTES)
#define PB_SPART (PB_SL + 32 * 132 * 4)
#define PB_SSP (PB_SPART + 4 * 4096)
#define PB_BYTES (PB_SSP + 32 * 272)

DI void phaseB_tile(const bf16_t* __restrict__ U, const char* __restrict__ KT, const bf16x8* __restrict__ WST, const bf16x8* __restrict__ CCAR,
                    const float* __restrict__ ABT, bf16_t* __restrict__ YPRE, int tile, char* smem, int wid) {
    const int gp = tile & 31, b = tile >> 5;
    const int g = ((gp & 7) << 2) | (gp >> 3);
    int tid = get_tid(wid);
    const int w = __builtin_amdgcn_readfirstlane(tid >> 6), lane = tid & 63, r = lane & 31, h = lane >> 5;
    char* sU = smem + PB_SU; char* sKT = smem + PB_SKT; float* sL = (float*)(smem + PB_SL); float* sPart = (float*)(smem + PB_SPART);
    char* sSp = smem + PB_SSP;
#pragma unroll
    for (int it = 0; it < 4; ++it) {
        const int tok = tid + NTHR * it;
        const uint4* src = (const uint4*)(U + (size_t)(b * SEQ + tok) * DM + g * 16);
        const uint4 v0 = src[0], v1 = src[1];
        char* d = sU + (tok >> 6) * SU_CH + (tok & 63) * 32;
        *(uint4*)d = v0; *(uint4*)(d + 16) = v1;
    }
    {
        const uint4* src = (const uint4*)(KT + (size_t)g * KT_BYTES);
        for (int it = tid; it < KT_BYTES / 16; it += NTHR) ((uint4*)sKT)[it] = src[it];
    }
    __syncthreads();
    {
        const int nt = w & 3, kh = w >> 2;
        f32x16 acc;
#pragma unroll
        for (int i = 0; i < 16; ++i) acc[i] = 0.f;
        const bf16x8* wp = WST + (size_t)g * WST_FRAGS + (size_t)(nt * 64 + kh * 32) * 64 + lane;
        const char* up = sU + r * SU_CH + h * 16 + kh * 32 * 32;
#pragma unroll 16
        for (int j = 0; j < 32; ++j) {
            const bf16x8 a = wp[j * 64];
            const bf16x8 bb = *(const bf16x8*)(up + j * 32);
            acc = MFMA32(a, bb, acc);
        }
        if (kh == 1) {
#pragma unroll
            for (int i = 0; i < 16; ++i) sPart[(nt * 16 + i) * 64 + lane] = acc[i];
        }
        __syncthreads();
        if (kh == 0) {
#pragma unroll
            for (int i = 0; i < 16; ++i) sL[r * 132 + nt * 32 + crow(i, h)] = acc[i] + sPart[(nt * 16 + i) * 64 + lane];
        }
        __syncthreads();
    }
    if (tid < 64) {
        const int p = tid;
        const float ar = ABT[g * 128 + 2 * p], ai = ABT[g * 128 + 2 * p + 1];
        float sr = 0.f, si = 0.f;
        for (int c = 0; c < 32; ++c) {
            *(bf16_t*)(sSp + c * 272 + p * 2) = (bf16_t)(pack_bf2(sr, 0.f) & 0xffffu);
            *(bf16_t*)(sSp + c * 272 + (64 + p) * 2) = (bf16_t)(pack_bf2(si, 0.f) & 0xffffu);
            const float lr = sL[c * 132 + p], li = sL[c * 132 + 64 + p];
            const float nr = ar * sr - ai * si + lr, ni = ar * si + ai * sr + li;
            sr = nr; si = ni;
        }
    }
    f32x16 acc4[4];
#pragma unroll
    for (int q = 0; q < 4; ++q)
#pragma unroll
        for (int i = 0; i < 16; ++i) acc4[q][i] = 0.f;
    const int mts0 = w, mts1 = 15 - w, mts2 = 16 + w, mts3 = 31 - w;
    {
        const char* up = sU + r * SU_CH + h * 16;
        const char* kp = sKT + (r & 15) * 32 + h * 16 + ((r >> 4) + 1) * KT_BLK;
        for (int j = 0; j < 64; ++j) {
            const bf16x8 bb = *(const bf16x8*)(up + j * 32);
#define TOEP_STEP(q, mt) if (2 * (mt) + 1 >= j) { const bf16x8 a = *(const bf16x8*)(kp + (2 * (mt) - j) * KT_BLK); acc4[q] = MFMA32(a, bb, acc4[q]); }
            TOEP_STEP(0, mts0) TOEP_STEP(1, mts1) TOEP_STEP(2, mts2) TOEP_STEP(3, mts3)
#undef TOEP_STEP
        }
    }
    __syncthreads();
    {
        const bf16x8* cp = CCAR + (size_t)g * CCAR_FRAGS + lane;
        const char* sp = sSp + r * 272 + h * 16;
#pragma unroll
        for (int ks = 0; ks < 8; ++ks) {
            const bf16x8 bb = *(const bf16x8*)(sp + ks * 32);
            acc4[0] = MFMA32(cp[(mts0 * 8 + ks) * 64], bb, acc4[0]);
            acc4[1] = MFMA32(cp[(mts1 * 8 + ks) * 64], bb, acc4[1]);
            acc4[2] = MFMA32(cp[(mts2 * 8 + ks) * 64], bb, acc4[2]);
            acc4[3] = MFMA32(cp[(mts3 * 8 + ks) * 64], bb, acc4[3]);
        }
    }
    {
        bf16_t* ybase = YPRE + (size_t)(b * SEQ + r * 64) * 512 + g * 16;
#define PB_STORE(q, mt) _Pragma("unroll") for (int rq = 0; rq < 4; ++rq) { const int c0 = 8 * rq + 4 * h; const int i = 2 * (mt) + (c0 >> 4); \
            uint2 o; o.x = pack_bf2(acc4[q][4 * rq], acc4[q][4 * rq + 1]); o.y = pack_bf2(acc4[q][4 * rq + 2], acc4[q][4 * rq + 3]); \
            *(uint2*)(ybase + (size_t)i * 512 + (c0 & 15)) = o; }
        PB_STORE(0, mts0) PB_STORE(1, mts1) PB_STORE(2, mts2) PB_STORE(3, mts3)
#undef PB_STORE
    }
    __syncthreads();
}

#ifndef REP_GLU
#define REP_GLU 1
#endif
#ifndef REP_POOL
#define REP_POOL 1
#endif
#ifndef REP_OUT
#define REP_OUT 1
#endif
#ifndef REP_Q
#define REP_Q 1
#endif
#ifndef REP_SC
#define REP_SC 1
#endif
struct ALoadGelu {
    const bf16_t* base; bf16_t* gout; u32x4 v0, v1; int cc; int dofs;
    DI void init(const bf16_t* rowbase, bf16_t* growbase, int tid) { base = rowbase + (tid & 7) * 16; gout = growbase + (tid & 7) * 16; dofs = (tid >> 3) * SA_STRIDE + (tid & 7) * 32; }
    DI void issue(int c) { const u32x4* p = (const u32x4*)(base + c * 128); v0 = p[0]; v1 = p[1]; cc = c; }
    DI unsigned g2(unsigned u) { return pack_bf2(gelu_exact(bf_lo(u)), gelu_exact(bf_hi(u))); }
    DI void commit(char* buf) {
        u32x4 o0, o1;
        o0.x = g2(v0.x); o0.y = g2(v0.y); o0.z = g2(v0.z); o0.w = g2(v0.w);
        o1.x = g2(v1.x); o1.y = g2(v1.y); o1.z = g2(v1.z); o1.w = g2(v1.w);
        char* d = buf + dofs;
        *(u32x4*)d = o0; *(u32x4*)(d + 16) = o1;
        u32x4* gp = (u32x4*)(gout + cc * 128); gp[0] = o0; gp[1] = o1;
    }
};

DI void tok_reduce(float p0, float p1, float* sred, float& t0, float& t1, int tid) {
    const int w = tid >> 6, lane = tid & 63, r = lane & 31, h = lane >> 5;
    __syncthreads();
    sred[(w * 2 + h) * 64 + r] = p0; sred[(w * 2 + h) * 64 + 32 + r] = p1;
    __syncthreads();
    float a = 0.f, b = 0.f;
#pragma unroll
    for (int k = 0; k < 16; ++k) { a += sred[k * 64 + r]; b += sred[k * 64 + 32 + r]; }
    t0 = a; t1 = b;
}

#define PC_SRED (4 * SA_BYTES)
#define PC_BYTES (PC_SRED + 4096 + 256)

struct PCArgs {
    const bf16_t* U; const bf16_t* YPRE; bf16_t* G1; bf16_t* A2; const float* Xin; float* Xout; float* Xdummy; bf16_t* Hb; float* RSTD;
    const bf16x8* wfglu; const float* b_glu; const bf16x8* wfpool; const float* pool_scale; const bf16x8* wfout;
};

DI void phaseC1_tile(const PCArgs& a, int tile, char* smem, int wid) {
    char* sA = smem; float* sred = (float*)(smem + PC_SRED);
    for (int rep_ = 0; rep_ < REP_GLU; ++rep_) {
        int tok0 = tile * 64; asm volatile("" : "+s"(tok0));
        int tid = get_tid(wid);
        const int w = __builtin_amdgcn_readfirstlane(tid >> 6), lane = tid & 63, r = lane & 31, h = lane >> 5;
        ALoadGelu al; al.init(a.YPRE + (size_t)(tok0 + (tid >> 3)) * 512, a.G1 + (size_t)(tok0 + (tid >> 3)) * 512, tid);
        f32x16 acc[2][2]; zero_acc<2>(acc);
        gemm64<2, 4>(acc, al, 4, a.wfglu + (size_t)w * (32 * 2 * 64) + lane, sA, lane);
        float ss0 = 0.f, ss1 = 0.f;
        {
            uint2 yp[2][2][4]; float4 bg[2][4];
#pragma unroll
            for (int nt = 0; nt < 2; ++nt)
#pragma unroll
                for (int q = 0; q < 4; ++q) bg[nt][q] = *(const float4*)(a.b_glu + w * 64 + nt * 32 + 8 * q + 4 * h);
#pragma unroll
            for (int mt = 0; mt < 2; ++mt)
#pragma unroll
                for (int nt = 0; nt < 2; ++nt)
#pragma unroll
                    for (int q = 0; q < 4; ++q)
                        yp[mt][nt][q] = *(const uint2*)(a.G1 + (size_t)(tok0 + mt * 32 + r) * 512 + w * 64 + nt * 32 + 8 * q + 4 * h);
#pragma unroll
            for (int mt = 0; mt < 2; ++mt)
#pragma unroll
                for (int nt = 0; nt < 2; ++nt)
#pragma unroll
                    for (int q = 0; q < 4; ++q) {
                        const float y0 = bf_lo(yp[mt][nt][q].x), y1 = bf_hi(yp[mt][nt][q].x), y2 = bf_lo(yp[mt][nt][q].y), y3 = bf_hi(yp[mt][nt][q].y);
                        const float o0 = y0 / (1.f + __expf(-(acc[nt][mt][4 * q] + bg[nt][q].x)));
                        const float o1 = y1 / (1.f + __expf(-(acc[nt][mt][4 * q + 1] + bg[nt][q].y)));
                        const float o2 = y2 / (1.f + __expf(-(acc[nt][mt][4 * q + 2] + bg[nt][q].z)));
                        const float o3 = y3 / (1.f + __expf(-(acc[nt][mt][4 * q + 3] + bg[nt][q].w)));
                        acc[nt][mt][4 * q] = o0; acc[nt][mt][4 * q + 1] = o1; acc[nt][mt][4 * q + 2] = o2; acc[nt][mt][4 * q + 3] = o3;
                        const float s = o0 * o0 + o1 * o1 + o2 * o2 + o3 * o3;
                        if (mt == 0) ss0 += s; else ss1 += s;
                    }
        }
        float t0, t1; tok_reduce(ss0, ss1, sred, t0, t1, tid);
        const float rs0 = rsqrtf(t0 * (1.f / 512.f) + 1e-6f), rs1 = rsqrtf(t1 * (1.f / 512.f) + 1e-6f);
#pragma unroll
        for (int mt = 0; mt < 2; ++mt) {
            const float rs = mt ? rs1 : rs0;
            bf16_t* orow = a.A2 + (size_t)(tok0 + mt * 32 + r) * DM + w * 64;
#pragma unroll
            for (int nt = 0; nt < 2; ++nt)
#pragma unroll
                for (int q = 0; q < 4; ++q) {
                    uint2 o; o.x = pack_bf2(acc[nt][mt][4 * q] * rs, acc[nt][mt][4 * q + 1] * rs);
                    o.y = pack_bf2(acc[nt][mt][4 * q + 2] * rs, acc[nt][mt][4 * q + 3] * rs);
                    *(uint2*)(orow + nt * 32 + 8 * q + 4 * h) = o;
                }
        }
    }
    for (int rep_ = 0; rep_ < REP_POOL; ++rep_) {
        int tok0 = tile * 64; asm volatile("" : "+s"(tok0));
        int tid = get_tid(wid);
        const int w = __builtin_amdgcn_readfirstlane(tid >> 6), lane = tid & 63, r = lane & 31, h = lane >> 5;
        const int row = tid >> 3, seg = tid & 7;
        const int tok = tok0 + row, t = tok & (SEQ - 1);
#pragma unroll
        for (int gi = 0; gi < 4; ++gi) {
            const int win = 2 << gi;
            const int cnt = (t + 1 < win) ? (t + 1) : win;
            const bf16_t* up = a.U + (size_t)tok * DM + 512 + gi * 128 + seg * 16;
            float s[16];
            const uint4 c0 = *(const uint4*)up, c1 = *(const uint4*)(up + 8);
            const unsigned cu[8] = {c0.x, c0.y, c0.z, c0.w, c1.x, c1.y, c1.z, c1.w};
#pragma unroll
            for (int i = 0; i < 8; ++i) { s[2 * i] = bf_lo(cu[i]); s[2 * i + 1] = bf_hi(cu[i]); }
#pragma unroll
            for (int k0 = 1; k0 < win; k0 += 5) {
                uint4 d0[5], d1[5];
#pragma unroll
                for (int u = 0; u < 5; ++u)
                    if (k0 + u < win) {
                        const bf16_t* p = (k0 + u <= t) ? up - (size_t)(k0 + u) * DM : up;
                        d0[u] = *(const uint4*)p; d1[u] = *(const uint4*)(p + 8);
                    }
#pragma unroll
                for (int u = 0; u < 5; ++u)
                    if (k0 + u < win) {
                        const float m = (k0 + u <= t) ? 1.f : 0.f;
                        const unsigned du[8] = {d0[u].x, d0[u].y, d0[u].z, d0[u].w, d1[u].x, d1[u].y, d1[u].z, d1[u].w};
#pragma unroll
                        for (int i = 0; i < 8; ++i) { s[2 * i] = fmaf(m, bf_lo(du[i]), s[2 * i]); s[2 * i + 1] = fmaf(m, bf_hi(du[i]), s[2 * i + 1]); }
                    }
            }
            const float inv = 1.f / (float)cnt;
            unsigned o[8];
#pragma unroll
            for (int i = 0; i < 8; ++i) o[i] = pack_bf2(s[2 * i] * inv - bf_lo(cu[i]), s[2 * i + 1] * inv - bf_hi(cu[i]));
            char* d = sA + gi * SA_BYTES + row * SA_STRIDE + seg * 32;
            *(uint4*)d = make_uint4(o[0], o[1], o[2], o[3]); *(uint4*)(d + 16) = make_uint4(o[4], o[5], o[6], o[7]);
        }
        __syncthreads();
        const int gi = w >> 1;
        f32x16 acc[2][2]; zero_acc<2>(acc);
        const bf16x8* wp = a.wfpool + (size_t)gi * (128 * 128 / 8) + (size_t)(w & 1) * (8 * 2 * 64) + lane;
        const char* buf = sA + gi * SA_BYTES + r * SA_STRIDE + h * 16;
#pragma unroll
        for (int ks = 0; ks < 8; ++ks) {
            const bf16x8 a0 = *(const bf16x8*)(buf + ks * 32);
            const bf16x8 a1 = *(const bf16x8*)(buf + 32 * SA_STRIDE + ks * 32);
#pragma unroll
            for (int nt = 0; nt < 2; ++nt) {
                const bf16x8 wv = wp[(ks * 2 + nt) * 64];
                acc[nt][0] = MFMA32(wv, a0, acc[nt][0]);
                acc[nt][1] = MFMA32(wv, a1, acc[nt][1]);
            }
        }
        float ss0 = 0.f, ss1 = 0.f;
        float4 psc[2][4];
#pragma unroll
        for (int nt = 0; nt < 2; ++nt)
#pragma unroll
            for (int q = 0; q < 4; ++q) psc[nt][q] = *(const float4*)(a.pool_scale + w * 64 + nt * 32 + 8 * q + 4 * h);
#pragma unroll
        for (int mt = 0; mt < 2; ++mt)
#pragma unroll
            for (int nt = 0; nt < 2; ++nt)
#pragma unroll
                for (int q = 0; q < 4; ++q) {
                    const float4 sc = psc[nt][q];
                    const float o0 = acc[nt][mt][4 * q] * sc.x, o1 = acc[nt][mt][4 * q + 1] * sc.y, o2 = acc[nt][mt][4 * q + 2] * sc.z, o3 = acc[nt][mt][4 * q + 3] * sc.w;
                    acc[nt][mt][4 * q] = o0; acc[nt][mt][4 * q + 1] = o1; acc[nt][mt][4 * q + 2] = o2; acc[nt][mt][4 * q + 3] = o3;
                    const float s = o0 * o0 + o1 * o1 + o2 * o2 + o3 * o3;
                    if (mt == 0) ss0 += s; else ss1 += s;
                }
        float t0, t1; tok_reduce(ss0, ss1, sred, t0, t1, tid);
        const float rs0 = rsqrtf(t0 * (1.f / 512.f) + 1e-6f), rs1 = rsqrtf(t1 * (1.f / 512.f) + 1e-6f);
#pragma unroll
        for (int mt = 0; mt < 2; ++mt) {
            const float rs = mt ? rs1 : rs0;
            bf16_t* orow = a.A2 + (size_t)(tok0 + mt * 32 + r) * DM + 512 + w * 64;
#pragma unroll
            for (int nt = 0; nt < 2; ++nt)
#pragma unroll
                for (int q = 0; q < 4; ++q) {
                    uint2 o; o.x = pack_bf2(acc[nt][mt][4 * q] * rs, acc[nt][mt][4 * q + 1] * rs);
                    o.y = pack_bf2(acc[nt][mt][4 * q + 2] * rs, acc[nt][mt][4 * q + 3] * rs);
                    *(uint2*)(orow + nt * 32 + 8 * q + 4 * h) = o;
                }
        }
        __syncthreads();
    }
    for (int rep_ = 0; rep_ < REP_OUT; ++rep_) {
        float* xout_ = (rep_ + 1 < REP_OUT) ? a.Xdummy : a.Xout;
        int tok0 = tile * 64; asm volatile("" : "+s"(tok0));
        int tid = get_tid(wid);
        const int w = __builtin_amdgcn_readfirstlane(tid >> 6), lane = tid & 63, r = lane & 31, h = lane >> 5;
        ALoadBF16 al; al.init(a.A2 + (size_t)(tok0 + (tid >> 3)) * DM, tid);
        f32x16 acc[4][2]; zero_acc<4>(acc);
        gemm64<4, 2>(acc, al, 8, a.wfout + (size_t)w * (64 * 4 * 64) + lane, sA, lane);
        {
            float* wscr = (float*)(smem + w * WSCR_BYTES);
            const int tl = lane >> 3, cl = (lane & 7) * 4;
            float ssj[2][4];
#pragma unroll
            for (int mt = 0; mt < 2; ++mt)
#pragma unroll
                for (int j = 0; j < 4; ++j) ssj[mt][j] = 0.f;
            float4 xc[4], xn[4];
            const size_t rbase = (size_t)(tok0 + tl) * DM + w * 128 + cl;
#pragma unroll
            for (int j = 0; j < 4; ++j) xc[j] = *(const float4*)(a.Xin + rbase + (size_t)(8 * j) * DM);
#pragma unroll
            for (int g = 0; g < 8; ++g) {
                const int mt = g >> 2, nt = g & 3;
                if (g < 7) {
                    const size_t rn = rbase + (size_t)((g + 1) >> 2) * 32 * DM + ((g + 1) & 3) * 32;
#pragma unroll
                    for (int j = 0; j < 4; ++j) xn[j] = *(const float4*)(a.Xin + rn + (size_t)(8 * j) * DM);
                }
                f32x4 o[4]; tile_transpose(acc[nt][mt], wscr, lane, o);
                const size_t ro = rbase + (size_t)mt * 32 * DM + nt * 32;
#pragma unroll
                for (int j = 0; j < 4; ++j) {
                    float4 xo; xo.x = xc[j].x + o[j].x; xo.y = xc[j].y + o[j].y; xo.z = xc[j].z + o[j].z; xo.w = xc[j].w + o[j].w;
                    *(float4*)(xout_ + ro + (size_t)(8 * j) * DM) = xo;
                    uint2 p; p.x = pack_bf2(xo.x, xo.y); p.y = pack_bf2(xo.z, xo.w);
                    *(uint2*)(a.Hb + ro + (size_t)(8 * j) * DM) = p;
                    ssj[mt][j] += xo.x * xo.x + xo.y * xo.y + xo.z * xo.z + xo.w * xo.w;
                }
                asm volatile("" ::: "memory");
#pragma unroll
                for (int j = 0; j < 4; ++j) xc[j] = xn[j];
            }
#pragma unroll
            for (int mt = 0; mt < 2; ++mt)
#pragma unroll
                for (int j = 0; j < 4; ++j) {
                    float v = ssj[mt][j];
                    v += shx<1>(v, lane); v += shx<2>(v, lane); v += shx<4>(v, lane);
                    if ((lane & 7) == 0) sred[w * 64 + mt * 32 + tl + 8 * j] = v;
                }
            __syncthreads();
            if (tid < 64) {
                float tot = 0.f;
#pragma unroll
                for (int k = 0; k < 8; ++k) tot += sred[k * 64 + tid];
                a.RSTD[tok0 + tid] = rsqrtf(tot * (1.f / 1024.f) + 1e-6f);
            }
        }
        __syncthreads();
    }
}

DI unsigned f2ord(float f) { const unsigned u = __float_as_uint(f); return u ^ ((u >> 31) ? 0xFFFFFFFFu : 0x80000000u); }
DI float ord2f(unsigned o) { return __uint_as_float((o & 0x80000000u) ? (o ^ 0x80000000u) : ~o); }
DI unsigned umax_(unsigned a, unsigned b) { return a > b ? a : b; }
DI unsigned umin_(unsigned a, unsigned b) { return a < b ? a : b; }

struct PRArgs {
    const bf16_t* Hb; const float* RSTD; const bf16x8* wfq; const bf16x8* kf1; const bf16x8* kf2; unsigned short* EX; float* GT;
};

DI void conv_kfrag(const float* __restrict__ K, bf16x8* __restrict__ dst, size_t gtid, size_t gstride) {
    for (size_t item = gtid; item < 8 * 4 * 64; item += gstride) {
        const int lane = (int)(item & 63), kt = (int)((item >> 6) & 3), ks = (int)(item >> 8);
        const int r = lane & 31, h = lane >> 5;
        float v[8];
#pragma unroll
        for (int j = 0; j < 8; ++j) v[j] = K[(size_t)(kt * 32 + r) * 128 + (ks >> 1) * 32 + 16 * (ks & 1) + 8 * (j >> 2) + 4 * h + (j & 3)];
        uint4 o; o.x = pack_bf2(v[0], v[1]); o.y = pack_bf2(v[2], v[3]); o.z = pack_bf2(v[4], v[5]); o.w = pack_bf2(v[6], v[7]);
        *(uint4*)(dst + item) = o;
    }
}

DI void bitonic_sort16(unsigned (&a)[16]) {
#pragma unroll
    for (int k = 2; k <= 16; k <<= 1)
#pragma unroll
        for (int j = k >> 1; j > 0; j >>= 1)
#pragma unroll
            for (int i = 0; i < 16; ++i) {
                const int l = i ^ j;
                if (l > i) {
                    const unsigned hi = umax_(a[i], a[l]), lo = umin_(a[i], a[l]);
                    if ((i & k) == 0) { a[i] = hi; a[l] = lo; } else { a[i] = lo; a[l] = hi; }
                }
            }
}
DI void bitonic_top16(unsigned (&a)[16], const unsigned (&b)[16]) {
#pragma unroll
    for (int i = 0; i < 16; ++i) a[i] = umax_(a[i], b[15 - i]);
#pragma unroll
    for (int j = 8; j > 0; j >>= 1)
#pragma unroll
        for (int i = 0; i < 16; ++i) {
            const int l = i ^ j;
            if (l > i) { const unsigned hi = umax_(a[i], a[l]), lo = umin_(a[i], a[l]); a[i] = hi; a[l] = lo; }
        }
}
DI void make_keys(unsigned (&x)[16], const f32x16& s, float rs, int nbase, int h) {
#pragma unroll
    for (int i = 0; i < 16; ++i) x[i] = (f2ord(s[i] * rs) & 0xFFFFFF80u) | (unsigned)(127 - (nbase + crow(i, h)));
}

#define PR_LIST_STRIDE 80
#define PR_SLIST (2 * SA_BYTES)
#define PR_SIDX (PR_SLIST + 8 * 32 * PR_LIST_STRIDE)

DI void phaseC2_tile(const PRArgs& a, int tile, char* smem, int wid) {
    char* sA = smem;
#pragma unroll 1
    for (int ps = 0; ps < 2; ++ps) {
        int tok0 = tile * 64; asm volatile("" : "+s"(tok0));
        int tid = get_tid(wid);
        const int w = __builtin_amdgcn_readfirstlane(tid >> 6), lane = tid & 63, r = lane & 31, h = lane >> 5;
        const int ng = ps * 8 + w, hd = ng >> 1, hf = ng & 1;
        bf16x8 qb[2][8];
        {
            ALoadBF16 al; al.init(a.Hb + (size_t)(tok0 + (tid >> 3)) * DM, tid);
            f32x16 acc[4][2]; zero_acc<4>(acc);
            gemm64<4, 2>(acc, al, 8, a.wfq + (size_t)ng * (64 * 4 * 64) + lane, sA, lane);
#pragma unroll
            for (int mt = 0; mt < 2; ++mt)
#pragma unroll
                for (int nt = 0; nt < 4; ++nt)
#pragma unroll
                    for (int s = 0; s < 2; ++s) {
                        u32x4 p;
                        p.x = pack_bf2(acc[nt][mt][8 * s], acc[nt][mt][8 * s + 1]); p.y = pack_bf2(acc[nt][mt][8 * s + 2], acc[nt][mt][8 * s + 3]);
                        p.z = pack_bf2(acc[nt][mt][8 * s + 4], acc[nt][mt][8 * s + 5]); p.w = pack_bf2(acc[nt][mt][8 * s + 6], acc[nt][mt][8 * s + 7]);
                        qb[mt][nt * 2 + s] = __builtin_bit_cast(bf16x8, p);
                    }
        }
        gwp_t kf = (gwp_t)(hf ? a.kf2 : a.kf1) + lane;
        unsigned Town[16];
#pragma unroll
        for (int mt = 0; mt < 2; ++mt) {
            f32x16 sc[4];
#pragma unroll
            for (int kt = 0; kt < 4; ++kt)
#pragma unroll
                for (int i = 0; i < 16; ++i) sc[kt][i] = 0.f;
#pragma unroll
            for (int ks = 0; ks < 8; ++ks) {
#pragma unroll
                for (int kt = 0; kt < 4; ++kt) sc[kt] = MFMA32(kf[(ks * 4 + kt) * 64], qb[mt][ks], sc[kt]);
                if (ks & 1) asm volatile("" ::: "memory");
            }
            const float rs = a.RSTD[tok0 + mt * 32 + r];
            unsigned L[16], S[16];
            make_keys(L, sc[0], rs, 0, h); bitonic_sort16(L);
#pragma unroll
            for (int kt = 1; kt < 4; ++kt) { make_keys(S, sc[kt], rs, kt * 32, h); bitonic_sort16(S); bitonic_top16(L, S); }
#pragma unroll
            for (int k = 0; k < 16; ++k) S[k] = (unsigned)shx_i<32>((int)L[k], lane);
            bitonic_top16(L, S);
            if (mt == hf) {
#pragma unroll
                for (int k = 0; k < 16; ++k) Town[k] = L[k];
            } else {
                char* dst = smem + PR_SLIST + (w * 32 + r) * PR_LIST_STRIDE + h * 32;
                u32x4 v0, v1;
                if (h == 0) { v0 = (u32x4){L[0], L[1], L[2], L[3]}; v1 = (u32x4){L[4], L[5], L[6], L[7]}; }
                else { v0 = (u32x4){L[8], L[9], L[10], L[11]}; v1 = (u32x4){L[12], L[13], L[14], L[15]}; }
                *(u32x4*)dst = v0; *(u32x4*)(dst + 16) = v1;
            }
        }
        __syncthreads();
        unsigned T0[16], T1[16];
        {
            const char* src = smem + PR_SLIST + ((w ^ 1) * 32 + r) * PR_LIST_STRIDE;
            const u32x4 p0 = *(const u32x4*)src, p1 = *(const u32x4*)(src + 16), p2 = *(const u32x4*)(src + 32), p3 = *(const u32x4*)(src + 48);
            const unsigned Tp[16] = {p0.x, p0.y, p0.z, p0.w, p1.x, p1.y, p1.z, p1.w, p2.x, p2.y, p2.z, p2.w, p3.x, p3.y, p3.z, p3.w};
#pragma unroll
            for (int k = 0; k < 16; ++k) { T0[k] = hf ? Tp[k] : Town[k]; T1[k] = hf ? Town[k] : Tp[k]; }
        }
        float v1[16], v2[16];
#pragma unroll
        for (int k = 0; k < 16; ++k) { v1[k] = ord2f(T0[k] & 0xFFFFFF80u); v2[k] = ord2f(T1[k] & 0xFFFFFF80u); }
        unsigned C[16];
#pragma unroll
        for (int b = 0; b < 16; ++b) C[b] = (f2ord(v1[0] + v2[b]) & 0xFFFFFF00u) | (unsigned)(255 - b);
#pragma unroll
        for (int aa = 1; aa < 16; ++aa)
#pragma unroll
            for (int b = 0; b < 16; ++b)
                if ((aa + 1) * (b + 1) <= 16) {
                    unsigned x = (f2ord(v1[aa] + v2[b]) & 0xFFFFFF00u) | (unsigned)(255 - (aa * 16 + b));
#pragma unroll
                    for (int k = (aa + 1) * (b + 1) - 1; k < 16; ++k) { const unsigned hi = umax_(C[k], x); x = umin_(C[k], x); C[k] = hi; }
                }
        unsigned* sI = (unsigned*)(smem + PR_SIDX) + (w * 64 + lane) * 9;
#pragma unroll
        for (int q = 0; q < 4; ++q) {
            unsigned p1 = 0u, p2 = 0u;
#pragma unroll
            for (int j = 0; j < 4; ++j) { p1 |= (127u - (T0[4 * q + j] & 0x7Fu)) << (8 * j); p2 |= (127u - (T1[4 * q + j] & 0x7Fu)) << (8 * j); }
            sI[q] = p1; sI[4 + q] = p2;
        }
        const unsigned char* sB = (const unsigned char*)sI;
        const float mx = ord2f(C[0] & 0xFFFFFF00u);
        float e[16]; float sum = 0.f; int ex[16];
#pragma unroll
        for (int k = 0; k < 16; ++k) {
            e[k] = __expf(ord2f(C[k] & 0xFFFFFF00u) - mx); sum += e[k];
            const unsigned ci = 255u - (C[k] & 0xFFu);
            ex[k] = (int)sB[ci >> 4] * 128 + (int)sB[16 + (ci & 15u)];
        }
        const float inv = 1.f / sum;
        const size_t ob = ((size_t)(tok0 + hf * 32 + r) * 8 + hd) * 16;
        if (h == 0) {
#pragma unroll
            for (int q = 0; q < 2; ++q) *(uint4*)(a.EX + ob + 8 * q) = make_uint4((unsigned)ex[8 * q] | ((unsigned)ex[8 * q + 1] << 16), (unsigned)ex[8 * q + 2] | ((unsigned)ex[8 * q + 3] << 16),
                                                                       (unsigned)ex[8 * q + 4] | ((unsigned)ex[8 * q + 5] << 16), (unsigned)ex[8 * q + 6] | ((unsigned)ex[8 * q + 7] << 16));
        } else {
#pragma unroll
            for (int q = 0; q < 4; ++q) *(float4*)(a.GT + ob + 4 * q) = make_float4(e[4 * q] * inv, e[4 * q + 1] * inv, e[4 * q + 2] * inv, e[4 * q + 3] * inv);
        }
        __syncthreads();
    }
}
typedef const __attribute__((address_space(1))) u32x4* grow_t;
typedef unsigned char fp8_t;

struct PGArgs {
    const bf16_t* Hb; const float* RSTD; const int* EX; const float* GT; const fp8_t* U8; const fp8_t* V8; const float* SU; const float* SV;
    const float* Xin; float* Xout; const float* gfinal; int final_norm;
};

#ifndef EMU_FP4
#define EMU_FP4 0
#endif
DI float q_e2m1(float x, float inv, float sc) {
    const float a = fabsf(x) * inv;
    float q = (a < 0.25f) ? 0.f : (a < 0.75f) ? 0.5f : (a < 1.25f) ? 1.f : (a < 1.75f) ? 1.5f : (a < 2.5f) ? 2.f : (a < 3.5f) ? 3.f : (a < 5.f) ? 4.f : 6.f;
    return copysignf(q * sc, x);
}
DI void emu_fp4_block(float4& v0, float4& v1, float4& v2, float4& v3) {
    float m = fmaxf(fmaxf(fmaxf(fabsf(v0.x), fabsf(v0.y)), fmaxf(fabsf(v0.z), fabsf(v0.w))), fmaxf(fmaxf(fabsf(v1.x), fabsf(v1.y)), fmaxf(fabsf(v1.z), fabsf(v1.w))));
    m = fmaxf(m, fmaxf(fmaxf(fmaxf(fabsf(v2.x), fabsf(v2.y)), fmaxf(fabsf(v2.z), fabsf(v2.w))), fmaxf(fmaxf(fabsf(v3.x), fabsf(v3.y)), fmaxf(fabsf(v3.z), fabsf(v3.w)))));
    const float sc = (m > 0.f) ? m * (1.f / 6.f) : 1.f, inv = 1.f / sc;
    v0.x = q_e2m1(v0.x, inv, sc); v0.y = q_e2m1(v0.y, inv, sc); v0.z = q_e2m1(v0.z, inv, sc); v0.w = q_e2m1(v0.w, inv, sc);
    v1.x = q_e2m1(v1.x, inv, sc); v1.y = q_e2m1(v1.y, inv, sc); v1.z = q_e2m1(v1.z, inv, sc); v1.w = q_e2m1(v1.w, inv, sc);
    v2.x = q_e2m1(v2.x, inv, sc); v2.y = q_e2m1(v2.y, inv, sc); v2.z = q_e2m1(v2.z, inv, sc); v2.w = q_e2m1(v2.w, inv, sc);
    v3.x = q_e2m1(v3.x, inv, sc); v3.y = q_e2m1(v3.y, inv, sc); v3.z = q_e2m1(v3.z, inv, sc); v3.w = q_e2m1(v3.w, inv, sc);
}
DI void conv_row_fp8_one(float4 v0, float4 v1, float4 v2, float4 v3, const float* __restrict__ gain, fp8_t* __restrict__ dst, float* __restrict__ scales,
                         int nrows, int row, int lane) {
    if (gain) {
        const float4* g = (const float4*)(gain + lane * 16);
        const float4 g0 = g[0], g1 = g[1], g2 = g[2], g3 = g[3];
        v0.x *= g0.x; v0.y *= g0.y; v0.z *= g0.z; v0.w *= g0.w; v1.x *= g1.x; v1.y *= g1.y; v1.z *= g1.z; v1.w *= g1.w;
        v2.x *= g2.x; v2.y *= g2.y; v2.z *= g2.z; v2.w *= g2.w; v3.x *= g3.x; v3.y *= g3.y; v3.z *= g3.z; v3.w *= g3.w;
    }
    if (gain ? (EMU_FP4 & 1) : (EMU_FP4 & 2)) emu_fp4_block(v0, v1, v2, v3);
    float m = fmaxf(fmaxf(fmaxf(fabsf(v0.x), fabsf(v0.y)), fmaxf(fabsf(v0.z), fabsf(v0.w))), fmaxf(fmaxf(fabsf(v1.x), fabsf(v1.y)), fmaxf(fabsf(v1.z), fabsf(v1.w))));
    m = fmaxf(m, fmaxf(fmaxf(fmaxf(fabsf(v2.x), fabsf(v2.y)), fmaxf(fabsf(v2.z), fabsf(v2.w))), fmaxf(fmaxf(fabsf(v3.x), fabsf(v3.y)), fmaxf(fabsf(v3.z), fabsf(v3.w)))));
    m = fmaxf(m, shx<1>(m, lane)); m = fmaxf(m, shx<2>(m, lane)); m = fmaxf(m, shx<4>(m, lane)); m = fmaxf(m, shx<8>(m, lane)); m = fmaxf(m, shx<16>(m, lane)); m = fmaxf(m, shx<32>(m, lane));
    const float sc = (m > 0.f) ? m * (1.f / 448.f) : 1.f;
    const float inv = 1.f / sc;
    u32x4 o;
    unsigned t;
    t = 0u; t = __builtin_amdgcn_cvt_pk_fp8_f32(v0.x * inv, v0.y * inv, t, false); t = __builtin_amdgcn_cvt_pk_fp8_f32(v0.z * inv, v0.w * inv, t, true); o.x = t;
    t = 0u; t = __builtin_amdgcn_cvt_pk_fp8_f32(v1.x * inv, v1.y * inv, t, false); t = __builtin_amdgcn_cvt_pk_fp8_f32(v1.z * inv, v1.w * inv, t, true); o.y = t;
    t = 0u; t = __builtin_amdgcn_cvt_pk_fp8_f32(v2.x * inv, v2.y * inv, t, false); t = __builtin_amdgcn_cvt_pk_fp8_f32(v2.z * inv, v2.w * inv, t, true); o.z = t;
    t = 0u; t = __builtin_amdgcn_cvt_pk_fp8_f32(v3.x * inv, v3.y * inv, t, false); t = __builtin_amdgcn_cvt_pk_fp8_f32(v3.z * inv, v3.w * inv, t, true); o.w = t;
    *(u32x4*)(dst + ((size_t)(lane >> 3) * nrows + row) * 128 + (lane & 7) * 16) = o;
    if (lane == 0) scales[row] = sc;
}
DI void conv_rows_fp8(const float* __restrict__ src, const float* __restrict__ gain, fp8_t* __restrict__ dst, float* __restrict__ scales,
                      int nrows, int gwave, int nwaves, int lane) {
#pragma unroll 1
    for (int row = gwave; row < nrows; row += 4 * nwaves) {
        const int r1 = min(row + nwaves, nrows - 1), r2 = min(row + 2 * nwaves, nrows - 1), r3 = min(row + 3 * nwaves, nrows - 1);
        const float4* p0 = (const float4*)(src + (size_t)row * DM + lane * 16);
        const float4* p1 = (const float4*)(src + (size_t)r1 * DM + lane * 16);
        const float4* p2 = (const float4*)(src + (size_t)r2 * DM + lane * 16);
        const float4* p3 = (const float4*)(src + (size_t)r3 * DM + lane * 16);
        const float4 a0 = p0[0], a1 = p0[1], a2 = p0[2], a3 = p0[3];
        const float4 b0 = p1[0], b1 = p1[1], b2 = p1[2], b3 = p1[3];
        const float4 c0 = p2[0], c1 = p2[1], c2 = p2[2], c3 = p2[3];
        const float4 d0 = p3[0], d1 = p3[1], d2 = p3[2], d3 = p3[3];
        conv_row_fp8_one(a0, a1, a2, a3, gain, dst, scales, nrows, row, lane);
        conv_row_fp8_one(b0, b1, b2, b3, gain, dst, scales, nrows, r1, lane);
        conv_row_fp8_one(c0, c1, c2, c3, gain, dst, scales, nrows, r2, lane);
        conv_row_fp8_one(d0, d1, d2, d3, gain, dst, scales, nrows, r3, lane);
    }
}

struct RowOct { u32x4 r0, r1, r2, r3, r4, r5, r6, r7; };
DI void oct_load(RowOct& q, const fp8_t* tab, int e0, int e1, int e2, int e3, int e4, int e5, int e6, int e7, int lane) {
    q.r0 = ((grow_t)(tab + (size_t)e0 * DM))[lane]; q.r1 = ((grow_t)(tab + (size_t)e1 * DM))[lane];
    q.r2 = ((grow_t)(tab + (size_t)e2 * DM))[lane]; q.r3 = ((grow_t)(tab + (size_t)e3 * DM))[lane];
    q.r4 = ((grow_t)(tab + (size_t)e4 * DM))[lane]; q.r5 = ((grow_t)(tab + (size_t)e5 * DM))[lane];
    q.r6 = ((grow_t)(tab + (size_t)e6 * DM))[lane]; q.r7 = ((grow_t)(tab + (size_t)e7 * DM))[lane];
}
DI float dot4w(unsigned w, float h0, float h1, float h2, float h3, float s) {
    const f2_t lo = __builtin_amdgcn_cvt_pk_f32_fp8(w, false), hi = __builtin_amdgcn_cvt_pk_f32_fp8(w, true);
    s = fmaf(lo.x, h0, s); s = fmaf(lo.y, h1, s); s = fmaf(hi.x, h2, s); s = fmaf(hi.y, h3, s);
    return s;
}
DI float row_dot8(const u32x4& r, const float (&h)[16]) {
    float s = 0.f;
    s = dot4w(r.x, h[0], h[1], h[2], h[3], s); s = dot4w(r.y, h[4], h[5], h[6], h[7], s);
    s = dot4w(r.z, h[8], h[9], h[10], h[11], s); s = dot4w(r.w, h[12], h[13], h[14], h[15], s);
    return s;
}
DI void axpy4w(unsigned w, float c, float& a0, float& a1, float& a2, float& a3) {
    const f2_t lo = __builtin_amdgcn_cvt_pk_f32_fp8(w, false), hi = __builtin_amdgcn_cvt_pk_f32_fp8(w, true);
    a0 = fmaf(c, lo.x, a0); a1 = fmaf(c, lo.y, a1); a2 = fmaf(c, hi.x, a2); a3 = fmaf(c, hi.y, a3);
}
DI void row_axpy8(float (&acc)[16], const u32x4& r, float c) {
    axpy4w(r.x, c, acc[0], acc[1], acc[2], acc[3]); axpy4w(r.y, c, acc[4], acc[5], acc[6], acc[7]);
    axpy4w(r.z, c, acc[8], acc[9], acc[10], acc[11]); axpy4w(r.w, c, acc[12], acc[13], acc[14], acc[15]);
}
#define RL(v, l) __builtin_amdgcn_readlane((v), (l))
#define RLF(v, l) __uint_as_float((unsigned)__builtin_amdgcn_readlane((int)__float_as_uint(v), (l)))

DI float reduce16(float (&p)[16], int lane) {
    const bool b5 = lane & 32, b4 = lane & 16, b3 = lane & 8, b2 = lane & 4;
    float q8[8], q4[4], q2[2];
#pragma unroll
    for (int k = 0; k < 8; ++k) { const float keep = b5 ? p[k + 8] : p[k], send = b5 ? p[k] : p[k + 8]; q8[k] = keep + shx<32>(send, lane); }
#pragma unroll
    for (int k = 0; k < 4; ++k) { const float keep = b4 ? q8[k + 4] : q8[k], send = b4 ? q8[k] : q8[k + 4]; q4[k] = keep + shx<16>(send, lane); }
#pragma unroll
    for (int k = 0; k < 2; ++k) { const float keep = b3 ? q4[k + 2] : q4[k], send = b3 ? q4[k] : q4[k + 2]; q2[k] = keep + shx<8>(send, lane); }
    float t;
    { const float keep = b2 ? q2[1] : q2[0], send = b2 ? q2[0] : q2[1]; t = keep + shx<4>(send, lane); }
    t += shx<1>(t, lane); t += shx<2>(t, lane);
    return t;
}

DI void phaseC3_tile(const PGArgs& a, int tile, int wid) {
    int tid = get_tid(wid);
    const int w = __builtin_amdgcn_readfirstlane(tid >> 6), lane = tid & 63;
    const int el = (lane >> 2) & 15;
#pragma unroll 1
    for (int ti = 0; ti < 8; ++ti) {
        const int tok = tile * 64 + w * 8 + ti;
        float h[16];
        {
            const u32x4* hp = (const u32x4*)(a.Hb + (size_t)tok * DM + lane * 16);
            const u32x4 h0 = hp[0], h1 = hp[1];
            h[0] = bf_lo(h0.x); h[1] = bf_hi(h0.x); h[2] = bf_lo(h0.y); h[3] = bf_hi(h0.y); h[4] = bf_lo(h0.z); h[5] = bf_hi(h0.z); h[6] = bf_lo(h0.w); h[7] = bf_hi(h0.w);
            h[8] = bf_lo(h1.x); h[9] = bf_hi(h1.x); h[10] = bf_lo(h1.y); h[11] = bf_hi(h1.y); h[12] = bf_lo(h1.z); h[13] = bf_hi(h1.z); h[14] = bf_lo(h1.w); h[15] = bf_hi(h1.w);
        }
        const float rs = a.RSTD[tok];
        float acc[16];
#pragma unroll
        for (int i = 0; i < 16; ++i) acc[i] = 0.f;
#pragma unroll 1
        for (int hd = 0; hd < 8; ++hd) {
            const size_t eb = ((size_t)tok * 8 + hd) * 16;
            const int exv = a.EX[eb + (lane & 15)];
            const int exl = a.EX[eb + el];
            const float coef = a.GT[eb + el] * a.SV[exl];
            const float su = a.SU[exl] * rs;
            RowOct qa, qb;
            float p[16];
            oct_load(qa, a.U8, RL(exv, 0), RL(exv, 1), RL(exv, 2), RL(exv, 3), RL(exv, 4), RL(exv, 5), RL(exv, 6), RL(exv, 7), lane);
            oct_load(qb, a.U8, RL(exv, 8), RL(exv, 9), RL(exv, 10), RL(exv, 11), RL(exv, 12), RL(exv, 13), RL(exv, 14), RL(exv, 15), lane);
            p[0] = row_dot8(qa.r0, h); p[1] = row_dot8(qa.r1, h); p[2] = row_dot8(qa.r2, h); p[3] = row_dot8(qa.r3, h);
            p[4] = row_dot8(qa.r4, h); p[5] = row_dot8(qa.r5, h); p[6] = row_dot8(qa.r6, h); p[7] = row_dot8(qa.r7, h);
            oct_load(qa, a.V8, RL(exv, 0), RL(exv, 1), RL(exv, 2), RL(exv, 3), RL(exv, 4), RL(exv, 5), RL(exv, 6), RL(exv, 7), lane);
            p[8] = row_dot8(qb.r0, h); p[9] = row_dot8(qb.r1, h); p[10] = row_dot8(qb.r2, h); p[11] = row_dot8(qb.r3, h);
            p[12] = row_dot8(qb.r4, h); p[13] = row_dot8(qb.r5, h); p[14] = row_dot8(qb.r6, h); p[15] = row_dot8(qb.r7, h);
            oct_load(qb, a.V8, RL(exv, 8), RL(exv, 9), RL(exv, 10), RL(exv, 11), RL(exv, 12), RL(exv, 13), RL(exv, 14), RL(exv, 15), lane);
            const float act = gelu_exact(reduce16(p, lane) * su) * coef;
            row_axpy8(acc, qa.r0, RLF(act, 0)); row_axpy8(acc, qa.r1, RLF(act, 4)); row_axpy8(acc, qa.r2, RLF(act, 8)); row_axpy8(acc, qa.r3, RLF(act, 12));
            row_axpy8(acc, qa.r4, RLF(act, 16)); row_axpy8(acc, qa.r5, RLF(act, 20)); row_axpy8(acc, qa.r6, RLF(act, 24)); row_axpy8(acc, qa.r7, RLF(act, 28));
            row_axpy8(acc, qb.r0, RLF(act, 32)); row_axpy8(acc, qb.r1, RLF(act, 36)); row_axpy8(acc, qb.r2, RLF(act, 40)); row_axpy8(acc, qb.r3, RLF(act, 44));
            row_axpy8(acc, qb.r4, RLF(act, 48)); row_axpy8(acc, qb.r5, RLF(act, 52)); row_axpy8(acc, qb.r6, RLF(act, 56)); row_axpy8(acc, qb.r7, RLF(act, 60));
        }
        const float* xi = a.Xin + (size_t)tok * DM + lane * 16;
        float* xo = a.Xout + (size_t)tok * DM + lane * 16;
        float4 x0 = *(const float4*)xi, x1 = *(const float4*)(xi + 4), x2 = *(const float4*)(xi + 8), x3 = *(const float4*)(xi + 12);
        x0.x += acc[0]; x0.y += acc[1]; x0.z += acc[2]; x0.w += acc[3]; x1.x += acc[4]; x1.y += acc[5]; x1.z += acc[6]; x1.w += acc[7];
        x2.x += acc[8]; x2.y += acc[9]; x2.z += acc[10]; x2.w += acc[11]; x3.x += acc[12]; x3.y += acc[13]; x3.z += acc[14]; x3.w += acc[15];
        if (a.final_norm) {
            float ss = x0.x * x0.x + x0.y * x0.y + x0.z * x0.z + x0.w * x0.w + x1.x * x1.x + x1.y * x1.y + x1.z * x1.z + x1.w * x1.w
                     + x2.x * x2.x + x2.y * x2.y + x2.z * x2.z + x2.w * x2.w + x3.x * x3.x + x3.y * x3.y + x3.z * x3.z + x3.w * x3.w;
            ss = wave_sum(ss, lane);
            const float rf = rsqrtf(ss * (1.f / 1024.f) + 1e-6f);
            const float* gf = a.gfinal + lane * 16;
            const float4 g0 = *(const float4*)gf, g1 = *(const float4*)(gf + 4), g2 = *(const float4*)(gf + 8), g3 = *(const float4*)(gf + 12);
            x0.x *= rf * g0.x; x0.y *= rf * g0.y; x0.z *= rf * g0.z; x0.w *= rf * g0.w; x1.x *= rf * g1.x; x1.y *= rf * g1.y; x1.z *= rf * g1.z; x1.w *= rf * g1.w;
            x2.x *= rf * g2.x; x2.y *= rf * g2.y; x2.z *= rf * g2.z; x2.w *= rf * g2.w; x3.x *= rf * g3.x; x3.y *= rf * g3.y; x3.z *= rf * g3.z; x3.w *= rf * g3.w;
        }
        *(float4*)xo = x0; *(float4*)(xo + 4) = x1; *(float4*)(xo + 8) = x2; *(float4*)(xo + 12) = x3;
    }
}
#define XB_TMO      128
#define XB_XCNT(j)  (256  + 64 * (j))
#define XB_XSUB(j)  (1280 + 64 * (j))
#define XB_XGEN(j)  (2304 + 64 * (j))
#define XB_TOP      3328
#define XB_TOPGEN   3392
#define XB_QUEUE(j) (3456 + 64 * (j))
#define XCD_BAR_WORDS (3456 + 64 * 64)
#define XB_SPIN_CAP (1u << 20)
#define LAS __attribute__((address_space(3)))

DI unsigned xb_ld(unsigned* p)              { return __hip_atomic_load(p, __ATOMIC_RELAXED, __HIP_MEMORY_SCOPE_AGENT); }
DI unsigned xb_add(unsigned* p, unsigned v) { return __hip_atomic_fetch_add(p, v, __ATOMIC_RELAXED, __HIP_MEMORY_SCOPE_AGENT); }
DI unsigned xb_xcc_id() { return (unsigned)__builtin_amdgcn_s_getreg((3 << 11) | 20) & 0xFu; }
#define XB_SPIN(cond, bar) do { unsigned _sp = 0; while (cond) { __builtin_amdgcn_s_sleep(1); \
    if ((++_sp & 255u) == 0u) { if (xb_ld(&(bar)[XB_TMO])) break; if (_sp > XB_SPIN_CAP) { atomicAdd(&(bar)[XB_TMO], 1u); break; } } } } while (0)

struct XcdBarrier { unsigned* bar; unsigned x; volatile LAS unsigned* st; };

DI XcdBarrier xcd_barrier_post(unsigned* bar, volatile LAS unsigned* st, int tid) {
    XcdBarrier b; b.bar = bar; b.x = xb_xcc_id(); b.st = st;
    if (tid == 0) st[2] = xb_add(&bar[XB_XCNT(b.x)], 1u);
    return b;
}
DI void xcd_barrier_complete(unsigned* bar, unsigned x, unsigned& nloc, unsigned& nx) {
    const unsigned G = gridDim.x * gridDim.y * gridDim.z;
    unsigned sum, cnt, mine, sp = 0u;
    for (;;) {
        sum = 0u; cnt = 0u; mine = 0u;
#pragma unroll
        for (unsigned j = 0; j < 16; ++j) { const unsigned c = xb_ld(&bar[XB_XCNT(j)]); sum += c; cnt += (c > 0u) ? 1u : 0u; mine = (j == x) ? c : mine; }
        if (sum == G) break;
        __builtin_amdgcn_s_sleep(1);
        if ((++sp & 255u) == 0u) { if (xb_ld(&bar[XB_TMO])) break; if (sp > XB_SPIN_CAP) { atomicAdd(&bar[XB_TMO], 1u); break; } }
    }
    nloc = mine > 0u ? mine : 1u; nx = cnt > 0u ? cnt : 1u;
}
DI void xcd_barrier(const XcdBarrier& b, int wid) {
    asm volatile("s_waitcnt vmcnt(0)" ::: "memory");
    __syncthreads();
    if (get_tid(wid) == 0) {
        unsigned* bar = b.bar;
        __builtin_amdgcn_s_waitcnt(0);
        unsigned nloc = b.st[0], nx = b.st[1];
        if (nloc == 0u) { xcd_barrier_complete(bar, b.x, nloc, nx); b.st[0] = nloc; b.st[1] = nx; }
        const unsigned old = xb_add(&bar[XB_XSUB(b.x)], 1u);
        const unsigned gen = old / nloc;
        if (old + 1u == (gen + 1u) * nloc) {
            __builtin_amdgcn_fence(__ATOMIC_RELEASE, "agent");
            asm volatile("s_waitcnt vmcnt(0)" ::: "memory");
            const unsigned og = xb_add(&bar[XB_TOP], 1u);
            const unsigned tg = og / nx;
            if (og + 1u == (tg + 1u) * nx) xb_add(&bar[XB_TOPGEN], 1u);
            else XB_SPIN(xb_ld(&bar[XB_TOPGEN]) == tg, bar);
            __builtin_amdgcn_fence(__ATOMIC_ACQUIRE, "agent");
            xb_add(&bar[XB_XGEN(b.x)], 1u);
            asm volatile("s_waitcnt vmcnt(0)" ::: "memory");
        } else {
            XB_SPIN(xb_ld(&bar[XB_XGEN(b.x)]) == gen, bar);
            __builtin_amdgcn_fence(__ATOMIC_ACQUIRE, "agent");
            asm volatile("s_waitcnt vmcnt(0)" ::: "memory");
        }
    }
    __syncthreads();
}
#ifndef U_FP4
#define U_FP4 1
#endif
#if U_FP4
#define NUSL 4
#else
#define NUSL 8
#endif
struct PSArgs {
    const bf16_t* Hb; const float* RSTD; const unsigned short* EX; const float* GT; const fp8_t* U8; const fp8_t* V8; const float* SU; const float* SV;
    float* PD; bf16_t* COEF; const float* Xin; float* Xout;
};

DI void dot4p(unsigned w, const f2_t& h01, const f2_t& h23, f2_t& s2) {
    const f2_t lo = __builtin_amdgcn_cvt_pk_f32_fp8(w, false), hi = __builtin_amdgcn_cvt_pk_f32_fp8(w, true);
    s2 = __builtin_elementwise_fma(lo, h01, s2); s2 = __builtin_elementwise_fma(hi, h23, s2);
}
DI float row_dot8p(const u32x4& r, const f2_t (&h)[8]) {
    f2_t s2 = {0.f, 0.f};
    dot4p(r.x, h[0], h[1], s2); dot4p(r.y, h[2], h[3], s2); dot4p(r.z, h[4], h[5], s2); dot4p(r.w, h[6], h[7], s2);
    return s2.x + s2.y;
}
DI void axpy4p(unsigned w, const f2_t& c2, f2_t& a01, f2_t& a23) {
    const f2_t lo = __builtin_amdgcn_cvt_pk_f32_fp8(w, false), hi = __builtin_amdgcn_cvt_pk_f32_fp8(w, true);
    a01 = __builtin_elementwise_fma(c2, lo, a01); a23 = __builtin_elementwise_fma(c2, hi, a23);
}
DI void row_axpy8p(f2_t (&acc)[8], const u32x4& r, float c) {
    const f2_t c2 = {c, c};
    axpy4p(r.x, c2, acc[0], acc[1]); axpy4p(r.y, c2, acc[2], acc[3]); axpy4p(r.z, c2, acc[4], acc[5]); axpy4p(r.w, c2, acc[6], acc[7]);
}

DI int run_token(int n, int k, int nloc, int wid) { return (k + (n >> 3) * nloc) * 64 + wid * 8 + (n & 7); }

struct Ids16 { u32x4 a, b; };
DI void ids_load(Ids16& q, const unsigned short* EX, int tok, int rg) { const u32x4* p = (const u32x4*)(EX + (size_t)tok * 128 + rg * 16); q.a = p[0]; q.b = p[1]; }
#define ID_LO(w) (((w) & 0xFFFFu) * 128u + loff)
#define ID_HI(w) (((w) >> 16) * 128u + loff)
DI void rows_lo(u32x4 (&r)[8], const Ids16& q, const fp8_t* tab, unsigned loff) {
    r[0] = *(grow_t)(tab + ID_LO(q.a.x)); r[1] = *(grow_t)(tab + ID_HI(q.a.x)); r[2] = *(grow_t)(tab + ID_LO(q.a.y)); r[3] = *(grow_t)(tab + ID_HI(q.a.y));
    r[4] = *(grow_t)(tab + ID_LO(q.a.z)); r[5] = *(grow_t)(tab + ID_HI(q.a.z)); r[6] = *(grow_t)(tab + ID_LO(q.a.w)); r[7] = *(grow_t)(tab + ID_HI(q.a.w));
}
DI void rows_hi(u32x4 (&r)[8], const Ids16& q, const fp8_t* tab, unsigned loff) {
    r[0] = *(grow_t)(tab + ID_LO(q.b.x)); r[1] = *(grow_t)(tab + ID_HI(q.b.x)); r[2] = *(grow_t)(tab + ID_LO(q.b.y)); r[3] = *(grow_t)(tab + ID_HI(q.b.y));
    r[4] = *(grow_t)(tab + ID_LO(q.b.z)); r[5] = *(grow_t)(tab + ID_HI(q.b.z)); r[6] = *(grow_t)(tab + ID_LO(q.b.w)); r[7] = *(grow_t)(tab + ID_HI(q.b.w));
}
DI void unpack_h(f2_t (&h)[8], const u32x4& h0, const u32x4& h1) {
    h[0] = (f2_t){bf_lo(h0.x), bf_hi(h0.x)}; h[1] = (f2_t){bf_lo(h0.y), bf_hi(h0.y)}; h[2] = (f2_t){bf_lo(h0.z), bf_hi(h0.z)}; h[3] = (f2_t){bf_lo(h0.w), bf_hi(h0.w)};
    h[4] = (f2_t){bf_lo(h1.x), bf_hi(h1.x)}; h[5] = (f2_t){bf_lo(h1.y), bf_hi(h1.y)}; h[6] = (f2_t){bf_lo(h1.z), bf_hi(h1.z)}; h[7] = (f2_t){bf_lo(h1.w), bf_hi(h1.w)};
}
DI void dots8(float* p, const u32x4 (&r)[8], const f2_t (&h)[8]) {
#pragma unroll
    for (int i = 0; i < 8; ++i) { p[i] = row_dot8p(r[i], h); if ((i & 1) == 1) __builtin_amdgcn_sched_barrier(0); }
}
DI void peerU_finish(const PSArgs& a, float (&p)[16], int tok, int s, int lane) {
    const int rg = lane >> 3, pc = lane & 7;
    const bool b2 = pc & 4, b1 = pc & 2, b0 = pc & 1;
    float q8[8], q4[4], q2[2];
#pragma unroll
    for (int k = 0; k < 8; ++k) { const float keep = b2 ? p[k + 8] : p[k], send = b2 ? p[k] : p[k + 8]; q8[k] = keep + shx<4>(send, lane); }
#pragma unroll
    for (int k = 0; k < 4; ++k) { const float keep = b1 ? q8[k + 4] : q8[k], send = b1 ? q8[k] : q8[k + 4]; q4[k] = keep + shx<2>(send, lane); }
#pragma unroll
    for (int k = 0; k < 2; ++k) { const float keep = b0 ? q4[k + 2] : q4[k], send = b0 ? q4[k] : q4[k + 2]; q2[k] = keep + shx<1>(send, lane); }
    *(float2*)(a.PD + ((size_t)s * NTOK + tok) * 128 + rg * 16 + 2 * pc) = make_float2(q2[0], q2[1]);
}

DI void peerU_run(const PSArgs& a, int s, int k, int nloc, int wid) {
    const int tid = get_tid(wid);
    const int lane = tid & 63, rg = lane >> 3, pc = lane & 7;
    const unsigned loff = (unsigned)(s * (NEXP * 128) + pc * 16);
    const int hoff = s * 128 + pc * 16;
    const int N = 8 * ((NTOK / 64 - k + nloc - 1) / nloc);
    Ids16 idE, idO;
    u32x4 rA[8], rB[8], hE0, hE1, hO0, hO1;
#define LOAD_H(d0, d1, tokv) { const u32x4* hp_ = (const u32x4*)(a.Hb + (size_t)(tokv) * DM + hoff); d0 = hp_[0]; d1 = hp_[1]; }
    ids_load(idE, a.EX, run_token(0, k, nloc, wid), rg);
    ids_load(idO, a.EX, run_token(1, k, nloc, wid), rg);
    rows_lo(rA, idE, a.U8, loff); LOAD_H(hE0, hE1, run_token(0, k, nloc, wid)); rows_hi(rB, idE, a.U8, loff);
#pragma unroll 1
    for (int n = 0; n < N; n += 2) {
        const int t0 = run_token(n, k, nloc, wid), t1 = run_token(n + 1, k, nloc, wid);
        const int t2 = run_token((n + 2 < N) ? n + 2 : N - 1, k, nloc, wid), t3 = run_token((n + 3 < N) ? n + 3 : N - 1, k, nloc, wid);
        {
            f2_t h[8]; float p[16];
            unpack_h(h, hE0, hE1);
            dots8(p, rA, h);
            rows_lo(rA, idO, a.U8, loff); LOAD_H(hO0, hO1, t1);
            dots8(p + 8, rB, h);
            rows_hi(rB, idO, a.U8, loff);
            ids_load(idE, a.EX, t2, rg);
            peerU_finish(a, p, t0, s, lane);
        }
        {
            f2_t h[8]; float p[16];
            unpack_h(h, hO0, hO1);
            dots8(p, rA, h);
            rows_lo(rA, idE, a.U8, loff); LOAD_H(hE0, hE1, t2);
            dots8(p + 8, rB, h);
            rows_hi(rB, idE, a.U8, loff);
            ids_load(idO, a.EX, t3, rg);
            peerU_finish(a, p, t1, s, lane);
        }
    }
#undef LOAD_H
}

DI void peerR_tile(const PSArgs& a, int tile, int wid) {
    const int tid = get_tid(wid);
    const int lane = tid & 63;
#pragma unroll 1
    for (int ti = 0; ti < 8; ++ti) {
        const int tok = tile * 64 + wid * 8 + ti;
        float d0 = 0.f, d1 = 0.f;
#pragma unroll
        for (int x = 0; x < NUSL; ++x) { const float2 v = *(const float2*)(a.PD + ((size_t)x * NTOK + tok) * 128 + 2 * lane); d0 += v.x; d1 += v.y; }
        const unsigned exw = *(const unsigned*)(a.EX + (size_t)tok * 128 + 2 * lane);
        const int2 ex = make_int2((int)(exw & 0xFFFFu), (int)(exw >> 16));
        const float2 gt = *(const float2*)(a.GT + (size_t)tok * 128 + 2 * lane);
        const float rs = a.RSTD[tok];
        float2 o;
        o.x = gelu_exact(d0 * a.SU[ex.x] * rs) * gt.x * a.SV[ex.x];
        o.y = gelu_exact(d1 * a.SU[ex.y] * rs) * gt.y * a.SV[ex.y];
        *(unsigned*)(a.COEF + (size_t)tok * 128 + 2 * lane) = pack_bf2(o.x, o.y);
    }
}

struct Cf16 { u32x4 a, b; };
DI void cf_load(Cf16& q, const bf16_t* COEF, int tok, int rg) { const u32x4* p = (const u32x4*)(COEF + (size_t)tok * 128 + rg * 16); q.a = p[0]; q.b = p[1]; }
DI void axpy8(f2_t (&acc)[8], const u32x4 (&r)[8], const u32x4& c) {
    row_axpy8p(acc, r[0], bf_lo(c.x)); row_axpy8p(acc, r[1], bf_hi(c.x)); __builtin_amdgcn_sched_barrier(0);
    row_axpy8p(acc, r[2], bf_lo(c.y)); row_axpy8p(acc, r[3], bf_hi(c.y)); __builtin_amdgcn_sched_barrier(0);
    row_axpy8p(acc, r[4], bf_lo(c.z)); row_axpy8p(acc, r[5], bf_hi(c.z)); __builtin_amdgcn_sched_barrier(0);
    row_axpy8p(acc, r[6], bf_lo(c.w)); row_axpy8p(acc, r[7], bf_hi(c.w)); __builtin_amdgcn_sched_barrier(0);
}
DI void peerV_finish(const PSArgs& a, f2_t (&acc)[8], float2 xv, int tok, int s, int lane) {
    const int rg = lane >> 3, pc = lane & 7;
    const bool r2 = rg & 4, r1 = rg & 2, r0 = rg & 1;
    f2_t q4[4], q2[2], q1;
#pragma unroll
    for (int k = 0; k < 4; ++k) {
        const f2_t keep = r2 ? acc[k + 4] : acc[k], send = r2 ? acc[k] : acc[k + 4];
        q4[k] = (f2_t){keep.x + shx<32>(send.x, lane), keep.y + shx<32>(send.y, lane)};
    }
#pragma unroll
    for (int k = 0; k < 2; ++k) {
        const f2_t keep = r1 ? q4[k + 2] : q4[k], send = r1 ? q4[k] : q4[k + 2];
        q2[k] = (f2_t){keep.x + shx<16>(send.x, lane), keep.y + shx<16>(send.y, lane)};
    }
    {
        const f2_t keep = r0 ? q2[1] : q2[0], send = r0 ? q2[0] : q2[1];
        q1 = (f2_t){keep.x + shx<8>(send.x, lane), keep.y + shx<8>(send.y, lane)};
    }
    xv.x += q1.x; xv.y += q1.y;
    *(float2*)(a.Xout + (size_t)tok * DM + s * 128 + 16 * pc + 2 * rg) = xv;
}

DI void peerV_run(const PSArgs& a, int s, int k, int nloc, int wid) {
    const int tid = get_tid(wid);
    const int lane = tid & 63, rg = lane >> 3, pc = lane & 7;
    const unsigned loff = (unsigned)(s * (NEXP * 128) + pc * 16);
    const int N = 8 * ((NTOK / 64 - k + nloc - 1) / nloc);
    Ids16 idE, idO; Cf16 cfE, cfO; float2 xE, xO;
    u32x4 rA[8], rB[8];
#define LOAD_X(x_, tokv) { x_ = *(const float2*)(a.Xin + (size_t)(tokv) * DM + s * 128 + 16 * pc + 2 * rg); }
    ids_load(idE, a.EX, run_token(0, k, nloc, wid), rg);
    ids_load(idO, a.EX, run_token(1, k, nloc, wid), rg);
    rows_lo(rA, idE, a.V8, loff); cf_load(cfE, a.COEF, run_token(0, k, nloc, wid), rg); rows_hi(rB, idE, a.V8, loff); LOAD_X(xE, run_token(0, k, nloc, wid));
#pragma unroll 1
    for (int n = 0; n < N; n += 2) {
        const int t0 = run_token(n, k, nloc, wid), t1 = run_token(n + 1, k, nloc, wid);
        const int t2 = run_token((n + 2 < N) ? n + 2 : N - 1, k, nloc, wid), t3 = run_token((n + 3 < N) ? n + 3 : N - 1, k, nloc, wid);
        {
            f2_t acc[8];
#pragma unroll
            for (int i = 0; i < 8; ++i) acc[i] = (f2_t){0.f, 0.f};
            axpy8(acc, rA, cfE.a);
            rows_lo(rA, idO, a.V8, loff); cf_load(cfO, a.COEF, t1, rg);
            axpy8(acc, rB, cfE.b);
            rows_hi(rB, idO, a.V8, loff); LOAD_X(xO, t1);
            ids_load(idE, a.EX, t2, rg);
            peerV_finish(a, acc, xE, t0, s, lane);
        }
        {
            f2_t acc[8];
#pragma unroll
            for (int i = 0; i < 8; ++i) acc[i] = (f2_t){0.f, 0.f};
            axpy8(acc, rA, cfO.a);
            rows_lo(rA, idE, a.V8, loff); cf_load(cfE, a.COEF, t2, rg);
            axpy8(acc, rB, cfO.b);
            rows_hi(rB, idE, a.V8, loff); LOAD_X(xE, t2);
            ids_load(idO, a.EX, t3, rg);
            peerV_finish(a, acc, xO, t1, s, lane);
        }
    }
#undef LOAD_X
}

DI void final_norm_tile(float* X, const float* __restrict__ g, int tile, int wid) {
    const int tid = get_tid(wid);
    const int lane = tid & 63;
    const float* gf = g + lane * 16;
    const float4 g0 = *(const float4*)gf, g1 = *(const float4*)(gf + 4), g2 = *(const float4*)(gf + 8), g3 = *(const float4*)(gf + 12);
#pragma unroll 1
    for (int ti = 0; ti < 8; ++ti) {
        float* xp = X + (size_t)(tile * 64 + wid * 8 + ti) * DM + lane * 16;
        float4 x0 = *(const float4*)xp, x1 = *(const float4*)(xp + 4), x2 = *(const float4*)(xp + 8), x3 = *(const float4*)(xp + 12);
        float ss = x0.x * x0.x + x0.y * x0.y + x0.z * x0.z + x0.w * x0.w + x1.x * x1.x + x1.y * x1.y + x1.z * x1.z + x1.w * x1.w
                 + x2.x * x2.x + x2.y * x2.y + x2.z * x2.z + x2.w * x2.w + x3.x * x3.x + x3.y * x3.y + x3.z * x3.z + x3.w * x3.w;
        ss = wave_sum(ss, lane);
        const float rf = rsqrtf(ss * (1.f / 1024.f) + 1e-6f);
        x0.x *= rf * g0.x; x0.y *= rf * g0.y; x0.z *= rf * g0.z; x0.w *= rf * g0.w; x1.x *= rf * g1.x; x1.y *= rf * g1.y; x1.z *= rf * g1.z; x1.w *= rf * g1.w;
        x2.x *= rf * g2.x; x2.y *= rf * g2.y; x2.z *= rf * g2.z; x2.w *= rf * g2.w; x3.x *= rf * g3.x; x3.y *= rf * g3.y; x3.z *= rf * g3.z; x3.w *= rf * g3.w;
        *(float4*)xp = x0; *(float4*)(xp + 4) = x1; *(float4*)(xp + 8) = x2; *(float4*)(xp + 12) = x3;
    }
}

typedef unsigned char fp4x2_t;
DI void conv_row_fp4_one(float4 v0, float4 v1, float4 v2, float4 v3, fp4x2_t* __restrict__ dst, float* __restrict__ scales, int nrows, int row, int lane) {
    float m = fmaxf(fmaxf(fmaxf(fabsf(v0.x), fabsf(v0.y)), fmaxf(fabsf(v0.z), fabsf(v0.w))), fmaxf(fmaxf(fabsf(v1.x), fabsf(v1.y)), fmaxf(fabsf(v1.z), fabsf(v1.w))));
    m = fmaxf(m, fmaxf(fmaxf(fmaxf(fabsf(v2.x), fabsf(v2.y)), fmaxf(fabsf(v2.z), fabsf(v2.w))), fmaxf(fmaxf(fabsf(v3.x), fabsf(v3.y)), fmaxf(fabsf(v3.z), fabsf(v3.w)))));
    m = fmaxf(m, shx<1>(m, lane)); m = fmaxf(m, shx<2>(m, lane)); m = fmaxf(m, shx<4>(m, lane)); m = fmaxf(m, shx<8>(m, lane)); m = fmaxf(m, shx<16>(m, lane)); m = fmaxf(m, shx<32>(m, lane));
    const float sc = (m > 0.f) ? m * (1.f / 6.f) : 1.f;
    const float inv = 1.f / sc;
    unsigned d0 = 0u, d1 = 0u;
    d0 = __builtin_amdgcn_cvt_scalef32_pk_fp4_f32(d0, v0.x * inv, v0.y * inv, 1.0f, 0); d0 = __builtin_amdgcn_cvt_scalef32_pk_fp4_f32(d0, v0.z * inv, v0.w * inv, 1.0f, 1);
    d0 = __builtin_amdgcn_cvt_scalef32_pk_fp4_f32(d0, v1.x * inv, v1.y * inv, 1.0f, 2); d0 = __builtin_amdgcn_cvt_scalef32_pk_fp4_f32(d0, v1.z * inv, v1.w * inv, 1.0f, 3);
    d1 = __builtin_amdgcn_cvt_scalef32_pk_fp4_f32(d1, v2.x * inv, v2.y * inv, 1.0f, 0); d1 = __builtin_amdgcn_cvt_scalef32_pk_fp4_f32(d1, v2.z * inv, v2.w * inv, 1.0f, 1);
    d1 = __builtin_amdgcn_cvt_scalef32_pk_fp4_f32(d1, v3.x * inv, v3.y * inv, 1.0f, 2); d1 = __builtin_amdgcn_cvt_scalef32_pk_fp4_f32(d1, v3.z * inv, v3.w * inv, 1.0f, 3);
    *(uint2*)(dst + ((size_t)(lane >> 4) * nrows + row) * 128 + (lane & 15) * 8) = make_uint2(d0, d1);
    if (lane == 0) scales[row] = sc;
}
DI void conv_rows_fp4(const float* __restrict__ src, fp4x2_t* __restrict__ dst, float* __restrict__ scales, int nrows, int gwave, int nwaves, int lane) {
#pragma unroll 1
    for (int row = gwave; row < nrows; row += 2 * nwaves) {
        const int r1 = min(row + nwaves, nrows - 1);
        const float4* p0 = (const float4*)(src + (size_t)row * DM + lane * 16);
        const float4* p1 = (const float4*)(src + (size_t)r1 * DM + lane * 16);
        const float4 a0 = p0[0], a1 = p0[1], a2 = p0[2], a3 = p0[3];
        const float4 b0 = p1[0], b1 = p1[1], b2 = p1[2], b3 = p1[3];
        conv_row_fp4_one(a0, a1, a2, a3, dst, scales, nrows, row, lane);
        conv_row_fp4_one(b0, b1, b2, b3, dst, scales, nrows, r1, lane);
    }
}

DI void axpy8w4(f2_t (&acc)[16], unsigned w, int base, const f2_t& c2) {
    acc[base + 0] = __builtin_elementwise_fma(c2, __builtin_amdgcn_cvt_scalef32_pk_f32_fp4(w, 1.0f, 0), acc[base + 0]);
    acc[base + 1] = __builtin_elementwise_fma(c2, __builtin_amdgcn_cvt_scalef32_pk_f32_fp4(w, 1.0f, 1), acc[base + 1]);
    acc[base + 2] = __builtin_elementwise_fma(c2, __builtin_amdgcn_cvt_scalef32_pk_f32_fp4(w, 1.0f, 2), acc[base + 2]);
    acc[base + 3] = __builtin_elementwise_fma(c2, __builtin_amdgcn_cvt_scalef32_pk_f32_fp4(w, 1.0f, 3), acc[base + 3]);
}
DI void row_axpy32(f2_t (&acc)[16], const u32x4& r, float c) {
    const f2_t c2 = {c, c};
    axpy8w4(acc, r.x, 0, c2); axpy8w4(acc, r.y, 4, c2); axpy8w4(acc, r.z, 8, c2); axpy8w4(acc, r.w, 12, c2);
}
DI void axpy8_4(f2_t (&acc)[16], const u32x4 (&r)[8], const u32x4& c) {
    row_axpy32(acc, r[0], bf_lo(c.x)); __builtin_amdgcn_sched_barrier(0); row_axpy32(acc, r[1], bf_hi(c.x)); __builtin_amdgcn_sched_barrier(0);
    row_axpy32(acc, r[2], bf_lo(c.y)); __builtin_amdgcn_sched_barrier(0); row_axpy32(acc, r[3], bf_hi(c.y)); __builtin_amdgcn_sched_barrier(0);
    row_axpy32(acc, r[4], bf_lo(c.z)); __builtin_amdgcn_sched_barrier(0); row_axpy32(acc, r[5], bf_hi(c.z)); __builtin_amdgcn_sched_barrier(0);
    row_axpy32(acc, r[6], bf_lo(c.w)); __builtin_amdgcn_sched_barrier(0); row_axpy32(acc, r[7], bf_hi(c.w)); __builtin_amdgcn_sched_barrier(0);
}
DI void peerV4_finish(const PSArgs& a, f2_t (&acc)[16], float4 xv, int tok, int s4, int lane) {
    const int rg = lane >> 3, pc = lane & 7;
    const bool r2 = rg & 4, r1 = rg & 2, r0 = rg & 1;
    f2_t q8[8], q4[4], q2[2];
#pragma unroll
    for (int k = 0; k < 8; ++k) {
        const f2_t keep = r2 ? acc[k + 8] : acc[k], send = r2 ? acc[k] : acc[k + 8];
        q8[k] = (f2_t){keep.x + shx<32>(send.x, lane), keep.y + shx<32>(send.y, lane)};
    }
#pragma unroll
    for (int k = 0; k < 4; ++k) {
        const f2_t keep = r1 ? q8[k + 4] : q8[k], send = r1 ? q8[k] : q8[k + 4];
        q4[k] = (f2_t){keep.x + shx<16>(send.x, lane), keep.y + shx<16>(send.y, lane)};
    }
#pragma unroll
    for (int k = 0; k < 2; ++k) {
        const f2_t keep = r0 ? q4[k + 2] : q4[k], send = r0 ? q4[k] : q4[k + 2];
        q2[k] = (f2_t){keep.x + shx<8>(send.x, lane), keep.y + shx<8>(send.y, lane)};
    }
    xv.x += q2[0].x; xv.y += q2[0].y; xv.z += q2[1].x; xv.w += q2[1].y;
    *(float4*)(a.Xout + (size_t)tok * DM + s4 * 256 + 32 * pc + 4 * rg) = xv;
}
DI int run_token2(int n, int k, int nloc, int wid, int th) { return (2 * (k + (n >> 3) * nloc) + th) * 64 + wid * 8 + (n & 7); }

DI void peerV4_run(const PSArgs& a, const fp4x2_t* V4, int s4, int th, int k, int nloc, int wid) {
    const int tid = get_tid(wid);
    const int lane = tid & 63, rg = lane >> 3, pc = lane & 7;
    const unsigned loff = (unsigned)(s4 * (NEXP * 128) + pc * 16);
    const int N = 8 * ((NTOK / 128 - k + nloc - 1) / nloc);
    if (N <= 0) return;
    Ids16 idE, idO; Cf16 cfE, cfO; float4 xE, xO;
    u32x4 rA[8], rB[8];
    const fp8_t* tab = (const fp8_t*)V4;
#define LOAD_X4(x_, tokv) { x_ = *(const float4*)(a.Xin + (size_t)(tokv) * DM + s4 * 256 + 32 * pc + 4 * rg); }
    ids_load(idE, a.EX, run_token2(0, k, nloc, wid, th), rg);
    ids_load(idO, a.EX, run_token2(1, k, nloc, wid, th), rg);
    rows_lo(rA, idE, tab, loff); cf_load(cfE, a.COEF, run_token2(0, k, nloc, wid, th), rg); rows_hi(rB, idE, tab, loff); LOAD_X4(xE, run_token2(0, k, nloc, wid, th));
#pragma unroll 1
    for (int n = 0; n < N; n += 2) {
        const int t0 = run_token2(n, k, nloc, wid, th), t1 = run_token2(n + 1, k, nloc, wid, th);
        const int t2 = run_token2((n + 2 < N) ? n + 2 : N - 1, k, nloc, wid, th), t3 = run_token2((n + 3 < N) ? n + 3 : N - 1, k, nloc, wid, th);
        {
            f2_t acc[16];
#pragma unroll
            for (int i = 0; i < 16; ++i) acc[i] = (f2_t){0.f, 0.f};
            axpy8_4(acc, rA, cfE.a);
            rows_lo(rA, idO, tab, loff); cf_load(cfO, a.COEF, t1, rg);
            axpy8_4(acc, rB, cfE.b);
            rows_hi(rB, idO, tab, loff); LOAD_X4(xO, t1);
            ids_load(idE, a.EX, t2, rg);
            peerV4_finish(a, acc, xE, t0, s4, lane);
        }
        {
            f2_t acc[16];
#pragma unroll
            for (int i = 0; i < 16; ++i) acc[i] = (f2_t){0.f, 0.f};
            axpy8_4(acc, rA, cfO.a);
            rows_lo(rA, idE, tab, loff); cf_load(cfE, a.COEF, t2, rg);
            axpy8_4(acc, rB, cfO.b);
            rows_hi(rB, idE, tab, loff); LOAD_X4(xE, t2);
            ids_load(idO, a.EX, t3, rg);
            peerV4_finish(a, acc, xO, t1, s4, lane);
        }
    }
#undef LOAD_X4
}

DI void conv_rows_fp4g(const float* __restrict__ src, const float* __restrict__ gain, fp4x2_t* __restrict__ dst, float* __restrict__ scales,
                       int nrows, int gwave, int nwaves, int lane) {
    const float4* g = (const float4*)(gain + lane * 16);
    const float4 g0 = g[0], g1 = g[1], g2 = g[2], g3 = g[3];
#pragma unroll 1
    for (int row = gwave; row < nrows; row += 2 * nwaves) {
        const int r1 = min(row + nwaves, nrows - 1);
        const float4* p0 = (const float4*)(src + (size_t)row * DM + lane * 16);
        const float4* p1 = (const float4*)(src + (size_t)r1 * DM + lane * 16);
        float4 a0 = p0[0], a1 = p0[1], a2 = p0[2], a3 = p0[3];
        float4 b0 = p1[0], b1 = p1[1], b2 = p1[2], b3 = p1[3];
        a0.x *= g0.x; a0.y *= g0.y; a0.z *= g0.z; a0.w *= g0.w; a1.x *= g1.x; a1.y *= g1.y; a1.z *= g1.z; a1.w *= g1.w;
        a2.x *= g2.x; a2.y *= g2.y; a2.z *= g2.z; a2.w *= g2.w; a3.x *= g3.x; a3.y *= g3.y; a3.z *= g3.z; a3.w *= g3.w;
        b0.x *= g0.x; b0.y *= g0.y; b0.z *= g0.z; b0.w *= g0.w; b1.x *= g1.x; b1.y *= g1.y; b1.z *= g1.z; b1.w *= g1.w;
        b2.x *= g2.x; b2.y *= g2.y; b2.z *= g2.z; b2.w *= g2.w; b3.x *= g3.x; b3.y *= g3.y; b3.z *= g3.z; b3.w *= g3.w;
        conv_row_fp4_one(a0, a1, a2, a3, dst, scales, nrows, row, lane);
        conv_row_fp4_one(b0, b1, b2, b3, dst, scales, nrows, r1, lane);
    }
}
DI void dot8w4(unsigned w, const f2_t (&h)[16], int base, f2_t& s2) {
    s2 = __builtin_elementwise_fma(__builtin_amdgcn_cvt_scalef32_pk_f32_fp4(w, 1.0f, 0), h[base + 0], s2);
    s2 = __builtin_elementwise_fma(__builtin_amdgcn_cvt_scalef32_pk_f32_fp4(w, 1.0f, 1), h[base + 1], s2);
    s2 = __builtin_elementwise_fma(__builtin_amdgcn_cvt_scalef32_pk_f32_fp4(w, 1.0f, 2), h[base + 2], s2);
    s2 = __builtin_elementwise_fma(__builtin_amdgcn_cvt_scalef32_pk_f32_fp4(w, 1.0f, 3), h[base + 3], s2);
}
DI float row_dot32(const u32x4& r, const f2_t (&h)[16]) {
    f2_t s2 = {0.f, 0.f};
    dot8w4(r.x, h, 0, s2); dot8w4(r.y, h, 4, s2); dot8w4(r.z, h, 8, s2); dot8w4(r.w, h, 12, s2);
    return s2.x + s2.y;
}
DI void dots8_4(float* p, const u32x4 (&r)[8], const f2_t (&h)[16]) {
#pragma unroll
    for (int i = 0; i < 8; ++i) { p[i] = row_dot32(r[i], h); __builtin_amdgcn_sched_barrier(0); }
}
struct H32 { u32x4 a, b, c, d; };
DI void h32_load(H32& q, const bf16_t* Hb, int tok, int hoff) { const u32x4* p = (const u32x4*)(Hb + (size_t)tok * DM + hoff); q.a = p[0]; q.b = p[1]; q.c = p[2]; q.d = p[3]; }
DI void h32_unpack(f2_t (&h)[16], const H32& q) {
    h[0] = (f2_t){bf_lo(q.a.x), bf_hi(q.a.x)}; h[1] = (f2_t){bf_lo(q.a.y), bf_hi(q.a.y)}; h[2] = (f2_t){bf_lo(q.a.z), bf_hi(q.a.z)}; h[3] = (f2_t){bf_lo(q.a.w), bf_hi(q.a.w)};
    h[4] = (f2_t){bf_lo(q.b.x), bf_hi(q.b.x)}; h[5] = (f2_t){bf_lo(q.b.y), bf_hi(q.b.y)}; h[6] = (f2_t){bf_lo(q.b.z), bf_hi(q.b.z)}; h[7] = (f2_t){bf_lo(q.b.w), bf_hi(q.b.w)};
    h[8] = (f2_t){bf_lo(q.c.x), bf_hi(q.c.x)}; h[9] = (f2_t){bf_lo(q.c.y), bf_hi(q.c.y)}; h[10] = (f2_t){bf_lo(q.c.z), bf_hi(q.c.z)}; h[11] = (f2_t){bf_lo(q.c.w), bf_hi(q.c.w)};
    h[12] = (f2_t){bf_lo(q.d.x), bf_hi(q.d.x)}; h[13] = (f2_t){bf_lo(q.d.y), bf_hi(q.d.y)}; h[14] = (f2_t){bf_lo(q.d.z), bf_hi(q.d.z)}; h[15] = (f2_t){bf_lo(q.d.w), bf_hi(q.d.w)};
}
DI void peerU4_run(const PSArgs& a, const fp4x2_t* U4, int s4, int th, int k, int nloc, int wid) {
    const int tid = get_tid(wid);
    const int lane = tid & 63, rg = lane >> 3, pc = lane & 7;
    const unsigned loff = (unsigned)(s4 * (NEXP * 128) + pc * 16);
    const int hoff = s4 * 256 + pc * 32;
    const int N = 8 * ((NTOK / 128 - k + nloc - 1) / nloc);
    if (N <= 0) return;
    Ids16 idE, idO; H32 hE, hO;
    u32x4 rA[8], rB[8];
    const fp8_t* tab = (const fp8_t*)U4;
    ids_load(idE, a.EX, run_token2(0, k, nloc, wid, th), rg);
    ids_load(idO, a.EX, run_token2(1, k, nloc, wid, th), rg);
    rows_lo(rA, idE, tab, loff); h32_load(hE, a.Hb, run_token2(0, k, nloc, wid, th), hoff); rows_hi(rB, idE, tab, loff);
#pragma unroll 1
    for (int n = 0; n < N; n += 2) {
        const int t0 = run_token2(n, k, nloc, wid, th), t1 = run_token2(n + 1, k, nloc, wid, th);
        const int t2 = run_token2((n + 2 < N) ? n + 2 : N - 1, k, nloc, wid, th), t3 = run_token2((n + 3 < N) ? n + 3 : N - 1, k, nloc, wid, th);
        {
            f2_t h[16]; float p[16];
            h32_unpack(h, hE);
            dots8_4(p, rA, h);
            rows_lo(rA, idO, tab, loff); h32_load(hO, a.Hb, t1, hoff);
            dots8_4(p + 8, rB, h);
            rows_hi(rB, idO, tab, loff);
            ids_load(idE, a.EX, t2, rg);
            peerU_finish(a, p, t0, s4, lane);
        }
        {
            f2_t h[16]; float p[16];
            h32_unpack(h, hO);
            dots8_4(p, rA, h);
            rows_lo(rA, idE, tab, loff); h32_load(hE, a.Hb, t2, hoff);
            dots8_4(p + 8, rB, h);
            rows_hi(rB, idE, tab, loff);
            ids_load(idO, a.EX, t3, rg);
            peerU_finish(a, p, t1, s4, lane);
        }
    }
}
struct MegaArgs {
    const float* x; const float* a_re; const float* a_im; const float* log_dt; const float* b_re; const float* b_im; const float* c_re;
    const float* c_im; const float* d_skip; const float* b_glu; const float* pool_scale; const float* u_exp; const float* v_exp;
    const float* norm_final;
    PrepW pw;
    float* X; bf16_t* U; bf16_t* YPRE; bf16_t* G1; bf16_t* A2; bf16_t* Hb; bf16_t* Qb; unsigned short* EX; float* GT; float* RSTD;
    char* KT; bf16x8* WST; bf16x8* CCAR; float* ABT; fp8_t* U8; fp4x2_t* U4; fp4x2_t* V4; float* SU; float* SV; float* PD; bf16_t* COEF;
    unsigned* bar;
    int coop_probe; int pad_;
};

#ifndef REP_P0
#define REP_P0 1
#endif
#ifndef REP_PA
#define REP_PA 1
#endif
#ifndef REP_PB
#define REP_PB 1
#endif
#ifndef REP_C1
#define REP_C1 1
#endif
#ifndef REP_C2
#define REP_C2 1
#endif
#ifndef REP_U
#define REP_U 1
#endif
#ifndef REP_R
#define REP_R 1
#endif
#ifndef REP_V
#define REP_V 1
#endif
#ifndef REP_BAR
#define REP_BAR 1
#endif
#define XBAR() do { for (int rb_ = 0; rb_ < REP_BAR; ++rb_) xcd_barrier(xb, wid); } while (0)
__global__ void __launch_bounds__(NTHR) mega_kernel(MegaArgs a) {
    __shared__ __attribute__((aligned(16))) char smem[PB_BYTES];
    __shared__ uint4 xb_words;
    cg::grid_group grid = cg::this_grid();
    const int nblk = gridDim.x;
    const int wid = __builtin_amdgcn_readfirstlane(threadIdx.x >> 6);
    if (get_tid(wid) == 0) xb_words = make_uint4(0u, 0u, 0u, 0u);
    __syncthreads();
    const XcdBarrier xb = xcd_barrier_post(a.bar, (volatile LAS unsigned*)&xb_words, get_tid(wid));
    for (int rep = 0; rep < REP_P0; ++rep) {
        const size_t gtid = (size_t)blockIdx.x * NTHR + get_tid(wid), gs = (size_t)nblk * NTHR;
        for (int it = blockIdx.x; it < 256; it += nblk)
            prep_s5_item(it >> 2, it & 3, a.a_re, a.a_im, a.log_dt, a.b_re, a.b_im, a.c_re, a.c_im, a.d_skip, a.KT, a.WST, a.CCAR, a.ABT, smem, wid);
        prep_weights(a.pw, gtid, gs);
        for (int l = 0; l < 2; ++l) {
            conv_kfrag(a.pw.k1 + (size_t)l * 128 * 128, a.pw.wfk1 + (size_t)l * (128 * 128 / 8), gtid, gs);
            conv_kfrag(a.pw.k2 + (size_t)l * 128 * 128, a.pw.wfk2 + (size_t)l * (128 * 128 / 8), gtid, gs);
        }
        {
            int tid = get_tid(wid);
            const int gwave = blockIdx.x * 8 + (tid >> 6), nwaves = nblk * 8, lane = tid & 63;
#pragma unroll 1
            for (int l = 0; l < 2; ++l) {
#if U_FP4
                conv_rows_fp4g(a.u_exp + (size_t)l * NEXP * DM, a.pw.norm_ffn + l * DM, a.U4 + (size_t)l * NEXP * (DM / 2), a.SU + l * NEXP, NEXP, gwave, nwaves, lane);
#else
                conv_rows_fp8(a.u_exp + (size_t)l * NEXP * DM, a.pw.norm_ffn + l * DM, a.U8 + (size_t)l * NEXP * DM, a.SU + l * NEXP, NEXP, gwave, nwaves, lane);
#endif
                conv_rows_fp4(a.v_exp + (size_t)l * NEXP * DM, a.V4 + (size_t)l * NEXP * (DM / 2), a.SV + l * NEXP, NEXP, gwave, nwaves, lane);
            }
        }
    }
    XBAR();
    if (a.coop_probe) grid.sync();
    __shared__ int sched[4];
    if (get_tid(wid) == 0) {
        int nx = 0, myj = 0, nloc = 1;
        for (unsigned j = 0; j < 16; ++j) {
            const unsigned cj = xb_ld(&a.bar[XB_XCNT(j)]);
            if (j == xb.x) { myj = nx; nloc = (int)cj; }
            nx += (cj > 0u) ? 1 : 0;
        }
        sched[0] = (int)xb.st[2]; sched[1] = nloc > 0 ? nloc : 1; sched[2] = myj; sched[3] = nx > 0 ? nx : 1;
    }
    __syncthreads();
    const int s_rank = sched[0], s_nloc = sched[1], s_myj = sched[2], s_nx = sched[3];
#pragma unroll 1
    for (int l = 0; l < 2; ++l) {
        const float* xin = (l == 0) ? a.x : a.X;
        if (l == 0) {
            for (int rep = 0; rep < REP_PA; ++rep)
            for (int tile = blockIdx.x; tile < NTOK / 64; tile += nblk) phaseA_tile(xin, a.pw.wfin, a.U, tile, smem, wid);
        }
        XBAR();
        bf16_t* Ul = a.U + (size_t)l * NTOK * DM;
        for (int rep = 0; rep < REP_PB; ++rep)
        for (int tile = blockIdx.x; tile < 256; tile += nblk)
            phaseB_tile(Ul, a.KT + (size_t)l * 32 * KT_BYTES, a.WST + (size_t)l * 32 * WST_FRAGS, a.CCAR + (size_t)l * 32 * CCAR_FRAGS, a.ABT + l * 32 * 128, a.YPRE, tile, smem, wid);
        XBAR();
        PCArgs pa; pa.U = Ul; pa.YPRE = a.YPRE; pa.G1 = a.G1; pa.A2 = a.A2; pa.Xin = xin; pa.Xout = a.X; pa.Xdummy = (float*)a.Qb; pa.Hb = a.Hb; pa.RSTD = a.RSTD;
        pa.wfglu = a.pw.wfglu + (size_t)l * (512 * 512 / 8); pa.b_glu = a.b_glu + l * 512; pa.wfpool = a.pw.wfpool + (size_t)l * 4 * (128 * 128 / 8);
        pa.pool_scale = a.pool_scale + l * 512; pa.wfout = a.pw.wfout + (size_t)l * (DM * DM / 8);
        PRArgs pr; pr.Hb = a.Hb; pr.RSTD = a.RSTD; pr.wfq = a.pw.wfq + (size_t)l * (DM * 2048 / 8); pr.kf1 = a.pw.wfk1 + (size_t)l * (128 * 128 / 8);
        pr.kf2 = a.pw.wfk2 + (size_t)l * (128 * 128 / 8); pr.EX = a.EX; pr.GT = a.GT;
        for (int tile = blockIdx.x; tile < NTOK / 64; tile += nblk) {
            for (int rep = 1; rep < REP_C1; ++rep) { PCArgs pa2 = pa; pa2.Xout = (float*)a.Qb; phaseC1_tile(pa2, tile, smem, wid); }
            phaseC1_tile(pa, tile, smem, wid);
            for (int rep = 0; rep < REP_C2; ++rep) phaseC2_tile(pr, tile, smem, wid);
        }
        XBAR();
        PSArgs ps; ps.Hb = a.Hb; ps.RSTD = a.RSTD; ps.EX = a.EX; ps.GT = a.GT; ps.U8 = a.U8 + (size_t)l * NEXP * DM; ps.V8 = nullptr;
        ps.SU = a.SU + l * NEXP; ps.SV = a.SV + l * NEXP; ps.PD = a.PD; ps.COEF = a.COEF; ps.Xin = a.X; ps.Xout = a.X;
        for (int rep = 0; rep < REP_U; ++rep) {
#if U_FP4
            for (int v = s_myj; v < 8; v += s_nx) peerU4_run(ps, a.U4 + (size_t)l * NEXP * (DM / 2), v & 3, v >> 2, s_rank, s_nloc, wid);
#else
            for (int s = s_myj; s < 8; s += s_nx) peerU_run(ps, s, s_rank, s_nloc, wid);
#endif
        }
        XBAR();
        for (int rep = 0; rep < REP_R; ++rep)
        for (int tile = blockIdx.x; tile < NTOK / 64; tile += nblk) peerR_tile(ps, tile, wid);
        XBAR();
        for (int rep = 1; rep < REP_V; ++rep) { PSArgs ps2 = ps; ps2.Xout = (float*)a.Qb; for (int v = s_myj; v < 8; v += s_nx) peerV4_run(ps2, a.V4 + (size_t)l * NEXP * (DM / 2), v & 3, v >> 2, s_rank, s_nloc, wid); }
        for (int v = s_myj; v < 8; v += s_nx) peerV4_run(ps, a.V4 + (size_t)l * NEXP * (DM / 2), v & 3, v >> 2, s_rank, s_nloc, wid);
        XBAR();
        if (l == 0) {
            for (int rep = 0; rep < REP_PA; ++rep)
            for (int tile = blockIdx.x; tile < NTOK / 64; tile += nblk) phaseA_tile(a.X, a.pw.wfin + (size_t)(DM * DM / 8), a.U + (size_t)NTOK * DM, tile, smem, wid);
        } else {
            for (int tile = blockIdx.x; tile < NTOK / 64; tile += nblk) final_norm_tile(a.X, a.norm_final, tile, wid);
        }
    }
}

extern "C" void kernel_launch(void* const* d_in, const int* in_sizes, int n_in, void* d_out, int out_size, void* d_ws, size_t ws_size,
                              hipStream_t stream) {
    char* wsb = (char*)d_ws;
    size_t off = 0;
    auto take = [&](size_t bytes) { char* p = wsb + off; off += (bytes + 255) & ~(size_t)255; return p; };
    MegaArgs a;
    memset(&a, 0, sizeof(a));
    a.x = (const float*)d_in[0];
    a.pw.norm_mix = (const float*)d_in[1]; a.pw.w_in = (const float*)d_in[2];
    a.a_re = (const float*)d_in[3]; a.a_im = (const float*)d_in[4]; a.log_dt = (const float*)d_in[5];
    a.b_re = (const float*)d_in[6]; a.b_im = (const float*)d_in[7]; a.c_re = (const float*)d_in[8]; a.c_im = (const float*)d_in[9];
    a.d_skip = (const float*)d_in[10]; a.pw.w_glu = (const float*)d_in[11]; a.b_glu = (const float*)d_in[12];
    a.pw.w_pool = (const float*)d_in[13]; a.pool_scale = (const float*)d_in[14]; a.pw.g_out_ssm = (const float*)d_in[15];
    a.pw.g_out_pool = (const float*)d_in[16]; a.pw.w_out = (const float*)d_in[17]; a.pw.norm_ffn = (const float*)d_in[18];
    a.pw.w_q = (const float*)d_in[19]; a.pw.k1 = (const float*)d_in[20]; a.pw.k2 = (const float*)d_in[21];
    a.u_exp = (const float*)d_in[22]; a.v_exp = (const float*)d_in[23]; a.norm_final = (const float*)d_in[24];
    a.X = (float*)d_out;
    a.U = (bf16_t*)take((size_t)2 * NTOK * DM * 2);
    a.YPRE = (bf16_t*)take((size_t)NTOK * 512 * 2);
    a.G1 = (bf16_t*)take((size_t)NTOK * 512 * 2);
    a.A2 = (bf16_t*)take((size_t)NTOK * DM * 2);
    a.Hb = (bf16_t*)take((size_t)NTOK * DM * 2);
    a.Qb = (bf16_t*)take((size_t)NTOK * 2048 * 2);
    a.EX = (unsigned short*)take((size_t)NTOK * 128 * 2);
    a.GT = (float*)take((size_t)NTOK * 128 * 4);
    a.RSTD = (float*)take(NTOK * 4);
    a.pw.wfin = (bf16x8*)take((size_t)2 * DM * DM * 2);
    a.pw.wfglu = (bf16x8*)take((size_t)2 * 512 * 512 * 2);
    a.pw.wfpool = (bf16x8*)take((size_t)2 * 4 * 128 * 128 * 2);
    a.pw.wfout = (bf16x8*)take((size_t)2 * DM * DM * 2);
    a.pw.wfq = (bf16x8*)take((size_t)2 * DM * 2048 * 2);
    a.pw.wfk1 = (bf16x8*)take((size_t)2 * 128 * 128 * 2);
    a.pw.wfk2 = (bf16x8*)take((size_t)2 * 128 * 128 * 2);
    a.KT = take((size_t)64 * KT_BYTES);
    a.WST = (bf16x8*)take((size_t)64 * WST_FRAGS * 16);
    a.CCAR = (bf16x8*)take((size_t)64 * CCAR_FRAGS * 16);
    a.ABT = (float*)take(64 * 128 * 4);
    a.U8 = (fp8_t*)take((size_t)2 * NEXP * DM);
    a.V4 = (fp4x2_t*)take((size_t)2 * NEXP * (DM / 2));
    a.U4 = (fp4x2_t*)take((size_t)2 * NEXP * (DM / 2));
    a.SU = (float*)take((size_t)2 * NEXP * 4);
    a.SV = (float*)take((size_t)2 * NEXP * 4);
    a.PD = (float*)take((size_t)8 * NTOK * 128 * 4);
    a.COEF = (bf16_t*)take((size_t)NTOK * 128 * 2);
    a.bar = (unsigned*)take((size_t)XCD_BAR_WORDS * 4);
    hipMemsetAsync(a.bar, 0, (size_t)XCD_BAR_WORDS * 4, stream);

    static int grid_blocks = 0;
    if (!grid_blocks) {
        int dev = 0, cus = 0, per_cu = 0;
        hipGetDevice(&dev);
        hipDeviceGetAttribute(&cus, hipDeviceAttributeMultiprocessorCount, dev);
        hipOccupancyMaxActiveBlocksPerMultiprocessor(&per_cu, mega_kernel, NTHR, 0);
        if (per_cu > 1) per_cu = 1;
        grid_blocks = cus * per_cu;
        if (grid_blocks > 256) grid_blocks = 256;
    }
    void* args[] = {&a};
    hipError_t e = hipLaunchCooperativeKernel((void*)mega_kernel, dim3(grid_blocks), dim3(NTHR), args, 0, stream);
    if (e != hipSuccess) fprintf(stderr, "cooperative launch failed: %s (grid %d)\n", hipGetErrorString(e), grid_blocks);
}
```

```cpp
#include <hip/hip_runtime.h>
#include <hip/hip_cooperative_groups.h>
#include <cstdio>
#include <cstring>
namespace cg = cooperative_groups;
#include <math.h>
#include <stdint.h>

#define NTOK 16384
#define SEQ 2048
#define DM 1024
#define SSMW 512
#define NEXP 16384

__device__ __forceinline__ float gelu_exact(float x) { return 0.5f * x * (1.f + erff(x * 0.70710678118654752f)); }

template <int M> __device__ __forceinline__ int shx_i(int v, int lane) {
    if constexpr (M == 1) return __builtin_amdgcn_mov_dpp(v, 0xB1, 0xF, 0xF, true);
    else if constexpr (M == 2) return __builtin_amdgcn_mov_dpp(v, 0x4E, 0xF, 0xF, true);
    else if constexpr (M < 32) return __builtin_amdgcn_ds_swizzle(v, (M << 10) | 0x1F);
    else return __builtin_amdgcn_ds_bpermute((lane ^ 32) << 2, v);
}
template <int M> __device__ __forceinline__ float shx(float v, int lane) { return __int_as_float(shx_i<M>(__float_as_int(v), lane)); }
__device__ __forceinline__ float wave_sum(float v, int lane) {
    v += shx<1>(v, lane); v += shx<2>(v, lane); v += shx<4>(v, lane); v += shx<8>(v, lane); v += shx<16>(v, lane); v += shx<32>(v, lane);
    return v;
}

__device__ __forceinline__ int get_tid(int wid) {
    int t = wid * 64 + (int)__builtin_amdgcn_mbcnt_hi(~0u, __builtin_amdgcn_mbcnt_lo(~0u, 0u));
    asm volatile("" : "+v"(t));
    return t;
}

#define DI __device__ __forceinline__
typedef __attribute__((ext_vector_type(8))) short bf16x8;
typedef __attribute__((ext_vector_type(16))) float f32x16;
typedef __attribute__((ext_vector_type(2))) __bf16 bf2_t;
typedef __attribute__((ext_vector_type(2))) float f2_t;
typedef unsigned short bf16_t;
typedef __attribute__((ext_vector_type(4))) unsigned u32x4;
typedef __attribute__((ext_vector_type(4))) float f32x4;
typedef const __attribute__((address_space(1))) bf16x8* gwp_t;
#define MFMA32(a, b, c) __builtin_amdgcn_mfma_f32_32x32x16_bf16((a), (b), (c), 0, 0, 0)

DI unsigned pack_bf2(float a, float b) { f2_t v = {a, b}; return __builtin_bit_cast(unsigned, __builtin_convertvector(v, bf2_t)); }
DI float bf_lo(unsigned u) { return __uint_as_float(u << 16); }
DI float bf_hi(unsigned u) { return __uint_as_float(u & 0xffff0000u); }
DI int crow(int reg, int h) { return (reg & 3) + 8 * (reg >> 2) + 4 * h; }

#define SA_STRIDE 272
#define SA_BYTES (64 * SA_STRIDE)
#define NTHR 512

template <bool GAIN>
DI void conv_wfrag(const float* __restrict__ src, int ldk, int ldn, const float* __restrict__ ga, const float* __restrict__ gb, int split,
                   int K, int N, int NTG, bf16x8* __restrict__ dst, size_t gtid, size_t gstride) {
    const int KS = K / 16;
    const size_t total = (size_t)(N / 32) * KS * 64;
    for (size_t item = gtid; item < total; item += gstride) {
        const int lane = (int)(item & 63); const size_t f = item >> 6;
        const int nti = (int)(f % NTG); const size_t f2 = f / NTG;
        const int ks = (int)(f2 % KS), nt = (int)(f2 / KS) * NTG + nti;
        const int r = lane & 31, h = lane >> 5;
        const int n = nt * 32 + r, k0 = ks * 16 + 8 * h;
        float v[8];
#pragma unroll
        for (int j = 0; j < 8; ++j) {
            const int k = k0 + j;
            float g = 1.f;
            if (GAIN) g = (k < split) ? ga[k] : gb[k - split];
            v[j] = src[(size_t)k * ldk + (size_t)n * ldn] * g;
        }
        uint4 o; o.x = pack_bf2(v[0], v[1]); o.y = pack_bf2(v[2], v[3]); o.z = pack_bf2(v[4], v[5]); o.w = pack_bf2(v[6], v[7]);
        *(uint4*)(dst + item) = o;
    }
}

DI void conv_rows_bf16(const float* __restrict__ src, const float* __restrict__ gain, bf16_t* __restrict__ dst, size_t nelem, size_t gtid, size_t gstride) {
    for (size_t i = gtid * 8; i < nelem; i += gstride * 8) {
        float4 a = *(const float4*)(src + i), b = *(const float4*)(src + i + 4);
        if (gain) {
            const int c = (int)(i & 1023);
            float4 g0 = *(const float4*)(gain + c), g1 = *(const float4*)(gain + c + 4);
            a.x *= g0.x; a.y *= g0.y; a.z *= g0.z; a.w *= g0.w; b.x *= g1.x; b.y *= g1.y; b.z *= g1.z; b.w *= g1.w;
        }
        uint4 o; o.x = pack_bf2(a.x, a.y); o.y = pack_bf2(a.z, a.w); o.z = pack_bf2(b.x, b.y); o.w = pack_bf2(b.z, b.w);
        *(uint4*)(dst + i) = o;
    }
}

struct ALoadF32 {
    const float* base; f32x4 v0, v1, v2, v3; float ss; int dofs;
    DI void init(const float* rowbase, int tid) { base = rowbase + (tid & 7) * 16; ss = 0.f; dofs = (tid >> 3) * SA_STRIDE + (tid & 7) * 32; }
    DI void issue(int c) { const f32x4* p = (const f32x4*)(base + c * 128); v0 = p[0]; v1 = p[1]; v2 = p[2]; v3 = p[3]; }
    DI void commit(char* buf) {
        u32x4 o0, o1;
        ss += v0.x * v0.x + v0.y * v0.y + v0.z * v0.z + v0.w * v0.w + v1.x * v1.x + v1.y * v1.y + v1.z * v1.z + v1.w * v1.w
            + v2.x * v2.x + v2.y * v2.y + v2.z * v2.z + v2.w * v2.w + v3.x * v3.x + v3.y * v3.y + v3.z * v3.z + v3.w * v3.w;
        o0.x = pack_bf2(v0.x, v0.y); o0.y = pack_bf2(v0.z, v0.w); o0.z = pack_bf2(v1.x, v1.y); o0.w = pack_bf2(v1.z, v1.w);
        o1.x = pack_bf2(v2.x, v2.y); o1.y = pack_bf2(v2.z, v2.w); o1.z = pack_bf2(v3.x, v3.y); o1.w = pack_bf2(v3.z, v3.w);
        char* d = buf + dofs;
        *(u32x4*)d = o0; *(u32x4*)(d + 16) = o1;
    }
};
struct ALoadBF16 {
    const bf16_t* base; u32x4 v0, v1; int dofs;
    DI void init(const bf16_t* rowbase, int tid) { base = rowbase + (tid & 7) * 16; dofs = (tid >> 3) * SA_STRIDE + (tid & 7) * 32; }
    DI void issue(int c) { const u32x4* p = (const u32x4*)(base + c * 128); v0 = p[0]; v1 = p[1]; }
    DI void commit(char* buf) {
        char* d = buf + dofs;
        *(u32x4*)d = v0; *(u32x4*)(d + 16) = v1;
    }
};

template <int NT, int PF, class AL>
DI void gemm64(f32x16 (&acc)[NT][2], AL& al, const int nchunks, const bf16x8* __restrict__ wf_, char* sA, const int lane) {
    gwp_t wf = (gwp_t)wf_;
    const int r = lane & 31, h = lane >> 5;
    bf16x8 bq[PF][NT];
    al.issue(0);
#pragma unroll
    for (int p = 0; p < PF; ++p)
#pragma unroll
        for (int nt = 0; nt < NT; ++nt) bq[p][nt] = wf[(p * NT + nt) * 64];
    gwp_t wpf = wf + PF * NT * 64;
    al.commit(sA);
    const int kend = nchunks * 8 - PF;
    int kg = 0;
#pragma unroll 1
    for (int c = 0; c < nchunks; ++c) {
        if (c + 1 < nchunks) al.issue(c + 1);
        __syncthreads();
        const char* buf = sA + (c & 1) * SA_BYTES + r * SA_STRIDE + h * 16;
#pragma unroll
        for (int ks = 0; ks < 8; ++ks) {
            const bf16x8 a0 = *(const bf16x8*)(buf + ks * 32);
            const bf16x8 a1 = *(const bf16x8*)(buf + 32 * SA_STRIDE + ks * 32);
#pragma unroll
            for (int nt = 0; nt < NT; ++nt) {
                acc[nt][0] = MFMA32(bq[ks % PF][nt], a0, acc[nt][0]);
                acc[nt][1] = MFMA32(bq[ks % PF][nt], a1, acc[nt][1]);
            }
            if (kg < kend) {
#pragma unroll
                for (int nt = 0; nt < NT; ++nt) bq[ks % PF][nt] = wpf[nt * 64];
            }
            wpf += NT * 64; ++kg;
            asm volatile("" : "+v"(wpf));
        }
        if (c + 1 < nchunks) al.commit(sA + ((c + 1) & 1) * SA_BYTES);
    }
    __syncthreads();
}

template <int NT>
DI void zero_acc(f32x16 (&acc)[NT][2]) {
#pragma unroll
    for (int nt = 0; nt < NT; ++nt)
#pragma unroll
        for (int mt = 0; mt < 2; ++mt)
#pragma unroll
            for (int i = 0; i < 16; ++i) acc[nt][mt][i] = 0.f;
}


DI void tile_transpose(const f32x16& t, float* wscr, int lane, f32x4 (&out)[4]) {
    const int r = lane & 31, h = lane >> 5;
#pragma unroll
    for (int q = 0; q < 4; ++q) { f32x4 v = {t[4 * q], t[4 * q + 1], t[4 * q + 2], t[4 * q + 3]}; *(f32x4*)(wscr + r * 36 + 8 * q + 4 * h) = v; }
#pragma unroll
    for (int j = 0; j < 4; ++j) out[j] = *(const f32x4*)(wscr + ((lane >> 3) + 8 * j) * 36 + (lane & 7) * 4);
}
#define WSCR_BYTES (32 * 36 * 4)

DI void phaseA_tile(const float* __restrict__ X, const bf16x8* __restrict__ wfin, bf16_t* __restrict__ U, int tile, char* smem, int wid) {
    char* sA = smem; float* srstd = (float*)(smem + 8 * WSCR_BYTES);
    int tok0 = tile * 64; asm volatile("" : "+s"(tok0));
    int tid = get_tid(wid);
    const int w = __builtin_amdgcn_readfirstlane(tid >> 6), lane = tid & 63, r = lane & 31, h = lane >> 5;
    ALoadF32 al; al.init(X + (size_t)(tok0 + (tid >> 3)) * DM, tid);
    f32x16 acc[4][2]; zero_acc<4>(acc);
    gemm64<4, 2>(acc, al, 8, wfin + (size_t)w * (64 * 4 * 64) + lane, sA, lane);
    float ss = al.ss;
    ss += shx<1>(ss, lane); ss += shx<2>(ss, lane); ss += shx<4>(ss, lane);
    if ((tid & 7) == 0) srstd[tid >> 3] = rsqrtf(ss * (1.f / 1024.f) + 1e-6f);
    __syncthreads();
    {
        float* wscr = (float*)(smem + w * WSCR_BYTES);
        const int tl = lane >> 3, cl = (lane & 7) * 4;
#pragma unroll
        for (int mt = 0; mt < 2; ++mt) {
            float rs[4];
#pragma unroll
            for (int j = 0; j < 4; ++j) rs[j] = srstd[mt * 32 + tl + 8 * j];
#pragma unroll
            for (int nt = 0; nt < 4; ++nt) {
                f32x4 o[4]; tile_transpose(acc[nt][mt], wscr, lane, o);
#pragma unroll
                for (int j = 0; j < 4; ++j) {
                    uint2 p; p.x = pack_bf2(o[j].x * rs[j], o[j].y * rs[j]); p.y = pack_bf2(o[j].z * rs[j], o[j].w * rs[j]);
                    *(uint2*)(U + (size_t)(tok0 + mt * 32 + tl + 8 * j) * DM + w * 128 + nt * 32 + cl) = p;
                }
            }
        }
    }
    __syncthreads();
}

struct PrepW {
    const float* norm_mix; const float* w_in; const float* w_glu; const float* w_pool; const float* g_out_ssm; const float* g_out_pool;
    const float* w_out; const float* norm_ffn; const float* w_q; const float* k1; const float* k2;
    bf16x8* wfin; bf16x8* wfglu; bf16x8* wfpool; bf16x8* wfout; bf16x8* wfq; bf16x8* wfk1; bf16x8* wfk2;
};
DI void prep_weights(const PrepW& p, size_t gtid, size_t gs) {
#pragma unroll 1
    for (int l = 0; l < 2; ++l) {
        conv_wfrag<true>(p.w_in + (size_t)l * DM * DM, DM, 1, p.norm_mix + l * DM, p.norm_mix + l * DM, DM, DM, DM, 4, p.wfin + (size_t)l * (DM * DM / 8), gtid, gs);
        conv_wfrag<false>(p.w_glu + (size_t)l * 512 * 512, 512, 1, p.norm_mix, p.norm_mix, 512, 512, 512, 2, p.wfglu + (size_t)l * (512 * 512 / 8), gtid, gs);
#pragma unroll 1
        for (int gi = 0; gi < 4; ++gi)
            conv_wfrag<false>(p.w_pool + (size_t)(l * 4 + gi) * 128 * 128, 128, 1, p.norm_mix, p.norm_mix, 128, 128, 128, 2, p.wfpool + (size_t)(l * 4 + gi) * (128 * 128 / 8), gtid, gs);
        conv_wfrag<true>(p.w_out + (size_t)l * DM * DM, DM, 1, p.g_out_ssm + l * 512, p.g_out_pool + l * 512, 512, DM, DM, 4, p.wfout + (size_t)l * (DM * DM / 8), gtid, gs);
        conv_wfrag<true>(p.w_q + (size_t)l * DM * 2048, 2048, 1, p.norm_ffn + l * DM, p.norm_ffn + l * DM, DM, DM, 2048, 4, p.wfq + (size_t)l * (DM * 2048 / 8), gtid, gs);
    }
}
#define KT_BLK 528
#define KT_BYTES (65 * KT_BLK)
#define WST_FRAGS (4 * 64 * 64)
#define CCAR_FRAGS (32 * 8 * 64)
#define SU_CH 2064

DI void prep_s5_item(int lg, int part, const float* __restrict__ a_re, const float* __restrict__ a_im, const float* __restrict__ log_dt,
                     const float* __restrict__ b_re, const float* __restrict__ b_im, const float* __restrict__ c_re, const float* __restrict__ c_im,
                     const float* __restrict__ d_skip, char* __restrict__ KT, bf16x8* __restrict__ WST, bf16x8* __restrict__ CCAR,
                     float* __restrict__ ABT, char* smem, int wid) {
    float* powr = (float*)smem;
    float* powi = powr + 65 * 64;
    float* bzr = powi + 65 * 64;
    float* bzi = bzr + 1024;
    float* cr = bzi + 1024;
    float* ci = cr + 1024;
    int tid = get_tid(wid);
    const float* are_p = a_re + lg * 64; const float* aim_p = a_im + lg * 64;
    const float dt = expf(log_dt[lg]);
    for (int it = tid; it < 65 * 64; it += NTHR) {
        const int tau = it >> 6, p = it & 63;
        const float lre = are_p[p], lim = aim_p[p];
        const float mag = expf((float)tau * lre * dt);
        double rev = (double)lim * (double)dt * (double)tau * 0.15915494309189535;
        rev -= floor(rev);
        const float ang = (float)rev * 6.283185307179586f;
        powr[it] = mag * cosf(ang); powi[it] = mag * sinf(ang);
    }
    for (int it = tid; it < 1024; it += NTHR) {
        cr[it] = c_re[lg * 1024 + it]; ci[it] = c_im[lg * 1024 + it];
    }
    __syncthreads();
    for (int it = tid; it < 1024; it += NTHR) {
        const int p = it >> 4;
        const float lre = are_p[p], lim = aim_p[p];
        const float ar = powr[64 + p], ai = powi[64 + p];
        const float inv = 1.f / (lre * lre + lim * lim), nre = ar - 1.f;
        const float zre = (nre * lre + ai * lim) * inv, zim = (ai * lre - nre * lim) * inv;
        const float br = b_re[lg * 1024 + it], bi = b_im[lg * 1024 + it];
        bzr[it] = zre * br - zim * bi; bzi[it] = zre * bi + zim * br;
    }
    __syncthreads();
    if (part == 0 && tid < 64) { ABT[lg * 128 + 2 * tid] = powr[64 * 64 + tid]; ABT[lg * 128 + 2 * tid + 1] = powi[64 * 64 + tid]; }
    char* kt = KT + (size_t)lg * KT_BYTES;
    if (part == 0) for (int it = tid; it < KT_BLK / 4; it += NTHR) ((unsigned*)kt)[it] = 0u;
    for (int it = part * (16 * 128) + tid; it < (part + 1) * (16 * 128); it += NTHR) {
        const int tau = it >> 7, ho = (it >> 3) & 15, hi = (it & 7) * 2;
        float s0 = 0.f, s1 = 0.f;
        for (int p = 0; p < 64; ++p) {
            const float c_r = cr[ho * 64 + p], c_i = ci[ho * 64 + p], pr = powr[tau * 64 + p], pi = powi[tau * 64 + p];
            const float cpr = c_r * pr - c_i * pi, cpi = c_r * pi + c_i * pr;
            s0 += cpr * bzr[p * 16 + hi] - cpi * bzi[p * 16 + hi];
            s1 += cpr * bzr[p * 16 + hi + 1] - cpi * bzi[p * 16 + hi + 1];
        }
        if (tau == 0) { if (ho == hi) s0 += d_skip[lg * 16 + ho]; if (ho == hi + 1) s1 += d_skip[lg * 16 + ho]; }
        *(unsigned*)(kt + (tau + 1) * KT_BLK + ho * 32 + hi * 2) = pack_bf2(s0, s1);
    }
    if (part == 0) for (int it = tid; it < 65 * 4; it += NTHR) ((unsigned*)(kt + (it >> 2) * KT_BLK + 512))[it & 3] = 0u;
    bf16x8* wst = WST + (size_t)lg * WST_FRAGS;
    for (int it = part * (WST_FRAGS / 4) + tid; it < (part + 1) * (WST_FRAGS / 4); it += NTHR) {
        const int lane = it & 63, j = (it >> 6) & 63, nt = it >> 12;
        const int r = lane & 31, h = lane >> 5, n = nt * 32 + r, p = n & 63, im = n >> 6;
        const float pr = powr[(63 - j) * 64 + p], pi = powi[(63 - j) * 64 + p];
        float v[8];
#pragma unroll
        for (int jj = 0; jj < 8; ++jj) {
            const float zr = bzr[p * 16 + 8 * h + jj], zi = bzi[p * 16 + 8 * h + jj];
            v[jj] = im ? (pr * zi + pi * zr) : (pr * zr - pi * zi);
        }
        uint4 o; o.x = pack_bf2(v[0], v[1]); o.y = pack_bf2(v[2], v[3]); o.z = pack_bf2(v[4], v[5]); o.w = pack_bf2(v[6], v[7]);
        *(uint4*)(wst + it) = o;
    }
    bf16x8* cc = CCAR + (size_t)lg * CCAR_FRAGS;
    for (int it = part * (CCAR_FRAGS / 4) + tid; it < (part + 1) * (CCAR_FRAGS / 4); it += NTHR) {
        const int lane = it & 63, ks = (it >> 6) & 7, mt = it >> 9;
        const int r = lane & 31, h = lane >> 5, m = mt * 32 + r, i = m >> 4, ho = m & 15;
        float v[8];
#pragma unroll
        for (int jj = 0; jj < 8; ++jj) {
            const int k = ks * 16 + 8 * h + jj, p = k & 63, im = k >> 6;
            const float c_r = cr[ho * 64 + p], c_i = ci[ho * 64 + p], pr = powr[(i + 1) * 64 + p], pi = powi[(i + 1) * 64 + p];
            v[jj] = im ? -(c_r * pi + c_i * pr) : (c_r * pr - c_i * pi);
        }
        uint4 o; o.x = pack_bf2(v[0], v[1]); o.y = pack_bf2(v[2], v[3]); o.z = pack_bf2(v[4], v[5]); o.w = pack_bf2(v[6], v[7]);
        *(uint4*)(cc + it) = o;
    }
    __syncthreads();
}

#define PB_SU 0
#define PB_SKT (32 * SU_CH)
#define PB_SL (PB_SKT + KT_BYTES)
#define PB_SPART (PB_SL + 32 * 132 * 4)
#define PB_SSP (PB_SPART + 4 * 4096)
#define PB_BYTES (PB_SSP + 32 * 272)

DI void phaseB_tile(const bf16_t* __restrict__ U, const char* __restrict__ KT, const bf16x8* __restrict__ WST, const bf16x8* __restrict__ CCAR,
                    const float* __restrict__ ABT, bf16_t* __restrict__ YPRE, int tile, char* smem, int wid) {
    const int gp = tile & 31, b = tile >> 5;
    const int g = ((gp & 7) << 2) | (gp >> 3);
    int tid = get_tid(wid);
    const int w = __builtin_amdgcn_readfirstlane(tid >> 6), lane = tid & 63, r = lane & 31, h = lane >> 5;
    char* sU = smem + PB_SU; char* sKT = smem + PB_SKT; float* sL = (float*)(smem + PB_SL); float* sPart = (float*)(smem + PB_SPART);
    char* sSp = smem + PB_SSP;
#pragma unroll
    for (int it = 0; it < 4; ++it) {
        const int tok = tid + NTHR * it;
        const uint4* src = (const uint4*)(U + (size_t)(b * SEQ + tok) * DM + g * 16);
        const uint4 v0 = src[0], v1 = src[1];
        char* d = sU + (tok >> 6) * SU_CH + (tok & 63) * 32;
        *(uint4*)d = v0; *(uint4*)(d + 16) = v1;
    }
    {
        const uint4* src = (const uint4*)(KT + (size_t)g * KT_BYTES);
        for (int it = tid; it < KT_BYTES / 16; it += NTHR) ((uint4*)sKT)[it] = src[it];
    }
    __syncthreads();
    {
        const int nt = w & 3, kh = w >> 2;
        f32x16 acc;
#pragma unroll
        for (int i = 0; i < 16; ++i) acc[i] = 0.f;
        const bf16x8* wp = WST + (size_t)g * WST_FRAGS + (size_t)(nt * 64 + kh * 32) * 64 + lane;
        const char* up = sU + r * SU_CH + h * 16 + kh * 32 * 32;
#pragma unroll 16
        for (int j = 0; j < 32; ++j) {
            const bf16x8 a = wp[j * 64];
            const bf16x8 bb = *(const bf16x8*)(up + j * 32);
            acc = MFMA32(a, bb, acc);
        }
        if (kh == 1) {
#pragma unroll
            for (int i = 0; i < 16; ++i) sPart[(nt * 16 + i) * 64 + lane] = acc[i];
        }
        __syncthreads();
        if (kh == 0) {
#pragma unroll
            for (int i = 0; i < 16; ++i) sL[r * 132 + nt * 32 + crow(i, h)] = acc[i] + sPart[(nt * 16 + i) * 64 + lane];
        }
        __syncthreads();
    }
    if (tid < 64) {
        const int p = tid;
        const float ar = ABT[g * 128 + 2 * p], ai = ABT[g * 128 + 2 * p + 1];
        float sr = 0.f, si = 0.f;
        for (int c = 0; c < 32; ++c) {
            *(bf16_t*)(sSp + c * 272 + p * 2) = (bf16_t)(pack_bf2(sr, 0.f) & 0xffffu);
            *(bf16_t*)(sSp + c * 272 + (64 + p) * 2) = (bf16_t)(pack_bf2(si, 0.f) & 0xffffu);
            const float lr = sL[c * 132 + p], li = sL[c * 132 + 64 + p];
            const float nr = ar * sr - ai * si + lr, ni = ar * si + ai * sr + li;
            sr = nr; si = ni;
        }
    }
    f32x16 acc4[4];
#pragma unroll
    for (int q = 0; q < 4; ++q)
#pragma unroll
        for (int i = 0; i < 16; ++i) acc4[q][i] = 0.f;
    const int mts0 = w, mts1 = 15 - w, mts2 = 16 + w, mts3 = 31 - w;
    {
        const char* up = sU + r * SU_CH + h * 16;
        const char* kp = sKT + (r & 15) * 32 + h * 16 + ((r >> 4) + 1) * KT_BLK;
        for (int j = 0; j < 64; ++j) {
            const bf16x8 bb = *(const bf16x8*)(up + j * 32);
#define TOEP_STEP(q, mt) if (2 * (mt) + 1 >= j) { const bf16x8 a = *(const bf16x8*)(kp + (2 * (mt) - j) * KT_BLK); acc4[q] = MFMA32(a, bb, acc4[q]); }
            TOEP_STEP(0, mts0) TOEP_STEP(1, mts1) TOEP_STEP(2, mts2) TOEP_STEP(3, mts3)
#undef TOEP_STEP
        }
    }
    __syncthreads();
    {
        const bf16x8* cp = CCAR + (size_t)g * CCAR_FRAGS + lane;
        const char* sp = sSp + r * 272 + h * 16;
#pragma unroll
        for (int ks = 0; ks < 8; ++ks) {
            const bf16x8 bb = *(const bf16x8*)(sp + ks * 32);
            acc4[0] = MFMA32(cp[(mts0 * 8 + ks) * 64], bb, acc4[0]);
            acc4[1] = MFMA32(cp[(mts1 * 8 + ks) * 64], bb, acc4[1]);
            acc4[2] = MFMA32(cp[(mts2 * 8 + ks) * 64], bb, acc4[2]);
            acc4[3] = MFMA32(cp[(mts3 * 8 + ks) * 64], bb, acc4[3]);
        }
    }
    {
        bf16_t* ybase = YPRE + (size_t)(b * SEQ + r * 64) * 512 + g * 16;
#define PB_STORE(q, mt) _Pragma("unroll") for (int rq = 0; rq < 4; ++rq) { const int c0 = 8 * rq + 4 * h; const int i = 2 * (mt) + (c0 >> 4); \
            uint2 o; o.x = pack_bf2(acc4[q][4 * rq], acc4[q][4 * rq + 1]); o.y = pack_bf2(acc4[q][4 * rq + 2], acc4[q][4 * rq + 3]); \
            *(uint2*)(ybase + (size_t)i * 512 + (c0 & 15)) = o; }
        PB_STORE(0, mts0) PB_STORE(1, mts1) PB_STORE(2, mts2) PB_STORE(3, mts3)
#undef PB_STORE
    }
    __syncthreads();
}

#ifndef REP_GLU
#define REP_GLU 1
#endif
#ifndef REP_POOL
#define REP_POOL 1
#endif
#ifndef REP_OUT
#define REP_OUT 1
#endif
#ifndef REP_Q
#define REP_Q 1
#endif
#ifndef REP_SC
#define REP_SC 1
#endif
struct ALoadGelu {
    const bf16_t* base; bf16_t* gout; u32x4 v0, v1; int cc; int dofs;
    DI void init(const bf16_t* rowbase, bf16_t* growbase, int tid) { base = rowbase + (tid & 7) * 16; gout = growbase + (tid & 7) * 16; dofs = (tid >> 3) * SA_STRIDE + (tid & 7) * 32; }
    DI void issue(int c) { const u32x4* p = (const u32x4*)(base + c * 128); v0 = p[0]; v1 = p[1]; cc = c; }
    DI unsigned g2(unsigned u) { return pack_bf2(gelu_exact(bf_lo(u)), gelu_exact(bf_hi(u))); }
    DI void commit(char* buf) {
        u32x4 o0, o1;
        o0.x = g2(v0.x); o0.y = g2(v0.y); o0.z = g2(v0.z); o0.w = g2(v0.w);
        o1.x = g2(v1.x); o1.y = g2(v1.y); o1.z = g2(v1.z); o1.w = g2(v1.w);
        char* d = buf + dofs;
        *(u32x4*)d = o0; *(u32x4*)(d + 16) = o1;
        u32x4* gp = (u32x4*)(gout + cc * 128); gp[0] = o0; gp[1] = o1;
    }
};

DI void tok_reduce(float p0, float p1, float* sred, float& t0, float& t1, int tid) {
    const int w = tid >> 6, lane = tid & 63, r = lane & 31, h = lane >> 5;
    __syncthreads();
    sred[(w * 2 + h) * 64 + r] = p0; sred[(w * 2 + h) * 64 + 32 + r] = p1;
    __syncthreads();
    float a = 0.f, b = 0.f;
#pragma unroll
    for (int k = 0; k < 16; ++k) { a += sred[k * 64 + r]; b += sred[k * 64 + 32 + r]; }
    t0 = a; t1 = b;
}

#define PC_SRED (4 * SA_BYTES)
#define PC_BYTES (PC_SRED + 4096 + 256)

struct PCArgs {
    const bf16_t* U; const bf16_t* YPRE; bf16_t* G1; bf16_t* A2; const float* Xin; float* Xout; float* Xdummy; bf16_t* Hb; float* RSTD;
    const bf16x8* wfglu; const float* b_glu; const bf16x8* wfpool; const float* pool_scale; const bf16x8* wfout;
};

DI void phaseC1_tile(const PCArgs& a, int tile, char* smem, int wid) {
    char* sA = smem; float* sred = (float*)(smem + PC_SRED);
    for (int rep_ = 0; rep_ < REP_GLU; ++rep_) {
        int tok0 = tile * 64; asm volatile("" : "+s"(tok0));
        int tid = get_tid(wid);
        const int w = __builtin_amdgcn_readfirstlane(tid >> 6), lane = tid & 63, r = lane & 31, h = lane >> 5;
        ALoadGelu al; al.init(a.YPRE + (size_t)(tok0 + (tid >> 3)) * 512, a.G1 + (size_t)(tok0 + (tid >> 3)) * 512, tid);
        f32x16 acc[2][2]; zero_acc<2>(acc);
        gemm64<2, 4>(acc, al, 4, a.wfglu + (size_t)w * (32 * 2 * 64) + lane, sA, lane);
        float ss0 = 0.f, ss1 = 0.f;
        {
            uint2 yp[2][2][4]; float4 bg[2][4];
#pragma unroll
            for (int nt = 0; nt < 2; ++nt)
#pragma unroll
                for (int q = 0; q < 4; ++q) bg[nt][q] = *(const float4*)(a.b_glu + w * 64 + nt * 32 + 8 * q + 4 * h);
#pragma unroll
            for (int mt = 0; mt < 2; ++mt)
#pragma unroll
                for (int nt = 0; nt < 2; ++nt)
#pragma unroll
                    for (int q = 0; q < 4; ++q)
                        yp[mt][nt][q] = *(const uint2*)(a.G1 + (size_t)(tok0 + mt * 32 + r) * 512 + w * 64 + nt * 32 + 8 * q + 4 * h);
#pragma unroll
            for (int mt = 0; mt < 2; ++mt)
#pragma unroll
                for (int nt = 0; nt < 2; ++nt)
#pragma unroll
                    for (int q = 0; q < 4; ++q) {
                        const float y0 = bf_lo(yp[mt][nt][q].x), y1 = bf_hi(yp[mt][nt][q].x), y2 = bf_lo(yp[mt][nt][q].y), y3 = bf_hi(yp[mt][nt][q].y);
                        const float o0 = y0 / (1.f + __expf(-(acc[nt][mt][4 * q] + bg[nt][q].x)));
                        const float o1 = y1 / (1.f + __expf(-(acc[nt][mt][4 * q + 1] + bg[nt][q].y)));
                        const float o2 = y2 / (1.f + __expf(-(acc[nt][mt][4 * q + 2] + bg[nt][q].z)));
                        const float o3 = y3 / (1.f + __expf(-(acc[nt][mt][4 * q + 3] + bg[nt][q].w)));
                        acc[nt][mt][4 * q] = o0; acc[nt][mt][4 * q + 1] = o1; acc[nt][mt][4 * q + 2] = o2; acc[nt][mt][4 * q + 3] = o3;
                        const float s = o0 * o0 + o1 * o1 + o2 * o2 + o3 * o3;
                        if (mt == 0) ss0 += s; else ss1 += s;
                    }
        }
        float t0, t1; tok_reduce(ss0, ss1, sred, t0, t1, tid);
        const float rs0 = rsqrtf(t0 * (1.f / 512.f) + 1e-6f), rs1 = rsqrtf(t1 * (1.f / 512.f) + 1e-6f);
#pragma unroll
        for (int mt = 0; mt < 2; ++mt) {
            const float rs = mt ? rs1 : rs0;
            bf16_t* orow = a.A2 + (size_t)(tok0 + mt * 32 + r) * DM + w * 64;
#pragma unroll
            for (int nt = 0; nt < 2; ++nt)
#pragma unroll
                for (int q = 0; q < 4; ++q) {
                    uint2 o; o.x = pack_bf2(acc[nt][mt][4 * q] * rs, acc[nt][mt][4 * q + 1] * rs);
                    o.y = pack_bf2(acc[nt][mt][4 * q + 2] * rs, acc[nt][mt][4 * q + 3] * rs);
                    *(uint2*)(orow + nt * 32 + 8 * q + 4 * h) = o;
                }
        }
    }
    for (int rep_ = 0; rep_ < REP_POOL; ++rep_) {
        int tok0 = tile * 64; asm volatile("" : "+s"(tok0));
        int tid = get_tid(wid);
        const int w = __builtin_amdgcn_readfirstlane(tid >> 6), lane = tid & 63, r = lane & 31, h = lane >> 5;
        const int row = tid >> 3, seg = tid & 7;
        const int tok = tok0 + row, t = tok & (SEQ - 1);
#pragma unroll
        for (int gi = 0; gi < 4; ++gi) {
            const int win = 2 << gi;
            const int cnt = (t + 1 < win) ? (t + 1) : win;
            const bf16_t* up = a.U + (size_t)tok * DM + 512 + gi * 128 + seg * 16;
            float s[16];
            const uint4 c0 = *(const uint4*)up, c1 = *(const uint4*)(up + 8);
            const unsigned cu[8] = {c0.x, c0.y, c0.z, c0.w, c1.x, c1.y, c1.z, c1.w};
#pragma unroll
            for (int i = 0; i < 8; ++i) { s[2 * i] = bf_lo(cu[i]); s[2 * i + 1] = bf_hi(cu[i]); }
#pragma unroll
            for (int k0 = 1; k0 < win; k0 += 5) {
                uint4 d0[5], d1[5];
#pragma unroll
                for (int u = 0; u < 5; ++u)
                    if (k0 + u < win) {
                        const bf16_t* p = (k0 + u <= t) ? up - (size_t)(k0 + u) * DM : up;
                        d0[u] = *(const uint4*)p; d1[u] = *(const uint4*)(p + 8);
                    }
#pragma unroll
                for (int u = 0; u < 5; ++u)
                    if (k0 + u < win) {
                        const float m = (k0 + u <= t) ? 1.f : 0.f;
                        const unsigned du[8] = {d0[u].x, d0[u].y, d0[u].z, d0[u].w, d1[u].x, d1[u].y, d1[u].z, d1[u].w};
#pragma unroll
                        for (int i = 0; i < 8; ++i) { s[2 * i] = fmaf(m, bf_lo(du[i]), s[2 * i]); s[2 * i + 1] = fmaf(m, bf_hi(du[i]), s[2 * i + 1]); }
                    }
            }
            const float inv = 1.f / (float)cnt;
            unsigned o[8];
#pragma unroll
            for (int i = 0; i < 8; ++i) o[i] = pack_bf2(s[2 * i] * inv - bf_lo(cu[i]), s[2 * i + 1] * inv - bf_hi(cu[i]));
            char* d = sA + gi * SA_BYTES + row * SA_STRIDE + seg * 32;
            *(uint4*)d = make_uint4(o[0], o[1], o[2], o[3]); *(uint4*)(d + 16) = make_uint4(o[4], o[5], o[6], o[7]);
        }
        __syncthreads();
        const int gi = w >> 1;
        f32x16 acc[2][2]; zero_acc<2>(acc);
        const bf16x8* wp = a.wfpool + (size_t)gi * (128 * 128 / 8) + (size_t)(w & 1) * (8 * 2 * 64) + lane;
        const char* buf = sA + gi * SA_BYTES + r * SA_STRIDE + h * 16;
#pragma unroll
        for (int ks = 0; ks < 8; ++ks) {
            const bf16x8 a0 = *(const bf16x8*)(buf + ks * 32);
            const bf16x8 a1 = *(const bf16x8*)(buf + 32 * SA_STRIDE + ks * 32);
#pragma unroll
            for (int nt = 0; nt < 2; ++nt) {
                const bf16x8 wv = wp[(ks * 2 + nt) * 64];
                acc[nt][0] = MFMA32(wv, a0, acc[nt][0]);
                acc[nt][1] = MFMA32(wv, a1, acc[nt][1]);
            }
        }
        float ss0 = 0.f, ss1 = 0.f;
        float4 psc[2][4];
#pragma unroll
        for (int nt = 0; nt < 2; ++nt)
#pragma unroll
            for (int q = 0; q < 4; ++q) psc[nt][q] = *(const float4*)(a.pool_scale + w * 64 + nt * 32 + 8 * q + 4 * h);
#pragma unroll
        for (int mt = 0; mt < 2; ++mt)
#pragma unroll
            for (int nt = 0; nt < 2; ++nt)
#pragma unroll
                for (int q = 0; q < 4; ++q) {
                    const float4 sc = psc[nt][q];
                    const float o0 = acc[nt][mt][4 * q] * sc.x, o1 = acc[nt][mt][4 * q + 1] * sc.y, o2 = acc[nt][mt][4 * q + 2] * sc.z, o3 = acc[nt][mt][4 * q + 3] * sc.w;
                    acc[nt][mt][4 * q] = o0; acc[nt][mt][4 * q + 1] = o1; acc[nt][mt][4 * q + 2] = o2; acc[nt][mt][4 * q + 3] = o3;
                    const float s = o0 * o0 + o1 * o1 + o2 * o2 + o3 * o3;
                    if (mt == 0) ss0 += s; else ss1 += s;
                }
        float t0, t1; tok_reduce(ss0, ss1, sred, t0, t1, tid);
        const float rs0 = rsqrtf(t0 * (1.f / 512.f) + 1e-6f), rs1 = rsqrtf(t1 * (1.f / 512.f) + 1e-6f);
#pragma unroll
        for (int mt = 0; mt < 2; ++mt) {
            const float rs = mt ? rs1 : rs0;
            bf16_t* orow = a.A2 + (size_t)(tok0 + mt * 32 + r) * DM + 512 + w * 64;
#pragma unroll
            for (int nt = 0; nt < 2; ++nt)
#pragma unroll
                for (int q = 0; q < 4; ++q) {
                    uint2 o; o.x = pack_bf2(acc[nt][mt][4 * q] * rs, acc[nt][mt][4 * q + 1] * rs);
                    o.y = pack_bf2(acc[nt][mt][4 * q + 2] * rs, acc[nt][mt][4 * q + 3] * rs);
                    *(uint2*)(orow + nt * 32 + 8 * q + 4 * h) = o;
                }
        }
        __syncthreads();
    }
    for (int rep_ = 0; rep_ < REP_OUT; ++rep_) {
        float* xout_ = (rep_ + 1 < REP_OUT) ? a.Xdummy : a.Xout;
        int tok0 = tile * 64; asm volatile("" : "+s"(tok0));
        int tid = get_tid(wid);
        const int w = __builtin_amdgcn_readfirstlane(tid >> 6), lane = tid & 63, r = lane & 31, h = lane >> 5;
        ALoadBF16 al; al.init(a.A2 + (size_t)(tok0 + (tid >> 3)) * DM, tid);
        f32x16 acc[4][2]; zero_acc<4>(acc);
        gemm64<4, 2>(acc, al, 8, a.wfout + (size_t)w * (64 * 4 * 64) + lane, sA, lane);
        {
            float* wscr = (float*)(smem + w * WSCR_BYTES);
            const int tl = lane >> 3, cl = (lane & 7) * 4;
            float ssj[2][4];
#pragma unroll
            for (int mt = 0; mt < 2; ++mt)
#pragma unroll
                for (int j = 0; j < 4; ++j) ssj[mt][j] = 0.f;
            float4 xc[4], xn[4];
            const size_t rbase = (size_t)(tok0 + tl) * DM + w * 128 + cl;
#pragma unroll
            for (int j = 0; j < 4; ++j) xc[j] = *(const float4*)(a.Xin + rbase + (size_t)(8 * j) * DM);
#pragma unroll
            for (int g = 0; g < 8; ++g) {
                const int mt = g >> 2, nt = g & 3;
                if (g < 7) {
                    const size_t rn = rbase + (size_t)((g + 1) >> 2) * 32 * DM + ((g + 1) & 3) * 32;
#pragma unroll
                    for (int j = 0; j < 4; ++j) xn[j] = *(const float4*)(a.Xin + rn + (size_t)(8 * j) * DM);
                }
                f32x4 o[4]; tile_transpose(acc[nt][mt], wscr, lane, o);
                const size_t ro = rbase + (size_t)mt * 32 * DM + nt * 32;
#pragma unroll
                for (int j = 0; j < 4; ++j) {
                    float4 xo; xo.x = xc[j].x + o[j].x; xo.y = xc[j].y + o[j].y; xo.z = xc[j].z + o[j].z; xo.w = xc[j].w + o[j].w;
                    *(float4*)(xout_ + ro + (size_t)(8 * j) * DM) = xo;
                    uint2 p; p.x = pack_bf2(xo.x, xo.y); p.y = pack_bf2(xo.z, xo.w);
                    *(uint2*)(a.Hb + ro + (size_t)(8 * j) * DM) = p;
                    ssj[mt][j] += xo.x * xo.x + xo.y * xo.y + xo.z * xo.z + xo.w * xo.w;
                }
                asm volatile("" ::: "memory");
#pragma unroll
                for (int j = 0; j < 4; ++j) xc[j] = xn[j];
            }
#pragma unroll
            for (int mt = 0; mt < 2; ++mt)
#pragma unroll
                for (int j = 0; j < 4; ++j) {
                    float v = ssj[mt][j];
                    v += shx<1>(v, lane); v += shx<2>(v, lane); v += shx<4>(v, lane);
                    if ((lane & 7) == 0) sred[w * 64 + mt * 32 + tl + 8 * j] = v;
                }
            __syncthreads();
            if (tid < 64) {
                float tot = 0.f;
#pragma unroll
                for (int k = 0; k < 8; ++k) tot += sred[k * 64 + tid];
                a.RSTD[tok0 + tid] = rsqrtf(tot * (1.f / 1024.f) + 1e-6f);
            }
        }
        __syncthreads();
    }
}

DI unsigned f2ord(float f) { const unsigned u = __float_as_uint(f); return u ^ ((u >> 31) ? 0xFFFFFFFFu : 0x80000000u); }
DI float ord2f(unsigned o) { return __uint_as_float((o & 0x80000000u) ? (o ^ 0x80000000u) : ~o); }
DI unsigned umax_(unsigned a, unsigned b) { return a > b ? a : b; }
DI unsigned umin_(unsigned a, unsigned b) { return a < b ? a : b; }

struct PRArgs {
    const bf16_t* Hb; const float* RSTD; const bf16x8* wfq; const bf16x8* kf1; const bf16x8* kf2; unsigned short* EX; float* GT;
};

DI void conv_kfrag(const float* __restrict__ K, bf16x8* __restrict__ dst, size_t gtid, size_t gstride) {
    for (size_t item = gtid; item < 8 * 4 * 64; item += gstride) {
        const int lane = (int)(item & 63), kt = (int)((item >> 6) & 3), ks = (int)(item >> 8);
        const int r = lane & 31, h = lane >> 5;
        float v[8];
#pragma unroll
        for (int j = 0; j < 8; ++j) v[j] = K[(size_t)(kt * 32 + r) * 128 + (ks >> 1) * 32 + 16 * (ks & 1) + 8 * (j >> 2) + 4 * h + (j & 3)];
        uint4 o; o.x = pack_bf2(v[0], v[1]); o.y = pack_bf2(v[2], v[3]); o.z = pack_bf2(v[4], v[5]); o.w = pack_bf2(v[6], v[7]);
        *(uint4*)(dst + item) = o;
    }
}

DI void bitonic_sort16(unsigned (&a)[16]) {
#pragma unroll
    for (int k = 2; k <= 16; k <<= 1)
#pragma unroll
        for (int j = k >> 1; j > 0; j >>= 1)
#pragma unroll
            for (int i = 0; i < 16; ++i) {
                const int l = i ^ j;
                if (l > i) {
                    const unsigned hi = umax_(a[i], a[l]), lo = umin_(a[i], a[l]);
                    if ((i & k) == 0) { a[i] = hi; a[l] = lo; } else { a[i] = lo; a[l] = hi; }
                }
            }
}
DI void bitonic_top16(unsigned (&a)[16], const unsigned (&b)[16]) {
#pragma unroll
    for (int i = 0; i < 16; ++i) a[i] = umax_(a[i], b[15 - i]);
#pragma unroll
    for (int j = 8; j > 0; j >>= 1)
#pragma unroll
        for (int i = 0; i < 16; ++i) {
            const int l = i ^ j;
            if (l > i) { const unsigned hi = umax_(a[i], a[l]), lo = umin_(a[i], a[l]); a[i] = hi; a[l] = lo; }
        }
}
DI void make_keys(unsigned (&x)[16], const f32x16& s, float rs, int nbase, int h) {
#pragma unroll
    for (int i = 0; i < 16; ++i) x[i] = (f2ord(s[i] * rs) & 0xFFFFFF80u) | (unsigned)(127 - (nbase + crow(i, h)));
}

#define PR_LIST_STRIDE 80
#define PR_SLIST (2 * SA_BYTES)
#define PR_SIDX (PR_SLIST + 8 * 32 * PR_LIST_STRIDE)

DI void phaseC2_tile(const PRArgs& a, int tile, char* smem, int wid) {
    char* sA = smem;
#pragma unroll 1
    for (int ps = 0; ps < 2; ++ps) {
        int tok0 = tile * 64; asm volatile("" : "+s"(tok0));
        int tid = get_tid(wid);
        const int w = __builtin_amdgcn_readfirstlane(tid >> 6), lane = tid & 63, r = lane & 31, h = lane >> 5;
        const int ng = ps * 8 + w, hd = ng >> 1, hf = ng & 1;
        bf16x8 qb[2][8];
        {
            ALoadBF16 al; al.init(a.Hb + (size_t)(tok0 + (tid >> 3)) * DM, tid);
            f32x16 acc[4][2]; zero_acc<4>(acc);
            gemm64<4, 2>(acc, al, 8, a.wfq + (size_t)ng * (64 * 4 * 64) + lane, sA, lane);
#pragma unroll
            for (int mt = 0; mt < 2; ++mt)
#pragma unroll
                for (int nt = 0; nt < 4; ++nt)
#pragma unroll
                    for (int s = 0; s < 2; ++s) {
                        u32x4 p;
                        p.x = pack_bf2(acc[nt][mt][8 * s], acc[nt][mt][8 * s + 1]); p.y = pack_bf2(acc[nt][mt][8 * s + 2], acc[nt][mt][8 * s + 3]);
                        p.z = pack_bf2(acc[nt][mt][8 * s + 4], acc[nt][mt][8 * s + 5]); p.w = pack_bf2(acc[nt][mt][8 * s + 6], acc[nt][mt][8 * s + 7]);
                        qb[mt][nt * 2 + s] = __builtin_bit_cast(bf16x8, p);
                    }
        }
        gwp_t kf = (gwp_t)(hf ? a.kf2 : a.kf1) + lane;
        unsigned Town[16];
#pragma unroll
        for (int mt = 0; mt < 2; ++mt) {
            f32x16 sc[4];
#pragma unroll
            for (int kt = 0; kt < 4; ++kt)
#pragma unroll
                for (int i = 0; i < 16; ++i) sc[kt][i] = 0.f;
#pragma unroll
            for (int ks = 0; ks < 8; ++ks) {
#pragma unroll
                for (int kt = 0; kt < 4; ++kt) sc[kt] = MFMA32(kf[(ks * 4 + kt) * 64], qb[mt][ks], sc[kt]);
                if (ks & 1) asm volatile("" ::: "memory");
            }
            const float rs = a.RSTD[tok0 + mt * 32 + r];
            unsigned L[16], S[16];
            make_keys(L, sc[0], rs, 0, h); bitonic_sort16(L);
#pragma unroll
            for (int kt = 1; kt < 4; ++kt) { make_keys(S, sc[kt], rs, kt * 32, h); bitonic_sort16(S); bitonic_top16(L, S); }
#pragma unroll
            for (int k = 0; k < 16; ++k) S[k] = (unsigned)shx_i<32>((int)L[k], lane);
            bitonic_top16(L, S);
            if (mt == hf) {
#pragma unroll
                for (int k = 0; k < 16; ++k) Town[k] = L[k];
            } else {
                char* dst = smem + PR_SLIST + (w * 32 + r) * PR_LIST_STRIDE + h * 32;
                u32x4 v0, v1;
                if (h == 0) { v0 = (u32x4){L[0], L[1], L[2], L[3]}; v1 = (u32x4){L[4], L[5], L[6], L[7]}; }
                else { v0 = (u32x4){L[8], L[9], L[10], L[11]}; v1 = (u32x4){L[12], L[13], L[14], L[15]}; }
                *(u32x4*)dst = v0; *(u32x4*)(dst + 16) = v1;
            }
        }
        __syncthreads();
        unsigned T0[16], T1[16];
        {
            const char* src = smem + PR_SLIST + ((w ^ 1) * 32 + r) * PR_LIST_STRIDE;
            const u32x4 p0 = *(const u32x4*)src, p1 = *(const u32x4*)(src + 16), p2 = *(const u32x4*)(src + 32), p3 = *(const u32x4*)(src + 48);
            const unsigned Tp[16] = {p0.x, p0.y, p0.z, p0.w, p1.x, p1.y, p1.z, p1.w, p2.x, p2.y, p2.z, p2.w, p3.x, p3.y, p3.z, p3.w};
#pragma unroll
            for (int k = 0; k < 16; ++k) { T0[k] = hf ? Tp[k] : Town[k]; T1[k] = hf ? Town[k] : Tp[k]; }
        }
        float v1[16], v2[16];
#pragma unroll
        for (int k = 0; k < 16; ++k) { v1[k] = ord2f(T0[k] & 0xFFFFFF80u); v2[k] = ord2f(T1[k] & 0xFFFFFF80u); }
        unsigned C[16];
#pragma unroll
        for (int b = 0; b < 16; ++b) C[b] = (f2ord(v1[0] + v2[b]) & 0xFFFFFF00u) | (unsigned)(255 - b);
#pragma unroll
        for (int aa = 1; aa < 16; ++aa)
#pragma unroll
            for (int b = 0; b < 16; ++b)
                if ((aa + 1) * (b + 1) <= 16) {
                    unsigned x = (f2ord(v1[aa] + v2[b]) & 0xFFFFFF00u) | (unsigned)(255 - (aa * 16 + b));
#pragma unroll
                    for (int k = (aa + 1) * (b + 1) - 1; k < 16; ++k) { const unsigned hi = umax_(C[k], x); x = umin_(C[k], x); C[k] = hi; }
                }
        unsigned* sI = (unsigned*)(smem + PR_SIDX) + (w * 64 + lane) * 9;
#pragma unroll
        for (int q = 0; q < 4; ++q) {
            unsigned p1 = 0u, p2 = 0u;
#pragma unroll
            for (int j = 0; j < 4; ++j) { p1 |= (127u - (T0[4 * q + j] & 0x7Fu)) << (8 * j); p2 |= (127u - (T1[4 * q + j] & 0x7Fu)) << (8 * j); }
            sI[q] = p1; sI[4 + q] = p2;
        }
        const unsigned char* sB = (const unsigned char*)sI;
        const float mx = ord2f(C[0] & 0xFFFFFF00u);
        float e[16]; float sum = 0.f; int ex[16];
#pragma unroll
        for (int k = 0; k < 16; ++k) {
            e[k] = __expf(ord2f(C[k] & 0xFFFFFF00u) - mx); sum += e[k];
            const unsigned ci = 255u - (C[k] & 0xFFu);
            ex[k] = (int)sB[ci >> 4] * 128 + (int)sB[16 + (ci & 15u)];
        }
        const float inv = 1.f / sum;
        const size_t ob = ((size_t)(tok0 + hf * 32 + r) * 8 + hd) * 16;
        if (h == 0) {
#pragma unroll
            for (int q = 0; q < 2; ++q) *(uint4*)(a.EX + ob + 8 * q) = make_uint4((unsigned)ex[8 * q] | ((unsigned)ex[8 * q + 1] << 16), (unsigned)ex[8 * q + 2] | ((unsigned)ex[8 * q + 3] << 16),
                                                                       (unsigned)ex[8 * q + 4] | ((unsigned)ex[8 * q + 5] << 16), (unsigned)ex[8 * q + 6] | ((unsigned)ex[8 * q + 7] << 16));
        } else {
#pragma unroll
            for (int q = 0; q < 4; ++q) *(float4*)(a.GT + ob + 4 * q) = make_float4(e[4 * q] * inv, e[4 * q + 1] * inv, e[4 * q + 2] * inv, e[4 * q + 3] * inv);
        }
        __syncthreads();
    }
}
typedef const __attribute__((address_space(1))) u32x4* grow_t;
typedef unsigned char fp8_t;

struct PGArgs {
    const bf16_t* Hb; const float* RSTD; const int* EX; const float* GT; const fp8_t* U8; const fp8_t* V8; const float* SU; const float* SV;
    const float* Xin; float* Xout; const float* gfinal; int final_norm;
};

#ifndef EMU_FP4
#define EMU_FP4 0
#endif
DI float q_e2m1(float x, float inv, float sc) {
    const float a = fabsf(x) * inv;
    float q = (a < 0.25f) ? 0.f : (a < 0.75f) ? 0.5f : (a < 1.25f) ? 1.f : (a < 1.75f) ? 1.5f : (a < 2.5f) ? 2.f : (a < 3.5f) ? 3.f : (a < 5.f) ? 4.f : 6.f;
    return copysignf(q * sc, x);
}
DI void emu_fp4_block(float4& v0, float4& v1, float4& v2, float4& v3) {
    float m = fmaxf(fmaxf(fmaxf(fabsf(v0.x), fabsf(v0.y)), fmaxf(fabsf(v0.z), fabsf(v0.w))), fmaxf(fmaxf(fabsf(v1.x), fabsf(v1.y)), fmaxf(fabsf(v1.z), fabsf(v1.w))));
    m = fmaxf(m, fmaxf(fmaxf(fmaxf(fabsf(v2.x), fabsf(v2.y)), fmaxf(fabsf(v2.z), fabsf(v2.w))), fmaxf(fmaxf(fabsf(v3.x), fabsf(v3.y)), fmaxf(fabsf(v3.z), fabsf(v3.w)))));
    const float sc = (m > 0.f) ? m * (1.f / 6.f) : 1.f, inv = 1.f / sc;
    v0.x = q_e2m1(v0.x, inv, sc); v0.y = q_e2m1(v0.y, inv, sc); v0.z = q_e2m1(v0.z, inv, sc); v0.w = q_e2m1(v0.w, inv, sc);
    v1.x = q_e2m1(v1.x, inv, sc); v1.y = q_e2m1(v1.y, inv, sc); v1.z = q_e2m1(v1.z, inv, sc); v1.w = q_e2m1(v1.w, inv, sc);
    v2.x = q_e2m1(v2.x, inv, sc); v2.y = q_e2m1(v2.y, inv, sc); v2.z = q_e2m1(v2.z, inv, sc); v2.w = q_e2m1(v2.w, inv, sc);
    v3.x = q_e2m1(v3.x, inv, sc); v3.y = q_e2m1(v3.y, inv, sc); v3.z = q_e2m1(v3.z, inv, sc); v3.w = q_e2m1(v3.w, inv, sc);
}
DI void conv_row_fp8_one(float4 v0, float4 v1, float4 v2, float4 v3, const float* __restrict__ gain, fp8_t* __restrict__ dst, float* __restrict__ scales,
                         int nrows, int row, int lane) {
    if (gain) {
        const float4* g = (const float4*)(gain + lane * 16);
        const float4 g0 = g[0], g1 = g[1], g2 = g[2], g3 = g[3];
        v0.x *= g0.x; v0.y *= g0.y; v0.z *= g0.z; v0.w *= g0.w; v1.x *= g1.x; v1.y *= g1.y; v1.z *= g1.z; v1.w *= g1.w;
        v2.x *= g2.x; v2.y *= g2.y; v2.z *= g2.z; v2.w *= g2.w; v3.x *= g3.x; v3.y *= g3.y; v3.z *= g3.z; v3.w *= g3.w;
    }
    if (gain ? (EMU_FP4 & 1) : (EMU_FP4 & 2)) emu_fp4_block(v0, v1, v2, v3);
    float m = fmaxf(fmaxf(fmaxf(fabsf(v0.x), fabsf(v0.y)), fmaxf(fabsf(v0.z), fabsf(v0.w))), fmaxf(fmaxf(fabsf(v1.x), fabsf(v1.y)), fmaxf(fabsf(v1.z), fabsf(v1.w))));
    m = fmaxf(m, fmaxf(fmaxf(fmaxf(fabsf(v2.x), fabsf(v2.y)), fmaxf(fabsf(v2.z), fabsf(v2.w))), fmaxf(fmaxf(fabsf(v3.x), fabsf(v3.y)), fmaxf(fabsf(v3.z), fabsf(v3.w)))));
    m = fmaxf(m, shx<1>(m, lane)); m = fmaxf(m, shx<2>(m, lane)); m = fmaxf(m, shx<4>(m, lane)); m = fmaxf(m, shx<8>(m, lane)); m = fmaxf(m, shx<16>(m, lane)); m = fmaxf(m, shx<32>(m, lane));
    const float sc = (m > 0.f) ? m * (1.f / 448.f) : 1.f;
    const float inv = 1.f / sc;
    u32x4 o;
    unsigned t;
    t = 0u; t = __builtin_amdgcn_cvt_pk_fp8_f32(v0.x * inv, v0.y * inv, t, false); t = __builtin_amdgcn_cvt_pk_fp8_f32(v0.z * inv, v0.w * inv, t, true); o.x = t;
    t = 0u; t = __builtin_amdgcn_cvt_pk_fp8_f32(v1.x * inv, v1.y * inv, t, false); t = __builtin_amdgcn_cvt_pk_fp8_f32(v1.z * inv, v1.w * inv, t, true); o.y = t;
    t = 0u; t = __builtin_amdgcn_cvt_pk_fp8_f32(v2.x * inv, v2.y * inv, t, false); t = __builtin_amdgcn_cvt_pk_fp8_f32(v2.z * inv, v2.w * inv, t, true); o.z = t;
    t = 0u; t = __builtin_amdgcn_cvt_pk_fp8_f32(v3.x * inv, v3.y * inv, t, false); t = __builtin_amdgcn_cvt_pk_fp8_f32(v3.z * inv, v3.w * inv, t, true); o.w = t;
    *(u32x4*)(dst + ((size_t)(lane >> 3) * nrows + row) * 128 + (lane & 7) * 16) = o;
    if (lane == 0) scales[row] = sc;
}
DI void conv_rows_fp8(const float* __restrict__ src, const float* __restrict__ gain, fp8_t* __restrict__ dst, float* __restrict__ scales,
                      int nrows, int gwave, int nwaves, int lane) {
#pragma unroll 1
    for (int row = gwave; row < nrows; row += 4 * nwaves) {
        const int r1 = min(row + nwaves, nrows - 1), r2 = min(row + 2 * nwaves, nrows - 1), r3 = min(row + 3 * nwaves, nrows - 1);
        const float4* p0 = (const float4*)(src + (size_t)row * DM + lane * 16);
        const float4* p1 = (const float4*)(src + (size_t)r1 * DM + lane * 16);
        const float4* p2 = (const float4*)(src + (size_t)r2 * DM + lane * 16);
        const float4* p3 = (const float4*)(src + (size_t)r3 * DM + lane * 16);
        const float4 a0 = p0[0], a1 = p0[1], a2 = p0[2], a3 = p0[3];
        const float4 b0 = p1[0], b1 = p1[1], b2 = p1[2], b3 = p1[3];
        const float4 c0 = p2[0], c1 = p2[1], c2 = p2[2], c3 = p2[3];
        const float4 d0 = p3[0], d1 = p3[1], d2 = p3[2], d3 = p3[3];
        conv_row_fp8_one(a0, a1, a2, a3, gain, dst, scales, nrows, row, lane);
        conv_row_fp8_one(b0, b1, b2, b3, gain, dst, scales, nrows, r1, lane);
        conv_row_fp8_one(c0, c1, c2, c3, gain, dst, scales, nrows, r2, lane);
        conv_row_fp8_one(d0, d1, d2, d3, gain, dst, scales, nrows, r3, lane);
    }
}

struct RowOct { u32x4 r0, r1, r2, r3, r4, r5, r6, r7; };
DI void oct_load(RowOct& q, const fp8_t* tab, int e0, int e1, int e2, int e3, int e4, int e5, int e6, int e7, int lane) {
    q.r0 = ((grow_t)(tab + (size_t)e0 * DM))[lane]; q.r1 = ((grow_t)(tab + (size_t)e1 * DM))[lane];
    q.r2 = ((grow_t)(tab + (size_t)e2 * DM))[lane]; q.r3 = ((grow_t)(tab + (size_t)e3 * DM))[lane];
    q.r4 = ((grow_t)(tab + (size_t)e4 * DM))[lane]; q.r5 = ((grow_t)(tab + (size_t)e5 * DM))[lane];
    q.r6 = ((grow_t)(tab + (size_t)e6 * DM))[lane]; q.r7 = ((grow_t)(tab + (size_t)e7 * DM))[lane];
}
DI float dot4w(unsigned w, float h0, float h1, float h2, float h3, float s) {
    const f2_t lo = __builtin_amdgcn_cvt_pk_f32_fp8(w, false), hi = __builtin_amdgcn_cvt_pk_f32_fp8(w, true);
    s = fmaf(lo.x, h0, s); s = fmaf(lo.y, h1, s); s = fmaf(hi.x, h2, s); s = fmaf(hi.y, h3, s);
    return s;
}
DI float row_dot8(const u32x4& r, const float (&h)[16]) {
    float s = 0.f;
    s = dot4w(r.x, h[0], h[1], h[2], h[3], s); s = dot4w(r.y, h[4], h[5], h[6], h[7], s);
    s = dot4w(r.z, h[8], h[9], h[10], h[11], s); s = dot4w(r.w, h[12], h[13], h[14], h[15], s);
    return s;
}
DI void axpy4w(unsigned w, float c, float& a0, float& a1, float& a2, float& a3) {
    const f2_t lo = __builtin_amdgcn_cvt_pk_f32_fp8(w, false), hi = __builtin_amdgcn_cvt_pk_f32_fp8(w, true);
    a0 = fmaf(c, lo.x, a0); a1 = fmaf(c, lo.y, a1); a2 = fmaf(c, hi.x, a2); a3 = fmaf(c, hi.y, a3);
}
DI void row_axpy8(float (&acc)[16], const u32x4& r, float c) {
    axpy4w(r.x, c, acc[0], acc[1], acc[2], acc[3]); axpy4w(r.y, c, acc[4], acc[5], acc[6], acc[7]);
    axpy4w(r.z, c, acc[8], acc[9], acc[10], acc[11]); axpy4w(r.w, c, acc[12], acc[13], acc[14], acc[15]);
}
#define RL(v, l) __builtin_amdgcn_readlane((v), (l))
#define RLF(v, l) __uint_as_float((unsigned)__builtin_amdgcn_readlane((int)__float_as_uint(v), (l)))

DI float reduce16(float (&p)[16], int lane) {
    const bool b5 = lane & 32, b4 = lane & 16, b3 = lane & 8, b2 = lane & 4;
    float q8[8], q4[4], q2[2];
#pragma unroll
    for (int k = 0; k < 8; ++k) { const float keep = b5 ? p[k + 8] : p[k], send = b5 ? p[k] : p[k + 8]; q8[k] = keep + shx<32>(send, lane); }
#pragma unroll
    for (int k = 0; k < 4; ++k) { const float keep = b4 ? q8[k + 4] : q8[k], send = b4 ? q8[k] : q8[k + 4]; q4[k] = keep + shx<16>(send, lane); }
#pragma unroll
    for (int k = 0; k < 2; ++k) { const float keep = b3 ? q4[k + 2] : q4[k], send = b3 ? q4[k] : q4[k + 2]; q2[k] = keep + shx<8>(send, lane); }
    float t;
    { const float keep = b2 ? q2[1] : q2[0], send = b2 ? q2[0] : q2[1]; t = keep + shx<4>(send, lane); }
    t += shx<1>(t, lane); t += shx<2>(t, lane);
    return t;
}

DI void phaseC3_tile(const PGArgs& a, int tile, int wid) {
    int tid = get_tid(wid);
    const int w = __builtin_amdgcn_readfirstlane(tid >> 6), lane = tid & 63;
    const int el = (lane >> 2) & 15;
#pragma unroll 1
    for (int ti = 0; ti < 8; ++ti) {
        const int tok = tile * 64 + w * 8 + ti;
        float h[16];
        {
            const u32x4* hp = (const u32x4*)(a.Hb + (size_t)tok * DM + lane * 16);
            const u32x4 h0 = hp[0], h1 = hp[1];
            h[0] = bf_lo(h0.x); h[1] = bf_hi(h0.x); h[2] = bf_lo(h0.y); h[3] = bf_hi(h0.y); h[4] = bf_lo(h0.z); h[5] = bf_hi(h0.z); h[6] = bf_lo(h0.w); h[7] = bf_hi(h0.w);
            h[8] = bf_lo(h1.x); h[9] = bf_hi(h1.x); h[10] = bf_lo(h1.y); h[11] = bf_hi(h1.y); h[12] = bf_lo(h1.z); h[13] = bf_hi(h1.z); h[14] = bf_lo(h1.w); h[15] = bf_hi(h1.w);
        }
        const float rs = a.RSTD[tok];
        float acc[16];
#pragma unroll
        for (int i = 0; i < 16; ++i) acc[i] = 0.f;
#pragma unroll 1
        for (int hd = 0; hd < 8; ++hd) {
            const size_t eb = ((size_t)tok * 8 + hd) * 16;
            const int exv = a.EX[eb + (lane & 15)];
            const int exl = a.EX[eb + el];
            const float coef = a.GT[eb + el] * a.SV[exl];
            const float su = a.SU[exl] * rs;
            RowOct qa, qb;
            float p[16];
            oct_load(qa, a.U8, RL(exv, 0), RL(exv, 1), RL(exv, 2), RL(exv, 3), RL(exv, 4), RL(exv, 5), RL(exv, 6), RL(exv, 7), lane);
            oct_load(qb, a.U8, RL(exv, 8), RL(exv, 9), RL(exv, 10), RL(exv, 11), RL(exv, 12), RL(exv, 13), RL(exv, 14), RL(exv, 15), lane);
            p[0] = row_dot8(qa.r0, h); p[1] = row_dot8(qa.r1, h); p[2] = row_dot8(qa.r2, h); p[3] = row_dot8(qa.r3, h);
            p[4] = row_dot8(qa.r4, h); p[5] = row_dot8(qa.r5, h); p[6] = row_dot8(qa.r6, h); p[7] = row_dot8(qa.r7, h);
            oct_load(qa, a.V8, RL(exv, 0), RL(exv, 1), RL(exv, 2), RL(exv, 3), RL(exv, 4), RL(exv, 5), RL(exv, 6), RL(exv, 7), lane);
            p[8] = row_dot8(qb.r0, h); p[9] = row_dot8(qb.r1, h); p[10] = row_dot8(qb.r2, h); p[11] = row_dot8(qb.r3, h);
            p[12] = row_dot8(qb.r4, h); p[13] = row_dot8(qb.r5, h); p[14] = row_dot8(qb.r6, h); p[15] = row_dot8(qb.r7, h);
            oct_load(qb, a.V8, RL(exv, 8), RL(exv, 9), RL(exv, 10), RL(exv, 11), RL(exv, 12), RL(exv, 13), RL(exv, 14), RL(exv, 15), lane);
            const float act = gelu_exact(reduce16(p, lane) * su) * coef;
            row_axpy8(acc, qa.r0, RLF(act, 0)); row_axpy8(acc, qa.r1, RLF(act, 4)); row_axpy8(acc, qa.r2, RLF(act, 8)); row_axpy8(acc, qa.r3, RLF(act, 12));
            row_axpy8(acc, qa.r4, RLF(act, 16)); row_axpy8(acc, qa.r5, RLF(act, 20)); row_axpy8(acc, qa.r6, RLF(act, 24)); row_axpy8(acc, qa.r7, RLF(act, 28));
            row_axpy8(acc, qb.r0, RLF(act, 32)); row_axpy8(acc, qb.r1, RLF(act, 36)); row_axpy8(acc, qb.r2, RLF(act, 40)); row_axpy8(acc, qb.r3, RLF(act, 44));
            row_axpy8(acc, qb.r4, RLF(act, 48)); row_axpy8(acc, qb.r5, RLF(act, 52)); row_axpy8(acc, qb.r6, RLF(act, 56)); row_axpy8(acc, qb.r7, RLF(act, 60));
        }
        const float* xi = a.Xin + (size_t)tok * DM + lane * 16;
        float* xo = a.Xout + (size_t)tok * DM + lane * 16;
        float4 x0 = *(const float4*)xi, x1 = *(const float4*)(xi + 4), x2 = *(const float4*)(xi + 8), x3 = *(const float4*)(xi + 12);
        x0.x += acc[0]; x0.y += acc[1]; x0.z += acc[2]; x0.w += acc[3]; x1.x += acc[4]; x1.y += acc[5]; x1.z += acc[6]; x1.w += acc[7];
        x2.x += acc[8]; x2.y += acc[9]; x2.z += acc[10]; x2.w += acc[11]; x3.x += acc[12]; x3.y += acc[13]; x3.z += acc[14]; x3.w += acc[15];
        if (a.final_norm) {
            float ss = x0.x * x0.x + x0.y * x0.y + x0.z * x0.z + x0.w * x0.w + x1.x * x1.x + x1.y * x1.y + x1.z * x1.z + x1.w * x1.w
                     + x2.x * x2.x + x2.y * x2.y + x2.z * x2.z + x2.w * x2.w + x3.x * x3.x + x3.y * x3.y + x3.z * x3.z + x3.w * x3.w;
            ss = wave_sum(ss, lane);
            const float rf = rsqrtf(ss * (1.f / 1024.f) + 1e-6f);
            const float* gf = a.gfinal + lane * 16;
            const float4 g0 = *(const float4*)gf, g1 = *(const float4*)(gf + 4), g2 = *(const float4*)(gf + 8), g3 = *(const float4*)(gf + 12);
            x0.x *= rf * g0.x; x0.y *= rf * g0.y; x0.z *= rf * g0.z; x0.w *= rf * g0.w; x1.x *= rf * g1.x; x1.y *= rf * g1.y; x1.z *= rf * g1.z; x1.w *= rf * g1.w;
            x2.x *= rf * g2.x; x2.y *= rf * g2.y; x2.z *= rf * g2.z; x2.w *= rf * g2.w; x3.x *= rf * g3.x; x3.y *= rf * g3.y; x3.z *= rf * g3.z; x3.w *= rf * g3.w;
        }
        *(float4*)xo = x0; *(float4*)(xo + 4) = x1; *(float4*)(xo + 8) = x2; *(float4*)(xo + 12) = x3;
    }
}
#define XB_TMO      128
#define XB_XCNT(j)  (256  + 64 * (j))
#define XB_XSUB(j)  (1280 + 64 * (j))
#define XB_XGEN(j)  (2304 + 64 * (j))
#define XB_TOP      3328
#define XB_TOPGEN   3392
#define XB_QUEUE(j) (3456 + 64 * (j))
#define XCD_BAR_WORDS (3456 + 64 * 64)
#define XB_SPIN_CAP (1u << 20)
#define LAS __attribute__((address_space(3)))

DI unsigned xb_ld(unsigned* p)              { return __hip_atomic_load(p, __ATOMIC_RELAXED, __HIP_MEMORY_SCOPE_AGENT); }
DI unsigned xb_add(unsigned* p, unsigned v) { return __hip_atomic_fetch_add(p, v, __ATOMIC_RELAXED, __HIP_MEMORY_SCOPE_AGENT); }
DI unsigned xb_xcc_id() { return (unsigned)__builtin_amdgcn_s_getreg((3 << 11) | 20) & 0xFu; }
#define XB_SPIN(cond, bar) do { unsigned _sp = 0; while (cond) { __builtin_amdgcn_s_sleep(1); \
    if ((++_sp & 255u) == 0u) { if (xb_ld(&(bar)[XB_TMO])) break; if (_sp > XB_SPIN_CAP) { atomicAdd(&(bar)[XB_TMO], 1u); break; } } } } while (0)

struct XcdBarrier { unsigned* bar; unsigned x; volatile LAS unsigned* st; };

DI XcdBarrier xcd_barrier_post(unsigned* bar, volatile LAS unsigned* st, int tid) {
    XcdBarrier b; b.bar = bar; b.x = xb_xcc_id(); b.st = st;
    if (tid == 0) st[2] = xb_add(&bar[XB_XCNT(b.x)], 1u);
    return b;
}
DI void xcd_barrier_complete(unsigned* bar, unsigned x, unsigned& nloc, unsigned& nx) {
    const unsigned G = gridDim.x * gridDim.y * gridDim.z;
    unsigned sum, cnt, mine, sp = 0u;
    for (;;) {
        sum = 0u; cnt = 0u; mine = 0u;
#pragma unroll
        for (unsigned j = 0; j < 16; ++j) { const unsigned c = xb_ld(&bar[XB_XCNT(j)]); sum += c; cnt += (c > 0u) ? 1u : 0u; mine = (j == x) ? c : mine; }
        if (sum == G) break;
        __builtin_amdgcn_s_sleep(1);
        if ((++sp & 255u) == 0u) { if (xb_ld(&bar[XB_TMO])) break; if (sp > XB_SPIN_CAP) { atomicAdd(&bar[XB_TMO], 1u); break; } }
    }
    nloc = mine > 0u ? mine : 1u; nx = cnt > 0u ? cnt : 1u;
}
DI void xcd_barrier(const XcdBarrier& b, int wid) {
    asm volatile("s_waitcnt vmcnt(0)" ::: "memory");
    __syncthreads();
    if (get_tid(wid) == 0) {
        unsigned* bar = b.bar;
        __builtin_amdgcn_s_waitcnt(0);
        unsigned nloc = b.st[0], nx = b.st[1];
        if (nloc == 0u) { xcd_barrier_complete(bar, b.x, nloc, nx); b.st[0] = nloc; b.st[1] = nx; }
        const unsigned old = xb_add(&bar[XB_XSUB(b.x)], 1u);
        const unsigned gen = old / nloc;
        if (old + 1u == (gen + 1u) * nloc) {
            __builtin_amdgcn_fence(__ATOMIC_RELEASE, "agent");
            asm volatile("s_waitcnt vmcnt(0)" ::: "memory");
            const unsigned og = xb_add(&bar[XB_TOP], 1u);
            const unsigned tg = og / nx;
            if (og + 1u == (tg + 1u) * nx) xb_add(&bar[XB_TOPGEN], 1u);
            else XB_SPIN(xb_ld(&bar[XB_TOPGEN]) == tg, bar);
            __builtin_amdgcn_fence(__ATOMIC_ACQUIRE, "agent");
            xb_add(&bar[XB_XGEN(b.x)], 1u);
            asm volatile("s_waitcnt vmcnt(0)" ::: "memory");
        } else {
            XB_SPIN(xb_ld(&bar[XB_XGEN(b.x)]) == gen, bar);
            __builtin_amdgcn_fence(__ATOMIC_ACQUIRE, "agent");
            asm volatile("s_waitcnt vmcnt(0)" ::: "memory");
        }
    }
    __syncthreads();
}
#ifndef U_FP4
#define U_FP4 1
#endif
#if U_FP4
#define NUSL 4
#else
#define NUSL 8
#endif
struct PSArgs {
    const bf16_t* Hb; const float* RSTD; const unsigned short* EX; const float* GT; const fp8_t* U8; const fp8_t* V8; const float* SU; const float* SV;
    float* PD; bf16_t* COEF; const float* Xin; float* Xout;
};

DI void dot4p(unsigned w, const f2_t& h01, const f2_t& h23, f2_t& s2) {
    const f2_t lo = __builtin_amdgcn_cvt_pk_f32_fp8(w, false), hi = __builtin_amdgcn_cvt_pk_f32_fp8(w, true);
    s2 = __builtin_elementwise_fma(lo, h01, s2); s2 = __builtin_elementwise_fma(hi, h23, s2);
}
DI float row_dot8p(const u32x4& r, const f2_t (&h)[8]) {
    f2_t s2 = {0.f, 0.f};
    dot4p(r.x, h[0], h[1], s2); dot4p(r.y, h[2], h[3], s2); dot4p(r.z, h[4], h[5], s2); dot4p(r.w, h[6], h[7], s2);
    return s2.x + s2.y;
}
DI void axpy4p(unsigned w, const f2_t& c2, f2_t& a01, f2_t& a23) {
    const f2_t lo = __builtin_amdgcn_cvt_pk_f32_fp8(w, false), hi = __builtin_amdgcn_cvt_pk_f32_fp8(w, true);
    a01 = __builtin_elementwise_fma(c2, lo, a01); a23 = __builtin_elementwise_fma(c2, hi, a23);
}
DI void row_axpy8p(f2_t (&acc)[8], const u32x4& r, float c) {
    const f2_t c2 = {c, c};
    axpy4p(r.x, c2, acc[0], acc[1]); axpy4p(r.y, c2, acc[2], acc[3]); axpy4p(r.z, c2, acc[4], acc[5]); axpy4p(r.w, c2, acc[6], acc[7]);
}

DI int run_token(int n, int k, int nloc, int wid) { return (k + (n >> 3) * nloc) * 64 + wid * 8 + (n & 7); }

struct Ids16 { u32x4 a, b; };
DI void ids_load(Ids16& q, const unsigned short* EX, int tok, int rg) { const u32x4* p = (const u32x4*)(EX + (size_t)tok * 128 + rg * 16); q.a = p[0]; q.b = p[1]; }
#define ID_LO(w) (((w) & 0xFFFFu) * 128u + loff)
#define ID_HI(w) (((w) >> 16) * 128u + loff)
DI void rows_lo(u32x4 (&r)[8], const Ids16& q, const fp8_t* tab, unsigned loff) {
    r[0] = *(grow_t)(tab + ID_LO(q.a.x)); r[1] = *(grow_t)(tab + ID_HI(q.a.x)); r[2] = *(grow_t)(tab + ID_LO(q.a.y)); r[3] = *(grow_t)(tab + ID_HI(q.a.y));
    r[4] = *(grow_t)(tab + ID_LO(q.a.z)); r[5] = *(grow_t)(tab + ID_HI(q.a.z)); r[6] = *(grow_t)(tab + ID_LO(q.a.w)); r[7] = *(grow_t)(tab + ID_HI(q.a.w));
}
DI void rows_hi(u32x4 (&r)[8], const Ids16& q, const fp8_t* tab, unsigned loff) {
    r[0] = *(grow_t)(tab + ID_LO(q.b.x)); r[1] = *(grow_t)(tab + ID_HI(q.b.x)); r[2] = *(grow_t)(tab + ID_LO(q.b.y)); r[3] = *(grow_t)(tab + ID_HI(q.b.y));
    r[4] = *(grow_t)(tab + ID_LO(q.b.z)); r[5] = *(grow_t)(tab + ID_HI(q.b.z)); r[6] = *(grow_t)(tab + ID_LO(q.b.w)); r[7] = *(grow_t)(tab + ID_HI(q.b.w));
}
DI void unpack_h(f2_t (&h)[8], const u32x4& h0, const u32x4& h1) {
    h[0] = (f2_t){bf_lo(h0.x), bf_hi(h0.x)}; h[1] = (f2_t){bf_lo(h0.y), bf_hi(h0.y)}; h[2] = (f2_t){bf_lo(h0.z), bf_hi(h0.z)}; h[3] = (f2_t){bf_lo(h0.w), bf_hi(h0.w)};
    h[4] = (f2_t){bf_lo(h1.x), bf_hi(h1.x)}; h[5] = (f2_t){bf_lo(h1.y), bf_hi(h1.y)}; h[6] = (f2_t){bf_lo(h1.z), bf_hi(h1.z)}; h[7] = (f2_t){bf_lo(h1.w), bf_hi(h1.w)};
}
DI void dots8(float* p, const u32x4 (&r)[8], const f2_t (&h)[8]) {
#pragma unroll
    for (int i = 0; i < 8; ++i) { p[i] = row_dot8p(r[i], h); if ((i & 1) == 1) __builtin_amdgcn_sched_barrier(0); }
}
DI void peerU_finish(const PSArgs& a, float (&p)[16], int tok, int s, int lane) {
    const int rg = lane >> 3, pc = lane & 7;
    const bool b2 = pc & 4, b1 = pc & 2, b0 = pc & 1;
    float q8[8], q4[4], q2[2];
#pragma unroll
    for (int k = 0; k < 8; ++k) { const float keep = b2 ? p[k + 8] : p[k], send = b2 ? p[k] : p[k + 8]; q8[k] = keep + shx<4>(send, lane); }
#pragma unroll
    for (int k = 0; k < 4; ++k) { const float keep = b1 ? q8[k + 4] : q8[k], send = b1 ? q8[k] : q8[k + 4]; q4[k] = keep + shx<2>(send, lane); }
#pragma unroll
    for (int k = 0; k < 2; ++k) { const float keep = b0 ? q4[k + 2] : q4[k], send = b0 ? q4[k] : q4[k + 2]; q2[k] = keep + shx<1>(send, lane); }
    *(float2*)(a.PD + ((size_t)s * NTOK + tok) * 128 + rg * 16 + 2 * pc) = make_float2(q2[0], q2[1]);
}

DI void peerU_run(const PSArgs& a, int s, int k, int nloc, int wid) {
    const int tid = get_tid(wid);
    const int lane = tid & 63, rg = lane >> 3, pc = lane & 7;
    const unsigned loff = (unsigned)(s * (NEXP * 128) + pc * 16);
    const int hoff = s * 128 + pc * 16;
    const int N = 8 * ((NTOK / 64 - k + nloc - 1) / nloc);
    Ids16 idE, idO;
    u32x4 rA[8], rB[8], hE0, hE1, hO0, hO1;
#define LOAD_H(d0, d1, tokv) { const u32x4* hp_ = (const u32x4*)(a.Hb + (size_t)(tokv) * DM + hoff); d0 = hp_[0]; d1 = hp_[1]; }
    ids_load(idE, a.EX, run_token(0, k, nloc, wid), rg);
    ids_load(idO, a.EX, run_token(1, k, nloc, wid), rg);
    rows_lo(rA, idE, a.U8, loff); LOAD_H(hE0, hE1, run_token(0, k, nloc, wid)); rows_hi(rB, idE, a.U8, loff);
#pragma unroll 1
    for (int n = 0; n < N; n += 2) {
        const int t0 = run_token(n, k, nloc, wid), t1 = run_token(n + 1, k, nloc, wid);
        const int t2 = run_token((n + 2 < N) ? n + 2 : N - 1, k, nloc, wid), t3 = run_token((n + 3 < N) ? n + 3 : N - 1, k, nloc, wid);
        {
            f2_t h[8]; float p[16];
            unpack_h(h, hE0, hE1);
            dots8(p, rA, h);
            rows_lo(rA, idO, a.U8, loff); LOAD_H(hO0, hO1, t1);
            dots8(p + 8, rB, h);
            rows_hi(rB, idO, a.U8, loff);
            ids_load(idE, a.EX, t2, rg);
            peerU_finish(a, p, t0, s, lane);
        }
        {
            f2_t h[8]; float p[16];
            unpack_h(h, hO0, hO1);
            dots8(p, rA, h);
            rows_lo(rA, idE, a.U8, loff); LOAD_H(hE0, hE1, t2);
            dots8(p + 8, rB, h);
            rows_hi(rB, idE, a.U8, loff);
            ids_load(idO, a.EX, t3, rg);
            peerU_finish(a, p, t1, s, lane);
        }
    }
#undef LOAD_H
}

DI void peerR_tile(const PSArgs& a, int tile, int wid) {
    const int tid = get_tid(wid);
    const int lane = tid & 63;
#pragma unroll 1
    for (int ti = 0; ti < 8; ++ti) {
        const int tok = tile * 64 + wid * 8 + ti;
        float d0 = 0.f, d1 = 0.f;
#pragma unroll
        for (int x = 0; x < NUSL; ++x) { const float2 v = *(const float2*)(a.PD + ((size_t)x * NTOK + tok) * 128 + 2 * lane); d0 += v.x; d1 += v.y; }
        const unsigned exw = *(const unsigned*)(a.EX + (size_t)tok * 128 + 2 * lane);
        const int2 ex = make_int2((int)(exw & 0xFFFFu), (int)(exw >> 16));
        const float2 gt = *(const float2*)(a.GT + (size_t)tok * 128 + 2 * lane);
        const float rs = a.RSTD[tok];
        float2 o;
        o.x = gelu_exact(d0 * a.SU[ex.x] * rs) * gt.x * a.SV[ex.x];
        o.y = gelu_exact(d1 * a.SU[ex.y] * rs) * gt.y * a.SV[ex.y];
        *(unsigned*)(a.COEF + (size_t)tok * 128 + 2 * lane) = pack_bf2(o.x, o.y);
    }
}

struct Cf16 { u32x4 a, b; };
DI void cf_load(Cf16& q, const bf16_t* COEF, int tok, int rg) { const u32x4* p = (const u32x4*)(COEF + (size_t)tok * 128 + rg * 16); q.a = p[0]; q.b = p[1]; }
DI void axpy8(f2_t (&acc)[8], const u32x4 (&r)[8], const u32x4& c) {
    row_axpy8p(acc, r[0], bf_lo(c.x)); row_axpy8p(acc, r[1], bf_hi(c.x)); __builtin_amdgcn_sched_barrier(0);
    row_axpy8p(acc, r[2], bf_lo(c.y)); row_axpy8p(acc, r[3], bf_hi(c.y)); __builtin_amdgcn_sched_barrier(0);
    row_axpy8p(acc, r[4], bf_lo(c.z)); row_axpy8p(acc, r[5], bf_hi(c.z)); __builtin_amdgcn_sched_barrier(0);
    row_axpy8p(acc, r[6], bf_lo(c.w)); row_axpy8p(acc, r[7], bf_hi(c.w)); __builtin_amdgcn_sched_barrier(0);
}
DI void peerV_finish(const PSArgs& a, f2_t (&acc)[8], float2 xv, int tok, int s, int lane) {
    const int rg = lane >> 3, pc = lane & 7;
    const bool r2 = rg & 4, r1 = rg & 2, r0 = rg & 1;
    f2_t q4[4], q2[2], q1;
#pragma unroll
    for (int k = 0; k < 4; ++k) {
        const f2_t keep = r2 ? acc[k + 4] : acc[k], send = r2 ? acc[k] : acc[k + 4];
        q4[k] = (f2_t){keep.x + shx<32>(send.x, lane), keep.y + shx<32>(send.y, lane)};
    }
#pragma unroll
    for (int k = 0; k < 2; ++k) {
        const f2_t keep = r1 ? q4[k + 2] : q4[k], send = r1 ? q4[k] : q4[k + 2];
        q2[k] = (f2_t){keep.x + shx<16>(send.x, lane), keep.y + shx<16>(send.y, lane)};
    }
    {
        const f2_t keep = r0 ? q2[1] : q2[0], send = r0 ? q2[0] : q2[1];
        q1 = (f2_t){keep.x + shx<8>(send.x, lane), keep.y + shx<8>(send.y, lane)};
    }
    xv.x += q1.x; xv.y += q1.y;
    *(float2*)(a.Xout + (size_t)tok * DM + s * 128 + 16 * pc + 2 * rg) = xv;
}

DI void peerV_run(const PSArgs& a, int s, int k, int nloc, int wid) {
    const int tid = get_tid(wid);
    const int lane = tid & 63, rg = lane >> 3, pc = lane & 7;
    const unsigned loff = (unsigned)(s * (NEXP * 128) + pc * 16);
    const int N = 8 * ((NTOK / 64 - k + nloc - 1) / nloc);
    Ids16 idE, idO; Cf16 cfE, cfO; float2 xE, xO;
    u32x4 rA[8], rB[8];
#define LOAD_X(x_, tokv) { x_ = *(const float2*)(a.Xin + (size_t)(tokv) * DM + s * 128 + 16 * pc + 2 * rg); }
    ids_load(idE, a.EX, run_token(0, k, nloc, wid), rg);
    ids_load(idO, a.EX, run_token(1, k, nloc, wid), rg);
    rows_lo(rA, idE, a.V8, loff); cf_load(cfE, a.COEF, run_token(0, k, nloc, wid), rg); rows_hi(rB, idE, a.V8, loff); LOAD_X(xE, run_token(0, k, nloc, wid));
#pragma unroll 1
    for (int n = 0; n < N; n += 2) {
        const int t0 = run_token(n, k, nloc, wid), t1 = run_token(n + 1, k, nloc, wid);
        const int t2 = run_token((n + 2 < N) ? n + 2 : N - 1, k, nloc, wid), t3 = run_token((n + 3 < N) ? n + 3 : N - 1, k, nloc, wid);
        {
            f2_t acc[8];
#pragma unroll
            for (int i = 0; i < 8; ++i) acc[i] = (f2_t){0.f, 0.f};
            axpy8(acc, rA, cfE.a);
            rows_lo(rA, idO, a.V8, loff); cf_load(cfO, a.COEF, t1, rg);
            axpy8(acc, rB, cfE.b);
            rows_hi(rB, idO, a.V8, loff); LOAD_X(xO, t1);
            ids_load(idE, a.EX, t2, rg);
            peerV_finish(a, acc, xE, t0, s, lane);
        }
        {
            f2_t acc[8];
#pragma unroll
            for (int i = 0; i < 8; ++i) acc[i] = (f2_t){0.f, 0.f};
            axpy8(acc, rA, cfO.a);
            rows_lo(rA, idE, a.V8, loff); cf_load(cfE, a.COEF, t2, rg);
            axpy8(acc, rB, cfO.b);
            rows_hi(rB, idE, a.V8, loff); LOAD_X(xE, t2);
            ids_load(idO, a.EX, t3, rg);
            peerV_finish(a, acc, xO, t1, s, lane);
        }
    }
#undef LOAD_X
}

DI void final_norm_tile(float* X, const float* __restrict__ g, int tile, int wid) {
    const int tid = get_tid(wid);
    const int lane = tid & 63;
    const float* gf = g + lane * 16;
    const float4 g0 = *(const float4*)gf, g1 = *(const float4*)(gf + 4), g2 = *(const float4*)(gf + 8), g3 = *(const float4*)(gf + 12);
#pragma unroll 1
    for (int ti = 0; ti < 8; ++ti) {
        float* xp = X + (size_t)(tile * 64 + wid * 8 + ti) * DM + lane * 16;
        float4 x0 = *(const float4*)xp, x1 = *(const float4*)(xp + 4), x2 = *(const float4*)(xp + 8), x3 = *(const float4*)(xp + 12);
        float ss = x0.x * x0.x + x0.y * x0.y + x0.z * x0.z + x0.w * x0.w + x1.x * x1.x + x1.y * x1.y + x1.z * x1.z + x1.w * x1.w
                 + x2.x * x2.x + x2.y * x2.y + x2.z * x2.z + x2.w * x2.w + x3.x * x3.x + x3.y * x3.y + x3.z * x3.z + x3.w * x3.w;
        ss = wave_sum(ss, lane);
        const float rf = rsqrtf(ss * (1.f / 1024.f) + 1e-6f);
        x0.x *= rf * g0.x; x0.y *= rf * g0.y; x0.z *= rf * g0.z; x0.w *= rf * g0.w; x1.x *= rf * g1.x; x1.y *= rf * g1.y; x1.z *= rf * g1.z; x1.w *= rf * g1.w;
        x2.x *= rf * g2.x; x2.y *= rf * g2.y; x2.z *= rf * g2.z; x2.w *= rf * g2.w; x3.x *= rf * g3.x; x3.y *= rf * g3.y; x3.z *= rf * g3.z; x3.w *= rf * g3.w;
        *(float4*)xp = x0; *(float4*)(xp + 4) = x1; *(float4*)(xp + 8) = x2; *(float4*)(xp + 12) = x3;
    }
}

typedef unsigned char fp4x2_t;
DI void conv_row_fp4_one(float4 v0, float4 v1, float4 v2, float4 v3, fp4x2_t* __restrict__ dst, float* __restrict__ scales, int nrows, int row, int lane) {
    float m = fmaxf(fmaxf(fmaxf(fabsf(v0.x), fabsf(v0.y)), fmaxf(fabsf(v0.z), fabsf(v0.w))), fmaxf(fmaxf(fabsf(v1.x), fabsf(v1.y)), fmaxf(fabsf(v1.z), fabsf(v1.w))));
    m = fmaxf(m, fmaxf(fmaxf(fmaxf(fabsf(v2.x), fabsf(v2.y)), fmaxf(fabsf(v2.z), fabsf(v2.w))), fmaxf(fmaxf(fabsf(v3.x), fabsf(v3.y)), fmaxf(fabsf(v3.z), fabsf(v3.w)))));
    m = fmaxf(m, shx<1>(m, lane)); m = fmaxf(m, shx<2>(m, lane)); m = fmaxf(m, shx<4>(m, lane)); m = fmaxf(m, shx<8>(m, lane)); m = fmaxf(m, shx<16>(m, lane)); m = fmaxf(m, shx<32>(m, lane));
    const float sc = (m > 0.f) ? m * (1.f / 6.f) : 1.f;
    const float inv = 1.f / sc;
    unsigned d0 = 0u, d1 = 0u;
    d0 = __builtin_amdgcn_cvt_scalef32_pk_fp4_f32(d0, v0.x * inv, v0.y * inv, 1.0f, 0); d0 = __builtin_amdgcn_cvt_scalef32_pk_fp4_f32(d0, v0.z * inv, v0.w * inv, 1.0f, 1);
    d0 = __builtin_amdgcn_cvt_scalef32_pk_fp4_f32(d0, v1.x * inv, v1.y * inv, 1.0f, 2); d0 = __builtin_amdgcn_cvt_scalef32_pk_fp4_f32(d0, v1.z * inv, v1.w * inv, 1.0f, 3);
    d1 = __builtin_amdgcn_cvt_scalef32_pk_fp4_f32(d1, v2.x * inv, v2.y * inv, 1.0f, 0); d1 = __builtin_amdgcn_cvt_scalef32_pk_fp4_f32(d1, v2.z * inv, v2.w * inv, 1.0f, 1);
    d1 = __builtin_amdgcn_cvt_scalef32_pk_fp4_f32(d1, v3.x * inv, v3.y * inv, 1.0f, 2); d1 = __builtin_amdgcn_cvt_scalef32_pk_fp4_f32(d1, v3.z * inv, v3.w * inv, 1.0f, 3);
    *(uint2*)(dst + ((size_t)(lane >> 4) * nrows + row) * 128 + (lane & 15) * 8) = make_uint2(d0, d1);
    if (lane == 0) scales[row] = sc;
}
DI void conv_rows_fp4(const float* __restrict__ src, fp4x2_t* __restrict__ dst, float* __restrict__ scales, int nrows, int gwave, int nwaves, int lane) {
#pragma unroll 1
    for (int row = gwave; row < nrows; row += 2 * nwaves) {
        const int r1 = min(row + nwaves, nrows - 1);
        const float4* p0 = (const float4*)(src + (size_t)row * DM + lane * 16);
        const float4* p1 = (const float4*)(src + (size_t)r1 * DM + lane * 16);
        const float4 a0 = p0[0], a1 = p0[1], a2 = p0[2], a3 = p0[3];
        const float4 b0 = p1[0], b1 = p1[1], b2 = p1[2], b3 = p1[3];
        conv_row_fp4_one(a0, a1, a2, a3, dst, scales, nrows, row, lane);
        conv_row_fp4_one(b0, b1, b2, b3, dst, scales, nrows, r1, lane);
    }
}

typedef __attribute__((ext_vector_type(2))) _Float16 h2_t;
DI h2_t cvt4(unsigned w, int b) {
    return b == 0 ? __builtin_amdgcn_cvt_scalef32_pk_f16_fp4(w, 1.0f, 0) : b == 1 ? __builtin_amdgcn_cvt_scalef32_pk_f16_fp4(w, 1.0f, 1)
         : b == 2 ? __builtin_amdgcn_cvt_scalef32_pk_f16_fp4(w, 1.0f, 2) : __builtin_amdgcn_cvt_scalef32_pk_f16_fp4(w, 1.0f, 3);
}
DI void row_axpy32h(h2_t (&acc)[16], const u32x4& r, float c) {
    const _Float16 ch = (_Float16)c; const h2_t c2 = {ch, ch};
#pragma unroll
    for (int b = 0; b < 4; ++b) {
        acc[b] = __builtin_elementwise_fma(c2, cvt4(r.x, b), acc[b]); acc[4 + b] = __builtin_elementwise_fma(c2, cvt4(r.y, b), acc[4 + b]);
        acc[8 + b] = __builtin_elementwise_fma(c2, cvt4(r.z, b), acc[8 + b]); acc[12 + b] = __builtin_elementwise_fma(c2, cvt4(r.w, b), acc[12 + b]);
    }
}
DI void axpy8_4(h2_t (&acc)[16], const u32x4 (&r)[8], const u32x4& c) {
    row_axpy32h(acc, r[0], bf_lo(c.x)); row_axpy32h(acc, r[1], bf_hi(c.x)); row_axpy32h(acc, r[2], bf_lo(c.y)); row_axpy32h(acc, r[3], bf_hi(c.y));
    __builtin_amdgcn_sched_barrier(0);
    row_axpy32h(acc, r[4], bf_lo(c.z)); row_axpy32h(acc, r[5], bf_hi(c.z)); row_axpy32h(acc, r[6], bf_lo(c.w)); row_axpy32h(acc, r[7], bf_hi(c.w));
    __builtin_amdgcn_sched_barrier(0);
}
typedef __attribute__((ext_vector_type(2))) unsigned u32x2_t;
DI h2_t pairsum32(h2_t x, h2_t y) { auto r = __builtin_amdgcn_permlane32_swap(__builtin_bit_cast(unsigned, x), __builtin_bit_cast(unsigned, y), false, false);
                                   return __builtin_bit_cast(h2_t, (unsigned)r[0]) + __builtin_bit_cast(h2_t, (unsigned)r[1]); }
DI h2_t pairsum16(h2_t x, h2_t y) { auto r = __builtin_amdgcn_permlane16_swap(__builtin_bit_cast(unsigned, x), __builtin_bit_cast(unsigned, y), false, false);
                                   return __builtin_bit_cast(h2_t, (unsigned)r[0]) + __builtin_bit_cast(h2_t, (unsigned)r[1]); }
DI h2_t pairsum8(h2_t x, h2_t y, bool hi) {
    const h2_t keep = hi ? y : x, send = hi ? x : y;
    const int rcv = __builtin_amdgcn_update_dpp(0, __builtin_bit_cast(int, send), 0x128, 0xF, 0xF, true);
    return keep + __builtin_bit_cast(h2_t, rcv);
}
DI void peerV4_finish(const PSArgs& a, h2_t (&acc)[16], float4 xv, int tok, int s4, int lane) {
    const int rg = lane >> 3, pc = lane & 7;
    h2_t q8[8], q4[4], q2[2];
#ifndef FINV
#define FINV 7
#endif
    const bool r2 = rg & 4, r1 = rg & 2, r0 = rg & 1;
#pragma unroll
    for (int k = 0; k < 8; ++k) {
        if (FINV & 1) q8[k] = pairsum32(acc[k], acc[k + 8]);
        else { const h2_t keep = r2 ? acc[k + 8] : acc[k], send = r2 ? acc[k] : acc[k + 8]; q8[k] = keep + __builtin_bit_cast(h2_t, shx_i<32>(__builtin_bit_cast(int, send), lane)); }
    }
#pragma unroll
    for (int k = 0; k < 4; ++k) {
        if (FINV & 2) q4[k] = pairsum16(q8[k], q8[k + 4]);
        else { const h2_t keep = r1 ? q8[k + 4] : q8[k], send = r1 ? q8[k] : q8[k + 4]; q4[k] = keep + __builtin_bit_cast(h2_t, shx_i<16>(__builtin_bit_cast(int, send), lane)); }
    }
#pragma unroll
    for (int k = 0; k < 2; ++k) {
        if (FINV & 4) q2[k] = pairsum8(q4[k], q4[k + 2], r0);
        else { const h2_t keep = r0 ? q4[k + 2] : q4[k], send = r0 ? q4[k] : q4[k + 2]; q2[k] = keep + __builtin_bit_cast(h2_t, shx_i<8>(__builtin_bit_cast(int, send), lane)); }
    }
    xv.x += (float)q2[0].x; xv.y += (float)q2[0].y; xv.z += (float)q2[1].x; xv.w += (float)q2[1].y;
    *(float4*)(a.Xout + (size_t)tok * DM + s4 * 256 + 32 * pc + 4 * rg) = xv;
}
DI int run_token2(int n, int k, int nloc, int wid, int th) { return (2 * (k + (n >> 3) * nloc) + th) * 64 + wid * 8 + (n & 7); }

DI void peerV4_run(const PSArgs& a, const fp4x2_t* V4, int s4, int th, int k, int nloc, int wid) {
    const int tid = get_tid(wid);
    const int lane = tid & 63, rg = lane >> 3, pc = lane & 7;
    const unsigned loff = (unsigned)(s4 * (NEXP * 128) + pc * 16);
    const int N = 8 * ((NTOK / 128 - k + nloc - 1) / nloc);
    if (N <= 0) return;
    Ids16 idE, idO; Cf16 cfE, cfO; float4 xE, xO;
    u32x4 rA[8], rB[8];
    const fp8_t* tab = (const fp8_t*)V4;
#define LOAD_X4(x_, tokv) { x_ = *(const float4*)(a.Xin + (size_t)(tokv) * DM + s4 * 256 + 32 * pc + 4 * rg); }
    ids_load(idE, a.EX, run_token2(0, k, nloc, wid, th), rg);
    ids_load(idO, a.EX, run_token2(1, k, nloc, wid, th), rg);
    rows_lo(rA, idE, tab, loff); cf_load(cfE, a.COEF, run_token2(0, k, nloc, wid, th), rg); rows_hi(rB, idE, tab, loff); LOAD_X4(xE, run_token2(0, k, nloc, wid, th));
#pragma unroll 1
    for (int n = 0; n < N; n += 2) {
        const int t0 = run_token2(n, k, nloc, wid, th), t1 = run_token2(n + 1, k, nloc, wid, th);
        const int t2 = run_token2((n + 2 < N) ? n + 2 : N - 1, k, nloc, wid, th), t3 = run_token2((n + 3 < N) ? n + 3 : N - 1, k, nloc, wid, th);
        {
            h2_t acc[16];
#pragma unroll
            for (int i = 0; i < 16; ++i) acc[i] = (h2_t){(_Float16)0.f, (_Float16)0.f};
            axpy8_4(acc, rA, cfE.a);
            rows_lo(rA, idO, tab, loff); cf_load(cfO, a.COEF, t1, rg);
            axpy8_4(acc, rB, cfE.b);
            rows_hi(rB, idO, tab, loff); LOAD_X4(xO, t1);
            ids_load(idE, a.EX, t2, rg);
            peerV4_finish(a, acc, xE, t0, s4, lane);
        }
        {
            h2_t acc[16];
#pragma unroll
            for (int i = 0; i < 16; ++i) acc[i] = (h2_t){(_Float16)0.f, (_Float16)0.f};
            axpy8_4(acc, rA, cfO.a);
            rows_lo(rA, idE, tab, loff); cf_load(cfE, a.COEF, t2, rg);
            axpy8_4(acc, rB, cfO.b);
            rows_hi(rB, idE, tab, loff); LOAD_X4(xE, t2);
            ids_load(idO, a.EX, t3, rg);
            peerV4_finish(a, acc, xO, t1, s4, lane);
        }
    }
#undef LOAD_X4
}

DI void conv_rows_fp4g(const float* __restrict__ src, const float* __restrict__ gain, fp4x2_t* __restrict__ dst, float* __restrict__ scales,
                       int nrows, int gwave, int nwaves, int lane) {
    const float4* g = (const float4*)(gain + lane * 16);
    const float4 g0 = g[0], g1 = g[1], g2 = g[2], g3 = g[3];
#pragma unroll 1
    for (int row = gwave; row < nrows; row += 2 * nwaves) {
        const int r1 = min(row + nwaves, nrows - 1);
        const float4* p0 = (const float4*)(src + (size_t)row * DM + lane * 16);
        const float4* p1 = (const float4*)(src + (size_t)r1 * DM + lane * 16);
        float4 a0 = p0[0], a1 = p0[1], a2 = p0[2], a3 = p0[3];
        float4 b0 = p1[0], b1 = p1[1], b2 = p1[2], b3 = p1[3];
        a0.x *= g0.x; a0.y *= g0.y; a0.z *= g0.z; a0.w *= g0.w; a1.x *= g1.x; a1.y *= g1.y; a1.z *= g1.z; a1.w *= g1.w;
        a2.x *= g2.x; a2.y *= g2.y; a2.z *= g2.z; a2.w *= g2.w; a3.x *= g3.x; a3.y *= g3.y; a3.z *= g3.z; a3.w *= g3.w;
        b0.x *= g0.x; b0.y *= g0.y; b0.z *= g0.z; b0.w *= g0.w; b1.x *= g1.x; b1.y *= g1.y; b1.z *= g1.z; b1.w *= g1.w;
        b2.x *= g2.x; b2.y *= g2.y; b2.z *= g2.z; b2.w *= g2.w; b3.x *= g3.x; b3.y *= g3.y; b3.z *= g3.z; b3.w *= g3.w;
        conv_row_fp4_one(a0, a1, a2, a3, dst, scales, nrows, row, lane);
        conv_row_fp4_one(b0, b1, b2, b3, dst, scales, nrows, r1, lane);
    }
}
DI float row_dot32h(const u32x4& r, const h2_t (&h)[16]) {
    float s0 = 0.f, s1 = 0.f;
#pragma unroll
    for (int b = 0; b < 4; ++b) {
        s0 = __builtin_amdgcn_fdot2(cvt4(r.x, b), h[b], s0, false); s1 = __builtin_amdgcn_fdot2(cvt4(r.y, b), h[4 + b], s1, false);
        s0 = __builtin_amdgcn_fdot2(cvt4(r.z, b), h[8 + b], s0, false); s1 = __builtin_amdgcn_fdot2(cvt4(r.w, b), h[12 + b], s1, false);
    }
    return s0 + s1;
}
DI void dots8_4(float* p, const u32x4 (&r)[8], const h2_t (&h)[16]) {
#pragma unroll
    for (int i = 0; i < 8; ++i) { p[i] = row_dot32h(r[i], h); if ((i & 3) == 3) __builtin_amdgcn_sched_barrier(0); }
}
struct H32 { u32x4 a, b, c, d; };
DI void h32_load(H32& q, const bf16_t* Hb, int tok, int hoff) { const u32x4* p = (const u32x4*)(Hb + (size_t)tok * DM + hoff); q.a = p[0]; q.b = p[1]; q.c = p[2]; q.d = p[3]; }
DI h2_t bf2_to_h2(unsigned u) { return __builtin_bit_cast(h2_t, __builtin_amdgcn_cvt_pkrtz(bf_lo(u), bf_hi(u))); }
DI void h32_unpack(h2_t (&h)[16], const H32& q) {
    h[0] = bf2_to_h2(q.a.x); h[1] = bf2_to_h2(q.a.y); h[2] = bf2_to_h2(q.a.z); h[3] = bf2_to_h2(q.a.w);
    h[4] = bf2_to_h2(q.b.x); h[5] = bf2_to_h2(q.b.y); h[6] = bf2_to_h2(q.b.z); h[7] = bf2_to_h2(q.b.w);
    h[8] = bf2_to_h2(q.c.x); h[9] = bf2_to_h2(q.c.y); h[10] = bf2_to_h2(q.c.z); h[11] = bf2_to_h2(q.c.w);
    h[12] = bf2_to_h2(q.d.x); h[13] = bf2_to_h2(q.d.y); h[14] = bf2_to_h2(q.d.z); h[15] = bf2_to_h2(q.d.w);
}
DI void peerU4_run(const PSArgs& a, const fp4x2_t* U4, int s4, int th, int k, int nloc, int wid) {
    const int tid = get_tid(wid);
    const int lane = tid & 63, rg = lane >> 3, pc = lane & 7;
    const unsigned loff = (unsigned)(s4 * (NEXP * 128) + pc * 16);
    const int hoff = s4 * 256 + pc * 32;
    const int N = 8 * ((NTOK / 128 - k + nloc - 1) / nloc);
    if (N <= 0) return;
    Ids16 idE, idO; H32 hE, hO;
    u32x4 rA[8], rB[8];
    const fp8_t* tab = (const fp8_t*)U4;
    ids_load(idE, a.EX, run_token2(0, k, nloc, wid, th), rg);
    ids_load(idO, a.EX, run_token2(1, k, nloc, wid, th), rg);
    rows_lo(rA, idE, tab, loff); h32_load(hE, a.Hb, run_token2(0, k, nloc, wid, th), hoff); rows_hi(rB, idE, tab, loff);
#pragma unroll 1
    for (int n = 0; n < N; n += 2) {
        const int t0 = run_token2(n, k, nloc, wid, th), t1 = run_token2(n + 1, k, nloc, wid, th);
        const int t2 = run_token2((n + 2 < N) ? n + 2 : N - 1, k, nloc, wid, th), t3 = run_token2((n + 3 < N) ? n + 3 : N - 1, k, nloc, wid, th);
        {
            h2_t h[16]; float p[16];
            h32_unpack(h, hE);
            dots8_4(p, rA, h);
            rows_lo(rA, idO, tab, loff); h32_load(hO, a.Hb, t1, hoff);
            dots8_4(p + 8, rB, h);
            rows_hi(rB, idO, tab, loff);
            ids_load(idE, a.EX, t2, rg);
            peerU_finish(a, p, t0, s4, lane);
        }
        {
            h2_t h[16]; float p[16];
            h32_unpack(h, hO);
            dots8_4(p, rA, h);
            rows_lo(rA, idE, tab, loff); h32_load(hE, a.Hb, t2, hoff);
            dots8_4(p + 8, rB, h);
            rows_hi(rB, idE, tab, loff);
            ids_load(idO, a.EX, t3, rg);
            peerU_finish(a, p, t1, s4, lane);
        }
    }
}
struct MegaArgs {
    const float* x; const float* a_re; const float* a_im; const float* log_dt; const float* b_re; const float* b_im; const float* c_re;
    const float* c_im; const float* d_skip; const float* b_glu; const float* pool_scale; const float* u_exp; const float* v_exp;
    const float* norm_final;
    PrepW pw;
    float* X; bf16_t* U; bf16_t* YPRE; bf16_t* G1; bf16_t* A2; bf16_t* Hb; bf16_t* Qb; unsigned short* EX; float* GT; float* RSTD;
    char* KT; bf16x8* WST; bf16x8* CCAR; float* ABT; fp8_t* U8; fp4x2_t* U4; fp4x2_t* V4; float* SU; float* SV; float* PD; bf16_t* COEF;
    unsigned* bar;
    int coop_probe; int pad_;
};

#ifndef REP_P0
#define REP_P0 1
#endif
#ifndef REP_PA
#define REP_PA 1
#endif
#ifndef REP_PB
#define REP_PB 1
#endif
#ifndef REP_C1
#define REP_C1 1
#endif
#ifndef REP_C2
#define REP_C2 1
#endif
#ifndef REP_U
#define REP_U 1
#endif
#ifndef REP_R
#define REP_R 1
#endif
#ifndef REP_V
#define REP_V 1
#endif
#ifndef REP_BAR
#define REP_BAR 1
#endif
#define XBAR() do { for (int rb_ = 0; rb_ < REP_BAR; ++rb_) xcd_barrier(xb, wid); } while (0)
__global__ void __launch_bounds__(NTHR) mega_kernel(MegaArgs a) {
    __shared__ __attribute__((aligned(16))) char smem[PB_BYTES];
    __shared__ uint4 xb_words;
    cg::grid_group grid = cg::this_grid();
    const int nblk = gridDim.x;
    const int wid = __builtin_amdgcn_readfirstlane(threadIdx.x >> 6);
    if (get_tid(wid) == 0) xb_words = make_uint4(0u, 0u, 0u, 0u);
    __syncthreads();
    const XcdBarrier xb = xcd_barrier_post(a.bar, (volatile LAS unsigned*)&xb_words, get_tid(wid));
    for (int rep = 0; rep < REP_P0; ++rep) {
        const size_t gtid = (size_t)blockIdx.x * NTHR + get_tid(wid), gs = (size_t)nblk * NTHR;
        for (int it = blockIdx.x; it < 256; it += nblk)
            prep_s5_item(it >> 2, it & 3, a.a_re, a.a_im, a.log_dt, a.b_re, a.b_im, a.c_re, a.c_im, a.d_skip, a.KT, a.WST, a.CCAR, a.ABT, smem, wid);
        prep_weights(a.pw, gtid, gs);
        for (int l = 0; l < 2; ++l) {
            conv_kfrag(a.pw.k1 + (size_t)l * 128 * 128, a.pw.wfk1 + (size_t)l * (128 * 128 / 8), gtid, gs);
            conv_kfrag(a.pw.k2 + (size_t)l * 128 * 128, a.pw.wfk2 + (size_t)l * (128 * 128 / 8), gtid, gs);
        }
        {
            int tid = get_tid(wid);
            const int gwave = blockIdx.x * 8 + (tid >> 6), nwaves = nblk * 8, lane = tid & 63;
#pragma unroll 1
            for (int l = 0; l < 2; ++l) {
#if U_FP4
                conv_rows_fp4g(a.u_exp + (size_t)l * NEXP * DM, a.pw.norm_ffn + l * DM, a.U4 + (size_t)l * NEXP * (DM / 2), a.SU + l * NEXP, NEXP, gwave, nwaves, lane);
#else
                conv_rows_fp8(a.u_exp + (size_t)l * NEXP * DM, a.pw.norm_ffn + l * DM, a.U8 + (size_t)l * NEXP * DM, a.SU + l * NEXP, NEXP, gwave, nwaves, lane);
#endif
                conv_rows_fp4(a.v_exp + (size_t)l * NEXP * DM, a.V4 + (size_t)l * NEXP * (DM / 2), a.SV + l * NEXP, NEXP, gwave, nwaves, lane);
            }
        }
    }
    XBAR();
    if (a.coop_probe) grid.sync();
    __shared__ int sched[4];
    if (get_tid(wid) == 0) {
        int nx = 0, myj = 0, nloc = 1;
        for (unsigned j = 0; j < 16; ++j) {
            const unsigned cj = xb_ld(&a.bar[XB_XCNT(j)]);
            if (j == xb.x) { myj = nx; nloc = (int)cj; }
            nx += (cj > 0u) ? 1 : 0;
        }
        sched[0] = (int)xb.st[2]; sched[1] = nloc > 0 ? nloc : 1; sched[2] = myj; sched[3] = nx > 0 ? nx : 1;
    }
    __syncthreads();
    const int s_rank = sched[0], s_nloc = sched[1], s_myj = sched[2], s_nx = sched[3];
#pragma unroll 1
    for (int l = 0; l < 2; ++l) {
        const float* xin = (l == 0) ? a.x : a.X;
        if (l == 0) {
            for (int rep = 0; rep < REP_PA; ++rep)
            for (int tile = blockIdx.x; tile < NTOK / 64; tile += nblk) phaseA_tile(xin, a.pw.wfin, a.U, tile, smem, wid);
        }
        XBAR();
        bf16_t* Ul = a.U + (size_t)l * NTOK * DM;
        for (int rep = 0; rep < REP_PB; ++rep)
        for (int tile = blockIdx.x; tile < 256; tile += nblk)
            phaseB_tile(Ul, a.KT + (size_t)l * 32 * KT_BYTES, a.WST + (size_t)l * 32 * WST_FRAGS, a.CCAR + (size_t)l * 32 * CCAR_FRAGS, a.ABT + l * 32 * 128, a.YPRE, tile, smem, wid);
        XBAR();
        PCArgs pa; pa.U = Ul; pa.YPRE = a.YPRE; pa.G1 = a.G1; pa.A2 = a.A2; pa.Xin = xin; pa.Xout = a.X; pa.Xdummy = (float*)a.Qb; pa.Hb = a.Hb; pa.RSTD = a.RSTD;
        pa.wfglu = a.pw.wfglu + (size_t)l * (512 * 512 / 8); pa.b_glu = a.b_glu + l * 512; pa.wfpool = a.pw.wfpool + (size_t)l * 4 * (128 * 128 / 8);
        pa.pool_scale = a.pool_scale + l * 512; pa.wfout = a.pw.wfout + (size_t)l * (DM * DM / 8);
        PRArgs pr; pr.Hb = a.Hb; pr.RSTD = a.RSTD; pr.wfq = a.pw.wfq + (size_t)l * (DM * 2048 / 8); pr.kf1 = a.pw.wfk1 + (size_t)l * (128 * 128 / 8);
        pr.kf2 = a.pw.wfk2 + (size_t)l * (128 * 128 / 8); pr.EX = a.EX; pr.GT = a.GT;
        for (int tile = blockIdx.x; tile < NTOK / 64; tile += nblk) {
            for (int rep = 1; rep < REP_C1; ++rep) { PCArgs pa2 = pa; pa2.Xout = (float*)a.Qb; phaseC1_tile(pa2, tile, smem, wid); }
            phaseC1_tile(pa, tile, smem, wid);
            for (int rep = 0; rep < REP_C2; ++rep) phaseC2_tile(pr, tile, smem, wid);
        }
        XBAR();
        PSArgs ps; ps.Hb = a.Hb; ps.RSTD = a.RSTD; ps.EX = a.EX; ps.GT = a.GT; ps.U8 = a.U8 + (size_t)l * NEXP * DM; ps.V8 = nullptr;
        ps.SU = a.SU + l * NEXP; ps.SV = a.SV + l * NEXP; ps.PD = a.PD; ps.COEF = a.COEF; ps.Xin = a.X; ps.Xout = a.X;
        for (int rep = 0; rep < REP_U; ++rep) {
#if U_FP4
            for (int v = s_myj; v < 8; v += s_nx) peerU4_run(ps, a.U4 + (size_t)l * NEXP * (DM / 2), v & 3, v >> 2, s_rank, s_nloc, wid);
#else
            for (int s = s_myj; s < 8; s += s_nx) peerU_run(ps, s, s_rank, s_nloc, wid);
#endif
        }
        XBAR();
        for (int rep = 0; rep < REP_R; ++rep)
        for (int tile = blockIdx.x; tile < NTOK / 64; tile += nblk) peerR_tile(ps, tile, wid);
        XBAR();
        for (int rep = 1; rep < REP_V; ++rep) { PSArgs ps2 = ps; ps2.Xout = (float*)a.Qb; for (int v = s_myj; v < 8; v += s_nx) peerV4_run(ps2, a.V4 + (size_t)l * NEXP * (DM / 2), v & 3, v >> 2, s_rank, s_nloc, wid); }
        for (int v = s_myj; v < 8; v += s_nx) peerV4_run(ps, a.V4 + (size_t)l * NEXP * (DM / 2), v & 3, v >> 2, s_rank, s_nloc, wid);
        XBAR();
        if (l == 0) {
            for (int rep = 0; rep < REP_PA; ++rep)
            for (int tile = blockIdx.x; tile < NTOK / 64; tile += nblk) phaseA_tile(a.X, a.pw.wfin + (size_t)(DM * DM / 8), a.U + (size_t)NTOK * DM, tile, smem, wid);
        } else {
            for (int tile = blockIdx.x; tile < NTOK / 64; tile += nblk) final_norm_tile(a.X, a.norm_final, tile, wid);
        }
    }
}

extern "C" void kernel_launch(void* const* d_in, const int* in_sizes, int n_in, void* d_out, int out_size, void* d_ws, size_t ws_size,
                              hipStream_t stream) {
    char* wsb = (char*)d_ws;
    size_t off = 0;
    auto take = [&](size_t bytes) { char* p = wsb + off; off += (bytes + 255) & ~(size_t)255; return p; };
    MegaArgs a;
    memset(&a, 0, sizeof(a));
    a.x = (const float*)d_in[0];
    a.pw.norm_mix = (const float*)d_in[1]; a.pw.w_in = (const float*)d_in[2];
    a.a_re = (const float*)d_in[3]; a.a_im = (const float*)d_in[4]; a.log_dt = (const float*)d_in[5];
    a.b_re = (const float*)d_in[6]; a.b_im = (const float*)d_in[7]; a.c_re = (const float*)d_in[8]; a.c_im = (const float*)d_in[9];
    a.d_skip = (const float*)d_in[10]; a.pw.w_glu = (const float*)d_in[11]; a.b_glu = (const float*)d_in[12];
    a.pw.w_pool = (const float*)d_in[13]; a.pool_scale = (const float*)d_in[14]; a.pw.g_out_ssm = (const float*)d_in[15];
    a.pw.g_out_pool = (const float*)d_in[16]; a.pw.w_out = (const float*)d_in[17]; a.pw.norm_ffn = (const float*)d_in[18];
    a.pw.w_q = (const float*)d_in[19]; a.pw.k1 = (const float*)d_in[20]; a.pw.k2 = (const float*)d_in[21];
    a.u_exp = (const float*)d_in[22]; a.v_exp = (const float*)d_in[23]; a.norm_final = (const float*)d_in[24];
    a.X = (float*)d_out;
    a.U = (bf16_t*)take((size_t)2 * NTOK * DM * 2);
    a.YPRE = (bf16_t*)take((size_t)NTOK * 512 * 2);
    a.G1 = (bf16_t*)take((size_t)NTOK * 512 * 2);
    a.A2 = (bf16_t*)take((size_t)NTOK * DM * 2);
    a.Hb = (bf16_t*)take((size_t)NTOK * DM * 2);
    a.Qb = (bf16_t*)take((size_t)NTOK * 2048 * 2);
    a.EX = (unsigned short*)take((size_t)NTOK * 128 * 2);
    a.GT = (float*)take((size_t)NTOK * 128 * 4);
    a.RSTD = (float*)take(NTOK * 4);
    a.pw.wfin = (bf16x8*)take((size_t)2 * DM * DM * 2);
    a.pw.wfglu = (bf16x8*)take((size_t)2 * 512 * 512 * 2);
    a.pw.wfpool = (bf16x8*)take((size_t)2 * 4 * 128 * 128 * 2);
    a.pw.wfout = (bf16x8*)take((size_t)2 * DM * DM * 2);
    a.pw.wfq = (bf16x8*)take((size_t)2 * DM * 2048 * 2);
    a.pw.wfk1 = (bf16x8*)take((size_t)2 * 128 * 128 * 2);
    a.pw.wfk2 = (bf16x8*)take((size_t)2 * 128 * 128 * 2);
    a.KT = take((size_t)64 * KT_BYTES);
    a.WST = (bf16x8*)take((size_t)64 * WST_FRAGS * 16);
    a.CCAR = (bf16x8*)take((size_t)64 * CCAR_FRAGS * 16);
    a.ABT = (float*)take(64 * 128 * 4);
    a.U8 = (fp8_t*)take((size_t)2 * NEXP * DM);
    a.V4 = (fp4x2_t*)take((size_t)2 * NEXP * (DM / 2));
    a.U4 = (fp4x2_t*)take((size_t)2 * NEXP * (DM / 2));
    a.SU = (float*)take((size_t)2 * NEXP * 4);
    a.SV = (float*)take((size_t)2 * NEXP * 4);
    a.PD = (float*)take((size_t)8 * NTOK * 128 * 4);
    a.COEF = (bf16_t*)take((size_t)NTOK * 128 * 2);
    a.bar = (unsigned*)take((size_t)XCD_BAR_WORDS * 4);
    hipMemsetAsync(a.bar, 0, (size_t)XCD_BAR_WORDS * 4, stream);

    static int grid_blocks = 0;
    if (!grid_blocks) {
        int dev = 0, cus = 0, per_cu = 0;
        hipGetDevice(&dev);
        hipDeviceGetAttribute(&cus, hipDeviceAttributeMultiprocessorCount, dev);
        hipOccupancyMaxActiveBlocksPerMultiprocessor(&per_cu, mega_kernel, NTHR, 0);
        if (per_cu > 1) per_cu = 1;
        grid_blocks = cus * per_cu;
        if (grid_blocks > 256) grid_blocks = 256;
    }
    void* args[] = {&a};
    hipError_t e = hipLaunchCooperativeKernel((void*)mega_kernel, dim3(grid_blocks), dim3(NTHR), args, 0, stream);
    if (e != hipSuccess) fprintf(stderr, "cooperative launch failed: %s (grid %d)\n", hipGetErrorString(e), grid_blocks);
}
```

```cpp
#include <hip/hip_runtime.h>
#include <hip/hip_cooperative_groups.h>
#include <cstdio>
#include <cstring>
namespace cg = cooperative_groups;
#include <math.h>
#include <stdint.h>

#define NTOK 16384
#define SEQ 2048
#define DM 1024
#define SSMW 512
#define NEXP 16384

__device__ __forceinline__ float gelu_exact(float x) { return 0.5f * x * (1.f + erff(x * 0.70710678118654752f)); }

template <int M> __device__ __forceinline__ int shx_i(int v, int lane) {
    if constexpr (M == 1) return __builtin_amdgcn_mov_dpp(v, 0xB1, 0xF, 0xF, true);
    else if constexpr (M == 2) return __builtin_amdgcn_mov_dpp(v, 0x4E, 0xF, 0xF, true);
    else if constexpr (M < 32) return __builtin_amdgcn_ds_swizzle(v, (M << 10) | 0x1F);
    else return __builtin_amdgcn_ds_bpermute((lane ^ 32) << 2, v);
}
template <int M> __device__ __forceinline__ float shx(float v, int lane) { return __int_as_float(shx_i<M>(__float_as_int(v), lane)); }
__device__ __forceinline__ float wave_sum(float v, int lane) {
    v += shx<1>(v, lane); v += shx<2>(v, lane); v += shx<4>(v, lane); v += shx<8>(v, lane); v += shx<16>(v, lane); v += shx<32>(v, lane);
    return v;
}

__device__ __forceinline__ int get_tid(int wid) {
    int t = wid * 64 + (int)__builtin_amdgcn_mbcnt_hi(~0u, __builtin_amdgcn_mbcnt_lo(~0u, 0u));
    asm volatile("" : "+v"(t));
    return t;
}

#define DI __device__ __forceinline__
typedef __attribute__((ext_vector_type(8))) short bf16x8;
typedef __attribute__((ext_vector_type(16))) float f32x16;
typedef __attribute__((ext_vector_type(2))) __bf16 bf2_t;
typedef __attribute__((ext_vector_type(2))) float f2_t;
typedef unsigned short bf16_t;
typedef __attribute__((ext_vector_type(4))) unsigned u32x4;
typedef __attribute__((ext_vector_type(4))) float f32x4;
typedef const __attribute__((address_space(1))) bf16x8* gwp_t;
#define MFMA32(a, b, c) __builtin_amdgcn_mfma_f32_32x32x16_bf16((a), (b), (c), 0, 0, 0)

DI unsigned pack_bf2(float a, float b) { f2_t v = {a, b}; return __builtin_bit_cast(unsigned, __builtin_convertvector(v, bf2_t)); }
DI float bf_lo(unsigned u) { return __uint_as_float(u << 16); }
DI float bf_hi(unsigned u) { return __uint_as_float(u & 0xffff0000u); }
DI int crow(int reg, int h) { return (reg & 3) + 8 * (reg >> 2) + 4 * h; }

#define SA_STRIDE 272
#define SA_BYTES (64 * SA_STRIDE)
#define NTHR 512

template <bool GAIN>
DI void conv_wfrag(const float* __restrict__ src, int ldk, int ldn, const float* __restrict__ ga, const float* __restrict__ gb, int split,
                   int K, int N, int NTG, bf16x8* __restrict__ dst, size_t gtid, size_t gstride) {
    const int KS = K / 16;
    const size_t total = (size_t)(N / 32) * KS * 64;
    for (size_t item = gtid; item < total; item += gstride) {
        const int lane = (int)(item & 63); const size_t f = item >> 6;
        const int nti = (int)(f % NTG); const size_t f2 = f / NTG;
        const int ks = (int)(f2 % KS), nt = (int)(f2 / KS) * NTG + nti;
        const int r = lane & 31, h = lane >> 5;
        const int n = nt * 32 + r, k0 = ks * 16 + 8 * h;
        float v[8];
#pragma unroll
        for (int j = 0; j < 8; ++j) {
            const int k = k0 + j;
            float g = 1.f;
            if (GAIN) g = (k < split) ? ga[k] : gb[k - split];
            v[j] = src[(size_t)k * ldk + (size_t)n * ldn] * g;
        }
        uint4 o; o.x = pack_bf2(v[0], v[1]); o.y = pack_bf2(v[2], v[3]); o.z = pack_bf2(v[4], v[5]); o.w = pack_bf2(v[6], v[7]);
        *(uint4*)(dst + item) = o;
    }
}

DI void conv_rows_bf16(const float* __restrict__ src, const float* __restrict__ gain, bf16_t* __restrict__ dst, size_t nelem, size_t gtid, size_t gstride) {
    for (size_t i = gtid * 8; i < nelem; i += gstride * 8) {
        float4 a = *(const float4*)(src + i), b = *(const float4*)(src + i + 4);
        if (gain) {
            const int c = (int)(i & 1023);
            float4 g0 = *(const float4*)(gain + c), g1 = *(const float4*)(gain + c + 4);
            a.x *= g0.x; a.y *= g0.y; a.z *= g0.z; a.w *= g0.w; b.x *= g1.x; b.y *= g1.y; b.z *= g1.z; b.w *= g1.w;
        }
        uint4 o; o.x = pack_bf2(a.x, a.y); o.y = pack_bf2(a.z, a.w); o.z = pack_bf2(b.x, b.y); o.w = pack_bf2(b.z, b.w);
        *(uint4*)(dst + i) = o;
    }
}

struct ALoadF32 {
    const float* base; f32x4 v0, v1, v2, v3; float ss; int dofs;
    DI void init(const float* rowbase, int tid) { base = rowbase + (tid & 7) * 16; ss = 0.f; dofs = (tid >> 3) * SA_STRIDE + (tid & 7) * 32; }
    DI void issue(int c) { const f32x4* p = (const f32x4*)(base + c * 128); v0 = p[0]; v1 = p[1]; v2 = p[2]; v3 = p[3]; }
    DI void commit(char* buf) {
        u32x4 o0, o1;
        ss += v0.x * v0.x + v0.y * v0.y + v0.z * v0.z + v0.w * v0.w + v1.x * v1.x + v1.y * v1.y + v1.z * v1.z + v1.w * v1.w
            + v2.x * v2.x + v2.y * v2.y + v2.z * v2.z + v2.w * v2.w + v3.x * v3.x + v3.y * v3.y + v3.z * v3.z + v3.w * v3.w;
        o0.x = pack_bf2(v0.x, v0.y); o0.y = pack_bf2(v0.z, v0.w); o0.z = pack_bf2(v1.x, v1.y); o0.w = pack_bf2(v1.z, v1.w);
        o1.x = pack_bf2(v2.x, v2.y); o1.y = pack_bf2(v2.z, v2.w); o1.z = pack_bf2(v3.x, v3.y); o1.w = pack_bf2(v3.z, v3.w);
        char* d = buf + dofs;
        *(u32x4*)d = o0; *(u32x4*)(d + 16) = o1;
    }
};
struct ALoadBF16 {
    const bf16_t* base; u32x4 v0, v1; int dofs;
    DI void init(const bf16_t* rowbase, int tid) { base = rowbase + (tid & 7) * 16; dofs = (tid >> 3) * SA_STRIDE + (tid & 7) * 32; }
    DI void issue(int c) { const u32x4* p = (const u32x4*)(base + c * 128); v0 = p[0]; v1 = p[1]; }
    DI void commit(char* buf) {
        char* d = buf + dofs;
        *(u32x4*)d = v0; *(u32x4*)(d + 16) = v1;
    }
};

template <int NT, int PF, class AL>
DI void gemm64(f32x16 (&acc)[NT][2], AL& al, const int nchunks, const bf16x8* __restrict__ wf_, char* sA, const int lane) {
    gwp_t wf = (gwp_t)wf_;
    const int r = lane & 31, h = lane >> 5;
    bf16x8 bq[PF][NT];
    al.issue(0);
#pragma unroll
    for (int p = 0; p < PF; ++p)
#pragma unroll
        for (int nt = 0; nt < NT; ++nt) bq[p][nt] = wf[(p * NT + nt) * 64];
    gwp_t wpf = wf + PF * NT * 64;
    al.commit(sA);
    const int kend = nchunks * 8 - PF;
    int kg = 0;
#pragma unroll 1
    for (int c = 0; c < nchunks; ++c) {
        if (c + 1 < nchunks) al.issue(c + 1);
        __syncthreads();
        const char* buf = sA + (c & 1) * SA_BYTES + r * SA_STRIDE + h * 16;
#pragma unroll
        for (int ks = 0; ks < 8; ++ks) {
            const bf16x8 a0 = *(const bf16x8*)(buf + ks * 32);
            const bf16x8 a1 = *(const bf16x8*)(buf + 32 * SA_STRIDE + ks * 32);
#pragma unroll
            for (int nt = 0; nt < NT; ++nt) {
                acc[nt][0] = MFMA32(bq[ks % PF][nt], a0, acc[nt][0]);
                acc[nt][1] = MFMA32(bq[ks % PF][nt], a1, acc[nt][1]);
            }
            if (kg < kend) {
#pragma unroll
                for (int nt = 0; nt < NT; ++nt) bq[ks % PF][nt] = wpf[nt * 64];
            }
            wpf += NT * 64; ++kg;
            asm volatile("" : "+v"(wpf));
        }
        if (c + 1 < nchunks) al.commit(sA + ((c + 1) & 1) * SA_BYTES);
    }
    __syncthreads();
}

template <int NT>
DI void zero_acc(f32x16 (&acc)[NT][2]) {
#pragma unroll
    for (int nt = 0; nt < NT; ++nt)
#pragma unroll
        for (int mt = 0; mt < 2; ++mt)
#pragma unroll
            for (int i = 0; i < 16; ++i) acc[nt][mt][i] = 0.f;
}


DI void tile_transpose(const f32x16& t, float* wscr, int lane, f32x4 (&out)[4]) {
    const int r = lane & 31, h = lane >> 5;
#pragma unroll
    for (int q = 0; q < 4; ++q) { f32x4 v = {t[4 * q], t[4 * q + 1], t[4 * q + 2], t[4 * q + 3]}; *(f32x4*)(wscr + r * 36 + 8 * q + 4 * h) = v; }
#pragma unroll
    for (int j = 0; j < 4; ++j) out[j] = *(const f32x4*)(wscr + ((lane >> 3) + 8 * j) * 36 + (lane & 7) * 4);
}
#define WSCR_BYTES (32 * 36 * 4)

DI void phaseA_tile(const float* __restrict__ X, const bf16x8* __restrict__ wfin, bf16_t* __restrict__ U, int tile, char* smem, int wid) {
    char* sA = smem; float* srstd = (float*)(smem + 8 * WSCR_BYTES);
    int tok0 = tile * 64; asm volatile("" : "+s"(tok0));
    int tid = get_tid(wid);
    const int w = __builtin_amdgcn_readfirstlane(tid >> 6), lane = tid & 63, r = lane & 31, h = lane >> 5;
    ALoadF32 al; al.init(X + (size_t)(tok0 + (tid >> 3)) * DM, tid);
    f32x16 acc[4][2]; zero_acc<4>(acc);
    gemm64<4, 2>(acc, al, 8, wfin + (size_t)w * (64 * 4 * 64) + lane, sA, lane);
    float ss = al.ss;
    ss += shx<1>(ss, lane); ss += shx<2>(ss, lane); ss += shx<4>(ss, lane);
    if ((tid & 7) == 0) srstd[tid >> 3] = rsqrtf(ss * (1.f / 1024.f) + 1e-6f);
    __syncthreads();
    {
        float* wscr = (float*)(smem + w * WSCR_BYTES);
        const int tl = lane >> 3, cl = (lane & 7) * 4;
#pragma unroll
        for (int mt = 0; mt < 2; ++mt) {
            float rs[4];
#pragma unroll
            for (int j = 0; j < 4; ++j) rs[j] = srstd[mt * 32 + tl + 8 * j];
#pragma unroll
            for (int nt = 0; nt < 4; ++nt) {
                f32x4 o[4]; tile_transpose(acc[nt][mt], wscr, lane, o);
#pragma unroll
                for (int j = 0; j < 4; ++j) {
                    uint2 p; p.x = pack_bf2(o[j].x * rs[j], o[j].y * rs[j]); p.y = pack_bf2(o[j].z * rs[j], o[j].w * rs[j]);
                    *(uint2*)(U + (size_t)(tok0 + mt * 32 + tl + 8 * j) * DM + w * 128 + nt * 32 + cl) = p;
                }
            }
        }
    }
    __syncthreads();
}

struct PrepW {
    const float* norm_mix; const float* w_in; const float* w_glu; const float* w_pool; const float* g_out_ssm; const float* g_out_pool;
    const float* w_out; const float* norm_ffn; const float* w_q; const float* k1; const float* k2;
    bf16x8* wfin; bf16x8* wfglu; bf16x8* wfpool; bf16x8* wfout; bf16x8* wfq; bf16x8* wfk1; bf16x8* wfk2;
};
DI void prep_weights(const PrepW& p, size_t gtid, size_t gs) {
#pragma unroll 1
    for (int l = 0; l < 2; ++l) {
        conv_wfrag<true>(p.w_in + (size_t)l * DM * DM, DM, 1, p.norm_mix + l * DM, p.norm_mix + l * DM, DM, DM, DM, 4, p.wfin + (size_t)l * (DM * DM / 8), gtid, gs);
        conv_wfrag<false>(p.w_glu + (size_t)l * 512 * 512, 512, 1, p.norm_mix, p.norm_mix, 512, 512, 512, 2, p.wfglu + (size_t)l * (512 * 512 / 8), gtid, gs);
#pragma unroll 1
        for (int gi = 0; gi < 4; ++gi)
            conv_wfrag<false>(p.w_pool + (size_t)(l * 4 + gi) * 128 * 128, 128, 1, p.norm_mix, p.norm_mix, 128, 128, 128, 2, p.wfpool + (size_t)(l * 4 + gi) * (128 * 128 / 8), gtid, gs);
        conv_wfrag<true>(p.w_out + (size_t)l * DM * DM, DM, 1, p.g_out_ssm + l * 512, p.g_out_pool + l * 512, 512, DM, DM, 4, p.wfout + (size_t)l * (DM * DM / 8), gtid, gs);
        conv_wfrag<true>(p.w_q + (size_t)l * DM * 2048, 2048, 1, p.norm_ffn + l * DM, p.norm_ffn + l * DM, DM, DM, 2048, 4, p.wfq + (size_t)l * (DM * 2048 / 8), gtid, gs);
    }
}
#define KT_BLK 528
#define KT_BYTES (65 * KT_BLK)
#define WST_FRAGS (4 * 64 * 64)
#define CCAR_FRAGS (32 * 8 * 64)
#define SU_CH 2064

DI void prep_s5_item(int lg, int part, const float* __restrict__ a_re, const float* __restrict__ a_im, const float* __restrict__ log_dt,
                     const float* __restrict__ b_re, const float* __restrict__ b_im, const float* __restrict__ c_re, const float* __restrict__ c_im,
                     const float* __restrict__ d_skip, char* __restrict__ KT, bf16x8* __restrict__ WST, bf16x8* __restrict__ CCAR,
                     float* __restrict__ ABT, char* smem, int wid) {
    float* powr = (float*)smem;
    float* powi = powr + 65 * 64;
    float* bzr = powi + 65 * 64;
    float* bzi = bzr + 1024;
    float* cr = bzi + 1024;
    float* ci = cr + 1024;
    int tid = get_tid(wid);
    const float* are_p = a_re + lg * 64; const float* aim_p = a_im + lg * 64;
    const float dt = expf(log_dt[lg]);
    for (int it = tid; it < 65 * 64; it += NTHR) {
        const int tau = it >> 6, p = it & 63;
        const float lre = are_p[p], lim = aim_p[p];
        const float mag = expf((float)tau * lre * dt);
        double rev = (double)lim * (double)dt * (double)tau * 0.15915494309189535;
        rev -= floor(rev);
        const float ang = (float)rev * 6.283185307179586f;
        powr[it] = mag * cosf(ang); powi[it] = mag * sinf(ang);
    }
    for (int it = tid; it < 1024; it += NTHR) {
        cr[it] = c_re[lg * 1024 + it]; ci[it] = c_im[lg * 1024 + it];
    }
    __syncthreads();
    for (int it = tid; it < 1024; it += NTHR) {
        const int p = it >> 4;
        const float lre = are_p[p], lim = aim_p[p];
        const float ar = powr[64 + p], ai = powi[64 + p];
        const float inv = 1.f / (lre * lre + lim * lim), nre = ar - 1.f;
        const float zre = (nre * lre + ai * lim) * inv, zim = (ai * lre - nre * lim) * inv;
        const float br = b_re[lg * 1024 + it], bi = b_im[lg * 1024 + it];
        bzr[it] = zre * br - zim * bi; bzi[it] = zre * bi + zim * br;
    }
    __syncthreads();
    if (part == 0 && tid < 64) { ABT[lg * 128 + 2 * tid] = powr[64 * 64 + tid]; ABT[lg * 128 + 2 * tid + 1] = powi[64 * 64 + tid]; }
    char* kt = KT + (size_t)lg * KT_BYTES;
    if (part == 0) for (int it = tid; it < KT_BLK / 4; it += NTHR) ((unsigned*)kt)[it] = 0u;
    for (int it = part * (16 * 128) + tid; it < (part + 1) * (16 * 128); it += NTHR) {
        const int tau = it >> 7, ho = (it >> 3) & 15, hi = (it & 7) * 2;
        float s0 = 0.f, s1 = 0.f;
        for (int p = 0; p < 64; ++p) {
            const float c_r = cr[ho * 64 + p], c_i = ci[ho * 64 + p], pr = powr[tau * 64 + p], pi = powi[tau * 64 + p];
            const float cpr = c_r * pr - c_i * pi, cpi = c_r * pi + c_i * pr;
            s0 += cpr * bzr[p * 16 + hi] - cpi * bzi[p * 16 + hi];
            s1 += cpr * bzr[p * 16 + hi + 1] - cpi * bzi[p * 16 + hi + 1];
        }
        if (tau == 0) { if (ho == hi) s0 += d_skip[lg * 16 + ho]; if (ho == hi + 1) s1 += d_skip[lg * 16 + ho]; }
        *(unsigned*)(kt + (tau + 1) * KT_BLK + ho * 32 + hi * 2) = pack_bf2(s0, s1);
    }
    if (part == 0) for (int it = tid; it < 65 * 4; it += NTHR) ((unsigned*)(kt + (it >> 2) * KT_BLK + 512))[it & 3] = 0u;
    bf16x8* wst = WST + (size_t)lg * WST_FRAGS;
    for (int it = part * (WST_FRAGS / 4) + tid; it < (part + 1) * (WST_FRAGS / 4); it += NTHR) {
        const int lane = it & 63, j = (it >> 6) & 63, nt = it >> 12;
        const int r = lane & 31, h = lane >> 5, n = nt * 32 + r, p = n & 63, im = n >> 6;
        const float pr = powr[(63 - j) * 64 + p], pi = powi[(63 - j) * 64 + p];
        float v[8];
#pragma unroll
        for (int jj = 0; jj < 8; ++jj) {
            const float zr = bzr[p * 16 + 8 * h + jj], zi = bzi[p * 16 + 8 * h + jj];
            v[jj] = im ? (pr * zi + pi * zr) : (pr * zr - pi * zi);
        }
        uint4 o; o.x = pack_bf2(v[0], v[1]); o.y = pack_bf2(v[2], v[3]); o.z = pack_bf2(v[4], v[5]); o.w = pack_bf2(v[6], v[7]);
        *(uint4*)(wst + it) = o;
    }
    bf16x8* cc = CCAR + (size_t)lg * CCAR_FRAGS;
    for (int it = part * (CCAR_FRAGS / 4) + tid; it < (part + 1) * (CCAR_FRAGS / 4); it += NTHR) {
        const int lane = it & 63, ks = (it >> 6) & 7, mt = it >> 9;
        const int r = lane & 31, h = lane >> 5, m = mt * 32 + r, i = m >> 4, ho = m & 15;
        float v[8];
#pragma unroll
        for (int jj = 0; jj < 8; ++jj) {
            const int k = ks * 16 + 8 * h + jj, p = k & 63, im = k >> 6;
            const float c_r = cr[ho * 64 + p], c_i = ci[ho * 64 + p], pr = powr[(i + 1) * 64 + p], pi = powi[(i + 1) * 64 + p];
            v[jj] = im ? -(c_r * pi + c_i * pr) : (c_r * pr - c_i * pi);
        }
        uint4 o; o.x = pack_bf2(v[0], v[1]); o.y = pack_bf2(v[2], v[3]); o.z = pack_bf2(v[4], v[5]); o.w = pack_bf2(v[6], v[7]);
        *(uint4*)(cc + it) = o;
    }
    __syncthreads();
}

#define PB_SU 0
#define PB_SKT (32 * SU_CH)
#define PB_SL (PB_SKT + KT_BYTES)
#define PB_SPART (PB_SL + 32 * 132 * 4)
#define PB_SSP (PB_SPART + 4 * 4096)
#define PB_BYTES (PB_SSP + 32 * 272)

DI void phaseB_tile(const bf16_t* __restrict__ U, const char* __restrict__ KT, const bf16x8* __restrict__ WST, const bf16x8* __restrict__ CCAR,
                    const float* __restrict__ ABT, bf16_t* __restrict__ YPRE, int tile, char* smem, int wid) {
    const int gp = tile & 31, b = tile >> 5;
    const int g = ((gp & 7) << 2) | (gp >> 3);
    int tid = get_tid(wid);
    const int w = __builtin_amdgcn_readfirstlane(tid >> 6), lane = tid & 63, r = lane & 31, h = lane >> 5;
    char* sU = smem + PB_SU; char* sKT = smem + PB_SKT; float* sL = (float*)(smem + PB_SL); float* sPart = (float*)(smem + PB_SPART);
    char* sSp = smem + PB_SSP;
#pragma unroll
    for (int it = 0; it < 4; ++it) {
        const int tok = tid + NTHR * it;
        const uint4* src = (const uint4*)(U + (size_t)(b * SEQ + tok) * DM + g * 16);
        const uint4 v0 = src[0], v1 = src[1];
        char* d = sU + (tok >> 6) * SU_CH + (tok & 63) * 32;
        *(uint4*)d = v0; *(uint4*)(d + 16) = v1;
    }
    {
        const uint4* src = (const uint4*)(KT + (size_t)g * KT_BYTES);
        for (int it = tid; it < KT_BYTES / 16; it += NTHR) ((uint4*)sKT)[it] = src[it];
    }
    __syncthreads();
    {
        const int nt = w & 3, kh = w >> 2;
        f32x16 acc;
#pragma unroll
        for (int i = 0; i < 16; ++i) acc[i] = 0.f;
        const bf16x8* wp = WST + (size_t)g * WST_FRAGS + (size_t)(nt * 64 + kh * 32) * 64 + lane;
        const char* up = sU + r * SU_CH + h * 16 + kh * 32 * 32;
#pragma unroll 16
        for (int j = 0; j < 32; ++j) {
            const bf16x8 a = wp[j * 64];
            const bf16x8 bb = *(const bf16x8*)(up + j * 32);
            acc = MFMA32(a, bb, acc);
        }
        if (kh == 1) {
#pragma unroll
            for (int i = 0; i < 16; ++i) sPart[(nt * 16 + i) * 64 + lane] = acc[i];
        }
        __syncthreads();
        if (kh == 0) {
#pragma unroll
            for (int i = 0; i < 16; ++i) sL[r * 132 + nt * 32 + crow(i, h)] = acc[i] + sPart[(nt * 16 + i) * 64 + lane];
        }
        __syncthreads();
    }
    if (tid < 64) {
        const int p = tid;
        const float ar = ABT[g * 128 + 2 * p], ai = ABT[g * 128 + 2 * p + 1];
        float sr = 0.f, si = 0.f;
        for (int c = 0; c < 32; ++c) {
            *(bf16_t*)(sSp + c * 272 + p * 2) = (bf16_t)(pack_bf2(sr, 0.f) & 0xffffu);
            *(bf16_t*)(sSp + c * 272 + (64 + p) * 2) = (bf16_t)(pack_bf2(si, 0.f) & 0xffffu);
            const float lr = sL[c * 132 + p], li = sL[c * 132 + 64 + p];
            const float nr = ar * sr - ai * si + lr, ni = ar * si + ai * sr + li;
            sr = nr; si = ni;
        }
    }
    f32x16 acc4[4];
#pragma unroll
    for (int q = 0; q < 4; ++q)
#pragma unroll
        for (int i = 0; i < 16; ++i) acc4[q][i] = 0.f;
    const int mts0 = w, mts1 = 15 - w, mts2 = 16 + w, mts3 = 31 - w;
    {
        const char* up = sU + r * SU_CH + h * 16;
        const char* kp = sKT + (r & 15) * 32 + h * 16 + ((r >> 4) + 1) * KT_BLK;
        for (int j = 0; j < 64; ++j) {
            const bf16x8 bb = *(const bf16x8*)(up + j * 32);
#define TOEP_STEP(q, mt) if (2 * (mt) + 1 >= j) { const bf16x8 a = *(const bf16x8*)(kp + (2 * (mt) - j) * KT_BLK); acc4[q] = MFMA32(a, bb, acc4[q]); }
            TOEP_STEP(0, mts0) TOEP_STEP(1, mts1) TOEP_STEP(2, mts2) TOEP_STEP(3, mts3)
#undef TOEP_STEP
        }
    }
    __syncthreads();
    {
        const bf16x8* cp = CCAR + (size_t)g * CCAR_FRAGS + lane;
        const char* sp = sSp + r * 272 + h * 16;
#pragma unroll
        for (int ks = 0; ks < 8; ++ks) {
            const bf16x8 bb = *(const bf16x8*)(sp + ks * 32);
            acc4[0] = MFMA32(cp[(mts0 * 8 + ks) * 64], bb, acc4[0]);
            acc4[1] = MFMA32(cp[(mts1 * 8 + ks) * 64], bb, acc4[1]);
            acc4[2] = MFMA32(cp[(mts2 * 8 + ks) * 64], bb, acc4[2]);
            acc4[3] = MFMA32(cp[(mts3 * 8 + ks) * 64], bb, acc4[3]);
        }
    }
    {
        bf16_t* ybase = YPRE + (size_t)(b * SEQ + r * 64) * 512 + g * 16;
#define PB_STORE(q, mt) _Pragma("unroll") for (int rq = 0; rq < 4; ++rq) { const int c0 = 8 * rq + 4 * h; const int i = 2 * (mt) + (c0 >> 4); \
            uint2 o; o.x = pack_bf2(acc4[q][4 * rq], acc4[q][4 * rq + 1]); o.y = pack_bf2(acc4[q][4 * rq + 2], acc4[q][4 * rq + 3]); \
            *(uint2*)(ybase + (size_t)i * 512 + (c0 & 15)) = o; }
        PB_STORE(0, mts0) PB_STORE(1, mts1) PB_STORE(2, mts2) PB_STORE(3, mts3)
#undef PB_STORE
    }
    __syncthreads();
}

#ifndef REP_GLU
#define REP_GLU 1
#endif
#ifndef REP_POOL
#define REP_POOL 1
#endif
#ifndef REP_OUT
#define REP_OUT 1
#endif
#ifndef REP_Q
#define REP_Q 1
#endif
#ifndef REP_SC
#define REP_SC 1
#endif
struct ALoadGelu {
    const bf16_t* base; bf16_t* gout; u32x4 v0, v1; int cc; int dofs;
    DI void init(const bf16_t* rowbase, bf16_t* growbase, int tid) { base = rowbase + (tid & 7) * 16; gout = growbase + (tid & 7) * 16; dofs = (tid >> 3) * SA_STRIDE + (tid & 7) * 32; }
    DI void issue(int c) { const u32x4* p = (const u32x4*)(base + c * 128); v0 = p[0]; v1 = p[1]; cc = c; }
    DI unsigned g2(unsigned u) { return pack_bf2(gelu_exact(bf_lo(u)), gelu_exact(bf_hi(u))); }
    DI void commit(char* buf) {
        u32x4 o0, o1;
        o0.x = g2(v0.x); o0.y = g2(v0.y); o0.z = g2(v0.z); o0.w = g2(v0.w);
        o1.x = g2(v1.x); o1.y = g2(v1.y); o1.z = g2(v1.z); o1.w = g2(v1.w);
        char* d = buf + dofs;
        *(u32x4*)d = o0; *(u32x4*)(d + 16) = o1;
        u32x4* gp = (u32x4*)(gout + cc * 128); gp[0] = o0; gp[1] = o1;
    }
};

DI void tok_reduce(float p0, float p1, float* sred, float& t0, float& t1, int tid) {
    const int w = tid >> 6, lane = tid & 63, r = lane & 31, h = lane >> 5;
    __syncthreads();
    sred[(w * 2 + h) * 64 + r] = p0; sred[(w * 2 + h) * 64 + 32 + r] = p1;
    __syncthreads();
    float a = 0.f, b = 0.f;
#pragma unroll
    for (int k = 0; k < 16; ++k) { a += sred[k * 64 + r]; b += sred[k * 64 + 32 + r]; }
    t0 = a; t1 = b;
}

#define PC_SRED (4 * SA_BYTES)
#define PC_BYTES (PC_SRED + 4096 + 256)

struct PCArgs {
    const bf16_t* U; const bf16_t* YPRE; bf16_t* G1; bf16_t* A2; const float* Xin; float* Xout; float* Xdummy; bf16_t* Hb; float* RSTD;
    const bf16x8* wfglu; const float* b_glu; const bf16x8* wfpool; const float* pool_scale; const bf16x8* wfout;
};

DI void phaseC1_tile(const PCArgs& a, int tile, char* smem, int wid) {
    char* sA = smem; float* sred = (float*)(smem + PC_SRED);
    for (int rep_ = 0; rep_ < REP_GLU; ++rep_) {
        int tok0 = tile * 64; asm volatile("" : "+s"(tok0));
        int tid = get_tid(wid);
        const int w = __builtin_amdgcn_readfirstlane(tid >> 6), lane = tid & 63, r = lane & 31, h = lane >> 5;
        ALoadGelu al; al.init(a.YPRE + (size_t)(tok0 + (tid >> 3)) * 512, a.G1 + (size_t)(tok0 + (tid >> 3)) * 512, tid);
        f32x16 acc[2][2]; zero_acc<2>(acc);
        gemm64<2, 4>(acc, al, 4, a.wfglu + (size_t)w * (32 * 2 * 64) + lane, sA, lane);
        float ss0 = 0.f, ss1 = 0.f;
        {
            uint2 yp[2][2][4]; float4 bg[2][4];
#pragma unroll
            for (int nt = 0; nt < 2; ++nt)
#pragma unroll
                for (int q = 0; q < 4; ++q) bg[nt][q] = *(const float4*)(a.b_glu + w * 64 + nt * 32 + 8 * q + 4 * h);
#pragma unroll
            for (int mt = 0; mt < 2; ++mt)
#pragma unroll
                for (int nt = 0; nt < 2; ++nt)
#pragma unroll
                    for (int q = 0; q < 4; ++q)
                        yp[mt][nt][q] = *(const uint2*)(a.G1 + (size_t)(tok0 + mt * 32 + r) * 512 + w * 64 + nt * 32 + 8 * q + 4 * h);
#pragma unroll
            for (int mt = 0; mt < 2; ++mt)
#pragma unroll
                for (int nt = 0; nt < 2; ++nt)
#pragma unroll
                    for (int q = 0; q < 4; ++q) {
                        const float y0 = bf_lo(yp[mt][nt][q].x), y1 = bf_hi(yp[mt][nt][q].x), y2 = bf_lo(yp[mt][nt][q].y), y3 = bf_hi(yp[mt][nt][q].y);
                        const float o0 = y0 / (1.f + __expf(-(acc[nt][mt][4 * q] + bg[nt][q].x)));
                        const float o1 = y1 / (1.f + __expf(-(acc[nt][mt][4 * q + 1] + bg[nt][q].y)));
                        const float o2 = y2 / (1.f + __expf(-(acc[nt][mt][4 * q + 2] + bg[nt][q].z)));
                        const float o3 = y3 / (1.f + __expf(-(acc[nt][mt][4 * q + 3] + bg[nt][q].w)));
                        acc[nt][mt][4 * q] = o0; acc[nt][mt][4 * q + 1] = o1; acc[nt][mt][4 * q + 2] = o2; acc[nt][mt][4 * q + 3] = o3;
                        const float s = o0 * o0 + o1 * o1 + o2 * o2 + o3 * o3;
                        if (mt == 0) ss0 += s; else ss1 += s;
                    }
        }
        float t0, t1; tok_reduce(ss0, ss1, sred, t0, t1, tid);
        const float rs0 = rsqrtf(t0 * (1.f / 512.f) + 1e-6f), rs1 = rsqrtf(t1 * (1.f / 512.f) + 1e-6f);
#pragma unroll
        for (int mt = 0; mt < 2; ++mt) {
            const float rs = mt ? rs1 : rs0;
            bf16_t* orow = a.A2 + (size_t)(tok0 + mt * 32 + r) * DM + w * 64;
#pragma unroll
            for (int nt = 0; nt < 2; ++nt)
#pragma unroll
                for (int q = 0; q < 4; ++q) {
                    uint2 o; o.x = pack_bf2(acc[nt][mt][4 * q] * rs, acc[nt][mt][4 * q + 1] * rs);
                    o.y = pack_bf2(acc[nt][mt][4 * q + 2] * rs, acc[nt][mt][4 * q + 3] * rs);
                    *(uint2*)(orow + nt * 32 + 8 * q + 4 * h) = o;
                }
        }
    }
    for (int rep_ = 0; rep_ < REP_POOL; ++rep_) {
        int tok0 = tile * 64; asm volatile("" : "+s"(tok0));
        int tid = get_tid(wid);
        const int w = __builtin_amdgcn_readfirstlane(tid >> 6), lane = tid & 63, r = lane & 31, h = lane >> 5;
        const int row = tid >> 3, seg = tid & 7;
        const int tok = tok0 + row, t = tok & (SEQ - 1);
#pragma unroll
        for (int gi = 0; gi < 4; ++gi) {
            const int win = 2 << gi;
            const int cnt = (t + 1 < win) ? (t + 1) : win;
            const bf16_t* up = a.U + (size_t)tok * DM + 512 + gi * 128 + seg * 16;
            float s[16];
            const uint4 c0 = *(const uint4*)up, c1 = *(const uint4*)(up + 8);
            const unsigned cu[8] = {c0.x, c0.y, c0.z, c0.w, c1.x, c1.y, c1.z, c1.w};
#pragma unroll
            for (int i = 0; i < 8; ++i) { s[2 * i] = bf_lo(cu[i]); s[2 * i + 1] = bf_hi(cu[i]); }
#pragma unroll
            for (int k0 = 1; k0 < win; k0 += 5) {
                uint4 d0[5], d1[5];
#pragma unroll
                for (int u = 0; u < 5; ++u)
                    if (k0 + u < win) {
                        const bf16_t* p = (k0 + u <= t) ? up - (size_t)(k0 + u) * DM : up;
                        d0[u] = *(const uint4*)p; d1[u] = *(const uint4*)(p + 8);
                    }
#pragma unroll
                for (int u = 0; u < 5; ++u)
                    if (k0 + u < win) {
                        const float m = (k0 + u <= t) ? 1.f : 0.f;
                        const unsigned du[8] = {d0[u].x, d0[u].y, d0[u].z, d0[u].w, d1[u].x, d1[u].y, d1[u].z, d1[u].w};
#pragma unroll
                        for (int i = 0; i < 8; ++i) { s[2 * i] = fmaf(m, bf_lo(du[i]), s[2 * i]); s[2 * i + 1] = fmaf(m, bf_hi(du[i]), s[2 * i + 1]); }
                    }
            }
            const float inv = 1.f / (float)cnt;
            unsigned o[8];
#pragma unroll
            for (int i = 0; i < 8; ++i) o[i] = pack_bf2(s[2 * i] * inv - bf_lo(cu[i]), s[2 * i + 1] * inv - bf_hi(cu[i]));
            char* d = sA + gi * SA_BYTES + row * SA_STRIDE + seg * 32;
            *(uint4*)d = make_uint4(o[0], o[1], o[2], o[3]); *(uint4*)(d + 16) = make_uint4(o[4], o[5], o[6], o[7]);
        }
        __syncthreads();
        const int gi = w >> 1;
        f32x16 acc[2][2]; zero_acc<2>(acc);
        const bf16x8* wp = a.wfpool + (size_t)gi * (128 * 128 / 8) + (size_t)(w & 1) * (8 * 2 * 64) + lane;
        const char* buf = sA + gi * SA_BYTES + r * SA_STRIDE + h * 16;
#pragma unroll
        for (int ks = 0; ks < 8; ++ks) {
            const bf16x8 a0 = *(const bf16x8*)(buf + ks * 32);
            const bf16x8 a1 = *(const bf16x8*)(buf + 32 * SA_STRIDE + ks * 32);
#pragma unroll
            for (int nt = 0; nt < 2; ++nt) {
                const bf16x8 wv = wp[(ks * 2 + nt) * 64];
                acc[nt][0] = MFMA32(wv, a0, acc[nt][0]);
                acc[nt][1] = MFMA32(wv, a1, acc[nt][1]);
            }
        }
        float ss0 = 0.f, ss1 = 0.f;
        float4 psc[2][4];
#pragma unroll
        for (int nt = 0; nt < 2; ++nt)
#pragma unroll
            for (int q = 0; q < 4; ++q) psc[nt][q] = *(const float4*)(a.pool_scale + w * 64 + nt * 32 + 8 * q + 4 * h);
#pragma unroll
        for (int mt = 0; mt < 2; ++mt)
#pragma unroll
            for (int nt = 0; nt < 2; ++nt)
#pragma unroll
                for (int q = 0; q < 4; ++q) {
                    const float4 sc = psc[nt][q];
                    const float o0 = acc[nt][mt][4 * q] * sc.x, o1 = acc[nt][mt][4 * q + 1] * sc.y, o2 = acc[nt][mt][4 * q + 2] * sc.z, o3 = acc[nt][mt][4 * q + 3] * sc.w;
                    acc[nt][mt][4 * q] = o0; acc[nt][mt][4 * q + 1] = o1; acc[nt][mt][4 * q + 2] = o2; acc[nt][mt][4 * q + 3] = o3;
                    const float s = o0 * o0 + o1 * o1 + o2 * o2 + o3 * o3;
                    if (mt == 0) ss0 += s; else ss1 += s;
                }
        float t0, t1; tok_reduce(ss0, ss1, sred, t0, t1, tid);
        const float rs0 = rsqrtf(t0 * (1.f / 512.f) + 1e-6f), rs1 = rsqrtf(t1 * (1.f / 512.f) + 1e-6f);
#pragma unroll
        for (int mt = 0; mt < 2; ++mt) {
            const float rs = mt ? rs1 : rs0;
            bf16_t* orow = a.A2 + (size_t)(tok0 + mt * 32 + r) * DM + 512 + w * 64;
#pragma unroll
            for (int nt = 0; nt < 2; ++nt)
#pragma unroll
                for (int q = 0; q < 4; ++q) {
                    uint2 o; o.x = pack_bf2(acc[nt][mt][4 * q] * rs, acc[nt][mt][4 * q + 1] * rs);
                    o.y = pack_bf2(acc[nt][mt][4 * q + 2] * rs, acc[nt][mt][4 * q + 3] * rs);
                    *(uint2*)(orow + nt * 32 + 8 * q + 4 * h) = o;
                }
        }
        __syncthreads();
    }
    for (int rep_ = 0; rep_ < REP_OUT; ++rep_) {
        float* xout_ = (rep_ + 1 < REP_OUT) ? a.Xdummy : a.Xout;
        int tok0 = tile * 64; asm volatile("" : "+s"(tok0));
        int tid = get_tid(wid);
        const int w = __builtin_amdgcn_readfirstlane(tid >> 6), lane = tid & 63, r = lane & 31, h = lane >> 5;
        ALoadBF16 al; al.init(a.A2 + (size_t)(tok0 + (tid >> 3)) * DM, tid);
        f32x16 acc[4][2]; zero_acc<4>(acc);
        gemm64<4, 2>(acc, al, 8, a.wfout + (size_t)w * (64 * 4 * 64) + lane, sA, lane);
        {
            float* wscr = (float*)(smem + w * WSCR_BYTES);
            const int tl = lane >> 3, cl = (lane & 7) * 4;
            float ssj[2][4];
#pragma unroll
            for (int mt = 0; mt < 2; ++mt)
#pragma unroll
                for (int j = 0; j < 4; ++j) ssj[mt][j] = 0.f;
            float4 xc[4], xn[4];
            const size_t rbase = (size_t)(tok0 + tl) * DM + w * 128 + cl;
#pragma unroll
            for (int j = 0; j < 4; ++j) xc[j] = *(const float4*)(a.Xin + rbase + (size_t)(8 * j) * DM);
#pragma unroll
            for (int g = 0; g < 8; ++g) {
                const int mt = g >> 2, nt = g & 3;
                if (g < 7) {
                    const size_t rn = rbase + (size_t)((g + 1) >> 2) * 32 * DM + ((g + 1) & 3) * 32;
#pragma unroll
                    for (int j = 0; j < 4; ++j) xn[j] = *(const float4*)(a.Xin + rn + (size_t)(8 * j) * DM);
                }
                f32x4 o[4]; tile_transpose(acc[nt][mt], wscr, lane, o);
                const size_t ro = rbase + (size_t)mt * 32 * DM + nt * 32;
#pragma unroll
                for (int j = 0; j < 4; ++j) {
                    float4 xo; xo.x = xc[j].x + o[j].x; xo.y = xc[j].y + o[j].y; xo.z = xc[j].z + o[j].z; xo.w = xc[j].w + o[j].w;
                    *(float4*)(xout_ + ro + (size_t)(8 * j) * DM) = xo;
                    uint2 p; p.x = pack_bf2(xo.x, xo.y); p.y = pack_bf2(xo.z, xo.w);
                    *(uint2*)(a.Hb + ro + (size_t)(8 * j) * DM) = p;
                    ssj[mt][j] += xo.x * xo.x + xo.y * xo.y + xo.z * xo.z + xo.w * xo.w;
                }
                asm volatile("" ::: "memory");
#pragma unroll
                for (int j = 0; j < 4; ++j) xc[j] = xn[j];
            }
#pragma unroll
            for (int mt = 0; mt < 2; ++mt)
#pragma unroll
                for (int j = 0; j < 4; ++j) {
                    float v = ssj[mt][j];
                    v += shx<1>(v, lane); v += shx<2>(v, lane); v += shx<4>(v, lane);
                    if ((lane & 7) == 0) sred[w * 64 + mt * 32 + tl + 8 * j] = v;
                }
            __syncthreads();
            if (tid < 64) {
                float tot = 0.f;
#pragma unroll
                for (int k = 0; k < 8; ++k) tot += sred[k * 64 + tid];
                a.RSTD[tok0 + tid] = rsqrtf(tot * (1.f / 1024.f) + 1e-6f);
            }
        }
        __syncthreads();
    }
}

DI unsigned f2ord(float f) { const unsigned u = __float_as_uint(f); return u ^ ((u >> 31) ? 0xFFFFFFFFu : 0x80000000u); }
DI float ord2f(unsigned o) { return __uint_as_float((o & 0x80000000u) ? (o ^ 0x80000000u) : ~o); }
DI unsigned umax_(unsigned a, unsigned b) { return a > b ? a : b; }
DI unsigned umin_(unsigned a, unsigned b) { return a < b ? a : b; }

struct PRArgs {
    const bf16_t* Hb; const float* RSTD; const bf16x8* wfq; const bf16x8* kf1; const bf16x8* kf2; unsigned short* EX; float* GT;
};

DI void conv_kfrag(const float* __restrict__ K, bf16x8* __restrict__ dst, size_t gtid, size_t gstride) {
    for (size_t item = gtid; item < 8 * 4 * 64; item += gstride) {
        const int lane = (int)(item & 63), kt = (int)((item >> 6) & 3), ks = (int)(item >> 8);
        const int r = lane & 31, h = lane >> 5;
        float v[8];
#pragma unroll
        for (int j = 0; j < 8; ++j) v[j] = K[(size_t)(kt * 32 + r) * 128 + (ks >> 1) * 32 + 16 * (ks & 1) + 8 * (j >> 2) + 4 * h + (j & 3)];
        uint4 o; o.x = pack_bf2(v[0], v[1]); o.y = pack_bf2(v[2], v[3]); o.z = pack_bf2(v[4], v[5]); o.w = pack_bf2(v[6], v[7]);
        *(uint4*)(dst + item) = o;
    }
}

DI void bitonic_sort16(unsigned (&a)[16]) {
#pragma unroll
    for (int k = 2; k <= 16; k <<= 1)
#pragma unroll
        for (int j = k >> 1; j > 0; j >>= 1)
#pragma unroll
            for (int i = 0; i < 16; ++i) {
                const int l = i ^ j;
                if (l > i) {
                    const unsigned hi = umax_(a[i], a[l]), lo = umin_(a[i], a[l]);
                    if ((i & k) == 0) { a[i] = hi; a[l] = lo; } else { a[i] = lo; a[l] = hi; }
                }
            }
}
DI void bitonic_top16(unsigned (&a)[16], const unsigned (&b)[16]) {
#pragma unroll
    for (int i = 0; i < 16; ++i) a[i] = umax_(a[i], b[15 - i]);
#pragma unroll
    for (int j = 8; j > 0; j >>= 1)
#pragma unroll
        for (int i = 0; i < 16; ++i) {
            const int l = i ^ j;
            if (l > i) { const unsigned hi = umax_(a[i], a[l]), lo = umin_(a[i], a[l]); a[i] = hi; a[l] = lo; }
        }
}
DI void make_keys(unsigned (&x)[16], const f32x16& s, float rs, int nbase, int h) {
#pragma unroll
    for (int i = 0; i < 16; ++i) x[i] = (f2ord(s[i] * rs) & 0xFFFFFF80u) | (unsigned)(127 - (nbase + crow(i, h)));
}

#define PR_LIST_STRIDE 80
#define PR_SLIST (2 * SA_BYTES)
#define PR_SIDX (PR_SLIST + 8 * 32 * PR_LIST_STRIDE)

DI void phaseC2_tile(const PRArgs& a, int tile, char* smem, int wid) {
    char* sA = smem;
#pragma unroll 1
    for (int ps = 0; ps < 2; ++ps) {
        int tok0 = tile * 64; asm volatile("" : "+s"(tok0));
        int tid = get_tid(wid);
        const int w = __builtin_amdgcn_readfirstlane(tid >> 6), lane = tid & 63, r = lane & 31, h = lane >> 5;
        const int ng = ps * 8 + w, hd = ng >> 1, hf = ng & 1;
        bf16x8 qb[2][8];
        {
            ALoadBF16 al; al.init(a.Hb + (size_t)(tok0 + (tid >> 3)) * DM, tid);
            f32x16 acc[4][2]; zero_acc<4>(acc);
            gemm64<4, 2>(acc, al, 8, a.wfq + (size_t)ng * (64 * 4 * 64) + lane, sA, lane);
#pragma unroll
            for (int mt = 0; mt < 2; ++mt)
#pragma unroll
                for (int nt = 0; nt < 4; ++nt)
#pragma unroll
                    for (int s = 0; s < 2; ++s) {
                        u32x4 p;
                        p.x = pack_bf2(acc[nt][mt][8 * s], acc[nt][mt][8 * s + 1]); p.y = pack_bf2(acc[nt][mt][8 * s + 2], acc[nt][mt][8 * s + 3]);
                        p.z = pack_bf2(acc[nt][mt][8 * s + 4], acc[nt][mt][8 * s + 5]); p.w = pack_bf2(acc[nt][mt][8 * s + 6], acc[nt][mt][8 * s + 7]);
                        qb[mt][nt * 2 + s] = __builtin_bit_cast(bf16x8, p);
                    }
        }
        gwp_t kf = (gwp_t)(hf ? a.kf2 : a.kf1) + lane;
        unsigned Town[16];
#pragma unroll
        for (int mt = 0; mt < 2; ++mt) {
            f32x16 sc[4];
#pragma unroll
            for (int kt = 0; kt < 4; ++kt)
#pragma unroll
                for (int i = 0; i < 16; ++i) sc[kt][i] = 0.f;
#pragma unroll
            for (int ks = 0; ks < 8; ++ks) {
#pragma unroll
                for (int kt = 0; kt < 4; ++kt) sc[kt] = MFMA32(kf[(ks * 4 + kt) * 64], qb[mt][ks], sc[kt]);
                if (ks & 1) asm volatile("" ::: "memory");
            }
            const float rs = a.RSTD[tok0 + mt * 32 + r];
            unsigned L[16], S[16];
            make_keys(L, sc[0], rs, 0, h); bitonic_sort16(L);
#pragma unroll
            for (int kt = 1; kt < 4; ++kt) { make_keys(S, sc[kt], rs, kt * 32, h); bitonic_sort16(S); bitonic_top16(L, S); }
#pragma unroll
            for (int k = 0; k < 16; ++k) S[k] = (unsigned)shx_i<32>((int)L[k], lane);
            bitonic_top16(L, S);
            if (mt == hf) {
#pragma unroll
                for (int k = 0; k < 16; ++k) Town[k] = L[k];
            } else {
                char* dst = smem + PR_SLIST + (w * 32 + r) * PR_LIST_STRIDE + h * 32;
                u32x4 v0, v1;
                if (h == 0) { v0 = (u32x4){L[0], L[1], L[2], L[3]}; v1 = (u32x4){L[4], L[5], L[6], L[7]}; }
                else { v0 = (u32x4){L[8], L[9], L[10], L[11]}; v1 = (u32x4){L[12], L[13], L[14], L[15]}; }
                *(u32x4*)dst = v0; *(u32x4*)(dst + 16) = v1;
            }
        }
        __syncthreads();
        unsigned T0[16], T1[16];
        {
            const char* src = smem + PR_SLIST + ((w ^ 1) * 32 + r) * PR_LIST_STRIDE;
            const u32x4 p0 = *(const u32x4*)src, p1 = *(const u32x4*)(src + 16), p2 = *(const u32x4*)(src + 32), p3 = *(const u32x4*)(src + 48);
            const unsigned Tp[16] = {p0.x, p0.y, p0.z, p0.w, p1.x, p1.y, p1.z, p1.w, p2.x, p2.y, p2.z, p2.w, p3.x, p3.y, p3.z, p3.w};
#pragma unroll
            for (int k = 0; k < 16; ++k) { T0[k] = hf ? Tp[k] : Town[k]; T1[k] = hf ? Town[k] : Tp[k]; }
        }
        float v1[16], v2[16];
#pragma unroll
        for (int k = 0; k < 16; ++k) { v1[k] = ord2f(T0[k] & 0xFFFFFF80u); v2[k] = ord2f(T1[k] & 0xFFFFFF80u); }
        unsigned C[16];
#pragma unroll
        for (int b = 0; b < 16; ++b) C[b] = (f2ord(v1[0] + v2[b]) & 0xFFFFFF00u) | (unsigned)(255 - b);
#pragma unroll
        for (int aa = 1; aa < 16; ++aa)
#pragma unroll
            for (int b = 0; b < 16; ++b)
                if ((aa + 1) * (b + 1) <= 16) {
                    unsigned x = (f2ord(v1[aa] + v2[b]) & 0xFFFFFF00u) | (unsigned)(255 - (aa * 16 + b));
#pragma unroll
                    for (int k = (aa + 1) * (b + 1) - 1; k < 16; ++k) { const unsigned hi = umax_(C[k], x); x = umin_(C[k], x); C[k] = hi; }
                }
        unsigned* sI = (unsigned*)(smem + PR_SIDX) + (w * 64 + lane) * 9;
#pragma unroll
        for (int q = 0; q < 4; ++q) {
            unsigned p1 = 0u, p2 = 0u;
#pragma unroll
            for (int j = 0; j < 4; ++j) { p1 |= (127u - (T0[4 * q + j] & 0x7Fu)) << (8 * j); p2 |= (127u - (T1[4 * q + j] & 0x7Fu)) << (8 * j); }
            sI[q] = p1; sI[4 + q] = p2;
        }
        const unsigned char* sB = (const unsigned char*)sI;
        const float mx = ord2f(C[0] & 0xFFFFFF00u);
        float e[16]; float sum = 0.f; int ex[16];
#pragma unroll
        for (int k = 0; k < 16; ++k) {
            e[k] = __expf(ord2f(C[k] & 0xFFFFFF00u) - mx); sum += e[k];
            const unsigned ci = 255u - (C[k] & 0xFFu);
            ex[k] = (int)sB[ci >> 4] * 128 + (int)sB[16 + (ci & 15u)];
        }
        const float inv = 1.f / sum;
        const size_t ob = ((size_t)(tok0 + hf * 32 + r) * 8 + hd) * 16;
        if (h == 0) {
#pragma unroll
            for (int q = 0; q < 2; ++q) *(uint4*)(a.EX + ob + 8 * q) = make_uint4((unsigned)ex[8 * q] | ((unsigned)ex[8 * q + 1] << 16), (unsigned)ex[8 * q + 2] | ((unsigned)ex[8 * q + 3] << 16),
                                                                       (unsigned)ex[8 * q + 4] | ((unsigned)ex[8 * q + 5] << 16), (unsigned)ex[8 * q + 6] | ((unsigned)ex[8 * q + 7] << 16));
        } else {
#pragma unroll
            for (int q = 0; q < 4; ++q) *(float4*)(a.GT + ob + 4 * q) = make_float4(e[4 * q] * inv, e[4 * q + 1] * inv, e[4 * q + 2] * inv, e[4 * q + 3] * inv);
        }
        __syncthreads();
    }
}
typedef const __attribute__((address_space(1))) u32x4* grow_t;
typedef unsigned char fp8_t;

struct PGArgs {
    const bf16_t* Hb; const float* RSTD; const int* EX; const float* GT; const fp8_t* U8; const fp8_t* V8; const float* SU; const float* SV;
    const float* Xin; float* Xout; const float* gfinal; int final_norm;
};

#ifndef EMU_FP4
#define EMU_FP4 0
#endif
DI float q_e2m1(float x, float inv, float sc) {
    const float a = fabsf(x) * inv;
    float q = (a < 0.25f) ? 0.f : (a < 0.75f) ? 0.5f : (a < 1.25f) ? 1.f : (a < 1.75f) ? 1.5f : (a < 2.5f) ? 2.f : (a < 3.5f) ? 3.f : (a < 5.f) ? 4.f : 6.f;
    return copysignf(q * sc, x);
}
DI void emu_fp4_block(float4& v0, float4& v1, float4& v2, float4& v3) {
    float m = fmaxf(fmaxf(fmaxf(fabsf(v0.x), fabsf(v0.y)), fmaxf(fabsf(v0.z), fabsf(v0.w))), fmaxf(fmaxf(fabsf(v1.x), fabsf(v1.y)), fmaxf(fabsf(v1.z), fabsf(v1.w))));
    m = fmaxf(m, fmaxf(fmaxf(fmaxf(fabsf(v2.x), fabsf(v2.y)), fmaxf(fabsf(v2.z), fabsf(v2.w))), fmaxf(fmaxf(fabsf(v3.x), fabsf(v3.y)), fmaxf(fabsf(v3.z), fabsf(v3.w)))));
    const float sc = (m > 0.f) ? m * (1.f / 6.f) : 1.f, inv = 1.f / sc;
    v0.x = q_e2m1(v0.x, inv, sc); v0.y = q_e2m1(v0.y, inv, sc); v0.z = q_e2m1(v0.z, inv, sc); v0.w = q_e2m1(v0.w, inv, sc);
    v1.x = q_e2m1(v1.x, inv, sc); v1.y = q_e2m1(v1.y, inv, sc); v1.z = q_e2m1(v1.z, inv, sc); v1.w = q_e2m1(v1.w, inv, sc);
    v2.x = q_e2m1(v2.x, inv, sc); v2.y = q_e2m1(v2.y, inv, sc); v2.z = q_e2m1(v2.z, inv, sc); v2.w = q_e2m1(v2.w, inv, sc);
    v3.x = q_e2m1(v3.x, inv, sc); v3.y = q_e2m1(v3.y, inv, sc); v3.z = q_e2m1(v3.z, inv, sc); v3.w = q_e2m1(v3.w, inv, sc);
}
DI void conv_row_fp8_one(float4 v0, float4 v1, float4 v2, float4 v3, const float* __restrict__ gain, fp8_t* __restrict__ dst, float* __restrict__ scales,
                         int nrows, int row, int lane) {
    if (gain) {
        const float4* g = (const float4*)(gain + lane * 16);
        const float4 g0 = g[0], g1 = g[1], g2 = g[2], g3 = g[3];
        v0.x *= g0.x; v0.y *= g0.y; v0.z *= g0.z; v0.w *= g0.w; v1.x *= g1.x; v1.y *= g1.y; v1.z *= g1.z; v1.w *= g1.w;
        v2.x *= g2.x; v2.y *= g2.y; v2.z *= g2.z; v2.w *= g2.w; v3.x *= g3.x; v3.y *= g3.y; v3.z *= g3.z; v3.w *= g3.w;
    }
    if (gain ? (EMU_FP4 & 1) : (EMU_FP4 & 2)) emu_fp4_block(v0, v1, v2, v3);
    float m = fmaxf(fmaxf(fmaxf(fabsf(v0.x), fabsf(v0.y)), fmaxf(fabsf(v0.z), fabsf(v0.w))), fmaxf(fmaxf(fabsf(v1.x), fabsf(v1.y)), fmaxf(fabsf(v1.z), fabsf(v1.w))));
    m = fmaxf(m, fmaxf(fmaxf(fmaxf(fabsf(v2.x), fabsf(v2.y)), fmaxf(fabsf(v2.z), fabsf(v2.w))), fmaxf(fmaxf(fabsf(v3.x), fabsf(v3.y)), fmaxf(fabsf(v3.z), fabsf(v3.w)))));
    m = fmaxf(m, shx<1>(m, lane)); m = fmaxf(m, shx<2>(m, lane)); m = fmaxf(m, shx<4>(m, lane)); m = fmaxf(m, shx<8>(m, lane)); m = fmaxf(m, shx<16>(m, lane)); m = fmaxf(m, shx<32>(m, lane));
    const float sc = (m > 0.f) ? m * (1.f / 448.f) : 1.f;
    const float inv = 1.f / sc;
    u32x4 o;
    unsigned t;
    t = 0u; t = __builtin_amdgcn_cvt_pk_fp8_f32(v0.x * inv, v0.y * inv, t, false); t = __builtin_amdgcn_cvt_pk_fp8_f32(v0.z * inv, v0.w * inv, t, true); o.x = t;
    t = 0u; t = __builtin_amdgcn_cvt_pk_fp8_f32(v1.x * inv, v1.y * inv, t, false); t = __builtin_amdgcn_cvt_pk_fp8_f32(v1.z * inv, v1.w * inv, t, true); o.y = t;
    t = 0u; t = __builtin_amdgcn_cvt_pk_fp8_f32(v2.x * inv, v2.y * inv, t, false); t = __builtin_amdgcn_cvt_pk_fp8_f32(v2.z * inv, v2.w * inv, t, true); o.z = t;
    t = 0u; t = __builtin_amdgcn_cvt_pk_fp8_f32(v3.x * inv, v3.y * inv, t, false); t = __builtin_amdgcn_cvt_pk_fp8_f32(v3.z * inv, v3.w * inv, t, true); o.w = t;
    *(u32x4*)(dst + ((size_t)(lane >> 3) * nrows + row) * 128 + (lane & 7) * 16) = o;
    if (lane == 0) scales[row] = sc;
}
DI void conv_rows_fp8(const float* __restrict__ src, const float* __restrict__ gain, fp8_t* __restrict__ dst, float* __restrict__ scales,
                      int nrows, int gwave, int nwaves, int lane) {
#pragma unroll 1
    for (int row = gwave; row < nrows; row += 4 * nwaves) {
        const int r1 = min(row + nwaves, nrows - 1), r2 = min(row + 2 * nwaves, nrows - 1), r3 = min(row + 3 * nwaves, nrows - 1);
        const float4* p0 = (const float4*)(src + (size_t)row * DM + lane * 16);
        const float4* p1 = (const float4*)(src + (size_t)r1 * DM + lane * 16);
        const float4* p2 = (const float4*)(src + (size_t)r2 * DM + lane * 16);
        const float4* p3 = (const float4*)(src + (size_t)r3 * DM + lane * 16);
        const float4 a0 = p0[0], a1 = p0[1], a2 = p0[2], a3 = p0[3];
        const float4 b0 = p1[0], b1 = p1[1], b2 = p1[2], b3 = p1[3];
        const float4 c0 = p2[0], c1 = p2[1], c2 = p2[2], c3 = p2[3];
        const float4 d0 = p3[0], d1 = p3[1], d2 = p3[2], d3 = p3[3];
        conv_row_fp8_one(a0, a1, a2, a3, gain, dst, scales, nrows, row, lane);
        conv_row_fp8_one(b0, b1, b2, b3, gain, dst, scales, nrows, r1, lane);
        conv_row_fp8_one(c0, c1, c2, c3, gain, dst, scales, nrows, r2, lane);
        conv_row_fp8_one(d0, d1, d2, d3, gain, dst, scales, nrows, r3, lane);
    }
}

struct RowOct { u32x4 r0, r1, r2, r3, r4, r5, r6, r7; };
DI void oct_load(RowOct& q, const fp8_t* tab, int e0, int e1, int e2, int e3, int e4, int e5, int e6, int e7, int lane) {
    q.r0 = ((grow_t)(tab + (size_t)e0 * DM))[lane]; q.r1 = ((grow_t)(tab + (size_t)e1 * DM))[lane];
    q.r2 = ((grow_t)(tab + (size_t)e2 * DM))[lane]; q.r3 = ((grow_t)(tab + (size_t)e3 * DM))[lane];
    q.r4 = ((grow_t)(tab + (size_t)e4 * DM))[lane]; q.r5 = ((grow_t)(tab + (size_t)e5 * DM))[lane];
    q.r6 = ((grow_t)(tab + (size_t)e6 * DM))[lane]; q.r7 = ((grow_t)(tab + (size_t)e7 * DM))[lane];
}
DI float dot4w(unsigned w, float h0, float h1, float h2, float h3, float s) {
    const f2_t lo = __builtin_amdgcn_cvt_pk_f32_fp8(w, false), hi = __builtin_amdgcn_cvt_pk_f32_fp8(w, true);
    s = fmaf(lo.x, h0, s); s = fmaf(lo.y, h1, s); s = fmaf(hi.x, h2, s); s = fmaf(hi.y, h3, s);
    return s;
}
DI float row_dot8(const u32x4& r, const float (&h)[16]) {
    float s = 0.f;
    s = dot4w(r.x, h[0], h[1], h[2], h[3], s); s = dot4w(r.y, h[4], h[5], h[6], h[7], s);
    s = dot4w(r.z, h[8], h[9], h[10], h[11], s); s = dot4w(r.w, h[12], h[13], h[14], h[15], s);
    return s;
}
DI void axpy4w(unsigned w, float c, float& a0, float& a1, float& a2, float& a3) {
    const f2_t lo = __builtin_amdgcn_cvt_pk_f32_fp8(w, false), hi = __builtin_amdgcn_cvt_pk_f32_fp8(w, true);
    a0 = fmaf(c, lo.x, a0); a1 = fmaf(c, lo.y, a1); a2 = fmaf(c, hi.x, a2); a3 = fmaf(c, hi.y, a3);
}
DI void row_axpy8(float (&acc)[16], const u32x4& r, float c) {
    axpy4w(r.x, c, acc[0], acc[1], acc[2], acc[3]); axpy4w(r.y, c, acc[4], acc[5], acc[6], acc[7]);
    axpy4w(r.z, c, acc[8], acc[9], acc[10], acc[11]); axpy4w(r.w, c, acc[12], acc[13], acc[14], acc[15]);
}
#define RL(v, l) __builtin_amdgcn_readlane((v), (l))
#define RLF(v, l) __uint_as_float((unsigned)__builtin_amdgcn_readlane((int)__float_as_uint(v), (l)))

DI float reduce16(float (&p)[16], int lane) {
    const bool b5 = lane & 32, b4 = lane & 16, b3 = lane & 8, b2 = lane & 4;
    float q8[8], q4[4], q2[2];
#pragma unroll
    for (int k = 0; k < 8; ++k) { const float keep = b5 ? p[k + 8] : p[k], send = b5 ? p[k] : p[k + 8]; q8[k] = keep + shx<32>(send, lane); }
#pragma unroll
    for (int k = 0; k < 4; ++k) { const float keep = b4 ? q8[k + 4] : q8[k], send = b4 ? q8[k] : q8[k + 4]; q4[k] = keep + shx<16>(send, lane); }
#pragma unroll
    for (int k = 0; k < 2; ++k) { const float keep = b3 ? q4[k + 2] : q4[k], send = b3 ? q4[k] : q4[k + 2]; q2[k] = keep + shx<8>(send, lane); }
    float t;
    { const float keep = b2 ? q2[1] : q2[0], send = b2 ? q2[0] : q2[1]; t = keep + shx<4>(send, lane); }
    t += shx<1>(t, lane); t += shx<2>(t, lane);
    return t;
}

DI void phaseC3_tile(const PGArgs& a, int tile, int wid) {
    int tid = get_tid(wid);
    const int w = __builtin_amdgcn_readfirstlane(tid >> 6), lane = tid & 63;
    const int el = (lane >> 2) & 15;
#pragma unroll 1
    for (int ti = 0; ti < 8; ++ti) {
        const int tok = tile * 64 + w * 8 + ti;
        float h[16];
        {
            const u32x4* hp = (const u32x4*)(a.Hb + (size_t)tok * DM + lane * 16);
            const u32x4 h0 = hp[0], h1 = hp[1];
            h[0] = bf_lo(h0.x); h[1] = bf_hi(h0.x); h[2] = bf_lo(h0.y); h[3] = bf_hi(h0.y); h[4] = bf_lo(h0.z); h[5] = bf_hi(h0.z); h[6] = bf_lo(h0.w); h[7] = bf_hi(h0.w);
            h[8] = bf_lo(h1.x); h[9] = bf_hi(h1.x); h[10] = bf_lo(h1.y); h[11] = bf_hi(h1.y); h[12] = bf_lo(h1.z); h[13] = bf_hi(h1.z); h[14] = bf_lo(h1.w); h[15] = bf_hi(h1.w);
        }
        const float rs = a.RSTD[tok];
        float acc[16];
#pragma unroll
        for (int i = 0; i < 16; ++i) acc[i] = 0.f;
#pragma unroll 1
        for (int hd = 0; hd < 8; ++hd) {
            const size_t eb = ((size_t)tok * 8 + hd) * 16;
            const int exv = a.EX[eb + (lane & 15)];
            const int exl = a.EX[eb + el];
            const float coef = a.GT[eb + el] * a.SV[exl];
            const float su = a.SU[exl] * rs;
            RowOct qa, qb;
            float p[16];
            oct_load(qa, a.U8, RL(exv, 0), RL(exv, 1), RL(exv, 2), RL(exv, 3), RL(exv, 4), RL(exv, 5), RL(exv, 6), RL(exv, 7), lane);
            oct_load(qb, a.U8, RL(exv, 8), RL(exv, 9), RL(exv, 10), RL(exv, 11), RL(exv, 12), RL(exv, 13), RL(exv, 14), RL(exv, 15), lane);
            p[0] = row_dot8(qa.r0, h); p[1] = row_dot8(qa.r1, h); p[2] = row_dot8(qa.r2, h); p[3] = row_dot8(qa.r3, h);
            p[4] = row_dot8(qa.r4, h); p[5] = row_dot8(qa.r5, h); p[6] = row_dot8(qa.r6, h); p[7] = row_dot8(qa.r7, h);
            oct_load(qa, a.V8, RL(exv, 0), RL(exv, 1), RL(exv, 2), RL(exv, 3), RL(exv, 4), RL(exv, 5), RL(exv, 6), RL(exv, 7), lane);
            p[8] = row_dot8(qb.r0, h); p[9] = row_dot8(qb.r1, h); p[10] = row_dot8(qb.r2, h); p[11] = row_dot8(qb.r3, h);
            p[12] = row_dot8(qb.r4, h); p[13] = row_dot8(qb.r5, h); p[14] = row_dot8(qb.r6, h); p[15] = row_dot8(qb.r7, h);
            oct_load(qb, a.V8, RL(exv, 8), RL(exv, 9), RL(exv, 10), RL(exv, 11), RL(exv, 12), RL(exv, 13), RL(exv, 14), RL(exv, 15), lane);
            const float act = gelu_exact(reduce16(p, lane) * su) * coef;
            row_axpy8(acc, qa.r0, RLF(act, 0)); row_axpy8(acc, qa.r1, RLF(act, 4)); row_axpy8(acc, qa.r2, RLF(act, 8)); row_axpy8(acc, qa.r3, RLF(act, 12));
            row_axpy8(acc, qa.r4, RLF(act, 16)); row_axpy8(acc, qa.r5, RLF(act, 20)); row_axpy8(acc, qa.r6, RLF(act, 24)); row_axpy8(acc, qa.r7, RLF(act, 28));
            row_axpy8(acc, qb.r0, RLF(act, 32)); row_axpy8(acc, qb.r1, RLF(act, 36)); row_axpy8(acc, qb.r2, RLF(act, 40)); row_axpy8(acc, qb.r3, RLF(act, 44));
            row_axpy8(acc, qb.r4, RLF(act, 48)); row_axpy8(acc, qb.r5, RLF(act, 52)); row_axpy8(acc, qb.r6, RLF(act, 56)); row_axpy8(acc, qb.r7, RLF(act, 60));
        }
        const float* xi = a.Xin + (size_t)tok * DM + lane * 16;
        float* xo = a.Xout + (size_t)tok * DM + lane * 16;
        float4 x0 = *(const float4*)xi, x1 = *(const float4*)(xi + 4), x2 = *(const float4*)(xi + 8), x3 = *(const float4*)(xi + 12);
        x0.x += acc[0]; x0.y += acc[1]; x0.z += acc[2]; x0.w += acc[3]; x1.x += acc[4]; x1.y += acc[5]; x1.z += acc[6]; x1.w += acc[7];
        x2.x += acc[8]; x2.y += acc[9]; x2.z += acc[10]; x2.w += acc[11]; x3.x += acc[12]; x3.y += acc[13]; x3.z += acc[14]; x3.w += acc[15];
        if (a.final_norm) {
            float ss = x0.x * x0.x + x0.y * x0.y + x0.z * x0.z + x0.w * x0.w + x1.x * x1.x + x1.y * x1.y + x1.z * x1.z + x1.w * x1.w
                     + x2.x * x2.x + x2.y * x2.y + x2.z * x2.z + x2.w * x2.w + x3.x * x3.x + x3.y * x3.y + x3.z * x3.z + x3.w * x3.w;
            ss = wave_sum(ss, lane);
            const float rf = rsqrtf(ss * (1.f / 1024.f) + 1e-6f);
            const float* gf = a.gfinal + lane * 16;
            const float4 g0 = *(const float4*)gf, g1 = *(const float4*)(gf + 4), g2 = *(const float4*)(gf + 8), g3 = *(const float4*)(gf + 12);
            x0.x *= rf * g0.x; x0.y *= rf * g0.y; x0.z *= rf * g0.z; x0.w *= rf * g0.w; x1.x *= rf * g1.x; x1.y *= rf * g1.y; x1.z *= rf * g1.z; x1.w *= rf * g1.w;
            x2.x *= rf * g2.x; x2.y *= rf * g2.y; x2.z *= rf * g2.z; x2.w *= rf * g2.w; x3.x *= rf * g3.x; x3.y *= rf * g3.y; x3.z *= rf * g3.z; x3.w *= rf * g3.w;
        }
        *(float4*)xo = x0; *(float4*)(xo + 4) = x1; *(float4*)(xo + 8) = x2; *(float4*)(xo + 12) = x3;
    }
}
#define XB_TMO      128
#define XB_XCNT(j)  (256  + 64 * (j))
#define XB_XSUB(j)  (1280 + 64 * (j))
#define XB_XGEN(j)  (2304 + 64 * (j))
#define XB_TOP      3328
#define XB_TOPGEN   3392
#define XB_QUEUE(j) (3456 + 64 * (j))
#define XCD_BAR_WORDS (3456 + 64 * 64)
#define XB_SPIN_CAP (1u << 20)
#define LAS __attribute__((address_space(3)))

DI unsigned xb_ld(unsigned* p)              { return __hip_atomic_load(p, __ATOMIC_RELAXED, __HIP_MEMORY_SCOPE_AGENT); }
DI unsigned xb_add(unsigned* p, unsigned v) { return __hip_atomic_fetch_add(p, v, __ATOMIC_RELAXED, __HIP_MEMORY_SCOPE_AGENT); }
DI unsigned xb_xcc_id() { return (unsigned)__builtin_amdgcn_s_getreg((3 << 11) | 20) & 0xFu; }
#define XB_SPIN(cond, bar) do { unsigned _sp = 0; while (cond) { __builtin_amdgcn_s_sleep(1); \
    if ((++_sp & 255u) == 0u) { if (xb_ld(&(bar)[XB_TMO])) break; if (_sp > XB_SPIN_CAP) { atomicAdd(&(bar)[XB_TMO], 1u); break; } } } } while (0)

struct XcdBarrier { unsigned* bar; unsigned x; volatile LAS unsigned* st; };

DI XcdBarrier xcd_barrier_post(unsigned* bar, volatile LAS unsigned* st, int tid) {
    XcdBarrier b; b.bar = bar; b.x = xb_xcc_id(); b.st = st;
    if (tid == 0) st[2] = xb_add(&bar[XB_XCNT(b.x)], 1u);
    return b;
}
DI void xcd_barrier_complete(unsigned* bar, unsigned x, unsigned& nloc, unsigned& nx) {
    const unsigned G = gridDim.x * gridDim.y * gridDim.z;
    unsigned sum, cnt, mine, sp = 0u;
    for (;;) {
        sum = 0u; cnt = 0u; mine = 0u;
#pragma unroll
        for (unsigned j = 0; j < 16; ++j) { const unsigned c = xb_ld(&bar[XB_XCNT(j)]); sum += c; cnt += (c > 0u) ? 1u : 0u; mine = (j == x) ? c : mine; }
        if (sum == G) break;
        __builtin_amdgcn_s_sleep(1);
        if ((++sp & 255u) == 0u) { if (xb_ld(&bar[XB_TMO])) break; if (sp > XB_SPIN_CAP) { atomicAdd(&bar[XB_TMO], 1u); break; } }
    }
    nloc = mine > 0u ? mine : 1u; nx = cnt > 0u ? cnt : 1u;
}
DI void xcd_barrier(const XcdBarrier& b, int wid) {
    asm volatile("s_waitcnt vmcnt(0)" ::: "memory");
    __syncthreads();
    if (get_tid(wid) == 0) {
        unsigned* bar = b.bar;
        __builtin_amdgcn_s_waitcnt(0);
        unsigned nloc = b.st[0], nx = b.st[1];
        if (nloc == 0u) { xcd_barrier_complete(bar, b.x, nloc, nx); b.st[0] = nloc; b.st[1] = nx; }
        const unsigned old = xb_add(&bar[XB_XSUB(b.x)], 1u);
        const unsigned gen = old / nloc;
        if (old + 1u == (gen + 1u) * nloc) {
            __builtin_amdgcn_fence(__ATOMIC_RELEASE, "agent");
            asm volatile("s_waitcnt vmcnt(0)" ::: "memory");
            const unsigned og = xb_add(&bar[XB_TOP], 1u);
            const unsigned tg = og / nx;
            if (og + 1u == (tg + 1u) * nx) xb_add(&bar[XB_TOPGEN], 1u);
            else XB_SPIN(xb_ld(&bar[XB_TOPGEN]) == tg, bar);
            __builtin_amdgcn_fence(__ATOMIC_ACQUIRE, "agent");
            xb_add(&bar[XB_XGEN(b.x)], 1u);
            asm volatile("s_waitcnt vmcnt(0)" ::: "memory");
        } else {
            XB_SPIN(xb_ld(&bar[XB_XGEN(b.x)]) == gen, bar);
            __builtin_amdgcn_fence(__ATOMIC_ACQUIRE, "agent");
            asm volatile("s_waitcnt vmcnt(0)" ::: "memory");
        }
    }
    __syncthreads();
}
#ifndef U_FP4
#define U_FP4 1
#endif
#if U_FP4
#define NUSL 4
#else
#define NUSL 8
#endif
struct PSArgs {
    const bf16_t* Hb; const float* RSTD; const unsigned short* EX; const float* GT; const fp8_t* U8; const fp8_t* V8; const float* SU; const float* SV;
    float* PD; bf16_t* COEF; const float* Xin; float* Xout;
};

DI void dot4p(unsigned w, const f2_t& h01, const f2_t& h23, f2_t& s2) {
    const f2_t lo = __builtin_amdgcn_cvt_pk_f32_fp8(w, false), hi = __builtin_amdgcn_cvt_pk_f32_fp8(w, true);
    s2 = __builtin_elementwise_fma(lo, h01, s2); s2 = __builtin_elementwise_fma(hi, h23, s2);
}
DI float row_dot8p(const u32x4& r, const f2_t (&h)[8]) {
    f2_t s2 = {0.f, 0.f};
    dot4p(r.x, h[0], h[1], s2); dot4p(r.y, h[2], h[3], s2); dot4p(r.z, h[4], h[5], s2); dot4p(r.w, h[6], h[7], s2);
    return s2.x + s2.y;
}
DI void axpy4p(unsigned w, const f2_t& c2, f2_t& a01, f2_t& a23) {
    const f2_t lo = __builtin_amdgcn_cvt_pk_f32_fp8(w, false), hi = __builtin_amdgcn_cvt_pk_f32_fp8(w, true);
    a01 = __builtin_elementwise_fma(c2, lo, a01); a23 = __builtin_elementwise_fma(c2, hi, a23);
}
DI void row_axpy8p(f2_t (&acc)[8], const u32x4& r, float c) {
    const f2_t c2 = {c, c};
    axpy4p(r.x, c2, acc[0], acc[1]); axpy4p(r.y, c2, acc[2], acc[3]); axpy4p(r.z, c2, acc[4], acc[5]); axpy4p(r.w, c2, acc[6], acc[7]);
}

DI int run_token(int n, int k, int nloc, int wid) { return (k + (n >> 3) * nloc) * 64 + wid * 8 + (n & 7); }

struct Ids16 { u32x4 a, b; };
DI void ids_load(Ids16& q, const unsigned short* EX, int tok, int rg) { const u32x4* p = (const u32x4*)(EX + (size_t)tok * 128 + rg * 16); q.a = p[0]; q.b = p[1]; }
#define ID_LO(w) (((w) & 0xFFFFu) * 128u + loff)
#define ID_HI(w) (((w) >> 16) * 128u + loff)
DI void rows_lo(u32x4 (&r)[8], const Ids16& q, const fp8_t* tab, unsigned loff) {
    r[0] = *(grow_t)(tab + ID_LO(q.a.x)); r[1] = *(grow_t)(tab + ID_HI(q.a.x)); r[2] = *(grow_t)(tab + ID_LO(q.a.y)); r[3] = *(grow_t)(tab + ID_HI(q.a.y));
    r[4] = *(grow_t)(tab + ID_LO(q.a.z)); r[5] = *(grow_t)(tab + ID_HI(q.a.z)); r[6] = *(grow_t)(tab + ID_LO(q.a.w)); r[7] = *(grow_t)(tab + ID_HI(q.a.w));
}
DI void rows_hi(u32x4 (&r)[8], const Ids16& q, const fp8_t* tab, unsigned loff) {
    r[0] = *(grow_t)(tab + ID_LO(q.b.x)); r[1] = *(grow_t)(tab + ID_HI(q.b.x)); r[2] = *(grow_t)(tab + ID_LO(q.b.y)); r[3] = *(grow_t)(tab + ID_HI(q.b.y));
    r[4] = *(grow_t)(tab + ID_LO(q.b.z)); r[5] = *(grow_t)(tab + ID_HI(q.b.z)); r[6] = *(grow_t)(tab + ID_LO(q.b.w)); r[7] = *(grow_t)(tab + ID_HI(q.b.w));
}
DI void unpack_h(f2_t (&h)[8], const u32x4& h0, const u32x4& h1) {
    h[0] = (f2_t){bf_lo(h0.x), bf_hi(h0.x)}; h[1] = (f2_t){bf_lo(h0.y), bf_hi(h0.y)}; h[2] = (f2_t){bf_lo(h0.z), bf_hi(h0.z)}; h[3] = (f2_t){bf_lo(h0.w), bf_hi(h0.w)};
    h[4] = (f2_t){bf_lo(h1.x), bf_hi(h1.x)}; h[5] = (f2_t){bf_lo(h1.y), bf_hi(h1.y)}; h[6] = (f2_t){bf_lo(h1.z), bf_hi(h1.z)}; h[7] = (f2_t){bf_lo(h1.w), bf_hi(h1.w)};
}
DI void dots8(float* p, const u32x4 (&r)[8], const f2_t (&h)[8]) {
#pragma unroll
    for (int i = 0; i < 8; ++i) { p[i] = row_dot8p(r[i], h); if ((i & 1) == 1) __builtin_amdgcn_sched_barrier(0); }
}
DI void peerU_finish(const PSArgs& a, float (&p)[16], int tok, int s, int lane) {
    const int rg = lane >> 3, pc = lane & 7;
    const bool b2 = pc & 4, b1 = pc & 2, b0 = pc & 1;
    float q8[8], q4[4], q2[2];
#pragma unroll
    for (int k = 0; k < 8; ++k) { const float keep = b2 ? p[k + 8] : p[k], send = b2 ? p[k] : p[k + 8]; q8[k] = keep + shx<4>(send, lane); }
#pragma unroll
    for (int k = 0; k < 4; ++k) { const float keep = b1 ? q8[k + 4] : q8[k], send = b1 ? q8[k] : q8[k + 4]; q4[k] = keep + shx<2>(send, lane); }
#pragma unroll
    for (int k = 0; k < 2; ++k) { const float keep = b0 ? q4[k + 2] : q4[k], send = b0 ? q4[k] : q4[k + 2]; q2[k] = keep + shx<1>(send, lane); }
    *(float2*)(a.PD + ((size_t)s * NTOK + tok) * 128 + rg * 16 + 2 * pc) = make_float2(q2[0], q2[1]);
}

DI void peerU_run(const PSArgs& a, int s, int k, int nloc, int wid) {
    const int tid = get_tid(wid);
    const int lane = tid & 63, rg = lane >> 3, pc = lane & 7;
    const unsigned loff = (unsigned)(s * (NEXP * 128) + pc * 16);
    const int hoff = s * 128 + pc * 16;
    const int N = 8 * ((NTOK / 64 - k + nloc - 1) / nloc);
    Ids16 idE, idO;
    u32x4 rA[8], rB[8], hE0, hE1, hO0, hO1;
#define LOAD_H(d0, d1, tokv) { const u32x4* hp_ = (const u32x4*)(a.Hb + (size_t)(tokv) * DM + hoff); d0 = hp_[0]; d1 = hp_[1]; }
    ids_load(idE, a.EX, run_token(0, k, nloc, wid), rg);
    ids_load(idO, a.EX, run_token(1, k, nloc, wid), rg);
    rows_lo(rA, idE, a.U8, loff); LOAD_H(hE0, hE1, run_token(0, k, nloc, wid)); rows_hi(rB, idE, a.U8, loff);
#pragma unroll 1
    for (int n = 0; n < N; n += 2) {
        const int t0 = run_token(n, k, nloc, wid), t1 = run_token(n + 1, k, nloc, wid);
        const int t2 = run_token((n + 2 < N) ? n + 2 : N - 1, k, nloc, wid), t3 = run_token((n + 3 < N) ? n + 3 : N - 1, k, nloc, wid);
        {
            f2_t h[8]; float p[16];
            unpack_h(h, hE0, hE1);
            dots8(p, rA, h);
            rows_lo(rA, idO, a.U8, loff); LOAD_H(hO0, hO1, t1);
            dots8(p + 8, rB, h);
            rows_hi(rB, idO, a.U8, loff);
            ids_load(idE, a.EX, t2, rg);
            peerU_finish(a, p, t0, s, lane);
        }
        {
            f2_t h[8]; float p[16];
            unpack_h(h, hO0, hO1);
            dots8(p, rA, h);
            rows_lo(rA, idE, a.U8, loff); LOAD_H(hE0, hE1, t2);
            dots8(p + 8, rB, h);
            rows_hi(rB, idE, a.U8, loff);
            ids_load(idO, a.EX, t3, rg);
            peerU_finish(a, p, t1, s, lane);
        }
    }
#undef LOAD_H
}

DI void peerR_tile(const PSArgs& a, int tile, int wid) {
    const int tid = get_tid(wid);
    const int lane = tid & 63;
#pragma unroll 1
    for (int ti = 0; ti < 8; ++ti) {
        const int tok = tile * 64 + wid * 8 + ti;
        float d0 = 0.f, d1 = 0.f;
#pragma unroll
        for (int x = 0; x < NUSL; ++x) { const float2 v = *(const float2*)(a.PD + ((size_t)x * NTOK + tok) * 128 + 2 * lane); d0 += v.x; d1 += v.y; }
        const unsigned exw = *(const unsigned*)(a.EX + (size_t)tok * 128 + 2 * lane);
        const int2 ex = make_int2((int)(exw & 0xFFFFu), (int)(exw >> 16));
        const float2 gt = *(const float2*)(a.GT + (size_t)tok * 128 + 2 * lane);
        const float rs = a.RSTD[tok];
        float2 o;
        o.x = gelu_exact(d0 * a.SU[ex.x] * rs) * gt.x * a.SV[ex.x];
        o.y = gelu_exact(d1 * a.SU[ex.y] * rs) * gt.y * a.SV[ex.y];
        *(unsigned*)(a.COEF + (size_t)tok * 128 + 2 * lane) = pack_bf2(o.x, o.y);
    }
}

struct Cf16 { u32x4 a, b; };
DI void cf_load(Cf16& q, const bf16_t* COEF, int tok, int rg) { const u32x4* p = (const u32x4*)(COEF + (size_t)tok * 128 + rg * 16); q.a = p[0]; q.b = p[1]; }
DI void axpy8(f2_t (&acc)[8], const u32x4 (&r)[8], const u32x4& c) {
    row_axpy8p(acc, r[0], bf_lo(c.x)); row_axpy8p(acc, r[1], bf_hi(c.x)); __builtin_amdgcn_sched_barrier(0);
    row_axpy8p(acc, r[2], bf_lo(c.y)); row_axpy8p(acc, r[3], bf_hi(c.y)); __builtin_amdgcn_sched_barrier(0);
    row_axpy8p(acc, r[4], bf_lo(c.z)); row_axpy8p(acc, r[5], bf_hi(c.z)); __builtin_amdgcn_sched_barrier(0);
    row_axpy8p(acc, r[6], bf_lo(c.w)); row_axpy8p(acc, r[7], bf_hi(c.w)); __builtin_amdgcn_sched_barrier(0);
}
DI void peerV_finish(const PSArgs& a, f2_t (&acc)[8], float2 xv, int tok, int s, int lane) {
    const int rg = lane >> 3, pc = lane & 7;
    const bool r2 = rg & 4, r1 = rg & 2, r0 = rg & 1;
    f2_t q4[4], q2[2], q1;
#pragma unroll
    for (int k = 0; k < 4; ++k) {
        const f2_t keep = r2 ? acc[k + 4] : acc[k], send = r2 ? acc[k] : acc[k + 4];
        q4[k] = (f2_t){keep.x + shx<32>(send.x, lane), keep.y + shx<32>(send.y, lane)};
    }
#pragma unroll
    for (int k = 0; k < 2; ++k) {
        const f2_t keep = r1 ? q4[k + 2] : q4[k], send = r1 ? q4[k] : q4[k + 2];
        q2[k] = (f2_t){keep.x + shx<16>(send.x, lane), keep.y + shx<16>(send.y, lane)};
    }
    {
        const f2_t keep = r0 ? q2[1] : q2[0], send = r0 ? q2[0] : q2[1];
        q1 = (f2_t){keep.x + shx<8>(send.x, lane), keep.y + shx<8>(send.y, lane)};
    }
    xv.x += q1.x; xv.y += q1.y;
    *(float2*)(a.Xout + (size_t)tok * DM + s * 128 + 16 * pc + 2 * rg) = xv;
}

DI void peerV_run(const PSArgs& a, int s, int k, int nloc, int wid) {
    const int tid = get_tid(wid);
    const int lane = tid & 63, rg = lane >> 3, pc = lane & 7;
    const unsigned loff = (unsigned)(s * (NEXP * 128) + pc * 16);
    const int N = 8 * ((NTOK / 64 - k + nloc - 1) / nloc);
    Ids16 idE, idO; Cf16 cfE, cfO; float2 xE, xO;
    u32x4 rA[8], rB[8];
#define LOAD_X(x_, tokv) { x_ = *(const float2*)(a.Xin + (size_t)(tokv) * DM + s * 128 + 16 * pc + 2 * rg); }
    ids_load(idE, a.EX, run_token(0, k, nloc, wid), rg);
    ids_load(idO, a.EX, run_token(1, k, nloc, wid), rg);
    rows_lo(rA, idE, a.V8, loff); cf_load(cfE, a.COEF, run_token(0, k, nloc, wid), rg); rows_hi(rB, idE, a.V8, loff); LOAD_X(xE, run_token(0, k, nloc, wid));
#pragma unroll 1
    for (int n = 0; n < N; n += 2) {
        const int t0 = run_token(n, k, nloc, wid), t1 = run_token(n + 1, k, nloc, wid);
        const int t2 = run_token((n + 2 < N) ? n + 2 : N - 1, k, nloc, wid), t3 = run_token((n + 3 < N) ? n + 3 : N - 1, k, nloc, wid);
        {
            f2_t acc[8];
#pragma unroll
            for (int i = 0; i < 8; ++i) acc[i] = (f2_t){0.f, 0.f};
            axpy8(acc, rA, cfE.a);
            rows_lo(rA, idO, a.V8, loff); cf_load(cfO, a.COEF, t1, rg);
            axpy8(acc, rB, cfE.b);
            rows_hi(rB, idO, a.V8, loff); LOAD_X(xO, t1);
            ids_load(idE, a.EX, t2, rg);
            peerV_finish(a, acc, xE, t0, s, lane);
        }
        {
            f2_t acc[8];
#pragma unroll
            for (int i = 0; i < 8; ++i) acc[i] = (f2_t){0.f, 0.f};
            axpy8(acc, rA, cfO.a);
            rows_lo(rA, idE, a.V8, loff); cf_load(cfE, a.COEF, t2, rg);
            axpy8(acc, rB, cfO.b);
            rows_hi(rB, idE, a.V8, loff); LOAD_X(xE, t2);
            ids_load(idO, a.EX, t3, rg);
            peerV_finish(a, acc, xO, t1, s, lane);
        }
    }
#undef LOAD_X
}

DI void final_norm_tile(float* X, const float* __restrict__ g, int tile, int wid) {
    const int tid = get_tid(wid);
    const int lane = tid & 63;
    const float* gf = g + lane * 16;
    const float4 g0 = *(const float4*)gf, g1 = *(const float4*)(gf + 4), g2 = *(const float4*)(gf + 8), g3 = *(const float4*)(gf + 12);
#pragma unroll 1
    for (int ti = 0; ti < 8; ++ti) {
        float* xp = X + (size_t)(tile * 64 + wid * 8 + ti) * DM + lane * 16;
        float4 x0 = *(const float4*)xp, x1 = *(const float4*)(xp + 4), x2 = *(const float4*)(xp + 8), x3 = *(const float4*)(xp + 12);
        float ss = x0.x * x0.x + x0.y * x0.y + x0.z * x0.z + x0.w * x0.w + x1.x * x1.x + x1.y * x1.y + x1.z * x1.z + x1.w * x1.w
                 + x2.x * x2.x + x2.y * x2.y + x2.z * x2.z + x2.w * x2.w + x3.x * x3.x + x3.y * x3.y + x3.z * x3.z + x3.w * x3.w;
        ss = wave_sum(ss, lane);
        const float rf = rsqrtf(ss * (1.f / 1024.f) + 1e-6f);
        x0.x *= rf * g0.x; x0.y *= rf * g0.y; x0.z *= rf * g0.z; x0.w *= rf * g0.w; x1.x *= rf * g1.x; x1.y *= rf * g1.y; x1.z *= rf * g1.z; x1.w *= rf * g1.w;
        x2.x *= rf * g2.x; x2.y *= rf * g2.y; x2.z *= rf * g2.z; x2.w *= rf * g2.w; x3.x *= rf * g3.x; x3.y *= rf * g3.y; x3.z *= rf * g3.z; x3.w *= rf * g3.w;
        *(float4*)xp = x0; *(float4*)(xp + 4) = x1; *(float4*)(xp + 8) = x2; *(float4*)(xp + 12) = x3;
    }
}

typedef unsigned char fp4x2_t;
DI void conv_row_fp4_one(float4 v0, float4 v1, float4 v2, float4 v3, fp4x2_t* __restrict__ dst, float* __restrict__ scales, int nrows, int row, int lane) {
    float m = fmaxf(fmaxf(fmaxf(fabsf(v0.x), fabsf(v0.y)), fmaxf(fabsf(v0.z), fabsf(v0.w))), fmaxf(fmaxf(fabsf(v1.x), fabsf(v1.y)), fmaxf(fabsf(v1.z), fabsf(v1.w))));
    m = fmaxf(m, fmaxf(fmaxf(fmaxf(fabsf(v2.x), fabsf(v2.y)), fmaxf(fabsf(v2.z), fabsf(v2.w))), fmaxf(fmaxf(fabsf(v3.x), fabsf(v3.y)), fmaxf(fabsf(v3.z), fabsf(v3.w)))));
    m = fmaxf(m, shx<1>(m, lane)); m = fmaxf(m, shx<2>(m, lane)); m = fmaxf(m, shx<4>(m, lane)); m = fmaxf(m, shx<8>(m, lane)); m = fmaxf(m, shx<16>(m, lane)); m = fmaxf(m, shx<32>(m, lane));
    const float sc = (m > 0.f) ? m * (1.f / 6.f) : 1.f;
    const float inv = 1.f / sc;
    unsigned d0 = 0u, d1 = 0u;
    d0 = __builtin_amdgcn_cvt_scalef32_pk_fp4_f32(d0, v0.x * inv, v0.y * inv, 1.0f, 0); d0 = __builtin_amdgcn_cvt_scalef32_pk_fp4_f32(d0, v0.z * inv, v0.w * inv, 1.0f, 1);
    d0 = __builtin_amdgcn_cvt_scalef32_pk_fp4_f32(d0, v1.x * inv, v1.y * inv, 1.0f, 2); d0 = __builtin_amdgcn_cvt_scalef32_pk_fp4_f32(d0, v1.z * inv, v1.w * inv, 1.0f, 3);
    d1 = __builtin_amdgcn_cvt_scalef32_pk_fp4_f32(d1, v2.x * inv, v2.y * inv, 1.0f, 0); d1 = __builtin_amdgcn_cvt_scalef32_pk_fp4_f32(d1, v2.z * inv, v2.w * inv, 1.0f, 1);
    d1 = __builtin_amdgcn_cvt_scalef32_pk_fp4_f32(d1, v3.x * inv, v3.y * inv, 1.0f, 2); d1 = __builtin_amdgcn_cvt_scalef32_pk_fp4_f32(d1, v3.z * inv, v3.w * inv, 1.0f, 3);
    *(uint2*)(dst + ((size_t)(lane >> 4) * nrows + row) * 128 + (lane & 15) * 8) = make_uint2(d0, d1);
    if (lane == 0) scales[row] = sc;
}
DI void conv_rows_fp4(const float* __restrict__ src, fp4x2_t* __restrict__ dst, float* __restrict__ scales, int nrows, int gwave, int nwaves, int lane) {
#pragma unroll 1
    for (int row = gwave; row < nrows; row += 2 * nwaves) {
        const int r1 = min(row + nwaves, nrows - 1);
        const float4* p0 = (const float4*)(src + (size_t)row * DM + lane * 16);
        const float4* p1 = (const float4*)(src + (size_t)r1 * DM + lane * 16);
        const float4 a0 = p0[0], a1 = p0[1], a2 = p0[2], a3 = p0[3];
        const float4 b0 = p1[0], b1 = p1[1], b2 = p1[2], b3 = p1[3];
        conv_row_fp4_one(a0, a1, a2, a3, dst, scales, nrows, row, lane);
        conv_row_fp4_one(b0, b1, b2, b3, dst, scales, nrows, r1, lane);
    }
}

typedef __attribute__((ext_vector_type(2))) _Float16 h2_t;
DI h2_t cvt4(unsigned w, int b) {
    return b == 0 ? __builtin_amdgcn_cvt_scalef32_pk_f16_fp4(w, 1.0f, 0) : b == 1 ? __builtin_amdgcn_cvt_scalef32_pk_f16_fp4(w, 1.0f, 1)
         : b == 2 ? __builtin_amdgcn_cvt_scalef32_pk_f16_fp4(w, 1.0f, 2) : __builtin_amdgcn_cvt_scalef32_pk_f16_fp4(w, 1.0f, 3);
}
DI void row_axpy32h(h2_t (&acc)[16], const u32x4& r, float c) {
    const _Float16 ch = (_Float16)c; const h2_t c2 = {ch, ch};
#pragma unroll
    for (int b = 0; b < 4; ++b) {
        acc[b] = __builtin_elementwise_fma(c2, cvt4(r.x, b), acc[b]); acc[4 + b] = __builtin_elementwise_fma(c2, cvt4(r.y, b), acc[4 + b]);
        acc[8 + b] = __builtin_elementwise_fma(c2, cvt4(r.z, b), acc[8 + b]); acc[12 + b] = __builtin_elementwise_fma(c2, cvt4(r.w, b), acc[12 + b]);
    }
}
DI void axpy8_4(h2_t (&acc)[16], const u32x4 (&r)[8], const u32x4& c) {
    row_axpy32h(acc, r[0], bf_lo(c.x)); row_axpy32h(acc, r[1], bf_hi(c.x)); row_axpy32h(acc, r[2], bf_lo(c.y)); row_axpy32h(acc, r[3], bf_hi(c.y));
    __builtin_amdgcn_sched_barrier(0);
    row_axpy32h(acc, r[4], bf_lo(c.z)); row_axpy32h(acc, r[5], bf_hi(c.z)); row_axpy32h(acc, r[6], bf_lo(c.w)); row_axpy32h(acc, r[7], bf_hi(c.w));
    __builtin_amdgcn_sched_barrier(0);
}
typedef __attribute__((ext_vector_type(2))) unsigned u32x2_t;
DI h2_t pairsum32(h2_t x, h2_t y) { auto r = __builtin_amdgcn_permlane32_swap(__builtin_bit_cast(unsigned, x), __builtin_bit_cast(unsigned, y), false, false);
                                   return __builtin_bit_cast(h2_t, (unsigned)r[0]) + __builtin_bit_cast(h2_t, (unsigned)r[1]); }
DI h2_t pairsum16(h2_t x, h2_t y) { auto r = __builtin_amdgcn_permlane16_swap(__builtin_bit_cast(unsigned, x), __builtin_bit_cast(unsigned, y), false, false);
                                   return __builtin_bit_cast(h2_t, (unsigned)r[0]) + __builtin_bit_cast(h2_t, (unsigned)r[1]); }
DI h2_t pairsum8(h2_t x, h2_t y, bool hi) {
    const h2_t keep = hi ? y : x, send = hi ? x : y;
    const int rcv = __builtin_amdgcn_update_dpp(0, __builtin_bit_cast(int, send), 0x128, 0xF, 0xF, true);
    return keep + __builtin_bit_cast(h2_t, rcv);
}
DI void peerV4_finish(const PSArgs& a, h2_t (&acc)[16], float4 xv, int tok, int s4, int lane) {
    const int rg = lane >> 3, pc = lane & 7;
    h2_t q8[8], q4[4], q2[2];
#ifndef FINV
#define FINV 7
#endif
    const bool r2 = rg & 4, r1 = rg & 2, r0 = rg & 1;
#pragma unroll
    for (int k = 0; k < 8; ++k) {
        if (FINV & 1) q8[k] = pairsum32(acc[k], acc[k + 8]);
        else { const h2_t keep = r2 ? acc[k + 8] : acc[k], send = r2 ? acc[k] : acc[k + 8]; q8[k] = keep + __builtin_bit_cast(h2_t, shx_i<32>(__builtin_bit_cast(int, send), lane)); }
    }
#pragma unroll
    for (int k = 0; k < 4; ++k) {
        if (FINV & 2) q4[k] = pairsum16(q8[k], q8[k + 4]);
        else { const h2_t keep = r1 ? q8[k + 4] : q8[k], send = r1 ? q8[k] : q8[k + 4]; q4[k] = keep + __builtin_bit_cast(h2_t, shx_i<16>(__builtin_bit_cast(int, send), lane)); }
    }
#pragma unroll
    for (int k = 0; k < 2; ++k) {
        if (FINV & 4) q2[k] = pairsum8(q4[k], q4[k + 2], r0);
        else { const h2_t keep = r0 ? q4[k + 2] : q4[k], send = r0 ? q4[k] : q4[k + 2]; q2[k] = keep + __builtin_bit_cast(h2_t, shx_i<8>(__builtin_bit_cast(int, send), lane)); }
    }
    xv.x += (float)q2[0].x; xv.y += (float)q2[0].y; xv.z += (float)q2[1].x; xv.w += (float)q2[1].y;
    *(float4*)(a.Xout + (size_t)tok * DM + s4 * 256 + 32 * pc + 4 * rg) = xv;
}
DI int run_token2(int n, int k, int nloc, int wid, int th) { return (2 * (k + (n >> 3) * nloc) + th) * 64 + wid * 8 + (n & 7); }

DI void peerV4_run(const PSArgs& a, const fp4x2_t* V4, int s4, int th, int k, int nloc, int wid) {
    const int tid = get_tid(wid);
    const int lane = tid & 63, rg = lane >> 3, pc = lane & 7;
    const unsigned loff = (unsigned)(s4 * (NEXP * 128) + pc * 16);
    const int N = 8 * ((NTOK / 128 - k + nloc - 1) / nloc);
    if (N <= 0) return;
    Ids16 idE, idO; Cf16 cfE, cfO; float4 xE, xO;
    u32x4 rA[8], rB[8];
    const fp8_t* tab = (const fp8_t*)V4;
#define LOAD_X4(x_, tokv) { x_ = *(const float4*)(a.Xin + (size_t)(tokv) * DM + s4 * 256 + 32 * pc + 4 * rg); }
    ids_load(idE, a.EX, run_token2(0, k, nloc, wid, th), rg);
    ids_load(idO, a.EX, run_token2(1, k, nloc, wid, th), rg);
    rows_lo(rA, idE, tab, loff); cf_load(cfE, a.COEF, run_token2(0, k, nloc, wid, th), rg); rows_hi(rB, idE, tab, loff); LOAD_X4(xE, run_token2(0, k, nloc, wid, th));
#pragma unroll 1
    for (int n = 0; n < N; n += 2) {
        const int t0 = run_token2(n, k, nloc, wid, th), t1 = run_token2(n + 1, k, nloc, wid, th);
        const int t2 = run_token2((n + 2 < N) ? n + 2 : N - 1, k, nloc, wid, th), t3 = run_token2((n + 3 < N) ? n + 3 : N - 1, k, nloc, wid, th);
        {
            h2_t acc[16];
#pragma unroll
            for (int i = 0; i < 16; ++i) acc[i] = (h2_t){(_Float16)0.f, (_Float16)0.f};
            axpy8_4(acc, rA, cfE.a);
            rows_lo(rA, idO, tab, loff); cf_load(cfO, a.COEF, t1, rg);
            axpy8_4(acc, rB, cfE.b);
            rows_hi(rB, idO, tab, loff); LOAD_X4(xO, t1);
            ids_load(idE, a.EX, t2, rg);
            peerV4_finish(a, acc, xE, t0, s4, lane);
        }
        {
            h2_t acc[16];
#pragma unroll
            for (int i = 0; i < 16; ++i) acc[i] = (h2_t){(_Float16)0.f, (_Float16)0.f};
            axpy8_4(acc, rA, cfO.a);
            rows_lo(rA, idE, tab, loff); cf_load(cfE, a.COEF, t2, rg);
            axpy8_4(acc, rB, cfO.b);
            rows_hi(rB, idE, tab, loff); LOAD_X4(xE, t2);
            ids_load(idO, a.EX, t3, rg);
            peerV4_finish(a, acc, xO, t1, s4, lane);
        }
    }
#undef LOAD_X4
}

DI void conv_rows_fp4g(const float* __restrict__ src, const float* __restrict__ gain, fp4x2_t* __restrict__ dst, float* __restrict__ scales,
                       int nrows, int gwave, int nwaves, int lane) {
    const float4* g = (const float4*)(gain + lane * 16);
    const float4 g0 = g[0], g1 = g[1], g2 = g[2], g3 = g[3];
#pragma unroll 1
    for (int row = gwave; row < nrows; row += 2 * nwaves) {
        const int r1 = min(row + nwaves, nrows - 1);
        const float4* p0 = (const float4*)(src + (size_t)row * DM + lane * 16);
        const float4* p1 = (const float4*)(src + (size_t)r1 * DM + lane * 16);
        float4 a0 = p0[0], a1 = p0[1], a2 = p0[2], a3 = p0[3];
        float4 b0 = p1[0], b1 = p1[1], b2 = p1[2], b3 = p1[3];
        a0.x *= g0.x; a0.y *= g0.y; a0.z *= g0.z; a0.w *= g0.w; a1.x *= g1.x; a1.y *= g1.y; a1.z *= g1.z; a1.w *= g1.w;
        a2.x *= g2.x; a2.y *= g2.y; a2.z *= g2.z; a2.w *= g2.w; a3.x *= g3.x; a3.y *= g3.y; a3.z *= g3.z; a3.w *= g3.w;
        b0.x *= g0.x; b0.y *= g0.y; b0.z *= g0.z; b0.w *= g0.w; b1.x *= g1.x; b1.y *= g1.y; b1.z *= g1.z; b1.w *= g1.w;
        b2.x *= g2.x; b2.y *= g2.y; b2.z *= g2.z; b2.w *= g2.w; b3.x *= g3.x; b3.y *= g3.y; b3.z *= g3.z; b3.w *= g3.w;
        conv_row_fp4_one(a0, a1, a2, a3, dst, scales, nrows, row, lane);
        conv_row_fp4_one(b0, b1, b2, b3, dst, scales, nrows, r1, lane);
    }
}
DI float row_dot32h(const u32x4& r, const h2_t (&h)[16]) {
    float s0 = 0.f, s1 = 0.f;
#pragma unroll
    for (int b = 0; b < 4; ++b) {
        s0 = __builtin_amdgcn_fdot2(cvt4(r.x, b), h[b], s0, false); s1 = __builtin_amdgcn_fdot2(cvt4(r.y, b), h[4 + b], s1, false);
        s0 = __builtin_amdgcn_fdot2(cvt4(r.z, b), h[8 + b], s0, false); s1 = __builtin_amdgcn_fdot2(cvt4(r.w, b), h[12 + b], s1, false);
    }
    return s0 + s1;
}
DI void dots8_4(float* p, const u32x4 (&r)[8], const h2_t (&h)[16]) {
#pragma unroll
    for (int i = 0; i < 8; ++i) { p[i] = row_dot32h(r[i], h); if ((i & 3) == 3) __builtin_amdgcn_sched_barrier(0); }
}
struct H32 { u32x4 a, b, c, d; };
DI void h32_load(H32& q, const bf16_t* Hb, int tok, int hoff) { const u32x4* p = (const u32x4*)(Hb + (size_t)tok * DM + hoff); q.a = p[0]; q.b = p[1]; q.c = p[2]; q.d = p[3]; }
DI h2_t bf2_to_h2(unsigned u) { return __builtin_bit_cast(h2_t, __builtin_amdgcn_cvt_pkrtz(bf_lo(u), bf_hi(u))); }
DI void h32_unpack(h2_t (&h)[16], const H32& q) {
    h[0] = bf2_to_h2(q.a.x); h[1] = bf2_to_h2(q.a.y); h[2] = bf2_to_h2(q.a.z); h[3] = bf2_to_h2(q.a.w);
    h[4] = bf2_to_h2(q.b.x); h[5] = bf2_to_h2(q.b.y); h[6] = bf2_to_h2(q.b.z); h[7] = bf2_to_h2(q.b.w);
    h[8] = bf2_to_h2(q.c.x); h[9] = bf2_to_h2(q.c.y); h[10] = bf2_to_h2(q.c.z); h[11] = bf2_to_h2(q.c.w);
    h[12] = bf2_to_h2(q.d.x); h[13] = bf2_to_h2(q.d.y); h[14] = bf2_to_h2(q.d.z); h[15] = bf2_to_h2(q.d.w);
}
DI void peerU4_run(const PSArgs& a, const fp4x2_t* U4, int s4, int th, int k, int nloc, int wid) {
    const int tid = get_tid(wid);
    const int lane = tid & 63, rg = lane >> 3, pc = lane & 7;
    const unsigned loff = (unsigned)(s4 * (NEXP * 128) + pc * 16);
    const int hoff = s4 * 256 + pc * 32;
    const int N = 8 * ((NTOK / 128 - k + nloc - 1) / nloc);
    if (N <= 0) return;
    Ids16 idE, idO; H32 hE, hO;
    u32x4 rA[8], rB[8];
    const fp8_t* tab = (const fp8_t*)U4;
    ids_load(idE, a.EX, run_token2(0, k, nloc, wid, th), rg);
    ids_load(idO, a.EX, run_token2(1, k, nloc, wid, th), rg);
    rows_lo(rA, idE, tab, loff); h32_load(hE, a.Hb, run_token2(0, k, nloc, wid, th), hoff); rows_hi(rB, idE, tab, loff);
#pragma unroll 1
    for (int n = 0; n < N; n += 2) {
        const int t0 = run_token2(n, k, nloc, wid, th), t1 = run_token2(n + 1, k, nloc, wid, th);
        const int t2 = run_token2((n + 2 < N) ? n + 2 : N - 1, k, nloc, wid, th), t3 = run_token2((n + 3 < N) ? n + 3 : N - 1, k, nloc, wid, th);
        {
            h2_t h[16]; float p[16];
            h32_unpack(h, hE);
            dots8_4(p, rA, h);
            rows_lo(rA, idO, tab, loff); h32_load(hO, a.Hb, t1, hoff);
            dots8_4(p + 8, rB, h);
            rows_hi(rB, idO, tab, loff);
            ids_load(idE, a.EX, t2, rg);
            peerU_finish(a, p, t0, s4, lane);
        }
        {
            h2_t h[16]; float p[16];
            h32_unpack(h, hO);
            dots8_4(p, rA, h);
            rows_lo(rA, idE, tab, loff); h32_load(hE, a.Hb, t2, hoff);
            dots8_4(p + 8, rB, h);
            rows_hi(rB, idE, tab, loff);
            ids_load(idO, a.EX, t3, rg);
            peerU_finish(a, p, t1, s4, lane);
        }
    }
}

#ifndef U_INT4
#define U_INT4 1
#endif
DI unsigned pack_i4x8(const float (&v)[8], float inv) {
    unsigned r = 0u;
#pragma unroll
    for (int i = 0; i < 4; ++i) {
        const int a = (int)fminf(fmaxf(rintf(v[i] * inv), -7.f), 7.f), b = (int)fminf(fmaxf(rintf(v[4 + i] * inv), -7.f), 7.f);
        r |= ((unsigned)a & 15u) << (8 * i); r |= ((unsigned)b & 15u) << (8 * i + 4);
    }
    return r;
}
DI void conv_rows_int4g(const float* __restrict__ src, const float* __restrict__ gain, fp4x2_t* __restrict__ dst, float* __restrict__ scales,
                        int nrows, int gwave, int nwaves, int lane) {
    const float4* g = (const float4*)(gain + lane * 16);
    const float4 g0 = g[0], g1 = g[1], g2 = g[2], g3 = g[3];
#pragma unroll 1
    for (int row = gwave; row < nrows; row += nwaves) {
        const float4* p0 = (const float4*)(src + (size_t)row * DM + lane * 16);
        const float4 a0 = p0[0], a1 = p0[1], a2 = p0[2], a3 = p0[3];
        const float v0[8] = {a0.x * g0.x, a0.y * g0.y, a0.z * g0.z, a0.w * g0.w, a1.x * g1.x, a1.y * g1.y, a1.z * g1.z, a1.w * g1.w};
        const float v1[8] = {a2.x * g2.x, a2.y * g2.y, a2.z * g2.z, a2.w * g2.w, a3.x * g3.x, a3.y * g3.y, a3.z * g3.z, a3.w * g3.w};
        float ss = 0.f;
#pragma unroll
        for (int i = 0; i < 8; ++i) ss += v0[i] * v0[i] + v1[i] * v1[i];
        ss = wave_sum(ss, lane);
        const float rms = sqrtf(ss * (1.f / 1024.f));
        const float step = (rms > 0.f) ? 0.36f * rms : 1.f, inv = 1.f / step;
        *(uint2*)(dst + ((size_t)(lane >> 4) * nrows + row) * 128 + (lane & 15) * 8) = make_uint2(pack_i4x8(v0, inv), pack_i4x8(v1, inv));
        if (lane == 0) scales[row] = step;
    }
}
DI float h_planes(int (&H)[4], int (&L)[4], const H32& q, int lane) {
    float f[32];
    const unsigned w[16] = {q.a.x, q.a.y, q.a.z, q.a.w, q.b.x, q.b.y, q.b.z, q.b.w, q.c.x, q.c.y, q.c.z, q.c.w, q.d.x, q.d.y, q.d.z, q.d.w};
    float m = 0.f;
#pragma unroll
    for (int i = 0; i < 16; ++i) { f[2 * i] = bf_lo(w[i]); f[2 * i + 1] = bf_hi(w[i]); m = fmaxf(m, fmaxf(fabsf(f[2 * i]), fabsf(f[2 * i + 1]))); }
    m = fmaxf(m, __int_as_float(__builtin_amdgcn_update_dpp(0, __float_as_int(m), 0xB1, 0xF, 0xF, true)));
    m = fmaxf(m, __int_as_float(__builtin_amdgcn_update_dpp(0, __float_as_int(m), 0x4E, 0xF, 0xF, true)));
    m = fmaxf(m, __int_as_float(__builtin_amdgcn_update_dpp(0, __float_as_int(m), 0x141, 0xF, 0xF, true)));
    const float sh = (m > 0.f) ? m * (1.f / 119.f) : 1.f, inv = 1.f / sh;
#pragma unroll
    for (int d = 0; d < 4; ++d) {
        unsigned A = 0u, B = 0u;
#pragma unroll
        for (int i = 0; i < 4; ++i) {
            A = __builtin_amdgcn_cvt_pk_u8_f32(rintf(f[8 * d + i] * inv) + 136.f, i, A);
            B = __builtin_amdgcn_cvt_pk_u8_f32(rintf(f[8 * d + 4 + i] * inv) + 136.f, i, B);
        }
        L[d] = (int)(((A & 0x0F0F0F0Fu) | ((B & 0x0F0F0F0Fu) << 4)) ^ 0x88888888u);
        H[d] = (int)((((A >> 4) & 0x0F0F0F0Fu) | (B & 0xF0F0F0F0u)) ^ 0x88888888u);
    }
    return sh;
}
DI float row_dot32i(const u32x4& r, const int (&H)[4], const int (&L)[4]) {
    int ah = 0, al = 0;
    ah = __builtin_amdgcn_sdot8((int)r.x, H[0], ah, false); al = __builtin_amdgcn_sdot8((int)r.x, L[0], al, false);
    ah = __builtin_amdgcn_sdot8((int)r.y, H[1], ah, false); al = __builtin_amdgcn_sdot8((int)r.y, L[1], al, false);
    ah = __builtin_amdgcn_sdot8((int)r.z, H[2], ah, false); al = __builtin_amdgcn_sdot8((int)r.z, L[2], al, false);
    ah = __builtin_amdgcn_sdot8((int)r.w, H[3], ah, false); al = __builtin_amdgcn_sdot8((int)r.w, L[3], al, false);
    return (float)(ah * 16 + al);
}
DI void peerUi_run(const PSArgs& a, const fp4x2_t* U4, int s4, int th, int k, int nloc, int wid) {
    const int tid = get_tid(wid);
    const int lane = tid & 63, rg = lane >> 3, pc = lane & 7;
    const unsigned loff = (unsigned)(s4 * (NEXP * 128) + pc * 16);
    const int hoff = s4 * 256 + pc * 32;
    const int N = 8 * ((NTOK / 128 - k + nloc - 1) / nloc);
    if (N <= 0) return;
    Ids16 idE, idO; H32 hE, hO;
    u32x4 rA[8], rB[8];
    const fp8_t* tab = (const fp8_t*)U4;
    ids_load(idE, a.EX, run_token2(0, k, nloc, wid, th), rg);
    ids_load(idO, a.EX, run_token2(1, k, nloc, wid, th), rg);
    rows_lo(rA, idE, tab, loff); h32_load(hE, a.Hb, run_token2(0, k, nloc, wid, th), hoff); rows_hi(rB, idE, tab, loff);
#pragma unroll 1
    for (int n = 0; n < N; n += 2) {
        const int t0 = run_token2(n, k, nloc, wid, th), t1 = run_token2(n + 1, k, nloc, wid, th);
        const int t2 = run_token2((n + 2 < N) ? n + 2 : N - 1, k, nloc, wid, th), t3 = run_token2((n + 3 < N) ? n + 3 : N - 1, k, nloc, wid, th);
        {
            int H[4], L[4]; float p[16];
            const float sh = h_planes(H, L, hE, lane);
#pragma unroll
            for (int i = 0; i < 8; ++i) p[i] = row_dot32i(rA[i], H, L) * sh;
            rows_lo(rA, idO, tab, loff); h32_load(hO, a.Hb, t1, hoff);
#pragma unroll
            for (int i = 0; i < 8; ++i) p[8 + i] = row_dot32i(rB[i], H, L) * sh;
            rows_hi(rB, idO, tab, loff);
            ids_load(idE, a.EX, t2, rg);
            peerU_finish(a, p, t0, s4, lane);
        }
        {
            int H[4], L[4]; float p[16];
            const float sh = h_planes(H, L, hO, lane);
#pragma unroll
            for (int i = 0; i < 8; ++i) p[i] = row_dot32i(rA[i], H, L) * sh;
            rows_lo(rA, idE, tab, loff); h32_load(hE, a.Hb, t2, hoff);
#pragma unroll
            for (int i = 0; i < 8; ++i) p[8 + i] = row_dot32i(rB[i], H, L) * sh;
            rows_hi(rB, idE, tab, loff);
            ids_load(idO, a.EX, t3, rg);
            peerU_finish(a, p, t1, s4, lane);
        }
    }
}
struct MegaArgs {
    const float* x; const float* a_re; const float* a_im; const float* log_dt; const float* b_re; const float* b_im; const float* c_re;
    const float* c_im; const float* d_skip; const float* b_glu; const float* pool_scale; const float* u_exp; const float* v_exp;
    const float* norm_final;
    PrepW pw;
    float* X; bf16_t* U; bf16_t* YPRE; bf16_t* G1; bf16_t* A2; bf16_t* Hb; bf16_t* Qb; unsigned short* EX; float* GT; float* RSTD;
    char* KT; bf16x8* WST; bf16x8* CCAR; float* ABT; fp8_t* U8; fp4x2_t* U4; fp4x2_t* V4; float* SU; float* SV; float* PD; bf16_t* COEF;
    unsigned* bar;
    int coop_probe; int pad_;
};

#ifndef REP_P0
#define REP_P0 1
#endif
#ifndef REP_PA
#define REP_PA 1
#endif
#ifndef REP_PB
#define REP_PB 1
#endif
#ifndef REP_C1
#define REP_C1 1
#endif
#ifndef REP_C2
#define REP_C2 1
#endif
#ifndef REP_U
#define REP_U 1
#endif
#ifndef REP_R
#define REP_R 1
#endif
#ifndef REP_V
#define REP_V 1
#endif
#ifndef REP_BAR
#define REP_BAR 1
#endif
#define XBAR() do { for (int rb_ = 0; rb_ < REP_BAR; ++rb_) xcd_barrier(xb, wid); } while (0)
__global__ void __launch_bounds__(NTHR) mega_kernel(MegaArgs a) {
    __shared__ __attribute__((aligned(16))) char smem[PB_BYTES];
    __shared__ uint4 xb_words;
    cg::grid_group grid = cg::this_grid();
    const int nblk = gridDim.x;
    const int wid = __builtin_amdgcn_readfirstlane(threadIdx.x >> 6);
    if (get_tid(wid) == 0) xb_words = make_uint4(0u, 0u, 0u, 0u);
    __syncthreads();
    const XcdBarrier xb = xcd_barrier_post(a.bar, (volatile LAS unsigned*)&xb_words, get_tid(wid));
    for (int rep = 0; rep < REP_P0; ++rep) {
        const size_t gtid = (size_t)blockIdx.x * NTHR + get_tid(wid), gs = (size_t)nblk * NTHR;
        for (int it = blockIdx.x; it < 256; it += nblk)
            prep_s5_item(it >> 2, it & 3, a.a_re, a.a_im, a.log_dt, a.b_re, a.b_im, a.c_re, a.c_im, a.d_skip, a.KT, a.WST, a.CCAR, a.ABT, smem, wid);
        prep_weights(a.pw, gtid, gs);
        for (int l = 0; l < 2; ++l) {
            conv_kfrag(a.pw.k1 + (size_t)l * 128 * 128, a.pw.wfk1 + (size_t)l * (128 * 128 / 8), gtid, gs);
            conv_kfrag(a.pw.k2 + (size_t)l * 128 * 128, a.pw.wfk2 + (size_t)l * (128 * 128 / 8), gtid, gs);
        }
        {
            int tid = get_tid(wid);
            const int gwave = blockIdx.x * 8 + (tid >> 6), nwaves = nblk * 8, lane = tid & 63;
#pragma unroll 1
            for (int l = 0; l < 2; ++l) {
#if U_INT4
                conv_rows_int4g(a.u_exp + (size_t)l * NEXP * DM, a.pw.norm_ffn + l * DM, a.U4 + (size_t)l * NEXP * (DM / 2), a.SU + l * NEXP, NEXP, gwave, nwaves, lane);
#elif U_FP4
                conv_rows_fp4g(a.u_exp + (size_t)l * NEXP * DM, a.pw.norm_ffn + l * DM, a.U4 + (size_t)l * NEXP * (DM / 2), a.SU + l * NEXP, NEXP, gwave, nwaves, lane);
#else
                conv_rows_fp8(a.u_exp + (size_t)l * NEXP * DM, a.pw.norm_ffn + l * DM, a.U8 + (size_t)l * NEXP * DM, a.SU + l * NEXP, NEXP, gwave, nwaves, lane);
#endif
                conv_rows_fp4(a.v_exp + (size_t)l * NEXP * DM, a.V4 + (size_t)l * NEXP * (DM / 2), a.SV + l * NEXP, NEXP, gwave, nwaves, lane);
            }
        }
    }
    XBAR();
    if (a.coop_probe) grid.sync();
    __shared__ int sched[4];
    if (get_tid(wid) == 0) {
        int nx = 0, myj = 0, nloc = 1;
        for (unsigned j = 0; j < 16; ++j) {
            const unsigned cj = xb_ld(&a.bar[XB_XCNT(j)]);
            if (j == xb.x) { myj = nx; nloc = (int)cj; }
            nx += (cj > 0u) ? 1 : 0;
        }
        sched[0] = (int)xb.st[2]; sched[1] = nloc > 0 ? nloc : 1; sched[2] = myj; sched[3] = nx > 0 ? nx : 1;
    }
    __syncthreads();
    const int s_rank = sched[0], s_nloc = sched[1], s_myj = sched[2], s_nx = sched[3];
#pragma unroll 1
    for (int l = 0; l < 2; ++l) {
        const float* xin = (l == 0) ? a.x : a.X;
        if (l == 0) {
            for (int rep = 0; rep < REP_PA; ++rep)
            for (int tile = blockIdx.x; tile < NTOK / 64; tile += nblk) phaseA_tile(xin, a.pw.wfin, a.U, tile, smem, wid);
        }
        XBAR();
        bf16_t* Ul = a.U + (size_t)l * NTOK * DM;
        for (int rep = 0; rep < REP_PB; ++rep)
        for (int tile = blockIdx.x; tile < 256; tile += nblk)
            phaseB_tile(Ul, a.KT + (size_t)l * 32 * KT_BYTES, a.WST + (size_t)l * 32 * WST_FRAGS, a.CCAR + (size_t)l * 32 * CCAR_FRAGS, a.ABT + l * 32 * 128, a.YPRE, tile, smem, wid);
        XBAR();
        PCArgs pa; pa.U = Ul; pa.YPRE = a.YPRE; pa.G1 = a.G1; pa.A2 = a.A2; pa.Xin = xin; pa.Xout = a.X; pa.Xdummy = (float*)a.Qb; pa.Hb = a.Hb; pa.RSTD = a.RSTD;
        pa.wfglu = a.pw.wfglu + (size_t)l * (512 * 512 / 8); pa.b_glu = a.b_glu + l * 512; pa.wfpool = a.pw.wfpool + (size_t)l * 4 * (128 * 128 / 8);
        pa.pool_scale = a.pool_scale + l * 512; pa.wfout = a.pw.wfout + (size_t)l * (DM * DM / 8);
        PRArgs pr; pr.Hb = a.Hb; pr.RSTD = a.RSTD; pr.wfq = a.pw.wfq + (size_t)l * (DM * 2048 / 8); pr.kf1 = a.pw.wfk1 + (size_t)l * (128 * 128 / 8);
        pr.kf2 = a.pw.wfk2 + (size_t)l * (128 * 128 / 8); pr.EX = a.EX; pr.GT = a.GT;
        for (int tile = blockIdx.x; tile < NTOK / 64; tile += nblk) {
            for (int rep = 1; rep < REP_C1; ++rep) { PCArgs pa2 = pa; pa2.Xout = (float*)a.Qb; phaseC1_tile(pa2, tile, smem, wid); }
            phaseC1_tile(pa, tile, smem, wid);
            for (int rep = 0; rep < REP_C2; ++rep) phaseC2_tile(pr, tile, smem, wid);
        }
        XBAR();
        PSArgs ps; ps.Hb = a.Hb; ps.RSTD = a.RSTD; ps.EX = a.EX; ps.GT = a.GT; ps.U8 = a.U8 + (size_t)l * NEXP * DM; ps.V8 = nullptr;
        ps.SU = a.SU + l * NEXP; ps.SV = a.SV + l * NEXP; ps.PD = a.PD; ps.COEF = a.COEF; ps.Xin = a.X; ps.Xout = a.X;
        for (int rep = 0; rep < REP_U; ++rep) {
#if U_INT4
            for (int v = s_myj; v < 8; v += s_nx) peerUi_run(ps, a.U4 + (size_t)l * NEXP * (DM / 2), v & 3, v >> 2, s_rank, s_nloc, wid);
#elif U_FP4
            for (int v = s_myj; v < 8; v += s_nx) peerU4_run(ps, a.U4 + (size_t)l * NEXP * (DM / 2), v & 3, v >> 2, s_rank, s_nloc, wid);
#else
            for (int s = s_myj; s < 8; s += s_nx) peerU_run(ps, s, s_rank, s_nloc, wid);
#endif
        }
        XBAR();
        for (int rep = 0; rep < REP_R; ++rep)
        for (int tile = blockIdx.x; tile < NTOK / 64; tile += nblk) peerR_tile(ps, tile, wid);
        XBAR();
        for (int rep = 1; rep < REP_V; ++rep) { PSArgs ps2 = ps; ps2.Xout = (float*)a.Qb; for (int v = s_myj; v < 8; v += s_nx) peerV4_run(ps2, a.V4 + (size_t)l * NEXP * (DM / 2), v & 3, v >> 2, s_rank, s_nloc, wid); }
        for (int v = s_myj; v < 8; v += s_nx) peerV4_run(ps, a.V4 + (size_t)l * NEXP * (DM / 2), v & 3, v >> 2, s_rank, s_nloc, wid);
        XBAR();
        if (l == 0) {
            for (int rep = 0; rep < REP_PA; ++rep)
            for (int tile = blockIdx.x; tile < NTOK / 64; tile += nblk) phaseA_tile(a.X, a.pw.wfin + (size_t)(DM * DM / 8), a.U + (size_t)NTOK * DM, tile, smem, wid);
        } else {
            for (int tile = blockIdx.x; tile < NTOK / 64; tile += nblk) final_norm_tile(a.X, a.norm_final, tile, wid);
        }
    }
}

extern "C" void kernel_launch(void* const* d_in, const int* in_sizes, int n_in, void* d_out, int out_size, void* d_ws, size_t ws_size,
                              hipStream_t stream) {
    char* wsb = (char*)d_ws;
    size_t off = 0;
    auto take = [&](size_t bytes) { char* p = wsb + off; off += (bytes + 255) & ~(size_t)255; return p; };
    MegaArgs a;
    memset(&a, 0, sizeof(a));
    a.x = (const float*)d_in[0];
    a.pw.norm_mix = (const float*)d_in[1]; a.pw.w_in = (const float*)d_in[2];
    a.a_re = (const float*)d_in[3]; a.a_im = (const float*)d_in[4]; a.log_dt = (const float*)d_in[5];
    a.b_re = (const float*)d_in[6]; a.b_im = (const float*)d_in[7]; a.c_re = (const float*)d_in[8]; a.c_im = (const float*)d_in[9];
    a.d_skip = (const float*)d_in[10]; a.pw.w_glu = (const float*)d_in[11]; a.b_glu = (const float*)d_in[12];
    a.pw.w_pool = (const float*)d_in[13]; a.pool_scale = (const float*)d_in[14]; a.pw.g_out_ssm = (const float*)d_in[15];
    a.pw.g_out_pool = (const float*)d_in[16]; a.pw.w_out = (const float*)d_in[17]; a.pw.norm_ffn = (const float*)d_in[18];
    a.pw.w_q = (const float*)d_in[19]; a.pw.k1 = (const float*)d_in[20]; a.pw.k2 = (const float*)d_in[21];
    a.u_exp = (const float*)d_in[22]; a.v_exp = (const float*)d_in[23]; a.norm_final = (const float*)d_in[24];
    a.X = (float*)d_out;
    a.U = (bf16_t*)take((size_t)2 * NTOK * DM * 2);
    a.YPRE = (bf16_t*)take((size_t)NTOK * 512 * 2);
    a.G1 = (bf16_t*)take((size_t)NTOK * 512 * 2);
    a.A2 = (bf16_t*)take((size_t)NTOK * DM * 2);
    a.Hb = (bf16_t*)take((size_t)NTOK * DM * 2);
    a.Qb = (bf16_t*)take((size_t)NTOK * 2048 * 2);
    a.EX = (unsigned short*)take((size_t)NTOK * 128 * 2);
    a.GT = (float*)take((size_t)NTOK * 128 * 4);
    a.RSTD = (float*)take(NTOK * 4);
    a.pw.wfin = (bf16x8*)take((size_t)2 * DM * DM * 2);
    a.pw.wfglu = (bf16x8*)take((size_t)2 * 512 * 512 * 2);
    a.pw.wfpool = (bf16x8*)take((size_t)2 * 4 * 128 * 128 * 2);
    a.pw.wfout = (bf16x8*)take((size_t)2 * DM * DM * 2);
    a.pw.wfq = (bf16x8*)take((size_t)2 * DM * 2048 * 2);
    a.pw.wfk1 = (bf16x8*)take((size_t)2 * 128 * 128 * 2);
    a.pw.wfk2 = (bf16x8*)take((size_t)2 * 128 * 128 * 2);
    a.KT = take((size_t)64 * KT_BYTES);
    a.WST = (bf16x8*)take((size_t)64 * WST_FRAGS * 16);
    a.CCAR = (bf16x8*)take((size_t)64 * CCAR_FRAGS * 16);
    a.ABT = (float*)take(64 * 128 * 4);
    a.U8 = (fp8_t*)take((size_t)2 * NEXP * DM);
    a.V4 = (fp4x2_t*)take((size_t)2 * NEXP * (DM / 2));
    a.U4 = (fp4x2_t*)take((size_t)2 * NEXP * (DM / 2));
    a.SU = (float*)take((size_t)2 * NEXP * 4);
    a.SV = (float*)take((size_t)2 * NEXP * 4);
    a.PD = (float*)take((size_t)8 * NTOK * 128 * 4);
    a.COEF = (bf16_t*)take((size_t)NTOK * 128 * 2);
    a.bar = (unsigned*)take((size_t)XCD_BAR_WORDS * 4);
    hipMemsetAsync(a.bar, 0, (size_t)XCD_BAR_WORDS * 4, stream);

    static int grid_blocks = 0;
    if (!grid_blocks) {
        int dev = 0, cus = 0, per_cu = 0;
        hipGetDevice(&dev);
        hipDeviceGetAttribute(&cus, hipDeviceAttributeMultiprocessorCount, dev);
        hipOccupancyMaxActiveBlocksPerMultiprocessor(&per_cu, mega_kernel, NTHR, 0);
        if (per_cu > 1) per_cu = 1;
        grid_blocks = cus * per_cu;
        if (grid_blocks > 256) grid_blocks = 256;
    }
    void* args[] = {&a};
    hipError_t e = hipLaunchCooperativeKernel((void*)mega_kernel, dim3(grid_blocks), dim3(NTHR), args, 0, stream);
    if (e != hipSuccess) fprintf(stderr, "cooperative launch failed: %s (grid %d)\n", hipGetErrorString(e), grid_blocks);
}
```

```cpp
#include <hip/hip_runtime.h>
#include <hip/hip_cooperative_groups.h>
#include <cstdio>
#include <cstring>
namespace cg = cooperative_groups;
#include <math.h>
#include <stdint.h>

#define NTOK 16384
#define SEQ 2048
#define DM 1024
#define SSMW 512
#define NEXP 16384

__device__ __forceinline__ float gelu_exact(float x) { return 0.5f * x * (1.f + erff(x * 0.70710678118654752f)); }

template <int M> __device__ __forceinline__ int shx_i(int v, int lane) {
    if constexpr (M == 1) return __builtin_amdgcn_mov_dpp(v, 0xB1, 0xF, 0xF, true);
    else if constexpr (M == 2) return __builtin_amdgcn_mov_dpp(v, 0x4E, 0xF, 0xF, true);
    else if constexpr (M < 32) return __builtin_amdgcn_ds_swizzle(v, (M << 10) | 0x1F);
    else return __builtin_amdgcn_ds_bpermute((lane ^ 32) << 2, v);
}
template <int M> __device__ __forceinline__ float shx(float v, int lane) { return __int_as_float(shx_i<M>(__float_as_int(v), lane)); }
__device__ __forceinline__ float wave_sum(float v, int lane) {
    v += shx<1>(v, lane); v += shx<2>(v, lane); v += shx<4>(v, lane); v += shx<8>(v, lane); v += shx<16>(v, lane); v += shx<32>(v, lane);
    return v;
}

__device__ __forceinline__ int get_tid(int wid) {
    int t = wid * 64 + (int)__builtin_amdgcn_mbcnt_hi(~0u, __builtin_amdgcn_mbcnt_lo(~0u, 0u));
    asm volatile("" : "+v"(t));
    return t;
}

#define DI __device__ __forceinline__
typedef __attribute__((ext_vector_type(8))) short bf16x8;
typedef __attribute__((ext_vector_type(16))) float f32x16;
typedef __attribute__((ext_vector_type(2))) __bf16 bf2_t;
typedef __attribute__((ext_vector_type(2))) float f2_t;
typedef unsigned short bf16_t;
typedef __attribute__((ext_vector_type(4))) unsigned u32x4;
typedef __attribute__((ext_vector_type(4))) float f32x4;
typedef const __attribute__((address_space(1))) bf16x8* gwp_t;
#define MFMA32(a, b, c) __builtin_amdgcn_mfma_f32_32x32x16_bf16((a), (b), (c), 0, 0, 0)

DI unsigned pack_bf2(float a, float b) { f2_t v = {a, b}; return __builtin_bit_cast(unsigned, __builtin_convertvector(v, bf2_t)); }
DI float bf_lo(unsigned u) { return __uint_as_float(u << 16); }
DI float bf_hi(unsigned u) { return __uint_as_float(u & 0xffff0000u); }
DI int crow(int reg, int h) { return (reg & 3) + 8 * (reg >> 2) + 4 * h; }

#define SA_STRIDE 272
#define SA_BYTES (64 * SA_STRIDE)
#define NTHR 512

template <bool GAIN>
DI void conv_wfrag(const float* __restrict__ src, int ldk, int ldn, const float* __restrict__ ga, const float* __restrict__ gb, int split,
                   int K, int N, int NTG, bf16x8* __restrict__ dst, size_t gtid, size_t gstride) {
    const int KS = K / 16;
    const size_t total = (size_t)(N / 32) * KS * 64;
    for (size_t item = gtid; item < total; item += gstride) {
        const int lane = (int)(item & 63); const size_t f = item >> 6;
        const int nti = (int)(f % NTG); const size_t f2 = f / NTG;
        const int ks = (int)(f2 % KS), nt = (int)(f2 / KS) * NTG + nti;
        const int r = lane & 31, h = lane >> 5;
        const int n = nt * 32 + r, k0 = ks * 16 + 8 * h;
        float v[8];
#pragma unroll
        for (int j = 0; j < 8; ++j) {
            const int k = k0 + j;
            float g = 1.f;
            if (GAIN) g = (k < split) ? ga[k] : gb[k - split];
            v[j] = src[(size_t)k * ldk + (size_t)n * ldn] * g;
        }
        uint4 o; o.x = pack_bf2(v[0], v[1]); o.y = pack_bf2(v[2], v[3]); o.z = pack_bf2(v[4], v[5]); o.w = pack_bf2(v[6], v[7]);
        *(uint4*)(dst + item) = o;
    }
}

DI void conv_rows_bf16(const float* __restrict__ src, const float* __restrict__ gain, bf16_t* __restrict__ dst, size_t nelem, size_t gtid, size_t gstride) {
    for (size_t i = gtid * 8; i < nelem; i += gstride * 8) {
        float4 a = *(const float4*)(src + i), b = *(const float4*)(src + i + 4);
        if (gain) {
            const int c = (int)(i & 1023);
            float4 g0 = *(const float4*)(gain + c), g1 = *(const float4*)(gain + c + 4);
            a.x *= g0.x; a.y *= g0.y; a.z *= g0.z; a.w *= g0.w; b.x *= g1.x; b.y *= g1.y; b.z *= g1.z; b.w *= g1.w;
        }
        uint4 o; o.x = pack_bf2(a.x, a.y); o.y = pack_bf2(a.z, a.w); o.z = pack_bf2(b.x, b.y); o.w = pack_bf2(b.z, b.w);
        *(uint4*)(dst + i) = o;
    }
}

struct ALoadF32 {
    const float* base; f32x4 v0, v1, v2, v3; float ss; int dofs;
    DI void init(const float* rowbase, int tid) { base = rowbase + (tid & 7) * 16; ss = 0.f; dofs = (tid >> 3) * SA_STRIDE + (tid & 7) * 32; }
    DI void issue(int c) { const f32x4* p = (const f32x4*)(base + c * 128); v0 = p[0]; v1 = p[1]; v2 = p[2]; v3 = p[3]; }
    DI void commit(char* buf) {
        u32x4 o0, o1;
        ss += v0.x * v0.x + v0.y * v0.y + v0.z * v0.z + v0.w * v0.w + v1.x * v1.x + v1.y * v1.y + v1.z * v1.z + v1.w * v1.w
            + v2.x * v2.x + v2.y * v2.y + v2.z * v2.z + v2.w * v2.w + v3.x * v3.x + v3.y * v3.y + v3.z * v3.z + v3.w * v3.w;
        o0.x = pack_bf2(v0.x, v0.y); o0.y = pack_bf2(v0.z, v0.w); o0.z = pack_bf2(v1.x, v1.y); o0.w = pack_bf2(v1.z, v1.w);
        o1.x = pack_bf2(v2.x, v2.y); o1.y = pack_bf2(v2.z, v2.w); o1.z = pack_bf2(v3.x, v3.y); o1.w = pack_bf2(v3.z, v3.w);
        char* d = buf + dofs;
        *(u32x4*)d = o0; *(u32x4*)(d + 16) = o1;
    }
};
struct ALoadBF16 {
    const bf16_t* base; u32x4 v0, v1; int dofs;
    DI void init(const bf16_t* rowbase, int tid) { base = rowbase + (tid & 7) * 16; dofs = (tid >> 3) * SA_STRIDE + (tid & 7) * 32; }
    DI void issue(int c) { const u32x4* p = (const u32x4*)(base + c * 128); v0 = p[0]; v1 = p[1]; }
    DI void commit(char* buf) {
        char* d = buf + dofs;
        *(u32x4*)d = v0; *(u32x4*)(d + 16) = v1;
    }
};

template <int NT, int PF, class AL>
DI void gemm64(f32x16 (&acc)[NT][2], AL& al, const int nchunks, const bf16x8* __restrict__ wf_, char* sA, const int lane) {
    gwp_t wf = (gwp_t)wf_;
    const int r = lane & 31, h = lane >> 5;
    bf16x8 bq[PF][NT];
    al.issue(0);
#pragma unroll
    for (int p = 0; p < PF; ++p)
#pragma unroll
        for (int nt = 0; nt < NT; ++nt) bq[p][nt] = wf[(p * NT + nt) * 64];
    gwp_t wpf = wf + PF * NT * 64;
    al.commit(sA);
    const int kend = nchunks * 8 - PF;
    int kg = 0;
#pragma unroll 1
    for (int c = 0; c < nchunks; ++c) {
        if (c + 1 < nchunks) al.issue(c + 1);
        __syncthreads();
        const char* buf = sA + (c & 1) * SA_BYTES + r * SA_STRIDE + h * 16;
#pragma unroll
        for (int ks = 0; ks < 8; ++ks) {
            const bf16x8 a0 = *(const bf16x8*)(buf + ks * 32);
            const bf16x8 a1 = *(const bf16x8*)(buf + 32 * SA_STRIDE + ks * 32);
#pragma unroll
            for (int nt = 0; nt < NT; ++nt) {
                acc[nt][0] = MFMA32(bq[ks % PF][nt], a0, acc[nt][0]);
                acc[nt][1] = MFMA32(bq[ks % PF][nt], a1, acc[nt][1]);
            }
            if (kg < kend) {
#pragma unroll
                for (int nt = 0; nt < NT; ++nt) bq[ks % PF][nt] = wpf[nt * 64];
            }
            wpf += NT * 64; ++kg;
            asm volatile("" : "+v"(wpf));
        }
        if (c + 1 < nchunks) al.commit(sA + ((c + 1) & 1) * SA_BYTES);
    }
    __syncthreads();
}

template <int NT>
DI void zero_acc(f32x16 (&acc)[NT][2]) {
#pragma unroll
    for (int nt = 0; nt < NT; ++nt)
#pragma unroll
        for (int mt = 0; mt < 2; ++mt)
#pragma unroll
            for (int i = 0; i < 16; ++i) acc[nt][mt][i] = 0.f;
}


DI void tile_transpose(const f32x16& t, float* wscr, int lane, f32x4 (&out)[4]) {
    const int r = lane & 31, h = lane >> 5;
#pragma unroll
    for (int q = 0; q < 4; ++q) { f32x4 v = {t[4 * q], t[4 * q + 1], t[4 * q + 2], t[4 * q + 3]}; *(f32x4*)(wscr + r * 36 + 8 * q + 4 * h) = v; }
#pragma unroll
    for (int j = 0; j < 4; ++j) out[j] = *(const f32x4*)(wscr + ((lane >> 3) + 8 * j) * 36 + (lane & 7) * 4);
}
#define WSCR_BYTES (32 * 36 * 4)

DI void phaseA_tile(const float* __restrict__ X, const bf16x8* __restrict__ wfin, bf16_t* __restrict__ U, int tile, char* smem, int wid) {
    char* sA = smem; float* srstd = (float*)(smem + 8 * WSCR_BYTES);
    int tok0 = tile * 64; asm volatile("" : "+s"(tok0));
    int tid = get_tid(wid);
    const int w = __builtin_amdgcn_readfirstlane(tid >> 6), lane = tid & 63, r = lane & 31, h = lane >> 5;
    ALoadF32 al; al.init(X + (size_t)(tok0 + (tid >> 3)) * DM, tid);
    f32x16 acc[4][2]; zero_acc<4>(acc);
    gemm64<4, 2>(acc, al, 8, wfin + (size_t)w * (64 * 4 * 64) + lane, sA, lane);
    float ss = al.ss;
    ss += shx<1>(ss, lane); ss += shx<2>(ss, lane); ss += shx<4>(ss, lane);
    if ((tid & 7) == 0) srstd[tid >> 3] = rsqrtf(ss * (1.f / 1024.f) + 1e-6f);
    __syncthreads();
    {
        float* wscr = (float*)(smem + w * WSCR_BYTES);
        const int tl = lane >> 3, cl = (lane & 7) * 4;
#pragma unroll
        for (int mt = 0; mt < 2; ++mt) {
            float rs[4];
#pragma unroll
            for (int j = 0; j < 4; ++j) rs[j] = srstd[mt * 32 + tl + 8 * j];
#pragma unroll
            for (int nt = 0; nt < 4; ++nt) {
                f32x4 o[4]; tile_transpose(acc[nt][mt], wscr, lane, o);
#pragma unroll
                for (int j = 0; j < 4; ++j) {
                    uint2 p; p.x = pack_bf2(o[j].x * rs[j], o[j].y * rs[j]); p.y = pack_bf2(o[j].z * rs[j], o[j].w * rs[j]);
                    *(uint2*)(U + (size_t)(tok0 + mt * 32 + tl + 8 * j) * DM + w * 128 + nt * 32 + cl) = p;
                }
            }
        }
    }
    __syncthreads();
}

struct PrepW {
    const float* norm_mix; const float* w_in; const float* w_glu; const float* w_pool; const float* g_out_ssm; const float* g_out_pool;
    const float* w_out; const float* norm_ffn; const float* w_q; const float* k1; const float* k2;
    bf16x8* wfin; bf16x8* wfglu; bf16x8* wfpool; bf16x8* wfout; bf16x8* wfq; bf16x8* wfk1; bf16x8* wfk2;
};
DI void prep_weights(const PrepW& p, size_t gtid, size_t gs) {
#pragma unroll 1
    for (int l = 0; l < 2; ++l) {
        conv_wfrag<true>(p.w_in + (size_t)l * DM * DM, DM, 1, p.norm_mix + l * DM, p.norm_mix + l * DM, DM, DM, DM, 4, p.wfin + (size_t)l * (DM * DM / 8), gtid, gs);
        conv_wfrag<false>(p.w_glu + (size_t)l * 512 * 512, 512, 1, p.norm_mix, p.norm_mix, 512, 512, 512, 2, p.wfglu + (size_t)l * (512 * 512 / 8), gtid, gs);
#pragma unroll 1
        for (int gi = 0; gi < 4; ++gi)
            conv_wfrag<false>(p.w_pool + (size_t)(l * 4 + gi) * 128 * 128, 128, 1, p.norm_mix, p.norm_mix, 128, 128, 128, 2, p.wfpool + (size_t)(l * 4 + gi) * (128 * 128 / 8), gtid, gs);
        conv_wfrag<true>(p.w_out + (size_t)l * DM * DM, DM, 1, p.g_out_ssm + l * 512, p.g_out_pool + l * 512, 512, DM, DM, 4, p.wfout + (size_t)l * (DM * DM / 8), gtid, gs);
        conv_wfrag<true>(p.w_q + (size_t)l * DM * 2048, 2048, 1, p.norm_ffn + l * DM, p.norm_ffn + l * DM, DM, DM, 2048, 4, p.wfq + (size_t)l * (DM * 2048 / 8), gtid, gs);
    }
}
#define KT_BLK 528
#define KT_BYTES (65 * KT_BLK)
#define WST_FRAGS (4 * 64 * 64)
#define CCAR_FRAGS (32 * 8 * 64)
#define SU_CH 2064

DI void prep_s5_item(int lg, int part, const float* __restrict__ a_re, const float* __restrict__ a_im, const float* __restrict__ log_dt,
                     const float* __restrict__ b_re, const float* __restrict__ b_im, const float* __restrict__ c_re, const float* __restrict__ c_im,
                     const float* __restrict__ d_skip, char* __restrict__ KT, bf16x8* __restrict__ WST, bf16x8* __restrict__ CCAR,
                     float* __restrict__ ABT, char* smem, int wid) {
    float* powr = (float*)smem;
    float* powi = powr + 65 * 64;
    float* bzr = powi + 65 * 64;
    float* bzi = bzr + 1024;
    float* cr = bzi + 1024;
    float* ci = cr + 1024;
    int tid = get_tid(wid);
    const float* are_p = a_re + lg * 64; const float* aim_p = a_im + lg * 64;
    const float dt = expf(log_dt[lg]);
    for (int it = tid; it < 65 * 64; it += NTHR) {
        const int tau = it >> 6, p = it & 63;
        const float lre = are_p[p], lim = aim_p[p];
        const float mag = expf((float)tau * lre * dt);
        double rev = (double)lim * (double)dt * (double)tau * 0.15915494309189535;
        rev -= floor(rev);
        const float ang = (float)rev * 6.283185307179586f;
        powr[it] = mag * cosf(ang); powi[it] = mag * sinf(ang);
    }
    for (int it = tid; it < 1024; it += NTHR) {
        cr[it] = c_re[lg * 1024 + it]; ci[it] = c_im[lg * 1024 + it];
    }
    __syncthreads();
    for (int it = tid; it < 1024; it += NTHR) {
        const int p = it >> 4;
        const float lre = are_p[p], lim = aim_p[p];
        const float ar = powr[64 + p], ai = powi[64 + p];
        const float inv = 1.f / (lre * lre + lim * lim), nre = ar - 1.f;
        const float zre = (nre * lre + ai * lim) * inv, zim = (ai * lre - nre * lim) * inv;
        const float br = b_re[lg * 1024 + it], bi = b_im[lg * 1024 + it];
        bzr[it] = zre * br - zim * bi; bzi[it] = zre * bi + zim * br;
    }
    __syncthreads();
    if (part == 0 && tid < 64) { ABT[lg * 128 + 2 * tid] = powr[64 * 64 + tid]; ABT[lg * 128 + 2 * tid + 1] = powi[64 * 64 + tid]; }
    char* kt = KT + (size_t)lg * KT_BYTES;
    if (part == 0) for (int it = tid; it < KT_BLK / 4; it += NTHR) ((unsigned*)kt)[it] = 0u;
    for (int it = part * (16 * 128) + tid; it < (part + 1) * (16 * 128); it += NTHR) {
        const int tau = it >> 7, ho = (it >> 3) & 15, hi = (it & 7) * 2;
        float s0 = 0.f, s1 = 0.f;
        for (int p = 0; p < 64; ++p) {
            const float c_r = cr[ho * 64 + p], c_i = ci[ho * 64 + p], pr = powr[tau * 64 + p], pi = powi[tau * 64 + p];
            const float cpr = c_r * pr - c_i * pi, cpi = c_r * pi + c_i * pr;
            s0 += cpr * bzr[p * 16 + hi] - cpi * bzi[p * 16 + hi];
            s1 += cpr * bzr[p * 16 + hi + 1] - cpi * bzi[p * 16 + hi + 1];
        }
        if (tau == 0) { if (ho == hi) s0 += d_skip[lg * 16 + ho]; if (ho == hi + 1) s1 += d_skip[lg * 16 + ho]; }
        *(unsigned*)(kt + (tau + 1) * KT_BLK + ho * 32 + hi * 2) = pack_bf2(s0, s1);
    }
    if (part == 0) for (int it = tid; it < 65 * 4; it += NTHR) ((unsigned*)(kt + (it >> 2) * KT_BLK + 512))[it & 3] = 0u;
    bf16x8* wst = WST + (size_t)lg * WST_FRAGS;
    for (int it = part * (WST_FRAGS / 4) + tid; it < (part + 1) * (WST_FRAGS / 4); it += NTHR) {
        const int lane = it & 63, j = (it >> 6) & 63, nt = it >> 12;
        const int r = lane & 31, h = lane >> 5, n = nt * 32 + r, p = n & 63, im = n >> 6;
        const float pr = powr[(63 - j) * 64 + p], pi = powi[(63 - j) * 64 + p];
        float v[8];
#pragma unroll
        for (int jj = 0; jj < 8; ++jj) {
            const float zr = bzr[p * 16 + 8 * h + jj], zi = bzi[p * 16 + 8 * h + jj];
            v[jj] = im ? (pr * zi + pi * zr) : (pr * zr - pi * zi);
        }
        uint4 o; o.x = pack_bf2(v[0], v[1]); o.y = pack_bf2(v[2], v[3]); o.z = pack_bf2(v[4], v[5]); o.w = pack_bf2(v[6], v[7]);
        *(uint4*)(wst + it) = o;
    }
    bf16x8* cc = CCAR + (size_t)lg * CCAR_FRAGS;
    for (int it = part * (CCAR_FRAGS / 4) + tid; it < (part + 1) * (CCAR_FRAGS / 4); it += NTHR) {
        const int lane = it & 63, ks = (it >> 6) & 7, mt = it >> 9;
        const int r = lane & 31, h = lane >> 5, m = mt * 32 + r, i = m >> 4, ho = m & 15;
        float v[8];
#pragma unroll
        for (int jj = 0; jj < 8; ++jj) {
            const int k = ks * 16 + 8 * h + jj, p = k & 63, im = k >> 6;
            const float c_r = cr[ho * 64 + p], c_i = ci[ho * 64 + p], pr = powr[(i + 1) * 64 + p], pi = powi[(i + 1) * 64 + p];
            v[jj] = im ? -(c_r * pi + c_i * pr) : (c_r * pr - c_i * pi);
        }
        uint4 o; o.x = pack_bf2(v[0], v[1]); o.y = pack_bf2(v[2], v[3]); o.z = pack_bf2(v[4], v[5]); o.w = pack_bf2(v[6], v[7]);
        *(uint4*)(cc + it) = o;
    }
    __syncthreads();
}

#define PB_SU 0
#define PB_SKT (32 * SU_CH)
#define PB_SL (PB_SKT + KT_BYTES)
#define PB_SPART (PB_SL + 32 * 132 * 4)
#define PB_SSP (PB_SPART + 4 * 4096)
#define PB_BYTES (PB_SSP + 32 * 272)

DI void phaseB_tile(const bf16_t* __restrict__ U, const char* __restrict__ KT, const bf16x8* __restrict__ WST, const bf16x8* __restrict__ CCAR,
                    const float* __restrict__ ABT, bf16_t* __restrict__ YPRE, int tile, char* smem, int wid) {
    const int gp = tile & 31, b = tile >> 5;
    const int g = ((gp & 7) << 2) | (gp >> 3);
    int tid = get_tid(wid);
    const int w = __builtin_amdgcn_readfirstlane(tid >> 6), lane = tid & 63, r = lane & 31, h = lane >> 5;
    char* sU = smem + PB_SU; char* sKT = smem + PB_SKT; float* sL = (float*)(smem + PB_SL); float* sPart = (float*)(smem + PB_SPART);
    char* sSp = smem + PB_SSP;
#pragma unroll
    for (int it = 0; it < 4; ++it) {
        const int tok = tid + NTHR * it;
        const uint4* src = (const uint4*)(U + (size_t)(b * SEQ + tok) * DM + g * 16);
        const uint4 v0 = src[0], v1 = src[1];
        char* d = sU + (tok >> 6) * SU_CH + (tok & 63) * 32;
        *(uint4*)d = v0; *(uint4*)(d + 16) = v1;
    }
    {
        const uint4* src = (const uint4*)(KT + (size_t)g * KT_BYTES);
        for (int it = tid; it < KT_BYTES / 16; it += NTHR) ((uint4*)sKT)[it] = src[it];
    }
    __syncthreads();
    {
        const int nt = w & 3, kh = w >> 2;
        f32x16 acc;
#pragma unroll
        for (int i = 0; i < 16; ++i) acc[i] = 0.f;
        const bf16x8* wp = WST + (size_t)g * WST_FRAGS + (size_t)(nt * 64 + kh * 32) * 64 + lane;
        const char* up = sU + r * SU_CH + h * 16 + kh * 32 * 32;
#pragma unroll 16
        for (int j = 0; j < 32; ++j) {
            const bf16x8 a = wp[j * 64];
            const bf16x8 bb = *(const bf16x8*)(up + j * 32);
            acc = MFMA32(a, bb, acc);
        }
        if (kh == 1) {
#pragma unroll
            for (int i = 0; i < 16; ++i) sPart[(nt * 16 + i) * 64 + lane] = acc[i];
        }
        __syncthreads();
        if (kh == 0) {
#pragma unroll
            for (int i = 0; i < 16; ++i) sL[r * 132 + nt * 32 + crow(i, h)] = acc[i] + sPart[(nt * 16 + i) * 64 + lane];
        }
        __syncthreads();
    }
    if (tid < 64) {
        const int p = tid;
        const float ar = ABT[g * 128 + 2 * p], ai = ABT[g * 128 + 2 * p + 1];
        float sr = 0.f, si = 0.f;
        for (int c = 0; c < 32; ++c) {
            *(bf16_t*)(sSp + c * 272 + p * 2) = (bf16_t)(pack_bf2(sr, 0.f) & 0xffffu);
            *(bf16_t*)(sSp + c * 272 + (64 + p) * 2) = (bf16_t)(pack_bf2(si, 0.f) & 0xffffu);
            const float lr = sL[c * 132 + p], li = sL[c * 132 + 64 + p];
            const float nr = ar * sr - ai * si + lr, ni = ar * si + ai * sr + li;
            sr = nr; si = ni;
        }
    }
    f32x16 acc4[4];
#pragma unroll
    for (int q = 0; q < 4; ++q)
#pragma unroll
        for (int i = 0; i < 16; ++i) acc4[q][i] = 0.f;
    const int mts0 = w, mts1 = 15 - w, mts2 = 16 + w, mts3 = 31 - w;
    {
        const char* up = sU + r * SU_CH + h * 16;
        const char* kp = sKT + (r & 15) * 32 + h * 16 + ((r >> 4) + 1) * KT_BLK;
        for (int j = 0; j < 64; ++j) {
            const bf16x8 bb = *(const bf16x8*)(up + j * 32);
#define TOEP_STEP(q, mt) if (2 * (mt) + 1 >= j) { const bf16x8 a = *(const bf16x8*)(kp + (2 * (mt) - j) * KT_BLK); acc4[q] = MFMA32(a, bb, acc4[q]); }
            TOEP_STEP(0, mts0) TOEP_STEP(1, mts1) TOEP_STEP(2, mts2) TOEP_STEP(3, mts3)
#undef TOEP_STEP
        }
    }
    __syncthreads();
    {
        const bf16x8* cp = CCAR + (size_t)g * CCAR_FRAGS + lane;
        const char* sp = sSp + r * 272 + h * 16;
#pragma unroll
        for (int ks = 0; ks < 8; ++ks) {
            const bf16x8 bb = *(const bf16x8*)(sp + ks * 32);
            acc4[0] = MFMA32(cp[(mts0 * 8 + ks) * 64], bb, acc4[0]);
            acc4[1] = MFMA32(cp[(mts1 * 8 + ks) * 64], bb, acc4[1]);
            acc4[2] = MFMA32(cp[(mts2 * 8 + ks) * 64], bb, acc4[2]);
            acc4[3] = MFMA32(cp[(mts3 * 8 + ks) * 64], bb, acc4[3]);
        }
    }
    {
        bf16_t* ybase = YPRE + (size_t)(b * SEQ + r * 64) * 512 + g * 16;
#define PB_STORE(q, mt) _Pragma("unroll") for (int rq = 0; rq < 4; ++rq) { const int c0 = 8 * rq + 4 * h; const int i = 2 * (mt) + (c0 >> 4); \
            uint2 o; o.x = pack_bf2(acc4[q][4 * rq], acc4[q][4 * rq + 1]); o.y = pack_bf2(acc4[q][4 * rq + 2], acc4[q][4 * rq + 3]); \
            *(uint2*)(ybase + (size_t)i * 512 + (c0 & 15)) = o; }
        PB_STORE(0, mts0) PB_STORE(1, mts1) PB_STORE(2, mts2) PB_STORE(3, mts3)
#undef PB_STORE
    }
    __syncthreads();
}

#ifndef REP_GLU
#define REP_GLU 1
#endif
#ifndef REP_POOL
#define REP_POOL 1
#endif
#ifndef REP_OUT
#define REP_OUT 1
#endif
#ifndef REP_Q
#define REP_Q 1
#endif
#ifndef REP_SC
#define REP_SC 1
#endif
struct ALoadGelu {
    const bf16_t* base; bf16_t* gout; u32x4 v0, v1; int cc; int dofs;
    DI void init(const bf16_t* rowbase, bf16_t* growbase, int tid) { base = rowbase + (tid & 7) * 16; gout = growbase + (tid & 7) * 16; dofs = (tid >> 3) * SA_STRIDE + (tid & 7) * 32; }
    DI void issue(int c) { const u32x4* p = (const u32x4*)(base + c * 128); v0 = p[0]; v1 = p[1]; cc = c; }
    DI unsigned g2(unsigned u) { return pack_bf2(gelu_exact(bf_lo(u)), gelu_exact(bf_hi(u))); }
    DI void commit(char* buf) {
        u32x4 o0, o1;
        o0.x = g2(v0.x); o0.y = g2(v0.y); o0.z = g2(v0.z); o0.w = g2(v0.w);
        o1.x = g2(v1.x); o1.y = g2(v1.y); o1.z = g2(v1.z); o1.w = g2(v1.w);
        char* d = buf + dofs;
        *(u32x4*)d = o0; *(u32x4*)(d + 16) = o1;
        u32x4* gp = (u32x4*)(gout + cc * 128); gp[0] = o0; gp[1] = o1;
    }
};

DI void tok_reduce(float p0, float p1, float* sred, float& t0, float& t1, int tid) {
    const int w = tid >> 6, lane = tid & 63, r = lane & 31, h = lane >> 5;
    __syncthreads();
    sred[(w * 2 + h) * 64 + r] = p0; sred[(w * 2 + h) * 64 + 32 + r] = p1;
    __syncthreads();
    float a = 0.f, b = 0.f;
#pragma unroll
    for (int k = 0; k < 16; ++k) { a += sred[k * 64 + r]; b += sred[k * 64 + 32 + r]; }
    t0 = a; t1 = b;
}

#define PC_SRED (4 * SA_BYTES)
#define PC_BYTES (PC_SRED + 4096 + 256)

struct PCArgs {
    const bf16_t* U; const bf16_t* YPRE; bf16_t* G1; bf16_t* A2; const float* Xin; float* Xout; float* Xdummy; unsigned* HPH; unsigned* HPL; float* HS; bf16_t* Hb; float* RSTD;
    const bf16x8* wfglu; const float* b_glu; const bf16x8* wfpool; const float* pool_scale; const bf16x8* wfout;
};

DI void phaseC1_tile(const PCArgs& a, int tile, char* smem, int wid) {
    char* sA = smem; float* sred = (float*)(smem + PC_SRED);
    for (int rep_ = 0; rep_ < REP_GLU; ++rep_) {
        int tok0 = tile * 64; asm volatile("" : "+s"(tok0));
        int tid = get_tid(wid);
        const int w = __builtin_amdgcn_readfirstlane(tid >> 6), lane = tid & 63, r = lane & 31, h = lane >> 5;
        ALoadGelu al; al.init(a.YPRE + (size_t)(tok0 + (tid >> 3)) * 512, a.G1 + (size_t)(tok0 + (tid >> 3)) * 512, tid);
        f32x16 acc[2][2]; zero_acc<2>(acc);
        gemm64<2, 4>(acc, al, 4, a.wfglu + (size_t)w * (32 * 2 * 64) + lane, sA, lane);
        float ss0 = 0.f, ss1 = 0.f;
        {
            uint2 yp[2][2][4]; float4 bg[2][4];
#pragma unroll
            for (int nt = 0; nt < 2; ++nt)
#pragma unroll
                for (int q = 0; q < 4; ++q) bg[nt][q] = *(const float4*)(a.b_glu + w * 64 + nt * 32 + 8 * q + 4 * h);
#pragma unroll
            for (int mt = 0; mt < 2; ++mt)
#pragma unroll
                for (int nt = 0; nt < 2; ++nt)
#pragma unroll
                    for (int q = 0; q < 4; ++q)
                        yp[mt][nt][q] = *(const uint2*)(a.G1 + (size_t)(tok0 + mt * 32 + r) * 512 + w * 64 + nt * 32 + 8 * q + 4 * h);
#pragma unroll
            for (int mt = 0; mt < 2; ++mt)
#pragma unroll
                for (int nt = 0; nt < 2; ++nt)
#pragma unroll
                    for (int q = 0; q < 4; ++q) {
                        const float y0 = bf_lo(yp[mt][nt][q].x), y1 = bf_hi(yp[mt][nt][q].x), y2 = bf_lo(yp[mt][nt][q].y), y3 = bf_hi(yp[mt][nt][q].y);
                        const float o0 = y0 / (1.f + __expf(-(acc[nt][mt][4 * q] + bg[nt][q].x)));
                        const float o1 = y1 / (1.f + __expf(-(acc[nt][mt][4 * q + 1] + bg[nt][q].y)));
                        const float o2 = y2 / (1.f + __expf(-(acc[nt][mt][4 * q + 2] + bg[nt][q].z)));
                        const float o3 = y3 / (1.f + __expf(-(acc[nt][mt][4 * q + 3] + bg[nt][q].w)));
                        acc[nt][mt][4 * q] = o0; acc[nt][mt][4 * q + 1] = o1; acc[nt][mt][4 * q + 2] = o2; acc[nt][mt][4 * q + 3] = o3;
                        const float s = o0 * o0 + o1 * o1 + o2 * o2 + o3 * o3;
                        if (mt == 0) ss0 += s; else ss1 += s;
                    }
        }
        float t0, t1; tok_reduce(ss0, ss1, sred, t0, t1, tid);
        const float rs0 = rsqrtf(t0 * (1.f / 512.f) + 1e-6f), rs1 = rsqrtf(t1 * (1.f / 512.f) + 1e-6f);
#pragma unroll
        for (int mt = 0; mt < 2; ++mt) {
            const float rs = mt ? rs1 : rs0;
            bf16_t* orow = a.A2 + (size_t)(tok0 + mt * 32 + r) * DM + w * 64;
#pragma unroll
            for (int nt = 0; nt < 2; ++nt)
#pragma unroll
                for (int q = 0; q < 4; ++q) {
                    uint2 o; o.x = pack_bf2(acc[nt][mt][4 * q] * rs, acc[nt][mt][4 * q + 1] * rs);
                    o.y = pack_bf2(acc[nt][mt][4 * q + 2] * rs, acc[nt][mt][4 * q + 3] * rs);
                    *(uint2*)(orow + nt * 32 + 8 * q + 4 * h) = o;
                }
        }
    }
    for (int rep_ = 0; rep_ < REP_POOL; ++rep_) {
        int tok0 = tile * 64; asm volatile("" : "+s"(tok0));
        int tid = get_tid(wid);
        const int w = __builtin_amdgcn_readfirstlane(tid >> 6), lane = tid & 63, r = lane & 31, h = lane >> 5;
        const int row = tid >> 3, seg = tid & 7;
        const int tok = tok0 + row, t = tok & (SEQ - 1);
#pragma unroll
        for (int gi = 0; gi < 4; ++gi) {
            const int win = 2 << gi;
            const int cnt = (t + 1 < win) ? (t + 1) : win;
            const bf16_t* up = a.U + (size_t)tok * DM + 512 + gi * 128 + seg * 16;
            float s[16];
            const uint4 c0 = *(const uint4*)up, c1 = *(const uint4*)(up + 8);
            const unsigned cu[8] = {c0.x, c0.y, c0.z, c0.w, c1.x, c1.y, c1.z, c1.w};
#pragma unroll
            for (int i = 0; i < 8; ++i) { s[2 * i] = bf_lo(cu[i]); s[2 * i + 1] = bf_hi(cu[i]); }
#pragma unroll
            for (int k0 = 1; k0 < win; k0 += 5) {
                uint4 d0[5], d1[5];
#pragma unroll
                for (int u = 0; u < 5; ++u)
                    if (k0 + u < win) {
                        const bf16_t* p = (k0 + u <= t) ? up - (size_t)(k0 + u) * DM : up;
                        d0[u] = *(const uint4*)p; d1[u] = *(const uint4*)(p + 8);
                    }
#pragma unroll
                for (int u = 0; u < 5; ++u)
                    if (k0 + u < win) {
                        const float m = (k0 + u <= t) ? 1.f : 0.f;
                        const unsigned du[8] = {d0[u].x, d0[u].y, d0[u].z, d0[u].w, d1[u].x, d1[u].y, d1[u].z, d1[u].w};
#pragma unroll
                        for (int i = 0; i < 8; ++i) { s[2 * i] = fmaf(m, bf_lo(du[i]), s[2 * i]); s[2 * i + 1] = fmaf(m, bf_hi(du[i]), s[2 * i + 1]); }
                    }
            }
            const float inv = 1.f / (float)cnt;
            unsigned o[8];
#pragma unroll
            for (int i = 0; i < 8; ++i) o[i] = pack_bf2(s[2 * i] * inv - bf_lo(cu[i]), s[2 * i + 1] * inv - bf_hi(cu[i]));
            char* d = sA + gi * SA_BYTES + row * SA_STRIDE + seg * 32;
            *(uint4*)d = make_uint4(o[0], o[1], o[2], o[3]); *(uint4*)(d + 16) = make_uint4(o[4], o[5], o[6], o[7]);
        }
        __syncthreads();
        const int gi = w >> 1;
        f32x16 acc[2][2]; zero_acc<2>(acc);
        const bf16x8* wp = a.wfpool + (size_t)gi * (128 * 128 / 8) + (size_t)(w & 1) * (8 * 2 * 64) + lane;
        const char* buf = sA + gi * SA_BYTES + r * SA_STRIDE + h * 16;
#pragma unroll
        for (int ks = 0; ks < 8; ++ks) {
            const bf16x8 a0 = *(const bf16x8*)(buf + ks * 32);
            const bf16x8 a1 = *(const bf16x8*)(buf + 32 * SA_STRIDE + ks * 32);
#pragma unroll
            for (int nt = 0; nt < 2; ++nt) {
                const bf16x8 wv = wp[(ks * 2 + nt) * 64];
                acc[nt][0] = MFMA32(wv, a0, acc[nt][0]);
                acc[nt][1] = MFMA32(wv, a1, acc[nt][1]);
            }
        }
        float ss0 = 0.f, ss1 = 0.f;
        float4 psc[2][4];
#pragma unroll
        for (int nt = 0; nt < 2; ++nt)
#pragma unroll
            for (int q = 0; q < 4; ++q) psc[nt][q] = *(const float4*)(a.pool_scale + w * 64 + nt * 32 + 8 * q + 4 * h);
#pragma unroll
        for (int mt = 0; mt < 2; ++mt)
#pragma unroll
            for (int nt = 0; nt < 2; ++nt)
#pragma unroll
                for (int q = 0; q < 4; ++q) {
                    const float4 sc = psc[nt][q];
                    const float o0 = acc[nt][mt][4 * q] * sc.x, o1 = acc[nt][mt][4 * q + 1] * sc.y, o2 = acc[nt][mt][4 * q + 2] * sc.z, o3 = acc[nt][mt][4 * q + 3] * sc.w;
                    acc[nt][mt][4 * q] = o0; acc[nt][mt][4 * q + 1] = o1; acc[nt][mt][4 * q + 2] = o2; acc[nt][mt][4 * q + 3] = o3;
                    const float s = o0 * o0 + o1 * o1 + o2 * o2 + o3 * o3;
                    if (mt == 0) ss0 += s; else ss1 += s;
                }
        float t0, t1; tok_reduce(ss0, ss1, sred, t0, t1, tid);
        const float rs0 = rsqrtf(t0 * (1.f / 512.f) + 1e-6f), rs1 = rsqrtf(t1 * (1.f / 512.f) + 1e-6f);
#pragma unroll
        for (int mt = 0; mt < 2; ++mt) {
            const float rs = mt ? rs1 : rs0;
            bf16_t* orow = a.A2 + (size_t)(tok0 + mt * 32 + r) * DM + 512 + w * 64;
#pragma unroll
            for (int nt = 0; nt < 2; ++nt)
#pragma unroll
                for (int q = 0; q < 4; ++q) {
                    uint2 o; o.x = pack_bf2(acc[nt][mt][4 * q] * rs, acc[nt][mt][4 * q + 1] * rs);
                    o.y = pack_bf2(acc[nt][mt][4 * q + 2] * rs, acc[nt][mt][4 * q + 3] * rs);
                    *(uint2*)(orow + nt * 32 + 8 * q + 4 * h) = o;
                }
        }
        __syncthreads();
    }
    for (int rep_ = 0; rep_ < REP_OUT; ++rep_) {
        float* xout_ = (rep_ + 1 < REP_OUT) ? a.Xdummy : a.Xout;
        int tok0 = tile * 64; asm volatile("" : "+s"(tok0));
        int tid = get_tid(wid);
        const int w = __builtin_amdgcn_readfirstlane(tid >> 6), lane = tid & 63, r = lane & 31, h = lane >> 5;
        ALoadBF16 al; al.init(a.A2 + (size_t)(tok0 + (tid >> 3)) * DM, tid);
        f32x16 acc[4][2]; zero_acc<4>(acc);
        gemm64<4, 2>(acc, al, 8, a.wfout + (size_t)w * (64 * 4 * 64) + lane, sA, lane);
        {
            float* wscr = (float*)(smem + w * WSCR_BYTES);
            const int tl = lane >> 3, cl = (lane & 7) * 4;
            float ssj[2][4];
#pragma unroll
            for (int mt = 0; mt < 2; ++mt)
#pragma unroll
                for (int j = 0; j < 4; ++j) ssj[mt][j] = 0.f;
            float4 xc[4], xn[4];
            const size_t rbase = (size_t)(tok0 + tl) * DM + w * 128 + cl;
#pragma unroll
            for (int j = 0; j < 4; ++j) xc[j] = *(const float4*)(a.Xin + rbase + (size_t)(8 * j) * DM);
#pragma unroll
            for (int g = 0; g < 8; ++g) {
                const int mt = g >> 2, nt = g & 3;
                if (g < 7) {
                    const size_t rn = rbase + (size_t)((g + 1) >> 2) * 32 * DM + ((g + 1) & 3) * 32;
#pragma unroll
                    for (int j = 0; j < 4; ++j) xn[j] = *(const float4*)(a.Xin + rn + (size_t)(8 * j) * DM);
                }
                f32x4 o[4]; tile_transpose(acc[nt][mt], wscr, lane, o);
                const size_t ro = rbase + (size_t)mt * 32 * DM + nt * 32;
#pragma unroll
                for (int j = 0; j < 4; ++j) {
                    float4 xo; xo.x = xc[j].x + o[j].x; xo.y = xc[j].y + o[j].y; xo.z = xc[j].z + o[j].z; xo.w = xc[j].w + o[j].w;
                    *(float4*)(xout_ + ro + (size_t)(8 * j) * DM) = xo;
                    uint2 p; p.x = pack_bf2(xo.x, xo.y); p.y = pack_bf2(xo.z, xo.w);
                    *(uint2*)(a.Hb + ro + (size_t)(8 * j) * DM) = p;
                    ssj[mt][j] += xo.x * xo.x + xo.y * xo.y + xo.z * xo.z + xo.w * xo.w;
                }
                asm volatile("" ::: "memory");
#pragma unroll
                for (int j = 0; j < 4; ++j) xc[j] = xn[j];
            }
#pragma unroll
            for (int mt = 0; mt < 2; ++mt)
#pragma unroll
                for (int j = 0; j < 4; ++j) {
                    float v = ssj[mt][j];
                    v += shx<1>(v, lane); v += shx<2>(v, lane); v += shx<4>(v, lane);
                    if ((lane & 7) == 0) sred[w * 64 + mt * 32 + tl + 8 * j] = v;
                }
            __syncthreads();
            if (tid < 64) {
                float tot = 0.f;
#pragma unroll
                for (int k = 0; k < 8; ++k) tot += sred[k * 64 + tid];
                a.RSTD[tok0 + tid] = rsqrtf(tot * (1.f / 1024.f) + 1e-6f);
            }
        }
        __syncthreads();
    }
    {
        int tok0 = tile * 64; asm volatile("" : "+s"(tok0));
        int tid = get_tid(wid);
        const int w = __builtin_amdgcn_readfirstlane(tid >> 6), lane = tid & 63;
#pragma unroll 1
        for (int ti = 0; ti < 8; ++ti) {
            const int tok = tok0 + w * 8 + ti;
            const u32x4* hp = (const u32x4*)(a.Hb + (size_t)tok * DM + lane * 16);
            const u32x4 h0 = hp[0], h1 = hp[1];
            const unsigned wv[8] = {h0.x, h0.y, h0.z, h0.w, h1.x, h1.y, h1.z, h1.w};
            float f[16]; float m = 0.f;
#pragma unroll
            for (int i = 0; i < 8; ++i) { f[2 * i] = bf_lo(wv[i]); f[2 * i + 1] = bf_hi(wv[i]); m = fmaxf(m, fmaxf(fabsf(f[2 * i]), fabsf(f[2 * i + 1]))); }
            m = fmaxf(m, __int_as_float(__builtin_amdgcn_update_dpp(0, __float_as_int(m), 0xB1, 0xF, 0xF, true)));
            m = fmaxf(m, __int_as_float(__builtin_amdgcn_update_dpp(0, __float_as_int(m), 0x4E, 0xF, 0xF, true)));
            m = fmaxf(m, __int_as_float(__builtin_amdgcn_update_dpp(0, __float_as_int(m), 0x141, 0xF, 0xF, true)));
            m = fmaxf(m, __int_as_float(__builtin_amdgcn_update_dpp(0, __float_as_int(m), 0x140, 0xF, 0xF, true)));
            const float sh = (m > 0.f) ? m * (1.f / 119.f) : 1.f, inv = 1.f / sh;
            unsigned Hd[2], Ld[2];
#pragma unroll
            for (int d = 0; d < 2; ++d) {
                unsigned A = 0u, B = 0u;
#pragma unroll
                for (int i = 0; i < 4; ++i) {
                    A = __builtin_amdgcn_cvt_pk_u8_f32(rintf(f[8 * d + i] * inv) + 136.f, i, A);
                    B = __builtin_amdgcn_cvt_pk_u8_f32(rintf(f[8 * d + 4 + i] * inv) + 136.f, i, B);
                }
                Ld[d] = ((A & 0x0F0F0F0Fu) | ((B & 0x0F0F0F0Fu) << 4)) ^ 0x88888888u;
                Hd[d] = (((A >> 4) & 0x0F0F0F0Fu) | (B & 0xF0F0F0F0u)) ^ 0x88888888u;
            }
            *(uint2*)(a.HPH + (size_t)tok * 128 + 2 * lane) = make_uint2(Hd[0], Hd[1]);
            *(uint2*)(a.HPL + (size_t)tok * 128 + 2 * lane) = make_uint2(Ld[0], Ld[1]);
            if ((lane & 15) == 0) a.HS[(size_t)tok * 4 + (lane >> 4)] = sh;
        }
    }
}

DI unsigned f2ord(float f) { const unsigned u = __float_as_uint(f); return u ^ ((u >> 31) ? 0xFFFFFFFFu : 0x80000000u); }
DI float ord2f(unsigned o) { return __uint_as_float((o & 0x80000000u) ? (o ^ 0x80000000u) : ~o); }
DI unsigned umax_(unsigned a, unsigned b) { return a > b ? a : b; }
DI unsigned umin_(unsigned a, unsigned b) { return a < b ? a : b; }

struct PRArgs {
    const bf16_t* Hb; const float* RSTD; const bf16x8* wfq; const bf16x8* kf1; const bf16x8* kf2; unsigned short* EX; float* GT;
};

DI void conv_kfrag(const float* __restrict__ K, bf16x8* __restrict__ dst, size_t gtid, size_t gstride) {
    for (size_t item = gtid; item < 8 * 4 * 64; item += gstride) {
        const int lane = (int)(item & 63), kt = (int)((item >> 6) & 3), ks = (int)(item >> 8);
        const int r = lane & 31, h = lane >> 5;
        float v[8];
#pragma unroll
        for (int j = 0; j < 8; ++j) v[j] = K[(size_t)(kt * 32 + r) * 128 + (ks >> 1) * 32 + 16 * (ks & 1) + 8 * (j >> 2) + 4 * h + (j & 3)];
        uint4 o; o.x = pack_bf2(v[0], v[1]); o.y = pack_bf2(v[2], v[3]); o.z = pack_bf2(v[4], v[5]); o.w = pack_bf2(v[6], v[7]);
        *(uint4*)(dst + item) = o;
    }
}

DI void bitonic_sort16(unsigned (&a)[16]) {
#pragma unroll
    for (int k = 2; k <= 16; k <<= 1)
#pragma unroll
        for (int j = k >> 1; j > 0; j >>= 1)
#pragma unroll
            for (int i = 0; i < 16; ++i) {
                const int l = i ^ j;
                if (l > i) {
                    const unsigned hi = umax_(a[i], a[l]), lo = umin_(a[i], a[l]);
                    if ((i & k) == 0) { a[i] = hi; a[l] = lo; } else { a[i] = lo; a[l] = hi; }
                }
            }
}
DI void bitonic_top16(unsigned (&a)[16], const unsigned (&b)[16]) {
#pragma unroll
    for (int i = 0; i < 16; ++i) a[i] = umax_(a[i], b[15 - i]);
#pragma unroll
    for (int j = 8; j > 0; j >>= 1)
#pragma unroll
        for (int i = 0; i < 16; ++i) {
            const int l = i ^ j;
            if (l > i) { const unsigned hi = umax_(a[i], a[l]), lo = umin_(a[i], a[l]); a[i] = hi; a[l] = lo; }
        }
}
DI void make_keys(unsigned (&x)[16], const f32x16& s, float rs, int nbase, int h) {
#pragma unroll
    for (int i = 0; i < 16; ++i) x[i] = (f2ord(s[i] * rs) & 0xFFFFFF80u) | (unsigned)(127 - (nbase + crow(i, h)));
}

#define PR_LIST_STRIDE 80
#define PR_SLIST (2 * SA_BYTES)
#define PR_SIDX (PR_SLIST + 8 * 32 * PR_LIST_STRIDE)

DI void phaseC2_tile(const PRArgs& a, int tile, char* smem, int wid) {
    char* sA = smem;
#pragma unroll 1
    for (int ps = 0; ps < 2; ++ps) {
        int tok0 = tile * 64; asm volatile("" : "+s"(tok0));
        int tid = get_tid(wid);
        const int w = __builtin_amdgcn_readfirstlane(tid >> 6), lane = tid & 63, r = lane & 31, h = lane >> 5;
        const int ng = ps * 8 + w, hd = ng >> 1, hf = ng & 1;
        bf16x8 qb[2][8];
        {
            ALoadBF16 al; al.init(a.Hb + (size_t)(tok0 + (tid >> 3)) * DM, tid);
            f32x16 acc[4][2]; zero_acc<4>(acc);
            gemm64<4, 2>(acc, al, 8, a.wfq + (size_t)ng * (64 * 4 * 64) + lane, sA, lane);
#pragma unroll
            for (int mt = 0; mt < 2; ++mt)
#pragma unroll
                for (int nt = 0; nt < 4; ++nt)
#pragma unroll
                    for (int s = 0; s < 2; ++s) {
                        u32x4 p;
                        p.x = pack_bf2(acc[nt][mt][8 * s], acc[nt][mt][8 * s + 1]); p.y = pack_bf2(acc[nt][mt][8 * s + 2], acc[nt][mt][8 * s + 3]);
                        p.z = pack_bf2(acc[nt][mt][8 * s + 4], acc[nt][mt][8 * s + 5]); p.w = pack_bf2(acc[nt][mt][8 * s + 6], acc[nt][mt][8 * s + 7]);
                        qb[mt][nt * 2 + s] = __builtin_bit_cast(bf16x8, p);
                    }
        }
        gwp_t kf = (gwp_t)(hf ? a.kf2 : a.kf1) + lane;
        unsigned Town[16];
#pragma unroll
        for (int mt = 0; mt < 2; ++mt) {
            f32x16 sc[4];
#pragma unroll
            for (int kt = 0; kt < 4; ++kt)
#pragma unroll
                for (int i = 0; i < 16; ++i) sc[kt][i] = 0.f;
#pragma unroll
            for (int ks = 0; ks < 8; ++ks) {
#pragma unroll
                for (int kt = 0; kt < 4; ++kt) sc[kt] = MFMA32(kf[(ks * 4 + kt) * 64], qb[mt][ks], sc[kt]);
                if (ks & 1) asm volatile("" ::: "memory");
            }
            const float rs = a.RSTD[tok0 + mt * 32 + r];
            unsigned L[16], S[16];
            make_keys(L, sc[0], rs, 0, h); bitonic_sort16(L);
#pragma unroll
            for (int kt = 1; kt < 4; ++kt) { make_keys(S, sc[kt], rs, kt * 32, h); bitonic_sort16(S); bitonic_top16(L, S); }
#pragma unroll
            for (int k = 0; k < 16; ++k) S[k] = (unsigned)shx_i<32>((int)L[k], lane);
            bitonic_top16(L, S);
            if (mt == hf) {
#pragma unroll
                for (int k = 0; k < 16; ++k) Town[k] = L[k];
            } else {
                char* dst = smem + PR_SLIST + (w * 32 + r) * PR_LIST_STRIDE + h * 32;
                u32x4 v0, v1;
                if (h == 0) { v0 = (u32x4){L[0], L[1], L[2], L[3]}; v1 = (u32x4){L[4], L[5], L[6], L[7]}; }
                else { v0 = (u32x4){L[8], L[9], L[10], L[11]}; v1 = (u32x4){L[12], L[13], L[14], L[15]}; }
                *(u32x4*)dst = v0; *(u32x4*)(dst + 16) = v1;
            }
        }
        __syncthreads();
        unsigned T0[16], T1[16];
        {
            const char* src = smem + PR_SLIST + ((w ^ 1) * 32 + r) * PR_LIST_STRIDE;
            const u32x4 p0 = *(const u32x4*)src, p1 = *(const u32x4*)(src + 16), p2 = *(const u32x4*)(src + 32), p3 = *(const u32x4*)(src + 48);
            const unsigned Tp[16] = {p0.x, p0.y, p0.z, p0.w, p1.x, p1.y, p1.z, p1.w, p2.x, p2.y, p2.z, p2.w, p3.x, p3.y, p3.z, p3.w};
#pragma unroll
            for (int k = 0; k < 16; ++k) { T0[k] = hf ? Tp[k] : Town[k]; T1[k] = hf ? Town[k] : Tp[k]; }
        }
        float v1[16], v2[16];
#pragma unroll
        for (int k = 0; k < 16; ++k) { v1[k] = ord2f(T0[k] & 0xFFFFFF80u); v2[k] = ord2f(T1[k] & 0xFFFFFF80u); }
        unsigned C[16];
#pragma unroll
        for (int b = 0; b < 16; ++b) C[b] = (f2ord(v1[0] + v2[b]) & 0xFFFFFF00u) | (unsigned)(255 - b);
#pragma unroll
        for (int aa = 1; aa < 16; ++aa)
#pragma unroll
            for (int b = 0; b < 16; ++b)
                if ((aa + 1) * (b + 1) <= 16) {
                    unsigned x = (f2ord(v1[aa] + v2[b]) & 0xFFFFFF00u) | (unsigned)(255 - (aa * 16 + b));
#pragma unroll
                    for (int k = (aa + 1) * (b + 1) - 1; k < 16; ++k) { const unsigned hi = umax_(C[k], x); x = umin_(C[k], x); C[k] = hi; }
                }
        unsigned* sI = (unsigned*)(smem + PR_SIDX) + (w * 64 + lane) * 9;
#pragma unroll
        for (int q = 0; q < 4; ++q) {
            unsigned p1 = 0u, p2 = 0u;
#pragma unroll
            for (int j = 0; j < 4; ++j) { p1 |= (127u - (T0[4 * q + j] & 0x7Fu)) << (8 * j); p2 |= (127u - (T1[4 * q + j] & 0x7Fu)) << (8 * j); }
            sI[q] = p1; sI[4 + q] = p2;
        }
        const unsigned char* sB = (const unsigned char*)sI;
        const float mx = ord2f(C[0] & 0xFFFFFF00u);
        float e[16]; float sum = 0.f; int ex[16];
#pragma unroll
        for (int k = 0; k < 16; ++k) {
            e[k] = __expf(ord2f(C[k] & 0xFFFFFF00u) - mx); sum += e[k];
            const unsigned ci = 255u - (C[k] & 0xFFu);
            ex[k] = (int)sB[ci >> 4] * 128 + (int)sB[16 + (ci & 15u)];
        }
        const float inv = 1.f / sum;
        const size_t ob = ((size_t)(tok0 + hf * 32 + r) * 8 + hd) * 16;
        if (h == 0) {
#pragma unroll
            for (int q = 0; q < 2; ++q) *(uint4*)(a.EX + ob + 8 * q) = make_uint4((unsigned)ex[8 * q] | ((unsigned)ex[8 * q + 1] << 16), (unsigned)ex[8 * q + 2] | ((unsigned)ex[8 * q + 3] << 16),
                                                                       (unsigned)ex[8 * q + 4] | ((unsigned)ex[8 * q + 5] << 16), (unsigned)ex[8 * q + 6] | ((unsigned)ex[8 * q + 7] << 16));
        } else {
#pragma unroll
            for (int q = 0; q < 4; ++q) *(float4*)(a.GT + ob + 4 * q) = make_float4(e[4 * q] * inv, e[4 * q + 1] * inv, e[4 * q + 2] * inv, e[4 * q + 3] * inv);
        }
        __syncthreads();
    }
}
typedef const __attribute__((address_space(1))) u32x4* grow_t;
typedef unsigned char fp8_t;

struct PGArgs {
    const bf16_t* Hb; const float* RSTD; const int* EX; const float* GT; const fp8_t* U8; const fp8_t* V8; const float* SU; const float* SV;
    const float* Xin; float* Xout; const float* gfinal; int final_norm;
};

#ifndef EMU_FP4
#define EMU_FP4 0
#endif
DI float q_e2m1(float x, float inv, float sc) {
    const float a = fabsf(x) * inv;
    float q = (a < 0.25f) ? 0.f : (a < 0.75f) ? 0.5f : (a < 1.25f) ? 1.f : (a < 1.75f) ? 1.5f : (a < 2.5f) ? 2.f : (a < 3.5f) ? 3.f : (a < 5.f) ? 4.f : 6.f;
    return copysignf(q * sc, x);
}
DI void emu_fp4_block(float4& v0, float4& v1, float4& v2, float4& v3) {
    float m = fmaxf(fmaxf(fmaxf(fabsf(v0.x), fabsf(v0.y)), fmaxf(fabsf(v0.z), fabsf(v0.w))), fmaxf(fmaxf(fabsf(v1.x), fabsf(v1.y)), fmaxf(fabsf(v1.z), fabsf(v1.w))));
    m = fmaxf(m, fmaxf(fmaxf(fmaxf(fabsf(v2.x), fabsf(v2.y)), fmaxf(fabsf(v2.z), fabsf(v2.w))), fmaxf(fmaxf(fabsf(v3.x), fabsf(v3.y)), fmaxf(fabsf(v3.z), fabsf(v3.w)))));
    const float sc = (m > 0.f) ? m * (1.f / 6.f) : 1.f, inv = 1.f / sc;
    v0.x = q_e2m1(v0.x, inv, sc); v0.y = q_e2m1(v0.y, inv, sc); v0.z = q_e2m1(v0.z, inv, sc); v0.w = q_e2m1(v0.w, inv, sc);
    v1.x = q_e2m1(v1.x, inv, sc); v1.y = q_e2m1(v1.y, inv, sc); v1.z = q_e2m1(v1.z, inv, sc); v1.w = q_e2m1(v1.w, inv, sc);
    v2.x = q_e2m1(v2.x, inv, sc); v2.y = q_e2m1(v2.y, inv, sc); v2.z = q_e2m1(v2.z, inv, sc); v2.w = q_e2m1(v2.w, inv, sc);
    v3.x = q_e2m1(v3.x, inv, sc); v3.y = q_e2m1(v3.y, inv, sc); v3.z = q_e2m1(v3.z, inv, sc); v3.w = q_e2m1(v3.w, inv, sc);
}
DI void conv_row_fp8_one(float4 v0, float4 v1, float4 v2, float4 v3, const float* __restrict__ gain, fp8_t* __restrict__ dst, float* __restrict__ scales,
                         int nrows, int row, int lane) {
    if (gain) {
        const float4* g = (const float4*)(gain + lane * 16);
        const float4 g0 = g[0], g1 = g[1], g2 = g[2], g3 = g[3];
        v0.x *= g0.x; v0.y *= g0.y; v0.z *= g0.z; v0.w *= g0.w; v1.x *= g1.x; v1.y *= g1.y; v1.z *= g1.z; v1.w *= g1.w;
        v2.x *= g2.x; v2.y *= g2.y; v2.z *= g2.z; v2.w *= g2.w; v3.x *= g3.x; v3.y *= g3.y; v3.z *= g3.z; v3.w *= g3.w;
    }
    if (gain ? (EMU_FP4 & 1) : (EMU_FP4 & 2)) emu_fp4_block(v0, v1, v2, v3);
    float m = fmaxf(fmaxf(fmaxf(fabsf(v0.x), fabsf(v0.y)), fmaxf(fabsf(v0.z), fabsf(v0.w))), fmaxf(fmaxf(fabsf(v1.x), fabsf(v1.y)), fmaxf(fabsf(v1.z), fabsf(v1.w))));
    m = fmaxf(m, fmaxf(fmaxf(fmaxf(fabsf(v2.x), fabsf(v2.y)), fmaxf(fabsf(v2.z), fabsf(v2.w))), fmaxf(fmaxf(fabsf(v3.x), fabsf(v3.y)), fmaxf(fabsf(v3.z), fabsf(v3.w)))));
    m = fmaxf(m, shx<1>(m, lane)); m = fmaxf(m, shx<2>(m, lane)); m = fmaxf(m, shx<4>(m, lane)); m = fmaxf(m, shx<8>(m, lane)); m = fmaxf(m, shx<16>(m, lane)); m = fmaxf(m, shx<32>(m, lane));
    const float sc = (m > 0.f) ? m * (1.f / 448.f) : 1.f;
    const float inv = 1.f / sc;
    u32x4 o;
    unsigned t;
    t = 0u; t = __builtin_amdgcn_cvt_pk_fp8_f32(v0.x * inv, v0.y * inv, t, false); t = __builtin_amdgcn_cvt_pk_fp8_f32(v0.z * inv, v0.w * inv, t, true); o.x = t;
    t = 0u; t = __builtin_amdgcn_cvt_pk_fp8_f32(v1.x * inv, v1.y * inv, t, false); t = __builtin_amdgcn_cvt_pk_fp8_f32(v1.z * inv, v1.w * inv, t, true); o.y = t;
    t = 0u; t = __builtin_amdgcn_cvt_pk_fp8_f32(v2.x * inv, v2.y * inv, t, false); t = __builtin_amdgcn_cvt_pk_fp8_f32(v2.z * inv, v2.w * inv, t, true); o.z = t;
    t = 0u; t = __builtin_amdgcn_cvt_pk_fp8_f32(v3.x * inv, v3.y * inv, t, false); t = __builtin_amdgcn_cvt_pk_fp8_f32(v3.z * inv, v3.w * inv, t, true); o.w = t;
    *(u32x4*)(dst + ((size_t)(lane >> 3) * nrows + row) * 128 + (lane & 7) * 16) = o;
    if (lane == 0) scales[row] = sc;
}
DI void conv_rows_fp8(const float* __restrict__ src, const float* __restrict__ gain, fp8_t* __restrict__ dst, float* __restrict__ scales,
                      int nrows, int gwave, int nwaves, int lane) {
#pragma unroll 1
    for (int row = gwave; row < nrows; row += 4 * nwaves) {
        const int r1 = min(row + nwaves, nrows - 1), r2 = min(row + 2 * nwaves, nrows - 1), r3 = min(row + 3 * nwaves, nrows - 1);
        const float4* p0 = (const float4*)(src + (size_t)row * DM + lane * 16);
        const float4* p1 = (const float4*)(src + (size_t)r1 * DM + lane * 16);
        const float4* p2 = (const float4*)(src + (size_t)r2 * DM + lane * 16);
        const float4* p3 = (const float4*)(src + (size_t)r3 * DM + lane * 16);
        const float4 a0 = p0[0], a1 = p0[1], a2 = p0[2], a3 = p0[3];
        const float4 b0 = p1[0], b1 = p1[1], b2 = p1[2], b3 = p1[3];
        const float4 c0 = p2[0], c1 = p2[1], c2 = p2[2], c3 = p2[3];
        const float4 d0 = p3[0], d1 = p3[1], d2 = p3[2], d3 = p3[3];
        conv_row_fp8_one(a0, a1, a2, a3, gain, dst, scales, nrows, row, lane);
        conv_row_fp8_one(b0, b1, b2, b3, gain, dst, scales, nrows, r1, lane);
        conv_row_fp8_one(c0, c1, c2, c3, gain, dst, scales, nrows, r2, lane);
        conv_row_fp8_one(d0, d1, d2, d3, gain, dst, scales, nrows, r3, lane);
    }
}

struct RowOct { u32x4 r0, r1, r2, r3, r4, r5, r6, r7; };
DI void oct_load(RowOct& q, const fp8_t* tab, int e0, int e1, int e2, int e3, int e4, int e5, int e6, int e7, int lane) {
    q.r0 = ((grow_t)(tab + (size_t)e0 * DM))[lane]; q.r1 = ((grow_t)(tab + (size_t)e1 * DM))[lane];
    q.r2 = ((grow_t)(tab + (size_t)e2 * DM))[lane]; q.r3 = ((grow_t)(tab + (size_t)e3 * DM))[lane];
    q.r4 = ((grow_t)(tab + (size_t)e4 * DM))[lane]; q.r5 = ((grow_t)(tab + (size_t)e5 * DM))[lane];
    q.r6 = ((grow_t)(tab + (size_t)e6 * DM))[lane]; q.r7 = ((grow_t)(tab + (size_t)e7 * DM))[lane];
}
DI float dot4w(unsigned w, float h0, float h1, float h2, float h3, float s) {
    const f2_t lo = __builtin_amdgcn_cvt_pk_f32_fp8(w, false), hi = __builtin_amdgcn_cvt_pk_f32_fp8(w, true);
    s = fmaf(lo.x, h0, s); s = fmaf(lo.y, h1, s); s = fmaf(hi.x, h2, s); s = fmaf(hi.y, h3, s);
    return s;
}
DI float row_dot8(const u32x4& r, const float (&h)[16]) {
    float s = 0.f;
    s = dot4w(r.x, h[0], h[1], h[2], h[3], s); s = dot4w(r.y, h[4], h[5], h[6], h[7], s);
    s = dot4w(r.z, h[8], h[9], h[10], h[11], s); s = dot4w(r.w, h[12], h[13], h[14], h[15], s);
    return s;
}
DI void axpy4w(unsigned w, float c, float& a0, float& a1, float& a2, float& a3) {
    const f2_t lo = __builtin_amdgcn_cvt_pk_f32_fp8(w, false), hi = __builtin_amdgcn_cvt_pk_f32_fp8(w, true);
    a0 = fmaf(c, lo.x, a0); a1 = fmaf(c, lo.y, a1); a2 = fmaf(c, hi.x, a2); a3 = fmaf(c, hi.y, a3);
}
DI void row_axpy8(float (&acc)[16], const u32x4& r, float c) {
    axpy4w(r.x, c, acc[0], acc[1], acc[2], acc[3]); axpy4w(r.y, c, acc[4], acc[5], acc[6], acc[7]);
    axpy4w(r.z, c, acc[8], acc[9], acc[10], acc[11]); axpy4w(r.w, c, acc[12], acc[13], acc[14], acc[15]);
}
#define RL(v, l) __builtin_amdgcn_readlane((v), (l))
#define RLF(v, l) __uint_as_float((unsigned)__builtin_amdgcn_readlane((int)__float_as_uint(v), (l)))

DI float reduce16(float (&p)[16], int lane) {
    const bool b5 = lane & 32, b4 = lane & 16, b3 = lane & 8, b2 = lane & 4;
    float q8[8], q4[4], q2[2];
#pragma unroll
    for (int k = 0; k < 8; ++k) { const float keep = b5 ? p[k + 8] : p[k], send = b5 ? p[k] : p[k + 8]; q8[k] = keep + shx<32>(send, lane); }
#pragma unroll
    for (int k = 0; k < 4; ++k) { const float keep = b4 ? q8[k + 4] : q8[k], send = b4 ? q8[k] : q8[k + 4]; q4[k] = keep + shx<16>(send, lane); }
#pragma unroll
    for (int k = 0; k < 2; ++k) { const float keep = b3 ? q4[k + 2] : q4[k], send = b3 ? q4[k] : q4[k + 2]; q2[k] = keep + shx<8>(send, lane); }
    float t;
    { const float keep = b2 ? q2[1] : q2[0], send = b2 ? q2[0] : q2[1]; t = keep + shx<4>(send, lane); }
    t += shx<1>(t, lane); t += shx<2>(t, lane);
    return t;
}

DI void phaseC3_tile(const PGArgs& a, int tile, int wid) {
    int tid = get_tid(wid);
    const int w = __builtin_amdgcn_readfirstlane(tid >> 6), lane = tid & 63;
    const int el = (lane >> 2) & 15;
#pragma unroll 1
    for (int ti = 0; ti < 8; ++ti) {
        const int tok = tile * 64 + w * 8 + ti;
        float h[16];
        {
            const u32x4* hp = (const u32x4*)(a.Hb + (size_t)tok * DM + lane * 16);
            const u32x4 h0 = hp[0], h1 = hp[1];
            h[0] = bf_lo(h0.x); h[1] = bf_hi(h0.x); h[2] = bf_lo(h0.y); h[3] = bf_hi(h0.y); h[4] = bf_lo(h0.z); h[5] = bf_hi(h0.z); h[6] = bf_lo(h0.w); h[7] = bf_hi(h0.w);
            h[8] = bf_lo(h1.x); h[9] = bf_hi(h1.x); h[10] = bf_lo(h1.y); h[11] = bf_hi(h1.y); h[12] = bf_lo(h1.z); h[13] = bf_hi(h1.z); h[14] = bf_lo(h1.w); h[15] = bf_hi(h1.w);
        }
        const float rs = a.RSTD[tok];
        float acc[16];
#pragma unroll
        for (int i = 0; i < 16; ++i) acc[i] = 0.f;
#pragma unroll 1
        for (int hd = 0; hd < 8; ++hd) {
            const size_t eb = ((size_t)tok * 8 + hd) * 16;
            const int exv = a.EX[eb + (lane & 15)];
            const int exl = a.EX[eb + el];
            const float coef = a.GT[eb + el] * a.SV[exl];
            const float su = a.SU[exl] * rs;
            RowOct qa, qb;
            float p[16];
            oct_load(qa, a.U8, RL(exv, 0), RL(exv, 1), RL(exv, 2), RL(exv, 3), RL(exv, 4), RL(exv, 5), RL(exv, 6), RL(exv, 7), lane);
            oct_load(qb, a.U8, RL(exv, 8), RL(exv, 9), RL(exv, 10), RL(exv, 11), RL(exv, 12), RL(exv, 13), RL(exv, 14), RL(exv, 15), lane);
            p[0] = row_dot8(qa.r0, h); p[1] = row_dot8(qa.r1, h); p[2] = row_dot8(qa.r2, h); p[3] = row_dot8(qa.r3, h);
            p[4] = row_dot8(qa.r4, h); p[5] = row_dot8(qa.r5, h); p[6] = row_dot8(qa.r6, h); p[7] = row_dot8(qa.r7, h);
            oct_load(qa, a.V8, RL(exv, 0), RL(exv, 1), RL(exv, 2), RL(exv, 3), RL(exv, 4), RL(exv, 5), RL(exv, 6), RL(exv, 7), lane);
            p[8] = row_dot8(qb.r0, h); p[9] = row_dot8(qb.r1, h); p[10] = row_dot8(qb.r2, h); p[11] = row_dot8(qb.r3, h);
            p[12] = row_dot8(qb.r4, h); p[13] = row_dot8(qb.r5, h); p[14] = row_dot8(qb.r6, h); p[15] = row_dot8(qb.r7, h);
            oct_load(qb, a.V8, RL(exv, 8), RL(exv, 9), RL(exv, 10), RL(exv, 11), RL(exv, 12), RL(exv, 13), RL(exv, 14), RL(exv, 15), lane);
            const float act = gelu_exact(reduce16(p, lane) * su) * coef;
            row_axpy8(acc, qa.r0, RLF(act, 0)); row_axpy8(acc, qa.r1, RLF(act, 4)); row_axpy8(acc, qa.r2, RLF(act, 8)); row_axpy8(acc, qa.r3, RLF(act, 12));
            row_axpy8(acc, qa.r4, RLF(act, 16)); row_axpy8(acc, qa.r5, RLF(act, 20)); row_axpy8(acc, qa.r6, RLF(act, 24)); row_axpy8(acc, qa.r7, RLF(act, 28));
            row_axpy8(acc, qb.r0, RLF(act, 32)); row_axpy8(acc, qb.r1, RLF(act, 36)); row_axpy8(acc, qb.r2, RLF(act, 40)); row_axpy8(acc, qb.r3, RLF(act, 44));
            row_axpy8(acc, qb.r4, RLF(act, 48)); row_axpy8(acc, qb.r5, RLF(act, 52)); row_axpy8(acc, qb.r6, RLF(act, 56)); row_axpy8(acc, qb.r7, RLF(act, 60));
        }
        const float* xi = a.Xin + (size_t)tok * DM + lane * 16;
        float* xo = a.Xout + (size_t)tok * DM + lane * 16;
        float4 x0 = *(const float4*)xi, x1 = *(const float4*)(xi + 4), x2 = *(const float4*)(xi + 8), x3 = *(const float4*)(xi + 12);
        x0.x += acc[0]; x0.y += acc[1]; x0.z += acc[2]; x0.w += acc[3]; x1.x += acc[4]; x1.y += acc[5]; x1.z += acc[6]; x1.w += acc[7];
        x2.x += acc[8]; x2.y += acc[9]; x2.z += acc[10]; x2.w += acc[11]; x3.x += acc[12]; x3.y += acc[13]; x3.z += acc[14]; x3.w += acc[15];
        if (a.final_norm) {
            float ss = x0.x * x0.x + x0.y * x0.y + x0.z * x0.z + x0.w * x0.w + x1.x * x1.x + x1.y * x1.y + x1.z * x1.z + x1.w * x1.w
                     + x2.x * x2.x + x2.y * x2.y + x2.z * x2.z + x2.w * x2.w + x3.x * x3.x + x3.y * x3.y + x3.z * x3.z + x3.w * x3.w;
            ss = wave_sum(ss, lane);
            const float rf = rsqrtf(ss * (1.f / 1024.f) + 1e-6f);
            const float* gf = a.gfinal + lane * 16;
            const float4 g0 = *(const float4*)gf, g1 = *(const float4*)(gf + 4), g2 = *(const float4*)(gf + 8), g3 = *(const float4*)(gf + 12);
            x0.x *= rf * g0.x; x0.y *= rf * g0.y; x0.z *= rf * g0.z; x0.w *= rf * g0.w; x1.x *= rf * g1.x; x1.y *= rf * g1.y; x1.z *= rf * g1.z; x1.w *= rf * g1.w;
            x2.x *= rf * g2.x; x2.y *= rf * g2.y; x2.z *= rf * g2.z; x2.w *= rf * g2.w; x3.x *= rf * g3.x; x3.y *= rf * g3.y; x3.z *= rf * g3.z; x3.w *= rf * g3.w;
        }
        *(float4*)xo = x0; *(float4*)(xo + 4) = x1; *(float4*)(xo + 8) = x2; *(float4*)(xo + 12) = x3;
    }
}
#define XB_TMO      128
#define XB_XCNT(j)  (256  + 64 * (j))
#define XB_XSUB(j)  (1280 + 64 * (j))
#define XB_XGEN(j)  (2304 + 64 * (j))
#define XB_TOP      3328
#define XB_TOPGEN   3392
#define XB_QUEUE(j) (3456 + 64 * (j))
#define XCD_BAR_WORDS (3456 + 64 * 64)
#define XB_SPIN_CAP (1u << 20)
#define LAS __attribute__((address_space(3)))

DI unsigned xb_ld(unsigned* p)              { return __hip_atomic_load(p, __ATOMIC_RELAXED, __HIP_MEMORY_SCOPE_AGENT); }
DI unsigned xb_add(unsigned* p, unsigned v) { return __hip_atomic_fetch_add(p, v, __ATOMIC_RELAXED, __HIP_MEMORY_SCOPE_AGENT); }
DI unsigned xb_xcc_id() { return (unsigned)__builtin_amdgcn_s_getreg((3 << 11) | 20) & 0xFu; }
#define XB_SPIN(cond, bar) do { unsigned _sp = 0; while (cond) { __builtin_amdgcn_s_sleep(1); \
    if ((++_sp & 255u) == 0u) { if (xb_ld(&(bar)[XB_TMO])) break; if (_sp > XB_SPIN_CAP) { atomicAdd(&(bar)[XB_TMO], 1u); break; } } } } while (0)

struct XcdBarrier { unsigned* bar; unsigned x; volatile LAS unsigned* st; };

DI XcdBarrier xcd_barrier_post(unsigned* bar, volatile LAS unsigned* st, int tid) {
    XcdBarrier b; b.bar = bar; b.x = xb_xcc_id(); b.st = st;
    if (tid == 0) st[2] = xb_add(&bar[XB_XCNT(b.x)], 1u);
    return b;
}
DI void xcd_barrier_complete(unsigned* bar, unsigned x, unsigned& nloc, unsigned& nx) {
    const unsigned G = gridDim.x * gridDim.y * gridDim.z;
    unsigned sum, cnt, mine, sp = 0u;
    for (;;) {
        sum = 0u; cnt = 0u; mine = 0u;
#pragma unroll
        for (unsigned j = 0; j < 16; ++j) { const unsigned c = xb_ld(&bar[XB_XCNT(j)]); sum += c; cnt += (c > 0u) ? 1u : 0u; mine = (j == x) ? c : mine; }
        if (sum == G) break;
        __builtin_amdgcn_s_sleep(1);
        if ((++sp & 255u) == 0u) { if (xb_ld(&bar[XB_TMO])) break; if (sp > XB_SPIN_CAP) { atomicAdd(&bar[XB_TMO], 1u); break; } }
    }
    nloc = mine > 0u ? mine : 1u; nx = cnt > 0u ? cnt : 1u;
}
DI void xcd_barrier(const XcdBarrier& b, int wid) {
    asm volatile("s_waitcnt vmcnt(0)" ::: "memory");
    __syncthreads();
    if (get_tid(wid) == 0) {
        unsigned* bar = b.bar;
        __builtin_amdgcn_s_waitcnt(0);
        unsigned nloc = b.st[0], nx = b.st[1];
        if (nloc == 0u) { xcd_barrier_complete(bar, b.x, nloc, nx); b.st[0] = nloc; b.st[1] = nx; }
        const unsigned old = xb_add(&bar[XB_XSUB(b.x)], 1u);
        const unsigned gen = old / nloc;
        if (old + 1u == (gen + 1u) * nloc) {
            __builtin_amdgcn_fence(__ATOMIC_RELEASE, "agent");
            asm volatile("s_waitcnt vmcnt(0)" ::: "memory");
            const unsigned og = xb_add(&bar[XB_TOP], 1u);
            const unsigned tg = og / nx;
            if (og + 1u == (tg + 1u) * nx) xb_add(&bar[XB_TOPGEN], 1u);
            else XB_SPIN(xb_ld(&bar[XB_TOPGEN]) == tg, bar);
            __builtin_amdgcn_fence(__ATOMIC_ACQUIRE, "agent");
            xb_add(&bar[XB_XGEN(b.x)], 1u);
            asm volatile("s_waitcnt vmcnt(0)" ::: "memory");
        } else {
            XB_SPIN(xb_ld(&bar[XB_XGEN(b.x)]) == gen, bar);
            __builtin_amdgcn_fence(__ATOMIC_ACQUIRE, "agent");
            asm volatile("s_waitcnt vmcnt(0)" ::: "memory");
        }
    }
    __syncthreads();
}
#ifndef U_FP4
#define U_FP4 1
#endif
#if U_FP4
#define NUSL 4
#else
#define NUSL 8
#endif
struct PSArgs {
    const bf16_t* Hb; const float* RSTD; const unsigned short* EX; const float* GT; const fp8_t* U8; const fp8_t* V8; const float* SU; const float* SV;
    float* PD; bf16_t* COEF; const float* Xin; float* Xout; const unsigned* HPH; const unsigned* HPL; const float* HS;
};

DI void dot4p(unsigned w, const f2_t& h01, const f2_t& h23, f2_t& s2) {
    const f2_t lo = __builtin_amdgcn_cvt_pk_f32_fp8(w, false), hi = __builtin_amdgcn_cvt_pk_f32_fp8(w, true);
    s2 = __builtin_elementwise_fma(lo, h01, s2); s2 = __builtin_elementwise_fma(hi, h23, s2);
}
DI float row_dot8p(const u32x4& r, const f2_t (&h)[8]) {
    f2_t s2 = {0.f, 0.f};
    dot4p(r.x, h[0], h[1], s2); dot4p(r.y, h[2], h[3], s2); dot4p(r.z, h[4], h[5], s2); dot4p(r.w, h[6], h[7], s2);
    return s2.x + s2.y;
}
DI void axpy4p(unsigned w, const f2_t& c2, f2_t& a01, f2_t& a23) {
    const f2_t lo = __builtin_amdgcn_cvt_pk_f32_fp8(w, false), hi = __builtin_amdgcn_cvt_pk_f32_fp8(w, true);
    a01 = __builtin_elementwise_fma(c2, lo, a01); a23 = __builtin_elementwise_fma(c2, hi, a23);
}
DI void row_axpy8p(f2_t (&acc)[8], const u32x4& r, float c) {
    const f2_t c2 = {c, c};
    axpy4p(r.x, c2, acc[0], acc[1]); axpy4p(r.y, c2, acc[2], acc[3]); axpy4p(r.z, c2, acc[4], acc[5]); axpy4p(r.w, c2, acc[6], acc[7]);
}

DI int run_token(int n, int k, int nloc, int wid) { return (k + (n >> 3) * nloc) * 64 + wid * 8 + (n & 7); }

struct Ids16 { u32x4 a, b; };
DI void ids_load(Ids16& q, const unsigned short* EX, int tok, int rg) { const u32x4* p = (const u32x4*)(EX + (size_t)tok * 128 + rg * 16); q.a = p[0]; q.b = p[1]; }
#define ID_LO(w) (((w) & 0xFFFFu) * 128u + loff)
#define ID_HI(w) (((w) >> 16) * 128u + loff)
DI void rows_lo(u32x4 (&r)[8], const Ids16& q, const fp8_t* tab, unsigned loff) {
    r[0] = *(grow_t)(tab + ID_LO(q.a.x)); r[1] = *(grow_t)(tab + ID_HI(q.a.x)); r[2] = *(grow_t)(tab + ID_LO(q.a.y)); r[3] = *(grow_t)(tab + ID_HI(q.a.y));
    r[4] = *(grow_t)(tab + ID_LO(q.a.z)); r[5] = *(grow_t)(tab + ID_HI(q.a.z)); r[6] = *(grow_t)(tab + ID_LO(q.a.w)); r[7] = *(grow_t)(tab + ID_HI(q.a.w));
}
DI void rows_hi(u32x4 (&r)[8], const Ids16& q, const fp8_t* tab, unsigned loff) {
    r[0] = *(grow_t)(tab + ID_LO(q.b.x)); r[1] = *(grow_t)(tab + ID_HI(q.b.x)); r[2] = *(grow_t)(tab + ID_LO(q.b.y)); r[3] = *(grow_t)(tab + ID_HI(q.b.y));
    r[4] = *(grow_t)(tab + ID_LO(q.b.z)); r[5] = *(grow_t)(tab + ID_HI(q.b.z)); r[6] = *(grow_t)(tab + ID_LO(q.b.w)); r[7] = *(grow_t)(tab + ID_HI(q.b.w));
}
DI void unpack_h(f2_t (&h)[8], const u32x4& h0, const u32x4& h1) {
    h[0] = (f2_t){bf_lo(h0.x), bf_hi(h0.x)}; h[1] = (f2_t){bf_lo(h0.y), bf_hi(h0.y)}; h[2] = (f2_t){bf_lo(h0.z), bf_hi(h0.z)}; h[3] = (f2_t){bf_lo(h0.w), bf_hi(h0.w)};
    h[4] = (f2_t){bf_lo(h1.x), bf_hi(h1.x)}; h[5] = (f2_t){bf_lo(h1.y), bf_hi(h1.y)}; h[6] = (f2_t){bf_lo(h1.z), bf_hi(h1.z)}; h[7] = (f2_t){bf_lo(h1.w), bf_hi(h1.w)};
}
DI void dots8(float* p, const u32x4 (&r)[8], const f2_t (&h)[8]) {
#pragma unroll
    for (int i = 0; i < 8; ++i) { p[i] = row_dot8p(r[i], h); if ((i & 1) == 1) __builtin_amdgcn_sched_barrier(0); }
}
DI void peerU_finish(const PSArgs& a, float (&p)[16], int tok, int s, int lane) {
    const int rg = lane >> 3, pc = lane & 7;
    const bool b2 = pc & 4, b1 = pc & 2, b0 = pc & 1;
    float q8[8], q4[4], q2[2];
#pragma unroll
    for (int k = 0; k < 8; ++k) { const float keep = b2 ? p[k + 8] : p[k], send = b2 ? p[k] : p[k + 8]; q8[k] = keep + shx<4>(send, lane); }
#pragma unroll
    for (int k = 0; k < 4; ++k) { const float keep = b1 ? q8[k + 4] : q8[k], send = b1 ? q8[k] : q8[k + 4]; q4[k] = keep + shx<2>(send, lane); }
#pragma unroll
    for (int k = 0; k < 2; ++k) { const float keep = b0 ? q4[k + 2] : q4[k], send = b0 ? q4[k] : q4[k + 2]; q2[k] = keep + shx<1>(send, lane); }
    *(float2*)(a.PD + ((size_t)s * NTOK + tok) * 128 + rg * 16 + 2 * pc) = make_float2(q2[0], q2[1]);
}

DI void peerU_run(const PSArgs& a, int s, int k, int nloc, int wid) {
    const int tid = get_tid(wid);
    const int lane = tid & 63, rg = lane >> 3, pc = lane & 7;
    const unsigned loff = (unsigned)(s * (NEXP * 128) + pc * 16);
    const int hoff = s * 128 + pc * 16;
    const int N = 8 * ((NTOK / 64 - k + nloc - 1) / nloc);
    Ids16 idE, idO;
    u32x4 rA[8], rB[8], hE0, hE1, hO0, hO1;
#define LOAD_H(d0, d1, tokv) { const u32x4* hp_ = (const u32x4*)(a.Hb + (size_t)(tokv) * DM + hoff); d0 = hp_[0]; d1 = hp_[1]; }
    ids_load(idE, a.EX, run_token(0, k, nloc, wid), rg);
    ids_load(idO, a.EX, run_token(1, k, nloc, wid), rg);
    rows_lo(rA, idE, a.U8, loff); LOAD_H(hE0, hE1, run_token(0, k, nloc, wid)); rows_hi(rB, idE, a.U8, loff);
#pragma unroll 1
    for (int n = 0; n < N; n += 2) {
        const int t0 = run_token(n, k, nloc, wid), t1 = run_token(n + 1, k, nloc, wid);
        const int t2 = run_token((n + 2 < N) ? n + 2 : N - 1, k, nloc, wid), t3 = run_token((n + 3 < N) ? n + 3 : N - 1, k, nloc, wid);
        {
            f2_t h[8]; float p[16];
            unpack_h(h, hE0, hE1);
            dots8(p, rA, h);
            rows_lo(rA, idO, a.U8, loff); LOAD_H(hO0, hO1, t1);
            dots8(p + 8, rB, h);
            rows_hi(rB, idO, a.U8, loff);
            ids_load(idE, a.EX, t2, rg);
            peerU_finish(a, p, t0, s, lane);
        }
        {
            f2_t h[8]; float p[16];
            unpack_h(h, hO0, hO1);
            dots8(p, rA, h);
            rows_lo(rA, idE, a.U8, loff); LOAD_H(hE0, hE1, t2);
            dots8(p + 8, rB, h);
            rows_hi(rB, idE, a.U8, loff);
            ids_load(idO, a.EX, t3, rg);
            peerU_finish(a, p, t1, s, lane);
        }
    }
#undef LOAD_H
}

DI void peerR_tile(const PSArgs& a, int tile, int wid) {
    const int tid = get_tid(wid);
    const int lane = tid & 63;
#pragma unroll 1
    for (int ti = 0; ti < 8; ++ti) {
        const int tok = tile * 64 + wid * 8 + ti;
        float d0 = 0.f, d1 = 0.f;
#pragma unroll
        for (int x = 0; x < NUSL; ++x) { const float2 v = *(const float2*)(a.PD + ((size_t)x * NTOK + tok) * 128 + 2 * lane); d0 += v.x; d1 += v.y; }
        const unsigned exw = *(const unsigned*)(a.EX + (size_t)tok * 128 + 2 * lane);
        const int2 ex = make_int2((int)(exw & 0xFFFFu), (int)(exw >> 16));
        const float2 gt = *(const float2*)(a.GT + (size_t)tok * 128 + 2 * lane);
        const float rs = a.RSTD[tok];
        float2 o;
        o.x = gelu_exact(d0 * a.SU[ex.x] * rs) * gt.x * a.SV[ex.x];
        o.y = gelu_exact(d1 * a.SU[ex.y] * rs) * gt.y * a.SV[ex.y];
        *(unsigned*)(a.COEF + (size_t)tok * 128 + 2 * lane) = pack_bf2(o.x, o.y);
    }
}

struct Cf16 { u32x4 a, b; };
DI void cf_load(Cf16& q, const bf16_t* COEF, int tok, int rg) { const u32x4* p = (const u32x4*)(COEF + (size_t)tok * 128 + rg * 16); q.a = p[0]; q.b = p[1]; }
DI void axpy8(f2_t (&acc)[8], const u32x4 (&r)[8], const u32x4& c) {
    row_axpy8p(acc, r[0], bf_lo(c.x)); row_axpy8p(acc, r[1], bf_hi(c.x)); __builtin_amdgcn_sched_barrier(0);
    row_axpy8p(acc, r[2], bf_lo(c.y)); row_axpy8p(acc, r[3], bf_hi(c.y)); __builtin_amdgcn_sched_barrier(0);
    row_axpy8p(acc, r[4], bf_lo(c.z)); row_axpy8p(acc, r[5], bf_hi(c.z)); __builtin_amdgcn_sched_barrier(0);
    row_axpy8p(acc, r[6], bf_lo(c.w)); row_axpy8p(acc, r[7], bf_hi(c.w)); __builtin_amdgcn_sched_barrier(0);
}
DI void peerV_finish(const PSArgs& a, f2_t (&acc)[8], float2 xv, int tok, int s, int lane) {
    const int rg = lane >> 3, pc = lane & 7;
    const bool r2 = rg & 4, r1 = rg & 2, r0 = rg & 1;
    f2_t q4[4], q2[2], q1;
#pragma unroll
    for (int k = 0; k < 4; ++k) {
        const f2_t keep = r2 ? acc[k + 4] : acc[k], send = r2 ? acc[k] : acc[k + 4];
        q4[k] = (f2_t){keep.x + shx<32>(send.x, lane), keep.y + shx<32>(send.y, lane)};
    }
#pragma unroll
    for (int k = 0; k < 2; ++k) {
        const f2_t keep = r1 ? q4[k + 2] : q4[k], send = r1 ? q4[k] : q4[k + 2];
        q2[k] = (f2_t){keep.x + shx<16>(send.x, lane), keep.y + shx<16>(send.y, lane)};
    }
    {
        const f2_t keep = r0 ? q2[1] : q2[0], send = r0 ? q2[0] : q2[1];
        q1 = (f2_t){keep.x + shx<8>(send.x, lane), keep.y + shx<8>(send.y, lane)};
    }
    xv.x += q1.x; xv.y += q1.y;
    *(float2*)(a.Xout + (size_t)tok * DM + s * 128 + 16 * pc + 2 * rg) = xv;
}

DI void peerV_run(const PSArgs& a, int s, int k, int nloc, int wid) {
    const int tid = get_tid(wid);
    const int lane = tid & 63, rg = lane >> 3, pc = lane & 7;
    const unsigned loff = (unsigned)(s * (NEXP * 128) + pc * 16);
    const int N = 8 * ((NTOK / 64 - k + nloc - 1) / nloc);
    Ids16 idE, idO; Cf16 cfE, cfO; float2 xE, xO;
    u32x4 rA[8], rB[8];
#define LOAD_X(x_, tokv) { x_ = *(const float2*)(a.Xin + (size_t)(tokv) * DM + s * 128 + 16 * pc + 2 * rg); }
    ids_load(idE, a.EX, run_token(0, k, nloc, wid), rg);
    ids_load(idO, a.EX, run_token(1, k, nloc, wid), rg);
    rows_lo(rA, idE, a.V8, loff); cf_load(cfE, a.COEF, run_token(0, k, nloc, wid), rg); rows_hi(rB, idE, a.V8, loff); LOAD_X(xE, run_token(0, k, nloc, wid));
#pragma unroll 1
    for (int n = 0; n < N; n += 2) {
        const int t0 = run_token(n, k, nloc, wid), t1 = run_token(n + 1, k, nloc, wid);
        const int t2 = run_token((n + 2 < N) ? n + 2 : N - 1, k, nloc, wid), t3 = run_token((n + 3 < N) ? n + 3 : N - 1, k, nloc, wid);
        {
            f2_t acc[8];
#pragma unroll
            for (int i = 0; i < 8; ++i) acc[i] = (f2_t){0.f, 0.f};
            axpy8(acc, rA, cfE.a);
            rows_lo(rA, idO, a.V8, loff); cf_load(cfO, a.COEF, t1, rg);
            axpy8(acc, rB, cfE.b);
            rows_hi(rB, idO, a.V8, loff); LOAD_X(xO, t1);
            ids_load(idE, a.EX, t2, rg);
            peerV_finish(a, acc, xE, t0, s, lane);
        }
        {
            f2_t acc[8];
#pragma unroll
            for (int i = 0; i < 8; ++i) acc[i] = (f2_t){0.f, 0.f};
            axpy8(acc, rA, cfO.a);
            rows_lo(rA, idE, a.V8, loff); cf_load(cfE, a.COEF, t2, rg);
            axpy8(acc, rB, cfO.b);
            rows_hi(rB, idE, a.V8, loff); LOAD_X(xE, t2);
            ids_load(idO, a.EX, t3, rg);
            peerV_finish(a, acc, xO, t1, s, lane);
        }
    }
#undef LOAD_X
}

DI void final_norm_tile(float* X, const float* __restrict__ g, int tile, int wid) {
    const int tid = get_tid(wid);
    const int lane = tid & 63;
    const float* gf = g + lane * 16;
    const float4 g0 = *(const float4*)gf, g1 = *(const float4*)(gf + 4), g2 = *(const float4*)(gf + 8), g3 = *(const float4*)(gf + 12);
#pragma unroll 1
    for (int ti = 0; ti < 8; ++ti) {
        float* xp = X + (size_t)(tile * 64 + wid * 8 + ti) * DM + lane * 16;
        float4 x0 = *(const float4*)xp, x1 = *(const float4*)(xp + 4), x2 = *(const float4*)(xp + 8), x3 = *(const float4*)(xp + 12);
        float ss = x0.x * x0.x + x0.y * x0.y + x0.z * x0.z + x0.w * x0.w + x1.x * x1.x + x1.y * x1.y + x1.z * x1.z + x1.w * x1.w
                 + x2.x * x2.x + x2.y * x2.y + x2.z * x2.z + x2.w * x2.w + x3.x * x3.x + x3.y * x3.y + x3.z * x3.z + x3.w * x3.w;
        ss = wave_sum(ss, lane);
        const float rf = rsqrtf(ss * (1.f / 1024.f) + 1e-6f);
        x0.x *= rf * g0.x; x0.y *= rf * g0.y; x0.z *= rf * g0.z; x0.w *= rf * g0.w; x1.x *= rf * g1.x; x1.y *= rf * g1.y; x1.z *= rf * g1.z; x1.w *= rf * g1.w;
        x2.x *= rf * g2.x; x2.y *= rf * g2.y; x2.z *= rf * g2.z; x2.w *= rf * g2.w; x3.x *= rf * g3.x; x3.y *= rf * g3.y; x3.z *= rf * g3.z; x3.w *= rf * g3.w;
        *(float4*)xp = x0; *(float4*)(xp + 4) = x1; *(float4*)(xp + 8) = x2; *(float4*)(xp + 12) = x3;
    }
}

typedef unsigned char fp4x2_t;
DI void conv_row_fp4_one(float4 v0, float4 v1, float4 v2, float4 v3, fp4x2_t* __restrict__ dst, float* __restrict__ scales, int nrows, int row, int lane) {
    float m = fmaxf(fmaxf(fmaxf(fabsf(v0.x), fabsf(v0.y)), fmaxf(fabsf(v0.z), fabsf(v0.w))), fmaxf(fmaxf(fabsf(v1.x), fabsf(v1.y)), fmaxf(fabsf(v1.z), fabsf(v1.w))));
    m = fmaxf(m, fmaxf(fmaxf(fmaxf(fabsf(v2.x), fabsf(v2.y)), fmaxf(fabsf(v2.z), fabsf(v2.w))), fmaxf(fmaxf(fabsf(v3.x), fabsf(v3.y)), fmaxf(fabsf(v3.z), fabsf(v3.w)))));
    m = fmaxf(m, shx<1>(m, lane)); m = fmaxf(m, shx<2>(m, lane)); m = fmaxf(m, shx<4>(m, lane)); m = fmaxf(m, shx<8>(m, lane)); m = fmaxf(m, shx<16>(m, lane)); m = fmaxf(m, shx<32>(m, lane));
    const float sc = (m > 0.f) ? m * (1.f / 6.f) : 1.f;
    const float inv = 1.f / sc;
    unsigned d0 = 0u, d1 = 0u;
    d0 = __builtin_amdgcn_cvt_scalef32_pk_fp4_f32(d0, v0.x * inv, v0.y * inv, 1.0f, 0); d0 = __builtin_amdgcn_cvt_scalef32_pk_fp4_f32(d0, v0.z * inv, v0.w * inv, 1.0f, 1);
    d0 = __builtin_amdgcn_cvt_scalef32_pk_fp4_f32(d0, v1.x * inv, v1.y * inv, 1.0f, 2); d0 = __builtin_amdgcn_cvt_scalef32_pk_fp4_f32(d0, v1.z * inv, v1.w * inv, 1.0f, 3);
    d1 = __builtin_amdgcn_cvt_scalef32_pk_fp4_f32(d1, v2.x * inv, v2.y * inv, 1.0f, 0); d1 = __builtin_amdgcn_cvt_scalef32_pk_fp4_f32(d1, v2.z * inv, v2.w * inv, 1.0f, 1);
    d1 = __builtin_amdgcn_cvt_scalef32_pk_fp4_f32(d1, v3.x * inv, v3.y * inv, 1.0f, 2); d1 = __builtin_amdgcn_cvt_scalef32_pk_fp4_f32(d1, v3.z * inv, v3.w * inv, 1.0f, 3);
    *(uint2*)(dst + ((size_t)(lane >> 4) * nrows + row) * 128 + (lane & 15) * 8) = make_uint2(d0, d1);
    if (lane == 0) scales[row] = sc;
}
DI void conv_rows_fp4(const float* __restrict__ src, fp4x2_t* __restrict__ dst, float* __restrict__ scales, int nrows, int gwave, int nwaves, int lane) {
#pragma unroll 1
    for (int row = gwave; row < nrows; row += 2 * nwaves) {
        const int r1 = min(row + nwaves, nrows - 1);
        const float4* p0 = (const float4*)(src + (size_t)row * DM + lane * 16);
        const float4* p1 = (const float4*)(src + (size_t)r1 * DM + lane * 16);
        const float4 a0 = p0[0], a1 = p0[1], a2 = p0[2], a3 = p0[3];
        const float4 b0 = p1[0], b1 = p1[1], b2 = p1[2], b3 = p1[3];
        conv_row_fp4_one(a0, a1, a2, a3, dst, scales, nrows, row, lane);
        conv_row_fp4_one(b0, b1, b2, b3, dst, scales, nrows, r1, lane);
    }
}

typedef __attribute__((ext_vector_type(2))) _Float16 h2_t;
DI h2_t cvt4(unsigned w, int b) {
    return b == 0 ? __builtin_amdgcn_cvt_scalef32_pk_f16_fp4(w, 1.0f, 0) : b == 1 ? __builtin_amdgcn_cvt_scalef32_pk_f16_fp4(w, 1.0f, 1)
         : b == 2 ? __builtin_amdgcn_cvt_scalef32_pk_f16_fp4(w, 1.0f, 2) : __builtin_amdgcn_cvt_scalef32_pk_f16_fp4(w, 1.0f, 3);
}
DI void row_axpy32h(h2_t (&acc)[16], const u32x4& r, float c) {
    const _Float16 ch = (_Float16)c; const h2_t c2 = {ch, ch};
#pragma unroll
    for (int b = 0; b < 4; ++b) {
        acc[b] = __builtin_elementwise_fma(c2, cvt4(r.x, b), acc[b]); acc[4 + b] = __builtin_elementwise_fma(c2, cvt4(r.y, b), acc[4 + b]);
        acc[8 + b] = __builtin_elementwise_fma(c2, cvt4(r.z, b), acc[8 + b]); acc[12 + b] = __builtin_elementwise_fma(c2, cvt4(r.w, b), acc[12 + b]);
    }
}
DI void axpy8_4(h2_t (&acc)[16], const u32x4 (&r)[8], const u32x4& c) {
    row_axpy32h(acc, r[0], bf_lo(c.x)); row_axpy32h(acc, r[1], bf_hi(c.x)); row_axpy32h(acc, r[2], bf_lo(c.y)); row_axpy32h(acc, r[3], bf_hi(c.y));
    __builtin_amdgcn_sched_barrier(0);
    row_axpy32h(acc, r[4], bf_lo(c.z)); row_axpy32h(acc, r[5], bf_hi(c.z)); row_axpy32h(acc, r[6], bf_lo(c.w)); row_axpy32h(acc, r[7], bf_hi(c.w));
    __builtin_amdgcn_sched_barrier(0);
}
typedef __attribute__((ext_vector_type(2))) unsigned u32x2_t;
DI h2_t pairsum32(h2_t x, h2_t y) { auto r = __builtin_amdgcn_permlane32_swap(__builtin_bit_cast(unsigned, x), __builtin_bit_cast(unsigned, y), false, false);
                                   return __builtin_bit_cast(h2_t, (unsigned)r[0]) + __builtin_bit_cast(h2_t, (unsigned)r[1]); }
DI h2_t pairsum16(h2_t x, h2_t y) { auto r = __builtin_amdgcn_permlane16_swap(__builtin_bit_cast(unsigned, x), __builtin_bit_cast(unsigned, y), false, false);
                                   return __builtin_bit_cast(h2_t, (unsigned)r[0]) + __builtin_bit_cast(h2_t, (unsigned)r[1]); }
DI h2_t pairsum8(h2_t x, h2_t y, bool hi) {
    const h2_t keep = hi ? y : x, send = hi ? x : y;
    const int rcv = __builtin_amdgcn_update_dpp(0, __builtin_bit_cast(int, send), 0x128, 0xF, 0xF, true);
    return keep + __builtin_bit_cast(h2_t, rcv);
}
DI void peerV4_finish(const PSArgs& a, h2_t (&acc)[16], float4 xv, int tok, int s4, int lane) {
    const int rg = lane >> 3, pc = lane & 7;
    h2_t q8[8], q4[4], q2[2];
#ifndef FINV
#define FINV 7
#endif
    const bool r2 = rg & 4, r1 = rg & 2, r0 = rg & 1;
#pragma unroll
    for (int k = 0; k < 8; ++k) {
        if (FINV & 1) q8[k] = pairsum32(acc[k], acc[k + 8]);
        else { const h2_t keep = r2 ? acc[k + 8] : acc[k], send = r2 ? acc[k] : acc[k + 8]; q8[k] = keep + __builtin_bit_cast(h2_t, shx_i<32>(__builtin_bit_cast(int, send), lane)); }
    }
#pragma unroll
    for (int k = 0; k < 4; ++k) {
        if (FINV & 2) q4[k] = pairsum16(q8[k], q8[k + 4]);
        else { const h2_t keep = r1 ? q8[k + 4] : q8[k], send = r1 ? q8[k] : q8[k + 4]; q4[k] = keep + __builtin_bit_cast(h2_t, shx_i<16>(__builtin_bit_cast(int, send), lane)); }
    }
#pragma unroll
    for (int k = 0; k < 2; ++k) {
        if (FINV & 4) q2[k] = pairsum8(q4[k], q4[k + 2], r0);
        else { const h2_t keep = r0 ? q4[k + 2] : q4[k], send = r0 ? q4[k] : q4[k + 2]; q2[k] = keep + __builtin_bit_cast(h2_t, shx_i<8>(__builtin_bit_cast(int, send), lane)); }
    }
    xv.x += (float)q2[0].x; xv.y += (float)q2[0].y; xv.z += (float)q2[1].x; xv.w += (float)q2[1].y;
    *(float4*)(a.Xout + (size_t)tok * DM + s4 * 256 + 32 * pc + 4 * rg) = xv;
}
DI int run_token2(int n, int k, int nloc, int wid, int th) { return (2 * (k + (n >> 3) * nloc) + th) * 64 + wid * 8 + (n & 7); }

DI void peerV4_run(const PSArgs& a, const fp4x2_t* V4, int s4, int th, int k, int nloc, int wid) {
    const int tid = get_tid(wid);
    const int lane = tid & 63, rg = lane >> 3, pc = lane & 7;
    const unsigned loff = (unsigned)(s4 * (NEXP * 128) + pc * 16);
    const int N = 8 * ((NTOK / 128 - k + nloc - 1) / nloc);
    if (N <= 0) return;
    Ids16 idE, idO; Cf16 cfE, cfO; float4 xE, xO;
    u32x4 rA[8], rB[8];
    const fp8_t* tab = (const fp8_t*)V4;
#define LOAD_X4(x_, tokv) { x_ = *(const float4*)(a.Xin + (size_t)(tokv) * DM + s4 * 256 + 32 * pc + 4 * rg); }
    ids_load(idE, a.EX, run_token2(0, k, nloc, wid, th), rg);
    ids_load(idO, a.EX, run_token2(1, k, nloc, wid, th), rg);
    rows_lo(rA, idE, tab, loff); cf_load(cfE, a.COEF, run_token2(0, k, nloc, wid, th), rg); rows_hi(rB, idE, tab, loff); LOAD_X4(xE, run_token2(0, k, nloc, wid, th));
#pragma unroll 1
    for (int n = 0; n < N; n += 2) {
        const int t0 = run_token2(n, k, nloc, wid, th), t1 = run_token2(n + 1, k, nloc, wid, th);
        const int t2 = run_token2((n + 2 < N) ? n + 2 : N - 1, k, nloc, wid, th), t3 = run_token2((n + 3 < N) ? n + 3 : N - 1, k, nloc, wid, th);
        {
            h2_t acc[16];
#pragma unroll
            for (int i = 0; i < 16; ++i) acc[i] = (h2_t){(_Float16)0.f, (_Float16)0.f};
            axpy8_4(acc, rA, cfE.a);
            rows_lo(rA, idO, tab, loff); cf_load(cfO, a.COEF, t1, rg);
            axpy8_4(acc, rB, cfE.b);
            rows_hi(rB, idO, tab, loff); LOAD_X4(xO, t1);
            ids_load(idE, a.EX, t2, rg);
            peerV4_finish(a, acc, xE, t0, s4, lane);
        }
        {
            h2_t acc[16];
#pragma unroll
            for (int i = 0; i < 16; ++i) acc[i] = (h2_t){(_Float16)0.f, (_Float16)0.f};
            axpy8_4(acc, rA, cfO.a);
            rows_lo(rA, idE, tab, loff); cf_load(cfE, a.COEF, t2, rg);
            axpy8_4(acc, rB, cfO.b);
            rows_hi(rB, idE, tab, loff); LOAD_X4(xE, t2);
            ids_load(idO, a.EX, t3, rg);
            peerV4_finish(a, acc, xO, t1, s4, lane);
        }
    }
#undef LOAD_X4
}

DI void conv_rows_fp4g(const float* __restrict__ src, const float* __restrict__ gain, fp4x2_t* __restrict__ dst, float* __restrict__ scales,
                       int nrows, int gwave, int nwaves, int lane) {
    const float4* g = (const float4*)(gain + lane * 16);
    const float4 g0 = g[0], g1 = g[1], g2 = g[2], g3 = g[3];
#pragma unroll 1
    for (int row = gwave; row < nrows; row += 2 * nwaves) {
        const int r1 = min(row + nwaves, nrows - 1);
        const float4* p0 = (const float4*)(src + (size_t)row * DM + lane * 16);
        const float4* p1 = (const float4*)(src + (size_t)r1 * DM + lane * 16);
        float4 a0 = p0[0], a1 = p0[1], a2 = p0[2], a3 = p0[3];
        float4 b0 = p1[0], b1 = p1[1], b2 = p1[2], b3 = p1[3];
        a0.x *= g0.x; a0.y *= g0.y; a0.z *= g0.z; a0.w *= g0.w; a1.x *= g1.x; a1.y *= g1.y; a1.z *= g1.z; a1.w *= g1.w;
        a2.x *= g2.x; a2.y *= g2.y; a2.z *= g2.z; a2.w *= g2.w; a3.x *= g3.x; a3.y *= g3.y; a3.z *= g3.z; a3.w *= g3.w;
        b0.x *= g0.x; b0.y *= g0.y; b0.z *= g0.z; b0.w *= g0.w; b1.x *= g1.x; b1.y *= g1.y; b1.z *= g1.z; b1.w *= g1.w;
        b2.x *= g2.x; b2.y *= g2.y; b2.z *= g2.z; b2.w *= g2.w; b3.x *= g3.x; b3.y *= g3.y; b3.z *= g3.z; b3.w *= g3.w;
        conv_row_fp4_one(a0, a1, a2, a3, dst, scales, nrows, row, lane);
        conv_row_fp4_one(b0, b1, b2, b3, dst, scales, nrows, r1, lane);
    }
}
DI float row_dot32h(const u32x4& r, const h2_t (&h)[16]) {
    float s0 = 0.f, s1 = 0.f;
#pragma unroll
    for (int b = 0; b < 4; ++b) {
        s0 = __builtin_amdgcn_fdot2(cvt4(r.x, b), h[b], s0, false); s1 = __builtin_amdgcn_fdot2(cvt4(r.y, b), h[4 + b], s1, false);
        s0 = __builtin_amdgcn_fdot2(cvt4(r.z, b), h[8 + b], s0, false); s1 = __builtin_amdgcn_fdot2(cvt4(r.w, b), h[12 + b], s1, false);
    }
    return s0 + s1;
}
DI void dots8_4(float* p, const u32x4 (&r)[8], const h2_t (&h)[16]) {
#pragma unroll
    for (int i = 0; i < 8; ++i) { p[i] = row_dot32h(r[i], h); if ((i & 3) == 3) __builtin_amdgcn_sched_barrier(0); }
}
struct H32 { u32x4 a, b, c, d; };
DI void h32_load(H32& q, const bf16_t* Hb, int tok, int hoff) { const u32x4* p = (const u32x4*)(Hb + (size_t)tok * DM + hoff); q.a = p[0]; q.b = p[1]; q.c = p[2]; q.d = p[3]; }
DI h2_t bf2_to_h2(unsigned u) { return __builtin_bit_cast(h2_t, __builtin_amdgcn_cvt_pkrtz(bf_lo(u), bf_hi(u))); }
DI void h32_unpack(h2_t (&h)[16], const H32& q) {
    h[0] = bf2_to_h2(q.a.x); h[1] = bf2_to_h2(q.a.y); h[2] = bf2_to_h2(q.a.z); h[3] = bf2_to_h2(q.a.w);
    h[4] = bf2_to_h2(q.b.x); h[5] = bf2_to_h2(q.b.y); h[6] = bf2_to_h2(q.b.z); h[7] = bf2_to_h2(q.b.w);
    h[8] = bf2_to_h2(q.c.x); h[9] = bf2_to_h2(q.c.y); h[10] = bf2_to_h2(q.c.z); h[11] = bf2_to_h2(q.c.w);
    h[12] = bf2_to_h2(q.d.x); h[13] = bf2_to_h2(q.d.y); h[14] = bf2_to_h2(q.d.z); h[15] = bf2_to_h2(q.d.w);
}
DI void peerU4_run(const PSArgs& a, const fp4x2_t* U4, int s4, int th, int k, int nloc, int wid) {
    const int tid = get_tid(wid);
    const int lane = tid & 63, rg = lane >> 3, pc = lane & 7;
    const unsigned loff = (unsigned)(s4 * (NEXP * 128) + pc * 16);
    const int hoff = s4 * 256 + pc * 32;
    const int N = 8 * ((NTOK / 128 - k + nloc - 1) / nloc);
    if (N <= 0) return;
    Ids16 idE, idO; H32 hE, hO;
    u32x4 rA[8], rB[8];
    const fp8_t* tab = (const fp8_t*)U4;
    ids_load(idE, a.EX, run_token2(0, k, nloc, wid, th), rg);
    ids_load(idO, a.EX, run_token2(1, k, nloc, wid, th), rg);
    rows_lo(rA, idE, tab, loff); h32_load(hE, a.Hb, run_token2(0, k, nloc, wid, th), hoff); rows_hi(rB, idE, tab, loff);
#pragma unroll 1
    for (int n = 0; n < N; n += 2) {
        const int t0 = run_token2(n, k, nloc, wid, th), t1 = run_token2(n + 1, k, nloc, wid, th);
        const int t2 = run_token2((n + 2 < N) ? n + 2 : N - 1, k, nloc, wid, th), t3 = run_token2((n + 3 < N) ? n + 3 : N - 1, k, nloc, wid, th);
        {
            h2_t h[16]; float p[16];
            h32_unpack(h, hE);
            dots8_4(p, rA, h);
            rows_lo(rA, idO, tab, loff); h32_load(hO, a.Hb, t1, hoff);
            dots8_4(p + 8, rB, h);
            rows_hi(rB, idO, tab, loff);
            ids_load(idE, a.EX, t2, rg);
            peerU_finish(a, p, t0, s4, lane);
        }
        {
            h2_t h[16]; float p[16];
            h32_unpack(h, hO);
            dots8_4(p, rA, h);
            rows_lo(rA, idE, tab, loff); h32_load(hE, a.Hb, t2, hoff);
            dots8_4(p + 8, rB, h);
            rows_hi(rB, idE, tab, loff);
            ids_load(idO, a.EX, t3, rg);
            peerU_finish(a, p, t1, s4, lane);
        }
    }
}

#ifndef U_INT4
#define U_INT4 1
#endif
DI unsigned pack_i4x8(const float (&v)[8], float inv) {
    unsigned r = 0u;
#pragma unroll
    for (int i = 0; i < 4; ++i) {
        const int a = (int)fminf(fmaxf(rintf(v[i] * inv), -7.f), 7.f), b = (int)fminf(fmaxf(rintf(v[4 + i] * inv), -7.f), 7.f);
        r |= ((unsigned)a & 15u) << (8 * i); r |= ((unsigned)b & 15u) << (8 * i + 4);
    }
    return r;
}
DI void conv_rows_int4g(const float* __restrict__ src, const float* __restrict__ gain, fp4x2_t* __restrict__ dst, float* __restrict__ scales,
                        int nrows, int gwave, int nwaves, int lane) {
    const float4* g = (const float4*)(gain + lane * 16);
    const float4 g0 = g[0], g1 = g[1], g2 = g[2], g3 = g[3];
#pragma unroll 1
    for (int row = gwave; row < nrows; row += nwaves) {
        const float4* p0 = (const float4*)(src + (size_t)row * DM + lane * 16);
        const float4 a0 = p0[0], a1 = p0[1], a2 = p0[2], a3 = p0[3];
        const float v0[8] = {a0.x * g0.x, a0.y * g0.y, a0.z * g0.z, a0.w * g0.w, a1.x * g1.x, a1.y * g1.y, a1.z * g1.z, a1.w * g1.w};
        const float v1[8] = {a2.x * g2.x, a2.y * g2.y, a2.z * g2.z, a2.w * g2.w, a3.x * g3.x, a3.y * g3.y, a3.z * g3.z, a3.w * g3.w};
        float ss = 0.f;
#pragma unroll
        for (int i = 0; i < 8; ++i) ss += v0[i] * v0[i] + v1[i] * v1[i];
        ss = wave_sum(ss, lane);
        const float rms = sqrtf(ss * (1.f / 1024.f));
        const float step = (rms > 0.f) ? 0.36f * rms : 1.f, inv = 1.f / step;
        *(uint2*)(dst + ((size_t)(lane >> 4) * nrows + row) * 128 + (lane & 15) * 8) = make_uint2(pack_i4x8(v0, inv), pack_i4x8(v1, inv));
        if (lane == 0) scales[row] = step;
    }
}
DI float h_planes(int (&H)[4], int (&L)[4], const H32& q, int lane) {
    float f[32];
    const unsigned w[16] = {q.a.x, q.a.y, q.a.z, q.a.w, q.b.x, q.b.y, q.b.z, q.b.w, q.c.x, q.c.y, q.c.z, q.c.w, q.d.x, q.d.y, q.d.z, q.d.w};
    float m = 0.f;
#pragma unroll
    for (int i = 0; i < 16; ++i) { f[2 * i] = bf_lo(w[i]); f[2 * i + 1] = bf_hi(w[i]); m = fmaxf(m, fmaxf(fabsf(f[2 * i]), fabsf(f[2 * i + 1]))); }
    m = fmaxf(m, __int_as_float(__builtin_amdgcn_update_dpp(0, __float_as_int(m), 0xB1, 0xF, 0xF, true)));
    m = fmaxf(m, __int_as_float(__builtin_amdgcn_update_dpp(0, __float_as_int(m), 0x4E, 0xF, 0xF, true)));
    m = fmaxf(m, __int_as_float(__builtin_amdgcn_update_dpp(0, __float_as_int(m), 0x141, 0xF, 0xF, true)));
    const float sh = (m > 0.f) ? m * (1.f / 119.f) : 1.f, inv = 1.f / sh;
#pragma unroll
    for (int d = 0; d < 4; ++d) {
        unsigned A = 0u, B = 0u;
#pragma unroll
        for (int i = 0; i < 4; ++i) {
            A = __builtin_amdgcn_cvt_pk_u8_f32(rintf(f[8 * d + i] * inv) + 136.f, i, A);
            B = __builtin_amdgcn_cvt_pk_u8_f32(rintf(f[8 * d + 4 + i] * inv) + 136.f, i, B);
        }
        L[d] = (int)(((A & 0x0F0F0F0Fu) | ((B & 0x0F0F0F0Fu) << 4)) ^ 0x88888888u);
        H[d] = (int)((((A >> 4) & 0x0F0F0F0Fu) | (B & 0xF0F0F0F0u)) ^ 0x88888888u);
    }
    return sh;
}
DI float row_dot32i(const u32x4& r, const int (&H)[4], const int (&L)[4]) {
    int ah = 0, al = 0;
    ah = __builtin_amdgcn_sdot8((int)r.x, H[0], ah, false); al = __builtin_amdgcn_sdot8((int)r.x, L[0], al, false);
    ah = __builtin_amdgcn_sdot8((int)r.y, H[1], ah, false); al = __builtin_amdgcn_sdot8((int)r.y, L[1], al, false);
    ah = __builtin_amdgcn_sdot8((int)r.z, H[2], ah, false); al = __builtin_amdgcn_sdot8((int)r.z, L[2], al, false);
    ah = __builtin_amdgcn_sdot8((int)r.w, H[3], ah, false); al = __builtin_amdgcn_sdot8((int)r.w, L[3], al, false);
    return (float)(ah * 16 + al);
}
struct HP8 { u32x4 h, l; float sh; };
DI void hp_load(HP8& q, const PSArgs& a, int tok, int s4, int pc) {
    q.h = *(const u32x4*)(a.HPH + (size_t)tok * 128 + s4 * 32 + pc * 4); q.l = *(const u32x4*)(a.HPL + (size_t)tok * 128 + s4 * 32 + pc * 4);
    q.sh = a.HS[(size_t)tok * 4 + s4];
}
DI float row_dot32q(const u32x4& r, const HP8& q) {
    int ah = 0, al = 0;
    ah = __builtin_amdgcn_sdot8((int)r.x, (int)q.h.x, ah, false); al = __builtin_amdgcn_sdot8((int)r.x, (int)q.l.x, al, false);
    ah = __builtin_amdgcn_sdot8((int)r.y, (int)q.h.y, ah, false); al = __builtin_amdgcn_sdot8((int)r.y, (int)q.l.y, al, false);
    ah = __builtin_amdgcn_sdot8((int)r.z, (int)q.h.z, ah, false); al = __builtin_amdgcn_sdot8((int)r.z, (int)q.l.z, al, false);
    ah = __builtin_amdgcn_sdot8((int)r.w, (int)q.h.w, ah, false); al = __builtin_amdgcn_sdot8((int)r.w, (int)q.l.w, al, false);
    return (float)(ah * 16 + al) * q.sh;
}
DI void peerUi_run(const PSArgs& a, const fp4x2_t* U4, int s4, int th, int k, int nloc, int wid) {
    const int tid = get_tid(wid);
    const int lane = tid & 63, rg = lane >> 3, pc = lane & 7;
    const unsigned loff = (unsigned)(s4 * (NEXP * 128) + pc * 16);
    const int N = 8 * ((NTOK / 128 - k + nloc - 1) / nloc);
    if (N <= 0) return;
    Ids16 idE, idO; HP8 hE, hO;
    u32x4 rA[8], rB[8];
    const fp8_t* tab = (const fp8_t*)U4;
    ids_load(idE, a.EX, run_token2(0, k, nloc, wid, th), rg);
    ids_load(idO, a.EX, run_token2(1, k, nloc, wid, th), rg);
    rows_lo(rA, idE, tab, loff); hp_load(hE, a, run_token2(0, k, nloc, wid, th), s4, pc); rows_hi(rB, idE, tab, loff);
#pragma unroll 1
    for (int n = 0; n < N; n += 2) {
        const int t0 = run_token2(n, k, nloc, wid, th), t1 = run_token2(n + 1, k, nloc, wid, th);
        const int t2 = run_token2((n + 2 < N) ? n + 2 : N - 1, k, nloc, wid, th), t3 = run_token2((n + 3 < N) ? n + 3 : N - 1, k, nloc, wid, th);
        {
            float p[16];
#pragma unroll
            for (int i = 0; i < 8; ++i) p[i] = row_dot32q(rA[i], hE);
            rows_lo(rA, idO, tab, loff); hp_load(hO, a, t1, s4, pc);
#pragma unroll
            for (int i = 0; i < 8; ++i) p[8 + i] = row_dot32q(rB[i], hE);
            rows_hi(rB, idO, tab, loff);
            ids_load(idE, a.EX, t2, rg);
            peerU_finish(a, p, t0, s4, lane);
        }
        {
            float p[16];
#pragma unroll
            for (int i = 0; i < 8; ++i) p[i] = row_dot32q(rA[i], hO);
            rows_lo(rA, idE, tab, loff); hp_load(hE, a, t2, s4, pc);
#pragma unroll
            for (int i = 0; i < 8; ++i) p[8 + i] = row_dot32q(rB[i], hO);
            rows_hi(rB, idE, tab, loff);
            ids_load(idO, a.EX, t3, rg);
            peerU_finish(a, p, t1, s4, lane);
        }
    }
}
struct MegaArgs {
    const float* x; const float* a_re; const float* a_im; const float* log_dt; const float* b_re; const float* b_im; const float* c_re;
    const float* c_im; const float* d_skip; const float* b_glu; const float* pool_scale; const float* u_exp; const float* v_exp;
    const float* norm_final;
    PrepW pw;
    float* X; bf16_t* U; bf16_t* YPRE; bf16_t* G1; bf16_t* A2; bf16_t* Hb; bf16_t* Qb; unsigned short* EX; float* GT; float* RSTD;
    char* KT; bf16x8* WST; bf16x8* CCAR; float* ABT; fp8_t* U8; fp4x2_t* U4; fp4x2_t* V4; float* SU; float* SV; float* PD; bf16_t* COEF; unsigned* HPH; unsigned* HPL; float* HS;
    unsigned* bar;
    int coop_probe; int pad_;
};

#ifndef REP_P0
#define REP_P0 1
#endif
#ifndef REP_PA
#define REP_PA 1
#endif
#ifndef REP_PB
#define REP_PB 1
#endif
#ifndef REP_C1
#define REP_C1 1
#endif
#ifndef REP_C2
#define REP_C2 1
#endif
#ifndef REP_U
#define REP_U 1
#endif
#ifndef REP_R
#define REP_R 1
#endif
#ifndef REP_V
#define REP_V 1
#endif
#ifndef REP_BAR
#define REP_BAR 1
#endif
#define XBAR() do { for (int rb_ = 0; rb_ < REP_BAR; ++rb_) xcd_barrier(xb, wid); } while (0)
__global__ void __launch_bounds__(NTHR) mega_kernel(MegaArgs a) {
    __shared__ __attribute__((aligned(16))) char smem[PB_BYTES];
    __shared__ uint4 xb_words;
    cg::grid_group grid = cg::this_grid();
    const int nblk = gridDim.x;
    const int wid = __builtin_amdgcn_readfirstlane(threadIdx.x >> 6);
    if (get_tid(wid) == 0) xb_words = make_uint4(0u, 0u, 0u, 0u);
    __syncthreads();
    const XcdBarrier xb = xcd_barrier_post(a.bar, (volatile LAS unsigned*)&xb_words, get_tid(wid));
    for (int rep = 0; rep < REP_P0; ++rep) {
        const size_t gtid = (size_t)blockIdx.x * NTHR + get_tid(wid), gs = (size_t)nblk * NTHR;
        for (int it = blockIdx.x; it < 256; it += nblk)
            prep_s5_item(it >> 2, it & 3, a.a_re, a.a_im, a.log_dt, a.b_re, a.b_im, a.c_re, a.c_im, a.d_skip, a.KT, a.WST, a.CCAR, a.ABT, smem, wid);
        prep_weights(a.pw, gtid, gs);
        for (int l = 0; l < 2; ++l) {
            conv_kfrag(a.pw.k1 + (size_t)l * 128 * 128, a.pw.wfk1 + (size_t)l * (128 * 128 / 8), gtid, gs);
            conv_kfrag(a.pw.k2 + (size_t)l * 128 * 128, a.pw.wfk2 + (size_t)l * (128 * 128 / 8), gtid, gs);
        }
        {
            int tid = get_tid(wid);
            const int gwave = blockIdx.x * 8 + (tid >> 6), nwaves = nblk * 8, lane = tid & 63;
#pragma unroll 1
            for (int l = 0; l < 2; ++l) {
#if U_INT4
                conv_rows_int4g(a.u_exp + (size_t)l * NEXP * DM, a.pw.norm_ffn + l * DM, a.U4 + (size_t)l * NEXP * (DM / 2), a.SU + l * NEXP, NEXP, gwave, nwaves, lane);
#elif U_FP4
                conv_rows_fp4g(a.u_exp + (size_t)l * NEXP * DM, a.pw.norm_ffn + l * DM, a.U4 + (size_t)l * NEXP * (DM / 2), a.SU + l * NEXP, NEXP, gwave, nwaves, lane);
#else
                conv_rows_fp8(a.u_exp + (size_t)l * NEXP * DM, a.pw.norm_ffn + l * DM, a.U8 + (size_t)l * NEXP * DM, a.SU + l * NEXP, NEXP, gwave, nwaves, lane);
#endif
                conv_rows_fp4(a.v_exp + (size_t)l * NEXP * DM, a.V4 + (size_t)l * NEXP * (DM / 2), a.SV + l * NEXP, NEXP, gwave, nwaves, lane);
            }
        }
    }
    XBAR();
    if (a.coop_probe) grid.sync();
    __shared__ int sched[4];
    if (get_tid(wid) == 0) {
        int nx = 0, myj = 0, nloc = 1;
        for (unsigned j = 0; j < 16; ++j) {
            const unsigned cj = xb_ld(&a.bar[XB_XCNT(j)]);
            if (j == xb.x) { myj = nx; nloc = (int)cj; }
            nx += (cj > 0u) ? 1 : 0;
        }
        sched[0] = (int)xb.st[2]; sched[1] = nloc > 0 ? nloc : 1; sched[2] = myj; sched[3] = nx > 0 ? nx : 1;
    }
    __syncthreads();
    const int s_rank = sched[0], s_nloc = sched[1], s_myj = sched[2], s_nx = sched[3];
#pragma unroll 1
    for (int l = 0; l < 2; ++l) {
        const float* xin = (l == 0) ? a.x : a.X;
        if (l == 0) {
            for (int rep = 0; rep < REP_PA; ++rep)
            for (int tile = blockIdx.x; tile < NTOK / 64; tile += nblk) phaseA_tile(xin, a.pw.wfin, a.U, tile, smem, wid);
        }
        XBAR();
        bf16_t* Ul = a.U + (size_t)l * NTOK * DM;
        for (int rep = 0; rep < REP_PB; ++rep)
        for (int tile = blockIdx.x; tile < 256; tile += nblk)
            phaseB_tile(Ul, a.KT + (size_t)l * 32 * KT_BYTES, a.WST + (size_t)l * 32 * WST_FRAGS, a.CCAR + (size_t)l * 32 * CCAR_FRAGS, a.ABT + l * 32 * 128, a.YPRE, tile, smem, wid);
        XBAR();
        PCArgs pa; pa.U = Ul; pa.YPRE = a.YPRE; pa.G1 = a.G1; pa.A2 = a.A2; pa.Xin = xin; pa.Xout = a.X; pa.Xdummy = (float*)a.Qb; pa.HPH = a.HPH; pa.HPL = a.HPL; pa.HS = a.HS; pa.Hb = a.Hb; pa.RSTD = a.RSTD;
        pa.wfglu = a.pw.wfglu + (size_t)l * (512 * 512 / 8); pa.b_glu = a.b_glu + l * 512; pa.wfpool = a.pw.wfpool + (size_t)l * 4 * (128 * 128 / 8);
        pa.pool_scale = a.pool_scale + l * 512; pa.wfout = a.pw.wfout + (size_t)l * (DM * DM / 8);
        PRArgs pr; pr.Hb = a.Hb; pr.RSTD = a.RSTD; pr.wfq = a.pw.wfq + (size_t)l * (DM * 2048 / 8); pr.kf1 = a.pw.wfk1 + (size_t)l * (128 * 128 / 8);
        pr.kf2 = a.pw.wfk2 + (size_t)l * (128 * 128 / 8); pr.EX = a.EX; pr.GT = a.GT;
        for (int tile = blockIdx.x; tile < NTOK / 64; tile += nblk) {
            for (int rep = 1; rep < REP_C1; ++rep) { PCArgs pa2 = pa; pa2.Xout = (float*)a.Qb; phaseC1_tile(pa2, tile, smem, wid); }
            phaseC1_tile(pa, tile, smem, wid);
            for (int rep = 0; rep < REP_C2; ++rep) phaseC2_tile(pr, tile, smem, wid);
        }
        XBAR();
        PSArgs ps; ps.Hb = a.Hb; ps.RSTD = a.RSTD; ps.EX = a.EX; ps.GT = a.GT; ps.U8 = a.U8 + (size_t)l * NEXP * DM; ps.V8 = nullptr;
        ps.SU = a.SU + l * NEXP; ps.SV = a.SV + l * NEXP; ps.PD = a.PD; ps.COEF = a.COEF; ps.Xin = a.X; ps.Xout = a.X; ps.HPH = a.HPH; ps.HPL = a.HPL; ps.HS = a.HS;
        for (int rep = 0; rep < REP_U; ++rep) {
#if U_INT4
            for (int v = s_myj; v < 8; v += s_nx) peerUi_run(ps, a.U4 + (size_t)l * NEXP * (DM / 2), v & 3, v >> 2, s_rank, s_nloc, wid);
#elif U_FP4
            for (int v = s_myj; v < 8; v += s_nx) peerU4_run(ps, a.U4 + (size_t)l * NEXP * (DM / 2), v & 3, v >> 2, s_rank, s_nloc, wid);
#else
            for (int s = s_myj; s < 8; s += s_nx) peerU_run(ps, s, s_rank, s_nloc, wid);
#endif
        }
        XBAR();
        for (int rep = 0; rep < REP_R; ++rep)
        for (int tile = blockIdx.x; tile < NTOK / 64; tile += nblk) peerR_tile(ps, tile, wid);
        XBAR();
        for (int rep = 1; rep < REP_V; ++rep) { PSArgs ps2 = ps; ps2.Xout = (float*)a.Qb; for (int v = s_myj; v < 8; v += s_nx) peerV4_run(ps2, a.V4 + (size_t)l * NEXP * (DM / 2), v & 3, v >> 2, s_rank, s_nloc, wid); }
        for (int v = s_myj; v < 8; v += s_nx) peerV4_run(ps, a.V4 + (size_t)l * NEXP * (DM / 2), v & 3, v >> 2, s_rank, s_nloc, wid);
        XBAR();
        if (l == 0) {
            for (int rep = 0; rep < REP_PA; ++rep)
            for (int tile = blockIdx.x; tile < NTOK / 64; tile += nblk) phaseA_tile(a.X, a.pw.wfin + (size_t)(DM * DM / 8), a.U + (size_t)NTOK * DM, tile, smem, wid);
        } else {
            for (int tile = blockIdx.x; tile < NTOK / 64; tile += nblk) final_norm_tile(a.X, a.norm_final, tile, wid);
        }
    }
}

extern "C" void kernel_launch(void* const* d_in, const int* in_sizes, int n_in, void* d_out, int out_size, void* d_ws, size_t ws_size,
                              hipStream_t stream) {
    char* wsb = (char*)d_ws;
    size_t off = 0;
    auto take = [&](size_t bytes) { char* p = wsb + off; off += (bytes + 255) & ~(size_t)255; return p; };
    MegaArgs a;
    memset(&a, 0, sizeof(a));
    a.x = (const float*)d_in[0];
    a.pw.norm_mix = (const float*)d_in[1]; a.pw.w_in = (const float*)d_in[2];
    a.a_re = (const float*)d_in[3]; a.a_im = (const float*)d_in[4]; a.log_dt = (const float*)d_in[5];
    a.b_re = (const float*)d_in[6]; a.b_im = (const float*)d_in[7]; a.c_re = (const float*)d_in[8]; a.c_im = (const float*)d_in[9];
    a.d_skip = (const float*)d_in[10]; a.pw.w_glu = (const float*)d_in[11]; a.b_glu = (const float*)d_in[12];
    a.pw.w_pool = (const float*)d_in[13]; a.pool_scale = (const float*)d_in[14]; a.pw.g_out_ssm = (const float*)d_in[15];
    a.pw.g_out_pool = (const float*)d_in[16]; a.pw.w_out = (const float*)d_in[17]; a.pw.norm_ffn = (const float*)d_in[18];
    a.pw.w_q = (const float*)d_in[19]; a.pw.k1 = (const float*)d_in[20]; a.pw.k2 = (const float*)d_in[21];
    a.u_exp = (const float*)d_in[22]; a.v_exp = (const float*)d_in[23]; a.norm_final = (const float*)d_in[24];
    a.X = (float*)d_out;
    a.U = (bf16_t*)take((size_t)2 * NTOK * DM * 2);
    a.YPRE = (bf16_t*)take((size_t)NTOK * 512 * 2);
    a.G1 = (bf16_t*)take((size_t)NTOK * 512 * 2);
    a.A2 = (bf16_t*)take((size_t)NTOK * DM * 2);
    a.Hb = (bf16_t*)take((size_t)NTOK * DM * 2);
    a.Qb = (bf16_t*)take((size_t)NTOK * 2048 * 2);
    a.EX = (unsigned short*)take((size_t)NTOK * 128 * 2);
    a.GT = (float*)take((size_t)NTOK * 128 * 4);
    a.RSTD = (float*)take(NTOK * 4);
    a.pw.wfin = (bf16x8*)take((size_t)2 * DM * DM * 2);
    a.pw.wfglu = (bf16x8*)take((size_t)2 * 512 * 512 * 2);
    a.pw.wfpool = (bf16x8*)take((size_t)2 * 4 * 128 * 128 * 2);
    a.pw.wfout = (bf16x8*)take((size_t)2 * DM * DM * 2);
    a.pw.wfq = (bf16x8*)take((size_t)2 * DM * 2048 * 2);
    a.pw.wfk1 = (bf16x8*)take((size_t)2 * 128 * 128 * 2);
    a.pw.wfk2 = (bf16x8*)take((size_t)2 * 128 * 128 * 2);
    a.KT = take((size_t)64 * KT_BYTES);
    a.WST = (bf16x8*)take((size_t)64 * WST_FRAGS * 16);
    a.CCAR = (bf16x8*)take((size_t)64 * CCAR_FRAGS * 16);
    a.ABT = (float*)take(64 * 128 * 4);
    a.U8 = (fp8_t*)take((size_t)2 * NEXP * DM);
    a.V4 = (fp4x2_t*)take((size_t)2 * NEXP * (DM / 2));
    a.U4 = (fp4x2_t*)take((size_t)2 * NEXP * (DM / 2));
    a.SU = (float*)take((size_t)2 * NEXP * 4);
    a.SV = (float*)take((size_t)2 * NEXP * 4);
    a.PD = (float*)take((size_t)8 * NTOK * 128 * 4);
    a.COEF = (bf16_t*)take((size_t)NTOK * 128 * 2);
    a.HPH = (unsigned*)take((size_t)NTOK * 128 * 4);
    a.HPL = (unsigned*)take((size_t)NTOK * 128 * 4);
    a.HS = (float*)take((size_t)NTOK * 4 * 4);
    a.bar = (unsigned*)take((size_t)XCD_BAR_WORDS * 4);
    hipMemsetAsync(a.bar, 0, (size_t)XCD_BAR_WORDS * 4, stream);

    static int grid_blocks = 0;
    if (!grid_blocks) {
        int dev = 0, cus = 0, per_cu = 0;
        hipGetDevice(&dev);
        hipDeviceGetAttribute(&cus, hipDeviceAttributeMultiprocessorCount, dev);
        hipOccupancyMaxActiveBlocksPerMultiprocessor(&per_cu, mega_kernel, NTHR, 0);
        if (per_cu > 1) per_cu = 1;
        grid_blocks = cus * per_cu;
        if (grid_blocks > 256) grid_blocks = 256;
    }
    void* args[] = {&a};
    hipError_t e = hipLaunchCooperativeKernel((void*)mega_kernel, dim3(grid_blocks), dim3(NTHR), args, 0, stream);
    if (e != hipSuccess) fprintf(stderr, "cooperative launch failed: %s (grid %d)\n", hipGetErrorString(e), grid_blocks);
}
```

```cpp
#include <hip/hip_runtime.h>
#include <hip/hip_cooperative_groups.h>
#include <cstdio>
#include <cstring>
namespace cg = cooperative_groups;
#include <math.h>
#include <stdint.h>

#define NTOK 16384
#define SEQ 2048
#define DM 1024
#define SSMW 512
#define NEXP 16384

__device__ __forceinline__ float gelu_exact(float x) { return 0.5f * x * (1.f + erff(x * 0.70710678118654752f)); }

template <int M> __device__ __forceinline__ int shx_i(int v, int lane) {
    if constexpr (M == 1) return __builtin_amdgcn_mov_dpp(v, 0xB1, 0xF, 0xF, true);
    else if constexpr (M == 2) return __builtin_amdgcn_mov_dpp(v, 0x4E, 0xF, 0xF, true);
    else if constexpr (M < 32) return __builtin_amdgcn_ds_swizzle(v, (M << 10) | 0x1F);
    else return __builtin_amdgcn_ds_bpermute((lane ^ 32) << 2, v);
}
template <int M> __device__ __forceinline__ float shx(float v, int lane) { return __int_as_float(shx_i<M>(__float_as_int(v), lane)); }
__device__ __forceinline__ float wave_sum(float v, int lane) {
    v += shx<1>(v, lane); v += shx<2>(v, lane); v += shx<4>(v, lane); v += shx<8>(v, lane); v += shx<16>(v, lane); v += shx<32>(v, lane);
    return v;
}

__device__ __forceinline__ int get_tid(int wid) {
    int t = wid * 64 + (int)__builtin_amdgcn_mbcnt_hi(~0u, __builtin_amdgcn_mbcnt_lo(~0u, 0u));
    asm volatile("" : "+v"(t));
    return t;
}

#define DI __device__ __forceinline__
typedef __attribute__((ext_vector_type(8))) short bf16x8;
typedef __attribute__((ext_vector_type(16))) float f32x16;
typedef __attribute__((ext_vector_type(2))) __bf16 bf2_t;
typedef __attribute__((ext_vector_type(2))) float f2_t;
typedef unsigned short bf16_t;
typedef __attribute__((ext_vector_type(4))) unsigned u32x4;
typedef __attribute__((ext_vector_type(4))) float f32x4;
typedef const __attribute__((address_space(1))) bf16x8* gwp_t;
#define MFMA32(a, b, c) __builtin_amdgcn_mfma_f32_32x32x16_bf16((a), (b), (c), 0, 0, 0)

DI unsigned pack_bf2(float a, float b) { f2_t v = {a, b}; return __builtin_bit_cast(unsigned, __builtin_convertvector(v, bf2_t)); }
DI float bf_lo(unsigned u) { return __uint_as_float(u << 16); }
DI float bf_hi(unsigned u) { return __uint_as_float(u & 0xffff0000u); }
DI int crow(int reg, int h) { return (reg & 3) + 8 * (reg >> 2) + 4 * h; }

#define SA_STRIDE 272
#define SA_BYTES (64 * SA_STRIDE)
#define NTHR 512

template <bool GAIN>
DI void conv_wfrag(const float* __restrict__ src, int ldk, int ldn, const float* __restrict__ ga, const float* __restrict__ gb, int split,
                   int K, int N, int NTG, bf16x8* __restrict__ dst, size_t gtid, size_t gstride) {
    const int KS = K / 16;
    const size_t total = (size_t)(N / 32) * KS * 64;
    for (size_t item = gtid; item < total; item += gstride) {
        const int lane = (int)(item & 63); const size_t f = item >> 6;
        const int nti = (int)(f % NTG); const size_t f2 = f / NTG;
        const int ks = (int)(f2 % KS), nt = (int)(f2 / KS) * NTG + nti;
        const int r = lane & 31, h = lane >> 5;
        const int n = nt * 32 + r, k0 = ks * 16 + 8 * h;
        float v[8];
#pragma unroll
        for (int j = 0; j < 8; ++j) {
            const int k = k0 + j;
            float g = 1.f;
            if (GAIN) g = (k < split) ? ga[k] : gb[k - split];
            v[j] = src[(size_t)k * ldk + (size_t)n * ldn] * g;
        }
        uint4 o; o.x = pack_bf2(v[0], v[1]); o.y = pack_bf2(v[2], v[3]); o.z = pack_bf2(v[4], v[5]); o.w = pack_bf2(v[6], v[7]);
        *(uint4*)(dst + item) = o;
    }
}

DI void conv_rows_bf16(const float* __restrict__ src, const float* __restrict__ gain, bf16_t* __restrict__ dst, size_t nelem, size_t gtid, size_t gstride) {
    for (size_t i = gtid * 8; i < nelem; i += gstride * 8) {
        float4 a = *(const float4*)(src + i), b = *(const float4*)(src + i + 4);
        if (gain) {
            const int c = (int)(i & 1023);
            float4 g0 = *(const float4*)(gain + c), g1 = *(const float4*)(gain + c + 4);
            a.x *= g0.x; a.y *= g0.y; a.z *= g0.z; a.w *= g0.w; b.x *= g1.x; b.y *= g1.y; b.z *= g1.z; b.w *= g1.w;
        }
        uint4 o; o.x = pack_bf2(a.x, a.y); o.y = pack_bf2(a.z, a.w); o.z = pack_bf2(b.x, b.y); o.w = pack_bf2(b.z, b.w);
        *(uint4*)(dst + i) = o;
    }
}

struct ALoadF32 {
    const float* base; f32x4 v0, v1, v2, v3; float ss; int dofs;
    DI void init(const float* rowbase, int tid) { base = rowbase + (tid & 7) * 16; ss = 0.f; dofs = (tid >> 3) * SA_STRIDE + (tid & 7) * 32; }
    DI void issue(int c) { const f32x4* p = (const f32x4*)(base + c * 128); v0 = p[0]; v1 = p[1]; v2 = p[2]; v3 = p[3]; }
    DI void commit(char* buf) {
        u32x4 o0, o1;
        ss += v0.x * v0.x + v0.y * v0.y + v0.z * v0.z + v0.w * v0.w + v1.x * v1.x + v1.y * v1.y + v1.z * v1.z + v1.w * v1.w
            + v2.x * v2.x + v2.y * v2.y + v2.z * v2.z + v2.w * v2.w + v3.x * v3.x + v3.y * v3.y + v3.z * v3.z + v3.w * v3.w;
        o0.x = pack_bf2(v0.x, v0.y); o0.y = pack_bf2(v0.z, v0.w); o0.z = pack_bf2(v1.x, v1.y); o0.w = pack_bf2(v1.z, v1.w);
        o1.x = pack_bf2(v2.x, v2.y); o1.y = pack_bf2(v2.z, v2.w); o1.z = pack_bf2(v3.x, v3.y); o1.w = pack_bf2(v3.z, v3.w);
        char* d = buf + dofs;
        *(u32x4*)d = o0; *(u32x4*)(d + 16) = o1;
    }
};
struct ALoadBF16 {
    const bf16_t* base; u32x4 v0, v1; int dofs;
    DI void init(const bf16_t* rowbase, int tid) { base = rowbase + (tid & 7) * 16; dofs = (tid >> 3) * SA_STRIDE + (tid & 7) * 32; }
    DI void issue(int c) { const u32x4* p = (const u32x4*)(base + c * 128); v0 = p[0]; v1 = p[1]; }
    DI void commit(char* buf) {
        char* d = buf + dofs;
        *(u32x4*)d = v0; *(u32x4*)(d + 16) = v1;
    }
};

template <int NT, int PF, class AL>
DI void gemm64(f32x16 (&acc)[NT][2], AL& al, const int nchunks, const bf16x8* __restrict__ wf_, char* sA, const int lane) {
    gwp_t wf = (gwp_t)wf_;
    const int r = lane & 31, h = lane >> 5;
    bf16x8 bq[PF][NT];
    al.issue(0);
#pragma unroll
    for (int p = 0; p < PF; ++p)
#pragma unroll
        for (int nt = 0; nt < NT; ++nt) bq[p][nt] = wf[(p * NT + nt) * 64];
    gwp_t wpf = wf + PF * NT * 64;
    al.commit(sA);
    const int kend = nchunks * 8 - PF;
    int kg = 0;
#pragma unroll 1
    for (int c = 0; c < nchunks; ++c) {
        if (c + 1 < nchunks) al.issue(c + 1);
        __syncthreads();
        const char* buf = sA + (c & 1) * SA_BYTES + r * SA_STRIDE + h * 16;
#pragma unroll
        for (int ks = 0; ks < 8; ++ks) {
            const bf16x8 a0 = *(const bf16x8*)(buf + ks * 32);
            const bf16x8 a1 = *(const bf16x8*)(buf + 32 * SA_STRIDE + ks * 32);
#pragma unroll
            for (int nt = 0; nt < NT; ++nt) {
                acc[nt][0] = MFMA32(bq[ks % PF][nt], a0, acc[nt][0]);
                acc[nt][1] = MFMA32(bq[ks % PF][nt], a1, acc[nt][1]);
            }
            if (kg < kend) {
#pragma unroll
                for (int nt = 0; nt < NT; ++nt) bq[ks % PF][nt] = wpf[nt * 64];
            }
            wpf += NT * 64; ++kg;
            asm volatile("" : "+v"(wpf));
        }
        if (c + 1 < nchunks) al.commit(sA + ((c + 1) & 1) * SA_BYTES);
    }
    __syncthreads();
}

template <int NT>
DI void zero_acc(f32x16 (&acc)[NT][2]) {
#pragma unroll
    for (int nt = 0; nt < NT; ++nt)
#pragma unroll
        for (int mt = 0; mt < 2; ++mt)
#pragma unroll
            for (int i = 0; i < 16; ++i) acc[nt][mt][i] = 0.f;
}


DI void tile_transpose(const f32x16& t, float* wscr, int lane, f32x4 (&out)[4]) {
    const int r = lane & 31, h = lane >> 5;
#pragma unroll
    for (int q = 0; q < 4; ++q) { f32x4 v = {t[4 * q], t[4 * q + 1], t[4 * q + 2], t[4 * q + 3]}; *(f32x4*)(wscr + r * 36 + 8 * q + 4 * h) = v; }
#pragma unroll
    for (int j = 0; j < 4; ++j) out[j] = *(const f32x4*)(wscr + ((lane >> 3) + 8 * j) * 36 + (lane & 7) * 4);
}
#define WSCR_BYTES (32 * 36 * 4)

DI void phaseA_tile(const float* __restrict__ X, const bf16x8* __restrict__ wfin, bf16_t* __restrict__ U, int tile, char* smem, int wid) {
    char* sA = smem; float* srstd = (float*)(smem + 8 * WSCR_BYTES);
    int tok0 = tile * 64; asm volatile("" : "+s"(tok0));
    int tid = get_tid(wid);
    const int w = __builtin_amdgcn_readfirstlane(tid >> 6), lane = tid & 63, r = lane & 31, h = lane >> 5;
    ALoadF32 al; al.init(X + (size_t)(tok0 + (tid >> 3)) * DM, tid);
    f32x16 acc[4][2]; zero_acc<4>(acc);
    gemm64<4, 2>(acc, al, 8, wfin + (size_t)w * (64 * 4 * 64) + lane, sA, lane);
    float ss = al.ss;
    ss += shx<1>(ss, lane); ss += shx<2>(ss, lane); ss += shx<4>(ss, lane);
    if ((tid & 7) == 0) srstd[tid >> 3] = rsqrtf(ss * (1.f / 1024.f) + 1e-6f);
    __syncthreads();
    {
        float* wscr = (float*)(smem + w * WSCR_BYTES);
        const int tl = lane >> 3, cl = (lane & 7) * 4;
#pragma unroll
        for (int mt = 0; mt < 2; ++mt) {
            float rs[4];
#pragma unroll
            for (int j = 0; j < 4; ++j) rs[j] = srstd[mt * 32 + tl + 8 * j];
#pragma unroll
            for (int nt = 0; nt < 4; ++nt) {
                f32x4 o[4]; tile_transpose(acc[nt][mt], wscr, lane, o);
#pragma unroll
                for (int j = 0; j < 4; ++j) {
                    uint2 p; p.x = pack_bf2(o[j].x * rs[j], o[j].y * rs[j]); p.y = pack_bf2(o[j].z * rs[j], o[j].w * rs[j]);
                    *(uint2*)(U + (size_t)(tok0 + mt * 32 + tl + 8 * j) * DM + w * 128 + nt * 32 + cl) = p;
                }
            }
        }
    }
    __syncthreads();
}

struct PrepW {
    const float* norm_mix; const float* w_in; const float* w_glu; const float* w_pool; const float* g_out_ssm; const float* g_out_pool;
    const float* w_out; const float* norm_ffn; const float* w_q; const float* k1; const float* k2;
    bf16x8* wfin; bf16x8* wfglu; bf16x8* wfpool; bf16x8* wfout; bf16x8* wfq; bf16x8* wfk1; bf16x8* wfk2;
};
DI void prep_weights(const PrepW& p, size_t gtid, size_t gs) {
#pragma unroll 1
    for (int l = 0; l < 2; ++l) {
        conv_wfrag<true>(p.w_in + (size_t)l * DM * DM, DM, 1, p.norm_mix + l * DM, p.norm_mix + l * DM, DM, DM, DM, 4, p.wfin + (size_t)l * (DM * DM / 8), gtid, gs);
        conv_wfrag<false>(p.w_glu + (size_t)l * 512 * 512, 512, 1, p.norm_mix, p.norm_mix, 512, 512, 512, 2, p.wfglu + (size_t)l * (512 * 512 / 8), gtid, gs);
#pragma unroll 1
        for (int gi = 0; gi < 4; ++gi)
            conv_wfrag<false>(p.w_pool + (size_t)(l * 4 + gi) * 128 * 128, 128, 1, p.norm_mix, p.norm_mix, 128, 128, 128, 2, p.wfpool + (size_t)(l * 4 + gi) * (128 * 128 / 8), gtid, gs);
        conv_wfrag<true>(p.w_out + (size_t)l * DM * DM, DM, 1, p.g_out_ssm + l * 512, p.g_out_pool + l * 512, 512, DM, DM, 4, p.wfout + (size_t)l * (DM * DM / 8), gtid, gs);
        conv_wfrag<true>(p.w_q + (size_t)l * DM * 2048, 2048, 1, p.norm_ffn + l * DM, p.norm_ffn + l * DM, DM, DM, 2048, 4, p.wfq + (size_t)l * (DM * 2048 / 8), gtid, gs);
    }
}
#define KT_BLK 528
#define KT_BYTES (65 * KT_BLK)
#define WST_FRAGS (4 * 64 * 64)
#define CCAR_FRAGS (32 * 8 * 64)
#define SU_CH 2064

DI void prep_s5_item(int lg, int part, const float* __restrict__ a_re, const float* __restrict__ a_im, const float* __restrict__ log_dt,
                     const float* __restrict__ b_re, const float* __restrict__ b_im, const float* __restrict__ c_re, const float* __restrict__ c_im,
                     const float* __restrict__ d_skip, char* __restrict__ KT, bf16x8* __restrict__ WST, bf16x8* __restrict__ CCAR,
                     float* __restrict__ ABT, char* smem, int wid) {
    float* powr = (float*)smem;
    float* powi = powr + 65 * 64;
    float* bzr = powi + 65 * 64;
    float* bzi = bzr + 1024;
    float* cr = bzi + 1024;
    float* ci = cr + 1024;
    int tid = get_tid(wid);
    const float* are_p = a_re + lg * 64; const float* aim_p = a_im + lg * 64;
    const float dt = expf(log_dt[lg]);
    for (int it = tid; it < 65 * 64; it += NTHR) {
        const int tau = it >> 6, p = it & 63;
        const float lre = are_p[p], lim = aim_p[p];
        const float mag = expf((float)tau * lre * dt);
        double rev = (double)lim * (double)dt * (double)tau * 0.15915494309189535;
        rev -= floor(rev);
        const float ang = (float)rev * 6.283185307179586f;
        powr[it] = mag * cosf(ang); powi[it] = mag * sinf(ang);
    }
    for (int it = tid; it < 1024; it += NTHR) {
        cr[it] = c_re[lg * 1024 + it]; ci[it] = c_im[lg * 1024 + it];
    }
    __syncthreads();
    for (int it = tid; it < 1024; it += NTHR) {
        const int p = it >> 4;
        const float lre = are_p[p], lim = aim_p[p];
        const float ar = powr[64 + p], ai = powi[64 + p];
        const float inv = 1.f / (lre * lre + lim * lim), nre = ar - 1.f;
        const float zre = (nre * lre + ai * lim) * inv, zim = (ai * lre - nre * lim) * inv;
        const float br = b_re[lg * 1024 + it], bi = b_im[lg * 1024 + it];
        bzr[it] = zre * br - zim * bi; bzi[it] = zre * bi + zim * br;
    }
    __syncthreads();
    if (part == 0 && tid < 64) { ABT[lg * 128 + 2 * tid] = powr[64 * 64 + tid]; ABT[lg * 128 + 2 * tid + 1] = powi[64 * 64 + tid]; }
    char* kt = KT + (size_t)lg * KT_BYTES;
    if (part == 0) for (int it = tid; it < KT_BLK / 4; it += NTHR) ((unsigned*)kt)[it] = 0u;
    for (int it = part * (16 * 128) + tid; it < (part + 1) * (16 * 128); it += NTHR) {
        const int tau = it >> 7, ho = (it >> 3) & 15, hi = (it & 7) * 2;
        float s0 = 0.f, s1 = 0.f;
        for (int p = 0; p < 64; ++p) {
            const float c_r = cr[ho * 64 + p], c_i = ci[ho * 64 + p], pr = powr[tau * 64 + p], pi = powi[tau * 64 + p];
            const float cpr = c_r * pr - c_i * pi, cpi = c_r * pi + c_i * pr;
            s0 += cpr * bzr[p * 16 + hi] - cpi * bzi[p * 16 + hi];
            s1 += cpr * bzr[p * 16 + hi + 1] - cpi * bzi[p * 16 + hi + 1];
        }
        if (tau == 0) { if (ho == hi) s0 += d_skip[lg * 16 + ho]; if (ho == hi + 1) s1 += d_skip[lg * 16 + ho]; }
        *(unsigned*)(kt + (tau + 1) * KT_BLK + ho * 32 + hi * 2) = pack_bf2(s0, s1);
    }
    if (part == 0) for (int it = tid; it < 65 * 4; it += NTHR) ((unsigned*)(kt + (it >> 2) * KT_BLK + 512))[it & 3] = 0u;
    bf16x8* wst = WST + (size_t)lg * WST_FRAGS;
    for (int it = part * (WST_FRAGS / 4) + tid; it < (part + 1) * (WST_FRAGS / 4); it += NTHR) {
        const int lane = it & 63, j = (it >> 6) & 63, nt = it >> 12;
        const int r = lane & 31, h = lane >> 5, n = nt * 32 + r, p = n & 63, im = n >> 6;
        const float pr = powr[(63 - j) * 64 + p], pi = powi[(63 - j) * 64 + p];
        float v[8];
#pragma unroll
        for (int jj = 0; jj < 8; ++jj) {
            const float zr = bzr[p * 16 + 8 * h + jj], zi = bzi[p * 16 + 8 * h + jj];
            v[jj] = im ? (pr * zi + pi * zr) : (pr * zr - pi * zi);
        }
        uint4 o; o.x = pack_bf2(v[0], v[1]); o.y = pack_bf2(v[2], v[3]); o.z = pack_bf2(v[4], v[5]); o.w = pack_bf2(v[6], v[7]);
        *(uint4*)(wst + it) = o;
    }
    bf16x8* cc = CCAR + (size_t)lg * CCAR_FRAGS;
    for (int it = part * (CCAR_FRAGS / 4) + tid; it < (part + 1) * (CCAR_FRAGS / 4); it += NTHR) {
        const int lane = it & 63, ks = (it >> 6) & 7, mt = it >> 9;
        const int r = lane & 31, h = lane >> 5, m = mt * 32 + r, i = m >> 4, ho = m & 15;
        float v[8];
#pragma unroll
        for (int jj = 0; jj < 8; ++jj) {
            const int k = ks * 16 + 8 * h + jj, p = k & 63, im = k >> 6;
            const float c_r = cr[ho * 64 + p], c_i = ci[ho * 64 + p], pr = powr[(i + 1) * 64 + p], pi = powi[(i + 1) * 64 + p];
            v[jj] = im ? -(c_r * pi + c_i * pr) : (c_r * pr - c_i * pi);
        }
        uint4 o; o.x = pack_bf2(v[0], v[1]); o.y = pack_bf2(v[2], v[3]); o.z = pack_bf2(v[4], v[5]); o.w = pack_bf2(v[6], v[7]);
        *(uint4*)(cc + it) = o;
    }
    __syncthreads();
}

#define PB_SU 0
#define PB_SKT (32 * SU_CH)
#define PB_SL (PB_SKT + KT_BYTES)
#define PB_SPART (PB_SL + 32 * 132 * 4)
#define PB_SSP (PB_SPART + 4 * 4096)
#define PB_BYTES (PB_SSP + 32 * 272)

DI void phaseB_tile(const bf16_t* __restrict__ U, const char* __restrict__ KT, const bf16x8* __restrict__ WST, const bf16x8* __restrict__ CCAR,
                    const float* __restrict__ ABT, bf16_t* __restrict__ YPRE, int tile, char* smem, int wid) {
    const int gp = tile & 31, b = tile >> 5;
    const int g = ((gp & 7) << 2) | (gp >> 3);
    int tid = get_tid(wid);
    const int w = __builtin_amdgcn_readfirstlane(tid >> 6), lane = tid & 63, r = lane & 31, h = lane >> 5;
    char* sU = smem + PB_SU; char* sKT = smem + PB_SKT; float* sL = (float*)(smem + PB_SL); float* sPart = (float*)(smem + PB_SPART);
    char* sSp = smem + PB_SSP;
#pragma unroll
    for (int it = 0; it < 4; ++it) {
        const int tok = tid + NTHR * it;
        const uint4* src = (const uint4*)(U + (size_t)(b * SEQ + tok) * DM + g * 16);
        const uint4 v0 = src[0], v1 = src[1];
        char* d = sU + (tok >> 6) * SU_CH + (tok & 63) * 32;
        *(uint4*)d = v0; *(uint4*)(d + 16) = v1;
    }
    {
        const uint4* src = (const uint4*)(KT + (size_t)g * KT_BYTES);
        for (int it = tid; it < KT_BYTES / 16; it += NTHR) ((uint4*)sKT)[it] = src[it];
    }
    __syncthreads();
    {
        const int nt = w & 3, kh = w >> 2;
        f32x16 acc;
#pragma unroll
        for (int i = 0; i < 16; ++i) acc[i] = 0.f;
        const bf16x8* wp = WST + (size_t)g * WST_FRAGS + (size_t)(nt * 64 + kh * 32) * 64 + lane;
        const char* up = sU + r * SU_CH + h * 16 + kh * 32 * 32;
#pragma unroll 16
        for (int j = 0; j < 32; ++j) {
            const bf16x8 a = wp[j * 64];
            const bf16x8 bb = *(const bf16x8*)(up + j * 32);
            acc = MFMA32(a, bb, acc);
        }
        if (kh == 1) {
#pragma unroll
            for (int i = 0; i < 16; ++i) sPart[(nt * 16 + i) * 64 + lane] = acc[i];
        }
        __syncthreads();
        if (kh == 0) {
#pragma unroll
            for (int i = 0; i < 16; ++i) sL[r * 132 + nt * 32 + crow(i, h)] = acc[i] + sPart[(nt * 16 + i) * 64 + lane];
        }
        __syncthreads();
    }
    if (tid < 64) {
        const int p = tid;
        const float ar = ABT[g * 128 + 2 * p], ai = ABT[g * 128 + 2 * p + 1];
        float sr = 0.f, si = 0.f;
        for (int c = 0; c < 32; ++c) {
            *(bf16_t*)(sSp + c * 272 + p * 2) = (bf16_t)(pack_bf2(sr, 0.f) & 0xffffu);
            *(bf16_t*)(sSp + c * 272 + (64 + p) * 2) = (bf16_t)(pack_bf2(si, 0.f) & 0xffffu);
            const float lr = sL[c * 132 + p], li = sL[c * 132 + 64 + p];
            const float nr = ar * sr - ai * si + lr, ni = ar * si + ai * sr + li;
            sr = nr; si = ni;
        }
    }
    f32x16 acc4[4];
#pragma unroll
    for (int q = 0; q < 4; ++q)
#pragma unroll
        for (int i = 0; i < 16; ++i) acc4[q][i] = 0.f;
    const int mts0 = w, mts1 = 15 - w, mts2 = 16 + w, mts3 = 31 - w;
    {
        const char* up = sU + r * SU_CH + h * 16;
        const char* kp = sKT + (r & 15) * 32 + h * 16 + ((r >> 4) + 1) * KT_BLK;
        for (int j = 0; j < 64; ++j) {
            const bf16x8 bb = *(const bf16x8*)(up + j * 32);
#define TOEP_STEP(q, mt) if (2 * (mt) + 1 >= j) { const bf16x8 a = *(const bf16x8*)(kp + (2 * (mt) - j) * KT_BLK); acc4[q] = MFMA32(a, bb, acc4[q]); }
            TOEP_STEP(0, mts0) TOEP_STEP(1, mts1) TOEP_STEP(2, mts2) TOEP_STEP(3, mts3)
#undef TOEP_STEP
        }
    }
    __syncthreads();
    {
        const bf16x8* cp = CCAR + (size_t)g * CCAR_FRAGS + lane;
        const char* sp = sSp + r * 272 + h * 16;
#pragma unroll
        for (int ks = 0; ks < 8; ++ks) {
            const bf16x8 bb = *(const bf16x8*)(sp + ks * 32);
            acc4[0] = MFMA32(cp[(mts0 * 8 + ks) * 64], bb, acc4[0]);
            acc4[1] = MFMA32(cp[(mts1 * 8 + ks) * 64], bb, acc4[1]);
            acc4[2] = MFMA32(cp[(mts2 * 8 + ks) * 64], bb, acc4[2]);
            acc4[3] = MFMA32(cp[(mts3 * 8 + ks) * 64], bb, acc4[3]);
        }
    }
    {
        bf16_t* ybase = YPRE + (size_t)(b * SEQ + r * 64) * 512 + g * 16;
#define PB_STORE(q, mt) _Pragma("unroll") for (int rq = 0; rq < 4; ++rq) { const int c0 = 8 * rq + 4 * h; const int i = 2 * (mt) + (c0 >> 4); \
            uint2 o; o.x = pack_bf2(acc4[q][4 * rq], acc4[q][4 * rq + 1]); o.y = pack_bf2(acc4[q][4 * rq + 2], acc4[q][4 * rq + 3]); \
            *(uint2*)(ybase + (size_t)i * 512 + (c0 & 15)) = o; }
        PB_STORE(0, mts0) PB_STORE(1, mts1) PB_STORE(2, mts2) PB_STORE(3, mts3)
#undef PB_STORE
    }
    __syncthreads();
}

#ifndef REP_GLU
#define REP_GLU 1
#endif
#ifndef REP_POOL
#define REP_POOL 1
#endif
#ifndef REP_OUT
#define REP_OUT 1
#endif
#ifndef REP_Q
#define REP_Q 1
#endif
#ifndef REP_SC
#define REP_SC 1
#endif
struct ALoadGelu {
    const bf16_t* base; bf16_t* gout; u32x4 v0, v1; int cc; int dofs;
    DI void init(const bf16_t* rowbase, bf16_t* growbase, int tid) { base = rowbase + (tid & 7) * 16; gout = growbase + (tid & 7) * 16; dofs = (tid >> 3) * SA_STRIDE + (tid & 7) * 32; }
    DI void issue(int c) { const u32x4* p = (const u32x4*)(base + c * 128); v0 = p[0]; v1 = p[1]; cc = c; }
    DI unsigned g2(unsigned u) { return pack_bf2(gelu_exact(bf_lo(u)), gelu_exact(bf_hi(u))); }
    DI void commit(char* buf) {
        u32x4 o0, o1;
        o0.x = g2(v0.x); o0.y = g2(v0.y); o0.z = g2(v0.z); o0.w = g2(v0.w);
        o1.x = g2(v1.x); o1.y = g2(v1.y); o1.z = g2(v1.z); o1.w = g2(v1.w);
        char* d = buf + dofs;
        *(u32x4*)d = o0; *(u32x4*)(d + 16) = o1;
        u32x4* gp = (u32x4*)(gout + cc * 128); gp[0] = o0; gp[1] = o1;
    }
};

DI void tok_reduce(float p0, float p1, float* sred, float& t0, float& t1, int tid) {
    const int w = tid >> 6, lane = tid & 63, r = lane & 31, h = lane >> 5;
    __syncthreads();
    sred[(w * 2 + h) * 64 + r] = p0; sred[(w * 2 + h) * 64 + 32 + r] = p1;
    __syncthreads();
    float a = 0.f, b = 0.f;
#pragma unroll
    for (int k = 0; k < 16; ++k) { a += sred[k * 64 + r]; b += sred[k * 64 + 32 + r]; }
    t0 = a; t1 = b;
}

#define PC_SRED (4 * SA_BYTES)
#define PC_BYTES (PC_SRED + 4096 + 256)

struct PCArgs {
    const bf16_t* U; const bf16_t* YPRE; bf16_t* G1; bf16_t* A2; const float* Xin; float* Xout; float* Xdummy; unsigned* HPH; unsigned* HPL; float* HS; bf16_t* Hb; float* RSTD;
    const bf16x8* wfglu; const float* b_glu; const bf16x8* wfpool; const float* pool_scale; const bf16x8* wfout;
};

DI void phaseC1_tile(const PCArgs& a, int tile, char* smem, int wid) {
    char* sA = smem; float* sred = (float*)(smem + PC_SRED);
    for (int rep_ = 0; rep_ < REP_GLU; ++rep_) {
        int tok0 = tile * 64; asm volatile("" : "+s"(tok0));
        int tid = get_tid(wid);
        const int w = __builtin_amdgcn_readfirstlane(tid >> 6), lane = tid & 63, r = lane & 31, h = lane >> 5;
        ALoadGelu al; al.init(a.YPRE + (size_t)(tok0 + (tid >> 3)) * 512, a.G1 + (size_t)(tok0 + (tid >> 3)) * 512, tid);
        f32x16 acc[2][2]; zero_acc<2>(acc);
        gemm64<2, 4>(acc, al, 4, a.wfglu + (size_t)w * (32 * 2 * 64) + lane, sA, lane);
        float ss0 = 0.f, ss1 = 0.f;
        {
            uint2 yp[2][2][4]; float4 bg[2][4];
#pragma unroll
            for (int nt = 0; nt < 2; ++nt)
#pragma unroll
                for (int q = 0; q < 4; ++q) bg[nt][q] = *(const float4*)(a.b_glu + w * 64 + nt * 32 + 8 * q + 4 * h);
#pragma unroll
            for (int mt = 0; mt < 2; ++mt)
#pragma unroll
                for (int nt = 0; nt < 2; ++nt)
#pragma unroll
                    for (int q = 0; q < 4; ++q)
                        yp[mt][nt][q] = *(const uint2*)(a.G1 + (size_t)(tok0 + mt * 32 + r) * 512 + w * 64 + nt * 32 + 8 * q + 4 * h);
#pragma unroll
            for (int mt = 0; mt < 2; ++mt)
#pragma unroll
                for (int nt = 0; nt < 2; ++nt)
#pragma unroll
                    for (int q = 0; q < 4; ++q) {
                        const float y0 = bf_lo(yp[mt][nt][q].x), y1 = bf_hi(yp[mt][nt][q].x), y2 = bf_lo(yp[mt][nt][q].y), y3 = bf_hi(yp[mt][nt][q].y);
                        const float o0 = y0 / (1.f + __expf(-(acc[nt][mt][4 * q] + bg[nt][q].x)));
                        const float o1 = y1 / (1.f + __expf(-(acc[nt][mt][4 * q + 1] + bg[nt][q].y)));
                        const float o2 = y2 / (1.f + __expf(-(acc[nt][mt][4 * q + 2] + bg[nt][q].z)));
                        const float o3 = y3 / (1.f + __expf(-(acc[nt][mt][4 * q + 3] + bg[nt][q].w)));
                        acc[nt][mt][4 * q] = o0; acc[nt][mt][4 * q + 1] = o1; acc[nt][mt][4 * q + 2] = o2; acc[nt][mt][4 * q + 3] = o3;
                        const float s = o0 * o0 + o1 * o1 + o2 * o2 + o3 * o3;
                        if (mt == 0) ss0 += s; else ss1 += s;
                    }
        }
        float t0, t1; tok_reduce(ss0, ss1, sred, t0, t1, tid);
        const float rs0 = rsqrtf(t0 * (1.f / 512.f) + 1e-6f), rs1 = rsqrtf(t1 * (1.f / 512.f) + 1e-6f);
#pragma unroll
        for (int mt = 0; mt < 2; ++mt) {
            const float rs = mt ? rs1 : rs0;
            bf16_t* orow = a.A2 + (size_t)(tok0 + mt * 32 + r) * DM + w * 64;
#pragma unroll
            for (int nt = 0; nt < 2; ++nt)
#pragma unroll
                for (int q = 0; q < 4; ++q) {
                    uint2 o; o.x = pack_bf2(acc[nt][mt][4 * q] * rs, acc[nt][mt][4 * q + 1] * rs);
                    o.y = pack_bf2(acc[nt][mt][4 * q + 2] * rs, acc[nt][mt][4 * q + 3] * rs);
                    *(uint2*)(orow + nt * 32 + 8 * q + 4 * h) = o;
                }
        }
    }
    for (int rep_ = 0; rep_ < REP_POOL; ++rep_) {
        int tok0 = tile * 64; asm volatile("" : "+s"(tok0));
        int tid = get_tid(wid);
        const int w = __builtin_amdgcn_readfirstlane(tid >> 6), lane = tid & 63, r = lane & 31, h = lane >> 5;
        const int row = tid >> 3, seg = tid & 7;
        const int tok = tok0 + row, t = tok & (SEQ - 1);
#pragma unroll
        for (int gi = 0; gi < 4; ++gi) {
            const int win = 2 << gi;
            const int cnt = (t + 1 < win) ? (t + 1) : win;
            const bf16_t* up = a.U + (size_t)tok * DM + 512 + gi * 128 + seg * 16;
            float s[16];
            const uint4 c0 = *(const uint4*)up, c1 = *(const uint4*)(up + 8);
            const unsigned cu[8] = {c0.x, c0.y, c0.z, c0.w, c1.x, c1.y, c1.z, c1.w};
#pragma unroll
            for (int i = 0; i < 8; ++i) { s[2 * i] = bf_lo(cu[i]); s[2 * i + 1] = bf_hi(cu[i]); }
#pragma unroll
            for (int k0 = 1; k0 < win; k0 += 5) {
                uint4 d0[5], d1[5];
#pragma unroll
                for (int u = 0; u < 5; ++u)
                    if (k0 + u < win) {
                        const bf16_t* p = (k0 + u <= t) ? up - (size_t)(k0 + u) * DM : up;
                        d0[u] = *(const uint4*)p; d1[u] = *(const uint4*)(p + 8);
                    }
#pragma unroll
                for (int u = 0; u < 5; ++u)
                    if (k0 + u < win) {
                        const float m = (k0 + u <= t) ? 1.f : 0.f;
                        const unsigned du[8] = {d0[u].x, d0[u].y, d0[u].z, d0[u].w, d1[u].x, d1[u].y, d1[u].z, d1[u].w};
#pragma unroll
                        for (int i = 0; i < 8; ++i) { s[2 * i] = fmaf(m, bf_lo(du[i]), s[2 * i]); s[2 * i + 1] = fmaf(m, bf_hi(du[i]), s[2 * i + 1]); }
                    }
            }
            const float inv = 1.f / (float)cnt;
            unsigned o[8];
#pragma unroll
            for (int i = 0; i < 8; ++i) o[i] = pack_bf2(s[2 * i] * inv - bf_lo(cu[i]), s[2 * i + 1] * inv - bf_hi(cu[i]));
            char* d = sA + gi * SA_BYTES + row * SA_STRIDE + seg * 32;
            *(uint4*)d = make_uint4(o[0], o[1], o[2], o[3]); *(uint4*)(d + 16) = make_uint4(o[4], o[5], o[6], o[7]);
        }
        __syncthreads();
        const int gi = w >> 1;
        f32x16 acc[2][2]; zero_acc<2>(acc);
        const bf16x8* wp = a.wfpool + (size_t)gi * (128 * 128 / 8) + (size_t)(w & 1) * (8 * 2 * 64) + lane;
        const char* buf = sA + gi * SA_BYTES + r * SA_STRIDE + h * 16;
#pragma unroll
        for (int ks = 0; ks < 8; ++ks) {
            const bf16x8 a0 = *(const bf16x8*)(buf + ks * 32);
            const bf16x8 a1 = *(const bf16x8*)(buf + 32 * SA_STRIDE + ks * 32);
#pragma unroll
            for (int nt = 0; nt < 2; ++nt) {
                const bf16x8 wv = wp[(ks * 2 + nt) * 64];
                acc[nt][0] = MFMA32(wv, a0, acc[nt][0]);
                acc[nt][1] = MFMA32(wv, a1, acc[nt][1]);
            }
        }
        float ss0 = 0.f, ss1 = 0.f;
        float4 psc[2][4];
#pragma unroll
        for (int nt = 0; nt < 2; ++nt)
#pragma unroll
            for (int q = 0; q < 4; ++q) psc[nt][q] = *(const float4*)(a.pool_scale + w * 64 + nt * 32 + 8 * q + 4 * h);
#pragma unroll
        for (int mt = 0; mt < 2; ++mt)
#pragma unroll
            for (int nt = 0; nt < 2; ++nt)
#pragma unroll
                for (int q = 0; q < 4; ++q) {
                    const float4 sc = psc[nt][q];
                    const float o0 = acc[nt][mt][4 * q] * sc.x, o1 = acc[nt][mt][4 * q + 1] * sc.y, o2 = acc[nt][mt][4 * q + 2] * sc.z, o3 = acc[nt][mt][4 * q + 3] * sc.w;
                    acc[nt][mt][4 * q] = o0; acc[nt][mt][4 * q + 1] = o1; acc[nt][mt][4 * q + 2] = o2; acc[nt][mt][4 * q + 3] = o3;
                    const float s = o0 * o0 + o1 * o1 + o2 * o2 + o3 * o3;
                    if (mt == 0) ss0 += s; else ss1 += s;
                }
        float t0, t1; tok_reduce(ss0, ss1, sred, t0, t1, tid);
        const float rs0 = rsqrtf(t0 * (1.f / 512.f) + 1e-6f), rs1 = rsqrtf(t1 * (1.f / 512.f) + 1e-6f);
#pragma unroll
        for (int mt = 0; mt < 2; ++mt) {
            const float rs = mt ? rs1 : rs0;
            bf16_t* orow = a.A2 + (size_t)(tok0 + mt * 32 + r) * DM + 512 + w * 64;
#pragma unroll
            for (int nt = 0; nt < 2; ++nt)
#pragma unroll
                for (int q = 0; q < 4; ++q) {
                    uint2 o; o.x = pack_bf2(acc[nt][mt][4 * q] * rs, acc[nt][mt][4 * q + 1] * rs);
                    o.y = pack_bf2(acc[nt][mt][4 * q + 2] * rs, acc[nt][mt][4 * q + 3] * rs);
                    *(uint2*)(orow + nt * 32 + 8 * q + 4 * h) = o;
                }
        }
        __syncthreads();
    }
    for (int rep_ = 0; rep_ < REP_OUT; ++rep_) {
        float* xout_ = (rep_ + 1 < REP_OUT) ? a.Xdummy : a.Xout;
        int tok0 = tile * 64; asm volatile("" : "+s"(tok0));
        int tid = get_tid(wid);
        const int w = __builtin_amdgcn_readfirstlane(tid >> 6), lane = tid & 63, r = lane & 31, h = lane >> 5;
        ALoadBF16 al; al.init(a.A2 + (size_t)(tok0 + (tid >> 3)) * DM, tid);
        f32x16 acc[4][2]; zero_acc<4>(acc);
        gemm64<4, 2>(acc, al, 8, a.wfout + (size_t)w * (64 * 4 * 64) + lane, sA, lane);
        {
            float* wscr = (float*)(smem + w * WSCR_BYTES);
            const int tl = lane >> 3, cl = (lane & 7) * 4;
            float ssj[2][4];
#pragma unroll
            for (int mt = 0; mt < 2; ++mt)
#pragma unroll
                for (int j = 0; j < 4; ++j) ssj[mt][j] = 0.f;
            float4 xc[4], xn[4];
            const size_t rbase = (size_t)(tok0 + tl) * DM + w * 128 + cl;
#pragma unroll
            for (int j = 0; j < 4; ++j) xc[j] = *(const float4*)(a.Xin + rbase + (size_t)(8 * j) * DM);
#pragma unroll
            for (int g = 0; g < 8; ++g) {
                const int mt = g >> 2, nt = g & 3;
                if (g < 7) {
                    const size_t rn = rbase + (size_t)((g + 1) >> 2) * 32 * DM + ((g + 1) & 3) * 32;
#pragma unroll
                    for (int j = 0; j < 4; ++j) xn[j] = *(const float4*)(a.Xin + rn + (size_t)(8 * j) * DM);
                }
                f32x4 o[4]; tile_transpose(acc[nt][mt], wscr, lane, o);
                const size_t ro = rbase + (size_t)mt * 32 * DM + nt * 32;
#pragma unroll
                for (int j = 0; j < 4; ++j) {
                    float4 xo; xo.x = xc[j].x + o[j].x; xo.y = xc[j].y + o[j].y; xo.z = xc[j].z + o[j].z; xo.w = xc[j].w + o[j].w;
                    *(float4*)(xout_ + ro + (size_t)(8 * j) * DM) = xo;
                    uint2 p; p.x = pack_bf2(xo.x, xo.y); p.y = pack_bf2(xo.z, xo.w);
                    *(uint2*)(a.Hb + ro + (size_t)(8 * j) * DM) = p;
                    ssj[mt][j] += xo.x * xo.x + xo.y * xo.y + xo.z * xo.z + xo.w * xo.w;
                }
                asm volatile("" ::: "memory");
#pragma unroll
                for (int j = 0; j < 4; ++j) xc[j] = xn[j];
            }
#pragma unroll
            for (int mt = 0; mt < 2; ++mt)
#pragma unroll
                for (int j = 0; j < 4; ++j) {
                    float v = ssj[mt][j];
                    v += shx<1>(v, lane); v += shx<2>(v, lane); v += shx<4>(v, lane);
                    if ((lane & 7) == 0) sred[w * 64 + mt * 32 + tl + 8 * j] = v;
                }
            __syncthreads();
            if (tid < 64) {
                float tot = 0.f;
#pragma unroll
                for (int k = 0; k < 8; ++k) tot += sred[k * 64 + tid];
                a.RSTD[tok0 + tid] = rsqrtf(tot * (1.f / 1024.f) + 1e-6f);
            }
        }
        __syncthreads();
    }
    {
        int tok0 = tile * 64; asm volatile("" : "+s"(tok0));
        int tid = get_tid(wid);
        const int w = __builtin_amdgcn_readfirstlane(tid >> 6), lane = tid & 63;
#pragma unroll 1
        for (int ti = 0; ti < 8; ++ti) {
            const int tok = tok0 + w * 8 + ti;
            const u32x4* hp = (const u32x4*)(a.Hb + (size_t)tok * DM + lane * 16);
            const u32x4 h0 = hp[0], h1 = hp[1];
            const unsigned wv[8] = {h0.x, h0.y, h0.z, h0.w, h1.x, h1.y, h1.z, h1.w};
            float f[16]; float m = 0.f;
#pragma unroll
            for (int i = 0; i < 8; ++i) { f[2 * i] = bf_lo(wv[i]); f[2 * i + 1] = bf_hi(wv[i]); m = fmaxf(m, fmaxf(fabsf(f[2 * i]), fabsf(f[2 * i + 1]))); }
            m = fmaxf(m, __int_as_float(__builtin_amdgcn_update_dpp(0, __float_as_int(m), 0xB1, 0xF, 0xF, true)));
            m = fmaxf(m, __int_as_float(__builtin_amdgcn_update_dpp(0, __float_as_int(m), 0x4E, 0xF, 0xF, true)));
            m = fmaxf(m, __int_as_float(__builtin_amdgcn_update_dpp(0, __float_as_int(m), 0x141, 0xF, 0xF, true)));
            m = fmaxf(m, __int_as_float(__builtin_amdgcn_update_dpp(0, __float_as_int(m), 0x140, 0xF, 0xF, true)));
            const float sh = (m > 0.f) ? m * (1.f / 119.f) : 1.f, inv = 1.f / sh;
            unsigned Hd[2], Ld[2];
#pragma unroll
            for (int d = 0; d < 2; ++d) {
                unsigned A = 0u, B = 0u;
#pragma unroll
                for (int i = 0; i < 4; ++i) {
                    A = __builtin_amdgcn_cvt_pk_u8_f32(rintf(f[8 * d + i] * inv) + 136.f, i, A);
                    B = __builtin_amdgcn_cvt_pk_u8_f32(rintf(f[8 * d + 4 + i] * inv) + 136.f, i, B);
                }
                Ld[d] = ((A & 0x0F0F0F0Fu) | ((B & 0x0F0F0F0Fu) << 4)) ^ 0x88888888u;
                Hd[d] = (((A >> 4) & 0x0F0F0F0Fu) | (B & 0xF0F0F0F0u)) ^ 0x88888888u;
            }
            *(uint2*)(a.HPH + (size_t)tok * 128 + 2 * lane) = make_uint2(Hd[0], Hd[1]);
            *(uint2*)(a.HPL + (size_t)tok * 128 + 2 * lane) = make_uint2(Ld[0], Ld[1]);
            if ((lane & 15) == 0) a.HS[(size_t)tok * 4 + (lane >> 4)] = sh;
        }
    }
}

DI unsigned f2ord(float f) { const unsigned u = __float_as_uint(f); return u ^ ((u >> 31) ? 0xFFFFFFFFu : 0x80000000u); }
DI float ord2f(unsigned o) { return __uint_as_float((o & 0x80000000u) ? (o ^ 0x80000000u) : ~o); }
DI unsigned umax_(unsigned a, unsigned b) { return a > b ? a : b; }
DI unsigned umin_(unsigned a, unsigned b) { return a < b ? a : b; }

struct PRArgs {
    const bf16_t* Hb; const float* RSTD; const bf16x8* wfq; const bf16x8* kf1; const bf16x8* kf2; unsigned short* EX; float* GT;
};

DI void conv_kfrag(const float* __restrict__ K, bf16x8* __restrict__ dst, size_t gtid, size_t gstride) {
    for (size_t item = gtid; item < 8 * 4 * 64; item += gstride) {
        const int lane = (int)(item & 63), kt = (int)((item >> 6) & 3), ks = (int)(item >> 8);
        const int r = lane & 31, h = lane >> 5;
        float v[8];
#pragma unroll
        for (int j = 0; j < 8; ++j) v[j] = K[(size_t)(kt * 32 + r) * 128 + (ks >> 1) * 32 + 16 * (ks & 1) + 8 * (j >> 2) + 4 * h + (j & 3)];
        uint4 o; o.x = pack_bf2(v[0], v[1]); o.y = pack_bf2(v[2], v[3]); o.z = pack_bf2(v[4], v[5]); o.w = pack_bf2(v[6], v[7]);
        *(uint4*)(dst + item) = o;
    }
}

DI void bitonic_sort16(unsigned (&a)[16]) {
#pragma unroll
    for (int k = 2; k <= 16; k <<= 1)
#pragma unroll
        for (int j = k >> 1; j > 0; j >>= 1)
#pragma unroll
            for (int i = 0; i < 16; ++i) {
                const int l = i ^ j;
                if (l > i) {
                    const unsigned hi = umax_(a[i], a[l]), lo = umin_(a[i], a[l]);
                    if ((i & k) == 0) { a[i] = hi; a[l] = lo; } else { a[i] = lo; a[l] = hi; }
                }
            }
}
DI void bitonic_top16(unsigned (&a)[16], const unsigned (&b)[16]) {
#pragma unroll
    for (int i = 0; i < 16; ++i) a[i] = umax_(a[i], b[15 - i]);
#pragma unroll
    for (int j = 8; j > 0; j >>= 1)
#pragma unroll
        for (int i = 0; i < 16; ++i) {
            const int l = i ^ j;
            if (l > i) { const unsigned hi = umax_(a[i], a[l]), lo = umin_(a[i], a[l]); a[i] = hi; a[l] = lo; }
        }
}
DI void make_keys(unsigned (&x)[16], const f32x16& s, float rs, int nbase, int h) {
#pragma unroll
    for (int i = 0; i < 16; ++i) x[i] = (f2ord(s[i] * rs) & 0xFFFFFF80u) | (unsigned)(127 - (nbase + crow(i, h)));
}

#define PR_LIST_STRIDE 80
#define PR_SLIST (2 * SA_BYTES)
#define PR_SIDX (PR_SLIST + 8 * 32 * PR_LIST_STRIDE)

DI void phaseC2_tile(const PRArgs& a, int tile, char* smem, int wid) {
    char* sA = smem;
#pragma unroll 1
    for (int ps = 0; ps < 2; ++ps) {
        int tok0 = tile * 64; asm volatile("" : "+s"(tok0));
        int tid = get_tid(wid);
        const int w = __builtin_amdgcn_readfirstlane(tid >> 6), lane = tid & 63, r = lane & 31, h = lane >> 5;
        const int ng = ps * 8 + w, hd = ng >> 1, hf = ng & 1;
        bf16x8 qb[2][8];
        {
            ALoadBF16 al; al.init(a.Hb + (size_t)(tok0 + (tid >> 3)) * DM, tid);
            f32x16 acc[4][2]; zero_acc<4>(acc);
            gemm64<4, 2>(acc, al, 8, a.wfq + (size_t)ng * (64 * 4 * 64) + lane, sA, lane);
#pragma unroll
            for (int mt = 0; mt < 2; ++mt)
#pragma unroll
                for (int nt = 0; nt < 4; ++nt)
#pragma unroll
                    for (int s = 0; s < 2; ++s) {
                        u32x4 p;
                        p.x = pack_bf2(acc[nt][mt][8 * s], acc[nt][mt][8 * s + 1]); p.y = pack_bf2(acc[nt][mt][8 * s + 2], acc[nt][mt][8 * s + 3]);
                        p.z = pack_bf2(acc[nt][mt][8 * s + 4], acc[nt][mt][8 * s + 5]); p.w = pack_bf2(acc[nt][mt][8 * s + 6], acc[nt][mt][8 * s + 7]);
                        qb[mt][nt * 2 + s] = __builtin_bit_cast(bf16x8, p);
                    }
        }
        gwp_t kf = (gwp_t)(hf ? a.kf2 : a.kf1) + lane;
        unsigned Town[16];
#pragma unroll
        for (int mt = 0; mt < 2; ++mt) {
            f32x16 sc[4];
#pragma unroll
            for (int kt = 0; kt < 4; ++kt)
#pragma unroll
                for (int i = 0; i < 16; ++i) sc[kt][i] = 0.f;
#pragma unroll
            for (int ks = 0; ks < 8; ++ks) {
#pragma unroll
                for (int kt = 0; kt < 4; ++kt) sc[kt] = MFMA32(kf[(ks * 4 + kt) * 64], qb[mt][ks], sc[kt]);
                if (ks & 1) asm volatile("" ::: "memory");
            }
            const float rs = a.RSTD[tok0 + mt * 32 + r];
            unsigned L[16], S[16];
            make_keys(L, sc[0], rs, 0, h); bitonic_sort16(L);
#pragma unroll
            for (int kt = 1; kt < 4; ++kt) { make_keys(S, sc[kt], rs, kt * 32, h); bitonic_sort16(S); bitonic_top16(L, S); }
#pragma unroll
            for (int k = 0; k < 16; ++k) S[k] = (unsigned)shx_i<32>((int)L[k], lane);
            bitonic_top16(L, S);
            if (mt == hf) {
#pragma unroll
                for (int k = 0; k < 16; ++k) Town[k] = L[k];
            } else {
                char* dst = smem + PR_SLIST + (w * 32 + r) * PR_LIST_STRIDE + h * 32;
                u32x4 v0, v1;
                if (h == 0) { v0 = (u32x4){L[0], L[1], L[2], L[3]}; v1 = (u32x4){L[4], L[5], L[6], L[7]}; }
                else { v0 = (u32x4){L[8], L[9], L[10], L[11]}; v1 = (u32x4){L[12], L[13], L[14], L[15]}; }
                *(u32x4*)dst = v0; *(u32x4*)(dst + 16) = v1;
            }
        }
        __syncthreads();
        unsigned T0[16], T1[16];
        {
            const char* src = smem + PR_SLIST + ((w ^ 1) * 32 + r) * PR_LIST_STRIDE;
            const u32x4 p0 = *(const u32x4*)src, p1 = *(const u32x4*)(src + 16), p2 = *(const u32x4*)(src + 32), p3 = *(const u32x4*)(src + 48);
            const unsigned Tp[16] = {p0.x, p0.y, p0.z, p0.w, p1.x, p1.y, p1.z, p1.w, p2.x, p2.y, p2.z, p2.w, p3.x, p3.y, p3.z, p3.w};
#pragma unroll
            for (int k = 0; k < 16; ++k) { T0[k] = hf ? Tp[k] : Town[k]; T1[k] = hf ? Town[k] : Tp[k]; }
        }
        float v1[16], v2[16];
#pragma unroll
        for (int k = 0; k < 16; ++k) { v1[k] = ord2f(T0[k] & 0xFFFFFF80u); v2[k] = ord2f(T1[k] & 0xFFFFFF80u); }
        unsigned C[16];
#pragma unroll
        for (int b = 0; b < 16; ++b) C[b] = (f2ord(v1[0] + v2[b]) & 0xFFFFFF00u) | (unsigned)(255 - b);
#pragma unroll
        for (int aa = 1; aa < 16; ++aa)
#pragma unroll
            for (int b = 0; b < 16; ++b)
                if ((aa + 1) * (b + 1) <= 16) {
                    unsigned x = (f2ord(v1[aa] + v2[b]) & 0xFFFFFF00u) | (unsigned)(255 - (aa * 16 + b));
#pragma unroll
                    for (int k = (aa + 1) * (b + 1) - 1; k < 16; ++k) { const unsigned hi = umax_(C[k], x); x = umin_(C[k], x); C[k] = hi; }
                }
        unsigned* sI = (unsigned*)(smem + PR_SIDX) + (w * 64 + lane) * 9;
#pragma unroll
        for (int q = 0; q < 4; ++q) {
            unsigned p1 = 0u, p2 = 0u;
#pragma unroll
            for (int j = 0; j < 4; ++j) { p1 |= (127u - (T0[4 * q + j] & 0x7Fu)) << (8 * j); p2 |= (127u - (T1[4 * q + j] & 0x7Fu)) << (8 * j); }
            sI[q] = p1; sI[4 + q] = p2;
        }
        const unsigned char* sB = (const unsigned char*)sI;
        const float mx = ord2f(C[0] & 0xFFFFFF00u);
        float e[16]; float sum = 0.f; int ex[16];
#pragma unroll
        for (int k = 0; k < 16; ++k) {
            e[k] = __expf(ord2f(C[k] & 0xFFFFFF00u) - mx); sum += e[k];
            const unsigned ci = 255u - (C[k] & 0xFFu);
            ex[k] = (int)sB[ci >> 4] * 128 + (int)sB[16 + (ci & 15u)];
        }
        const float inv = 1.f / sum;
        const size_t ob = ((size_t)(tok0 + hf * 32 + r) * 8 + hd) * 16;
        if (h == 0) {
#pragma unroll
            for (int q = 0; q < 2; ++q) *(uint4*)(a.EX + ob + 8 * q) = make_uint4((unsigned)ex[8 * q] | ((unsigned)ex[8 * q + 1] << 16), (unsigned)ex[8 * q + 2] | ((unsigned)ex[8 * q + 3] << 16),
                                                                       (unsigned)ex[8 * q + 4] | ((unsigned)ex[8 * q + 5] << 16), (unsigned)ex[8 * q + 6] | ((unsigned)ex[8 * q + 7] << 16));
        } else {
#pragma unroll
            for (int q = 0; q < 4; ++q) *(float4*)(a.GT + ob + 4 * q) = make_float4(e[4 * q] * inv, e[4 * q + 1] * inv, e[4 * q + 2] * inv, e[4 * q + 3] * inv);
        }
        __syncthreads();
    }
}
typedef const __attribute__((address_space(1))) u32x4* grow_t;
typedef unsigned char fp8_t;
#define XB_TMO      128
#define XB_XCNT(j)  (256  + 64 * (j))
#define XB_XSUB(j)  (1280 + 64 * (j))
#define XB_XGEN(j)  (2304 + 64 * (j))
#define XB_TOP      3328
#define XB_TOPGEN   3392
#define XB_QUEUE(j) (3456 + 64 * (j))
#define XCD_BAR_WORDS (3456 + 64 * 64)
#define XB_SPIN_CAP (1u << 20)
#define LAS __attribute__((address_space(3)))

DI unsigned xb_ld(unsigned* p)              { return __hip_atomic_load(p, __ATOMIC_RELAXED, __HIP_MEMORY_SCOPE_AGENT); }
DI unsigned xb_add(unsigned* p, unsigned v) { return __hip_atomic_fetch_add(p, v, __ATOMIC_RELAXED, __HIP_MEMORY_SCOPE_AGENT); }
DI unsigned xb_xcc_id() { return (unsigned)__builtin_amdgcn_s_getreg((3 << 11) | 20) & 0xFu; }
#define XB_SPIN(cond, bar) do { unsigned _sp = 0; while (cond) { __builtin_amdgcn_s_sleep(1); \
    if ((++_sp & 255u) == 0u) { if (xb_ld(&(bar)[XB_TMO])) break; if (_sp > XB_SPIN_CAP) { atomicAdd(&(bar)[XB_TMO], 1u); break; } } } } while (0)

struct XcdBarrier { unsigned* bar; unsigned x; volatile LAS unsigned* st; };

DI XcdBarrier xcd_barrier_post(unsigned* bar, volatile LAS unsigned* st, int tid) {
    XcdBarrier b; b.bar = bar; b.x = xb_xcc_id(); b.st = st;
    if (tid == 0) st[2] = xb_add(&bar[XB_XCNT(b.x)], 1u);
    return b;
}
DI void xcd_barrier_complete(unsigned* bar, unsigned x, unsigned& nloc, unsigned& nx) {
    const unsigned G = gridDim.x * gridDim.y * gridDim.z;
    unsigned sum, cnt, mine, sp = 0u;
    for (;;) {
        sum = 0u; cnt = 0u; mine = 0u;
#pragma unroll
        for (unsigned j = 0; j < 16; ++j) { const unsigned c = xb_ld(&bar[XB_XCNT(j)]); sum += c; cnt += (c > 0u) ? 1u : 0u; mine = (j == x) ? c : mine; }
        if (sum == G) break;
        __builtin_amdgcn_s_sleep(1);
        if ((++sp & 255u) == 0u) { if (xb_ld(&bar[XB_TMO])) break; if (sp > XB_SPIN_CAP) { atomicAdd(&bar[XB_TMO], 1u); break; } }
    }
    nloc = mine > 0u ? mine : 1u; nx = cnt > 0u ? cnt : 1u;
}
DI void xcd_barrier(const XcdBarrier& b, int wid) {
    asm volatile("s_waitcnt vmcnt(0)" ::: "memory");
    __syncthreads();
    if (get_tid(wid) == 0) {
        unsigned* bar = b.bar;
        __builtin_amdgcn_s_waitcnt(0);
        unsigned nloc = b.st[0], nx = b.st[1];
        if (nloc == 0u) { xcd_barrier_complete(bar, b.x, nloc, nx); b.st[0] = nloc; b.st[1] = nx; }
        const unsigned old = xb_add(&bar[XB_XSUB(b.x)], 1u);
        const unsigned gen = old / nloc;
        if (old + 1u == (gen + 1u) * nloc) {
            __builtin_amdgcn_fence(__ATOMIC_RELEASE, "agent");
            asm volatile("s_waitcnt vmcnt(0)" ::: "memory");
            const unsigned og = xb_add(&bar[XB_TOP], 1u);
            const unsigned tg = og / nx;
            if (og + 1u == (tg + 1u) * nx) xb_add(&bar[XB_TOPGEN], 1u);
            else XB_SPIN(xb_ld(&bar[XB_TOPGEN]) == tg, bar);
            __builtin_amdgcn_fence(__ATOMIC_ACQUIRE, "agent");
            xb_add(&bar[XB_XGEN(b.x)], 1u);
            asm volatile("s_waitcnt vmcnt(0)" ::: "memory");
        } else {
            XB_SPIN(xb_ld(&bar[XB_XGEN(b.x)]) == gen, bar);
            __builtin_amdgcn_fence(__ATOMIC_ACQUIRE, "agent");
            asm volatile("s_waitcnt vmcnt(0)" ::: "memory");
        }
    }
    __syncthreads();
}
#define NUSL 4
struct PSArgs {
    const bf16_t* Hb; const float* RSTD; const unsigned short* EX; const float* GT; const float* SU; const float* SV;
    float* PD; bf16_t* COEF; const float* Xin; float* Xout; const unsigned* HPH; const unsigned* HPL; const float* HS;
};

struct Ids16 { u32x4 a, b; };
DI void ids_load(Ids16& q, const unsigned short* EX, int tok, int rg) { const u32x4* p = (const u32x4*)(EX + (size_t)tok * 128 + rg * 16); q.a = p[0]; q.b = p[1]; }
#define ID_LO(w) (((w) & 0xFFFFu) * 128u + loff)
#define ID_HI(w) (((w) >> 16) * 128u + loff)
DI void rows_lo(u32x4 (&r)[8], const Ids16& q, const fp8_t* tab, unsigned loff) {
    r[0] = *(grow_t)(tab + ID_LO(q.a.x)); r[1] = *(grow_t)(tab + ID_HI(q.a.x)); r[2] = *(grow_t)(tab + ID_LO(q.a.y)); r[3] = *(grow_t)(tab + ID_HI(q.a.y));
    r[4] = *(grow_t)(tab + ID_LO(q.a.z)); r[5] = *(grow_t)(tab + ID_HI(q.a.z)); r[6] = *(grow_t)(tab + ID_LO(q.a.w)); r[7] = *(grow_t)(tab + ID_HI(q.a.w));
}
DI void rows_hi(u32x4 (&r)[8], const Ids16& q, const fp8_t* tab, unsigned loff) {
    r[0] = *(grow_t)(tab + ID_LO(q.b.x)); r[1] = *(grow_t)(tab + ID_HI(q.b.x)); r[2] = *(grow_t)(tab + ID_LO(q.b.y)); r[3] = *(grow_t)(tab + ID_HI(q.b.y));
    r[4] = *(grow_t)(tab + ID_LO(q.b.z)); r[5] = *(grow_t)(tab + ID_HI(q.b.z)); r[6] = *(grow_t)(tab + ID_LO(q.b.w)); r[7] = *(grow_t)(tab + ID_HI(q.b.w));
}
DI void peerU_finish(const PSArgs& a, float (&p)[16], int tok, int s, int lane) {
    const int rg = lane >> 3, pc = lane & 7;
    const bool b2 = pc & 4, b1 = pc & 2, b0 = pc & 1;
    float q8[8], q4[4], q2[2];
#pragma unroll
    for (int k = 0; k < 8; ++k) { const float keep = b2 ? p[k + 8] : p[k], send = b2 ? p[k] : p[k + 8]; q8[k] = keep + shx<4>(send, lane); }
#pragma unroll
    for (int k = 0; k < 4; ++k) { const float keep = b1 ? q8[k + 4] : q8[k], send = b1 ? q8[k] : q8[k + 4]; q4[k] = keep + shx<2>(send, lane); }
#pragma unroll
    for (int k = 0; k < 2; ++k) { const float keep = b0 ? q4[k + 2] : q4[k], send = b0 ? q4[k] : q4[k + 2]; q2[k] = keep + shx<1>(send, lane); }
    *(float2*)(a.PD + ((size_t)s * NTOK + tok) * 128 + rg * 16 + 2 * pc) = make_float2(q2[0], q2[1]);
}

DI void peerR_tile(const PSArgs& a, int tile, int wid) {
    const int tid = get_tid(wid);
    const int lane = tid & 63;
#pragma unroll 1
    for (int ti = 0; ti < 8; ++ti) {
        const int tok = tile * 64 + wid * 8 + ti;
        float d0 = 0.f, d1 = 0.f;
#pragma unroll
        for (int x = 0; x < NUSL; ++x) { const float2 v = *(const float2*)(a.PD + ((size_t)x * NTOK + tok) * 128 + 2 * lane); d0 += v.x; d1 += v.y; }
        const unsigned exw = *(const unsigned*)(a.EX + (size_t)tok * 128 + 2 * lane);
        const int2 ex = make_int2((int)(exw & 0xFFFFu), (int)(exw >> 16));
        const float2 gt = *(const float2*)(a.GT + (size_t)tok * 128 + 2 * lane);
        const float rs = a.RSTD[tok];
        float2 o;
        o.x = gelu_exact(d0 * a.SU[ex.x] * rs) * gt.x * a.SV[ex.x];
        o.y = gelu_exact(d1 * a.SU[ex.y] * rs) * gt.y * a.SV[ex.y];
        *(unsigned*)(a.COEF + (size_t)tok * 128 + 2 * lane) = pack_bf2(o.x, o.y);
    }
}

struct Cf16 { u32x4 a, b; };
DI void cf_load(Cf16& q, const bf16_t* COEF, int tok, int rg) { const u32x4* p = (const u32x4*)(COEF + (size_t)tok * 128 + rg * 16); q.a = p[0]; q.b = p[1]; }
DI void final_norm_tile(float* X, const float* __restrict__ g, int tile, int wid) {
    const int tid = get_tid(wid);
    const int lane = tid & 63;
    const float* gf = g + lane * 16;
    const float4 g0 = *(const float4*)gf, g1 = *(const float4*)(gf + 4), g2 = *(const float4*)(gf + 8), g3 = *(const float4*)(gf + 12);
#pragma unroll 1
    for (int ti = 0; ti < 8; ++ti) {
        float* xp = X + (size_t)(tile * 64 + wid * 8 + ti) * DM + lane * 16;
        float4 x0 = *(const float4*)xp, x1 = *(const float4*)(xp + 4), x2 = *(const float4*)(xp + 8), x3 = *(const float4*)(xp + 12);
        float ss = x0.x * x0.x + x0.y * x0.y + x0.z * x0.z + x0.w * x0.w + x1.x * x1.x + x1.y * x1.y + x1.z * x1.z + x1.w * x1.w
                 + x2.x * x2.x + x2.y * x2.y + x2.z * x2.z + x2.w * x2.w + x3.x * x3.x + x3.y * x3.y + x3.z * x3.z + x3.w * x3.w;
        ss = wave_sum(ss, lane);
        const float rf = rsqrtf(ss * (1.f / 1024.f) + 1e-6f);
        x0.x *= rf * g0.x; x0.y *= rf * g0.y; x0.z *= rf * g0.z; x0.w *= rf * g0.w; x1.x *= rf * g1.x; x1.y *= rf * g1.y; x1.z *= rf * g1.z; x1.w *= rf * g1.w;
        x2.x *= rf * g2.x; x2.y *= rf * g2.y; x2.z *= rf * g2.z; x2.w *= rf * g2.w; x3.x *= rf * g3.x; x3.y *= rf * g3.y; x3.z *= rf * g3.z; x3.w *= rf * g3.w;
        *(float4*)xp = x0; *(float4*)(xp + 4) = x1; *(float4*)(xp + 8) = x2; *(float4*)(xp + 12) = x3;
    }
}

typedef unsigned char fp4x2_t;
DI void conv_row_fp4_one(float4 v0, float4 v1, float4 v2, float4 v3, fp4x2_t* __restrict__ dst, float* __restrict__ scales, int nrows, int row, int lane) {
    float m = fmaxf(fmaxf(fmaxf(fabsf(v0.x), fabsf(v0.y)), fmaxf(fabsf(v0.z), fabsf(v0.w))), fmaxf(fmaxf(fabsf(v1.x), fabsf(v1.y)), fmaxf(fabsf(v1.z), fabsf(v1.w))));
    m = fmaxf(m, fmaxf(fmaxf(fmaxf(fabsf(v2.x), fabsf(v2.y)), fmaxf(fabsf(v2.z), fabsf(v2.w))), fmaxf(fmaxf(fabsf(v3.x), fabsf(v3.y)), fmaxf(fabsf(v3.z), fabsf(v3.w)))));
    m = fmaxf(m, shx<1>(m, lane)); m = fmaxf(m, shx<2>(m, lane)); m = fmaxf(m, shx<4>(m, lane)); m = fmaxf(m, shx<8>(m, lane)); m = fmaxf(m, shx<16>(m, lane)); m = fmaxf(m, shx<32>(m, lane));
    const float sc = (m > 0.f) ? m * (1.f / 6.f) : 1.f;
    const float inv = 1.f / sc;
    unsigned d0 = 0u, d1 = 0u;
    d0 = __builtin_amdgcn_cvt_scalef32_pk_fp4_f32(d0, v0.x * inv, v0.y * inv, 1.0f, 0); d0 = __builtin_amdgcn_cvt_scalef32_pk_fp4_f32(d0, v0.z * inv, v0.w * inv, 1.0f, 1);
    d0 = __builtin_amdgcn_cvt_scalef32_pk_fp4_f32(d0, v1.x * inv, v1.y * inv, 1.0f, 2); d0 = __builtin_amdgcn_cvt_scalef32_pk_fp4_f32(d0, v1.z * inv, v1.w * inv, 1.0f, 3);
    d1 = __builtin_amdgcn_cvt_scalef32_pk_fp4_f32(d1, v2.x * inv, v2.y * inv, 1.0f, 0); d1 = __builtin_amdgcn_cvt_scalef32_pk_fp4_f32(d1, v2.z * inv, v2.w * inv, 1.0f, 1);
    d1 = __builtin_amdgcn_cvt_scalef32_pk_fp4_f32(d1, v3.x * inv, v3.y * inv, 1.0f, 2); d1 = __builtin_amdgcn_cvt_scalef32_pk_fp4_f32(d1, v3.z * inv, v3.w * inv, 1.0f, 3);
    *(uint2*)(dst + ((size_t)(lane >> 4) * nrows + row) * 128 + (lane & 15) * 8) = make_uint2(d0, d1);
    if (lane == 0) scales[row] = sc;
}
DI void conv_rows_fp4(const float* __restrict__ src, fp4x2_t* __restrict__ dst, float* __restrict__ scales, int nrows, int gwave, int nwaves, int lane) {
#pragma unroll 1
    for (int row = gwave; row < nrows; row += 2 * nwaves) {
        const int r1 = min(row + nwaves, nrows - 1);
        const float4* p0 = (const float4*)(src + (size_t)row * DM + lane * 16);
        const float4* p1 = (const float4*)(src + (size_t)r1 * DM + lane * 16);
        const float4 a0 = p0[0], a1 = p0[1], a2 = p0[2], a3 = p0[3];
        const float4 b0 = p1[0], b1 = p1[1], b2 = p1[2], b3 = p1[3];
        conv_row_fp4_one(a0, a1, a2, a3, dst, scales, nrows, row, lane);
        conv_row_fp4_one(b0, b1, b2, b3, dst, scales, nrows, r1, lane);
    }
}

typedef __attribute__((ext_vector_type(2))) _Float16 h2_t;
DI h2_t cvt4(unsigned w, int b) {
    return b == 0 ? __builtin_amdgcn_cvt_scalef32_pk_f16_fp4(w, 1.0f, 0) : b == 1 ? __builtin_amdgcn_cvt_scalef32_pk_f16_fp4(w, 1.0f, 1)
         : b == 2 ? __builtin_amdgcn_cvt_scalef32_pk_f16_fp4(w, 1.0f, 2) : __builtin_amdgcn_cvt_scalef32_pk_f16_fp4(w, 1.0f, 3);
}
DI void row_axpy32h(h2_t (&acc)[16], const u32x4& r, float c) {
    const _Float16 ch = (_Float16)c; const h2_t c2 = {ch, ch};
#pragma unroll
    for (int b = 0; b < 4; ++b) {
        acc[b] = __builtin_elementwise_fma(c2, cvt4(r.x, b), acc[b]); acc[4 + b] = __builtin_elementwise_fma(c2, cvt4(r.y, b), acc[4 + b]);
        acc[8 + b] = __builtin_elementwise_fma(c2, cvt4(r.z, b), acc[8 + b]); acc[12 + b] = __builtin_elementwise_fma(c2, cvt4(r.w, b), acc[12 + b]);
    }
}
DI void axpy8_4(h2_t (&acc)[16], const u32x4 (&r)[8], const u32x4& c) {
    row_axpy32h(acc, r[0], bf_lo(c.x)); row_axpy32h(acc, r[1], bf_hi(c.x)); row_axpy32h(acc, r[2], bf_lo(c.y)); row_axpy32h(acc, r[3], bf_hi(c.y));
    __builtin_amdgcn_sched_barrier(0);
    row_axpy32h(acc, r[4], bf_lo(c.z)); row_axpy32h(acc, r[5], bf_hi(c.z)); row_axpy32h(acc, r[6], bf_lo(c.w)); row_axpy32h(acc, r[7], bf_hi(c.w));
    __builtin_amdgcn_sched_barrier(0);
}
typedef __attribute__((ext_vector_type(2))) unsigned u32x2_t;
DI h2_t pairsum32(h2_t x, h2_t y) { auto r = __builtin_amdgcn_permlane32_swap(__builtin_bit_cast(unsigned, x), __builtin_bit_cast(unsigned, y), false, false);
                                   return __builtin_bit_cast(h2_t, (unsigned)r[0]) + __builtin_bit_cast(h2_t, (unsigned)r[1]); }
DI h2_t pairsum16(h2_t x, h2_t y) { auto r = __builtin_amdgcn_permlane16_swap(__builtin_bit_cast(unsigned, x), __builtin_bit_cast(unsigned, y), false, false);
                                   return __builtin_bit_cast(h2_t, (unsigned)r[0]) + __builtin_bit_cast(h2_t, (unsigned)r[1]); }
DI h2_t pairsum8(h2_t x, h2_t y, bool hi) {
    const h2_t keep = hi ? y : x, send = hi ? x : y;
    const int rcv = __builtin_amdgcn_update_dpp(0, __builtin_bit_cast(int, send), 0x128, 0xF, 0xF, true);
    return keep + __builtin_bit_cast(h2_t, rcv);
}
DI void peerV4_finish(const PSArgs& a, h2_t (&acc)[16], float4 xv, int tok, int s4, int lane) {
    const int rg = lane >> 3, pc = lane & 7;
    h2_t q8[8], q4[4], q2[2];
#pragma unroll
    for (int k = 0; k < 8; ++k) q8[k] = pairsum32(acc[k], acc[k + 8]);
#pragma unroll
    for (int k = 0; k < 4; ++k) q4[k] = pairsum16(q8[k], q8[k + 4]);
#pragma unroll
    for (int k = 0; k < 2; ++k) q2[k] = pairsum8(q4[k], q4[k + 2], (rg & 1) != 0);
    xv.x += (float)q2[0].x; xv.y += (float)q2[0].y; xv.z += (float)q2[1].x; xv.w += (float)q2[1].y;
    *(float4*)(a.Xout + (size_t)tok * DM + s4 * 256 + 32 * pc + 4 * rg) = xv;
}
DI int run_token2(int n, int k, int nloc, int wid, int th) { return (2 * (k + (n >> 3) * nloc) + th) * 64 + wid * 8 + (n & 7); }

DI void peerV4_run(const PSArgs& a, const fp4x2_t* V4, int s4, int th, int k, int nloc, int wid) {
    const int tid = get_tid(wid);
    const int lane = tid & 63, rg = lane >> 3, pc = lane & 7;
    const unsigned loff = (unsigned)(s4 * (NEXP * 128) + pc * 16);
    const int N = 8 * ((NTOK / 128 - k + nloc - 1) / nloc);
    if (N <= 0) return;
    Ids16 idE, idO; Cf16 cfE, cfO; float4 xE, xO;
    u32x4 rA[8], rB[8];
    const fp8_t* tab = (const fp8_t*)V4;
#define LOAD_X4(x_, tokv) { x_ = *(const float4*)(a.Xin + (size_t)(tokv) * DM + s4 * 256 + 32 * pc + 4 * rg); }
    ids_load(idE, a.EX, run_token2(0, k, nloc, wid, th), rg);
    ids_load(idO, a.EX, run_token2(1, k, nloc, wid, th), rg);
    rows_lo(rA, idE, tab, loff); cf_load(cfE, a.COEF, run_token2(0, k, nloc, wid, th), rg); rows_hi(rB, idE, tab, loff); LOAD_X4(xE, run_token2(0, k, nloc, wid, th));
#pragma unroll 1
    for (int n = 0; n < N; n += 2) {
        const int t0 = run_token2(n, k, nloc, wid, th), t1 = run_token2(n + 1, k, nloc, wid, th);
        const int t2 = run_token2((n + 2 < N) ? n + 2 : N - 1, k, nloc, wid, th), t3 = run_token2((n + 3 < N) ? n + 3 : N - 1, k, nloc, wid, th);
        {
            h2_t acc[16];
#pragma unroll
            for (int i = 0; i < 16; ++i) acc[i] = (h2_t){(_Float16)0.f, (_Float16)0.f};
            axpy8_4(acc, rA, cfE.a);
            rows_lo(rA, idO, tab, loff); cf_load(cfO, a.COEF, t1, rg);
            axpy8_4(acc, rB, cfE.b);
            rows_hi(rB, idO, tab, loff); LOAD_X4(xO, t1);
            ids_load(idE, a.EX, t2, rg);
            peerV4_finish(a, acc, xE, t0, s4, lane);
        }
        {
            h2_t acc[16];
#pragma unroll
            for (int i = 0; i < 16; ++i) acc[i] = (h2_t){(_Float16)0.f, (_Float16)0.f};
            axpy8_4(acc, rA, cfO.a);
            rows_lo(rA, idE, tab, loff); cf_load(cfE, a.COEF, t2, rg);
            axpy8_4(acc, rB, cfO.b);
            rows_hi(rB, idE, tab, loff); LOAD_X4(xE, t2);
            ids_load(idO, a.EX, t3, rg);
            peerV4_finish(a, acc, xO, t1, s4, lane);
        }
    }
#undef LOAD_X4
}

DI unsigned pack_i4x8(const float (&v)[8], float inv) {
    unsigned r = 0u;
#pragma unroll
    for (int i = 0; i < 4; ++i) {
        const int a = (int)fminf(fmaxf(rintf(v[i] * inv), -7.f), 7.f), b = (int)fminf(fmaxf(rintf(v[4 + i] * inv), -7.f), 7.f);
        r |= ((unsigned)a & 15u) << (8 * i); r |= ((unsigned)b & 15u) << (8 * i + 4);
    }
    return r;
}
DI void conv_rows_int4g(const float* __restrict__ src, const float* __restrict__ gain, fp4x2_t* __restrict__ dst, float* __restrict__ scales,
                        int nrows, int gwave, int nwaves, int lane) {
    const float4* g = (const float4*)(gain + lane * 16);
    const float4 g0 = g[0], g1 = g[1], g2 = g[2], g3 = g[3];
#pragma unroll 1
    for (int row = gwave; row < nrows; row += nwaves) {
        const float4* p0 = (const float4*)(src + (size_t)row * DM + lane * 16);
        const float4 a0 = p0[0], a1 = p0[1], a2 = p0[2], a3 = p0[3];
        const float v0[8] = {a0.x * g0.x, a0.y * g0.y, a0.z * g0.z, a0.w * g0.w, a1.x * g1.x, a1.y * g1.y, a1.z * g1.z, a1.w * g1.w};
        const float v1[8] = {a2.x * g2.x, a2.y * g2.y, a2.z * g2.z, a2.w * g2.w, a3.x * g3.x, a3.y * g3.y, a3.z * g3.z, a3.w * g3.w};
        float ss = 0.f;
#pragma unroll
        for (int i = 0; i < 8; ++i) ss += v0[i] * v0[i] + v1[i] * v1[i];
        ss = wave_sum(ss, lane);
        const float rms = sqrtf(ss * (1.f / 1024.f));
        const float step = (rms > 0.f) ? 0.36f * rms : 1.f, inv = 1.f / step;
        *(uint2*)(dst + ((size_t)(lane >> 4) * nrows + row) * 128 + (lane & 15) * 8) = make_uint2(pack_i4x8(v0, inv), pack_i4x8(v1, inv));
        if (lane == 0) scales[row] = step;
    }
}
struct HP8 { u32x4 h, l; float sh; };
DI void hp_load(HP8& q, const PSArgs& a, int tok, int s4, int pc) {
    q.h = *(const u32x4*)(a.HPH + (size_t)tok * 128 + s4 * 32 + pc * 4); q.l = *(const u32x4*)(a.HPL + (size_t)tok * 128 + s4 * 32 + pc * 4);
    q.sh = a.HS[(size_t)tok * 4 + s4];
}
DI float row_dot32q(const u32x4& r, const HP8& q) {
    int ah = 0, al = 0;
    ah = __builtin_amdgcn_sdot8((int)r.x, (int)q.h.x, ah, false); al = __builtin_amdgcn_sdot8((int)r.x, (int)q.l.x, al, false);
    ah = __builtin_amdgcn_sdot8((int)r.y, (int)q.h.y, ah, false); al = __builtin_amdgcn_sdot8((int)r.y, (int)q.l.y, al, false);
    ah = __builtin_amdgcn_sdot8((int)r.z, (int)q.h.z, ah, false); al = __builtin_amdgcn_sdot8((int)r.z, (int)q.l.z, al, false);
    ah = __builtin_amdgcn_sdot8((int)r.w, (int)q.h.w, ah, false); al = __builtin_amdgcn_sdot8((int)r.w, (int)q.l.w, al, false);
    return (float)(ah * 16 + al) * q.sh;
}
DI void peerUi_run(const PSArgs& a, const fp4x2_t* U4, int s4, int th, int k, int nloc, int wid) {
    const int tid = get_tid(wid);
    const int lane = tid & 63, rg = lane >> 3, pc = lane & 7;
    const unsigned loff = (unsigned)(s4 * (NEXP * 128) + pc * 16);
    const int N = 8 * ((NTOK / 128 - k + nloc - 1) / nloc);
    if (N <= 0) return;
    Ids16 idE, idO; HP8 hE, hO;
    u32x4 rA[8], rB[8];
    const fp8_t* tab = (const fp8_t*)U4;
    ids_load(idE, a.EX, run_token2(0, k, nloc, wid, th), rg);
    ids_load(idO, a.EX, run_token2(1, k, nloc, wid, th), rg);
    rows_lo(rA, idE, tab, loff); hp_load(hE, a, run_token2(0, k, nloc, wid, th), s4, pc); rows_hi(rB, idE, tab, loff);
#pragma unroll 1
    for (int n = 0; n < N; n += 2) {
        const int t0 = run_token2(n, k, nloc, wid, th), t1 = run_token2(n + 1, k, nloc, wid, th);
        const int t2 = run_token2((n + 2 < N) ? n + 2 : N - 1, k, nloc, wid, th), t3 = run_token2((n + 3 < N) ? n + 3 : N - 1, k, nloc, wid, th);
        {
            float p[16];
#pragma unroll
            for (int i = 0; i < 8; ++i) p[i] = row_dot32q(rA[i], hE);
            rows_lo(rA, idO, tab, loff); hp_load(hO, a, t1, s4, pc);
#pragma unroll
            for (int i = 0; i < 8; ++i) p[8 + i] = row_dot32q(rB[i], hE);
            rows_hi(rB, idO, tab, loff);
            ids_load(idE, a.EX, t2, rg);
            peerU_finish(a, p, t0, s4, lane);
        }
        {
            float p[16];
#pragma unroll
            for (int i = 0; i < 8; ++i) p[i] = row_dot32q(rA[i], hO);
            rows_lo(rA, idE, tab, loff); hp_load(hE, a, t2, s4, pc);
#pragma unroll
            for (int i = 0; i < 8; ++i) p[8 + i] = row_dot32q(rB[i], hO);
            rows_hi(rB, idE, tab, loff);
            ids_load(idO, a.EX, t3, rg);
            peerU_finish(a, p, t1, s4, lane);
        }
    }
}
struct MegaArgs {
    const float* x; const float* a_re; const float* a_im; const float* log_dt; const float* b_re; const float* b_im; const float* c_re;
    const float* c_im; const float* d_skip; const float* b_glu; const float* pool_scale; const float* u_exp; const float* v_exp;
    const float* norm_final;
    PrepW pw;
    float* X; bf16_t* U; bf16_t* YPRE; bf16_t* G1; bf16_t* A2; bf16_t* Hb; bf16_t* Qb; unsigned short* EX; float* GT; float* RSTD;
    char* KT; bf16x8* WST; bf16x8* CCAR; float* ABT; fp4x2_t* U4; fp4x2_t* V4; float* SU; float* SV; float* PD; bf16_t* COEF; unsigned* HPH; unsigned* HPL; float* HS;
    unsigned* bar;
    int coop_probe; int pad_;
};

#ifndef REP_P0
#define REP_P0 1
#endif
#ifndef REP_PA
#define REP_PA 1
#endif
#ifndef REP_PB
#define REP_PB 1
#endif
#ifndef REP_C1
#define REP_C1 1
#endif
#ifndef REP_C2
#define REP_C2 1
#endif
#ifndef REP_U
#define REP_U 1
#endif
#ifndef REP_R
#define REP_R 1
#endif
#ifndef REP_V
#define REP_V 1
#endif
#ifndef REP_BAR
#define REP_BAR 1
#endif
#define XBAR() do { for (int rb_ = 0; rb_ < REP_BAR; ++rb_) xcd_barrier(xb, wid); } while (0)
__global__ void __launch_bounds__(NTHR) mega_kernel(MegaArgs a) {
    __shared__ __attribute__((aligned(16))) char smem[PB_BYTES];
    __shared__ uint4 xb_words;
    cg::grid_group grid = cg::this_grid();
    const int nblk = gridDim.x;
    const int wid = __builtin_amdgcn_readfirstlane(threadIdx.x >> 6);
    if (get_tid(wid) == 0) xb_words = make_uint4(0u, 0u, 0u, 0u);
    __syncthreads();
    const XcdBarrier xb = xcd_barrier_post(a.bar, (volatile LAS unsigned*)&xb_words, get_tid(wid));
    for (int rep = 0; rep < REP_P0; ++rep) {
        const size_t gtid = (size_t)blockIdx.x * NTHR + get_tid(wid), gs = (size_t)nblk * NTHR;
        for (int it = blockIdx.x; it < 256; it += nblk)
            prep_s5_item(it >> 2, it & 3, a.a_re, a.a_im, a.log_dt, a.b_re, a.b_im, a.c_re, a.c_im, a.d_skip, a.KT, a.WST, a.CCAR, a.ABT, smem, wid);
        prep_weights(a.pw, gtid, gs);
        for (int l = 0; l < 2; ++l) {
            conv_kfrag(a.pw.k1 + (size_t)l * 128 * 128, a.pw.wfk1 + (size_t)l * (128 * 128 / 8), gtid, gs);
            conv_kfrag(a.pw.k2 + (size_t)l * 128 * 128, a.pw.wfk2 + (size_t)l * (128 * 128 / 8), gtid, gs);
        }
        {
            int tid = get_tid(wid);
            const int gwave = blockIdx.x * 8 + (tid >> 6), nwaves = nblk * 8, lane = tid & 63;
#pragma unroll 1
            for (int l = 0; l < 2; ++l) {
                conv_rows_int4g(a.u_exp + (size_t)l * NEXP * DM, a.pw.norm_ffn + l * DM, a.U4 + (size_t)l * NEXP * (DM / 2), a.SU + l * NEXP, NEXP, gwave, nwaves, lane);
                conv_rows_fp4(a.v_exp + (size_t)l * NEXP * DM, a.V4 + (size_t)l * NEXP * (DM / 2), a.SV + l * NEXP, NEXP, gwave, nwaves, lane);
            }
        }
    }
    XBAR();
    if (a.coop_probe) grid.sync();
    __shared__ int sched[4];
    if (get_tid(wid) == 0) {
        int nx = 0, myj = 0, nloc = 1;
        for (unsigned j = 0; j < 16; ++j) {
            const unsigned cj = xb_ld(&a.bar[XB_XCNT(j)]);
            if (j == xb.x) { myj = nx; nloc = (int)cj; }
            nx += (cj > 0u) ? 1 : 0;
        }
        sched[0] = (int)xb.st[2]; sched[1] = nloc > 0 ? nloc : 1; sched[2] = myj; sched[3] = nx > 0 ? nx : 1;
    }
    __syncthreads();
    const int s_rank = sched[0], s_nloc = sched[1], s_myj = sched[2], s_nx = sched[3];
#pragma unroll 1
    for (int l = 0; l < 2; ++l) {
        const float* xin = (l == 0) ? a.x : a.X;
        if (l == 0) {
            for (int rep = 0; rep < REP_PA; ++rep)
            for (int tile = blockIdx.x; tile < NTOK / 64; tile += nblk) phaseA_tile(xin, a.pw.wfin, a.U, tile, smem, wid);
        }
        XBAR();
        bf16_t* Ul = a.U + (size_t)l * NTOK * DM;
        for (int rep = 0; rep < REP_PB; ++rep)
        for (int tile = blockIdx.x; tile < 256; tile += nblk)
            phaseB_tile(Ul, a.KT + (size_t)l * 32 * KT_BYTES, a.WST + (size_t)l * 32 * WST_FRAGS, a.CCAR + (size_t)l * 32 * CCAR_FRAGS, a.ABT + l * 32 * 128, a.YPRE, tile, smem, wid);
        XBAR();
        PCArgs pa; pa.U = Ul; pa.YPRE = a.YPRE; pa.G1 = a.G1; pa.A2 = a.A2; pa.Xin = xin; pa.Xout = a.X; pa.Xdummy = (float*)a.Qb; pa.HPH = a.HPH; pa.HPL = a.HPL; pa.HS = a.HS; pa.Hb = a.Hb; pa.RSTD = a.RSTD;
        pa.wfglu = a.pw.wfglu + (size_t)l * (512 * 512 / 8); pa.b_glu = a.b_glu + l * 512; pa.wfpool = a.pw.wfpool + (size_t)l * 4 * (128 * 128 / 8);
        pa.pool_scale = a.pool_scale + l * 512; pa.wfout = a.pw.wfout + (size_t)l * (DM * DM / 8);
        PRArgs pr; pr.Hb = a.Hb; pr.RSTD = a.RSTD; pr.wfq = a.pw.wfq + (size_t)l * (DM * 2048 / 8); pr.kf1 = a.pw.wfk1 + (size_t)l * (128 * 128 / 8);
        pr.kf2 = a.pw.wfk2 + (size_t)l * (128 * 128 / 8); pr.EX = a.EX; pr.GT = a.GT;
        for (int tile = blockIdx.x; tile < NTOK / 64; tile += nblk) {
            for (int rep = 1; rep < REP_C1; ++rep) { PCArgs pa2 = pa; pa2.Xout = (float*)a.Qb; phaseC1_tile(pa2, tile, smem, wid); }
            phaseC1_tile(pa, tile, smem, wid);
            for (int rep = 0; rep < REP_C2; ++rep) phaseC2_tile(pr, tile, smem, wid);
        }
        XBAR();
        PSArgs ps; ps.Hb = a.Hb; ps.RSTD = a.RSTD; ps.EX = a.EX; ps.GT = a.GT;
        ps.SU = a.SU + l * NEXP; ps.SV = a.SV + l * NEXP; ps.PD = a.PD; ps.COEF = a.COEF; ps.Xin = a.X; ps.Xout = a.X; ps.HPH = a.HPH; ps.HPL = a.HPL; ps.HS = a.HS;
        for (int rep = 0; rep < REP_U; ++rep) {
            for (int v = s_myj; v < 8; v += s_nx) peerUi_run(ps, a.U4 + (size_t)l * NEXP * (DM / 2), v & 3, v >> 2, s_rank, s_nloc, wid);
        }
        XBAR();
        for (int rep = 0; rep < REP_R; ++rep)
        for (int tile = blockIdx.x; tile < NTOK / 64; tile += nblk) peerR_tile(ps, tile, wid);
        XBAR();
        for (int rep = 1; rep < REP_V; ++rep) { PSArgs ps2 = ps; ps2.Xout = (float*)a.Qb; for (int v = s_myj; v < 8; v += s_nx) peerV4_run(ps2, a.V4 + (size_t)l * NEXP * (DM / 2), v & 3, v >> 2, s_rank, s_nloc, wid); }
        for (int v = s_myj; v < 8; v += s_nx) peerV4_run(ps, a.V4 + (size_t)l * NEXP * (DM / 2), v & 3, v >> 2, s_rank, s_nloc, wid);
        XBAR();
        if (l == 0) {
            for (int rep = 0; rep < REP_PA; ++rep)
            for (int tile = blockIdx.x; tile < NTOK / 64; tile += nblk) phaseA_tile(a.X, a.pw.wfin + (size_t)(DM * DM / 8), a.U + (size_t)NTOK * DM, tile, smem, wid);
        } else {
            for (int tile = blockIdx.x; tile < NTOK / 64; tile += nblk) final_norm_tile(a.X, a.norm_final, tile, wid);
        }
    }
}

extern "C" void kernel_launch(void* const* d_in, const int* in_sizes, int n_in, void* d_out, int out_size, void* d_ws, size_t ws_size,
                              hipStream_t stream) {
    char* wsb = (char*)d_ws;
    size_t off = 0;
    auto take = [&](size_t bytes) { char* p = wsb + off; off += (bytes + 255) & ~(size_t)255; return p; };
    MegaArgs a;
    memset(&a, 0, sizeof(a));
    a.x = (const float*)d_in[0];
    a.pw.norm_mix = (const float*)d_in[1]; a.pw.w_in = (const float*)d_in[2];
    a.a_re = (const float*)d_in[3]; a.a_im = (const float*)d_in[4]; a.log_dt = (const float*)d_in[5];
    a.b_re = (const float*)d_in[6]; a.b_im = (const float*)d_in[7]; a.c_re = (const float*)d_in[8]; a.c_im = (const float*)d_in[9];
    a.d_skip = (const float*)d_in[10]; a.pw.w_glu = (const float*)d_in[11]; a.b_glu = (const float*)d_in[12];
    a.pw.w_pool = (const float*)d_in[13]; a.pool_scale = (const float*)d_in[14]; a.pw.g_out_ssm = (const float*)d_in[15];
    a.pw.g_out_pool = (const float*)d_in[16]; a.pw.w_out = (const float*)d_in[17]; a.pw.norm_ffn = (const float*)d_in[18];
    a.pw.w_q = (const float*)d_in[19]; a.pw.k1 = (const float*)d_in[20]; a.pw.k2 = (const float*)d_in[21];
    a.u_exp = (const float*)d_in[22]; a.v_exp = (const float*)d_in[23]; a.norm_final = (const float*)d_in[24];
    a.X = (float*)d_out;
    a.U = (bf16_t*)take((size_t)2 * NTOK * DM * 2);
    a.YPRE = (bf16_t*)take((size_t)NTOK * 512 * 2);
    a.G1 = (bf16_t*)take((size_t)NTOK * 512 * 2);
    a.A2 = (bf16_t*)take((size_t)NTOK * DM * 2);
    a.Hb = (bf16_t*)take((size_t)NTOK * DM * 2);
    a.Qb = (bf16_t*)take((size_t)NTOK * 2048 * 2);
    a.EX = (unsigned short*)take((size_t)NTOK * 128 * 2);
    a.GT = (float*)take((size_t)NTOK * 128 * 4);
    a.RSTD = (float*)take(NTOK * 4);
    a.pw.wfin = (bf16x8*)take((size_t)2 * DM * DM * 2);
    a.pw.wfglu = (bf16x8*)take((size_t)2 * 512 * 512 * 2);
    a.pw.wfpool = (bf16x8*)take((size_t)2 * 4 * 128 * 128 * 2);
    a.pw.wfout = (bf16x8*)take((size_t)2 * DM * DM * 2);
    a.pw.wfq = (bf16x8*)take((size_t)2 * DM * 2048 * 2);
    a.pw.wfk1 = (bf16x8*)take((size_t)2 * 128 * 128 * 2);
    a.pw.wfk2 = (bf16x8*)take((size_t)2 * 128 * 128 * 2);
    a.KT = take((size_t)64 * KT_BYTES);
    a.WST = (bf16x8*)take((size_t)64 * WST_FRAGS * 16);
    a.CCAR = (bf16x8*)take((size_t)64 * CCAR_FRAGS * 16);
    a.ABT = (float*)take(64 * 128 * 4);
    a.V4 = (fp4x2_t*)take((size_t)2 * NEXP * (DM / 2));
    a.U4 = (fp4x2_t*)take((size_t)2 * NEXP * (DM / 2));
    a.SU = (float*)take((size_t)2 * NEXP * 4);
    a.SV = (float*)take((size_t)2 * NEXP * 4);
    a.PD = (float*)take((size_t)NUSL * NTOK * 128 * 4);
    a.COEF = (bf16_t*)take((size_t)NTOK * 128 * 2);
    a.HPH = (unsigned*)take((size_t)NTOK * 128 * 4);
    a.HPL = (unsigned*)take((size_t)NTOK * 128 * 4);
    a.HS = (float*)take((size_t)NTOK * 4 * 4);
    a.bar = (unsigned*)take((size_t)XCD_BAR_WORDS * 4);
    hipMemsetAsync(a.bar, 0, (size_t)XCD_BAR_WORDS * 4, stream);

    static int grid_blocks = 0;
    if (!grid_blocks) {
        int dev = 0, cus = 0, per_cu = 0;
        hipGetDevice(&dev);
        hipDeviceGetAttribute(&cus, hipDeviceAttributeMultiprocessorCount, dev);
        hipOccupancyMaxActiveBlocksPerMultiprocessor(&per_cu, mega_kernel, NTHR, 0);
        if (per_cu > 1) per_cu = 1;
        grid_blocks = cus * per_cu;
        if (grid_blocks > 256) grid_blocks = 256;
    }
    void* args[] = {&a};
    hipError_t e = hipLaunchCooperativeKernel((void*)mega_kernel, dim3(grid_blocks), dim3(NTHR), args, 0, stream);
    if (e != hipSuccess) fprintf(stderr, "cooperative launch failed: %s (grid %d)\n", hipGetErrorString(e), grid_blocks);
}
```

```cpp
#include <hip/hip_runtime.h>
#include <hip/hip_cooperative_groups.h>
#include <cstdio>
#include <cstring>
namespace cg = cooperative_groups;
#include <math.h>
#include <stdint.h>

#define NTOK 16384
#define SEQ 2048
#define DM 1024
#define SSMW 512
#define NEXP 16384

__device__ __forceinline__ float gelu_exact(float x) { return 0.5f * x * (1.f + erff(x * 0.70710678118654752f)); }

template <int M> __device__ __forceinline__ int shx_i(int v, int lane) {
    if constexpr (M == 1) return __builtin_amdgcn_mov_dpp(v, 0xB1, 0xF, 0xF, true);
    else if constexpr (M == 2) return __builtin_amdgcn_mov_dpp(v, 0x4E, 0xF, 0xF, true);
    else if constexpr (M < 32) return __builtin_amdgcn_ds_swizzle(v, (M << 10) | 0x1F);
    else return __builtin_amdgcn_ds_bpermute((lane ^ 32) << 2, v);
}
template <int M> __device__ __forceinline__ float shx(float v, int lane) { return __int_as_float(shx_i<M>(__float_as_int(v), lane)); }
__device__ __forceinline__ float wave_sum(float v, int lane) {
    v += shx<1>(v, lane); v += shx<2>(v, lane); v += shx<4>(v, lane); v += shx<8>(v, lane); v += shx<16>(v, lane); v += shx<32>(v, lane);
    return v;
}

__device__ __forceinline__ int get_tid(int wid) {
    int t = wid * 64 + (int)__builtin_amdgcn_mbcnt_hi(~0u, __builtin_amdgcn_mbcnt_lo(~0u, 0u));
    asm volatile("" : "+v"(t));
    return t;
}

#define DI __device__ __forceinline__
typedef __attribute__((ext_vector_type(8))) short bf16x8;
typedef __attribute__((ext_vector_type(16))) float f32x16;
typedef __attribute__((ext_vector_type(2))) __bf16 bf2_t;
typedef __attribute__((ext_vector_type(2))) float f2_t;
typedef unsigned short bf16_t;
typedef __attribute__((ext_vector_type(4))) unsigned u32x4;
typedef __attribute__((ext_vector_type(4))) float f32x4;
typedef const __attribute__((address_space(1))) bf16x8* gwp_t;
#define MFMA32(a, b, c) __builtin_amdgcn_mfma_f32_32x32x16_bf16((a), (b), (c), 0, 0, 0)

DI unsigned pack_bf2(float a, float b) { f2_t v = {a, b}; return __builtin_bit_cast(unsigned, __builtin_convertvector(v, bf2_t)); }
DI float bf_lo(unsigned u) { return __uint_as_float(u << 16); }
DI float bf_hi(unsigned u) { return __uint_as_float(u & 0xffff0000u); }
DI int crow(int reg, int h) { return (reg & 3) + 8 * (reg >> 2) + 4 * h; }

#define SA_STRIDE 272
#define SA_BYTES (64 * SA_STRIDE)
#define NTHR 512

template <bool GAIN>
DI void conv_wfrag(const float* __restrict__ src, int ldk, int ldn, const float* __restrict__ ga, const float* __restrict__ gb, int split,
                   int K, int N, int NTG, bf16x8* __restrict__ dst, size_t gtid, size_t gstride) {
    const int KS = K / 16;
    const size_t total = (size_t)(N / 32) * KS * 64;
    for (size_t item = gtid; item < total; item += gstride) {
        const int lane = (int)(item & 63); const size_t f = item >> 6;
        const int nti = (int)(f % NTG); const size_t f2 = f / NTG;
        const int ks = (int)(f2 % KS), nt = (int)(f2 / KS) * NTG + nti;
        const int r = lane & 31, h = lane >> 5;
        const int n = nt * 32 + r, k0 = ks * 16 + 8 * h;
        float v[8];
#pragma unroll
        for (int j = 0; j < 8; ++j) {
            const int k = k0 + j;
            float g = 1.f;
            if (GAIN) g = (k < split) ? ga[k] : gb[k - split];
            v[j] = src[(size_t)k * ldk + (size_t)n * ldn] * g;
        }
        uint4 o; o.x = pack_bf2(v[0], v[1]); o.y = pack_bf2(v[2], v[3]); o.z = pack_bf2(v[4], v[5]); o.w = pack_bf2(v[6], v[7]);
        *(uint4*)(dst + item) = o;
    }
}

DI void conv_rows_bf16(const float* __restrict__ src, const float* __restrict__ gain, bf16_t* __restrict__ dst, size_t nelem, size_t gtid, size_t gstride) {
    for (size_t i = gtid * 8; i < nelem; i += gstride * 8) {
        float4 a = *(const float4*)(src + i), b = *(const float4*)(src + i + 4);
        if (gain) {
            const int c = (int)(i & 1023);
            float4 g0 = *(const float4*)(gain + c), g1 = *(const float4*)(gain + c + 4);
            a.x *= g0.x; a.y *= g0.y; a.z *= g0.z; a.w *= g0.w; b.x *= g1.x; b.y *= g1.y; b.z *= g1.z; b.w *= g1.w;
        }
        uint4 o; o.x = pack_bf2(a.x, a.y); o.y = pack_bf2(a.z, a.w); o.z = pack_bf2(b.x, b.y); o.w = pack_bf2(b.z, b.w);
        *(uint4*)(dst + i) = o;
    }
}

struct ALoadF32 {
    const float* base; f32x4 v0, v1, v2, v3; float ss; int dofs;
    DI void init(const float* rowbase, int tid) { base = rowbase + (tid & 7) * 16; ss = 0.f; dofs = (tid >> 3) * SA_STRIDE + (tid & 7) * 32; }
    DI void issue(int c) { const f32x4* p = (const f32x4*)(base + c * 128); v0 = p[0]; v1 = p[1]; v2 = p[2]; v3 = p[3]; }
    DI void commit(char* buf) {
        u32x4 o0, o1;
        ss += v0.x * v0.x + v0.y * v0.y + v0.z * v0.z + v0.w * v0.w + v1.x * v1.x + v1.y * v1.y + v1.z * v1.z + v1.w * v1.w
            + v2.x * v2.x + v2.y * v2.y + v2.z * v2.z + v2.w * v2.w + v3.x * v3.x + v3.y * v3.y + v3.z * v3.z + v3.w * v3.w;
        o0.x = pack_bf2(v0.x, v0.y); o0.y = pack_bf2(v0.z, v0.w); o0.z = pack_bf2(v1.x, v1.y); o0.w = pack_bf2(v1.z, v1.w);
        o1.x = pack_bf2(v2.x, v2.y); o1.y = pack_bf2(v2.z, v2.w); o1.z = pack_bf2(v3.x, v3.y); o1.w = pack_bf2(v3.z, v3.w);
        char* d = buf + dofs;
        *(u32x4*)d = o0; *(u32x4*)(d + 16) = o1;
    }
};
struct ALoadBF16 {
    const bf16_t* base; u32x4 v0, v1; int dofs;
    DI void init(const bf16_t* rowbase, int tid) { base = rowbase + (tid & 7) * 16; dofs = (tid >> 3) * SA_STRIDE + (tid & 7) * 32; }
    DI void issue(int c) { const u32x4* p = (const u32x4*)(base + c * 128); v0 = p[0]; v1 = p[1]; }
    DI void commit(char* buf) {
        char* d = buf + dofs;
        *(u32x4*)d = v0; *(u32x4*)(d + 16) = v1;
    }
};

template <int NT, int PF, class AL>
DI void gemm64(f32x16 (&acc)[NT][2], AL& al, const int nchunks, const bf16x8* __restrict__ wf_, char* sA, const int lane) {
    gwp_t wf = (gwp_t)wf_;
    const int r = lane & 31, h = lane >> 5;
    bf16x8 bq[PF][NT];
    al.issue(0);
#pragma unroll
    for (int p = 0; p < PF; ++p)
#pragma unroll
        for (int nt = 0; nt < NT; ++nt) bq[p][nt] = wf[(p * NT + nt) * 64];
    gwp_t wpf = wf + PF * NT * 64;
    al.commit(sA);
    const int kend = nchunks * 8 - PF;
    int kg = 0;
#pragma unroll 1
    for (int c = 0; c < nchunks; ++c) {
        if (c + 1 < nchunks) al.issue(c + 1);
        __syncthreads();
        const char* buf = sA + (c & 1) * SA_BYTES + r * SA_STRIDE + h * 16;
#pragma unroll
        for (int ks = 0; ks < 8; ++ks) {
            const bf16x8 a0 = *(const bf16x8*)(buf + ks * 32);
            const bf16x8 a1 = *(const bf16x8*)(buf + 32 * SA_STRIDE + ks * 32);
#pragma unroll
            for (int nt = 0; nt < NT; ++nt) {
                acc[nt][0] = MFMA32(bq[ks % PF][nt], a0, acc[nt][0]);
                acc[nt][1] = MFMA32(bq[ks % PF][nt], a1, acc[nt][1]);
            }
            if (kg < kend) {
#pragma unroll
                for (int nt = 0; nt < NT; ++nt) bq[ks % PF][nt] = wpf[nt * 64];
            }
            wpf += NT * 64; ++kg;
            asm volatile("" : "+v"(wpf));
        }
        if (c + 1 < nchunks) al.commit(sA + ((c + 1) & 1) * SA_BYTES);
    }
    __syncthreads();
}

template <int NT>
DI void zero_acc(f32x16 (&acc)[NT][2]) {
#pragma unroll
    for (int nt = 0; nt < NT; ++nt)
#pragma unroll
        for (int mt = 0; mt < 2; ++mt)
#pragma unroll
            for (int i = 0; i < 16; ++i) acc[nt][mt][i] = 0.f;
}


DI void tile_transpose(const f32x16& t, float* wscr, int lane, f32x4 (&out)[4]) {
    const int r = lane & 31, h = lane >> 5;
#pragma unroll
    for (int q = 0; q < 4; ++q) { f32x4 v = {t[4 * q], t[4 * q + 1], t[4 * q + 2], t[4 * q + 3]}; *(f32x4*)(wscr + r * 36 + 8 * q + 4 * h) = v; }
#pragma unroll
    for (int j = 0; j < 4; ++j) out[j] = *(const f32x4*)(wscr + ((lane >> 3) + 8 * j) * 36 + (lane & 7) * 4);
}
#define WSCR_BYTES (32 * 36 * 4)

DI void phaseA_tile(const float* __restrict__ X, const bf16x8* __restrict__ wfin, bf16_t* __restrict__ U, int tile, char* smem, int wid) {
    char* sA = smem; float* srstd = (float*)(smem + 8 * WSCR_BYTES);
    int tok0 = tile * 64; asm volatile("" : "+s"(tok0));
    int tid = get_tid(wid);
    const int w = __builtin_amdgcn_readfirstlane(tid >> 6), lane = tid & 63, r = lane & 31, h = lane >> 5;
    ALoadF32 al; al.init(X + (size_t)(tok0 + (tid >> 3)) * DM, tid);
    f32x16 acc[4][2]; zero_acc<4>(acc);
    gemm64<4, 2>(acc, al, 8, wfin + (size_t)w * (64 * 4 * 64) + lane, sA, lane);
    float ss = al.ss;
    ss += shx<1>(ss, lane); ss += shx<2>(ss, lane); ss += shx<4>(ss, lane);
    if ((tid & 7) == 0) srstd[tid >> 3] = rsqrtf(ss * (1.f / 1024.f) + 1e-6f);
    __syncthreads();
    {
        float* wscr = (float*)(smem + w * WSCR_BYTES);
        const int tl = lane >> 3, cl = (lane & 7) * 4;
#pragma unroll
        for (int mt = 0; mt < 2; ++mt) {
            float rs[4];
#pragma unroll
            for (int j = 0; j < 4; ++j) rs[j] = srstd[mt * 32 + tl + 8 * j];
#pragma unroll
            for (int nt = 0; nt < 4; ++nt) {
                f32x4 o[4]; tile_transpose(acc[nt][mt], wscr, lane, o);
#pragma unroll
                for (int j = 0; j < 4; ++j) {
                    uint2 p; p.x = pack_bf2(o[j].x * rs[j], o[j].y * rs[j]); p.y = pack_bf2(o[j].z * rs[j], o[j].w * rs[j]);
                    *(uint2*)(U + (size_t)(tok0 + mt * 32 + tl + 8 * j) * DM + w * 128 + nt * 32 + cl) = p;
                }
            }
        }
    }
    __syncthreads();
}

struct PrepW {
    const float* norm_mix; const float* w_in; const float* w_glu; const float* w_pool; const float* g_out_ssm; const float* g_out_pool;
    const float* w_out; const float* norm_ffn; const float* w_q; const float* k1; const float* k2;
    bf16x8* wfin; bf16x8* wfglu; bf16x8* wfpool; bf16x8* wfout; bf16x8* wfq; bf16x8* wfk1; bf16x8* wfk2;
};
DI void prep_weights(const PrepW& p, size_t gtid, size_t gs) {
#pragma unroll 1
    for (int l = 0; l < 2; ++l) {
        conv_wfrag<true>(p.w_in + (size_t)l * DM * DM, DM, 1, p.norm_mix + l * DM, p.norm_mix + l * DM, DM, DM, DM, 4, p.wfin + (size_t)l * (DM * DM / 8), gtid, gs);
        conv_wfrag<false>(p.w_glu + (size_t)l * 512 * 512, 512, 1, p.norm_mix, p.norm_mix, 512, 512, 512, 2, p.wfglu + (size_t)l * (512 * 512 / 8), gtid, gs);
#pragma unroll 1
        for (int gi = 0; gi < 4; ++gi)
            conv_wfrag<false>(p.w_pool + (size_t)(l * 4 + gi) * 128 * 128, 128, 1, p.norm_mix, p.norm_mix, 128, 128, 128, 2, p.wfpool + (size_t)(l * 4 + gi) * (128 * 128 / 8), gtid, gs);
        conv_wfrag<true>(p.w_out + (size_t)l * DM * DM, DM, 1, p.g_out_ssm + l * 512, p.g_out_pool + l * 512, 512, DM, DM, 4, p.wfout + (size_t)l * (DM * DM / 8), gtid, gs);
        conv_wfrag<true>(p.w_q + (size_t)l * DM * 2048, 2048, 1, p.norm_ffn + l * DM, p.norm_ffn + l * DM, DM, DM, 2048, 4, p.wfq + (size_t)l * (DM * 2048 / 8), gtid, gs);
    }
}
#define KT_BLK 528
#define KT_BYTES (65 * KT_BLK)
#define WST_FRAGS (4 * 64 * 64)
#define CCAR_FRAGS (32 * 8 * 64)
#define SU_CH 2064

DI void prep_s5_item(int lg, int part, const float* __restrict__ a_re, const float* __restrict__ a_im, const float* __restrict__ log_dt,
                     const float* __restrict__ b_re, const float* __restrict__ b_im, const float* __restrict__ c_re, const float* __restrict__ c_im,
                     const float* __restrict__ d_skip, char* __restrict__ KT, bf16x8* __restrict__ WST, bf16x8* __restrict__ CCAR,
                     float* __restrict__ ABT, char* smem, int wid) {
    float* powr = (float*)smem;
    float* powi = powr + 65 * 64;
    float* bzr = powi + 65 * 64;
    float* bzi = bzr + 1024;
    float* cr = bzi + 1024;
    float* ci = cr + 1024;
    int tid = get_tid(wid);
    const float* are_p = a_re + lg * 64; const float* aim_p = a_im + lg * 64;
    const float dt = expf(log_dt[lg]);
    for (int it = tid; it < 65 * 64; it += NTHR) {
        const int tau = it >> 6, p = it & 63;
        const float lre = are_p[p], lim = aim_p[p];
        const float mag = expf((float)tau * lre * dt);
        double rev = (double)lim * (double)dt * (double)tau * 0.15915494309189535;
        rev -= floor(rev);
        const float ang = (float)rev * 6.283185307179586f;
        powr[it] = mag * cosf(ang); powi[it] = mag * sinf(ang);
    }
    for (int it = tid; it < 1024; it += NTHR) {
        cr[it] = c_re[lg * 1024 + it]; ci[it] = c_im[lg * 1024 + it];
    }
    __syncthreads();
    for (int it = tid; it < 1024; it += NTHR) {
        const int p = it >> 4;
        const float lre = are_p[p], lim = aim_p[p];
        const float ar = powr[64 + p], ai = powi[64 + p];
        const float inv = 1.f / (lre * lre + lim * lim), nre = ar - 1.f;
        const float zre = (nre * lre + ai * lim) * inv, zim = (ai * lre - nre * lim) * inv;
        const float br = b_re[lg * 1024 + it], bi = b_im[lg * 1024 + it];
        bzr[it] = zre * br - zim * bi; bzi[it] = zre * bi + zim * br;
    }
    __syncthreads();
    if (part == 0 && tid < 64) { ABT[lg * 128 + 2 * tid] = powr[64 * 64 + tid]; ABT[lg * 128 + 2 * tid + 1] = powi[64 * 64 + tid]; }
    char* kt = KT + (size_t)lg * KT_BYTES;
    if (part == 0) for (int it = tid; it < KT_BLK / 4; it += NTHR) ((unsigned*)kt)[it] = 0u;
    for (int it = part * (16 * 128) + tid; it < (part + 1) * (16 * 128); it += NTHR) {
        const int tau = it >> 7, ho = (it >> 3) & 15, hi = (it & 7) * 2;
        float s0 = 0.f, s1 = 0.f;
        for (int p = 0; p < 64; ++p) {
            const float c_r = cr[ho * 64 + p], c_i = ci[ho * 64 + p], pr = powr[tau * 64 + p], pi = powi[tau * 64 + p];
            const float cpr = c_r * pr - c_i * pi, cpi = c_r * pi + c_i * pr;
            s0 += cpr * bzr[p * 16 + hi] - cpi * bzi[p * 16 + hi];
            s1 += cpr * bzr[p * 16 + hi + 1] - cpi * bzi[p * 16 + hi + 1];
        }
        if (tau == 0) { if (ho == hi) s0 += d_skip[lg * 16 + ho]; if (ho == hi + 1) s1 += d_skip[lg * 16 + ho]; }
        *(unsigned*)(kt + (tau + 1) * KT_BLK + ho * 32 + hi * 2) = pack_bf2(s0, s1);
    }
    if (part == 0) for (int it = tid; it < 65 * 4; it += NTHR) ((unsigned*)(kt + (it >> 2) * KT_BLK + 512))[it & 3] = 0u;
    bf16x8* wst = WST + (size_t)lg * WST_FRAGS;
    for (int it = part * (WST_FRAGS / 4) + tid; it < (part + 1) * (WST_FRAGS / 4); it += NTHR) {
        const int lane = it & 63, j = (it >> 6) & 63, nt = it >> 12;
        const int r = lane & 31, h = lane >> 5, n = nt * 32 + r, p = n & 63, im = n >> 6;
        const float pr = powr[(63 - j) * 64 + p], pi = powi[(63 - j) * 64 + p];
        float v[8];
#pragma unroll
        for (int jj = 0; jj < 8; ++jj) {
            const float zr = bzr[p * 16 + 8 * h + jj], zi = bzi[p * 16 + 8 * h + jj];
            v[jj] = im ? (pr * zi + pi * zr) : (pr * zr - pi * zi);
        }
        uint4 o; o.x = pack_bf2(v[0], v[1]); o.y = pack_bf2(v[2], v[3]); o.z = pack_bf2(v[4], v[5]); o.w = pack_bf2(v[6], v[7]);
        *(uint4*)(wst + it) = o;
    }
    bf16x8* cc = CCAR + (size_t)lg * CCAR_FRAGS;
    for (int it = part * (CCAR_FRAGS / 4) + tid; it < (part + 1) * (CCAR_FRAGS / 4); it += NTHR) {
        const int lane = it & 63, ks = (it >> 6) & 7, mt = it >> 9;
        const int r = lane & 31, h = lane >> 5, m = mt * 32 + r, i = m >> 4, ho = m & 15;
        float v[8];
#pragma unroll
        for (int jj = 0; jj < 8; ++jj) {
            const int k = ks * 16 + 8 * h + jj, p = k & 63, im = k >> 6;
            const float c_r = cr[ho * 64 + p], c_i = ci[ho * 64 + p], pr = powr[(i + 1) * 64 + p], pi = powi[(i + 1) * 64 + p];
            v[jj] = im ? -(c_r * pi + c_i * pr) : (c_r * pr - c_i * pi);
        }
        uint4 o; o.x = pack_bf2(v[0], v[1]); o.y = pack_bf2(v[2], v[3]); o.z = pack_bf2(v[4], v[5]); o.w = pack_bf2(v[6], v[7]);
        *(uint4*)(cc + it) = o;
    }
    __syncthreads();
}

#define PB_SU 0
#define PB_SKT (32 * SU_CH)
#define PB_SL (PB_SKT + KT_BYTES)
#define PB_SPART (PB_SL + 32 * 132 * 4)
#define PB_SSP (PB_SPART + 4 * 4096)
#define PB_BYTES (PB_SSP + 32 * 272)

DI void phaseB_tile(const bf16_t* __restrict__ U, const char* __restrict__ KT, const bf16x8* __restrict__ WST, const bf16x8* __restrict__ CCAR,
                    const float* __restrict__ ABT, bf16_t* __restrict__ YPRE, int tile, char* smem, int wid) {
    const int gp = tile & 31, b = tile >> 5;
    const int g = ((gp & 7) << 2) | (gp >> 3);
    int tid = get_tid(wid);
    const int w = __builtin_amdgcn_readfirstlane(tid >> 6), lane = tid & 63, r = lane & 31, h = lane >> 5;
    char* sU = smem + PB_SU; char* sKT = smem + PB_SKT; float* sL = (float*)(smem + PB_SL); float* sPart = (float*)(smem + PB_SPART);
    char* sSp = smem + PB_SSP;
#pragma unroll
    for (int it = 0; it < 4; ++it) {
        const int tok = tid + NTHR * it;
        const uint4* src = (const uint4*)(U + (size_t)(b * SEQ + tok) * DM + g * 16);
        const uint4 v0 = src[0], v1 = src[1];
        char* d = sU + (tok >> 6) * SU_CH + (tok & 63) * 32;
        *(uint4*)d = v0; *(uint4*)(d + 16) = v1;
    }
    {
        const uint4* src = (const uint4*)(KT + (size_t)g * KT_BYTES);
        for (int it = tid; it < KT_BYTES / 16; it += NTHR) ((uint4*)sKT)[it] = src[it];
    }
    __syncthreads();
    {
        const int nt = w & 3, kh = w >> 2;
        f32x16 acc;
#pragma unroll
        for (int i = 0; i < 16; ++i) acc[i] = 0.f;
        const bf16x8* wp = WST + (size_t)g * WST_FRAGS + (size_t)(nt * 64 + kh * 32) * 64 + lane;
        const char* up = sU + r * SU_CH + h * 16 + kh * 32 * 32;
#pragma unroll 16
        for (int j = 0; j < 32; ++j) {
            const bf16x8 a = wp[j * 64];
            const bf16x8 bb = *(const bf16x8*)(up + j * 32);
            acc = MFMA32(a, bb, acc);
        }
        if (kh == 1) {
#pragma unroll
            for (int i = 0; i < 16; ++i) sPart[(nt * 16 + i) * 64 + lane] = acc[i];
        }
        __syncthreads();
        if (kh == 0) {
#pragma unroll
            for (int i = 0; i < 16; ++i) sL[r * 132 + nt * 32 + crow(i, h)] = acc[i] + sPart[(nt * 16 + i) * 64 + lane];
        }
        __syncthreads();
    }
    if (tid < 64) {
        const int p = tid;
        const float ar = ABT[g * 128 + 2 * p], ai = ABT[g * 128 + 2 * p + 1];
        float sr = 0.f, si = 0.f;
        for (int c = 0; c < 32; ++c) {
            *(bf16_t*)(sSp + c * 272 + p * 2) = (bf16_t)(pack_bf2(sr, 0.f) & 0xffffu);
            *(bf16_t*)(sSp + c * 272 + (64 + p) * 2) = (bf16_t)(pack_bf2(si, 0.f) & 0xffffu);
            const float lr = sL[c * 132 + p], li = sL[c * 132 + 64 + p];
            const float nr = ar * sr - ai * si + lr, ni = ar * si + ai * sr + li;
            sr = nr; si = ni;
        }
    }
    f32x16 acc4[4];
#pragma unroll
    for (int q = 0; q < 4; ++q)
#pragma unroll
        for (int i = 0; i < 16; ++i) acc4[q][i] = 0.f;
    const int mts0 = w, mts1 = 15 - w, mts2 = 16 + w, mts3 = 31 - w;
    {
        const char* up = sU + r * SU_CH + h * 16;
        const char* kp = sKT + (r & 15) * 32 + h * 16 + ((r >> 4) + 1) * KT_BLK;
        for (int j = 0; j < 64; ++j) {
            const bf16x8 bb = *(const bf16x8*)(up + j * 32);
#define TOEP_STEP(q, mt) if (2 * (mt) + 1 >= j) { const bf16x8 a = *(const bf16x8*)(kp + (2 * (mt) - j) * KT_BLK); acc4[q] = MFMA32(a, bb, acc4[q]); }
            TOEP_STEP(0, mts0) TOEP_STEP(1, mts1) TOEP_STEP(2, mts2) TOEP_STEP(3, mts3)
#undef TOEP_STEP
        }
    }
    __syncthreads();
    {
        const bf16x8* cp = CCAR + (size_t)g * CCAR_FRAGS + lane;
        const char* sp = sSp + r * 272 + h * 16;
#pragma unroll
        for (int ks = 0; ks < 8; ++ks) {
            const bf16x8 bb = *(const bf16x8*)(sp + ks * 32);
            acc4[0] = MFMA32(cp[(mts0 * 8 + ks) * 64], bb, acc4[0]);
            acc4[1] = MFMA32(cp[(mts1 * 8 + ks) * 64], bb, acc4[1]);
            acc4[2] = MFMA32(cp[(mts2 * 8 + ks) * 64], bb, acc4[2]);
            acc4[3] = MFMA32(cp[(mts3 * 8 + ks) * 64], bb, acc4[3]);
        }
    }
    {
        bf16_t* ybase = YPRE + (size_t)(b * SEQ + r * 64) * 512 + g * 16;
#define PB_STORE(q, mt) _Pragma("unroll") for (int rq = 0; rq < 4; ++rq) { const int c0 = 8 * rq + 4 * h; const int i = 2 * (mt) + (c0 >> 4); \
            uint2 o; o.x = pack_bf2(acc4[q][4 * rq], acc4[q][4 * rq + 1]); o.y = pack_bf2(acc4[q][4 * rq + 2], acc4[q][4 * rq + 3]); \
            *(uint2*)(ybase + (size_t)i * 512 + (c0 & 15)) = o; }
        PB_STORE(0, mts0) PB_STORE(1, mts1) PB_STORE(2, mts2) PB_STORE(3, mts3)
#undef PB_STORE
    }
    __syncthreads();
}

#ifndef REP_GLU
#define REP_GLU 1
#endif
#ifndef REP_POOL
#define REP_POOL 1
#endif
#ifndef REP_OUT
#define REP_OUT 1
#endif
#ifndef REP_Q
#define REP_Q 1
#endif
#ifndef REP_SC
#define REP_SC 1
#endif
struct ALoadGelu {
    const bf16_t* base; bf16_t* gout; u32x4 v0, v1; int cc; int dofs;
    DI void init(const bf16_t* rowbase, bf16_t* growbase, int tid) { base = rowbase + (tid & 7) * 16; gout = growbase + (tid & 7) * 16; dofs = (tid >> 3) * SA_STRIDE + (tid & 7) * 32; }
    DI void issue(int c) { const u32x4* p = (const u32x4*)(base + c * 128); v0 = p[0]; v1 = p[1]; cc = c; }
    DI unsigned g2(unsigned u) { return pack_bf2(gelu_exact(bf_lo(u)), gelu_exact(bf_hi(u))); }
    DI void commit(char* buf) {
        u32x4 o0, o1;
        o0.x = g2(v0.x); o0.y = g2(v0.y); o0.z = g2(v0.z); o0.w = g2(v0.w);
        o1.x = g2(v1.x); o1.y = g2(v1.y); o1.z = g2(v1.z); o1.w = g2(v1.w);
        char* d = buf + dofs;
        *(u32x4*)d = o0; *(u32x4*)(d + 16) = o1;
        u32x4* gp = (u32x4*)(gout + cc * 128); gp[0] = o0; gp[1] = o1;
    }
};

DI void tok_reduce(float p0, float p1, float* sred, float& t0, float& t1, int tid) {
    const int w = tid >> 6, lane = tid & 63, r = lane & 31, h = lane >> 5;
    __syncthreads();
    sred[(w * 2 + h) * 64 + r] = p0; sred[(w * 2 + h) * 64 + 32 + r] = p1;
    __syncthreads();
    float a = 0.f, b = 0.f;
#pragma unroll
    for (int k = 0; k < 16; ++k) { a += sred[k * 64 + r]; b += sred[k * 64 + 32 + r]; }
    t0 = a; t1 = b;
}

#define PC_SRED (4 * SA_BYTES)
#define PC_BYTES (PC_SRED + 4096 + 256)

struct PCArgs {
    const bf16_t* U; const bf16_t* YPRE; bf16_t* G1; bf16_t* A2; const float* Xin; float* Xout; float* Xdummy; unsigned* HPH; unsigned* HPL; float* HS; bf16_t* Hb; float* RSTD;
    const bf16x8* wfglu; const float* b_glu; const bf16x8* wfpool; const float* pool_scale; const bf16x8* wfout;
};

DI void phaseC1_tile(const PCArgs& a, int tile, char* smem, int wid) {
    char* sA = smem; float* sred = (float*)(smem + PC_SRED);
    for (int rep_ = 0; rep_ < REP_GLU; ++rep_) {
        int tok0 = tile * 64; asm volatile("" : "+s"(tok0));
        int tid = get_tid(wid);
        const int w = __builtin_amdgcn_readfirstlane(tid >> 6), lane = tid & 63, r = lane & 31, h = lane >> 5;
        ALoadGelu al; al.init(a.YPRE + (size_t)(tok0 + (tid >> 3)) * 512, a.G1 + (size_t)(tok0 + (tid >> 3)) * 512, tid);
        f32x16 acc[2][2]; zero_acc<2>(acc);
        gemm64<2, 4>(acc, al, 4, a.wfglu + (size_t)w * (32 * 2 * 64) + lane, sA, lane);
        float ss0 = 0.f, ss1 = 0.f;
        {
            uint2 yp[2][2][4]; float4 bg[2][4];
#pragma unroll
            for (int nt = 0; nt < 2; ++nt)
#pragma unroll
                for (int q = 0; q < 4; ++q) bg[nt][q] = *(const float4*)(a.b_glu + w * 64 + nt * 32 + 8 * q + 4 * h);
#pragma unroll
            for (int mt = 0; mt < 2; ++mt)
#pragma unroll
                for (int nt = 0; nt < 2; ++nt)
#pragma unroll
                    for (int q = 0; q < 4; ++q)
                        yp[mt][nt][q] = *(const uint2*)(a.G1 + (size_t)(tok0 + mt * 32 + r) * 512 + w * 64 + nt * 32 + 8 * q + 4 * h);
#pragma unroll
            for (int mt = 0; mt < 2; ++mt)
#pragma unroll
                for (int nt = 0; nt < 2; ++nt)
#pragma unroll
                    for (int q = 0; q < 4; ++q) {
                        const float y0 = bf_lo(yp[mt][nt][q].x), y1 = bf_hi(yp[mt][nt][q].x), y2 = bf_lo(yp[mt][nt][q].y), y3 = bf_hi(yp[mt][nt][q].y);
                        const float o0 = y0 / (1.f + __expf(-(acc[nt][mt][4 * q] + bg[nt][q].x)));
                        const float o1 = y1 / (1.f + __expf(-(acc[nt][mt][4 * q + 1] + bg[nt][q].y)));
                        const float o2 = y2 / (1.f + __expf(-(acc[nt][mt][4 * q + 2] + bg[nt][q].z)));
                        const float o3 = y3 / (1.f + __expf(-(acc[nt][mt][4 * q + 3] + bg[nt][q].w)));
                        acc[nt][mt][4 * q] = o0; acc[nt][mt][4 * q + 1] = o1; acc[nt][mt][4 * q + 2] = o2; acc[nt][mt][4 * q + 3] = o3;
                        const float s = o0 * o0 + o1 * o1 + o2 * o2 + o3 * o3;
                        if (mt == 0) ss0 += s; else ss1 += s;
                    }
        }
        float t0, t1; tok_reduce(ss0, ss1, sred, t0, t1, tid);
        const float rs0 = rsqrtf(t0 * (1.f / 512.f) + 1e-6f), rs1 = rsqrtf(t1 * (1.f / 512.f) + 1e-6f);
#pragma unroll
        for (int mt = 0; mt < 2; ++mt) {
            const float rs = mt ? rs1 : rs0;
            bf16_t* orow = a.A2 + (size_t)(tok0 + mt * 32 + r) * DM + w * 64;
#pragma unroll
            for (int nt = 0; nt < 2; ++nt)
#pragma unroll
                for (int q = 0; q < 4; ++q) {
                    uint2 o; o.x = pack_bf2(acc[nt][mt][4 * q] * rs, acc[nt][mt][4 * q + 1] * rs);
                    o.y = pack_bf2(acc[nt][mt][4 * q + 2] * rs, acc[nt][mt][4 * q + 3] * rs);
                    *(uint2*)(orow + nt * 32 + 8 * q + 4 * h) = o;
                }
        }
    }
    for (int rep_ = 0; rep_ < REP_POOL; ++rep_) {
        int tok0 = tile * 64; asm volatile("" : "+s"(tok0));
        int tid = get_tid(wid);
        const int w = __builtin_amdgcn_readfirstlane(tid >> 6), lane = tid & 63, r = lane & 31, h = lane >> 5;
        const int row = tid >> 3, seg = tid & 7;
        const int tok = tok0 + row, t = tok & (SEQ - 1);
#pragma unroll
        for (int gi = 0; gi < 4; ++gi) {
            const int win = 2 << gi;
            const int cnt = (t + 1 < win) ? (t + 1) : win;
            const bf16_t* up = a.U + (size_t)tok * DM + 512 + gi * 128 + seg * 16;
            float s[16];
            const uint4 c0 = *(const uint4*)up, c1 = *(const uint4*)(up + 8);
            const unsigned cu[8] = {c0.x, c0.y, c0.z, c0.w, c1.x, c1.y, c1.z, c1.w};
#pragma unroll
            for (int i = 0; i < 8; ++i) { s[2 * i] = bf_lo(cu[i]); s[2 * i + 1] = bf_hi(cu[i]); }
#pragma unroll
            for (int k0 = 1; k0 < win; k0 += 5) {
                uint4 d0[5], d1[5];
#pragma unroll
                for (int u = 0; u < 5; ++u)
                    if (k0 + u < win) {
                        const bf16_t* p = (k0 + u <= t) ? up - (size_t)(k0 + u) * DM : up;
                        d0[u] = *(const uint4*)p; d1[u] = *(const uint4*)(p + 8);
                    }
#pragma unroll
                for (int u = 0; u < 5; ++u)
                    if (k0 + u < win) {
                        const float m = (k0 + u <= t) ? 1.f : 0.f;
                        const unsigned du[8] = {d0[u].x, d0[u].y, d0[u].z, d0[u].w, d1[u].x, d1[u].y, d1[u].z, d1[u].w};
#pragma unroll
                        for (int i = 0; i < 8; ++i) { s[2 * i] = fmaf(m, bf_lo(du[i]), s[2 * i]); s[2 * i + 1] = fmaf(m, bf_hi(du[i]), s[2 * i + 1]); }
                    }
            }
            const float inv = 1.f / (float)cnt;
            unsigned o[8];
#pragma unroll
            for (int i = 0; i < 8; ++i) o[i] = pack_bf2(s[2 * i] * inv - bf_lo(cu[i]), s[2 * i + 1] * inv - bf_hi(cu[i]));
            char* d = sA + gi * SA_BYTES + row * SA_STRIDE + seg * 32;
            *(uint4*)d = make_uint4(o[0], o[1], o[2], o[3]); *(uint4*)(d + 16) = make_uint4(o[4], o[5], o[6], o[7]);
        }
        __syncthreads();
        const int gi = w >> 1;
        f32x16 acc[2][2]; zero_acc<2>(acc);
        const bf16x8* wp = a.wfpool + (size_t)gi * (128 * 128 / 8) + (size_t)(w & 1) * (8 * 2 * 64) + lane;
        const char* buf = sA + gi * SA_BYTES + r * SA_STRIDE + h * 16;
#pragma unroll
        for (int ks = 0; ks < 8; ++ks) {
            const bf16x8 a0 = *(const bf16x8*)(buf + ks * 32);
            const bf16x8 a1 = *(const bf16x8*)(buf + 32 * SA_STRIDE + ks * 32);
#pragma unroll
            for (int nt = 0; nt < 2; ++nt) {
                const bf16x8 wv = wp[(ks * 2 + nt) * 64];
                acc[nt][0] = MFMA32(wv, a0, acc[nt][0]);
                acc[nt][1] = MFMA32(wv, a1, acc[nt][1]);
            }
        }
        float ss0 = 0.f, ss1 = 0.f;
        float4 psc[2][4];
#pragma unroll
        for (int nt = 0; nt < 2; ++nt)
#pragma unroll
            for (int q = 0; q < 4; ++q) psc[nt][q] = *(const float4*)(a.pool_scale + w * 64 + nt * 32 + 8 * q + 4 * h);
#pragma unroll
        for (int mt = 0; mt < 2; ++mt)
#pragma unroll
            for (int nt = 0; nt < 2; ++nt)
#pragma unroll
                for (int q = 0; q < 4; ++q) {
                    const float4 sc = psc[nt][q];
                    const float o0 = acc[nt][mt][4 * q] * sc.x, o1 = acc[nt][mt][4 * q + 1] * sc.y, o2 = acc[nt][mt][4 * q + 2] * sc.z, o3 = acc[nt][mt][4 * q + 3] * sc.w;
                    acc[nt][mt][4 * q] = o0; acc[nt][mt][4 * q + 1] = o1; acc[nt][mt][4 * q + 2] = o2; acc[nt][mt][4 * q + 3] = o3;
                    const float s = o0 * o0 + o1 * o1 + o2 * o2 + o3 * o3;
                    if (mt == 0) ss0 += s; else ss1 += s;
                }
        float t0, t1; tok_reduce(ss0, ss1, sred, t0, t1, tid);
        const float rs0 = rsqrtf(t0 * (1.f / 512.f) + 1e-6f), rs1 = rsqrtf(t1 * (1.f / 512.f) + 1e-6f);
#pragma unroll
        for (int mt = 0; mt < 2; ++mt) {
            const float rs = mt ? rs1 : rs0;
            bf16_t* orow = a.A2 + (size_t)(tok0 + mt * 32 + r) * DM + 512 + w * 64;
#pragma unroll
            for (int nt = 0; nt < 2; ++nt)
#pragma unroll
                for (int q = 0; q < 4; ++q) {
                    uint2 o; o.x = pack_bf2(acc[nt][mt][4 * q] * rs, acc[nt][mt][4 * q + 1] * rs);
                    o.y = pack_bf2(acc[nt][mt][4 * q + 2] * rs, acc[nt][mt][4 * q + 3] * rs);
                    *(uint2*)(orow + nt * 32 + 8 * q + 4 * h) = o;
                }
        }
        __syncthreads();
    }
    for (int rep_ = 0; rep_ < REP_OUT; ++rep_) {
        float* xout_ = (rep_ + 1 < REP_OUT) ? a.Xdummy : a.Xout;
        int tok0 = tile * 64; asm volatile("" : "+s"(tok0));
        int tid = get_tid(wid);
        const int w = __builtin_amdgcn_readfirstlane(tid >> 6), lane = tid & 63, r = lane & 31, h = lane >> 5;
        ALoadBF16 al; al.init(a.A2 + (size_t)(tok0 + (tid >> 3)) * DM, tid);
        f32x16 acc[4][2]; zero_acc<4>(acc);
        gemm64<4, 2>(acc, al, 8, a.wfout + (size_t)w * (64 * 4 * 64) + lane, sA, lane);
        {
            float* wscr = (float*)(smem + w * WSCR_BYTES);
            const int tl = lane >> 3, cl = (lane & 7) * 4;
            float ssj[2][4];
#pragma unroll
            for (int mt = 0; mt < 2; ++mt)
#pragma unroll
                for (int j = 0; j < 4; ++j) ssj[mt][j] = 0.f;
            float4 xc[4], xn[4];
            const size_t rbase = (size_t)(tok0 + tl) * DM + w * 128 + cl;
#pragma unroll
            for (int j = 0; j < 4; ++j) xc[j] = *(const float4*)(a.Xin + rbase + (size_t)(8 * j) * DM);
#pragma unroll
            for (int g = 0; g < 8; ++g) {
                const int mt = g >> 2, nt = g & 3;
                if (g < 7) {
                    const size_t rn = rbase + (size_t)((g + 1) >> 2) * 32 * DM + ((g + 1) & 3) * 32;
#pragma unroll
                    for (int j = 0; j < 4; ++j) xn[j] = *(const float4*)(a.Xin + rn + (size_t)(8 * j) * DM);
                }
                f32x4 o[4]; tile_transpose(acc[nt][mt], wscr, lane, o);
                const size_t ro = rbase + (size_t)mt * 32 * DM + nt * 32;
#pragma unroll
                for (int j = 0; j < 4; ++j) {
                    float4 xo; xo.x = xc[j].x + o[j].x; xo.y = xc[j].y + o[j].y; xo.z = xc[j].z + o[j].z; xo.w = xc[j].w + o[j].w;
                    *(float4*)(xout_ + ro + (size_t)(8 * j) * DM) = xo;
                    uint2 p; p.x = pack_bf2(xo.x, xo.y); p.y = pack_bf2(xo.z, xo.w);
                    *(uint2*)(a.Hb + ro + (size_t)(8 * j) * DM) = p;
                    ssj[mt][j] += xo.x * xo.x + xo.y * xo.y + xo.z * xo.z + xo.w * xo.w;
                }
                asm volatile("" ::: "memory");
#pragma unroll
                for (int j = 0; j < 4; ++j) xc[j] = xn[j];
            }
#pragma unroll
            for (int mt = 0; mt < 2; ++mt)
#pragma unroll
                for (int j = 0; j < 4; ++j) {
                    float v = ssj[mt][j];
                    v += shx<1>(v, lane); v += shx<2>(v, lane); v += shx<4>(v, lane);
                    if ((lane & 7) == 0) sred[w * 64 + mt * 32 + tl + 8 * j] = v;
                }
            __syncthreads();
            if (tid < 64) {
                float tot = 0.f;
#pragma unroll
                for (int k = 0; k < 8; ++k) tot += sred[k * 64 + tid];
                a.RSTD[tok0 + tid] = rsqrtf(tot * (1.f / 1024.f) + 1e-6f);
            }
        }
        __syncthreads();
    }
    {
        int tok0 = tile * 64; asm volatile("" : "+s"(tok0));
        int tid = get_tid(wid);
        const int w = __builtin_amdgcn_readfirstlane(tid >> 6), lane = tid & 63;
#pragma unroll 1
        for (int ti = 0; ti < 8; ++ti) {
            const int tok = tok0 + w * 8 + ti;
            const u32x4* hp = (const u32x4*)(a.Hb + (size_t)tok * DM + lane * 16);
            const u32x4 h0 = hp[0], h1 = hp[1];
            const unsigned wv[8] = {h0.x, h0.y, h0.z, h0.w, h1.x, h1.y, h1.z, h1.w};
            float f[16]; float m = 0.f;
#pragma unroll
            for (int i = 0; i < 8; ++i) { f[2 * i] = bf_lo(wv[i]); f[2 * i + 1] = bf_hi(wv[i]); m = fmaxf(m, fmaxf(fabsf(f[2 * i]), fabsf(f[2 * i + 1]))); }
            m = fmaxf(m, __int_as_float(__builtin_amdgcn_update_dpp(0, __float_as_int(m), 0xB1, 0xF, 0xF, true)));
            m = fmaxf(m, __int_as_float(__builtin_amdgcn_update_dpp(0, __float_as_int(m), 0x4E, 0xF, 0xF, true)));
            m = fmaxf(m, __int_as_float(__builtin_amdgcn_update_dpp(0, __float_as_int(m), 0x141, 0xF, 0xF, true)));
            m = fmaxf(m, __int_as_float(__builtin_amdgcn_update_dpp(0, __float_as_int(m), 0x140, 0xF, 0xF, true)));
            const float sh = (m > 0.f) ? m * (1.f / 119.f) : 1.f, inv = 1.f / sh;
            unsigned Hd[2], Ld[2];
#pragma unroll
            for (int d = 0; d < 2; ++d) {
                unsigned A = 0u, B = 0u;
#pragma unroll
                for (int i = 0; i < 4; ++i) {
                    A = __builtin_amdgcn_cvt_pk_u8_f32(rintf(f[8 * d + i] * inv) + 136.f, i, A);
                    B = __builtin_amdgcn_cvt_pk_u8_f32(rintf(f[8 * d + 4 + i] * inv) + 136.f, i, B);
                }
                Ld[d] = ((A & 0x0F0F0F0Fu) | ((B & 0x0F0F0F0Fu) << 4)) ^ 0x88888888u;
                Hd[d] = (((A >> 4) & 0x0F0F0F0Fu) | (B & 0xF0F0F0F0u)) ^ 0x88888888u;
            }
            *(uint2*)(a.HPH + (size_t)tok * 128 + 2 * lane) = make_uint2(Hd[0], Hd[1]);
            *(uint2*)(a.HPL + (size_t)tok * 128 + 2 * lane) = make_uint2(Ld[0], Ld[1]);
            if ((lane & 15) == 0) a.HS[(size_t)tok * 4 + (lane >> 4)] = sh;
        }
    }
}

DI unsigned f2ord(float f) { const unsigned u = __float_as_uint(f); return u ^ ((u >> 31) ? 0xFFFFFFFFu : 0x80000000u); }
DI float ord2f(unsigned o) { return __uint_as_float((o & 0x80000000u) ? (o ^ 0x80000000u) : ~o); }
DI unsigned umax_(unsigned a, unsigned b) { return a > b ? a : b; }
DI unsigned umin_(unsigned a, unsigned b) { return a < b ? a : b; }

struct PRArgs {
    const bf16_t* Hb; const float* RSTD; const bf16x8* wfq; const bf16x8* kf1; const bf16x8* kf2; unsigned short* EX; float* GT;
};

DI void conv_kfrag(const float* __restrict__ K, bf16x8* __restrict__ dst, size_t gtid, size_t gstride) {
    for (size_t item = gtid; item < 8 * 4 * 64; item += gstride) {
        const int lane = (int)(item & 63), kt = (int)((item >> 6) & 3), ks = (int)(item >> 8);
        const int r = lane & 31, h = lane >> 5;
        float v[8];
#pragma unroll
        for (int j = 0; j < 8; ++j) v[j] = K[(size_t)(kt * 32 + r) * 128 + (ks >> 1) * 32 + 16 * (ks & 1) + 8 * (j >> 2) + 4 * h + (j & 3)];
        uint4 o; o.x = pack_bf2(v[0], v[1]); o.y = pack_bf2(v[2], v[3]); o.z = pack_bf2(v[4], v[5]); o.w = pack_bf2(v[6], v[7]);
        *(uint4*)(dst + item) = o;
    }
}

DI void bitonic_sort16(unsigned (&a)[16]) {
#pragma unroll
    for (int k = 2; k <= 16; k <<= 1)
#pragma unroll
        for (int j = k >> 1; j > 0; j >>= 1)
#pragma unroll
            for (int i = 0; i < 16; ++i) {
                const int l = i ^ j;
                if (l > i) {
                    const unsigned hi = umax_(a[i], a[l]), lo = umin_(a[i], a[l]);
                    if ((i & k) == 0) { a[i] = hi; a[l] = lo; } else { a[i] = lo; a[l] = hi; }
                }
            }
}
DI void bitonic_top16(unsigned (&a)[16], const unsigned (&b)[16]) {
#pragma unroll
    for (int i = 0; i < 16; ++i) a[i] = umax_(a[i], b[15 - i]);
#pragma unroll
    for (int j = 8; j > 0; j >>= 1)
#pragma unroll
        for (int i = 0; i < 16; ++i) {
            const int l = i ^ j;
            if (l > i) { const unsigned hi = umax_(a[i], a[l]), lo = umin_(a[i], a[l]); a[i] = hi; a[l] = lo; }
        }
}
DI void make_keys(unsigned (&x)[16], const f32x16& s, float rs, int nbase, int h) {
#pragma unroll
    for (int i = 0; i < 16; ++i) x[i] = (f2ord(s[i] * rs) & 0xFFFFFF80u) | (unsigned)(127 - (nbase + crow(i, h)));
}

#define PR_LIST_STRIDE 80
#define PR_SLIST (2 * SA_BYTES)
#define PR_SIDX (PR_SLIST + 8 * 32 * PR_LIST_STRIDE)

DI void phaseC2_tile(const PRArgs& a, int tile, char* smem, int wid) {
    char* sA = smem;
#pragma unroll 1
    for (int ps = 0; ps < 2; ++ps) {
        int tok0 = tile * 64; asm volatile("" : "+s"(tok0));
        int tid = get_tid(wid);
        const int w = __builtin_amdgcn_readfirstlane(tid >> 6), lane = tid & 63, r = lane & 31, h = lane >> 5;
        const int ng = ps * 8 + w, hd = ng >> 1, hf = ng & 1;
        bf16x8 qb[2][8];
        {
            ALoadBF16 al; al.init(a.Hb + (size_t)(tok0 + (tid >> 3)) * DM, tid);
            f32x16 acc[4][2]; zero_acc<4>(acc);
            gemm64<4, 2>(acc, al, 8, a.wfq + (size_t)ng * (64 * 4 * 64) + lane, sA, lane);
#pragma unroll
            for (int mt = 0; mt < 2; ++mt)
#pragma unroll
                for (int nt = 0; nt < 4; ++nt)
#pragma unroll
                    for (int s = 0; s < 2; ++s) {
                        u32x4 p;
                        p.x = pack_bf2(acc[nt][mt][8 * s], acc[nt][mt][8 * s + 1]); p.y = pack_bf2(acc[nt][mt][8 * s + 2], acc[nt][mt][8 * s + 3]);
                        p.z = pack_bf2(acc[nt][mt][8 * s + 4], acc[nt][mt][8 * s + 5]); p.w = pack_bf2(acc[nt][mt][8 * s + 6], acc[nt][mt][8 * s + 7]);
                        qb[mt][nt * 2 + s] = __builtin_bit_cast(bf16x8, p);
                    }
        }
        gwp_t kf = (gwp_t)(hf ? a.kf2 : a.kf1) + lane;
        unsigned Town[16];
#pragma unroll
        for (int mt = 0; mt < 2; ++mt) {
            f32x16 sc[4];
#pragma unroll
            for (int kt = 0; kt < 4; ++kt)
#pragma unroll
                for (int i = 0; i < 16; ++i) sc[kt][i] = 0.f;
#pragma unroll
            for (int ks = 0; ks < 8; ++ks) {
#pragma unroll
                for (int kt = 0; kt < 4; ++kt) sc[kt] = MFMA32(kf[(ks * 4 + kt) * 64], qb[mt][ks], sc[kt]);
                if (ks & 1) asm volatile("" ::: "memory");
            }
            const float rs = a.RSTD[tok0 + mt * 32 + r];
            unsigned L[16], S[16];
            make_keys(L, sc[0], rs, 0, h); bitonic_sort16(L);
#pragma unroll
            for (int kt = 1; kt < 4; ++kt) { make_keys(S, sc[kt], rs, kt * 32, h); bitonic_sort16(S); bitonic_top16(L, S); }
#pragma unroll
            for (int k = 0; k < 16; ++k) S[k] = (unsigned)shx_i<32>((int)L[k], lane);
            bitonic_top16(L, S);
            if (mt == hf) {
#pragma unroll
                for (int k = 0; k < 16; ++k) Town[k] = L[k];
            } else {
                char* dst = smem + PR_SLIST + (w * 32 + r) * PR_LIST_STRIDE + h * 32;
                u32x4 v0, v1;
                if (h == 0) { v0 = (u32x4){L[0], L[1], L[2], L[3]}; v1 = (u32x4){L[4], L[5], L[6], L[7]}; }
                else { v0 = (u32x4){L[8], L[9], L[10], L[11]}; v1 = (u32x4){L[12], L[13], L[14], L[15]}; }
                *(u32x4*)dst = v0; *(u32x4*)(dst + 16) = v1;
            }
        }
        __syncthreads();
        unsigned T0[16], T1[16];
        {
            const char* src = smem + PR_SLIST + ((w ^ 1) * 32 + r) * PR_LIST_STRIDE;
            const u32x4 p0 = *(const u32x4*)src, p1 = *(const u32x4*)(src + 16), p2 = *(const u32x4*)(src + 32), p3 = *(const u32x4*)(src + 48);
            const unsigned Tp[16] = {p0.x, p0.y, p0.z, p0.w, p1.x, p1.y, p1.z, p1.w, p2.x, p2.y, p2.z, p2.w, p3.x, p3.y, p3.z, p3.w};
#pragma unroll
            for (int k = 0; k < 16; ++k) { T0[k] = hf ? Tp[k] : Town[k]; T1[k] = hf ? Town[k] : Tp[k]; }
        }
        float v1[16], v2[16];
#pragma unroll
        for (int k = 0; k < 16; ++k) { v1[k] = ord2f(T0[k] & 0xFFFFFF80u); v2[k] = ord2f(T1[k] & 0xFFFFFF80u); }
        unsigned C[16];
#pragma unroll
        for (int b = 0; b < 16; ++b) C[b] = (f2ord(v1[0] + v2[b]) & 0xFFFFFF00u) | (unsigned)(255 - b);
#pragma unroll
        for (int aa = 1; aa < 16; ++aa)
#pragma unroll
            for (int b = 0; b < 16; ++b)
                if ((aa + 1) * (b + 1) <= 16) {
                    unsigned x = (f2ord(v1[aa] + v2[b]) & 0xFFFFFF00u) | (unsigned)(255 - (aa * 16 + b));
#pragma unroll
                    for (int k = (aa + 1) * (b + 1) - 1; k < 16; ++k) { const unsigned hi = umax_(C[k], x); x = umin_(C[k], x); C[k] = hi; }
                }
        unsigned* sI = (unsigned*)(smem + PR_SIDX) + (w * 64 + lane) * 9;
#pragma unroll
        for (int q = 0; q < 4; ++q) {
            unsigned p1 = 0u, p2 = 0u;
#pragma unroll
            for (int j = 0; j < 4; ++j) { p1 |= (127u - (T0[4 * q + j] & 0x7Fu)) << (8 * j); p2 |= (127u - (T1[4 * q + j] & 0x7Fu)) << (8 * j); }
            sI[q] = p1; sI[4 + q] = p2;
        }
        const unsigned char* sB = (const unsigned char*)sI;
        const float mx = ord2f(C[0] & 0xFFFFFF00u);
        float e[16]; float sum = 0.f; int ex[16];
#pragma unroll
        for (int k = 0; k < 16; ++k) {
            e[k] = __expf(ord2f(C[k] & 0xFFFFFF00u) - mx); sum += e[k];
            const unsigned ci = 255u - (C[k] & 0xFFu);
            ex[k] = (int)sB[ci >> 4] * 128 + (int)sB[16 + (ci & 15u)];
        }
        const float inv = 1.f / sum;
        const size_t ob = ((size_t)(tok0 + hf * 32 + r) * 8 + hd) * 16;
        if (h == 0) {
#pragma unroll
            for (int q = 0; q < 2; ++q) *(uint4*)(a.EX + ob + 8 * q) = make_uint4((unsigned)ex[8 * q] | ((unsigned)ex[8 * q + 1] << 16), (unsigned)ex[8 * q + 2] | ((unsigned)ex[8 * q + 3] << 16),
                                                                       (unsigned)ex[8 * q + 4] | ((unsigned)ex[8 * q + 5] << 16), (unsigned)ex[8 * q + 6] | ((unsigned)ex[8 * q + 7] << 16));
        } else {
#pragma unroll
            for (int q = 0; q < 4; ++q) *(float4*)(a.GT + ob + 4 * q) = make_float4(e[4 * q] * inv, e[4 * q + 1] * inv, e[4 * q + 2] * inv, e[4 * q + 3] * inv);
        }
        __syncthreads();
    }
}
typedef const __attribute__((address_space(1))) u32x4* grow_t;
typedef unsigned char fp8_t;
#define XB_TMO      128
#define XB_XCNT(j)  (256  + 64 * (j))
#define XB_XSUB(j)  (1280 + 64 * (j))
#define XB_XGEN(j)  (2304 + 64 * (j))
#define XB_TOP      3328
#define XB_TOPGEN   3392
#define XB_QUEUE(j) (3456 + 64 * (j))
#define XCD_BAR_WORDS (3456 + 64 * 64)
#define XB_SPIN_CAP (1u << 20)
#define LAS __attribute__((address_space(3)))

DI unsigned xb_ld(unsigned* p)              { return __hip_atomic_load(p, __ATOMIC_RELAXED, __HIP_MEMORY_SCOPE_AGENT); }
DI unsigned xb_add(unsigned* p, unsigned v) { return __hip_atomic_fetch_add(p, v, __ATOMIC_RELAXED, __HIP_MEMORY_SCOPE_AGENT); }
DI unsigned xb_xcc_id() { return (unsigned)__builtin_amdgcn_s_getreg((3 << 11) | 20) & 0xFu; }
#define XB_SPIN(cond, bar) do { unsigned _sp = 0; while (cond) { __builtin_amdgcn_s_sleep(1); \
    if ((++_sp & 255u) == 0u) { if (xb_ld(&(bar)[XB_TMO])) break; if (_sp > XB_SPIN_CAP) { atomicAdd(&(bar)[XB_TMO], 1u); break; } } } } while (0)

struct XcdBarrier { unsigned* bar; unsigned x; volatile LAS unsigned* st; };

DI XcdBarrier xcd_barrier_post(unsigned* bar, volatile LAS unsigned* st, int tid) {
    XcdBarrier b; b.bar = bar; b.x = xb_xcc_id(); b.st = st;
    if (tid == 0) st[2] = xb_add(&bar[XB_XCNT(b.x)], 1u);
    return b;
}
DI void xcd_barrier_complete(unsigned* bar, unsigned x, unsigned& nloc, unsigned& nx) {
    const unsigned G = gridDim.x * gridDim.y * gridDim.z;
    unsigned sum, cnt, mine, sp = 0u;
    for (;;) {
        sum = 0u; cnt = 0u; mine = 0u;
#pragma unroll
        for (unsigned j = 0; j < 16; ++j) { const unsigned c = xb_ld(&bar[XB_XCNT(j)]); sum += c; cnt += (c > 0u) ? 1u : 0u; mine = (j == x) ? c : mine; }
        if (sum == G) break;
        __builtin_amdgcn_s_sleep(1);
        if ((++sp & 255u) == 0u) { if (xb_ld(&bar[XB_TMO])) break; if (sp > XB_SPIN_CAP) { atomicAdd(&bar[XB_TMO], 1u); break; } }
    }
    nloc = mine > 0u ? mine : 1u; nx = cnt > 0u ? cnt : 1u;
}
DI void xcd_barrier(const XcdBarrier& b, int wid) {
    asm volatile("s_waitcnt vmcnt(0)" ::: "memory");
    __syncthreads();
    if (get_tid(wid) == 0) {
        unsigned* bar = b.bar;
        __builtin_amdgcn_s_waitcnt(0);
        unsigned nloc = b.st[0], nx = b.st[1];
        if (nloc == 0u) { xcd_barrier_complete(bar, b.x, nloc, nx); b.st[0] = nloc; b.st[1] = nx; }
        const unsigned old = xb_add(&bar[XB_XSUB(b.x)], 1u);
        const unsigned gen = old / nloc;
        if (old + 1u == (gen + 1u) * nloc) {
            __builtin_amdgcn_fence(__ATOMIC_RELEASE, "agent");
            asm volatile("s_waitcnt vmcnt(0)" ::: "memory");
            const unsigned og = xb_add(&bar[XB_TOP], 1u);
            const unsigned tg = og / nx;
            if (og + 1u == (tg + 1u) * nx) xb_add(&bar[XB_TOPGEN], 1u);
            else XB_SPIN(xb_ld(&bar[XB_TOPGEN]) == tg, bar);
            __builtin_amdgcn_fence(__ATOMIC_ACQUIRE, "agent");
            xb_add(&bar[XB_XGEN(b.x)], 1u);
            asm volatile("s_waitcnt vmcnt(0)" ::: "memory");
        } else {
            XB_SPIN(xb_ld(&bar[XB_XGEN(b.x)]) == gen, bar);
            __builtin_amdgcn_fence(__ATOMIC_ACQUIRE, "agent");
            asm volatile("s_waitcnt vmcnt(0)" ::: "memory");
        }
    }
    __syncthreads();
}
#define NUSL 4
struct PSArgs {
    const bf16_t* Hb; const float* RSTD; const unsigned short* EX; const float* GT; const float* SU; const float* SV;
    float* PD; bf16_t* COEF; const float* Xin; float* Xout; const unsigned* HPH; const unsigned* HPL; const float* HS;
};

struct Ids16 { u32x4 a, b; };
DI void ids_load(Ids16& q, const unsigned short* EX, int tok, int rg) { const u32x4* p = (const u32x4*)(EX + (size_t)tok * 128 + rg * 16); q.a = p[0]; q.b = p[1]; }
#define ID_LO(w) (((w) & 0xFFFFu) * 128u + loff)
#define ID_HI(w) (((w) >> 16) * 128u + loff)
DI void rows_lo(u32x4 (&r)[8], const Ids16& q, const fp8_t* tab, unsigned loff) {
    r[0] = *(grow_t)(tab + ID_LO(q.a.x)); r[1] = *(grow_t)(tab + ID_HI(q.a.x)); r[2] = *(grow_t)(tab + ID_LO(q.a.y)); r[3] = *(grow_t)(tab + ID_HI(q.a.y));
    r[4] = *(grow_t)(tab + ID_LO(q.a.z)); r[5] = *(grow_t)(tab + ID_HI(q.a.z)); r[6] = *(grow_t)(tab + ID_LO(q.a.w)); r[7] = *(grow_t)(tab + ID_HI(q.a.w));
}
DI void rows_hi(u32x4 (&r)[8], const Ids16& q, const fp8_t* tab, unsigned loff) {
    r[0] = *(grow_t)(tab + ID_LO(q.b.x)); r[1] = *(grow_t)(tab + ID_HI(q.b.x)); r[2] = *(grow_t)(tab + ID_LO(q.b.y)); r[3] = *(grow_t)(tab + ID_HI(q.b.y));
    r[4] = *(grow_t)(tab + ID_LO(q.b.z)); r[5] = *(grow_t)(tab + ID_HI(q.b.z)); r[6] = *(grow_t)(tab + ID_LO(q.b.w)); r[7] = *(grow_t)(tab + ID_HI(q.b.w));
}
DI void peerU_finish(const PSArgs& a, float (&p)[16], int tok, int s, int lane) {
    const int rg = lane >> 3, pc = lane & 7;
    const bool b2 = pc & 4, b1 = pc & 2, b0 = pc & 1;
    float q8[8], q4[4], q2[2];
#pragma unroll
    for (int k = 0; k < 8; ++k) { const float keep = b2 ? p[k + 8] : p[k], send = b2 ? p[k] : p[k + 8]; q8[k] = keep + shx<4>(send, lane); }
#pragma unroll
    for (int k = 0; k < 4; ++k) { const float keep = b1 ? q8[k + 4] : q8[k], send = b1 ? q8[k] : q8[k + 4]; q4[k] = keep + shx<2>(send, lane); }
#pragma unroll
    for (int k = 0; k < 2; ++k) { const float keep = b0 ? q4[k + 2] : q4[k], send = b0 ? q4[k] : q4[k + 2]; q2[k] = keep + shx<1>(send, lane); }
    *(float2*)(a.PD + ((size_t)s * NTOK + tok) * 128 + rg * 16 + 2 * pc) = make_float2(q2[0], q2[1]);
}

DI void peerR_tile(const PSArgs& a, int tile, int wid) {
    const int tid = get_tid(wid);
    const int lane = tid & 63;
#pragma unroll 1
    for (int ti = 0; ti < 8; ++ti) {
        const int tok = tile * 64 + wid * 8 + ti;
        float d0 = 0.f, d1 = 0.f;
#pragma unroll
        for (int x = 0; x < NUSL; ++x) { const float2 v = *(const float2*)(a.PD + ((size_t)x * NTOK + tok) * 128 + 2 * lane); d0 += v.x; d1 += v.y; }
        const unsigned exw = *(const unsigned*)(a.EX + (size_t)tok * 128 + 2 * lane);
        const int2 ex = make_int2((int)(exw & 0xFFFFu), (int)(exw >> 16));
        const float2 gt = *(const float2*)(a.GT + (size_t)tok * 128 + 2 * lane);
        const float rs = a.RSTD[tok];
        float2 o;
        o.x = gelu_exact(d0 * a.SU[ex.x] * rs) * gt.x * a.SV[ex.x];
        o.y = gelu_exact(d1 * a.SU[ex.y] * rs) * gt.y * a.SV[ex.y];
        *(unsigned*)(a.COEF + (size_t)tok * 128 + 2 * lane) = pack_bf2(o.x, o.y);
    }
}

struct Cf16 { u32x4 a, b; };
DI void cf_load(Cf16& q, const bf16_t* COEF, int tok, int rg) { const u32x4* p = (const u32x4*)(COEF + (size_t)tok * 128 + rg * 16); q.a = p[0]; q.b = p[1]; }
DI void final_norm_tile(float* X, const float* __restrict__ g, int tile, int wid) {
    const int tid = get_tid(wid);
    const int lane = tid & 63;
    const float* gf = g + lane * 16;
    const float4 g0 = *(const float4*)gf, g1 = *(const float4*)(gf + 4), g2 = *(const float4*)(gf + 8), g3 = *(const float4*)(gf + 12);
#pragma unroll 1
    for (int ti = 0; ti < 8; ++ti) {
        float* xp = X + (size_t)(tile * 64 + wid * 8 + ti) * DM + lane * 16;
        float4 x0 = *(const float4*)xp, x1 = *(const float4*)(xp + 4), x2 = *(const float4*)(xp + 8), x3 = *(const float4*)(xp + 12);
        float ss = x0.x * x0.x + x0.y * x0.y + x0.z * x0.z + x0.w * x0.w + x1.x * x1.x + x1.y * x1.y + x1.z * x1.z + x1.w * x1.w
                 + x2.x * x2.x + x2.y * x2.y + x2.z * x2.z + x2.w * x2.w + x3.x * x3.x + x3.y * x3.y + x3.z * x3.z + x3.w * x3.w;
        ss = wave_sum(ss, lane);
        const float rf = rsqrtf(ss * (1.f / 1024.f) + 1e-6f);
        x0.x *= rf * g0.x; x0.y *= rf * g0.y; x0.z *= rf * g0.z; x0.w *= rf * g0.w; x1.x *= rf * g1.x; x1.y *= rf * g1.y; x1.z *= rf * g1.z; x1.w *= rf * g1.w;
        x2.x *= rf * g2.x; x2.y *= rf * g2.y; x2.z *= rf * g2.z; x2.w *= rf * g2.w; x3.x *= rf * g3.x; x3.y *= rf * g3.y; x3.z *= rf * g3.z; x3.w *= rf * g3.w;
        *(float4*)xp = x0; *(float4*)(xp + 4) = x1; *(float4*)(xp + 8) = x2; *(float4*)(xp + 12) = x3;
    }
}

typedef unsigned char fp4x2_t;
DI void conv_row_fp4_one(float4 v0, float4 v1, float4 v2, float4 v3, fp4x2_t* __restrict__ dst, float* __restrict__ scales, int nrows, int row, int lane) {
    float m = fmaxf(fmaxf(fmaxf(fabsf(v0.x), fabsf(v0.y)), fmaxf(fabsf(v0.z), fabsf(v0.w))), fmaxf(fmaxf(fabsf(v1.x), fabsf(v1.y)), fmaxf(fabsf(v1.z), fabsf(v1.w))));
    m = fmaxf(m, fmaxf(fmaxf(fmaxf(fabsf(v2.x), fabsf(v2.y)), fmaxf(fabsf(v2.z), fabsf(v2.w))), fmaxf(fmaxf(fabsf(v3.x), fabsf(v3.y)), fmaxf(fabsf(v3.z), fabsf(v3.w)))));
    m = fmaxf(m, shx<1>(m, lane)); m = fmaxf(m, shx<2>(m, lane)); m = fmaxf(m, shx<4>(m, lane)); m = fmaxf(m, shx<8>(m, lane)); m = fmaxf(m, shx<16>(m, lane)); m = fmaxf(m, shx<32>(m, lane));
    const float sc = (m > 0.f) ? m * (1.f / 6.f) : 1.f;
    const float inv = 1.f / sc;
    unsigned d0 = 0u, d1 = 0u;
    d0 = __builtin_amdgcn_cvt_scalef32_pk_fp4_f32(d0, v0.x * inv, v0.y * inv, 1.0f, 0); d0 = __builtin_amdgcn_cvt_scalef32_pk_fp4_f32(d0, v0.z * inv, v0.w * inv, 1.0f, 1);
    d0 = __builtin_amdgcn_cvt_scalef32_pk_fp4_f32(d0, v1.x * inv, v1.y * inv, 1.0f, 2); d0 = __builtin_amdgcn_cvt_scalef32_pk_fp4_f32(d0, v1.z * inv, v1.w * inv, 1.0f, 3);
    d1 = __builtin_amdgcn_cvt_scalef32_pk_fp4_f32(d1, v2.x * inv, v2.y * inv, 1.0f, 0); d1 = __builtin_amdgcn_cvt_scalef32_pk_fp4_f32(d1, v2.z * inv, v2.w * inv, 1.0f, 1);
    d1 = __builtin_amdgcn_cvt_scalef32_pk_fp4_f32(d1, v3.x * inv, v3.y * inv, 1.0f, 2); d1 = __builtin_amdgcn_cvt_scalef32_pk_fp4_f32(d1, v3.z * inv, v3.w * inv, 1.0f, 3);
    *(uint2*)(dst + ((size_t)(lane >> 4) * nrows + row) * 128 + (lane & 15) * 8) = make_uint2(d0, d1);
    if (lane == 0) scales[row] = sc;
}
DI void conv_rows_fp4(const float* __restrict__ src, fp4x2_t* __restrict__ dst, float* __restrict__ scales, int nrows, int gwave, int nwaves, int lane) {
#pragma unroll 1
    for (int row = gwave; row < nrows; row += 2 * nwaves) {
        const int r1 = min(row + nwaves, nrows - 1);
        const float4* p0 = (const float4*)(src + (size_t)row * DM + lane * 16);
        const float4* p1 = (const float4*)(src + (size_t)r1 * DM + lane * 16);
        const float4 a0 = p0[0], a1 = p0[1], a2 = p0[2], a3 = p0[3];
        const float4 b0 = p1[0], b1 = p1[1], b2 = p1[2], b3 = p1[3];
        conv_row_fp4_one(a0, a1, a2, a3, dst, scales, nrows, row, lane);
        conv_row_fp4_one(b0, b1, b2, b3, dst, scales, nrows, r1, lane);
    }
}

typedef __attribute__((ext_vector_type(2))) _Float16 h2_t;
DI h2_t cvt4(unsigned w, int b) {
    return b == 0 ? __builtin_amdgcn_cvt_scalef32_pk_f16_fp4(w, 1.0f, 0) : b == 1 ? __builtin_amdgcn_cvt_scalef32_pk_f16_fp4(w, 1.0f, 1)
         : b == 2 ? __builtin_amdgcn_cvt_scalef32_pk_f16_fp4(w, 1.0f, 2) : __builtin_amdgcn_cvt_scalef32_pk_f16_fp4(w, 1.0f, 3);
}
DI void row_axpy32h(h2_t (&acc)[16], const u32x4& r, float c) {
    const _Float16 ch = (_Float16)c; const h2_t c2 = {ch, ch};
#pragma unroll
    for (int b = 0; b < 4; ++b) {
        acc[b] = __builtin_elementwise_fma(c2, cvt4(r.x, b), acc[b]); acc[4 + b] = __builtin_elementwise_fma(c2, cvt4(r.y, b), acc[4 + b]);
        acc[8 + b] = __builtin_elementwise_fma(c2, cvt4(r.z, b), acc[8 + b]); acc[12 + b] = __builtin_elementwise_fma(c2, cvt4(r.w, b), acc[12 + b]);
    }
}
DI void axpy8_4(h2_t (&acc)[16], const u32x4 (&r)[8], const u32x4& c) {
    row_axpy32h(acc, r[0], bf_lo(c.x)); row_axpy32h(acc, r[1], bf_hi(c.x)); row_axpy32h(acc, r[2], bf_lo(c.y)); row_axpy32h(acc, r[3], bf_hi(c.y));
    __builtin_amdgcn_sched_barrier(0);
    row_axpy32h(acc, r[4], bf_lo(c.z)); row_axpy32h(acc, r[5], bf_hi(c.z)); row_axpy32h(acc, r[6], bf_lo(c.w)); row_axpy32h(acc, r[7], bf_hi(c.w));
    __builtin_amdgcn_sched_barrier(0);
}
typedef __attribute__((ext_vector_type(2))) unsigned u32x2_t;
DI h2_t pairsum32(h2_t x, h2_t y) { auto r = __builtin_amdgcn_permlane32_swap(__builtin_bit_cast(unsigned, x), __builtin_bit_cast(unsigned, y), false, false);
                                   return __builtin_bit_cast(h2_t, (unsigned)r[0]) + __builtin_bit_cast(h2_t, (unsigned)r[1]); }
DI h2_t pairsum16(h2_t x, h2_t y) { auto r = __builtin_amdgcn_permlane16_swap(__builtin_bit_cast(unsigned, x), __builtin_bit_cast(unsigned, y), false, false);
                                   return __builtin_bit_cast(h2_t, (unsigned)r[0]) + __builtin_bit_cast(h2_t, (unsigned)r[1]); }
DI h2_t pairsum8(h2_t x, h2_t y, bool hi) {
    const h2_t keep = hi ? y : x, send = hi ? x : y;
    const int rcv = __builtin_amdgcn_update_dpp(0, __builtin_bit_cast(int, send), 0x128, 0xF, 0xF, true);
    return keep + __builtin_bit_cast(h2_t, rcv);
}
DI void peerV4_finish(const PSArgs& a, h2_t (&acc)[16], float4 xv, int tok, int s4, int lane) {
    const int rg = lane >> 3, pc = lane & 7;
    h2_t q8[8], q4[4], q2[2];
#pragma unroll
    for (int k = 0; k < 8; ++k) q8[k] = pairsum32(acc[k], acc[k + 8]);
#pragma unroll
    for (int k = 0; k < 4; ++k) q4[k] = pairsum16(q8[k], q8[k + 4]);
#pragma unroll
    for (int k = 0; k < 2; ++k) q2[k] = pairsum8(q4[k], q4[k + 2], (rg & 1) != 0);
    xv.x += (float)q2[0].x; xv.y += (float)q2[0].y; xv.z += (float)q2[1].x; xv.w += (float)q2[1].y;
    *(float4*)(a.Xout + (size_t)tok * DM + s4 * 256 + 32 * pc + 4 * rg) = xv;
}
DI int run_token2(int n, int k, int nloc, int wid, int th) { return (2 * (k + (n >> 3) * nloc) + th) * 64 + wid * 8 + (n & 7); }

DI void peerV4_run(const PSArgs& a, const fp4x2_t* V4, int s4, int th, int k, int nloc, int wid) {
    const int tid = get_tid(wid);
    const int lane = tid & 63, rg = lane >> 3, pc = lane & 7;
    const unsigned loff = (unsigned)(s4 * (NEXP * 128) + pc * 16);
    const int N = 8 * ((NTOK / 128 - k + nloc - 1) / nloc);
    if (N <= 0) return;
    Ids16 idE, idO; Cf16 cfE, cfO; float4 xE, xO;
    u32x4 rA[8], rB[8];
    const fp8_t* tab = (const fp8_t*)V4;
#define LOAD_X4(x_, tokv) { x_ = *(const float4*)(a.Xin + (size_t)(tokv) * DM + s4 * 256 + 32 * pc + 4 * rg); }
    ids_load(idE, a.EX, run_token2(0, k, nloc, wid, th), rg);
    ids_load(idO, a.EX, run_token2(1, k, nloc, wid, th), rg);
    rows_lo(rA, idE, tab, loff); cf_load(cfE, a.COEF, run_token2(0, k, nloc, wid, th), rg); rows_hi(rB, idE, tab, loff); LOAD_X4(xE, run_token2(0, k, nloc, wid, th));
#pragma unroll 1
    for (int n = 0; n < N; n += 2) {
        const int t0 = run_token2(n, k, nloc, wid, th), t1 = run_token2(n + 1, k, nloc, wid, th);
        const int t2 = run_token2((n + 2 < N) ? n + 2 : N - 1, k, nloc, wid, th), t3 = run_token2((n + 3 < N) ? n + 3 : N - 1, k, nloc, wid, th);
        {
            h2_t acc[16];
#pragma unroll
            for (int i = 0; i < 16; ++i) acc[i] = (h2_t){(_Float16)0.f, (_Float16)0.f};
            axpy8_4(acc, rA, cfE.a);
            rows_lo(rA, idO, tab, loff); cf_load(cfO, a.COEF, t1, rg);
            axpy8_4(acc, rB, cfE.b);
            rows_hi(rB, idO, tab, loff); LOAD_X4(xO, t1);
            ids_load(idE, a.EX, t2, rg);
            peerV4_finish(a, acc, xE, t0, s4, lane);
        }
        {
            h2_t acc[16];
#pragma unroll
            for (int i = 0; i < 16; ++i) acc[i] = (h2_t){(_Float16)0.f, (_Float16)0.f};
            axpy8_4(acc, rA, cfO.a);
            rows_lo(rA, idE, tab, loff); cf_load(cfE, a.COEF, t2, rg);
            axpy8_4(acc, rB, cfO.b);
            rows_hi(rB, idE, tab, loff); LOAD_X4(xE, t2);
            ids_load(idO, a.EX, t3, rg);
            peerV4_finish(a, acc, xO, t1, s4, lane);
        }
    }
#undef LOAD_X4
}

DI unsigned pack_i4x8(const float (&v)[8], float inv) {
    unsigned r = 0u;
#pragma unroll
    for (int i = 0; i < 4; ++i) {
        const int a = (int)fminf(fmaxf(rintf(v[i] * inv), -7.f), 7.f), b = (int)fminf(fmaxf(rintf(v[4 + i] * inv), -7.f), 7.f);
        r |= ((unsigned)a & 15u) << (8 * i); r |= ((unsigned)b & 15u) << (8 * i + 4);
    }
    return r;
}
DI void conv_rows_int4g(const float* __restrict__ src, const float* __restrict__ gain, fp4x2_t* __restrict__ dst, float* __restrict__ scales,
                        int nrows, int gwave, int nwaves, int lane) {
    const float4* g = (const float4*)(gain + lane * 16);
    const float4 g0 = g[0], g1 = g[1], g2 = g[2], g3 = g[3];
#pragma unroll 1
    for (int row = gwave; row < nrows; row += nwaves) {
        const float4* p0 = (const float4*)(src + (size_t)row * DM + lane * 16);
        const float4 a0 = p0[0], a1 = p0[1], a2 = p0[2], a3 = p0[3];
        const float v0[8] = {a0.x * g0.x, a0.y * g0.y, a0.z * g0.z, a0.w * g0.w, a1.x * g1.x, a1.y * g1.y, a1.z * g1.z, a1.w * g1.w};
        const float v1[8] = {a2.x * g2.x, a2.y * g2.y, a2.z * g2.z, a2.w * g2.w, a3.x * g3.x, a3.y * g3.y, a3.z * g3.z, a3.w * g3.w};
        float ss = 0.f;
#pragma unroll
        for (int i = 0; i < 8; ++i) ss += v0[i] * v0[i] + v1[i] * v1[i];
        ss = wave_sum(ss, lane);
        const float rms = sqrtf(ss * (1.f / 1024.f));
        const float step = (rms > 0.f) ? 0.36f * rms : 1.f, inv = 1.f / step;
        *(uint2*)(dst + ((size_t)(lane >> 4) * nrows + row) * 128 + (lane & 15) * 8) = make_uint2(pack_i4x8(v0, inv), pack_i4x8(v1, inv));
        if (lane == 0) scales[row] = step;
    }
}
struct HP8 { u32x4 h, l; float sh; };
DI void hp_load(HP8& q, const PSArgs& a, int tok, int s4, int pc) {
    q.h = *(const u32x4*)(a.HPH + (size_t)tok * 128 + s4 * 32 + pc * 4); q.l = *(const u32x4*)(a.HPL + (size_t)tok * 128 + s4 * 32 + pc * 4);
    q.sh = a.HS[(size_t)tok * 4 + s4];
}
DI float row_dot32q(const u32x4& r, const HP8& q) {
    int ah = 0, al = 0;
    ah = __builtin_amdgcn_sdot8((int)r.x, (int)q.h.x, ah, false); al = __builtin_amdgcn_sdot8((int)r.x, (int)q.l.x, al, false);
    ah = __builtin_amdgcn_sdot8((int)r.y, (int)q.h.y, ah, false); al = __builtin_amdgcn_sdot8((int)r.y, (int)q.l.y, al, false);
    ah = __builtin_amdgcn_sdot8((int)r.z, (int)q.h.z, ah, false); al = __builtin_amdgcn_sdot8((int)r.z, (int)q.l.z, al, false);
    ah = __builtin_amdgcn_sdot8((int)r.w, (int)q.h.w, ah, false); al = __builtin_amdgcn_sdot8((int)r.w, (int)q.l.w, al, false);
    return (float)(ah * 16 + al) * q.sh;
}
DI void peerUi_run(const PSArgs& a, const fp4x2_t* U4, int s4, int th, int k, int nloc, int wid) {
    const int tid = get_tid(wid);
    const int lane = tid & 63, rg = lane >> 3, pc = lane & 7;
    const unsigned loff = (unsigned)(s4 * (NEXP * 128) + pc * 16);
    const int N = 8 * ((NTOK / 128 - k + nloc - 1) / nloc);
    if (N <= 0) return;
    Ids16 idE, idO; HP8 hE, hO;
    u32x4 rA[8], rB[8];
    const fp8_t* tab = (const fp8_t*)U4;
    ids_load(idE, a.EX, run_token2(0, k, nloc, wid, th), rg);
    ids_load(idO, a.EX, run_token2(1, k, nloc, wid, th), rg);
    rows_lo(rA, idE, tab, loff); hp_load(hE, a, run_token2(0, k, nloc, wid, th), s4, pc); rows_hi(rB, idE, tab, loff);
#pragma unroll 1
    for (int n = 0; n < N; n += 2) {
        const int t0 = run_token2(n, k, nloc, wid, th), t1 = run_token2(n + 1, k, nloc, wid, th);
        const int t2 = run_token2((n + 2 < N) ? n + 2 : N - 1, k, nloc, wid, th), t3 = run_token2((n + 3 < N) ? n + 3 : N - 1, k, nloc, wid, th);
        {
            float p[16];
#pragma unroll
            for (int i = 0; i < 8; ++i) p[i] = row_dot32q(rA[i], hE);
            rows_lo(rA, idO, tab, loff); hp_load(hO, a, t1, s4, pc);
#pragma unroll
            for (int i = 0; i < 8; ++i) p[8 + i] = row_dot32q(rB[i], hE);
            rows_hi(rB, idO, tab, loff);
            ids_load(idE, a.EX, t2, rg);
            peerU_finish(a, p, t0, s4, lane);
        }
        {
            float p[16];
#pragma unroll
            for (int i = 0; i < 8; ++i) p[i] = row_dot32q(rA[i], hO);
            rows_lo(rA, idE, tab, loff); hp_load(hE, a, t2, s4, pc);
#pragma unroll
            for (int i = 0; i < 8; ++i) p[8 + i] = row_dot32q(rB[i], hO);
            rows_hi(rB, idE, tab, loff);
            ids_load(idO, a.EX, t3, rg);
            peerU_finish(a, p, t1, s4, lane);
        }
    }
}

DI void conv_batch_v(const float* __restrict__ src, fp4x2_t* __restrict__ dst, float* __restrict__ scales, int r0, int lane) {
#pragma unroll 1
    for (int row = r0; row < r0 + 32; row += 2) {
        const float4* p0 = (const float4*)(src + (size_t)row * DM + lane * 16);
        const float4* p1 = (const float4*)(src + (size_t)(row + 1) * DM + lane * 16);
        const float4 a0 = p0[0], a1 = p0[1], a2 = p0[2], a3 = p0[3];
        const float4 b0 = p1[0], b1 = p1[1], b2 = p1[2], b3 = p1[3];
        conv_row_fp4_one(a0, a1, a2, a3, dst, scales, NEXP, row, lane);
        conv_row_fp4_one(b0, b1, b2, b3, dst, scales, NEXP, row + 1, lane);
    }
}
DI void conv_row_int4_one(float4 a0, float4 a1, float4 a2, float4 a3, const float4& g0, const float4& g1, const float4& g2, const float4& g3,
                          fp4x2_t* __restrict__ dst, float* __restrict__ scales, int row, int lane) {
    const float v0[8] = {a0.x * g0.x, a0.y * g0.y, a0.z * g0.z, a0.w * g0.w, a1.x * g1.x, a1.y * g1.y, a1.z * g1.z, a1.w * g1.w};
    const float v1[8] = {a2.x * g2.x, a2.y * g2.y, a2.z * g2.z, a2.w * g2.w, a3.x * g3.x, a3.y * g3.y, a3.z * g3.z, a3.w * g3.w};
    float ss = 0.f;
#pragma unroll
    for (int i = 0; i < 8; ++i) ss += v0[i] * v0[i] + v1[i] * v1[i];
    ss = wave_sum(ss, lane);
    const float rms = sqrtf(ss * (1.f / 1024.f));
    const float step = (rms > 0.f) ? 0.36f * rms : 1.f, inv = 1.f / step;
    *(uint2*)(dst + ((size_t)(lane >> 4) * NEXP + row) * 128 + (lane & 15) * 8) = make_uint2(pack_i4x8(v0, inv), pack_i4x8(v1, inv));
    if (lane == 0) scales[row] = step;
}
DI void conv_batch_u(const float* __restrict__ src, const float* __restrict__ gain, fp4x2_t* __restrict__ dst, float* __restrict__ scales, int r0, int lane) {
    const float4* g = (const float4*)(gain + lane * 16);
    const float4 g0 = g[0], g1 = g[1], g2 = g[2], g3 = g[3];
#pragma unroll 1
    for (int row = r0; row < r0 + 32; row += 2) {
        const float4* p0 = (const float4*)(src + (size_t)row * DM + lane * 16);
        const float4* p1 = (const float4*)(src + (size_t)(row + 1) * DM + lane * 16);
        const float4 a0 = p0[0], a1 = p0[1], a2 = p0[2], a3 = p0[3];
        const float4 b0 = p1[0], b1 = p1[1], b2 = p1[2], b3 = p1[3];
        conv_row_int4_one(a0, a1, a2, a3, g0, g1, g2, g3, dst, scales, row, lane);
        conv_row_int4_one(b0, b1, b2, b3, g0, g1, g2, g3, dst, scales, row + 1, lane);
    }
}
struct MegaArgs {
    const float* x; const float* a_re; const float* a_im; const float* log_dt; const float* b_re; const float* b_im; const float* c_re;
    const float* c_im; const float* d_skip; const float* b_glu; const float* pool_scale; const float* u_exp; const float* v_exp;
    const float* norm_final;
    PrepW pw;
    float* X; bf16_t* U; bf16_t* YPRE; bf16_t* G1; bf16_t* A2; bf16_t* Hb; bf16_t* Qb; unsigned short* EX; float* GT; float* RSTD;
    char* KT; bf16x8* WST; bf16x8* CCAR; float* ABT; fp4x2_t* U4; fp4x2_t* V4; float* SU; float* SV; float* PD; bf16_t* COEF; unsigned* HPH; unsigned* HPL; float* HS;
    unsigned* bar;
    int coop_probe; int pad_;
};

#ifndef REP_P0
#define REP_P0 1
#endif
#ifndef REP_PA
#define REP_PA 1
#endif
#ifndef REP_PB
#define REP_PB 1
#endif
#ifndef REP_C1
#define REP_C1 1
#endif
#ifndef REP_C2
#define REP_C2 1
#endif
#ifndef REP_U
#define REP_U 1
#endif
#ifndef REP_R
#define REP_R 1
#endif
#ifndef REP_V
#define REP_V 1
#endif
#ifndef REP_BAR
#define REP_BAR 1
#endif
#define XBAR() do { for (int rb_ = 0; rb_ < REP_BAR; ++rb_) xcd_barrier(xb, wid); } while (0)
__global__ void __launch_bounds__(NTHR) mega_kernel(MegaArgs a) {
    __shared__ __attribute__((aligned(16))) char smem[PB_BYTES];
    __shared__ uint4 xb_words;
    cg::grid_group grid = cg::this_grid();
    const int nblk = gridDim.x;
    const int wid = __builtin_amdgcn_readfirstlane(threadIdx.x >> 6);
    if (get_tid(wid) == 0) xb_words = make_uint4(0u, 0u, 0u, 0u);
    __syncthreads();
    const XcdBarrier xb = xcd_barrier_post(a.bar, (volatile LAS unsigned*)&xb_words, get_tid(wid));
    for (int rep = 0; rep < REP_P0; ++rep) {
        const size_t gtid = (size_t)blockIdx.x * NTHR + get_tid(wid), gs = (size_t)nblk * NTHR;
        const int nprep = nblk >> 1;
        if ((int)blockIdx.x >= nblk - nprep) {
            const int pb = (int)blockIdx.x - (nblk - nprep);
            for (int it = pb; it < 256; it += nprep)
                prep_s5_item(it >> 2, it & 3, a.a_re, a.a_im, a.log_dt, a.b_re, a.b_im, a.c_re, a.c_im, a.d_skip, a.KT, a.WST, a.CCAR, a.ABT, smem, wid);
            const size_t ptid = (size_t)pb * NTHR + (gtid - (size_t)blockIdx.x * NTHR), pgs = (size_t)nprep * NTHR;
            prep_weights(a.pw, ptid, pgs);
            for (int l = 0; l < 2; ++l) {
                conv_kfrag(a.pw.k1 + (size_t)l * 128 * 128, a.pw.wfk1 + (size_t)l * (128 * 128 / 8), ptid, pgs);
                conv_kfrag(a.pw.k2 + (size_t)l * 128 * 128, a.pw.wfk2 + (size_t)l * (128 * 128 / 8), ptid, pgs);
            }
        } else if (nprep == 0) {
            for (int it = 0; it < 256; ++it)
                prep_s5_item(it >> 2, it & 3, a.a_re, a.a_im, a.log_dt, a.b_re, a.b_im, a.c_re, a.c_im, a.d_skip, a.KT, a.WST, a.CCAR, a.ABT, smem, wid);
            prep_weights(a.pw, gtid, gs);
            for (int l = 0; l < 2; ++l) {
                conv_kfrag(a.pw.k1 + (size_t)l * 128 * 128, a.pw.wfk1 + (size_t)l * (128 * 128 / 8), gtid, gs);
                conv_kfrag(a.pw.k2 + (size_t)l * 128 * 128, a.pw.wfk2 + (size_t)l * (128 * 128 / 8), gtid, gs);
            }
        }
        {
            const int lane = get_tid(wid) & 63;
            unsigned* ctr = a.bar + XB_QUEUE(rep);
            for (;;) {
                unsigned q = 0u;
                if (lane == 0) q = xb_add(ctr, 1u);
                q = (unsigned)__builtin_amdgcn_readfirstlane((int)q);
                if (q >= 4u * (NEXP / 32)) break;
                const int tb = (int)(q / (NEXP / 32)), r0 = (int)(q % (NEXP / 32)) * 32, l = tb >> 1;
                if (tb & 1) conv_batch_v(a.v_exp + (size_t)l * NEXP * DM, a.V4 + (size_t)l * NEXP * (DM / 2), a.SV + l * NEXP, r0, lane);
                else conv_batch_u(a.u_exp + (size_t)l * NEXP * DM, a.pw.norm_ffn + l * DM, a.U4 + (size_t)l * NEXP * (DM / 2), a.SU + l * NEXP, r0, lane);
            }
        }
    }
    XBAR();
    if (a.coop_probe) grid.sync();
    __shared__ int sched[4];
    if (get_tid(wid) == 0) {
        int nx = 0, myj = 0, nloc = 1;
        for (unsigned j = 0; j < 16; ++j) {
            const unsigned cj = xb_ld(&a.bar[XB_XCNT(j)]);
            if (j == xb.x) { myj = nx; nloc = (int)cj; }
            nx += (cj > 0u) ? 1 : 0;
        }
        sched[0] = (int)xb.st[2]; sched[1] = nloc > 0 ? nloc : 1; sched[2] = myj; sched[3] = nx > 0 ? nx : 1;
    }
    __syncthreads();
    const int s_rank = sched[0], s_nloc = sched[1], s_myj = sched[2], s_nx = sched[3];
#pragma unroll 1
    for (int l = 0; l < 2; ++l) {
        const float* xin = (l == 0) ? a.x : a.X;
        if (l == 0) {
            for (int rep = 0; rep < REP_PA; ++rep)
            for (int tile = blockIdx.x; tile < NTOK / 64; tile += nblk) phaseA_tile(xin, a.pw.wfin, a.U, tile, smem, wid);
        }
        XBAR();
        bf16_t* Ul = a.U + (size_t)l * NTOK * DM;
        for (int rep = 0; rep < REP_PB; ++rep)
        for (int tile = blockIdx.x; tile < 256; tile += nblk)
            phaseB_tile(Ul, a.KT + (size_t)l * 32 * KT_BYTES, a.WST + (size_t)l * 32 * WST_FRAGS, a.CCAR + (size_t)l * 32 * CCAR_FRAGS, a.ABT + l * 32 * 128, a.YPRE, tile, smem, wid);
        XBAR();
        PCArgs pa; pa.U = Ul; pa.YPRE = a.YPRE; pa.G1 = a.G1; pa.A2 = a.A2; pa.Xin = xin; pa.Xout = a.X; pa.Xdummy = (float*)a.Qb; pa.HPH = a.HPH; pa.HPL = a.HPL; pa.HS = a.HS; pa.Hb = a.Hb; pa.RSTD = a.RSTD;
        pa.wfglu = a.pw.wfglu + (size_t)l * (512 * 512 / 8); pa.b_glu = a.b_glu + l * 512; pa.wfpool = a.pw.wfpool + (size_t)l * 4 * (128 * 128 / 8);
        pa.pool_scale = a.pool_scale + l * 512; pa.wfout = a.pw.wfout + (size_t)l * (DM * DM / 8);
        PRArgs pr; pr.Hb = a.Hb; pr.RSTD = a.RSTD; pr.wfq = a.pw.wfq + (size_t)l * (DM * 2048 / 8); pr.kf1 = a.pw.wfk1 + (size_t)l * (128 * 128 / 8);
        pr.kf2 = a.pw.wfk2 + (size_t)l * (128 * 128 / 8); pr.EX = a.EX; pr.GT = a.GT;
        for (int tile = blockIdx.x; tile < NTOK / 64; tile += nblk) {
            for (int rep = 1; rep < REP_C1; ++rep) { PCArgs pa2 = pa; pa2.Xout = (float*)a.Qb; phaseC1_tile(pa2, tile, smem, wid); }
            phaseC1_tile(pa, tile, smem, wid);
            for (int rep = 0; rep < REP_C2; ++rep) phaseC2_tile(pr, tile, smem, wid);
        }
        XBAR();
        PSArgs ps; ps.Hb = a.Hb; ps.RSTD = a.RSTD; ps.EX = a.EX; ps.GT = a.GT;
        ps.SU = a.SU + l * NEXP; ps.SV = a.SV + l * NEXP; ps.PD = a.PD; ps.COEF = a.COEF; ps.Xin = a.X; ps.Xout = a.X; ps.HPH = a.HPH; ps.HPL = a.HPL; ps.HS = a.HS;
        for (int rep = 0; rep < REP_U; ++rep) {
            for (int v = s_myj; v < 8; v += s_nx) peerUi_run(ps, a.U4 + (size_t)l * NEXP * (DM / 2), v & 3, v >> 2, s_rank, s_nloc, wid);
        }
        XBAR();
        for (int rep = 0; rep < REP_R; ++rep)
        for (int tile = blockIdx.x; tile < NTOK / 64; tile += nblk) peerR_tile(ps, tile, wid);
        XBAR();
        for (int rep = 1; rep < REP_V; ++rep) { PSArgs ps2 = ps; ps2.Xout = (float*)a.Qb; for (int v = s_myj; v < 8; v += s_nx) peerV4_run(ps2, a.V4 + (size_t)l * NEXP * (DM / 2), v & 3, v >> 2, s_rank, s_nloc, wid); }
        for (int v = s_myj; v < 8; v += s_nx) peerV4_run(ps, a.V4 + (size_t)l * NEXP * (DM / 2), v & 3, v >> 2, s_rank, s_nloc, wid);
        XBAR();
        if (l == 0) {
            for (int rep = 0; rep < REP_PA; ++rep)
            for (int tile = blockIdx.x; tile < NTOK / 64; tile += nblk) phaseA_tile(a.X, a.pw.wfin + (size_t)(DM * DM / 8), a.U + (size_t)NTOK * DM, tile, smem, wid);
        } else {
            for (int tile = blockIdx.x; tile < NTOK / 64; tile += nblk) final_norm_tile(a.X, a.norm_final, tile, wid);
        }
    }
}

extern "C" void kernel_launch(void* const* d_in, const int* in_sizes, int n_in, void* d_out, int out_size, void* d_ws, size_t ws_size,
                              hipStream_t stream) {
    char* wsb = (char*)d_ws;
    size_t off = 0;
    auto take = [&](size_t bytes) { char* p = wsb + off; off += (bytes + 255) & ~(size_t)255; return p; };
    MegaArgs a;
    memset(&a, 0, sizeof(a));
    a.x = (const float*)d_in[0];
    a.pw.norm_mix = (const float*)d_in[1]; a.pw.w_in = (const float*)d_in[2];
    a.a_re = (const float*)d_in[3]; a.a_im = (const float*)d_in[4]; a.log_dt = (const float*)d_in[5];
    a.b_re = (const float*)d_in[6]; a.b_im = (const float*)d_in[7]; a.c_re = (const float*)d_in[8]; a.c_im = (const float*)d_in[9];
    a.d_skip = (const float*)d_in[10]; a.pw.w_glu = (const float*)d_in[11]; a.b_glu = (const float*)d_in[12];
    a.pw.w_pool = (const float*)d_in[13]; a.pool_scale = (const float*)d_in[14]; a.pw.g_out_ssm = (const float*)d_in[15];
    a.pw.g_out_pool = (const float*)d_in[16]; a.pw.w_out = (const float*)d_in[17]; a.pw.norm_ffn = (const float*)d_in[18];
    a.pw.w_q = (const float*)d_in[19]; a.pw.k1 = (const float*)d_in[20]; a.pw.k2 = (const float*)d_in[21];
    a.u_exp = (const float*)d_in[22]; a.v_exp = (const float*)d_in[23]; a.norm_final = (const float*)d_in[24];
    a.X = (float*)d_out;
    a.U = (bf16_t*)take((size_t)2 * NTOK * DM * 2);
    a.YPRE = (bf16_t*)take((size_t)NTOK * 512 * 2);
    a.G1 = (bf16_t*)take((size_t)NTOK * 512 * 2);
    a.A2 = (bf16_t*)take((size_t)NTOK * DM * 2);
    a.Hb = (bf16_t*)take((size_t)NTOK * DM * 2);
    a.Qb = (bf16_t*)take((size_t)NTOK * 2048 * 2);
    a.EX = (unsigned short*)take((size_t)NTOK * 128 * 2);
    a.GT = (float*)take((size_t)NTOK * 128 * 4);
    a.RSTD = (float*)take(NTOK * 4);
    a.pw.wfin = (bf16x8*)take((size_t)2 * DM * DM * 2);
    a.pw.wfglu = (bf16x8*)take((size_t)2 * 512 * 512 * 2);
    a.pw.wfpool = (bf16x8*)take((size_t)2 * 4 * 128 * 128 * 2);
    a.pw.wfout = (bf16x8*)take((size_t)2 * DM * DM * 2);
    a.pw.wfq = (bf16x8*)take((size_t)2 * DM * 2048 * 2);
    a.pw.wfk1 = (bf16x8*)take((size_t)2 * 128 * 128 * 2);
    a.pw.wfk2 = (bf16x8*)take((size_t)2 * 128 * 128 * 2);
    a.KT = take((size_t)64 * KT_BYTES);
    a.WST = (bf16x8*)take((size_t)64 * WST_FRAGS * 16);
    a.CCAR = (bf16x8*)take((size_t)64 * CCAR_FRAGS * 16);
    a.ABT = (float*)take(64 * 128 * 4);
    a.V4 = (fp4x2_t*)take((size_t)2 * NEXP * (DM / 2));
    a.U4 = (fp4x2_t*)take((size_t)2 * NEXP * (DM / 2));
    a.SU = (float*)take((size_t)2 * NEXP * 4);
    a.SV = (float*)take((size_t)2 * NEXP * 4);
    a.PD = (float*)take((size_t)NUSL * NTOK * 128 * 4);
    a.COEF = (bf16_t*)take((size_t)NTOK * 128 * 2);
    a.HPH = (unsigned*)take((size_t)NTOK * 128 * 4);
    a.HPL = (unsigned*)take((size_t)NTOK * 128 * 4);
    a.HS = (float*)take((size_t)NTOK * 4 * 4);
    a.bar = (unsigned*)take((size_t)XCD_BAR_WORDS * 4);
    hipMemsetAsync(a.bar, 0, (size_t)XCD_BAR_WORDS * 4, stream);

    static int grid_blocks = 0;
    if (!grid_blocks) {
        int dev = 0, cus = 0, per_cu = 0;
        hipGetDevice(&dev);
        hipDeviceGetAttribute(&cus, hipDeviceAttributeMultiprocessorCount, dev);
        hipOccupancyMaxActiveBlocksPerMultiprocessor(&per_cu, mega_kernel, NTHR, 0);
        if (per_cu > 1) per_cu = 1;
        grid_blocks = cus * per_cu;
        if (grid_blocks > 256) grid_blocks = 256;
    }
    void* args[] = {&a};
    hipError_t e = hipLaunchCooperativeKernel((void*)mega_kernel, dim3(grid_blocks), dim3(NTHR), args, 0, stream);
    if (e != hipSuccess) fprintf(stderr, "cooperative launch failed: %s (grid %d)\n", hipGetErrorString(e), grid_blocks);
}
```

```cpp
#include <hip/hip_runtime.h>
#include <hip/hip_cooperative_groups.h>
#include <cstdio>
#include <cstring>
#include <type_traits>
namespace cg = cooperative_groups;
#include <math.h>
#include <stdint.h>
#ifndef V_LO
#define V_LO 0
#endif
#ifndef V_MFMA
#define V_MFMA 1
#endif

#define NTOK 16384
#define SEQ 2048
#define DM 1024
#define SSMW 512
#define NEXP 16384

__device__ __forceinline__ float gelu_exact(float x) { return 0.5f * x * (1.f + erff(x * 0.70710678118654752f)); }

template <int M> __device__ __forceinline__ int shx_i(int v, int lane) {
    if constexpr (M == 1) return __builtin_amdgcn_mov_dpp(v, 0xB1, 0xF, 0xF, true);
    else if constexpr (M == 2) return __builtin_amdgcn_mov_dpp(v, 0x4E, 0xF, 0xF, true);
    else if constexpr (M < 32) return __builtin_amdgcn_ds_swizzle(v, (M << 10) | 0x1F);
    else return __builtin_amdgcn_ds_bpermute((lane ^ 32) << 2, v);
}
template <int M> __device__ __forceinline__ float shx(float v, int lane) { return __int_as_float(shx_i<M>(__float_as_int(v), lane)); }
__device__ __forceinline__ float wave_sum(float v, int lane) {
    v += shx<1>(v, lane); v += shx<2>(v, lane); v += shx<4>(v, lane); v += shx<8>(v, lane); v += shx<16>(v, lane); v += shx<32>(v, lane);
    return v;
}

__device__ __forceinline__ int get_tid(int wid) {
    int t = wid * 64 + (int)__builtin_amdgcn_mbcnt_hi(~0u, __builtin_amdgcn_mbcnt_lo(~0u, 0u));
    asm volatile("" : "+v"(t));
    return t;
}

#define DI __device__ __forceinline__
typedef __attribute__((ext_vector_type(8))) short bf16x8;
typedef __attribute__((ext_vector_type(16))) float f32x16;
typedef __attribute__((ext_vector_type(2))) __bf16 bf2_t;
typedef __attribute__((ext_vector_type(2))) float f2_t;
typedef unsigned short bf16_t;
typedef __attribute__((ext_vector_type(4))) unsigned u32x4;
typedef __attribute__((ext_vector_type(4))) float f32x4;
typedef const __attribute__((address_space(1))) bf16x8* gwp_t;
#define MFMA32(a, b, c) __builtin_amdgcn_mfma_f32_32x32x16_bf16((a), (b), (c), 0, 0, 0)

DI unsigned pack_bf2(float a, float b) { f2_t v = {a, b}; return __builtin_bit_cast(unsigned, __builtin_convertvector(v, bf2_t)); }
DI float bf_lo(unsigned u) { return __uint_as_float(u << 16); }
DI float bf_hi(unsigned u) { return __uint_as_float(u & 0xffff0000u); }
DI int crow(int reg, int h) { return (reg & 3) + 8 * (reg >> 2) + 4 * h; }

#define SA_STRIDE 272
#define SA_BYTES (64 * SA_STRIDE)
#define NTHR 512

template <bool GAIN>
DI void conv_wfrag(const float* __restrict__ src, int ldk, int ldn, const float* __restrict__ ga, const float* __restrict__ gb, int split,
                   int K, int N, int NTG, bf16x8* __restrict__ dst, size_t gtid, size_t gstride) {
    const int KS = K / 16;
    const size_t total = (size_t)(N / 32) * KS * 64;
    for (size_t item = gtid; item < total; item += gstride) {
        const int lane = (int)(item & 63); const size_t f = item >> 6;
        const int nti = (int)(f % NTG); const size_t f2 = f / NTG;
        const int ks = (int)(f2 % KS), nt = (int)(f2 / KS) * NTG + nti;
        const int r = lane & 31, h = lane >> 5;
        const int n = nt * 32 + r, k0 = ks * 16 + 8 * h;
        float v[8];
#pragma unroll
        for (int j = 0; j < 8; ++j) {
            const int k = k0 + j;
            float g = 1.f;
            if (GAIN) g = (k < split) ? ga[k] : gb[k - split];
            v[j] = src[(size_t)k * ldk + (size_t)n * ldn] * g;
        }
        uint4 o; o.x = pack_bf2(v[0], v[1]); o.y = pack_bf2(v[2], v[3]); o.z = pack_bf2(v[4], v[5]); o.w = pack_bf2(v[6], v[7]);
        *(uint4*)(dst + item) = o;
    }
}

DI void conv_rows_bf16(const float* __restrict__ src, const float* __restrict__ gain, bf16_t* __restrict__ dst, size_t nelem, size_t gtid, size_t gstride) {
    for (size_t i = gtid * 8; i < nelem; i += gstride * 8) {
        float4 a = *(const float4*)(src + i), b = *(const float4*)(src + i + 4);
        if (gain) {
            const int c = (int)(i & 1023);
            float4 g0 = *(const float4*)(gain + c), g1 = *(const float4*)(gain + c + 4);
            a.x *= g0.x; a.y *= g0.y; a.z *= g0.z; a.w *= g0.w; b.x *= g1.x; b.y *= g1.y; b.z *= g1.z; b.w *= g1.w;
        }
        uint4 o; o.x = pack_bf2(a.x, a.y); o.y = pack_bf2(a.z, a.w); o.z = pack_bf2(b.x, b.y); o.w = pack_bf2(b.z, b.w);
        *(uint4*)(dst + i) = o;
    }
}

struct ALoadF32 {
    const float* base; f32x4 v0, v1, v2, v3; float ss; int dofs;
    DI void init(const float* rowbase, int tid) { base = rowbase + (tid & 7) * 16; ss = 0.f; dofs = (tid >> 3) * SA_STRIDE + (tid & 7) * 32; }
    DI void issue(int c) { const f32x4* p = (const f32x4*)(base + c * 128); v0 = p[0]; v1 = p[1]; v2 = p[2]; v3 = p[3]; }
    DI void commit(char* buf) {
        u32x4 o0, o1;
        ss += v0.x * v0.x + v0.y * v0.y + v0.z * v0.z + v0.w * v0.w + v1.x * v1.x + v1.y * v1.y + v1.z * v1.z + v1.w * v1.w
            + v2.x * v2.x + v2.y * v2.y + v2.z * v2.z + v2.w * v2.w + v3.x * v3.x + v3.y * v3.y + v3.z * v3.z + v3.w * v3.w;
        o0.x = pack_bf2(v0.x, v0.y); o0.y = pack_bf2(v0.z, v0.w); o0.z = pack_bf2(v1.x, v1.y); o0.w = pack_bf2(v1.z, v1.w);
        o1.x = pack_bf2(v2.x, v2.y); o1.y = pack_bf2(v2.z, v2.w); o1.z = pack_bf2(v3.x, v3.y); o1.w = pack_bf2(v3.z, v3.w);
        char* d = buf + dofs;
        *(u32x4*)d = o0; *(u32x4*)(d + 16) = o1;
    }
};
struct ALoadF32W {
    const float* base; bf16_t* hb; f32x4 v0, v1, v2, v3; float ss; int dofs;
    DI void init(const float* rowbase, bf16_t* hbrow, int tid) { base = rowbase + (tid & 7) * 16; hb = hbrow + (tid & 7) * 16; ss = 0.f; dofs = (tid >> 3) * SA_STRIDE + (tid & 7) * 32; }
    DI void issue(int c) { const f32x4* p = (const f32x4*)(base + c * 128); v0 = p[0]; v1 = p[1]; v2 = p[2]; v3 = p[3]; }
    DI void commit(char* buf) {
        u32x4 o0, o1;
        ss += v0.x * v0.x + v0.y * v0.y + v0.z * v0.z + v0.w * v0.w + v1.x * v1.x + v1.y * v1.y + v1.z * v1.z + v1.w * v1.w
            + v2.x * v2.x + v2.y * v2.y + v2.z * v2.z + v2.w * v2.w + v3.x * v3.x + v3.y * v3.y + v3.z * v3.z + v3.w * v3.w;
        o0.x = pack_bf2(v0.x, v0.y); o0.y = pack_bf2(v0.z, v0.w); o0.z = pack_bf2(v1.x, v1.y); o0.w = pack_bf2(v1.z, v1.w);
        o1.x = pack_bf2(v2.x, v2.y); o1.y = pack_bf2(v2.z, v2.w); o1.z = pack_bf2(v3.x, v3.y); o1.w = pack_bf2(v3.z, v3.w);
        char* d = buf + dofs;
        *(u32x4*)d = o0; *(u32x4*)(d + 16) = o1;
        *(u32x4*)hb = o0; *(u32x4*)(hb + 8) = o1; hb += 128;
    }
};
struct ALoadBF16S {
    const bf16_t* base; u32x4 v0, v1; float ss; int dofs;
    DI void init(const bf16_t* rowbase, int tid) { base = rowbase + (tid & 7) * 16; ss = 0.f; dofs = (tid >> 3) * SA_STRIDE + (tid & 7) * 32; }
    DI void issue(int c) { const u32x4* p = (const u32x4*)(base + c * 128); v0 = p[0]; v1 = p[1]; }
    DI void commit(char* buf) {
        const unsigned w[8] = {v0.x, v0.y, v0.z, v0.w, v1.x, v1.y, v1.z, v1.w};
#pragma unroll
        for (int i = 0; i < 8; ++i) { const float lo = bf_lo(w[i]), hi = bf_hi(w[i]); ss += lo * lo + hi * hi; }
        char* d = buf + dofs;
        *(u32x4*)d = v0; *(u32x4*)(d + 16) = v1;
    }
};
struct ALoadBF16 {
    const bf16_t* base; u32x4 v0, v1; int dofs;
    DI void init(const bf16_t* rowbase, int tid) { base = rowbase + (tid & 7) * 16; dofs = (tid >> 3) * SA_STRIDE + (tid & 7) * 32; }
    DI void issue(int c) { const u32x4* p = (const u32x4*)(base + c * 128); v0 = p[0]; v1 = p[1]; }
    DI void commit(char* buf) {
        char* d = buf + dofs;
        *(u32x4*)d = v0; *(u32x4*)(d + 16) = v1;
    }
};

template <int NT, int PF, class AL>
DI void gemm64(f32x16 (&acc)[NT][2], AL& al, const int nchunks, const bf16x8* __restrict__ wf_, char* sA, const int lane) {
    gwp_t wf = (gwp_t)wf_;
    const int r = lane & 31, h = lane >> 5;
    bf16x8 bq[PF][NT];
    al.issue(0);
#pragma unroll
    for (int p = 0; p < PF; ++p)
#pragma unroll
        for (int nt = 0; nt < NT; ++nt) bq[p][nt] = wf[(p * NT + nt) * 64];
    gwp_t wpf = wf + PF * NT * 64;
    al.commit(sA);
    const int kend = nchunks * 8 - PF;
    int kg = 0;
#pragma unroll 1
    for (int c = 0; c < nchunks; ++c) {
        if (c + 1 < nchunks) al.issue(c + 1);
        __syncthreads();
        const char* buf = sA + (c & 1) * SA_BYTES + r * SA_STRIDE + h * 16;
#pragma unroll
        for (int ks = 0; ks < 8; ++ks) {
            const bf16x8 a0 = *(const bf16x8*)(buf + ks * 32);
            const bf16x8 a1 = *(const bf16x8*)(buf + 32 * SA_STRIDE + ks * 32);
#pragma unroll
            for (int nt = 0; nt < NT; ++nt) {
                acc[nt][0] = MFMA32(bq[ks % PF][nt], a0, acc[nt][0]);
                acc[nt][1] = MFMA32(bq[ks % PF][nt], a1, acc[nt][1]);
            }
            if (kg < kend) {
#pragma unroll
                for (int nt = 0; nt < NT; ++nt) bq[ks % PF][nt] = wpf[nt * 64];
            }
            wpf += NT * 64; ++kg;
            asm volatile("" : "+v"(wpf));
        }
        if (c + 1 < nchunks) al.commit(sA + ((c + 1) & 1) * SA_BYTES);
    }
    __syncthreads();
}

template <int NT>
DI void zero_acc(f32x16 (&acc)[NT][2]) {
#pragma unroll
    for (int nt = 0; nt < NT; ++nt)
#pragma unroll
        for (int mt = 0; mt < 2; ++mt)
#pragma unroll
            for (int i = 0; i < 16; ++i) acc[nt][mt][i] = 0.f;
}


DI void tile_transpose(const f32x16& t, float* wscr, int lane, f32x4 (&out)[4]) {
    const int r = lane & 31, h = lane >> 5;
#pragma unroll
    for (int q = 0; q < 4; ++q) { f32x4 v = {t[4 * q], t[4 * q + 1], t[4 * q + 2], t[4 * q + 3]}; *(f32x4*)(wscr + r * 36 + 8 * q + 4 * h) = v; }
#pragma unroll
    for (int j = 0; j < 4; ++j) out[j] = *(const f32x4*)(wscr + ((lane >> 3) + 8 * j) * 36 + (lane & 7) * 4);
}
#define WSCR_BYTES (32 * 36 * 4)

template <bool FIRST>
DI void phaseA_tile(const float* __restrict__ X, bf16_t* __restrict__ Hb, const bf16x8* __restrict__ wfin, bf16_t* __restrict__ U, int tile, char* smem, int wid) {
    char* sA = smem; float* srstd = (float*)(smem + 8 * WSCR_BYTES);
    int tok0 = tile * 64; asm volatile("" : "+s"(tok0));
    int tid = get_tid(wid);
    const int w = __builtin_amdgcn_readfirstlane(tid >> 6), lane = tid & 63, r = lane & 31, h = lane >> 5;
    typename std::conditional<FIRST, ALoadF32W, ALoadBF16S>::type al;
    if constexpr (FIRST) al.init(X + (size_t)(tok0 + (tid >> 3)) * DM, Hb + (size_t)(tok0 + (tid >> 3)) * DM, tid);
    else al.init(Hb + (size_t)(tok0 + (tid >> 3)) * DM, tid);
    f32x16 acc[4][2]; zero_acc<4>(acc);
    gemm64<4, 2>(acc, al, 8, wfin + (size_t)w * (64 * 4 * 64) + lane, sA, lane);
    float ss = al.ss;
    ss += shx<1>(ss, lane); ss += shx<2>(ss, lane); ss += shx<4>(ss, lane);
    if ((tid & 7) == 0) srstd[tid >> 3] = rsqrtf(ss * (1.f / 1024.f) + 1e-6f);
    __syncthreads();
    {
        float* wscr = (float*)(smem + w * WSCR_BYTES);
        const int tl = lane >> 3, cl = (lane & 7) * 4;
#pragma unroll
        for (int mt = 0; mt < 2; ++mt) {
            float rs[4];
#pragma unroll
            for (int j = 0; j < 4; ++j) rs[j] = srstd[mt * 32 + tl + 8 * j];
#pragma unroll
            for (int nt = 0; nt < 4; ++nt) {
                f32x4 o[4]; tile_transpose(acc[nt][mt], wscr, lane, o);
#pragma unroll
                for (int j = 0; j < 4; ++j) {
                    uint2 p; p.x = pack_bf2(o[j].x * rs[j], o[j].y * rs[j]); p.y = pack_bf2(o[j].z * rs[j], o[j].w * rs[j]);
                    *(uint2*)(U + (size_t)(tok0 + mt * 32 + tl + 8 * j) * DM + w * 128 + nt * 32 + cl) = p;
                }
            }
        }
    }
    __syncthreads();
}

struct PrepW {
    const float* norm_mix; const float* w_in; const float* w_glu; const float* w_pool; const float* g_out_ssm; const float* g_out_pool;
    const float* w_out; const float* norm_ffn; const float* w_q; const float* k1; const float* k2;
    bf16x8* wfin; bf16x8* wfglu; bf16x8* wfpool; bf16x8* wfout; bf16x8* wfq; bf16x8* wfk1; bf16x8* wfk2;
};
DI void prep_weights(const PrepW& p, size_t gtid, size_t gs) {
#pragma unroll 1
    for (int l = 0; l < 2; ++l) {
        conv_wfrag<true>(p.w_in + (size_t)l * DM * DM, DM, 1, p.norm_mix + l * DM, p.norm_mix + l * DM, DM, DM, DM, 4, p.wfin + (size_t)l * (DM * DM / 8), gtid, gs);
        conv_wfrag<false>(p.w_glu + (size_t)l * 512 * 512, 512, 1, p.norm_mix, p.norm_mix, 512, 512, 512, 2, p.wfglu + (size_t)l * (512 * 512 / 8), gtid, gs);
#pragma unroll 1
        for (int gi = 0; gi < 4; ++gi)
            conv_wfrag<false>(p.w_pool + (size_t)(l * 4 + gi) * 128 * 128, 128, 1, p.norm_mix, p.norm_mix, 128, 128, 128, 2, p.wfpool + (size_t)(l * 4 + gi) * (128 * 128 / 8), gtid, gs);
        conv_wfrag<true>(p.w_out + (size_t)l * DM * DM, DM, 1, p.g_out_ssm + l * 512, p.g_out_pool + l * 512, 512, DM, DM, 4, p.wfout + (size_t)l * (DM * DM / 8), gtid, gs);
        conv_wfrag<true>(p.w_q + (size_t)l * DM * 2048, 2048, 1, p.norm_ffn + l * DM, p.norm_ffn + l * DM, DM, DM, 2048, 4, p.wfq + (size_t)l * (DM * 2048 / 8), gtid, gs);
    }
}
#define KT_BLK 528
#define KT_BYTES (65 * KT_BLK)
#define WST_FRAGS (4 * 64 * 64)
#define CCAR_FRAGS (32 * 8 * 64)
#define SU_CH 2064

DI void prep_s5_item(int lg, int part, const float* __restrict__ a_re, const float* __restrict__ a_im, const float* __restrict__ log_dt,
                     const float* __restrict__ b_re, const float* __restrict__ b_im, const float* __restrict__ c_re, const float* __restrict__ c_im,
                     const float* __restrict__ d_skip, char* __restrict__ KT, bf16x8* __restrict__ WST, bf16x8* __restrict__ CCAR,
                     float* __restrict__ ABT, char* smem, int wid) {
    float* powr = (float*)smem;
    float* powi = powr + 65 * 64;
    float* bzr = powi + 65 * 64;
    float* bzi = bzr + 1024;
    float* cr = bzi + 1024;
    float* ci = cr + 1024;
    float* p1r = ci + 1024;
    float* p1i = p1r + 512;
    float* p8r = p1i + 512;
    float* p8i = p8r + 576;
    int tid = get_tid(wid);
    const float* are_p = a_re + lg * 64; const float* aim_p = a_im + lg * 64;
    const float dt = expf(log_dt[lg]);
    for (int it = tid; it < 17 * 64; it += NTHR) {
        const int q = it >> 6, p = it & 63, tau = q < 8 ? q : 8 * (q - 8);
        const float lre = are_p[p], lim = aim_p[p];
        const float mag = expf((float)tau * lre * dt);
        double rev = (double)lim * (double)dt * (double)tau * 0.15915494309189535;
        rev -= floor(rev);
        const float ang = (float)rev * 6.283185307179586f;
        const float vr = mag * cosf(ang), vi = mag * sinf(ang);
        if (q < 8) { p1r[q * 64 + p] = vr; p1i[q * 64 + p] = vi; } else { p8r[(q - 8) * 64 + p] = vr; p8i[(q - 8) * 64 + p] = vi; }
    }
    for (int it = tid; it < 1024; it += NTHR) {
        const int ho = it >> 6, p = it & 63;
        cr[p * 16 + ho] = c_re[lg * 1024 + it]; ci[p * 16 + ho] = c_im[lg * 1024 + it];
    }
    __syncthreads();
    for (int it = tid; it < 65 * 64; it += NTHR) {
        const int tau = it >> 6, p = it & 63, qa = tau >> 3, qb = tau & 7;
        const float ar = p8r[qa * 64 + p], ai = p8i[qa * 64 + p], br = p1r[qb * 64 + p], bi = p1i[qb * 64 + p];
        powr[it] = ar * br - ai * bi; powi[it] = ar * bi + ai * br;
    }
    __syncthreads();
    for (int it = tid; it < 1024; it += NTHR) {
        const int p = it >> 4;
        const float lre = are_p[p], lim = aim_p[p];
        const float ar = powr[64 + p], ai = powi[64 + p];
        const float inv = 1.f / (lre * lre + lim * lim), nre = ar - 1.f;
        const float zre = (nre * lre + ai * lim) * inv, zim = (ai * lre - nre * lim) * inv;
        const float br = b_re[lg * 1024 + it], bi = b_im[lg * 1024 + it];
        bzr[it] = zre * br - zim * bi; bzi[it] = zre * bi + zim * br;
    }
    __syncthreads();
    if (part == 0 && tid < 64) { ABT[lg * 128 + 2 * tid] = powr[64 * 64 + tid]; ABT[lg * 128 + 2 * tid + 1] = powi[64 * 64 + tid]; }
    char* kt = KT + (size_t)lg * KT_BYTES;
    if (part == 0) for (int it = tid; it < KT_BLK / 4; it += NTHR) ((unsigned*)kt)[it] = 0u;
    {
        const int tau = part * 16 + (tid >> 5), ho = (tid >> 1) & 15, hh = tid & 1;
        float sacc[8];
#pragma unroll
        for (int j = 0; j < 8; ++j) sacc[j] = 0.f;
#pragma unroll 4
        for (int p = 0; p < 64; ++p) {
            const float c_r = cr[p * 16 + ho], c_i = ci[p * 16 + ho], pr = powr[tau * 64 + p], pi = powi[tau * 64 + p];
            const float cpr = c_r * pr - c_i * pi, cpi = c_r * pi + c_i * pr;
            const float4 b0 = *(const float4*)(bzr + p * 16 + 8 * hh), b1 = *(const float4*)(bzr + p * 16 + 8 * hh + 4);
            const float4 d0 = *(const float4*)(bzi + p * 16 + 8 * hh), d1 = *(const float4*)(bzi + p * 16 + 8 * hh + 4);
            sacc[0] += cpr * b0.x - cpi * d0.x; sacc[1] += cpr * b0.y - cpi * d0.y; sacc[2] += cpr * b0.z - cpi * d0.z; sacc[3] += cpr * b0.w - cpi * d0.w;
            sacc[4] += cpr * b1.x - cpi * d1.x; sacc[5] += cpr * b1.y - cpi * d1.y; sacc[6] += cpr * b1.z - cpi * d1.z; sacc[7] += cpr * b1.w - cpi * d1.w;
        }
        if (tau == 0) {
#pragma unroll
            for (int j = 0; j < 8; ++j) if (ho == 8 * hh + j) sacc[j] += d_skip[lg * 16 + ho];
        }
        uint4 o; o.x = pack_bf2(sacc[0], sacc[1]); o.y = pack_bf2(sacc[2], sacc[3]); o.z = pack_bf2(sacc[4], sacc[5]); o.w = pack_bf2(sacc[6], sacc[7]);
        *(uint4*)(kt + (tau + 1) * KT_BLK + ho * 32 + hh * 16) = o;
    }
    if (part == 0) for (int it = tid; it < 65 * 4; it += NTHR) ((unsigned*)(kt + (it >> 2) * KT_BLK + 512))[it & 3] = 0u;
    bf16x8* wst = WST + (size_t)lg * WST_FRAGS;
    for (int it = part * (WST_FRAGS / 4) + tid; it < (part + 1) * (WST_FRAGS / 4); it += NTHR) {
        const int lane = it & 63, j = (it >> 6) & 63, nt = it >> 12;
        const int r = lane & 31, h = lane >> 5, n = nt * 32 + r, p = n & 63, im = n >> 6;
        const float pr = powr[(63 - j) * 64 + p], pi = powi[(63 - j) * 64 + p];
        float v[8];
#pragma unroll
        for (int jj = 0; jj < 8; ++jj) {
            const float zr = bzr[p * 16 + 8 * h + jj], zi = bzi[p * 16 + 8 * h + jj];
            v[jj] = im ? (pr * zi + pi * zr) : (pr * zr - pi * zi);
        }
        uint4 o; o.x = pack_bf2(v[0], v[1]); o.y = pack_bf2(v[2], v[3]); o.z = pack_bf2(v[4], v[5]); o.w = pack_bf2(v[6], v[7]);
        *(uint4*)(wst + it) = o;
    }
    bf16x8* cc = CCAR + (size_t)lg * CCAR_FRAGS;
    for (int it = part * (CCAR_FRAGS / 4) + tid; it < (part + 1) * (CCAR_FRAGS / 4); it += NTHR) {
        const int lane = it & 63, ks = (it >> 6) & 7, mt = it >> 9;
        const int r = lane & 31, h = lane >> 5, m = mt * 32 + r, i = m >> 4, ho = m & 15;
        float v[8];
#pragma unroll
        for (int jj = 0; jj < 8; ++jj) {
            const int k = ks * 16 + 8 * h + jj, p = k & 63, im = k >> 6;
            const float c_r = cr[p * 16 + ho], c_i = ci[p * 16 + ho], pr = powr[(i + 1) * 64 + p], pi = powi[(i + 1) * 64 + p];
            v[jj] = im ? -(c_r * pi + c_i * pr) : (c_r * pr - c_i * pi);
        }
        uint4 o; o.x = pack_bf2(v[0], v[1]); o.y = pack_bf2(v[2], v[3]); o.z = pack_bf2(v[4], v[5]); o.w = pack_bf2(v[6], v[7]);
        *(uint4*)(cc + it) = o;
    }
    __syncthreads();
}

#define PB_SU 0
#define PB_SKT (32 * SU_CH)
#define PB_SL (PB_SKT + KT_BYTES)
#define PB_SPART (PB_SL + 32 * 132 * 4)
#define PB_SSP (PB_SPART + 4 * 4096)
#define PB_BYTES (PB_SSP + 32 * 272)

DI void phaseB_tile(const bf16_t* __restrict__ U, const char* __restrict__ KT, const bf16x8* __restrict__ WST, const bf16x8* __restrict__ CCAR,
                    const float* __restrict__ ABT, bf16_t* __restrict__ YPRE, int tile, char* smem, int wid) {
    const int gp = tile & 31, b = tile >> 5;
    const int g = ((gp & 7) << 2) | (gp >> 3);
    int tid = get_tid(wid);
    const int w = __builtin_amdgcn_readfirstlane(tid >> 6), lane = tid & 63, r = lane & 31, h = lane >> 5;
    char* sU = smem + PB_SU; char* sKT = smem + PB_SKT; float* sL = (float*)(smem + PB_SL); float* sPart = (float*)(smem + PB_SPART);
    char* sSp = smem + PB_SSP;
#pragma unroll
    for (int it = 0; it < 4; ++it) {
        const int tok = tid + NTHR * it;
        const uint4* src = (const uint4*)(U + (size_t)(b * SEQ + tok) * DM + g * 16);
        const uint4 v0 = src[0], v1 = src[1];
        char* d = sU + (tok >> 6) * SU_CH + (tok & 63) * 32;
        *(uint4*)d = v0; *(uint4*)(d + 16) = v1;
    }
    {
        const uint4* src = (const uint4*)(KT + (size_t)g * KT_BYTES);
        for (int it = tid; it < KT_BYTES / 16; it += NTHR) ((uint4*)sKT)[it] = src[it];
    }
    __syncthreads();
    {
        const int nt = w & 3, kh = w >> 2;
        f32x16 acc;
#pragma unroll
        for (int i = 0; i < 16; ++i) acc[i] = 0.f;
        const bf16x8* wp = WST + (size_t)g * WST_FRAGS + (size_t)(nt * 64 + kh * 32) * 64 + lane;
        const char* up = sU + r * SU_CH + h * 16 + kh * 32 * 32;
#pragma unroll 16
        for (int j = 0; j < 32; ++j) {
            const bf16x8 a = wp[j * 64];
            const bf16x8 bb = *(const bf16x8*)(up + j * 32);
            acc = MFMA32(a, bb, acc);
        }
        if (kh == 1) {
#pragma unroll
            for (int i = 0; i < 16; ++i) sPart[(nt * 16 + i) * 64 + lane] = acc[i];
        }
        __syncthreads();
        if (kh == 0) {
#pragma unroll
            for (int i = 0; i < 16; ++i) sL[r * 132 + nt * 32 + crow(i, h)] = acc[i] + sPart[(nt * 16 + i) * 64 + lane];
        }
        __syncthreads();
    }
    if (tid < 64) {
        const int p = tid;
        const float ar = ABT[g * 128 + 2 * p], ai = ABT[g * 128 + 2 * p + 1];
        float sr = 0.f, si = 0.f;
        for (int c = 0; c < 32; ++c) {
            *(bf16_t*)(sSp + c * 272 + p * 2) = (bf16_t)(pack_bf2(sr, 0.f) & 0xffffu);
            *(bf16_t*)(sSp + c * 272 + (64 + p) * 2) = (bf16_t)(pack_bf2(si, 0.f) & 0xffffu);
            const float lr = sL[c * 132 + p], li = sL[c * 132 + 64 + p];
            const float nr = ar * sr - ai * si + lr, ni = ar * si + ai * sr + li;
            sr = nr; si = ni;
        }
    }
    f32x16 acc4[4];
#pragma unroll
    for (int q = 0; q < 4; ++q)
#pragma unroll
        for (int i = 0; i < 16; ++i) acc4[q][i] = 0.f;
    const int mts0 = w, mts1 = 15 - w, mts2 = 16 + w, mts3 = 31 - w;
    {
        const char* up = sU + r * SU_CH + h * 16;
        const char* kp = sKT + (r & 15) * 32 + h * 16 + ((r >> 4) + 1) * KT_BLK;
        for (int j = 0; j < 64; ++j) {
            const bf16x8 bb = *(const bf16x8*)(up + j * 32);
#define TOEP_STEP(q, mt) if (2 * (mt) + 1 >= j) { const bf16x8 a = *(const bf16x8*)(kp + (2 * (mt) - j) * KT_BLK); acc4[q] = MFMA32(a, bb, acc4[q]); }
            TOEP_STEP(0, mts0) TOEP_STEP(1, mts1) TOEP_STEP(2, mts2) TOEP_STEP(3, mts3)
#undef TOEP_STEP
        }
    }
    __syncthreads();
    {
        const bf16x8* cp = CCAR + (size_t)g * CCAR_FRAGS + lane;
        const char* sp = sSp + r * 272 + h * 16;
#pragma unroll
        for (int ks = 0; ks < 8; ++ks) {
            const bf16x8 bb = *(const bf16x8*)(sp + ks * 32);
            acc4[0] = MFMA32(cp[(mts0 * 8 + ks) * 64], bb, acc4[0]);
            acc4[1] = MFMA32(cp[(mts1 * 8 + ks) * 64], bb, acc4[1]);
            acc4[2] = MFMA32(cp[(mts2 * 8 + ks) * 64], bb, acc4[2]);
            acc4[3] = MFMA32(cp[(mts3 * 8 + ks) * 64], bb, acc4[3]);
        }
    }
    {
        bf16_t* ybase = YPRE + (size_t)(b * SEQ + r * 64) * 512 + g * 16;
#define PB_STORE(q, mt) _Pragma("unroll") for (int rq = 0; rq < 4; ++rq) { const int c0 = 8 * rq + 4 * h; const int i = 2 * (mt) + (c0 >> 4); \
            uint2 o; o.x = pack_bf2(acc4[q][4 * rq], acc4[q][4 * rq + 1]); o.y = pack_bf2(acc4[q][4 * rq + 2], acc4[q][4 * rq + 3]); \
            *(uint2*)(ybase + (size_t)i * 512 + (c0 & 15)) = o; }
        PB_STORE(0, mts0) PB_STORE(1, mts1) PB_STORE(2, mts2) PB_STORE(3, mts3)
#undef PB_STORE
    }
    __syncthreads();
}

#ifndef REP_GLU
#define REP_GLU 1
#endif
#ifndef REP_POOL
#define REP_POOL 1
#endif
#ifndef REP_OUT
#define REP_OUT 1
#endif
#ifndef REP_Q
#define REP_Q 1
#endif
#ifndef REP_SC
#define REP_SC 1
#endif
#define G1_STRIDE 1040
#define G1_OFF (4 * SA_BYTES + 4096 + 256)
struct ALoadGelu {
    const bf16_t* base; char* gout; u32x4 v0, v1; int cc; int dofs;
    DI void init(const bf16_t* rowbase, char* smem, int tid) { base = rowbase + (tid & 7) * 16; gout = smem + G1_OFF + (tid >> 3) * G1_STRIDE + (tid & 7) * 32; dofs = (tid >> 3) * SA_STRIDE + (tid & 7) * 32; }
    DI void issue(int c) { const u32x4* p = (const u32x4*)(base + c * 128); v0 = p[0]; v1 = p[1]; cc = c; }
    DI unsigned g2(unsigned u) { return pack_bf2(gelu_exact(bf_lo(u)), gelu_exact(bf_hi(u))); }
    DI void commit(char* buf) {
        u32x4 o0, o1;
        o0.x = g2(v0.x); o0.y = g2(v0.y); o0.z = g2(v0.z); o0.w = g2(v0.w);
        o1.x = g2(v1.x); o1.y = g2(v1.y); o1.z = g2(v1.z); o1.w = g2(v1.w);
        char* d = buf + dofs;
        *(u32x4*)d = o0; *(u32x4*)(d + 16) = o1;
        u32x4* gp = (u32x4*)(gout + cc * 256); gp[0] = o0; gp[1] = o1;
    }
};

DI void tok_reduce(float p0, float p1, float* sred, float& t0, float& t1, int tid) {
    const int w = tid >> 6, lane = tid & 63, r = lane & 31, h = lane >> 5;
    __syncthreads();
    sred[(w * 2 + h) * 64 + r] = p0; sred[(w * 2 + h) * 64 + 32 + r] = p1;
    __syncthreads();
    float a = 0.f, b = 0.f;
#pragma unroll
    for (int k = 0; k < 16; ++k) { a += sred[k * 64 + r]; b += sred[k * 64 + 32 + r]; }
    t0 = a; t1 = b;
}

#define PC_SRED (4 * SA_BYTES)
#define PC_BYTES (PC_SRED + 4096 + 256)

struct PCArgs {
    const bf16_t* U; const bf16_t* YPRE; bf16_t* G1; bf16_t* A2; const float* Xin; float* Xout; float* Xdummy; unsigned* HPH; unsigned* HPL; float* HS; bf16_t* Hb; float* RSTD;
    const bf16x8* wfglu; const float* b_glu; const bf16x8* wfpool; const float* pool_scale; const bf16x8* wfout;
};

DI void phaseC1_tile(const PCArgs& a, int tile, char* smem, int wid) {
    char* sA = smem; float* sred = (float*)(smem + PC_SRED);
    for (int rep_ = 0; rep_ < REP_GLU; ++rep_) {
        int tok0 = tile * 64; asm volatile("" : "+s"(tok0));
        int tid = get_tid(wid);
        const int w = __builtin_amdgcn_readfirstlane(tid >> 6), lane = tid & 63, r = lane & 31, h = lane >> 5;
        ALoadGelu al; al.init(a.YPRE + (size_t)(tok0 + (tid >> 3)) * 512, smem, tid);
        f32x16 acc[2][2]; zero_acc<2>(acc);
        gemm64<2, 4>(acc, al, 4, a.wfglu + (size_t)w * (32 * 2 * 64) + lane, sA, lane);
        float ss0 = 0.f, ss1 = 0.f;
        {
            uint2 yp[2][2][4]; float4 bg[2][4];
#pragma unroll
            for (int nt = 0; nt < 2; ++nt)
#pragma unroll
                for (int q = 0; q < 4; ++q) bg[nt][q] = *(const float4*)(a.b_glu + w * 64 + nt * 32 + 8 * q + 4 * h);
#pragma unroll
            for (int mt = 0; mt < 2; ++mt)
#pragma unroll
                for (int nt = 0; nt < 2; ++nt)
#pragma unroll
                    for (int q = 0; q < 4; ++q)
                        yp[mt][nt][q] = *(const uint2*)(smem + G1_OFF + (mt * 32 + r) * G1_STRIDE + (w * 64 + nt * 32 + 8 * q + 4 * h) * 2);
#pragma unroll
            for (int mt = 0; mt < 2; ++mt)
#pragma unroll
                for (int nt = 0; nt < 2; ++nt)
#pragma unroll
                    for (int q = 0; q < 4; ++q) {
                        const float y0 = bf_lo(yp[mt][nt][q].x), y1 = bf_hi(yp[mt][nt][q].x), y2 = bf_lo(yp[mt][nt][q].y), y3 = bf_hi(yp[mt][nt][q].y);
                        const float o0 = y0 / (1.f + __expf(-(acc[nt][mt][4 * q] + bg[nt][q].x)));
                        const float o1 = y1 / (1.f + __expf(-(acc[nt][mt][4 * q + 1] + bg[nt][q].y)));
                        const float o2 = y2 / (1.f + __expf(-(acc[nt][mt][4 * q + 2] + bg[nt][q].z)));
                        const float o3 = y3 / (1.f + __expf(-(acc[nt][mt][4 * q + 3] + bg[nt][q].w)));
                        acc[nt][mt][4 * q] = o0; acc[nt][mt][4 * q + 1] = o1; acc[nt][mt][4 * q + 2] = o2; acc[nt][mt][4 * q + 3] = o3;
                        const float s = o0 * o0 + o1 * o1 + o2 * o2 + o3 * o3;
                        if (mt == 0) ss0 += s; else ss1 += s;
                    }
        }
        float t0, t1; tok_reduce(ss0, ss1, sred, t0, t1, tid);
        const float rs0 = rsqrtf(t0 * (1.f / 512.f) + 1e-6f), rs1 = rsqrtf(t1 * (1.f / 512.f) + 1e-6f);
#pragma unroll
        for (int mt = 0; mt < 2; ++mt) {
            const float rs = mt ? rs1 : rs0;
            bf16_t* orow = a.A2 + (size_t)(tok0 + mt * 32 + r) * DM + w * 64;
#pragma unroll
            for (int nt = 0; nt < 2; ++nt)
#pragma unroll
                for (int q = 0; q < 4; ++q) {
                    uint2 o; o.x = pack_bf2(acc[nt][mt][4 * q] * rs, acc[nt][mt][4 * q + 1] * rs);
                    o.y = pack_bf2(acc[nt][mt][4 * q + 2] * rs, acc[nt][mt][4 * q + 3] * rs);
                    *(uint2*)(orow + nt * 32 + 8 * q + 4 * h) = o;
                }
        }
    }
    for (int rep_ = 0; rep_ < REP_POOL; ++rep_) {
        int tok0 = tile * 64; asm volatile("" : "+s"(tok0));
        int tid = get_tid(wid);
        const int w = __builtin_amdgcn_readfirstlane(tid >> 6), lane = tid & 63, r = lane & 31, h = lane >> 5;
        const int row = tid >> 3, seg = tid & 7;
        const int tok = tok0 + row, t = tok & (SEQ - 1);
#pragma unroll
        for (int gi = 0; gi < 4; ++gi) {
            const int win = 2 << gi;
            const int cnt = (t + 1 < win) ? (t + 1) : win;
            const bf16_t* up = a.U + (size_t)tok * DM + 512 + gi * 128 + seg * 16;
            float s[16];
            const uint4 c0 = *(const uint4*)up, c1 = *(const uint4*)(up + 8);
            const unsigned cu[8] = {c0.x, c0.y, c0.z, c0.w, c1.x, c1.y, c1.z, c1.w};
#pragma unroll
            for (int i = 0; i < 8; ++i) { s[2 * i] = bf_lo(cu[i]); s[2 * i + 1] = bf_hi(cu[i]); }
#pragma unroll
            for (int k0 = 1; k0 < win; k0 += 5) {
                uint4 d0[5], d1[5];
#pragma unroll
                for (int u = 0; u < 5; ++u)
                    if (k0 + u < win) {
                        const bf16_t* p = (k0 + u <= t) ? up - (size_t)(k0 + u) * DM : up;
                        d0[u] = *(const uint4*)p; d1[u] = *(const uint4*)(p + 8);
                    }
#pragma unroll
                for (int u = 0; u < 5; ++u)
                    if (k0 + u < win) {
                        const float m = (k0 + u <= t) ? 1.f : 0.f;
                        const unsigned du[8] = {d0[u].x, d0[u].y, d0[u].z, d0[u].w, d1[u].x, d1[u].y, d1[u].z, d1[u].w};
#pragma unroll
                        for (int i = 0; i < 8; ++i) { s[2 * i] = fmaf(m, bf_lo(du[i]), s[2 * i]); s[2 * i + 1] = fmaf(m, bf_hi(du[i]), s[2 * i + 1]); }
                    }
            }
            const float inv = 1.f / (float)cnt;
            unsigned o[8];
#pragma unroll
            for (int i = 0; i < 8; ++i) o[i] = pack_bf2(s[2 * i] * inv - bf_lo(cu[i]), s[2 * i + 1] * inv - bf_hi(cu[i]));
            char* d = sA + gi * SA_BYTES + row * SA_STRIDE + seg * 32;
            *(uint4*)d = make_uint4(o[0], o[1], o[2], o[3]); *(uint4*)(d + 16) = make_uint4(o[4], o[5], o[6], o[7]);
        }
        __syncthreads();
        const int gi = w >> 1;
        f32x16 acc[2][2]; zero_acc<2>(acc);
        const bf16x8* wp = a.wfpool + (size_t)gi * (128 * 128 / 8) + (size_t)(w & 1) * (8 * 2 * 64) + lane;
        const char* buf = sA + gi * SA_BYTES + r * SA_STRIDE + h * 16;
#pragma unroll
        for (int ks = 0; ks < 8; ++ks) {
            const bf16x8 a0 = *(const bf16x8*)(buf + ks * 32);
            const bf16x8 a1 = *(const bf16x8*)(buf + 32 * SA_STRIDE + ks * 32);
#pragma unroll
            for (int nt = 0; nt < 2; ++nt) {
                const bf16x8 wv = wp[(ks * 2 + nt) * 64];
                acc[nt][0] = MFMA32(wv, a0, acc[nt][0]);
                acc[nt][1] = MFMA32(wv, a1, acc[nt][1]);
            }
        }
        float ss0 = 0.f, ss1 = 0.f;
        float4 psc[2][4];
#pragma unroll
        for (int nt = 0; nt < 2; ++nt)
#pragma unroll
            for (int q = 0; q < 4; ++q) psc[nt][q] = *(const float4*)(a.pool_scale + w * 64 + nt * 32 + 8 * q + 4 * h);
#pragma unroll
        for (int mt = 0; mt < 2; ++mt)
#pragma unroll
            for (int nt = 0; nt < 2; ++nt)
#pragma unroll
                for (int q = 0; q < 4; ++q) {
                    const float4 sc = psc[nt][q];
                    const float o0 = acc[nt][mt][4 * q] * sc.x, o1 = acc[nt][mt][4 * q + 1] * sc.y, o2 = acc[nt][mt][4 * q + 2] * sc.z, o3 = acc[nt][mt][4 * q + 3] * sc.w;
                    acc[nt][mt][4 * q] = o0; acc[nt][mt][4 * q + 1] = o1; acc[nt][mt][4 * q + 2] = o2; acc[nt][mt][4 * q + 3] = o3;
                    const float s = o0 * o0 + o1 * o1 + o2 * o2 + o3 * o3;
                    if (mt == 0) ss0 += s; else ss1 += s;
                }
        float t0, t1; tok_reduce(ss0, ss1, sred, t0, t1, tid);
        const float rs0 = rsqrtf(t0 * (1.f / 512.f) + 1e-6f), rs1 = rsqrtf(t1 * (1.f / 512.f) + 1e-6f);
#pragma unroll
        for (int mt = 0; mt < 2; ++mt) {
            const float rs = mt ? rs1 : rs0;
            bf16_t* orow = a.A2 + (size_t)(tok0 + mt * 32 + r) * DM + 512 + w * 64;
#pragma unroll
            for (int nt = 0; nt < 2; ++nt)
#pragma unroll
                for (int q = 0; q < 4; ++q) {
                    uint2 o; o.x = pack_bf2(acc[nt][mt][4 * q] * rs, acc[nt][mt][4 * q + 1] * rs);
                    o.y = pack_bf2(acc[nt][mt][4 * q + 2] * rs, acc[nt][mt][4 * q + 3] * rs);
                    *(uint2*)(orow + nt * 32 + 8 * q + 4 * h) = o;
                }
        }
        __syncthreads();
    }
    for (int rep_ = 0; rep_ < REP_OUT; ++rep_) {
        int tok0 = tile * 64; asm volatile("" : "+s"(tok0));
        int tid = get_tid(wid);
        const int w = __builtin_amdgcn_readfirstlane(tid >> 6), lane = tid & 63, r = lane & 31, h = lane >> 5;
        ALoadBF16 al; al.init(a.A2 + (size_t)(tok0 + (tid >> 3)) * DM, tid);
        f32x16 acc[4][2]; zero_acc<4>(acc);
        gemm64<4, 2>(acc, al, 8, a.wfout + (size_t)w * (64 * 4 * 64) + lane, sA, lane);
        {
            float* wscr = (float*)(smem + w * WSCR_BYTES);
            const int tl = lane >> 3, cl = (lane & 7) * 4;
            float ssj[2][4];
#pragma unroll
            for (int mt = 0; mt < 2; ++mt)
#pragma unroll
                for (int j = 0; j < 4; ++j) ssj[mt][j] = 0.f;
            uint2 xc[4], xn[4];
            const size_t rbase = (size_t)(tok0 + tl) * DM + w * 128 + cl;
#pragma unroll
            for (int j = 0; j < 4; ++j) xc[j] = *(const uint2*)(a.Hb + rbase + (size_t)(8 * j) * DM);
#pragma unroll
            for (int g = 0; g < 8; ++g) {
                const int mt = g >> 2, nt = g & 3;
                if (g < 7) {
                    const size_t rn = rbase + (size_t)((g + 1) >> 2) * 32 * DM + ((g + 1) & 3) * 32;
#pragma unroll
                    for (int j = 0; j < 4; ++j) xn[j] = *(const uint2*)(a.Hb + rn + (size_t)(8 * j) * DM);
                }
                f32x4 o[4]; tile_transpose(acc[nt][mt], wscr, lane, o);
                const size_t ro = rbase + (size_t)mt * 32 * DM + nt * 32;
#pragma unroll
                for (int j = 0; j < 4; ++j) {
                    float4 xo; xo.x = bf_lo(xc[j].x) + o[j].x; xo.y = bf_hi(xc[j].x) + o[j].y; xo.z = bf_lo(xc[j].y) + o[j].z; xo.w = bf_hi(xc[j].y) + o[j].w;
                    uint2 p; p.x = pack_bf2(xo.x, xo.y); p.y = pack_bf2(xo.z, xo.w);
                    *(uint2*)(a.Hb + ro + (size_t)(8 * j) * DM) = p;
                    ssj[mt][j] += xo.x * xo.x + xo.y * xo.y + xo.z * xo.z + xo.w * xo.w;
                }
                asm volatile("" ::: "memory");
#pragma unroll
                for (int j = 0; j < 4; ++j) xc[j] = xn[j];
            }
#pragma unroll
            for (int mt = 0; mt < 2; ++mt)
#pragma unroll
                for (int j = 0; j < 4; ++j) {
                    float v = ssj[mt][j];
                    v += shx<1>(v, lane); v += shx<2>(v, lane); v += shx<4>(v, lane);
                    if ((lane & 7) == 0) sred[w * 64 + mt * 32 + tl + 8 * j] = v;
                }
            __syncthreads();
            if (tid < 64) {
                float tot = 0.f;
#pragma unroll
                for (int k = 0; k < 8; ++k) tot += sred[k * 64 + tid];
                a.RSTD[tok0 + tid] = rsqrtf(tot * (1.f / 1024.f) + 1e-6f);
            }
        }
        __syncthreads();
    }
    {
        int tok0 = tile * 64; asm volatile("" : "+s"(tok0));
        int tid = get_tid(wid);
        const int w = __builtin_amdgcn_readfirstlane(tid >> 6), lane = tid & 63;
        u32x4 hq0[8], hq1[8];
#pragma unroll
        for (int ti = 0; ti < 8; ++ti) { const u32x4* hp = (const u32x4*)(a.Hb + (size_t)(tok0 + w * 8 + ti) * DM + lane * 16); hq0[ti] = hp[0]; hq1[ti] = hp[1]; }
#pragma unroll
        for (int ti = 0; ti < 8; ++ti) {
            const int tok = tok0 + w * 8 + ti;
            const u32x4 h0 = hq0[ti], h1 = hq1[ti];
            const unsigned wv[8] = {h0.x, h0.y, h0.z, h0.w, h1.x, h1.y, h1.z, h1.w};
            float f[16]; float m = 0.f;
#pragma unroll
            for (int i = 0; i < 8; ++i) { f[2 * i] = bf_lo(wv[i]); f[2 * i + 1] = bf_hi(wv[i]); m = fmaxf(m, fmaxf(fabsf(f[2 * i]), fabsf(f[2 * i + 1]))); }
            m = fmaxf(m, __int_as_float(__builtin_amdgcn_update_dpp(0, __float_as_int(m), 0xB1, 0xF, 0xF, true)));
            m = fmaxf(m, __int_as_float(__builtin_amdgcn_update_dpp(0, __float_as_int(m), 0x4E, 0xF, 0xF, true)));
            m = fmaxf(m, __int_as_float(__builtin_amdgcn_update_dpp(0, __float_as_int(m), 0x141, 0xF, 0xF, true)));
            m = fmaxf(m, __int_as_float(__builtin_amdgcn_update_dpp(0, __float_as_int(m), 0x140, 0xF, 0xF, true)));
            const float sh = (m > 0.f) ? m * (1.f / 119.f) : 1.f, inv = 1.f / sh;
            unsigned Hd[2], Ld[2];
#pragma unroll
            for (int d = 0; d < 2; ++d) {
                unsigned A = 0u, B = 0u;
#pragma unroll
                for (int i = 0; i < 4; ++i) {
                    A = __builtin_amdgcn_cvt_pk_u8_f32(rintf(f[8 * d + i] * inv) + 136.f, i, A);
                    B = __builtin_amdgcn_cvt_pk_u8_f32(rintf(f[8 * d + 4 + i] * inv) + 136.f, i, B);
                }
                Ld[d] = ((A & 0x0F0F0F0Fu) | ((B & 0x0F0F0F0Fu) << 4)) ^ 0x88888888u;
                Hd[d] = (((A >> 4) & 0x0F0F0F0Fu) | (B & 0xF0F0F0F0u)) ^ 0x88888888u;
            }
            *(uint2*)(a.HPH + (size_t)tok * 128 + 2 * lane) = make_uint2(Hd[0], Hd[1]);
            *(uint2*)(a.HPL + (size_t)tok * 128 + 2 * lane) = make_uint2(Ld[0], Ld[1]);
            if ((lane & 15) == 0) a.HS[(size_t)tok * 4 + (lane >> 4)] = sh;
        }
    }
}

DI unsigned f2ord(float f) { const unsigned u = __float_as_uint(f); return u ^ ((u >> 31) ? 0xFFFFFFFFu : 0x80000000u); }
DI float ord2f(unsigned o) { return __uint_as_float((o & 0x80000000u) ? (o ^ 0x80000000u) : ~o); }
DI unsigned umax_(unsigned a, unsigned b) { return a > b ? a : b; }
DI unsigned umin_(unsigned a, unsigned b) { return a < b ? a : b; }

struct PRArgs {
    const bf16_t* Hb; const float* RSTD; const bf16x8* wfq; const bf16x8* kf1; const bf16x8* kf2; unsigned short* EX; float* GT;
};

DI void conv_kfrag(const float* __restrict__ K, bf16x8* __restrict__ dst, size_t gtid, size_t gstride) {
    for (size_t item = gtid; item < 8 * 4 * 64; item += gstride) {
        const int lane = (int)(item & 63), kt = (int)((item >> 6) & 3), ks = (int)(item >> 8);
        const int r = lane & 31, h = lane >> 5;
        float v[8];
#pragma unroll
        for (int j = 0; j < 8; ++j) v[j] = K[(size_t)(kt * 32 + r) * 128 + (ks >> 1) * 32 + 16 * (ks & 1) + 8 * (j >> 2) + 4 * h + (j & 3)];
        uint4 o; o.x = pack_bf2(v[0], v[1]); o.y = pack_bf2(v[2], v[3]); o.z = pack_bf2(v[4], v[5]); o.w = pack_bf2(v[6], v[7]);
        *(uint4*)(dst + item) = o;
    }
}

DI float fmax_(float a, float b) { return __builtin_fmaxf(a, b); }
DI float fmin_(float a, float b) { return __builtin_fminf(a, b); }
#define CE_(i, j) { const float hi_ = fmax_(a[i], a[j]), lo_ = fmin_(a[i], a[j]); a[i] = hi_; a[j] = lo_; }
DI void sort16_desc(float (&a)[16]) {
    CE_(0,13) CE_(1,12) CE_(2,15) CE_(3,14) CE_(4,8) CE_(5,6) CE_(7,11) CE_(9,10)
    CE_(0,5) CE_(1,7) CE_(2,9) CE_(3,4) CE_(6,13) CE_(8,14) CE_(10,15) CE_(11,12)
    CE_(0,1) CE_(2,3) CE_(4,5) CE_(6,8) CE_(7,9) CE_(10,11) CE_(12,13) CE_(14,15)
    CE_(0,2) CE_(1,3) CE_(4,10) CE_(5,11) CE_(6,7) CE_(8,9) CE_(12,14) CE_(13,15)
    CE_(1,2) CE_(3,12) CE_(4,6) CE_(5,7) CE_(8,10) CE_(9,11) CE_(13,14)
    CE_(1,4) CE_(2,6) CE_(5,8) CE_(7,10) CE_(9,13) CE_(11,14)
    CE_(2,4) CE_(3,6) CE_(9,12) CE_(11,13)
    CE_(3,5) CE_(6,8) CE_(7,9) CE_(10,12)
    CE_(3,4) CE_(5,6) CE_(7,8) CE_(9,10) CE_(11,12)
    CE_(6,7) CE_(8,9)
}
DI void top16_merge(float (&a)[16], const float (&b)[16]) {
#pragma unroll
    for (int i = 0; i < 16; ++i) a[i] = fmax_(a[i], b[15 - i]);
#pragma unroll
    for (int j = 8; j > 0; j >>= 1)
#pragma unroll
        for (int i = 0; i < 16; ++i) {
            const int l = i ^ j;
            if (l > i) CE_(i, l)
        }
}
DI void make_keys(float (&x)[16], const f32x16& s, int nbase) {
#pragma unroll
    for (int i = 0; i < 16; ++i) x[i] = __uint_as_float((__float_as_uint(s[i]) & 0xFFFFFF80u) | (unsigned)(127 - (nbase + crow(i, 0))));
}

#define PR_LIST_STRIDE 80
#define PR_SLIST (2 * SA_BYTES)
#define PR_SIDX (PR_SLIST + 8 * 32 * PR_LIST_STRIDE)

DI void phaseC2_tile(const PRArgs& a, int tile, char* smem, int wid) {
    char* sA = smem;
#pragma unroll 1
    for (int ps = 0; ps < 2; ++ps) {
        int tok0 = tile * 64; asm volatile("" : "+s"(tok0));
        int tid = get_tid(wid);
        const int w = __builtin_amdgcn_readfirstlane(tid >> 6), lane = tid & 63, r = lane & 31, h = lane >> 5;
        const int ng = ps * 8 + w, hd = ng >> 1, hf = ng & 1;
        bf16x8 qb[2][8];
        {
            ALoadBF16 al; al.init(a.Hb + (size_t)(tok0 + (tid >> 3)) * DM, tid);
            f32x16 acc[4][2]; zero_acc<4>(acc);
            gemm64<4, 2>(acc, al, 8, a.wfq + (size_t)ng * (64 * 4 * 64) + lane, sA, lane);
#pragma unroll
            for (int mt = 0; mt < 2; ++mt)
#pragma unroll
                for (int nt = 0; nt < 4; ++nt)
#pragma unroll
                    for (int s = 0; s < 2; ++s) {
                        u32x4 p;
                        p.x = pack_bf2(acc[nt][mt][8 * s], acc[nt][mt][8 * s + 1]); p.y = pack_bf2(acc[nt][mt][8 * s + 2], acc[nt][mt][8 * s + 3]);
                        p.z = pack_bf2(acc[nt][mt][8 * s + 4], acc[nt][mt][8 * s + 5]); p.w = pack_bf2(acc[nt][mt][8 * s + 6], acc[nt][mt][8 * s + 7]);
                        qb[mt][nt * 2 + s] = __builtin_bit_cast(bf16x8, p);
                    }
        }
        gwp_t kf = (gwp_t)(hf ? a.kf2 : a.kf1) + lane;
        float Town[16];
        const unsigned hmask = ~((unsigned)h << 2);
#pragma unroll
        for (int mt = 0; mt < 2; ++mt) {
            f32x16 sc[4];
#pragma unroll
            for (int kt = 0; kt < 4; ++kt)
#pragma unroll
                for (int i = 0; i < 16; ++i) sc[kt][i] = 0.f;
#pragma unroll
            for (int ks = 0; ks < 8; ++ks) {
#pragma unroll
                for (int kt = 0; kt < 4; ++kt) sc[kt] = MFMA32(kf[(ks * 4 + kt) * 64], qb[mt][ks], sc[kt]);
                if (ks & 1) asm volatile("" ::: "memory");
            }
            float L[16], S[16];
            make_keys(L, sc[0], 0); sort16_desc(L);
#pragma unroll
            for (int kt = 1; kt < 4; ++kt) { make_keys(S, sc[kt], kt * 32); sort16_desc(S); top16_merge(L, S); }
#pragma unroll
            for (int k = 0; k < 16; ++k) L[k] = __uint_as_float(__float_as_uint(L[k]) & hmask);
#pragma unroll
            for (int k = 0; k < 16; ++k) S[k] = __int_as_float(shx_i<32>(__float_as_int(L[k]), lane));
            top16_merge(L, S);
            if (mt == hf) {
#pragma unroll
                for (int k = 0; k < 16; ++k) Town[k] = L[k];
            } else {
                char* dst = smem + PR_SLIST + (w * 32 + r) * PR_LIST_STRIDE + h * 32;
                f32x4 v0, v1;
                if (h == 0) { v0 = (f32x4){L[0], L[1], L[2], L[3]}; v1 = (f32x4){L[4], L[5], L[6], L[7]}; }
                else { v0 = (f32x4){L[8], L[9], L[10], L[11]}; v1 = (f32x4){L[12], L[13], L[14], L[15]}; }
                *(f32x4*)dst = v0; *(f32x4*)(dst + 16) = v1;
            }
        }
        __syncthreads();
        float T0[16], T1[16];
        {
            const char* src = smem + PR_SLIST + ((w ^ 1) * 32 + r) * PR_LIST_STRIDE;
            const f32x4 p0 = *(const f32x4*)src, p1 = *(const f32x4*)(src + 16), p2 = *(const f32x4*)(src + 32), p3 = *(const f32x4*)(src + 48);
            const float Tp[16] = {p0.x, p0.y, p0.z, p0.w, p1.x, p1.y, p1.z, p1.w, p2.x, p2.y, p2.z, p2.w, p3.x, p3.y, p3.z, p3.w};
#pragma unroll
            for (int k = 0; k < 16; ++k) { T0[k] = hf ? Tp[k] : Town[k]; T1[k] = hf ? Town[k] : Tp[k]; }
        }
        const float rs = a.RSTD[tok0 + hf * 32 + r];
        float v1[16], v2[16];
#pragma unroll
        for (int k = 0; k < 16; ++k) { v1[k] = __uint_as_float(__float_as_uint(T0[k]) & 0xFFFFFF80u) * rs; v2[k] = __uint_as_float(__float_as_uint(T1[k]) & 0xFFFFFF80u) * rs; }
        float C[16];
#pragma unroll
        for (int b = 0; b < 16; ++b) C[b] = __uint_as_float((__float_as_uint(v1[0] + v2[b]) & 0xFFFFFF00u) | (unsigned)(255 - b));
#pragma unroll
        for (int aa = 1; aa < 16; ++aa)
#pragma unroll
            for (int b = 0; b < 16; ++b)
                if ((aa + 1) * (b + 1) <= 16) {
                    float x = __uint_as_float((__float_as_uint(v1[aa] + v2[b]) & 0xFFFFFF00u) | (unsigned)(255 - (aa * 16 + b)));
#pragma unroll
                    for (int k = (aa + 1) * (b + 1) - 1; k < 16; ++k) { const float hi = fmax_(C[k], x); x = fmin_(C[k], x); C[k] = hi; }
                }
        unsigned* sI = (unsigned*)(smem + PR_SIDX) + (w * 64 + lane) * 9;
#pragma unroll
        for (int q = 0; q < 4; ++q) {
            unsigned p1 = 0u, p2 = 0u;
#pragma unroll
            for (int j = 0; j < 4; ++j) { p1 |= (127u - (__float_as_uint(T0[4 * q + j]) & 0x7Fu)) << (8 * j); p2 |= (127u - (__float_as_uint(T1[4 * q + j]) & 0x7Fu)) << (8 * j); }
            sI[q] = p1; sI[4 + q] = p2;
        }
        const unsigned char* sB = (const unsigned char*)sI;
        const float mx = __uint_as_float(__float_as_uint(C[0]) & 0xFFFFFF00u);
        float e[16]; float sum = 0.f; int ex[16];
#pragma unroll
        for (int k = 0; k < 16; ++k) {
            e[k] = __expf(__uint_as_float(__float_as_uint(C[k]) & 0xFFFFFF00u) - mx); sum += e[k];
            const unsigned ci = 255u - (__float_as_uint(C[k]) & 0xFFu);
            ex[k] = (int)sB[ci >> 4] * 128 + (int)sB[16 + (ci & 15u)];
        }
        const float inv = 1.f / sum;
        const size_t ob = ((size_t)(tok0 + hf * 32 + r) * 8 + hd) * 16;
        if (h == 0) {
#pragma unroll
            for (int q = 0; q < 2; ++q) *(uint4*)(a.EX + ob + 8 * q) = make_uint4((unsigned)ex[8 * q] | ((unsigned)ex[8 * q + 1] << 16), (unsigned)ex[8 * q + 2] | ((unsigned)ex[8 * q + 3] << 16),
                                                                       (unsigned)ex[8 * q + 4] | ((unsigned)ex[8 * q + 5] << 16), (unsigned)ex[8 * q + 6] | ((unsigned)ex[8 * q + 7] << 16));
        } else {
#pragma unroll
            for (int q = 0; q < 4; ++q) *(float4*)(a.GT + ob + 4 * q) = make_float4(e[4 * q] * inv, e[4 * q + 1] * inv, e[4 * q + 2] * inv, e[4 * q + 3] * inv);
        }
        __syncthreads();
    }
}
typedef const __attribute__((address_space(1))) u32x4* grow_t;
typedef unsigned char fp8_t;
#define XB_TMO      128
#define XB_XCNT(j)  (256  + 64 * (j))
#define XB_XSUB(j)  (1280 + 64 * (j))
#define XB_XGEN(j)  (2304 + 64 * (j))
#define XB_TOP      3328
#define XB_TOPGEN   3392
#define XB_QUEUE(j) (3456 + 64 * (j))
#define XCD_BAR_WORDS (3456 + 64 * 64)
#define XB_SPIN_CAP (1u << 20)
#define LAS __attribute__((address_space(3)))

DI unsigned xb_ld(unsigned* p)              { return __hip_atomic_load(p, __ATOMIC_RELAXED, __HIP_MEMORY_SCOPE_AGENT); }
DI unsigned xb_add(unsigned* p, unsigned v) { return __hip_atomic_fetch_add(p, v, __ATOMIC_RELAXED, __HIP_MEMORY_SCOPE_AGENT); }
DI unsigned xb_xcc_id() { return (unsigned)__builtin_amdgcn_s_getreg((3 << 11) | 20) & 0xFu; }
#define XB_SPIN(cond, bar) do { unsigned _sp = 0; while (cond) { __builtin_amdgcn_s_sleep(1); \
    if ((++_sp & 255u) == 0u) { if (xb_ld(&(bar)[XB_TMO])) break; if (_sp > XB_SPIN_CAP) { atomicAdd(&(bar)[XB_TMO], 1u); break; } } } } while (0)

struct XcdBarrier { unsigned* bar; unsigned x; volatile LAS unsigned* st; };

DI XcdBarrier xcd_barrier_post(unsigned* bar, volatile LAS unsigned* st, int tid) {
    XcdBarrier b; b.bar = bar; b.x = xb_xcc_id(); b.st = st;
    if (tid == 0) st[2] = xb_add(&bar[XB_XCNT(b.x)], 1u);
    return b;
}
DI void xcd_barrier_complete(unsigned* bar, unsigned x, unsigned& nloc, unsigned& nx) {
    const unsigned G = gridDim.x * gridDim.y * gridDim.z;
    unsigned sum, cnt, mine, sp = 0u;
    for (;;) {
        sum = 0u; cnt = 0u; mine = 0u;
#pragma unroll
        for (unsigned j = 0; j < 16; ++j) { const unsigned c = xb_ld(&bar[XB_XCNT(j)]); sum += c; cnt += (c > 0u) ? 1u : 0u; mine = (j == x) ? c : mine; }
        if (sum == G) break;
        __builtin_amdgcn_s_sleep(1);
        if ((++sp & 255u) == 0u) { if (xb_ld(&bar[XB_TMO])) break; if (sp > XB_SPIN_CAP) { atomicAdd(&bar[XB_TMO], 1u); break; } }
    }
    nloc = mine > 0u ? mine : 1u; nx = cnt > 0u ? cnt : 1u;
}
DI void xcd_barrier(const XcdBarrier& b, int wid) {
    asm volatile("s_waitcnt vmcnt(0)" ::: "memory");
    __syncthreads();
    if (get_tid(wid) == 0) {
        unsigned* bar = b.bar;
        __builtin_amdgcn_s_waitcnt(0);
        unsigned nloc = b.st[0], nx = b.st[1];
        if (nloc == 0u) { xcd_barrier_complete(bar, b.x, nloc, nx); b.st[0] = nloc; b.st[1] = nx; }
        const unsigned old = xb_add(&bar[XB_XSUB(b.x)], 1u);
        const unsigned gen = old / nloc;
        if (old + 1u == (gen + 1u) * nloc) {
            __builtin_amdgcn_fence(__ATOMIC_RELEASE, "agent");
            asm volatile("s_waitcnt vmcnt(0)" ::: "memory");
            const unsigned og = xb_add(&bar[XB_TOP], 1u);
            const unsigned tg = og / nx;
            if (og + 1u == (tg + 1u) * nx) xb_add(&bar[XB_TOPGEN], 1u);
            else XB_SPIN(xb_ld(&bar[XB_TOPGEN]) == tg, bar);
            __builtin_amdgcn_fence(__ATOMIC_ACQUIRE, "agent");
            xb_add(&bar[XB_XGEN(b.x)], 1u);
            asm volatile("s_waitcnt vmcnt(0)" ::: "memory");
        } else {
            XB_SPIN(xb_ld(&bar[XB_XGEN(b.x)]) == gen, bar);
            __builtin_amdgcn_fence(__ATOMIC_ACQUIRE, "agent");
            asm volatile("s_waitcnt vmcnt(0)" ::: "memory");
        }
    }
    __syncthreads();
}
#define NUSL 4
struct PSArgs {
    bf16_t* Hb; const float* RSTD; const unsigned short* EX; const float* GT; const float* SU; const float* SV;
    float* PD; bf16_t* COEF; const float* Xin; float* Xout; const unsigned* HPH; const unsigned* HPL; const float* HS; float* CS;
};

struct Ids16 { u32x4 a, b; };
DI void ids_load(Ids16& q, const unsigned short* EX, int tok, int rg) { const u32x4* p = (const u32x4*)(EX + (size_t)tok * 128 + rg * 16); q.a = p[0]; q.b = p[1]; }
#define ID_LO(w) (((w) & 0xFFFFu) * 128u + loff)
#define ID_HI(w) (((w) >> 16) * 128u + loff)
DI void rows_lo(u32x4 (&r)[8], const Ids16& q, const fp8_t* tab, unsigned loff) {
    r[0] = *(grow_t)(tab + ID_LO(q.a.x)); r[1] = *(grow_t)(tab + ID_HI(q.a.x)); r[2] = *(grow_t)(tab + ID_LO(q.a.y)); r[3] = *(grow_t)(tab + ID_HI(q.a.y));
    r[4] = *(grow_t)(tab + ID_LO(q.a.z)); r[5] = *(grow_t)(tab + ID_HI(q.a.z)); r[6] = *(grow_t)(tab + ID_LO(q.a.w)); r[7] = *(grow_t)(tab + ID_HI(q.a.w));
}
DI void rows_hi(u32x4 (&r)[8], const Ids16& q, const fp8_t* tab, unsigned loff) {
    r[0] = *(grow_t)(tab + ID_LO(q.b.x)); r[1] = *(grow_t)(tab + ID_HI(q.b.x)); r[2] = *(grow_t)(tab + ID_LO(q.b.y)); r[3] = *(grow_t)(tab + ID_HI(q.b.y));
    r[4] = *(grow_t)(tab + ID_LO(q.b.z)); r[5] = *(grow_t)(tab + ID_HI(q.b.z)); r[6] = *(grow_t)(tab + ID_LO(q.b.w)); r[7] = *(grow_t)(tab + ID_HI(q.b.w));
}
DI void peerU_finish(const PSArgs& a, float (&p)[16], int tok, int s, int lane) {
    const int rg = lane >> 3, pc = lane & 7;
    const bool b2 = pc & 4, b1 = pc & 2, b0 = pc & 1;
    float q8[8], q4[4], q2[2];
#pragma unroll
    for (int k = 0; k < 8; ++k) { const float keep = b2 ? p[k + 8] : p[k], send = b2 ? p[k] : p[k + 8]; q8[k] = keep + shx<4>(send, lane); }
#pragma unroll
    for (int k = 0; k < 4; ++k) { const float keep = b1 ? q8[k + 4] : q8[k], send = b1 ? q8[k] : q8[k + 4]; q4[k] = keep + shx<2>(send, lane); }
#pragma unroll
    for (int k = 0; k < 2; ++k) { const float keep = b0 ? q4[k + 2] : q4[k], send = b0 ? q4[k] : q4[k + 2]; q2[k] = keep + shx<1>(send, lane); }
    *(float2*)(a.PD + ((size_t)s * NTOK + tok) * 128 + rg * 16 + 2 * pc) = make_float2(q2[0], q2[1]);
}

DI void peerR_tile(const PSArgs& a, int tile, int wid) {
    const int tid = get_tid(wid);
    const int lane = tid & 63;
    const int tok0 = tile * 64 + wid * 8;
    int e0[8], e1[8];
#pragma unroll
    for (int ti = 0; ti < 8; ++ti) { e0[ti] = (int)a.EX[(size_t)(tok0 + ti) * 128 + lane]; e1[ti] = (int)a.EX[(size_t)(tok0 + ti) * 128 + 64 + lane]; }
#pragma unroll
    for (int hb = 0; hb < 2; ++hb) {
        float d0[4], d1[4], g0[4], g1[4], rs[4], u0[4], u1[4], v0[4], v1[4];
#pragma unroll
        for (int q = 0; q < 4; ++q) {
            const int tok = tok0 + hb * 4 + q;
            float s0 = 0.f, s1 = 0.f;
#pragma unroll
            for (int x = 0; x < NUSL; ++x) { const float* pp = a.PD + ((size_t)x * NTOK + tok) * 128 + lane; s0 += pp[0]; s1 += pp[64]; }
            d0[q] = s0; d1[q] = s1;
            g0[q] = a.GT[(size_t)tok * 128 + lane]; g1[q] = a.GT[(size_t)tok * 128 + 64 + lane]; rs[q] = a.RSTD[tok];
            u0[q] = a.SU[e0[hb * 4 + q]]; u1[q] = a.SU[e1[hb * 4 + q]]; v0[q] = a.SV[e0[hb * 4 + q]]; v1[q] = a.SV[e1[hb * 4 + q]];
        }
#pragma unroll
        for (int q = 0; q < 4; ++q) {
            const int tok = tok0 + hb * 4 + q;
            float2 o;
            o.x = gelu_exact(d0[q] * u0[q] * rs[q]) * g0[q] * v0[q];
            o.y = gelu_exact(d1[q] * u1[q] * rs[q]) * g1[q] * v1[q];
            float am = fmaxf(fabsf(o.x), fabsf(o.y));
            am = fmaxf(am, shx<1>(am, lane)); am = fmaxf(am, shx<2>(am, lane)); am = fmaxf(am, shx<4>(am, lane)); am = fmaxf(am, shx<8>(am, lane));
            am = fmaxf(am, shx<16>(am, lane)); am = fmaxf(am, shx<32>(am, lane));
            int ee = 0; (void)frexpf(am, &ee); ee = max(ee, -100);
            const float sc = ldexpf(1.f, 8 - ee), isc = ldexpf(1.f, ee - 8);
            const float sx = o.x * sc, sy = o.y * sc;
            int w8 = __builtin_amdgcn_cvt_pk_fp8_f32(sx, sy, 0, false);
            const float hx = __builtin_amdgcn_cvt_f32_fp8(w8, 0), hy = __builtin_amdgcn_cvt_f32_fp8(w8, 1);
            w8 = __builtin_amdgcn_cvt_pk_fp8_f32(sx - hx, sy - hy, w8, true);
            *(unsigned*)(a.COEF + (size_t)tok * 128 + 2 * lane) = (unsigned)w8;
            if (lane == 0) a.CS[tok] = isc;
        }
    }
}

struct Cf16 { u32x4 a, b; };
DI void cf_load(Cf16& q, const bf16_t* COEF, int tok, int rg) { const u32x4* p = (const u32x4*)(COEF + (size_t)tok * 128 + rg * 16); q.a = p[0]; q.b = p[1]; }
DI void final_norm_tile(const bf16_t* __restrict__ Hb, float* __restrict__ Out, const float* __restrict__ g, int tile, int wid) {
    const int tid = get_tid(wid);
    const int lane = tid & 63;
    const float* gf = g + lane * 16;
    const float4 g0 = *(const float4*)gf, g1 = *(const float4*)(gf + 4), g2 = *(const float4*)(gf + 8), g3 = *(const float4*)(gf + 12);
#pragma unroll 1
    for (int tb = 0; tb < 8; tb += 4) {
        u32x4 xv[4][2];
#pragma unroll
        for (int q = 0; q < 4; ++q) {
            const u32x4* xp = (const u32x4*)(Hb + (size_t)(tile * 64 + wid * 8 + tb + q) * DM + lane * 16);
            xv[q][0] = xp[0]; xv[q][1] = xp[1];
        }
#pragma unroll
        for (int q = 0; q < 4; ++q) {
            float* op = Out + (size_t)(tile * 64 + wid * 8 + tb + q) * DM + lane * 16;
            float4 x0 = make_float4(bf_lo(xv[q][0].x), bf_hi(xv[q][0].x), bf_lo(xv[q][0].y), bf_hi(xv[q][0].y));
            float4 x1 = make_float4(bf_lo(xv[q][0].z), bf_hi(xv[q][0].z), bf_lo(xv[q][0].w), bf_hi(xv[q][0].w));
            float4 x2 = make_float4(bf_lo(xv[q][1].x), bf_hi(xv[q][1].x), bf_lo(xv[q][1].y), bf_hi(xv[q][1].y));
            float4 x3 = make_float4(bf_lo(xv[q][1].z), bf_hi(xv[q][1].z), bf_lo(xv[q][1].w), bf_hi(xv[q][1].w));
            float ss = x0.x * x0.x + x0.y * x0.y + x0.z * x0.z + x0.w * x0.w + x1.x * x1.x + x1.y * x1.y + x1.z * x1.z + x1.w * x1.w
                     + x2.x * x2.x + x2.y * x2.y + x2.z * x2.z + x2.w * x2.w + x3.x * x3.x + x3.y * x3.y + x3.z * x3.z + x3.w * x3.w;
            ss = wave_sum(ss, lane);
            const float rf = rsqrtf(ss * (1.f / 1024.f) + 1e-6f);
            x0.x *= rf * g0.x; x0.y *= rf * g0.y; x0.z *= rf * g0.z; x0.w *= rf * g0.w; x1.x *= rf * g1.x; x1.y *= rf * g1.y; x1.z *= rf * g1.z; x1.w *= rf * g1.w;
            x2.x *= rf * g2.x; x2.y *= rf * g2.y; x2.z *= rf * g2.z; x2.w *= rf * g2.w; x3.x *= rf * g3.x; x3.y *= rf * g3.y; x3.z *= rf * g3.z; x3.w *= rf * g3.w;
            *(float4*)op = x0; *(float4*)(op + 4) = x1; *(float4*)(op + 8) = x2; *(float4*)(op + 12) = x3;
        }
    }
}

typedef unsigned char fp4x2_t;
DI void conv_row_fp4_one(float4 v0, float4 v1, float4 v2, float4 v3, fp4x2_t* __restrict__ dst, float* __restrict__ scales, int nrows, int row, int lane) {
    float m = fmaxf(fmaxf(fmaxf(fabsf(v0.x), fabsf(v0.y)), fmaxf(fabsf(v0.z), fabsf(v0.w))), fmaxf(fmaxf(fabsf(v1.x), fabsf(v1.y)), fmaxf(fabsf(v1.z), fabsf(v1.w))));
    m = fmaxf(m, fmaxf(fmaxf(fmaxf(fabsf(v2.x), fabsf(v2.y)), fmaxf(fabsf(v2.z), fabsf(v2.w))), fmaxf(fmaxf(fabsf(v3.x), fabsf(v3.y)), fmaxf(fabsf(v3.z), fabsf(v3.w)))));
    m = fmaxf(m, shx<1>(m, lane)); m = fmaxf(m, shx<2>(m, lane)); m = fmaxf(m, shx<4>(m, lane)); m = fmaxf(m, shx<8>(m, lane)); m = fmaxf(m, shx<16>(m, lane)); m = fmaxf(m, shx<32>(m, lane));
    const float sc = (m > 0.f) ? m * (1.f / 6.f) : 1.f;
    const float inv = 1.f / sc;
#if V_MFMA
    const int p = lane & 15;
    const float w[16] = {v0.x * inv, v0.y * inv, v0.z * inv, v0.w * inv, v1.x * inv, v1.y * inv, v1.z * inv, v1.w * inv,
                         v2.x * inv, v2.y * inv, v2.z * inv, v2.w * inv, v3.x * inv, v3.y * inv, v3.z * inv, v3.w * inv};
    fp4x2_t* rowp = dst + ((size_t)(lane >> 4) * nrows + row) * 128 + (4 * (p >> 2)) * 8 + 2 * (p & 3);
#pragma unroll
    for (int b = 0; b < 4; ++b) {
        unsigned d = 0u;
        d = __builtin_amdgcn_cvt_scalef32_pk_fp4_f32(d, w[b], w[b + 4], 1.0f, 0);
        d = __builtin_amdgcn_cvt_scalef32_pk_fp4_f32(d, w[b + 8], w[b + 12], 1.0f, 1);
        *(unsigned short*)(rowp + b * 8) = (unsigned short)d;
    }
#else
    unsigned d0 = 0u, d1 = 0u;
    d0 = __builtin_amdgcn_cvt_scalef32_pk_fp4_f32(d0, v0.x * inv, v0.y * inv, 1.0f, 0); d0 = __builtin_amdgcn_cvt_scalef32_pk_fp4_f32(d0, v0.z * inv, v0.w * inv, 1.0f, 1);
    d0 = __builtin_amdgcn_cvt_scalef32_pk_fp4_f32(d0, v1.x * inv, v1.y * inv, 1.0f, 2); d0 = __builtin_amdgcn_cvt_scalef32_pk_fp4_f32(d0, v1.z * inv, v1.w * inv, 1.0f, 3);
    d1 = __builtin_amdgcn_cvt_scalef32_pk_fp4_f32(d1, v2.x * inv, v2.y * inv, 1.0f, 0); d1 = __builtin_amdgcn_cvt_scalef32_pk_fp4_f32(d1, v2.z * inv, v2.w * inv, 1.0f, 1);
    d1 = __builtin_amdgcn_cvt_scalef32_pk_fp4_f32(d1, v3.x * inv, v3.y * inv, 1.0f, 2); d1 = __builtin_amdgcn_cvt_scalef32_pk_fp4_f32(d1, v3.z * inv, v3.w * inv, 1.0f, 3);
    *(uint2*)(dst + ((size_t)(lane >> 4) * nrows + row) * 128 + (lane & 15) * 8) = make_uint2(d0, d1);
#endif
    if (lane == 0) scales[row] = sc;
}
DI void conv_rows_fp4(const float* __restrict__ src, fp4x2_t* __restrict__ dst, float* __restrict__ scales, int nrows, int gwave, int nwaves, int lane) {
#pragma unroll 1
    for (int row = gwave; row < nrows; row += 2 * nwaves) {
        const int r1 = min(row + nwaves, nrows - 1);
        const float4* p0 = (const float4*)(src + (size_t)row * DM + lane * 16);
        const float4* p1 = (const float4*)(src + (size_t)r1 * DM + lane * 16);
        const float4 a0 = p0[0], a1 = p0[1], a2 = p0[2], a3 = p0[3];
        const float4 b0 = p1[0], b1 = p1[1], b2 = p1[2], b3 = p1[3];
        conv_row_fp4_one(a0, a1, a2, a3, dst, scales, nrows, row, lane);
        conv_row_fp4_one(b0, b1, b2, b3, dst, scales, nrows, r1, lane);
    }
}

typedef __attribute__((ext_vector_type(2))) _Float16 h2_t;
DI h2_t cvt4(unsigned w, int b) {
    return b == 0 ? __builtin_amdgcn_cvt_scalef32_pk_f16_fp4(w, 1.0f, 0) : b == 1 ? __builtin_amdgcn_cvt_scalef32_pk_f16_fp4(w, 1.0f, 1)
         : b == 2 ? __builtin_amdgcn_cvt_scalef32_pk_f16_fp4(w, 1.0f, 2) : __builtin_amdgcn_cvt_scalef32_pk_f16_fp4(w, 1.0f, 3);
}
DI void row_axpy32h(h2_t (&acc)[16], const u32x4& r, float c) {
    const _Float16 ch = (_Float16)c; const h2_t c2 = {ch, ch};
#pragma unroll
    for (int b = 0; b < 4; ++b) {
        acc[b] = __builtin_elementwise_fma(c2, cvt4(r.x, b), acc[b]); acc[4 + b] = __builtin_elementwise_fma(c2, cvt4(r.y, b), acc[4 + b]);
        acc[8 + b] = __builtin_elementwise_fma(c2, cvt4(r.z, b), acc[8 + b]); acc[12 + b] = __builtin_elementwise_fma(c2, cvt4(r.w, b), acc[12 + b]);
    }
}
DI void axpy8_4(h2_t (&acc)[16], const u32x4 (&r)[8], const u32x4& c) {
    row_axpy32h(acc, r[0], bf_lo(c.x)); row_axpy32h(acc, r[1], bf_hi(c.x)); row_axpy32h(acc, r[2], bf_lo(c.y)); row_axpy32h(acc, r[3], bf_hi(c.y));
    __builtin_amdgcn_sched_barrier(0);
    row_axpy32h(acc, r[4], bf_lo(c.z)); row_axpy32h(acc, r[5], bf_hi(c.z)); row_axpy32h(acc, r[6], bf_lo(c.w)); row_axpy32h(acc, r[7], bf_hi(c.w));
    __builtin_amdgcn_sched_barrier(0);
}
typedef __attribute__((ext_vector_type(2))) unsigned u32x2_t;
DI h2_t pairsum32(h2_t x, h2_t y) { auto r = __builtin_amdgcn_permlane32_swap(__builtin_bit_cast(unsigned, x), __builtin_bit_cast(unsigned, y), false, false);
                                   return __builtin_bit_cast(h2_t, (unsigned)r[0]) + __builtin_bit_cast(h2_t, (unsigned)r[1]); }
DI h2_t pairsum16(h2_t x, h2_t y) { auto r = __builtin_amdgcn_permlane16_swap(__builtin_bit_cast(unsigned, x), __builtin_bit_cast(unsigned, y), false, false);
                                   return __builtin_bit_cast(h2_t, (unsigned)r[0]) + __builtin_bit_cast(h2_t, (unsigned)r[1]); }
DI h2_t pairsum8(h2_t x, h2_t y, bool hi) {
    const h2_t keep = hi ? y : x, send = hi ? x : y;
    const int rcv = __builtin_amdgcn_update_dpp(0, __builtin_bit_cast(int, send), 0x128, 0xF, 0xF, true);
    return keep + __builtin_bit_cast(h2_t, rcv);
}
DI void peerV4_finish(const PSArgs& a, h2_t (&acc)[16], float4 xv, int tok, int s4, int lane) {
    const int rg = lane >> 3, pc = lane & 7;
    h2_t q8[8], q4[4], q2[2];
#pragma unroll
    for (int k = 0; k < 8; ++k) q8[k] = pairsum32(acc[k], acc[k + 8]);
#pragma unroll
    for (int k = 0; k < 4; ++k) q4[k] = pairsum16(q8[k], q8[k + 4]);
#pragma unroll
    for (int k = 0; k < 2; ++k) q2[k] = pairsum8(q4[k], q4[k + 2], (rg & 1) != 0);
    xv.x += (float)q2[0].x; xv.y += (float)q2[0].y; xv.z += (float)q2[1].x; xv.w += (float)q2[1].y;
    *(float4*)(a.Xout + (size_t)tok * DM + s4 * 256 + 32 * pc + 4 * rg) = xv;
}
DI int run_token2(int n, int k, int nloc, int wid, int th) { return (2 * (k + (n >> 3) * nloc) + th) * 64 + wid * 8 + (n & 7); }

DI void peerV4_run(const PSArgs& a, const fp4x2_t* V4, int s4, int th, int k, int nloc, int wid) {
    const int tid = get_tid(wid);
    const int lane = tid & 63, rg = lane >> 3, pc = lane & 7;
    const unsigned loff = (unsigned)(s4 * (NEXP * 128) + pc * 16);
    const int N = 8 * ((NTOK / 128 - k + nloc - 1) / nloc);
    if (N <= 0) return;
    Ids16 idE, idO; Cf16 cfE, cfO; float4 xE, xO;
    u32x4 rA[8], rB[8];
    const fp8_t* tab = (const fp8_t*)V4;
#define LOAD_X4(x_, tokv) { x_ = *(const float4*)(a.Xin + (size_t)(tokv) * DM + s4 * 256 + 32 * pc + 4 * rg); }
    ids_load(idE, a.EX, run_token2(0, k, nloc, wid, th), rg);
    ids_load(idO, a.EX, run_token2(1, k, nloc, wid, th), rg);
    rows_lo(rA, idE, tab, loff); cf_load(cfE, a.COEF, run_token2(0, k, nloc, wid, th), rg); rows_hi(rB, idE, tab, loff); LOAD_X4(xE, run_token2(0, k, nloc, wid, th));
#pragma unroll 1
    for (int n = 0; n < N; n += 2) {
        const int t0 = run_token2(n, k, nloc, wid, th), t1 = run_token2(n + 1, k, nloc, wid, th);
        const int t2 = run_token2((n + 2 < N) ? n + 2 : N - 1, k, nloc, wid, th), t3 = run_token2((n + 3 < N) ? n + 3 : N - 1, k, nloc, wid, th);
        {
            h2_t acc[16];
#pragma unroll
            for (int i = 0; i < 16; ++i) acc[i] = (h2_t){(_Float16)0.f, (_Float16)0.f};
            axpy8_4(acc, rA, cfE.a);
            rows_lo(rA, idO, tab, loff); cf_load(cfO, a.COEF, t1, rg);
            axpy8_4(acc, rB, cfE.b);
            rows_hi(rB, idO, tab, loff); LOAD_X4(xO, t1);
            ids_load(idE, a.EX, t2, rg);
            peerV4_finish(a, acc, xE, t0, s4, lane);
        }
        {
            h2_t acc[16];
#pragma unroll
            for (int i = 0; i < 16; ++i) acc[i] = (h2_t){(_Float16)0.f, (_Float16)0.f};
            axpy8_4(acc, rA, cfO.a);
            rows_lo(rA, idE, tab, loff); cf_load(cfE, a.COEF, t2, rg);
            axpy8_4(acc, rB, cfO.b);
            rows_hi(rB, idE, tab, loff); LOAD_X4(xE, t2);
            ids_load(idO, a.EX, t3, rg);
            peerV4_finish(a, acc, xO, t1, s4, lane);
        }
    }
#undef LOAD_X4
}

typedef __attribute__((ext_vector_type(8))) int i32x8;
typedef const __attribute__((address_space(1))) u32x2_t* grow8_t;
#define MFMA_F4F8(A_, B_, C_) __builtin_amdgcn_mfma_scale_f32_16x16x128_f8f6f4(A_, B_, C_, 4, 0, 0, 0x7F7F7F7F, 0, 0x7F7F7F7F)
template <int S> DI unsigned rowbc(unsigned v) { return (unsigned)__builtin_amdgcn_update_dpp(0, (int)v, 0x150 + S, 0xF, 0xF, true); }
template <int S> DI u32x4 vm_row1(unsigned idp, unsigned idsh, const fp8_t* tab, unsigned loff) {
    const unsigned w = rowbc<S>(idp);
    return *(grow_t)(tab + (__builtin_amdgcn_ubfe(w, idsh, 16) * 128u + loff));
}
template <int H> DI void vm_rows(u32x4 (&r)[8], unsigned idp, unsigned idsh, const fp8_t* tab, unsigned loff) {
    r[0] = vm_row1<H + 0>(idp, idsh, tab, loff); r[1] = vm_row1<H + 1>(idp, idsh, tab, loff); r[2] = vm_row1<H + 2>(idp, idsh, tab, loff); r[3] = vm_row1<H + 3>(idp, idsh, tab, loff);
    r[4] = vm_row1<H + 4>(idp, idsh, tab, loff); r[5] = vm_row1<H + 5>(idp, idsh, tab, loff); r[6] = vm_row1<H + 6>(idp, idsh, tab, loff); r[7] = vm_row1<H + 7>(idp, idsh, tab, loff);
}
#define VM_NSEL (V_LO ? 16 : 8)
#ifndef VM_PROBE_NOMFMA
#define VM_PROBE_NOMFMA 0
#endif
template <int S> DI void vm_step(f32x4& accH, f32x4& accL, const u32x4& row, unsigned cfw, const unsigned (&sel)[VM_NSEL]) {
    unsigned cw = rowbc<S>(cfw);
    asm volatile("" : "+v"(cw));
    int A0, A1, A2, A3;
    asm volatile("s_mov_b64 vcc, %8\n\ts_nop 1\n\t"
                 "v_cndmask_b32_dpp %0, %6, %4, vcc quad_perm:[1,0,3,2] row_mask:0xf bank_mask:0xf\n\t"
                 "v_cndmask_b32_dpp %1, %7, %5, vcc quad_perm:[1,0,3,2] row_mask:0xf bank_mask:0xf\n\t"
                 "s_not_b64 vcc, vcc\n\t"
                 "v_cndmask_b32_dpp %2, %4, %6, vcc quad_perm:[1,0,3,2] row_mask:0xf bank_mask:0xf\n\t"
                 "v_cndmask_b32_dpp %3, %5, %7, vcc quad_perm:[1,0,3,2] row_mask:0xf bank_mask:0xf\n\ts_nop 1"
                 : "=&v"(A0), "=&v"(A1), "=&v"(A2), "=&v"(A3)
                 : "v"(row.x), "v"(row.y), "v"(row.z), "v"(row.w), "s"(0x5555555555555555ull)
                 : "vcc");
    const i32x8 A = {A0, A1, A2, A3, 0, 0, 0, 0};
    const i32x8 Bh = {(int)__builtin_amdgcn_perm(cw, cw, sel[0]), (int)__builtin_amdgcn_perm(cw, cw, sel[1]), (int)__builtin_amdgcn_perm(cw, cw, sel[2]), (int)__builtin_amdgcn_perm(cw, cw, sel[3]),
                      (int)__builtin_amdgcn_perm(cw, cw, sel[4]), (int)__builtin_amdgcn_perm(cw, cw, sel[5]), (int)__builtin_amdgcn_perm(cw, cw, sel[6]), (int)__builtin_amdgcn_perm(cw, cw, sel[7])};
    accH = MFMA_F4F8(A, Bh, accH);
#if V_LO
    const i32x8 Bl = {(int)__builtin_amdgcn_perm(cw, cw, sel[8]), (int)__builtin_amdgcn_perm(cw, cw, sel[9]), (int)__builtin_amdgcn_perm(cw, cw, sel[10]), (int)__builtin_amdgcn_perm(cw, cw, sel[11]),
                      (int)__builtin_amdgcn_perm(cw, cw, sel[12]), (int)__builtin_amdgcn_perm(cw, cw, sel[13]), (int)__builtin_amdgcn_perm(cw, cw, sel[14]), (int)__builtin_amdgcn_perm(cw, cw, sel[15])};
    accL = MFMA_F4F8(A, Bl, accL);
#endif
}
template <int H> DI void vm_half(f32x4& accH, f32x4& accL, const u32x4 (&r)[8], unsigned cfw, const unsigned (&sel)[VM_NSEL]) {
    vm_step<H + 0>(accH, accL, r[0], cfw, sel); vm_step<H + 1>(accH, accL, r[1], cfw, sel); __builtin_amdgcn_sched_barrier(0);
    vm_step<H + 2>(accH, accL, r[2], cfw, sel); vm_step<H + 3>(accH, accL, r[3], cfw, sel); __builtin_amdgcn_sched_barrier(0);
    vm_step<H + 4>(accH, accL, r[4], cfw, sel); vm_step<H + 5>(accH, accL, r[5], cfw, sel); __builtin_amdgcn_sched_barrier(0);
    vm_step<H + 6>(accH, accL, r[6], cfw, sel); vm_step<H + 7>(accH, accL, r[7], cfw, sel); __builtin_amdgcn_sched_barrier(0);
}
template <bool DRY> DI void vm_finish(const PSArgs& a, const f32x4& accH, const f32x4& accL, uint2 xb, float cs, int tok, int s4, int lane) {
    float4 xv = make_float4(bf_lo(xb.x), bf_hi(xb.x), bf_lo(xb.y), bf_hi(xb.y));
    xv.x += (accH[0] + accL[0]) * cs; xv.y += (accH[1] + accL[1]) * cs; xv.z += (accH[2] + accL[2]) * cs; xv.w += (accH[3] + accL[3]) * cs;
    uint2 p; p.x = pack_bf2(xv.x, xv.y); p.y = pack_bf2(xv.z, xv.w);
    *(uint2*)(a.Hb + (size_t)tok * DM + s4 * 256 + 64 * (lane >> 4) + 4 * (lane & 15)) = p;
}
template <bool DRY> DI void peerVm_run(const PSArgs& a, const fp4x2_t* V4, int s4, int th, int k, int nloc, int wid) {
    const int tid = get_tid(wid);
    const int lane = tid & 63, kq = lane >> 4, m = lane & 15;
    const unsigned loff = (unsigned)(s4 * (NEXP * 128) + (m >> 1) * 16);
    const bool odd = (m & 1) != 0;
    unsigned sel[VM_NSEL];
#pragma unroll
    for (int j = 0; j < VM_NSEL / 4; ++j)
#pragma unroll
        for (int d = 0; d < 4; ++d) sel[4 * j + d] = ((m >> 2) == d) ? ((0x0C0C0C0Cu & ~(0xFFu << (8 * (m & 3)))) | ((unsigned)j << (8 * (m & 3)))) : 0x0C0C0C0Cu;
    const int N = 8 * ((NTOK / 128 - k + nloc - 1) / nloc);
    if (N <= 0) return;
    unsigned ilE, ihE, ilO, ihO, cfE, cfO; uint2 xE, xO; float sE, sO;
    u32x4 rEA[8], rEB[8], rOA[8], rOB[8];
    const unsigned idsh = odd ? 16u : 0u;
    const fp8_t* tab = (const fp8_t*)V4;
#define LOAD_X4(x_, tokv) { x_ = *(const uint2*)(a.Hb + (size_t)(tokv) * DM + s4 * 256 + 64 * kq + 4 * m); }
#define TOKN(nn) run_token2(((nn) < N) ? (nn) : N - 1, k, nloc, wid, th)
#define IDP_LOAD(lo_, hi_, t_) { const unsigned* ep_ = (const unsigned*)(a.EX + (size_t)(t_) * 128 + 32 * kq + (m & ~1)); lo_ = ep_[0]; hi_ = ep_[8]; }
#define CFW_LOAD(d_, t_) { d_ = *(const unsigned*)(a.COEF + (size_t)(t_) * 128 + 2 * lane); }
#define IDP_USE(lo_, hi_) ({ asm volatile("" : "+v"(lo_), "+v"(hi_)); (__builtin_amdgcn_ubfe(lo_, idsh, 16) | (__builtin_amdgcn_ubfe(hi_, idsh, 16) << 16)); })
#define VT_FILL(rA_, rB_, lo_, hi_, cf_, x_, s_, tn_, tn2_) { \
        const unsigned idp_ = IDP_USE(lo_, hi_); \
        vm_rows<0>(rA_, idp_, idsh, tab, loff); CFW_LOAD(cf_, tn_); vm_rows<8>(rB_, idp_, idsh, tab, loff); \
        LOAD_X4(x_, tn_); s_ = a.CS[tn_]; IDP_LOAD(lo_, hi_, tn2_); __builtin_amdgcn_sched_barrier(0); }
#define VT_BLOCK(rA_, rB_, lo_, hi_, cf_, x_, s_, tc_, tn_, tn2_) { \
        f32x4 aH = {0.f, 0.f, 0.f, 0.f}, aL = {0.f, 0.f, 0.f, 0.f}; asm volatile("" : "+v"(aH), "+v"(aL), "+v"(cf_));      \
        vm_half<0>(aH, aL, rA_, cf_, sel); asm volatile("" : "+v"(aH), "+v"(aL)); __builtin_amdgcn_sched_barrier(0); \
        const unsigned idp_ = IDP_USE(lo_, hi_); \
        vm_rows<0>(rA_, idp_, idsh, tab, loff); __builtin_amdgcn_sched_barrier(0); \
        asm volatile("" : "+v"(cf_)); \
        vm_half<8>(aH, aL, rB_, cf_, sel); asm volatile("" : "+v"(aH), "+v"(aL)); __builtin_amdgcn_sched_barrier(0); \
        CFW_LOAD(cf_, tn_); vm_rows<8>(rB_, idp_, idsh, tab, loff); __builtin_amdgcn_sched_barrier(0); \
        vm_finish<DRY>(a, aH, aL, x_, s_, tc_, s4, lane); __builtin_amdgcn_sched_barrier(0); \
        LOAD_X4(x_, tn_); s_ = a.CS[tn_]; IDP_LOAD(lo_, hi_, tn2_); __builtin_amdgcn_sched_barrier(0); }
    {
        const int t0 = TOKN(0), t1 = TOKN(1);
        IDP_LOAD(ilE, ihE, t0); IDP_LOAD(ilO, ihO, t1);
        __builtin_amdgcn_sched_barrier(0);
        VT_FILL(rEA, rEB, ilE, ihE, cfE, xE, sE, t0, TOKN(2));
        VT_FILL(rOA, rOB, ilO, ihO, cfO, xO, sO, t1, TOKN(3));
    }
#pragma unroll 1
    for (int n = 0; n < N; n += 2) {
        VT_BLOCK(rEA, rEB, ilE, ihE, cfE, xE, sE, TOKN(n), TOKN(n + 2), TOKN(n + 4));
        VT_BLOCK(rOA, rOB, ilO, ihO, cfO, xO, sO, TOKN(n + 1), TOKN(n + 3), TOKN(n + 5));
    }
#undef VT_BLOCK
#undef VT_FILL
#undef IDP_USE
#undef CFW_LOAD
#undef IDP_LOAD
#undef TOKN
#undef LOAD_X4
}


DI unsigned pack_i4x8(const float (&v)[8], float inv) {
    unsigned r = 0u;
#pragma unroll
    for (int i = 0; i < 4; ++i) {
        const int a = (int)fminf(fmaxf(rintf(v[i] * inv), -7.f), 7.f), b = (int)fminf(fmaxf(rintf(v[4 + i] * inv), -7.f), 7.f);
        r |= ((unsigned)a & 15u) << (8 * i); r |= ((unsigned)b & 15u) << (8 * i + 4);
    }
    return r;
}
DI void conv_rows_int4g(const float* __restrict__ src, const float* __restrict__ gain, fp4x2_t* __restrict__ dst, float* __restrict__ scales,
                        int nrows, int gwave, int nwaves, int lane) {
    const float4* g = (const float4*)(gain + lane * 16);
    const float4 g0 = g[0], g1 = g[1], g2 = g[2], g3 = g[3];
#pragma unroll 1
    for (int row = gwave; row < nrows; row += nwaves) {
        const float4* p0 = (const float4*)(src + (size_t)row * DM + lane * 16);
        const float4 a0 = p0[0], a1 = p0[1], a2 = p0[2], a3 = p0[3];
        const float v0[8] = {a0.x * g0.x, a0.y * g0.y, a0.z * g0.z, a0.w * g0.w, a1.x * g1.x, a1.y * g1.y, a1.z * g1.z, a1.w * g1.w};
        const float v1[8] = {a2.x * g2.x, a2.y * g2.y, a2.z * g2.z, a2.w * g2.w, a3.x * g3.x, a3.y * g3.y, a3.z * g3.z, a3.w * g3.w};
        float ss = 0.f;
#pragma unroll
        for (int i = 0; i < 8; ++i) ss += v0[i] * v0[i] + v1[i] * v1[i];
        ss = wave_sum(ss, lane);
        const float rms = sqrtf(ss * (1.f / 1024.f));
        const float step = (rms > 0.f) ? 0.36f * rms : 1.f, inv = 1.f / step;
        *(uint2*)(dst + ((size_t)(lane >> 4) * nrows + row) * 128 + (lane & 15) * 8) = make_uint2(pack_i4x8(v0, inv), pack_i4x8(v1, inv));
        if (lane == 0) scales[row] = step;
    }
}
struct HP8 { u32x4 h, l; float sh; };
DI void hp_load(HP8& q, const PSArgs& a, int tok, int s4, int pc) {
    q.h = *(const u32x4*)(a.HPH + (size_t)tok * 128 + s4 * 32 + pc * 4); q.l = *(const u32x4*)(a.HPL + (size_t)tok * 128 + s4 * 32 + pc * 4);
    q.sh = a.HS[(size_t)tok * 4 + s4];
}
DI float row_dot32q(const u32x4& r, const HP8& q) {
    int ah = 0, al = 0;
    ah = __builtin_amdgcn_sdot8((int)r.x, (int)q.h.x, ah, false); al = __builtin_amdgcn_sdot8((int)r.x, (int)q.l.x, al, false);
    ah = __builtin_amdgcn_sdot8((int)r.y, (int)q.h.y, ah, false); al = __builtin_amdgcn_sdot8((int)r.y, (int)q.l.y, al, false);
    ah = __builtin_amdgcn_sdot8((int)r.z, (int)q.h.z, ah, false); al = __builtin_amdgcn_sdot8((int)r.z, (int)q.l.z, al, false);
    ah = __builtin_amdgcn_sdot8((int)r.w, (int)q.h.w, ah, false); al = __builtin_amdgcn_sdot8((int)r.w, (int)q.l.w, al, false);
    return (float)(ah * 16 + al) * q.sh;
}
DI void peerUi_run(const PSArgs& a, const fp4x2_t* U4, int s4, int th, int k, int nloc, int wid) {
    const int tid = get_tid(wid);
    const int lane = tid & 63, rg = lane >> 3, pc = lane & 7;
    const unsigned loff = (unsigned)(s4 * (NEXP * 128) + pc * 16);
    const int N = 8 * ((NTOK / 128 - k + nloc - 1) / nloc);
    if (N <= 0) return;
    Ids16 idE, idO; HP8 hE, hO;
    u32x4 rEA[8], rEB[8], rOA[8], rOB[8];
    const fp8_t* tab = (const fp8_t*)U4;
#define TOKN(nn) run_token2(((nn) < N) ? (nn) : N - 1, k, nloc, wid, th)
#define UT_FILL(rA_, rB_, id_, h_, tn_, tn2_) { \
        asm volatile("" : "+v"(id_.a), "+v"(id_.b)); \
        rows_lo(rA_, id_, tab, loff); rows_hi(rB_, id_, tab, loff); hp_load(h_, a, tn_, s4, pc); ids_load(id_, a.EX, tn2_, rg); __builtin_amdgcn_sched_barrier(0); }
#define UT_BLOCK(rA_, rB_, id_, h_, tc_, tn_, tn2_) { \
        float p[16]; \
        asm volatile("" : "+v"(h_.h), "+v"(h_.l), "+v"(h_.sh));        \
        _Pragma("unroll") for (int i = 0; i < 8; ++i) p[i] = row_dot32q(rA_[i], h_); \
        asm volatile("" : "+v"(p[0]), "+v"(p[1]), "+v"(p[2]), "+v"(p[3]), "+v"(p[4]), "+v"(p[5]), "+v"(p[6]), "+v"(p[7])); __builtin_amdgcn_sched_barrier(0); \
        asm volatile("" : "+v"(id_.a), "+v"(id_.b)); \
        rows_lo(rA_, id_, tab, loff); __builtin_amdgcn_sched_barrier(0); \
        _Pragma("unroll") for (int i = 0; i < 8; ++i) p[8 + i] = row_dot32q(rB_[i], h_); \
        asm volatile("" : "+v"(p[8]), "+v"(p[9]), "+v"(p[10]), "+v"(p[11]), "+v"(p[12]), "+v"(p[13]), "+v"(p[14]), "+v"(p[15])); __builtin_amdgcn_sched_barrier(0); \
        rows_hi(rB_, id_, tab, loff); hp_load(h_, a, tn_, s4, pc); __builtin_amdgcn_sched_barrier(0); \
        peerU_finish(a, p, tc_, s4, lane); __builtin_amdgcn_sched_barrier(0); \
        ids_load(id_, a.EX, tn2_, rg); __builtin_amdgcn_sched_barrier(0); }
    {
        ids_load(idE, a.EX, TOKN(0), rg); ids_load(idO, a.EX, TOKN(1), rg);
        __builtin_amdgcn_sched_barrier(0);
        UT_FILL(rEA, rEB, idE, hE, TOKN(0), TOKN(2));
        UT_FILL(rOA, rOB, idO, hO, TOKN(1), TOKN(3));
    }
#pragma unroll 1
    for (int n = 0; n < N; n += 2) {
        UT_BLOCK(rEA, rEB, idE, hE, TOKN(n), TOKN(n + 2), TOKN(n + 4));
        UT_BLOCK(rOA, rOB, idO, hO, TOKN(n + 1), TOKN(n + 3), TOKN(n + 5));
    }
#undef UT_BLOCK
#undef UT_FILL
#undef TOKN
}

DI void conv_batch_v(const float* __restrict__ src, fp4x2_t* __restrict__ dst, float* __restrict__ scales, int r0, int lane) {
#pragma unroll 1
    for (int row = r0; row < r0 + 32; row += 2) {
        const float4* p0 = (const float4*)(src + (size_t)row * DM + lane * 16);
        const float4* p1 = (const float4*)(src + (size_t)(row + 1) * DM + lane * 16);
        const float4 a0 = p0[0], a1 = p0[1], a2 = p0[2], a3 = p0[3];
        const float4 b0 = p1[0], b1 = p1[1], b2 = p1[2], b3 = p1[3];
        conv_row_fp4_one(a0, a1, a2, a3, dst, scales, NEXP, row, lane);
        conv_row_fp4_one(b0, b1, b2, b3, dst, scales, NEXP, row + 1, lane);
    }
}
DI void conv_row_int4_one(float4 a0, float4 a1, float4 a2, float4 a3, const float4& g0, const float4& g1, const float4& g2, const float4& g3,
                          fp4x2_t* __restrict__ dst, float* __restrict__ scales, int row, int lane) {
    const float v0[8] = {a0.x * g0.x, a0.y * g0.y, a0.z * g0.z, a0.w * g0.w, a1.x * g1.x, a1.y * g1.y, a1.z * g1.z, a1.w * g1.w};
    const float v1[8] = {a2.x * g2.x, a2.y * g2.y, a2.z * g2.z, a2.w * g2.w, a3.x * g3.x, a3.y * g3.y, a3.z * g3.z, a3.w * g3.w};
    float ss = 0.f;
#pragma unroll
    for (int i = 0; i < 8; ++i) ss += v0[i] * v0[i] + v1[i] * v1[i];
    ss = wave_sum(ss, lane);
    const float rms = sqrtf(ss * (1.f / 1024.f));
    const float step = (rms > 0.f) ? 0.36f * rms : 1.f, inv = 1.f / step;
    *(uint2*)(dst + ((size_t)(lane >> 4) * NEXP + row) * 128 + (lane & 15) * 8) = make_uint2(pack_i4x8(v0, inv), pack_i4x8(v1, inv));
    if (lane == 0) scales[row] = step;
}
DI void conv_batch_u(const float* __restrict__ src, const float* __restrict__ gain, fp4x2_t* __restrict__ dst, float* __restrict__ scales, int r0, int lane) {
    const float4* g = (const float4*)(gain + lane * 16);
    const float4 g0 = g[0], g1 = g[1], g2 = g[2], g3 = g[3];
#pragma unroll 1
    for (int row = r0; row < r0 + 32; row += 2) {
        const float4* p0 = (const float4*)(src + (size_t)row * DM + lane * 16);
        const float4* p1 = (const float4*)(src + (size_t)(row + 1) * DM + lane * 16);
        const float4 a0 = p0[0], a1 = p0[1], a2 = p0[2], a3 = p0[3];
        const float4 b0 = p1[0], b1 = p1[1], b2 = p1[2], b3 = p1[3];
        conv_row_int4_one(a0, a1, a2, a3, g0, g1, g2, g3, dst, scales, row, lane);
        conv_row_int4_one(b0, b1, b2, b3, g0, g1, g2, g3, dst, scales, row + 1, lane);
    }
}
struct MegaArgs {
    const float* x; const float* a_re; const float* a_im; const float* log_dt; const float* b_re; const float* b_im; const float* c_re;
    const float* c_im; const float* d_skip; const float* b_glu; const float* pool_scale; const float* u_exp; const float* v_exp;
    const float* norm_final;
    PrepW pw;
    float* X; bf16_t* U; bf16_t* YPRE; bf16_t* G1; bf16_t* A2; bf16_t* Hb; bf16_t* Qb; unsigned short* EX; float* GT; float* RSTD;
    char* KT; bf16x8* WST; bf16x8* CCAR; float* ABT; fp4x2_t* U4; fp4x2_t* V4; float* SU; float* SV; float* PD; bf16_t* COEF; float* CS; unsigned* HPH; unsigned* HPL; float* HS;
    unsigned* bar;
    int coop_probe; int pad_;
};

#ifndef REP_S5
#define REP_S5 1
#endif
#ifndef REP_PW
#define REP_PW 1
#endif
#ifndef REP_P0
#define REP_P0 1
#endif
#ifndef REP_PA
#define REP_PA 1
#endif
#ifndef REP_PB
#define REP_PB 1
#endif
#ifndef REP_C1
#define REP_C1 1
#endif
#ifndef REP_C2
#define REP_C2 1
#endif
#ifndef REP_U
#define REP_U 1
#endif
#ifndef REP_R
#define REP_R 1
#endif
#if V_MFMA
#define PEERV_RUN peerVm_run<false>
#define PEERV_DRY peerVm_run<true>
#else
#define PEERV_RUN peerV4_run
#define PEERV_DRY peerV4_run
#endif
#ifdef REP_V_DRY
#define PEERV_REP PEERV_DRY
#else
#define PEERV_REP PEERV_RUN
#endif
#ifndef REP_V
#define REP_V 1
#endif
#ifndef REP_BAR
#define REP_BAR 1
#endif
#define XBAR() do { for (int rb_ = 0; rb_ < REP_BAR; ++rb_) xcd_barrier(xb, wid); } while (0)
__global__ void __launch_bounds__(NTHR) mega_kernel(MegaArgs a) {
    __shared__ __attribute__((aligned(16))) char smem[PB_BYTES];
    __shared__ uint4 xb_words;
    cg::grid_group grid = cg::this_grid();
    const int nblk = gridDim.x;
    const int wid = __builtin_amdgcn_readfirstlane(threadIdx.x >> 6);
    if (get_tid(wid) == 0) xb_words = make_uint4(0u, 0u, 0u, 0u);
    __syncthreads();
    const XcdBarrier xb = xcd_barrier_post(a.bar, (volatile LAS unsigned*)&xb_words, get_tid(wid));
    for (int rep = 0; rep < REP_P0; ++rep) {
        const size_t gtid = (size_t)blockIdx.x * NTHR + get_tid(wid), gs = (size_t)nblk * NTHR;
        const int nprep = nblk >> 1;
        if ((int)blockIdx.x >= nblk - nprep) {
            const int pb = (int)blockIdx.x - (nblk - nprep);
            for (int rs5 = 0; rs5 < REP_S5; ++rs5)
            for (int it = pb; it < 256; it += nprep)
                prep_s5_item(it >> 2, it & 3, a.a_re, a.a_im, a.log_dt, a.b_re, a.b_im, a.c_re, a.c_im, a.d_skip, a.KT, a.WST, a.CCAR, a.ABT, smem, wid);
            const size_t ptid = (size_t)pb * NTHR + (gtid - (size_t)blockIdx.x * NTHR), pgs = (size_t)nprep * NTHR;
            for (int rpw = 0; rpw < REP_PW; ++rpw)
            prep_weights(a.pw, ptid, pgs);
            for (int l = 0; l < 2; ++l) {
                conv_kfrag(a.pw.k1 + (size_t)l * 128 * 128, a.pw.wfk1 + (size_t)l * (128 * 128 / 8), ptid, pgs);
                conv_kfrag(a.pw.k2 + (size_t)l * 128 * 128, a.pw.wfk2 + (size_t)l * (128 * 128 / 8), ptid, pgs);
            }
        } else if (nprep == 0) {
            for (int it = 0; it < 256; ++it)
                prep_s5_item(it >> 2, it & 3, a.a_re, a.a_im, a.log_dt, a.b_re, a.b_im, a.c_re, a.c_im, a.d_skip, a.KT, a.WST, a.CCAR, a.ABT, smem, wid);
            prep_weights(a.pw, gtid, gs);
            for (int l = 0; l < 2; ++l) {
                conv_kfrag(a.pw.k1 + (size_t)l * 128 * 128, a.pw.wfk1 + (size_t)l * (128 * 128 / 8), gtid, gs);
                conv_kfrag(a.pw.k2 + (size_t)l * 128 * 128, a.pw.wfk2 + (size_t)l * (128 * 128 / 8), gtid, gs);
            }
        }
        {
            const int lane = get_tid(wid) & 63;
            unsigned* ctr = a.bar + XB_QUEUE(rep);
            for (;;) {
                unsigned q = 0u;
                if (lane == 0) q = xb_add(ctr, 1u);
                q = (unsigned)__builtin_amdgcn_readfirstlane((int)q);
                if (q >= 4u * (NEXP / 32)) break;
                const int tb = (int)(q / (NEXP / 32)), r0 = (int)(q % (NEXP / 32)) * 32, l = tb >> 1;
                if (tb & 1) conv_batch_v(a.v_exp + (size_t)l * NEXP * DM, a.V4 + (size_t)l * NEXP * (DM / 2), a.SV + l * NEXP, r0, lane);
                else conv_batch_u(a.u_exp + (size_t)l * NEXP * DM, a.pw.norm_ffn + l * DM, a.U4 + (size_t)l * NEXP * (DM / 2), a.SU + l * NEXP, r0, lane);
            }
        }
    }
    XBAR();
    if (a.coop_probe) grid.sync();
    __shared__ int sched[4];
    if (get_tid(wid) == 0) {
        int nx = 0, myj = 0, nloc = 1;
        for (unsigned j = 0; j < 16; ++j) {
            const unsigned cj = xb_ld(&a.bar[XB_XCNT(j)]);
            if (j == xb.x) { myj = nx; nloc = (int)cj; }
            nx += (cj > 0u) ? 1 : 0;
        }
        sched[0] = (int)xb.st[2]; sched[1] = nloc > 0 ? nloc : 1; sched[2] = myj; sched[3] = nx > 0 ? nx : 1;
    }
    __syncthreads();
    const int s_rank = sched[0], s_nloc = sched[1], s_myj = sched[2], s_nx = sched[3];
#pragma unroll 1
    for (int l = 0; l < 2; ++l) {
        const float* xin = (l == 0) ? a.x : a.X;
        if (l == 0) {
            for (int rep = 0; rep < REP_PA; ++rep)
            for (int tile = blockIdx.x; tile < NTOK / 64; tile += nblk) phaseA_tile<true>(a.x, a.Hb, a.pw.wfin, a.U, tile, smem, wid);
        }
        XBAR();
        bf16_t* Ul = a.U + (size_t)l * NTOK * DM;
        for (int rep = 0; rep < REP_PB; ++rep)
        for (int tile = blockIdx.x; tile < 256; tile += nblk)
            phaseB_tile(Ul, a.KT + (size_t)l * 32 * KT_BYTES, a.WST + (size_t)l * 32 * WST_FRAGS, a.CCAR + (size_t)l * 32 * CCAR_FRAGS, a.ABT + l * 32 * 128, a.YPRE, tile, smem, wid);
        XBAR();
        PCArgs pa; pa.U = Ul; pa.YPRE = a.YPRE; pa.G1 = a.G1; pa.A2 = a.A2; pa.Xin = xin; pa.Xout = a.X; pa.Xdummy = (float*)a.Qb; pa.HPH = a.HPH; pa.HPL = a.HPL; pa.HS = a.HS; pa.Hb = a.Hb; pa.RSTD = a.RSTD;
        pa.wfglu = a.pw.wfglu + (size_t)l * (512 * 512 / 8); pa.b_glu = a.b_glu + l * 512; pa.wfpool = a.pw.wfpool + (size_t)l * 4 * (128 * 128 / 8);
        pa.pool_scale = a.pool_scale + l * 512; pa.wfout = a.pw.wfout + (size_t)l * (DM * DM / 8);
        PRArgs pr; pr.Hb = a.Hb; pr.RSTD = a.RSTD; pr.wfq = a.pw.wfq + (size_t)l * (DM * 2048 / 8); pr.kf1 = a.pw.wfk1 + (size_t)l * (128 * 128 / 8);
        pr.kf2 = a.pw.wfk2 + (size_t)l * (128 * 128 / 8); pr.EX = a.EX; pr.GT = a.GT;
        for (int tile = blockIdx.x; tile < NTOK / 64; tile += nblk) {
            for (int rep = 1; rep < REP_C1; ++rep) { PCArgs pa2 = pa; pa2.Xout = (float*)a.Qb; phaseC1_tile(pa2, tile, smem, wid); }
            phaseC1_tile(pa, tile, smem, wid);
            for (int rep = 0; rep < REP_C2; ++rep) phaseC2_tile(pr, tile, smem, wid);
        }
        XBAR();
        PSArgs ps; ps.Hb = a.Hb; ps.RSTD = a.RSTD; ps.EX = a.EX; ps.GT = a.GT;
        ps.SU = a.SU + l * NEXP; ps.SV = a.SV + l * NEXP; ps.PD = a.PD; ps.COEF = a.COEF; ps.CS = a.CS; ps.Xin = a.X; ps.Xout = a.X; ps.HPH = a.HPH; ps.HPL = a.HPL; ps.HS = a.HS;
        for (int rep = 0; rep < REP_U; ++rep) {
            for (int v = s_myj; v < 8; v += s_nx) peerUi_run(ps, a.U4 + (size_t)l * NEXP * (DM / 2), v & 3, v >> 2, s_rank, s_nloc, wid);
        }
        XBAR();
        for (int rep = 0; rep < REP_R; ++rep)
        for (int tile = blockIdx.x; tile < NTOK / 64; tile += nblk) peerR_tile(ps, tile, wid);
        XBAR();
        for (int rep = 1; rep < REP_V; ++rep) { PSArgs ps2 = ps; ps2.Xout = (float*)a.Qb; for (int v = s_myj; v < 8; v += s_nx) PEERV_REP(ps2, a.V4 + (size_t)l * NEXP * (DM / 2), v & 3, v >> 2, s_rank, s_nloc, wid); }
        for (int v = s_myj; v < 8; v += s_nx) PEERV_RUN(ps, a.V4 + (size_t)l * NEXP * (DM / 2), v & 3, v >> 2, s_rank, s_nloc, wid);
        XBAR();
        if (l == 0) {
            for (int rep = 0; rep < REP_PA; ++rep)
            for (int tile = blockIdx.x; tile < NTOK / 64; tile += nblk) phaseA_tile<false>(nullptr, a.Hb, a.pw.wfin + (size_t)(DM * DM / 8), a.U + (size_t)NTOK * DM, tile, smem, wid);
        } else {
            for (int tile = blockIdx.x; tile < NTOK / 64; tile += nblk) final_norm_tile(a.Hb, a.X, a.norm_final, tile, wid);
        }
    }
}

extern "C" void kernel_launch(void* const* d_in, const int* in_sizes, int n_in, void* d_out, int out_size, void* d_ws, size_t ws_size,
                              hipStream_t stream) {
    char* wsb = (char*)d_ws;
    size_t off = 0;
    auto take = [&](size_t bytes) { char* p = wsb + off; off += (bytes + 255) & ~(size_t)255; return p; };
    MegaArgs a;
    memset(&a, 0, sizeof(a));
    a.x = (const float*)d_in[0];
    a.pw.norm_mix = (const float*)d_in[1]; a.pw.w_in = (const float*)d_in[2];
    a.a_re = (const float*)d_in[3]; a.a_im = (const float*)d_in[4]; a.log_dt = (const float*)d_in[5];
    a.b_re = (const float*)d_in[6]; a.b_im = (const float*)d_in[7]; a.c_re = (const float*)d_in[8]; a.c_im = (const float*)d_in[9];
    a.d_skip = (const float*)d_in[10]; a.pw.w_glu = (const float*)d_in[11]; a.b_glu = (const float*)d_in[12];
    a.pw.w_pool = (const float*)d_in[13]; a.pool_scale = (const float*)d_in[14]; a.pw.g_out_ssm = (const float*)d_in[15];
    a.pw.g_out_pool = (const float*)d_in[16]; a.pw.w_out = (const float*)d_in[17]; a.pw.norm_ffn = (const float*)d_in[18];
    a.pw.w_q = (const float*)d_in[19]; a.pw.k1 = (const float*)d_in[20]; a.pw.k2 = (const float*)d_in[21];
    a.u_exp = (const float*)d_in[22]; a.v_exp = (const float*)d_in[23]; a.norm_final = (const float*)d_in[24];
    a.X = (float*)d_out;
    a.U = (bf16_t*)take((size_t)2 * NTOK * DM * 2);
    a.YPRE = (bf16_t*)take((size_t)NTOK * 512 * 2);
    a.G1 = (bf16_t*)take((size_t)NTOK * 512 * 2);
    a.A2 = (bf16_t*)take((size_t)NTOK * DM * 2);
    a.Hb = (bf16_t*)take((size_t)NTOK * DM * 2);
    a.Qb = (bf16_t*)take((size_t)NTOK * 2048 * 2);
    a.EX = (unsigned short*)take((size_t)NTOK * 128 * 2);
    a.GT = (float*)take((size_t)NTOK * 128 * 4);
    a.RSTD = (float*)take(NTOK * 4);
    a.pw.wfin = (bf16x8*)take((size_t)2 * DM * DM * 2);
    a.pw.wfglu = (bf16x8*)take((size_t)2 * 512 * 512 * 2);
    a.pw.wfpool = (bf16x8*)take((size_t)2 * 4 * 128 * 128 * 2);
    a.pw.wfout = (bf16x8*)take((size_t)2 * DM * DM * 2);
    a.pw.wfq = (bf16x8*)take((size_t)2 * DM * 2048 * 2);
    a.pw.wfk1 = (bf16x8*)take((size_t)2 * 128 * 128 * 2);
    a.pw.wfk2 = (bf16x8*)take((size_t)2 * 128 * 128 * 2);
    a.KT = take((size_t)64 * KT_BYTES);
    a.WST = (bf16x8*)take((size_t)64 * WST_FRAGS * 16);
    a.CCAR = (bf16x8*)take((size_t)64 * CCAR_FRAGS * 16);
    a.ABT = (float*)take(64 * 128 * 4);
    a.V4 = (fp4x2_t*)take((size_t)2 * NEXP * (DM / 2));
    a.U4 = (fp4x2_t*)take((size_t)2 * NEXP * (DM / 2));
    a.SU = (float*)take((size_t)2 * NEXP * 4);
    a.SV = (float*)take((size_t)2 * NEXP * 4);
    a.PD = (float*)take((size_t)NUSL * NTOK * 128 * 4);
    a.COEF = (bf16_t*)take((size_t)NTOK * 128 * 2);
    a.CS = (float*)take((size_t)NTOK * 4 + 256);
    a.HPH = (unsigned*)take((size_t)NTOK * 128 * 4);
    a.HPL = (unsigned*)take((size_t)NTOK * 128 * 4);
    a.HS = (float*)take((size_t)NTOK * 4 * 4);
    a.bar = (unsigned*)take((size_t)XCD_BAR_WORDS * 4);
    hipMemsetAsync(a.bar, 0, (size_t)XCD_BAR_WORDS * 4, stream);

    static int grid_blocks = 0;
    if (!grid_blocks) {
        int dev = 0, cus = 0, per_cu = 0;
        hipGetDevice(&dev);
        hipDeviceGetAttribute(&cus, hipDeviceAttributeMultiprocessorCount, dev);
        hipOccupancyMaxActiveBlocksPerMultiprocessor(&per_cu, mega_kernel, NTHR, 0);
        if (per_cu > 1) per_cu = 1;
        grid_blocks = cus * per_cu;
        if (grid_blocks > 256) grid_blocks = 256;
    }
    void* args[] = {&a};
    hipError_t e = hipLaunchCooperativeKernel((void*)mega_kernel, dim3(grid_blocks), dim3(NTHR), args, 0, stream);
    if (e != hipSuccess) fprintf(stderr, "cooperative launch failed: %s (grid %d)\n", hipGetErrorString(e), grid_blocks);
}
```

```cpp
#include <hip/hip_runtime.h>
#include <hip/hip_cooperative_groups.h>
#include <cstdio>
#include <cstring>
#include <type_traits>
namespace cg = cooperative_groups;
#include <math.h>
#include <stdint.h>
#ifndef V_LO
#define V_LO 0
#endif
#ifndef V_MFMA
#define V_MFMA 1
#endif

#define NTOK 16384
#define SEQ 2048
#define DM 1024
#define SSMW 512
#define NEXP 16384

__device__ __forceinline__ float gelu_exact(float x) { return 0.5f * x * (1.f + erff(x * 0.70710678118654752f)); }
__device__ __forceinline__ float gelu_erf_as(float x) {
    const float z = x * 0.70710678118654752f, az = fabsf(z);
    const float t = __builtin_amdgcn_rcpf(fmaf(0.3275911f, az, 1.f));
    float p = 1.061405429f; p = fmaf(p, t, -1.453152027f); p = fmaf(p, t, 1.421413741f); p = fmaf(p, t, -0.284496736f); p = fmaf(p, t, 0.254829592f);
    const float er = 1.f - p * t * __expf(-az * az);
    return 0.5f * x * (1.f + copysignf(er, z));
}

template <int M> __device__ __forceinline__ int shx_i(int v, int lane) {
    if constexpr (M == 1) return __builtin_amdgcn_mov_dpp(v, 0xB1, 0xF, 0xF, true);
    else if constexpr (M == 2) return __builtin_amdgcn_mov_dpp(v, 0x4E, 0xF, 0xF, true);
    else if constexpr (M < 32) return __builtin_amdgcn_ds_swizzle(v, (M << 10) | 0x1F);
    else return __builtin_amdgcn_ds_bpermute((lane ^ 32) << 2, v);
}
template <int M> __device__ __forceinline__ float shx(float v, int lane) { return __int_as_float(shx_i<M>(__float_as_int(v), lane)); }
__device__ __forceinline__ float wave_sum(float v, int lane) {
    v += shx<1>(v, lane); v += shx<2>(v, lane); v += shx<4>(v, lane); v += shx<8>(v, lane); v += shx<16>(v, lane); v += shx<32>(v, lane);
    return v;
}

__device__ __forceinline__ int get_tid(int wid) {
    int t = wid * 64 + (int)__builtin_amdgcn_mbcnt_hi(~0u, __builtin_amdgcn_mbcnt_lo(~0u, 0u));
    asm volatile("" : "+v"(t));
    return t;
}

#define DI __device__ __forceinline__
typedef __attribute__((ext_vector_type(8))) short bf16x8;
typedef __attribute__((ext_vector_type(16))) float f32x16;
typedef __attribute__((ext_vector_type(2))) __bf16 bf2_t;
typedef __attribute__((ext_vector_type(2))) float f2_t;
typedef unsigned short bf16_t;
typedef __attribute__((ext_vector_type(4))) unsigned u32x4;
typedef __attribute__((ext_vector_type(4))) float f32x4;
typedef const __attribute__((address_space(1))) bf16x8* gwp_t;
#define MFMA32(a, b, c) __builtin_amdgcn_mfma_f32_32x32x16_bf16((a), (b), (c), 0, 0, 0)

DI unsigned pack_bf2(float a, float b) { f2_t v = {a, b}; return __builtin_bit_cast(unsigned, __builtin_convertvector(v, bf2_t)); }
DI float bf_lo(unsigned u) { return __uint_as_float(u << 16); }
DI float bf_hi(unsigned u) { return __uint_as_float(u & 0xffff0000u); }
DI int crow(int reg, int h) { return (reg & 3) + 8 * (reg >> 2) + 4 * h; }

#define SA_STRIDE 272
#define SA_BYTES (64 * SA_STRIDE)
#define NTHR 512

template <bool GAIN>
DI void conv_wfrag(const float* __restrict__ src, int ldk, int ldn, const float* __restrict__ ga, const float* __restrict__ gb, int split,
                   int K, int N, int NTG, bf16x8* __restrict__ dst, size_t gtid, size_t gstride) {
    const int KS = K / 16;
    const size_t total = (size_t)(N / 32) * KS * 64;
    for (size_t item = gtid; item < total; item += gstride) {
        const int lane = (int)(item & 63); const size_t f = item >> 6;
        const int nti = (int)(f % NTG); const size_t f2 = f / NTG;
        const int ks = (int)(f2 % KS), nt = (int)(f2 / KS) * NTG + nti;
        const int r = lane & 31, h = lane >> 5;
        const int n = nt * 32 + r, k0 = ks * 16 + 8 * h;
        float v[8];
#pragma unroll
        for (int j = 0; j < 8; ++j) {
            const int k = k0 + j;
            float g = 1.f;
            if (GAIN) g = (k < split) ? ga[k] : gb[k - split];
            v[j] = src[(size_t)k * ldk + (size_t)n * ldn] * g;
        }
        uint4 o; o.x = pack_bf2(v[0], v[1]); o.y = pack_bf2(v[2], v[3]); o.z = pack_bf2(v[4], v[5]); o.w = pack_bf2(v[6], v[7]);
        *(uint4*)(dst + item) = o;
    }
}
struct WJob { const float* src; int ldk; const float* ga; const float* gb; int split; int K; int N; int NTG; bf16x8* dst; };
template <bool GAIN>
DI void wf_load(const WJob& jb, size_t item, float (&v)[8]) {
    const int KS = jb.K / 16;
    const size_t total = (size_t)(jb.N / 32) * KS * 64;
    if (item >= total) return;
    const int lane = (int)(item & 63); const size_t f = item >> 6;
    const int nti = (int)(f % jb.NTG); const size_t f2 = f / jb.NTG;
    const int ks = (int)(f2 % KS), nt = (int)(f2 / KS) * jb.NTG + nti;
    const int r = lane & 31, h = lane >> 5;
    const int n = nt * 32 + r, k0 = ks * 16 + 8 * h;
#pragma unroll
    for (int j = 0; j < 8; ++j) {
        const int k = k0 + j;
        float g = 1.f;
        if (GAIN) g = (k < jb.split) ? jb.ga[k] : jb.gb[k - jb.split];
        v[j] = jb.src[(size_t)k * jb.ldk + n] * g;
    }
}
DI void wf_store(const WJob& jb, size_t item, const float (&v)[8]) {
    const size_t total = (size_t)(jb.N / 32) * (jb.K / 16) * 64;
    if (item >= total) return;
    uint4 o; o.x = pack_bf2(v[0], v[1]); o.y = pack_bf2(v[2], v[3]); o.z = pack_bf2(v[4], v[5]); o.w = pack_bf2(v[6], v[7]);
    *(uint4*)(jb.dst + item) = o;
}

DI void conv_rows_bf16(const float* __restrict__ src, const float* __restrict__ gain, bf16_t* __restrict__ dst, size_t nelem, size_t gtid, size_t gstride) {
    for (size_t i = gtid * 8; i < nelem; i += gstride * 8) {
        float4 a = *(const float4*)(src + i), b = *(const float4*)(src + i + 4);
        if (gain) {
            const int c = (int)(i & 1023);
            float4 g0 = *(const float4*)(gain + c), g1 = *(const float4*)(gain + c + 4);
            a.x *= g0.x; a.y *= g0.y; a.z *= g0.z; a.w *= g0.w; b.x *= g1.x; b.y *= g1.y; b.z *= g1.z; b.w *= g1.w;
        }
        uint4 o; o.x = pack_bf2(a.x, a.y); o.y = pack_bf2(a.z, a.w); o.z = pack_bf2(b.x, b.y); o.w = pack_bf2(b.z, b.w);
        *(uint4*)(dst + i) = o;
    }
}

struct ALoadF32 {
    const float* base; f32x4 v0, v1, v2, v3; float ss; int dofs;
    DI void init(const float* rowbase, int tid) { base = rowbase + (tid & 7) * 16; ss = 0.f; dofs = (tid >> 3) * SA_STRIDE + (tid & 7) * 32; }
    DI void issue(int c) { const f32x4* p = (const f32x4*)(base + c * 128); v0 = p[0]; v1 = p[1]; v2 = p[2]; v3 = p[3]; }
    DI void commit(char* buf) {
        u32x4 o0, o1;
        ss += v0.x * v0.x + v0.y * v0.y + v0.z * v0.z + v0.w * v0.w + v1.x * v1.x + v1.y * v1.y + v1.z * v1.z + v1.w * v1.w
            + v2.x * v2.x + v2.y * v2.y + v2.z * v2.z + v2.w * v2.w + v3.x * v3.x + v3.y * v3.y + v3.z * v3.z + v3.w * v3.w;
        o0.x = pack_bf2(v0.x, v0.y); o0.y = pack_bf2(v0.z, v0.w); o0.z = pack_bf2(v1.x, v1.y); o0.w = pack_bf2(v1.z, v1.w);
        o1.x = pack_bf2(v2.x, v2.y); o1.y = pack_bf2(v2.z, v2.w); o1.z = pack_bf2(v3.x, v3.y); o1.w = pack_bf2(v3.z, v3.w);
        char* d = buf + dofs;
        *(u32x4*)d = o0; *(u32x4*)(d + 16) = o1;
    }
};
struct ALoadF32W {
    const float* base; bf16_t* hb; f32x4 v0, v1, v2, v3; float ss; int dofs;
    DI void init(const float* rowbase, bf16_t* hbrow, int tid) { base = rowbase + (tid & 7) * 16; hb = hbrow + (tid & 7) * 16; ss = 0.f; dofs = (tid >> 3) * SA_STRIDE + (tid & 7) * 32; }
    DI void issue(int c) { const f32x4* p = (const f32x4*)(base + c * 128); v0 = p[0]; v1 = p[1]; v2 = p[2]; v3 = p[3]; }
    DI void commit(char* buf) {
        u32x4 o0, o1;
        ss += v0.x * v0.x + v0.y * v0.y + v0.z * v0.z + v0.w * v0.w + v1.x * v1.x + v1.y * v1.y + v1.z * v1.z + v1.w * v1.w
            + v2.x * v2.x + v2.y * v2.y + v2.z * v2.z + v2.w * v2.w + v3.x * v3.x + v3.y * v3.y + v3.z * v3.z + v3.w * v3.w;
        o0.x = pack_bf2(v0.x, v0.y); o0.y = pack_bf2(v0.z, v0.w); o0.z = pack_bf2(v1.x, v1.y); o0.w = pack_bf2(v1.z, v1.w);
        o1.x = pack_bf2(v2.x, v2.y); o1.y = pack_bf2(v2.z, v2.w); o1.z = pack_bf2(v3.x, v3.y); o1.w = pack_bf2(v3.z, v3.w);
        char* d = buf + dofs;
        *(u32x4*)d = o0; *(u32x4*)(d + 16) = o1;
        *(u32x4*)hb = o0; *(u32x4*)(hb + 8) = o1; hb += 128;
    }
};
struct ALoadBF16S {
    const bf16_t* base; u32x4 v0, v1; float ss; int dofs;
    DI void init(const bf16_t* rowbase, int tid) { base = rowbase + (tid & 7) * 16; ss = 0.f; dofs = (tid >> 3) * SA_STRIDE + (tid & 7) * 32; }
    DI void issue(int c) { const u32x4* p = (const u32x4*)(base + c * 128); v0 = p[0]; v1 = p[1]; }
    DI void commit(char* buf) {
        const unsigned w[8] = {v0.x, v0.y, v0.z, v0.w, v1.x, v1.y, v1.z, v1.w};
#pragma unroll
        for (int i = 0; i < 8; ++i) { const float lo = bf_lo(w[i]), hi = bf_hi(w[i]); ss += lo * lo + hi * hi; }
        char* d = buf + dofs;
        *(u32x4*)d = v0; *(u32x4*)(d + 16) = v1;
    }
};
struct ALoadBF16 {
    const bf16_t* base; u32x4 v0, v1; int dofs;
    DI void init(const bf16_t* rowbase, int tid) { base = rowbase + (tid & 7) * 16; dofs = (tid >> 3) * SA_STRIDE + (tid & 7) * 32; }
    DI void issue(int c) { const u32x4* p = (const u32x4*)(base + c * 128); v0 = p[0]; v1 = p[1]; }
    DI void commit(char* buf) {
        char* d = buf + dofs;
        *(u32x4*)d = v0; *(u32x4*)(d + 16) = v1;
    }
};

template <int NT, int PF, class AL>
DI void gemm64(f32x16 (&acc)[NT][2], AL& al, const int nchunks, const bf16x8* __restrict__ wf_, char* sA, const int lane) {
    gwp_t wf = (gwp_t)wf_;
    const int r = lane & 31, h = lane >> 5;
    bf16x8 bq[PF][NT];
    al.issue(0);
#pragma unroll
    for (int p = 0; p < PF; ++p)
#pragma unroll
        for (int nt = 0; nt < NT; ++nt) bq[p][nt] = wf[(p * NT + nt) * 64];
    gwp_t wpf = wf + PF * NT * 64;
    al.commit(sA);
    const int kend = nchunks * 8 - PF;
    int kg = 0;
#pragma unroll 1
    for (int c = 0; c < nchunks; ++c) {
        if (c + 1 < nchunks) al.issue(c + 1);
        __syncthreads();
        const char* buf = sA + (c & 1) * SA_BYTES + r * SA_STRIDE + h * 16;
#pragma unroll
        for (int ks = 0; ks < 8; ++ks) {
            const bf16x8 a0 = *(const bf16x8*)(buf + ks * 32);
            const bf16x8 a1 = *(const bf16x8*)(buf + 32 * SA_STRIDE + ks * 32);
#pragma unroll
            for (int nt = 0; nt < NT; ++nt) {
                acc[nt][0] = MFMA32(bq[ks % PF][nt], a0, acc[nt][0]);
                acc[nt][1] = MFMA32(bq[ks % PF][nt], a1, acc[nt][1]);
            }
            if (kg < kend) {
#pragma unroll
                for (int nt = 0; nt < NT; ++nt) bq[ks % PF][nt] = wpf[nt * 64];
            }
            wpf += NT * 64; ++kg;
            asm volatile("" : "+v"(wpf));
        }
        if (c + 1 < nchunks) al.commit(sA + ((c + 1) & 1) * SA_BYTES);
    }
    __syncthreads();
}

template <int NT, int PF>
DI void gemm64_res(f32x16 (&acc)[NT][2], const bf16x8* __restrict__ wf_, const char* imgLo, const char* imgHi, const int lane) {
    gwp_t wf = (gwp_t)wf_;
    const int r = lane & 31, h = lane >> 5;
    bf16x8 bq[PF][NT];
#pragma unroll
    for (int p = 0; p < PF; ++p)
#pragma unroll
        for (int nt = 0; nt < NT; ++nt) bq[p][nt] = wf[(p * NT + nt) * 64];
    gwp_t wpf = wf + PF * NT * 64;
    const int kend = 8 * 8 - PF;
    int kg = 0;
#pragma unroll 1
    for (int c = 0; c < 8; ++c) {
        const char* buf = ((c < 4) ? imgHi + c * SA_BYTES : imgLo + (c - 4) * SA_BYTES) + r * SA_STRIDE + h * 16;
#pragma unroll
        for (int ks = 0; ks < 8; ++ks) {
            const bf16x8 a0 = *(const bf16x8*)(buf + ks * 32);
            const bf16x8 a1 = *(const bf16x8*)(buf + 32 * SA_STRIDE + ks * 32);
#pragma unroll
            for (int nt = 0; nt < NT; ++nt) {
                acc[nt][0] = MFMA32(bq[ks % PF][nt], a0, acc[nt][0]);
                acc[nt][1] = MFMA32(bq[ks % PF][nt], a1, acc[nt][1]);
            }
            if (kg < kend) {
#pragma unroll
                for (int nt = 0; nt < NT; ++nt) bq[ks % PF][nt] = wpf[nt * 64];
            }
            wpf += NT * 64; ++kg;
            asm volatile("" : "+v"(wpf));
        }
    }
    __syncthreads();
}

template <int NT>
DI void zero_acc(f32x16 (&acc)[NT][2]) {
#pragma unroll
    for (int nt = 0; nt < NT; ++nt)
#pragma unroll
        for (int mt = 0; mt < 2; ++mt)
#pragma unroll
            for (int i = 0; i < 16; ++i) acc[nt][mt][i] = 0.f;
}


DI void tile_transpose(const f32x16& t, float* wscr, int lane, f32x4 (&out)[4]) {
    const int r = lane & 31, h = lane >> 5;
#pragma unroll
    for (int q = 0; q < 4; ++q) { f32x4 v = {t[4 * q], t[4 * q + 1], t[4 * q + 2], t[4 * q + 3]}; *(f32x4*)(wscr + r * 36 + 8 * q + 4 * h) = v; }
#pragma unroll
    for (int j = 0; j < 4; ++j) out[j] = *(const f32x4*)(wscr + ((lane >> 3) + 8 * j) * 36 + (lane & 7) * 4);
}
#define WSCR_BYTES (32 * 36 * 4)

typedef unsigned char fp4x2_t;
DI void conv_row_fp4_one(float4 v0, float4 v1, float4 v2, float4 v3, fp4x2_t* __restrict__ dst, float* __restrict__ scales, int nrows, int row, int lane);
template <bool FIRST>
DI void phaseA_tile(const float* __restrict__ X, bf16_t* __restrict__ Hb, const bf16x8* __restrict__ wfin, bf16_t* __restrict__ U, int tile, char* smem, int wid,
                    const float* __restrict__ bg_src, fp4x2_t* __restrict__ bg_dst, float* __restrict__ bg_sc, int bg_r0) {
    char* sA = smem; float* srstd = (float*)(smem + 8 * WSCR_BYTES);
    int tok0 = tile * 64; asm volatile("" : "+s"(tok0));
    int tid = get_tid(wid);
    const int w = __builtin_amdgcn_readfirstlane(tid >> 6), lane = tid & 63, r = lane & 31, h = lane >> 5;
    typename std::conditional<FIRST, ALoadF32W, ALoadBF16S>::type al;
    if constexpr (FIRST) al.init(X + (size_t)(tok0 + (tid >> 3)) * DM, Hb + (size_t)(tok0 + (tid >> 3)) * DM, tid);
    else al.init(Hb + (size_t)(tok0 + (tid >> 3)) * DM, tid);
    f32x4 bgv[2][4];
    if (bg_r0 >= 0) {
#pragma unroll
        for (int q = 0; q < 2; ++q) { const f32x4* pq = (const f32x4*)(bg_src + (size_t)(bg_r0 + q) * DM + lane * 16); bgv[q][0] = pq[0]; bgv[q][1] = pq[1]; bgv[q][2] = pq[2]; bgv[q][3] = pq[3]; }
    }
    f32x16 acc[4][2]; zero_acc<4>(acc);
    gemm64<4, 2>(acc, al, 8, wfin + (size_t)w * (64 * 4 * 64) + lane, sA, lane);
    if (bg_r0 >= 0) {
#pragma unroll
        for (int q = 0; q < 2; ++q)
            conv_row_fp4_one(make_float4(bgv[q][0][0], bgv[q][0][1], bgv[q][0][2], bgv[q][0][3]), make_float4(bgv[q][1][0], bgv[q][1][1], bgv[q][1][2], bgv[q][1][3]),
                             make_float4(bgv[q][2][0], bgv[q][2][1], bgv[q][2][2], bgv[q][2][3]), make_float4(bgv[q][3][0], bgv[q][3][1], bgv[q][3][2], bgv[q][3][3]), bg_dst, bg_sc, NEXP, bg_r0 + q, lane);
    }
    float ss = al.ss;
    ss += shx<1>(ss, lane); ss += shx<2>(ss, lane); ss += shx<4>(ss, lane);
    if ((tid & 7) == 0) srstd[tid >> 3] = rsqrtf(ss * (1.f / 1024.f) + 1e-6f);
    __syncthreads();
    {
        float* wscr = (float*)(smem + w * WSCR_BYTES);
        const int tl = lane >> 3, cl = (lane & 7) * 4;
#pragma unroll
        for (int mt = 0; mt < 2; ++mt) {
            float rs[4];
#pragma unroll
            for (int j = 0; j < 4; ++j) rs[j] = srstd[mt * 32 + tl + 8 * j];
#pragma unroll
            for (int nt = 0; nt < 4; ++nt) {
                f32x4 o[4]; tile_transpose(acc[nt][mt], wscr, lane, o);
#pragma unroll
                for (int j = 0; j < 4; ++j) {
                    uint2 p; p.x = pack_bf2(o[j].x * rs[j], o[j].y * rs[j]); p.y = pack_bf2(o[j].z * rs[j], o[j].w * rs[j]);
                    *(uint2*)(U + (size_t)(tok0 + mt * 32 + tl + 8 * j) * DM + w * 128 + nt * 32 + cl) = p;
                }
            }
        }
    }
    __syncthreads();
}

struct PrepW {
    const float* norm_mix; const float* w_in; const float* w_glu; const float* w_pool; const float* g_out_ssm; const float* g_out_pool;
    const float* w_out; const float* norm_ffn; const float* w_q; const float* k1; const float* k2;
    bf16x8* wfin; bf16x8* wfglu; bf16x8* wfpool; bf16x8* wfout; bf16x8* wfq; bf16x8* wfk1; bf16x8* wfk2;
};
DI void prep_weights(const PrepW& p, size_t gtid, size_t gs) {
#pragma unroll 1
    for (int l = 0; l < 2; ++l) {
        conv_wfrag<true>(p.w_in + (size_t)l * DM * DM, DM, 1, p.norm_mix + l * DM, p.norm_mix + l * DM, DM, DM, DM, 4, p.wfin + (size_t)l * (DM * DM / 8), gtid, gs);
        conv_wfrag<false>(p.w_glu + (size_t)l * 512 * 512, 512, 1, p.norm_mix, p.norm_mix, 512, 512, 512, 2, p.wfglu + (size_t)l * (512 * 512 / 8), gtid, gs);
#pragma unroll 1
        for (int gi = 0; gi < 4; ++gi)
            conv_wfrag<false>(p.w_pool + (size_t)(l * 4 + gi) * 128 * 128, 128, 1, p.norm_mix, p.norm_mix, 128, 128, 128, 2, p.wfpool + (size_t)(l * 4 + gi) * (128 * 128 / 8), gtid, gs);
        conv_wfrag<true>(p.w_out + (size_t)l * DM * DM, DM, 1, p.g_out_ssm + l * 512, p.g_out_pool + l * 512, 512, DM, DM, 4, p.wfout + (size_t)l * (DM * DM / 8), gtid, gs);
        conv_wfrag<true>(p.w_q + (size_t)l * DM * 2048, 2048, 1, p.norm_ffn + l * DM, p.norm_ffn + l * DM, DM, DM, 2048, 4, p.wfq + (size_t)l * (DM * 2048 / 8), gtid, gs);
    }
}
#define KT_BLK 528
#define KT_BYTES (65 * KT_BLK)
#define WST_FRAGS (4 * 64 * 64)
#define CCAR_FRAGS (32 * 8 * 64)
#define SU_CH 2064

DI WJob wjob_in(const PrepW& p, int l) { WJob j; j.src = p.w_in + (size_t)l * DM * DM; j.ldk = DM; j.ga = j.gb = p.norm_mix + l * DM; j.split = DM; j.K = DM; j.N = DM; j.NTG = 4; j.dst = p.wfin + (size_t)l * (DM * DM / 8); return j; }
DI WJob wjob_out(const PrepW& p, int l) { WJob j; j.src = p.w_out + (size_t)l * DM * DM; j.ldk = DM; j.ga = p.g_out_ssm + l * 512; j.gb = p.g_out_pool + l * 512; j.split = 512; j.K = DM; j.N = DM; j.NTG = 4; j.dst = p.wfout + (size_t)l * (DM * DM / 8); return j; }
DI WJob wjob_q(const PrepW& p, int l) { WJob j; j.src = p.w_q + (size_t)l * DM * 2048; j.ldk = 2048; j.ga = j.gb = p.norm_ffn + l * DM; j.split = DM; j.K = DM; j.N = 2048; j.NTG = 4; j.dst = p.wfq + (size_t)l * (DM * 2048 / 8); return j; }
DI WJob wjob_glu(const PrepW& p, int l) { WJob j; j.src = p.w_glu + (size_t)l * 512 * 512; j.ldk = 512; j.ga = j.gb = p.norm_mix; j.split = 512; j.K = 512; j.N = 512; j.NTG = 2; j.dst = p.wfglu + (size_t)l * (512 * 512 / 8); return j; }
DI WJob wjob_pool(const PrepW& p, int idx) { WJob j; j.src = p.w_pool + (size_t)idx * 128 * 128; j.ldk = 128; j.ga = j.gb = p.norm_mix; j.split = 128; j.K = 128; j.N = 128; j.NTG = 2; j.dst = p.wfpool + (size_t)idx * (128 * 128 / 8); return j; }
#define PW_NONE ((size_t)1 << 40)
DI void prep_s5_item(int lg, int part, const float* __restrict__ a_re, const float* __restrict__ a_im, const float* __restrict__ log_dt,
                     const float* __restrict__ b_re, const float* __restrict__ b_im, const float* __restrict__ c_re, const float* __restrict__ c_im,
                     const float* __restrict__ d_skip, char* __restrict__ KT, bf16x8* __restrict__ WST, bf16x8* __restrict__ CCAR,
                     float* __restrict__ ABT, char* smem, int wid, const PrepW* pw = nullptr, size_t gtid = 0, size_t gs = 0, bool skip_in0 = false) {
    float pv0[8], pv1[8];
#define PW_SLOT_ISSUE(G0, mk0_, it0_, G1, mk1_, it1_) WJob pj0_, pj1_; size_t pi0_ = PW_NONE, pi1_ = PW_NONE; \
        if (pw) { pj0_ = mk0_; pj1_ = mk1_; pi0_ = it0_; pi1_ = it1_; wf_load<G0>(pj0_, pi0_, pv0); wf_load<G1>(pj1_, pi1_, pv1); }
#define PW_SLOT_FINISH() if (pw) { wf_store(pj0_, pi0_, pv0); wf_store(pj1_, pi1_, pv1); }
    float* powr = (float*)smem;
    float* powi = powr + 65 * 64;
    float* bzr = powi + 65 * 64;
    float* bzi = bzr + 1024;
    float* cr = bzi + 1024;
    float* ci = cr + 1024;
    float* p1r = ci + 1024;
    float* p1i = p1r + 512;
    float* p8r = p1i + 512;
    float* p8i = p8r + 576;
    int tid = get_tid(wid);
    const float* are_p = a_re + lg * 64; const float* aim_p = a_im + lg * 64;
    const float dt = expf(log_dt[lg]);
    { PW_SLOT_ISSUE(true, wjob_in(*pw, 0), (skip_in0 ? PW_NONE : gtid), true, wjob_out(*pw, 0), gtid)
    for (int it = tid; it < 17 * 64; it += NTHR) {
        const int q = it >> 6, p = it & 63, tau = q < 8 ? q : 8 * (q - 8);
        const float lre = are_p[p], lim = aim_p[p];
        const float mag = expf((float)tau * lre * dt);
        double rev = (double)lim * (double)dt * (double)tau * 0.15915494309189535;
        rev -= floor(rev);
        const float ang = (float)rev * 6.283185307179586f;
        const float vr = mag * cosf(ang), vi = mag * sinf(ang);
        if (q < 8) { p1r[q * 64 + p] = vr; p1i[q * 64 + p] = vi; } else { p8r[(q - 8) * 64 + p] = vr; p8i[(q - 8) * 64 + p] = vi; }
    }
    for (int it = tid; it < 1024; it += NTHR) {
        const int ho = it >> 6, p = it & 63;
        cr[p * 16 + ho] = c_re[lg * 1024 + it]; ci[p * 16 + ho] = c_im[lg * 1024 + it];
    }
    PW_SLOT_FINISH() }
    __syncthreads();
    { PW_SLOT_ISSUE(true, wjob_q(*pw, 0), gtid, true, wjob_q(*pw, 0), gtid + gs)
    for (int it = tid; it < 65 * 64; it += NTHR) {
        const int tau = it >> 6, p = it & 63, qa = tau >> 3, qb = tau & 7;
        const float ar = p8r[qa * 64 + p], ai = p8i[qa * 64 + p], br = p1r[qb * 64 + p], bi = p1i[qb * 64 + p];
        powr[it] = ar * br - ai * bi; powi[it] = ar * bi + ai * br;
    }
    __syncthreads();
    for (int it = tid; it < 1024; it += NTHR) {
        const int p = it >> 4;
        const float lre = are_p[p], lim = aim_p[p];
        const float ar = powr[64 + p], ai = powi[64 + p];
        const float inv = 1.f / (lre * lre + lim * lim), nre = ar - 1.f;
        const float zre = (nre * lre + ai * lim) * inv, zim = (ai * lre - nre * lim) * inv;
        const float br = b_re[lg * 1024 + it], bi = b_im[lg * 1024 + it];
        bzr[it] = zre * br - zim * bi; bzi[it] = zre * bi + zim * br;
    }
    PW_SLOT_FINISH() }
    __syncthreads();
    if (part == 0 && tid < 64) { ABT[lg * 128 + 2 * tid] = powr[64 * 64 + tid]; ABT[lg * 128 + 2 * tid + 1] = powi[64 * 64 + tid]; }
    char* kt = KT + (size_t)lg * KT_BYTES;
    if (part == 0) for (int it = tid; it < KT_BLK / 4; it += NTHR) ((unsigned*)kt)[it] = 0u;
    { PW_SLOT_ISSUE(true, wjob_in(*pw, 1), gtid, true, wjob_out(*pw, 1), gtid)
    {
        const int tau = part * 16 + (tid >> 5), ho = (tid >> 1) & 15, hh = tid & 1;
        float sacc[8];
#pragma unroll
        for (int j = 0; j < 8; ++j) sacc[j] = 0.f;
#pragma unroll 4
        for (int p = 0; p < 64; ++p) {
            const float c_r = cr[p * 16 + ho], c_i = ci[p * 16 + ho], pr = powr[tau * 64 + p], pi = powi[tau * 64 + p];
            const float cpr = c_r * pr - c_i * pi, cpi = c_r * pi + c_i * pr;
            const float4 b0 = *(const float4*)(bzr + p * 16 + 8 * hh), b1 = *(const float4*)(bzr + p * 16 + 8 * hh + 4);
            const float4 d0 = *(const float4*)(bzi + p * 16 + 8 * hh), d1 = *(const float4*)(bzi + p * 16 + 8 * hh + 4);
            sacc[0] += cpr * b0.x - cpi * d0.x; sacc[1] += cpr * b0.y - cpi * d0.y; sacc[2] += cpr * b0.z - cpi * d0.z; sacc[3] += cpr * b0.w - cpi * d0.w;
            sacc[4] += cpr * b1.x - cpi * d1.x; sacc[5] += cpr * b1.y - cpi * d1.y; sacc[6] += cpr * b1.z - cpi * d1.z; sacc[7] += cpr * b1.w - cpi * d1.w;
        }
        if (tau == 0) {
#pragma unroll
            for (int j = 0; j < 8; ++j) if (ho == 8 * hh + j) sacc[j] += d_skip[lg * 16 + ho];
        }
        uint4 o; o.x = pack_bf2(sacc[0], sacc[1]); o.y = pack_bf2(sacc[2], sacc[3]); o.z = pack_bf2(sacc[4], sacc[5]); o.w = pack_bf2(sacc[6], sacc[7]);
        *(uint4*)(kt + (tau + 1) * KT_BLK + ho * 32 + hh * 16) = o;
    }
    PW_SLOT_FINISH() }
    if (part == 0) for (int it = tid; it < 65 * 4; it += NTHR) ((unsigned*)(kt + (it >> 2) * KT_BLK + 512))[it & 3] = 0u;
    bf16x8* wst = WST + (size_t)lg * WST_FRAGS;
    { PW_SLOT_ISSUE(true, wjob_q(*pw, 1), gtid, true, wjob_q(*pw, 1), gtid + gs)
    for (int it = part * (WST_FRAGS / 4) + tid; it < (part + 1) * (WST_FRAGS / 4); it += NTHR) {
        const int lane = it & 63, j = (it >> 6) & 63, nt = it >> 12;
        const int r = lane & 31, h = lane >> 5, n = nt * 32 + r, p = n & 63, im = n >> 6;
        const float pr = powr[(63 - j) * 64 + p], pi = powi[(63 - j) * 64 + p];
        float v[8];
#pragma unroll
        for (int jj = 0; jj < 8; ++jj) {
            const float zr = bzr[p * 16 + 8 * h + jj], zi = bzi[p * 16 + 8 * h + jj];
            v[jj] = im ? (pr * zi + pi * zr) : (pr * zr - pi * zi);
        }
        uint4 o; o.x = pack_bf2(v[0], v[1]); o.y = pack_bf2(v[2], v[3]); o.z = pack_bf2(v[4], v[5]); o.w = pack_bf2(v[6], v[7]);
        *(uint4*)(wst + it) = o;
    }
    PW_SLOT_FINISH() }
    bf16x8* cc = CCAR + (size_t)lg * CCAR_FRAGS;
    { PW_SLOT_ISSUE(false, wjob_glu(*pw, (int)(gtid >> 15) & 1), (gtid < 65536 ? (gtid & 32767) : PW_NONE), false, wjob_pool(*pw, (int)(gtid >> 11) & 7), (gtid < 16384 ? (gtid & 2047) : PW_NONE))
    for (int it = part * (CCAR_FRAGS / 4) + tid; it < (part + 1) * (CCAR_FRAGS / 4); it += NTHR) {
        const int lane = it & 63, ks = (it >> 6) & 7, mt = it >> 9;
        const int r = lane & 31, h = lane >> 5, m = mt * 32 + r, i = m >> 4, ho = m & 15;
        float v[8];
#pragma unroll
        for (int jj = 0; jj < 8; ++jj) {
            const int k = ks * 16 + 8 * h + jj, p = k & 63, im = k >> 6;
            const float c_r = cr[p * 16 + ho], c_i = ci[p * 16 + ho], pr = powr[(i + 1) * 64 + p], pi = powi[(i + 1) * 64 + p];
            v[jj] = im ? -(c_r * pi + c_i * pr) : (c_r * pr - c_i * pi);
        }
        uint4 o; o.x = pack_bf2(v[0], v[1]); o.y = pack_bf2(v[2], v[3]); o.z = pack_bf2(v[4], v[5]); o.w = pack_bf2(v[6], v[7]);
        *(uint4*)(cc + it) = o;
    }
    PW_SLOT_FINISH() }
    __syncthreads();
}

#define PB_SU 0
#define PB_SKT (32 * SU_CH)
#define PB_SL (PB_SKT + KT_BYTES)
#define PB_SPART (PB_SL + 32 * 132 * 4)
#define PB_SSP (PB_SPART + 4 * 4096)
#define PB_BYTES (PB_SSP + 32 * 272)

typedef unsigned char fp4x2_t;
DI void conv_row_fp4_one(float4 v0, float4 v1, float4 v2, float4 v3, fp4x2_t* __restrict__ dst, float* __restrict__ scales, int nrows, int row, int lane);
#define BG_ISSUE(base_, n_) if (bg_r0 >= 0) { _Pragma("unroll") for (int q_ = 0; q_ < (n_); ++q_) { const f32x4* pq_ = (const f32x4*)(bg_src + (size_t)(bg_r0 + (base_) + q_) * DM + lane * 16); \
        bgv[q_][0] = pq_[0]; bgv[q_][1] = pq_[1]; bgv[q_][2] = pq_[2]; bgv[q_][3] = pq_[3]; } }
#define BG_F4(x_) make_float4((x_)[0], (x_)[1], (x_)[2], (x_)[3])
#define BG_FINISH(base_, n_) if (bg_r0 >= 0) { _Pragma("unroll") for (int q_ = 0; q_ < (n_); ++q_) \
        conv_row_fp4_one(BG_F4(bgv[q_][0]), BG_F4(bgv[q_][1]), BG_F4(bgv[q_][2]), BG_F4(bgv[q_][3]), bg_dst, bg_sc, NEXP, bg_r0 + (base_) + q_, lane); }
DI void phaseB_tile(const bf16_t* __restrict__ U, const char* __restrict__ KT, const bf16x8* __restrict__ WST, const bf16x8* __restrict__ CCAR,
                    const float* __restrict__ ABT, bf16_t* __restrict__ YPRE, int tile, char* smem, int wid,
                    const float* __restrict__ bg_src, fp4x2_t* __restrict__ bg_dst, float* __restrict__ bg_sc, int bg_r0) {
    f32x4 bgv[2][4];
    const int gp = tile & 31, b = tile >> 5;
    const int g = ((gp & 7) << 2) | (gp >> 3);
    int tid = get_tid(wid);
    const int w = __builtin_amdgcn_readfirstlane(tid >> 6), lane = tid & 63, r = lane & 31, h = lane >> 5;
    char* sU = smem + PB_SU; char* sKT = smem + PB_SKT; float* sL = (float*)(smem + PB_SL); float* sPart = (float*)(smem + PB_SPART);
    char* sSp = smem + PB_SSP;
    bf16x8 wq[32];
    {
        const int nt = w & 3, kh = w >> 2;
        const bf16x8* wp = WST + (size_t)g * WST_FRAGS + (size_t)(nt * 64 + kh * 32) * 64 + lane;
#pragma unroll
        for (int j = 0; j < 32; ++j) wq[j] = wp[j * 64];
    }
#pragma unroll
    for (int it = 0; it < 4; ++it) {
        const int tok = tid + NTHR * it;
        const uint4* src = (const uint4*)(U + (size_t)(b * SEQ + tok) * DM + g * 16);
        const uint4 v0 = src[0], v1 = src[1];
        char* d = sU + (tok >> 6) * SU_CH + (tok & 63) * 32;
        *(uint4*)d = v0; *(uint4*)(d + 16) = v1;
    }
    {
        const uint4* src = (const uint4*)(KT + (size_t)g * KT_BYTES);
        constexpr int KT_Q = KT_BYTES / 16, KT_IT = (KT_Q + NTHR - 1) / NTHR;
        uint4 kv[KT_IT];
#pragma unroll
        for (int i = 0; i < KT_IT; ++i) { const int it = tid + NTHR * i; kv[i] = src[it < KT_Q ? it : KT_Q - 1]; }
#pragma unroll
        for (int i = 0; i < KT_IT; ++i) { const int it = tid + NTHR * i; if (it < KT_Q) ((uint4*)sKT)[it] = kv[i]; }
    }
    __syncthreads();
    BG_ISSUE(0, 2)
    {
        const int nt = w & 3, kh = w >> 2;
        f32x16 acc;
#pragma unroll
        for (int i = 0; i < 16; ++i) acc[i] = 0.f;
        const char* up = sU + r * SU_CH + h * 16 + kh * 32 * 32;
#pragma unroll
        for (int j = 0; j < 32; ++j) {
            const bf16x8 bb = *(const bf16x8*)(up + j * 32);
            acc = MFMA32(wq[j], bb, acc);
        }
        if (kh == 1) {
#pragma unroll
            for (int i = 0; i < 16; ++i) sPart[(nt * 16 + i) * 64 + lane] = acc[i];
        }
        __syncthreads();
        if (kh == 0) {
#pragma unroll
            for (int i = 0; i < 16; ++i) sL[r * 132 + nt * 32 + crow(i, h)] = acc[i] + sPart[(nt * 16 + i) * 64 + lane];
        }
        __syncthreads();
    }
    BG_FINISH(0, 2) BG_ISSUE(2, 2)
    if (tid < 64) {
        const int p = tid;
        const float ar = ABT[g * 128 + 2 * p], ai = ABT[g * 128 + 2 * p + 1];
        float sr = 0.f, si = 0.f;
        float lrv[32], liv[32];
#pragma unroll
        for (int c = 0; c < 32; ++c) { lrv[c] = sL[c * 132 + p]; liv[c] = sL[c * 132 + 64 + p]; }
#pragma unroll
        for (int c = 0; c < 32; ++c) {
            *(bf16_t*)(sSp + c * 272 + p * 2) = (bf16_t)(pack_bf2(sr, 0.f) & 0xffffu);
            *(bf16_t*)(sSp + c * 272 + (64 + p) * 2) = (bf16_t)(pack_bf2(si, 0.f) & 0xffffu);
            const float nr = ar * sr - ai * si + lrv[c], ni = ar * si + ai * sr + liv[c];
            sr = nr; si = ni;
        }
    }
    BG_FINISH(2, 2)
    f32x16 acc4[4];
#pragma unroll
    for (int q = 0; q < 4; ++q)
#pragma unroll
        for (int i = 0; i < 16; ++i) acc4[q][i] = 0.f;
    const int mts0 = w, mts1 = 15 - w, mts2 = 16 + w, mts3 = 31 - w;
    bf16x8 cq[4][8];
    {
        const bf16x8* cp = CCAR + (size_t)g * CCAR_FRAGS + lane;
#pragma unroll
        for (int ks = 0; ks < 8; ++ks) { cq[0][ks] = cp[(mts0 * 8 + ks) * 64]; cq[1][ks] = cp[(mts1 * 8 + ks) * 64]; cq[2][ks] = cp[(mts2 * 8 + ks) * 64]; cq[3][ks] = cp[(mts3 * 8 + ks) * 64]; }
    }
    {
        const char* up = sU + r * SU_CH + h * 16;
        const char* kp = sKT + (r & 15) * 32 + h * 16 + ((r >> 4) + 1) * KT_BLK;
        for (int j = 0; j < 64; ++j) {
            const bf16x8 bb = *(const bf16x8*)(up + j * 32);
#define TOEP_STEP(q, mt) if (2 * (mt) + 1 >= j) { const bf16x8 a = *(const bf16x8*)(kp + (2 * (mt) - j) * KT_BLK); acc4[q] = MFMA32(a, bb, acc4[q]); }
            TOEP_STEP(0, mts0) TOEP_STEP(1, mts1) TOEP_STEP(2, mts2) TOEP_STEP(3, mts3)
#undef TOEP_STEP
        }
    }
    __syncthreads();
    {
        const char* sp = sSp + r * 272 + h * 16;
#pragma unroll
        for (int ks = 0; ks < 8; ++ks) {
            const bf16x8 bb = *(const bf16x8*)(sp + ks * 32);
            acc4[0] = MFMA32(cq[0][ks], bb, acc4[0]);
            acc4[1] = MFMA32(cq[1][ks], bb, acc4[1]);
            acc4[2] = MFMA32(cq[2][ks], bb, acc4[2]);
            acc4[3] = MFMA32(cq[3][ks], bb, acc4[3]);
        }
    }
    BG_ISSUE(4, 2)
    {
        bf16_t* ybase = YPRE + (size_t)(b * SEQ + r * 64) * 512 + g * 16;
#define PB_STORE(q, mt) _Pragma("unroll") for (int rp = 0; rp < 2; ++rp) { const int i = 2 * (mt) + rp; \
            const unsigned px = pack_bf2(acc4[q][8 * rp], acc4[q][8 * rp + 1]), py = pack_bf2(acc4[q][8 * rp + 2], acc4[q][8 * rp + 3]); \
            const unsigned qx = pack_bf2(acc4[q][8 * rp + 4], acc4[q][8 * rp + 5]), qy = pack_bf2(acc4[q][8 * rp + 6], acc4[q][8 * rp + 7]); \
            auto sx = __builtin_amdgcn_permlane32_swap(px, qx, false, false); auto sy = __builtin_amdgcn_permlane32_swap(py, qy, false, false); \
            u32x4 o = {(unsigned)sx[0], (unsigned)sy[0], (unsigned)sx[1], (unsigned)sy[1]}; \
            *(u32x4*)(ybase + (size_t)i * 512 + 8 * h) = o; }
        PB_STORE(0, mts0) PB_STORE(1, mts1) PB_STORE(2, mts2) PB_STORE(3, mts3)
#undef PB_STORE
    }
    BG_FINISH(4, 2) BG_ISSUE(6, 2) BG_FINISH(6, 2)
    __syncthreads();
}

#ifndef REP_GLU
#define REP_GLU 1
#endif
#ifndef REP_POOL
#define REP_POOL 1
#endif
#ifndef REP_OUT
#define REP_OUT 1
#endif
#ifndef REP_Q
#define REP_Q 1
#endif
#ifndef REP_SC
#define REP_SC 1
#endif
struct ALoadGelu {
    const bf16_t* base; u32x4 v0[4], v1[4]; int dofs;
    DI void init(const bf16_t* rowbase, int tid) { base = rowbase + (tid & 7) * 16; dofs = (tid >> 3) * SA_STRIDE + (tid & 7) * 32; }
    DI void issue_all() {
#pragma unroll
        for (int q = 0; q < 4; ++q) { const u32x4* p = (const u32x4*)(base + q * 128); v0[q] = p[0]; v1[q] = p[1]; }
    }
    DI unsigned g2(unsigned u) { return pack_bf2(gelu_erf_as(bf_lo(u)), gelu_erf_as(bf_hi(u))); }
    DI void commit_q(char* img, const u32x4& a0, const u32x4& a1) {
        u32x4 o0, o1;
        o0.x = g2(a0.x); o0.y = g2(a0.y); o0.z = g2(a0.z); o0.w = g2(a0.w);
        o1.x = g2(a1.x); o1.y = g2(a1.y); o1.z = g2(a1.z); o1.w = g2(a1.w);
        char* d = img + dofs;
        *(u32x4*)d = o0; *(u32x4*)(d + 16) = o1;
    }
    DI void commit(char* img, int c) {
        if (c == 0) commit_q(img, v0[0], v1[0]); else if (c == 1) commit_q(img, v0[1], v1[1]); else if (c == 2) commit_q(img, v0[2], v1[2]); else commit_q(img, v0[3], v1[3]);
    }
};
template <int NT, int PF>
DI void gemm64_glu(f32x16 (&acc)[NT][2], ALoadGelu& al, const bf16x8* __restrict__ wf_, char* img, const int lane) {
    gwp_t wf = (gwp_t)wf_;
    const int r = lane & 31, h = lane >> 5;
    bf16x8 bq[PF][NT];
    al.issue_all();
#pragma unroll
    for (int p = 0; p < PF; ++p)
#pragma unroll
        for (int nt = 0; nt < NT; ++nt) bq[p][nt] = wf[(p * NT + nt) * 64];
    gwp_t wpf = wf + PF * NT * 64;
    al.commit(img, 0);
    const int kend = 4 * 8 - PF;
    int kg = 0;
#pragma unroll 1
    for (int c = 0; c < 4; ++c) {
        __syncthreads();
        const char* buf = img + c * SA_BYTES + r * SA_STRIDE + h * 16;
#pragma unroll
        for (int ks = 0; ks < 8; ++ks) {
            const bf16x8 a0 = *(const bf16x8*)(buf + ks * 32);
            const bf16x8 a1 = *(const bf16x8*)(buf + 32 * SA_STRIDE + ks * 32);
#pragma unroll
            for (int nt = 0; nt < NT; ++nt) {
                acc[nt][0] = MFMA32(bq[ks % PF][nt], a0, acc[nt][0]);
                acc[nt][1] = MFMA32(bq[ks % PF][nt], a1, acc[nt][1]);
            }
            if (kg < kend) {
#pragma unroll
                for (int nt = 0; nt < NT; ++nt) bq[ks % PF][nt] = wpf[nt * 64];
            }
            wpf += NT * 64; ++kg;
            asm volatile("" : "+v"(wpf));
        }
        if (c + 1 < 4) al.commit(img + (c + 1) * SA_BYTES, c + 1);
    }
    __syncthreads();
}

DI void tok_reduce(float p0, float p1, float* sred, float& t0, float& t1, int tid) {
    const int w = tid >> 6, lane = tid & 63, r = lane & 31, h = lane >> 5;
    __syncthreads();
    sred[(w * 2 + h) * 64 + r] = p0; sred[(w * 2 + h) * 64 + 32 + r] = p1;
    __syncthreads();
    float a = 0.f, b = 0.f;
#pragma unroll
    for (int k = 0; k < 16; ++k) { a += sred[k * 64 + r]; b += sred[k * 64 + 32 + r]; }
    t0 = a; t1 = b;
}

#define PC_SRED (4 * SA_BYTES)
#define PC_BYTES (PC_SRED + 4096 + 256)
#define PC_IMGHI PC_BYTES

struct PCArgs {
    const bf16_t* U; const bf16_t* YPRE; bf16_t* G1; bf16_t* A2; const float* Xin; float* Xout; float* Xdummy; unsigned* HPH; unsigned* HPL; float* HS; bf16_t* Hb; float* RSTD;
    const bf16x8* wfglu; const float* b_glu; const bf16x8* wfpool; const float* pool_scale; const bf16x8* wfout;
    const float* bg_usrc; const float* bg_gain; fp4x2_t* bg_udst; float* bg_usc; int bg_r0;
};
DI void conv_row_int4_one(float4 a0, float4 a1, float4 a2, float4 a3, const float4& g0, const float4& g1, const float4& g2, const float4& g3,
                          fp4x2_t* __restrict__ dst, float* __restrict__ scales, int row, int lane);
#define CBG_ISSUE(base_) if (a.bg_r0 >= 0) { _Pragma("unroll") for (int q_ = 0; q_ < 2; ++q_) { const f32x4* pq_ = (const f32x4*)(a.bg_usrc + (size_t)(a.bg_r0 + (base_) + q_) * DM + lane * 16); \
        cbg[q_][0] = pq_[0]; cbg[q_][1] = pq_[1]; cbg[q_][2] = pq_[2]; cbg[q_][3] = pq_[3]; } }
#define CBG_FINISH(base_) if (a.bg_r0 >= 0) { const f32x4* gp_ = (const f32x4*)(a.bg_gain + lane * 16); const f32x4 gq0_ = gp_[0], gq1_ = gp_[1], gq2_ = gp_[2], gq3_ = gp_[3]; \
        _Pragma("unroll") for (int q_ = 0; q_ < 2; ++q_) conv_row_int4_one(BG_F4(cbg[q_][0]), BG_F4(cbg[q_][1]), BG_F4(cbg[q_][2]), BG_F4(cbg[q_][3]), BG_F4(gq0_), BG_F4(gq1_), BG_F4(gq2_), BG_F4(gq3_), a.bg_udst, a.bg_usc, a.bg_r0 + (base_) + q_, lane); }

DI void phaseC1_tile(const PCArgs& a, int tile, char* smem, int wid) {
    char* sA = smem; float* sred = (float*)(smem + PC_SRED);
    f32x4 cbg[2][4];
    const int lane = get_tid(wid) & 63;
    for (int rep_ = 0; rep_ < REP_GLU; ++rep_) {
        int tok0 = tile * 64; asm volatile("" : "+s"(tok0));
        int tid = get_tid(wid);
        const int w = __builtin_amdgcn_readfirstlane(tid >> 6), lane = tid & 63, r = lane & 31, h = lane >> 5;
        CBG_ISSUE(0)
        ALoadGelu al; al.init(a.YPRE + (size_t)(tok0 + (tid >> 3)) * 512, tid);
        f32x16 acc[2][2]; zero_acc<2>(acc);
        gemm64_glu<2, 4>(acc, al, a.wfglu + (size_t)w * (32 * 2 * 64) + lane, smem + PC_IMGHI, lane);
        CBG_FINISH(0)
        float ss0 = 0.f, ss1 = 0.f;
        {
            uint2 yp[2][2][4]; float4 bg[2][4];
#pragma unroll
            for (int nt = 0; nt < 2; ++nt)
#pragma unroll
                for (int q = 0; q < 4; ++q) bg[nt][q] = *(const float4*)(a.b_glu + w * 64 + nt * 32 + 8 * q + 4 * h);
#pragma unroll
            for (int mt = 0; mt < 2; ++mt)
#pragma unroll
                for (int nt = 0; nt < 2; ++nt)
#pragma unroll
                    for (int q = 0; q < 4; ++q)
                        yp[mt][nt][q] = *(const uint2*)(smem + PC_IMGHI + (w >> 1) * SA_BYTES + (mt * 32 + r) * SA_STRIDE + (w & 1) * 128 + (nt * 32 + 8 * q + 4 * h) * 2);
#pragma unroll
            for (int mt = 0; mt < 2; ++mt)
#pragma unroll
                for (int nt = 0; nt < 2; ++nt)
#pragma unroll
                    for (int q = 0; q < 4; ++q) {
                        const float y0 = bf_lo(yp[mt][nt][q].x), y1 = bf_hi(yp[mt][nt][q].x), y2 = bf_lo(yp[mt][nt][q].y), y3 = bf_hi(yp[mt][nt][q].y);
                        const float o0 = y0 * __builtin_amdgcn_rcpf(1.f + __expf(-(acc[nt][mt][4 * q] + bg[nt][q].x)));
                        const float o1 = y1 * __builtin_amdgcn_rcpf(1.f + __expf(-(acc[nt][mt][4 * q + 1] + bg[nt][q].y)));
                        const float o2 = y2 * __builtin_amdgcn_rcpf(1.f + __expf(-(acc[nt][mt][4 * q + 2] + bg[nt][q].z)));
                        const float o3 = y3 * __builtin_amdgcn_rcpf(1.f + __expf(-(acc[nt][mt][4 * q + 3] + bg[nt][q].w)));
                        acc[nt][mt][4 * q] = o0; acc[nt][mt][4 * q + 1] = o1; acc[nt][mt][4 * q + 2] = o2; acc[nt][mt][4 * q + 3] = o3;
                        const float s = o0 * o0 + o1 * o1 + o2 * o2 + o3 * o3;
                        if (mt == 0) ss0 += s; else ss1 += s;
                    }
        }
        float t0, t1; tok_reduce(ss0, ss1, sred, t0, t1, tid);
        const float rs0 = rsqrtf(t0 * (1.f / 512.f) + 1e-6f), rs1 = rsqrtf(t1 * (1.f / 512.f) + 1e-6f);
#ifdef GLU_PROBE_NOSTORE
        if (!(rep_ + 1 < REP_GLU) || rs0 == 1234.5f)
#endif
#pragma unroll
        for (int mt = 0; mt < 2; ++mt) {
            const float rs = mt ? rs1 : rs0;
            char* orow = smem + PC_IMGHI + (w >> 1) * SA_BYTES + (mt * 32 + r) * SA_STRIDE + (w & 1) * 128;
#pragma unroll
            for (int nt = 0; nt < 2; ++nt)
#pragma unroll
                for (int q = 0; q < 4; ++q) {
                    uint2 o; o.x = pack_bf2(acc[nt][mt][4 * q] * rs, acc[nt][mt][4 * q + 1] * rs);
                    o.y = pack_bf2(acc[nt][mt][4 * q + 2] * rs, acc[nt][mt][4 * q + 3] * rs);
                    *(uint2*)(orow + (nt * 32 + 8 * q + 4 * h) * 2) = o;
                }
        }
    }
    for (int rep_ = 0; rep_ < REP_POOL; ++rep_) {
        int tok0 = tile * 64; asm volatile("" : "+s"(tok0));
        int tid = get_tid(wid);
        const int w = __builtin_amdgcn_readfirstlane(tid >> 6), lane = tid & 63, r = lane & 31, h = lane >> 5;
        const int row = tid >> 3, seg = tid & 7;
        const int tok = tok0 + row, t = tok & (SEQ - 1);
#define POOL_LOAD(gi_, K0, K1, arr0, arr1, base_) _Pragma("unroll") for (int kk = K0; kk < K1; ++kk) { \
            const bf16_t* up_ = a.U + (size_t)tok * DM + 512 + (gi_) * 128 + seg * 16; const bf16_t* p_ = (kk <= t) ? up_ - (size_t)kk * DM : up_; \
            arr0[(base_) + kk] = *(const u32x4*)p_; arr1[(base_) + kk] = *(const u32x4*)(p_ + 8); }
#define POOL_FINISH(gi_, arr0, arr1, base_) { const int win_ = 2 << (gi_); const int cnt_ = (t + 1 < win_) ? (t + 1) : win_; float s_[16]; \
            const unsigned cu_[8] = {arr0[base_].x, arr0[base_].y, arr0[base_].z, arr0[base_].w, arr1[base_].x, arr1[base_].y, arr1[base_].z, arr1[base_].w}; \
            _Pragma("unroll") for (int i = 0; i < 8; ++i) { s_[2 * i] = bf_lo(cu_[i]); s_[2 * i + 1] = bf_hi(cu_[i]); } \
            _Pragma("unroll") for (int kk = 1; kk < win_; ++kk) { const float m_ = (kk <= t) ? 1.f : 0.f; \
                const unsigned du_[8] = {arr0[(base_) + kk].x, arr0[(base_) + kk].y, arr0[(base_) + kk].z, arr0[(base_) + kk].w, arr1[(base_) + kk].x, arr1[(base_) + kk].y, arr1[(base_) + kk].z, arr1[(base_) + kk].w}; \
                _Pragma("unroll") for (int i = 0; i < 8; ++i) { s_[2 * i] = fmaf(m_, bf_lo(du_[i]), s_[2 * i]); s_[2 * i + 1] = fmaf(m_, bf_hi(du_[i]), s_[2 * i + 1]); } } \
            const float inv_ = 1.f / (float)cnt_; unsigned o_[8]; \
            _Pragma("unroll") for (int i = 0; i < 8; ++i) o_[i] = pack_bf2(s_[2 * i] * inv_ - bf_lo(cu_[i]), s_[2 * i + 1] * inv_ - bf_hi(cu_[i])); \
            char* d_ = sA + (gi_) * SA_BYTES + row * SA_STRIDE + seg * 32; \
            *(uint4*)d_ = make_uint4(o_[0], o_[1], o_[2], o_[3]); *(uint4*)(d_ + 16) = make_uint4(o_[4], o_[5], o_[6], o_[7]); }
        {
            u32x4 q0[14], q1[14];
            POOL_LOAD(0, 0, 2, q0, q1, 0) POOL_LOAD(1, 0, 4, q0, q1, 2) POOL_LOAD(2, 0, 8, q0, q1, 6)
            POOL_FINISH(0, q0, q1, 0) POOL_FINISH(1, q0, q1, 2) POOL_FINISH(2, q0, q1, 6)
        }
        {
            u32x4 q0[16], q1[16];
            POOL_LOAD(3, 0, 16, q0, q1, 0)
            POOL_FINISH(3, q0, q1, 0)
        }
#undef POOL_LOAD
#undef POOL_FINISH
        __syncthreads();
        const int gi = w >> 1;
        f32x16 acc[2][2]; zero_acc<2>(acc);
        const bf16x8* wp = a.wfpool + (size_t)gi * (128 * 128 / 8) + (size_t)(w & 1) * (8 * 2 * 64) + lane;
        const char* buf = sA + gi * SA_BYTES + r * SA_STRIDE + h * 16;
#pragma unroll
        for (int ks = 0; ks < 8; ++ks) {
            const bf16x8 a0 = *(const bf16x8*)(buf + ks * 32);
            const bf16x8 a1 = *(const bf16x8*)(buf + 32 * SA_STRIDE + ks * 32);
#pragma unroll
            for (int nt = 0; nt < 2; ++nt) {
                const bf16x8 wv = wp[(ks * 2 + nt) * 64];
                acc[nt][0] = MFMA32(wv, a0, acc[nt][0]);
                acc[nt][1] = MFMA32(wv, a1, acc[nt][1]);
            }
        }
        float ss0 = 0.f, ss1 = 0.f;
        float4 psc[2][4];
#pragma unroll
        for (int nt = 0; nt < 2; ++nt)
#pragma unroll
            for (int q = 0; q < 4; ++q) psc[nt][q] = *(const float4*)(a.pool_scale + w * 64 + nt * 32 + 8 * q + 4 * h);
#pragma unroll
        for (int mt = 0; mt < 2; ++mt)
#pragma unroll
            for (int nt = 0; nt < 2; ++nt)
#pragma unroll
                for (int q = 0; q < 4; ++q) {
                    const float4 sc = psc[nt][q];
                    const float o0 = acc[nt][mt][4 * q] * sc.x, o1 = acc[nt][mt][4 * q + 1] * sc.y, o2 = acc[nt][mt][4 * q + 2] * sc.z, o3 = acc[nt][mt][4 * q + 3] * sc.w;
                    acc[nt][mt][4 * q] = o0; acc[nt][mt][4 * q + 1] = o1; acc[nt][mt][4 * q + 2] = o2; acc[nt][mt][4 * q + 3] = o3;
                    const float s = o0 * o0 + o1 * o1 + o2 * o2 + o3 * o3;
                    if (mt == 0) ss0 += s; else ss1 += s;
                }
        float t0, t1; tok_reduce(ss0, ss1, sred, t0, t1, tid);
        const float rs0 = rsqrtf(t0 * (1.f / 512.f) + 1e-6f), rs1 = rsqrtf(t1 * (1.f / 512.f) + 1e-6f);
#pragma unroll
        for (int mt = 0; mt < 2; ++mt) {
            const float rs = mt ? rs1 : rs0;
            char* orow = smem + (w >> 1) * SA_BYTES + (mt * 32 + r) * SA_STRIDE + (w & 1) * 128;
#pragma unroll
            for (int nt = 0; nt < 2; ++nt)
#pragma unroll
                for (int q = 0; q < 4; ++q) {
                    uint2 o; o.x = pack_bf2(acc[nt][mt][4 * q] * rs, acc[nt][mt][4 * q + 1] * rs);
                    o.y = pack_bf2(acc[nt][mt][4 * q + 2] * rs, acc[nt][mt][4 * q + 3] * rs);
                    *(uint2*)(orow + (nt * 32 + 8 * q + 4 * h) * 2) = o;
                }
        }
        __syncthreads();
    }
    for (int rep_ = 0; rep_ < REP_OUT; ++rep_) {
        int tok0 = tile * 64; asm volatile("" : "+s"(tok0));
        int tid = get_tid(wid);
        const int w = __builtin_amdgcn_readfirstlane(tid >> 6), lane = tid & 63, r = lane & 31, h = lane >> 5;
        CBG_ISSUE(2)
        f32x16 acc[4][2]; zero_acc<4>(acc);
        gemm64_res<4, 2>(acc, a.wfout + (size_t)w * (64 * 4 * 64) + lane, smem, smem + PC_IMGHI, lane);
        CBG_FINISH(2)
        {
            float* wscr = (float*)(smem + w * WSCR_BYTES);
            const int tl = lane >> 3, cl = (lane & 7) * 4;
            float ssj[2][4];
#pragma unroll
            for (int mt = 0; mt < 2; ++mt)
#pragma unroll
                for (int j = 0; j < 4; ++j) ssj[mt][j] = 0.f;
            uint2 xc[4], xn[4];
            const size_t rbase = (size_t)(tok0 + tl) * DM + w * 128 + cl;
#pragma unroll
            for (int j = 0; j < 4; ++j) xc[j] = *(const uint2*)(a.Hb + rbase + (size_t)(8 * j) * DM);
#pragma unroll
            for (int g = 0; g < 8; ++g) {
                const int mt = g >> 2, nt = g & 3;
                if (g < 7) {
                    const size_t rn = rbase + (size_t)((g + 1) >> 2) * 32 * DM + ((g + 1) & 3) * 32;
#pragma unroll
                    for (int j = 0; j < 4; ++j) xn[j] = *(const uint2*)(a.Hb + rn + (size_t)(8 * j) * DM);
                }
                f32x4 o[4]; tile_transpose(acc[nt][mt], wscr, lane, o);
                const size_t ro = rbase + (size_t)mt * 32 * DM + nt * 32;
#pragma unroll
                for (int j = 0; j < 4; ++j) {
                    float4 xo; xo.x = bf_lo(xc[j].x) + o[j].x; xo.y = bf_hi(xc[j].x) + o[j].y; xo.z = bf_lo(xc[j].y) + o[j].z; xo.w = bf_hi(xc[j].y) + o[j].w;
                    uint2 p; p.x = pack_bf2(xo.x, xo.y); p.y = pack_bf2(xo.z, xo.w);
                    *(uint2*)(a.Hb + ro + (size_t)(8 * j) * DM) = p;
                    ssj[mt][j] += xo.x * xo.x + xo.y * xo.y + xo.z * xo.z + xo.w * xo.w;
                }
                asm volatile("" ::: "memory");
#pragma unroll
                for (int j = 0; j < 4; ++j) xc[j] = xn[j];
            }
#pragma unroll
            for (int mt = 0; mt < 2; ++mt)
#pragma unroll
                for (int j = 0; j < 4; ++j) {
                    float v = ssj[mt][j];
                    v += shx<1>(v, lane); v += shx<2>(v, lane); v += shx<4>(v, lane);
                    if ((lane & 7) == 0) sred[w * 64 + mt * 32 + tl + 8 * j] = v;
                }
            __syncthreads();
            if (tid < 64) {
                float tot = 0.f;
#pragma unroll
                for (int k = 0; k < 8; ++k) tot += sred[k * 64 + tid];
                a.RSTD[tok0 + tid] = rsqrtf(tot * (1.f / 1024.f) + 1e-6f);
            }
        }
        __syncthreads();
    }
    {
        int tok0 = tile * 64; asm volatile("" : "+s"(tok0));
        int tid = get_tid(wid);
        const int w = __builtin_amdgcn_readfirstlane(tid >> 6), lane = tid & 63;
        u32x4 hq0[8], hq1[8];
#pragma unroll
        for (int ti = 0; ti < 8; ++ti) { const u32x4* hp = (const u32x4*)(a.Hb + (size_t)(tok0 + w * 8 + ti) * DM + lane * 16); hq0[ti] = hp[0]; hq1[ti] = hp[1]; }
#pragma unroll
        for (int ti = 0; ti < 8; ++ti) {
            const int tok = tok0 + w * 8 + ti;
            const u32x4 h0 = hq0[ti], h1 = hq1[ti];
            const unsigned wv[8] = {h0.x, h0.y, h0.z, h0.w, h1.x, h1.y, h1.z, h1.w};
            float f[16]; float m = 0.f;
#pragma unroll
            for (int i = 0; i < 8; ++i) { f[2 * i] = bf_lo(wv[i]); f[2 * i + 1] = bf_hi(wv[i]); m = fmaxf(m, fmaxf(fabsf(f[2 * i]), fabsf(f[2 * i + 1]))); }
            m = fmaxf(m, __int_as_float(__builtin_amdgcn_update_dpp(0, __float_as_int(m), 0xB1, 0xF, 0xF, true)));
            m = fmaxf(m, __int_as_float(__builtin_amdgcn_update_dpp(0, __float_as_int(m), 0x4E, 0xF, 0xF, true)));
            m = fmaxf(m, __int_as_float(__builtin_amdgcn_update_dpp(0, __float_as_int(m), 0x141, 0xF, 0xF, true)));
            m = fmaxf(m, __int_as_float(__builtin_amdgcn_update_dpp(0, __float_as_int(m), 0x140, 0xF, 0xF, true)));
            const float sh = (m > 0.f) ? m * (1.f / 119.f) : 1.f, inv = 1.f / sh;
            unsigned Hd[2], Ld[2];
#pragma unroll
            for (int d = 0; d < 2; ++d) {
                unsigned A = 0u, B = 0u;
#pragma unroll
                for (int i = 0; i < 4; ++i) {
                    A = __builtin_amdgcn_cvt_pk_u8_f32(rintf(f[8 * d + i] * inv) + 136.f, i, A);
                    B = __builtin_amdgcn_cvt_pk_u8_f32(rintf(f[8 * d + 4 + i] * inv) + 136.f, i, B);
                }
                Ld[d] = ((A & 0x0F0F0F0Fu) | ((B & 0x0F0F0F0Fu) << 4)) ^ 0x88888888u;
                Hd[d] = (((A >> 4) & 0x0F0F0F0Fu) | (B & 0xF0F0F0F0u)) ^ 0x88888888u;
            }
            *(uint2*)(a.HPH + (size_t)tok * 128 + 2 * lane) = make_uint2(Hd[0], Hd[1]);
            *(uint2*)(a.HPL + (size_t)tok * 128 + 2 * lane) = make_uint2(Ld[0], Ld[1]);
            if ((lane & 15) == 0) a.HS[(size_t)tok * 4 + (lane >> 4)] = sh;
        }
    }
}

DI unsigned f2ord(float f) { const unsigned u = __float_as_uint(f); return u ^ ((u >> 31) ? 0xFFFFFFFFu : 0x80000000u); }
DI float ord2f(unsigned o) { return __uint_as_float((o & 0x80000000u) ? (o ^ 0x80000000u) : ~o); }
DI unsigned umax_(unsigned a, unsigned b) { return a > b ? a : b; }
DI unsigned umin_(unsigned a, unsigned b) { return a < b ? a : b; }

struct PRArgs {
    const bf16_t* Hb; const float* RSTD; const bf16x8* wfq; const bf16x8* kf1; const bf16x8* kf2; unsigned short* EX; float* GT;
    const float* bg_usrc; const float* bg_gain; fp4x2_t* bg_udst; float* bg_usc; int bg_r0;
};

DI void conv_kfrag(const float* __restrict__ K, bf16x8* __restrict__ dst, size_t gtid, size_t gstride) {
    for (size_t item = gtid; item < 8 * 4 * 64; item += gstride) {
        const int lane = (int)(item & 63), kt = (int)((item >> 6) & 3), ks = (int)(item >> 8);
        const int r = lane & 31, h = lane >> 5;
        float v[8];
#pragma unroll
        for (int j = 0; j < 8; ++j) v[j] = K[(size_t)(kt * 32 + r) * 128 + (ks >> 1) * 32 + 16 * (ks & 1) + 8 * (j >> 2) + 4 * h + (j & 3)];
        uint4 o; o.x = pack_bf2(v[0], v[1]); o.y = pack_bf2(v[2], v[3]); o.z = pack_bf2(v[4], v[5]); o.w = pack_bf2(v[6], v[7]);
        *(uint4*)(dst + item) = o;
    }
}

DI float fmax_(float a, float b) { return __builtin_fmaxf(a, b); }
DI float fmin_(float a, float b) { return __builtin_fminf(a, b); }
#define CE_(i, j) { const float hi_ = fmax_(a[i], a[j]), lo_ = fmin_(a[i], a[j]); a[i] = hi_; a[j] = lo_; }
DI void sort16_desc(float (&a)[16]) {
    CE_(0,13) CE_(1,12) CE_(2,15) CE_(3,14) CE_(4,8) CE_(5,6) CE_(7,11) CE_(9,10)
    CE_(0,5) CE_(1,7) CE_(2,9) CE_(3,4) CE_(6,13) CE_(8,14) CE_(10,15) CE_(11,12)
    CE_(0,1) CE_(2,3) CE_(4,5) CE_(6,8) CE_(7,9) CE_(10,11) CE_(12,13) CE_(14,15)
    CE_(0,2) CE_(1,3) CE_(4,10) CE_(5,11) CE_(6,7) CE_(8,9) CE_(12,14) CE_(13,15)
    CE_(1,2) CE_(3,12) CE_(4,6) CE_(5,7) CE_(8,10) CE_(9,11) CE_(13,14)
    CE_(1,4) CE_(2,6) CE_(5,8) CE_(7,10) CE_(9,13) CE_(11,14)
    CE_(2,4) CE_(3,6) CE_(9,12) CE_(11,13)
    CE_(3,5) CE_(6,8) CE_(7,9) CE_(10,12)
    CE_(3,4) CE_(5,6) CE_(7,8) CE_(9,10) CE_(11,12)
    CE_(6,7) CE_(8,9)
}
DI void top16_merge(float (&a)[16], const float (&b)[16]) {
#pragma unroll
    for (int i = 0; i < 16; ++i) a[i] = fmax_(a[i], b[15 - i]);
#pragma unroll
    for (int j = 8; j > 0; j >>= 1)
#pragma unroll
        for (int i = 0; i < 16; ++i) {
            const int l = i ^ j;
            if (l > i) CE_(i, l)
        }
}
DI void make_keys(float (&x)[16], const f32x16& s, int nbase) {
#pragma unroll
    for (int i = 0; i < 16; ++i) x[i] = __uint_as_float((__float_as_uint(s[i]) & 0xFFFFFF80u) | (unsigned)(127 - (nbase + crow(i, 0))));
}

#define PR_LIST_STRIDE 80
#define PR_SLIST (2 * SA_BYTES)
#define PR_SIDX (PR_SLIST + 8 * 32 * PR_LIST_STRIDE)

#define PR_KEYS (4 * SA_BYTES + 4096 + 256)
DI void phaseC2_tile(const PRArgs& a, int tile, char* smem, int wid) {
    char* sA = smem;
    {
        const int tid0 = get_tid(wid);
        u32x4 kv[8];
#pragma unroll
        for (int i = 0; i < 4; ++i) { kv[i] = ((const u32x4*)a.kf1)[tid0 + NTHR * i]; kv[4 + i] = ((const u32x4*)a.kf2)[tid0 + NTHR * i]; }
#pragma unroll
        for (int i = 0; i < 8; ++i) ((u32x4*)(smem + PR_KEYS))[tid0 + NTHR * i] = kv[i];
    }
#pragma unroll 1
    for (int ps = 0; ps < 2; ++ps) {
        int tok0 = tile * 64; asm volatile("" : "+s"(tok0));
        int tid = get_tid(wid);
        const int w = __builtin_amdgcn_readfirstlane(tid >> 6), lane = tid & 63, r = lane & 31, h = lane >> 5;
        const int ng = ps * 8 + w, hd = ng >> 1, hf = ng & 1;
        bf16x8 qb[2][8];
        {
            ALoadBF16 al; al.init(a.Hb + (size_t)(tok0 + (tid >> 3)) * DM, tid);
            f32x4 cbg[2][4];
            CBG_ISSUE(4 + 2 * ps)
            f32x16 acc[4][2]; zero_acc<4>(acc);
            gemm64<4, 2>(acc, al, 8, a.wfq + (size_t)ng * (64 * 4 * 64) + lane, sA, lane);
            CBG_FINISH(4 + 2 * ps)
#pragma unroll
            for (int mt = 0; mt < 2; ++mt)
#pragma unroll
                for (int nt = 0; nt < 4; ++nt)
#pragma unroll
                    for (int s = 0; s < 2; ++s) {
                        u32x4 p;
                        p.x = pack_bf2(acc[nt][mt][8 * s], acc[nt][mt][8 * s + 1]); p.y = pack_bf2(acc[nt][mt][8 * s + 2], acc[nt][mt][8 * s + 3]);
                        p.z = pack_bf2(acc[nt][mt][8 * s + 4], acc[nt][mt][8 * s + 5]); p.w = pack_bf2(acc[nt][mt][8 * s + 6], acc[nt][mt][8 * s + 7]);
                        qb[mt][nt * 2 + s] = __builtin_bit_cast(bf16x8, p);
                    }
        }
        const bf16x8* kf = (const bf16x8*)(smem + PR_KEYS + hf * 32768) + lane;
        float Town[16];
        const unsigned hmask = ~((unsigned)h << 2);
#pragma unroll
        for (int mt = 0; mt < 2; ++mt) {
            f32x16 sc[4];
#pragma unroll
            for (int kt = 0; kt < 4; ++kt)
#pragma unroll
                for (int i = 0; i < 16; ++i) sc[kt][i] = 0.f;
#pragma unroll
            for (int ks = 0; ks < 8; ++ks) {
#pragma unroll
                for (int kt = 0; kt < 4; ++kt) sc[kt] = MFMA32(kf[(ks * 4 + kt) * 64], qb[mt][ks], sc[kt]);
            }
            float L[16], S[16];
            make_keys(L, sc[0], 0); sort16_desc(L);
#pragma unroll
            for (int kt = 1; kt < 4; ++kt) { make_keys(S, sc[kt], kt * 32); sort16_desc(S); top16_merge(L, S); }
#pragma unroll
            for (int k = 0; k < 16; ++k) L[k] = __uint_as_float(__float_as_uint(L[k]) & hmask);
#pragma unroll
            for (int k = 0; k < 16; ++k) S[k] = __int_as_float(shx_i<32>(__float_as_int(L[k]), lane));
            top16_merge(L, S);
            if (mt == hf) {
#pragma unroll
                for (int k = 0; k < 16; ++k) Town[k] = L[k];
            } else {
                char* dst = smem + PR_SLIST + (w * 32 + r) * PR_LIST_STRIDE + h * 32;
                f32x4 v0, v1;
                if (h == 0) { v0 = (f32x4){L[0], L[1], L[2], L[3]}; v1 = (f32x4){L[4], L[5], L[6], L[7]}; }
                else { v0 = (f32x4){L[8], L[9], L[10], L[11]}; v1 = (f32x4){L[12], L[13], L[14], L[15]}; }
                *(f32x4*)dst = v0; *(f32x4*)(dst + 16) = v1;
            }
        }
        __syncthreads();
        float T0[16], T1[16];
        {
            const char* src = smem + PR_SLIST + ((w ^ 1) * 32 + r) * PR_LIST_STRIDE;
            const f32x4 p0 = *(const f32x4*)src, p1 = *(const f32x4*)(src + 16), p2 = *(const f32x4*)(src + 32), p3 = *(const f32x4*)(src + 48);
            const float Tp[16] = {p0.x, p0.y, p0.z, p0.w, p1.x, p1.y, p1.z, p1.w, p2.x, p2.y, p2.z, p2.w, p3.x, p3.y, p3.z, p3.w};
#pragma unroll
            for (int k = 0; k < 16; ++k) { T0[k] = hf ? Tp[k] : Town[k]; T1[k] = hf ? Town[k] : Tp[k]; }
        }
        const float rs = a.RSTD[tok0 + hf * 32 + r];
        float v1[16], v2[16];
#pragma unroll
        for (int k = 0; k < 16; ++k) { v1[k] = __uint_as_float(__float_as_uint(T0[k]) & 0xFFFFFF80u) * rs; v2[k] = __uint_as_float(__float_as_uint(T1[k]) & 0xFFFFFF80u) * rs; }
        float C[16];
#pragma unroll
        for (int b = 0; b < 16; ++b) C[b] = __uint_as_float((__float_as_uint(v1[0] + v2[b]) & 0xFFFFFF00u) | (unsigned)(255 - b));
#pragma unroll
        for (int aa = 1; aa < 16; ++aa)
#pragma unroll
            for (int b = 0; b < 16; ++b)
                if ((aa + 1) * (b + 1) <= 16) {
                    const float x = __uint_as_float((__float_as_uint(v1[aa] + v2[b]) & 0xFFFFFF00u) | (unsigned)(255 - (aa * 16 + b)));
                    const int k0 = (aa + 1) * (b + 1) - 1;
#pragma unroll
                    for (int k = 15; k > k0; --k) C[k] = __builtin_amdgcn_fmed3f(C[k - 1], x, C[k]);
                    C[k0] = fmax_(C[k0], x);
                }
        unsigned* sI = (unsigned*)(smem + PR_SIDX) + (w * 64 + lane) * 9;
#pragma unroll
        for (int q = 0; q < 4; ++q) {
            unsigned p1 = 0u, p2 = 0u;
#pragma unroll
            for (int j = 0; j < 4; ++j) { p1 |= (127u - (__float_as_uint(T0[4 * q + j]) & 0x7Fu)) << (8 * j); p2 |= (127u - (__float_as_uint(T1[4 * q + j]) & 0x7Fu)) << (8 * j); }
            sI[q] = p1; sI[4 + q] = p2;
        }
        const unsigned char* sB = (const unsigned char*)sI;
        const float mx = __uint_as_float(__float_as_uint(C[0]) & 0xFFFFFF00u);
        float e[16]; float sum = 0.f; int ex[16];
#pragma unroll
        for (int k = 0; k < 16; ++k) {
            e[k] = __expf(__uint_as_float(__float_as_uint(C[k]) & 0xFFFFFF00u) - mx); sum += e[k];
            const unsigned ci = 255u - (__float_as_uint(C[k]) & 0xFFu);
            ex[k] = (int)sB[ci >> 4] * 128 + (int)sB[16 + (ci & 15u)];
        }
        const float inv = 1.f / sum;
        const size_t ob = ((size_t)(tok0 + hf * 32 + r) * 8 + hd) * 16;
        if (h == 0) {
#pragma unroll
            for (int q = 0; q < 2; ++q) *(uint4*)(a.EX + ob + 8 * q) = make_uint4((unsigned)ex[8 * q] | ((unsigned)ex[8 * q + 1] << 16), (unsigned)ex[8 * q + 2] | ((unsigned)ex[8 * q + 3] << 16),
                                                                       (unsigned)ex[8 * q + 4] | ((unsigned)ex[8 * q + 5] << 16), (unsigned)ex[8 * q + 6] | ((unsigned)ex[8 * q + 7] << 16));
        } else {
#pragma unroll
            for (int q = 0; q < 2; ++q)
                *(uint4*)((bf16_t*)a.GT + ob + 8 * q) = make_uint4(pack_bf2(e[8 * q] * inv, e[8 * q + 1] * inv), pack_bf2(e[8 * q + 2] * inv, e[8 * q + 3] * inv),
                                                                    pack_bf2(e[8 * q + 4] * inv, e[8 * q + 5] * inv), pack_bf2(e[8 * q + 6] * inv, e[8 * q + 7] * inv));
        }
        __syncthreads();
    }
}
typedef const __attribute__((address_space(1))) u32x4* grow_t;
typedef unsigned char fp8_t;
#define XB_TMO      128
#define XB_XCNT(j)  (256  + 64 * (j))
#define XB_XSUB(j)  (1280 + 64 * (j))
#define XB_XGEN(j)  (2304 + 64 * (j))
#define XB_TOP      3328
#define XB_TOPGEN   3392
#define XB_QUEUE(j) (3456 + 64 * (j))
#define XCD_BAR_WORDS (3456 + 64 * 64)
#define XB_SPIN_CAP (1u << 20)
#define LAS __attribute__((address_space(3)))

DI unsigned xb_ld(unsigned* p)              { return __hip_atomic_load(p, __ATOMIC_RELAXED, __HIP_MEMORY_SCOPE_AGENT); }
DI unsigned xb_add(unsigned* p, unsigned v) { return __hip_atomic_fetch_add(p, v, __ATOMIC_RELAXED, __HIP_MEMORY_SCOPE_AGENT); }
DI unsigned xb_xcc_id() { return (unsigned)__builtin_amdgcn_s_getreg((3 << 11) | 20) & 0xFu; }
#define XB_SPIN(cond, bar) do { unsigned _sp = 0; while (cond) { __builtin_amdgcn_s_sleep(1); \
    if ((++_sp & 255u) == 0u) { if (xb_ld(&(bar)[XB_TMO])) break; if (_sp > XB_SPIN_CAP) { atomicAdd(&(bar)[XB_TMO], 1u); break; } } } } while (0)

struct XcdBarrier { unsigned* bar; unsigned x; volatile LAS unsigned* st; };

DI XcdBarrier xcd_barrier_post(unsigned* bar, volatile LAS unsigned* st, int tid) {
    XcdBarrier b; b.bar = bar; b.x = xb_xcc_id(); b.st = st;
    if (tid == 0) st[2] = xb_add(&bar[XB_XCNT(b.x)], 1u);
    return b;
}
DI void xcd_barrier_complete(unsigned* bar, unsigned x, unsigned& nloc, unsigned& nx) {
    const unsigned G = gridDim.x * gridDim.y * gridDim.z;
    unsigned sum, cnt, mine, sp = 0u;
    for (;;) {
        sum = 0u; cnt = 0u; mine = 0u;
#pragma unroll
        for (unsigned j = 0; j < 16; ++j) { const unsigned c = xb_ld(&bar[XB_XCNT(j)]); sum += c; cnt += (c > 0u) ? 1u : 0u; mine = (j == x) ? c : mine; }
        if (sum == G) break;
        __builtin_amdgcn_s_sleep(1);
        if ((++sp & 255u) == 0u) { if (xb_ld(&bar[XB_TMO])) break; if (sp > XB_SPIN_CAP) { atomicAdd(&bar[XB_TMO], 1u); break; } }
    }
    nloc = mine > 0u ? mine : 1u; nx = cnt > 0u ? cnt : 1u;
}
template <bool ACQ>
DI void xcd_barrier(const XcdBarrier& b, int wid) {
    asm volatile("s_waitcnt vmcnt(0)" ::: "memory");
    __syncthreads();
    if (get_tid(wid) == 0) {
        unsigned* bar = b.bar;
        __builtin_amdgcn_s_waitcnt(0);
        unsigned nloc = b.st[0], nx = b.st[1];
        if (nloc == 0u) { xcd_barrier_complete(bar, b.x, nloc, nx); b.st[0] = nloc; b.st[1] = nx; }
        const unsigned old = xb_add(&bar[XB_XSUB(b.x)], 1u);
        const unsigned gen = old / nloc;
        if (old + 1u == (gen + 1u) * nloc) {
            __builtin_amdgcn_fence(__ATOMIC_RELEASE, "agent");
            asm volatile("s_waitcnt vmcnt(0)" ::: "memory");
            const unsigned og = xb_add(&bar[XB_TOP], 1u);
            const unsigned tgt = (og / nx + 1u) * nx;
            if (og + 1u != tgt) XB_SPIN((int)(xb_ld(&bar[XB_TOP]) - tgt) < 0, bar);
            if (ACQ) __builtin_amdgcn_fence(__ATOMIC_ACQUIRE, "agent");
            xb_add(&bar[XB_XGEN(b.x)], 1u);
            asm volatile("s_waitcnt vmcnt(0)" ::: "memory");
        } else {
            if (((old - gen * nloc) & 7u) == 0u) asm volatile("buffer_wbl2 sc1" ::: "memory");
            XB_SPIN(xb_ld(&bar[XB_XGEN(b.x)]) == gen, bar);
            if (ACQ) __builtin_amdgcn_fence(__ATOMIC_ACQUIRE, "agent");
            asm volatile("s_waitcnt vmcnt(0)" ::: "memory");
        }
    }
    __syncthreads();
}
#define NUSL 4
struct PSArgs {
    bf16_t* Hb; const float* RSTD; const unsigned short* EX; const float* GT; const float* SU; const float* SV;
    float* PD; bf16_t* COEF; const float* Xin; float* Xout; const unsigned* HPH; const unsigned* HPL; const float* HS; float* CS;
};

struct Ids16 { u32x4 a, b; };
DI void ids_load(Ids16& q, const unsigned short* EX, int tok, int rg) { const u32x4* p = (const u32x4*)(EX + (size_t)tok * 128 + rg * 16); q.a = p[0]; q.b = p[1]; }
#define ID_LO(w) (((w) & 0xFFFFu) * 128u + loff)
#define ID_HI(w) (((w) >> 16) * 128u + loff)
DI void rows_lo(u32x4 (&r)[8], const Ids16& q, const fp8_t* tab, unsigned loff) {
    r[0] = *(grow_t)(tab + ID_LO(q.a.x)); r[1] = *(grow_t)(tab + ID_HI(q.a.x)); r[2] = *(grow_t)(tab + ID_LO(q.a.y)); r[3] = *(grow_t)(tab + ID_HI(q.a.y));
    r[4] = *(grow_t)(tab + ID_LO(q.a.z)); r[5] = *(grow_t)(tab + ID_HI(q.a.z)); r[6] = *(grow_t)(tab + ID_LO(q.a.w)); r[7] = *(grow_t)(tab + ID_HI(q.a.w));
}
DI void rows_hi(u32x4 (&r)[8], const Ids16& q, const fp8_t* tab, unsigned loff) {
    r[0] = *(grow_t)(tab + ID_LO(q.b.x)); r[1] = *(grow_t)(tab + ID_HI(q.b.x)); r[2] = *(grow_t)(tab + ID_LO(q.b.y)); r[3] = *(grow_t)(tab + ID_HI(q.b.y));
    r[4] = *(grow_t)(tab + ID_LO(q.b.z)); r[5] = *(grow_t)(tab + ID_HI(q.b.z)); r[6] = *(grow_t)(tab + ID_LO(q.b.w)); r[7] = *(grow_t)(tab + ID_HI(q.b.w));
}
DI void peerU_finish(const PSArgs& a, float (&p)[16], int tok, int s, int lane) {
    const int rg = lane >> 3, pc = lane & 7;
    const bool b2 = pc & 4, b1 = pc & 2, b0 = pc & 1;
    float q8[8], q4[4], q2[2];
#pragma unroll
    for (int k = 0; k < 8; ++k) { const float keep = b2 ? p[k + 8] : p[k], send = b2 ? p[k] : p[k + 8]; q8[k] = keep + shx<4>(send, lane); }
#pragma unroll
    for (int k = 0; k < 4; ++k) { const float keep = b1 ? q8[k + 4] : q8[k], send = b1 ? q8[k] : q8[k + 4]; q4[k] = keep + shx<2>(send, lane); }
#pragma unroll
    for (int k = 0; k < 2; ++k) { const float keep = b0 ? q4[k + 2] : q4[k], send = b0 ? q4[k] : q4[k + 2]; q2[k] = keep + shx<1>(send, lane); }
    ((unsigned*)a.PD)[((size_t)s * NTOK + tok) * 64 + lane] = pack_bf2(q2[0], q2[1]);
}

DI void peerR_tile(const PSArgs& a, int tile, int wid) {
    const int tid = get_tid(wid);
    const int lane = tid & 63;
    const int tok0 = tile * 64 + wid * 8;
    int e0[8], e1[8];
#pragma unroll
    for (int ti = 0; ti < 8; ++ti) { e0[ti] = (int)a.EX[(size_t)(tok0 + ti) * 128 + lane]; e1[ti] = (int)a.EX[(size_t)(tok0 + ti) * 128 + 64 + lane]; }
#pragma unroll
    for (int hb = 0; hb < 1; ++hb) {
        float d0[8], d1[8], g0[8], g1[8], rs[8], u0[8], u1[8], v0[8], v1[8];
#pragma unroll
        for (int q = 0; q < 8; ++q) {
            const int tok = tok0 + q;
            float s0 = 0.f, s1 = 0.f;
#pragma unroll
            for (int x = 0; x < NUSL; ++x) { const unsigned short* pp = (const unsigned short*)a.PD + ((size_t)x * NTOK + tok) * 128 + lane; s0 += __uint_as_float((unsigned)pp[0] << 16); s1 += __uint_as_float((unsigned)pp[64] << 16); }
            d0[q] = s0; d1[q] = s1;
            { const unsigned short* gp = (const unsigned short*)a.GT + (size_t)tok * 128 + lane; g0[q] = __uint_as_float((unsigned)gp[0] << 16); g1[q] = __uint_as_float((unsigned)gp[64] << 16); } rs[q] = a.RSTD[tok];
            u0[q] = a.SU[e0[q]]; u1[q] = a.SU[e1[q]]; v0[q] = a.SV[e0[q]]; v1[q] = a.SV[e1[q]];
        }
#pragma unroll
        for (int q = 0; q < 8; ++q) {
            const int tok = tok0 + q;
            float2 o;
            o.x = gelu_exact(d0[q] * u0[q] * rs[q]) * g0[q] * v0[q];
            o.y = gelu_exact(d1[q] * u1[q] * rs[q]) * g1[q] * v1[q];
            float am = fmaxf(fabsf(o.x), fabsf(o.y));
            am = fmaxf(am, shx<1>(am, lane)); am = fmaxf(am, shx<2>(am, lane)); am = fmaxf(am, shx<4>(am, lane)); am = fmaxf(am, shx<8>(am, lane));
            am = fmaxf(am, shx<16>(am, lane)); am = fmaxf(am, shx<32>(am, lane));
            int ee = 0; (void)frexpf(am, &ee); ee = max(ee, -100);
            const float sc = ldexpf(1.f, 8 - ee), isc = ldexpf(1.f, ee - 8);
            const float sx = o.x * sc, sy = o.y * sc;
            int w8 = __builtin_amdgcn_cvt_pk_fp8_f32(sx, sy, 0, false);
            const float hx = __builtin_amdgcn_cvt_f32_fp8(w8, 0), hy = __builtin_amdgcn_cvt_f32_fp8(w8, 1);
            w8 = __builtin_amdgcn_cvt_pk_fp8_f32(sx - hx, sy - hy, w8, true);
            *(unsigned*)(a.COEF + (size_t)tok * 128 + 2 * lane) = (unsigned)w8;
            if (lane == 0) a.CS[tok] = isc;
        }
    }
}

struct Cf16 { u32x4 a, b; };
DI void cf_load(Cf16& q, const bf16_t* COEF, int tok, int rg) { const u32x4* p = (const u32x4*)(COEF + (size_t)tok * 128 + rg * 16); q.a = p[0]; q.b = p[1]; }
DI void final_norm_tile(const bf16_t* __restrict__ Hb, float* __restrict__ Out, const float* __restrict__ g, int tile, int wid) {
    const int tid = get_tid(wid);
    const int lane = tid & 63;
    const float* gf = g + lane * 16;
    const float4 g0 = *(const float4*)gf, g1 = *(const float4*)(gf + 4), g2 = *(const float4*)(gf + 8), g3 = *(const float4*)(gf + 12);
#pragma unroll 1
    for (int tb = 0; tb < 8; tb += 4) {
        u32x4 xv[4][2];
#pragma unroll
        for (int q = 0; q < 4; ++q) {
            const u32x4* xp = (const u32x4*)(Hb + (size_t)(tile * 64 + wid * 8 + tb + q) * DM + lane * 16);
            xv[q][0] = xp[0]; xv[q][1] = xp[1];
        }
#pragma unroll
        for (int q = 0; q < 4; ++q) {
            float* op = Out + (size_t)(tile * 64 + wid * 8 + tb + q) * DM + lane * 16;
            float4 x0 = make_float4(bf_lo(xv[q][0].x), bf_hi(xv[q][0].x), bf_lo(xv[q][0].y), bf_hi(xv[q][0].y));
            float4 x1 = make_float4(bf_lo(xv[q][0].z), bf_hi(xv[q][0].z), bf_lo(xv[q][0].w), bf_hi(xv[q][0].w));
            float4 x2 = make_float4(bf_lo(xv[q][1].x), bf_hi(xv[q][1].x), bf_lo(xv[q][1].y), bf_hi(xv[q][1].y));
            float4 x3 = make_float4(bf_lo(xv[q][1].z), bf_hi(xv[q][1].z), bf_lo(xv[q][1].w), bf_hi(xv[q][1].w));
            float ss = x0.x * x0.x + x0.y * x0.y + x0.z * x0.z + x0.w * x0.w + x1.x * x1.x + x1.y * x1.y + x1.z * x1.z + x1.w * x1.w
                     + x2.x * x2.x + x2.y * x2.y + x2.z * x2.z + x2.w * x2.w + x3.x * x3.x + x3.y * x3.y + x3.z * x3.z + x3.w * x3.w;
            ss = wave_sum(ss, lane);
            const float rf = rsqrtf(ss * (1.f / 1024.f) + 1e-6f);
            x0.x *= rf * g0.x; x0.y *= rf * g0.y; x0.z *= rf * g0.z; x0.w *= rf * g0.w; x1.x *= rf * g1.x; x1.y *= rf * g1.y; x1.z *= rf * g1.z; x1.w *= rf * g1.w;
            x2.x *= rf * g2.x; x2.y *= rf * g2.y; x2.z *= rf * g2.z; x2.w *= rf * g2.w; x3.x *= rf * g3.x; x3.y *= rf * g3.y; x3.z *= rf * g3.z; x3.w *= rf * g3.w;
            *(float4*)op = x0; *(float4*)(op + 4) = x1; *(float4*)(op + 8) = x2; *(float4*)(op + 12) = x3;
        }
    }
}

typedef unsigned char fp4x2_t;
DI void conv_row_fp4_one(float4 v0, float4 v1, float4 v2, float4 v3, fp4x2_t* __restrict__ dst, float* __restrict__ scales, int nrows, int row, int lane) {
    float m = fmaxf(fmaxf(fmaxf(fabsf(v0.x), fabsf(v0.y)), fmaxf(fabsf(v0.z), fabsf(v0.w))), fmaxf(fmaxf(fabsf(v1.x), fabsf(v1.y)), fmaxf(fabsf(v1.z), fabsf(v1.w))));
    m = fmaxf(m, fmaxf(fmaxf(fmaxf(fabsf(v2.x), fabsf(v2.y)), fmaxf(fabsf(v2.z), fabsf(v2.w))), fmaxf(fmaxf(fabsf(v3.x), fabsf(v3.y)), fmaxf(fabsf(v3.z), fabsf(v3.w)))));
    m = fmaxf(m, shx<1>(m, lane)); m = fmaxf(m, shx<2>(m, lane)); m = fmaxf(m, shx<4>(m, lane)); m = fmaxf(m, shx<8>(m, lane)); m = fmaxf(m, shx<16>(m, lane)); m = fmaxf(m, shx<32>(m, lane));
    const float sc = (m > 0.f) ? m * (1.f / 6.f) : 1.f;
    const float inv = 1.f / sc;
#if V_MFMA
    const int p = lane & 15;
    const float w[16] = {v0.x * inv, v0.y * inv, v0.z * inv, v0.w * inv, v1.x * inv, v1.y * inv, v1.z * inv, v1.w * inv,
                         v2.x * inv, v2.y * inv, v2.z * inv, v2.w * inv, v3.x * inv, v3.y * inv, v3.z * inv, v3.w * inv};
    fp4x2_t* rowp = dst + ((size_t)(lane >> 4) * nrows + row) * 128 + (4 * (p >> 2)) * 8 + 2 * (p & 3);
#pragma unroll
    for (int b = 0; b < 4; ++b) {
        unsigned d = 0u;
        d = __builtin_amdgcn_cvt_scalef32_pk_fp4_f32(d, w[b], w[b + 4], 1.0f, 0);
        d = __builtin_amdgcn_cvt_scalef32_pk_fp4_f32(d, w[b + 8], w[b + 12], 1.0f, 1);
        *(unsigned short*)(rowp + b * 8) = (unsigned short)d;
    }
#else
    unsigned d0 = 0u, d1 = 0u;
    d0 = __builtin_amdgcn_cvt_scalef32_pk_fp4_f32(d0, v0.x * inv, v0.y * inv, 1.0f, 0); d0 = __builtin_amdgcn_cvt_scalef32_pk_fp4_f32(d0, v0.z * inv, v0.w * inv, 1.0f, 1);
    d0 = __builtin_amdgcn_cvt_scalef32_pk_fp4_f32(d0, v1.x * inv, v1.y * inv, 1.0f, 2); d0 = __builtin_amdgcn_cvt_scalef32_pk_fp4_f32(d0, v1.z * inv, v1.w * inv, 1.0f, 3);
    d1 = __builtin_amdgcn_cvt_scalef32_pk_fp4_f32(d1, v2.x * inv, v2.y * inv, 1.0f, 0); d1 = __builtin_amdgcn_cvt_scalef32_pk_fp4_f32(d1, v2.z * inv, v2.w * inv, 1.0f, 1);
    d1 = __builtin_amdgcn_cvt_scalef32_pk_fp4_f32(d1, v3.x * inv, v3.y * inv, 1.0f, 2); d1 = __builtin_amdgcn_cvt_scalef32_pk_fp4_f32(d1, v3.z * inv, v3.w * inv, 1.0f, 3);
    *(uint2*)(dst + ((size_t)(lane >> 4) * nrows + row) * 128 + (lane & 15) * 8) = make_uint2(d0, d1);
#endif
    if (lane == 0) scales[row] = sc;
}
DI void conv_rows_fp4(const float* __restrict__ src, fp4x2_t* __restrict__ dst, float* __restrict__ scales, int nrows, int gwave, int nwaves, int lane) {
#pragma unroll 1
    for (int row = gwave; row < nrows; row += 2 * nwaves) {
        const int r1 = min(row + nwaves, nrows - 1);
        const float4* p0 = (const float4*)(src + (size_t)row * DM + lane * 16);
        const float4* p1 = (const float4*)(src + (size_t)r1 * DM + lane * 16);
        const float4 a0 = p0[0], a1 = p0[1], a2 = p0[2], a3 = p0[3];
        const float4 b0 = p1[0], b1 = p1[1], b2 = p1[2], b3 = p1[3];
        conv_row_fp4_one(a0, a1, a2, a3, dst, scales, nrows, row, lane);
        conv_row_fp4_one(b0, b1, b2, b3, dst, scales, nrows, r1, lane);
    }
}

typedef __attribute__((ext_vector_type(2))) _Float16 h2_t;
DI h2_t cvt4(unsigned w, int b) {
    return b == 0 ? __builtin_amdgcn_cvt_scalef32_pk_f16_fp4(w, 1.0f, 0) : b == 1 ? __builtin_amdgcn_cvt_scalef32_pk_f16_fp4(w, 1.0f, 1)
         : b == 2 ? __builtin_amdgcn_cvt_scalef32_pk_f16_fp4(w, 1.0f, 2) : __builtin_amdgcn_cvt_scalef32_pk_f16_fp4(w, 1.0f, 3);
}
DI void row_axpy32h(h2_t (&acc)[16], const u32x4& r, float c) {
    const _Float16 ch = (_Float16)c; const h2_t c2 = {ch, ch};
#pragma unroll
    for (int b = 0; b < 4; ++b) {
        acc[b] = __builtin_elementwise_fma(c2, cvt4(r.x, b), acc[b]); acc[4 + b] = __builtin_elementwise_fma(c2, cvt4(r.y, b), acc[4 + b]);
        acc[8 + b] = __builtin_elementwise_fma(c2, cvt4(r.z, b), acc[8 + b]); acc[12 + b] = __builtin_elementwise_fma(c2, cvt4(r.w, b), acc[12 + b]);
    }
}
DI void axpy8_4(h2_t (&acc)[16], const u32x4 (&r)[8], const u32x4& c) {
    row_axpy32h(acc, r[0], bf_lo(c.x)); row_axpy32h(acc, r[1], bf_hi(c.x)); row_axpy32h(acc, r[2], bf_lo(c.y)); row_axpy32h(acc, r[3], bf_hi(c.y));
    __builtin_amdgcn_sched_barrier(0);
    row_axpy32h(acc, r[4], bf_lo(c.z)); row_axpy32h(acc, r[5], bf_hi(c.z)); row_axpy32h(acc, r[6], bf_lo(c.w)); row_axpy32h(acc, r[7], bf_hi(c.w));
    __builtin_amdgcn_sched_barrier(0);
}
typedef __attribute__((ext_vector_type(2))) unsigned u32x2_t;
DI h2_t pairsum32(h2_t x, h2_t y) { auto r = __builtin_amdgcn_permlane32_swap(__builtin_bit_cast(unsigned, x), __builtin_bit_cast(unsigned, y), false, false);
                                   return __builtin_bit_cast(h2_t, (unsigned)r[0]) + __builtin_bit_cast(h2_t, (unsigned)r[1]); }
DI h2_t pairsum16(h2_t x, h2_t y) { auto r = __builtin_amdgcn_permlane16_swap(__builtin_bit_cast(unsigned, x), __builtin_bit_cast(unsigned, y), false, false);
                                   return __builtin_bit_cast(h2_t, (unsigned)r[0]) + __builtin_bit_cast(h2_t, (unsigned)r[1]); }
DI h2_t pairsum8(h2_t x, h2_t y, bool hi) {
    const h2_t keep = hi ? y : x, send = hi ? x : y;
    const int rcv = __builtin_amdgcn_update_dpp(0, __builtin_bit_cast(int, send), 0x128, 0xF, 0xF, true);
    return keep + __builtin_bit_cast(h2_t, rcv);
}
DI void peerV4_finish(const PSArgs& a, h2_t (&acc)[16], float4 xv, int tok, int s4, int lane) {
    const int rg = lane >> 3, pc = lane & 7;
    h2_t q8[8], q4[4], q2[2];
#pragma unroll
    for (int k = 0; k < 8; ++k) q8[k] = pairsum32(acc[k], acc[k + 8]);
#pragma unroll
    for (int k = 0; k < 4; ++k) q4[k] = pairsum16(q8[k], q8[k + 4]);
#pragma unroll
    for (int k = 0; k < 2; ++k) q2[k] = pairsum8(q4[k], q4[k + 2], (rg & 1) != 0);
    xv.x += (float)q2[0].x; xv.y += (float)q2[0].y; xv.z += (float)q2[1].x; xv.w += (float)q2[1].y;
    *(float4*)(a.Xout + (size_t)tok * DM + s4 * 256 + 32 * pc + 4 * rg) = xv;
}
DI int run_token2(int n, int k, int nloc, int wid, int th) { return (2 * (k + (n >> 3) * nloc) + th) * 64 + wid * 8 + (n & 7); }

DI void peerV4_run(const PSArgs& a, const fp4x2_t* V4, int s4, int th, int k, int nloc, int wid) {
    const int tid = get_tid(wid);
    const int lane = tid & 63, rg = lane >> 3, pc = lane & 7;
    const unsigned loff = (unsigned)(s4 * (NEXP * 128) + pc * 16);
    const int N = 8 * ((NTOK / 128 - k + nloc - 1) / nloc);
    if (N <= 0) return;
    Ids16 idE, idO; Cf16 cfE, cfO; float4 xE, xO;
    u32x4 rA[8], rB[8];
    const fp8_t* tab = (const fp8_t*)V4;
#define LOAD_X4(x_, tokv) { x_ = *(const float4*)(a.Xin + (size_t)(tokv) * DM + s4 * 256 + 32 * pc + 4 * rg); }
    ids_load(idE, a.EX, run_token2(0, k, nloc, wid, th), rg);
    ids_load(idO, a.EX, run_token2(1, k, nloc, wid, th), rg);
    rows_lo(rA, idE, tab, loff); cf_load(cfE, a.COEF, run_token2(0, k, nloc, wid, th), rg); rows_hi(rB, idE, tab, loff); LOAD_X4(xE, run_token2(0, k, nloc, wid, th));
#pragma unroll 1
    for (int n = 0; n < N; n += 2) {
        const int t0 = run_token2(n, k, nloc, wid, th), t1 = run_token2(n + 1, k, nloc, wid, th);
        const int t2 = run_token2((n + 2 < N) ? n + 2 : N - 1, k, nloc, wid, th), t3 = run_token2((n + 3 < N) ? n + 3 : N - 1, k, nloc, wid, th);
        {
            h2_t acc[16];
#pragma unroll
            for (int i = 0; i < 16; ++i) acc[i] = (h2_t){(_Float16)0.f, (_Float16)0.f};
            axpy8_4(acc, rA, cfE.a);
            rows_lo(rA, idO, tab, loff); cf_load(cfO, a.COEF, t1, rg);
            axpy8_4(acc, rB, cfE.b);
            rows_hi(rB, idO, tab, loff); LOAD_X4(xO, t1);
            ids_load(idE, a.EX, t2, rg);
            peerV4_finish(a, acc, xE, t0, s4, lane);
        }
        {
            h2_t acc[16];
#pragma unroll
            for (int i = 0; i < 16; ++i) acc[i] = (h2_t){(_Float16)0.f, (_Float16)0.f};
            axpy8_4(acc, rA, cfO.a);
            rows_lo(rA, idE, tab, loff); cf_load(cfE, a.COEF, t2, rg);
            axpy8_4(acc, rB, cfO.b);
            rows_hi(rB, idE, tab, loff); LOAD_X4(xE, t2);
            ids_load(idO, a.EX, t3, rg);
            peerV4_finish(a, acc, xO, t1, s4, lane);
        }
    }
#undef LOAD_X4
}

typedef __attribute__((ext_vector_type(8))) int i32x8;
typedef const __attribute__((address_space(1))) u32x2_t* grow8_t;
#define MFMA_F4F8(A_, B_, C_) __builtin_amdgcn_mfma_scale_f32_16x16x128_f8f6f4(A_, B_, C_, 4, 0, 0, 0x7F7F7F7F, 0, 0x7F7F7F7F)
template <int S> DI unsigned rowbc(unsigned v) { return (unsigned)__builtin_amdgcn_update_dpp(0, (int)v, 0x150 + S, 0xF, 0xF, true); }
template <int S> DI u32x4 vm_row1(unsigned idp, unsigned idsh, const fp8_t* tab, unsigned loff) {
    const unsigned w = rowbc<S>(idp);
    return *(grow_t)(tab + (__builtin_amdgcn_ubfe(w, idsh, 16) * 128u + loff));
}
template <int H> DI void vm_rows(u32x4 (&r)[8], unsigned idp, unsigned idsh, const fp8_t* tab, unsigned loff) {
    r[0] = vm_row1<H + 0>(idp, idsh, tab, loff); r[1] = vm_row1<H + 1>(idp, idsh, tab, loff); r[2] = vm_row1<H + 2>(idp, idsh, tab, loff); r[3] = vm_row1<H + 3>(idp, idsh, tab, loff);
    r[4] = vm_row1<H + 4>(idp, idsh, tab, loff); r[5] = vm_row1<H + 5>(idp, idsh, tab, loff); r[6] = vm_row1<H + 6>(idp, idsh, tab, loff); r[7] = vm_row1<H + 7>(idp, idsh, tab, loff);
}
#define VM_NSEL (V_LO ? 16 : 8)
#ifndef VM_PROBE_NOMFMA
#define VM_PROBE_NOMFMA 0
#endif
template <int S> DI void vm_step(f32x4& accH, f32x4& accL, const u32x4& row, unsigned cfw, const unsigned (&sel)[VM_NSEL]) {
    unsigned cw = rowbc<S>(cfw);
    asm volatile("" : "+v"(cw));
    int A0, A1, A2, A3;
    asm volatile("s_mov_b64 vcc, %8\n\ts_nop 1\n\t"
                 "v_cndmask_b32_dpp %0, %6, %4, vcc quad_perm:[1,0,3,2] row_mask:0xf bank_mask:0xf\n\t"
                 "v_cndmask_b32_dpp %1, %7, %5, vcc quad_perm:[1,0,3,2] row_mask:0xf bank_mask:0xf\n\t"
                 "s_not_b64 vcc, vcc\n\t"
                 "v_cndmask_b32_dpp %2, %4, %6, vcc quad_perm:[1,0,3,2] row_mask:0xf bank_mask:0xf\n\t"
                 "v_cndmask_b32_dpp %3, %5, %7, vcc quad_perm:[1,0,3,2] row_mask:0xf bank_mask:0xf\n\ts_nop 1"
                 : "=&v"(A0), "=&v"(A1), "=&v"(A2), "=&v"(A3)
                 : "v"(row.x), "v"(row.y), "v"(row.z), "v"(row.w), "s"(0x5555555555555555ull)
                 : "vcc");
    const i32x8 A = {A0, A1, A2, A3, 0, 0, 0, 0};
    const i32x8 Bh = {(int)__builtin_amdgcn_perm(cw, cw, sel[0]), (int)__builtin_amdgcn_perm(cw, cw, sel[1]), (int)__builtin_amdgcn_perm(cw, cw, sel[2]), (int)__builtin_amdgcn_perm(cw, cw, sel[3]),
                      (int)__builtin_amdgcn_perm(cw, cw, sel[4]), (int)__builtin_amdgcn_perm(cw, cw, sel[5]), (int)__builtin_amdgcn_perm(cw, cw, sel[6]), (int)__builtin_amdgcn_perm(cw, cw, sel[7])};
    accH = MFMA_F4F8(A, Bh, accH);
#if V_LO
    const i32x8 Bl = {(int)__builtin_amdgcn_perm(cw, cw, sel[8]), (int)__builtin_amdgcn_perm(cw, cw, sel[9]), (int)__builtin_amdgcn_perm(cw, cw, sel[10]), (int)__builtin_amdgcn_perm(cw, cw, sel[11]),
                      (int)__builtin_amdgcn_perm(cw, cw, sel[12]), (int)__builtin_amdgcn_perm(cw, cw, sel[13]), (int)__builtin_amdgcn_perm(cw, cw, sel[14]), (int)__builtin_amdgcn_perm(cw, cw, sel[15])};
    accL = MFMA_F4F8(A, Bl, accL);
#endif
}
template <int H> DI void vm_half(f32x4& accH, f32x4& accL, const u32x4 (&r)[8], unsigned cfw, const unsigned (&sel)[VM_NSEL]) {
    vm_step<H + 0>(accH, accL, r[0], cfw, sel); vm_step<H + 1>(accH, accL, r[1], cfw, sel); __builtin_amdgcn_sched_barrier(0);
    vm_step<H + 2>(accH, accL, r[2], cfw, sel); vm_step<H + 3>(accH, accL, r[3], cfw, sel); __builtin_amdgcn_sched_barrier(0);
    vm_step<H + 4>(accH, accL, r[4], cfw, sel); vm_step<H + 5>(accH, accL, r[5], cfw, sel); __builtin_amdgcn_sched_barrier(0);
    vm_step<H + 6>(accH, accL, r[6], cfw, sel); vm_step<H + 7>(accH, accL, r[7], cfw, sel); __builtin_amdgcn_sched_barrier(0);
}
template <bool DRY> DI void vm_finish(const PSArgs& a, const f32x4& accH, const f32x4& accL, uint2 xb, float cs, int tok, int s4, int lane) {
    float4 xv = make_float4(bf_lo(xb.x), bf_hi(xb.x), bf_lo(xb.y), bf_hi(xb.y));
    xv.x += (accH[0] + accL[0]) * cs; xv.y += (accH[1] + accL[1]) * cs; xv.z += (accH[2] + accL[2]) * cs; xv.w += (accH[3] + accL[3]) * cs;
    uint2 p; p.x = pack_bf2(xv.x, xv.y); p.y = pack_bf2(xv.z, xv.w);
    *(uint2*)(a.Hb + (size_t)tok * DM + s4 * 256 + 64 * (lane >> 4) + 4 * (lane & 15)) = p;
}
template <bool DRY> DI void peerVm_run(const PSArgs& a, const fp4x2_t* V4, int s4, int th, int k, int nloc, int wid) {
    const int tid = get_tid(wid);
    const int lane = tid & 63, kq = lane >> 4, m = lane & 15;
    const unsigned loff = (unsigned)(s4 * (NEXP * 128) + (m >> 1) * 16);
    const bool odd = (m & 1) != 0;
    unsigned sel[VM_NSEL];
#pragma unroll
    for (int j = 0; j < VM_NSEL / 4; ++j)
#pragma unroll
        for (int d = 0; d < 4; ++d) sel[4 * j + d] = ((m >> 2) == d) ? ((0x0C0C0C0Cu & ~(0xFFu << (8 * (m & 3)))) | ((unsigned)j << (8 * (m & 3)))) : 0x0C0C0C0Cu;
    const int N = 8 * ((NTOK / 128 - k + nloc - 1) / nloc);
    if (N <= 0) return;
    unsigned ilE, ihE, ilO, ihO, cfE, cfO; uint2 xE, xO; float sE, sO;
    u32x4 rEA[8], rEB[8], rOA[8], rOB[8];
    const unsigned idsh = odd ? 16u : 0u;
    const fp8_t* tab = (const fp8_t*)V4;
#define LOAD_X4(x_, tokv) { x_ = *(const uint2*)(a.Hb + (size_t)(tokv) * DM + s4 * 256 + 64 * kq + 4 * m); }
#define TOKN(nn) run_token2(((nn) < N) ? (nn) : N - 1, k, nloc, wid, th)
#define IDP_LOAD(lo_, hi_, t_) { const unsigned* ep_ = (const unsigned*)(a.EX + (size_t)(t_) * 128 + 32 * kq + (m & ~1)); lo_ = ep_[0]; hi_ = ep_[8]; }
#define CFW_LOAD(d_, t_) { d_ = *(const unsigned*)(a.COEF + (size_t)(t_) * 128 + 2 * lane); }
#define IDP_USE(lo_, hi_) ({ asm volatile("" : "+v"(lo_), "+v"(hi_)); (__builtin_amdgcn_ubfe(lo_, idsh, 16) | (__builtin_amdgcn_ubfe(hi_, idsh, 16) << 16)); })
#define VT_FILL(rA_, rB_, lo_, hi_, cf_, x_, s_, tn_, tn2_) { \
        const unsigned idp_ = IDP_USE(lo_, hi_); \
        vm_rows<0>(rA_, idp_, idsh, tab, loff); CFW_LOAD(cf_, tn_); vm_rows<8>(rB_, idp_, idsh, tab, loff); \
        LOAD_X4(x_, tn_); s_ = a.CS[tn_]; IDP_LOAD(lo_, hi_, tn2_); __builtin_amdgcn_sched_barrier(0); }
#define VT_BLOCK(rA_, rB_, lo_, hi_, cf_, x_, s_, tc_, tn_, tn2_) { \
        f32x4 aH = {0.f, 0.f, 0.f, 0.f}, aL = {0.f, 0.f, 0.f, 0.f}; asm volatile("" : "+v"(aH), "+v"(aL), "+v"(cf_));      \
        vm_half<0>(aH, aL, rA_, cf_, sel); asm volatile("" : "+v"(aH), "+v"(aL)); __builtin_amdgcn_sched_barrier(0); \
        const unsigned idp_ = IDP_USE(lo_, hi_); \
        vm_rows<0>(rA_, idp_, idsh, tab, loff); __builtin_amdgcn_sched_barrier(0); \
        asm volatile("" : "+v"(cf_)); \
        vm_half<8>(aH, aL, rB_, cf_, sel); asm volatile("" : "+v"(aH), "+v"(aL)); __builtin_amdgcn_sched_barrier(0); \
        CFW_LOAD(cf_, tn_); vm_rows<8>(rB_, idp_, idsh, tab, loff); __builtin_amdgcn_sched_barrier(0); \
        vm_finish<DRY>(a, aH, aL, x_, s_, tc_, s4, lane); __builtin_amdgcn_sched_barrier(0); \
        LOAD_X4(x_, tn_); s_ = a.CS[tn_]; IDP_LOAD(lo_, hi_, tn2_); __builtin_amdgcn_sched_barrier(0); }
    {
        const int t0 = TOKN(0), t1 = TOKN(1);
        IDP_LOAD(ilE, ihE, t0); IDP_LOAD(ilO, ihO, t1);
        __builtin_amdgcn_sched_barrier(0);
        VT_FILL(rEA, rEB, ilE, ihE, cfE, xE, sE, t0, TOKN(2));
        VT_FILL(rOA, rOB, ilO, ihO, cfO, xO, sO, t1, TOKN(3));
    }
#pragma unroll 1
    for (int n = 0; n < N; n += 2) {
        VT_BLOCK(rEA, rEB, ilE, ihE, cfE, xE, sE, TOKN(n), TOKN(n + 2), TOKN(n + 4));
        VT_BLOCK(rOA, rOB, ilO, ihO, cfO, xO, sO, TOKN(n + 1), TOKN(n + 3), TOKN(n + 5));
    }
#undef VT_BLOCK
#undef VT_FILL
#undef IDP_USE
#undef CFW_LOAD
#undef IDP_LOAD
#undef TOKN
#undef LOAD_X4
}


DI unsigned pack_i4x8(const float (&v)[8], float inv) {
    unsigned r = 0u;
#pragma unroll
    for (int i = 0; i < 4; ++i) {
        const int a = (int)fminf(fmaxf(rintf(v[i] * inv), -7.f), 7.f), b = (int)fminf(fmaxf(rintf(v[4 + i] * inv), -7.f), 7.f);
        r |= ((unsigned)a & 15u) << (8 * i); r |= ((unsigned)b & 15u) << (8 * i + 4);
    }
    return r;
}
DI void conv_rows_int4g(const float* __restrict__ src, const float* __restrict__ gain, fp4x2_t* __restrict__ dst, float* __restrict__ scales,
                        int nrows, int gwave, int nwaves, int lane) {
    const float4* g = (const float4*)(gain + lane * 16);
    const float4 g0 = g[0], g1 = g[1], g2 = g[2], g3 = g[3];
#pragma unroll 1
    for (int row = gwave; row < nrows; row += nwaves) {
        const float4* p0 = (const float4*)(src + (size_t)row * DM + lane * 16);
        const float4 a0 = p0[0], a1 = p0[1], a2 = p0[2], a3 = p0[3];
        const float v0[8] = {a0.x * g0.x, a0.y * g0.y, a0.z * g0.z, a0.w * g0.w, a1.x * g1.x, a1.y * g1.y, a1.z * g1.z, a1.w * g1.w};
        const float v1[8] = {a2.x * g2.x, a2.y * g2.y, a2.z * g2.z, a2.w * g2.w, a3.x * g3.x, a3.y * g3.y, a3.z * g3.z, a3.w * g3.w};
        float ss = 0.f;
#pragma unroll
        for (int i = 0; i < 8; ++i) ss += v0[i] * v0[i] + v1[i] * v1[i];
        ss = wave_sum(ss, lane);
        const float rms = sqrtf(ss * (1.f / 1024.f));
        const float step = (rms > 0.f) ? 0.36f * rms : 1.f, inv = 1.f / step;
        *(uint2*)(dst + ((size_t)(lane >> 4) * nrows + row) * 128 + (lane & 15) * 8) = make_uint2(pack_i4x8(v0, inv), pack_i4x8(v1, inv));
        if (lane == 0) scales[row] = step;
    }
}
struct HP8 { u32x4 h, l; float sh; };
DI void hp_load(HP8& q, const PSArgs& a, int tok, int s4, int pc) {
    q.h = *(const u32x4*)(a.HPH + (size_t)tok * 128 + s4 * 32 + pc * 4); q.l = *(const u32x4*)(a.HPL + (size_t)tok * 128 + s4 * 32 + pc * 4);
    q.sh = a.HS[(size_t)tok * 4 + s4];
}
DI float row_dot32q(const u32x4& r, const HP8& q) {
    int ah = 0, al = 0;
    ah = __builtin_amdgcn_sdot8((int)r.x, (int)q.h.x, ah, false); al = __builtin_amdgcn_sdot8((int)r.x, (int)q.l.x, al, false);
    ah = __builtin_amdgcn_sdot8((int)r.y, (int)q.h.y, ah, false); al = __builtin_amdgcn_sdot8((int)r.y, (int)q.l.y, al, false);
    ah = __builtin_amdgcn_sdot8((int)r.z, (int)q.h.z, ah, false); al = __builtin_amdgcn_sdot8((int)r.z, (int)q.l.z, al, false);
    ah = __builtin_amdgcn_sdot8((int)r.w, (int)q.h.w, ah, false); al = __builtin_amdgcn_sdot8((int)r.w, (int)q.l.w, al, false);
    return (float)(ah * 16 + al) * q.sh;
}
DI void peerUi_run(const PSArgs& a, const fp4x2_t* U4, int s4, int th, int k, int nloc, int wid) {
    const int tid = get_tid(wid);
    const int lane = tid & 63, rg = lane >> 3, pc = lane & 7;
    const unsigned loff = (unsigned)(s4 * (NEXP * 128) + pc * 16);
    const int N = 8 * ((NTOK / 128 - k + nloc - 1) / nloc);
    if (N <= 0) return;
    Ids16 idE, idO; HP8 hE, hO;
    u32x4 rEA[8], rEB[8], rOA[8], rOB[8];
    const fp8_t* tab = (const fp8_t*)U4;
#define TOKN(nn) run_token2(((nn) < N) ? (nn) : N - 1, k, nloc, wid, th)
#define UT_FILL(rA_, rB_, id_, h_, tn_, tn2_) { \
        asm volatile("" : "+v"(id_.a), "+v"(id_.b)); \
        rows_lo(rA_, id_, tab, loff); rows_hi(rB_, id_, tab, loff); hp_load(h_, a, tn_, s4, pc); ids_load(id_, a.EX, tn2_, rg); __builtin_amdgcn_sched_barrier(0); }
#define UT_BLOCK(rA_, rB_, id_, h_, tc_, tn_, tn2_) { \
        float p[16]; \
        asm volatile("" : "+v"(h_.h), "+v"(h_.l), "+v"(h_.sh));        \
        _Pragma("unroll") for (int i = 0; i < 8; ++i) p[i] = row_dot32q(rA_[i], h_); \
        asm volatile("" : "+v"(p[0]), "+v"(p[1]), "+v"(p[2]), "+v"(p[3]), "+v"(p[4]), "+v"(p[5]), "+v"(p[6]), "+v"(p[7])); __builtin_amdgcn_sched_barrier(0); \
        asm volatile("" : "+v"(id_.a), "+v"(id_.b)); \
        rows_lo(rA_, id_, tab, loff); __builtin_amdgcn_sched_barrier(0); \
        _Pragma("unroll") for (int i = 0; i < 8; ++i) p[8 + i] = row_dot32q(rB_[i], h_); \
        asm volatile("" : "+v"(p[8]), "+v"(p[9]), "+v"(p[10]), "+v"(p[11]), "+v"(p[12]), "+v"(p[13]), "+v"(p[14]), "+v"(p[15])); __builtin_amdgcn_sched_barrier(0); \
        rows_hi(rB_, id_, tab, loff); hp_load(h_, a, tn_, s4, pc); __builtin_amdgcn_sched_barrier(0); \
        peerU_finish(a, p, tc_, s4, lane); __builtin_amdgcn_sched_barrier(0); \
        ids_load(id_, a.EX, tn2_, rg); __builtin_amdgcn_sched_barrier(0); }
    {
        ids_load(idE, a.EX, TOKN(0), rg); ids_load(idO, a.EX, TOKN(1), rg);
        __builtin_amdgcn_sched_barrier(0);
        UT_FILL(rEA, rEB, idE, hE, TOKN(0), TOKN(2));
        UT_FILL(rOA, rOB, idO, hO, TOKN(1), TOKN(3));
    }
#pragma unroll 1
    for (int n = 0; n < N; n += 2) {
        UT_BLOCK(rEA, rEB, idE, hE, TOKN(n), TOKN(n + 2), TOKN(n + 4));
        UT_BLOCK(rOA, rOB, idO, hO, TOKN(n + 1), TOKN(n + 3), TOKN(n + 5));
    }
#undef UT_BLOCK
#undef UT_FILL
#undef TOKN
}

DI void conv_batch_v(const float* __restrict__ src, fp4x2_t* __restrict__ dst, float* __restrict__ scales, int r0, int lane) {
#pragma unroll 1
    for (int row = r0; row < r0 + 32; row += 2) {
        const float4* p0 = (const float4*)(src + (size_t)row * DM + lane * 16);
        const float4* p1 = (const float4*)(src + (size_t)(row + 1) * DM + lane * 16);
        const float4 a0 = p0[0], a1 = p0[1], a2 = p0[2], a3 = p0[3];
        const float4 b0 = p1[0], b1 = p1[1], b2 = p1[2], b3 = p1[3];
        conv_row_fp4_one(a0, a1, a2, a3, dst, scales, NEXP, row, lane);
        conv_row_fp4_one(b0, b1, b2, b3, dst, scales, NEXP, row + 1, lane);
    }
}
DI void conv_row_int4_one(float4 a0, float4 a1, float4 a2, float4 a3, const float4& g0, const float4& g1, const float4& g2, const float4& g3,
                          fp4x2_t* __restrict__ dst, float* __restrict__ scales, int row, int lane) {
    const float v0[8] = {a0.x * g0.x, a0.y * g0.y, a0.z * g0.z, a0.w * g0.w, a1.x * g1.x, a1.y * g1.y, a1.z * g1.z, a1.w * g1.w};
    const float v1[8] = {a2.x * g2.x, a2.y * g2.y, a2.z * g2.z, a2.w * g2.w, a3.x * g3.x, a3.y * g3.y, a3.z * g3.z, a3.w * g3.w};
    float ss = 0.f;
#pragma unroll
    for (int i = 0; i < 8; ++i) ss += v0[i] * v0[i] + v1[i] * v1[i];
    ss = wave_sum(ss, lane);
    const float rms = sqrtf(ss * (1.f / 1024.f));
    const float step = (rms > 0.f) ? 0.36f * rms : 1.f, inv = 1.f / step;
    *(uint2*)(dst + ((size_t)(lane >> 4) * NEXP + row) * 128 + (lane & 15) * 8) = make_uint2(pack_i4x8(v0, inv), pack_i4x8(v1, inv));
    if (lane == 0) scales[row] = step;
}
DI void conv_batch_u(const float* __restrict__ src, const float* __restrict__ gain, fp4x2_t* __restrict__ dst, float* __restrict__ scales, int r0, int lane) {
    const float4* g = (const float4*)(gain + lane * 16);
    const float4 g0 = g[0], g1 = g[1], g2 = g[2], g3 = g[3];
#pragma unroll 1
    for (int row = r0; row < r0 + 32; row += 2) {
        const float4* p0 = (const float4*)(src + (size_t)row * DM + lane * 16);
        const float4* p1 = (const float4*)(src + (size_t)(row + 1) * DM + lane * 16);
        const float4 a0 = p0[0], a1 = p0[1], a2 = p0[2], a3 = p0[3];
        const float4 b0 = p1[0], b1 = p1[1], b2 = p1[2], b3 = p1[3];
        conv_row_int4_one(a0, a1, a2, a3, g0, g1, g2, g3, dst, scales, row, lane);
        conv_row_int4_one(b0, b1, b2, b3, g0, g1, g2, g3, dst, scales, row + 1, lane);
    }
}
DI void conv_rows_u(const float* __restrict__ src, const float* __restrict__ gain, fp4x2_t* __restrict__ dst, float* __restrict__ scales, int r0, int n, int lane) {
    const float4* g = (const float4*)(gain + lane * 16);
    const float4 g0 = g[0], g1 = g[1], g2 = g[2], g3 = g[3];
#pragma unroll 1
    for (int row = r0; row < r0 + n; row += 4) {
        float4 v[4][4];
#pragma unroll
        for (int q = 0; q < 4; ++q) { const float4* pq = (const float4*)(src + (size_t)(row + q) * DM + lane * 16); v[q][0] = pq[0]; v[q][1] = pq[1]; v[q][2] = pq[2]; v[q][3] = pq[3]; }
#pragma unroll
        for (int q = 0; q < 4; ++q) conv_row_int4_one(v[q][0], v[q][1], v[q][2], v[q][3], g0, g1, g2, g3, dst, scales, row + q, lane);
    }
}
DI void conv_rows_v(const float* __restrict__ src, fp4x2_t* __restrict__ dst, float* __restrict__ scales, int r0, int n, int lane) {
#pragma unroll 1
    for (int row = r0; row < r0 + n; row += 4) {
        float4 v[4][4];
#pragma unroll
        for (int q = 0; q < 4; ++q) { const float4* pq = (const float4*)(src + (size_t)(row + q) * DM + lane * 16); v[q][0] = pq[0]; v[q][1] = pq[1]; v[q][2] = pq[2]; v[q][3] = pq[3]; }
#pragma unroll
        for (int q = 0; q < 4; ++q) conv_row_fp4_one(v[q][0], v[q][1], v[q][2], v[q][3], dst, scales, NEXP, row + q, lane);
    }
}
struct MegaArgs {
    const float* x; const float* a_re; const float* a_im; const float* log_dt; const float* b_re; const float* b_im; const float* c_re;
    const float* c_im; const float* d_skip; const float* b_glu; const float* pool_scale; const float* u_exp; const float* v_exp;
    const float* norm_final;
    PrepW pw;
    float* X; bf16_t* U; bf16_t* YPRE; bf16_t* G1; bf16_t* A2; bf16_t* Hb; bf16_t* Qb; unsigned short* EX; float* GT; float* RSTD;
    char* KT; bf16x8* WST; bf16x8* CCAR; float* ABT; fp4x2_t* U4; fp4x2_t* V4; float* SU; float* SV; float* PD; bf16_t* COEF; float* CS; unsigned* HPH; unsigned* HPL; float* HS;
    unsigned* bar;
    int coop_probe; int pad_;
};

#ifndef REP_S5
#define REP_S5 1
#endif
#ifndef REP_PW
#define REP_PW 1
#endif
#ifndef REP_P0
#define REP_P0 1
#endif
#ifndef REP_PA
#define REP_PA 1
#endif
#ifndef REP_PB
#define REP_PB 1
#endif
#ifndef REP_C1
#define REP_C1 1
#endif
#ifndef REP_C2
#define REP_C2 1
#endif
#ifndef REP_U
#define REP_U 1
#endif
#ifndef REP_R
#define REP_R 1
#endif
#if V_MFMA
#define PEERV_RUN peerVm_run<false>
#define PEERV_DRY peerVm_run<true>
#else
#define PEERV_RUN peerV4_run
#define PEERV_DRY peerV4_run
#endif
#ifdef REP_V_DRY
#define PEERV_REP PEERV_DRY
#else
#define PEERV_REP PEERV_RUN
#endif
#ifndef REP_V
#define REP_V 1
#endif
#ifndef REP_BAR
#define REP_BAR 1
#endif
#define EXPERT_SHARE(tb_) do { const int l_ = (tb_) >> 1, lane_ = get_tid(wid) & 63; \
        for (int r0_ = ((int)blockIdx.x * 8 + wid) * 8; r0_ < NEXP; r0_ += nblk * 64) { \
            if ((tb_) & 1) conv_rows_v(a.v_exp + (size_t)l_ * NEXP * DM, a.V4 + (size_t)l_ * NEXP * (DM / 2), a.SV + l_ * NEXP, r0_, 8, lane_); \
            else conv_rows_u(a.u_exp + (size_t)l_ * NEXP * DM, a.pw.norm_ffn + l_ * DM, a.U4 + (size_t)l_ * NEXP * (DM / 2), a.SU + l_ * NEXP, r0_, 8, lane_); } } while (0)
#define XBAR(acq_) do { for (int rb_ = 0; rb_ < REP_BAR; ++rb_) xcd_barrier<acq_>(xb, wid); } while (0)
__global__ void __launch_bounds__(NTHR) mega_kernel(MegaArgs a) {
    __shared__ __attribute__((aligned(16))) char smem[(PB_BYTES > PC_IMGHI + 4 * SA_BYTES) ? PB_BYTES : PC_IMGHI + 4 * SA_BYTES];
    __shared__ uint4 xb_words;
    cg::grid_group grid = cg::this_grid();
    const int nblk = gridDim.x;
    const int wid = __builtin_amdgcn_readfirstlane(threadIdx.x >> 6);
    if (get_tid(wid) == 0) xb_words = make_uint4(0u, 0u, 0u, 0u);
    __syncthreads();
    const XcdBarrier xb = xcd_barrier_post(a.bar, (volatile LAS unsigned*)&xb_words, get_tid(wid));
    for (int rep = 0; rep < REP_P0; ++rep) {
        const size_t gtid = (size_t)blockIdx.x * NTHR + get_tid(wid), gs = (size_t)nblk * NTHR;
#define PREP_REST(skip_) do { \
        prep_s5_item((int)blockIdx.x >> 2, (int)blockIdx.x & 3, a.a_re, a.a_im, a.log_dt, a.b_re, a.b_im, a.c_re, a.c_im, a.d_skip, a.KT, a.WST, a.CCAR, a.ABT, smem, wid, &a.pw, gtid, gs, skip_); \
        if (gtid < 8192) { const int jb_ = (int)(gtid >> 11), l_ = jb_ >> 1; \
            conv_kfrag(((jb_ & 1) ? a.pw.k2 : a.pw.k1) + (size_t)l_ * 128 * 128, ((jb_ & 1) ? a.pw.wfk2 : a.pw.wfk1) + (size_t)l_ * (128 * 128 / 8), gtid & 2047, 2048); } } while (0)
        if (nblk == 256) {
            const WJob j0 = wjob_in(a.pw, 0); float v0[8];
            wf_load<true>(j0, gtid, v0); wf_store(j0, gtid, v0);
        } else {
            for (int it = blockIdx.x; it < 256; it += nblk)
                prep_s5_item(it >> 2, it & 3, a.a_re, a.a_im, a.log_dt, a.b_re, a.b_im, a.c_re, a.c_im, a.d_skip, a.KT, a.WST, a.CCAR, a.ABT, smem, wid);
            prep_weights(a.pw, gtid, gs);
            for (int l = 0; l < 2; ++l) {
                conv_kfrag(a.pw.k1 + (size_t)l * 128 * 128, a.pw.wfk1 + (size_t)l * (128 * 128 / 8), gtid, gs);
                conv_kfrag(a.pw.k2 + (size_t)l * 128 * 128, a.pw.wfk2 + (size_t)l * (128 * 128 / 8), gtid, gs);
            }
        }
    }
    XBAR(false);
    if (a.coop_probe) grid.sync();
    __shared__ int sched[4];
    if (get_tid(wid) == 0) {
        int nx = 0, myj = 0, nloc = 1;
        unsigned cjs[16];
#pragma unroll
        for (unsigned j = 0; j < 16; ++j) cjs[j] = xb_ld(&a.bar[XB_XCNT(j)]);
        unsigned csum = 0u;
#pragma unroll
        for (unsigned j = 0; j < 16; ++j) csum += cjs[j];
        asm volatile("" : "+v"(csum));
#pragma unroll
        for (unsigned j = 0; j < 16; ++j) {
            const unsigned cj = cjs[j];
            if (j == xb.x) { myj = nx; nloc = (int)cj; }
            nx += (cj > 0u) ? 1 : 0;
        }
        sched[0] = (int)xb.st[2]; sched[1] = nloc > 0 ? nloc : 1; sched[2] = myj; sched[3] = nx > 0 ? nx : 1;
    }
    __syncthreads();
    const int s_rank = sched[0], s_nloc = sched[1], s_myj = sched[2], s_nx = sched[3];
    const bool hidebg = (nblk * 64 == NEXP);
    const int bg_r0 = ((int)blockIdx.x * 8 + wid) * 8;
    {
            const size_t gtid = (size_t)blockIdx.x * NTHR + get_tid(wid), gs = (size_t)nblk * NTHR;
            const bool prep_first = (nblk == 256) && (((int)blockIdx.x >> 3) & 1);
            if (!prep_first)
                for (int tile = blockIdx.x; tile < NTOK / 64; tile += nblk) phaseA_tile<true>(a.x, a.Hb, a.pw.wfin, a.U, tile, smem, wid, a.v_exp, a.V4, a.SV, -1);
            if (nblk == 256) PREP_REST(true);
            if (prep_first)
                for (int tile = blockIdx.x; tile < NTOK / 64; tile += nblk) phaseA_tile<true>(a.x, a.Hb, a.pw.wfin, a.U, tile, smem, wid, a.v_exp, a.V4, a.SV, -1);
        }
#pragma unroll 1
    for (int l = 0; l < 2; ++l) {
        const float* xin = (l == 0) ? a.x : a.X;
        XBAR(true);
        bf16_t* Ul = a.U + (size_t)l * NTOK * DM;
        for (int rep = 0; rep < REP_PB; ++rep)
        for (int tile = blockIdx.x; tile < 256; tile += nblk)
            phaseB_tile(Ul, a.KT + (size_t)l * 32 * KT_BYTES, a.WST + (size_t)l * 32 * WST_FRAGS, a.CCAR + (size_t)l * 32 * CCAR_FRAGS, a.ABT + l * 32 * 128, a.YPRE, tile, smem, wid,
                        a.v_exp + (size_t)l * NEXP * DM, a.V4 + (size_t)l * NEXP * (DM / 2), a.SV + l * NEXP, hidebg ? bg_r0 : -1);
        if (!hidebg) { EXPERT_SHARE(2 * l); EXPERT_SHARE(2 * l + 1); }
        XBAR(true);
        PCArgs pa; pa.U = Ul; pa.YPRE = a.YPRE; pa.G1 = a.G1; pa.A2 = a.A2; pa.Xin = xin; pa.Xout = a.X; pa.Xdummy = (float*)a.Qb; pa.HPH = a.HPH; pa.HPL = a.HPL; pa.HS = a.HS; pa.Hb = a.Hb; pa.RSTD = a.RSTD;
        pa.wfglu = a.pw.wfglu + (size_t)l * (512 * 512 / 8); pa.b_glu = a.b_glu + l * 512; pa.wfpool = a.pw.wfpool + (size_t)l * 4 * (128 * 128 / 8);
        pa.pool_scale = a.pool_scale + l * 512; pa.wfout = a.pw.wfout + (size_t)l * (DM * DM / 8);
        pa.bg_usrc = a.u_exp + (size_t)l * NEXP * DM; pa.bg_gain = a.pw.norm_ffn + l * DM; pa.bg_udst = a.U4 + (size_t)l * NEXP * (DM / 2); pa.bg_usc = a.SU + l * NEXP; pa.bg_r0 = hidebg ? bg_r0 : -1;
        PRArgs pr; pr.Hb = a.Hb; pr.RSTD = a.RSTD; pr.wfq = a.pw.wfq + (size_t)l * (DM * 2048 / 8); pr.kf1 = a.pw.wfk1 + (size_t)l * (128 * 128 / 8);
        pr.kf2 = a.pw.wfk2 + (size_t)l * (128 * 128 / 8); pr.EX = a.EX; pr.GT = a.GT;
        pr.bg_usrc = pa.bg_usrc; pr.bg_gain = pa.bg_gain; pr.bg_udst = pa.bg_udst; pr.bg_usc = pa.bg_usc; pr.bg_r0 = pa.bg_r0;
        for (int tile = blockIdx.x; tile < NTOK / 64; tile += nblk) {
            for (int rep = 1; rep < REP_C1; ++rep) { PCArgs pa2 = pa; pa2.Xout = (float*)a.Qb; phaseC1_tile(pa2, tile, smem, wid); }
            phaseC1_tile(pa, tile, smem, wid);
            for (int rep = 0; rep < REP_C2; ++rep) phaseC2_tile(pr, tile, smem, wid);
        }
        XBAR(false);
        PSArgs ps; ps.Hb = a.Hb; ps.RSTD = a.RSTD; ps.EX = a.EX; ps.GT = a.GT;
        ps.SU = a.SU + l * NEXP; ps.SV = a.SV + l * NEXP; ps.PD = a.PD; ps.COEF = a.COEF; ps.CS = a.CS; ps.Xin = a.X; ps.Xout = a.X; ps.HPH = a.HPH; ps.HPL = a.HPL; ps.HS = a.HS;
        for (int rep = 0; rep < REP_U; ++rep) {
            for (int v = s_myj; v < 8; v += s_nx) peerUi_run(ps, a.U4 + (size_t)l * NEXP * (DM / 2), v & 3, v >> 2, s_rank, s_nloc, wid);
        }
        XBAR(false);
        for (int rep = 0; rep < REP_R; ++rep)
        for (int tile = blockIdx.x; tile < NTOK / 64; tile += nblk) peerR_tile(ps, tile, wid);
        XBAR(false);
        for (int rep = 1; rep < REP_V; ++rep) { PSArgs ps2 = ps; ps2.Xout = (float*)a.Qb; for (int v = s_myj; v < 8; v += s_nx) PEERV_REP(ps2, a.V4 + (size_t)l * NEXP * (DM / 2), v & 3, v >> 2, s_rank, s_nloc, wid); }
        for (int v = s_myj; v < 8; v += s_nx) PEERV_RUN(ps, a.V4 + (size_t)l * NEXP * (DM / 2), v & 3, v >> 2, s_rank, s_nloc, wid);
        XBAR(true);
        if (l == 0) {
            for (int rep = 0; rep < REP_PA; ++rep)
            for (int tile = blockIdx.x; tile < NTOK / 64; tile += nblk) phaseA_tile<false>(nullptr, a.Hb, a.pw.wfin + (size_t)(DM * DM / 8), a.U + (size_t)NTOK * DM, tile, smem, wid,
                                                                                                  a.v_exp + (size_t)NEXP * DM, a.V4 + (size_t)NEXP * (DM / 2), a.SV + NEXP, -1);
        } else {
            for (int tile = blockIdx.x; tile < NTOK / 64; tile += nblk) final_norm_tile(a.Hb, a.X, a.norm_final, tile, wid);
        }
    }
}

extern "C" void kernel_launch(void* const* d_in, const int* in_sizes, int n_in, void* d_out, int out_size, void* d_ws, size_t ws_size,
                              hipStream_t stream) {
    char* wsb = (char*)d_ws;
    size_t off = 0;
    auto take = [&](size_t bytes) { char* p = wsb + off; off += (bytes + 255) & ~(size_t)255; return p; };
    MegaArgs a;
    memset(&a, 0, sizeof(a));
    a.x = (const float*)d_in[0];
    a.pw.norm_mix = (const float*)d_in[1]; a.pw.w_in = (const float*)d_in[2];
    a.a_re = (const float*)d_in[3]; a.a_im = (const float*)d_in[4]; a.log_dt = (const float*)d_in[5];
    a.b_re = (const float*)d_in[6]; a.b_im = (const float*)d_in[7]; a.c_re = (const float*)d_in[8]; a.c_im = (const float*)d_in[9];
    a.d_skip = (const float*)d_in[10]; a.pw.w_glu = (const float*)d_in[11]; a.b_glu = (const float*)d_in[12];
    a.pw.w_pool = (const float*)d_in[13]; a.pool_scale = (const float*)d_in[14]; a.pw.g_out_ssm = (const float*)d_in[15];
    a.pw.g_out_pool = (const float*)d_in[16]; a.pw.w_out = (const float*)d_in[17]; a.pw.norm_ffn = (const float*)d_in[18];
    a.pw.w_q = (const float*)d_in[19]; a.pw.k1 = (const float*)d_in[20]; a.pw.k2 = (const float*)d_in[21];
    a.u_exp = (const float*)d_in[22]; a.v_exp = (const float*)d_in[23]; a.norm_final = (const float*)d_in[24];
    a.X = (float*)d_out;
    a.U = (bf16_t*)take((size_t)2 * NTOK * DM * 2);
    a.YPRE = (bf16_t*)take((size_t)NTOK * 512 * 2);
    a.G1 = (bf16_t*)take((size_t)NTOK * 512 * 2);
    a.A2 = (bf16_t*)take((size_t)NTOK * DM * 2);
    a.Hb = (bf16_t*)take((size_t)NTOK * DM * 2);
    a.Qb = (bf16_t*)take((size_t)NTOK * 2048 * 2);
    a.EX = (unsigned short*)take((size_t)NTOK * 128 * 2);
    a.GT = (float*)take((size_t)NTOK * 128 * 4);
    a.RSTD = (float*)take(NTOK * 4);
    a.pw.wfin = (bf16x8*)take((size_t)2 * DM * DM * 2);
    a.pw.wfglu = (bf16x8*)take((size_t)2 * 512 * 512 * 2);
    a.pw.wfpool = (bf16x8*)take((size_t)2 * 4 * 128 * 128 * 2);
    a.pw.wfout = (bf16x8*)take((size_t)2 * DM * DM * 2);
    a.pw.wfq = (bf16x8*)take((size_t)2 * DM * 2048 * 2);
    a.pw.wfk1 = (bf16x8*)take((size_t)2 * 128 * 128 * 2);
    a.pw.wfk2 = (bf16x8*)take((size_t)2 * 128 * 128 * 2);
    a.KT = take((size_t)64 * KT_BYTES);
    a.WST = (bf16x8*)take((size_t)64 * WST_FRAGS * 16);
    a.CCAR = (bf16x8*)take((size_t)64 * CCAR_FRAGS * 16);
    a.ABT = (float*)take(64 * 128 * 4);
    a.V4 = (fp4x2_t*)take((size_t)2 * NEXP * (DM / 2));
    a.U4 = (fp4x2_t*)take((size_t)2 * NEXP * (DM / 2));
    a.SU = (float*)take((size_t)2 * NEXP * 4);
    a.SV = (float*)take((size_t)2 * NEXP * 4);
    a.PD = (float*)take((size_t)NUSL * NTOK * 128 * 4);
    a.COEF = (bf16_t*)take((size_t)NTOK * 128 * 2);
    a.CS = (float*)take((size_t)NTOK * 4 + 256);
    a.HPH = (unsigned*)take((size_t)NTOK * 128 * 4);
    a.HPL = (unsigned*)take((size_t)NTOK * 128 * 4);
    a.HS = (float*)take((size_t)NTOK * 4 * 4);
    a.bar = (unsigned*)take((size_t)XCD_BAR_WORDS * 4);
    hipMemsetAsync(a.bar, 0, (size_t)XCD_BAR_WORDS * 4, stream);

    static int grid_blocks = 0;
    if (!grid_blocks) {
        int dev = 0, cus = 0, per_cu = 0;
        hipGetDevice(&dev);
        hipDeviceGetAttribute(&cus, hipDeviceAttributeMultiprocessorCount, dev);
        hipOccupancyMaxActiveBlocksPerMultiprocessor(&per_cu, mega_kernel, NTHR, 0);
        if (per_cu > 1) per_cu = 1;
        grid_blocks = cus * per_cu;
        if (grid_blocks > 256) grid_blocks = 256;
    }
    void* args[] = {&a};
    hipError_t e = hipLaunchCooperativeKernel((void*)mega_kernel, dim3(grid_blocks), dim3(NTHR), args, 0, stream);
    if (e != hipSuccess) fprintf(stderr, "cooperative launch failed: %s (grid %d)\n", hipGetErrorString(e), grid_blocks);
}
```
